# Optimizing an MI355X kernel written in HIP

```python
import math
import jax
import jax.numpy as jnp
from jax import lax
import numpy as np

D_MODEL = 1024
BATCH = 4
SEQ = 4096
DEPTH = 1

GRID_W = 64
CTX_LEN = 256
N_DIR = 2
DN_HEADS = 4
DN_HEAD_DIM = 128
DN_WIDTH = DN_HEADS * DN_HEAD_DIM
DN_CHUNK = 64
SHORT_CONV = 3
S5_WIDTH = 512
S5_GROUP = 16
S5_GROUPS = S5_WIDTH // S5_GROUP
S5_STATE = 64
D_FF = 2816
FFN_CONV = 3
N_BRANCH = 2
N_MOD = 6
RMS_EPS = 1e-6
L2_EPS = 1e-6
IN_SIZES = (DN_WIDTH, DN_WIDTH, DN_WIDTH, DN_WIDTH, N_DIR * DN_HEADS, N_DIR * DN_HEADS, S5_WIDTH, D_MODEL, D_MODEL)
IN_COLS = 4 * DN_WIDTH + 2 * N_DIR * DN_HEADS + S5_WIDTH + N_BRANCH * D_MODEL

kernel_name = "hybrid_gdn_s5_convffn_block"


def rmsnorm(x, w):
    xf = x.astype(jnp.float32)
    y = xf * lax.rsqrt(jnp.mean(xf * xf, axis=-1, keepdims=True) + RMS_EPS)
    return (y * w.astype(jnp.float32)).astype(x.dtype)


def l2norm(x):
    xf = x.astype(jnp.float32)
    return xf * lax.rsqrt(jnp.sum(xf * xf, axis=-1, keepdims=True) + L2_EPS)


def modulate(h, shift, scale):
    return h * (1 + scale) + shift


def flip_if(a, rev, axis):
    return jnp.flip(a, axis=axis) if rev else a


def dw_conv1d(x, w):
    k = w.shape[0]
    pad = k // 2
    t = x.shape[1]
    xp = jnp.pad(x, ((0, 0), (pad, pad), (0, 0)))
    out = xp[:, 0:t] * w[0]
    for j in range(1, k):
        out = out + xp[:, j:j + t] * w[j]
    return out


def dw_conv2d(x, w, rows):
    b, t, ch = x.shape
    img = x.reshape(b, rows, t // rows, ch)
    y = lax.conv_general_dilated(img, w[:, :, None, :].astype(x.dtype), (1, 1), 'SAME',
                                 dimension_numbers=('NHWC', 'HWIO', 'NHWC'), feature_group_count=ch)
    return y.reshape(b, t, ch)


def gated_delta_chunked(q, k, v, g, beta, s0):
    bsz, h, t, _ = q.shape
    dv = v.shape[-1]
    n = t // DN_CHUNK

    def chunks(a):
        return jnp.moveaxis(a.reshape(bsz, h, n, DN_CHUNK, *a.shape[3:]), 2, 0)

    q, k, v, beta = chunks(q), chunks(k), chunks(v), chunks(beta)
    g = jnp.cumsum(chunks(g), axis=-1)
    kb = k * beta[..., None]
    vb = v * beta[..., None]
    idx = jnp.arange(DN_CHUNK)
    incl = idx[:, None] >= idx[None, :]
    strict = idx[:, None] > idx[None, :]
    diff = g[..., :, None] - g[..., None, :]
    decay = jnp.where(incl, jnp.exp(jnp.where(incl, diff, 0.0)), 0.0)
    lmat = jnp.where(strict, jnp.einsum('nbhcd,nbhsd->nbhcs', kb, k) * decay, 0.0)
    rhs = jnp.concatenate([vb, kb * jnp.exp(g)[..., None]], axis=-1)
    sol = lax.linalg.triangular_solve(lmat, rhs, left_side=True, lower=True, unit_diagonal=True)
    u, w = sol[..., :dv], sol[..., dv:]
    a_intra = jnp.einsum('nbhcd,nbhsd->nbhcs', q, k) * decay

    def step(state, xs):
        q_i, k_i, u_i, w_i, g_i, a_i = xs
        v_new = u_i - jnp.einsum('bhck,bhkv->bhcv', w_i, state)
        o = (jnp.einsum('bhck,bhkv->bhcv', q_i * jnp.exp(g_i)[..., None], state)
             + jnp.einsum('bhcs,bhsv->bhcv', a_i, v_new))
        g_last = g_i[..., -1:]
        state = (state * jnp.exp(g_last)[..., None]
                 + jnp.einsum('bhck,bhcv->bhkv', k_i * jnp.exp(g_last - g_i)[..., None], v_new))
        return state, o

    s_fin, o = lax.scan(step, s0, (q, k, u, w, g, a_intra))
    o = jnp.moveaxis(o, 0, 2).reshape(bsz, h, t, dv)
    return s_fin, o


def delta_prep(q, k, v, beta_logit, alpha, conv_w, a_log, dt_bias):
    b, t, _ = q.shape
    qkv = jax.nn.silu(dw_conv1d(jnp.concatenate([q, k, v], axis=-1), conv_w))

    def heads(a):
        return a.reshape(b, t, DN_HEADS, DN_HEAD_DIM).transpose(0, 2, 1, 3)

    qh, kh, vh = [heads(a) for a in jnp.split(qkv, 3, axis=-1)]
    qh = l2norm(qh) * (DN_HEAD_DIM ** -0.5)
    kh = l2norm(kh)
    vh = vh.astype(jnp.float32)

    def per_dir(a):
        return a.astype(jnp.float32).reshape(b, t, N_DIR, DN_HEADS).transpose(0, 2, 3, 1)

    beta = jax.nn.sigmoid(per_dir(beta_logit))
    g = (-jnp.exp(a_log.astype(jnp.float32))[None, :, :, None]
         * jax.nn.softplus(per_dir(alpha) + dt_bias.astype(jnp.float32)[None, :, :, None]))
    return qh, kh, vh, g, beta


def delta_branch(p_ctx, p_lat, conv_w, a_log, dt_bias, norm_w, w_out, need_ctx):
    qc, kc, vc, zc, bc, ac = p_ctx
    ql, kl, vl, zl, bl, al = p_lat
    ctx_in = delta_prep(qc, kc, vc, bc, ac, conv_w, a_log, dt_bias)
    lat_in = delta_prep(ql, kl, vl, bl, al, conv_w, a_log, dt_bias)
    b = ql.shape[0]
    s0 = jnp.zeros((b, DN_HEADS, DN_HEAD_DIM, DN_HEAD_DIM), jnp.float32)
    o_ctx = jnp.zeros_like(ctx_in[2])
    o_lat = jnp.zeros_like(lat_in[2])
    for r in range(N_DIR):
        rev = r == 1
        qh, kh, vh, g, beta = ctx_in
        s_ctx, o = gated_delta_chunked(flip_if(qh, rev, 2), flip_if(kh, rev, 2), flip_if(vh, rev, 2),
                                       flip_if(g[:, r], rev, 2), flip_if(beta[:, r], rev, 2), s0)
        if need_ctx:
            o_ctx = o_ctx + flip_if(o, rev, 2)
        qh, kh, vh, g, beta = lat_in
        _, o = gated_delta_chunked(flip_if(qh, rev, 2), flip_if(kh, rev, 2), flip_if(vh, rev, 2),
                                   flip_if(g[:, r], rev, 2), flip_if(beta[:, r], rev, 2), s_ctx)
        o_lat = o_lat + flip_if(o, rev, 2)

    def post(o, z):
        t = o.shape[2]
        on = rmsnorm(o.transpose(0, 2, 1, 3), norm_w)
        zf = z.astype(jnp.float32).reshape(b, t, DN_HEADS, DN_HEAD_DIM)
        y = (on * jax.nn.silu(zf)).reshape(b, t, DN_WIDTH).astype(z.dtype)
        return y @ w_out

    out_lat = post(o_lat, zl)
    out_ctx = post(o_ctx, zc) if need_ctx else None
    return out_ctx, out_lat


def s5_discretize(a_re, a_im, log_step, b_re, b_im):
    lam = lax.complex(a_re.astype(jnp.float32), a_im.astype(jnp.float32))
    step = jnp.exp(log_step.astype(jnp.float32))[:, None]
    lam_bar = jnp.exp(lam * step)
    bmat = lax.complex(b_re.astype(jnp.float32), b_im.astype(jnp.float32))
    b_bar = ((lam_bar - 1.0) / lam)[..., None] * bmat
    return lam_bar, b_bar


def s5_combine(left, right):
    a_l, b_l = left
    a_r, b_r = right
    return a_r * a_l, a_r * b_l + b_r


def s5_scan(u, lam_bar, b_bar, x0):
    bu = lax.complex(jnp.einsum('btgp,gnp->btgn', u, jnp.real(b_bar)),
                     jnp.einsum('btgp,gnp->btgn', u, jnp.imag(b_bar)))
    bu = bu.at[:, 0].add(lam_bar * x0)
    lam_el = jnp.broadcast_to(lam_bar, bu.shape)
    _, xs = lax.associative_scan(s5_combine, (lam_el, bu), axis=1)
    return xs


def s5_readout(c_re, c_im, xs):
    return (jnp.einsum('gpn,btgn->btgp', c_re, jnp.real(xs))
            - jnp.einsum('gpn,btgn->btgp', c_im, jnp.imag(xs)))


def s5_branch(u_ctx, u_lat, a_re, a_im, log_step, b_re, b_im, c_re, c_im, d_skip,
              w_glu, b_glu, w_out, need_ctx):
    def groups(u):
        return u.astype(jnp.float32).reshape(u.shape[0], u.shape[1], S5_GROUPS, S5_GROUP)

    gc, gl = groups(u_ctx), groups(u_lat)
    dsk = d_skip.astype(jnp.float32).reshape(S5_GROUPS, S5_GROUP)
    y_ctx = dsk * gc
    y_lat = dsk * gl
    x0 = jnp.zeros((gl.shape[0], S5_GROUPS, S5_STATE), jnp.complex64)
    for r in range(N_DIR):
        rev = r == 1
        lam_bar, b_bar = s5_discretize(a_re[r], a_im[r], log_step[r], b_re[r], b_im[r])
        cr = c_re[r].astype(jnp.float32)
        ci = c_im[r].astype(jnp.float32)
        xs_ctx = s5_scan(flip_if(gc, rev, 1), lam_bar, b_bar, x0)
        xs_lat = s5_scan(flip_if(gl, rev, 1), lam_bar, b_bar, xs_ctx[:, -1])
        y_lat = y_lat + flip_if(s5_readout(cr, ci, xs_lat), rev, 1)
        if need_ctx:
            y_ctx = y_ctx + flip_if(s5_readout(cr, ci, xs_ctx), rev, 1)

    def glu_out(y, dtype):
        y = jax.nn.gelu(y.reshape(y.shape[0], y.shape[1], S5_WIDTH)).astype(dtype)
        z = y @ w_glu + b_glu
        y = z[..., :S5_WIDTH] * jax.nn.sigmoid(z[..., S5_WIDTH:])
        return y @ w_out

    out_lat = glu_out(y_lat, u_lat.dtype)
    out_ctx = glu_out(y_ctx, u_ctx.dtype) if need_ctx else None
    return out_ctx, out_lat


def conv_ffn(h, w_up, conv_w, w_down, rows):
    u = dw_conv2d(h @ w_up, conv_w, rows)
    gate, val = jnp.split(u, 2, axis=-1)
    return (jax.nn.silu(gate) * val) @ w_down


def setup_inputs(seed: int = 0) -> dict:
    key = jax.random.key(seed)
    ks = iter(list(jax.random.split(key, 48)))
    f32 = jnp.float32
    L = DEPTH

    def nrm(shape, scale):
        return jax.random.normal(next(ks), shape, f32) * scale

    def gain(shape):
        return 1.0 + nrm(shape, 0.02)

    x = nrm((BATCH, SEQ, D_MODEL), 1.0)
    c = nrm((BATCH, D_MODEL), 1.0)
    ctx = nrm((BATCH, CTX_LEN, D_MODEL), 1.0)
    c_ctx = nrm((D_MODEL,), 1.0)
    w_ada = nrm((L, D_MODEL, N_MOD * D_MODEL), 0.5 * D_MODEL ** -0.5)
    b_ada = nrm((L, N_MOD * D_MODEL), 0.02)
    norm1_w = gain((L, D_MODEL))
    w_in = nrm((L, D_MODEL, IN_COLS), D_MODEL ** -0.5)
    dn_conv_w = nrm((L, SHORT_CONV, 3 * DN_WIDTH), SHORT_CONV ** -0.5)
    dn_a_log = jnp.log(jax.random.uniform(next(ks), (L, N_DIR, DN_HEADS), f32, 1.0, 16.0))
    dt = jnp.exp(jax.random.uniform(next(ks), (L, N_DIR, DN_HEADS), f32, math.log(1e-3), math.log(1e-1)))
    dn_dt_bias = dt + jnp.log(-jnp.expm1(-dt))
    dn_norm_w = gain((L, DN_HEAD_DIM))
    w_a_out = nrm((L, DN_WIDTH, D_MODEL), DN_WIDTH ** -0.5)
    s5_a_re = -0.5 + nrm((L, N_DIR, S5_GROUPS, S5_STATE), 0.01)
    s5_a_im = jnp.pi * jnp.arange(S5_STATE, dtype=f32) + nrm((L, N_DIR, S5_GROUPS, S5_STATE), 0.01)
    s5_log_step = jax.random.uniform(next(ks), (L, N_DIR, S5_GROUPS), f32, math.log(1e-3), math.log(1e-1))
    s5_b_re = nrm((L, N_DIR, S5_GROUPS, S5_STATE, S5_GROUP), (2 * S5_GROUP) ** -0.5)
    s5_b_im = nrm((L, N_DIR, S5_GROUPS, S5_STATE, S5_GROUP), (2 * S5_GROUP) ** -0.5)
    s5_c_re = nrm((L, N_DIR, S5_GROUPS, S5_GROUP, S5_STATE), S5_STATE ** -0.5)
    s5_c_im = nrm((L, N_DIR, S5_GROUPS, S5_GROUP, S5_STATE), S5_STATE ** -0.5)
    s5_d = nrm((L, S5_WIDTH), 0.5)
    w_glu = nrm((L, S5_WIDTH, 2 * S5_WIDTH), S5_WIDTH ** -0.5)
    b_glu = nrm((L, 2 * S5_WIDTH), 0.02)
    w_b_out = nrm((L, S5_WIDTH, D_MODEL), S5_WIDTH ** -0.5)
    w_o = nrm((L, D_MODEL, D_MODEL), D_MODEL ** -0.5)
    norm2_w = gain((L, D_MODEL))
    w_up = nrm((L, D_MODEL, 2 * D_FF), D_MODEL ** -0.5)
    ffn_conv_w = nrm((L, FFN_CONV, FFN_CONV, 2 * D_FF), 1.0 / FFN_CONV)
    w_down = nrm((L, D_FF, D_MODEL), D_FF ** -0.5)
    norm_f_w = gain((D_MODEL,))
    return {"x": x, "c": c, "ctx": ctx, "c_ctx": c_ctx, "w_ada": w_ada, "b_ada": b_ada,
            "norm1_w": norm1_w, "w_in": w_in, "dn_conv_w": dn_conv_w, "dn_a_log": dn_a_log,
            "dn_dt_bias": dn_dt_bias, "dn_norm_w": dn_norm_w, "w_a_out": w_a_out,
            "s5_a_re": s5_a_re, "s5_a_im": s5_a_im, "s5_log_step": s5_log_step,
            "s5_b_re": s5_b_re, "s5_b_im": s5_b_im, "s5_c_re": s5_c_re, "s5_c_im": s5_c_im,
            "s5_d": s5_d, "w_glu": w_glu, "b_glu": b_glu, "w_b_out": w_b_out, "w_o": w_o,
            "norm2_w": norm2_w, "w_up": w_up, "ffn_conv_w": ffn_conv_w, "w_down": w_down,
            "norm_f_w": norm_f_w}


def reference(x, c, ctx, c_ctx, w_ada, b_ada, norm1_w, w_in, dn_conv_w, dn_a_log, dn_dt_bias,
              dn_norm_w, w_a_out, s5_a_re, s5_a_im, s5_log_step, s5_b_re, s5_b_im, s5_c_re,
              s5_c_im, s5_d, w_glu, b_glu, w_b_out, w_o, norm2_w, w_up, ffn_conv_w, w_down,
              norm_f_w):
    rows = x.shape[1] // GRID_W
    split_idx = np.cumsum(IN_SIZES)[:-1].tolist()
    xl, xc = x, ctx
    sc = jax.nn.silu(c)
    scc = jax.nn.silu(c_ctx)
    for l in range(DEPTH):
        need_ctx = l < DEPTH - 1
        mod_l = jnp.split((sc @ w_ada[l] + b_ada[l])[:, None, :], N_MOD, axis=-1)
        mod_c = jnp.split(scc @ w_ada[l] + b_ada[l], N_MOD, axis=-1)

        hl = modulate(rmsnorm(xl, norm1_w[l]), mod_l[0], mod_l[1])
        hc = modulate(rmsnorm(xc, norm1_w[l]), mod_c[0], mod_c[1])
        pl = jnp.split(hl @ w_in[l], split_idx, axis=-1)
        pc = jnp.split(hc @ w_in[l], split_idx, axis=-1)
        ya_c, ya_l = delta_branch(pc[:6], pl[:6], dn_conv_w[l], dn_a_log[l], dn_dt_bias[l],
                                  dn_norm_w[l], w_a_out[l], need_ctx)
        yb_c, yb_l = s5_branch(pc[6], pl[6], s5_a_re[l], s5_a_im[l], s5_log_step[l], s5_b_re[l],
                               s5_b_im[l], s5_c_re[l], s5_c_im[l], s5_d[l], w_glu[l], b_glu[l],
                               w_b_out[l], need_ctx)
        mix_l = (jax.nn.sigmoid(pl[7]) * ya_l + jax.nn.sigmoid(pl[8]) * yb_l) @ w_o[l]
        xl = xl + mod_l[2] * mix_l
        if need_ctx:
            mix_c = (jax.nn.sigmoid(pc[7]) * ya_c + jax.nn.sigmoid(pc[8]) * yb_c) @ w_o[l]
            xc = xc + mod_c[2] * mix_c

        hl = modulate(rmsnorm(xl, norm2_w[l]), mod_l[3], mod_l[4])
        xl = xl + mod_l[5] * conv_ffn(hl, w_up[l], ffn_conv_w[l], w_down[l], rows)
        if need_ctx:
            hc = modulate(rmsnorm(xc, norm2_w[l]), mod_c[3], mod_c[4])
            xc = xc + mod_c[5] * conv_ffn(hc, w_up[l], ffn_conv_w[l], w_down[l], 1)
    return rmsnorm(xl, norm_f_w)
```

```cpp
#include <hip/hip_runtime.h>
#include <hip/hip_cooperative_groups.h>
#include <cstdio>
#include <cstdint>
namespace cg = cooperative_groups;

#ifndef MULTI_LAUNCH
#define MULTI_LAUNCH 0
#endif

typedef unsigned short u16;
typedef __attribute__((ext_vector_type(8))) short bf16x8;
typedef __attribute__((ext_vector_type(4))) float f32x4;

#define NT 512
constexpr int LDS_BYTES = 131072;
constexpr int NPHASE = 18;

constexpr size_t OFF_WT_IN   = 0;
constexpr size_t OFF_WT_AOUT = 9699328;
constexpr size_t OFF_WT_GLU  = 10747904;
constexpr size_t OFF_WT_BOUT = 11796480;
constexpr size_t OFF_WT_O    = 12845056;
constexpr size_t OFF_WT_UP   = 14942208;
constexpr size_t OFF_WT_DOWN = 26476544;
constexpr size_t OFF_MOD     = 32243712;
constexpr size_t OFF_R2      = 33554432;
constexpr size_t OFF_R1      = 69206016;
constexpr size_t OFF_KTAB    = OFF_R1;
constexpr size_t OFF_MEND    = OFF_R1 + 2097152;
constexpr size_t OFF_MST     = OFF_R1 + 10485760;
constexpr size_t OFF_MINTRA  = OFF_R1 + 18874368;
constexpr size_t OFF_R3      = 104857600;
constexpr size_t OFF_O       = OFF_R3;
constexpr size_t OFF_XIN     = OFF_R3 + 33554432;
constexpr size_t OFF_MIX     = 158334976;
constexpr size_t OFF_SG      = OFF_R1;
constexpr size_t OFF_Z       = 158334976;
constexpr size_t OFF_U5      = 175112192;
constexpr size_t OFF_BA      = 192937984;
constexpr size_t OFF_GC      = OFF_BA + 1179648;
constexpr size_t OFF_UF      = 195035136;
constexpr size_t OFF_YA      = OFF_UF;
constexpr size_t OFF_YB      = OFF_UF + 16777216;
constexpr size_t OFF_E       = 230686720;
constexpr size_t OFF_YG      = OFF_E;
constexpr size_t OFF_UPH     = OFF_R1;
constexpr size_t OFF_G       = 161480704;
constexpr size_t WS_NEED     = 253755392;
constexpr size_t OFF_QKN     = 0;
constexpr size_t OFF_AQ      = 35651584;

struct Params {
  const float *x, *c, *ctx, *c_ctx, *w_ada, *b_ada, *norm1_w, *w_in, *dn_conv_w, *dn_a_log, *dn_dt_bias, *dn_norm_w,
      *w_a_out, *s5_a_re, *s5_a_im, *s5_log_step, *s5_b_re, *s5_b_im, *s5_c_re, *s5_c_im, *s5_d, *w_glu, *b_glu,
      *w_b_out, *w_o, *norm2_w, *w_up, *ffn_conv_w, *w_down, *norm_f_w;
  float* out;
  char* ws;
  long long ph_lo, ph_hi;
};

__device__ __forceinline__ u16 f2bf(float f) {
  uint32_t u = __float_as_uint(f);
  u += 0x7fffu + ((u >> 16) & 1u);
  return (u16)(u >> 16);
}
__device__ __forceinline__ float bf2f(u16 h) { return __uint_as_float(((uint32_t)h) << 16); }
__device__ __forceinline__ uint32_t pack2(float a, float b) { return (uint32_t)f2bf(a) | ((uint32_t)f2bf(b) << 16); }
__device__ __forceinline__ float lo16(uint32_t w) { return __uint_as_float(w << 16); }
__device__ __forceinline__ float hi16(uint32_t w) { return __uint_as_float(w & 0xffff0000u); }
__device__ __forceinline__ int opq(int v) { asm volatile("" : "+v"(v)); return v; }
__device__ __forceinline__ float sigm(float x) { return 1.f / (1.f + __expf(-x)); }
__device__ __forceinline__ void unpack8(uint4 v, float* f) {
  f[0] = lo16(v.x); f[1] = hi16(v.x); f[2] = lo16(v.y); f[3] = hi16(v.y);
  f[4] = lo16(v.z); f[5] = hi16(v.z); f[6] = lo16(v.w); f[7] = hi16(v.w);
}
__device__ __forceinline__ uint4 pack8(const float* f) {
  uint4 v; v.x = pack2(f[0], f[1]); v.y = pack2(f[2], f[3]); v.z = pack2(f[4], f[5]); v.w = pack2(f[6], f[7]);
  return v;
}
__device__ __forceinline__ float wsum64(float v) {
#pragma unroll
  for (int o = 32; o > 0; o >>= 1) v += __shfl_xor(v, o, 64);
  return v;
}
__device__ __forceinline__ float gelu_tanh(float x) {
  float u = 0.7978845608028654f * (x + 0.044715f * x * x * x);
  float t = 1.f - 2.f / (1.f + __expf(2.f * u));
  return 0.5f * x * (1.f + t);
}

__device__ __forceinline__ void gemm_main(const u16* __restrict__ A, int lda, const u16* __restrict__ Bt, int ldb, int K,
                                          f32x4 (&acc)[4][4], u16* lds) {
  const int tid = opq(threadIdx.x), lane = tid & 63, w = tid >> 6, wm = w >> 1, wn = w & 1, fr = lane & 15, fq = lane >> 4;
  u16* As = lds;
  u16* Bs = lds + 2 * 256 * 72;
  const int nk = K >> 6;
  uint4 ra[4], rb[2];
  const int lr = tid >> 3, lc = (tid & 7) * 8;
  const u16* ap = A + (size_t)lr * lda + lc;
  const u16* bp = Bt + (size_t)lr * ldb + lc;
  __syncthreads();
#pragma unroll
  for (int i = 0; i < 4; ++i) ra[i] = *(const uint4*)(ap + (size_t)i * 64 * lda);
#pragma unroll
  for (int i = 0; i < 2; ++i) rb[i] = *(const uint4*)(bp + (size_t)i * 64 * ldb);
#pragma unroll
  for (int i = 0; i < 4; ++i) *(uint4*)(As + (lr + i * 64) * 72 + lc) = ra[i];
#pragma unroll
  for (int i = 0; i < 2; ++i) *(uint4*)(Bs + (lr + i * 64) * 72 + lc) = rb[i];
  __syncthreads();
  for (int kt = 0; kt < nk; ++kt) {
    const int buf = kt & 1;
    if (kt + 1 < nk) {
#pragma unroll
      for (int i = 0; i < 4; ++i) ra[i] = *(const uint4*)(ap + (size_t)i * 64 * lda + (kt + 1) * 64);
#pragma unroll
      for (int i = 0; i < 2; ++i) rb[i] = *(const uint4*)(bp + (size_t)i * 64 * ldb + (kt + 1) * 64);
    }
    const u16* as = As + (buf * 256 + wm * 64 + fr) * 72 + fq * 8;
    const u16* bs = Bs + (buf * 128 + wn * 64 + fr) * 72 + fq * 8;
#pragma unroll
    for (int ks = 0; ks < 2; ++ks) {
      bf16x8 a[4], b[4];
#pragma unroll
      for (int i = 0; i < 4; ++i) a[i] = *(const bf16x8*)(as + i * 16 * 72 + ks * 32);
#pragma unroll
      for (int j = 0; j < 4; ++j) b[j] = *(const bf16x8*)(bs + j * 16 * 72 + ks * 32);
#pragma unroll
      for (int i = 0; i < 4; ++i)
#pragma unroll
        for (int j = 0; j < 4; ++j) acc[i][j] = __builtin_amdgcn_mfma_f32_16x16x32_bf16(a[i], b[j], acc[i][j], 0, 0, 0);
    }
    if (kt + 1 < nk) {
      const int nb = buf ^ 1;
#pragma unroll
      for (int i = 0; i < 4; ++i) *(uint4*)(As + (nb * 256 + lr + i * 64) * 72 + lc) = ra[i];
#pragma unroll
      for (int i = 0; i < 2; ++i) *(uint4*)(Bs + (nb * 128 + lr + i * 64) * 72 + lc) = rb[i];
    }
    __syncthreads();
  }
}

__device__ __forceinline__ void acc_zero(f32x4 (&acc)[4][4]) {
#pragma unroll
  for (int i = 0; i < 4; ++i)
#pragma unroll
    for (int j = 0; j < 4; ++j) acc[i][j] = f32x4{0.f, 0.f, 0.f, 0.f};
}

#define TILE_COORDS                                                                                  \
  const int tid_ = opq(threadIdx.x), lane_ = tid_ & 63, w_ = tid_ >> 6, wm_ = w_ >> 1, wn_ = w_ & 1,     \
            fr_ = lane_ & 15, fq_ = lane_ >> 4;
#define TROW(m0, i, e) ((m0) + wm_ * 64 + (i) * 16 + fq_ * 4 + (e))
#define TCOL(n0, j) ((n0) + wn_ * 64 + (j) * 16 + fr_)

__device__ __forceinline__ int srccol(int which, int r) {
  switch (which) {
    case 0:
      if (r < 2048) return r;
      if (r < 2560) return 2064 + (r - 2048);
      if (r < 2576) return 2048 + (r - 2560);
      if (r < 2688) return -1;
      if (r < 3712) return 2576 + (r - 2688);
      return 3600 + (r - 3712);
    case 2: {
      int tile = r >> 7, wn = (r >> 6) & 1, wi = r & 63;
      return (wi < 32) ? (tile * 64 + wn * 32 + wi) : (512 + tile * 64 + wn * 32 + (wi - 32));
    }
    case 5: {
      int hh = r / 2816, cc = r % 2816;
      return (cc < 1408) ? (hh * 1408 + cc) : (2816 + hh * 1408 + (cc - 1408));
    }
    default: return r;
  }
}

__device__ __forceinline__ void convert_item(const float* __restrict__ src, int K, int N, u16* __restrict__ dst, int which, int item, char* lds) {
  float* tile = (float*)lds;
  const int tid = opq(threadIdx.x);
  const int kb = K >> 7;
  const int r0 = (item / kb) * 32, k0 = (item % kb) * 128;
  __syncthreads();
  {
    const int nn = tid & 31, kk = tid >> 5;
    const int sc = srccol(which, r0 + nn);
#pragma unroll
    for (int it = 0; it < 8; ++it) {
      const int k = kk + 16 * it;
      float v = (sc >= 0) ? src[(size_t)(k0 + k) * N + sc] : 0.f;
      tile[nn * 129 + k] = v;
    }
  }
  __syncthreads();
  {
    const int row = tid >> 4, ks = (tid & 15) * 8;
    float f[8];
#pragma unroll
    for (int e = 0; e < 8; ++e) f[e] = tile[row * 129 + ks + e];
    *(uint4*)(dst + (size_t)(r0 + row) * K + k0 + ks) = pack8(f);
  }
}

__device__ __forceinline__ void mod_item(const Params& P, int item, char* lds) {
  float* sc = (float*)lds;
  float* red = sc + 5 * 1024;
  const int tid = opq(threadIdx.x);
  __syncthreads();
  for (int i = tid; i < 5 * 1024; i += NT) {
    const int r = i >> 10, k = i & 1023;
    float v = (r < 4) ? P.c[r * 1024 + k] : P.c_ctx[k];
    sc[i] = v * sigm(v);
  }
  __syncthreads();
  const int nn = tid & 31, kg = tid >> 5;
  const int n = item * 32 + nn;
  float a0 = 0, a1 = 0, a2 = 0, a3 = 0, a4 = 0;
  for (int kk = 0; kk < 64; ++kk) {
    const int k = kg * 64 + kk;
    const float wv = P.w_ada[(size_t)k * 6144 + n];
    a0 += sc[k] * wv; a1 += sc[1024 + k] * wv; a2 += sc[2048 + k] * wv; a3 += sc[3072 + k] * wv; a4 += sc[4096 + k] * wv;
  }
  red[(kg * 5 + 0) * 32 + nn] = a0; red[(kg * 5 + 1) * 32 + nn] = a1; red[(kg * 5 + 2) * 32 + nn] = a2;
  red[(kg * 5 + 3) * 32 + nn] = a3; red[(kg * 5 + 4) * 32 + nn] = a4;
  __syncthreads();
  if (tid < 160) {
    const int r = tid >> 5, n2 = tid & 31;
    float s = 0.f;
#pragma unroll
    for (int g = 0; g < 16; ++g) s += red[(g * 5 + r) * 32 + n2];
    float* MOD = (float*)(P.ws + OFF_MOD);
    MOD[r * 6144 + item * 32 + n2] = s + P.b_ada[item * 32 + n2];
  }
}

__device__ __forceinline__ void lam_pow(float step, float are, float aim, int e, float& pr, float& pi) {
  const float mag = expf((float)e * step * are);
  double ang = (double)e * (double)step * (double)aim;
  ang -= 6.283185307179586476925 * rint(ang * 0.15915494309189533577);
  float s, c;
  __sincosf((float)ang, &s, &c);
  pr = mag * c; pi = mag * s;
}

__device__ __forceinline__ void s5tab_item(const Params& P, int item, char* lds) {
  const int tid = opq(threadIdx.x);
  const int tau = item & 31, g = (item >> 5) & 31, r = item >> 10;
  float* cfr = (float*)lds;
  float* cfi = cfr + 64;
  float* p0r = cfi + 64;
  float* p0i = p0r + 64;
  float* p1r = p0i + 64;
  float* p1i = p1r + 64;
  float* Gr = p1i + 64;
  float* Gi = Gr + 1024;
  float* Cr = Gi + 1024;
  float* Ci = Cr + 1024;
  const int rg = r * 32 + g;
  __syncthreads();
  if (tid < 64) {
    const int n = tid;
    const float step = expf(P.s5_log_step[rg]);
    const float are = P.s5_a_re[rg * 64 + n], aim = P.s5_a_im[rg * 64 + n];
    const float za = step * are;
    double zb = (double)step * (double)aim;
    zb -= 6.283185307179586476925 * rint(zb * 0.15915494309189533577);
    float sb, cb, sh, ch;
    __sincosf((float)zb, &sb, &cb);
    __sincosf((float)(0.5 * zb), &sh, &ch);
    const float em1 = expm1f(za);
    const float re1 = em1 * cb - 2.f * sh * sh;
    const float im1 = (1.f + em1) * sb;
    const float den = are * are + aim * aim;
    cfr[n] = (re1 * are + im1 * aim) / den;
    cfi[n] = (im1 * are - re1 * aim) / den;
    float pr, pi;
    lam_pow(step, are, aim, tau, pr, pi);
    p0r[n] = pr; p0i[n] = pi;
    lam_pow(step, are, aim, tau + 1, pr, pi);
    p1r[n] = pr; p1i[n] = pi;
  }
  for (int i = tid; i < 1024; i += NT) {
    Cr[i] = P.s5_c_re[(size_t)rg * 1024 + i];
    Ci[i] = P.s5_c_im[(size_t)rg * 1024 + i];
  }
  __syncthreads();
  for (int i = tid; i < 1024; i += NT) {
    const int n = i >> 4;
    const float br = P.s5_b_re[(size_t)rg * 1024 + i], bi = P.s5_b_im[(size_t)rg * 1024 + i];
    const float tr = cfr[n] * br - cfi[n] * bi, ti = cfr[n] * bi + cfi[n] * br;
    Gr[i] = p0r[n] * tr - p0i[n] * ti;
    Gi[i] = p0r[n] * ti + p0i[n] * tr;
  }
  __syncthreads();
  u16* MEND = (u16*)(P.ws + OFF_MEND);
  u16* MST = (u16*)(P.ws + OFF_MST);
  float* KTAB = (float*)(P.ws + OFF_KTAB);
  {
    const int ii = (r == 0) ? (31 - tau) : tau;
    for (int i = tid; i < 2048; i += NT) {
      const int part = i >> 10, n = (i >> 4) & 63, pi_ = i & 15;
      const float v = part ? Gi[n * 16 + pi_] : Gr[n * 16 + pi_];
      MEND[((size_t)g * 256 + r * 128 + part * 64 + n) * 512 + ii * 16 + pi_] = f2bf(v);
    }
  }
  if (tid < 256) {
    const int po = tid >> 4, pi_ = tid & 15;
    float s = 0.f;
    for (int n = 0; n < 64; ++n) s += Cr[po * 64 + n] * Gr[n * 16 + pi_] - Ci[po * 64 + n] * Gi[n * 16 + pi_];
    KTAB[(((size_t)rg) * 32 + tau) * 256 + tid] = s;
  }
  {
    const int jj = (r == 0) ? tau : (31 - tau);
    for (int i = tid; i < 2048; i += NT) {
      const int po = i >> 7, part = (i >> 6) & 1, n = i & 63;
      const float cr = Cr[po * 64 + n], ci = Ci[po * 64 + n];
      const float v = part ? -(cr * p1i[n] + ci * p1r[n]) : (cr * p1r[n] - ci * p1i[n]);
      MST[((size_t)g * 512 + jj * 16 + po) * 256 + r * 128 + part * 64 + n] = f2bf(v);
    }
  }
}

__device__ __forceinline__ void norm_row(const float* __restrict__ xr, const float* __restrict__ nw, const float* __restrict__ shift,
                                         const float* __restrict__ scale, u16* __restrict__ dst, int lane) {
  float4 v[4];
  float ss = 0.f;
#pragma unroll
  for (int it = 0; it < 4; ++it) {
    v[it] = *(const float4*)(xr + (it * 64 + lane) * 4);
    ss += v[it].x * v[it].x + v[it].y * v[it].y + v[it].z * v[it].z + v[it].w * v[it].w;
  }
  ss = wsum64(ss);
  const float rstd = rsqrtf(ss * (1.f / 1024.f) + 1e-6f);
#pragma unroll
  for (int it = 0; it < 4; ++it) {
    const int c = (it * 64 + lane) * 4;
    const float4 w4 = *(const float4*)(nw + c), sh = *(const float4*)(shift + c), sc = *(const float4*)(scale + c);
    const float y0 = v[it].x * rstd * w4.x * (1.f + sc.x) + sh.x;
    const float y1 = v[it].y * rstd * w4.y * (1.f + sc.y) + sh.y;
    const float y2 = v[it].z * rstd * w4.z * (1.f + sc.z) + sh.z;
    const float y3 = v[it].w * rstd * w4.w * (1.f + sc.w) + sh.w;
    uint2 o; o.x = pack2(y0, y1); o.y = pack2(y2, y3);
    *(uint2*)(dst + c) = o;
  }
}

__device__ __forceinline__ void norm1_item(const Params& P, int item) {
  const int lane = opq(threadIdx.x) & 63, w = opq(threadIdx.x) >> 6;
  const int row = item * 8 + w;
  const float* MOD = (const float*)(P.ws + OFF_MOD);
  const int bi = (row < 16384) ? (row >> 12) : 4;
  const float* xr = (row < 16384) ? (P.x + (size_t)row * 1024) : (P.ctx + (size_t)(row - 16384) * 1024);
  norm_row(xr, P.norm1_w, MOD + bi * 6144, MOD + bi * 6144 + 1024, (u16*)(P.ws + OFF_R2) + (size_t)row * 1024, lane);
}

__device__ __forceinline__ void mintra_item(const Params& P, int item) {
  const int tid = opq(threadIdx.x);
  const int rowg = item * 8 + (tid >> 6);
  const int g = rowg >> 9, nout = rowg & 511, j = nout >> 4, po = nout & 15;
  const int k0 = (tid & 63) * 8, i = k0 >> 4, pi0 = k0 & 15;
  const float* KTAB = (const float*)(P.ws + OFF_KTAB);
  float f[8];
#pragma unroll
  for (int e = 0; e < 8; ++e) f[e] = 0.f;
  if (i <= j) {
    const float* kp = KTAB + (((size_t)(0 * 32 + g)) * 32 + (j - i)) * 256 + po * 16 + pi0;
#pragma unroll
    for (int e = 0; e < 8; ++e) f[e] += kp[e];
  }
  if (i >= j) {
    const float* kp = KTAB + (((size_t)(1 * 32 + g)) * 32 + (i - j)) * 256 + po * 16 + pi0;
#pragma unroll
    for (int e = 0; e < 8; ++e) f[e] += kp[e];
  }
  if (i == j) {
    const float dv = P.s5_d[g * 16 + po];
#pragma unroll
    for (int e = 0; e < 8; ++e) if (pi0 + e == po) f[e] += dv;
  }
  u16* MI = (u16*)(P.ws + OFF_MINTRA);
  *(uint4*)(MI + (size_t)rowg * 512 + k0) = pack8(f);
}

__device__ __forceinline__ void inproj_tile(const Params& P, int t, char* lds) {
  int mt, nt;
  if (t < 1344) { nt = t / 64; mt = t % 64; }
  else {
    const int tt = t - 1344; mt = 64 + (tt & 3);
    const int ni = tt >> 2;
    nt = (ni < 8) ? (4 + ni) : ((ni < 12) ? (16 + ni - 8) : 20);
  }
  const int m0 = mt * 256, n0 = nt * 128;
  f32x4 acc[4][4];
  acc_zero(acc);
  gemm_main((const u16*)(P.ws + OFF_R2) + (size_t)m0 * 1024, 1024, (const u16*)(P.ws + OFF_WT_IN) + (size_t)n0 * 1024, 1024, 1024, acc, (u16*)lds);
  TILE_COORDS
  if (nt < 12) {
    u16* QKV = (u16*)(P.ws + OFF_R3);
#pragma unroll
    for (int i = 0; i < 4; ++i)
#pragma unroll
      for (int j = 0; j < 4; ++j)
#pragma unroll
        for (int e = 0; e < 4; ++e) QKV[(size_t)TROW(m0, i, e) * 1536 + TCOL(n0, j)] = f2bf(acc[i][j][e]);
  } else if (nt < 16) {
    u16* Z = (u16*)(P.ws + OFF_Z);
#pragma unroll
    for (int i = 0; i < 4; ++i)
#pragma unroll
      for (int j = 0; j < 4; ++j)
#pragma unroll
        for (int e = 0; e < 4; ++e) Z[(size_t)TROW(m0, i, e) * 512 + TCOL(n0, j) - 1536] = f2bf(acc[i][j][e]);
  } else if (nt < 20) {
    u16* U5 = (u16*)(P.ws + OFF_U5);
#pragma unroll
    for (int i = 0; i < 4; ++i)
#pragma unroll
      for (int j = 0; j < 4; ++j)
#pragma unroll
        for (int e = 0; e < 4; ++e) {
          const int cc = TCOL(n0, j) - 2048;
          U5[((size_t)(cc >> 4) * 17408 + TROW(m0, i, e)) * 16 + (cc & 15)] = f2bf(acc[i][j][e]);
        }
  } else {
    float* BA = (float*)(P.ws + OFF_BA);
#pragma unroll
    for (int i = 0; i < 4; ++i)
#pragma unroll
      for (int j = 0; j < 4; ++j)
#pragma unroll
        for (int e = 0; e < 4; ++e) {
          const int cc = TCOL(n0, j) - 2560;
          if (cc < 16) BA[(size_t)TROW(m0, i, e) * 16 + cc] = acc[i][j][e];
        }
  }
}

template <int DIR>
__device__ __forceinline__ void solve_cols(const Params& P, int itb, int c, const float* Lt, const float* bpp, const float* gcp,
                                           const u16* Vs, const u16* Ks) {
  float sol[64];
  const float* bp_ = bpp + DIR * 64;
  const float* gc_ = gcp + DIR * 64;
  if (c < 128) {
    const u16* vp = Vs + c;
#pragma unroll
    for (int p = 0; p < 64; ++p) sol[p] = bp_[p] * bf2f(vp[(DIR ? (63 - p) : p) * 136]);
  } else {
    const u16* kp = Ks + (c - 128);
#pragma unroll
    for (int p = 0; p < 64; ++p) sol[p] = bp_[p] * __expf(gc_[p]) * bf2f(kp[(DIR ? (63 - p) : p) * 136]);
  }
  const float* Lr = Lt + opq(DIR * 4096);
#ifndef NO_SOLVE
#pragma unroll
  for (int j = 0; j < 63; ++j) {
    const float sj = sol[j];
#pragma unroll
    for (int i = j + 1; i < 64; ++i) sol[i] -= Lr[j * 64 + i] * sj;
  }
#endif
  const size_t it2 = (size_t)(itb + DIR);
  if (c < 128) {
    u16* UF = (u16*)(P.ws + OFF_UF) + (it2 * 128 + c) * 64;
#pragma unroll
    for (int q = 0; q < 8; ++q) *(uint4*)(UF + q * 8) = pack8(sol + q * 8);
  } else {
    u16* Wg = (u16*)(P.ws + OFF_R2) + it2 * 8192 + (c - 128);
#pragma unroll
    for (int p = 0; p < 64; ++p) Wg[p * 128] = f2bf(-sol[p]);
  }
}

__device__ __forceinline__ void delta_prep_item(const Params& P, int item, char* lds) {
  const int tid = opq(threadIdx.x), lane = tid & 63, wv = tid >> 6, fr = lane & 15, fq = lane >> 4;
  const int cid = item >> 2, h = item & 3;
  const int row0 = cid * 64;
  int seq_lo, seq_hi;
  if (cid < 256) { seq_lo = (cid >> 6) * 4096; seq_hi = seq_lo + 4096; }
  else { seq_lo = 16384 + ((cid - 256) >> 2) * 256; seq_hi = seq_lo + 256; }
  u16* Qs = (u16*)(lds + opq(0));
  u16* Ks = (u16*)(lds + opq(17408));
  u16* Vs = (u16*)(lds + opq(34816));
  float* KKs = (float*)(lds + opq(52224));
  float* QKs = (float*)(lds + opq(69632));
  float* Lt = (float*)(lds + opq(87040));
  float* gtok = (float*)(lds + opq(119808));
  float* btok = gtok + 128;
  float* gcp = btok + 128;
  float* bpp = gcp + 128;
  u16* QKN = (u16*)((char*)P.out + OFF_QKN);
  __syncthreads();
  {
    const int j = tid >> 3, sg = tid & 7;
    const int row = row0 + j;
    const bool hm = (row - 1 >= seq_lo), hp = (row + 1 < seq_hi);
    const u16* qkv = (const u16*)(P.ws + OFF_R3);
#pragma unroll
    for (int s = 0; s < 3; ++s) {
      const int col = s * 512 + h * 128 + sg * 16;
      const u16* p0 = qkv + (size_t)row * 1536 + col;
      const uint4 zero4 = make_uint4(0, 0, 0, 0);
      float y[16];
      float ssq = 0.f;
#pragma unroll
      for (int hh = 0; hh < 2; ++hh) {
        const uint4 c0 = *(const uint4*)(p0 + hh * 8);
        const uint4 m0 = hm ? *(const uint4*)(p0 - 1536 + hh * 8) : zero4;
        const uint4 n0 = hp ? *(const uint4*)(p0 + 1536 + hh * 8) : zero4;
        float fc[8], fm[8], fn[8];
        unpack8(c0, fc); unpack8(m0, fm); unpack8(n0, fn);
        const float* cw = P.dn_conv_w + col + hh * 8;
#pragma unroll
        for (int e = 0; e < 8; ++e) {
          const float v = cw[e] * fm[e] + cw[1536 + e] * fc[e] + cw[3072 + e] * fn[e];
          const float yy = v * sigm(v);
          y[hh * 8 + e] = yy;
          ssq += yy * yy;
        }
      }
      if (s < 2) {
        ssq += __shfl_xor(ssq, 1, 64); ssq += __shfl_xor(ssq, 2, 64); ssq += __shfl_xor(ssq, 4, 64);
        const float sc = rsqrtf(ssq + 1e-6f) * ((s == 0) ? 0.08838834764831845f : 1.f);
#pragma unroll
        for (int e = 0; e < 16; ++e) y[e] *= sc;
      }
      u16* dl = ((s == 0) ? Qs : ((s == 1) ? Ks : Vs)) + j * 136 + sg * 16;
      const uint4 o0 = pack8(y), o1 = pack8(y + 8);
      *(uint4*)dl = o0; *(uint4*)(dl + 8) = o1;
      if (s < 2) {
        u16* dg = QKN + (size_t)row * 1024 + s * 512 + h * 128 + sg * 16;
        *(uint4*)dg = o0; *(uint4*)(dg + 8) = o1;
      }
    }
  }
  if (tid < 128) {
    const int j = tid & 63, dir = tid >> 6;
    const float* BA = (const float*)(P.ws + OFF_BA) + (size_t)(row0 + j) * 16;
    const float bl = BA[dir * 4 + h], al = BA[8 + dir * 4 + h];
    const float xx = al + P.dn_dt_bias[dir * 4 + h];
    const float sp = (xx > 20.f) ? xx : log1pf(expf(xx));
    gtok[dir * 64 + j] = -expf(P.dn_a_log[dir * 4 + h]) * sp;
    btok[dir * 64 + j] = 1.f / (1.f + expf(-bl));
  }
  __syncthreads();
  if (tid < 2) {
    const int dir = tid;
    float a = 0.f;
    for (int p = 0; p < 64; ++p) {
      const int tk = dir ? (63 - p) : p;
      a += gtok[dir * 64 + tk];
      gcp[dir * 64 + p] = a;
      bpp[dir * 64 + p] = btok[dir * 64 + tk];
    }
  }
  {
#pragma unroll
    for (int q = 0; q < 4; ++q) {
      const int t = wv * 4 + q;
      const int which = t >> 4, mi = (t >> 2) & 3, ni = t & 3;
      const u16* Am = (which ? Qs : Ks) + (mi * 16 + fr) * 136 + fq * 8;
      const u16* Bm = Ks + (ni * 16 + fr) * 136 + fq * 8;
      f32x4 a4 = {0.f, 0.f, 0.f, 0.f};
#pragma unroll
      for (int kk = 0; kk < 4; ++kk)
        a4 = __builtin_amdgcn_mfma_f32_16x16x32_bf16(*(const bf16x8*)(Am + kk * 32), *(const bf16x8*)(Bm + kk * 32), a4, 0, 0, 0);
      float* dst = which ? QKs : KKs;
#pragma unroll
      for (int e = 0; e < 4; ++e) dst[(mi * 16 + fq * 4 + e) * 68 + ni * 16 + fr] = a4[e];
    }
  }
  __syncthreads();
  const int itb = item * 2;
  {
    u16* AQ = (u16*)((char*)P.out + OFF_AQ);
    for (int idx = tid; idx < 8192; idx += NT) {
      const int dir = idx >> 12, p = (idx >> 6) & 63, s = idx & 63;
      const int tp = dir ? (63 - p) : p, ts = dir ? (63 - s) : s;
      const float dg = gcp[dir * 64 + p] - gcp[dir * 64 + s];
      const float dec = (p >= s) ? __expf(dg) : 0.f;
      const float lv = (p > s) ? bpp[dir * 64 + p] * KKs[tp * 68 + ts] * dec : 0.f;
      Lt[dir * 4096 + s * 64 + p] = lv;
      AQ[((size_t)(itb + dir) * 64 + p) * 64 + s] = f2bf(QKs[tp * 68 + ts] * dec);
    }
    if (tid < 128) {
      float* GC = (float*)(P.ws + OFF_GC);
      GC[(size_t)(itb + (tid >> 6)) * 64 + (tid & 63)] = gcp[tid];
    }
  }
  __syncthreads();
  if (tid < 256) solve_cols<0>(P, itb, tid, Lt, bpp, gcp, Vs, Ks);
  else solve_cols<1>(P, itb, tid - 256, Lt, bpp, gcp, Vs, Ks);
}

__device__ __forceinline__ void s5end_tile(const Params& P, int t, char* lds) {
  const int g = t / 6, mt = (t % 6) >> 1, nt = t & 1;
  const int m0 = mt * 256, n0 = nt * 128;
  f32x4 acc[4][4];
  acc_zero(acc);
  gemm_main((const u16*)(P.ws + OFF_U5) + ((size_t)g * 544 + m0) * 512, 512,
            (const u16*)(P.ws + OFF_MEND) + ((size_t)g * 256 + n0) * 512, 512, 512, acc, (u16*)lds);
  TILE_COORDS
  float* E = (float*)(P.ws + OFF_E);
#pragma unroll
  for (int i = 0; i < 4; ++i)
#pragma unroll
    for (int j = 0; j < 4; ++j)
#pragma unroll
      for (int e = 0; e < 4; ++e) {
        const int row = TROW(m0, i, e);
        if (row < 544) E[((size_t)g * 544 + row) * 256 + TCOL(n0, j)] = acc[i][j][e];
      }
}

__device__ __forceinline__ void delta_scan_block(const Params& P, int sb, char* lds) {
  const int tid = opq(threadIdx.x), lane = tid & 63, w = tid >> 6, fr = lane & 15, fq = lane >> 4;
  const int b = sb >> 3, h = (sb >> 1) & 3, dir = sb & 1;
  u16* Wl = (u16*)(lds + opq(0));
  u16* QTl = (u16*)(lds + opq(17408));
  u16* KTl = (u16*)(lds + opq(34816));
  u16* AQl = (u16*)(lds + opq(53248));
  u16* ST = (u16*)(lds + opq(62464));
  u16* VT = (u16*)(lds + opq(97280));
  __syncthreads();
  for (int i = tid; i < 128 * 136 / 2; i += NT) ((uint32_t*)ST)[i] = 0u;
  f32x4 accS[8];
#pragma unroll
  for (int d = 0; d < 8; ++d) accS[d] = f32x4{0.f, 0.f, 0.f, 0.f};
  const int nw = w * 16;
  const u16* QKN = (const u16*)((const char*)P.out + OFF_QKN);
  const u16* AQg = (const u16*)((const char*)P.out + OFF_AQ);
  const u16* Wg = (const u16*)(P.ws + OFF_R2);
  const u16* UFg = (const u16*)(P.ws + OFF_UF);
  const float* GC = (const float*)(P.ws + OFF_GC);
  u16* Og = (u16*)(P.ws + OFF_O);

  uint4 rw0, rw1, rq0, rq1, rk0, rk1, ra;
  float gq0, gq1, gk, g63;
  uint2 ru0, ru1, ru2, ru3;
  int cur_row0 = 0, cur_lat = 0;
  int nxt_row0 = 0, nxt_lat = 0;

#define SCAN_PF_ONE(i)                                                                             \
    {                                                                                              \
      const int id = tid + (i) * 512;                                                              \
      const int p = id >> 4, seg = id & 15;                                                        \
      const int tk = dir ? (63 - p) : p;                                                           \
      rw##i = *(const uint4*)(Wg + it2__ * 8192 + p * 128 + seg * 8);                              \
      rq##i = *(const uint4*)(QKN + (size_t)(nxt_row0 + tk) * 1024 + h * 128 + seg * 8);           \
      gq##i = GC[it2__ * 64 + p];                                                                  \
      const int s = id & 63, sg2 = id >> 6;                                                        \
      const int tks = dir ? (63 - s) : s;                                                          \
      rk##i = *(const uint4*)(QKN + (size_t)(nxt_row0 + tks) * 1024 + 512 + h * 128 + sg2 * 8);    \
    }
#define SCAN_PREFETCH(n_)                                                                          \
  {                                                                                                \
    const int n__ = (n_);                                                                          \
    int cid__;                                                                                     \
    if (n__ < 4) { cid__ = 256 + b * 4 + (dir ? (3 - n__) : n__); nxt_lat = 0; }                   \
    else { const int m__ = n__ - 4; cid__ = b * 64 + (dir ? (63 - m__) : m__); nxt_lat = 1; }      \
    nxt_row0 = cid__ * 64;                                                                         \
    const size_t it2__ = (size_t)((cid__ * 4 + h) * 2 + dir);                                      \
    SCAN_PF_ONE(0)                                                                                 \
    SCAN_PF_ONE(1)                                                                                 \
    gk = GC[it2__ * 64 + (tid & 63)];                                                              \
    g63 = GC[it2__ * 64 + 63];                                                                     \
    ra = *(const uint4*)(AQg + it2__ * 4096 + (tid >> 3) * 64 + (tid & 7) * 8);                    \
    ru0 = *(const uint2*)(UFg + (it2__ * 128 + nw + fr) * 64 + 0 * 16 + fq * 4);                   \
    ru1 = *(const uint2*)(UFg + (it2__ * 128 + nw + fr) * 64 + 1 * 16 + fq * 4);                   \
    ru2 = *(const uint2*)(UFg + (it2__ * 128 + nw + fr) * 64 + 2 * 16 + fq * 4);                   \
    ru3 = *(const uint2*)(UFg + (it2__ * 128 + nw + fr) * 64 + 3 * 16 + fq * 4);                   \
  }

  SCAN_PREFETCH(0)
  for (int n = 0; n < 68; ++n) {
    cur_row0 = nxt_row0; cur_lat = nxt_lat;
    const float gl = __expf(g63);
    const float sk = __expf(g63 - gk);
#define SCAN_STAGE_ONE(i)                                                     \
    {                                                                         \
      const int id = tid + (i) * 512;                                         \
      const int p = id >> 4, seg = id & 15;                                   \
      *(uint4*)(Wl + p * 136 + seg * 8) = rw##i;                              \
      float f[8];                                                             \
      unpack8(rq##i, f);                                                      \
      const float sq = __expf(gq##i);                                         \
      _Pragma("unroll") for (int e = 0; e < 8; ++e) f[e] *= sq;               \
      *(uint4*)(QTl + p * 136 + seg * 8) = pack8(f);                          \
      const int s = id & 63, sg2 = id >> 6;                                   \
      unpack8(rk##i, f);                                                      \
      _Pragma("unroll") for (int e = 0; e < 8; ++e) KTl[(sg2 * 8 + e) * 72 + s] = f2bf(f[e] * sk); \
    }
    SCAN_STAGE_ONE(0)
    SCAN_STAGE_ONE(1)
#undef SCAN_STAGE_ONE
    *(uint4*)(AQl + (tid >> 3) * 72 + (tid & 7) * 8) = ra;
    f32x4 av[4], ao[4];
    av[0] = f32x4{lo16(ru0.x), hi16(ru0.x), lo16(ru0.y), hi16(ru0.y)};
    av[1] = f32x4{lo16(ru1.x), hi16(ru1.x), lo16(ru1.y), hi16(ru1.y)};
    av[2] = f32x4{lo16(ru2.x), hi16(ru2.x), lo16(ru2.y), hi16(ru2.y)};
    av[3] = f32x4{lo16(ru3.x), hi16(ru3.x), lo16(ru3.y), hi16(ru3.y)};
#pragma unroll
    for (int mt = 0; mt < 4; ++mt) ao[mt] = f32x4{0.f, 0.f, 0.f, 0.f};
    __syncthreads();
    if (n + 1 < 68) SCAN_PREFETCH(n + 1)
#pragma unroll
    for (int kk = 0; kk < 4; ++kk) {
      const bf16x8 bS = *(const bf16x8*)(ST + (nw + fr) * 136 + kk * 32 + fq * 8);
#pragma unroll
      for (int mt = 0; mt < 4; ++mt) {
        const bf16x8 a1 = *(const bf16x8*)(Wl + (mt * 16 + fr) * 136 + kk * 32 + fq * 8);
        av[mt] = __builtin_amdgcn_mfma_f32_16x16x32_bf16(a1, bS, av[mt], 0, 0, 0);
        const bf16x8 a2 = *(const bf16x8*)(QTl + (mt * 16 + fr) * 136 + kk * 32 + fq * 8);
        ao[mt] = __builtin_amdgcn_mfma_f32_16x16x32_bf16(a2, bS, ao[mt], 0, 0, 0);
      }
    }
#pragma unroll
    for (int mt = 0; mt < 4; ++mt) {
      uint2 v; v.x = pack2(av[mt][0], av[mt][1]); v.y = pack2(av[mt][2], av[mt][3]);
      *(uint2*)(VT + (nw + fr) * 72 + mt * 16 + fq * 4) = v;
    }
    __syncthreads();
#pragma unroll
    for (int d = 0; d < 8; ++d) { accS[d][0] *= gl; accS[d][1] *= gl; accS[d][2] *= gl; accS[d][3] *= gl; }
#pragma unroll
    for (int ks = 0; ks < 2; ++ks) {
      const bf16x8 bV = *(const bf16x8*)(VT + (nw + fr) * 72 + ks * 32 + fq * 8);
#pragma unroll
      for (int mt = 0; mt < 4; ++mt) {
        const bf16x8 a1 = *(const bf16x8*)(AQl + (mt * 16 + fr) * 72 + ks * 32 + fq * 8);
        ao[mt] = __builtin_amdgcn_mfma_f32_16x16x32_bf16(a1, bV, ao[mt], 0, 0, 0);
      }
#pragma unroll
      for (int d = 0; d < 8; ++d) {
        const bf16x8 a2 = *(const bf16x8*)(KTl + (d * 16 + fr) * 72 + ks * 32 + fq * 8);
        accS[d] = __builtin_amdgcn_mfma_f32_16x16x32_bf16(a2, bV, accS[d], 0, 0, 0);
      }
    }
#pragma unroll
    for (int d = 0; d < 8; ++d) {
      uint2 v; v.x = pack2(accS[d][0], accS[d][1]); v.y = pack2(accS[d][2], accS[d][3]);
      *(uint2*)(ST + (nw + fr) * 136 + d * 16 + fq * 4) = v;
    }
    if (cur_lat) {
#pragma unroll
      for (int mt = 0; mt < 4; ++mt)
#pragma unroll
        for (int e = 0; e < 4; ++e) {
          const int p = mt * 16 + fq * 4 + e;
          const int tk = dir ? (63 - p) : p;
          Og[((size_t)dir * 16384 + cur_row0 + tk) * 512 + h * 128 + nw + fr] = f2bf(ao[mt][e]);
        }
    }
    __syncthreads();
  }
#undef SCAN_PREFETCH
#undef SCAN_PF_ONE
}

__device__ __forceinline__ void s5_carry_block(const Params& P, int cb) {
  const int idx = cb * NT + opq(threadIdx.x);
  const int n = idx & 63, g = (idx >> 6) & 31, r = (idx >> 11) & 1, b = idx >> 12;
  const int rg = r * 32 + g;
  const float step = expf(P.s5_log_step[rg]);
  float lr, li;
  lam_pow(step, P.s5_a_re[rg * 64 + n], P.s5_a_im[rg * 64 + n], 32, lr, li);
  const float* E = (const float*)(P.ws + OFF_E) + (size_t)g * 544 * 256 + r * 128 + n;
  u16* XIN = (u16*)(P.ws + OFF_XIN) + (size_t)g * 512 * 256 + r * 128 + n;
  float xr = 0.f, xi = 0.f;
  for (int k = 0; k < 8; ++k) {
    const int cc = r ? (7 - k) : k;
    const int row = 512 + b * 8 + cc;
    const float er = E[(size_t)row * 256], ei = E[(size_t)row * 256 + 64];
    const float nr = lr * xr - li * xi + er, ni = lr * xi + li * xr + ei;
    xr = nr; xi = ni;
  }
  for (int k = 0; k < 128; ++k) {
    const int cc = r ? (127 - k) : k;
    const int row = b * 128 + cc;
    XIN[(size_t)row * 256] = f2bf(xr);
    XIN[(size_t)row * 256 + 64] = f2bf(xi);
    const float er = E[(size_t)row * 256], ei = E[(size_t)row * 256 + 64];
    const float nr = lr * xr - li * xi + er, ni = lr * xi + li * xr + ei;
    xr = nr; xi = ni;
  }
}

__device__ __forceinline__ void s5out_tile(const Params& P, int t, char* lds) {
  const int g = t >> 3, mt = (t >> 2) & 1, nt = t & 3;
  const int m0 = mt * 256, n0 = nt * 128;
  f32x4 acc[4][4];
  acc_zero(acc);
  gemm_main((const u16*)(P.ws + OFF_XIN) + ((size_t)g * 512 + m0) * 256, 256,
            (const u16*)(P.ws + OFF_MST) + ((size_t)g * 512 + n0) * 256, 256, 256, acc, (u16*)lds);
  gemm_main((const u16*)(P.ws + OFF_U5) + ((size_t)g * 544 + m0) * 512, 512,
            (const u16*)(P.ws + OFF_MINTRA) + ((size_t)g * 512 + n0) * 512, 512, 512, acc, (u16*)lds);
  TILE_COORDS
  u16* YB = (u16*)(P.ws + OFF_YB);
#pragma unroll
  for (int i = 0; i < 4; ++i)
#pragma unroll
    for (int j = 0; j < 4; ++j)
#pragma unroll
      for (int e = 0; e < 4; ++e) {
        const int row = TROW(m0, i, e), nn = TCOL(n0, j);
        const int token = row * 32 + (nn >> 4);
        YB[(size_t)token * 512 + g * 16 + (nn & 15)] = f2bf(gelu_tanh(acc[i][j][e]));
      }
}

__device__ __forceinline__ void delta_post_item(const Params& P, int item) {
  const int lane = opq(threadIdx.x) & 63, w = opq(threadIdx.x) >> 6;
  const int row = item * 8 + w;
  const u16* O = (const u16*)(P.ws + OFF_O);
  const uint4 o0 = *(const uint4*)(O + (size_t)row * 512 + lane * 8);
  const uint4 o1 = *(const uint4*)(O + ((size_t)16384 + row) * 512 + lane * 8);
  const uint4 zz = *(const uint4*)((const u16*)(P.ws + OFF_Z) + (size_t)row * 512 + lane * 8);
  float a[8], bq[8], z[8];
  unpack8(o0, a); unpack8(o1, bq); unpack8(zz, z);
  float ss = 0.f;
#pragma unroll
  for (int e = 0; e < 8; ++e) { a[e] += bq[e]; ss += a[e] * a[e]; }
  ss += __shfl_xor(ss, 1, 64); ss += __shfl_xor(ss, 2, 64); ss += __shfl_xor(ss, 4, 64); ss += __shfl_xor(ss, 8, 64);
  const float rstd = rsqrtf(ss * (1.f / 128.f) + 1e-6f);
  const float* nw = P.dn_norm_w + (lane & 15) * 8;
  float y[8];
#pragma unroll
  for (int e = 0; e < 8; ++e) y[e] = a[e] * rstd * nw[e] * (z[e] * sigm(z[e]));
  *(uint4*)((u16*)(P.ws + OFF_YA) + (size_t)row * 512 + lane * 8) = pack8(y);
}

__device__ __forceinline__ void glu_tile(const Params& P, int t, char* lds) {
  const int nt = t >> 6, mt = t & 63;
  const int m0 = mt * 256, n0 = nt * 128;
  f32x4 acc[4][4];
  acc_zero(acc);
  gemm_main((const u16*)(P.ws + OFF_YB) + (size_t)m0 * 512, 512, (const u16*)(P.ws + OFF_WT_GLU) + (size_t)n0 * 512, 512, 512, acc, (u16*)lds);
  TILE_COORDS
  u16* YG = (u16*)(P.ws + OFF_YG);
#pragma unroll
  for (int i = 0; i < 4; ++i)
#pragma unroll
    for (int j = 0; j < 2; ++j) {
      const int oc = nt * 64 + wn_ * 32 + j * 16 + fr_;
      const float bv = P.b_glu[oc], bg = P.b_glu[512 + oc];
#pragma unroll
      for (int e = 0; e < 4; ++e) {
        const float val = acc[i][j][e] + bv, gt = acc[i][j + 2][e] + bg;
        YG[(size_t)TROW(m0, i, e) * 512 + oc] = f2bf(val * sigm(gt));
      }
    }
}

__device__ __forceinline__ void gates_tile(const Params& P, int t, char* lds) {
  const int nt = t >> 6, mt = t & 63;
  const int m0 = mt * 256, n0 = nt * 128;
  f32x4 acc[4][4];
  acc_zero(acc);
  gemm_main((const u16*)(P.ws + OFF_R2) + (size_t)m0 * 1024, 1024, (const u16*)(P.ws + OFF_WT_IN) + (size_t)(2688 + n0) * 1024, 1024, 1024, acc, (u16*)lds);
  TILE_COORDS
  u16* SG = (u16*)(P.ws + OFF_SG);
#pragma unroll
  for (int i = 0; i < 4; ++i)
#pragma unroll
    for (int j = 0; j < 4; ++j)
#pragma unroll
      for (int e = 0; e < 4; ++e) SG[(size_t)TROW(m0, i, e) * 2048 + TCOL(n0, j)] = f2bf(sigm(acc[i][j][e]));
}

__device__ __forceinline__ void mix_tile(const Params& P, int t, char* lds) {
  const int nt = t >> 6, mt = t & 63;
  const int m0 = mt * 256, n0 = nt * 128;
  const u16* SG = (const u16*)(P.ws + OFF_SG);
  f32x4 acc[4][4];
  uint32_t mixp[4][4][2];
  acc_zero(acc);
  gemm_main((const u16*)(P.ws + OFF_YA) + (size_t)m0 * 512, 512, (const u16*)(P.ws + OFF_WT_AOUT) + (size_t)n0 * 512, 512, 512, acc, (u16*)lds);
  {
    TILE_COORDS
#pragma unroll
    for (int i = 0; i < 4; ++i)
#pragma unroll
      for (int j = 0; j < 4; ++j) {
        const int col = TCOL(n0, j);
        const float m0v = bf2f(SG[(size_t)TROW(m0, i, 0) * 2048 + col]) * acc[i][j][0];
        const float m1v = bf2f(SG[(size_t)TROW(m0, i, 1) * 2048 + col]) * acc[i][j][1];
        const float m2v = bf2f(SG[(size_t)TROW(m0, i, 2) * 2048 + col]) * acc[i][j][2];
        const float m3v = bf2f(SG[(size_t)TROW(m0, i, 3) * 2048 + col]) * acc[i][j][3];
        mixp[i][j][0] = pack2(m0v, m1v);
        mixp[i][j][1] = pack2(m2v, m3v);
      }
  }
  acc_zero(acc);
  gemm_main((const u16*)(P.ws + OFF_YG) + (size_t)m0 * 512, 512, (const u16*)(P.ws + OFF_WT_BOUT) + (size_t)n0 * 512, 512, 512, acc, (u16*)lds);
  TILE_COORDS
  u16* MIX = (u16*)(P.ws + OFF_MIX);
#pragma unroll
  for (int i = 0; i < 4; ++i)
#pragma unroll
    for (int j = 0; j < 4; ++j) {
      const int col = TCOL(n0, j);
      const float pm[4] = {lo16(mixp[i][j][0]), hi16(mixp[i][j][0]), lo16(mixp[i][j][1]), hi16(mixp[i][j][1])};
#pragma unroll
      for (int e = 0; e < 4; ++e) {
        const size_t r = (size_t)TROW(m0, i, e);
        MIX[r * 1024 + col] = f2bf(pm[e] + bf2f(SG[r * 2048 + 1024 + col]) * acc[i][j][e]);
      }
    }
}

__device__ __forceinline__ void wo_tile(const Params& P, int t, char* lds) {
  const int nt = t >> 6, mt = t & 63;
  const int m0 = mt * 256, n0 = nt * 128;
  f32x4 acc[4][4];
  acc_zero(acc);
  gemm_main((const u16*)(P.ws + OFF_MIX) + (size_t)m0 * 1024, 1024, (const u16*)(P.ws + OFF_WT_O) + (size_t)n0 * 1024, 1024, 1024, acc, (u16*)lds);
  TILE_COORDS
  const float* MOD = (const float*)(P.ws + OFF_MOD) + (m0 >> 12) * 6144 + 2 * 1024;
#pragma unroll
  for (int j = 0; j < 4; ++j) {
    const int col = TCOL(n0, j);
    const float gate = MOD[col];
#pragma unroll
    for (int i = 0; i < 4; ++i)
#pragma unroll
      for (int e = 0; e < 4; ++e) {
        const size_t o = (size_t)TROW(m0, i, e) * 1024 + col;
        P.out[o] = P.x[o] + gate * acc[i][j][e];
      }
  }
}

__device__ __forceinline__ void norm2_item(const Params& P, int item) {
  const int lane = opq(threadIdx.x) & 63, w = opq(threadIdx.x) >> 6;
  const int row = item * 8 + w;
  const float* MOD = (const float*)(P.ws + OFF_MOD) + (row >> 12) * 6144;
  norm_row(P.out + (size_t)row * 1024, P.norm2_w, MOD + 3 * 1024, MOD + 4 * 1024, (u16*)(P.ws + OFF_R2) + (size_t)row * 1024, lane);
}

__device__ __forceinline__ void up_tile(const Params& P, int t, int hh, char* lds) {
  const int nt = t >> 6, mt = t & 63;
  const int m0 = mt * 256, n0 = nt * 128;
  f32x4 acc[4][4];
  acc_zero(acc);
  gemm_main((const u16*)(P.ws + OFF_R2) + (size_t)m0 * 1024, 1024,
            (const u16*)(P.ws + OFF_WT_UP) + ((size_t)hh * 2816 + n0) * 1024, 1024, 1024, acc, (u16*)lds);
  TILE_COORDS
  u16* UPH = (u16*)(P.ws + OFF_UPH);
#pragma unroll
  for (int i = 0; i < 4; ++i)
#pragma unroll
    for (int j = 0; j < 4; ++j)
#pragma unroll
      for (int e = 0; e < 4; ++e) UPH[(size_t)TROW(m0, i, e) * 2816 + TCOL(n0, j)] = f2bf(acc[i][j][e]);
}

__device__ __forceinline__ void convgate_item(const Params& P, int item, int hh) {
  const int tid = opq(threadIdx.x);
  if (tid >= 352) return;
  const int xh = item & 1, y = (item >> 1) & 63, b = item >> 7;
  const int c4 = tid * 4;
  const u16* UPH = (const u16*)(P.ws + OFF_UPH);
  u16* G = (u16*)(P.ws + OFF_G);
  float wg[9][4], wv[9][4];
#pragma unroll
  for (int k = 0; k < 9; ++k) {
    const float4 a = *(const float4*)(P.ffn_conv_w + (size_t)k * 5632 + hh * 1408 + c4);
    const float4 bq = *(const float4*)(P.ffn_conv_w + (size_t)k * 5632 + 2816 + hh * 1408 + c4);
    wg[k][0] = a.x; wg[k][1] = a.y; wg[k][2] = a.z; wg[k][3] = a.w;
    wv[k][0] = bq.x; wv[k][1] = bq.y; wv[k][2] = bq.z; wv[k][3] = bq.w;
  }
  const size_t base = (size_t)b * 4096;
  for (int xx = 0; xx < 32; ++xx) {
    const int x = xh * 32 + xx;
    float ag[4] = {0.f, 0.f, 0.f, 0.f}, av[4] = {0.f, 0.f, 0.f, 0.f};
#pragma unroll
    for (int dy = 0; dy < 3; ++dy) {
      const int yy = y + dy - 1;
      if (yy < 0 || yy > 63) continue;
#pragma unroll
      for (int dx = 0; dx < 3; ++dx) {
        const int x2 = x + dx - 1;
        if (x2 < 0 || x2 > 63) continue;
        const u16* src = UPH + (base + yy * 64 + x2) * 2816 + c4;
        const uint2 gv = *(const uint2*)src;
        const uint2 vv = *(const uint2*)(src + 1408);
        const int k = dy * 3 + dx;
        ag[0] += wg[k][0] * lo16(gv.x); ag[1] += wg[k][1] * hi16(gv.x); ag[2] += wg[k][2] * lo16(gv.y); ag[3] += wg[k][3] * hi16(gv.y);
        av[0] += wv[k][0] * lo16(vv.x); av[1] += wv[k][1] * hi16(vv.x); av[2] += wv[k][2] * lo16(vv.y); av[3] += wv[k][3] * hi16(vv.y);
      }
    }
    uint2 o;
    o.x = pack2(ag[0] * sigm(ag[0]) * av[0], ag[1] * sigm(ag[1]) * av[1]);
    o.y = pack2(ag[2] * sigm(ag[2]) * av[2], ag[3] * sigm(ag[3]) * av[3]);
    *(uint2*)(G + (base + y * 64 + x) * 2816 + hh * 1408 + c4) = o;
  }
}

__device__ __forceinline__ void down_tile(const Params& P, int t, char* lds) {
  const int nt = t >> 6, mt = t & 63;
  const int m0 = mt * 256, n0 = nt * 128;
  f32x4 acc[4][4];
  acc_zero(acc);
  gemm_main((const u16*)(P.ws + OFF_G) + (size_t)m0 * 2816, 2816, (const u16*)(P.ws + OFF_WT_DOWN) + (size_t)n0 * 2816, 2816, 2816, acc, (u16*)lds);
  TILE_COORDS
  const float* MOD = (const float*)(P.ws + OFF_MOD) + (m0 >> 12) * 6144 + 5 * 1024;
#pragma unroll
  for (int j = 0; j < 4; ++j) {
    const int col = TCOL(n0, j);
    const float gate = MOD[col];
#pragma unroll
    for (int i = 0; i < 4; ++i)
#pragma unroll
      for (int e = 0; e < 4; ++e) {
        const size_t o = (size_t)TROW(m0, i, e) * 1024 + col;
        P.out[o] = P.out[o] + gate * acc[i][j][e];
      }
  }
}

__device__ __forceinline__ void final_item(const Params& P, int item) {
  const int lane = opq(threadIdx.x) & 63, w = opq(threadIdx.x) >> 6;
  const int row = item * 8 + w;
  float* xr = P.out + (size_t)row * 1024;
  float4 v[4];
  float ss = 0.f;
#pragma unroll
  for (int it = 0; it < 4; ++it) {
    v[it] = *(const float4*)(xr + (it * 64 + lane) * 4);
    ss += v[it].x * v[it].x + v[it].y * v[it].y + v[it].z * v[it].z + v[it].w * v[it].w;
  }
  ss = wsum64(ss);
  const float rstd = rsqrtf(ss * (1.f / 1024.f) + 1e-6f);
#pragma unroll
  for (int it = 0; it < 4; ++it) {
    const int c = (it * 64 + lane) * 4;
    const float4 w4 = *(const float4*)(P.norm_f_w + c);
    float4 o;
    o.x = v[it].x * rstd * w4.x; o.y = v[it].y * rstd * w4.y; o.z = v[it].z * rstd * w4.z; o.w = v[it].w * rstd * w4.w;
    *(float4*)(xr + c) = o;
  }
}

__device__ __forceinline__ void run_phase(const Params& P, int ph, char* lds) {
  const int bid = blockIdx.x, nb = gridDim.x;
#ifdef ONLY_PHASE
  if (ph != ONLY_PHASE) return;
#endif
  switch (ph) {
    case 0: {
      for (int it = bid; it < 3936 + 192 + 2048; it += nb) {
        if (it < 1184) convert_item(P.w_in, 1024, 4624, (u16*)(P.ws + OFF_WT_IN), 0, it, lds);
        else if (it < 1312) convert_item(P.w_a_out, 512, 1024, (u16*)(P.ws + OFF_WT_AOUT), 1, it - 1184, lds);
        else if (it < 1440) convert_item(P.w_glu, 512, 1024, (u16*)(P.ws + OFF_WT_GLU), 2, it - 1312, lds);
        else if (it < 1568) convert_item(P.w_b_out, 512, 1024, (u16*)(P.ws + OFF_WT_BOUT), 3, it - 1440, lds);
        else if (it < 1824) convert_item(P.w_o, 1024, 1024, (u16*)(P.ws + OFF_WT_O), 4, it - 1568, lds);
        else if (it < 3232) convert_item(P.w_up, 1024, 5632, (u16*)(P.ws + OFF_WT_UP), 5, it - 1824, lds);
        else if (it < 3936) convert_item(P.w_down, 2816, 1024, (u16*)(P.ws + OFF_WT_DOWN), 6, it - 3232, lds);
        else if (it < 4128) mod_item(P, it - 3936, lds);
        else s5tab_item(P, it - 4128, lds);
      }
    } break;
    case 1:
      for (int it = bid; it < 2176 + 2048; it += nb) {
        if (it < 2176) norm1_item(P, it); else mintra_item(P, it - 2176);
      }
      break;
    case 2:
      for (int it = bid; it < 1396; it += nb) inproj_tile(P, it, lds);
      break;
    case 3:
      for (int it = bid; it < 1088 + 192; it += nb) {
        if (it < 1088) delta_prep_item(P, it, lds); else s5end_tile(P, it - 1088, lds);
      }
      break;
    case 4:
      if (bid < 32) delta_scan_block(P, bid, lds);
      else if (bid < 64) s5_carry_block(P, bid - 32);
      break;
    case 5:
      for (int it = bid; it < 256 + 2048 + 2048; it += nb) {
        if (it < 256) s5out_tile(P, it, lds);
        else if (it < 2304) delta_post_item(P, it - 256);
        else norm1_item(P, it - 2304);
      }
      break;
    case 6:
      for (int it = bid; it < 512 + 1024; it += nb) {
        if (it < 512) glu_tile(P, it, lds); else gates_tile(P, it - 512, lds);
      }
      break;
    case 7:
      for (int it = bid; it < 512; it += nb) mix_tile(P, it, lds);
      break;
    case 8:
      for (int it = bid; it < 512; it += nb) wo_tile(P, it, lds);
      break;
    case 9:
      for (int it = bid; it < 2048; it += nb) norm2_item(P, it);
      break;
    case 10:
      for (int it = bid; it < 1408; it += nb) up_tile(P, it, 0, lds);
      break;
    case 11:
      for (int it = bid; it < 512; it += nb) convgate_item(P, it, 0);
      break;
    case 12:
      for (int it = bid; it < 1408; it += nb) up_tile(P, it, 1, lds);
      break;
    case 13:
      for (int it = bid; it < 512; it += nb) convgate_item(P, it, 1);
      break;
    case 14:
      for (int it = bid; it < 512; it += nb) down_tile(P, it, lds);
      break;
    case 15:
      for (int it = bid; it < 2048; it += nb) final_item(P, it);
      break;
    default: break;
  }
}

__global__ void __launch_bounds__(NT) fwd_megakernel(Params P) {
  extern __shared__ __attribute__((aligned(16))) char lds[];
  const int lo = (int)P.ph_lo, hi = (int)P.ph_hi;
#if MULTI_LAUNCH
  for (int ph = lo; ph < hi; ++ph) run_phase(P, ph, lds);
#else
  cg::grid_group grid = cg::this_grid();
  for (int ph = lo; ph < hi; ++ph) {
    run_phase(P, ph, lds);
    if (ph + 1 < hi) grid.sync();
  }
#endif
}

extern "C" void kernel_launch(void* const* d_in, const int* in_sizes, int n_in, void* d_out, int out_size, void* d_ws,
                              size_t ws_size, hipStream_t stream) {
  static int grid_blocks = 0;
  if (grid_blocks == 0) {
    if (n_in != 30 || out_size != 16384 * 1024 || ws_size < WS_NEED) {
      fprintf(stderr, "kernel_launch: unexpected shapes: n_in %d out %d ws %zu (need %zu)\n", n_in, out_size, ws_size, (size_t)WS_NEED);
      grid_blocks = -1;
      return;
    }
    int dev = 0, cus = 0, per_cu = 0;
    hipGetDevice(&dev);
    hipDeviceGetAttribute(&cus, hipDeviceAttributeMultiprocessorCount, dev);
    if (hipFuncSetAttribute((const void*)fwd_megakernel, hipFuncAttributeMaxDynamicSharedMemorySize, LDS_BYTES) != hipSuccess) {
      fprintf(stderr, "kernel_launch: hipFuncSetAttribute failed\n");
      grid_blocks = -1;
      return;
    }
    if (hipOccupancyMaxActiveBlocksPerMultiprocessor(&per_cu, (const void*)fwd_megakernel, NT, LDS_BYTES) != hipSuccess || per_cu < 1) {
      fprintf(stderr, "kernel_launch: occupancy query failed / zero (%d)\n", per_cu);
      grid_blocks = -1;
      return;
    }
    grid_blocks = cus;
    if (grid_blocks < 64) { fprintf(stderr, "kernel_launch: too few CUs (%d)\n", cus); grid_blocks = -1; return; }
  }
  if (grid_blocks < 0) return;
  Params p{};
  const float** pp = (const float**)&p;
  for (int i = 0; i < 30; ++i) pp[i] = (const float*)d_in[i];
  p.out = (float*)d_out;
  p.ws = (char*)d_ws;
#if MULTI_LAUNCH
  for (int ph = 0; ph < 16; ++ph) {
    p.ph_lo = ph; p.ph_hi = ph + 1;
    hipLaunchKernelGGL(fwd_megakernel, dim3(grid_blocks), dim3(NT), LDS_BYTES, stream, p);
  }
#else
  p.ph_lo = 0; p.ph_hi = 16;
  void* args[] = {&p};
  hipError_t e = hipLaunchCooperativeKernel((const void*)fwd_megakernel, dim3(grid_blocks), dim3(NT), args, LDS_BYTES, stream);
  if (e != hipSuccess) fprintf(stderr, "cooperative launch failed: %s (grid %d)\n", hipGetErrorString(e), grid_blocks);
#endif
}
```

```cpp
#include <hip/hip_runtime.h>
#include <hip/hip_cooperative_groups.h>
#include <cstdio>
#include <cstdint>
namespace cg = cooperative_groups;

#ifndef MULTI_LAUNCH
#define MULTI_LAUNCH 0
#endif

typedef unsigned short u16;
typedef __attribute__((ext_vector_type(8))) short bf16x8;
typedef __attribute__((ext_vector_type(4))) float f32x4;

#define NT 512
constexpr int LDS_BYTES = 131072;
constexpr int NPHASE = 18;

constexpr size_t OFF_WT_IN   = 0;
constexpr size_t OFF_WT_AOUT = 9699328;
constexpr size_t OFF_WT_GLU  = 10747904;
constexpr size_t OFF_WT_BOUT = 11796480;
constexpr size_t OFF_WT_O    = 12845056;
constexpr size_t OFF_WT_UP   = 14942208;
constexpr size_t OFF_WT_DOWN = 26476544;
constexpr size_t OFF_MOD     = 32243712;
constexpr size_t OFF_R2      = 33554432;
constexpr size_t OFF_R1      = 69206016;
constexpr size_t OFF_KTAB    = OFF_R1;
constexpr size_t OFF_MEND    = OFF_R1 + 2097152;
constexpr size_t OFF_MST     = OFF_R1 + 10485760;
constexpr size_t OFF_MINTRA  = OFF_R1 + 18874368;
constexpr size_t OFF_R3      = 104857600;
constexpr size_t OFF_O       = OFF_R3;
constexpr size_t OFF_XIN     = OFF_R3 + 33554432;
constexpr size_t OFF_MIX     = 158334976;
constexpr size_t OFF_SG      = OFF_R1;
constexpr size_t OFF_Z       = 158334976;
constexpr size_t OFF_U5      = 175112192;
constexpr size_t OFF_BA      = 192937984;
constexpr size_t OFF_GC      = OFF_BA + 1179648;
constexpr size_t OFF_UF      = 195035136;
constexpr size_t OFF_YA      = OFF_UF;
constexpr size_t OFF_YB      = OFF_UF + 16777216;
constexpr size_t OFF_E       = 230686720;
constexpr size_t OFF_YG      = OFF_E;
constexpr size_t OFF_UPH     = OFF_R1;
constexpr size_t OFF_G       = 161480704;
constexpr size_t WS_NEED     = 253755392;
constexpr size_t OFF_QKN     = 0;
constexpr size_t OFF_AQ      = 35651584;

struct Params {
  const float *x, *c, *ctx, *c_ctx, *w_ada, *b_ada, *norm1_w, *w_in, *dn_conv_w, *dn_a_log, *dn_dt_bias, *dn_norm_w,
      *w_a_out, *s5_a_re, *s5_a_im, *s5_log_step, *s5_b_re, *s5_b_im, *s5_c_re, *s5_c_im, *s5_d, *w_glu, *b_glu,
      *w_b_out, *w_o, *norm2_w, *w_up, *ffn_conv_w, *w_down, *norm_f_w;
  float* out;
  char* ws;
  long long ph_lo, ph_hi;
};

__device__ __forceinline__ u16 f2bf(float f) {
  uint32_t u = __float_as_uint(f);
  u += 0x7fffu + ((u >> 16) & 1u);
  return (u16)(u >> 16);
}
__device__ __forceinline__ float bf2f(u16 h) { return __uint_as_float(((uint32_t)h) << 16); }
__device__ __forceinline__ uint32_t pack2(float a, float b) { return (uint32_t)f2bf(a) | ((uint32_t)f2bf(b) << 16); }
__device__ __forceinline__ float lo16(uint32_t w) { return __uint_as_float(w << 16); }
__device__ __forceinline__ float hi16(uint32_t w) { return __uint_as_float(w & 0xffff0000u); }
__device__ __forceinline__ int opq(int v) { asm volatile("" : "+v"(v)); return v; }
__device__ __forceinline__ float sigm(float x) { return 1.f / (1.f + __expf(-x)); }
__device__ __forceinline__ void unpack8(uint4 v, float* f) {
  f[0] = lo16(v.x); f[1] = hi16(v.x); f[2] = lo16(v.y); f[3] = hi16(v.y);
  f[4] = lo16(v.z); f[5] = hi16(v.z); f[6] = lo16(v.w); f[7] = hi16(v.w);
}
__device__ __forceinline__ uint4 pack8(const float* f) {
  uint4 v; v.x = pack2(f[0], f[1]); v.y = pack2(f[2], f[3]); v.z = pack2(f[4], f[5]); v.w = pack2(f[6], f[7]);
  return v;
}
__device__ __forceinline__ float wsum64(float v) {
#pragma unroll
  for (int o = 32; o > 0; o >>= 1) v += __shfl_xor(v, o, 64);
  return v;
}
__device__ __forceinline__ float gelu_tanh(float x) {
  float u = 0.7978845608028654f * (x + 0.044715f * x * x * x);
  float t = 1.f - 2.f / (1.f + __expf(2.f * u));
  return 0.5f * x * (1.f + t);
}

__device__ __forceinline__ void gemm_main(const u16* __restrict__ A, int lda, const u16* __restrict__ Bt, int ldb, int K,
                                          f32x4 (&acc)[4][4], u16* lds) {
  const int tid = opq(threadIdx.x), lane = tid & 63, w = tid >> 6, wm = w >> 1, wn = w & 1, fr = lane & 15, fq = lane >> 4;
  u16* As = lds;
  u16* Bs = lds + 2 * 256 * 72;
  const int nk = K >> 6;
  uint4 ra0, ra1, ra2, ra3, rb0, rb1;
  const int lr = tid >> 3, lc = (tid & 7) * 8;
  const u16* ap = A + (size_t)lr * lda + lc;
  const u16* bp = Bt + (size_t)lr * ldb + lc;
  const size_t sa = (size_t)64 * lda, sb = (size_t)64 * ldb;
#define G_LOAD(kt_)                                             \
  {                                                             \
    const u16* a_ = ap + (kt_) * 64;                            \
    const u16* b_ = bp + (kt_) * 64;                            \
    ra0 = *(const uint4*)(a_);                                  \
    ra1 = *(const uint4*)(a_ + sa);                             \
    ra2 = *(const uint4*)(a_ + 2 * sa);                         \
    ra3 = *(const uint4*)(a_ + 3 * sa);                         \
    rb0 = *(const uint4*)(b_);                                  \
    rb1 = *(const uint4*)(b_ + sb);                             \
  }
#define G_STORE(buf_)                                                        \
  {                                                                          \
    u16* as_ = As + ((buf_) * 256 + lr) * 72 + lc;                           \
    u16* bs_ = Bs + ((buf_) * 128 + lr) * 72 + lc;                           \
    *(uint4*)(as_) = ra0;                                                    \
    *(uint4*)(as_ + 64 * 72) = ra1;                                          \
    *(uint4*)(as_ + 128 * 72) = ra2;                                         \
    *(uint4*)(as_ + 192 * 72) = ra3;                                         \
    *(uint4*)(bs_) = rb0;                                                    \
    *(uint4*)(bs_ + 64 * 72) = rb1;                                          \
  }
  G_LOAD(0)
  __syncthreads();
  G_STORE(0)
  if (nk > 1) G_LOAD(1)
  __syncthreads();
  for (int kt = 0; kt < nk; ++kt) {
    const int buf = kt & 1;
    if (kt + 1 < nk) G_STORE(buf ^ 1)
    if (kt + 2 < nk) G_LOAD(kt + 2)
    __builtin_amdgcn_sched_barrier(0);
    const u16* as = As + (buf * 256 + wm * 64 + fr) * 72 + fq * 8;
    const u16* bs = Bs + (buf * 128 + wn * 64 + fr) * 72 + fq * 8;
#pragma unroll
    for (int ks = 0; ks < 2; ++ks) {
      bf16x8 a[4], b[4];
#pragma unroll
      for (int i = 0; i < 4; ++i) a[i] = *(const bf16x8*)(as + i * 16 * 72 + ks * 32);
#pragma unroll
      for (int j = 0; j < 4; ++j) b[j] = *(const bf16x8*)(bs + j * 16 * 72 + ks * 32);
#pragma unroll
      for (int i = 0; i < 4; ++i)
#pragma unroll
        for (int j = 0; j < 4; ++j) acc[i][j] = __builtin_amdgcn_mfma_f32_16x16x32_bf16(a[i], b[j], acc[i][j], 0, 0, 0);
    }
    __syncthreads();
  }
#undef G_LOAD
#undef G_STORE
}

__device__ __forceinline__ void acc_zero(f32x4 (&acc)[4][4]) {
#pragma unroll
  for (int i = 0; i < 4; ++i)
#pragma unroll
    for (int j = 0; j < 4; ++j) acc[i][j] = f32x4{0.f, 0.f, 0.f, 0.f};
}

#define TILE_COORDS                                                                                  \
  const int tid_ = opq(threadIdx.x), lane_ = tid_ & 63, w_ = tid_ >> 6, wm_ = w_ >> 1, wn_ = w_ & 1,     \
            fr_ = lane_ & 15, fq_ = lane_ >> 4;
#define TROW(m0, i, e) ((m0) + wm_ * 64 + (i) * 16 + fq_ * 4 + (e))
#define TCOL(n0, j) ((n0) + wn_ * 64 + (j) * 16 + fr_)

__device__ __forceinline__ int srccol(int which, int r) {
  switch (which) {
    case 0:
      if (r < 2048) return r;
      if (r < 2560) return 2064 + (r - 2048);
      if (r < 2576) return 2048 + (r - 2560);
      if (r < 2688) return -1;
      if (r < 3712) return 2576 + (r - 2688);
      return 3600 + (r - 3712);
    case 2: {
      int tile = r >> 7, wn = (r >> 6) & 1, wi = r & 63;
      return (wi < 32) ? (tile * 64 + wn * 32 + wi) : (512 + tile * 64 + wn * 32 + (wi - 32));
    }
    case 5: {
      int hh = r / 2816, cc = r % 2816;
      return (cc < 1408) ? (hh * 1408 + cc) : (2816 + hh * 1408 + (cc - 1408));
    }
    default: return r;
  }
}

__device__ __forceinline__ void convert_item(const float* __restrict__ src, int K, int N, u16* __restrict__ dst, int which, int item, char* lds) {
  float* tile = (float*)lds;
  const int tid = opq(threadIdx.x);
  const int kb = K >> 8;
  const int r0 = (item / kb) * 64, k0 = (item % kb) * 256;
  __syncthreads();
  {
    const int n4 = (tid & 15) * 4, kk = tid >> 4;
    const int sc = srccol(which, r0 + n4);
    float4 v[8];
#pragma unroll
    for (int it = 0; it < 8; ++it) {
      const int k = kk + 32 * it;
      v[it] = (sc >= 0) ? *(const float4*)(src + (size_t)(k0 + k) * N + sc) : make_float4(0.f, 0.f, 0.f, 0.f);
    }
#pragma unroll
    for (int it = 0; it < 8; ++it) {
      const int k = kk + 32 * it;
      tile[(n4 + 0) * 257 + k] = v[it].x; tile[(n4 + 1) * 257 + k] = v[it].y;
      tile[(n4 + 2) * 257 + k] = v[it].z; tile[(n4 + 3) * 257 + k] = v[it].w;
    }
  }
  __syncthreads();
  {
    const int ks = (tid & 31) * 8, rr = tid >> 5;
#pragma unroll
    for (int it = 0; it < 4; ++it) {
      const int row = rr + 16 * it;
      float f[8];
#pragma unroll
      for (int e = 0; e < 8; ++e) f[e] = tile[row * 257 + ks + e];
      *(uint4*)(dst + (size_t)(r0 + row) * K + k0 + ks) = pack8(f);
    }
  }
}

__device__ __forceinline__ void mod_item(const Params& P, int item, char* lds) {
  float* sc = (float*)lds;
  float* red = sc + 5 * 1024;
  const int tid = opq(threadIdx.x);
  __syncthreads();
  for (int i = tid; i < 5 * 1024; i += NT) {
    const int r = i >> 10, k = i & 1023;
    float v = (r < 4) ? P.c[r * 1024 + k] : P.c_ctx[k];
    sc[i] = v * sigm(v);
  }
  __syncthreads();
  const int nn = tid & 31, kg = tid >> 5;
  const int n = item * 32 + nn;
  float a0 = 0, a1 = 0, a2 = 0, a3 = 0, a4 = 0;
  for (int kk = 0; kk < 64; ++kk) {
    const int k = kg * 64 + kk;
    const float wv = P.w_ada[(size_t)k * 6144 + n];
    a0 += sc[k] * wv; a1 += sc[1024 + k] * wv; a2 += sc[2048 + k] * wv; a3 += sc[3072 + k] * wv; a4 += sc[4096 + k] * wv;
  }
  red[(kg * 5 + 0) * 32 + nn] = a0; red[(kg * 5 + 1) * 32 + nn] = a1; red[(kg * 5 + 2) * 32 + nn] = a2;
  red[(kg * 5 + 3) * 32 + nn] = a3; red[(kg * 5 + 4) * 32 + nn] = a4;
  __syncthreads();
  if (tid < 160) {
    const int r = tid >> 5, n2 = tid & 31;
    float s = 0.f;
#pragma unroll
    for (int g = 0; g < 16; ++g) s += red[(g * 5 + r) * 32 + n2];
    float* MOD = (float*)(P.ws + OFF_MOD);
    MOD[r * 6144 + item * 32 + n2] = s + P.b_ada[item * 32 + n2];
  }
}

__device__ __forceinline__ void lam_pow(float step, float are, float aim, int e, float& pr, float& pi) {
  const float mag = expf((float)e * step * are);
  double ang = (double)e * (double)step * (double)aim;
  ang -= 6.283185307179586476925 * rint(ang * 0.15915494309189533577);
  float s, c;
  __sincosf((float)ang, &s, &c);
  pr = mag * c; pi = mag * s;
}

__device__ __forceinline__ void s5tab_item(const Params& P, int item, char* lds) {
  const int tid = opq(threadIdx.x);
  const int tau = item & 31, g = (item >> 5) & 31, r = item >> 10;
  float* cfr = (float*)lds;
  float* cfi = cfr + 64;
  float* p0r = cfi + 64;
  float* p0i = p0r + 64;
  float* p1r = p0i + 64;
  float* p1i = p1r + 64;
  float* Gr = p1i + 64;
  float* Gi = Gr + 1024;
  float* Cr = Gi + 1024;
  float* Ci = Cr + 1024;
  const int rg = r * 32 + g;
  __syncthreads();
  if (tid < 64) {
    const int n = tid;
    const float step = expf(P.s5_log_step[rg]);
    const float are = P.s5_a_re[rg * 64 + n], aim = P.s5_a_im[rg * 64 + n];
    const float za = step * are;
    double zb = (double)step * (double)aim;
    zb -= 6.283185307179586476925 * rint(zb * 0.15915494309189533577);
    float sb, cb, sh, ch;
    __sincosf((float)zb, &sb, &cb);
    __sincosf((float)(0.5 * zb), &sh, &ch);
    const float em1 = expm1f(za);
    const float re1 = em1 * cb - 2.f * sh * sh;
    const float im1 = (1.f + em1) * sb;
    const float den = are * are + aim * aim;
    cfr[n] = (re1 * are + im1 * aim) / den;
    cfi[n] = (im1 * are - re1 * aim) / den;
    float pr, pi;
    lam_pow(step, are, aim, tau, pr, pi);
    p0r[n] = pr; p0i[n] = pi;
    lam_pow(step, are, aim, tau + 1, pr, pi);
    p1r[n] = pr; p1i[n] = pi;
  }
  for (int i = tid; i < 1024; i += NT) {
    Cr[i] = P.s5_c_re[(size_t)rg * 1024 + i];
    Ci[i] = P.s5_c_im[(size_t)rg * 1024 + i];
  }
  __syncthreads();
  for (int i = tid; i < 1024; i += NT) {
    const int n = i >> 4;
    const float br = P.s5_b_re[(size_t)rg * 1024 + i], bi = P.s5_b_im[(size_t)rg * 1024 + i];
    const float tr = cfr[n] * br - cfi[n] * bi, ti = cfr[n] * bi + cfi[n] * br;
    Gr[i] = p0r[n] * tr - p0i[n] * ti;
    Gi[i] = p0r[n] * ti + p0i[n] * tr;
  }
  __syncthreads();
  u16* MEND = (u16*)(P.ws + OFF_MEND);
  u16* MST = (u16*)(P.ws + OFF_MST);
  float* KTAB = (float*)(P.ws + OFF_KTAB);
  {
    const int ii = (r == 0) ? (31 - tau) : tau;
    for (int i = tid; i < 2048; i += NT) {
      const int part = i >> 10, n = (i >> 4) & 63, pi_ = i & 15;
      const float v = part ? Gi[n * 16 + pi_] : Gr[n * 16 + pi_];
      MEND[((size_t)g * 256 + r * 128 + part * 64 + n) * 512 + ii * 16 + pi_] = f2bf(v);
    }
  }
  if (tid < 256) {
    const int po = tid >> 4, pi_ = tid & 15;
    float s = 0.f;
    for (int n = 0; n < 64; ++n) s += Cr[po * 64 + n] * Gr[n * 16 + pi_] - Ci[po * 64 + n] * Gi[n * 16 + pi_];
    KTAB[(((size_t)rg) * 32 + tau) * 256 + tid] = s;
  }
  {
    const int jj = (r == 0) ? tau : (31 - tau);
    for (int i = tid; i < 2048; i += NT) {
      const int po = i >> 7, part = (i >> 6) & 1, n = i & 63;
      const float cr = Cr[po * 64 + n], ci = Ci[po * 64 + n];
      const float v = part ? -(cr * p1i[n] + ci * p1r[n]) : (cr * p1r[n] - ci * p1i[n]);
      MST[((size_t)g * 512 + jj * 16 + po) * 256 + r * 128 + part * 64 + n] = f2bf(v);
    }
  }
}

__device__ __forceinline__ void norm_row(const float* __restrict__ xr, const float* __restrict__ nw, const float* __restrict__ shift,
                                         const float* __restrict__ scale, u16* __restrict__ dst, int lane) {
  float4 v[4];
  float ss = 0.f;
#pragma unroll
  for (int it = 0; it < 4; ++it) {
    v[it] = *(const float4*)(xr + (it * 64 + lane) * 4);
    ss += v[it].x * v[it].x + v[it].y * v[it].y + v[it].z * v[it].z + v[it].w * v[it].w;
  }
  ss = wsum64(ss);
  const float rstd = rsqrtf(ss * (1.f / 1024.f) + 1e-6f);
#pragma unroll
  for (int it = 0; it < 4; ++it) {
    const int c = (it * 64 + lane) * 4;
    const float4 w4 = *(const float4*)(nw + c), sh = *(const float4*)(shift + c), sc = *(const float4*)(scale + c);
    const float y0 = v[it].x * rstd * w4.x * (1.f + sc.x) + sh.x;
    const float y1 = v[it].y * rstd * w4.y * (1.f + sc.y) + sh.y;
    const float y2 = v[it].z * rstd * w4.z * (1.f + sc.z) + sh.z;
    const float y3 = v[it].w * rstd * w4.w * (1.f + sc.w) + sh.w;
    uint2 o; o.x = pack2(y0, y1); o.y = pack2(y2, y3);
    *(uint2*)(dst + c) = o;
  }
}

__device__ __forceinline__ void norm1_item(const Params& P, int item) {
  const int lane = opq(threadIdx.x) & 63, w = opq(threadIdx.x) >> 6;
  const int row = item * 8 + w;
  const float* MOD = (const float*)(P.ws + OFF_MOD);
  const int bi = (row < 16384) ? (row >> 12) : 4;
  const float* xr = (row < 16384) ? (P.x + (size_t)row * 1024) : (P.ctx + (size_t)(row - 16384) * 1024);
  norm_row(xr, P.norm1_w, MOD + bi * 6144, MOD + bi * 6144 + 1024, (u16*)(P.ws + OFF_R2) + (size_t)row * 1024, lane);
}

__device__ __forceinline__ void mintra_item(const Params& P, int item) {
  const int tid = opq(threadIdx.x);
  const int rowg = item * 8 + (tid >> 6);
  const int g = rowg >> 9, nout = rowg & 511, j = nout >> 4, po = nout & 15;
  const int k0 = (tid & 63) * 8, i = k0 >> 4, pi0 = k0 & 15;
  const float* KTAB = (const float*)(P.ws + OFF_KTAB);
  float f[8];
#pragma unroll
  for (int e = 0; e < 8; ++e) f[e] = 0.f;
  if (i <= j) {
    const float* kp = KTAB + (((size_t)(0 * 32 + g)) * 32 + (j - i)) * 256 + po * 16 + pi0;
#pragma unroll
    for (int e = 0; e < 8; ++e) f[e] += kp[e];
  }
  if (i >= j) {
    const float* kp = KTAB + (((size_t)(1 * 32 + g)) * 32 + (i - j)) * 256 + po * 16 + pi0;
#pragma unroll
    for (int e = 0; e < 8; ++e) f[e] += kp[e];
  }
  if (i == j) {
    const float dv = P.s5_d[g * 16 + po];
#pragma unroll
    for (int e = 0; e < 8; ++e) if (pi0 + e == po) f[e] += dv;
  }
  u16* MI = (u16*)(P.ws + OFF_MINTRA);
  *(uint4*)(MI + (size_t)rowg * 512 + k0) = pack8(f);
}

__device__ __forceinline__ void inproj_tile(const Params& P, int t, char* lds) {
  int mt, nt;
  if (t < 1344) { nt = t / 64; mt = t % 64; }
  else {
    const int tt = t - 1344; mt = 64 + (tt & 3);
    const int ni = tt >> 2;
    nt = (ni < 8) ? (4 + ni) : ((ni < 12) ? (16 + ni - 8) : 20);
  }
  const int m0 = mt * 256, n0 = nt * 128;
  f32x4 acc[4][4];
  acc_zero(acc);
  gemm_main((const u16*)(P.ws + OFF_R2) + (size_t)m0 * 1024, 1024, (const u16*)(P.ws + OFF_WT_IN) + (size_t)n0 * 1024, 1024, 1024, acc, (u16*)lds);
  TILE_COORDS
  if (nt < 12) {
    u16* QKV = (u16*)(P.ws + OFF_R3);
#pragma unroll
    for (int i = 0; i < 4; ++i)
#pragma unroll
      for (int j = 0; j < 4; ++j)
#pragma unroll
        for (int e = 0; e < 4; ++e) QKV[(size_t)TROW(m0, i, e) * 1536 + TCOL(n0, j)] = f2bf(acc[i][j][e]);
  } else if (nt < 16) {
    u16* Z = (u16*)(P.ws + OFF_Z);
#pragma unroll
    for (int i = 0; i < 4; ++i)
#pragma unroll
      for (int j = 0; j < 4; ++j)
#pragma unroll
        for (int e = 0; e < 4; ++e) Z[(size_t)TROW(m0, i, e) * 512 + TCOL(n0, j) - 1536] = f2bf(acc[i][j][e]);
  } else if (nt < 20) {
    u16* U5 = (u16*)(P.ws + OFF_U5);
#pragma unroll
    for (int i = 0; i < 4; ++i)
#pragma unroll
      for (int j = 0; j < 4; ++j)
#pragma unroll
        for (int e = 0; e < 4; ++e) {
          const int cc = TCOL(n0, j) - 2048;
          U5[((size_t)(cc >> 4) * 17408 + TROW(m0, i, e)) * 16 + (cc & 15)] = f2bf(acc[i][j][e]);
        }
  } else {
    float* BA = (float*)(P.ws + OFF_BA);
#pragma unroll
    for (int i = 0; i < 4; ++i)
#pragma unroll
      for (int j = 0; j < 4; ++j)
#pragma unroll
        for (int e = 0; e < 4; ++e) {
          const int cc = TCOL(n0, j) - 2560;
          if (cc < 16) BA[(size_t)TROW(m0, i, e) * 16 + cc] = acc[i][j][e];
        }
  }
}

template <int DIR>
__device__ __forceinline__ void solve_cols(const Params& P, int itb, int c, const float* Lt, const float* bpp, const float* gcp,
                                           const u16* Vs, const u16* Ks) {
  float sol[64];
  const float* bp_ = bpp + DIR * 64;
  const float* gc_ = gcp + DIR * 64;
  if (c < 128) {
    const u16* vp = Vs + c;
#pragma unroll
    for (int p = 0; p < 64; ++p) sol[p] = bp_[p] * bf2f(vp[(DIR ? (63 - p) : p) * 136]);
  } else {
    const u16* kp = Ks + (c - 128);
#pragma unroll
    for (int p = 0; p < 64; ++p) sol[p] = bp_[p] * __expf(gc_[p]) * bf2f(kp[(DIR ? (63 - p) : p) * 136]);
  }
  const float* Lr = Lt + opq(DIR * 4096);
#ifndef NO_SOLVE
#pragma unroll
  for (int j = 0; j < 63; ++j) {
    const float sj = sol[j];
#pragma unroll
    for (int i = j + 1; i < 64; ++i) sol[i] -= Lr[j * 64 + i] * sj;
  }
#endif
  const size_t it2 = (size_t)(itb + DIR);
  if (c < 128) {
    u16* UF = (u16*)(P.ws + OFF_UF) + (it2 * 128 + c) * 64;
#pragma unroll
    for (int q = 0; q < 8; ++q) *(uint4*)(UF + q * 8) = pack8(sol + q * 8);
  } else {
    u16* Wg = (u16*)(P.ws + OFF_R2) + it2 * 8192 + (c - 128);
#pragma unroll
    for (int p = 0; p < 64; ++p) Wg[p * 128] = f2bf(-sol[p]);
  }
}

__device__ __forceinline__ void delta_prep_item(const Params& P, int item, char* lds) {
  const int tid = opq(threadIdx.x), lane = tid & 63, wv = tid >> 6, fr = lane & 15, fq = lane >> 4;
  const int cid = item >> 2, h = item & 3;
  const int row0 = cid * 64;
  int seq_lo, seq_hi;
  if (cid < 256) { seq_lo = (cid >> 6) * 4096; seq_hi = seq_lo + 4096; }
  else { seq_lo = 16384 + ((cid - 256) >> 2) * 256; seq_hi = seq_lo + 256; }
  u16* Qs = (u16*)(lds + opq(0));
  u16* Ks = (u16*)(lds + opq(17408));
  u16* Vs = (u16*)(lds + opq(34816));
  float* KKs = (float*)(lds + opq(52224));
  float* QKs = (float*)(lds + opq(69632));
  float* Lt = (float*)(lds + opq(87040));
  float* gtok = (float*)(lds + opq(119808));
  float* btok = gtok + 128;
  float* gcp = btok + 128;
  float* bpp = gcp + 128;
  u16* QKN = (u16*)((char*)P.out + OFF_QKN);
  __syncthreads();
  {
    const int j = tid >> 3, sg = tid & 7;
    const int row = row0 + j;
    const bool hm = (row - 1 >= seq_lo), hp = (row + 1 < seq_hi);
    const u16* qkv = (const u16*)(P.ws + OFF_R3);
#pragma unroll
    for (int s = 0; s < 3; ++s) {
      const int col = s * 512 + h * 128 + sg * 16;
      const u16* p0 = qkv + (size_t)row * 1536 + col;
      float y[16];
      float ssq = 0.f;
#pragma unroll
      for (int hh = 0; hh < 2; ++hh) {
        const uint4 c0 = *(const uint4*)(p0 + hh * 8);
        uint4 m0 = *(const uint4*)(p0 - (hm ? 1536 : 0) + hh * 8);
        uint4 n0 = *(const uint4*)(p0 + (hp ? 1536 : 0) + hh * 8);
        m0.x = hm ? m0.x : 0u; m0.y = hm ? m0.y : 0u; m0.z = hm ? m0.z : 0u; m0.w = hm ? m0.w : 0u;
        n0.x = hp ? n0.x : 0u; n0.y = hp ? n0.y : 0u; n0.z = hp ? n0.z : 0u; n0.w = hp ? n0.w : 0u;
        float fc[8], fm[8], fn[8];
        unpack8(c0, fc); unpack8(m0, fm); unpack8(n0, fn);
        const float* cw = P.dn_conv_w + col + hh * 8;
#pragma unroll
        for (int e = 0; e < 8; ++e) {
          const float v = cw[e] * fm[e] + cw[1536 + e] * fc[e] + cw[3072 + e] * fn[e];
          const float yy = v * sigm(v);
          y[hh * 8 + e] = yy;
          ssq += yy * yy;
        }
      }
      if (s < 2) {
        ssq += __shfl_xor(ssq, 1, 64); ssq += __shfl_xor(ssq, 2, 64); ssq += __shfl_xor(ssq, 4, 64);
        const float sc = rsqrtf(ssq + 1e-6f) * ((s == 0) ? 0.08838834764831845f : 1.f);
#pragma unroll
        for (int e = 0; e < 16; ++e) y[e] *= sc;
      }
      u16* dl = ((s == 0) ? Qs : ((s == 1) ? Ks : Vs)) + j * 136 + sg * 16;
      const uint4 o0 = pack8(y), o1 = pack8(y + 8);
      *(uint4*)dl = o0; *(uint4*)(dl + 8) = o1;
      if (s < 2) {
        u16* dg = QKN + (size_t)row * 1024 + s * 512 + h * 128 + sg * 16;
        *(uint4*)dg = o0; *(uint4*)(dg + 8) = o1;
      }
    }
  }
  if (tid < 128) {
    const int j = tid & 63, dir = tid >> 6;
    const float* BA = (const float*)(P.ws + OFF_BA) + (size_t)(row0 + j) * 16;
    const float bl = BA[dir * 4 + h], al = BA[8 + dir * 4 + h];
    const float xx = al + P.dn_dt_bias[dir * 4 + h];
    const float sp = (xx > 20.f) ? xx : log1pf(expf(xx));
    gtok[dir * 64 + j] = -expf(P.dn_a_log[dir * 4 + h]) * sp;
    btok[dir * 64 + j] = 1.f / (1.f + expf(-bl));
  }
  __syncthreads();
  if (tid < 2) {
    const int dir = tid;
    float a = 0.f;
    for (int p = 0; p < 64; ++p) {
      const int tk = dir ? (63 - p) : p;
      a += gtok[dir * 64 + tk];
      gcp[dir * 64 + p] = a;
      bpp[dir * 64 + p] = btok[dir * 64 + tk];
    }
  }
  {
#pragma unroll
    for (int q = 0; q < 4; ++q) {
      const int t = wv * 4 + q;
      const int which = t >> 4, mi = (t >> 2) & 3, ni = t & 3;
      const u16* Am = (which ? Qs : Ks) + (mi * 16 + fr) * 136 + fq * 8;
      const u16* Bm = Ks + (ni * 16 + fr) * 136 + fq * 8;
      f32x4 a4 = {0.f, 0.f, 0.f, 0.f};
#pragma unroll
      for (int kk = 0; kk < 4; ++kk)
        a4 = __builtin_amdgcn_mfma_f32_16x16x32_bf16(*(const bf16x8*)(Am + kk * 32), *(const bf16x8*)(Bm + kk * 32), a4, 0, 0, 0);
      float* dst = which ? QKs : KKs;
#pragma unroll
      for (int e = 0; e < 4; ++e) dst[(mi * 16 + fq * 4 + e) * 68 + ni * 16 + fr] = a4[e];
    }
  }
  __syncthreads();
  const int itb = item * 2;
  {
    u16* AQ = (u16*)((char*)P.out + OFF_AQ);
    for (int idx = tid; idx < 8192; idx += NT) {
      const int dir = idx >> 12, p = (idx >> 6) & 63, s = idx & 63;
      const int tp = dir ? (63 - p) : p, ts = dir ? (63 - s) : s;
      const float dg = gcp[dir * 64 + p] - gcp[dir * 64 + s];
      const float dec = (p >= s) ? __expf(dg) : 0.f;
      const float lv = (p > s) ? bpp[dir * 64 + p] * KKs[tp * 68 + ts] * dec : 0.f;
      Lt[dir * 4096 + s * 64 + p] = lv;
      AQ[((size_t)(itb + dir) * 64 + p) * 64 + s] = f2bf(QKs[tp * 68 + ts] * dec);
    }
    if (tid < 128) {
      float* GC = (float*)(P.ws + OFF_GC);
      GC[(size_t)(itb + (tid >> 6)) * 64 + (tid & 63)] = gcp[tid];
    }
  }
  __syncthreads();
  if (tid < 256) solve_cols<0>(P, itb, tid, Lt, bpp, gcp, Vs, Ks);
  else solve_cols<1>(P, itb, tid - 256, Lt, bpp, gcp, Vs, Ks);
}

__device__ __forceinline__ void s5end_tile(const Params& P, int t, char* lds) {
  const int g = t / 6, mt = (t % 6) >> 1, nt = t & 1;
  const int m0 = mt * 256, n0 = nt * 128;
  f32x4 acc[4][4];
  acc_zero(acc);
  gemm_main((const u16*)(P.ws + OFF_U5) + ((size_t)g * 544 + m0) * 512, 512,
            (const u16*)(P.ws + OFF_MEND) + ((size_t)g * 256 + n0) * 512, 512, 512, acc, (u16*)lds);
  TILE_COORDS
  float* E = (float*)(P.ws + OFF_E);
#pragma unroll
  for (int i = 0; i < 4; ++i)
#pragma unroll
    for (int j = 0; j < 4; ++j)
#pragma unroll
      for (int e = 0; e < 4; ++e) {
        const int row = TROW(m0, i, e);
        if (row < 544) E[((size_t)g * 544 + row) * 256 + TCOL(n0, j)] = acc[i][j][e];
      }
}

__device__ __forceinline__ void delta_scan_block(const Params& P, int sb, char* lds) {
  const int tid = opq(threadIdx.x), lane = tid & 63, w = tid >> 6, fr = lane & 15, fq = lane >> 4;
  const int b = sb >> 3, h = (sb >> 1) & 3, dir = sb & 1;
  u16* Wl = (u16*)(lds + opq(0));
  u16* QTl = (u16*)(lds + opq(17408));
  u16* KTl = (u16*)(lds + opq(34816));
  u16* AQl = (u16*)(lds + opq(53248));
  u16* ST = (u16*)(lds + opq(62464));
  u16* VT = (u16*)(lds + opq(97280));
  __syncthreads();
  for (int i = tid; i < 128 * 136 / 2; i += NT) ((uint32_t*)ST)[i] = 0u;
  f32x4 accS[8];
#pragma unroll
  for (int d = 0; d < 8; ++d) accS[d] = f32x4{0.f, 0.f, 0.f, 0.f};
  const int nw = w * 16;
  const u16* QKN = (const u16*)((const char*)P.out + OFF_QKN);
  const u16* AQg = (const u16*)((const char*)P.out + OFF_AQ);
  const u16* Wg = (const u16*)(P.ws + OFF_R2);
  const u16* UFg = (const u16*)(P.ws + OFF_UF);
  const float* GC = (const float*)(P.ws + OFF_GC);
  u16* Og = (u16*)(P.ws + OFF_O);

  uint4 rw0, rw1, rq0, rq1, rk0, rk1, ra;
  float gq0, gq1, gk, g63;
  uint2 ru0, ru1, ru2, ru3;
  int cur_row0 = 0, cur_lat = 0;
  int nxt_row0 = 0, nxt_lat = 0;
  int prv_row0 = 0, prv_lat = 0;
  uint32_t osv[4][2];
#pragma unroll
  for (int mt = 0; mt < 4; ++mt) { osv[mt][0] = 0u; osv[mt][1] = 0u; }

#define SCAN_PF_ONE(i)                                                                             \
    {                                                                                              \
      const int id = tid + (i) * 512;                                                              \
      const int p = id >> 4, seg = id & 15;                                                        \
      const int tk = dir ? (63 - p) : p;                                                           \
      rw##i = *(const uint4*)(Wg + it2__ * 8192 + p * 128 + seg * 8);                              \
      rq##i = *(const uint4*)(QKN + (size_t)(nxt_row0 + tk) * 1024 + h * 128 + seg * 8);           \
      gq##i = GC[it2__ * 64 + p];                                                                  \
      const int s = id & 63, sg2 = id >> 6;                                                        \
      const int tks = dir ? (63 - s) : s;                                                          \
      rk##i = *(const uint4*)(QKN + (size_t)(nxt_row0 + tks) * 1024 + 512 + h * 128 + sg2 * 8);    \
    }
#define SCAN_PREFETCH(n_)                                                                          \
  {                                                                                                \
    const int n__ = (n_);                                                                          \
    int cid__;                                                                                     \
    if (n__ < 4) { cid__ = 256 + b * 4 + (dir ? (3 - n__) : n__); nxt_lat = 0; }                   \
    else { const int m__ = n__ - 4; cid__ = b * 64 + (dir ? (63 - m__) : m__); nxt_lat = 1; }      \
    nxt_row0 = cid__ * 64;                                                                         \
    const size_t it2__ = (size_t)((cid__ * 4 + h) * 2 + dir);                                      \
    SCAN_PF_ONE(0)                                                                                 \
    SCAN_PF_ONE(1)                                                                                 \
    gk = GC[it2__ * 64 + (tid & 63)];                                                              \
    g63 = GC[it2__ * 64 + 63];                                                                     \
    ra = *(const uint4*)(AQg + it2__ * 4096 + (tid >> 3) * 64 + (tid & 7) * 8);                    \
    ru0 = *(const uint2*)(UFg + (it2__ * 128 + nw + fr) * 64 + 0 * 16 + fq * 4);                   \
    ru1 = *(const uint2*)(UFg + (it2__ * 128 + nw + fr) * 64 + 1 * 16 + fq * 4);                   \
    ru2 = *(const uint2*)(UFg + (it2__ * 128 + nw + fr) * 64 + 2 * 16 + fq * 4);                   \
    ru3 = *(const uint2*)(UFg + (it2__ * 128 + nw + fr) * 64 + 3 * 16 + fq * 4);                   \
  }

  SCAN_PREFETCH(0)
  for (int n = 0; n < 68; ++n) {
    cur_row0 = nxt_row0; cur_lat = nxt_lat;
    const float gl = __expf(g63);
    const float sk = __expf(g63 - gk);
#define SCAN_STAGE_ONE(i)                                                     \
    {                                                                         \
      const int id = tid + (i) * 512;                                         \
      const int p = id >> 4, seg = id & 15;                                   \
      *(uint4*)(Wl + p * 136 + seg * 8) = rw##i;                              \
      float f[8];                                                             \
      unpack8(rq##i, f);                                                      \
      const float sq = __expf(gq##i);                                         \
      _Pragma("unroll") for (int e = 0; e < 8; ++e) f[e] *= sq;               \
      *(uint4*)(QTl + p * 136 + seg * 8) = pack8(f);                          \
      const int s = id & 63, sg2 = id >> 6;                                   \
      unpack8(rk##i, f);                                                      \
      _Pragma("unroll") for (int e = 0; e < 8; ++e) KTl[(sg2 * 8 + e) * 72 + s] = f2bf(f[e] * sk); \
    }
    SCAN_STAGE_ONE(0)
    SCAN_STAGE_ONE(1)
#undef SCAN_STAGE_ONE
    *(uint4*)(AQl + (tid >> 3) * 72 + (tid & 7) * 8) = ra;
    f32x4 av[4], ao[4];
    av[0] = f32x4{lo16(ru0.x), hi16(ru0.x), lo16(ru0.y), hi16(ru0.y)};
    av[1] = f32x4{lo16(ru1.x), hi16(ru1.x), lo16(ru1.y), hi16(ru1.y)};
    av[2] = f32x4{lo16(ru2.x), hi16(ru2.x), lo16(ru2.y), hi16(ru2.y)};
    av[3] = f32x4{lo16(ru3.x), hi16(ru3.x), lo16(ru3.y), hi16(ru3.y)};
#pragma unroll
    for (int mt = 0; mt < 4; ++mt) ao[mt] = f32x4{0.f, 0.f, 0.f, 0.f};
    __syncthreads();
    if (prv_lat) {
#pragma unroll
      for (int mt = 0; mt < 4; ++mt) {
        const float pv[4] = {lo16(osv[mt][0]), hi16(osv[mt][0]), lo16(osv[mt][1]), hi16(osv[mt][1])};
#pragma unroll
        for (int e = 0; e < 4; ++e) {
          const int p = mt * 16 + fq * 4 + e;
          const int tk = dir ? (63 - p) : p;
          Og[((size_t)dir * 16384 + prv_row0 + tk) * 512 + h * 128 + nw + fr] = f2bf(pv[e]);
        }
      }
    }
    if (n + 1 < 68) SCAN_PREFETCH(n + 1)
#pragma unroll
    for (int kk = 0; kk < 4; ++kk) {
      const bf16x8 bS = *(const bf16x8*)(ST + (nw + fr) * 136 + kk * 32 + fq * 8);
#pragma unroll
      for (int mt = 0; mt < 4; ++mt) {
        const bf16x8 a1 = *(const bf16x8*)(Wl + (mt * 16 + fr) * 136 + kk * 32 + fq * 8);
        av[mt] = __builtin_amdgcn_mfma_f32_16x16x32_bf16(a1, bS, av[mt], 0, 0, 0);
        const bf16x8 a2 = *(const bf16x8*)(QTl + (mt * 16 + fr) * 136 + kk * 32 + fq * 8);
        ao[mt] = __builtin_amdgcn_mfma_f32_16x16x32_bf16(a2, bS, ao[mt], 0, 0, 0);
      }
    }
#pragma unroll
    for (int mt = 0; mt < 4; ++mt) {
      uint2 v; v.x = pack2(av[mt][0], av[mt][1]); v.y = pack2(av[mt][2], av[mt][3]);
      *(uint2*)(VT + (nw + fr) * 72 + mt * 16 + fq * 4) = v;
    }
    __syncthreads();
#pragma unroll
    for (int d = 0; d < 8; ++d) { accS[d][0] *= gl; accS[d][1] *= gl; accS[d][2] *= gl; accS[d][3] *= gl; }
#pragma unroll
    for (int ks = 0; ks < 2; ++ks) {
      const bf16x8 bV = *(const bf16x8*)(VT + (nw + fr) * 72 + ks * 32 + fq * 8);
#pragma unroll
      for (int mt = 0; mt < 4; ++mt) {
        const bf16x8 a1 = *(const bf16x8*)(AQl + (mt * 16 + fr) * 72 + ks * 32 + fq * 8);
        ao[mt] = __builtin_amdgcn_mfma_f32_16x16x32_bf16(a1, bV, ao[mt], 0, 0, 0);
      }
#pragma unroll
      for (int d = 0; d < 8; ++d) {
        const bf16x8 a2 = *(const bf16x8*)(KTl + (d * 16 + fr) * 72 + ks * 32 + fq * 8);
        accS[d] = __builtin_amdgcn_mfma_f32_16x16x32_bf16(a2, bV, accS[d], 0, 0, 0);
      }
    }
#pragma unroll
    for (int d = 0; d < 8; ++d) {
      uint2 v; v.x = pack2(accS[d][0], accS[d][1]); v.y = pack2(accS[d][2], accS[d][3]);
      *(uint2*)(ST + (nw + fr) * 136 + d * 16 + fq * 4) = v;
    }
#pragma unroll
    for (int mt = 0; mt < 4; ++mt) { osv[mt][0] = pack2(ao[mt][0], ao[mt][1]); osv[mt][1] = pack2(ao[mt][2], ao[mt][3]); }
    prv_lat = cur_lat; prv_row0 = cur_row0;
    __syncthreads();
  }
  if (prv_lat) {
#pragma unroll
    for (int mt = 0; mt < 4; ++mt) {
      const float pv[4] = {lo16(osv[mt][0]), hi16(osv[mt][0]), lo16(osv[mt][1]), hi16(osv[mt][1])};
#pragma unroll
      for (int e = 0; e < 4; ++e) {
        const int p = mt * 16 + fq * 4 + e;
        const int tk = dir ? (63 - p) : p;
        Og[((size_t)dir * 16384 + prv_row0 + tk) * 512 + h * 128 + nw + fr] = f2bf(pv[e]);
      }
    }
  }
#undef SCAN_PREFETCH
#undef SCAN_PF_ONE
}

__device__ __forceinline__ void s5_carry_block(const Params& P, int cb) {
  const int idx = cb * NT + opq(threadIdx.x);
  const int n = idx & 63, g = (idx >> 6) & 31, r = (idx >> 11) & 1, b = idx >> 12;
  const int rg = r * 32 + g;
  const float step = expf(P.s5_log_step[rg]);
  float lr, li;
  lam_pow(step, P.s5_a_re[rg * 64 + n], P.s5_a_im[rg * 64 + n], 32, lr, li);
  const float* E = (const float*)(P.ws + OFF_E) + (size_t)g * 544 * 256 + r * 128 + n;
  u16* XIN = (u16*)(P.ws + OFF_XIN) + (size_t)g * 512 * 256 + r * 128 + n;
  float xr = 0.f, xi = 0.f;
  for (int k = 0; k < 8; ++k) {
    const int cc = r ? (7 - k) : k;
    const int row = 512 + b * 8 + cc;
    const float er = E[(size_t)row * 256], ei = E[(size_t)row * 256 + 64];
    const float nr = lr * xr - li * xi + er, ni = lr * xi + li * xr + ei;
    xr = nr; xi = ni;
  }
  for (int k = 0; k < 128; ++k) {
    const int cc = r ? (127 - k) : k;
    const int row = b * 128 + cc;
    XIN[(size_t)row * 256] = f2bf(xr);
    XIN[(size_t)row * 256 + 64] = f2bf(xi);
    const float er = E[(size_t)row * 256], ei = E[(size_t)row * 256 + 64];
    const float nr = lr * xr - li * xi + er, ni = lr * xi + li * xr + ei;
    xr = nr; xi = ni;
  }
}

__device__ __forceinline__ void s5out_tile(const Params& P, int t, char* lds) {
  const int g = t >> 3, mt = (t >> 2) & 1, nt = t & 3;
  const int m0 = mt * 256, n0 = nt * 128;
  f32x4 acc[4][4];
  acc_zero(acc);
  gemm_main((const u16*)(P.ws + OFF_XIN) + ((size_t)g * 512 + m0) * 256, 256,
            (const u16*)(P.ws + OFF_MST) + ((size_t)g * 512 + n0) * 256, 256, 256, acc, (u16*)lds);
  gemm_main((const u16*)(P.ws + OFF_U5) + ((size_t)g * 544 + m0) * 512, 512,
            (const u16*)(P.ws + OFF_MINTRA) + ((size_t)g * 512 + n0) * 512, 512, 512, acc, (u16*)lds);
  TILE_COORDS
  u16* YB = (u16*)(P.ws + OFF_YB);
#pragma unroll
  for (int i = 0; i < 4; ++i)
#pragma unroll
    for (int j = 0; j < 4; ++j)
#pragma unroll
      for (int e = 0; e < 4; ++e) {
        const int row = TROW(m0, i, e), nn = TCOL(n0, j);
        const int token = row * 32 + (nn >> 4);
        YB[(size_t)token * 512 + g * 16 + (nn & 15)] = f2bf(gelu_tanh(acc[i][j][e]));
      }
}

__device__ __forceinline__ void delta_post_item(const Params& P, int item) {
  const int lane = opq(threadIdx.x) & 63, w = opq(threadIdx.x) >> 6;
  const int row = item * 8 + w;
  const u16* O = (const u16*)(P.ws + OFF_O);
  const uint4 o0 = *(const uint4*)(O + (size_t)row * 512 + lane * 8);
  const uint4 o1 = *(const uint4*)(O + ((size_t)16384 + row) * 512 + lane * 8);
  const uint4 zz = *(const uint4*)((const u16*)(P.ws + OFF_Z) + (size_t)row * 512 + lane * 8);
  float a[8], bq[8], z[8];
  unpack8(o0, a); unpack8(o1, bq); unpack8(zz, z);
  float ss = 0.f;
#pragma unroll
  for (int e = 0; e < 8; ++e) { a[e] += bq[e]; ss += a[e] * a[e]; }
  ss += __shfl_xor(ss, 1, 64); ss += __shfl_xor(ss, 2, 64); ss += __shfl_xor(ss, 4, 64); ss += __shfl_xor(ss, 8, 64);
  const float rstd = rsqrtf(ss * (1.f / 128.f) + 1e-6f);
  const float* nw = P.dn_norm_w + (lane & 15) * 8;
  float y[8];
#pragma unroll
  for (int e = 0; e < 8; ++e) y[e] = a[e] * rstd * nw[e] * (z[e] * sigm(z[e]));
  *(uint4*)((u16*)(P.ws + OFF_YA) + (size_t)row * 512 + lane * 8) = pack8(y);
}

__device__ __forceinline__ void glu_tile(const Params& P, int t, char* lds) {
  const int nt = t >> 6, mt = t & 63;
  const int m0 = mt * 256, n0 = nt * 128;
  f32x4 acc[4][4];
  acc_zero(acc);
  gemm_main((const u16*)(P.ws + OFF_YB) + (size_t)m0 * 512, 512, (const u16*)(P.ws + OFF_WT_GLU) + (size_t)n0 * 512, 512, 512, acc, (u16*)lds);
  TILE_COORDS
  u16* YG = (u16*)(P.ws + OFF_YG);
#pragma unroll
  for (int i = 0; i < 4; ++i)
#pragma unroll
    for (int j = 0; j < 2; ++j) {
      const int oc = nt * 64 + wn_ * 32 + j * 16 + fr_;
      const float bv = P.b_glu[oc], bg = P.b_glu[512 + oc];
#pragma unroll
      for (int e = 0; e < 4; ++e) {
        const float val = acc[i][j][e] + bv, gt = acc[i][j + 2][e] + bg;
        YG[(size_t)TROW(m0, i, e) * 512 + oc] = f2bf(val * sigm(gt));
      }
    }
}

__device__ __forceinline__ void gates_tile(const Params& P, int t, char* lds) {
  const int nt = t >> 6, mt = t & 63;
  const int m0 = mt * 256, n0 = nt * 128;
  f32x4 acc[4][4];
  acc_zero(acc);
  gemm_main((const u16*)(P.ws + OFF_R2) + (size_t)m0 * 1024, 1024, (const u16*)(P.ws + OFF_WT_IN) + (size_t)(2688 + n0) * 1024, 1024, 1024, acc, (u16*)lds);
  TILE_COORDS
  u16* SG = (u16*)(P.ws + OFF_SG);
#pragma unroll
  for (int i = 0; i < 4; ++i)
#pragma unroll
    for (int j = 0; j < 4; ++j)
#pragma unroll
      for (int e = 0; e < 4; ++e) SG[(size_t)TROW(m0, i, e) * 2048 + TCOL(n0, j)] = f2bf(sigm(acc[i][j][e]));
}

__device__ __forceinline__ void mix_tile(const Params& P, int t, char* lds) {
  const int nt = t >> 6, mt = t & 63;
  const int m0 = mt * 256, n0 = nt * 128;
  const u16* SG = (const u16*)(P.ws + OFF_SG);
  f32x4 acc[4][4];
  u16* MIX = (u16*)(P.ws + OFF_MIX);
  acc_zero(acc);
  gemm_main((const u16*)(P.ws + OFF_YA) + (size_t)m0 * 512, 512, (const u16*)(P.ws + OFF_WT_AOUT) + (size_t)n0 * 512, 512, 512, acc, (u16*)lds);
  {
    TILE_COORDS
#pragma unroll
    for (int i = 0; i < 4; ++i)
#pragma unroll
      for (int j = 0; j < 4; ++j)
#pragma unroll
        for (int e = 0; e < 4; ++e) {
          const int r = TROW(m0, i, e), col = TCOL(n0, j);
          MIX[(size_t)r * 1024 + col] = f2bf(bf2f(SG[(size_t)r * 2048 + col]) * acc[i][j][e]);
        }
  }
  acc_zero(acc);
  gemm_main((const u16*)(P.ws + OFF_YG) + (size_t)m0 * 512, 512, (const u16*)(P.ws + OFF_WT_BOUT) + (size_t)n0 * 512, 512, 512, acc, (u16*)lds);
  {
    TILE_COORDS
#pragma unroll
    for (int i = 0; i < 4; ++i)
#pragma unroll
      for (int j = 0; j < 4; ++j)
#pragma unroll
        for (int e = 0; e < 4; ++e) {
          const int r = TROW(m0, i, e), col = TCOL(n0, j);
          const size_t o = (size_t)r * 1024 + col;
          MIX[o] = f2bf(bf2f(MIX[o]) + bf2f(SG[(size_t)r * 2048 + 1024 + col]) * acc[i][j][e]);
        }
  }
}

__device__ __forceinline__ void wo_tile(const Params& P, int t, char* lds) {
  const int nt = t >> 6, mt = t & 63;
  const int m0 = mt * 256, n0 = nt * 128;
  f32x4 acc[4][4];
  acc_zero(acc);
  gemm_main((const u16*)(P.ws + OFF_MIX) + (size_t)m0 * 1024, 1024, (const u16*)(P.ws + OFF_WT_O) + (size_t)n0 * 1024, 1024, 1024, acc, (u16*)lds);
  TILE_COORDS
  const float* MOD = (const float*)(P.ws + OFF_MOD) + (m0 >> 12) * 6144 + 2 * 1024;
#pragma unroll
  for (int j = 0; j < 4; ++j) {
    const int col = TCOL(n0, j);
    const float gate = MOD[col];
#pragma unroll
    for (int i = 0; i < 4; ++i)
#pragma unroll
      for (int e = 0; e < 4; ++e) {
        const size_t o = (size_t)TROW(m0, i, e) * 1024 + col;
        P.out[o] = P.x[o] + gate * acc[i][j][e];
      }
  }
}

__device__ __forceinline__ void norm2_item(const Params& P, int item) {
  const int lane = opq(threadIdx.x) & 63, w = opq(threadIdx.x) >> 6;
  const int row = item * 8 + w;
  const float* MOD = (const float*)(P.ws + OFF_MOD) + (row >> 12) * 6144;
  norm_row(P.out + (size_t)row * 1024, P.norm2_w, MOD + 3 * 1024, MOD + 4 * 1024, (u16*)(P.ws + OFF_R2) + (size_t)row * 1024, lane);
}

__device__ __forceinline__ void up_tile(const Params& P, int t, int hh, char* lds) {
  const int nt = t >> 6, mt = t & 63;
  const int m0 = mt * 256, n0 = nt * 128;
  f32x4 acc[4][4];
  acc_zero(acc);
  gemm_main((const u16*)(P.ws + OFF_R2) + (size_t)m0 * 1024, 1024,
            (const u16*)(P.ws + OFF_WT_UP) + ((size_t)hh * 2816 + n0) * 1024, 1024, 1024, acc, (u16*)lds);
  TILE_COORDS
  u16* UPH = (u16*)(P.ws + OFF_UPH);
#pragma unroll
  for (int i = 0; i < 4; ++i)
#pragma unroll
    for (int j = 0; j < 4; ++j)
#pragma unroll
      for (int e = 0; e < 4; ++e) UPH[(size_t)TROW(m0, i, e) * 2816 + TCOL(n0, j)] = f2bf(acc[i][j][e]);
}

__device__ __forceinline__ void convgate_item(const Params& P, int item, int hh) {
  const int tid = opq(threadIdx.x);
  if (tid >= 352) return;
  const int xq = item & 3, y = (item >> 2) & 63, b = item >> 8;
  const int c4 = tid * 4;
  const u16* UPH = (const u16*)(P.ws + OFF_UPH);
  u16* G = (u16*)(P.ws + OFF_G);
  float wg[9][4], wv[9][4];
#pragma unroll
  for (int k = 0; k < 9; ++k) {
    const float4 a = *(const float4*)(P.ffn_conv_w + (size_t)k * 5632 + hh * 1408 + c4);
    const float4 bq = *(const float4*)(P.ffn_conv_w + (size_t)k * 5632 + 2816 + hh * 1408 + c4);
    wg[k][0] = a.x; wg[k][1] = a.y; wg[k][2] = a.z; wg[k][3] = a.w;
    wv[k][0] = bq.x; wv[k][1] = bq.y; wv[k][2] = bq.z; wv[k][3] = bq.w;
  }
  const size_t base = (size_t)b * 4096;
  const bool r0ok = (y > 0), r2ok = (y < 63);
  uint2 gL[3], gM[3], gR[3], vL[3], vM[3], vR[3];
  const int x0 = xq * 16;
#define CG_LOADONE(dy, okrow, gdst, vdst)                                                   \
    {                                                                                       \
      const bool ok = cok && (okrow);                                                       \
      const int yy__ = (okrow) ? (y + (dy) - 1) : y;                                        \
      const u16* src = UPH + (base + (size_t)yy__ * 64 + xcc__) * 2816 + c4;                \
      uint2 g__ = *(const uint2*)src;                                                       \
      uint2 v__ = *(const uint2*)(src + 1408);                                              \
      g__.x = ok ? g__.x : 0u; g__.y = ok ? g__.y : 0u;                                     \
      v__.x = ok ? v__.x : 0u; v__.y = ok ? v__.y : 0u;                                     \
      gdst[dy] = g__; vdst[dy] = v__;                                                       \
    }
#define CG_LOADCOL(xc_, gdst, vdst)                                                         \
  {                                                                                         \
    const int xc__ = (xc_);                                                                 \
    const bool cok = (xc__ >= 0) && (xc__ <= 63);                                           \
    const int xcc__ = cok ? xc__ : x0;                                                      \
    CG_LOADONE(0, r0ok, gdst, vdst)                                                         \
    CG_LOADONE(1, true, gdst, vdst)                                                         \
    CG_LOADONE(2, r2ok, gdst, vdst)                                                         \
  }
  CG_LOADCOL(x0 - 1, gL, vL)
  CG_LOADCOL(x0, gM, vM)
  for (int xx = 0; xx < 16; ++xx) {
    const int x = x0 + xx;
    CG_LOADCOL(x + 1, gR, vR)
    float ag[4] = {0.f, 0.f, 0.f, 0.f}, av[4] = {0.f, 0.f, 0.f, 0.f};
#pragma unroll
    for (int dy = 0; dy < 3; ++dy) {
#define CG_TAP(gsrc, vsrc, k_)                                                                                  \
      {                                                                                                         \
        ag[0] += wg[k_][0] * lo16(gsrc[dy].x); ag[1] += wg[k_][1] * hi16(gsrc[dy].x);                           \
        ag[2] += wg[k_][2] * lo16(gsrc[dy].y); ag[3] += wg[k_][3] * hi16(gsrc[dy].y);                           \
        av[0] += wv[k_][0] * lo16(vsrc[dy].x); av[1] += wv[k_][1] * hi16(vsrc[dy].x);                           \
        av[2] += wv[k_][2] * lo16(vsrc[dy].y); av[3] += wv[k_][3] * hi16(vsrc[dy].y);                           \
      }
      CG_TAP(gL, vL, dy * 3 + 0)
      CG_TAP(gM, vM, dy * 3 + 1)
      CG_TAP(gR, vR, dy * 3 + 2)
#undef CG_TAP
    }
    uint2 o;
    o.x = pack2(ag[0] * sigm(ag[0]) * av[0], ag[1] * sigm(ag[1]) * av[1]);
    o.y = pack2(ag[2] * sigm(ag[2]) * av[2], ag[3] * sigm(ag[3]) * av[3]);
    *(uint2*)(G + (base + y * 64 + x) * 2816 + hh * 1408 + c4) = o;
#pragma unroll
    for (int dy = 0; dy < 3; ++dy) { gL[dy] = gM[dy]; vL[dy] = vM[dy]; gM[dy] = gR[dy]; vM[dy] = vR[dy]; }
  }
#undef CG_LOADCOL
}

__device__ __forceinline__ void down_tile(const Params& P, int t, char* lds) {
  const int nt = t >> 6, mt = t & 63;
  const int m0 = mt * 256, n0 = nt * 128;
  f32x4 acc[4][4];
  acc_zero(acc);
  gemm_main((const u16*)(P.ws + OFF_G) + (size_t)m0 * 2816, 2816, (const u16*)(P.ws + OFF_WT_DOWN) + (size_t)n0 * 2816, 2816, 2816, acc, (u16*)lds);
  TILE_COORDS
  const float* MOD = (const float*)(P.ws + OFF_MOD) + (m0 >> 12) * 6144 + 5 * 1024;
#pragma unroll
  for (int j = 0; j < 4; ++j) {
    const int col = TCOL(n0, j);
    const float gate = MOD[col];
#pragma unroll
    for (int i = 0; i < 4; ++i)
#pragma unroll
      for (int e = 0; e < 4; ++e) {
        const size_t o = (size_t)TROW(m0, i, e) * 1024 + col;
        P.out[o] = P.out[o] + gate * acc[i][j][e];
      }
  }
}

__device__ __forceinline__ void final_item(const Params& P, int item) {
  const int lane = opq(threadIdx.x) & 63, w = opq(threadIdx.x) >> 6;
  const int row = item * 8 + w;
  float* xr = P.out + (size_t)row * 1024;
  float4 v[4];
  float ss = 0.f;
#pragma unroll
  for (int it = 0; it < 4; ++it) {
    v[it] = *(const float4*)(xr + (it * 64 + lane) * 4);
    ss += v[it].x * v[it].x + v[it].y * v[it].y + v[it].z * v[it].z + v[it].w * v[it].w;
  }
  ss = wsum64(ss);
  const float rstd = rsqrtf(ss * (1.f / 1024.f) + 1e-6f);
#pragma unroll
  for (int it = 0; it < 4; ++it) {
    const int c = (it * 64 + lane) * 4;
    const float4 w4 = *(const float4*)(P.norm_f_w + c);
    float4 o;
    o.x = v[it].x * rstd * w4.x; o.y = v[it].y * rstd * w4.y; o.z = v[it].z * rstd * w4.z; o.w = v[it].w * rstd * w4.w;
    *(float4*)(xr + c) = o;
  }
}

__device__ __forceinline__ void run_phase(const Params& P, int ph, char* lds) {
  const int bid = blockIdx.x, nb = gridDim.x;
#ifdef ONLY_PHASE
  if (ph != ONLY_PHASE) return;
#endif
  switch (ph) {
    case 0: {
      for (int it = bid; it < 984 + 192 + 2048; it += nb) {
        if (it < 296) convert_item(P.w_in, 1024, 4624, (u16*)(P.ws + OFF_WT_IN), 0, it, lds);
        else if (it < 328) convert_item(P.w_a_out, 512, 1024, (u16*)(P.ws + OFF_WT_AOUT), 1, it - 296, lds);
        else if (it < 360) convert_item(P.w_glu, 512, 1024, (u16*)(P.ws + OFF_WT_GLU), 2, it - 328, lds);
        else if (it < 392) convert_item(P.w_b_out, 512, 1024, (u16*)(P.ws + OFF_WT_BOUT), 3, it - 360, lds);
        else if (it < 456) convert_item(P.w_o, 1024, 1024, (u16*)(P.ws + OFF_WT_O), 4, it - 392, lds);
        else if (it < 808) convert_item(P.w_up, 1024, 5632, (u16*)(P.ws + OFF_WT_UP), 5, it - 456, lds);
        else if (it < 984) convert_item(P.w_down, 2816, 1024, (u16*)(P.ws + OFF_WT_DOWN), 6, it - 808, lds);
        else if (it < 1176) mod_item(P, it - 984, lds);
        else s5tab_item(P, it - 1176, lds);
      }
    } break;
    case 1:
      for (int it = bid; it < 2176 + 2048; it += nb) {
        if (it < 2176) norm1_item(P, it); else mintra_item(P, it - 2176);
      }
      break;
    case 2:
      for (int it = bid; it < 1396; it += nb) inproj_tile(P, it, lds);
      break;
    case 3:
      for (int it = bid; it < 1088 + 192; it += nb) {
        if (it < 1088) delta_prep_item(P, it, lds); else s5end_tile(P, it - 1088, lds);
      }
      break;
    case 4:
      if (bid < 32) delta_scan_block(P, bid, lds);
      else if (bid < 64) s5_carry_block(P, bid - 32);
      break;
    case 5:
      for (int it = bid; it < 256 + 2048 + 2048; it += nb) {
        if (it < 256) s5out_tile(P, it, lds);
        else if (it < 2304) delta_post_item(P, it - 256);
        else norm1_item(P, it - 2304);
      }
      break;
    case 6:
      for (int it = bid; it < 512 + 1024; it += nb) {
        if (it < 512) glu_tile(P, it, lds); else gates_tile(P, it - 512, lds);
      }
      break;
    case 7:
      for (int it = bid; it < 512; it += nb) mix_tile(P, it, lds);
      break;
    case 8:
      for (int it = bid; it < 512; it += nb) wo_tile(P, it, lds);
      break;
    case 9:
      for (int it = bid; it < 2048; it += nb) norm2_item(P, it);
      break;
    case 10:
      for (int it = bid; it < 1408; it += nb) up_tile(P, it, 0, lds);
      break;
    case 11:
      for (int it = bid; it < 1024; it += nb) convgate_item(P, it, 0);
      break;
    case 12:
      for (int it = bid; it < 1408; it += nb) up_tile(P, it, 1, lds);
      break;
    case 13:
      for (int it = bid; it < 1024; it += nb) convgate_item(P, it, 1);
      break;
    case 14:
      for (int it = bid; it < 512; it += nb) down_tile(P, it, lds);
      break;
    case 15:
      for (int it = bid; it < 2048; it += nb) final_item(P, it);
      break;
    default: break;
  }
}

__global__ void __launch_bounds__(NT) fwd_megakernel(Params P) {
  extern __shared__ __attribute__((aligned(16))) char lds[];
  const int lo = (int)P.ph_lo, hi = (int)P.ph_hi;
#if MULTI_LAUNCH
  for (int ph = lo; ph < hi; ++ph) run_phase(P, ph, lds);
#else
  cg::grid_group grid = cg::this_grid();
  for (int ph = lo; ph < hi; ++ph) {
    run_phase(P, ph, lds);
#ifdef REPEAT_MASK
    if ((REPEAT_MASK >> ph) & 1) { grid.sync(); run_phase(P, ph, lds); }
#endif
    if (ph + 1 < hi) grid.sync();
  }
#endif
}

extern "C" void kernel_launch(void* const* d_in, const int* in_sizes, int n_in, void* d_out, int out_size, void* d_ws,
                              size_t ws_size, hipStream_t stream) {
  static int grid_blocks = 0;
  if (grid_blocks == 0) {
    if (n_in != 30 || out_size != 16384 * 1024 || ws_size < WS_NEED) {
      fprintf(stderr, "kernel_launch: unexpected shapes: n_in %d out %d ws %zu (need %zu)\n", n_in, out_size, ws_size, (size_t)WS_NEED);
      grid_blocks = -1;
      return;
    }
    int dev = 0, cus = 0, per_cu = 0;
    hipGetDevice(&dev);
    hipDeviceGetAttribute(&cus, hipDeviceAttributeMultiprocessorCount, dev);
    if (hipFuncSetAttribute((const void*)fwd_megakernel, hipFuncAttributeMaxDynamicSharedMemorySize, LDS_BYTES) != hipSuccess) {
      fprintf(stderr, "kernel_launch: hipFuncSetAttribute failed\n");
      grid_blocks = -1;
      return;
    }
    if (hipOccupancyMaxActiveBlocksPerMultiprocessor(&per_cu, (const void*)fwd_megakernel, NT, LDS_BYTES) != hipSuccess || per_cu < 1) {
      fprintf(stderr, "kernel_launch: occupancy query failed / zero (%d)\n", per_cu);
      grid_blocks = -1;
      return;
    }
    grid_blocks = cus;
    if (grid_blocks < 64) { fprintf(stderr, "kernel_launch: too few CUs (%d)\n", cus); grid_blocks = -1; return; }
  }
  if (grid_blocks < 0) return;
  Params p{};
  const float** pp = (const float**)&p;
  for (int i = 0; i < 30; ++i) pp[i] = (const float*)d_in[i];
  p.out = (float*)d_out;
  p.ws = (char*)d_ws;
#if MULTI_LAUNCH
  for (int ph = 0; ph < 16; ++ph) {
    p.ph_lo = ph; p.ph_hi = ph + 1;
    hipLaunchKernelGGL(fwd_megakernel, dim3(grid_blocks), dim3(NT), LDS_BYTES, stream, p);
  }
#else
  p.ph_lo = 0; p.ph_hi = 16;
  void* args[] = {&p};
  hipError_t e = hipLaunchCooperativeKernel((const void*)fwd_megakernel, dim3(grid_blocks), dim3(NT), args, LDS_BYTES, stream);
  if (e != hipSuccess) fprintf(stderr, "cooperative launch failed: %s (grid %d)\n", hipGetErrorString(e), grid_blocks);
#endif
}
```

```cpp
#include <hip/hip_runtime.h>
#include <hip/hip_cooperative_groups.h>
#include <cstdio>
#include <cstdint>
namespace cg = cooperative_groups;

#ifndef MULTI_LAUNCH
#define MULTI_LAUNCH 0
#endif

typedef unsigned short u16;
typedef __attribute__((ext_vector_type(8))) short bf16x8;
typedef __attribute__((ext_vector_type(4))) float f32x4;

#define NT 512
constexpr int LDS_BYTES = 131072 + 1024;
constexpr int NPHASE = 18;

constexpr size_t OFF_WT_IN   = 0;
constexpr size_t OFF_WT_AOUT = 9699328;
constexpr size_t OFF_WT_GLU  = 10747904;
constexpr size_t OFF_WT_BOUT = 11796480;
constexpr size_t OFF_WT_O    = 12845056;
constexpr size_t OFF_WT_UP   = 14942208;
constexpr size_t OFF_WT_DOWN = 26476544;
constexpr size_t OFF_MOD     = 32243712;
constexpr size_t OFF_BAR     = 32505856;
constexpr size_t OFF_R2      = 33554432;
constexpr size_t OFF_R1      = 69206016;
constexpr size_t OFF_KTAB    = OFF_R1;
constexpr size_t OFF_MEND    = OFF_R1 + 2097152;
constexpr size_t OFF_MST     = OFF_R1 + 10485760;
constexpr size_t OFF_MINTRA  = OFF_R1 + 18874368;
constexpr size_t OFF_R3      = 104857600;
constexpr size_t OFF_O       = OFF_R3;
constexpr size_t OFF_XIN     = OFF_R3 + 33554432;
constexpr size_t OFF_MIX     = 158334976;
constexpr size_t OFF_SG      = OFF_R1;
constexpr size_t OFF_Z       = 158334976;
constexpr size_t OFF_U5      = 175112192;
constexpr size_t OFF_BA      = 192937984;
constexpr size_t OFF_GC      = OFF_BA + 1179648;
constexpr size_t OFF_UF      = 195035136;
constexpr size_t OFF_YA      = OFF_UF;
constexpr size_t OFF_YB      = OFF_UF + 16777216;
constexpr size_t OFF_E       = 230686720;
constexpr size_t OFF_YG      = OFF_E;
constexpr size_t OFF_UPH     = OFF_R1;
constexpr size_t OFF_G       = 161480704;
constexpr size_t WS_NEED     = 253755392;
constexpr size_t OFF_QKN     = 0;
constexpr size_t OFF_AQ      = 35651584;

struct Params {
  const float *x, *c, *ctx, *c_ctx, *w_ada, *b_ada, *norm1_w, *w_in, *dn_conv_w, *dn_a_log, *dn_dt_bias, *dn_norm_w,
      *w_a_out, *s5_a_re, *s5_a_im, *s5_log_step, *s5_b_re, *s5_b_im, *s5_c_re, *s5_c_im, *s5_d, *w_glu, *b_glu,
      *w_b_out, *w_o, *norm2_w, *w_up, *ffn_conv_w, *w_down, *norm_f_w;
  float* out;
  char* ws;
  long long ph_lo, ph_hi;
};

#define XB_TMO      128
#define XB_XCNT(j)  (256  + 64 * (j))
#define XB_XSUB(j)  (1280 + 64 * (j))
#define XB_XGEN(j)  (2304 + 64 * (j))
#define XB_TOP      3328
#define XB_TOPGEN   3392
#define XCD_BAR_WORDS 3456
#define XB_SPIN_CAP (1u << 18)
#define LAS __attribute__((address_space(3)))

__device__ __forceinline__ unsigned xb_ld(unsigned* p)              { return __hip_atomic_load(p, __ATOMIC_RELAXED, __HIP_MEMORY_SCOPE_AGENT); }
__device__ __forceinline__ unsigned xb_add(unsigned* p, unsigned v) { return __hip_atomic_fetch_add(p, v, __ATOMIC_RELAXED, __HIP_MEMORY_SCOPE_AGENT); }
__device__ __forceinline__ unsigned xb_xcc_id() { return (unsigned)__builtin_amdgcn_s_getreg((3 << 11) | 20) & 0xFu; }
#define XB_SPIN(cond, bar) do { unsigned _sp = 0; while (cond) { __builtin_amdgcn_s_sleep(1); \
    if ((++_sp & 255u) == 0u) { if (xb_ld(&(bar)[XB_TMO])) break; if (_sp > XB_SPIN_CAP) { atomicAdd(&(bar)[XB_TMO], 1u); break; } } } } while (0)

struct XcdBarrier {
    unsigned* bar; unsigned x;
    volatile LAS unsigned* st;
};

__device__ __forceinline__ XcdBarrier xcd_barrier_post(unsigned* bar, volatile LAS unsigned* st) {
    XcdBarrier b; b.bar = bar; b.x = xb_xcc_id(); b.st = st;
    if (threadIdx.x == 0) (void)xb_add(&bar[XB_XCNT(b.x)], 1u);
    return b;
}
__device__ __forceinline__ void xcd_barrier_complete(unsigned* bar, unsigned x, unsigned& nloc, unsigned& nx) {
    const unsigned G = gridDim.x * gridDim.y * gridDim.z;
    unsigned sum, cnt, mine, sp = 0u;
    for (;;) {
        sum = 0u; cnt = 0u; mine = 0u;
#pragma unroll
        for (unsigned j = 0; j < 16; ++j) { const unsigned c = xb_ld(&bar[XB_XCNT(j)]); sum += c; cnt += (c > 0u) ? 1u : 0u; mine = (j == x) ? c : mine; }
        if (sum == G) break;
        __builtin_amdgcn_s_sleep(1);
        if ((++sp & 255u) == 0u) { if (xb_ld(&bar[XB_TMO])) break; if (sp > XB_SPIN_CAP) { atomicAdd(&bar[XB_TMO], 1u); break; } }
    }
    nloc = mine > 0u ? mine : 1u; nx = cnt > 0u ? cnt : 1u;
}

__device__ __forceinline__ void xcd_barrier(const XcdBarrier& b) {
    asm volatile("s_waitcnt vmcnt(0)" ::: "memory");
    __syncthreads();
    if (threadIdx.x == 0) {
        unsigned* bar = b.bar;
        __builtin_amdgcn_s_waitcnt(0);
        unsigned nloc = b.st[0], nx = b.st[1];
        if (nloc == 0u) { xcd_barrier_complete(bar, b.x, nloc, nx); b.st[0] = nloc; b.st[1] = nx; }
        const unsigned old = xb_add(&bar[XB_XSUB(b.x)], 1u);
        const unsigned gen = old / nloc;
        if (old + 1u == (gen + 1u) * nloc) {
            __builtin_amdgcn_fence(__ATOMIC_RELEASE, "agent");
            asm volatile("s_waitcnt vmcnt(0)" ::: "memory");
            const unsigned og = xb_add(&bar[XB_TOP], 1u);
            const unsigned tg = og / nx;
            if (og + 1u == (tg + 1u) * nx) xb_add(&bar[XB_TOPGEN], 1u);
            else XB_SPIN(xb_ld(&bar[XB_TOPGEN]) == tg, bar);
            __builtin_amdgcn_fence(__ATOMIC_ACQUIRE, "agent");
            xb_add(&bar[XB_XGEN(b.x)], 1u);
            asm volatile("s_waitcnt vmcnt(0)" ::: "memory");
        } else {
            XB_SPIN(xb_ld(&bar[XB_XGEN(b.x)]) == gen, bar);
            __builtin_amdgcn_fence(__ATOMIC_ACQUIRE, "agent");
            asm volatile("s_waitcnt vmcnt(0)" ::: "memory");
        }
    }
    __syncthreads();
}


__device__ __forceinline__ u16 f2bf(float f) {
  uint32_t u = __float_as_uint(f);
  u += 0x7fffu + ((u >> 16) & 1u);
  return (u16)(u >> 16);
}
__device__ __forceinline__ float bf2f(u16 h) { return __uint_as_float(((uint32_t)h) << 16); }
__device__ __forceinline__ uint32_t pack2(float a, float b) { return (uint32_t)f2bf(a) | ((uint32_t)f2bf(b) << 16); }
__device__ __forceinline__ float lo16(uint32_t w) { return __uint_as_float(w << 16); }
__device__ __forceinline__ float hi16(uint32_t w) { return __uint_as_float(w & 0xffff0000u); }
__device__ __forceinline__ int opq(int v) { asm volatile("" : "+v"(v)); return v; }
__device__ __forceinline__ float sigm(float x) { return 1.f / (1.f + __expf(-x)); }
__device__ __forceinline__ void unpack8(uint4 v, float* f) {
  f[0] = lo16(v.x); f[1] = hi16(v.x); f[2] = lo16(v.y); f[3] = hi16(v.y);
  f[4] = lo16(v.z); f[5] = hi16(v.z); f[6] = lo16(v.w); f[7] = hi16(v.w);
}
__device__ __forceinline__ uint4 pack8(const float* f) {
  uint4 v; v.x = pack2(f[0], f[1]); v.y = pack2(f[2], f[3]); v.z = pack2(f[4], f[5]); v.w = pack2(f[6], f[7]);
  return v;
}
__device__ __forceinline__ float wsum64(float v) {
#pragma unroll
  for (int o = 32; o > 0; o >>= 1) v += __shfl_xor(v, o, 64);
  return v;
}
__device__ __forceinline__ float gelu_tanh(float x) {
  float u = 0.7978845608028654f * (x + 0.044715f * x * x * x);
  float t = 1.f - 2.f / (1.f + __expf(2.f * u));
  return 0.5f * x * (1.f + t);
}

__device__ __forceinline__ void g_compute(const u16* As, const u16* Bs, int buf, int wm, int wn, int fr, int fq, f32x4 (&acc)[4][4]) {
  const u16* as = As + (buf * 256 + wm * 64 + fr) * 72 + fq * 8;
  const u16* bs = Bs + (buf * 128 + wn * 64 + fr) * 72 + fq * 8;
#pragma unroll
  for (int ks = 0; ks < 2; ++ks) {
    bf16x8 a[4], b[4];
#pragma unroll
    for (int i = 0; i < 4; ++i) a[i] = *(const bf16x8*)(as + i * 16 * 72 + ks * 32);
#pragma unroll
    for (int j = 0; j < 4; ++j) b[j] = *(const bf16x8*)(bs + j * 16 * 72 + ks * 32);
#pragma unroll
    for (int i = 0; i < 4; ++i)
#pragma unroll
      for (int j = 0; j < 4; ++j) acc[i][j] = __builtin_amdgcn_mfma_f32_16x16x32_bf16(a[i], b[j], acc[i][j], 0, 0, 0);
  }
}
__device__ __forceinline__ void gemm_main(const u16* __restrict__ A, int lda, const u16* __restrict__ Bt, int ldb, int K,
                                          f32x4 (&acc)[4][4], u16* lds) {
  const int tid = opq(threadIdx.x), lane = tid & 63, w = tid >> 6, wm = w >> 1, wn = w & 1, fr = lane & 15, fq = lane >> 4;
  u16* As = lds;
  u16* Bs = lds + 2 * 256 * 72;
  const int nk = K >> 6;
  uint4 p0, p1, p2, p3, p4, p5;
  uint4 q0, q1, q2, q3, q4, q5;
  const int lr = tid >> 3, lc = (tid & 7) * 8;
  const u16* ap = A + (size_t)lr * lda + lc;
  const u16* bp = Bt + (size_t)lr * ldb + lc;
  const size_t sa = (size_t)64 * lda, sb = (size_t)64 * ldb;
#define G_LOAD(S, kt_)                                          \
  {                                                             \
    const u16* a_ = ap + (kt_) * 64;                            \
    const u16* b_ = bp + (kt_) * 64;                            \
    S##0 = *(const uint4*)(a_);                                 \
    S##1 = *(const uint4*)(a_ + sa);                            \
    S##2 = *(const uint4*)(a_ + 2 * sa);                        \
    S##3 = *(const uint4*)(a_ + 3 * sa);                        \
    S##4 = *(const uint4*)(b_);                                 \
    S##5 = *(const uint4*)(b_ + sb);                            \
  }
#define G_STORE(S, buf_)                                                     \
  {                                                                          \
    u16* as_ = As + ((buf_) * 256 + lr) * 72 + lc;                           \
    u16* bs_ = Bs + ((buf_) * 128 + lr) * 72 + lc;                           \
    *(uint4*)(as_) = S##0;                                                   \
    *(uint4*)(as_ + 64 * 72) = S##1;                                         \
    *(uint4*)(as_ + 128 * 72) = S##2;                                        \
    *(uint4*)(as_ + 192 * 72) = S##3;                                        \
    *(uint4*)(bs_) = S##4;                                                   \
    *(uint4*)(bs_ + 64 * 72) = S##5;                                         \
  }
  G_LOAD(p, 0)
  __syncthreads();
  G_STORE(p, 0)
  G_LOAD(q, 1)
  G_LOAD(p, (nk > 2 ? 2 : 1))
  __syncthreads();
  for (int kt = 0; kt < nk; kt += 2) {
    G_STORE(q, 1)
    G_LOAD(q, (kt + 3 < nk ? kt + 3 : nk - 1))
    __builtin_amdgcn_sched_barrier(0);
    g_compute(As, Bs, 0, wm, wn, fr, fq, acc);
    __syncthreads();
    G_STORE(p, 0)
    G_LOAD(p, (kt + 4 < nk ? kt + 4 : nk - 1))
    __builtin_amdgcn_sched_barrier(0);
    g_compute(As, Bs, 1, wm, wn, fr, fq, acc);
    __syncthreads();
  }
#undef G_LOAD
#undef G_STORE
}

__device__ __forceinline__ void acc_zero(f32x4 (&acc)[4][4]) {
#pragma unroll
  for (int i = 0; i < 4; ++i)
#pragma unroll
    for (int j = 0; j < 4; ++j) acc[i][j] = f32x4{0.f, 0.f, 0.f, 0.f};
}

#define TILE_COORDS                                                                                  \
  const int tid_ = opq(threadIdx.x), lane_ = tid_ & 63, w_ = tid_ >> 6, wm_ = w_ >> 1, wn_ = w_ & 1,     \
            fr_ = lane_ & 15, fq_ = lane_ >> 4;
#define TROW(m0, i, e) ((m0) + wm_ * 64 + (i) * 16 + fq_ * 4 + (e))
#define TCOL(n0, j) ((n0) + wn_ * 64 + (j) * 16 + fr_)

__device__ __forceinline__ int srccol(int which, int r) {
  switch (which) {
    case 0:
      if (r < 2048) return r;
      if (r < 2560) return 2064 + (r - 2048);
      if (r < 2576) return 2048 + (r - 2560);
      if (r < 2688) return -1;
      if (r < 3712) return 2576 + (r - 2688);
      return 3600 + (r - 3712);
    case 2: {
      int tile = r >> 7, wn = (r >> 6) & 1, wi = r & 63;
      return (wi < 32) ? (tile * 64 + wn * 32 + wi) : (512 + tile * 64 + wn * 32 + (wi - 32));
    }
    case 5: {
      int hh = r / 2816, cc = r % 2816;
      return (cc < 1408) ? (hh * 1408 + cc) : (2816 + hh * 1408 + (cc - 1408));
    }
    default: return r;
  }
}

__device__ __forceinline__ void convert_item(const float* __restrict__ src, int K, int N, u16* __restrict__ dst, int which, int item, char* lds) {
  float* tile = (float*)lds;
  const int tid = opq(threadIdx.x);
  const int kb = K >> 8;
  const int r0 = (item / kb) * 64, k0 = (item % kb) * 256;
  __syncthreads();
  {
    const int n4 = (tid & 15) * 4, kk = tid >> 4;
    const int sc = srccol(which, r0 + n4);
    float4 v[8];
#pragma unroll
    for (int it = 0; it < 8; ++it) {
      const int k = kk + 32 * it;
      v[it] = (sc >= 0) ? *(const float4*)(src + (size_t)(k0 + k) * N + sc) : make_float4(0.f, 0.f, 0.f, 0.f);
    }
#pragma unroll
    for (int it = 0; it < 8; ++it) {
      const int k = kk + 32 * it;
      tile[(n4 + 0) * 257 + k] = v[it].x; tile[(n4 + 1) * 257 + k] = v[it].y;
      tile[(n4 + 2) * 257 + k] = v[it].z; tile[(n4 + 3) * 257 + k] = v[it].w;
    }
  }
  __syncthreads();
  {
    const int ks = (tid & 31) * 8, rr = tid >> 5;
#pragma unroll
    for (int it = 0; it < 4; ++it) {
      const int row = rr + 16 * it;
      float f[8];
#pragma unroll
      for (int e = 0; e < 8; ++e) f[e] = tile[row * 257 + ks + e];
      *(uint4*)(dst + (size_t)(r0 + row) * K + k0 + ks) = pack8(f);
    }
  }
}

__device__ __forceinline__ void mod_item(const Params& P, int item, char* lds) {
  float* sc = (float*)lds;
  float* red = sc + 5 * 1024;
  const int tid = opq(threadIdx.x);
  __syncthreads();
  for (int i = tid; i < 5 * 1024; i += NT) {
    const int r = i >> 10, k = i & 1023;
    float v = (r < 4) ? P.c[r * 1024 + k] : P.c_ctx[k];
    sc[i] = v * sigm(v);
  }
  __syncthreads();
  const int nn = tid & 31, kg = tid >> 5;
  const int n = item * 32 + nn;
  float a0 = 0, a1 = 0, a2 = 0, a3 = 0, a4 = 0;
  for (int kk = 0; kk < 64; ++kk) {
    const int k = kg * 64 + kk;
    const float wv = P.w_ada[(size_t)k * 6144 + n];
    a0 += sc[k] * wv; a1 += sc[1024 + k] * wv; a2 += sc[2048 + k] * wv; a3 += sc[3072 + k] * wv; a4 += sc[4096 + k] * wv;
  }
  red[(kg * 5 + 0) * 32 + nn] = a0; red[(kg * 5 + 1) * 32 + nn] = a1; red[(kg * 5 + 2) * 32 + nn] = a2;
  red[(kg * 5 + 3) * 32 + nn] = a3; red[(kg * 5 + 4) * 32 + nn] = a4;
  __syncthreads();
  if (tid < 160) {
    const int r = tid >> 5, n2 = tid & 31;
    float s = 0.f;
#pragma unroll
    for (int g = 0; g < 16; ++g) s += red[(g * 5 + r) * 32 + n2];
    float* MOD = (float*)(P.ws + OFF_MOD);
    MOD[r * 6144 + item * 32 + n2] = s + P.b_ada[item * 32 + n2];
  }
}

__device__ __forceinline__ void lam_pow(float step, float are, float aim, int e, float& pr, float& pi) {
  const float mag = expf((float)e * step * are);
  double ang = (double)e * (double)step * (double)aim;
  ang -= 6.283185307179586476925 * rint(ang * 0.15915494309189533577);
  float s, c;
  __sincosf((float)ang, &s, &c);
  pr = mag * c; pi = mag * s;
}

__device__ __forceinline__ void s5tab_item(const Params& P, int item, char* lds) {
  const int tid = opq(threadIdx.x);
  const int tau = item & 31, g = (item >> 5) & 31, r = item >> 10;
  float* cfr = (float*)lds;
  float* cfi = cfr + 64;
  float* p0r = cfi + 64;
  float* p0i = p0r + 64;
  float* p1r = p0i + 64;
  float* p1i = p1r + 64;
  float* Gr = p1i + 64;
  float* Gi = Gr + 1024;
  float* Cr = Gi + 1024;
  float* Ci = Cr + 1024;
  const int rg = r * 32 + g;
  __syncthreads();
  if (tid < 64) {
    const int n = tid;
    const float step = expf(P.s5_log_step[rg]);
    const float are = P.s5_a_re[rg * 64 + n], aim = P.s5_a_im[rg * 64 + n];
    const float za = step * are;
    double zb = (double)step * (double)aim;
    zb -= 6.283185307179586476925 * rint(zb * 0.15915494309189533577);
    float sb, cb, sh, ch;
    __sincosf((float)zb, &sb, &cb);
    __sincosf((float)(0.5 * zb), &sh, &ch);
    const float em1 = expm1f(za);
    const float re1 = em1 * cb - 2.f * sh * sh;
    const float im1 = (1.f + em1) * sb;
    const float den = are * are + aim * aim;
    cfr[n] = (re1 * are + im1 * aim) / den;
    cfi[n] = (im1 * are - re1 * aim) / den;
    float pr, pi;
    lam_pow(step, are, aim, tau, pr, pi);
    p0r[n] = pr; p0i[n] = pi;
    lam_pow(step, are, aim, tau + 1, pr, pi);
    p1r[n] = pr; p1i[n] = pi;
  }
  for (int i = tid; i < 1024; i += NT) {
    Cr[i] = P.s5_c_re[(size_t)rg * 1024 + i];
    Ci[i] = P.s5_c_im[(size_t)rg * 1024 + i];
  }
  __syncthreads();
  for (int i = tid; i < 1024; i += NT) {
    const int n = i >> 4;
    const float br = P.s5_b_re[(size_t)rg * 1024 + i], bi = P.s5_b_im[(size_t)rg * 1024 + i];
    const float tr = cfr[n] * br - cfi[n] * bi, ti = cfr[n] * bi + cfi[n] * br;
    Gr[i] = p0r[n] * tr - p0i[n] * ti;
    Gi[i] = p0r[n] * ti + p0i[n] * tr;
  }
  __syncthreads();
  u16* MEND = (u16*)(P.ws + OFF_MEND);
  u16* MST = (u16*)(P.ws + OFF_MST);
  float* KTAB = (float*)(P.ws + OFF_KTAB);
  {
    const int ii = (r == 0) ? (31 - tau) : tau;
    for (int i = tid; i < 2048; i += NT) {
      const int part = i >> 10, n = (i >> 4) & 63, pi_ = i & 15;
      const float v = part ? Gi[n * 16 + pi_] : Gr[n * 16 + pi_];
      MEND[((size_t)g * 256 + r * 128 + part * 64 + n) * 512 + ii * 16 + pi_] = f2bf(v);
    }
  }
  if (tid < 256) {
    const int po = tid >> 4, pi_ = tid & 15;
    float s = 0.f;
    for (int n = 0; n < 64; ++n) s += Cr[po * 64 + n] * Gr[n * 16 + pi_] - Ci[po * 64 + n] * Gi[n * 16 + pi_];
    KTAB[(((size_t)rg) * 32 + tau) * 256 + tid] = s;
  }
  {
    const int jj = (r == 0) ? tau : (31 - tau);
    for (int i = tid; i < 2048; i += NT) {
      const int po = i >> 7, part = (i >> 6) & 1, n = i & 63;
      const float cr = Cr[po * 64 + n], ci = Ci[po * 64 + n];
      const float v = part ? -(cr * p1i[n] + ci * p1r[n]) : (cr * p1r[n] - ci * p1i[n]);
      MST[((size_t)g * 512 + jj * 16 + po) * 256 + r * 128 + part * 64 + n] = f2bf(v);
    }
  }
}

__device__ __forceinline__ void norm_row(const float* __restrict__ xr, const float* __restrict__ nw, const float* __restrict__ shift,
                                         const float* __restrict__ scale, u16* __restrict__ dst, int lane) {
  float4 v[4];
  float ss = 0.f;
#pragma unroll
  for (int it = 0; it < 4; ++it) {
    v[it] = *(const float4*)(xr + (it * 64 + lane) * 4);
    ss += v[it].x * v[it].x + v[it].y * v[it].y + v[it].z * v[it].z + v[it].w * v[it].w;
  }
  ss = wsum64(ss);
  const float rstd = rsqrtf(ss * (1.f / 1024.f) + 1e-6f);
#pragma unroll
  for (int it = 0; it < 4; ++it) {
    const int c = (it * 64 + lane) * 4;
    const float4 w4 = *(const float4*)(nw + c), sh = *(const float4*)(shift + c), sc = *(const float4*)(scale + c);
    const float y0 = v[it].x * rstd * w4.x * (1.f + sc.x) + sh.x;
    const float y1 = v[it].y * rstd * w4.y * (1.f + sc.y) + sh.y;
    const float y2 = v[it].z * rstd * w4.z * (1.f + sc.z) + sh.z;
    const float y3 = v[it].w * rstd * w4.w * (1.f + sc.w) + sh.w;
    uint2 o; o.x = pack2(y0, y1); o.y = pack2(y2, y3);
    *(uint2*)(dst + c) = o;
  }
}

__device__ __forceinline__ void norm1_item(const Params& P, int item) {
  const int lane = opq(threadIdx.x) & 63, w = opq(threadIdx.x) >> 6;
  const int row = item * 8 + w;
  const float* MOD = (const float*)(P.ws + OFF_MOD);
  const int bi = (row < 16384) ? (row >> 12) : 4;
  const float* xr = (row < 16384) ? (P.x + (size_t)row * 1024) : (P.ctx + (size_t)(row - 16384) * 1024);
  norm_row(xr, P.norm1_w, MOD + bi * 6144, MOD + bi * 6144 + 1024, (u16*)(P.ws + OFF_R2) + (size_t)row * 1024, lane);
}

__device__ __forceinline__ void mintra_item(const Params& P, int item) {
  const int tid = opq(threadIdx.x);
  const int rowg = item * 8 + (tid >> 6);
  const int g = rowg >> 9, nout = rowg & 511, j = nout >> 4, po = nout & 15;
  const int k0 = (tid & 63) * 8, i = k0 >> 4, pi0 = k0 & 15;
  const float* KTAB = (const float*)(P.ws + OFF_KTAB);
  float f[8];
#pragma unroll
  for (int e = 0; e < 8; ++e) f[e] = 0.f;
  if (i <= j) {
    const float* kp = KTAB + (((size_t)(0 * 32 + g)) * 32 + (j - i)) * 256 + po * 16 + pi0;
#pragma unroll
    for (int e = 0; e < 8; ++e) f[e] += kp[e];
  }
  if (i >= j) {
    const float* kp = KTAB + (((size_t)(1 * 32 + g)) * 32 + (i - j)) * 256 + po * 16 + pi0;
#pragma unroll
    for (int e = 0; e < 8; ++e) f[e] += kp[e];
  }
  if (i == j) {
    const float dv = P.s5_d[g * 16 + po];
#pragma unroll
    for (int e = 0; e < 8; ++e) if (pi0 + e == po) f[e] += dv;
  }
  u16* MI = (u16*)(P.ws + OFF_MINTRA);
  *(uint4*)(MI + (size_t)rowg * 512 + k0) = pack8(f);
}

__device__ __forceinline__ void inproj_tile(const Params& P, int t, char* lds) {
  int mt, nt;
  if (t < 1344) { nt = t / 64; mt = t % 64; }
  else {
    const int tt = t - 1344; mt = 64 + (tt & 3);
    const int ni = tt >> 2;
    nt = (ni < 8) ? (4 + ni) : ((ni < 12) ? (16 + ni - 8) : 20);
  }
  const int m0 = mt * 256, n0 = nt * 128;
  f32x4 acc[4][4];
  acc_zero(acc);
  gemm_main((const u16*)(P.ws + OFF_R2) + (size_t)m0 * 1024, 1024, (const u16*)(P.ws + OFF_WT_IN) + (size_t)n0 * 1024, 1024, 1024, acc, (u16*)lds);
  TILE_COORDS
  if (nt < 12) {
    u16* QKV = (u16*)(P.ws + OFF_R3);
#pragma unroll
    for (int i = 0; i < 4; ++i)
#pragma unroll
      for (int j = 0; j < 4; ++j)
#pragma unroll
        for (int e = 0; e < 4; ++e) QKV[(size_t)TROW(m0, i, e) * 1536 + TCOL(n0, j)] = f2bf(acc[i][j][e]);
  } else if (nt < 16) {
    u16* Z = (u16*)(P.ws + OFF_Z);
#pragma unroll
    for (int i = 0; i < 4; ++i)
#pragma unroll
      for (int j = 0; j < 4; ++j)
#pragma unroll
        for (int e = 0; e < 4; ++e) Z[(size_t)TROW(m0, i, e) * 512 + TCOL(n0, j) - 1536] = f2bf(acc[i][j][e]);
  } else if (nt < 20) {
    u16* U5 = (u16*)(P.ws + OFF_U5);
#pragma unroll
    for (int i = 0; i < 4; ++i)
#pragma unroll
      for (int j = 0; j < 4; ++j)
#pragma unroll
        for (int e = 0; e < 4; ++e) {
          const int cc = TCOL(n0, j) - 2048;
          U5[((size_t)(cc >> 4) * 17408 + TROW(m0, i, e)) * 16 + (cc & 15)] = f2bf(acc[i][j][e]);
        }
  } else {
    float* BA = (float*)(P.ws + OFF_BA);
#pragma unroll
    for (int i = 0; i < 4; ++i)
#pragma unroll
      for (int j = 0; j < 4; ++j)
#pragma unroll
        for (int e = 0; e < 4; ++e) {
          const int cc = TCOL(n0, j) - 2560;
          if (cc < 16) BA[(size_t)TROW(m0, i, e) * 16 + cc] = acc[i][j][e];
        }
  }
}

template <int DIR>
__device__ __forceinline__ void solve_cols(const Params& P, int itb, int c, const float* Lt, const float* bpp, const float* gcp,
                                           const u16* Vs, const u16* Ks) {
  float sol[64];
  const float* bp_ = bpp + DIR * 64;
  const float* gc_ = gcp + DIR * 64;
  if (c < 128) {
    const u16* vp = Vs + c;
#pragma unroll
    for (int p = 0; p < 64; ++p) sol[p] = bp_[p] * bf2f(vp[(DIR ? (63 - p) : p) * 136]);
  } else {
    const u16* kp = Ks + (c - 128);
#pragma unroll
    for (int p = 0; p < 64; ++p) sol[p] = bp_[p] * __expf(gc_[p]) * bf2f(kp[(DIR ? (63 - p) : p) * 136]);
  }
  const float* Lr = Lt + opq(DIR * 4096);
#ifndef NO_SOLVE
#pragma unroll
  for (int j = 0; j < 63; ++j) {
    const float sj = sol[j];
#pragma unroll
    for (int i = j + 1; i < 64; ++i) sol[i] -= Lr[j * 64 + i] * sj;
  }
#endif
  const size_t it2 = (size_t)(itb + DIR);
  if (c < 128) {
    u16* UF = (u16*)(P.ws + OFF_UF) + (it2 * 128 + c) * 64;
#pragma unroll
    for (int q = 0; q < 8; ++q) *(uint4*)(UF + q * 8) = pack8(sol + q * 8);
  } else {
    u16* Wg = (u16*)(P.ws + OFF_R2) + it2 * 8192 + (c - 128);
#pragma unroll
    for (int p = 0; p < 64; ++p) Wg[p * 128] = f2bf(-sol[p]);
  }
}

__device__ __forceinline__ void delta_prep_item(const Params& P, int item, char* lds) {
  const int tid = opq(threadIdx.x), lane = tid & 63, wv = tid >> 6, fr = lane & 15, fq = lane >> 4;
  const int cid = item >> 2, h = item & 3;
  const int row0 = cid * 64;
  int seq_lo, seq_hi;
  if (cid < 256) { seq_lo = (cid >> 6) * 4096; seq_hi = seq_lo + 4096; }
  else { seq_lo = 16384 + ((cid - 256) >> 2) * 256; seq_hi = seq_lo + 256; }
  u16* Qs = (u16*)(lds + opq(0));
  u16* Ks = (u16*)(lds + opq(17408));
  u16* Vs = (u16*)(lds + opq(34816));
  float* KKs = (float*)(lds + opq(52224));
  float* QKs = (float*)(lds + opq(69632));
  float* Lt = (float*)(lds + opq(87040));
  float* gtok = (float*)(lds + opq(119808));
  float* btok = gtok + 128;
  float* gcp = btok + 128;
  float* bpp = gcp + 128;
  u16* QKN = (u16*)((char*)P.out + OFF_QKN);
  __syncthreads();
  {
    const int j = tid >> 3, sg = tid & 7;
    const int row = row0 + j;
    const bool hm = (row - 1 >= seq_lo), hp = (row + 1 < seq_hi);
    const u16* qkv = (const u16*)(P.ws + OFF_R3);
#pragma unroll
    for (int s = 0; s < 3; ++s) {
      const int col = s * 512 + h * 128 + sg * 16;
      const u16* p0 = qkv + (size_t)row * 1536 + col;
      float y[16];
      float ssq = 0.f;
#pragma unroll
      for (int hh = 0; hh < 2; ++hh) {
        const uint4 c0 = *(const uint4*)(p0 + hh * 8);
        uint4 m0 = *(const uint4*)(p0 - (hm ? 1536 : 0) + hh * 8);
        uint4 n0 = *(const uint4*)(p0 + (hp ? 1536 : 0) + hh * 8);
        m0.x = hm ? m0.x : 0u; m0.y = hm ? m0.y : 0u; m0.z = hm ? m0.z : 0u; m0.w = hm ? m0.w : 0u;
        n0.x = hp ? n0.x : 0u; n0.y = hp ? n0.y : 0u; n0.z = hp ? n0.z : 0u; n0.w = hp ? n0.w : 0u;
        float fc[8], fm[8], fn[8];
        unpack8(c0, fc); unpack8(m0, fm); unpack8(n0, fn);
        const float* cwp = P.dn_conv_w + col + hh * 8;
        float cw0[8], cw1[8], cw2[8];
        {
          const float4 t0 = *(const float4*)(cwp), t1 = *(const float4*)(cwp + 4);
          const float4 t2 = *(const float4*)(cwp + 1536), t3 = *(const float4*)(cwp + 1540);
          const float4 t4 = *(const float4*)(cwp + 3072), t5 = *(const float4*)(cwp + 3076);
          cw0[0] = t0.x; cw0[1] = t0.y; cw0[2] = t0.z; cw0[3] = t0.w; cw0[4] = t1.x; cw0[5] = t1.y; cw0[6] = t1.z; cw0[7] = t1.w;
          cw1[0] = t2.x; cw1[1] = t2.y; cw1[2] = t2.z; cw1[3] = t2.w; cw1[4] = t3.x; cw1[5] = t3.y; cw1[6] = t3.z; cw1[7] = t3.w;
          cw2[0] = t4.x; cw2[1] = t4.y; cw2[2] = t4.z; cw2[3] = t4.w; cw2[4] = t5.x; cw2[5] = t5.y; cw2[6] = t5.z; cw2[7] = t5.w;
        }
#pragma unroll
        for (int e = 0; e < 8; ++e) {
          const float v = cw0[e] * fm[e] + cw1[e] * fc[e] + cw2[e] * fn[e];
          const float yy = v * sigm(v);
          y[hh * 8 + e] = yy;
          ssq += yy * yy;
        }
      }
      if (s < 2) {
        ssq += __shfl_xor(ssq, 1, 64); ssq += __shfl_xor(ssq, 2, 64); ssq += __shfl_xor(ssq, 4, 64);
        const float sc = rsqrtf(ssq + 1e-6f) * ((s == 0) ? 0.08838834764831845f : 1.f);
#pragma unroll
        for (int e = 0; e < 16; ++e) y[e] *= sc;
      }
      u16* dl = ((s == 0) ? Qs : ((s == 1) ? Ks : Vs)) + j * 136 + sg * 16;
      const uint4 o0 = pack8(y), o1 = pack8(y + 8);
      *(uint4*)dl = o0; *(uint4*)(dl + 8) = o1;
      if (s < 2) {
        u16* dg = QKN + (size_t)row * 1024 + s * 512 + h * 128 + sg * 16;
        *(uint4*)dg = o0; *(uint4*)(dg + 8) = o1;
      }
    }
  }
  if (tid < 128) {
    const int j = tid & 63, dir = tid >> 6;
    const float* BA = (const float*)(P.ws + OFF_BA) + (size_t)(row0 + j) * 16;
    const float bl = BA[dir * 4 + h], al = BA[8 + dir * 4 + h];
    const float xx = al + P.dn_dt_bias[dir * 4 + h];
    const float sp = (xx > 20.f) ? xx : log1pf(expf(xx));
    gtok[dir * 64 + j] = -expf(P.dn_a_log[dir * 4 + h]) * sp;
    btok[dir * 64 + j] = 1.f / (1.f + expf(-bl));
  }
  __syncthreads();
  if (tid < 2) {
    const int dir = tid;
    float a = 0.f;
    for (int p = 0; p < 64; ++p) {
      const int tk = dir ? (63 - p) : p;
      a += gtok[dir * 64 + tk];
      gcp[dir * 64 + p] = a;
      bpp[dir * 64 + p] = btok[dir * 64 + tk];
    }
  }
  {
#pragma unroll
    for (int q = 0; q < 4; ++q) {
      const int t = wv * 4 + q;
      const int which = t >> 4, mi = (t >> 2) & 3, ni = t & 3;
      const u16* Am = (which ? Qs : Ks) + (mi * 16 + fr) * 136 + fq * 8;
      const u16* Bm = Ks + (ni * 16 + fr) * 136 + fq * 8;
      f32x4 a4 = {0.f, 0.f, 0.f, 0.f};
#pragma unroll
      for (int kk = 0; kk < 4; ++kk)
        a4 = __builtin_amdgcn_mfma_f32_16x16x32_bf16(*(const bf16x8*)(Am + kk * 32), *(const bf16x8*)(Bm + kk * 32), a4, 0, 0, 0);
      float* dst = which ? QKs : KKs;
#pragma unroll
      for (int e = 0; e < 4; ++e) dst[(mi * 16 + fq * 4 + e) * 68 + ni * 16 + fr] = a4[e];
    }
  }
  __syncthreads();
  const int itb = item * 2;
  {
    u16* AQ = (u16*)((char*)P.out + OFF_AQ);
    for (int idx = tid; idx < 8192; idx += NT) {
      const int dir = idx >> 12, p = (idx >> 6) & 63, s = idx & 63;
      const int tp = dir ? (63 - p) : p, ts = dir ? (63 - s) : s;
      const float dg = gcp[dir * 64 + p] - gcp[dir * 64 + s];
      const float dec = (p >= s) ? __expf(dg) : 0.f;
      AQ[((size_t)(itb + dir) * 64 + p) * 64 + s] = f2bf(QKs[tp * 68 + ts] * dec);
    }
    for (int idx = tid; idx < 8192; idx += NT) {
      const int dir = idx >> 12, s = (idx >> 6) & 63, p = idx & 63;
      const int tp = dir ? (63 - p) : p, ts = dir ? (63 - s) : s;
      const float dg = gcp[dir * 64 + p] - gcp[dir * 64 + s];
      const float lv = (p > s) ? bpp[dir * 64 + p] * KKs[ts * 68 + tp] * __expf(dg) : 0.f;
      Lt[dir * 4096 + s * 64 + p] = lv;
    }
    if (tid < 128) {
      float* GC = (float*)(P.ws + OFF_GC);
      GC[(size_t)(itb + (tid >> 6)) * 64 + (tid & 63)] = gcp[tid];
    }
  }
  __syncthreads();
  if (tid < 256) solve_cols<0>(P, itb, tid, Lt, bpp, gcp, Vs, Ks);
  else solve_cols<1>(P, itb, tid - 256, Lt, bpp, gcp, Vs, Ks);
}

__device__ __forceinline__ void s5end_tile(const Params& P, int t, char* lds) {
  const int g = t / 6, mt = (t % 6) >> 1, nt = t & 1;
  const int m0 = mt * 256, n0 = nt * 128;
  f32x4 acc[4][4];
  acc_zero(acc);
  gemm_main((const u16*)(P.ws + OFF_U5) + ((size_t)g * 544 + m0) * 512, 512,
            (const u16*)(P.ws + OFF_MEND) + ((size_t)g * 256 + n0) * 512, 512, 512, acc, (u16*)lds);
  TILE_COORDS
  float* E = (float*)(P.ws + OFF_E);
#pragma unroll
  for (int i = 0; i < 4; ++i)
#pragma unroll
    for (int j = 0; j < 4; ++j)
#pragma unroll
      for (int e = 0; e < 4; ++e) {
        const int row = TROW(m0, i, e);
        if (row < 544) E[((size_t)g * 544 + row) * 256 + TCOL(n0, j)] = acc[i][j][e];
      }
}

__device__ __forceinline__ void delta_scan_block(const Params& P, int sb, char* lds) {
  const int tid = opq(threadIdx.x), lane = tid & 63, w = tid >> 6, fr = lane & 15, fq = lane >> 4;
  const int b = sb >> 3, h = (sb >> 1) & 3, dir = sb & 1;
  u16* Wl = (u16*)(lds + opq(0));
  u16* QTl = (u16*)(lds + opq(17408));
  u16* KTl = (u16*)(lds + opq(34816));
  u16* AQl = (u16*)(lds + opq(53248));
  u16* ST = (u16*)(lds + opq(62464));
  u16* VT = (u16*)(lds + opq(97280));
  __syncthreads();
  for (int i = tid; i < 128 * 136 / 2; i += NT) ((uint32_t*)ST)[i] = 0u;
  f32x4 accS[8];
#pragma unroll
  for (int d = 0; d < 8; ++d) accS[d] = f32x4{0.f, 0.f, 0.f, 0.f};
  const int nw = w * 16;
  const u16* QKN = (const u16*)((const char*)P.out + OFF_QKN);
  const u16* AQg = (const u16*)((const char*)P.out + OFF_AQ);
  const u16* Wg = (const u16*)(P.ws + OFF_R2);
  const u16* UFg = (const u16*)(P.ws + OFF_UF);
  const float* GC = (const float*)(P.ws + OFF_GC);
  u16* Og = (u16*)(P.ws + OFF_O);

  uint4 rw0, rw1, rq0, rq1, rk0, rk1, ra;
  float gq0, gq1, gk, g63;
  uint2 ru0, ru1, ru2, ru3;
  int cur_row0 = 0, cur_lat = 0;
  int nxt_row0 = 0, nxt_lat = 0;
  int prv_row0 = 0, prv_lat = 0;
  uint32_t osv[4][2];
#pragma unroll
  for (int mt = 0; mt < 4; ++mt) { osv[mt][0] = 0u; osv[mt][1] = 0u; }

#define SCAN_PF_ONE(i)                                                                             \
    {                                                                                              \
      const int id = tid + (i) * 512;                                                              \
      const int p = id >> 4, seg = id & 15;                                                        \
      const int tk = dir ? (63 - p) : p;                                                           \
      rw##i = *(const uint4*)(Wg + it2__ * 8192 + p * 128 + seg * 8);                              \
      rq##i = *(const uint4*)(QKN + (size_t)(nxt_row0 + tk) * 1024 + h * 128 + seg * 8);           \
      gq##i = GC[it2__ * 64 + p];                                                                  \
      const int s = id & 63, sg2 = id >> 6;                                                        \
      const int tks = dir ? (63 - s) : s;                                                          \
      rk##i = *(const uint4*)(QKN + (size_t)(nxt_row0 + tks) * 1024 + 512 + h * 128 + sg2 * 8);    \
    }
#define SCAN_PREFETCH(n_)                                                                          \
  {                                                                                                \
    const int n__ = (n_);                                                                          \
    int cid__;                                                                                     \
    if (n__ < 4) { cid__ = 256 + b * 4 + (dir ? (3 - n__) : n__); nxt_lat = 0; }                   \
    else { const int m__ = n__ - 4; cid__ = b * 64 + (dir ? (63 - m__) : m__); nxt_lat = 1; }      \
    nxt_row0 = cid__ * 64;                                                                         \
    const size_t it2__ = (size_t)((cid__ * 4 + h) * 2 + dir);                                      \
    SCAN_PF_ONE(0)                                                                                 \
    SCAN_PF_ONE(1)                                                                                 \
    gk = GC[it2__ * 64 + (tid & 63)];                                                              \
    g63 = GC[it2__ * 64 + 63];                                                                     \
    ra = *(const uint4*)(AQg + it2__ * 4096 + (tid >> 3) * 64 + (tid & 7) * 8);                    \
    ru0 = *(const uint2*)(UFg + (it2__ * 128 + nw + fr) * 64 + 0 * 16 + fq * 4);                   \
    ru1 = *(const uint2*)(UFg + (it2__ * 128 + nw + fr) * 64 + 1 * 16 + fq * 4);                   \
    ru2 = *(const uint2*)(UFg + (it2__ * 128 + nw + fr) * 64 + 2 * 16 + fq * 4);                   \
    ru3 = *(const uint2*)(UFg + (it2__ * 128 + nw + fr) * 64 + 3 * 16 + fq * 4);                   \
  }

  SCAN_PREFETCH(0)
  for (int n = 0; n < 68; ++n) {
    cur_row0 = nxt_row0; cur_lat = nxt_lat;
    const float gl = __expf(g63);
    const float sk = __expf(g63 - gk);
#define SCAN_STAGE_ONE(i)                                                     \
    {                                                                         \
      const int id = tid + (i) * 512;                                         \
      const int p = id >> 4, seg = id & 15;                                   \
      *(uint4*)(Wl + p * 136 + seg * 8) = rw##i;                              \
      float f[8];                                                             \
      unpack8(rq##i, f);                                                      \
      const float sq = __expf(gq##i);                                         \
      _Pragma("unroll") for (int e = 0; e < 8; ++e) f[e] *= sq;               \
      *(uint4*)(QTl + p * 136 + seg * 8) = pack8(f);                          \
      const int s = id & 63, sg2 = id >> 6;                                   \
      unpack8(rk##i, f);                                                      \
      _Pragma("unroll") for (int e = 0; e < 8; ++e) KTl[(sg2 * 8 + e) * 72 + s] = f2bf(f[e] * sk); \
    }
    SCAN_STAGE_ONE(0)
    SCAN_STAGE_ONE(1)
#undef SCAN_STAGE_ONE
    *(uint4*)(AQl + (tid >> 3) * 72 + (tid & 7) * 8) = ra;
    f32x4 av[4], ao[4];
    av[0] = f32x4{lo16(ru0.x), hi16(ru0.x), lo16(ru0.y), hi16(ru0.y)};
    av[1] = f32x4{lo16(ru1.x), hi16(ru1.x), lo16(ru1.y), hi16(ru1.y)};
    av[2] = f32x4{lo16(ru2.x), hi16(ru2.x), lo16(ru2.y), hi16(ru2.y)};
    av[3] = f32x4{lo16(ru3.x), hi16(ru3.x), lo16(ru3.y), hi16(ru3.y)};
#pragma unroll
    for (int mt = 0; mt < 4; ++mt) ao[mt] = f32x4{0.f, 0.f, 0.f, 0.f};
    __syncthreads();
    if (prv_lat) {
#pragma unroll
      for (int mt = 0; mt < 4; ++mt) {
        const float pv[4] = {lo16(osv[mt][0]), hi16(osv[mt][0]), lo16(osv[mt][1]), hi16(osv[mt][1])};
#pragma unroll
        for (int e = 0; e < 4; ++e) {
          const int p = mt * 16 + fq * 4 + e;
          const int tk = dir ? (63 - p) : p;
          Og[((size_t)dir * 16384 + prv_row0 + tk) * 512 + h * 128 + nw + fr] = f2bf(pv[e]);
        }
      }
    }
    if (n + 1 < 68) SCAN_PREFETCH(n + 1)
#pragma unroll
    for (int kk = 0; kk < 4; ++kk) {
      const bf16x8 bS = *(const bf16x8*)(ST + (nw + fr) * 136 + kk * 32 + fq * 8);
#pragma unroll
      for (int mt = 0; mt < 4; ++mt) {
        const bf16x8 a1 = *(const bf16x8*)(Wl + (mt * 16 + fr) * 136 + kk * 32 + fq * 8);
        av[mt] = __builtin_amdgcn_mfma_f32_16x16x32_bf16(a1, bS, av[mt], 0, 0, 0);
        const bf16x8 a2 = *(const bf16x8*)(QTl + (mt * 16 + fr) * 136 + kk * 32 + fq * 8);
        ao[mt] = __builtin_amdgcn_mfma_f32_16x16x32_bf16(a2, bS, ao[mt], 0, 0, 0);
      }
    }
#pragma unroll
    for (int mt = 0; mt < 4; ++mt) {
      uint2 v; v.x = pack2(av[mt][0], av[mt][1]); v.y = pack2(av[mt][2], av[mt][3]);
      *(uint2*)(VT + (nw + fr) * 72 + mt * 16 + fq * 4) = v;
    }
    __syncthreads();
#pragma unroll
    for (int d = 0; d < 8; ++d) { accS[d][0] *= gl; accS[d][1] *= gl; accS[d][2] *= gl; accS[d][3] *= gl; }
#pragma unroll
    for (int ks = 0; ks < 2; ++ks) {
      const bf16x8 bV = *(const bf16x8*)(VT + (nw + fr) * 72 + ks * 32 + fq * 8);
#pragma unroll
      for (int mt = 0; mt < 4; ++mt) {
        const bf16x8 a1 = *(const bf16x8*)(AQl + (mt * 16 + fr) * 72 + ks * 32 + fq * 8);
        ao[mt] = __builtin_amdgcn_mfma_f32_16x16x32_bf16(a1, bV, ao[mt], 0, 0, 0);
      }
#pragma unroll
      for (int d = 0; d < 8; ++d) {
        const bf16x8 a2 = *(const bf16x8*)(KTl + (d * 16 + fr) * 72 + ks * 32 + fq * 8);
        accS[d] = __builtin_amdgcn_mfma_f32_16x16x32_bf16(a2, bV, accS[d], 0, 0, 0);
      }
    }
#pragma unroll
    for (int d = 0; d < 8; ++d) {
      uint2 v; v.x = pack2(accS[d][0], accS[d][1]); v.y = pack2(accS[d][2], accS[d][3]);
      *(uint2*)(ST + (nw + fr) * 136 + d * 16 + fq * 4) = v;
    }
#pragma unroll
    for (int mt = 0; mt < 4; ++mt) { osv[mt][0] = pack2(ao[mt][0], ao[mt][1]); osv[mt][1] = pack2(ao[mt][2], ao[mt][3]); }
    prv_lat = cur_lat; prv_row0 = cur_row0;
    __syncthreads();
  }
  if (prv_lat) {
#pragma unroll
    for (int mt = 0; mt < 4; ++mt) {
      const float pv[4] = {lo16(osv[mt][0]), hi16(osv[mt][0]), lo16(osv[mt][1]), hi16(osv[mt][1])};
#pragma unroll
      for (int e = 0; e < 4; ++e) {
        const int p = mt * 16 + fq * 4 + e;
        const int tk = dir ? (63 - p) : p;
        Og[((size_t)dir * 16384 + prv_row0 + tk) * 512 + h * 128 + nw + fr] = f2bf(pv[e]);
      }
    }
  }
#undef SCAN_PREFETCH
#undef SCAN_PF_ONE
}

__device__ __forceinline__ void s5_carry_block(const Params& P, int cb) {
  const int idx = cb * NT + opq(threadIdx.x);
  const int n = idx & 63, g = (idx >> 6) & 31, r = (idx >> 11) & 1, b = idx >> 12;
  const int rg = r * 32 + g;
  const float step = expf(P.s5_log_step[rg]);
  float lr, li;
  lam_pow(step, P.s5_a_re[rg * 64 + n], P.s5_a_im[rg * 64 + n], 32, lr, li);
  const float* E = (const float*)(P.ws + OFF_E) + (size_t)g * 544 * 256 + r * 128 + n;
  u16* XIN = (u16*)(P.ws + OFF_XIN) + (size_t)g * 512 * 256 + r * 128 + n;
  float xr = 0.f, xi = 0.f;
  for (int k = 0; k < 8; ++k) {
    const int cc = r ? (7 - k) : k;
    const int row = 512 + b * 8 + cc;
    const float er = E[(size_t)row * 256], ei = E[(size_t)row * 256 + 64];
    const float nr = lr * xr - li * xi + er, ni = lr * xi + li * xr + ei;
    xr = nr; xi = ni;
  }
  for (int k = 0; k < 128; ++k) {
    const int cc = r ? (127 - k) : k;
    const int row = b * 128 + cc;
    XIN[(size_t)row * 256] = f2bf(xr);
    XIN[(size_t)row * 256 + 64] = f2bf(xi);
    const float er = E[(size_t)row * 256], ei = E[(size_t)row * 256 + 64];
    const float nr = lr * xr - li * xi + er, ni = lr * xi + li * xr + ei;
    xr = nr; xi = ni;
  }
}

__device__ __forceinline__ void s5out_tile(const Params& P, int t, char* lds) {
  const int g = t >> 3, mt = (t >> 2) & 1, nt = t & 3;
  const int m0 = mt * 256, n0 = nt * 128;
  f32x4 acc[4][4];
  acc_zero(acc);
  gemm_main((const u16*)(P.ws + OFF_XIN) + ((size_t)g * 512 + m0) * 256, 256,
            (const u16*)(P.ws + OFF_MST) + ((size_t)g * 512 + n0) * 256, 256, 256, acc, (u16*)lds);
  gemm_main((const u16*)(P.ws + OFF_U5) + ((size_t)g * 544 + m0) * 512, 512,
            (const u16*)(P.ws + OFF_MINTRA) + ((size_t)g * 512 + n0) * 512, 512, 512, acc, (u16*)lds);
  TILE_COORDS
  u16* YB = (u16*)(P.ws + OFF_YB);
#pragma unroll
  for (int i = 0; i < 4; ++i)
#pragma unroll
    for (int j = 0; j < 4; ++j)
#pragma unroll
      for (int e = 0; e < 4; ++e) {
        const int row = TROW(m0, i, e), nn = TCOL(n0, j);
        const int token = row * 32 + (nn >> 4);
        YB[(size_t)token * 512 + g * 16 + (nn & 15)] = f2bf(gelu_tanh(acc[i][j][e]));
      }
}

__device__ __forceinline__ void delta_post_item(const Params& P, int item) {
  const int lane = opq(threadIdx.x) & 63, w = opq(threadIdx.x) >> 6;
  const int row = item * 8 + w;
  const u16* O = (const u16*)(P.ws + OFF_O);
  const uint4 o0 = *(const uint4*)(O + (size_t)row * 512 + lane * 8);
  const uint4 o1 = *(const uint4*)(O + ((size_t)16384 + row) * 512 + lane * 8);
  const uint4 zz = *(const uint4*)((const u16*)(P.ws + OFF_Z) + (size_t)row * 512 + lane * 8);
  float a[8], bq[8], z[8];
  unpack8(o0, a); unpack8(o1, bq); unpack8(zz, z);
  float ss = 0.f;
#pragma unroll
  for (int e = 0; e < 8; ++e) { a[e] += bq[e]; ss += a[e] * a[e]; }
  ss += __shfl_xor(ss, 1, 64); ss += __shfl_xor(ss, 2, 64); ss += __shfl_xor(ss, 4, 64); ss += __shfl_xor(ss, 8, 64);
  const float rstd = rsqrtf(ss * (1.f / 128.f) + 1e-6f);
  const float* nw = P.dn_norm_w + (lane & 15) * 8;
  float y[8];
#pragma unroll
  for (int e = 0; e < 8; ++e) y[e] = a[e] * rstd * nw[e] * (z[e] * sigm(z[e]));
  *(uint4*)((u16*)(P.ws + OFF_YA) + (size_t)row * 512 + lane * 8) = pack8(y);
}

__device__ __forceinline__ void glu_tile(const Params& P, int t, char* lds) {
  const int nt = t >> 6, mt = t & 63;
  const int m0 = mt * 256, n0 = nt * 128;
  f32x4 acc[4][4];
  acc_zero(acc);
  gemm_main((const u16*)(P.ws + OFF_YB) + (size_t)m0 * 512, 512, (const u16*)(P.ws + OFF_WT_GLU) + (size_t)n0 * 512, 512, 512, acc, (u16*)lds);
  TILE_COORDS
  u16* YG = (u16*)(P.ws + OFF_YG);
#pragma unroll
  for (int i = 0; i < 4; ++i)
#pragma unroll
    for (int j = 0; j < 2; ++j) {
      const int oc = nt * 64 + wn_ * 32 + j * 16 + fr_;
      const float bv = P.b_glu[oc], bg = P.b_glu[512 + oc];
#pragma unroll
      for (int e = 0; e < 4; ++e) {
        const float val = acc[i][j][e] + bv, gt = acc[i][j + 2][e] + bg;
        YG[(size_t)TROW(m0, i, e) * 512 + oc] = f2bf(val * sigm(gt));
      }
    }
}

__device__ __forceinline__ void gates_tile(const Params& P, int t, char* lds) {
  const int nt = t >> 6, mt = t & 63;
  const int m0 = mt * 256, n0 = nt * 128;
  f32x4 acc[4][4];
  acc_zero(acc);
  gemm_main((const u16*)(P.ws + OFF_R2) + (size_t)m0 * 1024, 1024, (const u16*)(P.ws + OFF_WT_IN) + (size_t)(2688 + n0) * 1024, 1024, 1024, acc, (u16*)lds);
  TILE_COORDS
  u16* SG = (u16*)(P.ws + OFF_SG);
#pragma unroll
  for (int i = 0; i < 4; ++i)
#pragma unroll
    for (int j = 0; j < 4; ++j)
#pragma unroll
      for (int e = 0; e < 4; ++e) SG[(size_t)TROW(m0, i, e) * 2048 + TCOL(n0, j)] = f2bf(sigm(acc[i][j][e]));
}

__device__ __forceinline__ void mix_tile(const Params& P, int t, char* lds) {
  const int nt = t >> 6, mt = t & 63;
  const int m0 = mt * 256, n0 = nt * 128;
  const u16* SG = (const u16*)(P.ws + OFF_SG);
  f32x4 acc[4][4];
  u16* MIX = (u16*)(P.ws + OFF_MIX);
  acc_zero(acc);
  gemm_main((const u16*)(P.ws + OFF_YA) + (size_t)m0 * 512, 512, (const u16*)(P.ws + OFF_WT_AOUT) + (size_t)n0 * 512, 512, 512, acc, (u16*)lds);
  {
    TILE_COORDS
#pragma unroll
    for (int i = 0; i < 4; ++i)
#pragma unroll
      for (int j = 0; j < 4; ++j)
#pragma unroll
        for (int e = 0; e < 4; ++e) {
          const int r = TROW(m0, i, e), col = TCOL(n0, j);
          MIX[(size_t)r * 1024 + col] = f2bf(bf2f(SG[(size_t)r * 2048 + col]) * acc[i][j][e]);
        }
  }
  acc_zero(acc);
  gemm_main((const u16*)(P.ws + OFF_YG) + (size_t)m0 * 512, 512, (const u16*)(P.ws + OFF_WT_BOUT) + (size_t)n0 * 512, 512, 512, acc, (u16*)lds);
  {
    TILE_COORDS
#pragma unroll
    for (int i = 0; i < 4; ++i)
#pragma unroll
      for (int j = 0; j < 4; ++j)
#pragma unroll
        for (int e = 0; e < 4; ++e) {
          const int r = TROW(m0, i, e), col = TCOL(n0, j);
          const size_t o = (size_t)r * 1024 + col;
          MIX[o] = f2bf(bf2f(MIX[o]) + bf2f(SG[(size_t)r * 2048 + 1024 + col]) * acc[i][j][e]);
        }
  }
}

__device__ __forceinline__ void wo_tile(const Params& P, int t, char* lds) {
  const int nt = t >> 6, mt = t & 63;
  const int m0 = mt * 256, n0 = nt * 128;
  f32x4 acc[4][4];
  acc_zero(acc);
  gemm_main((const u16*)(P.ws + OFF_MIX) + (size_t)m0 * 1024, 1024, (const u16*)(P.ws + OFF_WT_O) + (size_t)n0 * 1024, 1024, 1024, acc, (u16*)lds);
  TILE_COORDS
  const float* MOD = (const float*)(P.ws + OFF_MOD) + (m0 >> 12) * 6144 + 2 * 1024;
#pragma unroll
  for (int j = 0; j < 4; ++j) {
    const int col = TCOL(n0, j);
    const float gate = MOD[col];
#pragma unroll
    for (int i = 0; i < 4; ++i)
#pragma unroll
      for (int e = 0; e < 4; ++e) {
        const size_t o = (size_t)TROW(m0, i, e) * 1024 + col;
        P.out[o] = P.x[o] + gate * acc[i][j][e];
      }
  }
}

__device__ __forceinline__ void norm2_item(const Params& P, int item) {
  const int lane = opq(threadIdx.x) & 63, w = opq(threadIdx.x) >> 6;
  const int row = item * 8 + w;
  const float* MOD = (const float*)(P.ws + OFF_MOD) + (row >> 12) * 6144;
  norm_row(P.out + (size_t)row * 1024, P.norm2_w, MOD + 3 * 1024, MOD + 4 * 1024, (u16*)(P.ws + OFF_R2) + (size_t)row * 1024, lane);
}

__device__ __forceinline__ void up_tile(const Params& P, int t, int hh, char* lds) {
  const int nt = t >> 6, mt = t & 63;
  const int m0 = mt * 256, n0 = nt * 128;
  f32x4 acc[4][4];
  acc_zero(acc);
  gemm_main((const u16*)(P.ws + OFF_R2) + (size_t)m0 * 1024, 1024,
            (const u16*)(P.ws + OFF_WT_UP) + ((size_t)hh * 2816 + n0) * 1024, 1024, 1024, acc, (u16*)lds);
  TILE_COORDS
  u16* UPH = (u16*)(P.ws + OFF_UPH);
#pragma unroll
  for (int i = 0; i < 4; ++i)
#pragma unroll
    for (int j = 0; j < 4; ++j)
#pragma unroll
      for (int e = 0; e < 4; ++e) UPH[(size_t)TROW(m0, i, e) * 2816 + TCOL(n0, j)] = f2bf(acc[i][j][e]);
}

#define CG_LD(ci, dy)                                                                       \
    {                                                                                       \
      const int xc = x0 - 1 + (ci);                                                         \
      const bool cok = (xc >= 0) && (xc <= 63);                                             \
      const bool rok = ((dy) == 1) || ((dy) == 0 ? r0ok : r2ok);                            \
      const int yy = rok ? (y + (dy) - 1) : y;                                              \
      const u16* src = UPH + (base + (size_t)yy * 64 + (cok ? xc : x0)) * 2816 + c4;        \
      uint2 g__ = *(const uint2*)src;                                                       \
      uint2 v__ = *(const uint2*)(src + 1408);                                              \
      const bool ok = cok && rok;                                                           \
      g__.x = ok ? g__.x : 0u; g__.y = ok ? g__.y : 0u;                                     \
      v__.x = ok ? v__.x : 0u; v__.y = ok ? v__.y : 0u;                                     \
      gg[ci][dy] = g__; vv[ci][dy] = v__;                                                   \
    }
__device__ __forceinline__ void convgate_item(const Params& P, int item, int hh) {
  const int tid = opq(threadIdx.x);
  if (tid >= 352) return;
  const int xo = item & 7, y = (item >> 3) & 63, b = item >> 9;
  const int c4 = tid * 4;
  const u16* UPH = (const u16*)(P.ws + OFF_UPH);
  u16* G = (u16*)(P.ws + OFF_G);
  const size_t base = (size_t)b * 4096;
  const bool r0ok = (y > 0), r2ok = (y < 63);
  const int x0 = xo * 8;
  uint2 gg[10][3], vv[10][3];
#pragma unroll
  for (int ci = 0; ci < 10; ++ci) {
    CG_LD(ci, 0)
    CG_LD(ci, 1)
    CG_LD(ci, 2)
  }
  float wg[9][4], wv[9][4];
#pragma unroll
  for (int k = 0; k < 9; ++k) {
    const float4 a = *(const float4*)(P.ffn_conv_w + (size_t)k * 5632 + hh * 1408 + c4);
    const float4 bq = *(const float4*)(P.ffn_conv_w + (size_t)k * 5632 + 2816 + hh * 1408 + c4);
    wg[k][0] = a.x; wg[k][1] = a.y; wg[k][2] = a.z; wg[k][3] = a.w;
    wv[k][0] = bq.x; wv[k][1] = bq.y; wv[k][2] = bq.z; wv[k][3] = bq.w;
  }
#pragma unroll
  for (int xx = 0; xx < 8; ++xx) {
    float ag[4] = {0.f, 0.f, 0.f, 0.f}, av[4] = {0.f, 0.f, 0.f, 0.f};
#pragma unroll
    for (int dy = 0; dy < 3; ++dy)
#pragma unroll
      for (int dx = 0; dx < 3; ++dx) {
        const uint2 gq = gg[xx + dx][dy], vq = vv[xx + dx][dy];
        const int k = dy * 3 + dx;
        ag[0] += wg[k][0] * lo16(gq.x); ag[1] += wg[k][1] * hi16(gq.x); ag[2] += wg[k][2] * lo16(gq.y); ag[3] += wg[k][3] * hi16(gq.y);
        av[0] += wv[k][0] * lo16(vq.x); av[1] += wv[k][1] * hi16(vq.x); av[2] += wv[k][2] * lo16(vq.y); av[3] += wv[k][3] * hi16(vq.y);
      }
    uint2 o;
    o.x = pack2(ag[0] * sigm(ag[0]) * av[0], ag[1] * sigm(ag[1]) * av[1]);
    o.y = pack2(ag[2] * sigm(ag[2]) * av[2], ag[3] * sigm(ag[3]) * av[3]);
    *(uint2*)(G + (base + y * 64 + x0 + xx) * 2816 + hh * 1408 + c4) = o;
  }
}
#undef CG_LD

__device__ __forceinline__ void down_tile(const Params& P, int t, char* lds) {
  const int nt = t >> 6, mt = t & 63;
  const int m0 = mt * 256, n0 = nt * 128;
  f32x4 acc[4][4];
  acc_zero(acc);
  gemm_main((const u16*)(P.ws + OFF_G) + (size_t)m0 * 2816, 2816, (const u16*)(P.ws + OFF_WT_DOWN) + (size_t)n0 * 2816, 2816, 2816, acc, (u16*)lds);
  TILE_COORDS
  const float* MOD = (const float*)(P.ws + OFF_MOD) + (m0 >> 12) * 6144 + 5 * 1024;
#pragma unroll
  for (int j = 0; j < 4; ++j) {
    const int col = TCOL(n0, j);
    const float gate = MOD[col];
#pragma unroll
    for (int i = 0; i < 4; ++i)
#pragma unroll
      for (int e = 0; e < 4; ++e) {
        const size_t o = (size_t)TROW(m0, i, e) * 1024 + col;
        P.out[o] = P.out[o] + gate * acc[i][j][e];
      }
  }
}

__device__ __forceinline__ void final_item(const Params& P, int item) {
  const int lane = opq(threadIdx.x) & 63, w = opq(threadIdx.x) >> 6;
  const int row = item * 8 + w;
  float* xr = P.out + (size_t)row * 1024;
  float4 v[4];
  float ss = 0.f;
#pragma unroll
  for (int it = 0; it < 4; ++it) {
    v[it] = *(const float4*)(xr + (it * 64 + lane) * 4);
    ss += v[it].x * v[it].x + v[it].y * v[it].y + v[it].z * v[it].z + v[it].w * v[it].w;
  }
  ss = wsum64(ss);
  const float rstd = rsqrtf(ss * (1.f / 1024.f) + 1e-6f);
#pragma unroll
  for (int it = 0; it < 4; ++it) {
    const int c = (it * 64 + lane) * 4;
    const float4 w4 = *(const float4*)(P.norm_f_w + c);
    float4 o;
    o.x = v[it].x * rstd * w4.x; o.y = v[it].y * rstd * w4.y; o.z = v[it].z * rstd * w4.z; o.w = v[it].w * rstd * w4.w;
    *(float4*)(xr + c) = o;
  }
}

__device__ __forceinline__ void run_phase(const Params& P, int ph, char* lds) {
  const int bid = blockIdx.x, nb = gridDim.x;
#ifdef ONLY_PHASE
  if (ph != ONLY_PHASE) return;
#endif
  switch (ph) {
    case 0: {
      for (int it = bid; it < 984 + 192 + 2048; it += nb) {
        if (it < 296) convert_item(P.w_in, 1024, 4624, (u16*)(P.ws + OFF_WT_IN), 0, it, lds);
        else if (it < 328) convert_item(P.w_a_out, 512, 1024, (u16*)(P.ws + OFF_WT_AOUT), 1, it - 296, lds);
        else if (it < 360) convert_item(P.w_glu, 512, 1024, (u16*)(P.ws + OFF_WT_GLU), 2, it - 328, lds);
        else if (it < 392) convert_item(P.w_b_out, 512, 1024, (u16*)(P.ws + OFF_WT_BOUT), 3, it - 360, lds);
        else if (it < 456) convert_item(P.w_o, 1024, 1024, (u16*)(P.ws + OFF_WT_O), 4, it - 392, lds);
        else if (it < 808) convert_item(P.w_up, 1024, 5632, (u16*)(P.ws + OFF_WT_UP), 5, it - 456, lds);
        else if (it < 984) convert_item(P.w_down, 2816, 1024, (u16*)(P.ws + OFF_WT_DOWN), 6, it - 808, lds);
        else if (it < 1176) mod_item(P, it - 984, lds);
        else s5tab_item(P, it - 1176, lds);
      }
    } break;
    case 1:
      for (int it = bid; it < 2176 + 2048; it += nb) {
        if (it < 2176) norm1_item(P, it); else mintra_item(P, it - 2176);
      }
      break;
    case 2:
      for (int it = bid; it < 1396; it += nb) inproj_tile(P, it, lds);
      break;
    case 3:
      for (int it = bid; it < 1088 + 192; it += nb) {
        if (it < 1088) delta_prep_item(P, it, lds); else s5end_tile(P, it - 1088, lds);
      }
      break;
    case 4:
      if (bid < 32) delta_scan_block(P, bid, lds);
      else if (bid < 64) s5_carry_block(P, bid - 32);
      break;
    case 5:
      for (int it = bid; it < 256 + 2048 + 2048; it += nb) {
        if (it < 256) s5out_tile(P, it, lds);
        else if (it < 2304) delta_post_item(P, it - 256);
        else norm1_item(P, it - 2304);
      }
      break;
    case 6:
      for (int it = bid; it < 512 + 1024; it += nb) {
        if (it < 512) glu_tile(P, it, lds); else gates_tile(P, it - 512, lds);
      }
      break;
    case 7:
      for (int it = bid; it < 512; it += nb) mix_tile(P, it, lds);
      break;
    case 8:
      for (int it = bid; it < 512; it += nb) wo_tile(P, it, lds);
      break;
    case 9:
      for (int it = bid; it < 2048; it += nb) norm2_item(P, it);
      break;
    case 10:
      for (int it = bid; it < 1408; it += nb) up_tile(P, it, 0, lds);
      break;
    case 11:
      for (int it = bid; it < 2048; it += nb) convgate_item(P, it, 0);
      break;
    case 12:
      for (int it = bid; it < 1408; it += nb) up_tile(P, it, 1, lds);
      break;
    case 13:
      for (int it = bid; it < 2048; it += nb) convgate_item(P, it, 1);
      break;
    case 14:
      for (int it = bid; it < 512; it += nb) down_tile(P, it, lds);
      break;
    case 15:
      for (int it = bid; it < 2048; it += nb) final_item(P, it);
      break;
    default: break;
  }
}

typedef const __attribute__((address_space(4))) Params* KParamsPtr;
__global__ void __launch_bounds__(NT) fwd_megakernel(Params Pk) {
#if defined(__HIP_DEVICE_COMPILE__)
  extern __shared__ __attribute__((aligned(16))) char lds[];
  KParamsPtr pp = (KParamsPtr)__builtin_amdgcn_kernarg_segment_ptr();
  const int lo = (int)pp->ph_lo, hi = (int)pp->ph_hi;
#if MULTI_LAUNCH
  for (int ph = lo; ph < hi; ++ph) { KParamsPtr q = pp; asm volatile("" : "+s"(q)); Params P; for (int i_ = 0; i_ < (int)(sizeof(Params) / 8); ++i_) ((unsigned long long*)&P)[i_] = ((const __attribute__((address_space(4))) unsigned long long*)q)[i_]; run_phase(P, ph, lds); }
#else
  cg::grid_group grid = cg::this_grid();
  volatile LAS unsigned* xst = (volatile LAS unsigned*)(lds + (LDS_BYTES - 16));
  if (threadIdx.x == 0) { xst[0] = 0u; xst[1] = 0u; xst[2] = 0u; xst[3] = 0u; }
  __syncthreads();
  XcdBarrier xb = xcd_barrier_post((unsigned*)(pp->ws + OFF_BAR), xst);
  for (int ph = lo; ph < hi; ++ph) {
    {
      KParamsPtr q = pp;
      asm volatile("" : "+s"(q));
      Params P;
#pragma unroll
      for (int i_ = 0; i_ < (int)(sizeof(Params) / 8); ++i_) ((unsigned long long*)&P)[i_] = ((const __attribute__((address_space(4))) unsigned long long*)q)[i_];
      run_phase(P, ph, lds);
#ifdef REPEAT_MASK
      if ((REPEAT_MASK >> ph) & 1) { xcd_barrier(xb); run_phase(P, ph, lds); }
#endif
    }
    if (ph + 1 < hi) {
      if (ph == lo) grid.sync();
      else xcd_barrier(xb);
    }
  }
#ifdef EXTRA_SYNCS
  for (int i = 0; i < EXTRA_SYNCS; ++i) xcd_barrier(xb);
#endif
#endif
#endif
}

extern "C" void kernel_launch(void* const* d_in, const int* in_sizes, int n_in, void* d_out, int out_size, void* d_ws,
                              size_t ws_size, hipStream_t stream) {
  static int grid_blocks = 0;
  if (grid_blocks == 0) {
    if (n_in != 30 || out_size != 16384 * 1024 || ws_size < WS_NEED) {
      fprintf(stderr, "kernel_launch: unexpected shapes: n_in %d out %d ws %zu (need %zu)\n", n_in, out_size, ws_size, (size_t)WS_NEED);
      grid_blocks = -1;
      return;
    }
    int dev = 0, cus = 0, per_cu = 0;
    hipGetDevice(&dev);
    hipDeviceGetAttribute(&cus, hipDeviceAttributeMultiprocessorCount, dev);
    if (hipFuncSetAttribute((const void*)fwd_megakernel, hipFuncAttributeMaxDynamicSharedMemorySize, LDS_BYTES) != hipSuccess) {
      fprintf(stderr, "kernel_launch: hipFuncSetAttribute failed\n");
      grid_blocks = -1;
      return;
    }
    if (hipOccupancyMaxActiveBlocksPerMultiprocessor(&per_cu, (const void*)fwd_megakernel, NT, LDS_BYTES) != hipSuccess || per_cu < 1) {
      fprintf(stderr, "kernel_launch: occupancy query failed / zero (%d)\n", per_cu);
      grid_blocks = -1;
      return;
    }
    grid_blocks = cus;
    if (grid_blocks < 64) { fprintf(stderr, "kernel_launch: too few CUs (%d)\n", cus); grid_blocks = -1; return; }
  }
  if (grid_blocks < 0) return;
  (void)hipMemsetAsync((char*)d_ws + OFF_BAR, 0, XCD_BAR_WORDS * sizeof(unsigned), stream);
  Params p{};
  const float** pp = (const float**)&p;
  for (int i = 0; i < 30; ++i) pp[i] = (const float*)d_in[i];
  p.out = (float*)d_out;
  p.ws = (char*)d_ws;
#if MULTI_LAUNCH
  for (int ph = 0; ph < 16; ++ph) {
    p.ph_lo = ph; p.ph_hi = ph + 1;
    hipLaunchKernelGGL(fwd_megakernel, dim3(grid_blocks), dim3(NT), LDS_BYTES, stream, p);
  }
#else
  p.ph_lo = 0; p.ph_hi = 16;
  void* args[] = {&p};
  hipError_t e = hipLaunchCooperativeKernel((const void*)fwd_megakernel, dim3(grid_blocks), dim3(NT), args, LDS_BYTES, stream);
  if (e != hipSuccess) fprintf(stderr, "cooperative launch failed: %s (grid %d)\n", hipGetErrorString(e), grid_blocks);
#endif
}
```

```cpp
#include <hip/hip_runtime.h>
#include <hip/hip_cooperative_groups.h>
#include <cstdio>
#include <cstdint>
namespace cg = cooperative_groups;

#ifndef MULTI_LAUNCH
#define MULTI_LAUNCH 0
#endif

typedef unsigned short u16;
typedef __attribute__((ext_vector_type(8))) short bf16x8;
typedef __attribute__((ext_vector_type(4))) float f32x4;

#define NT 512
constexpr int LDS_BYTES = 131072 + 1024;
constexpr int NPHASE = 18;

constexpr size_t OFF_WT_IN   = 0;
constexpr size_t OFF_WT_AOUT = 9699328;
constexpr size_t OFF_WT_GLU  = 10747904;
constexpr size_t OFF_WT_BOUT = 11796480;
constexpr size_t OFF_WT_O    = 12845056;
constexpr size_t OFF_WT_UP   = 14942208;
constexpr size_t OFF_WT_DOWN = 26476544;
constexpr size_t OFF_MOD     = 32243712;
constexpr size_t OFF_BAR     = 32505856;
constexpr size_t OFF_R2      = 33554432;
constexpr size_t OFF_R1      = 69206016;
constexpr size_t OFF_KTAB    = OFF_R1;
constexpr size_t OFF_MEND    = OFF_R1 + 2097152;
constexpr size_t OFF_MST     = OFF_R1 + 10485760;
constexpr size_t OFF_MINTRA  = OFF_R1 + 18874368;
constexpr size_t OFF_R3      = 104857600;
constexpr size_t OFF_O       = OFF_R3;
constexpr size_t OFF_XIN     = OFF_R3 + 33554432;
constexpr size_t OFF_MIX     = 158334976;
constexpr size_t OFF_SG      = OFF_R1;
constexpr size_t OFF_Z       = 158334976;
constexpr size_t OFF_U5      = 175112192;
constexpr size_t OFF_BA      = 192937984;
constexpr size_t OFF_GC      = OFF_BA + 1179648;
constexpr size_t OFF_UF      = 195035136;
constexpr size_t OFF_YA      = OFF_UF;
constexpr size_t OFF_YB      = OFF_UF + 16777216;
constexpr size_t OFF_E       = 230686720;
constexpr size_t OFF_YG      = OFF_E;
constexpr size_t OFF_UPH     = OFF_R1;
constexpr size_t OFF_G       = 161480704;
constexpr size_t WS_NEED     = 253755392;
constexpr size_t OFF_QKN     = 0;
constexpr size_t OFF_AQ      = 35651584;

struct Params {
  const float *x, *c, *ctx, *c_ctx, *w_ada, *b_ada, *norm1_w, *w_in, *dn_conv_w, *dn_a_log, *dn_dt_bias, *dn_norm_w,
      *w_a_out, *s5_a_re, *s5_a_im, *s5_log_step, *s5_b_re, *s5_b_im, *s5_c_re, *s5_c_im, *s5_d, *w_glu, *b_glu,
      *w_b_out, *w_o, *norm2_w, *w_up, *ffn_conv_w, *w_down, *norm_f_w;
  float* out;
  char* ws;
  long long ph_lo, ph_hi;
  long long rep_mask;
};

#define XB_TMO      128
#define XB_XCNT(j)  (256  + 64 * (j))
#define XB_XSUB(j)  (1280 + 64 * (j))
#define XB_XGEN(j)  (2304 + 64 * (j))
#define XB_TOP      3328
#define XB_TOPGEN   3392
#define XCD_BAR_WORDS 3456
#define XB_SPIN_CAP (1u << 18)
#define LAS __attribute__((address_space(3)))

__device__ __forceinline__ unsigned xb_ld(unsigned* p)              { return __hip_atomic_load(p, __ATOMIC_RELAXED, __HIP_MEMORY_SCOPE_AGENT); }
__device__ __forceinline__ unsigned xb_add(unsigned* p, unsigned v) { return __hip_atomic_fetch_add(p, v, __ATOMIC_RELAXED, __HIP_MEMORY_SCOPE_AGENT); }
__device__ __forceinline__ unsigned xb_xcc_id() { return (unsigned)__builtin_amdgcn_s_getreg((3 << 11) | 20) & 0xFu; }
#define XB_SPIN(cond, bar) do { unsigned _sp = 0; while (cond) { __builtin_amdgcn_s_sleep(1); \
    if ((++_sp & 255u) == 0u) { if (xb_ld(&(bar)[XB_TMO])) break; if (_sp > XB_SPIN_CAP) { atomicAdd(&(bar)[XB_TMO], 1u); break; } } } } while (0)

struct XcdBarrier {
    unsigned* bar; unsigned x;
    volatile LAS unsigned* st;
};

__device__ __forceinline__ XcdBarrier xcd_barrier_post(unsigned* bar, volatile LAS unsigned* st) {
    XcdBarrier b; b.bar = bar; b.x = xb_xcc_id(); b.st = st;
    if (threadIdx.x == 0) (void)xb_add(&bar[XB_XCNT(b.x)], 1u);
    return b;
}
__device__ __forceinline__ void xcd_barrier_complete(unsigned* bar, unsigned x, unsigned& nloc, unsigned& nx) {
    const unsigned G = gridDim.x * gridDim.y * gridDim.z;
    unsigned sum, cnt, mine, sp = 0u;
    for (;;) {
        sum = 0u; cnt = 0u; mine = 0u;
#pragma unroll
        for (unsigned j = 0; j < 16; ++j) { const unsigned c = xb_ld(&bar[XB_XCNT(j)]); sum += c; cnt += (c > 0u) ? 1u : 0u; mine = (j == x) ? c : mine; }
        if (sum == G) break;
        __builtin_amdgcn_s_sleep(1);
        if ((++sp & 255u) == 0u) { if (xb_ld(&bar[XB_TMO])) break; if (sp > XB_SPIN_CAP) { atomicAdd(&bar[XB_TMO], 1u); break; } }
    }
    nloc = mine > 0u ? mine : 1u; nx = cnt > 0u ? cnt : 1u;
}

__device__ __forceinline__ void xcd_barrier(const XcdBarrier& b) {
    asm volatile("s_waitcnt vmcnt(0)" ::: "memory");
    __syncthreads();
    if (threadIdx.x == 0) {
        unsigned* bar = b.bar;
        __builtin_amdgcn_s_waitcnt(0);
        unsigned nloc = b.st[0], nx = b.st[1];
        if (nloc == 0u) { xcd_barrier_complete(bar, b.x, nloc, nx); b.st[0] = nloc; b.st[1] = nx; }
        const unsigned old = xb_add(&bar[XB_XSUB(b.x)], 1u);
        const unsigned gen = old / nloc;
        if (old + 1u == (gen + 1u) * nloc) {
            __builtin_amdgcn_fence(__ATOMIC_RELEASE, "agent");
            asm volatile("s_waitcnt vmcnt(0)" ::: "memory");
            const unsigned og = xb_add(&bar[XB_TOP], 1u);
            const unsigned tg = og / nx;
            if (og + 1u == (tg + 1u) * nx) xb_add(&bar[XB_TOPGEN], 1u);
            else XB_SPIN(xb_ld(&bar[XB_TOPGEN]) == tg, bar);
            __builtin_amdgcn_fence(__ATOMIC_ACQUIRE, "agent");
            xb_add(&bar[XB_XGEN(b.x)], 1u);
            asm volatile("s_waitcnt vmcnt(0)" ::: "memory");
        } else {
            XB_SPIN(xb_ld(&bar[XB_XGEN(b.x)]) == gen, bar);
            __builtin_amdgcn_fence(__ATOMIC_ACQUIRE, "agent");
            asm volatile("s_waitcnt vmcnt(0)" ::: "memory");
        }
    }
    __syncthreads();
}


__device__ __forceinline__ u16 f2bf(float f) {
  uint32_t u = __float_as_uint(f);
  u += 0x7fffu + ((u >> 16) & 1u);
  return (u16)(u >> 16);
}
__device__ __forceinline__ float bf2f(u16 h) { return __uint_as_float(((uint32_t)h) << 16); }
__device__ __forceinline__ uint32_t pack2(float a, float b) { return (uint32_t)f2bf(a) | ((uint32_t)f2bf(b) << 16); }
__device__ __forceinline__ float lo16(uint32_t w) { return __uint_as_float(w << 16); }
__device__ __forceinline__ float hi16(uint32_t w) { return __uint_as_float(w & 0xffff0000u); }
__device__ __forceinline__ int opq(int v) { asm volatile("" : "+v"(v)); return v; }
__device__ __forceinline__ float sigm(float x) { return 1.f / (1.f + __expf(-x)); }
__device__ __forceinline__ void unpack8(uint4 v, float* f) {
  f[0] = lo16(v.x); f[1] = hi16(v.x); f[2] = lo16(v.y); f[3] = hi16(v.y);
  f[4] = lo16(v.z); f[5] = hi16(v.z); f[6] = lo16(v.w); f[7] = hi16(v.w);
}
__device__ __forceinline__ uint4 pack8(const float* f) {
  uint4 v; v.x = pack2(f[0], f[1]); v.y = pack2(f[2], f[3]); v.z = pack2(f[4], f[5]); v.w = pack2(f[6], f[7]);
  return v;
}
__device__ __forceinline__ float wsum64(float v) {
#pragma unroll
  for (int o = 32; o > 0; o >>= 1) v += __shfl_xor(v, o, 64);
  return v;
}
__device__ __forceinline__ float gelu_tanh(float x) {
  float u = 0.7978845608028654f * (x + 0.044715f * x * x * x);
  float t = 1.f - 2.f / (1.f + __expf(2.f * u));
  return 0.5f * x * (1.f + t);
}

__device__ __forceinline__ void g_compute(const u16* As, const u16* Bs, int buf, int wm, int wn, int fr, int fq, f32x4 (&acc)[4][4]) {
  const u16* as = As + (buf * 256 + wm * 64 + fr) * 72 + fq * 8;
  const u16* bs = Bs + (buf * 128 + wn * 64 + fr) * 72 + fq * 8;
#pragma unroll
  for (int ks = 0; ks < 2; ++ks) {
    bf16x8 a[4], b[4];
#pragma unroll
    for (int i = 0; i < 4; ++i) a[i] = *(const bf16x8*)(as + i * 16 * 72 + ks * 32);
#pragma unroll
    for (int j = 0; j < 4; ++j) b[j] = *(const bf16x8*)(bs + j * 16 * 72 + ks * 32);
#pragma unroll
    for (int i = 0; i < 4; ++i)
#pragma unroll
      for (int j = 0; j < 4; ++j) acc[i][j] = __builtin_amdgcn_mfma_f32_16x16x32_bf16(a[i], b[j], acc[i][j], 0, 0, 0);
  }
}
__device__ __forceinline__ void gemm_main(const u16* __restrict__ A, int lda, const u16* __restrict__ Bt, int ldb, int K,
                                          f32x4 (&acc)[4][4], u16* lds) {
  const int tid = opq(threadIdx.x), lane = tid & 63, w = tid >> 6, wm = w >> 1, wn = w & 1, fr = lane & 15, fq = lane >> 4;
  u16* As = lds;
  u16* Bs = lds + 2 * 256 * 72;
  const int nk = K >> 6;
  uint4 p0, p1, p2, p3, p4, p5;
  uint4 q0, q1, q2, q3, q4, q5;
  const int lr = tid >> 3, lc = (tid & 7) * 8;
  const u16* ap = A + (size_t)lr * lda + lc;
  const u16* bp = Bt + (size_t)lr * ldb + lc;
  const size_t sa = (size_t)64 * lda, sb = (size_t)64 * ldb;
#define G_LOAD(S, kt_)                                          \
  {                                                             \
    const u16* a_ = ap + (kt_) * 64;                            \
    const u16* b_ = bp + (kt_) * 64;                            \
    S##0 = *(const uint4*)(a_);                                 \
    S##1 = *(const uint4*)(a_ + sa);                            \
    S##2 = *(const uint4*)(a_ + 2 * sa);                        \
    S##3 = *(const uint4*)(a_ + 3 * sa);                        \
    S##4 = *(const uint4*)(b_);                                 \
    S##5 = *(const uint4*)(b_ + sb);                            \
  }
#define G_STORE(S, buf_)                                                     \
  {                                                                          \
    u16* as_ = As + ((buf_) * 256 + lr) * 72 + lc;                           \
    u16* bs_ = Bs + ((buf_) * 128 + lr) * 72 + lc;                           \
    *(uint4*)(as_) = S##0;                                                   \
    *(uint4*)(as_ + 64 * 72) = S##1;                                         \
    *(uint4*)(as_ + 128 * 72) = S##2;                                        \
    *(uint4*)(as_ + 192 * 72) = S##3;                                        \
    *(uint4*)(bs_) = S##4;                                                   \
    *(uint4*)(bs_ + 64 * 72) = S##5;                                         \
  }
  G_LOAD(p, 0)
  __syncthreads();
  G_STORE(p, 0)
  G_LOAD(q, 1)
  G_LOAD(p, (nk > 2 ? 2 : 1))
  __syncthreads();
  for (int kt = 0; kt < nk; kt += 2) {
    G_STORE(q, 1)
    G_LOAD(q, (kt + 3 < nk ? kt + 3 : nk - 1))
    __builtin_amdgcn_sched_barrier(0);
    g_compute(As, Bs, 0, wm, wn, fr, fq, acc);
    __syncthreads();
    G_STORE(p, 0)
    G_LOAD(p, (kt + 4 < nk ? kt + 4 : nk - 1))
    __builtin_amdgcn_sched_barrier(0);
    g_compute(As, Bs, 1, wm, wn, fr, fq, acc);
    __syncthreads();
  }
#undef G_LOAD
#undef G_STORE
}

__device__ __forceinline__ void acc_zero(f32x4 (&acc)[4][4]) {
#pragma unroll
  for (int i = 0; i < 4; ++i)
#pragma unroll
    for (int j = 0; j < 4; ++j) acc[i][j] = f32x4{0.f, 0.f, 0.f, 0.f};
}

#define TILE_COORDS                                                                                  \
  const int tid_ = opq(threadIdx.x), lane_ = tid_ & 63, w_ = tid_ >> 6, wm_ = w_ >> 1, wn_ = w_ & 1,     \
            fr_ = lane_ & 15, fq_ = lane_ >> 4;
#define TROW(m0, i, e) ((m0) + wm_ * 64 + (i) * 16 + fq_ * 4 + (e))
#define TCOL(n0, j) ((n0) + wn_ * 64 + (j) * 16 + fr_)

__device__ __forceinline__ int srccol(int which, int r) {
  switch (which) {
    case 0:
      if (r < 2048) return r;
      if (r < 2560) return 2064 + (r - 2048);
      if (r < 2576) return 2048 + (r - 2560);
      if (r < 2688) return -1;
      if (r < 3712) return 2576 + (r - 2688);
      return 3600 + (r - 3712);
    case 2: {
      int tile = r >> 7, wn = (r >> 6) & 1, wi = r & 63;
      return (wi < 32) ? (tile * 64 + wn * 32 + wi) : (512 + tile * 64 + wn * 32 + (wi - 32));
    }
    case 5: {
      int hh = r / 2816, cc = r % 2816;
      return (cc < 1408) ? (hh * 1408 + cc) : (2816 + hh * 1408 + (cc - 1408));
    }
    default: return r;
  }
}

__device__ __forceinline__ void convert_item(const float* __restrict__ src, int K, int N, u16* __restrict__ dst, int which, int item, char* lds) {
  float* tile = (float*)lds;
  const int tid = opq(threadIdx.x);
  const int kb = K >> 8;
  const int r0 = (item / kb) * 64, k0 = (item % kb) * 256;
  __syncthreads();
  {
    const int n4 = (tid & 15) * 4, kk = tid >> 4;
    const int sc = srccol(which, r0 + n4);
    float4 v[8];
#pragma unroll
    for (int it = 0; it < 8; ++it) {
      const int k = kk + 32 * it;
      v[it] = (sc >= 0) ? *(const float4*)(src + (size_t)(k0 + k) * N + sc) : make_float4(0.f, 0.f, 0.f, 0.f);
    }
#pragma unroll
    for (int it = 0; it < 8; ++it) {
      const int k = kk + 32 * it;
      tile[(n4 + 0) * 257 + k] = v[it].x; tile[(n4 + 1) * 257 + k] = v[it].y;
      tile[(n4 + 2) * 257 + k] = v[it].z; tile[(n4 + 3) * 257 + k] = v[it].w;
    }
  }
  __syncthreads();
  {
    const int ks = (tid & 31) * 8, rr = tid >> 5;
#pragma unroll
    for (int it = 0; it < 4; ++it) {
      const int row = rr + 16 * it;
      float f[8];
#pragma unroll
      for (int e = 0; e < 8; ++e) f[e] = tile[row * 257 + ks + e];
      *(uint4*)(dst + (size_t)(r0 + row) * K + k0 + ks) = pack8(f);
    }
  }
}

__device__ __forceinline__ void mod_item(const Params& P, int item, char* lds) {
  float* sc = (float*)lds;
  float* red = sc + 5 * 1024;
  const int tid = opq(threadIdx.x);
  __syncthreads();
  for (int i = tid; i < 5 * 1024; i += NT) {
    const int r = i >> 10, k = i & 1023;
    float v = (r < 4) ? P.c[r * 1024 + k] : P.c_ctx[k];
    sc[i] = v * sigm(v);
  }
  __syncthreads();
  const int nn = tid & 31, kg = tid >> 5;
  const int n = item * 32 + nn;
  float a0 = 0, a1 = 0, a2 = 0, a3 = 0, a4 = 0;
  for (int kk = 0; kk < 64; ++kk) {
    const int k = kg * 64 + kk;
    const float wv = P.w_ada[(size_t)k * 6144 + n];
    a0 += sc[k] * wv; a1 += sc[1024 + k] * wv; a2 += sc[2048 + k] * wv; a3 += sc[3072 + k] * wv; a4 += sc[4096 + k] * wv;
  }
  red[(kg * 5 + 0) * 32 + nn] = a0; red[(kg * 5 + 1) * 32 + nn] = a1; red[(kg * 5 + 2) * 32 + nn] = a2;
  red[(kg * 5 + 3) * 32 + nn] = a3; red[(kg * 5 + 4) * 32 + nn] = a4;
  __syncthreads();
  if (tid < 160) {
    const int r = tid >> 5, n2 = tid & 31;
    float s = 0.f;
#pragma unroll
    for (int g = 0; g < 16; ++g) s += red[(g * 5 + r) * 32 + n2];
    float* MOD = (float*)(P.ws + OFF_MOD);
    MOD[r * 6144 + item * 32 + n2] = s + P.b_ada[item * 32 + n2];
  }
}

__device__ __forceinline__ void lam_pow(float step, float are, float aim, int e, float& pr, float& pi) {
  const float mag = expf((float)e * step * are);
  double ang = (double)e * (double)step * (double)aim;
  ang -= 6.283185307179586476925 * rint(ang * 0.15915494309189533577);
  float s, c;
  __sincosf((float)ang, &s, &c);
  pr = mag * c; pi = mag * s;
}

__device__ __forceinline__ void s5tab_item(const Params& P, int item, char* lds) {
  const int tid = opq(threadIdx.x);
  const int tau = item & 31, g = (item >> 5) & 31, r = item >> 10;
  float* cfr = (float*)lds;
  float* cfi = cfr + 64;
  float* p0r = cfi + 64;
  float* p0i = p0r + 64;
  float* p1r = p0i + 64;
  float* p1i = p1r + 64;
  float* Gr = p1i + 64;
  float* Gi = Gr + 1024;
  float* Cr = Gi + 1024;
  float* Ci = Cr + 1024;
  const int rg = r * 32 + g;
  __syncthreads();
  if (tid < 64) {
    const int n = tid;
    const float step = expf(P.s5_log_step[rg]);
    const float are = P.s5_a_re[rg * 64 + n], aim = P.s5_a_im[rg * 64 + n];
    const float za = step * are;
    double zb = (double)step * (double)aim;
    zb -= 6.283185307179586476925 * rint(zb * 0.15915494309189533577);
    float sb, cb, sh, ch;
    __sincosf((float)zb, &sb, &cb);
    __sincosf((float)(0.5 * zb), &sh, &ch);
    const float em1 = expm1f(za);
    const float re1 = em1 * cb - 2.f * sh * sh;
    const float im1 = (1.f + em1) * sb;
    const float den = are * are + aim * aim;
    cfr[n] = (re1 * are + im1 * aim) / den;
    cfi[n] = (im1 * are - re1 * aim) / den;
    float pr, pi;
    lam_pow(step, are, aim, tau, pr, pi);
    p0r[n] = pr; p0i[n] = pi;
    lam_pow(step, are, aim, tau + 1, pr, pi);
    p1r[n] = pr; p1i[n] = pi;
  }
  for (int i = tid; i < 1024; i += NT) {
    Cr[i] = P.s5_c_re[(size_t)rg * 1024 + i];
    Ci[i] = P.s5_c_im[(size_t)rg * 1024 + i];
  }
  __syncthreads();
  for (int i = tid; i < 1024; i += NT) {
    const int n = i >> 4;
    const float br = P.s5_b_re[(size_t)rg * 1024 + i], bi = P.s5_b_im[(size_t)rg * 1024 + i];
    const float tr = cfr[n] * br - cfi[n] * bi, ti = cfr[n] * bi + cfi[n] * br;
    Gr[i] = p0r[n] * tr - p0i[n] * ti;
    Gi[i] = p0r[n] * ti + p0i[n] * tr;
  }
  __syncthreads();
  u16* MEND = (u16*)(P.ws + OFF_MEND);
  u16* MST = (u16*)(P.ws + OFF_MST);
  float* KTAB = (float*)(P.ws + OFF_KTAB);
  {
    const int ii = (r == 0) ? (31 - tau) : tau;
    for (int i = tid; i < 2048; i += NT) {
      const int part = i >> 10, n = (i >> 4) & 63, pi_ = i & 15;
      const float v = part ? Gi[n * 16 + pi_] : Gr[n * 16 + pi_];
      MEND[((size_t)g * 256 + r * 128 + part * 64 + n) * 512 + ii * 16 + pi_] = f2bf(v);
    }
  }
  if (tid < 256) {
    const int po = tid >> 4, pi_ = tid & 15;
    float s = 0.f;
    for (int n = 0; n < 64; ++n) s += Cr[po * 64 + n] * Gr[n * 16 + pi_] - Ci[po * 64 + n] * Gi[n * 16 + pi_];
    KTAB[(((size_t)rg) * 32 + tau) * 256 + tid] = s;
  }
  {
    const int jj = (r == 0) ? tau : (31 - tau);
    for (int i = tid; i < 2048; i += NT) {
      const int po = i >> 7, part = (i >> 6) & 1, n = i & 63;
      const float cr = Cr[po * 64 + n], ci = Ci[po * 64 + n];
      const float v = part ? -(cr * p1i[n] + ci * p1r[n]) : (cr * p1r[n] - ci * p1i[n]);
      MST[((size_t)g * 512 + jj * 16 + po) * 256 + r * 128 + part * 64 + n] = f2bf(v);
    }
  }
}

__device__ __forceinline__ void norm_row(const float* __restrict__ xr, const float* __restrict__ nw, const float* __restrict__ shift,
                                         const float* __restrict__ scale, u16* __restrict__ dst, int lane) {
  float4 v[4];
  float ss = 0.f;
#pragma unroll
  for (int it = 0; it < 4; ++it) {
    v[it] = *(const float4*)(xr + (it * 64 + lane) * 4);
    ss += v[it].x * v[it].x + v[it].y * v[it].y + v[it].z * v[it].z + v[it].w * v[it].w;
  }
  ss = wsum64(ss);
  const float rstd = rsqrtf(ss * (1.f / 1024.f) + 1e-6f);
#pragma unroll
  for (int it = 0; it < 4; ++it) {
    const int c = (it * 64 + lane) * 4;
    const float4 w4 = *(const float4*)(nw + c), sh = *(const float4*)(shift + c), sc = *(const float4*)(scale + c);
    const float y0 = v[it].x * rstd * w4.x * (1.f + sc.x) + sh.x;
    const float y1 = v[it].y * rstd * w4.y * (1.f + sc.y) + sh.y;
    const float y2 = v[it].z * rstd * w4.z * (1.f + sc.z) + sh.z;
    const float y3 = v[it].w * rstd * w4.w * (1.f + sc.w) + sh.w;
    uint2 o; o.x = pack2(y0, y1); o.y = pack2(y2, y3);
    *(uint2*)(dst + c) = o;
  }
}

__device__ __forceinline__ void norm1_item(const Params& P, int item) {
  const int lane = opq(threadIdx.x) & 63, w = opq(threadIdx.x) >> 6;
  const int row = item * 8 + w;
  const float* MOD = (const float*)(P.ws + OFF_MOD);
  const int bi = (row < 16384) ? (row >> 12) : 4;
  const float* xr = (row < 16384) ? (P.x + (size_t)row * 1024) : (P.ctx + (size_t)(row - 16384) * 1024);
  norm_row(xr, P.norm1_w, MOD + bi * 6144, MOD + bi * 6144 + 1024, (u16*)(P.ws + OFF_R2) + (size_t)row * 1024, lane);
}

__device__ __forceinline__ void mintra_item(const Params& P, int item) {
  const int tid = opq(threadIdx.x);
  const int rowg = item * 8 + (tid >> 6);
  const int g = rowg >> 9, nout = rowg & 511, j = nout >> 4, po = nout & 15;
  const int k0 = (tid & 63) * 8, i = k0 >> 4, pi0 = k0 & 15;
  const float* KTAB = (const float*)(P.ws + OFF_KTAB);
  float f[8];
#pragma unroll
  for (int e = 0; e < 8; ++e) f[e] = 0.f;
  if (i <= j) {
    const float* kp = KTAB + (((size_t)(0 * 32 + g)) * 32 + (j - i)) * 256 + po * 16 + pi0;
#pragma unroll
    for (int e = 0; e < 8; ++e) f[e] += kp[e];
  }
  if (i >= j) {
    const float* kp = KTAB + (((size_t)(1 * 32 + g)) * 32 + (i - j)) * 256 + po * 16 + pi0;
#pragma unroll
    for (int e = 0; e < 8; ++e) f[e] += kp[e];
  }
  if (i == j) {
    const float dv = P.s5_d[g * 16 + po];
#pragma unroll
    for (int e = 0; e < 8; ++e) if (pi0 + e == po) f[e] += dv;
  }
  u16* MI = (u16*)(P.ws + OFF_MINTRA);
  *(uint4*)(MI + (size_t)rowg * 512 + k0) = pack8(f);
}

__device__ __forceinline__ void inproj_tile(const Params& P, int t, char* lds) {
  int mt, nt;
  if (t < 1344) { nt = t / 64; mt = t % 64; }
  else {
    const int tt = t - 1344; mt = 64 + (tt & 3);
    const int ni = tt >> 2;
    nt = (ni < 8) ? (4 + ni) : ((ni < 12) ? (16 + ni - 8) : 20);
  }
  const int m0 = mt * 256, n0 = nt * 128;
  f32x4 acc[4][4];
  acc_zero(acc);
  gemm_main((const u16*)(P.ws + OFF_R2) + (size_t)m0 * 1024, 1024, (const u16*)(P.ws + OFF_WT_IN) + (size_t)n0 * 1024, 1024, 1024, acc, (u16*)lds);
  TILE_COORDS
  if (nt < 12) {
    u16* QKV = (u16*)(P.ws + OFF_R3);
#pragma unroll
    for (int i = 0; i < 4; ++i)
#pragma unroll
      for (int j = 0; j < 4; ++j)
#pragma unroll
        for (int e = 0; e < 4; ++e) QKV[(size_t)TROW(m0, i, e) * 1536 + TCOL(n0, j)] = f2bf(acc[i][j][e]);
  } else if (nt < 16) {
    u16* Z = (u16*)(P.ws + OFF_Z);
#pragma unroll
    for (int i = 0; i < 4; ++i)
#pragma unroll
      for (int j = 0; j < 4; ++j)
#pragma unroll
        for (int e = 0; e < 4; ++e) Z[(size_t)TROW(m0, i, e) * 512 + TCOL(n0, j) - 1536] = f2bf(acc[i][j][e]);
  } else if (nt < 20) {
    u16* U5 = (u16*)(P.ws + OFF_U5);
#pragma unroll
    for (int i = 0; i < 4; ++i)
#pragma unroll
      for (int j = 0; j < 4; ++j)
#pragma unroll
        for (int e = 0; e < 4; ++e) {
          const int cc = TCOL(n0, j) - 2048;
          U5[((size_t)(cc >> 4) * 17408 + TROW(m0, i, e)) * 16 + (cc & 15)] = f2bf(acc[i][j][e]);
        }
  } else {
    float* BA = (float*)(P.ws + OFF_BA);
#pragma unroll
    for (int i = 0; i < 4; ++i)
#pragma unroll
      for (int j = 0; j < 4; ++j)
#pragma unroll
        for (int e = 0; e < 4; ++e) {
          const int cc = TCOL(n0, j) - 2560;
          if (cc < 16) BA[(size_t)TROW(m0, i, e) * 16 + cc] = acc[i][j][e];
        }
  }
}

template <int DIR>
__device__ __forceinline__ void solve_cols(const Params& P, int itb, int c, const float* Lt, const float* bpp, const float* gcp,
                                           const u16* Vs, const u16* Ks) {
  float sol[64];
  const float* bp_ = bpp + DIR * 64;
  const float* gc_ = gcp + DIR * 64;
  if (c < 128) {
    const u16* vp = Vs + c;
#pragma unroll
    for (int p = 0; p < 64; ++p) sol[p] = bp_[p] * bf2f(vp[(DIR ? (63 - p) : p) * 136]);
  } else {
    const u16* kp = Ks + (c - 128);
#pragma unroll
    for (int p = 0; p < 64; ++p) sol[p] = bp_[p] * __expf(gc_[p]) * bf2f(kp[(DIR ? (63 - p) : p) * 136]);
  }
  const float* Lr = Lt + opq(DIR * 4096);
#ifdef SOLVE_TWICE
  float sol0[64];
#pragma unroll
  for (int p = 0; p < 64; ++p) sol0[p] = sol[p];
#pragma unroll
  for (int j = 0; j < 63; ++j) {
    const float sj = sol0[j];
#pragma unroll
    for (int i = j + 1; i < 64; ++i) sol0[i] -= Lr[j * 64 + i] * sj;
  }
  if (sol0[63] == 12345.678f) sol[0] += 1.f;
#endif
#pragma unroll
  for (int j = 0; j < 63; ++j) {
    const float sj = sol[j];
#pragma unroll
    for (int i = j + 1; i < 64; ++i) sol[i] -= Lr[j * 64 + i] * sj;
  }
  const size_t it2 = (size_t)(itb + DIR);
  if (c < 128) {
    u16* UF = (u16*)(P.ws + OFF_UF) + (it2 * 128 + c) * 64;
#pragma unroll
    for (int q = 0; q < 8; ++q) *(uint4*)(UF + q * 8) = pack8(sol + q * 8);
  } else {
    u16* Wg = (u16*)(P.ws + OFF_R2) + it2 * 8192 + (c - 128);
#pragma unroll
    for (int p = 0; p < 64; ++p) Wg[p * 128] = f2bf(-sol[p]);
  }
}

__device__ __forceinline__ void delta_prep_item(const Params& P, int item, char* lds) {
  const int tid = opq(threadIdx.x), lane = tid & 63, wv = tid >> 6, fr = lane & 15, fq = lane >> 4;
  const int cid = item >> 2, h = item & 3;
  const int row0 = cid * 64;
  int seq_lo, seq_hi;
  if (cid < 256) { seq_lo = (cid >> 6) * 4096; seq_hi = seq_lo + 4096; }
  else { seq_lo = 16384 + ((cid - 256) >> 2) * 256; seq_hi = seq_lo + 256; }
  u16* Qs = (u16*)(lds + opq(0));
  u16* Ks = (u16*)(lds + opq(17408));
  u16* Vs = (u16*)(lds + opq(34816));
  float* KKs = (float*)(lds + opq(52224));
  float* QKs = (float*)(lds + opq(69632));
  float* Lt = (float*)(lds + opq(87040));
  float* gtok = (float*)(lds + opq(119808));
  float* btok = gtok + 128;
  float* gcp = btok + 128;
  float* bpp = gcp + 128;
  u16* QKN = (u16*)((char*)P.out + OFF_QKN);
  __syncthreads();
  {
    const int j = tid >> 3, sg = tid & 7;
    const int row = row0 + j;
    const bool hm = (row - 1 >= seq_lo), hp = (row + 1 < seq_hi);
    const u16* qkv = (const u16*)(P.ws + OFF_R3);
#pragma unroll
    for (int s = 0; s < 3; ++s) {
      const int col = s * 512 + h * 128 + sg * 16;
      const u16* p0 = qkv + (size_t)row * 1536 + col;
      float y[16];
      float ssq = 0.f;
#pragma unroll
      for (int hh = 0; hh < 2; ++hh) {
        const uint4 c0 = *(const uint4*)(p0 + hh * 8);
        uint4 m0 = *(const uint4*)(p0 - (hm ? 1536 : 0) + hh * 8);
        uint4 n0 = *(const uint4*)(p0 + (hp ? 1536 : 0) + hh * 8);
        m0.x = hm ? m0.x : 0u; m0.y = hm ? m0.y : 0u; m0.z = hm ? m0.z : 0u; m0.w = hm ? m0.w : 0u;
        n0.x = hp ? n0.x : 0u; n0.y = hp ? n0.y : 0u; n0.z = hp ? n0.z : 0u; n0.w = hp ? n0.w : 0u;
        float fc[8], fm[8], fn[8];
        unpack8(c0, fc); unpack8(m0, fm); unpack8(n0, fn);
        const float* cwp = P.dn_conv_w + col + hh * 8;
        float cw0[8], cw1[8], cw2[8];
        {
          const float4 t0 = *(const float4*)(cwp), t1 = *(const float4*)(cwp + 4);
          const float4 t2 = *(const float4*)(cwp + 1536), t3 = *(const float4*)(cwp + 1540);
          const float4 t4 = *(const float4*)(cwp + 3072), t5 = *(const float4*)(cwp + 3076);
          cw0[0] = t0.x; cw0[1] = t0.y; cw0[2] = t0.z; cw0[3] = t0.w; cw0[4] = t1.x; cw0[5] = t1.y; cw0[6] = t1.z; cw0[7] = t1.w;
          cw1[0] = t2.x; cw1[1] = t2.y; cw1[2] = t2.z; cw1[3] = t2.w; cw1[4] = t3.x; cw1[5] = t3.y; cw1[6] = t3.z; cw1[7] = t3.w;
          cw2[0] = t4.x; cw2[1] = t4.y; cw2[2] = t4.z; cw2[3] = t4.w; cw2[4] = t5.x; cw2[5] = t5.y; cw2[6] = t5.z; cw2[7] = t5.w;
        }
#pragma unroll
        for (int e = 0; e < 8; ++e) {
          const float v = cw0[e] * fm[e] + cw1[e] * fc[e] + cw2[e] * fn[e];
          const float yy = v * sigm(v);
          y[hh * 8 + e] = yy;
          ssq += yy * yy;
        }
      }
      if (s < 2) {
        ssq += __shfl_xor(ssq, 1, 64); ssq += __shfl_xor(ssq, 2, 64); ssq += __shfl_xor(ssq, 4, 64);
        const float sc = rsqrtf(ssq + 1e-6f) * ((s == 0) ? 0.08838834764831845f : 1.f);
#pragma unroll
        for (int e = 0; e < 16; ++e) y[e] *= sc;
      }
      u16* dl = ((s == 0) ? Qs : ((s == 1) ? Ks : Vs)) + j * 136 + sg * 16;
      const uint4 o0 = pack8(y), o1 = pack8(y + 8);
      *(uint4*)dl = o0; *(uint4*)(dl + 8) = o1;
      if (s < 2) {
        u16* dg = QKN + (size_t)row * 1024 + s * 512 + h * 128 + sg * 16;
        *(uint4*)dg = o0; *(uint4*)(dg + 8) = o1;
      }
    }
  }
  if (tid < 128) {
    const int j = tid & 63, dir = tid >> 6;
    const float* BA = (const float*)(P.ws + OFF_BA) + (size_t)(row0 + j) * 16;
    const float bl = BA[dir * 4 + h], al = BA[8 + dir * 4 + h];
    const float xx = al + P.dn_dt_bias[dir * 4 + h];
    const float sp = (xx > 20.f) ? xx : log1pf(expf(xx));
    gtok[dir * 64 + j] = -expf(P.dn_a_log[dir * 4 + h]) * sp;
    btok[dir * 64 + j] = 1.f / (1.f + expf(-bl));
  }
  __syncthreads();
  if (tid < 2) {
    const int dir = tid;
    float a = 0.f;
    for (int p = 0; p < 64; ++p) {
      const int tk = dir ? (63 - p) : p;
      a += gtok[dir * 64 + tk];
      gcp[dir * 64 + p] = a;
      bpp[dir * 64 + p] = btok[dir * 64 + tk];
    }
  }
  {
#pragma unroll
    for (int q = 0; q < 4; ++q) {
      const int t = wv * 4 + q;
      const int which = t >> 4, mi = (t >> 2) & 3, ni = t & 3;
      const u16* Am = (which ? Qs : Ks) + (mi * 16 + fr) * 136 + fq * 8;
      const u16* Bm = Ks + (ni * 16 + fr) * 136 + fq * 8;
      f32x4 a4 = {0.f, 0.f, 0.f, 0.f};
#pragma unroll
      for (int kk = 0; kk < 4; ++kk)
        a4 = __builtin_amdgcn_mfma_f32_16x16x32_bf16(*(const bf16x8*)(Am + kk * 32), *(const bf16x8*)(Bm + kk * 32), a4, 0, 0, 0);
      float* dst = which ? QKs : KKs;
#pragma unroll
      for (int e = 0; e < 4; ++e) dst[(mi * 16 + fq * 4 + e) * 68 + ni * 16 + fr] = a4[e];
    }
  }
  __syncthreads();
  const int itb = item * 2;
  {
    u16* AQ = (u16*)((char*)P.out + OFF_AQ);
    for (int idx = tid; idx < 8192; idx += NT) {
      const int dir = idx >> 12, p = (idx >> 6) & 63, s = idx & 63;
      const int tp = dir ? (63 - p) : p, ts = dir ? (63 - s) : s;
      const float dg = gcp[dir * 64 + p] - gcp[dir * 64 + s];
      const float dec = (p >= s) ? __expf(dg) : 0.f;
      AQ[((size_t)(itb + dir) * 64 + p) * 64 + s] = f2bf(QKs[tp * 68 + ts] * dec);
    }
    for (int idx = tid; idx < 8192; idx += NT) {
      const int dir = idx >> 12, s = (idx >> 6) & 63, p = idx & 63;
      const int tp = dir ? (63 - p) : p, ts = dir ? (63 - s) : s;
      const float dg = gcp[dir * 64 + p] - gcp[dir * 64 + s];
      const float lv = (p > s) ? bpp[dir * 64 + p] * KKs[ts * 68 + tp] * __expf(dg) : 0.f;
      Lt[dir * 4096 + s * 64 + p] = lv;
    }
    if (tid < 128) {
      float* GC = (float*)(P.ws + OFF_GC);
      GC[(size_t)(itb + (tid >> 6)) * 64 + (tid & 63)] = gcp[tid];
    }
  }
  __syncthreads();
  if (tid < 256) solve_cols<0>(P, itb, tid, Lt, bpp, gcp, Vs, Ks);
  else solve_cols<1>(P, itb, tid - 256, Lt, bpp, gcp, Vs, Ks);
}

__device__ __forceinline__ void s5end_tile(const Params& P, int t, char* lds) {
  const int g = t / 6, mt = (t % 6) >> 1, nt = t & 1;
  const int m0 = mt * 256, n0 = nt * 128;
  f32x4 acc[4][4];
  acc_zero(acc);
  gemm_main((const u16*)(P.ws + OFF_U5) + ((size_t)g * 544 + m0) * 512, 512,
            (const u16*)(P.ws + OFF_MEND) + ((size_t)g * 256 + n0) * 512, 512, 512, acc, (u16*)lds);
  TILE_COORDS
  float* E = (float*)(P.ws + OFF_E);
#pragma unroll
  for (int i = 0; i < 4; ++i)
#pragma unroll
    for (int j = 0; j < 4; ++j)
#pragma unroll
      for (int e = 0; e < 4; ++e) {
        const int row = TROW(m0, i, e);
        if (row < 544) E[((size_t)g * 544 + row) * 256 + TCOL(n0, j)] = acc[i][j][e];
      }
}

__device__ __forceinline__ void delta_scan_block(const Params& P, int sb, char* lds) {
  const int tid = opq(threadIdx.x), lane = tid & 63, w = tid >> 6, fr = lane & 15, fq = lane >> 4;
  const int bhd = sb & 31, dvq = sb >> 5;
  const int b = bhd >> 3, h = (bhd >> 1) & 3, dir = bhd & 1;
  const int wd = w & 1, wq = w >> 1;
  const int dv0 = dvq * 32 + wd * 16;
  u16* Wl = (u16*)(lds + opq(0));
  u16* QTl = (u16*)(lds + opq(17408));
  u16* KTl = (u16*)(lds + opq(34816));
  u16* AQl = (u16*)(lds + opq(53248));
  u16* ST = (u16*)(lds + opq(62464));
  u16* VT = (u16*)(lds + opq(71168));
  __syncthreads();
  for (int i = tid; i < 32 * 136 / 2; i += NT) ((uint32_t*)ST)[i] = 0u;
  f32x4 accS0 = {0.f, 0.f, 0.f, 0.f}, accS1 = {0.f, 0.f, 0.f, 0.f};
  const u16* QKN = (const u16*)((const char*)P.out + OFF_QKN);
  const u16* AQg = (const u16*)((const char*)P.out + OFF_AQ);
  const u16* Wg = (const u16*)(P.ws + OFF_R2);
  const u16* UFg = (const u16*)(P.ws + OFF_UF);
  const float* GC = (const float*)(P.ws + OFF_GC);
  u16* Og = (u16*)(P.ws + OFF_O);

  uint4 rw0, rw1, rq0, rq1, rk0, rk1, ra;
  float gq0, gq1, gk, g63;
  uint2 ru;
  int cur_row0 = 0, cur_lat = 0;
  int nxt_row0 = 0, nxt_lat = 0;

#define SCAN_PF_ONE(i)                                                                             \
    {                                                                                              \
      const int id = tid + (i) * 512;                                                              \
      const int p = id >> 4, seg = id & 15;                                                        \
      const int tk = dir ? (63 - p) : p;                                                           \
      rw##i = *(const uint4*)(Wg + it2__ * 8192 + p * 128 + seg * 8);                              \
      rq##i = *(const uint4*)(QKN + (size_t)(nxt_row0 + tk) * 1024 + h * 128 + seg * 8);           \
      gq##i = GC[it2__ * 64 + p];                                                                  \
      const int s = id & 63, sg2 = id >> 6;                                                        \
      const int tks = dir ? (63 - s) : s;                                                          \
      rk##i = *(const uint4*)(QKN + (size_t)(nxt_row0 + tks) * 1024 + 512 + h * 128 + sg2 * 8);    \
    }
#define SCAN_PREFETCH(n_)                                                                          \
  {                                                                                                \
    const int n__ = (n_);                                                                          \
    int cid__;                                                                                     \
    if (n__ < 4) { cid__ = 256 + b * 4 + (dir ? (3 - n__) : n__); nxt_lat = 0; }                   \
    else { const int m__ = n__ - 4; cid__ = b * 64 + (dir ? (63 - m__) : m__); nxt_lat = 1; }      \
    nxt_row0 = cid__ * 64;                                                                         \
    const size_t it2__ = (size_t)((cid__ * 4 + h) * 2 + dir);                                      \
    SCAN_PF_ONE(0)                                                                                 \
    SCAN_PF_ONE(1)                                                                                 \
    gk = GC[it2__ * 64 + (tid & 63)];                                                              \
    g63 = GC[it2__ * 64 + 63];                                                                     \
    ra = *(const uint4*)(AQg + it2__ * 4096 + (tid >> 3) * 64 + (tid & 7) * 8);                    \
    ru = *(const uint2*)(UFg + (it2__ * 128 + dv0 + fr) * 64 + wq * 16 + fq * 4);                  \
  }

  SCAN_PREFETCH(0)
  for (int n = 0; n < 68; ++n) {
    cur_row0 = nxt_row0; cur_lat = nxt_lat;
    const float gl = __expf(g63);
    const float sk = __expf(g63 - gk);
#define SCAN_STAGE_ONE(i)                                                     \
    {                                                                         \
      const int id = tid + (i) * 512;                                         \
      const int p = id >> 4, seg = id & 15;                                   \
      *(uint4*)(Wl + p * 136 + seg * 8) = rw##i;                              \
      float f[8];                                                             \
      unpack8(rq##i, f);                                                      \
      const float sq = __expf(gq##i);                                         \
      f[0] *= sq; f[1] *= sq; f[2] *= sq; f[3] *= sq; f[4] *= sq; f[5] *= sq; f[6] *= sq; f[7] *= sq; \
      *(uint4*)(QTl + p * 136 + seg * 8) = pack8(f);                          \
      const int s = id & 63, sg2 = id >> 6;                                   \
      unpack8(rk##i, f);                                                      \
      u16* kd = KTl + (sg2 * 8) * 72 + s;                                     \
      kd[0 * 72] = f2bf(f[0] * sk); kd[1 * 72] = f2bf(f[1] * sk); kd[2 * 72] = f2bf(f[2] * sk); kd[3 * 72] = f2bf(f[3] * sk); \
      kd[4 * 72] = f2bf(f[4] * sk); kd[5 * 72] = f2bf(f[5] * sk); kd[6 * 72] = f2bf(f[6] * sk); kd[7 * 72] = f2bf(f[7] * sk); \
    }
    SCAN_STAGE_ONE(0)
    SCAN_STAGE_ONE(1)
#undef SCAN_STAGE_ONE
    *(uint4*)(AQl + (tid >> 3) * 72 + (tid & 7) * 8) = ra;
    f32x4 av = f32x4{lo16(ru.x), hi16(ru.x), lo16(ru.y), hi16(ru.y)};
    f32x4 ao = f32x4{0.f, 0.f, 0.f, 0.f};
    __syncthreads();
    if (n + 1 < 68) SCAN_PREFETCH(n + 1)
#pragma unroll
    for (int kk = 0; kk < 4; ++kk) {
      const bf16x8 bS = *(const bf16x8*)(ST + (wd * 16 + fr) * 136 + kk * 32 + fq * 8);
      const bf16x8 a1 = *(const bf16x8*)(Wl + (wq * 16 + fr) * 136 + kk * 32 + fq * 8);
      av = __builtin_amdgcn_mfma_f32_16x16x32_bf16(a1, bS, av, 0, 0, 0);
      const bf16x8 a2 = *(const bf16x8*)(QTl + (wq * 16 + fr) * 136 + kk * 32 + fq * 8);
      ao = __builtin_amdgcn_mfma_f32_16x16x32_bf16(a2, bS, ao, 0, 0, 0);
    }
    {
      uint2 v; v.x = pack2(av[0], av[1]); v.y = pack2(av[2], av[3]);
      *(uint2*)(VT + (wd * 16 + fr) * 72 + wq * 16 + fq * 4) = v;
    }
    __syncthreads();
    accS0[0] *= gl; accS0[1] *= gl; accS0[2] *= gl; accS0[3] *= gl;
    accS1[0] *= gl; accS1[1] *= gl; accS1[2] *= gl; accS1[3] *= gl;
#pragma unroll
    for (int ks = 0; ks < 2; ++ks) {
      const bf16x8 bV = *(const bf16x8*)(VT + (wd * 16 + fr) * 72 + ks * 32 + fq * 8);
      const bf16x8 a1 = *(const bf16x8*)(AQl + (wq * 16 + fr) * 72 + ks * 32 + fq * 8);
      ao = __builtin_amdgcn_mfma_f32_16x16x32_bf16(a1, bV, ao, 0, 0, 0);
      const bf16x8 k0 = *(const bf16x8*)(KTl + ((2 * wq) * 16 + fr) * 72 + ks * 32 + fq * 8);
      accS0 = __builtin_amdgcn_mfma_f32_16x16x32_bf16(k0, bV, accS0, 0, 0, 0);
      const bf16x8 k1 = *(const bf16x8*)(KTl + ((2 * wq + 1) * 16 + fr) * 72 + ks * 32 + fq * 8);
      accS1 = __builtin_amdgcn_mfma_f32_16x16x32_bf16(k1, bV, accS1, 0, 0, 0);
    }
    {
      uint2 v; v.x = pack2(accS0[0], accS0[1]); v.y = pack2(accS0[2], accS0[3]);
      *(uint2*)(ST + (wd * 16 + fr) * 136 + (2 * wq) * 16 + fq * 4) = v;
      v.x = pack2(accS1[0], accS1[1]); v.y = pack2(accS1[2], accS1[3]);
      *(uint2*)(ST + (wd * 16 + fr) * 136 + (2 * wq + 1) * 16 + fq * 4) = v;
    }
    if (cur_lat) {
#pragma unroll
      for (int e = 0; e < 4; ++e) {
        const int p = wq * 16 + fq * 4 + e;
        const int tk = dir ? (63 - p) : p;
        Og[((size_t)dir * 16384 + cur_row0 + tk) * 512 + h * 128 + dv0 + fr] = f2bf(ao[e]);
      }
    }
    __syncthreads();
  }
#undef SCAN_PREFETCH
#undef SCAN_PF_ONE
}

__device__ __forceinline__ void s5_carry_block(const Params& P, int cb) {
  const int idx = cb * NT + opq(threadIdx.x);
  const int n = idx & 63, g = (idx >> 6) & 31, r = (idx >> 11) & 1, b = idx >> 12;
  const int rg = r * 32 + g;
  const float step = expf(P.s5_log_step[rg]);
  float lr, li;
  lam_pow(step, P.s5_a_re[rg * 64 + n], P.s5_a_im[rg * 64 + n], 32, lr, li);
  const float* E = (const float*)(P.ws + OFF_E) + (size_t)g * 544 * 256 + r * 128 + n;
  u16* XIN = (u16*)(P.ws + OFF_XIN) + (size_t)g * 512 * 256 + r * 128 + n;
  float xr = 0.f, xi = 0.f;
  for (int k = 0; k < 8; ++k) {
    const int cc = r ? (7 - k) : k;
    const int row = 512 + b * 8 + cc;
    const float er = E[(size_t)row * 256], ei = E[(size_t)row * 256 + 64];
    const float nr = lr * xr - li * xi + er, ni = lr * xi + li * xr + ei;
    xr = nr; xi = ni;
  }
  for (int k = 0; k < 128; ++k) {
    const int cc = r ? (127 - k) : k;
    const int row = b * 128 + cc;
    XIN[(size_t)row * 256] = f2bf(xr);
    XIN[(size_t)row * 256 + 64] = f2bf(xi);
    const float er = E[(size_t)row * 256], ei = E[(size_t)row * 256 + 64];
    const float nr = lr * xr - li * xi + er, ni = lr * xi + li * xr + ei;
    xr = nr; xi = ni;
  }
}

__device__ __forceinline__ void s5out_tile(const Params& P, int t, char* lds) {
  const int g = t >> 3, mt = (t >> 2) & 1, nt = t & 3;
  const int m0 = mt * 256, n0 = nt * 128;
  f32x4 acc[4][4];
  acc_zero(acc);
  gemm_main((const u16*)(P.ws + OFF_XIN) + ((size_t)g * 512 + m0) * 256, 256,
            (const u16*)(P.ws + OFF_MST) + ((size_t)g * 512 + n0) * 256, 256, 256, acc, (u16*)lds);
  gemm_main((const u16*)(P.ws + OFF_U5) + ((size_t)g * 544 + m0) * 512, 512,
            (const u16*)(P.ws + OFF_MINTRA) + ((size_t)g * 512 + n0) * 512, 512, 512, acc, (u16*)lds);
  TILE_COORDS
  u16* YB = (u16*)(P.ws + OFF_YB);
#pragma unroll
  for (int i = 0; i < 4; ++i)
#pragma unroll
    for (int j = 0; j < 4; ++j)
#pragma unroll
      for (int e = 0; e < 4; ++e) {
        const int row = TROW(m0, i, e), nn = TCOL(n0, j);
        const int token = row * 32 + (nn >> 4);
        YB[(size_t)token * 512 + g * 16 + (nn & 15)] = f2bf(gelu_tanh(acc[i][j][e]));
      }
}

__device__ __forceinline__ void delta_post_item(const Params& P, int item) {
  const int lane = opq(threadIdx.x) & 63, w = opq(threadIdx.x) >> 6;
  const int row = item * 8 + w;
  const u16* O = (const u16*)(P.ws + OFF_O);
  const uint4 o0 = *(const uint4*)(O + (size_t)row * 512 + lane * 8);
  const uint4 o1 = *(const uint4*)(O + ((size_t)16384 + row) * 512 + lane * 8);
  const uint4 zz = *(const uint4*)((const u16*)(P.ws + OFF_Z) + (size_t)row * 512 + lane * 8);
  float a[8], bq[8], z[8];
  unpack8(o0, a); unpack8(o1, bq); unpack8(zz, z);
  float ss = 0.f;
#pragma unroll
  for (int e = 0; e < 8; ++e) { a[e] += bq[e]; ss += a[e] * a[e]; }
  ss += __shfl_xor(ss, 1, 64); ss += __shfl_xor(ss, 2, 64); ss += __shfl_xor(ss, 4, 64); ss += __shfl_xor(ss, 8, 64);
  const float rstd = rsqrtf(ss * (1.f / 128.f) + 1e-6f);
  const float* nw = P.dn_norm_w + (lane & 15) * 8;
  float y[8];
#pragma unroll
  for (int e = 0; e < 8; ++e) y[e] = a[e] * rstd * nw[e] * (z[e] * sigm(z[e]));
  *(uint4*)((u16*)(P.ws + OFF_YA) + (size_t)row * 512 + lane * 8) = pack8(y);
}

__device__ __forceinline__ void glu_tile(const Params& P, int t, char* lds) {
  const int nt = t >> 6, mt = t & 63;
  const int m0 = mt * 256, n0 = nt * 128;
  f32x4 acc[4][4];
  acc_zero(acc);
  gemm_main((const u16*)(P.ws + OFF_YB) + (size_t)m0 * 512, 512, (const u16*)(P.ws + OFF_WT_GLU) + (size_t)n0 * 512, 512, 512, acc, (u16*)lds);
  TILE_COORDS
  u16* YG = (u16*)(P.ws + OFF_YG);
#pragma unroll
  for (int i = 0; i < 4; ++i)
#pragma unroll
    for (int j = 0; j < 2; ++j) {
      const int oc = nt * 64 + wn_ * 32 + j * 16 + fr_;
      const float bv = P.b_glu[oc], bg = P.b_glu[512 + oc];
#pragma unroll
      for (int e = 0; e < 4; ++e) {
        const float val = acc[i][j][e] + bv, gt = acc[i][j + 2][e] + bg;
        YG[(size_t)TROW(m0, i, e) * 512 + oc] = f2bf(val * sigm(gt));
      }
    }
}

__device__ __forceinline__ void gates_tile(const Params& P, int t, char* lds) {
  const int nt = t >> 6, mt = t & 63;
  const int m0 = mt * 256, n0 = nt * 128;
  f32x4 acc[4][4];
  acc_zero(acc);
  gemm_main((const u16*)(P.ws + OFF_R2) + (size_t)m0 * 1024, 1024, (const u16*)(P.ws + OFF_WT_IN) + (size_t)(2688 + n0) * 1024, 1024, 1024, acc, (u16*)lds);
  TILE_COORDS
  u16* SG = (u16*)(P.ws + OFF_SG);
#pragma unroll
  for (int i = 0; i < 4; ++i)
#pragma unroll
    for (int j = 0; j < 4; ++j)
#pragma unroll
      for (int e = 0; e < 4; ++e) SG[(size_t)TROW(m0, i, e) * 2048 + TCOL(n0, j)] = f2bf(sigm(acc[i][j][e]));
}

__device__ __forceinline__ void mix_tile(const Params& P, int t, char* lds) {
  const int nt = t >> 6, mt = t & 63;
  const int m0 = mt * 256, n0 = nt * 128;
  const u16* SG = (const u16*)(P.ws + OFF_SG);
  f32x4 acc[4][4];
  u16* MIX = (u16*)(P.ws + OFF_MIX);
  acc_zero(acc);
  gemm_main((const u16*)(P.ws + OFF_YA) + (size_t)m0 * 512, 512, (const u16*)(P.ws + OFF_WT_AOUT) + (size_t)n0 * 512, 512, 512, acc, (u16*)lds);
  {
    TILE_COORDS
#pragma unroll
    for (int i = 0; i < 4; ++i)
#pragma unroll
      for (int j = 0; j < 4; ++j)
#pragma unroll
        for (int e = 0; e < 4; ++e) {
          const int r = TROW(m0, i, e), col = TCOL(n0, j);
          MIX[(size_t)r * 1024 + col] = f2bf(bf2f(SG[(size_t)r * 2048 + col]) * acc[i][j][e]);
        }
  }
  acc_zero(acc);
  gemm_main((const u16*)(P.ws + OFF_YG) + (size_t)m0 * 512, 512, (const u16*)(P.ws + OFF_WT_BOUT) + (size_t)n0 * 512, 512, 512, acc, (u16*)lds);
  {
    TILE_COORDS
#pragma unroll
    for (int i = 0; i < 4; ++i)
#pragma unroll
      for (int j = 0; j < 4; ++j)
#pragma unroll
        for (int e = 0; e < 4; ++e) {
          const int r = TROW(m0, i, e), col = TCOL(n0, j);
          const size_t o = (size_t)r * 1024 + col;
          MIX[o] = f2bf(bf2f(MIX[o]) + bf2f(SG[(size_t)r * 2048 + 1024 + col]) * acc[i][j][e]);
        }
  }
}

__device__ __forceinline__ void wo_tile(const Params& P, int t, char* lds) {
  const int nt = t >> 6, mt = t & 63;
  const int m0 = mt * 256, n0 = nt * 128;
  f32x4 acc[4][4];
  acc_zero(acc);
  gemm_main((const u16*)(P.ws + OFF_MIX) + (size_t)m0 * 1024, 1024, (const u16*)(P.ws + OFF_WT_O) + (size_t)n0 * 1024, 1024, 1024, acc, (u16*)lds);
  TILE_COORDS
  const float* MOD = (const float*)(P.ws + OFF_MOD) + (m0 >> 12) * 6144 + 2 * 1024;
#pragma unroll
  for (int j = 0; j < 4; ++j) {
    const int col = TCOL(n0, j);
    const float gate = MOD[col];
#pragma unroll
    for (int i = 0; i < 4; ++i)
#pragma unroll
      for (int e = 0; e < 4; ++e) {
        const size_t o = (size_t)TROW(m0, i, e) * 1024 + col;
        P.out[o] = P.x[o] + gate * acc[i][j][e];
      }
  }
}

__device__ __forceinline__ void norm2_item(const Params& P, int item) {
  const int lane = opq(threadIdx.x) & 63, w = opq(threadIdx.x) >> 6;
  const int row = item * 8 + w;
  const float* MOD = (const float*)(P.ws + OFF_MOD) + (row >> 12) * 6144;
  norm_row(P.out + (size_t)row * 1024, P.norm2_w, MOD + 3 * 1024, MOD + 4 * 1024, (u16*)(P.ws + OFF_R2) + (size_t)row * 1024, lane);
}

__device__ __forceinline__ void up_tile(const Params& P, int t, int hh, char* lds) {
  const int nt = t >> 6, mt = t & 63;
  const int m0 = mt * 256, n0 = nt * 128;
  f32x4 acc[4][4];
  acc_zero(acc);
  gemm_main((const u16*)(P.ws + OFF_R2) + (size_t)m0 * 1024, 1024,
            (const u16*)(P.ws + OFF_WT_UP) + ((size_t)hh * 2816 + n0) * 1024, 1024, 1024, acc, (u16*)lds);
  TILE_COORDS
  u16* UPH = (u16*)(P.ws + OFF_UPH);
#pragma unroll
  for (int i = 0; i < 4; ++i)
#pragma unroll
    for (int j = 0; j < 4; ++j)
#pragma unroll
      for (int e = 0; e < 4; ++e) UPH[(size_t)TROW(m0, i, e) * 2816 + TCOL(n0, j)] = f2bf(acc[i][j][e]);
}

#define CG_LD(ci, dy)                                                                       \
    {                                                                                       \
      const int xc = x0 - 1 + (ci);                                                         \
      const bool cok = (xc >= 0) && (xc <= 63);                                             \
      const bool rok = ((dy) == 1) || ((dy) == 0 ? r0ok : r2ok);                            \
      const int yy = rok ? (y + (dy) - 1) : y;                                              \
      const u16* src = UPH + (base + (size_t)yy * 64 + (cok ? xc : x0)) * 2816 + c4;        \
      uint2 g__ = *(const uint2*)src;                                                       \
      uint2 v__ = *(const uint2*)(src + 1408);                                              \
      const bool ok = cok && rok;                                                           \
      g__.x = ok ? g__.x : 0u; g__.y = ok ? g__.y : 0u;                                     \
      v__.x = ok ? v__.x : 0u; v__.y = ok ? v__.y : 0u;                                     \
      gg[ci][dy] = g__; vv[ci][dy] = v__;                                                   \
    }
__device__ __forceinline__ void convgate_item(const Params& P, int item, int hh) {
  const int tid = opq(threadIdx.x);
  if (tid >= 352) return;
  const int xo = item & 15, y = (item >> 4) & 63, b = item >> 10;
  const int c4 = tid * 4;
  const u16* UPH = (const u16*)(P.ws + OFF_UPH);
  u16* G = (u16*)(P.ws + OFF_G);
  const size_t base = (size_t)b * 4096;
  const bool r0ok = (y > 0), r2ok = (y < 63);
  const int x0 = xo * 4;
  uint2 gg[6][3], vv[6][3];
#pragma unroll
  for (int ci = 0; ci < 6; ++ci) {
    CG_LD(ci, 0)
    CG_LD(ci, 1)
    CG_LD(ci, 2)
  }
  float wg[9][4], wv[9][4];
#pragma unroll
  for (int k = 0; k < 9; ++k) {
    const float4 a = *(const float4*)(P.ffn_conv_w + (size_t)k * 5632 + hh * 1408 + c4);
    const float4 bq = *(const float4*)(P.ffn_conv_w + (size_t)k * 5632 + 2816 + hh * 1408 + c4);
    wg[k][0] = a.x; wg[k][1] = a.y; wg[k][2] = a.z; wg[k][3] = a.w;
    wv[k][0] = bq.x; wv[k][1] = bq.y; wv[k][2] = bq.z; wv[k][3] = bq.w;
  }
#pragma unroll
  for (int xx = 0; xx < 4; ++xx) {
    float ag[4] = {0.f, 0.f, 0.f, 0.f}, av[4] = {0.f, 0.f, 0.f, 0.f};
#pragma unroll
    for (int dy = 0; dy < 3; ++dy)
#pragma unroll
      for (int dx = 0; dx < 3; ++dx) {
        const uint2 gq = gg[xx + dx][dy], vq = vv[xx + dx][dy];
        const int k = dy * 3 + dx;
        ag[0] += wg[k][0] * lo16(gq.x); ag[1] += wg[k][1] * hi16(gq.x); ag[2] += wg[k][2] * lo16(gq.y); ag[3] += wg[k][3] * hi16(gq.y);
        av[0] += wv[k][0] * lo16(vq.x); av[1] += wv[k][1] * hi16(vq.x); av[2] += wv[k][2] * lo16(vq.y); av[3] += wv[k][3] * hi16(vq.y);
      }
    uint2 o;
    o.x = pack2(ag[0] * sigm(ag[0]) * av[0], ag[1] * sigm(ag[1]) * av[1]);
    o.y = pack2(ag[2] * sigm(ag[2]) * av[2], ag[3] * sigm(ag[3]) * av[3]);
    *(uint2*)(G + (base + y * 64 + x0 + xx) * 2816 + hh * 1408 + c4) = o;
  }
}
#undef CG_LD

__device__ __forceinline__ void down_tile(const Params& P, int t, char* lds) {
  const int nt = t >> 6, mt = t & 63;
  const int m0 = mt * 256, n0 = nt * 128;
  f32x4 acc[4][4];
  acc_zero(acc);
  gemm_main((const u16*)(P.ws + OFF_G) + (size_t)m0 * 2816, 2816, (const u16*)(P.ws + OFF_WT_DOWN) + (size_t)n0 * 2816, 2816, 2816, acc, (u16*)lds);
  TILE_COORDS
  const float* MOD = (const float*)(P.ws + OFF_MOD) + (m0 >> 12) * 6144 + 5 * 1024;
#pragma unroll
  for (int j = 0; j < 4; ++j) {
    const int col = TCOL(n0, j);
    const float gate = MOD[col];
#pragma unroll
    for (int i = 0; i < 4; ++i)
#pragma unroll
      for (int e = 0; e < 4; ++e) {
        const size_t o = (size_t)TROW(m0, i, e) * 1024 + col;
        P.out[o] = P.out[o] + gate * acc[i][j][e];
      }
  }
}

__device__ __forceinline__ void final_item(const Params& P, int item) {
  const int lane = opq(threadIdx.x) & 63, w = opq(threadIdx.x) >> 6;
  const int row = item * 8 + w;
  float* xr = P.out + (size_t)row * 1024;
  float4 v[4];
  float ss = 0.f;
#pragma unroll
  for (int it = 0; it < 4; ++it) {
    v[it] = *(const float4*)(xr + (it * 64 + lane) * 4);
    ss += v[it].x * v[it].x + v[it].y * v[it].y + v[it].z * v[it].z + v[it].w * v[it].w;
  }
  ss = wsum64(ss);
  const float rstd = rsqrtf(ss * (1.f / 1024.f) + 1e-6f);
#pragma unroll
  for (int it = 0; it < 4; ++it) {
    const int c = (it * 64 + lane) * 4;
    const float4 w4 = *(const float4*)(P.norm_f_w + c);
    float4 o;
    o.x = v[it].x * rstd * w4.x; o.y = v[it].y * rstd * w4.y; o.z = v[it].z * rstd * w4.z; o.w = v[it].w * rstd * w4.w;
    *(float4*)(xr + c) = o;
  }
}

__device__ __forceinline__ void run_phase(const Params& P, int ph, char* lds) {
  const int bid = blockIdx.x, nb = gridDim.x;
#ifdef ONLY_PHASE
  if (ph != ONLY_PHASE) return;
#endif
  switch (ph) {
    case 0: {
      for (int it = bid; it < 984 + 192 + 2048; it += nb) {
        if (it < 296) convert_item(P.w_in, 1024, 4624, (u16*)(P.ws + OFF_WT_IN), 0, it, lds);
        else if (it < 328) convert_item(P.w_a_out, 512, 1024, (u16*)(P.ws + OFF_WT_AOUT), 1, it - 296, lds);
        else if (it < 360) convert_item(P.w_glu, 512, 1024, (u16*)(P.ws + OFF_WT_GLU), 2, it - 328, lds);
        else if (it < 392) convert_item(P.w_b_out, 512, 1024, (u16*)(P.ws + OFF_WT_BOUT), 3, it - 360, lds);
        else if (it < 456) convert_item(P.w_o, 1024, 1024, (u16*)(P.ws + OFF_WT_O), 4, it - 392, lds);
        else if (it < 808) convert_item(P.w_up, 1024, 5632, (u16*)(P.ws + OFF_WT_UP), 5, it - 456, lds);
        else if (it < 984) convert_item(P.w_down, 2816, 1024, (u16*)(P.ws + OFF_WT_DOWN), 6, it - 808, lds);
        else if (it < 1176) mod_item(P, it - 984, lds);
        else s5tab_item(P, it - 1176, lds);
      }
    } break;
    case 1:
      for (int it = bid; it < 2176 + 2048; it += nb) {
        if (it < 2176) norm1_item(P, it); else mintra_item(P, it - 2176);
      }
      break;
    case 2:
      for (int it = bid; it < 1396; it += nb) inproj_tile(P, it, lds);
      break;
    case 3:
      for (int it = bid; it < 1088 + 192; it += nb) {
        if (it < 1088) delta_prep_item(P, it, lds); else s5end_tile(P, it - 1088, lds);
      }
      break;
    case 4:
      if (bid < 128) delta_scan_block(P, bid, lds);
      else if (bid < 160) s5_carry_block(P, bid - 128);
      break;
    case 5:
      for (int it = bid; it < 256 + 2048 + 2048; it += nb) {
        if (it < 256) s5out_tile(P, it, lds);
        else if (it < 2304) delta_post_item(P, it - 256);
        else norm1_item(P, it - 2304);
      }
      break;
    case 6:
      for (int it = bid; it < 512 + 1024; it += nb) {
        if (it < 512) glu_tile(P, it, lds); else gates_tile(P, it - 512, lds);
      }
      break;
    case 7:
      for (int it = bid; it < 512; it += nb) mix_tile(P, it, lds);
      break;
    case 8:
      for (int it = bid; it < 512; it += nb) wo_tile(P, it, lds);
      break;
    case 9:
      for (int it = bid; it < 2048; it += nb) norm2_item(P, it);
      break;
    case 10:
      for (int it = bid; it < 1408; it += nb) up_tile(P, it, 0, lds);
      break;
    case 11:
      for (int it = bid; it < 4096; it += nb) convgate_item(P, it, 0);
      break;
    case 12:
      for (int it = bid; it < 1408; it += nb) up_tile(P, it, 1, lds);
      break;
    case 13:
      for (int it = bid; it < 4096; it += nb) convgate_item(P, it, 1);
      break;
    case 14:
      for (int it = bid; it < 512; it += nb) down_tile(P, it, lds);
      break;
    case 15:
      for (int it = bid; it < 2048; it += nb) final_item(P, it);
      break;
    default: break;
  }
}

typedef const __attribute__((address_space(4))) Params* KParamsPtr;
__global__ void __launch_bounds__(NT) fwd_megakernel(Params Pk) {
#if defined(__HIP_DEVICE_COMPILE__)
  extern __shared__ __attribute__((aligned(16))) char lds[];
  KParamsPtr pp = (KParamsPtr)__builtin_amdgcn_kernarg_segment_ptr();
  const int lo = (int)pp->ph_lo, hi = (int)pp->ph_hi;
#if MULTI_LAUNCH
  for (int ph = lo; ph < hi; ++ph) { KParamsPtr q = pp; asm volatile("" : "+s"(q)); Params P; for (int i_ = 0; i_ < (int)(sizeof(Params) / 8); ++i_) ((unsigned long long*)&P)[i_] = ((const __attribute__((address_space(4))) unsigned long long*)q)[i_]; run_phase(P, ph, lds); }
#else
  cg::grid_group grid = cg::this_grid();
  volatile LAS unsigned* xst = (volatile LAS unsigned*)(lds + (LDS_BYTES - 16));
  if (threadIdx.x == 0) { xst[0] = 0u; xst[1] = 0u; xst[2] = 0u; xst[3] = 0u; }
  __syncthreads();
  XcdBarrier xb = xcd_barrier_post((unsigned*)(pp->ws + OFF_BAR), xst);
  const unsigned rep_mask = (unsigned)pp->rep_mask;
  bool first_sync = true;
  for (int ph = lo; ph < hi; ++ph) {
    const int reps = 1 + (int)((rep_mask >> ph) & 1u);
    for (int rp = 0; rp < reps; ++rp) {
      {
        KParamsPtr q = pp;
        asm volatile("" : "+s"(q));
        Params P;
        {
          typedef __attribute__((address_space(1))) const float* GF;
          const float** dp = (const float**)&P;
          const __attribute__((address_space(4))) unsigned long long* sp = (const __attribute__((address_space(4))) unsigned long long*)q;
#pragma unroll
          for (int i_ = 0; i_ < 30; ++i_) dp[i_] = (const float*)(GF)(sp[i_]);
          P.out = (float*)(__attribute__((address_space(1))) float*)(sp[30]);
          P.ws = (char*)(__attribute__((address_space(1))) char*)(sp[31]);
          P.ph_lo = 0; P.ph_hi = 0; P.rep_mask = 0;
        }
        run_phase(P, ph, lds);
      }
      if (ph + 1 < hi || rp + 1 < reps) {
        if (first_sync) { grid.sync(); first_sync = false; }
        else xcd_barrier(xb);
      }
    }
  }
#endif
#endif
}

extern "C" void kernel_launch(void* const* d_in, const int* in_sizes, int n_in, void* d_out, int out_size, void* d_ws,
                              size_t ws_size, hipStream_t stream) {
  static int grid_blocks = 0;
  if (grid_blocks == 0) {
    if (n_in != 30 || out_size != 16384 * 1024 || ws_size < WS_NEED) {
      fprintf(stderr, "kernel_launch: unexpected shapes: n_in %d out %d ws %zu (need %zu)\n", n_in, out_size, ws_size, (size_t)WS_NEED);
      grid_blocks = -1;
      return;
    }
    int dev = 0, cus = 0, per_cu = 0;
    hipGetDevice(&dev);
    hipDeviceGetAttribute(&cus, hipDeviceAttributeMultiprocessorCount, dev);
    if (hipFuncSetAttribute((const void*)fwd_megakernel, hipFuncAttributeMaxDynamicSharedMemorySize, LDS_BYTES) != hipSuccess) {
      fprintf(stderr, "kernel_launch: hipFuncSetAttribute failed\n");
      grid_blocks = -1;
      return;
    }
    if (hipOccupancyMaxActiveBlocksPerMultiprocessor(&per_cu, (const void*)fwd_megakernel, NT, LDS_BYTES) != hipSuccess || per_cu < 1) {
      fprintf(stderr, "kernel_launch: occupancy query failed / zero (%d)\n", per_cu);
      grid_blocks = -1;
      return;
    }
    grid_blocks = cus;
    if (grid_blocks < 64) { fprintf(stderr, "kernel_launch: too few CUs (%d)\n", cus); grid_blocks = -1; return; }
  }
  if (grid_blocks < 0) return;
  (void)hipMemsetAsync((char*)d_ws + OFF_BAR, 0, XCD_BAR_WORDS * sizeof(unsigned), stream);
  Params p{};
  const float** pp = (const float**)&p;
  for (int i = 0; i < 30; ++i) pp[i] = (const float*)d_in[i];
  p.out = (float*)d_out;
  p.ws = (char*)d_ws;
#if MULTI_LAUNCH
  for (int ph = 0; ph < 16; ++ph) {
    p.ph_lo = ph; p.ph_hi = ph + 1;
    hipLaunchKernelGGL(fwd_megakernel, dim3(grid_blocks), dim3(NT), LDS_BYTES, stream, p);
  }
#else
  p.ph_lo = 0; p.ph_hi = 16;
#ifdef REPEAT_MASK
  p.rep_mask = REPEAT_MASK;
#endif
  void* args[] = {&p};
  hipError_t e = hipLaunchCooperativeKernel((const void*)fwd_megakernel, dim3(grid_blocks), dim3(NT), args, LDS_BYTES, stream);
  if (e != hipSuccess) fprintf(stderr, "cooperative launch failed: %s (grid %d)\n", hipGetErrorString(e), grid_blocks);
#endif
}
```

```cpp
#include <hip/hip_runtime.h>
#include <hip/hip_cooperative_groups.h>
#include <cstdio>
#include <cstdint>
namespace cg = cooperative_groups;

#ifndef MULTI_LAUNCH
#define MULTI_LAUNCH 0
#endif

typedef unsigned short u16;
typedef __attribute__((ext_vector_type(8))) short bf16x8;
typedef __attribute__((ext_vector_type(4))) float f32x4;
typedef __attribute__((ext_vector_type(16))) float f32x16;

#define NT 512
constexpr int LDS_BYTES = 131072 + 1024;
constexpr int NPHASE = 18;

constexpr size_t OFF_WT_IN   = 0;
constexpr size_t OFF_WT_AOUT = 9699328;
constexpr size_t OFF_WT_GLU  = 10747904;
constexpr size_t OFF_WT_BOUT = 11796480;
constexpr size_t OFF_WT_O    = 12845056;
constexpr size_t OFF_WT_UP   = 14942208;
constexpr size_t OFF_WT_DOWN = 26476544;
constexpr size_t OFF_MOD     = 32243712;
constexpr size_t OFF_BAR     = 32505856;
constexpr size_t OFF_R2      = 33554432;
constexpr size_t OFF_R1      = 69206016;
constexpr size_t OFF_KTAB    = OFF_R1;
constexpr size_t OFF_MEND    = OFF_R1 + 2097152;
constexpr size_t OFF_MST     = OFF_R1 + 10485760;
constexpr size_t OFF_MINTRA  = OFF_R1 + 18874368;
constexpr size_t OFF_R3      = 104857600;
constexpr size_t OFF_O       = OFF_R3;
constexpr size_t OFF_XIN     = OFF_R3 + 33554432;
constexpr size_t OFF_MIX     = 158334976;
constexpr size_t OFF_SG      = OFF_R1;
constexpr size_t OFF_Z       = 158334976;
constexpr size_t OFF_U5      = 175112192;
constexpr size_t OFF_BA      = 192937984;
constexpr size_t OFF_GC      = OFF_BA + 1179648;
constexpr size_t OFF_UF      = 195035136;
constexpr size_t OFF_YA      = OFF_UF;
constexpr size_t OFF_YB      = OFF_UF + 16777216;
constexpr size_t OFF_E       = 230686720;
constexpr size_t OFF_YG      = OFF_E;
constexpr size_t OFF_UPH     = OFF_R1;
constexpr size_t OFF_G       = 161480704;
constexpr size_t WS_NEED     = 253755392;
constexpr size_t OFF_QKN     = 0;
constexpr size_t OFF_AQ      = 35651584;

struct Params {
  const float *x, *c, *ctx, *c_ctx, *w_ada, *b_ada, *norm1_w, *w_in, *dn_conv_w, *dn_a_log, *dn_dt_bias, *dn_norm_w,
      *w_a_out, *s5_a_re, *s5_a_im, *s5_log_step, *s5_b_re, *s5_b_im, *s5_c_re, *s5_c_im, *s5_d, *w_glu, *b_glu,
      *w_b_out, *w_o, *norm2_w, *w_up, *ffn_conv_w, *w_down, *norm_f_w;
  float* out;
  char* ws;
  long long ph_lo, ph_hi;
  long long rep_mask;
};

#define XB_TMO      128
#define XB_XCNT(j)  (256  + 64 * (j))
#define XB_XSUB(j)  (1280 + 64 * (j))
#define XB_XGEN(j)  (2304 + 64 * (j))
#define XB_TOP      3328
#define XB_TOPGEN   3392
#define XCD_BAR_WORDS 3456
#define XB_SPIN_CAP (1u << 18)
#define LAS __attribute__((address_space(3)))

__device__ __forceinline__ unsigned xb_ld(unsigned* p)              { return __hip_atomic_load(p, __ATOMIC_RELAXED, __HIP_MEMORY_SCOPE_AGENT); }
__device__ __forceinline__ unsigned xb_add(unsigned* p, unsigned v) { return __hip_atomic_fetch_add(p, v, __ATOMIC_RELAXED, __HIP_MEMORY_SCOPE_AGENT); }
__device__ __forceinline__ unsigned xb_xcc_id() { return (unsigned)__builtin_amdgcn_s_getreg((3 << 11) | 20) & 0xFu; }
#define XB_SPIN(cond, bar) do { unsigned _sp = 0; while (cond) { __builtin_amdgcn_s_sleep(1); \
    if ((++_sp & 255u) == 0u) { if (xb_ld(&(bar)[XB_TMO])) break; if (_sp > XB_SPIN_CAP) { atomicAdd(&(bar)[XB_TMO], 1u); break; } } } } while (0)

struct XcdBarrier {
    unsigned* bar; unsigned x;
    volatile LAS unsigned* st;
};

__device__ __forceinline__ XcdBarrier xcd_barrier_post(unsigned* bar, volatile LAS unsigned* st) {
    XcdBarrier b; b.bar = bar; b.x = xb_xcc_id(); b.st = st;
    if (threadIdx.x == 0) (void)xb_add(&bar[XB_XCNT(b.x)], 1u);
    return b;
}
__device__ __forceinline__ void xcd_barrier_complete(unsigned* bar, unsigned x, unsigned& nloc, unsigned& nx) {
    const unsigned G = gridDim.x * gridDim.y * gridDim.z;
    unsigned sum, cnt, mine, sp = 0u;
    for (;;) {
        sum = 0u; cnt = 0u; mine = 0u;
#pragma unroll
        for (unsigned j = 0; j < 16; ++j) { const unsigned c = xb_ld(&bar[XB_XCNT(j)]); sum += c; cnt += (c > 0u) ? 1u : 0u; mine = (j == x) ? c : mine; }
        if (sum == G) break;
        __builtin_amdgcn_s_sleep(1);
        if ((++sp & 255u) == 0u) { if (xb_ld(&bar[XB_TMO])) break; if (sp > XB_SPIN_CAP) { atomicAdd(&bar[XB_TMO], 1u); break; } }
    }
    nloc = mine > 0u ? mine : 1u; nx = cnt > 0u ? cnt : 1u;
}

__device__ __forceinline__ void xcd_barrier(const XcdBarrier& b) {
    asm volatile("s_waitcnt vmcnt(0)" ::: "memory");
    __syncthreads();
    if (threadIdx.x == 0) {
        unsigned* bar = b.bar;
        __builtin_amdgcn_s_waitcnt(0);
        unsigned nloc = b.st[0], nx = b.st[1];
        if (nloc == 0u) { xcd_barrier_complete(bar, b.x, nloc, nx); b.st[0] = nloc; b.st[1] = nx; }
        const unsigned old = xb_add(&bar[XB_XSUB(b.x)], 1u);
        const unsigned gen = old / nloc;
        if (old + 1u == (gen + 1u) * nloc) {
            __builtin_amdgcn_fence(__ATOMIC_RELEASE, "agent");
            asm volatile("s_waitcnt vmcnt(0)" ::: "memory");
            const unsigned og = xb_add(&bar[XB_TOP], 1u);
            const unsigned tg = og / nx;
            if (og + 1u == (tg + 1u) * nx) xb_add(&bar[XB_TOPGEN], 1u);
            else XB_SPIN(xb_ld(&bar[XB_TOPGEN]) == tg, bar);
            __builtin_amdgcn_fence(__ATOMIC_ACQUIRE, "agent");
            xb_add(&bar[XB_XGEN(b.x)], 1u);
            asm volatile("s_waitcnt vmcnt(0)" ::: "memory");
        } else {
            XB_SPIN(xb_ld(&bar[XB_XGEN(b.x)]) == gen, bar);
            __builtin_amdgcn_fence(__ATOMIC_ACQUIRE, "agent");
            asm volatile("s_waitcnt vmcnt(0)" ::: "memory");
        }
    }
    __syncthreads();
}


__device__ __forceinline__ u16 f2bf(float f) {
  uint32_t u = __float_as_uint(f);
  u += 0x7fffu + ((u >> 16) & 1u);
  return (u16)(u >> 16);
}
__device__ __forceinline__ float bf2f(u16 h) { return __uint_as_float(((uint32_t)h) << 16); }
__device__ __forceinline__ uint32_t pack2(float a, float b) { return (uint32_t)f2bf(a) | ((uint32_t)f2bf(b) << 16); }
__device__ __forceinline__ float lo16(uint32_t w) { return __uint_as_float(w << 16); }
__device__ __forceinline__ float hi16(uint32_t w) { return __uint_as_float(w & 0xffff0000u); }
__device__ __forceinline__ int opq(int v) { asm volatile("" : "+v"(v)); return v; }
__device__ __forceinline__ float sigm(float x) { return 1.f / (1.f + __expf(-x)); }
__device__ __forceinline__ void unpack8(uint4 v, float* f) {
  f[0] = lo16(v.x); f[1] = hi16(v.x); f[2] = lo16(v.y); f[3] = hi16(v.y);
  f[4] = lo16(v.z); f[5] = hi16(v.z); f[6] = lo16(v.w); f[7] = hi16(v.w);
}
__device__ __forceinline__ uint4 pack8(const float* f) {
  uint4 v; v.x = pack2(f[0], f[1]); v.y = pack2(f[2], f[3]); v.z = pack2(f[4], f[5]); v.w = pack2(f[6], f[7]);
  return v;
}
__device__ __forceinline__ float wsum64(float v) {
#pragma unroll
  for (int o = 32; o > 0; o >>= 1) v += __shfl_xor(v, o, 64);
  return v;
}
__device__ __forceinline__ float gelu_tanh(float x) {
  float u = 0.7978845608028654f * (x + 0.044715f * x * x * x);
  float t = 1.f - 2.f / (1.f + __expf(2.f * u));
  return 0.5f * x * (1.f + t);
}

__device__ __forceinline__ void g_frag(const u16* as, const u16* bs, int ks, bf16x8 (&a)[2], bf16x8 (&b)[2]) {
  a[0] = *(const bf16x8*)(as + ks * 16);
  a[1] = *(const bf16x8*)(as + 32 * 72 + ks * 16);
  b[0] = *(const bf16x8*)(bs + ks * 16);
  b[1] = *(const bf16x8*)(bs + 32 * 72 + ks * 16);
}
__device__ __forceinline__ void g_mma(const bf16x8 (&a)[2], const bf16x8 (&b)[2], f32x16 (&acc)[2][2]) {
  acc[0][0] = __builtin_amdgcn_mfma_f32_32x32x16_bf16(a[0], b[0], acc[0][0], 0, 0, 0);
  acc[0][1] = __builtin_amdgcn_mfma_f32_32x32x16_bf16(a[0], b[1], acc[0][1], 0, 0, 0);
  acc[1][0] = __builtin_amdgcn_mfma_f32_32x32x16_bf16(a[1], b[0], acc[1][0], 0, 0, 0);
  acc[1][1] = __builtin_amdgcn_mfma_f32_32x32x16_bf16(a[1], b[1], acc[1][1], 0, 0, 0);
}
__device__ __forceinline__ void gemm_main(const u16* __restrict__ A, int lda, const u16* __restrict__ Bt, int ldb, int K,
                                          f32x16 (&acc)[2][2], u16* lds) {
  const int tid = opq(threadIdx.x), lane = tid & 63, w = tid >> 6, wm = w >> 1, wn = w & 1, fr = lane & 31, fq = lane >> 5;
  u16* As = lds;
  u16* Bs = lds + 2 * 256 * 72;
  const int nk = K >> 6;
  uint4 p0, p1, p2, p3, p4, p5;
  uint4 q0, q1, q2, q3, q4, q5;
  uint4 r0, r1, r2, r3, r4, r5;
  const int lr = tid >> 3, lc = (tid & 7) * 8;
  const unsigned oa0 = (unsigned)(lr * lda + lc) * 2u, sa2 = (unsigned)lda * 128u;
  const unsigned oa1 = oa0 + sa2, oa2 = oa0 + 2u * sa2, oa3 = oa0 + 3u * sa2;
  const unsigned ob0 = (unsigned)(lr * ldb + lc) * 2u, ob1 = ob0 + (unsigned)ldb * 128u;
#define G_LOAD(S, kt_)                                          \
  {                                                             \
    const int kc_ = ((kt_) < nk) ? (kt_) : (nk - 1);            \
    const char* a_ = (const char*)A + kc_ * 128;                \
    const char* b_ = (const char*)Bt + kc_ * 128;               \
    S##0 = *(const uint4*)(a_ + oa0);                           \
    S##1 = *(const uint4*)(a_ + oa1);                           \
    S##2 = *(const uint4*)(a_ + oa2);                           \
    S##3 = *(const uint4*)(a_ + oa3);                           \
    S##4 = *(const uint4*)(b_ + ob0);                           \
    S##5 = *(const uint4*)(b_ + ob1);                           \
  }
#define G_STORE(S, buf_)                                                     \
  {                                                                          \
    u16* as_ = As + ((buf_) * 256 + lr) * 72 + lc;                           \
    u16* bs_ = Bs + ((buf_) * 128 + lr) * 72 + lc;                           \
    *(uint4*)(as_) = S##0;                                                   \
    *(uint4*)(as_ + 64 * 72) = S##1;                                         \
    *(uint4*)(as_ + 128 * 72) = S##2;                                        \
    *(uint4*)(as_ + 192 * 72) = S##3;                                        \
    *(uint4*)(bs_) = S##4;                                                   \
    *(uint4*)(bs_ + 64 * 72) = S##5;                                         \
  }
#define G_STEP(S, BUF, kt_)                                                               \
  {                                                                                       \
    const u16* as = As + ((BUF) * 256 + wm * 64 + fr) * 72 + fq * 8;                      \
    const u16* bs = Bs + ((BUF) * 128 + wn * 64 + fr) * 72 + fq * 8;                      \
    bf16x8 fa0[2], fb0[2], fa1[2], fb1[2], fa2[2], fb2[2];                                \
    g_frag(as, bs, 0, fa0, fb0);                                                          \
    g_frag(as, bs, 1, fa1, fb1);                                                          \
    __builtin_amdgcn_sched_barrier(0);                                                    \
    G_STORE(S, (BUF) ^ 1)                                                                 \
    G_LOAD(S, (kt_) + 4)                                                                  \
    __builtin_amdgcn_sched_barrier(0);                                                    \
    g_frag(as, bs, 2, fa2, fb2);                                                          \
    __builtin_amdgcn_sched_barrier(0);                                                    \
    g_mma(fa0, fb0, acc);                                                                 \
    __builtin_amdgcn_sched_barrier(0);                                                    \
    g_frag(as, bs, 3, fa0, fb0);                                                          \
    __builtin_amdgcn_sched_barrier(0);                                                    \
    g_mma(fa1, fb1, acc);                                                                 \
    g_mma(fa2, fb2, acc);                                                                 \
    g_mma(fa0, fb0, acc);                                                                 \
    __syncthreads();                                                                      \
  }
  G_LOAD(p, 0)
  __syncthreads();
  G_STORE(p, 0)
  G_LOAD(q, 1)
  G_LOAD(r, 2)
  G_LOAD(p, 3)
  __syncthreads();
  for (int kt = 0; kt < nk; kt += 6) {
    G_STEP(q, 0, kt)
    G_STEP(r, 1, kt + 1)
    if (kt + 2 < nk) {
      G_STEP(p, 0, kt + 2)
      G_STEP(q, 1, kt + 3)
    }
    if (kt + 4 < nk) {
      G_STEP(r, 0, kt + 4)
      G_STEP(p, 1, kt + 5)
    }
  }
#undef G_STEP
#undef G_LOAD
#undef G_STORE
}

__device__ __forceinline__ void acc_zero(f32x16 (&acc)[2][2]) {
#pragma unroll
  for (int i = 0; i < 2; ++i)
#pragma unroll
    for (int j = 0; j < 2; ++j)
#pragma unroll
      for (int e = 0; e < 16; ++e) acc[i][j][e] = 0.f;
}

#define TILE_COORDS                                                                                  \
  const int tid_ = opq(threadIdx.x), lane_ = tid_ & 63, w_ = tid_ >> 6, wm_ = w_ >> 1, wn_ = w_ & 1, \
            fr_ = lane_ & 31, fq_ = lane_ >> 5;
#define TROW(m0, i, e) ((m0) + wm_ * 64 + (i) * 32 + ((e) & 3) + 8 * ((e) >> 2) + 4 * fq_)
#define TCOL(n0, j) ((n0) + wn_ * 64 + (j) * 32 + fr_)

__device__ __forceinline__ int srccol(int which, int r) {
  switch (which) {
    case 0:
      if (r < 2048) return r;
      if (r < 2560) return 2064 + (r - 2048);
      if (r < 2576) return 2048 + (r - 2560);
      if (r < 2688) return -1;
      if (r < 3712) return 2576 + (r - 2688);
      return 3600 + (r - 3712);
    case 2: {
      int tile = r >> 7, wn = (r >> 6) & 1, wi = r & 63;
      return (wi < 32) ? (tile * 64 + wn * 32 + wi) : (512 + tile * 64 + wn * 32 + (wi - 32));
    }
    case 5: {
      int hh = r / 2816, cc = r % 2816;
      return (cc < 1408) ? (hh * 1408 + cc) : (2816 + hh * 1408 + (cc - 1408));
    }
    default: return r;
  }
}

__device__ __forceinline__ void convert_item(const float* __restrict__ src, int K, int N, u16* __restrict__ dst, int which, int item, char* lds) {
  float* tile = (float*)lds;
  const int tid = opq(threadIdx.x);
  const int kb = K >> 8;
  const int r0 = (item / kb) * 64, k0 = (item % kb) * 256;
  __syncthreads();
  {
    const int n4 = (tid & 15) * 4, kk = tid >> 4;
    const int sc = srccol(which, r0 + n4);
    float4 v[8];
#pragma unroll
    for (int it = 0; it < 8; ++it) {
      const int k = kk + 32 * it;
      v[it] = (sc >= 0) ? *(const float4*)(src + (size_t)(k0 + k) * N + sc) : make_float4(0.f, 0.f, 0.f, 0.f);
    }
#pragma unroll
    for (int it = 0; it < 8; ++it) {
      const int k = kk + 32 * it;
      tile[(n4 + 0) * 257 + k] = v[it].x; tile[(n4 + 1) * 257 + k] = v[it].y;
      tile[(n4 + 2) * 257 + k] = v[it].z; tile[(n4 + 3) * 257 + k] = v[it].w;
    }
  }
  __syncthreads();
  {
    const int ks = (tid & 31) * 8, rr = tid >> 5;
#pragma unroll
    for (int it = 0; it < 4; ++it) {
      const int row = rr + 16 * it;
      float f[8];
#pragma unroll
      for (int e = 0; e < 8; ++e) f[e] = tile[row * 257 + ks + e];
      *(uint4*)(dst + (size_t)(r0 + row) * K + k0 + ks) = pack8(f);
    }
  }
}

__device__ __forceinline__ void mod_item(const Params& P, int item, char* lds) {
  float* sc = (float*)lds;
  float* red = sc + 5 * 1024;
  const int tid = opq(threadIdx.x);
  __syncthreads();
  for (int i = tid; i < 5 * 1024; i += NT) {
    const int r = i >> 10, k = i & 1023;
    float v = (r < 4) ? P.c[r * 1024 + k] : P.c_ctx[k];
    sc[i] = v * sigm(v);
  }
  __syncthreads();
  const int nn = tid & 31, kg = tid >> 5;
  const int n = item * 32 + nn;
  float a0 = 0, a1 = 0, a2 = 0, a3 = 0, a4 = 0;
  for (int kk = 0; kk < 64; ++kk) {
    const int k = kg * 64 + kk;
    const float wv = P.w_ada[(size_t)k * 6144 + n];
    a0 += sc[k] * wv; a1 += sc[1024 + k] * wv; a2 += sc[2048 + k] * wv; a3 += sc[3072 + k] * wv; a4 += sc[4096 + k] * wv;
  }
  red[(kg * 5 + 0) * 32 + nn] = a0; red[(kg * 5 + 1) * 32 + nn] = a1; red[(kg * 5 + 2) * 32 + nn] = a2;
  red[(kg * 5 + 3) * 32 + nn] = a3; red[(kg * 5 + 4) * 32 + nn] = a4;
  __syncthreads();
  if (tid < 160) {
    const int r = tid >> 5, n2 = tid & 31;
    float s = 0.f;
#pragma unroll
    for (int g = 0; g < 16; ++g) s += red[(g * 5 + r) * 32 + n2];
    float* MOD = (float*)(P.ws + OFF_MOD);
    MOD[r * 6144 + item * 32 + n2] = s + P.b_ada[item * 32 + n2];
  }
}

__device__ __forceinline__ void lam_pow(float step, float are, float aim, int e, float& pr, float& pi) {
  const float mag = expf((float)e * step * are);
  double ang = (double)e * (double)step * (double)aim;
  ang -= 6.283185307179586476925 * rint(ang * 0.15915494309189533577);
  float s, c;
  __sincosf((float)ang, &s, &c);
  pr = mag * c; pi = mag * s;
}

__device__ __forceinline__ void s5tab_item(const Params& P, int item, char* lds) {
  const int tid = opq(threadIdx.x);
  const int tau = item & 31, g = (item >> 5) & 31, r = item >> 10;
  float* cfr = (float*)lds;
  float* cfi = cfr + 64;
  float* p0r = cfi + 64;
  float* p0i = p0r + 64;
  float* p1r = p0i + 64;
  float* p1i = p1r + 64;
  float* Gr = p1i + 64;
  float* Gi = Gr + 1024;
  float* Cr = Gi + 1024;
  float* Ci = Cr + 1024;
  const int rg = r * 32 + g;
  __syncthreads();
  if (tid < 64) {
    const int n = tid;
    const float step = expf(P.s5_log_step[rg]);
    const float are = P.s5_a_re[rg * 64 + n], aim = P.s5_a_im[rg * 64 + n];
    const float za = step * are;
    double zb = (double)step * (double)aim;
    zb -= 6.283185307179586476925 * rint(zb * 0.15915494309189533577);
    float sb, cb, sh, ch;
    __sincosf((float)zb, &sb, &cb);
    __sincosf((float)(0.5 * zb), &sh, &ch);
    const float em1 = expm1f(za);
    const float re1 = em1 * cb - 2.f * sh * sh;
    const float im1 = (1.f + em1) * sb;
    const float den = are * are + aim * aim;
    cfr[n] = (re1 * are + im1 * aim) / den;
    cfi[n] = (im1 * are - re1 * aim) / den;
    float pr, pi;
    lam_pow(step, are, aim, tau, pr, pi);
    p0r[n] = pr; p0i[n] = pi;
    lam_pow(step, are, aim, tau + 1, pr, pi);
    p1r[n] = pr; p1i[n] = pi;
  }
  for (int i = tid; i < 1024; i += NT) {
    Cr[i] = P.s5_c_re[(size_t)rg * 1024 + i];
    Ci[i] = P.s5_c_im[(size_t)rg * 1024 + i];
  }
  __syncthreads();
  for (int i = tid; i < 1024; i += NT) {
    const int n = i >> 4;
    const float br = P.s5_b_re[(size_t)rg * 1024 + i], bi = P.s5_b_im[(size_t)rg * 1024 + i];
    const float tr = cfr[n] * br - cfi[n] * bi, ti = cfr[n] * bi + cfi[n] * br;
    Gr[i] = p0r[n] * tr - p0i[n] * ti;
    Gi[i] = p0r[n] * ti + p0i[n] * tr;
  }
  __syncthreads();
  u16* MEND = (u16*)(P.ws + OFF_MEND);
  u16* MST = (u16*)(P.ws + OFF_MST);
  float* KTAB = (float*)(P.ws + OFF_KTAB);
  {
    const int ii = (r == 0) ? (31 - tau) : tau;
    for (int i = tid; i < 2048; i += NT) {
      const int part = i >> 10, n = (i >> 4) & 63, pi_ = i & 15;
      const float v = part ? Gi[n * 16 + pi_] : Gr[n * 16 + pi_];
      MEND[((size_t)g * 256 + r * 128 + part * 64 + n) * 512 + ii * 16 + pi_] = f2bf(v);
    }
  }
  if (tid < 256) {
    const int po = tid >> 4, pi_ = tid & 15;
    float s = 0.f;
    for (int n = 0; n < 64; ++n) s += Cr[po * 64 + n] * Gr[n * 16 + pi_] - Ci[po * 64 + n] * Gi[n * 16 + pi_];
    KTAB[(((size_t)rg) * 32 + tau) * 256 + tid] = s;
  }
  {
    const int jj = (r == 0) ? tau : (31 - tau);
    for (int i = tid; i < 2048; i += NT) {
      const int po = i >> 7, part = (i >> 6) & 1, n = i & 63;
      const float cr = Cr[po * 64 + n], ci = Ci[po * 64 + n];
      const float v = part ? -(cr * p1i[n] + ci * p1r[n]) : (cr * p1r[n] - ci * p1i[n]);
      MST[((size_t)g * 512 + jj * 16 + po) * 256 + r * 128 + part * 64 + n] = f2bf(v);
    }
  }
}

__device__ __forceinline__ void norm_row(const float* __restrict__ xr, const float* __restrict__ nw, const float* __restrict__ shift,
                                         const float* __restrict__ scale, u16* __restrict__ dst, int lane) {
  float4 v[4];
  float ss = 0.f;
#pragma unroll
  for (int it = 0; it < 4; ++it) {
    v[it] = *(const float4*)(xr + (it * 64 + lane) * 4);
    ss += v[it].x * v[it].x + v[it].y * v[it].y + v[it].z * v[it].z + v[it].w * v[it].w;
  }
  ss = wsum64(ss);
  const float rstd = rsqrtf(ss * (1.f / 1024.f) + 1e-6f);
#pragma unroll
  for (int it = 0; it < 4; ++it) {
    const int c = (it * 64 + lane) * 4;
    const float4 w4 = *(const float4*)(nw + c), sh = *(const float4*)(shift + c), sc = *(const float4*)(scale + c);
    const float y0 = v[it].x * rstd * w4.x * (1.f + sc.x) + sh.x;
    const float y1 = v[it].y * rstd * w4.y * (1.f + sc.y) + sh.y;
    const float y2 = v[it].z * rstd * w4.z * (1.f + sc.z) + sh.z;
    const float y3 = v[it].w * rstd * w4.w * (1.f + sc.w) + sh.w;
    uint2 o; o.x = pack2(y0, y1); o.y = pack2(y2, y3);
    *(uint2*)(dst + c) = o;
  }
}

__device__ __forceinline__ void norm1_item(const Params& P, int item) {
  const int lane = opq(threadIdx.x) & 63, w = opq(threadIdx.x) >> 6;
  const int row = item * 8 + w;
  const float* MOD = (const float*)(P.ws + OFF_MOD);
  const int bi = (row < 16384) ? (row >> 12) : 4;
  const float* xr = (row < 16384) ? (P.x + (size_t)row * 1024) : (P.ctx + (size_t)(row - 16384) * 1024);
  norm_row(xr, P.norm1_w, MOD + bi * 6144, MOD + bi * 6144 + 1024, (u16*)(P.ws + OFF_R2) + (size_t)row * 1024, lane);
}

__device__ __forceinline__ void mintra_item(const Params& P, int item) {
  const int tid = opq(threadIdx.x);
  const int rowg = item * 8 + (tid >> 6);
  const int g = rowg >> 9, nout = rowg & 511, j = nout >> 4, po = nout & 15;
  const int k0 = (tid & 63) * 8, i = k0 >> 4, pi0 = k0 & 15;
  const float* KTAB = (const float*)(P.ws + OFF_KTAB);
  float f[8];
#pragma unroll
  for (int e = 0; e < 8; ++e) f[e] = 0.f;
  if (i <= j) {
    const float* kp = KTAB + (((size_t)(0 * 32 + g)) * 32 + (j - i)) * 256 + po * 16 + pi0;
#pragma unroll
    for (int e = 0; e < 8; ++e) f[e] += kp[e];
  }
  if (i >= j) {
    const float* kp = KTAB + (((size_t)(1 * 32 + g)) * 32 + (i - j)) * 256 + po * 16 + pi0;
#pragma unroll
    for (int e = 0; e < 8; ++e) f[e] += kp[e];
  }
  if (i == j) {
    const float dv = P.s5_d[g * 16 + po];
#pragma unroll
    for (int e = 0; e < 8; ++e) if (pi0 + e == po) f[e] += dv;
  }
  u16* MI = (u16*)(P.ws + OFF_MINTRA);
  *(uint4*)(MI + (size_t)rowg * 512 + k0) = pack8(f);
}

__device__ __forceinline__ void inproj_tile(const Params& P, int t, char* lds) {
  int mt, nt;
  if (t < 1344) { nt = t / 64; mt = t % 64; }
  else {
    const int tt = t - 1344; mt = 64 + (tt & 3);
    const int ni = tt >> 2;
    nt = (ni < 8) ? (4 + ni) : ((ni < 12) ? (16 + ni - 8) : 20);
  }
  const int m0 = mt * 256, n0 = nt * 128;
  f32x16 acc[2][2];
  acc_zero(acc);
  gemm_main((const u16*)(P.ws + OFF_R2) + (size_t)m0 * 1024, 1024, (const u16*)(P.ws + OFF_WT_IN) + (size_t)n0 * 1024, 1024, 1024, acc, (u16*)lds);
  TILE_COORDS
  if (nt < 12) {
    u16* QKV = (u16*)(P.ws + OFF_R3);
#pragma unroll
    for (int i = 0; i < 2; ++i)
#pragma unroll
      for (int j = 0; j < 2; ++j)
#pragma unroll
        for (int e = 0; e < 16; ++e) QKV[(size_t)TROW(m0, i, e) * 1536 + TCOL(n0, j)] = f2bf(acc[i][j][e]);
  } else if (nt < 16) {
    u16* Z = (u16*)(P.ws + OFF_Z);
#pragma unroll
    for (int i = 0; i < 2; ++i)
#pragma unroll
      for (int j = 0; j < 2; ++j)
#pragma unroll
        for (int e = 0; e < 16; ++e) Z[(size_t)TROW(m0, i, e) * 512 + TCOL(n0, j) - 1536] = f2bf(acc[i][j][e]);
  } else if (nt < 20) {
    u16* U5 = (u16*)(P.ws + OFF_U5);
#pragma unroll
    for (int i = 0; i < 2; ++i)
#pragma unroll
      for (int j = 0; j < 2; ++j)
#pragma unroll
        for (int e = 0; e < 16; ++e) {
          const int cc = TCOL(n0, j) - 2048;
          U5[((size_t)(cc >> 4) * 17408 + TROW(m0, i, e)) * 16 + (cc & 15)] = f2bf(acc[i][j][e]);
        }
  } else {
    float* BA = (float*)(P.ws + OFF_BA);
#pragma unroll
    for (int i = 0; i < 2; ++i)
#pragma unroll
      for (int j = 0; j < 2; ++j)
#pragma unroll
        for (int e = 0; e < 16; ++e) {
          const int cc = TCOL(n0, j) - 2560;
          if (cc < 16) BA[(size_t)TROW(m0, i, e) * 16 + cc] = acc[i][j][e];
        }
  }
}

template <int DIR>
__device__ __forceinline__ void solve_cols(const Params& P, int itb, int c, const float* Lt, const float* bpp, const float* gcp,
                                           const u16* Vs, const u16* Ks) {
  float sol[64];
  const float* bp_ = bpp + DIR * 64;
  const float* gc_ = gcp + DIR * 64;
  if (c < 128) {
    const u16* vp = Vs + c;
#pragma unroll
    for (int p = 0; p < 64; ++p) sol[p] = bp_[p] * bf2f(vp[(DIR ? (63 - p) : p) * 136]);
  } else {
    const u16* kp = Ks + (c - 128);
#pragma unroll
    for (int p = 0; p < 64; ++p) sol[p] = bp_[p] * __expf(gc_[p]) * bf2f(kp[(DIR ? (63 - p) : p) * 136]);
  }
  const float* Lr = Lt + opq(DIR * 4096);
#ifdef SOLVE_TWICE
  float sol0[64];
#pragma unroll
  for (int p = 0; p < 64; ++p) sol0[p] = sol[p];
#pragma unroll
  for (int j = 0; j < 63; ++j) {
    const float sj = sol0[j];
#pragma unroll
    for (int i = j + 1; i < 64; ++i) sol0[i] -= Lr[j * 64 + i] * sj;
  }
  if (sol0[63] == 12345.678f) sol[0] += 1.f;
#endif
#pragma unroll
  for (int j = 0; j < 63; ++j) {
    const float sj = sol[j];
#pragma unroll
    for (int i = j + 1; i < 64; ++i) sol[i] -= Lr[j * 64 + i] * sj;
  }
  const size_t it2 = (size_t)(itb + DIR);
  if (c < 128) {
    u16* UF = (u16*)(P.ws + OFF_UF) + (it2 * 128 + c) * 64;
#pragma unroll
    for (int q = 0; q < 8; ++q) *(uint4*)(UF + q * 8) = pack8(sol + q * 8);
  } else {
    u16* Wg = (u16*)(P.ws + OFF_R2) + it2 * 8192 + (c - 128);
#pragma unroll
    for (int p = 0; p < 64; ++p) Wg[p * 128] = f2bf(-sol[p]);
  }
}

__device__ __forceinline__ void delta_prep_item(const Params& P, int item, char* lds) {
  const int tid = opq(threadIdx.x), lane = tid & 63, wv = tid >> 6, fr = lane & 15, fq = lane >> 4;
  const int cid = item >> 2, h = item & 3;
  const int row0 = cid * 64;
  int seq_lo, seq_hi;
  if (cid < 256) { seq_lo = (cid >> 6) * 4096; seq_hi = seq_lo + 4096; }
  else { seq_lo = 16384 + ((cid - 256) >> 2) * 256; seq_hi = seq_lo + 256; }
  u16* Qs = (u16*)(lds + opq(0));
  u16* Ks = (u16*)(lds + opq(17408));
  u16* Vs = (u16*)(lds + opq(34816));
  float* KKs = (float*)(lds + opq(52224));
  float* QKs = (float*)(lds + opq(69632));
  float* Lt = (float*)(lds + opq(87040));
  float* gtok = (float*)(lds + opq(119808));
  float* btok = gtok + 128;
  float* gcp = btok + 128;
  float* bpp = gcp + 128;
  u16* QKN = (u16*)((char*)P.out + OFF_QKN);
  __syncthreads();
  {
    const int j = tid >> 3, sg = tid & 7;
    const int row = row0 + j;
    const bool hm = (row - 1 >= seq_lo), hp = (row + 1 < seq_hi);
    const u16* qkv = (const u16*)(P.ws + OFF_R3);
#pragma unroll
    for (int s = 0; s < 3; ++s) {
      const int col = s * 512 + h * 128 + sg * 16;
      const u16* p0 = qkv + (size_t)row * 1536 + col;
      float y[16];
      float ssq = 0.f;
#pragma unroll
      for (int hh = 0; hh < 2; ++hh) {
        const uint4 c0 = *(const uint4*)(p0 + hh * 8);
        uint4 m0 = *(const uint4*)(p0 - (hm ? 1536 : 0) + hh * 8);
        uint4 n0 = *(const uint4*)(p0 + (hp ? 1536 : 0) + hh * 8);
        m0.x = hm ? m0.x : 0u; m0.y = hm ? m0.y : 0u; m0.z = hm ? m0.z : 0u; m0.w = hm ? m0.w : 0u;
        n0.x = hp ? n0.x : 0u; n0.y = hp ? n0.y : 0u; n0.z = hp ? n0.z : 0u; n0.w = hp ? n0.w : 0u;
        float fc[8], fm[8], fn[8];
        unpack8(c0, fc); unpack8(m0, fm); unpack8(n0, fn);
        const float* cwp = P.dn_conv_w + col + hh * 8;
        float cw0[8], cw1[8], cw2[8];
        {
          const float4 t0 = *(const float4*)(cwp), t1 = *(const float4*)(cwp + 4);
          const float4 t2 = *(const float4*)(cwp + 1536), t3 = *(const float4*)(cwp + 1540);
          const float4 t4 = *(const float4*)(cwp + 3072), t5 = *(const float4*)(cwp + 3076);
          cw0[0] = t0.x; cw0[1] = t0.y; cw0[2] = t0.z; cw0[3] = t0.w; cw0[4] = t1.x; cw0[5] = t1.y; cw0[6] = t1.z; cw0[7] = t1.w;
          cw1[0] = t2.x; cw1[1] = t2.y; cw1[2] = t2.z; cw1[3] = t2.w; cw1[4] = t3.x; cw1[5] = t3.y; cw1[6] = t3.z; cw1[7] = t3.w;
          cw2[0] = t4.x; cw2[1] = t4.y; cw2[2] = t4.z; cw2[3] = t4.w; cw2[4] = t5.x; cw2[5] = t5.y; cw2[6] = t5.z; cw2[7] = t5.w;
        }
#pragma unroll
        for (int e = 0; e < 8; ++e) {
          const float v = cw0[e] * fm[e] + cw1[e] * fc[e] + cw2[e] * fn[e];
          const float yy = v * sigm(v);
          y[hh * 8 + e] = yy;
          ssq += yy * yy;
        }
      }
      if (s < 2) {
        ssq += __shfl_xor(ssq, 1, 64); ssq += __shfl_xor(ssq, 2, 64); ssq += __shfl_xor(ssq, 4, 64);
        const float sc = rsqrtf(ssq + 1e-6f) * ((s == 0) ? 0.08838834764831845f : 1.f);
#pragma unroll
        for (int e = 0; e < 16; ++e) y[e] *= sc;
      }
      u16* dl = ((s == 0) ? Qs : ((s == 1) ? Ks : Vs)) + j * 136 + sg * 16;
      const uint4 o0 = pack8(y), o1 = pack8(y + 8);
      *(uint4*)dl = o0; *(uint4*)(dl + 8) = o1;
      if (s < 2) {
        u16* dg = QKN + (size_t)row * 1024 + s * 512 + h * 128 + sg * 16;
        *(uint4*)dg = o0; *(uint4*)(dg + 8) = o1;
      }
    }
  }
  if (tid < 128) {
    const int j = tid & 63, dir = tid >> 6;
    const float* BA = (const float*)(P.ws + OFF_BA) + (size_t)(row0 + j) * 16;
    const float bl = BA[dir * 4 + h], al = BA[8 + dir * 4 + h];
    const float xx = al + P.dn_dt_bias[dir * 4 + h];
    const float sp = (xx > 20.f) ? xx : log1pf(expf(xx));
    gtok[dir * 64 + j] = -expf(P.dn_a_log[dir * 4 + h]) * sp;
    btok[dir * 64 + j] = 1.f / (1.f + expf(-bl));
  }
  __syncthreads();
  if (tid < 2) {
    const int dir = tid;
    float a = 0.f;
    for (int p = 0; p < 64; ++p) {
      const int tk = dir ? (63 - p) : p;
      a += gtok[dir * 64 + tk];
      gcp[dir * 64 + p] = a;
      bpp[dir * 64 + p] = btok[dir * 64 + tk];
    }
  }
  {
#pragma unroll
    for (int q = 0; q < 4; ++q) {
      const int t = wv * 4 + q;
      const int which = t >> 4, mi = (t >> 2) & 3, ni = t & 3;
      const u16* Am = (which ? Qs : Ks) + (mi * 16 + fr) * 136 + fq * 8;
      const u16* Bm = Ks + (ni * 16 + fr) * 136 + fq * 8;
      f32x4 a4 = {0.f, 0.f, 0.f, 0.f};
#pragma unroll
      for (int kk = 0; kk < 4; ++kk)
        a4 = __builtin_amdgcn_mfma_f32_16x16x32_bf16(*(const bf16x8*)(Am + kk * 32), *(const bf16x8*)(Bm + kk * 32), a4, 0, 0, 0);
      float* dst = which ? QKs : KKs;
#pragma unroll
      for (int e = 0; e < 4; ++e) dst[(mi * 16 + fq * 4 + e) * 68 + ni * 16 + fr] = a4[e];
    }
  }
  __syncthreads();
  const int itb = item * 2;
  {
    u16* AQ = (u16*)((char*)P.out + OFF_AQ);
    for (int idx = tid; idx < 8192; idx += NT) {
      const int dir = idx >> 12, p = (idx >> 6) & 63, s = idx & 63;
      const int tp = dir ? (63 - p) : p, ts = dir ? (63 - s) : s;
      const float dg = gcp[dir * 64 + p] - gcp[dir * 64 + s];
      const float dec = (p >= s) ? __expf(dg) : 0.f;
      AQ[((size_t)(itb + dir) * 64 + p) * 64 + s] = f2bf(QKs[tp * 68 + ts] * dec);
    }
    for (int idx = tid; idx < 8192; idx += NT) {
      const int dir = idx >> 12, s = (idx >> 6) & 63, p = idx & 63;
      const int tp = dir ? (63 - p) : p, ts = dir ? (63 - s) : s;
      const float dg = gcp[dir * 64 + p] - gcp[dir * 64 + s];
      const float lv = (p > s) ? bpp[dir * 64 + p] * KKs[ts * 68 + tp] * __expf(dg) : 0.f;
      Lt[dir * 4096 + s * 64 + p] = lv;
    }
    if (tid < 128) {
      float* GC = (float*)(P.ws + OFF_GC);
      GC[(size_t)(itb + (tid >> 6)) * 64 + (tid & 63)] = gcp[tid];
    }
  }
  __syncthreads();
  if (tid < 256) solve_cols<0>(P, itb, tid, Lt, bpp, gcp, Vs, Ks);
  else solve_cols<1>(P, itb, tid - 256, Lt, bpp, gcp, Vs, Ks);
}

__device__ __forceinline__ void s5end_tile(const Params& P, int t, char* lds) {
  const int g = t / 6, mt = (t % 6) >> 1, nt = t & 1;
  const int m0 = mt * 256, n0 = nt * 128;
  f32x16 acc[2][2];
  acc_zero(acc);
  gemm_main((const u16*)(P.ws + OFF_U5) + ((size_t)g * 544 + m0) * 512, 512,
            (const u16*)(P.ws + OFF_MEND) + ((size_t)g * 256 + n0) * 512, 512, 512, acc, (u16*)lds);
  TILE_COORDS
  float* E = (float*)(P.ws + OFF_E);
#pragma unroll
  for (int i = 0; i < 2; ++i)
#pragma unroll
    for (int j = 0; j < 2; ++j)
#pragma unroll
      for (int e = 0; e < 16; ++e) {
        const int row = TROW(m0, i, e);
        if (row < 544) E[((size_t)g * 544 + row) * 256 + TCOL(n0, j)] = acc[i][j][e];
      }
}

__device__ __forceinline__ void delta_scan_block(const Params& P, int sb, char* lds) {
  const int tid = opq(threadIdx.x), lane = tid & 63, w = tid >> 6, fr = lane & 15, fq = lane >> 4;
  const int bhd = sb & 31, dvq = sb >> 5;
  const int b = bhd >> 3, h = (bhd >> 1) & 3, dir = bhd & 1;
  const int wd = w & 1, wq = w >> 1;
  const int dv0 = dvq * 32 + wd * 16;
  u16* Wl = (u16*)(lds + opq(0));
  u16* QTl = (u16*)(lds + opq(17408));
  u16* KTl = (u16*)(lds + opq(34816));
  u16* AQl = (u16*)(lds + opq(53248));
  u16* ST = (u16*)(lds + opq(62464));
  u16* VT = (u16*)(lds + opq(71168));
  __syncthreads();
  for (int i = tid; i < 32 * 136 / 2; i += NT) ((uint32_t*)ST)[i] = 0u;
  f32x4 accS0 = {0.f, 0.f, 0.f, 0.f}, accS1 = {0.f, 0.f, 0.f, 0.f};
  const u16* QKN = (const u16*)((const char*)P.out + OFF_QKN);
  const u16* AQg = (const u16*)((const char*)P.out + OFF_AQ);
  const u16* Wg = (const u16*)(P.ws + OFF_R2);
  const u16* UFg = (const u16*)(P.ws + OFF_UF);
  const float* GC = (const float*)(P.ws + OFF_GC);
  u16* Og = (u16*)(P.ws + OFF_O);

  uint4 rw0, rw1, rq0, rq1, rk0, rk1, ra;
  float gq0, gq1, gk, g63;
  uint2 ru;
  int cur_row0 = 0, cur_lat = 0;
  int nxt_row0 = 0, nxt_lat = 0;

#define SCAN_PF_ONE(i)                                                                             \
    {                                                                                              \
      const int id = tid + (i) * 512;                                                              \
      const int p = id >> 4, seg = id & 15;                                                        \
      const int tk = dir ? (63 - p) : p;                                                           \
      rw##i = *(const uint4*)(Wg + it2__ * 8192 + p * 128 + seg * 8);                              \
      rq##i = *(const uint4*)(QKN + (size_t)(nxt_row0 + tk) * 1024 + h * 128 + seg * 8);           \
      gq##i = GC[it2__ * 64 + p];                                                                  \
      const int s = id & 63, sg2 = id >> 6;                                                        \
      const int tks = dir ? (63 - s) : s;                                                          \
      rk##i = *(const uint4*)(QKN + (size_t)(nxt_row0 + tks) * 1024 + 512 + h * 128 + sg2 * 8);    \
    }
#define SCAN_PREFETCH(n_)                                                                          \
  {                                                                                                \
    const int n__ = (n_);                                                                          \
    int cid__;                                                                                     \
    if (n__ < 4) { cid__ = 256 + b * 4 + (dir ? (3 - n__) : n__); nxt_lat = 0; }                   \
    else { const int m__ = n__ - 4; cid__ = b * 64 + (dir ? (63 - m__) : m__); nxt_lat = 1; }      \
    nxt_row0 = cid__ * 64;                                                                         \
    const size_t it2__ = (size_t)((cid__ * 4 + h) * 2 + dir);                                      \
    SCAN_PF_ONE(0)                                                                                 \
    SCAN_PF_ONE(1)                                                                                 \
    gk = GC[it2__ * 64 + (tid & 63)];                                                              \
    g63 = GC[it2__ * 64 + 63];                                                                     \
    ra = *(const uint4*)(AQg + it2__ * 4096 + (tid >> 3) * 64 + (tid & 7) * 8);                    \
    ru = *(const uint2*)(UFg + (it2__ * 128 + dv0 + fr) * 64 + wq * 16 + fq * 4);                  \
  }

  SCAN_PREFETCH(0)
  for (int n = 0; n < 68; ++n) {
    cur_row0 = nxt_row0; cur_lat = nxt_lat;
    const float gl = __expf(g63);
    const float sk = __expf(g63 - gk);
#define SCAN_STAGE_ONE(i)                                                     \
    {                                                                         \
      const int id = tid + (i) * 512;                                         \
      const int p = id >> 4, seg = id & 15;                                   \
      *(uint4*)(Wl + p * 136 + seg * 8) = rw##i;                              \
      float f[8];                                                             \
      unpack8(rq##i, f);                                                      \
      const float sq = __expf(gq##i);                                         \
      f[0] *= sq; f[1] *= sq; f[2] *= sq; f[3] *= sq; f[4] *= sq; f[5] *= sq; f[6] *= sq; f[7] *= sq; \
      *(uint4*)(QTl + p * 136 + seg * 8) = pack8(f);                          \
      const int s = id & 63, sg2 = id >> 6;                                   \
      unpack8(rk##i, f);                                                      \
      u16* kd = KTl + (sg2 * 8) * 72 + s;                                     \
      kd[0 * 72] = f2bf(f[0] * sk); kd[1 * 72] = f2bf(f[1] * sk); kd[2 * 72] = f2bf(f[2] * sk); kd[3 * 72] = f2bf(f[3] * sk); \
      kd[4 * 72] = f2bf(f[4] * sk); kd[5 * 72] = f2bf(f[5] * sk); kd[6 * 72] = f2bf(f[6] * sk); kd[7 * 72] = f2bf(f[7] * sk); \
    }
    SCAN_STAGE_ONE(0)
    SCAN_STAGE_ONE(1)
#undef SCAN_STAGE_ONE
    *(uint4*)(AQl + (tid >> 3) * 72 + (tid & 7) * 8) = ra;
    f32x4 av = f32x4{lo16(ru.x), hi16(ru.x), lo16(ru.y), hi16(ru.y)};
    f32x4 ao = f32x4{0.f, 0.f, 0.f, 0.f};
    __syncthreads();
    if (n + 1 < 68) SCAN_PREFETCH(n + 1)
#pragma unroll
    for (int kk = 0; kk < 4; ++kk) {
      const bf16x8 bS = *(const bf16x8*)(ST + (wd * 16 + fr) * 136 + kk * 32 + fq * 8);
      const bf16x8 a1 = *(const bf16x8*)(Wl + (wq * 16 + fr) * 136 + kk * 32 + fq * 8);
      av = __builtin_amdgcn_mfma_f32_16x16x32_bf16(a1, bS, av, 0, 0, 0);
      const bf16x8 a2 = *(const bf16x8*)(QTl + (wq * 16 + fr) * 136 + kk * 32 + fq * 8);
      ao = __builtin_amdgcn_mfma_f32_16x16x32_bf16(a2, bS, ao, 0, 0, 0);
    }
    {
      uint2 v; v.x = pack2(av[0], av[1]); v.y = pack2(av[2], av[3]);
      *(uint2*)(VT + (wd * 16 + fr) * 72 + wq * 16 + fq * 4) = v;
    }
    __syncthreads();
    accS0[0] *= gl; accS0[1] *= gl; accS0[2] *= gl; accS0[3] *= gl;
    accS1[0] *= gl; accS1[1] *= gl; accS1[2] *= gl; accS1[3] *= gl;
#pragma unroll
    for (int ks = 0; ks < 2; ++ks) {
      const bf16x8 bV = *(const bf16x8*)(VT + (wd * 16 + fr) * 72 + ks * 32 + fq * 8);
      const bf16x8 a1 = *(const bf16x8*)(AQl + (wq * 16 + fr) * 72 + ks * 32 + fq * 8);
      ao = __builtin_amdgcn_mfma_f32_16x16x32_bf16(a1, bV, ao, 0, 0, 0);
      const bf16x8 k0 = *(const bf16x8*)(KTl + ((2 * wq) * 16 + fr) * 72 + ks * 32 + fq * 8);
      accS0 = __builtin_amdgcn_mfma_f32_16x16x32_bf16(k0, bV, accS0, 0, 0, 0);
      const bf16x8 k1 = *(const bf16x8*)(KTl + ((2 * wq + 1) * 16 + fr) * 72 + ks * 32 + fq * 8);
      accS1 = __builtin_amdgcn_mfma_f32_16x16x32_bf16(k1, bV, accS1, 0, 0, 0);
    }
    {
      uint2 v; v.x = pack2(accS0[0], accS0[1]); v.y = pack2(accS0[2], accS0[3]);
      *(uint2*)(ST + (wd * 16 + fr) * 136 + (2 * wq) * 16 + fq * 4) = v;
      v.x = pack2(accS1[0], accS1[1]); v.y = pack2(accS1[2], accS1[3]);
      *(uint2*)(ST + (wd * 16 + fr) * 136 + (2 * wq + 1) * 16 + fq * 4) = v;
    }
    if (cur_lat) {
#pragma unroll
      for (int e = 0; e < 4; ++e) {
        const int p = wq * 16 + fq * 4 + e;
        const int tk = dir ? (63 - p) : p;
        Og[((size_t)dir * 16384 + cur_row0 + tk) * 512 + h * 128 + dv0 + fr] = f2bf(ao[e]);
      }
    }
    __syncthreads();
  }
#undef SCAN_PREFETCH
#undef SCAN_PF_ONE
}

__device__ __forceinline__ void s5_carry_block(const Params& P, int cb) {
  const int idx = cb * NT + opq(threadIdx.x);
  const int n = idx & 63, g = (idx >> 6) & 31, r = (idx >> 11) & 1, b = idx >> 12;
  const int rg = r * 32 + g;
  const float step = expf(P.s5_log_step[rg]);
  float lr, li;
  lam_pow(step, P.s5_a_re[rg * 64 + n], P.s5_a_im[rg * 64 + n], 32, lr, li);
  const float* E = (const float*)(P.ws + OFF_E) + (size_t)g * 544 * 256 + r * 128 + n;
  u16* XIN = (u16*)(P.ws + OFF_XIN) + (size_t)g * 512 * 256 + r * 128 + n;
  float xr = 0.f, xi = 0.f;
  for (int k = 0; k < 8; ++k) {
    const int cc = r ? (7 - k) : k;
    const int row = 512 + b * 8 + cc;
    const float er = E[(size_t)row * 256], ei = E[(size_t)row * 256 + 64];
    const float nr = lr * xr - li * xi + er, ni = lr * xi + li * xr + ei;
    xr = nr; xi = ni;
  }
  for (int k = 0; k < 128; ++k) {
    const int cc = r ? (127 - k) : k;
    const int row = b * 128 + cc;
    XIN[(size_t)row * 256] = f2bf(xr);
    XIN[(size_t)row * 256 + 64] = f2bf(xi);
    const float er = E[(size_t)row * 256], ei = E[(size_t)row * 256 + 64];
    const float nr = lr * xr - li * xi + er, ni = lr * xi + li * xr + ei;
    xr = nr; xi = ni;
  }
}

__device__ __forceinline__ void s5out_tile(const Params& P, int t, char* lds) {
  const int g = t >> 3, mt = (t >> 2) & 1, nt = t & 3;
  const int m0 = mt * 256, n0 = nt * 128;
  f32x16 acc[2][2];
  acc_zero(acc);
  gemm_main((const u16*)(P.ws + OFF_XIN) + ((size_t)g * 512 + m0) * 256, 256,
            (const u16*)(P.ws + OFF_MST) + ((size_t)g * 512 + n0) * 256, 256, 256, acc, (u16*)lds);
  gemm_main((const u16*)(P.ws + OFF_U5) + ((size_t)g * 544 + m0) * 512, 512,
            (const u16*)(P.ws + OFF_MINTRA) + ((size_t)g * 512 + n0) * 512, 512, 512, acc, (u16*)lds);
  TILE_COORDS
  u16* YB = (u16*)(P.ws + OFF_YB);
#pragma unroll
  for (int i = 0; i < 2; ++i)
#pragma unroll
    for (int j = 0; j < 2; ++j)
#pragma unroll
      for (int e = 0; e < 16; ++e) {
        const int row = TROW(m0, i, e), nn = TCOL(n0, j);
        const int token = row * 32 + (nn >> 4);
        YB[(size_t)token * 512 + g * 16 + (nn & 15)] = f2bf(gelu_tanh(acc[i][j][e]));
      }
}

__device__ __forceinline__ void delta_post_item(const Params& P, int item) {
  const int lane = opq(threadIdx.x) & 63, w = opq(threadIdx.x) >> 6;
  const int row = item * 8 + w;
  const u16* O = (const u16*)(P.ws + OFF_O);
  const uint4 o0 = *(const uint4*)(O + (size_t)row * 512 + lane * 8);
  const uint4 o1 = *(const uint4*)(O + ((size_t)16384 + row) * 512 + lane * 8);
  const uint4 zz = *(const uint4*)((const u16*)(P.ws + OFF_Z) + (size_t)row * 512 + lane * 8);
  float a[8], bq[8], z[8];
  unpack8(o0, a); unpack8(o1, bq); unpack8(zz, z);
  float ss = 0.f;
#pragma unroll
  for (int e = 0; e < 8; ++e) { a[e] += bq[e]; ss += a[e] * a[e]; }
  ss += __shfl_xor(ss, 1, 64); ss += __shfl_xor(ss, 2, 64); ss += __shfl_xor(ss, 4, 64); ss += __shfl_xor(ss, 8, 64);
  const float rstd = rsqrtf(ss * (1.f / 128.f) + 1e-6f);
  const float* nw = P.dn_norm_w + (lane & 15) * 8;
  float y[8];
#pragma unroll
  for (int e = 0; e < 8; ++e) y[e] = a[e] * rstd * nw[e] * (z[e] * sigm(z[e]));
  *(uint4*)((u16*)(P.ws + OFF_YA) + (size_t)row * 512 + lane * 8) = pack8(y);
}

__device__ __forceinline__ void glu_tile(const Params& P, int t, char* lds) {
  const int nt = t >> 6, mt = t & 63;
  const int m0 = mt * 256, n0 = nt * 128;
  f32x16 acc[2][2];
  acc_zero(acc);
  gemm_main((const u16*)(P.ws + OFF_YB) + (size_t)m0 * 512, 512, (const u16*)(P.ws + OFF_WT_GLU) + (size_t)n0 * 512, 512, 512, acc, (u16*)lds);
  TILE_COORDS
  u16* YG = (u16*)(P.ws + OFF_YG);
  {
    const int oc = nt * 64 + wn_ * 32 + fr_;
    const float bv = P.b_glu[oc], bg = P.b_glu[512 + oc];
#pragma unroll
    for (int i = 0; i < 2; ++i)
#pragma unroll
      for (int e = 0; e < 16; ++e) {
        const float val = acc[i][0][e] + bv, gt = acc[i][1][e] + bg;
        YG[(size_t)TROW(m0, i, e) * 512 + oc] = f2bf(val * sigm(gt));
      }
  }
}

__device__ __forceinline__ void gates_tile(const Params& P, int t, char* lds) {
  const int nt = t >> 6, mt = t & 63;
  const int m0 = mt * 256, n0 = nt * 128;
  f32x16 acc[2][2];
  acc_zero(acc);
  gemm_main((const u16*)(P.ws + OFF_R2) + (size_t)m0 * 1024, 1024, (const u16*)(P.ws + OFF_WT_IN) + (size_t)(2688 + n0) * 1024, 1024, 1024, acc, (u16*)lds);
  TILE_COORDS
  u16* SG = (u16*)(P.ws + OFF_SG);
#pragma unroll
  for (int i = 0; i < 2; ++i)
#pragma unroll
    for (int j = 0; j < 2; ++j)
#pragma unroll
      for (int e = 0; e < 16; ++e) SG[(size_t)TROW(m0, i, e) * 2048 + TCOL(n0, j)] = f2bf(sigm(acc[i][j][e]));
}

__device__ __forceinline__ void mix_tile(const Params& P, int t, char* lds) {
  const int nt = t >> 6, mt = t & 63;
  const int m0 = mt * 256, n0 = nt * 128;
  const u16* SG = (const u16*)(P.ws + OFF_SG);
  f32x16 acc[2][2];
  u16* MIX = (u16*)(P.ws + OFF_MIX);
  acc_zero(acc);
  gemm_main((const u16*)(P.ws + OFF_YA) + (size_t)m0 * 512, 512, (const u16*)(P.ws + OFF_WT_AOUT) + (size_t)n0 * 512, 512, 512, acc, (u16*)lds);
  {
    TILE_COORDS
#pragma unroll
    for (int i = 0; i < 2; ++i)
#pragma unroll
      for (int j = 0; j < 2; ++j)
#pragma unroll
        for (int e = 0; e < 16; ++e) {
          const int r = TROW(m0, i, e), col = TCOL(n0, j);
          MIX[(size_t)r * 1024 + col] = f2bf(bf2f(SG[(size_t)r * 2048 + col]) * acc[i][j][e]);
        }
  }
  acc_zero(acc);
  gemm_main((const u16*)(P.ws + OFF_YG) + (size_t)m0 * 512, 512, (const u16*)(P.ws + OFF_WT_BOUT) + (size_t)n0 * 512, 512, 512, acc, (u16*)lds);
  {
    TILE_COORDS
#pragma unroll
    for (int i = 0; i < 2; ++i)
#pragma unroll
      for (int j = 0; j < 2; ++j)
#pragma unroll
        for (int e = 0; e < 16; ++e) {
          const int r = TROW(m0, i, e), col = TCOL(n0, j);
          const size_t o = (size_t)r * 1024 + col;
          MIX[o] = f2bf(bf2f(MIX[o]) + bf2f(SG[(size_t)r * 2048 + 1024 + col]) * acc[i][j][e]);
        }
  }
}

__device__ __forceinline__ void wo_tile(const Params& P, int t, char* lds) {
  const int nt = t >> 6, mt = t & 63;
  const int m0 = mt * 256, n0 = nt * 128;
  f32x16 acc[2][2];
  acc_zero(acc);
  gemm_main((const u16*)(P.ws + OFF_MIX) + (size_t)m0 * 1024, 1024, (const u16*)(P.ws + OFF_WT_O) + (size_t)n0 * 1024, 1024, 1024, acc, (u16*)lds);
  TILE_COORDS
  const float* MOD = (const float*)(P.ws + OFF_MOD) + (m0 >> 12) * 6144 + 2 * 1024;
#pragma unroll
  for (int j = 0; j < 2; ++j) {
    const int col = TCOL(n0, j);
    const float gate = MOD[col];
#pragma unroll
    for (int i = 0; i < 2; ++i)
#pragma unroll
      for (int e = 0; e < 16; ++e) {
        const size_t o = (size_t)TROW(m0, i, e) * 1024 + col;
        P.out[o] = P.x[o] + gate * acc[i][j][e];
      }
  }
}

__device__ __forceinline__ void norm2_item(const Params& P, int item) {
  const int lane = opq(threadIdx.x) & 63, w = opq(threadIdx.x) >> 6;
  const int row = item * 8 + w;
  const float* MOD = (const float*)(P.ws + OFF_MOD) + (row >> 12) * 6144;
  norm_row(P.out + (size_t)row * 1024, P.norm2_w, MOD + 3 * 1024, MOD + 4 * 1024, (u16*)(P.ws + OFF_R2) + (size_t)row * 1024, lane);
}

__device__ __forceinline__ void up_tile(const Params& P, int t, int hh, char* lds) {
  const int nt = t >> 6, mt = t & 63;
  const int m0 = mt * 256, n0 = nt * 128;
  f32x16 acc[2][2];
  acc_zero(acc);
  gemm_main((const u16*)(P.ws + OFF_R2) + (size_t)m0 * 1024, 1024,
            (const u16*)(P.ws + OFF_WT_UP) + ((size_t)hh * 2816 + n0) * 1024, 1024, 1024, acc, (u16*)lds);
  TILE_COORDS
  u16* UPH = (u16*)(P.ws + OFF_UPH);
#pragma unroll
  for (int i = 0; i < 2; ++i)
#pragma unroll
    for (int j = 0; j < 2; ++j)
#pragma unroll
      for (int e = 0; e < 16; ++e) UPH[(size_t)TROW(m0, i, e) * 2816 + TCOL(n0, j)] = f2bf(acc[i][j][e]);
}

#define CG_LD(ci, dy)                                                                       \
    {                                                                                       \
      const int xc = x0 - 1 + (ci);                                                         \
      const bool cok = (xc >= 0) && (xc <= 63);                                             \
      const bool rok = ((dy) == 1) || ((dy) == 0 ? r0ok : r2ok);                            \
      const int yy = rok ? (y + (dy) - 1) : y;                                              \
      const u16* src = UPH + (base + (size_t)yy * 64 + (cok ? xc : x0)) * 2816 + c4;        \
      uint2 g__ = *(const uint2*)src;                                                       \
      uint2 v__ = *(const uint2*)(src + 1408);                                              \
      const bool ok = cok && rok;                                                           \
      g__.x = ok ? g__.x : 0u; g__.y = ok ? g__.y : 0u;                                     \
      v__.x = ok ? v__.x : 0u; v__.y = ok ? v__.y : 0u;                                     \
      gg[ci][dy] = g__; vv[ci][dy] = v__;                                                   \
    }
__device__ __forceinline__ void convgate_item(const Params& P, int item, int hh) {
  const int tid = opq(threadIdx.x);
  if (tid >= 352) return;
  const int xo = item & 15, y = (item >> 4) & 63, b = item >> 10;
  const int c4 = tid * 4;
  const u16* UPH = (const u16*)(P.ws + OFF_UPH);
  u16* G = (u16*)(P.ws + OFF_G);
  const size_t base = (size_t)b * 4096;
  const bool r0ok = (y > 0), r2ok = (y < 63);
  const int x0 = xo * 4;
  uint2 gg[6][3], vv[6][3];
#pragma unroll
  for (int ci = 0; ci < 6; ++ci) {
    CG_LD(ci, 0)
    CG_LD(ci, 1)
    CG_LD(ci, 2)
  }
  float wg[9][4], wv[9][4];
#pragma unroll
  for (int k = 0; k < 9; ++k) {
    const float4 a = *(const float4*)(P.ffn_conv_w + (size_t)k * 5632 + hh * 1408 + c4);
    const float4 bq = *(const float4*)(P.ffn_conv_w + (size_t)k * 5632 + 2816 + hh * 1408 + c4);
    wg[k][0] = a.x; wg[k][1] = a.y; wg[k][2] = a.z; wg[k][3] = a.w;
    wv[k][0] = bq.x; wv[k][1] = bq.y; wv[k][2] = bq.z; wv[k][3] = bq.w;
  }
#pragma unroll
  for (int xx = 0; xx < 4; ++xx) {
    float ag[4] = {0.f, 0.f, 0.f, 0.f}, av[4] = {0.f, 0.f, 0.f, 0.f};
#pragma unroll
    for (int dy = 0; dy < 3; ++dy)
#pragma unroll
      for (int dx = 0; dx < 3; ++dx) {
        const uint2 gq = gg[xx + dx][dy], vq = vv[xx + dx][dy];
        const int k = dy * 3 + dx;
        ag[0] += wg[k][0] * lo16(gq.x); ag[1] += wg[k][1] * hi16(gq.x); ag[2] += wg[k][2] * lo16(gq.y); ag[3] += wg[k][3] * hi16(gq.y);
        av[0] += wv[k][0] * lo16(vq.x); av[1] += wv[k][1] * hi16(vq.x); av[2] += wv[k][2] * lo16(vq.y); av[3] += wv[k][3] * hi16(vq.y);
      }
    uint2 o;
    o.x = pack2(ag[0] * sigm(ag[0]) * av[0], ag[1] * sigm(ag[1]) * av[1]);
    o.y = pack2(ag[2] * sigm(ag[2]) * av[2], ag[3] * sigm(ag[3]) * av[3]);
    *(uint2*)(G + (base + y * 64 + x0 + xx) * 2816 + hh * 1408 + c4) = o;
  }
}
#undef CG_LD

__device__ __forceinline__ void down_tile(const Params& P, int t, char* lds) {
  const int nt = t >> 6, mt = t & 63;
  const int m0 = mt * 256, n0 = nt * 128;
  f32x16 acc[2][2];
  acc_zero(acc);
  gemm_main((const u16*)(P.ws + OFF_G) + (size_t)m0 * 2816, 2816, (const u16*)(P.ws + OFF_WT_DOWN) + (size_t)n0 * 2816, 2816, 2816, acc, (u16*)lds);
  TILE_COORDS
  const float* MOD = (const float*)(P.ws + OFF_MOD) + (m0 >> 12) * 6144 + 5 * 1024;
#pragma unroll
  for (int j = 0; j < 2; ++j) {
    const int col = TCOL(n0, j);
    const float gate = MOD[col];
#pragma unroll
    for (int i = 0; i < 2; ++i)
#pragma unroll
      for (int e = 0; e < 16; ++e) {
        const size_t o = (size_t)TROW(m0, i, e) * 1024 + col;
        P.out[o] = P.out[o] + gate * acc[i][j][e];
      }
  }
}

__device__ __forceinline__ void final_item(const Params& P, int item) {
  const int lane = opq(threadIdx.x) & 63, w = opq(threadIdx.x) >> 6;
  const int row = item * 8 + w;
  float* xr = P.out + (size_t)row * 1024;
  float4 v[4];
  float ss = 0.f;
#pragma unroll
  for (int it = 0; it < 4; ++it) {
    v[it] = *(const float4*)(xr + (it * 64 + lane) * 4);
    ss += v[it].x * v[it].x + v[it].y * v[it].y + v[it].z * v[it].z + v[it].w * v[it].w;
  }
  ss = wsum64(ss);
  const float rstd = rsqrtf(ss * (1.f / 1024.f) + 1e-6f);
#pragma unroll
  for (int it = 0; it < 4; ++it) {
    const int c = (it * 64 + lane) * 4;
    const float4 w4 = *(const float4*)(P.norm_f_w + c);
    float4 o;
    o.x = v[it].x * rstd * w4.x; o.y = v[it].y * rstd * w4.y; o.z = v[it].z * rstd * w4.z; o.w = v[it].w * rstd * w4.w;
    *(float4*)(xr + c) = o;
  }
}

__device__ __forceinline__ void run_phase(const Params& P, int ph, char* lds) {
  const int bid = blockIdx.x, nb = gridDim.x;
#ifdef ONLY_PHASE
  if (ph != ONLY_PHASE) return;
#endif
  switch (ph) {
    case 0: {
      for (int it = bid; it < 984 + 192 + 2048; it += nb) {
        if (it < 296) convert_item(P.w_in, 1024, 4624, (u16*)(P.ws + OFF_WT_IN), 0, it, lds);
        else if (it < 328) convert_item(P.w_a_out, 512, 1024, (u16*)(P.ws + OFF_WT_AOUT), 1, it - 296, lds);
        else if (it < 360) convert_item(P.w_glu, 512, 1024, (u16*)(P.ws + OFF_WT_GLU), 2, it - 328, lds);
        else if (it < 392) convert_item(P.w_b_out, 512, 1024, (u16*)(P.ws + OFF_WT_BOUT), 3, it - 360, lds);
        else if (it < 456) convert_item(P.w_o, 1024, 1024, (u16*)(P.ws + OFF_WT_O), 4, it - 392, lds);
        else if (it < 808) convert_item(P.w_up, 1024, 5632, (u16*)(P.ws + OFF_WT_UP), 5, it - 456, lds);
        else if (it < 984) convert_item(P.w_down, 2816, 1024, (u16*)(P.ws + OFF_WT_DOWN), 6, it - 808, lds);
        else if (it < 1176) mod_item(P, it - 984, lds);
        else s5tab_item(P, it - 1176, lds);
      }
    } break;
    case 1:
      for (int it = bid; it < 2176 + 2048; it += nb) {
        if (it < 2176) norm1_item(P, it); else mintra_item(P, it - 2176);
      }
      break;
    case 2:
      for (int it = bid; it < 1396; it += nb) inproj_tile(P, it, lds);
      break;
    case 3:
      for (int it = bid; it < 1088 + 192; it += nb) {
        if (it < 1088) delta_prep_item(P, it, lds); else s5end_tile(P, it - 1088, lds);
      }
      break;
    case 4:
      if (bid < 128) delta_scan_block(P, bid, lds);
      else if (bid < 160) s5_carry_block(P, bid - 128);
      break;
    case 5:
      for (int it = bid; it < 256 + 2048 + 2048; it += nb) {
        if (it < 256) s5out_tile(P, it, lds);
        else if (it < 2304) delta_post_item(P, it - 256);
        else norm1_item(P, it - 2304);
      }
      break;
    case 6:
      for (int it = bid; it < 512 + 1024; it += nb) {
        if (it < 512) glu_tile(P, it, lds); else gates_tile(P, it - 512, lds);
      }
      break;
    case 7:
      for (int it = bid; it < 512; it += nb) mix_tile(P, it, lds);
      break;
    case 8:
      for (int it = bid; it < 512; it += nb) wo_tile(P, it, lds);
      break;
    case 9:
      for (int it = bid; it < 2048; it += nb) norm2_item(P, it);
      break;
    case 10:
      for (int it = bid; it < 1408; it += nb) up_tile(P, it, 0, lds);
      break;
    case 11:
      for (int it = bid; it < 4096; it += nb) convgate_item(P, it, 0);
      break;
    case 12:
      for (int it = bid; it < 1408; it += nb) up_tile(P, it, 1, lds);
      break;
    case 13:
      for (int it = bid; it < 4096; it += nb) convgate_item(P, it, 1);
      break;
    case 14:
      for (int it = bid; it < 512; it += nb) down_tile(P, it, lds);
      break;
    case 15:
      for (int it = bid; it < 2048; it += nb) final_item(P, it);
      break;
    default: break;
  }
}

typedef const __attribute__((address_space(4))) Params* KParamsPtr;
__global__ void __launch_bounds__(NT) fwd_megakernel(Params Pk) {
#if defined(__HIP_DEVICE_COMPILE__)
  extern __shared__ __attribute__((aligned(16))) char lds[];
  KParamsPtr pp = (KParamsPtr)__builtin_amdgcn_kernarg_segment_ptr();
  const int lo = (int)pp->ph_lo, hi = (int)pp->ph_hi;
#if MULTI_LAUNCH
  for (int ph = lo; ph < hi; ++ph) { KParamsPtr q = pp; asm volatile("" : "+s"(q)); Params P; for (int i_ = 0; i_ < (int)(sizeof(Params) / 8); ++i_) ((unsigned long long*)&P)[i_] = ((const __attribute__((address_space(4))) unsigned long long*)q)[i_]; run_phase(P, ph, lds); }
#else
  cg::grid_group grid = cg::this_grid();
  volatile LAS unsigned* xst = (volatile LAS unsigned*)(lds + (LDS_BYTES - 16));
  if (threadIdx.x == 0) { xst[0] = 0u; xst[1] = 0u; xst[2] = 0u; xst[3] = 0u; }
  __syncthreads();
  XcdBarrier xb = xcd_barrier_post((unsigned*)(pp->ws + OFF_BAR), xst);
  const unsigned rep_mask = (unsigned)pp->rep_mask;
  bool first_sync = true;
  for (int ph = lo; ph < hi; ++ph) {
    const int reps = 1 + (int)((rep_mask >> ph) & 1u);
    for (int rp = 0; rp < reps; ++rp) {
      {
        KParamsPtr q = pp;
        asm volatile("" : "+s"(q));
        Params P;
        {
          typedef __attribute__((address_space(1))) const float* GF;
          const float** dp = (const float**)&P;
          const __attribute__((address_space(4))) unsigned long long* sp = (const __attribute__((address_space(4))) unsigned long long*)q;
#pragma unroll
          for (int i_ = 0; i_ < 30; ++i_) dp[i_] = (const float*)(GF)(sp[i_]);
          P.out = (float*)(__attribute__((address_space(1))) float*)(sp[30]);
          P.ws = (char*)(__attribute__((address_space(1))) char*)(sp[31]);
          P.ph_lo = 0; P.ph_hi = 0; P.rep_mask = 0;
        }
        run_phase(P, ph, lds);
      }
      if (ph + 1 < hi || rp + 1 < reps) {
        if (first_sync) { grid.sync(); first_sync = false; }
        else xcd_barrier(xb);
      }
    }
  }
#endif
#endif
}

extern "C" void kernel_launch(void* const* d_in, const int* in_sizes, int n_in, void* d_out, int out_size, void* d_ws,
                              size_t ws_size, hipStream_t stream) {
  static int grid_blocks = 0;
  if (grid_blocks == 0) {
    if (n_in != 30 || out_size != 16384 * 1024 || ws_size < WS_NEED) {
      fprintf(stderr, "kernel_launch: unexpected shapes: n_in %d out %d ws %zu (need %zu)\n", n_in, out_size, ws_size, (size_t)WS_NEED);
      grid_blocks = -1;
      return;
    }
    int dev = 0, cus = 0, per_cu = 0;
    hipGetDevice(&dev);
    hipDeviceGetAttribute(&cus, hipDeviceAttributeMultiprocessorCount, dev);
    if (hipFuncSetAttribute((const void*)fwd_megakernel, hipFuncAttributeMaxDynamicSharedMemorySize, LDS_BYTES) != hipSuccess) {
      fprintf(stderr, "kernel_launch: hipFuncSetAttribute failed\n");
      grid_blocks = -1;
      return;
    }
    if (hipOccupancyMaxActiveBlocksPerMultiprocessor(&per_cu, (const void*)fwd_megakernel, NT, LDS_BYTES) != hipSuccess || per_cu < 1) {
      fprintf(stderr, "kernel_launch: occupancy query failed / zero (%d)\n", per_cu);
      grid_blocks = -1;
      return;
    }
    grid_blocks = cus;
    if (grid_blocks < 64) { fprintf(stderr, "kernel_launch: too few CUs (%d)\n", cus); grid_blocks = -1; return; }
  }
  if (grid_blocks < 0) return;
  (void)hipMemsetAsync((char*)d_ws + OFF_BAR, 0, XCD_BAR_WORDS * sizeof(unsigned), stream);
  Params p{};
  const float** pp = (const float**)&p;
  for (int i = 0; i < 30; ++i) pp[i] = (const float*)d_in[i];
  p.out = (float*)d_out;
  p.ws = (char*)d_ws;
#if MULTI_LAUNCH
  for (int ph = 0; ph < 16; ++ph) {
    p.ph_lo = ph; p.ph_hi = ph + 1;
    hipLaunchKernelGGL(fwd_megakernel, dim3(grid_blocks), dim3(NT), LDS_BYTES, stream, p);
  }
#else
  p.ph_lo = 0; p.ph_hi = 16;
#ifdef REPEAT_MASK
  p.rep_mask = REPEAT_MASK;
#endif
  void* args[] = {&p};
  hipError_t e = hipLaunchCooperativeKernel((const void*)fwd_megakernel, dim3(grid_blocks), dim3(NT), args, LDS_BYTES, stream);
  if (e != hipSuccess) fprintf(stderr, "cooperative launch failed: %s (grid %d)\n", hipGetErrorString(e), grid_blocks);
#endif
}
```

```cpp
#include <hip/hip_runtime.h>
#include <hip/hip_cooperative_groups.h>
#include <cstdio>
#include <cstdint>
namespace cg = cooperative_groups;

#ifndef MULTI_LAUNCH
#define MULTI_LAUNCH 0
#endif

typedef unsigned short u16;
typedef __attribute__((ext_vector_type(8))) short bf16x8;
typedef __attribute__((ext_vector_type(4))) float f32x4;
typedef __attribute__((ext_vector_type(16))) float f32x16;

#define NT 512
constexpr int LDS_BYTES = 131072 + 1024;
constexpr int NPHASE = 18;

constexpr size_t OFF_WT_IN   = 0;
constexpr size_t OFF_WT_AOUT = 9699328;
constexpr size_t OFF_WT_GLU  = 10747904;
constexpr size_t OFF_WT_BOUT = 11796480;
constexpr size_t OFF_WT_O    = 12845056;
constexpr size_t OFF_WT_UP   = 14942208;
constexpr size_t OFF_WT_DOWN = 26476544;
constexpr size_t OFF_MOD     = 32243712;
constexpr size_t OFF_BAR     = 32505856;
constexpr size_t OFF_R2      = 33554432;
constexpr size_t OFF_R1      = 69206016;
constexpr size_t OFF_KTAB    = OFF_R1;
constexpr size_t OFF_MEND    = OFF_R1 + 2097152;
constexpr size_t OFF_MST     = OFF_R1 + 10485760;
constexpr size_t OFF_MINTRA  = OFF_R1 + 18874368;
constexpr size_t OFF_R3      = 104857600;
constexpr size_t OFF_O       = OFF_R3;
constexpr size_t OFF_XIN     = OFF_R3 + 33554432;
constexpr size_t OFF_MIX     = 158334976;
constexpr size_t OFF_SG      = OFF_R1;
constexpr size_t OFF_Z       = 158334976;
constexpr size_t OFF_U5      = 175112192;
constexpr size_t OFF_BA      = 192937984;
constexpr size_t OFF_GC      = OFF_BA + 1179648;
constexpr size_t OFF_UF      = 195035136;
constexpr size_t OFF_YA      = OFF_UF;
constexpr size_t OFF_YB      = OFF_UF + 16777216;
constexpr size_t OFF_E       = 230686720;
constexpr size_t OFF_YG      = OFF_E;
constexpr size_t OFF_UPH     = OFF_R1;
constexpr size_t OFF_G       = 161480704;
constexpr size_t WS_NEED     = 253755392;
constexpr size_t OFF_QKN     = 0;
constexpr size_t OFF_AQ      = 35651584;

struct Params {
  const float *x, *c, *ctx, *c_ctx, *w_ada, *b_ada, *norm1_w, *w_in, *dn_conv_w, *dn_a_log, *dn_dt_bias, *dn_norm_w,
      *w_a_out, *s5_a_re, *s5_a_im, *s5_log_step, *s5_b_re, *s5_b_im, *s5_c_re, *s5_c_im, *s5_d, *w_glu, *b_glu,
      *w_b_out, *w_o, *norm2_w, *w_up, *ffn_conv_w, *w_down, *norm_f_w;
  float* out;
  char* ws;
  long long ph_lo, ph_hi;
  long long rep_mask;
};

#define XB_TMO      128
#define XB_XCNT(j)  (256  + 64 * (j))
#define XB_XSUB(j)  (1280 + 64 * (j))
#define XB_XGEN(j)  (2304 + 64 * (j))
#define XB_TOP      3328
#define XB_TOPGEN   3392
#define XCD_BAR_WORDS 3456
#define XB_SPIN_CAP (1u << 18)
#define LAS __attribute__((address_space(3)))

__device__ __forceinline__ unsigned xb_ld(unsigned* p)              { return __hip_atomic_load(p, __ATOMIC_RELAXED, __HIP_MEMORY_SCOPE_AGENT); }
__device__ __forceinline__ unsigned xb_add(unsigned* p, unsigned v) { return __hip_atomic_fetch_add(p, v, __ATOMIC_RELAXED, __HIP_MEMORY_SCOPE_AGENT); }
__device__ __forceinline__ unsigned xb_xcc_id() { return (unsigned)__builtin_amdgcn_s_getreg((3 << 11) | 20) & 0xFu; }
#define XB_SPIN(cond, bar) do { unsigned _sp = 0; while (cond) { __builtin_amdgcn_s_sleep(1); \
    if ((++_sp & 255u) == 0u) { if (xb_ld(&(bar)[XB_TMO])) break; if (_sp > XB_SPIN_CAP) { atomicAdd(&(bar)[XB_TMO], 1u); break; } } } } while (0)

struct XcdBarrier {
    unsigned* bar; unsigned x;
    volatile LAS unsigned* st;
};

__device__ __forceinline__ XcdBarrier xcd_barrier_post(unsigned* bar, volatile LAS unsigned* st) {
    XcdBarrier b; b.bar = bar; b.x = xb_xcc_id(); b.st = st;
    if (threadIdx.x == 0) (void)xb_add(&bar[XB_XCNT(b.x)], 1u);
    return b;
}
__device__ __forceinline__ void xcd_barrier_complete(unsigned* bar, unsigned x, unsigned& nloc, unsigned& nx) {
    const unsigned G = gridDim.x * gridDim.y * gridDim.z;
    unsigned sum, cnt, mine, sp = 0u;
    for (;;) {
        sum = 0u; cnt = 0u; mine = 0u;
#pragma unroll
        for (unsigned j = 0; j < 16; ++j) { const unsigned c = xb_ld(&bar[XB_XCNT(j)]); sum += c; cnt += (c > 0u) ? 1u : 0u; mine = (j == x) ? c : mine; }
        if (sum == G) break;
        __builtin_amdgcn_s_sleep(1);
        if ((++sp & 255u) == 0u) { if (xb_ld(&bar[XB_TMO])) break; if (sp > XB_SPIN_CAP) { atomicAdd(&bar[XB_TMO], 1u); break; } }
    }
    nloc = mine > 0u ? mine : 1u; nx = cnt > 0u ? cnt : 1u;
}

__device__ __forceinline__ void xcd_barrier(const XcdBarrier& b) {
    asm volatile("s_waitcnt vmcnt(0)" ::: "memory");
    __syncthreads();
    if (threadIdx.x == 0) {
        unsigned* bar = b.bar;
        __builtin_amdgcn_s_waitcnt(0);
        unsigned nloc = b.st[0], nx = b.st[1];
        if (nloc == 0u) { xcd_barrier_complete(bar, b.x, nloc, nx); b.st[0] = nloc; b.st[1] = nx; }
        const unsigned old = xb_add(&bar[XB_XSUB(b.x)], 1u);
        const unsigned gen = old / nloc;
        if (old + 1u == (gen + 1u) * nloc) {
            __builtin_amdgcn_fence(__ATOMIC_RELEASE, "agent");
            asm volatile("s_waitcnt vmcnt(0)" ::: "memory");
            const unsigned og = xb_add(&bar[XB_TOP], 1u);
            const unsigned tg = og / nx;
            if (og + 1u == (tg + 1u) * nx) xb_add(&bar[XB_TOPGEN], 1u);
            else XB_SPIN(xb_ld(&bar[XB_TOPGEN]) == tg, bar);
            __builtin_amdgcn_fence(__ATOMIC_ACQUIRE, "agent");
            xb_add(&bar[XB_XGEN(b.x)], 1u);
            asm volatile("s_waitcnt vmcnt(0)" ::: "memory");
        } else {
            XB_SPIN(xb_ld(&bar[XB_XGEN(b.x)]) == gen, bar);
            __builtin_amdgcn_fence(__ATOMIC_ACQUIRE, "agent");
            asm volatile("s_waitcnt vmcnt(0)" ::: "memory");
        }
    }
    __syncthreads();
}


__device__ __forceinline__ u16 f2bf(float f) {
  uint32_t u = __float_as_uint(f);
  u += 0x7fffu + ((u >> 16) & 1u);
  return (u16)(u >> 16);
}
__device__ __forceinline__ float bf2f(u16 h) { return __uint_as_float(((uint32_t)h) << 16); }
__device__ __forceinline__ uint32_t pack2(float a, float b) { return (uint32_t)f2bf(a) | ((uint32_t)f2bf(b) << 16); }
__device__ __forceinline__ float lo16(uint32_t w) { return __uint_as_float(w << 16); }
__device__ __forceinline__ float hi16(uint32_t w) { return __uint_as_float(w & 0xffff0000u); }
__device__ __forceinline__ int opq(int v) { asm volatile("" : "+v"(v)); return v; }
__device__ __forceinline__ float sigm(float x) { return 1.f / (1.f + __expf(-x)); }
__device__ __forceinline__ void unpack8(uint4 v, float* f) {
  f[0] = lo16(v.x); f[1] = hi16(v.x); f[2] = lo16(v.y); f[3] = hi16(v.y);
  f[4] = lo16(v.z); f[5] = hi16(v.z); f[6] = lo16(v.w); f[7] = hi16(v.w);
}
__device__ __forceinline__ uint4 pack8(const float* f) {
  uint4 v; v.x = pack2(f[0], f[1]); v.y = pack2(f[2], f[3]); v.z = pack2(f[4], f[5]); v.w = pack2(f[6], f[7]);
  return v;
}
__device__ __forceinline__ float wsum64(float v) {
#pragma unroll
  for (int o = 32; o > 0; o >>= 1) v += __shfl_xor(v, o, 64);
  return v;
}
__device__ __forceinline__ float gelu_tanh(float x) {
  float u = 0.7978845608028654f * (x + 0.044715f * x * x * x);
  float t = 1.f - 2.f / (1.f + __expf(2.f * u));
  return 0.5f * x * (1.f + t);
}

__device__ __forceinline__ void g_frag(const u16* as, const u16* bs, int ks, bf16x8 (&a)[2], bf16x8 (&b)[2]) {
  a[0] = *(const bf16x8*)(as + ks * 16);
  a[1] = *(const bf16x8*)(as + 32 * 72 + ks * 16);
  b[0] = *(const bf16x8*)(bs + ks * 16);
  b[1] = *(const bf16x8*)(bs + 32 * 72 + ks * 16);
}
__device__ __forceinline__ void g_mma(const bf16x8 (&a)[2], const bf16x8 (&b)[2], f32x16 (&acc)[2][2]) {
  acc[0][0] = __builtin_amdgcn_mfma_f32_32x32x16_bf16(a[0], b[0], acc[0][0], 0, 0, 0);
  acc[0][1] = __builtin_amdgcn_mfma_f32_32x32x16_bf16(a[0], b[1], acc[0][1], 0, 0, 0);
  acc[1][0] = __builtin_amdgcn_mfma_f32_32x32x16_bf16(a[1], b[0], acc[1][0], 0, 0, 0);
  acc[1][1] = __builtin_amdgcn_mfma_f32_32x32x16_bf16(a[1], b[1], acc[1][1], 0, 0, 0);
}
__device__ __forceinline__ void gemm_main(const u16* __restrict__ A, int lda, const u16* __restrict__ Bt, int ldb, int K,
                                          f32x16 (&acc)[2][2], u16* lds) {
  const int tid = opq(threadIdx.x), lane = tid & 63, w = tid >> 6, wm = w >> 1, wn = w & 1, fr = lane & 31, fq = lane >> 5;
  u16* As = lds;
  u16* Bs = lds + 2 * 256 * 72;
  const int nk = K >> 6;
  uint4 p0, p1, p2, p3, p4, p5;
  uint4 q0, q1, q2, q3, q4, q5;
  uint4 r0, r1, r2, r3, r4, r5;
  const int lr = tid >> 3, lc = (tid & 7) * 8;
  const unsigned oa0 = (unsigned)(lr * lda + lc) * 2u, sa2 = (unsigned)lda * 128u;
  const unsigned oa1 = oa0 + sa2, oa2 = oa0 + 2u * sa2, oa3 = oa0 + 3u * sa2;
  const unsigned ob0 = (unsigned)(lr * ldb + lc) * 2u, ob1 = ob0 + (unsigned)ldb * 128u;
#define G_LOAD(S, kt_)                                          \
  {                                                             \
    const int kc_ = ((kt_) < nk) ? (kt_) : (nk - 1);            \
    const char* a_ = (const char*)A + kc_ * 128;                \
    const char* b_ = (const char*)Bt + kc_ * 128;               \
    S##0 = *(const uint4*)(a_ + oa0);                           \
    S##1 = *(const uint4*)(a_ + oa1);                           \
    S##2 = *(const uint4*)(a_ + oa2);                           \
    S##3 = *(const uint4*)(a_ + oa3);                           \
    S##4 = *(const uint4*)(b_ + ob0);                           \
    S##5 = *(const uint4*)(b_ + ob1);                           \
  }
#define G_STORE(S, buf_)                                                     \
  {                                                                          \
    u16* as_ = As + ((buf_) * 256 + lr) * 72 + lc;                           \
    u16* bs_ = Bs + ((buf_) * 128 + lr) * 72 + lc;                           \
    *(uint4*)(as_) = S##0;                                                   \
    *(uint4*)(as_ + 64 * 72) = S##1;                                         \
    *(uint4*)(as_ + 128 * 72) = S##2;                                        \
    *(uint4*)(as_ + 192 * 72) = S##3;                                        \
    *(uint4*)(bs_) = S##4;                                                   \
    *(uint4*)(bs_ + 64 * 72) = S##5;                                         \
  }
#define G_STEP(S, BUF, kt_)                                                               \
  {                                                                                       \
    const u16* as = As + ((BUF) * 256 + wm * 64 + fr) * 72 + fq * 8;                      \
    const u16* bs = Bs + ((BUF) * 128 + wn * 64 + fr) * 72 + fq * 8;                      \
    bf16x8 fa0[2], fb0[2], fa1[2], fb1[2], fa2[2], fb2[2];                                \
    g_frag(as, bs, 0, fa0, fb0);                                                          \
    g_frag(as, bs, 1, fa1, fb1);                                                          \
    __builtin_amdgcn_sched_barrier(0);                                                    \
    G_STORE(S, (BUF) ^ 1)                                                                 \
    G_LOAD(S, (kt_) + 4)                                                                  \
    __builtin_amdgcn_sched_barrier(0);                                                    \
    g_frag(as, bs, 2, fa2, fb2);                                                          \
    __builtin_amdgcn_sched_barrier(0);                                                    \
    g_mma(fa0, fb0, acc);                                                                 \
    __builtin_amdgcn_sched_barrier(0);                                                    \
    g_frag(as, bs, 3, fa0, fb0);                                                          \
    __builtin_amdgcn_sched_barrier(0);                                                    \
    g_mma(fa1, fb1, acc);                                                                 \
    g_mma(fa2, fb2, acc);                                                                 \
    g_mma(fa0, fb0, acc);                                                                 \
    __syncthreads();                                                                      \
  }
  G_LOAD(p, 0)
  __syncthreads();
  G_STORE(p, 0)
  G_LOAD(q, 1)
  G_LOAD(r, 2)
  G_LOAD(p, 3)
  __syncthreads();
  for (int kt = 0; kt < nk; kt += 6) {
    G_STEP(q, 0, kt)
    G_STEP(r, 1, kt + 1)
    if (kt + 2 < nk) {
      G_STEP(p, 0, kt + 2)
      G_STEP(q, 1, kt + 3)
    }
    if (kt + 4 < nk) {
      G_STEP(r, 0, kt + 4)
      G_STEP(p, 1, kt + 5)
    }
  }
#undef G_STEP
#undef G_LOAD
#undef G_STORE
}

__device__ __forceinline__ void acc_zero(f32x16 (&acc)[2][2]) {
#pragma unroll
  for (int i = 0; i < 2; ++i)
#pragma unroll
    for (int j = 0; j < 2; ++j)
#pragma unroll
      for (int e = 0; e < 16; ++e) acc[i][j][e] = 0.f;
}

#define TILE_COORDS                                                                                  \
  const int tid_ = opq(threadIdx.x), lane_ = tid_ & 63, w_ = __builtin_amdgcn_readfirstlane(tid_ >> 6), \
            wm_ = w_ >> 1, wn_ = w_ & 1, fr_ = lane_ & 31, fq_ = lane_ >> 5;
#define TROW(m0, i, e) ((m0) + wm_ * 64 + (i) * 32 + ((e) & 3) + 8 * ((e) >> 2) + 4 * fq_)
#define TCOL(n0, j) ((n0) + wn_ * 64 + (j) * 32 + fr_)
#define TIDX2(m0, cb, i, e, ld) ((size_t)((m0) + wm_ * 64 + (i) * 32 + ((e) & 3) + 8 * ((e) >> 2)) * (ld) + (cb) + (size_t)(unsigned)(4 * fq_ * (ld) + fr_))
#define TIDX(m0, n0, i, j, e, ld) TIDX2(m0, (n0) + wn_ * 64 + (j) * 32, i, e, ld)

__device__ __forceinline__ int srccol(int which, int r) {
  switch (which) {
    case 0:
      if (r < 2048) return r;
      if (r < 2560) return 2064 + (r - 2048);
      if (r < 2576) return 2048 + (r - 2560);
      if (r < 2688) return -1;
      if (r < 3712) return 2576 + (r - 2688);
      return 3600 + (r - 3712);
    case 2: {
      int tile = r >> 7, wn = (r >> 6) & 1, wi = r & 63;
      return (wi < 32) ? (tile * 64 + wn * 32 + wi) : (512 + tile * 64 + wn * 32 + (wi - 32));
    }
    case 5: {
      int hh = r / 2816, cc = r % 2816;
      return (cc < 1408) ? (hh * 1408 + cc) : (2816 + hh * 1408 + (cc - 1408));
    }
    default: return r;
  }
}

__device__ __forceinline__ void convert_item(const float* __restrict__ src, int K, int N, u16* __restrict__ dst, int which, int item, char* lds) {
  float* tile = (float*)lds;
  const int tid = opq(threadIdx.x);
  const int kb = K >> 8;
  const int r0 = (item / kb) * 64, k0 = (item % kb) * 256;
  __syncthreads();
  {
    const int n4 = (tid & 15) * 4, kk = tid >> 4;
    const int sc = srccol(which, r0 + n4);
    float4 v[8];
#pragma unroll
    for (int it = 0; it < 8; ++it) {
      const int k = kk + 32 * it;
      v[it] = (sc >= 0) ? *(const float4*)(src + (size_t)(k0 + k) * N + sc) : make_float4(0.f, 0.f, 0.f, 0.f);
    }
#pragma unroll
    for (int it = 0; it < 8; ++it) {
      const int k = kk + 32 * it;
      tile[(n4 + 0) * 257 + k] = v[it].x; tile[(n4 + 1) * 257 + k] = v[it].y;
      tile[(n4 + 2) * 257 + k] = v[it].z; tile[(n4 + 3) * 257 + k] = v[it].w;
    }
  }
  __syncthreads();
  {
    const int ks = (tid & 31) * 8, rr = tid >> 5;
#pragma unroll
    for (int it = 0; it < 4; ++it) {
      const int row = rr + 16 * it;
      float f[8];
#pragma unroll
      for (int e = 0; e < 8; ++e) f[e] = tile[row * 257 + ks + e];
      *(uint4*)(dst + (size_t)(r0 + row) * K + k0 + ks) = pack8(f);
    }
  }
}

__device__ __forceinline__ void mod_item(const Params& P, int item, char* lds) {
  float* sc = (float*)lds;
  float* red = sc + 5 * 1024;
  const int tid = opq(threadIdx.x);
  __syncthreads();
  for (int i = tid; i < 5 * 1024; i += NT) {
    const int r = i >> 10, k = i & 1023;
    float v = (r < 4) ? P.c[r * 1024 + k] : P.c_ctx[k];
    sc[i] = v * sigm(v);
  }
  __syncthreads();
  const int nn = tid & 31, kg = tid >> 5;
  const int n = item * 32 + nn;
  float a0 = 0, a1 = 0, a2 = 0, a3 = 0, a4 = 0;
  for (int kk = 0; kk < 64; ++kk) {
    const int k = kg * 64 + kk;
    const float wv = P.w_ada[(size_t)k * 6144 + n];
    a0 += sc[k] * wv; a1 += sc[1024 + k] * wv; a2 += sc[2048 + k] * wv; a3 += sc[3072 + k] * wv; a4 += sc[4096 + k] * wv;
  }
  red[(kg * 5 + 0) * 32 + nn] = a0; red[(kg * 5 + 1) * 32 + nn] = a1; red[(kg * 5 + 2) * 32 + nn] = a2;
  red[(kg * 5 + 3) * 32 + nn] = a3; red[(kg * 5 + 4) * 32 + nn] = a4;
  __syncthreads();
  if (tid < 160) {
    const int r = tid >> 5, n2 = tid & 31;
    float s = 0.f;
#pragma unroll
    for (int g = 0; g < 16; ++g) s += red[(g * 5 + r) * 32 + n2];
    float* MOD = (float*)(P.ws + OFF_MOD);
    MOD[r * 6144 + item * 32 + n2] = s + P.b_ada[item * 32 + n2];
  }
}

__device__ __forceinline__ void lam_pow(float step, float are, float aim, int e, float& pr, float& pi) {
  const float mag = expf((float)e * step * are);
  double ang = (double)e * (double)step * (double)aim;
  ang -= 6.283185307179586476925 * rint(ang * 0.15915494309189533577);
  float s, c;
  __sincosf((float)ang, &s, &c);
  pr = mag * c; pi = mag * s;
}

__device__ __forceinline__ void s5tab_item(const Params& P, int item, char* lds) {
  const int tid = opq(threadIdx.x);
  const int tau = item & 31, g = (item >> 5) & 31, r = item >> 10;
  float* cfr = (float*)lds;
  float* cfi = cfr + 64;
  float* p0r = cfi + 64;
  float* p0i = p0r + 64;
  float* p1r = p0i + 64;
  float* p1i = p1r + 64;
  float* Gr = p1i + 64;
  float* Gi = Gr + 1024;
  float* Cr = Gi + 1024;
  float* Ci = Cr + 1024;
  const int rg = r * 32 + g;
  __syncthreads();
  if (tid < 64) {
    const int n = tid;
    const float step = expf(P.s5_log_step[rg]);
    const float are = P.s5_a_re[rg * 64 + n], aim = P.s5_a_im[rg * 64 + n];
    const float za = step * are;
    double zb = (double)step * (double)aim;
    zb -= 6.283185307179586476925 * rint(zb * 0.15915494309189533577);
    float sb, cb, sh, ch;
    __sincosf((float)zb, &sb, &cb);
    __sincosf((float)(0.5 * zb), &sh, &ch);
    const float em1 = expm1f(za);
    const float re1 = em1 * cb - 2.f * sh * sh;
    const float im1 = (1.f + em1) * sb;
    const float den = are * are + aim * aim;
    cfr[n] = (re1 * are + im1 * aim) / den;
    cfi[n] = (im1 * are - re1 * aim) / den;
    float pr, pi;
    lam_pow(step, are, aim, tau, pr, pi);
    p0r[n] = pr; p0i[n] = pi;
    lam_pow(step, are, aim, tau + 1, pr, pi);
    p1r[n] = pr; p1i[n] = pi;
  }
  for (int i = tid; i < 1024; i += NT) {
    Cr[i] = P.s5_c_re[(size_t)rg * 1024 + i];
    Ci[i] = P.s5_c_im[(size_t)rg * 1024 + i];
  }
  __syncthreads();
  for (int i = tid; i < 1024; i += NT) {
    const int n = i >> 4;
    const float br = P.s5_b_re[(size_t)rg * 1024 + i], bi = P.s5_b_im[(size_t)rg * 1024 + i];
    const float tr = cfr[n] * br - cfi[n] * bi, ti = cfr[n] * bi + cfi[n] * br;
    Gr[i] = p0r[n] * tr - p0i[n] * ti;
    Gi[i] = p0r[n] * ti + p0i[n] * tr;
  }
  __syncthreads();
  u16* MEND = (u16*)(P.ws + OFF_MEND);
  u16* MST = (u16*)(P.ws + OFF_MST);
  float* KTAB = (float*)(P.ws + OFF_KTAB);
  {
    const int ii = (r == 0) ? (31 - tau) : tau;
    for (int i = tid; i < 2048; i += NT) {
      const int part = i >> 10, n = (i >> 4) & 63, pi_ = i & 15;
      const float v = part ? Gi[n * 16 + pi_] : Gr[n * 16 + pi_];
      MEND[((size_t)g * 256 + r * 128 + part * 64 + n) * 512 + ii * 16 + pi_] = f2bf(v);
    }
  }
  if (tid < 256) {
    const int po = tid >> 4, pi_ = tid & 15;
    float s = 0.f;
    for (int n = 0; n < 64; ++n) s += Cr[po * 64 + n] * Gr[n * 16 + pi_] - Ci[po * 64 + n] * Gi[n * 16 + pi_];
    KTAB[(((size_t)rg) * 32 + tau) * 256 + tid] = s;
  }
  {
    const int jj = (r == 0) ? tau : (31 - tau);
    for (int i = tid; i < 2048; i += NT) {
      const int po = i >> 7, part = (i >> 6) & 1, n = i & 63;
      const float cr = Cr[po * 64 + n], ci = Ci[po * 64 + n];
      const float v = part ? -(cr * p1i[n] + ci * p1r[n]) : (cr * p1r[n] - ci * p1i[n]);
      MST[((size_t)g * 512 + jj * 16 + po) * 256 + r * 128 + part * 64 + n] = f2bf(v);
    }
  }
}

__device__ __forceinline__ void norm_row(const float* __restrict__ xr, const float* __restrict__ nw, const float* __restrict__ shift,
                                         const float* __restrict__ scale, u16* __restrict__ dst, int lane) {
  float4 v[4];
  float ss = 0.f;
#pragma unroll
  for (int it = 0; it < 4; ++it) {
    v[it] = *(const float4*)(xr + (it * 64 + lane) * 4);
    ss += v[it].x * v[it].x + v[it].y * v[it].y + v[it].z * v[it].z + v[it].w * v[it].w;
  }
  ss = wsum64(ss);
  const float rstd = rsqrtf(ss * (1.f / 1024.f) + 1e-6f);
#pragma unroll
  for (int it = 0; it < 4; ++it) {
    const int c = (it * 64 + lane) * 4;
    const float4 w4 = *(const float4*)(nw + c), sh = *(const float4*)(shift + c), sc = *(const float4*)(scale + c);
    const float y0 = v[it].x * rstd * w4.x * (1.f + sc.x) + sh.x;
    const float y1 = v[it].y * rstd * w4.y * (1.f + sc.y) + sh.y;
    const float y2 = v[it].z * rstd * w4.z * (1.f + sc.z) + sh.z;
    const float y3 = v[it].w * rstd * w4.w * (1.f + sc.w) + sh.w;
    uint2 o; o.x = pack2(y0, y1); o.y = pack2(y2, y3);
    *(uint2*)(dst + c) = o;
  }
}

__device__ __forceinline__ void norm1_item(const Params& P, int item) {
  const int lane = opq(threadIdx.x) & 63, w = opq(threadIdx.x) >> 6;
  const int row = item * 8 + w;
  const float* MOD = (const float*)(P.ws + OFF_MOD);
  const int bi = (row < 16384) ? (row >> 12) : 4;
  const float* xr = (row < 16384) ? (P.x + (size_t)row * 1024) : (P.ctx + (size_t)(row - 16384) * 1024);
  norm_row(xr, P.norm1_w, MOD + bi * 6144, MOD + bi * 6144 + 1024, (u16*)(P.ws + OFF_R2) + (size_t)row * 1024, lane);
}

__device__ __forceinline__ void mintra_item(const Params& P, int item) {
  const int tid = opq(threadIdx.x);
  const int rowg = item * 8 + (tid >> 6);
  const int g = rowg >> 9, nout = rowg & 511, j = nout >> 4, po = nout & 15;
  const int k0 = (tid & 63) * 8, i = k0 >> 4, pi0 = k0 & 15;
  const float* KTAB = (const float*)(P.ws + OFF_KTAB);
  float f[8];
#pragma unroll
  for (int e = 0; e < 8; ++e) f[e] = 0.f;
  if (i <= j) {
    const float* kp = KTAB + (((size_t)(0 * 32 + g)) * 32 + (j - i)) * 256 + po * 16 + pi0;
#pragma unroll
    for (int e = 0; e < 8; ++e) f[e] += kp[e];
  }
  if (i >= j) {
    const float* kp = KTAB + (((size_t)(1 * 32 + g)) * 32 + (i - j)) * 256 + po * 16 + pi0;
#pragma unroll
    for (int e = 0; e < 8; ++e) f[e] += kp[e];
  }
  if (i == j) {
    const float dv = P.s5_d[g * 16 + po];
#pragma unroll
    for (int e = 0; e < 8; ++e) if (pi0 + e == po) f[e] += dv;
  }
  u16* MI = (u16*)(P.ws + OFF_MINTRA);
  *(uint4*)(MI + (size_t)rowg * 512 + k0) = pack8(f);
}

__device__ __forceinline__ void inproj_tile(const Params& P, int t, char* lds) {
  int mt, nt;
  if (t < 1344) { nt = t / 64; mt = t % 64; }
  else {
    const int tt = t - 1344; mt = 64 + (tt & 3);
    const int ni = tt >> 2;
    nt = (ni < 8) ? (4 + ni) : ((ni < 12) ? (16 + ni - 8) : 20);
  }
  const int m0 = mt * 256, n0 = nt * 128;
  f32x16 acc[2][2];
  acc_zero(acc);
  gemm_main((const u16*)(P.ws + OFF_R2) + (size_t)m0 * 1024, 1024, (const u16*)(P.ws + OFF_WT_IN) + (size_t)n0 * 1024, 1024, 1024, acc, (u16*)lds);
  TILE_COORDS
  if (nt < 12) {
    u16* QKV = (u16*)(P.ws + OFF_R3);
#pragma unroll
    for (int i = 0; i < 2; ++i)
#pragma unroll
      for (int j = 0; j < 2; ++j)
#pragma unroll
        for (int e = 0; e < 16; ++e) QKV[TIDX(m0, n0, i, j, e, 1536)] = f2bf(acc[i][j][e]);
  } else if (nt < 16) {
    u16* Z = (u16*)(P.ws + OFF_Z);
#pragma unroll
    for (int i = 0; i < 2; ++i)
#pragma unroll
      for (int j = 0; j < 2; ++j)
#pragma unroll
        for (int e = 0; e < 16; ++e) Z[TIDX(m0, n0, i, j, e, 512) - 1536] = f2bf(acc[i][j][e]);
  } else if (nt < 20) {
    u16* U5 = (u16*)(P.ws + OFF_U5);
#pragma unroll
    for (int i = 0; i < 2; ++i)
#pragma unroll
      for (int j = 0; j < 2; ++j)
#pragma unroll
        for (int e = 0; e < 16; ++e) {
          const int cc = TCOL(n0, j) - 2048;
          U5[((size_t)(cc >> 4) * 17408 + TROW(m0, i, e)) * 16 + (cc & 15)] = f2bf(acc[i][j][e]);
        }
  } else {
    float* BA = (float*)(P.ws + OFF_BA);
#pragma unroll
    for (int i = 0; i < 2; ++i)
#pragma unroll
      for (int j = 0; j < 2; ++j)
#pragma unroll
        for (int e = 0; e < 16; ++e) {
          const int cc = TCOL(n0, j) - 2560;
          if (cc < 16) BA[(size_t)TROW(m0, i, e) * 16 + cc] = acc[i][j][e];
        }
  }
}

template <int DIR>
__device__ __forceinline__ void solve_cols(const Params& P, int itb, int c, const float* Lt, const float* bpp, const float* gcp,
                                           const u16* Vs, const u16* Ks) {
  float sol[64];
  const float* bp_ = bpp + DIR * 64;
  const float* gc_ = gcp + DIR * 64;
  if (c < 128) {
    const u16* vp = Vs + c;
#pragma unroll
    for (int p = 0; p < 64; ++p) sol[p] = bp_[p] * bf2f(vp[(DIR ? (63 - p) : p) * 136]);
  } else {
    const u16* kp = Ks + (c - 128);
#pragma unroll
    for (int p = 0; p < 64; ++p) sol[p] = bp_[p] * __expf(gc_[p]) * bf2f(kp[(DIR ? (63 - p) : p) * 136]);
  }
  const float* Lr = Lt + opq(DIR * 4096);
#ifdef SOLVE_TWICE
  float sol0[64];
#pragma unroll
  for (int p = 0; p < 64; ++p) sol0[p] = sol[p];
#pragma unroll
  for (int j = 0; j < 63; ++j) {
    const float sj = sol0[j];
#pragma unroll
    for (int i = j + 1; i < 64; ++i) sol0[i] -= Lr[j * 64 + i] * sj;
  }
  if (sol0[63] == 12345.678f) sol[0] += 1.f;
#endif
#pragma unroll
  for (int j = 0; j < 63; ++j) {
    const float sj = sol[j];
#pragma unroll
    for (int i = j + 1; i < 64; ++i) sol[i] -= Lr[j * 64 + i] * sj;
  }
  const size_t it2 = (size_t)(itb + DIR);
  if (c < 128) {
    u16* UF = (u16*)(P.ws + OFF_UF) + (it2 * 128 + c) * 64;
#pragma unroll
    for (int q = 0; q < 8; ++q) *(uint4*)(UF + q * 8) = pack8(sol + q * 8);
  } else {
    u16* Wg = (u16*)(P.ws + OFF_R2) + it2 * 8192 + (c - 128);
#pragma unroll
    for (int p = 0; p < 64; ++p) Wg[p * 128] = f2bf(-sol[p]);
  }
}

__device__ __forceinline__ void delta_prep_item(const Params& P, int item, char* lds) {
  const int tid = opq(threadIdx.x), lane = tid & 63, wv = tid >> 6, fr = lane & 15, fq = lane >> 4;
  const int cid = item >> 2, h = item & 3;
  const int row0 = cid * 64;
  int seq_lo, seq_hi;
  if (cid < 256) { seq_lo = (cid >> 6) * 4096; seq_hi = seq_lo + 4096; }
  else { seq_lo = 16384 + ((cid - 256) >> 2) * 256; seq_hi = seq_lo + 256; }
  u16* Qs = (u16*)(lds + opq(0));
  u16* Ks = (u16*)(lds + opq(17408));
  u16* Vs = (u16*)(lds + opq(34816));
  float* KKs = (float*)(lds + opq(52224));
  float* QKs = (float*)(lds + opq(69632));
  float* Lt = (float*)(lds + opq(87040));
  float* gtok = (float*)(lds + opq(119808));
  float* btok = gtok + 128;
  float* gcp = btok + 128;
  float* bpp = gcp + 128;
  u16* QKN = (u16*)((char*)P.out + OFF_QKN);
  __syncthreads();
  {
    const int j = tid >> 3, sg = tid & 7;
    const int row = row0 + j;
    const bool hm = (row - 1 >= seq_lo), hp = (row + 1 < seq_hi);
    const u16* qkv = (const u16*)(P.ws + OFF_R3);
#pragma unroll
    for (int s = 0; s < 3; ++s) {
      const int col = s * 512 + h * 128 + sg * 16;
      const u16* p0 = qkv + (size_t)row * 1536 + col;
      float y[16];
      float ssq = 0.f;
#pragma unroll
      for (int hh = 0; hh < 2; ++hh) {
        const uint4 c0 = *(const uint4*)(p0 + hh * 8);
        uint4 m0 = *(const uint4*)(p0 - (hm ? 1536 : 0) + hh * 8);
        uint4 n0 = *(const uint4*)(p0 + (hp ? 1536 : 0) + hh * 8);
        m0.x = hm ? m0.x : 0u; m0.y = hm ? m0.y : 0u; m0.z = hm ? m0.z : 0u; m0.w = hm ? m0.w : 0u;
        n0.x = hp ? n0.x : 0u; n0.y = hp ? n0.y : 0u; n0.z = hp ? n0.z : 0u; n0.w = hp ? n0.w : 0u;
        float fc[8], fm[8], fn[8];
        unpack8(c0, fc); unpack8(m0, fm); unpack8(n0, fn);
        const float* cwp = P.dn_conv_w + col + hh * 8;
        float cw0[8], cw1[8], cw2[8];
        {
          const float4 t0 = *(const float4*)(cwp), t1 = *(const float4*)(cwp + 4);
          const float4 t2 = *(const float4*)(cwp + 1536), t3 = *(const float4*)(cwp + 1540);
          const float4 t4 = *(const float4*)(cwp + 3072), t5 = *(const float4*)(cwp + 3076);
          cw0[0] = t0.x; cw0[1] = t0.y; cw0[2] = t0.z; cw0[3] = t0.w; cw0[4] = t1.x; cw0[5] = t1.y; cw0[6] = t1.z; cw0[7] = t1.w;
          cw1[0] = t2.x; cw1[1] = t2.y; cw1[2] = t2.z; cw1[3] = t2.w; cw1[4] = t3.x; cw1[5] = t3.y; cw1[6] = t3.z; cw1[7] = t3.w;
          cw2[0] = t4.x; cw2[1] = t4.y; cw2[2] = t4.z; cw2[3] = t4.w; cw2[4] = t5.x; cw2[5] = t5.y; cw2[6] = t5.z; cw2[7] = t5.w;
        }
#pragma unroll
        for (int e = 0; e < 8; ++e) {
          const float v = cw0[e] * fm[e] + cw1[e] * fc[e] + cw2[e] * fn[e];
          const float yy = v * sigm(v);
          y[hh * 8 + e] = yy;
          ssq += yy * yy;
        }
      }
      if (s < 2) {
        ssq += __shfl_xor(ssq, 1, 64); ssq += __shfl_xor(ssq, 2, 64); ssq += __shfl_xor(ssq, 4, 64);
        const float sc = rsqrtf(ssq + 1e-6f) * ((s == 0) ? 0.08838834764831845f : 1.f);
#pragma unroll
        for (int e = 0; e < 16; ++e) y[e] *= sc;
      }
      u16* dl = ((s == 0) ? Qs : ((s == 1) ? Ks : Vs)) + j * 136 + sg * 16;
      const uint4 o0 = pack8(y), o1 = pack8(y + 8);
      *(uint4*)dl = o0; *(uint4*)(dl + 8) = o1;
      if (s < 2) {
        u16* dg = QKN + (size_t)row * 1024 + s * 512 + h * 128 + sg * 16;
        *(uint4*)dg = o0; *(uint4*)(dg + 8) = o1;
      }
    }
  }
  if (tid < 128) {
    const int j = tid & 63, dir = tid >> 6;
    const float* BA = (const float*)(P.ws + OFF_BA) + (size_t)(row0 + j) * 16;
    const float bl = BA[dir * 4 + h], al = BA[8 + dir * 4 + h];
    const float xx = al + P.dn_dt_bias[dir * 4 + h];
    const float sp = (xx > 20.f) ? xx : log1pf(expf(xx));
    gtok[dir * 64 + j] = -expf(P.dn_a_log[dir * 4 + h]) * sp;
    btok[dir * 64 + j] = 1.f / (1.f + expf(-bl));
  }
  __syncthreads();
  if (tid < 2) {
    const int dir = tid;
    float a = 0.f;
    for (int p = 0; p < 64; ++p) {
      const int tk = dir ? (63 - p) : p;
      a += gtok[dir * 64 + tk];
      gcp[dir * 64 + p] = a;
      bpp[dir * 64 + p] = btok[dir * 64 + tk];
    }
  }
  {
#pragma unroll
    for (int q = 0; q < 4; ++q) {
      const int t = wv * 4 + q;
      const int which = t >> 4, mi = (t >> 2) & 3, ni = t & 3;
      const u16* Am = (which ? Qs : Ks) + (mi * 16 + fr) * 136 + fq * 8;
      const u16* Bm = Ks + (ni * 16 + fr) * 136 + fq * 8;
      f32x4 a4 = {0.f, 0.f, 0.f, 0.f};
#pragma unroll
      for (int kk = 0; kk < 4; ++kk)
        a4 = __builtin_amdgcn_mfma_f32_16x16x32_bf16(*(const bf16x8*)(Am + kk * 32), *(const bf16x8*)(Bm + kk * 32), a4, 0, 0, 0);
      float* dst = which ? QKs : KKs;
#pragma unroll
      for (int e = 0; e < 4; ++e) dst[(mi * 16 + fq * 4 + e) * 68 + ni * 16 + fr] = a4[e];
    }
  }
  __syncthreads();
  const int itb = item * 2;
  {
    u16* AQ = (u16*)((char*)P.out + OFF_AQ);
    for (int idx = tid; idx < 8192; idx += NT) {
      const int dir = idx >> 12, p = (idx >> 6) & 63, s = idx & 63;
      const int tp = dir ? (63 - p) : p, ts = dir ? (63 - s) : s;
      const float dg = gcp[dir * 64 + p] - gcp[dir * 64 + s];
      const float dec = (p >= s) ? __expf(dg) : 0.f;
      AQ[((size_t)(itb + dir) * 64 + p) * 64 + s] = f2bf(QKs[tp * 68 + ts] * dec);
    }
    for (int idx = tid; idx < 8192; idx += NT) {
      const int dir = idx >> 12, s = (idx >> 6) & 63, p = idx & 63;
      const int tp = dir ? (63 - p) : p, ts = dir ? (63 - s) : s;
      const float dg = gcp[dir * 64 + p] - gcp[dir * 64 + s];
      const float lv = (p > s) ? bpp[dir * 64 + p] * KKs[ts * 68 + tp] * __expf(dg) : 0.f;
      Lt[dir * 4096 + s * 64 + p] = lv;
    }
    if (tid < 128) {
      float* GC = (float*)(P.ws + OFF_GC);
      GC[(size_t)(itb + (tid >> 6)) * 64 + (tid & 63)] = gcp[tid];
    }
  }
  __syncthreads();
  if (tid < 256) solve_cols<0>(P, itb, tid, Lt, bpp, gcp, Vs, Ks);
  else solve_cols<1>(P, itb, tid - 256, Lt, bpp, gcp, Vs, Ks);
}

__device__ __forceinline__ void s5end_tile(const Params& P, int t, char* lds) {
  const int g = t / 6, mt = (t % 6) >> 1, nt = t & 1;
  const int m0 = mt * 256, n0 = nt * 128;
  f32x16 acc[2][2];
  acc_zero(acc);
  gemm_main((const u16*)(P.ws + OFF_U5) + ((size_t)g * 544 + m0) * 512, 512,
            (const u16*)(P.ws + OFF_MEND) + ((size_t)g * 256 + n0) * 512, 512, 512, acc, (u16*)lds);
  TILE_COORDS
  float* E = (float*)(P.ws + OFF_E);
#pragma unroll
  for (int i = 0; i < 2; ++i)
#pragma unroll
    for (int j = 0; j < 2; ++j)
#pragma unroll
      for (int e = 0; e < 16; ++e) {
        const int row = TROW(m0, i, e);
        if (row < 544) E[((size_t)g * 544 + row) * 256 + TCOL(n0, j)] = acc[i][j][e];
      }
}

__device__ __forceinline__ void delta_scan_block(const Params& P, int sb, char* lds) {
  const int tid = opq(threadIdx.x), lane = tid & 63, w = tid >> 6, fr = lane & 15, fq = lane >> 4;
  const int bhd = sb & 31, dvq = sb >> 5;
  const int b = bhd >> 3, h = (bhd >> 1) & 3, dir = bhd & 1;
  const int wd = w & 1, wq = w >> 1;
  const int dv0 = dvq * 32 + wd * 16;
  u16* Wl = (u16*)(lds + opq(0));
  u16* QTl = (u16*)(lds + opq(17408));
  u16* KTl = (u16*)(lds + opq(34816));
  u16* AQl = (u16*)(lds + opq(53248));
  u16* ST = (u16*)(lds + opq(62464));
  u16* VT = (u16*)(lds + opq(71168));
  __syncthreads();
  for (int i = tid; i < 32 * 136 / 2; i += NT) ((uint32_t*)ST)[i] = 0u;
  f32x4 accS0 = {0.f, 0.f, 0.f, 0.f}, accS1 = {0.f, 0.f, 0.f, 0.f};
  const u16* QKN = (const u16*)((const char*)P.out + OFF_QKN);
  const u16* AQg = (const u16*)((const char*)P.out + OFF_AQ);
  const u16* Wg = (const u16*)(P.ws + OFF_R2);
  const u16* UFg = (const u16*)(P.ws + OFF_UF);
  const float* GC = (const float*)(P.ws + OFF_GC);
  u16* Og = (u16*)(P.ws + OFF_O);

  uint4 rw0, rw1, rq0, rq1, rk0, rk1, ra;
  float gq0, gq1, gk, g63;
  uint2 ru;
  int cur_row0 = 0, cur_lat = 0;
  int nxt_row0 = 0, nxt_lat = 0;

#define SCAN_PF_ONE(i)                                                                             \
    {                                                                                              \
      const int id = tid + (i) * 512;                                                              \
      const int p = id >> 4, seg = id & 15;                                                        \
      const int tk = dir ? (63 - p) : p;                                                           \
      rw##i = *(const uint4*)(Wg + it2__ * 8192 + p * 128 + seg * 8);                              \
      rq##i = *(const uint4*)(QKN + (size_t)(nxt_row0 + tk) * 1024 + h * 128 + seg * 8);           \
      gq##i = GC[it2__ * 64 + p];                                                                  \
      const int s = id & 63, sg2 = id >> 6;                                                        \
      const int tks = dir ? (63 - s) : s;                                                          \
      rk##i = *(const uint4*)(QKN + (size_t)(nxt_row0 + tks) * 1024 + 512 + h * 128 + sg2 * 8);    \
    }
#define SCAN_PREFETCH(n_)                                                                          \
  {                                                                                                \
    const int n__ = (n_);                                                                          \
    int cid__;                                                                                     \
    if (n__ < 4) { cid__ = 256 + b * 4 + (dir ? (3 - n__) : n__); nxt_lat = 0; }                   \
    else { const int m__ = n__ - 4; cid__ = b * 64 + (dir ? (63 - m__) : m__); nxt_lat = 1; }      \
    nxt_row0 = cid__ * 64;                                                                         \
    const size_t it2__ = (size_t)((cid__ * 4 + h) * 2 + dir);                                      \
    SCAN_PF_ONE(0)                                                                                 \
    SCAN_PF_ONE(1)                                                                                 \
    gk = GC[it2__ * 64 + (tid & 63)];                                                              \
    g63 = GC[it2__ * 64 + 63];                                                                     \
    ra = *(const uint4*)(AQg + it2__ * 4096 + (tid >> 3) * 64 + (tid & 7) * 8);                    \
    ru = *(const uint2*)(UFg + (it2__ * 128 + dv0 + fr) * 64 + wq * 16 + fq * 4);                  \
  }

  SCAN_PREFETCH(0)
  for (int n = 0; n < 68; ++n) {
    cur_row0 = nxt_row0; cur_lat = nxt_lat;
    const float gl = __expf(g63);
    const float sk = __expf(g63 - gk);
#define SCAN_STAGE_ONE(i)                                                     \
    {                                                                         \
      const int id = tid + (i) * 512;                                         \
      const int p = id >> 4, seg = id & 15;                                   \
      *(uint4*)(Wl + p * 136 + seg * 8) = rw##i;                              \
      float f[8];                                                             \
      unpack8(rq##i, f);                                                      \
      const float sq = __expf(gq##i);                                         \
      f[0] *= sq; f[1] *= sq; f[2] *= sq; f[3] *= sq; f[4] *= sq; f[5] *= sq; f[6] *= sq; f[7] *= sq; \
      *(uint4*)(QTl + p * 136 + seg * 8) = pack8(f);                          \
      const int s = id & 63, sg2 = id >> 6;                                   \
      unpack8(rk##i, f);                                                      \
      u16* kd = KTl + (sg2 * 8) * 72 + s;                                     \
      kd[0 * 72] = f2bf(f[0] * sk); kd[1 * 72] = f2bf(f[1] * sk); kd[2 * 72] = f2bf(f[2] * sk); kd[3 * 72] = f2bf(f[3] * sk); \
      kd[4 * 72] = f2bf(f[4] * sk); kd[5 * 72] = f2bf(f[5] * sk); kd[6 * 72] = f2bf(f[6] * sk); kd[7 * 72] = f2bf(f[7] * sk); \
    }
    SCAN_STAGE_ONE(0)
    SCAN_STAGE_ONE(1)
#undef SCAN_STAGE_ONE
    *(uint4*)(AQl + (tid >> 3) * 72 + (tid & 7) * 8) = ra;
    f32x4 av = f32x4{lo16(ru.x), hi16(ru.x), lo16(ru.y), hi16(ru.y)};
    f32x4 ao = f32x4{0.f, 0.f, 0.f, 0.f};
    __syncthreads();
    if (n + 1 < 68) SCAN_PREFETCH(n + 1)
#pragma unroll
    for (int kk = 0; kk < 4; ++kk) {
      const bf16x8 bS = *(const bf16x8*)(ST + (wd * 16 + fr) * 136 + kk * 32 + fq * 8);
      const bf16x8 a1 = *(const bf16x8*)(Wl + (wq * 16 + fr) * 136 + kk * 32 + fq * 8);
      av = __builtin_amdgcn_mfma_f32_16x16x32_bf16(a1, bS, av, 0, 0, 0);
      const bf16x8 a2 = *(const bf16x8*)(QTl + (wq * 16 + fr) * 136 + kk * 32 + fq * 8);
      ao = __builtin_amdgcn_mfma_f32_16x16x32_bf16(a2, bS, ao, 0, 0, 0);
    }
    {
      uint2 v; v.x = pack2(av[0], av[1]); v.y = pack2(av[2], av[3]);
      *(uint2*)(VT + (wd * 16 + fr) * 72 + wq * 16 + fq * 4) = v;
    }
    __syncthreads();
    accS0[0] *= gl; accS0[1] *= gl; accS0[2] *= gl; accS0[3] *= gl;
    accS1[0] *= gl; accS1[1] *= gl; accS1[2] *= gl; accS1[3] *= gl;
#pragma unroll
    for (int ks = 0; ks < 2; ++ks) {
      const bf16x8 bV = *(const bf16x8*)(VT + (wd * 16 + fr) * 72 + ks * 32 + fq * 8);
      const bf16x8 a1 = *(const bf16x8*)(AQl + (wq * 16 + fr) * 72 + ks * 32 + fq * 8);
      ao = __builtin_amdgcn_mfma_f32_16x16x32_bf16(a1, bV, ao, 0, 0, 0);
      const bf16x8 k0 = *(const bf16x8*)(KTl + ((2 * wq) * 16 + fr) * 72 + ks * 32 + fq * 8);
      accS0 = __builtin_amdgcn_mfma_f32_16x16x32_bf16(k0, bV, accS0, 0, 0, 0);
      const bf16x8 k1 = *(const bf16x8*)(KTl + ((2 * wq + 1) * 16 + fr) * 72 + ks * 32 + fq * 8);
      accS1 = __builtin_amdgcn_mfma_f32_16x16x32_bf16(k1, bV, accS1, 0, 0, 0);
    }
    {
      uint2 v; v.x = pack2(accS0[0], accS0[1]); v.y = pack2(accS0[2], accS0[3]);
      *(uint2*)(ST + (wd * 16 + fr) * 136 + (2 * wq) * 16 + fq * 4) = v;
      v.x = pack2(accS1[0], accS1[1]); v.y = pack2(accS1[2], accS1[3]);
      *(uint2*)(ST + (wd * 16 + fr) * 136 + (2 * wq + 1) * 16 + fq * 4) = v;
    }
    if (cur_lat) {
#pragma unroll
      for (int e = 0; e < 4; ++e) {
        const int p = wq * 16 + fq * 4 + e;
        const int tk = dir ? (63 - p) : p;
        Og[((size_t)dir * 16384 + cur_row0 + tk) * 512 + h * 128 + dv0 + fr] = f2bf(ao[e]);
      }
    }
    __syncthreads();
  }
#undef SCAN_PREFETCH
#undef SCAN_PF_ONE
}

__device__ __forceinline__ void s5_carry_block(const Params& P, int cb) {
  const int idx = cb * NT + opq(threadIdx.x);
  const int n = idx & 63, g = (idx >> 6) & 31, r = (idx >> 11) & 1, b = idx >> 12;
  const int rg = r * 32 + g;
  const float step = expf(P.s5_log_step[rg]);
  float lr, li;
  lam_pow(step, P.s5_a_re[rg * 64 + n], P.s5_a_im[rg * 64 + n], 32, lr, li);
  const float* E = (const float*)(P.ws + OFF_E) + (size_t)g * 544 * 256 + r * 128 + n;
  u16* XIN = (u16*)(P.ws + OFF_XIN) + (size_t)g * 512 * 256 + r * 128 + n;
  float xr = 0.f, xi = 0.f;
  for (int k = 0; k < 8; ++k) {
    const int cc = r ? (7 - k) : k;
    const int row = 512 + b * 8 + cc;
    const float er = E[(size_t)row * 256], ei = E[(size_t)row * 256 + 64];
    const float nr = lr * xr - li * xi + er, ni = lr * xi + li * xr + ei;
    xr = nr; xi = ni;
  }
  for (int k = 0; k < 128; ++k) {
    const int cc = r ? (127 - k) : k;
    const int row = b * 128 + cc;
    XIN[(size_t)row * 256] = f2bf(xr);
    XIN[(size_t)row * 256 + 64] = f2bf(xi);
    const float er = E[(size_t)row * 256], ei = E[(size_t)row * 256 + 64];
    const float nr = lr * xr - li * xi + er, ni = lr * xi + li * xr + ei;
    xr = nr; xi = ni;
  }
}

__device__ __forceinline__ void s5out_tile(const Params& P, int t, char* lds) {
  const int g = t >> 3, mt = (t >> 2) & 1, nt = t & 3;
  const int m0 = mt * 256, n0 = nt * 128;
  f32x16 acc[2][2];
  acc_zero(acc);
  gemm_main((const u16*)(P.ws + OFF_XIN) + ((size_t)g * 512 + m0) * 256, 256,
            (const u16*)(P.ws + OFF_MST) + ((size_t)g * 512 + n0) * 256, 256, 256, acc, (u16*)lds);
  gemm_main((const u16*)(P.ws + OFF_U5) + ((size_t)g * 544 + m0) * 512, 512,
            (const u16*)(P.ws + OFF_MINTRA) + ((size_t)g * 512 + n0) * 512, 512, 512, acc, (u16*)lds);
  TILE_COORDS
  u16* YB = (u16*)(P.ws + OFF_YB);
#pragma unroll
  for (int i = 0; i < 2; ++i)
#pragma unroll
    for (int j = 0; j < 2; ++j)
#pragma unroll
      for (int e = 0; e < 16; ++e) {
        const int row = TROW(m0, i, e), nn = TCOL(n0, j);
        const int token = row * 32 + (nn >> 4);
        YB[(size_t)token * 512 + g * 16 + (nn & 15)] = f2bf(gelu_tanh(acc[i][j][e]));
      }
}

__device__ __forceinline__ void delta_post_item(const Params& P, int item) {
  const int lane = opq(threadIdx.x) & 63, w = opq(threadIdx.x) >> 6;
  const int row = item * 8 + w;
  const u16* O = (const u16*)(P.ws + OFF_O);
  const uint4 o0 = *(const uint4*)(O + (size_t)row * 512 + lane * 8);
  const uint4 o1 = *(const uint4*)(O + ((size_t)16384 + row) * 512 + lane * 8);
  const uint4 zz = *(const uint4*)((const u16*)(P.ws + OFF_Z) + (size_t)row * 512 + lane * 8);
  float a[8], bq[8], z[8];
  unpack8(o0, a); unpack8(o1, bq); unpack8(zz, z);
  float ss = 0.f;
#pragma unroll
  for (int e = 0; e < 8; ++e) { a[e] += bq[e]; ss += a[e] * a[e]; }
  ss += __shfl_xor(ss, 1, 64); ss += __shfl_xor(ss, 2, 64); ss += __shfl_xor(ss, 4, 64); ss += __shfl_xor(ss, 8, 64);
  const float rstd = rsqrtf(ss * (1.f / 128.f) + 1e-6f);
  const float* nw = P.dn_norm_w + (lane & 15) * 8;
  float y[8];
#pragma unroll
  for (int e = 0; e < 8; ++e) y[e] = a[e] * rstd * nw[e] * (z[e] * sigm(z[e]));
  *(uint4*)((u16*)(P.ws + OFF_YA) + (size_t)row * 512 + lane * 8) = pack8(y);
}

__device__ __forceinline__ void glu_tile(const Params& P, int t, char* lds) {
  const int nt = t >> 6, mt = t & 63;
  const int m0 = mt * 256, n0 = nt * 128;
  f32x16 acc[2][2];
  acc_zero(acc);
  gemm_main((const u16*)(P.ws + OFF_YB) + (size_t)m0 * 512, 512, (const u16*)(P.ws + OFF_WT_GLU) + (size_t)n0 * 512, 512, 512, acc, (u16*)lds);
  TILE_COORDS
  u16* YG = (u16*)(P.ws + OFF_YG);
  {
    const int oc = nt * 64 + wn_ * 32 + fr_;
    const float bv = P.b_glu[oc], bg = P.b_glu[512 + oc];
#pragma unroll
    for (int i = 0; i < 2; ++i)
#pragma unroll
      for (int e = 0; e < 16; ++e) {
        const float val = acc[i][0][e] + bv, gt = acc[i][1][e] + bg;
        YG[TIDX2(m0, nt * 64 + wn_ * 32, i, e, 512)] = f2bf(val * sigm(gt));
      }
  }
}

__device__ __forceinline__ void gates_tile(const Params& P, int t, char* lds) {
  const int nt = t >> 6, mt = t & 63;
  const int m0 = mt * 256, n0 = nt * 128;
  f32x16 acc[2][2];
  acc_zero(acc);
  gemm_main((const u16*)(P.ws + OFF_R2) + (size_t)m0 * 1024, 1024, (const u16*)(P.ws + OFF_WT_IN) + (size_t)(2688 + n0) * 1024, 1024, 1024, acc, (u16*)lds);
  TILE_COORDS
  u16* SG = (u16*)(P.ws + OFF_SG);
#pragma unroll
  for (int i = 0; i < 2; ++i)
#pragma unroll
    for (int j = 0; j < 2; ++j)
#pragma unroll
      for (int e = 0; e < 16; ++e) SG[TIDX(m0, n0, i, j, e, 2048)] = f2bf(sigm(acc[i][j][e]));
}

__device__ __forceinline__ void mix_tile(const Params& P, int t, char* lds) {
  const int nt = t >> 6, mt = t & 63;
  const int m0 = mt * 256, n0 = nt * 128;
  const u16* SG = (const u16*)(P.ws + OFF_SG);
  f32x16 acc[2][2];
  u16* MIX = (u16*)(P.ws + OFF_MIX);
  acc_zero(acc);
  gemm_main((const u16*)(P.ws + OFF_YA) + (size_t)m0 * 512, 512, (const u16*)(P.ws + OFF_WT_AOUT) + (size_t)n0 * 512, 512, 512, acc, (u16*)lds);
  {
    TILE_COORDS
    u16 sv[2][2][16];
#pragma unroll
    for (int i = 0; i < 2; ++i)
#pragma unroll
      for (int j = 0; j < 2; ++j)
#pragma unroll
        for (int e = 0; e < 16; ++e) sv[i][j][e] = SG[TIDX(m0, n0, i, j, e, 2048)];
#pragma unroll
    for (int i = 0; i < 2; ++i)
#pragma unroll
      for (int j = 0; j < 2; ++j)
#pragma unroll
        for (int e = 0; e < 16; ++e) MIX[TIDX(m0, n0, i, j, e, 1024)] = f2bf(bf2f(sv[i][j][e]) * acc[i][j][e]);
  }
  acc_zero(acc);
  gemm_main((const u16*)(P.ws + OFF_YG) + (size_t)m0 * 512, 512, (const u16*)(P.ws + OFF_WT_BOUT) + (size_t)n0 * 512, 512, 512, acc, (u16*)lds);
  {
    TILE_COORDS
#pragma unroll
    for (int i = 0; i < 2; ++i) {
      u16 sv[2][16], pv[2][16];
#pragma unroll
      for (int j = 0; j < 2; ++j)
#pragma unroll
        for (int e = 0; e < 16; ++e) {
          sv[j][e] = SG[TIDX(m0, n0, i, j, e, 2048) + 1024];
          pv[j][e] = MIX[TIDX(m0, n0, i, j, e, 1024)];
        }
#pragma unroll
      for (int j = 0; j < 2; ++j)
#pragma unroll
        for (int e = 0; e < 16; ++e)
          MIX[TIDX(m0, n0, i, j, e, 1024)] = f2bf(bf2f(pv[j][e]) + bf2f(sv[j][e]) * acc[i][j][e]);
    }
  }
}

__device__ __forceinline__ void wo_tile(const Params& P, int t, char* lds) {
  const int nt = t >> 6, mt = t & 63;
  const int m0 = mt * 256, n0 = nt * 128;
  f32x16 acc[2][2];
  acc_zero(acc);
  gemm_main((const u16*)(P.ws + OFF_MIX) + (size_t)m0 * 1024, 1024, (const u16*)(P.ws + OFF_WT_O) + (size_t)n0 * 1024, 1024, 1024, acc, (u16*)lds);
  TILE_COORDS
  const float* MOD = (const float*)(P.ws + OFF_MOD) + (m0 >> 12) * 6144 + 2 * 1024;
  float xv[2][2][16];
#pragma unroll
  for (int j = 0; j < 2; ++j)
#pragma unroll
    for (int i = 0; i < 2; ++i)
#pragma unroll
      for (int e = 0; e < 16; ++e) xv[i][j][e] = P.x[TIDX(m0, n0, i, j, e, 1024)];
#pragma unroll
  for (int j = 0; j < 2; ++j) {
    const int col = TCOL(n0, j);
    const float gate = MOD[col];
#pragma unroll
    for (int i = 0; i < 2; ++i)
#pragma unroll
      for (int e = 0; e < 16; ++e) P.out[TIDX(m0, n0, i, j, e, 1024)] = xv[i][j][e] + gate * acc[i][j][e];
  }
}

__device__ __forceinline__ void norm2_item(const Params& P, int item) {
  const int lane = opq(threadIdx.x) & 63, w = opq(threadIdx.x) >> 6;
  const int row = item * 8 + w;
  const float* MOD = (const float*)(P.ws + OFF_MOD) + (row >> 12) * 6144;
  norm_row(P.out + (size_t)row * 1024, P.norm2_w, MOD + 3 * 1024, MOD + 4 * 1024, (u16*)(P.ws + OFF_R2) + (size_t)row * 1024, lane);
}

__device__ __forceinline__ void up_tile(const Params& P, int t, int hh, char* lds) {
  const int nt = t >> 6, mt = t & 63;
  const int m0 = mt * 256, n0 = nt * 128;
  f32x16 acc[2][2];
  acc_zero(acc);
  gemm_main((const u16*)(P.ws + OFF_R2) + (size_t)m0 * 1024, 1024,
            (const u16*)(P.ws + OFF_WT_UP) + ((size_t)hh * 2816 + n0) * 1024, 1024, 1024, acc, (u16*)lds);
  TILE_COORDS
  u16* UPH = (u16*)(P.ws + OFF_UPH);
#pragma unroll
  for (int i = 0; i < 2; ++i)
#pragma unroll
    for (int j = 0; j < 2; ++j)
#pragma unroll
      for (int e = 0; e < 16; ++e) UPH[TIDX(m0, n0, i, j, e, 2816)] = f2bf(acc[i][j][e]);
}

#define CG_LD(ci, dy)                                                                       \
    {                                                                                       \
      const int xc = x0 - 1 + (ci);                                                         \
      const bool cok = (xc >= 0) && (xc <= 63);                                             \
      const bool rok = ((dy) == 1) || ((dy) == 0 ? r0ok : r2ok);                            \
      const int yy = rok ? (y + (dy) - 1) : y;                                              \
      const u16* src = UPH + (base + (size_t)yy * 64 + (cok ? xc : x0)) * 2816 + c4;        \
      uint2 g__ = *(const uint2*)src;                                                       \
      uint2 v__ = *(const uint2*)(src + 1408);                                              \
      const bool ok = cok && rok;                                                           \
      g__.x = ok ? g__.x : 0u; g__.y = ok ? g__.y : 0u;                                     \
      v__.x = ok ? v__.x : 0u; v__.y = ok ? v__.y : 0u;                                     \
      gg[ci][dy] = g__; vv[ci][dy] = v__;                                                   \
    }
__device__ __forceinline__ void convgate_item(const Params& P, int item, int hh) {
  const int tid = opq(threadIdx.x);
  if (tid >= 352) return;
  const int xo = item & 15, y = (item >> 4) & 63, b = item >> 10;
  const int c4 = tid * 4;
  const u16* UPH = (const u16*)(P.ws + OFF_UPH);
  u16* G = (u16*)(P.ws + OFF_G);
  const size_t base = (size_t)b * 4096;
  const bool r0ok = (y > 0), r2ok = (y < 63);
  const int x0 = xo * 4;
  uint2 gg[6][3], vv[6][3];
#pragma unroll
  for (int ci = 0; ci < 6; ++ci) {
    CG_LD(ci, 0)
    CG_LD(ci, 1)
    CG_LD(ci, 2)
  }
  float wg[9][4], wv[9][4];
#pragma unroll
  for (int k = 0; k < 9; ++k) {
    const float4 a = *(const float4*)(P.ffn_conv_w + (size_t)k * 5632 + hh * 1408 + c4);
    const float4 bq = *(const float4*)(P.ffn_conv_w + (size_t)k * 5632 + 2816 + hh * 1408 + c4);
    wg[k][0] = a.x; wg[k][1] = a.y; wg[k][2] = a.z; wg[k][3] = a.w;
    wv[k][0] = bq.x; wv[k][1] = bq.y; wv[k][2] = bq.z; wv[k][3] = bq.w;
  }
#pragma unroll
  for (int xx = 0; xx < 4; ++xx) {
    float ag[4] = {0.f, 0.f, 0.f, 0.f}, av[4] = {0.f, 0.f, 0.f, 0.f};
#pragma unroll
    for (int dy = 0; dy < 3; ++dy)
#pragma unroll
      for (int dx = 0; dx < 3; ++dx) {
        const uint2 gq = gg[xx + dx][dy], vq = vv[xx + dx][dy];
        const int k = dy * 3 + dx;
        ag[0] += wg[k][0] * lo16(gq.x); ag[1] += wg[k][1] * hi16(gq.x); ag[2] += wg[k][2] * lo16(gq.y); ag[3] += wg[k][3] * hi16(gq.y);
        av[0] += wv[k][0] * lo16(vq.x); av[1] += wv[k][1] * hi16(vq.x); av[2] += wv[k][2] * lo16(vq.y); av[3] += wv[k][3] * hi16(vq.y);
      }
    uint2 o;
    o.x = pack2(ag[0] * sigm(ag[0]) * av[0], ag[1] * sigm(ag[1]) * av[1]);
    o.y = pack2(ag[2] * sigm(ag[2]) * av[2], ag[3] * sigm(ag[3]) * av[3]);
    *(uint2*)(G + (base + y * 64 + x0 + xx) * 2816 + hh * 1408 + c4) = o;
  }
}
#undef CG_LD

__device__ __forceinline__ void down_tile(const Params& P, int t, char* lds) {
  const int nt = t >> 6, mt = t & 63;
  const int m0 = mt * 256, n0 = nt * 128;
  f32x16 acc[2][2];
  acc_zero(acc);
  gemm_main((const u16*)(P.ws + OFF_G) + (size_t)m0 * 2816, 2816, (const u16*)(P.ws + OFF_WT_DOWN) + (size_t)n0 * 2816, 2816, 2816, acc, (u16*)lds);
  TILE_COORDS
  const float* MOD = (const float*)(P.ws + OFF_MOD) + (m0 >> 12) * 6144 + 5 * 1024;
  float xv[2][2][16];
#pragma unroll
  for (int j = 0; j < 2; ++j)
#pragma unroll
    for (int i = 0; i < 2; ++i)
#pragma unroll
      for (int e = 0; e < 16; ++e) xv[i][j][e] = P.out[TIDX(m0, n0, i, j, e, 1024)];
#pragma unroll
  for (int j = 0; j < 2; ++j) {
    const int col = TCOL(n0, j);
    const float gate = MOD[col];
#pragma unroll
    for (int i = 0; i < 2; ++i)
#pragma unroll
      for (int e = 0; e < 16; ++e) P.out[TIDX(m0, n0, i, j, e, 1024)] = xv[i][j][e] + gate * acc[i][j][e];
  }
}

__device__ __forceinline__ void final_item(const Params& P, int item) {
  const int lane = opq(threadIdx.x) & 63, w = opq(threadIdx.x) >> 6;
  const int row = item * 8 + w;
  float* xr = P.out + (size_t)row * 1024;
  float4 v[4];
  float ss = 0.f;
#pragma unroll
  for (int it = 0; it < 4; ++it) {
    v[it] = *(const float4*)(xr + (it * 64 + lane) * 4);
    ss += v[it].x * v[it].x + v[it].y * v[it].y + v[it].z * v[it].z + v[it].w * v[it].w;
  }
  ss = wsum64(ss);
  const float rstd = rsqrtf(ss * (1.f / 1024.f) + 1e-6f);
#pragma unroll
  for (int it = 0; it < 4; ++it) {
    const int c = (it * 64 + lane) * 4;
    const float4 w4 = *(const float4*)(P.norm_f_w + c);
    float4 o;
    o.x = v[it].x * rstd * w4.x; o.y = v[it].y * rstd * w4.y; o.z = v[it].z * rstd * w4.z; o.w = v[it].w * rstd * w4.w;
    *(float4*)(xr + c) = o;
  }
}

__device__ __forceinline__ void run_phase(const Params& P, int ph, char* lds) {
  const int bid = blockIdx.x, nb = gridDim.x;
#ifdef ONLY_PHASE
  if (ph != ONLY_PHASE) return;
#endif
  switch (ph) {
    case 0: {
      for (int it = bid; it < 984 + 192 + 2048; it += nb) {
        if (it < 296) convert_item(P.w_in, 1024, 4624, (u16*)(P.ws + OFF_WT_IN), 0, it, lds);
        else if (it < 328) convert_item(P.w_a_out, 512, 1024, (u16*)(P.ws + OFF_WT_AOUT), 1, it - 296, lds);
        else if (it < 360) convert_item(P.w_glu, 512, 1024, (u16*)(P.ws + OFF_WT_GLU), 2, it - 328, lds);
        else if (it < 392) convert_item(P.w_b_out, 512, 1024, (u16*)(P.ws + OFF_WT_BOUT), 3, it - 360, lds);
        else if (it < 456) convert_item(P.w_o, 1024, 1024, (u16*)(P.ws + OFF_WT_O), 4, it - 392, lds);
        else if (it < 808) convert_item(P.w_up, 1024, 5632, (u16*)(P.ws + OFF_WT_UP), 5, it - 456, lds);
        else if (it < 984) convert_item(P.w_down, 2816, 1024, (u16*)(P.ws + OFF_WT_DOWN), 6, it - 808, lds);
        else if (it < 1176) mod_item(P, it - 984, lds);
        else s5tab_item(P, it - 1176, lds);
      }
    } break;
    case 1:
      for (int it = bid; it < 2176 + 2048; it += nb) {
        if (it < 2176) norm1_item(P, it); else mintra_item(P, it - 2176);
      }
      break;
    case 2:
      for (int it = bid; it < 1396; it += nb) inproj_tile(P, it, lds);
      break;
    case 3:
      for (int it = bid; it < 1088 + 192; it += nb) {
        if (it < 1088) delta_prep_item(P, it, lds); else s5end_tile(P, it - 1088, lds);
      }
      break;
    case 4:
      if (bid < 128) delta_scan_block(P, bid, lds);
      else if (bid < 160) s5_carry_block(P, bid - 128);
      break;
    case 5:
      for (int it = bid; it < 256 + 2048 + 2048; it += nb) {
        if (it < 256) s5out_tile(P, it, lds);
        else if (it < 2304) delta_post_item(P, it - 256);
        else norm1_item(P, it - 2304);
      }
      break;
    case 6:
      for (int it = bid; it < 512 + 1024; it += nb) {
        if (it < 512) glu_tile(P, it, lds); else gates_tile(P, it - 512, lds);
      }
      break;
    case 7:
      for (int it = bid; it < 512; it += nb) mix_tile(P, it, lds);
      break;
    case 8:
      for (int it = bid; it < 512; it += nb) wo_tile(P, it, lds);
      break;
    case 9:
      for (int it = bid; it < 2048; it += nb) norm2_item(P, it);
      break;
    case 10:
      for (int it = bid; it < 1408; it += nb) up_tile(P, it, 0, lds);
      break;
    case 11:
      for (int it = bid; it < 4096; it += nb) convgate_item(P, it, 0);
      break;
    case 12:
      for (int it = bid; it < 1408; it += nb) up_tile(P, it, 1, lds);
      break;
    case 13:
      for (int it = bid; it < 4096; it += nb) convgate_item(P, it, 1);
      break;
    case 14:
      for (int it = bid; it < 512; it += nb) down_tile(P, it, lds);
      break;
    case 15:
      for (int it = bid; it < 2048; it += nb) final_item(P, it);
      break;
    default: break;
  }
}

typedef const __attribute__((address_space(4))) Params* KParamsPtr;
__global__ void __launch_bounds__(NT) fwd_megakernel(Params Pk) {
#if defined(__HIP_DEVICE_COMPILE__)
  extern __shared__ __attribute__((aligned(16))) char lds[];
  KParamsPtr pp = (KParamsPtr)__builtin_amdgcn_kernarg_segment_ptr();
  const int lo = (int)pp->ph_lo, hi = (int)pp->ph_hi;
#if MULTI_LAUNCH
  for (int ph = lo; ph < hi; ++ph) { KParamsPtr q = pp; asm volatile("" : "+s"(q)); Params P; for (int i_ = 0; i_ < (int)(sizeof(Params) / 8); ++i_) ((unsigned long long*)&P)[i_] = ((const __attribute__((address_space(4))) unsigned long long*)q)[i_]; run_phase(P, ph, lds); }
#else
  cg::grid_group grid = cg::this_grid();
  volatile LAS unsigned* xst = (volatile LAS unsigned*)(lds + (LDS_BYTES - 16));
  if (threadIdx.x == 0) { xst[0] = 0u; xst[1] = 0u; xst[2] = 0u; xst[3] = 0u; }
  __syncthreads();
  XcdBarrier xb = xcd_barrier_post((unsigned*)(pp->ws + OFF_BAR), xst);
  const unsigned rep_mask = (unsigned)pp->rep_mask;
  bool first_sync = true;
  for (int ph = lo; ph < hi; ++ph) {
    const int reps = 1 + (int)((rep_mask >> ph) & 1u);
    for (int rp = 0; rp < reps; ++rp) {
      {
        KParamsPtr q = pp;
        asm volatile("" : "+s"(q));
        Params P;
        {
          typedef __attribute__((address_space(1))) const float* GF;
          const float** dp = (const float**)&P;
          const __attribute__((address_space(4))) unsigned long long* sp = (const __attribute__((address_space(4))) unsigned long long*)q;
#pragma unroll
          for (int i_ = 0; i_ < 30; ++i_) dp[i_] = (const float*)(GF)(sp[i_]);
          P.out = (float*)(__attribute__((address_space(1))) float*)(sp[30]);
          P.ws = (char*)(__attribute__((address_space(1))) char*)(sp[31]);
          P.ph_lo = 0; P.ph_hi = 0; P.rep_mask = 0;
        }
        run_phase(P, ph, lds);
      }
      if (ph + 1 < hi || rp + 1 < reps) {
        if (first_sync) { grid.sync(); first_sync = false; }
        else xcd_barrier(xb);
      }
    }
  }
#endif
#endif
}

extern "C" void kernel_launch(void* const* d_in, const int* in_sizes, int n_in, void* d_out, int out_size, void* d_ws,
                              size_t ws_size, hipStream_t stream) {
  static int grid_blocks = 0;
  if (grid_blocks == 0) {
    if (n_in != 30 || out_size != 16384 * 1024 || ws_size < WS_NEED) {
      fprintf(stderr, "kernel_launch: unexpected shapes: n_in %d out %d ws %zu (need %zu)\n", n_in, out_size, ws_size, (size_t)WS_NEED);
      grid_blocks = -1;
      return;
    }
    int dev = 0, cus = 0, per_cu = 0;
    hipGetDevice(&dev);
    hipDeviceGetAttribute(&cus, hipDeviceAttributeMultiprocessorCount, dev);
    if (hipFuncSetAttribute((const void*)fwd_megakernel, hipFuncAttributeMaxDynamicSharedMemorySize, LDS_BYTES) != hipSuccess) {
      fprintf(stderr, "kernel_launch: hipFuncSetAttribute failed\n");
      grid_blocks = -1;
      return;
    }
    if (hipOccupancyMaxActiveBlocksPerMultiprocessor(&per_cu, (const void*)fwd_megakernel, NT, LDS_BYTES) != hipSuccess || per_cu < 1) {
      fprintf(stderr, "kernel_launch: occupancy query failed / zero (%d)\n", per_cu);
      grid_blocks = -1;
      return;
    }
    grid_blocks = cus;
    if (grid_blocks < 64) { fprintf(stderr, "kernel_launch: too few CUs (%d)\n", cus); grid_blocks = -1; return; }
  }
  if (grid_blocks < 0) return;
  (void)hipMemsetAsync((char*)d_ws + OFF_BAR, 0, XCD_BAR_WORDS * sizeof(unsigned), stream);
  Params p{};
  const float** pp = (const float**)&p;
  for (int i = 0; i < 30; ++i) pp[i] = (const float*)d_in[i];
  p.out = (float*)d_out;
  p.ws = (char*)d_ws;
#if MULTI_LAUNCH
  for (int ph = 0; ph < 16; ++ph) {
    p.ph_lo = ph; p.ph_hi = ph + 1;
    hipLaunchKernelGGL(fwd_megakernel, dim3(grid_blocks), dim3(NT), LDS_BYTES, stream, p);
  }
#else
  p.ph_lo = 0; p.ph_hi = 16;
#ifdef REPEAT_MASK
  p.rep_mask = REPEAT_MASK;
#endif
  void* args[] = {&p};
  hipError_t e = hipLaunchCooperativeKernel((const void*)fwd_megakernel, dim3(grid_blocks), dim3(NT), args, LDS_BYTES, stream);
  if (e != hipSuccess) fprintf(stderr, "cooperative launch failed: %s (grid %d)\n", hipGetErrorString(e), grid_blocks);
#endif
}
```

```cpp
#include <hip/hip_runtime.h>
#include <hip/hip_cooperative_groups.h>
#include <cstdio>
#include <cstdint>
namespace cg = cooperative_groups;

#ifndef MULTI_LAUNCH
#define MULTI_LAUNCH 0
#endif

typedef unsigned short u16;
typedef __attribute__((ext_vector_type(8))) short bf16x8;
typedef __attribute__((ext_vector_type(4))) float f32x4;
typedef __attribute__((ext_vector_type(16))) float f32x16;

#define NT 512
constexpr int LDS_BYTES = 131072 + 1024;
constexpr int NPHASE = 18;

constexpr size_t OFF_WT_IN   = 0;
constexpr size_t OFF_WT_AOUT = 9699328;
constexpr size_t OFF_WT_GLU  = 10747904;
constexpr size_t OFF_WT_BOUT = 11796480;
constexpr size_t OFF_WT_O    = 12845056;
constexpr size_t OFF_WT_UP   = 14942208;
constexpr size_t OFF_WT_DOWN = 26476544;
constexpr size_t OFF_MOD     = 32243712;
constexpr size_t OFF_BAR     = 32505856;
constexpr size_t OFF_R2      = 33554432;
constexpr size_t OFF_R1      = 69206016;
constexpr size_t OFF_KTAB    = OFF_R1;
constexpr size_t OFF_MEND    = OFF_R1 + 2097152;
constexpr size_t OFF_MST     = OFF_R1 + 10485760;
constexpr size_t OFF_MINTRA  = OFF_R1 + 18874368;
constexpr size_t OFF_R3      = 104857600;
constexpr size_t OFF_O       = OFF_R3;
constexpr size_t OFF_XIN     = OFF_R3 + 33554432;
constexpr size_t OFF_MIX     = 158334976;
constexpr size_t OFF_SG      = OFF_R1;
constexpr size_t OFF_Z       = 158334976;
constexpr size_t OFF_U5      = 175112192;
constexpr size_t OFF_BA      = 192937984;
constexpr size_t OFF_GC      = OFF_BA + 1179648;
constexpr size_t OFF_UF      = 195035136;
constexpr size_t OFF_YA      = OFF_UF;
constexpr size_t OFF_YB      = OFF_UF + 16777216;
constexpr size_t OFF_E       = 230686720;
constexpr size_t OFF_YG      = OFF_E;
constexpr size_t OFF_UPH     = OFF_R1;
constexpr size_t OFF_G       = 161480704;
constexpr size_t WS_NEED     = 253755392;
constexpr size_t OFF_QKN     = 0;
constexpr size_t OFF_AQ      = 35651584;

struct Params {
  const float *x, *c, *ctx, *c_ctx, *w_ada, *b_ada, *norm1_w, *w_in, *dn_conv_w, *dn_a_log, *dn_dt_bias, *dn_norm_w,
      *w_a_out, *s5_a_re, *s5_a_im, *s5_log_step, *s5_b_re, *s5_b_im, *s5_c_re, *s5_c_im, *s5_d, *w_glu, *b_glu,
      *w_b_out, *w_o, *norm2_w, *w_up, *ffn_conv_w, *w_down, *norm_f_w;
  float* out;
  char* ws;
  long long ph_lo, ph_hi;
  long long rep_mask;
};

#define XB_TMO      128
#define XB_XCNT(j)  (256  + 64 * (j))
#define XB_XSUB(j)  (1280 + 64 * (j))
#define XB_XGEN(j)  (2304 + 64 * (j))
#define XB_TOP      3328
#define XB_TOPGEN   3392
#define XCD_BAR_WORDS 3456
#define XB_SPIN_CAP (1u << 18)
#define LAS __attribute__((address_space(3)))

__device__ __forceinline__ unsigned xb_ld(unsigned* p)              { return __hip_atomic_load(p, __ATOMIC_RELAXED, __HIP_MEMORY_SCOPE_AGENT); }
__device__ __forceinline__ unsigned xb_add(unsigned* p, unsigned v) { return __hip_atomic_fetch_add(p, v, __ATOMIC_RELAXED, __HIP_MEMORY_SCOPE_AGENT); }
__device__ __forceinline__ unsigned xb_xcc_id() { return (unsigned)__builtin_amdgcn_s_getreg((3 << 11) | 20) & 0xFu; }
#define XB_SPIN(cond, bar) do { unsigned _sp = 0; while (cond) { __builtin_amdgcn_s_sleep(1); \
    if ((++_sp & 255u) == 0u) { if (xb_ld(&(bar)[XB_TMO])) break; if (_sp > XB_SPIN_CAP) { atomicAdd(&(bar)[XB_TMO], 1u); break; } } } } while (0)

struct XcdBarrier {
    unsigned* bar; unsigned x;
    volatile LAS unsigned* st;
};

__device__ __forceinline__ XcdBarrier xcd_barrier_post(unsigned* bar, volatile LAS unsigned* st) {
    XcdBarrier b; b.bar = bar; b.x = xb_xcc_id(); b.st = st;
    if (threadIdx.x == 0) (void)xb_add(&bar[XB_XCNT(b.x)], 1u);
    return b;
}
__device__ __forceinline__ void xcd_barrier_complete(unsigned* bar, unsigned x, unsigned& nloc, unsigned& nx) {
    const unsigned G = gridDim.x * gridDim.y * gridDim.z;
    unsigned sum, cnt, mine, sp = 0u;
    for (;;) {
        sum = 0u; cnt = 0u; mine = 0u;
#pragma unroll
        for (unsigned j = 0; j < 16; ++j) { const unsigned c = xb_ld(&bar[XB_XCNT(j)]); sum += c; cnt += (c > 0u) ? 1u : 0u; mine = (j == x) ? c : mine; }
        if (sum == G) break;
        __builtin_amdgcn_s_sleep(1);
        if ((++sp & 255u) == 0u) { if (xb_ld(&bar[XB_TMO])) break; if (sp > XB_SPIN_CAP) { atomicAdd(&bar[XB_TMO], 1u); break; } }
    }
    nloc = mine > 0u ? mine : 1u; nx = cnt > 0u ? cnt : 1u;
}

__device__ __forceinline__ void xcd_barrier(const XcdBarrier& b) {
    asm volatile("s_waitcnt vmcnt(0)" ::: "memory");
    __syncthreads();
    if (threadIdx.x == 0) {
        unsigned* bar = b.bar;
        __builtin_amdgcn_s_waitcnt(0);
        unsigned nloc = b.st[0], nx = b.st[1];
        if (nloc == 0u) { xcd_barrier_complete(bar, b.x, nloc, nx); b.st[0] = nloc; b.st[1] = nx; }
        const unsigned old = xb_add(&bar[XB_XSUB(b.x)], 1u);
        const unsigned gen = old / nloc;
        if (old + 1u == (gen + 1u) * nloc) {
            __builtin_amdgcn_fence(__ATOMIC_RELEASE, "agent");
            asm volatile("s_waitcnt vmcnt(0)" ::: "memory");
            const unsigned og = xb_add(&bar[XB_TOP], 1u);
            const unsigned tg = og / nx;
            if (og + 1u == (tg + 1u) * nx) xb_add(&bar[XB_TOPGEN], 1u);
            else XB_SPIN(xb_ld(&bar[XB_TOPGEN]) == tg, bar);
            __builtin_amdgcn_fence(__ATOMIC_ACQUIRE, "agent");
            xb_add(&bar[XB_XGEN(b.x)], 1u);
            asm volatile("s_waitcnt vmcnt(0)" ::: "memory");
        } else {
            XB_SPIN(xb_ld(&bar[XB_XGEN(b.x)]) == gen, bar);
            __builtin_amdgcn_fence(__ATOMIC_ACQUIRE, "agent");
            asm volatile("s_waitcnt vmcnt(0)" ::: "memory");
        }
    }
    __syncthreads();
}


typedef __attribute__((ext_vector_type(2))) float f32x2_t;
typedef __attribute__((ext_vector_type(2))) __bf16 bf16x2_t;
__device__ __forceinline__ u16 f2bf(float f) {
  const __bf16 h = (__bf16)f;
  return __builtin_bit_cast(u16, h);
}
__device__ __forceinline__ float bf2f(u16 h) { return __uint_as_float(((uint32_t)h) << 16); }
__device__ __forceinline__ uint32_t pack2(float a, float b) {
  const f32x2_t v = {a, b};
  const bf16x2_t r = __builtin_convertvector(v, bf16x2_t);
  return __builtin_bit_cast(uint32_t, r);
}
__device__ __forceinline__ float lo16(uint32_t w) { return __uint_as_float(w << 16); }
__device__ __forceinline__ float hi16(uint32_t w) { return __uint_as_float(w & 0xffff0000u); }
__device__ __forceinline__ int opq(int v) { asm volatile("" : "+v"(v)); return v; }
__device__ __forceinline__ float sigm(float x) { return 1.f / (1.f + __expf(-x)); }
__device__ __forceinline__ void unpack8(uint4 v, float* f) {
  f[0] = lo16(v.x); f[1] = hi16(v.x); f[2] = lo16(v.y); f[3] = hi16(v.y);
  f[4] = lo16(v.z); f[5] = hi16(v.z); f[6] = lo16(v.w); f[7] = hi16(v.w);
}
__device__ __forceinline__ uint4 pack8(const float* f) {
  uint4 v; v.x = pack2(f[0], f[1]); v.y = pack2(f[2], f[3]); v.z = pack2(f[4], f[5]); v.w = pack2(f[6], f[7]);
  return v;
}
__device__ __forceinline__ float wsum64(float v) {
#pragma unroll
  for (int o = 32; o > 0; o >>= 1) v += __shfl_xor(v, o, 64);
  return v;
}
__device__ __forceinline__ float gelu_tanh(float x) {
  float u = 0.7978845608028654f * (x + 0.044715f * x * x * x);
  float t = 1.f - 2.f / (1.f + __expf(2.f * u));
  return 0.5f * x * (1.f + t);
}

__device__ __forceinline__ void g_frag(const u16* as, const u16* bs, int ks, bf16x8 (&a)[2], bf16x8 (&b)[2]) {
  a[0] = *(const bf16x8*)(as + ks * 16);
  a[1] = *(const bf16x8*)(as + 32 * 72 + ks * 16);
  b[0] = *(const bf16x8*)(bs + ks * 16);
  b[1] = *(const bf16x8*)(bs + 32 * 72 + ks * 16);
}
__device__ __forceinline__ void g_mma(const bf16x8 (&a)[2], const bf16x8 (&b)[2], f32x16 (&acc)[2][2]) {
  acc[0][0] = __builtin_amdgcn_mfma_f32_32x32x16_bf16(a[0], b[0], acc[0][0], 0, 0, 0);
  acc[0][1] = __builtin_amdgcn_mfma_f32_32x32x16_bf16(a[0], b[1], acc[0][1], 0, 0, 0);
  acc[1][0] = __builtin_amdgcn_mfma_f32_32x32x16_bf16(a[1], b[0], acc[1][0], 0, 0, 0);
  acc[1][1] = __builtin_amdgcn_mfma_f32_32x32x16_bf16(a[1], b[1], acc[1][1], 0, 0, 0);
}
__device__ __forceinline__ void gemm_main(const u16* __restrict__ A, int lda, const u16* __restrict__ Bt, int ldb, int K,
                                          f32x16 (&acc)[2][2], u16* lds) {
  const int tid = opq(threadIdx.x), lane = tid & 63, w = tid >> 6, wm = w >> 1, wn = w & 1, fr = lane & 31, fq = lane >> 5;
  u16* As = lds;
  u16* Bs = lds + 2 * 256 * 72;
  const int nk = K >> 6;
  uint4 p0, p1, p2, p3, p4, p5;
  uint4 q0, q1, q2, q3, q4, q5;
  uint4 r0, r1, r2, r3, r4, r5;
  const int lr = tid >> 3, lc = (tid & 7) * 8;
  const unsigned oa0 = (unsigned)(lr * lda + lc) * 2u, sa2 = (unsigned)lda * 128u;
  const unsigned oa1 = oa0 + sa2, oa2 = oa0 + 2u * sa2, oa3 = oa0 + 3u * sa2;
  const unsigned ob0 = (unsigned)(lr * ldb + lc) * 2u, ob1 = ob0 + (unsigned)ldb * 128u;
#define G_LOAD(S, kt_)                                          \
  {                                                             \
    const int kc_ = ((kt_) < nk) ? (kt_) : (nk - 1);            \
    const char* a_ = (const char*)A + kc_ * 128;                \
    const char* b_ = (const char*)Bt + kc_ * 128;               \
    S##0 = *(const uint4*)(a_ + oa0);                           \
    S##1 = *(const uint4*)(a_ + oa1);                           \
    S##2 = *(const uint4*)(a_ + oa2);                           \
    S##3 = *(const uint4*)(a_ + oa3);                           \
    S##4 = *(const uint4*)(b_ + ob0);                           \
    S##5 = *(const uint4*)(b_ + ob1);                           \
  }
#define G_STORE(S, buf_)                                                     \
  {                                                                          \
    u16* as_ = As + ((buf_) * 256 + lr) * 72 + lc;                           \
    u16* bs_ = Bs + ((buf_) * 128 + lr) * 72 + lc;                           \
    *(uint4*)(as_) = S##0;                                                   \
    *(uint4*)(as_ + 64 * 72) = S##1;                                         \
    *(uint4*)(as_ + 128 * 72) = S##2;                                        \
    *(uint4*)(as_ + 192 * 72) = S##3;                                        \
    *(uint4*)(bs_) = S##4;                                                   \
    *(uint4*)(bs_ + 64 * 72) = S##5;                                         \
  }
#define G_STEP(S, BUF, kt_)                                                               \
  {                                                                                       \
    const u16* as = As + ((BUF) * 256 + wm * 64 + fr) * 72 + fq * 8;                      \
    const u16* bs = Bs + ((BUF) * 128 + wn * 64 + fr) * 72 + fq * 8;                      \
    bf16x8 fa0[2], fb0[2], fa1[2], fb1[2], fa2[2], fb2[2];                                \
    g_frag(as, bs, 0, fa0, fb0);                                                          \
    g_frag(as, bs, 1, fa1, fb1);                                                          \
    __builtin_amdgcn_sched_barrier(0);                                                    \
    G_STORE(S, (BUF) ^ 1)                                                                 \
    G_LOAD(S, (kt_) + 4)                                                                  \
    __builtin_amdgcn_sched_barrier(0);                                                    \
    g_frag(as, bs, 2, fa2, fb2);                                                          \
    __builtin_amdgcn_sched_barrier(0);                                                    \
    g_mma(fa0, fb0, acc);                                                                 \
    __builtin_amdgcn_sched_barrier(0);                                                    \
    g_frag(as, bs, 3, fa0, fb0);                                                          \
    __builtin_amdgcn_sched_barrier(0);                                                    \
    g_mma(fa1, fb1, acc);                                                                 \
    g_mma(fa2, fb2, acc);                                                                 \
    g_mma(fa0, fb0, acc);                                                                 \
    __syncthreads();                                                                      \
  }
  G_LOAD(p, 0)
  __syncthreads();
  G_STORE(p, 0)
  G_LOAD(q, 1)
  G_LOAD(r, 2)
  G_LOAD(p, 3)
  __syncthreads();
  for (int kt = 0; kt < nk; kt += 6) {
    G_STEP(q, 0, kt)
    G_STEP(r, 1, kt + 1)
    if (kt + 2 < nk) {
      G_STEP(p, 0, kt + 2)
      G_STEP(q, 1, kt + 3)
    }
    if (kt + 4 < nk) {
      G_STEP(r, 0, kt + 4)
      G_STEP(p, 1, kt + 5)
    }
  }
#undef G_STEP
#undef G_LOAD
#undef G_STORE
}

__device__ __forceinline__ void acc_zero(f32x16 (&acc)[2][2]) {
#pragma unroll
  for (int i = 0; i < 2; ++i)
#pragma unroll
    for (int j = 0; j < 2; ++j)
#pragma unroll
      for (int e = 0; e < 16; ++e) acc[i][j][e] = 0.f;
}

#define TILE_COORDS                                                                                  \
  const int tid_ = opq(threadIdx.x), lane_ = tid_ & 63, w_ = __builtin_amdgcn_readfirstlane(tid_ >> 6), \
            wm_ = w_ >> 1, wn_ = w_ & 1, fr_ = lane_ & 31, fq_ = lane_ >> 5;
#define TROW(m0, i, e) ((m0) + wm_ * 64 + (i) * 32 + ((e) & 3) + 8 * ((e) >> 2) + 4 * fq_)
#define TCOL(n0, j) ((n0) + wn_ * 64 + (j) * 32 + fr_)
#define TIDX2(m0, cb, i, e, ld) ((size_t)((m0) + wm_ * 64 + (i) * 32 + ((e) & 3) + 8 * ((e) >> 2)) * (ld) + (cb) + (size_t)(unsigned)(4 * fq_ * (ld) + fr_))
#define TIDX(m0, n0, i, j, e, ld) TIDX2(m0, (n0) + wn_ * 64 + (j) * 32, i, e, ld)

__device__ __forceinline__ int srccol(int which, int r) {
  switch (which) {
    case 0:
      if (r < 2048) return r;
      if (r < 2560) return 2064 + (r - 2048);
      if (r < 2576) return 2048 + (r - 2560);
      if (r < 2688) return -1;
      if (r < 3712) return 2576 + (r - 2688);
      return 3600 + (r - 3712);
    case 2: {
      int tile = r >> 7, wn = (r >> 6) & 1, wi = r & 63;
      return (wi < 32) ? (tile * 64 + wn * 32 + wi) : (512 + tile * 64 + wn * 32 + (wi - 32));
    }
    case 5: {
      int hh = r / 2816, cc = r % 2816;
      return (cc < 1408) ? (hh * 1408 + cc) : (2816 + hh * 1408 + (cc - 1408));
    }
    default: return r;
  }
}

__device__ __forceinline__ void convert_item(const float* __restrict__ src, int K, int N, u16* __restrict__ dst, int which, int item, char* lds) {
  float* tile = (float*)lds;
  const int tid = opq(threadIdx.x);
  const int kb = K >> 8;
  const int r0 = (item / kb) * 64, k0 = (item % kb) * 256;
  __syncthreads();
  {
    const int n4 = (tid & 15) * 4, kk = tid >> 4;
    const int sc = srccol(which, r0 + n4);
    float4 v[8];
#pragma unroll
    for (int it = 0; it < 8; ++it) {
      const int k = kk + 32 * it;
      v[it] = (sc >= 0) ? *(const float4*)(src + (size_t)(k0 + k) * N + sc) : make_float4(0.f, 0.f, 0.f, 0.f);
    }
#pragma unroll
    for (int it = 0; it < 8; ++it) {
      const int k = kk + 32 * it;
      tile[(n4 + 0) * 257 + k] = v[it].x; tile[(n4 + 1) * 257 + k] = v[it].y;
      tile[(n4 + 2) * 257 + k] = v[it].z; tile[(n4 + 3) * 257 + k] = v[it].w;
    }
  }
  __syncthreads();
  {
    const int ks = (tid & 31) * 8, rr = tid >> 5;
#pragma unroll
    for (int it = 0; it < 4; ++it) {
      const int row = rr + 16 * it;
      float f[8];
#pragma unroll
      for (int e = 0; e < 8; ++e) f[e] = tile[row * 257 + ks + e];
      *(uint4*)(dst + (size_t)(r0 + row) * K + k0 + ks) = pack8(f);
    }
  }
}

__device__ __forceinline__ void mod_item(const Params& P, int item, char* lds) {
  float* sc = (float*)lds;
  float* red = sc + 5 * 1024;
  const int tid = opq(threadIdx.x);
  __syncthreads();
  for (int i = tid; i < 5 * 1024; i += NT) {
    const int r = i >> 10, k = i & 1023;
    float v = (r < 4) ? P.c[r * 1024 + k] : P.c_ctx[k];
    sc[i] = v * sigm(v);
  }
  __syncthreads();
  const int nn = tid & 31, kg = tid >> 5;
  const int n = item * 32 + nn;
  float a0 = 0, a1 = 0, a2 = 0, a3 = 0, a4 = 0;
  for (int kk = 0; kk < 64; ++kk) {
    const int k = kg * 64 + kk;
    const float wv = P.w_ada[(size_t)k * 6144 + n];
    a0 += sc[k] * wv; a1 += sc[1024 + k] * wv; a2 += sc[2048 + k] * wv; a3 += sc[3072 + k] * wv; a4 += sc[4096 + k] * wv;
  }
  red[(kg * 5 + 0) * 32 + nn] = a0; red[(kg * 5 + 1) * 32 + nn] = a1; red[(kg * 5 + 2) * 32 + nn] = a2;
  red[(kg * 5 + 3) * 32 + nn] = a3; red[(kg * 5 + 4) * 32 + nn] = a4;
  __syncthreads();
  if (tid < 160) {
    const int r = tid >> 5, n2 = tid & 31;
    float s = 0.f;
#pragma unroll
    for (int g = 0; g < 16; ++g) s += red[(g * 5 + r) * 32 + n2];
    float* MOD = (float*)(P.ws + OFF_MOD);
    MOD[r * 6144 + item * 32 + n2] = s + P.b_ada[item * 32 + n2];
  }
}

__device__ __forceinline__ void lam_pow(float step, float are, float aim, int e, float& pr, float& pi) {
  const float mag = expf((float)e * step * are);
  double ang = (double)e * (double)step * (double)aim;
  ang -= 6.283185307179586476925 * rint(ang * 0.15915494309189533577);
  float s, c;
  __sincosf((float)ang, &s, &c);
  pr = mag * c; pi = mag * s;
}

__device__ __forceinline__ void s5tab_item(const Params& P, int item, char* lds) {
  const int tid = opq(threadIdx.x);
  const int tau = item & 31, g = (item >> 5) & 31, r = item >> 10;
  float* cfr = (float*)lds;
  float* cfi = cfr + 64;
  float* p0r = cfi + 64;
  float* p0i = p0r + 64;
  float* p1r = p0i + 64;
  float* p1i = p1r + 64;
  float* Gr = p1i + 64;
  float* Gi = Gr + 1024;
  float* Cr = Gi + 1024;
  float* Ci = Cr + 1024;
  const int rg = r * 32 + g;
  __syncthreads();
  if (tid < 64) {
    const int n = tid;
    const float step = expf(P.s5_log_step[rg]);
    const float are = P.s5_a_re[rg * 64 + n], aim = P.s5_a_im[rg * 64 + n];
    const float za = step * are;
    double zb = (double)step * (double)aim;
    zb -= 6.283185307179586476925 * rint(zb * 0.15915494309189533577);
    float sb, cb, sh, ch;
    __sincosf((float)zb, &sb, &cb);
    __sincosf((float)(0.5 * zb), &sh, &ch);
    const float em1 = expm1f(za);
    const float re1 = em1 * cb - 2.f * sh * sh;
    const float im1 = (1.f + em1) * sb;
    const float den = are * are + aim * aim;
    cfr[n] = (re1 * are + im1 * aim) / den;
    cfi[n] = (im1 * are - re1 * aim) / den;
    float pr, pi;
    lam_pow(step, are, aim, tau, pr, pi);
    p0r[n] = pr; p0i[n] = pi;
    lam_pow(step, are, aim, tau + 1, pr, pi);
    p1r[n] = pr; p1i[n] = pi;
  }
  for (int i = tid; i < 1024; i += NT) {
    Cr[i] = P.s5_c_re[(size_t)rg * 1024 + i];
    Ci[i] = P.s5_c_im[(size_t)rg * 1024 + i];
  }
  __syncthreads();
  for (int i = tid; i < 1024; i += NT) {
    const int n = i >> 4;
    const float br = P.s5_b_re[(size_t)rg * 1024 + i], bi = P.s5_b_im[(size_t)rg * 1024 + i];
    const float tr = cfr[n] * br - cfi[n] * bi, ti = cfr[n] * bi + cfi[n] * br;
    Gr[i] = p0r[n] * tr - p0i[n] * ti;
    Gi[i] = p0r[n] * ti + p0i[n] * tr;
  }
  __syncthreads();
  u16* MEND = (u16*)(P.ws + OFF_MEND);
  u16* MST = (u16*)(P.ws + OFF_MST);
  float* KTAB = (float*)(P.ws + OFF_KTAB);
  {
    const int ii = (r == 0) ? (31 - tau) : tau;
    for (int i = tid; i < 2048; i += NT) {
      const int part = i >> 10, n = (i >> 4) & 63, pi_ = i & 15;
      const float v = part ? Gi[n * 16 + pi_] : Gr[n * 16 + pi_];
      MEND[((size_t)g * 256 + r * 128 + part * 64 + n) * 512 + ii * 16 + pi_] = f2bf(v);
    }
  }
  if (tid < 256) {
    const int po = tid >> 4, pi_ = tid & 15;
    float s = 0.f;
    for (int n = 0; n < 64; ++n) s += Cr[po * 64 + n] * Gr[n * 16 + pi_] - Ci[po * 64 + n] * Gi[n * 16 + pi_];
    KTAB[(((size_t)rg) * 32 + tau) * 256 + tid] = s;
  }
  {
    const int jj = (r == 0) ? tau : (31 - tau);
    for (int i = tid; i < 2048; i += NT) {
      const int po = i >> 7, part = (i >> 6) & 1, n = i & 63;
      const float cr = Cr[po * 64 + n], ci = Ci[po * 64 + n];
      const float v = part ? -(cr * p1i[n] + ci * p1r[n]) : (cr * p1r[n] - ci * p1i[n]);
      MST[((size_t)g * 512 + jj * 16 + po) * 256 + r * 128 + part * 64 + n] = f2bf(v);
    }
  }
}

__device__ __forceinline__ void norm_row(const float* __restrict__ xr, const float* __restrict__ nw, const float* __restrict__ shift,
                                         const float* __restrict__ scale, u16* __restrict__ dst, int lane) {
  float4 v[4];
  float ss = 0.f;
#pragma unroll
  for (int it = 0; it < 4; ++it) {
    v[it] = *(const float4*)(xr + (it * 64 + lane) * 4);
    ss += v[it].x * v[it].x + v[it].y * v[it].y + v[it].z * v[it].z + v[it].w * v[it].w;
  }
  ss = wsum64(ss);
  const float rstd = rsqrtf(ss * (1.f / 1024.f) + 1e-6f);
#pragma unroll
  for (int it = 0; it < 4; ++it) {
    const int c = (it * 64 + lane) * 4;
    const float4 w4 = *(const float4*)(nw + c), sh = *(const float4*)(shift + c), sc = *(const float4*)(scale + c);
    const float y0 = v[it].x * rstd * w4.x * (1.f + sc.x) + sh.x;
    const float y1 = v[it].y * rstd * w4.y * (1.f + sc.y) + sh.y;
    const float y2 = v[it].z * rstd * w4.z * (1.f + sc.z) + sh.z;
    const float y3 = v[it].w * rstd * w4.w * (1.f + sc.w) + sh.w;
    uint2 o; o.x = pack2(y0, y1); o.y = pack2(y2, y3);
    *(uint2*)(dst + c) = o;
  }
}

__device__ __forceinline__ void norm1_item(const Params& P, int item) {
  const int lane = opq(threadIdx.x) & 63, w = opq(threadIdx.x) >> 6;
  const int row = item * 8 + w;
  const float* MOD = (const float*)(P.ws + OFF_MOD);
  const int bi = (row < 16384) ? (row >> 12) : 4;
  const float* xr = (row < 16384) ? (P.x + (size_t)row * 1024) : (P.ctx + (size_t)(row - 16384) * 1024);
  norm_row(xr, P.norm1_w, MOD + bi * 6144, MOD + bi * 6144 + 1024, (u16*)(P.ws + OFF_R2) + (size_t)row * 1024, lane);
}

__device__ __forceinline__ void mintra_item(const Params& P, int item) {
  const int tid = opq(threadIdx.x);
  const int rowg = item * 8 + (tid >> 6);
  const int g = rowg >> 9, nout = rowg & 511, j = nout >> 4, po = nout & 15;
  const int k0 = (tid & 63) * 8, i = k0 >> 4, pi0 = k0 & 15;
  const float* KTAB = (const float*)(P.ws + OFF_KTAB);
  float f[8];
#pragma unroll
  for (int e = 0; e < 8; ++e) f[e] = 0.f;
  if (i <= j) {
    const float* kp = KTAB + (((size_t)(0 * 32 + g)) * 32 + (j - i)) * 256 + po * 16 + pi0;
#pragma unroll
    for (int e = 0; e < 8; ++e) f[e] += kp[e];
  }
  if (i >= j) {
    const float* kp = KTAB + (((size_t)(1 * 32 + g)) * 32 + (i - j)) * 256 + po * 16 + pi0;
#pragma unroll
    for (int e = 0; e < 8; ++e) f[e] += kp[e];
  }
  if (i == j) {
    const float dv = P.s5_d[g * 16 + po];
#pragma unroll
    for (int e = 0; e < 8; ++e) if (pi0 + e == po) f[e] += dv;
  }
  u16* MI = (u16*)(P.ws + OFF_MINTRA);
  *(uint4*)(MI + (size_t)rowg * 512 + k0) = pack8(f);
}

__device__ __forceinline__ void inproj_tile(const Params& P, int t, char* lds) {
  int mt, nt;
  if (t < 1344) { nt = t / 64; mt = t % 64; }
  else {
    const int tt = t - 1344; mt = 64 + (tt & 3);
    const int ni = tt >> 2;
    nt = (ni < 8) ? (4 + ni) : ((ni < 12) ? (16 + ni - 8) : 20);
  }
  const int m0 = mt * 256, n0 = nt * 128;
  f32x16 acc[2][2];
  acc_zero(acc);
  gemm_main((const u16*)(P.ws + OFF_R2) + (size_t)m0 * 1024, 1024, (const u16*)(P.ws + OFF_WT_IN) + (size_t)n0 * 1024, 1024, 1024, acc, (u16*)lds);
  TILE_COORDS
  if (nt < 12) {
    u16* QKV = (u16*)(P.ws + OFF_R3);
#pragma unroll
    for (int i = 0; i < 2; ++i)
#pragma unroll
      for (int j = 0; j < 2; ++j)
#pragma unroll
        for (int e = 0; e < 16; ++e) QKV[TIDX(m0, n0, i, j, e, 1536)] = f2bf(acc[i][j][e]);
  } else if (nt < 16) {
    u16* Z = (u16*)(P.ws + OFF_Z);
#pragma unroll
    for (int i = 0; i < 2; ++i)
#pragma unroll
      for (int j = 0; j < 2; ++j)
#pragma unroll
        for (int e = 0; e < 16; ++e) Z[TIDX(m0, n0, i, j, e, 512) - 1536] = f2bf(acc[i][j][e]);
  } else if (nt < 20) {
    u16* U5 = (u16*)(P.ws + OFF_U5);
#pragma unroll
    for (int i = 0; i < 2; ++i)
#pragma unroll
      for (int j = 0; j < 2; ++j)
#pragma unroll
        for (int e = 0; e < 16; ++e) {
          const int cc = TCOL(n0, j) - 2048;
          U5[((size_t)(cc >> 4) * 17408 + TROW(m0, i, e)) * 16 + (cc & 15)] = f2bf(acc[i][j][e]);
        }
  } else {
    float* BA = (float*)(P.ws + OFF_BA);
#pragma unroll
    for (int i = 0; i < 2; ++i)
#pragma unroll
      for (int j = 0; j < 2; ++j)
#pragma unroll
        for (int e = 0; e < 16; ++e) {
          const int cc = TCOL(n0, j) - 2560;
          if (cc < 16) BA[(size_t)TROW(m0, i, e) * 16 + cc] = acc[i][j][e];
        }
  }
}

__device__ __forceinline__ void solve_elim(float (&sol)[64], const float* Lr) {
  float4 b0a, b0b, b0c, b0d, b1a, b1b, b1c, b1d, b2a, b2b, b2c, b2d;
  b0a = *(const float4*)(Lr + 0); b0b = *(const float4*)(Lr + 4); b0c = *(const float4*)(Lr + 8); b0d = *(const float4*)(Lr + 12);
  b1a = *(const float4*)(Lr + 16); b1b = *(const float4*)(Lr + 20); b1c = *(const float4*)(Lr + 24); b1d = *(const float4*)(Lr + 28);
  b2a = *(const float4*)(Lr + 32); b2b = *(const float4*)(Lr + 36); b2c = *(const float4*)(Lr + 40); b2d = *(const float4*)(Lr + 44);
  __builtin_amdgcn_sched_barrier(0);
  sol[1] -= b0a.y * sol[0]; sol[2] -= b0a.z * sol[0]; sol[3] -= b0a.w * sol[0]; sol[4] -= b0b.x * sol[0]; sol[5] -= b0b.y * sol[0]; sol[6] -= b0b.z * sol[0]; sol[7] -= b0b.w * sol[0]; sol[8] -= b0c.x * sol[0]; sol[9] -= b0c.y * sol[0]; sol[10] -= b0c.z * sol[0]; sol[11] -= b0c.w * sol[0]; sol[12] -= b0d.x * sol[0]; sol[13] -= b0d.y * sol[0]; sol[14] -= b0d.z * sol[0]; sol[15] -= b0d.w * sol[0];
  __builtin_amdgcn_sched_barrier(0);
  b0a = *(const float4*)(Lr + 48); b0b = *(const float4*)(Lr + 52); b0c = *(const float4*)(Lr + 56); b0d = *(const float4*)(Lr + 60);
  __builtin_amdgcn_sched_barrier(0);
  sol[16] -= b1a.x * sol[0]; sol[17] -= b1a.y * sol[0]; sol[18] -= b1a.z * sol[0]; sol[19] -= b1a.w * sol[0]; sol[20] -= b1b.x * sol[0]; sol[21] -= b1b.y * sol[0]; sol[22] -= b1b.z * sol[0]; sol[23] -= b1b.w * sol[0]; sol[24] -= b1c.x * sol[0]; sol[25] -= b1c.y * sol[0]; sol[26] -= b1c.z * sol[0]; sol[27] -= b1c.w * sol[0]; sol[28] -= b1d.x * sol[0]; sol[29] -= b1d.y * sol[0]; sol[30] -= b1d.z * sol[0]; sol[31] -= b1d.w * sol[0];
  __builtin_amdgcn_sched_barrier(0);
  b1a = *(const float4*)(Lr + 64); b1b = *(const float4*)(Lr + 68); b1c = *(const float4*)(Lr + 72); b1d = *(const float4*)(Lr + 76);
  __builtin_amdgcn_sched_barrier(0);
  sol[32] -= b2a.x * sol[0]; sol[33] -= b2a.y * sol[0]; sol[34] -= b2a.z * sol[0]; sol[35] -= b2a.w * sol[0]; sol[36] -= b2b.x * sol[0]; sol[37] -= b2b.y * sol[0]; sol[38] -= b2b.z * sol[0]; sol[39] -= b2b.w * sol[0]; sol[40] -= b2c.x * sol[0]; sol[41] -= b2c.y * sol[0]; sol[42] -= b2c.z * sol[0]; sol[43] -= b2c.w * sol[0]; sol[44] -= b2d.x * sol[0]; sol[45] -= b2d.y * sol[0]; sol[46] -= b2d.z * sol[0]; sol[47] -= b2d.w * sol[0];
  __builtin_amdgcn_sched_barrier(0);
  b2a = *(const float4*)(Lr + 80); b2b = *(const float4*)(Lr + 84); b2c = *(const float4*)(Lr + 88); b2d = *(const float4*)(Lr + 92);
  __builtin_amdgcn_sched_barrier(0);
  sol[48] -= b0a.x * sol[0]; sol[49] -= b0a.y * sol[0]; sol[50] -= b0a.z * sol[0]; sol[51] -= b0a.w * sol[0]; sol[52] -= b0b.x * sol[0]; sol[53] -= b0b.y * sol[0]; sol[54] -= b0b.z * sol[0]; sol[55] -= b0b.w * sol[0]; sol[56] -= b0c.x * sol[0]; sol[57] -= b0c.y * sol[0]; sol[58] -= b0c.z * sol[0]; sol[59] -= b0c.w * sol[0]; sol[60] -= b0d.x * sol[0]; sol[61] -= b0d.y * sol[0]; sol[62] -= b0d.z * sol[0]; sol[63] -= b0d.w * sol[0];
  __builtin_amdgcn_sched_barrier(0);
  b0a = *(const float4*)(Lr + 96); b0b = *(const float4*)(Lr + 100); b0c = *(const float4*)(Lr + 104); b0d = *(const float4*)(Lr + 108);
  __builtin_amdgcn_sched_barrier(0);
  sol[2] -= b1a.z * sol[1]; sol[3] -= b1a.w * sol[1]; sol[4] -= b1b.x * sol[1]; sol[5] -= b1b.y * sol[1]; sol[6] -= b1b.z * sol[1]; sol[7] -= b1b.w * sol[1]; sol[8] -= b1c.x * sol[1]; sol[9] -= b1c.y * sol[1]; sol[10] -= b1c.z * sol[1]; sol[11] -= b1c.w * sol[1]; sol[12] -= b1d.x * sol[1]; sol[13] -= b1d.y * sol[1]; sol[14] -= b1d.z * sol[1]; sol[15] -= b1d.w * sol[1];
  __builtin_amdgcn_sched_barrier(0);
  b1a = *(const float4*)(Lr + 112); b1b = *(const float4*)(Lr + 116); b1c = *(const float4*)(Lr + 120); b1d = *(const float4*)(Lr + 124);
  __builtin_amdgcn_sched_barrier(0);
  sol[16] -= b2a.x * sol[1]; sol[17] -= b2a.y * sol[1]; sol[18] -= b2a.z * sol[1]; sol[19] -= b2a.w * sol[1]; sol[20] -= b2b.x * sol[1]; sol[21] -= b2b.y * sol[1]; sol[22] -= b2b.z * sol[1]; sol[23] -= b2b.w * sol[1]; sol[24] -= b2c.x * sol[1]; sol[25] -= b2c.y * sol[1]; sol[26] -= b2c.z * sol[1]; sol[27] -= b2c.w * sol[1]; sol[28] -= b2d.x * sol[1]; sol[29] -= b2d.y * sol[1]; sol[30] -= b2d.z * sol[1]; sol[31] -= b2d.w * sol[1];
  __builtin_amdgcn_sched_barrier(0);
  b2a = *(const float4*)(Lr + 128); b2b = *(const float4*)(Lr + 132); b2c = *(const float4*)(Lr + 136); b2d = *(const float4*)(Lr + 140);
  __builtin_amdgcn_sched_barrier(0);
  sol[32] -= b0a.x * sol[1]; sol[33] -= b0a.y * sol[1]; sol[34] -= b0a.z * sol[1]; sol[35] -= b0a.w * sol[1]; sol[36] -= b0b.x * sol[1]; sol[37] -= b0b.y * sol[1]; sol[38] -= b0b.z * sol[1]; sol[39] -= b0b.w * sol[1]; sol[40] -= b0c.x * sol[1]; sol[41] -= b0c.y * sol[1]; sol[42] -= b0c.z * sol[1]; sol[43] -= b0c.w * sol[1]; sol[44] -= b0d.x * sol[1]; sol[45] -= b0d.y * sol[1]; sol[46] -= b0d.z * sol[1]; sol[47] -= b0d.w * sol[1];
  __builtin_amdgcn_sched_barrier(0);
  b0a = *(const float4*)(Lr + 144); b0b = *(const float4*)(Lr + 148); b0c = *(const float4*)(Lr + 152); b0d = *(const float4*)(Lr + 156);
  __builtin_amdgcn_sched_barrier(0);
  sol[48] -= b1a.x * sol[1]; sol[49] -= b1a.y * sol[1]; sol[50] -= b1a.z * sol[1]; sol[51] -= b1a.w * sol[1]; sol[52] -= b1b.x * sol[1]; sol[53] -= b1b.y * sol[1]; sol[54] -= b1b.z * sol[1]; sol[55] -= b1b.w * sol[1]; sol[56] -= b1c.x * sol[1]; sol[57] -= b1c.y * sol[1]; sol[58] -= b1c.z * sol[1]; sol[59] -= b1c.w * sol[1]; sol[60] -= b1d.x * sol[1]; sol[61] -= b1d.y * sol[1]; sol[62] -= b1d.z * sol[1]; sol[63] -= b1d.w * sol[1];
  __builtin_amdgcn_sched_barrier(0);
  b1a = *(const float4*)(Lr + 160); b1b = *(const float4*)(Lr + 164); b1c = *(const float4*)(Lr + 168); b1d = *(const float4*)(Lr + 172);
  __builtin_amdgcn_sched_barrier(0);
  sol[3] -= b2a.w * sol[2]; sol[4] -= b2b.x * sol[2]; sol[5] -= b2b.y * sol[2]; sol[6] -= b2b.z * sol[2]; sol[7] -= b2b.w * sol[2]; sol[8] -= b2c.x * sol[2]; sol[9] -= b2c.y * sol[2]; sol[10] -= b2c.z * sol[2]; sol[11] -= b2c.w * sol[2]; sol[12] -= b2d.x * sol[2]; sol[13] -= b2d.y * sol[2]; sol[14] -= b2d.z * sol[2]; sol[15] -= b2d.w * sol[2];
  __builtin_amdgcn_sched_barrier(0);
  b2a = *(const float4*)(Lr + 176); b2b = *(const float4*)(Lr + 180); b2c = *(const float4*)(Lr + 184); b2d = *(const float4*)(Lr + 188);
  __builtin_amdgcn_sched_barrier(0);
  sol[16] -= b0a.x * sol[2]; sol[17] -= b0a.y * sol[2]; sol[18] -= b0a.z * sol[2]; sol[19] -= b0a.w * sol[2]; sol[20] -= b0b.x * sol[2]; sol[21] -= b0b.y * sol[2]; sol[22] -= b0b.z * sol[2]; sol[23] -= b0b.w * sol[2]; sol[24] -= b0c.x * sol[2]; sol[25] -= b0c.y * sol[2]; sol[26] -= b0c.z * sol[2]; sol[27] -= b0c.w * sol[2]; sol[28] -= b0d.x * sol[2]; sol[29] -= b0d.y * sol[2]; sol[30] -= b0d.z * sol[2]; sol[31] -= b0d.w * sol[2];
  __builtin_amdgcn_sched_barrier(0);
  b0a = *(const float4*)(Lr + 192); b0b = *(const float4*)(Lr + 196); b0c = *(const float4*)(Lr + 200); b0d = *(const float4*)(Lr + 204);
  __builtin_amdgcn_sched_barrier(0);
  sol[32] -= b1a.x * sol[2]; sol[33] -= b1a.y * sol[2]; sol[34] -= b1a.z * sol[2]; sol[35] -= b1a.w * sol[2]; sol[36] -= b1b.x * sol[2]; sol[37] -= b1b.y * sol[2]; sol[38] -= b1b.z * sol[2]; sol[39] -= b1b.w * sol[2]; sol[40] -= b1c.x * sol[2]; sol[41] -= b1c.y * sol[2]; sol[42] -= b1c.z * sol[2]; sol[43] -= b1c.w * sol[2]; sol[44] -= b1d.x * sol[2]; sol[45] -= b1d.y * sol[2]; sol[46] -= b1d.z * sol[2]; sol[47] -= b1d.w * sol[2];
  __builtin_amdgcn_sched_barrier(0);
  b1a = *(const float4*)(Lr + 208); b1b = *(const float4*)(Lr + 212); b1c = *(const float4*)(Lr + 216); b1d = *(const float4*)(Lr + 220);
  __builtin_amdgcn_sched_barrier(0);
  sol[48] -= b2a.x * sol[2]; sol[49] -= b2a.y * sol[2]; sol[50] -= b2a.z * sol[2]; sol[51] -= b2a.w * sol[2]; sol[52] -= b2b.x * sol[2]; sol[53] -= b2b.y * sol[2]; sol[54] -= b2b.z * sol[2]; sol[55] -= b2b.w * sol[2]; sol[56] -= b2c.x * sol[2]; sol[57] -= b2c.y * sol[2]; sol[58] -= b2c.z * sol[2]; sol[59] -= b2c.w * sol[2]; sol[60] -= b2d.x * sol[2]; sol[61] -= b2d.y * sol[2]; sol[62] -= b2d.z * sol[2]; sol[63] -= b2d.w * sol[2];
  __builtin_amdgcn_sched_barrier(0);
  b2a = *(const float4*)(Lr + 224); b2b = *(const float4*)(Lr + 228); b2c = *(const float4*)(Lr + 232); b2d = *(const float4*)(Lr + 236);
  __builtin_amdgcn_sched_barrier(0);
  sol[4] -= b0b.x * sol[3]; sol[5] -= b0b.y * sol[3]; sol[6] -= b0b.z * sol[3]; sol[7] -= b0b.w * sol[3]; sol[8] -= b0c.x * sol[3]; sol[9] -= b0c.y * sol[3]; sol[10] -= b0c.z * sol[3]; sol[11] -= b0c.w * sol[3]; sol[12] -= b0d.x * sol[3]; sol[13] -= b0d.y * sol[3]; sol[14] -= b0d.z * sol[3]; sol[15] -= b0d.w * sol[3];
  __builtin_amdgcn_sched_barrier(0);
  b0a = *(const float4*)(Lr + 240); b0b = *(const float4*)(Lr + 244); b0c = *(const float4*)(Lr + 248); b0d = *(const float4*)(Lr + 252);
  __builtin_amdgcn_sched_barrier(0);
  sol[16] -= b1a.x * sol[3]; sol[17] -= b1a.y * sol[3]; sol[18] -= b1a.z * sol[3]; sol[19] -= b1a.w * sol[3]; sol[20] -= b1b.x * sol[3]; sol[21] -= b1b.y * sol[3]; sol[22] -= b1b.z * sol[3]; sol[23] -= b1b.w * sol[3]; sol[24] -= b1c.x * sol[3]; sol[25] -= b1c.y * sol[3]; sol[26] -= b1c.z * sol[3]; sol[27] -= b1c.w * sol[3]; sol[28] -= b1d.x * sol[3]; sol[29] -= b1d.y * sol[3]; sol[30] -= b1d.z * sol[3]; sol[31] -= b1d.w * sol[3];
  __builtin_amdgcn_sched_barrier(0);
  b1a = *(const float4*)(Lr + 256); b1b = *(const float4*)(Lr + 260); b1c = *(const float4*)(Lr + 264); b1d = *(const float4*)(Lr + 268);
  __builtin_amdgcn_sched_barrier(0);
  sol[32] -= b2a.x * sol[3]; sol[33] -= b2a.y * sol[3]; sol[34] -= b2a.z * sol[3]; sol[35] -= b2a.w * sol[3]; sol[36] -= b2b.x * sol[3]; sol[37] -= b2b.y * sol[3]; sol[38] -= b2b.z * sol[3]; sol[39] -= b2b.w * sol[3]; sol[40] -= b2c.x * sol[3]; sol[41] -= b2c.y * sol[3]; sol[42] -= b2c.z * sol[3]; sol[43] -= b2c.w * sol[3]; sol[44] -= b2d.x * sol[3]; sol[45] -= b2d.y * sol[3]; sol[46] -= b2d.z * sol[3]; sol[47] -= b2d.w * sol[3];
  __builtin_amdgcn_sched_barrier(0);
  b2a = *(const float4*)(Lr + 272); b2b = *(const float4*)(Lr + 276); b2c = *(const float4*)(Lr + 280); b2d = *(const float4*)(Lr + 284);
  __builtin_amdgcn_sched_barrier(0);
  sol[48] -= b0a.x * sol[3]; sol[49] -= b0a.y * sol[3]; sol[50] -= b0a.z * sol[3]; sol[51] -= b0a.w * sol[3]; sol[52] -= b0b.x * sol[3]; sol[53] -= b0b.y * sol[3]; sol[54] -= b0b.z * sol[3]; sol[55] -= b0b.w * sol[3]; sol[56] -= b0c.x * sol[3]; sol[57] -= b0c.y * sol[3]; sol[58] -= b0c.z * sol[3]; sol[59] -= b0c.w * sol[3]; sol[60] -= b0d.x * sol[3]; sol[61] -= b0d.y * sol[3]; sol[62] -= b0d.z * sol[3]; sol[63] -= b0d.w * sol[3];
  __builtin_amdgcn_sched_barrier(0);
  b0a = *(const float4*)(Lr + 288); b0b = *(const float4*)(Lr + 292); b0c = *(const float4*)(Lr + 296); b0d = *(const float4*)(Lr + 300);
  __builtin_amdgcn_sched_barrier(0);
  sol[5] -= b1b.y * sol[4]; sol[6] -= b1b.z * sol[4]; sol[7] -= b1b.w * sol[4]; sol[8] -= b1c.x * sol[4]; sol[9] -= b1c.y * sol[4]; sol[10] -= b1c.z * sol[4]; sol[11] -= b1c.w * sol[4]; sol[12] -= b1d.x * sol[4]; sol[13] -= b1d.y * sol[4]; sol[14] -= b1d.z * sol[4]; sol[15] -= b1d.w * sol[4];
  __builtin_amdgcn_sched_barrier(0);
  b1a = *(const float4*)(Lr + 304); b1b = *(const float4*)(Lr + 308); b1c = *(const float4*)(Lr + 312); b1d = *(const float4*)(Lr + 316);
  __builtin_amdgcn_sched_barrier(0);
  sol[16] -= b2a.x * sol[4]; sol[17] -= b2a.y * sol[4]; sol[18] -= b2a.z * sol[4]; sol[19] -= b2a.w * sol[4]; sol[20] -= b2b.x * sol[4]; sol[21] -= b2b.y * sol[4]; sol[22] -= b2b.z * sol[4]; sol[23] -= b2b.w * sol[4]; sol[24] -= b2c.x * sol[4]; sol[25] -= b2c.y * sol[4]; sol[26] -= b2c.z * sol[4]; sol[27] -= b2c.w * sol[4]; sol[28] -= b2d.x * sol[4]; sol[29] -= b2d.y * sol[4]; sol[30] -= b2d.z * sol[4]; sol[31] -= b2d.w * sol[4];
  __builtin_amdgcn_sched_barrier(0);
  b2a = *(const float4*)(Lr + 320); b2b = *(const float4*)(Lr + 324); b2c = *(const float4*)(Lr + 328); b2d = *(const float4*)(Lr + 332);
  __builtin_amdgcn_sched_barrier(0);
  sol[32] -= b0a.x * sol[4]; sol[33] -= b0a.y * sol[4]; sol[34] -= b0a.z * sol[4]; sol[35] -= b0a.w * sol[4]; sol[36] -= b0b.x * sol[4]; sol[37] -= b0b.y * sol[4]; sol[38] -= b0b.z * sol[4]; sol[39] -= b0b.w * sol[4]; sol[40] -= b0c.x * sol[4]; sol[41] -= b0c.y * sol[4]; sol[42] -= b0c.z * sol[4]; sol[43] -= b0c.w * sol[4]; sol[44] -= b0d.x * sol[4]; sol[45] -= b0d.y * sol[4]; sol[46] -= b0d.z * sol[4]; sol[47] -= b0d.w * sol[4];
  __builtin_amdgcn_sched_barrier(0);
  b0a = *(const float4*)(Lr + 336); b0b = *(const float4*)(Lr + 340); b0c = *(const float4*)(Lr + 344); b0d = *(const float4*)(Lr + 348);
  __builtin_amdgcn_sched_barrier(0);
  sol[48] -= b1a.x * sol[4]; sol[49] -= b1a.y * sol[4]; sol[50] -= b1a.z * sol[4]; sol[51] -= b1a.w * sol[4]; sol[52] -= b1b.x * sol[4]; sol[53] -= b1b.y * sol[4]; sol[54] -= b1b.z * sol[4]; sol[55] -= b1b.w * sol[4]; sol[56] -= b1c.x * sol[4]; sol[57] -= b1c.y * sol[4]; sol[58] -= b1c.z * sol[4]; sol[59] -= b1c.w * sol[4]; sol[60] -= b1d.x * sol[4]; sol[61] -= b1d.y * sol[4]; sol[62] -= b1d.z * sol[4]; sol[63] -= b1d.w * sol[4];
  __builtin_amdgcn_sched_barrier(0);
  b1a = *(const float4*)(Lr + 352); b1b = *(const float4*)(Lr + 356); b1c = *(const float4*)(Lr + 360); b1d = *(const float4*)(Lr + 364);
  __builtin_amdgcn_sched_barrier(0);
  sol[6] -= b2b.z * sol[5]; sol[7] -= b2b.w * sol[5]; sol[8] -= b2c.x * sol[5]; sol[9] -= b2c.y * sol[5]; sol[10] -= b2c.z * sol[5]; sol[11] -= b2c.w * sol[5]; sol[12] -= b2d.x * sol[5]; sol[13] -= b2d.y * sol[5]; sol[14] -= b2d.z * sol[5]; sol[15] -= b2d.w * sol[5];
  __builtin_amdgcn_sched_barrier(0);
  b2a = *(const float4*)(Lr + 368); b2b = *(const float4*)(Lr + 372); b2c = *(const float4*)(Lr + 376); b2d = *(const float4*)(Lr + 380);
  __builtin_amdgcn_sched_barrier(0);
  sol[16] -= b0a.x * sol[5]; sol[17] -= b0a.y * sol[5]; sol[18] -= b0a.z * sol[5]; sol[19] -= b0a.w * sol[5]; sol[20] -= b0b.x * sol[5]; sol[21] -= b0b.y * sol[5]; sol[22] -= b0b.z * sol[5]; sol[23] -= b0b.w * sol[5]; sol[24] -= b0c.x * sol[5]; sol[25] -= b0c.y * sol[5]; sol[26] -= b0c.z * sol[5]; sol[27] -= b0c.w * sol[5]; sol[28] -= b0d.x * sol[5]; sol[29] -= b0d.y * sol[5]; sol[30] -= b0d.z * sol[5]; sol[31] -= b0d.w * sol[5];
  __builtin_amdgcn_sched_barrier(0);
  b0a = *(const float4*)(Lr + 384); b0b = *(const float4*)(Lr + 388); b0c = *(const float4*)(Lr + 392); b0d = *(const float4*)(Lr + 396);
  __builtin_amdgcn_sched_barrier(0);
  sol[32] -= b1a.x * sol[5]; sol[33] -= b1a.y * sol[5]; sol[34] -= b1a.z * sol[5]; sol[35] -= b1a.w * sol[5]; sol[36] -= b1b.x * sol[5]; sol[37] -= b1b.y * sol[5]; sol[38] -= b1b.z * sol[5]; sol[39] -= b1b.w * sol[5]; sol[40] -= b1c.x * sol[5]; sol[41] -= b1c.y * sol[5]; sol[42] -= b1c.z * sol[5]; sol[43] -= b1c.w * sol[5]; sol[44] -= b1d.x * sol[5]; sol[45] -= b1d.y * sol[5]; sol[46] -= b1d.z * sol[5]; sol[47] -= b1d.w * sol[5];
  __builtin_amdgcn_sched_barrier(0);
  b1a = *(const float4*)(Lr + 400); b1b = *(const float4*)(Lr + 404); b1c = *(const float4*)(Lr + 408); b1d = *(const float4*)(Lr + 412);
  __builtin_amdgcn_sched_barrier(0);
  sol[48] -= b2a.x * sol[5]; sol[49] -= b2a.y * sol[5]; sol[50] -= b2a.z * sol[5]; sol[51] -= b2a.w * sol[5]; sol[52] -= b2b.x * sol[5]; sol[53] -= b2b.y * sol[5]; sol[54] -= b2b.z * sol[5]; sol[55] -= b2b.w * sol[5]; sol[56] -= b2c.x * sol[5]; sol[57] -= b2c.y * sol[5]; sol[58] -= b2c.z * sol[5]; sol[59] -= b2c.w * sol[5]; sol[60] -= b2d.x * sol[5]; sol[61] -= b2d.y * sol[5]; sol[62] -= b2d.z * sol[5]; sol[63] -= b2d.w * sol[5];
  __builtin_amdgcn_sched_barrier(0);
  b2a = *(const float4*)(Lr + 416); b2b = *(const float4*)(Lr + 420); b2c = *(const float4*)(Lr + 424); b2d = *(const float4*)(Lr + 428);
  __builtin_amdgcn_sched_barrier(0);
  sol[7] -= b0b.w * sol[6]; sol[8] -= b0c.x * sol[6]; sol[9] -= b0c.y * sol[6]; sol[10] -= b0c.z * sol[6]; sol[11] -= b0c.w * sol[6]; sol[12] -= b0d.x * sol[6]; sol[13] -= b0d.y * sol[6]; sol[14] -= b0d.z * sol[6]; sol[15] -= b0d.w * sol[6];
  __builtin_amdgcn_sched_barrier(0);
  b0a = *(const float4*)(Lr + 432); b0b = *(const float4*)(Lr + 436); b0c = *(const float4*)(Lr + 440); b0d = *(const float4*)(Lr + 444);
  __builtin_amdgcn_sched_barrier(0);
  sol[16] -= b1a.x * sol[6]; sol[17] -= b1a.y * sol[6]; sol[18] -= b1a.z * sol[6]; sol[19] -= b1a.w * sol[6]; sol[20] -= b1b.x * sol[6]; sol[21] -= b1b.y * sol[6]; sol[22] -= b1b.z * sol[6]; sol[23] -= b1b.w * sol[6]; sol[24] -= b1c.x * sol[6]; sol[25] -= b1c.y * sol[6]; sol[26] -= b1c.z * sol[6]; sol[27] -= b1c.w * sol[6]; sol[28] -= b1d.x * sol[6]; sol[29] -= b1d.y * sol[6]; sol[30] -= b1d.z * sol[6]; sol[31] -= b1d.w * sol[6];
  __builtin_amdgcn_sched_barrier(0);
  b1a = *(const float4*)(Lr + 448); b1b = *(const float4*)(Lr + 452); b1c = *(const float4*)(Lr + 456); b1d = *(const float4*)(Lr + 460);
  __builtin_amdgcn_sched_barrier(0);
  sol[32] -= b2a.x * sol[6]; sol[33] -= b2a.y * sol[6]; sol[34] -= b2a.z * sol[6]; sol[35] -= b2a.w * sol[6]; sol[36] -= b2b.x * sol[6]; sol[37] -= b2b.y * sol[6]; sol[38] -= b2b.z * sol[6]; sol[39] -= b2b.w * sol[6]; sol[40] -= b2c.x * sol[6]; sol[41] -= b2c.y * sol[6]; sol[42] -= b2c.z * sol[6]; sol[43] -= b2c.w * sol[6]; sol[44] -= b2d.x * sol[6]; sol[45] -= b2d.y * sol[6]; sol[46] -= b2d.z * sol[6]; sol[47] -= b2d.w * sol[6];
  __builtin_amdgcn_sched_barrier(0);
  b2a = *(const float4*)(Lr + 464); b2b = *(const float4*)(Lr + 468); b2c = *(const float4*)(Lr + 472); b2d = *(const float4*)(Lr + 476);
  __builtin_amdgcn_sched_barrier(0);
  sol[48] -= b0a.x * sol[6]; sol[49] -= b0a.y * sol[6]; sol[50] -= b0a.z * sol[6]; sol[51] -= b0a.w * sol[6]; sol[52] -= b0b.x * sol[6]; sol[53] -= b0b.y * sol[6]; sol[54] -= b0b.z * sol[6]; sol[55] -= b0b.w * sol[6]; sol[56] -= b0c.x * sol[6]; sol[57] -= b0c.y * sol[6]; sol[58] -= b0c.z * sol[6]; sol[59] -= b0c.w * sol[6]; sol[60] -= b0d.x * sol[6]; sol[61] -= b0d.y * sol[6]; sol[62] -= b0d.z * sol[6]; sol[63] -= b0d.w * sol[6];
  __builtin_amdgcn_sched_barrier(0);
  b0a = *(const float4*)(Lr + 480); b0b = *(const float4*)(Lr + 484); b0c = *(const float4*)(Lr + 488); b0d = *(const float4*)(Lr + 492);
  __builtin_amdgcn_sched_barrier(0);
  sol[8] -= b1c.x * sol[7]; sol[9] -= b1c.y * sol[7]; sol[10] -= b1c.z * sol[7]; sol[11] -= b1c.w * sol[7]; sol[12] -= b1d.x * sol[7]; sol[13] -= b1d.y * sol[7]; sol[14] -= b1d.z * sol[7]; sol[15] -= b1d.w * sol[7];
  __builtin_amdgcn_sched_barrier(0);
  b1a = *(const float4*)(Lr + 496); b1b = *(const float4*)(Lr + 500); b1c = *(const float4*)(Lr + 504); b1d = *(const float4*)(Lr + 508);
  __builtin_amdgcn_sched_barrier(0);
  sol[16] -= b2a.x * sol[7]; sol[17] -= b2a.y * sol[7]; sol[18] -= b2a.z * sol[7]; sol[19] -= b2a.w * sol[7]; sol[20] -= b2b.x * sol[7]; sol[21] -= b2b.y * sol[7]; sol[22] -= b2b.z * sol[7]; sol[23] -= b2b.w * sol[7]; sol[24] -= b2c.x * sol[7]; sol[25] -= b2c.y * sol[7]; sol[26] -= b2c.z * sol[7]; sol[27] -= b2c.w * sol[7]; sol[28] -= b2d.x * sol[7]; sol[29] -= b2d.y * sol[7]; sol[30] -= b2d.z * sol[7]; sol[31] -= b2d.w * sol[7];
  __builtin_amdgcn_sched_barrier(0);
  b2a = *(const float4*)(Lr + 512); b2b = *(const float4*)(Lr + 516); b2c = *(const float4*)(Lr + 520); b2d = *(const float4*)(Lr + 524);
  __builtin_amdgcn_sched_barrier(0);
  sol[32] -= b0a.x * sol[7]; sol[33] -= b0a.y * sol[7]; sol[34] -= b0a.z * sol[7]; sol[35] -= b0a.w * sol[7]; sol[36] -= b0b.x * sol[7]; sol[37] -= b0b.y * sol[7]; sol[38] -= b0b.z * sol[7]; sol[39] -= b0b.w * sol[7]; sol[40] -= b0c.x * sol[7]; sol[41] -= b0c.y * sol[7]; sol[42] -= b0c.z * sol[7]; sol[43] -= b0c.w * sol[7]; sol[44] -= b0d.x * sol[7]; sol[45] -= b0d.y * sol[7]; sol[46] -= b0d.z * sol[7]; sol[47] -= b0d.w * sol[7];
  __builtin_amdgcn_sched_barrier(0);
  b0a = *(const float4*)(Lr + 528); b0b = *(const float4*)(Lr + 532); b0c = *(const float4*)(Lr + 536); b0d = *(const float4*)(Lr + 540);
  __builtin_amdgcn_sched_barrier(0);
  sol[48] -= b1a.x * sol[7]; sol[49] -= b1a.y * sol[7]; sol[50] -= b1a.z * sol[7]; sol[51] -= b1a.w * sol[7]; sol[52] -= b1b.x * sol[7]; sol[53] -= b1b.y * sol[7]; sol[54] -= b1b.z * sol[7]; sol[55] -= b1b.w * sol[7]; sol[56] -= b1c.x * sol[7]; sol[57] -= b1c.y * sol[7]; sol[58] -= b1c.z * sol[7]; sol[59] -= b1c.w * sol[7]; sol[60] -= b1d.x * sol[7]; sol[61] -= b1d.y * sol[7]; sol[62] -= b1d.z * sol[7]; sol[63] -= b1d.w * sol[7];
  __builtin_amdgcn_sched_barrier(0);
  b1a = *(const float4*)(Lr + 544); b1b = *(const float4*)(Lr + 548); b1c = *(const float4*)(Lr + 552); b1d = *(const float4*)(Lr + 556);
  __builtin_amdgcn_sched_barrier(0);
  sol[9] -= b2c.y * sol[8]; sol[10] -= b2c.z * sol[8]; sol[11] -= b2c.w * sol[8]; sol[12] -= b2d.x * sol[8]; sol[13] -= b2d.y * sol[8]; sol[14] -= b2d.z * sol[8]; sol[15] -= b2d.w * sol[8];
  __builtin_amdgcn_sched_barrier(0);
  b2a = *(const float4*)(Lr + 560); b2b = *(const float4*)(Lr + 564); b2c = *(const float4*)(Lr + 568); b2d = *(const float4*)(Lr + 572);
  __builtin_amdgcn_sched_barrier(0);
  sol[16] -= b0a.x * sol[8]; sol[17] -= b0a.y * sol[8]; sol[18] -= b0a.z * sol[8]; sol[19] -= b0a.w * sol[8]; sol[20] -= b0b.x * sol[8]; sol[21] -= b0b.y * sol[8]; sol[22] -= b0b.z * sol[8]; sol[23] -= b0b.w * sol[8]; sol[24] -= b0c.x * sol[8]; sol[25] -= b0c.y * sol[8]; sol[26] -= b0c.z * sol[8]; sol[27] -= b0c.w * sol[8]; sol[28] -= b0d.x * sol[8]; sol[29] -= b0d.y * sol[8]; sol[30] -= b0d.z * sol[8]; sol[31] -= b0d.w * sol[8];
  __builtin_amdgcn_sched_barrier(0);
  b0a = *(const float4*)(Lr + 576); b0b = *(const float4*)(Lr + 580); b0c = *(const float4*)(Lr + 584); b0d = *(const float4*)(Lr + 588);
  __builtin_amdgcn_sched_barrier(0);
  sol[32] -= b1a.x * sol[8]; sol[33] -= b1a.y * sol[8]; sol[34] -= b1a.z * sol[8]; sol[35] -= b1a.w * sol[8]; sol[36] -= b1b.x * sol[8]; sol[37] -= b1b.y * sol[8]; sol[38] -= b1b.z * sol[8]; sol[39] -= b1b.w * sol[8]; sol[40] -= b1c.x * sol[8]; sol[41] -= b1c.y * sol[8]; sol[42] -= b1c.z * sol[8]; sol[43] -= b1c.w * sol[8]; sol[44] -= b1d.x * sol[8]; sol[45] -= b1d.y * sol[8]; sol[46] -= b1d.z * sol[8]; sol[47] -= b1d.w * sol[8];
  __builtin_amdgcn_sched_barrier(0);
  b1a = *(const float4*)(Lr + 592); b1b = *(const float4*)(Lr + 596); b1c = *(const float4*)(Lr + 600); b1d = *(const float4*)(Lr + 604);
  __builtin_amdgcn_sched_barrier(0);
  sol[48] -= b2a.x * sol[8]; sol[49] -= b2a.y * sol[8]; sol[50] -= b2a.z * sol[8]; sol[51] -= b2a.w * sol[8]; sol[52] -= b2b.x * sol[8]; sol[53] -= b2b.y * sol[8]; sol[54] -= b2b.z * sol[8]; sol[55] -= b2b.w * sol[8]; sol[56] -= b2c.x * sol[8]; sol[57] -= b2c.y * sol[8]; sol[58] -= b2c.z * sol[8]; sol[59] -= b2c.w * sol[8]; sol[60] -= b2d.x * sol[8]; sol[61] -= b2d.y * sol[8]; sol[62] -= b2d.z * sol[8]; sol[63] -= b2d.w * sol[8];
  __builtin_amdgcn_sched_barrier(0);
  b2a = *(const float4*)(Lr + 608); b2b = *(const float4*)(Lr + 612); b2c = *(const float4*)(Lr + 616); b2d = *(const float4*)(Lr + 620);
  __builtin_amdgcn_sched_barrier(0);
  sol[10] -= b0c.z * sol[9]; sol[11] -= b0c.w * sol[9]; sol[12] -= b0d.x * sol[9]; sol[13] -= b0d.y * sol[9]; sol[14] -= b0d.z * sol[9]; sol[15] -= b0d.w * sol[9];
  __builtin_amdgcn_sched_barrier(0);
  b0a = *(const float4*)(Lr + 624); b0b = *(const float4*)(Lr + 628); b0c = *(const float4*)(Lr + 632); b0d = *(const float4*)(Lr + 636);
  __builtin_amdgcn_sched_barrier(0);
  sol[16] -= b1a.x * sol[9]; sol[17] -= b1a.y * sol[9]; sol[18] -= b1a.z * sol[9]; sol[19] -= b1a.w * sol[9]; sol[20] -= b1b.x * sol[9]; sol[21] -= b1b.y * sol[9]; sol[22] -= b1b.z * sol[9]; sol[23] -= b1b.w * sol[9]; sol[24] -= b1c.x * sol[9]; sol[25] -= b1c.y * sol[9]; sol[26] -= b1c.z * sol[9]; sol[27] -= b1c.w * sol[9]; sol[28] -= b1d.x * sol[9]; sol[29] -= b1d.y * sol[9]; sol[30] -= b1d.z * sol[9]; sol[31] -= b1d.w * sol[9];
  __builtin_amdgcn_sched_barrier(0);
  b1a = *(const float4*)(Lr + 640); b1b = *(const float4*)(Lr + 644); b1c = *(const float4*)(Lr + 648); b1d = *(const float4*)(Lr + 652);
  __builtin_amdgcn_sched_barrier(0);
  sol[32] -= b2a.x * sol[9]; sol[33] -= b2a.y * sol[9]; sol[34] -= b2a.z * sol[9]; sol[35] -= b2a.w * sol[9]; sol[36] -= b2b.x * sol[9]; sol[37] -= b2b.y * sol[9]; sol[38] -= b2b.z * sol[9]; sol[39] -= b2b.w * sol[9]; sol[40] -= b2c.x * sol[9]; sol[41] -= b2c.y * sol[9]; sol[42] -= b2c.z * sol[9]; sol[43] -= b2c.w * sol[9]; sol[44] -= b2d.x * sol[9]; sol[45] -= b2d.y * sol[9]; sol[46] -= b2d.z * sol[9]; sol[47] -= b2d.w * sol[9];
  __builtin_amdgcn_sched_barrier(0);
  b2a = *(const float4*)(Lr + 656); b2b = *(const float4*)(Lr + 660); b2c = *(const float4*)(Lr + 664); b2d = *(const float4*)(Lr + 668);
  __builtin_amdgcn_sched_barrier(0);
  sol[48] -= b0a.x * sol[9]; sol[49] -= b0a.y * sol[9]; sol[50] -= b0a.z * sol[9]; sol[51] -= b0a.w * sol[9]; sol[52] -= b0b.x * sol[9]; sol[53] -= b0b.y * sol[9]; sol[54] -= b0b.z * sol[9]; sol[55] -= b0b.w * sol[9]; sol[56] -= b0c.x * sol[9]; sol[57] -= b0c.y * sol[9]; sol[58] -= b0c.z * sol[9]; sol[59] -= b0c.w * sol[9]; sol[60] -= b0d.x * sol[9]; sol[61] -= b0d.y * sol[9]; sol[62] -= b0d.z * sol[9]; sol[63] -= b0d.w * sol[9];
  __builtin_amdgcn_sched_barrier(0);
  b0a = *(const float4*)(Lr + 672); b0b = *(const float4*)(Lr + 676); b0c = *(const float4*)(Lr + 680); b0d = *(const float4*)(Lr + 684);
  __builtin_amdgcn_sched_barrier(0);
  sol[11] -= b1c.w * sol[10]; sol[12] -= b1d.x * sol[10]; sol[13] -= b1d.y * sol[10]; sol[14] -= b1d.z * sol[10]; sol[15] -= b1d.w * sol[10];
  __builtin_amdgcn_sched_barrier(0);
  b1a = *(const float4*)(Lr + 688); b1b = *(const float4*)(Lr + 692); b1c = *(const float4*)(Lr + 696); b1d = *(const float4*)(Lr + 700);
  __builtin_amdgcn_sched_barrier(0);
  sol[16] -= b2a.x * sol[10]; sol[17] -= b2a.y * sol[10]; sol[18] -= b2a.z * sol[10]; sol[19] -= b2a.w * sol[10]; sol[20] -= b2b.x * sol[10]; sol[21] -= b2b.y * sol[10]; sol[22] -= b2b.z * sol[10]; sol[23] -= b2b.w * sol[10]; sol[24] -= b2c.x * sol[10]; sol[25] -= b2c.y * sol[10]; sol[26] -= b2c.z * sol[10]; sol[27] -= b2c.w * sol[10]; sol[28] -= b2d.x * sol[10]; sol[29] -= b2d.y * sol[10]; sol[30] -= b2d.z * sol[10]; sol[31] -= b2d.w * sol[10];
  __builtin_amdgcn_sched_barrier(0);
  b2a = *(const float4*)(Lr + 704); b2b = *(const float4*)(Lr + 708); b2c = *(const float4*)(Lr + 712); b2d = *(const float4*)(Lr + 716);
  __builtin_amdgcn_sched_barrier(0);
  sol[32] -= b0a.x * sol[10]; sol[33] -= b0a.y * sol[10]; sol[34] -= b0a.z * sol[10]; sol[35] -= b0a.w * sol[10]; sol[36] -= b0b.x * sol[10]; sol[37] -= b0b.y * sol[10]; sol[38] -= b0b.z * sol[10]; sol[39] -= b0b.w * sol[10]; sol[40] -= b0c.x * sol[10]; sol[41] -= b0c.y * sol[10]; sol[42] -= b0c.z * sol[10]; sol[43] -= b0c.w * sol[10]; sol[44] -= b0d.x * sol[10]; sol[45] -= b0d.y * sol[10]; sol[46] -= b0d.z * sol[10]; sol[47] -= b0d.w * sol[10];
  __builtin_amdgcn_sched_barrier(0);
  b0a = *(const float4*)(Lr + 720); b0b = *(const float4*)(Lr + 724); b0c = *(const float4*)(Lr + 728); b0d = *(const float4*)(Lr + 732);
  __builtin_amdgcn_sched_barrier(0);
  sol[48] -= b1a.x * sol[10]; sol[49] -= b1a.y * sol[10]; sol[50] -= b1a.z * sol[10]; sol[51] -= b1a.w * sol[10]; sol[52] -= b1b.x * sol[10]; sol[53] -= b1b.y * sol[10]; sol[54] -= b1b.z * sol[10]; sol[55] -= b1b.w * sol[10]; sol[56] -= b1c.x * sol[10]; sol[57] -= b1c.y * sol[10]; sol[58] -= b1c.z * sol[10]; sol[59] -= b1c.w * sol[10]; sol[60] -= b1d.x * sol[10]; sol[61] -= b1d.y * sol[10]; sol[62] -= b1d.z * sol[10]; sol[63] -= b1d.w * sol[10];
  __builtin_amdgcn_sched_barrier(0);
  b1a = *(const float4*)(Lr + 736); b1b = *(const float4*)(Lr + 740); b1c = *(const float4*)(Lr + 744); b1d = *(const float4*)(Lr + 748);
  __builtin_amdgcn_sched_barrier(0);
  sol[12] -= b2d.x * sol[11]; sol[13] -= b2d.y * sol[11]; sol[14] -= b2d.z * sol[11]; sol[15] -= b2d.w * sol[11];
  __builtin_amdgcn_sched_barrier(0);
  b2a = *(const float4*)(Lr + 752); b2b = *(const float4*)(Lr + 756); b2c = *(const float4*)(Lr + 760); b2d = *(const float4*)(Lr + 764);
  __builtin_amdgcn_sched_barrier(0);
  sol[16] -= b0a.x * sol[11]; sol[17] -= b0a.y * sol[11]; sol[18] -= b0a.z * sol[11]; sol[19] -= b0a.w * sol[11]; sol[20] -= b0b.x * sol[11]; sol[21] -= b0b.y * sol[11]; sol[22] -= b0b.z * sol[11]; sol[23] -= b0b.w * sol[11]; sol[24] -= b0c.x * sol[11]; sol[25] -= b0c.y * sol[11]; sol[26] -= b0c.z * sol[11]; sol[27] -= b0c.w * sol[11]; sol[28] -= b0d.x * sol[11]; sol[29] -= b0d.y * sol[11]; sol[30] -= b0d.z * sol[11]; sol[31] -= b0d.w * sol[11];
  __builtin_amdgcn_sched_barrier(0);
  b0a = *(const float4*)(Lr + 768); b0b = *(const float4*)(Lr + 772); b0c = *(const float4*)(Lr + 776); b0d = *(const float4*)(Lr + 780);
  __builtin_amdgcn_sched_barrier(0);
  sol[32] -= b1a.x * sol[11]; sol[33] -= b1a.y * sol[11]; sol[34] -= b1a.z * sol[11]; sol[35] -= b1a.w * sol[11]; sol[36] -= b1b.x * sol[11]; sol[37] -= b1b.y * sol[11]; sol[38] -= b1b.z * sol[11]; sol[39] -= b1b.w * sol[11]; sol[40] -= b1c.x * sol[11]; sol[41] -= b1c.y * sol[11]; sol[42] -= b1c.z * sol[11]; sol[43] -= b1c.w * sol[11]; sol[44] -= b1d.x * sol[11]; sol[45] -= b1d.y * sol[11]; sol[46] -= b1d.z * sol[11]; sol[47] -= b1d.w * sol[11];
  __builtin_amdgcn_sched_barrier(0);
  b1a = *(const float4*)(Lr + 784); b1b = *(const float4*)(Lr + 788); b1c = *(const float4*)(Lr + 792); b1d = *(const float4*)(Lr + 796);
  __builtin_amdgcn_sched_barrier(0);
  sol[48] -= b2a.x * sol[11]; sol[49] -= b2a.y * sol[11]; sol[50] -= b2a.z * sol[11]; sol[51] -= b2a.w * sol[11]; sol[52] -= b2b.x * sol[11]; sol[53] -= b2b.y * sol[11]; sol[54] -= b2b.z * sol[11]; sol[55] -= b2b.w * sol[11]; sol[56] -= b2c.x * sol[11]; sol[57] -= b2c.y * sol[11]; sol[58] -= b2c.z * sol[11]; sol[59] -= b2c.w * sol[11]; sol[60] -= b2d.x * sol[11]; sol[61] -= b2d.y * sol[11]; sol[62] -= b2d.z * sol[11]; sol[63] -= b2d.w * sol[11];
  __builtin_amdgcn_sched_barrier(0);
  b2a = *(const float4*)(Lr + 800); b2b = *(const float4*)(Lr + 804); b2c = *(const float4*)(Lr + 808); b2d = *(const float4*)(Lr + 812);
  __builtin_amdgcn_sched_barrier(0);
  sol[13] -= b0d.y * sol[12]; sol[14] -= b0d.z * sol[12]; sol[15] -= b0d.w * sol[12];
  __builtin_amdgcn_sched_barrier(0);
  b0a = *(const float4*)(Lr + 816); b0b = *(const float4*)(Lr + 820); b0c = *(const float4*)(Lr + 824); b0d = *(const float4*)(Lr + 828);
  __builtin_amdgcn_sched_barrier(0);
  sol[16] -= b1a.x * sol[12]; sol[17] -= b1a.y * sol[12]; sol[18] -= b1a.z * sol[12]; sol[19] -= b1a.w * sol[12]; sol[20] -= b1b.x * sol[12]; sol[21] -= b1b.y * sol[12]; sol[22] -= b1b.z * sol[12]; sol[23] -= b1b.w * sol[12]; sol[24] -= b1c.x * sol[12]; sol[25] -= b1c.y * sol[12]; sol[26] -= b1c.z * sol[12]; sol[27] -= b1c.w * sol[12]; sol[28] -= b1d.x * sol[12]; sol[29] -= b1d.y * sol[12]; sol[30] -= b1d.z * sol[12]; sol[31] -= b1d.w * sol[12];
  __builtin_amdgcn_sched_barrier(0);
  b1a = *(const float4*)(Lr + 832); b1b = *(const float4*)(Lr + 836); b1c = *(const float4*)(Lr + 840); b1d = *(const float4*)(Lr + 844);
  __builtin_amdgcn_sched_barrier(0);
  sol[32] -= b2a.x * sol[12]; sol[33] -= b2a.y * sol[12]; sol[34] -= b2a.z * sol[12]; sol[35] -= b2a.w * sol[12]; sol[36] -= b2b.x * sol[12]; sol[37] -= b2b.y * sol[12]; sol[38] -= b2b.z * sol[12]; sol[39] -= b2b.w * sol[12]; sol[40] -= b2c.x * sol[12]; sol[41] -= b2c.y * sol[12]; sol[42] -= b2c.z * sol[12]; sol[43] -= b2c.w * sol[12]; sol[44] -= b2d.x * sol[12]; sol[45] -= b2d.y * sol[12]; sol[46] -= b2d.z * sol[12]; sol[47] -= b2d.w * sol[12];
  __builtin_amdgcn_sched_barrier(0);
  b2a = *(const float4*)(Lr + 848); b2b = *(const float4*)(Lr + 852); b2c = *(const float4*)(Lr + 856); b2d = *(const float4*)(Lr + 860);
  __builtin_amdgcn_sched_barrier(0);
  sol[48] -= b0a.x * sol[12]; sol[49] -= b0a.y * sol[12]; sol[50] -= b0a.z * sol[12]; sol[51] -= b0a.w * sol[12]; sol[52] -= b0b.x * sol[12]; sol[53] -= b0b.y * sol[12]; sol[54] -= b0b.z * sol[12]; sol[55] -= b0b.w * sol[12]; sol[56] -= b0c.x * sol[12]; sol[57] -= b0c.y * sol[12]; sol[58] -= b0c.z * sol[12]; sol[59] -= b0c.w * sol[12]; sol[60] -= b0d.x * sol[12]; sol[61] -= b0d.y * sol[12]; sol[62] -= b0d.z * sol[12]; sol[63] -= b0d.w * sol[12];
  __builtin_amdgcn_sched_barrier(0);
  b0a = *(const float4*)(Lr + 864); b0b = *(const float4*)(Lr + 868); b0c = *(const float4*)(Lr + 872); b0d = *(const float4*)(Lr + 876);
  __builtin_amdgcn_sched_barrier(0);
  sol[14] -= b1d.z * sol[13]; sol[15] -= b1d.w * sol[13];
  __builtin_amdgcn_sched_barrier(0);
  b1a = *(const float4*)(Lr + 880); b1b = *(const float4*)(Lr + 884); b1c = *(const float4*)(Lr + 888); b1d = *(const float4*)(Lr + 892);
  __builtin_amdgcn_sched_barrier(0);
  sol[16] -= b2a.x * sol[13]; sol[17] -= b2a.y * sol[13]; sol[18] -= b2a.z * sol[13]; sol[19] -= b2a.w * sol[13]; sol[20] -= b2b.x * sol[13]; sol[21] -= b2b.y * sol[13]; sol[22] -= b2b.z * sol[13]; sol[23] -= b2b.w * sol[13]; sol[24] -= b2c.x * sol[13]; sol[25] -= b2c.y * sol[13]; sol[26] -= b2c.z * sol[13]; sol[27] -= b2c.w * sol[13]; sol[28] -= b2d.x * sol[13]; sol[29] -= b2d.y * sol[13]; sol[30] -= b2d.z * sol[13]; sol[31] -= b2d.w * sol[13];
  __builtin_amdgcn_sched_barrier(0);
  b2a = *(const float4*)(Lr + 896); b2b = *(const float4*)(Lr + 900); b2c = *(const float4*)(Lr + 904); b2d = *(const float4*)(Lr + 908);
  __builtin_amdgcn_sched_barrier(0);
  sol[32] -= b0a.x * sol[13]; sol[33] -= b0a.y * sol[13]; sol[34] -= b0a.z * sol[13]; sol[35] -= b0a.w * sol[13]; sol[36] -= b0b.x * sol[13]; sol[37] -= b0b.y * sol[13]; sol[38] -= b0b.z * sol[13]; sol[39] -= b0b.w * sol[13]; sol[40] -= b0c.x * sol[13]; sol[41] -= b0c.y * sol[13]; sol[42] -= b0c.z * sol[13]; sol[43] -= b0c.w * sol[13]; sol[44] -= b0d.x * sol[13]; sol[45] -= b0d.y * sol[13]; sol[46] -= b0d.z * sol[13]; sol[47] -= b0d.w * sol[13];
  __builtin_amdgcn_sched_barrier(0);
  b0a = *(const float4*)(Lr + 912); b0b = *(const float4*)(Lr + 916); b0c = *(const float4*)(Lr + 920); b0d = *(const float4*)(Lr + 924);
  __builtin_amdgcn_sched_barrier(0);
  sol[48] -= b1a.x * sol[13]; sol[49] -= b1a.y * sol[13]; sol[50] -= b1a.z * sol[13]; sol[51] -= b1a.w * sol[13]; sol[52] -= b1b.x * sol[13]; sol[53] -= b1b.y * sol[13]; sol[54] -= b1b.z * sol[13]; sol[55] -= b1b.w * sol[13]; sol[56] -= b1c.x * sol[13]; sol[57] -= b1c.y * sol[13]; sol[58] -= b1c.z * sol[13]; sol[59] -= b1c.w * sol[13]; sol[60] -= b1d.x * sol[13]; sol[61] -= b1d.y * sol[13]; sol[62] -= b1d.z * sol[13]; sol[63] -= b1d.w * sol[13];
  __builtin_amdgcn_sched_barrier(0);
  b1a = *(const float4*)(Lr + 928); b1b = *(const float4*)(Lr + 932); b1c = *(const float4*)(Lr + 936); b1d = *(const float4*)(Lr + 940);
  __builtin_amdgcn_sched_barrier(0);
  sol[15] -= b2d.w * sol[14];
  __builtin_amdgcn_sched_barrier(0);
  b2a = *(const float4*)(Lr + 944); b2b = *(const float4*)(Lr + 948); b2c = *(const float4*)(Lr + 952); b2d = *(const float4*)(Lr + 956);
  __builtin_amdgcn_sched_barrier(0);
  sol[16] -= b0a.x * sol[14]; sol[17] -= b0a.y * sol[14]; sol[18] -= b0a.z * sol[14]; sol[19] -= b0a.w * sol[14]; sol[20] -= b0b.x * sol[14]; sol[21] -= b0b.y * sol[14]; sol[22] -= b0b.z * sol[14]; sol[23] -= b0b.w * sol[14]; sol[24] -= b0c.x * sol[14]; sol[25] -= b0c.y * sol[14]; sol[26] -= b0c.z * sol[14]; sol[27] -= b0c.w * sol[14]; sol[28] -= b0d.x * sol[14]; sol[29] -= b0d.y * sol[14]; sol[30] -= b0d.z * sol[14]; sol[31] -= b0d.w * sol[14];
  __builtin_amdgcn_sched_barrier(0);
  b0a = *(const float4*)(Lr + 976); b0b = *(const float4*)(Lr + 980); b0c = *(const float4*)(Lr + 984); b0d = *(const float4*)(Lr + 988);
  __builtin_amdgcn_sched_barrier(0);
  sol[32] -= b1a.x * sol[14]; sol[33] -= b1a.y * sol[14]; sol[34] -= b1a.z * sol[14]; sol[35] -= b1a.w * sol[14]; sol[36] -= b1b.x * sol[14]; sol[37] -= b1b.y * sol[14]; sol[38] -= b1b.z * sol[14]; sol[39] -= b1b.w * sol[14]; sol[40] -= b1c.x * sol[14]; sol[41] -= b1c.y * sol[14]; sol[42] -= b1c.z * sol[14]; sol[43] -= b1c.w * sol[14]; sol[44] -= b1d.x * sol[14]; sol[45] -= b1d.y * sol[14]; sol[46] -= b1d.z * sol[14]; sol[47] -= b1d.w * sol[14];
  __builtin_amdgcn_sched_barrier(0);
  b1a = *(const float4*)(Lr + 992); b1b = *(const float4*)(Lr + 996); b1c = *(const float4*)(Lr + 1000); b1d = *(const float4*)(Lr + 1004);
  __builtin_amdgcn_sched_barrier(0);
  sol[48] -= b2a.x * sol[14]; sol[49] -= b2a.y * sol[14]; sol[50] -= b2a.z * sol[14]; sol[51] -= b2a.w * sol[14]; sol[52] -= b2b.x * sol[14]; sol[53] -= b2b.y * sol[14]; sol[54] -= b2b.z * sol[14]; sol[55] -= b2b.w * sol[14]; sol[56] -= b2c.x * sol[14]; sol[57] -= b2c.y * sol[14]; sol[58] -= b2c.z * sol[14]; sol[59] -= b2c.w * sol[14]; sol[60] -= b2d.x * sol[14]; sol[61] -= b2d.y * sol[14]; sol[62] -= b2d.z * sol[14]; sol[63] -= b2d.w * sol[14];
  __builtin_amdgcn_sched_barrier(0);
  b2a = *(const float4*)(Lr + 1008); b2b = *(const float4*)(Lr + 1012); b2c = *(const float4*)(Lr + 1016); b2d = *(const float4*)(Lr + 1020);
  __builtin_amdgcn_sched_barrier(0);
  sol[16] -= b0a.x * sol[15]; sol[17] -= b0a.y * sol[15]; sol[18] -= b0a.z * sol[15]; sol[19] -= b0a.w * sol[15]; sol[20] -= b0b.x * sol[15]; sol[21] -= b0b.y * sol[15]; sol[22] -= b0b.z * sol[15]; sol[23] -= b0b.w * sol[15]; sol[24] -= b0c.x * sol[15]; sol[25] -= b0c.y * sol[15]; sol[26] -= b0c.z * sol[15]; sol[27] -= b0c.w * sol[15]; sol[28] -= b0d.x * sol[15]; sol[29] -= b0d.y * sol[15]; sol[30] -= b0d.z * sol[15]; sol[31] -= b0d.w * sol[15];
  __builtin_amdgcn_sched_barrier(0);
  b0a = *(const float4*)(Lr + 1040); b0b = *(const float4*)(Lr + 1044); b0c = *(const float4*)(Lr + 1048); b0d = *(const float4*)(Lr + 1052);
  __builtin_amdgcn_sched_barrier(0);
  sol[32] -= b1a.x * sol[15]; sol[33] -= b1a.y * sol[15]; sol[34] -= b1a.z * sol[15]; sol[35] -= b1a.w * sol[15]; sol[36] -= b1b.x * sol[15]; sol[37] -= b1b.y * sol[15]; sol[38] -= b1b.z * sol[15]; sol[39] -= b1b.w * sol[15]; sol[40] -= b1c.x * sol[15]; sol[41] -= b1c.y * sol[15]; sol[42] -= b1c.z * sol[15]; sol[43] -= b1c.w * sol[15]; sol[44] -= b1d.x * sol[15]; sol[45] -= b1d.y * sol[15]; sol[46] -= b1d.z * sol[15]; sol[47] -= b1d.w * sol[15];
  __builtin_amdgcn_sched_barrier(0);
  b1a = *(const float4*)(Lr + 1056); b1b = *(const float4*)(Lr + 1060); b1c = *(const float4*)(Lr + 1064); b1d = *(const float4*)(Lr + 1068);
  __builtin_amdgcn_sched_barrier(0);
  sol[48] -= b2a.x * sol[15]; sol[49] -= b2a.y * sol[15]; sol[50] -= b2a.z * sol[15]; sol[51] -= b2a.w * sol[15]; sol[52] -= b2b.x * sol[15]; sol[53] -= b2b.y * sol[15]; sol[54] -= b2b.z * sol[15]; sol[55] -= b2b.w * sol[15]; sol[56] -= b2c.x * sol[15]; sol[57] -= b2c.y * sol[15]; sol[58] -= b2c.z * sol[15]; sol[59] -= b2c.w * sol[15]; sol[60] -= b2d.x * sol[15]; sol[61] -= b2d.y * sol[15]; sol[62] -= b2d.z * sol[15]; sol[63] -= b2d.w * sol[15];
  __builtin_amdgcn_sched_barrier(0);
  b2a = *(const float4*)(Lr + 1072); b2b = *(const float4*)(Lr + 1076); b2c = *(const float4*)(Lr + 1080); b2d = *(const float4*)(Lr + 1084);
  __builtin_amdgcn_sched_barrier(0);
  sol[17] -= b0a.y * sol[16]; sol[18] -= b0a.z * sol[16]; sol[19] -= b0a.w * sol[16]; sol[20] -= b0b.x * sol[16]; sol[21] -= b0b.y * sol[16]; sol[22] -= b0b.z * sol[16]; sol[23] -= b0b.w * sol[16]; sol[24] -= b0c.x * sol[16]; sol[25] -= b0c.y * sol[16]; sol[26] -= b0c.z * sol[16]; sol[27] -= b0c.w * sol[16]; sol[28] -= b0d.x * sol[16]; sol[29] -= b0d.y * sol[16]; sol[30] -= b0d.z * sol[16]; sol[31] -= b0d.w * sol[16];
  __builtin_amdgcn_sched_barrier(0);
  b0a = *(const float4*)(Lr + 1104); b0b = *(const float4*)(Lr + 1108); b0c = *(const float4*)(Lr + 1112); b0d = *(const float4*)(Lr + 1116);
  __builtin_amdgcn_sched_barrier(0);
  sol[32] -= b1a.x * sol[16]; sol[33] -= b1a.y * sol[16]; sol[34] -= b1a.z * sol[16]; sol[35] -= b1a.w * sol[16]; sol[36] -= b1b.x * sol[16]; sol[37] -= b1b.y * sol[16]; sol[38] -= b1b.z * sol[16]; sol[39] -= b1b.w * sol[16]; sol[40] -= b1c.x * sol[16]; sol[41] -= b1c.y * sol[16]; sol[42] -= b1c.z * sol[16]; sol[43] -= b1c.w * sol[16]; sol[44] -= b1d.x * sol[16]; sol[45] -= b1d.y * sol[16]; sol[46] -= b1d.z * sol[16]; sol[47] -= b1d.w * sol[16];
  __builtin_amdgcn_sched_barrier(0);
  b1a = *(const float4*)(Lr + 1120); b1b = *(const float4*)(Lr + 1124); b1c = *(const float4*)(Lr + 1128); b1d = *(const float4*)(Lr + 1132);
  __builtin_amdgcn_sched_barrier(0);
  sol[48] -= b2a.x * sol[16]; sol[49] -= b2a.y * sol[16]; sol[50] -= b2a.z * sol[16]; sol[51] -= b2a.w * sol[16]; sol[52] -= b2b.x * sol[16]; sol[53] -= b2b.y * sol[16]; sol[54] -= b2b.z * sol[16]; sol[55] -= b2b.w * sol[16]; sol[56] -= b2c.x * sol[16]; sol[57] -= b2c.y * sol[16]; sol[58] -= b2c.z * sol[16]; sol[59] -= b2c.w * sol[16]; sol[60] -= b2d.x * sol[16]; sol[61] -= b2d.y * sol[16]; sol[62] -= b2d.z * sol[16]; sol[63] -= b2d.w * sol[16];
  __builtin_amdgcn_sched_barrier(0);
  b2a = *(const float4*)(Lr + 1136); b2b = *(const float4*)(Lr + 1140); b2c = *(const float4*)(Lr + 1144); b2d = *(const float4*)(Lr + 1148);
  __builtin_amdgcn_sched_barrier(0);
  sol[18] -= b0a.z * sol[17]; sol[19] -= b0a.w * sol[17]; sol[20] -= b0b.x * sol[17]; sol[21] -= b0b.y * sol[17]; sol[22] -= b0b.z * sol[17]; sol[23] -= b0b.w * sol[17]; sol[24] -= b0c.x * sol[17]; sol[25] -= b0c.y * sol[17]; sol[26] -= b0c.z * sol[17]; sol[27] -= b0c.w * sol[17]; sol[28] -= b0d.x * sol[17]; sol[29] -= b0d.y * sol[17]; sol[30] -= b0d.z * sol[17]; sol[31] -= b0d.w * sol[17];
  __builtin_amdgcn_sched_barrier(0);
  b0a = *(const float4*)(Lr + 1168); b0b = *(const float4*)(Lr + 1172); b0c = *(const float4*)(Lr + 1176); b0d = *(const float4*)(Lr + 1180);
  __builtin_amdgcn_sched_barrier(0);
  sol[32] -= b1a.x * sol[17]; sol[33] -= b1a.y * sol[17]; sol[34] -= b1a.z * sol[17]; sol[35] -= b1a.w * sol[17]; sol[36] -= b1b.x * sol[17]; sol[37] -= b1b.y * sol[17]; sol[38] -= b1b.z * sol[17]; sol[39] -= b1b.w * sol[17]; sol[40] -= b1c.x * sol[17]; sol[41] -= b1c.y * sol[17]; sol[42] -= b1c.z * sol[17]; sol[43] -= b1c.w * sol[17]; sol[44] -= b1d.x * sol[17]; sol[45] -= b1d.y * sol[17]; sol[46] -= b1d.z * sol[17]; sol[47] -= b1d.w * sol[17];
  __builtin_amdgcn_sched_barrier(0);
  b1a = *(const float4*)(Lr + 1184); b1b = *(const float4*)(Lr + 1188); b1c = *(const float4*)(Lr + 1192); b1d = *(const float4*)(Lr + 1196);
  __builtin_amdgcn_sched_barrier(0);
  sol[48] -= b2a.x * sol[17]; sol[49] -= b2a.y * sol[17]; sol[50] -= b2a.z * sol[17]; sol[51] -= b2a.w * sol[17]; sol[52] -= b2b.x * sol[17]; sol[53] -= b2b.y * sol[17]; sol[54] -= b2b.z * sol[17]; sol[55] -= b2b.w * sol[17]; sol[56] -= b2c.x * sol[17]; sol[57] -= b2c.y * sol[17]; sol[58] -= b2c.z * sol[17]; sol[59] -= b2c.w * sol[17]; sol[60] -= b2d.x * sol[17]; sol[61] -= b2d.y * sol[17]; sol[62] -= b2d.z * sol[17]; sol[63] -= b2d.w * sol[17];
  __builtin_amdgcn_sched_barrier(0);
  b2a = *(const float4*)(Lr + 1200); b2b = *(const float4*)(Lr + 1204); b2c = *(const float4*)(Lr + 1208); b2d = *(const float4*)(Lr + 1212);
  __builtin_amdgcn_sched_barrier(0);
  sol[19] -= b0a.w * sol[18]; sol[20] -= b0b.x * sol[18]; sol[21] -= b0b.y * sol[18]; sol[22] -= b0b.z * sol[18]; sol[23] -= b0b.w * sol[18]; sol[24] -= b0c.x * sol[18]; sol[25] -= b0c.y * sol[18]; sol[26] -= b0c.z * sol[18]; sol[27] -= b0c.w * sol[18]; sol[28] -= b0d.x * sol[18]; sol[29] -= b0d.y * sol[18]; sol[30] -= b0d.z * sol[18]; sol[31] -= b0d.w * sol[18];
  __builtin_amdgcn_sched_barrier(0);
  b0a = *(const float4*)(Lr + 1232); b0b = *(const float4*)(Lr + 1236); b0c = *(const float4*)(Lr + 1240); b0d = *(const float4*)(Lr + 1244);
  __builtin_amdgcn_sched_barrier(0);
  sol[32] -= b1a.x * sol[18]; sol[33] -= b1a.y * sol[18]; sol[34] -= b1a.z * sol[18]; sol[35] -= b1a.w * sol[18]; sol[36] -= b1b.x * sol[18]; sol[37] -= b1b.y * sol[18]; sol[38] -= b1b.z * sol[18]; sol[39] -= b1b.w * sol[18]; sol[40] -= b1c.x * sol[18]; sol[41] -= b1c.y * sol[18]; sol[42] -= b1c.z * sol[18]; sol[43] -= b1c.w * sol[18]; sol[44] -= b1d.x * sol[18]; sol[45] -= b1d.y * sol[18]; sol[46] -= b1d.z * sol[18]; sol[47] -= b1d.w * sol[18];
  __builtin_amdgcn_sched_barrier(0);
  b1a = *(const float4*)(Lr + 1248); b1b = *(const float4*)(Lr + 1252); b1c = *(const float4*)(Lr + 1256); b1d = *(const float4*)(Lr + 1260);
  __builtin_amdgcn_sched_barrier(0);
  sol[48] -= b2a.x * sol[18]; sol[49] -= b2a.y * sol[18]; sol[50] -= b2a.z * sol[18]; sol[51] -= b2a.w * sol[18]; sol[52] -= b2b.x * sol[18]; sol[53] -= b2b.y * sol[18]; sol[54] -= b2b.z * sol[18]; sol[55] -= b2b.w * sol[18]; sol[56] -= b2c.x * sol[18]; sol[57] -= b2c.y * sol[18]; sol[58] -= b2c.z * sol[18]; sol[59] -= b2c.w * sol[18]; sol[60] -= b2d.x * sol[18]; sol[61] -= b2d.y * sol[18]; sol[62] -= b2d.z * sol[18]; sol[63] -= b2d.w * sol[18];
  __builtin_amdgcn_sched_barrier(0);
  b2a = *(const float4*)(Lr + 1264); b2b = *(const float4*)(Lr + 1268); b2c = *(const float4*)(Lr + 1272); b2d = *(const float4*)(Lr + 1276);
  __builtin_amdgcn_sched_barrier(0);
  sol[20] -= b0b.x * sol[19]; sol[21] -= b0b.y * sol[19]; sol[22] -= b0b.z * sol[19]; sol[23] -= b0b.w * sol[19]; sol[24] -= b0c.x * sol[19]; sol[25] -= b0c.y * sol[19]; sol[26] -= b0c.z * sol[19]; sol[27] -= b0c.w * sol[19]; sol[28] -= b0d.x * sol[19]; sol[29] -= b0d.y * sol[19]; sol[30] -= b0d.z * sol[19]; sol[31] -= b0d.w * sol[19];
  __builtin_amdgcn_sched_barrier(0);
  b0a = *(const float4*)(Lr + 1296); b0b = *(const float4*)(Lr + 1300); b0c = *(const float4*)(Lr + 1304); b0d = *(const float4*)(Lr + 1308);
  __builtin_amdgcn_sched_barrier(0);
  sol[32] -= b1a.x * sol[19]; sol[33] -= b1a.y * sol[19]; sol[34] -= b1a.z * sol[19]; sol[35] -= b1a.w * sol[19]; sol[36] -= b1b.x * sol[19]; sol[37] -= b1b.y * sol[19]; sol[38] -= b1b.z * sol[19]; sol[39] -= b1b.w * sol[19]; sol[40] -= b1c.x * sol[19]; sol[41] -= b1c.y * sol[19]; sol[42] -= b1c.z * sol[19]; sol[43] -= b1c.w * sol[19]; sol[44] -= b1d.x * sol[19]; sol[45] -= b1d.y * sol[19]; sol[46] -= b1d.z * sol[19]; sol[47] -= b1d.w * sol[19];
  __builtin_amdgcn_sched_barrier(0);
  b1a = *(const float4*)(Lr + 1312); b1b = *(const float4*)(Lr + 1316); b1c = *(const float4*)(Lr + 1320); b1d = *(const float4*)(Lr + 1324);
  __builtin_amdgcn_sched_barrier(0);
  sol[48] -= b2a.x * sol[19]; sol[49] -= b2a.y * sol[19]; sol[50] -= b2a.z * sol[19]; sol[51] -= b2a.w * sol[19]; sol[52] -= b2b.x * sol[19]; sol[53] -= b2b.y * sol[19]; sol[54] -= b2b.z * sol[19]; sol[55] -= b2b.w * sol[19]; sol[56] -= b2c.x * sol[19]; sol[57] -= b2c.y * sol[19]; sol[58] -= b2c.z * sol[19]; sol[59] -= b2c.w * sol[19]; sol[60] -= b2d.x * sol[19]; sol[61] -= b2d.y * sol[19]; sol[62] -= b2d.z * sol[19]; sol[63] -= b2d.w * sol[19];
  __builtin_amdgcn_sched_barrier(0);
  b2a = *(const float4*)(Lr + 1328); b2b = *(const float4*)(Lr + 1332); b2c = *(const float4*)(Lr + 1336); b2d = *(const float4*)(Lr + 1340);
  __builtin_amdgcn_sched_barrier(0);
  sol[21] -= b0b.y * sol[20]; sol[22] -= b0b.z * sol[20]; sol[23] -= b0b.w * sol[20]; sol[24] -= b0c.x * sol[20]; sol[25] -= b0c.y * sol[20]; sol[26] -= b0c.z * sol[20]; sol[27] -= b0c.w * sol[20]; sol[28] -= b0d.x * sol[20]; sol[29] -= b0d.y * sol[20]; sol[30] -= b0d.z * sol[20]; sol[31] -= b0d.w * sol[20];
  __builtin_amdgcn_sched_barrier(0);
  b0a = *(const float4*)(Lr + 1360); b0b = *(const float4*)(Lr + 1364); b0c = *(const float4*)(Lr + 1368); b0d = *(const float4*)(Lr + 1372);
  __builtin_amdgcn_sched_barrier(0);
  sol[32] -= b1a.x * sol[20]; sol[33] -= b1a.y * sol[20]; sol[34] -= b1a.z * sol[20]; sol[35] -= b1a.w * sol[20]; sol[36] -= b1b.x * sol[20]; sol[37] -= b1b.y * sol[20]; sol[38] -= b1b.z * sol[20]; sol[39] -= b1b.w * sol[20]; sol[40] -= b1c.x * sol[20]; sol[41] -= b1c.y * sol[20]; sol[42] -= b1c.z * sol[20]; sol[43] -= b1c.w * sol[20]; sol[44] -= b1d.x * sol[20]; sol[45] -= b1d.y * sol[20]; sol[46] -= b1d.z * sol[20]; sol[47] -= b1d.w * sol[20];
  __builtin_amdgcn_sched_barrier(0);
  b1a = *(const float4*)(Lr + 1376); b1b = *(const float4*)(Lr + 1380); b1c = *(const float4*)(Lr + 1384); b1d = *(const float4*)(Lr + 1388);
  __builtin_amdgcn_sched_barrier(0);
  sol[48] -= b2a.x * sol[20]; sol[49] -= b2a.y * sol[20]; sol[50] -= b2a.z * sol[20]; sol[51] -= b2a.w * sol[20]; sol[52] -= b2b.x * sol[20]; sol[53] -= b2b.y * sol[20]; sol[54] -= b2b.z * sol[20]; sol[55] -= b2b.w * sol[20]; sol[56] -= b2c.x * sol[20]; sol[57] -= b2c.y * sol[20]; sol[58] -= b2c.z * sol[20]; sol[59] -= b2c.w * sol[20]; sol[60] -= b2d.x * sol[20]; sol[61] -= b2d.y * sol[20]; sol[62] -= b2d.z * sol[20]; sol[63] -= b2d.w * sol[20];
  __builtin_amdgcn_sched_barrier(0);
  b2a = *(const float4*)(Lr + 1392); b2b = *(const float4*)(Lr + 1396); b2c = *(const float4*)(Lr + 1400); b2d = *(const float4*)(Lr + 1404);
  __builtin_amdgcn_sched_barrier(0);
  sol[22] -= b0b.z * sol[21]; sol[23] -= b0b.w * sol[21]; sol[24] -= b0c.x * sol[21]; sol[25] -= b0c.y * sol[21]; sol[26] -= b0c.z * sol[21]; sol[27] -= b0c.w * sol[21]; sol[28] -= b0d.x * sol[21]; sol[29] -= b0d.y * sol[21]; sol[30] -= b0d.z * sol[21]; sol[31] -= b0d.w * sol[21];
  __builtin_amdgcn_sched_barrier(0);
  b0a = *(const float4*)(Lr + 1424); b0b = *(const float4*)(Lr + 1428); b0c = *(const float4*)(Lr + 1432); b0d = *(const float4*)(Lr + 1436);
  __builtin_amdgcn_sched_barrier(0);
  sol[32] -= b1a.x * sol[21]; sol[33] -= b1a.y * sol[21]; sol[34] -= b1a.z * sol[21]; sol[35] -= b1a.w * sol[21]; sol[36] -= b1b.x * sol[21]; sol[37] -= b1b.y * sol[21]; sol[38] -= b1b.z * sol[21]; sol[39] -= b1b.w * sol[21]; sol[40] -= b1c.x * sol[21]; sol[41] -= b1c.y * sol[21]; sol[42] -= b1c.z * sol[21]; sol[43] -= b1c.w * sol[21]; sol[44] -= b1d.x * sol[21]; sol[45] -= b1d.y * sol[21]; sol[46] -= b1d.z * sol[21]; sol[47] -= b1d.w * sol[21];
  __builtin_amdgcn_sched_barrier(0);
  b1a = *(const float4*)(Lr + 1440); b1b = *(const float4*)(Lr + 1444); b1c = *(const float4*)(Lr + 1448); b1d = *(const float4*)(Lr + 1452);
  __builtin_amdgcn_sched_barrier(0);
  sol[48] -= b2a.x * sol[21]; sol[49] -= b2a.y * sol[21]; sol[50] -= b2a.z * sol[21]; sol[51] -= b2a.w * sol[21]; sol[52] -= b2b.x * sol[21]; sol[53] -= b2b.y * sol[21]; sol[54] -= b2b.z * sol[21]; sol[55] -= b2b.w * sol[21]; sol[56] -= b2c.x * sol[21]; sol[57] -= b2c.y * sol[21]; sol[58] -= b2c.z * sol[21]; sol[59] -= b2c.w * sol[21]; sol[60] -= b2d.x * sol[21]; sol[61] -= b2d.y * sol[21]; sol[62] -= b2d.z * sol[21]; sol[63] -= b2d.w * sol[21];
  __builtin_amdgcn_sched_barrier(0);
  b2a = *(const float4*)(Lr + 1456); b2b = *(const float4*)(Lr + 1460); b2c = *(const float4*)(Lr + 1464); b2d = *(const float4*)(Lr + 1468);
  __builtin_amdgcn_sched_barrier(0);
  sol[23] -= b0b.w * sol[22]; sol[24] -= b0c.x * sol[22]; sol[25] -= b0c.y * sol[22]; sol[26] -= b0c.z * sol[22]; sol[27] -= b0c.w * sol[22]; sol[28] -= b0d.x * sol[22]; sol[29] -= b0d.y * sol[22]; sol[30] -= b0d.z * sol[22]; sol[31] -= b0d.w * sol[22];
  __builtin_amdgcn_sched_barrier(0);
  b0a = *(const float4*)(Lr + 1488); b0b = *(const float4*)(Lr + 1492); b0c = *(const float4*)(Lr + 1496); b0d = *(const float4*)(Lr + 1500);
  __builtin_amdgcn_sched_barrier(0);
  sol[32] -= b1a.x * sol[22]; sol[33] -= b1a.y * sol[22]; sol[34] -= b1a.z * sol[22]; sol[35] -= b1a.w * sol[22]; sol[36] -= b1b.x * sol[22]; sol[37] -= b1b.y * sol[22]; sol[38] -= b1b.z * sol[22]; sol[39] -= b1b.w * sol[22]; sol[40] -= b1c.x * sol[22]; sol[41] -= b1c.y * sol[22]; sol[42] -= b1c.z * sol[22]; sol[43] -= b1c.w * sol[22]; sol[44] -= b1d.x * sol[22]; sol[45] -= b1d.y * sol[22]; sol[46] -= b1d.z * sol[22]; sol[47] -= b1d.w * sol[22];
  __builtin_amdgcn_sched_barrier(0);
  b1a = *(const float4*)(Lr + 1504); b1b = *(const float4*)(Lr + 1508); b1c = *(const float4*)(Lr + 1512); b1d = *(const float4*)(Lr + 1516);
  __builtin_amdgcn_sched_barrier(0);
  sol[48] -= b2a.x * sol[22]; sol[49] -= b2a.y * sol[22]; sol[50] -= b2a.z * sol[22]; sol[51] -= b2a.w * sol[22]; sol[52] -= b2b.x * sol[22]; sol[53] -= b2b.y * sol[22]; sol[54] -= b2b.z * sol[22]; sol[55] -= b2b.w * sol[22]; sol[56] -= b2c.x * sol[22]; sol[57] -= b2c.y * sol[22]; sol[58] -= b2c.z * sol[22]; sol[59] -= b2c.w * sol[22]; sol[60] -= b2d.x * sol[22]; sol[61] -= b2d.y * sol[22]; sol[62] -= b2d.z * sol[22]; sol[63] -= b2d.w * sol[22];
  __builtin_amdgcn_sched_barrier(0);
  b2a = *(const float4*)(Lr + 1520); b2b = *(const float4*)(Lr + 1524); b2c = *(const float4*)(Lr + 1528); b2d = *(const float4*)(Lr + 1532);
  __builtin_amdgcn_sched_barrier(0);
  sol[24] -= b0c.x * sol[23]; sol[25] -= b0c.y * sol[23]; sol[26] -= b0c.z * sol[23]; sol[27] -= b0c.w * sol[23]; sol[28] -= b0d.x * sol[23]; sol[29] -= b0d.y * sol[23]; sol[30] -= b0d.z * sol[23]; sol[31] -= b0d.w * sol[23];
  __builtin_amdgcn_sched_barrier(0);
  b0a = *(const float4*)(Lr + 1552); b0b = *(const float4*)(Lr + 1556); b0c = *(const float4*)(Lr + 1560); b0d = *(const float4*)(Lr + 1564);
  __builtin_amdgcn_sched_barrier(0);
  sol[32] -= b1a.x * sol[23]; sol[33] -= b1a.y * sol[23]; sol[34] -= b1a.z * sol[23]; sol[35] -= b1a.w * sol[23]; sol[36] -= b1b.x * sol[23]; sol[37] -= b1b.y * sol[23]; sol[38] -= b1b.z * sol[23]; sol[39] -= b1b.w * sol[23]; sol[40] -= b1c.x * sol[23]; sol[41] -= b1c.y * sol[23]; sol[42] -= b1c.z * sol[23]; sol[43] -= b1c.w * sol[23]; sol[44] -= b1d.x * sol[23]; sol[45] -= b1d.y * sol[23]; sol[46] -= b1d.z * sol[23]; sol[47] -= b1d.w * sol[23];
  __builtin_amdgcn_sched_barrier(0);
  b1a = *(const float4*)(Lr + 1568); b1b = *(const float4*)(Lr + 1572); b1c = *(const float4*)(Lr + 1576); b1d = *(const float4*)(Lr + 1580);
  __builtin_amdgcn_sched_barrier(0);
  sol[48] -= b2a.x * sol[23]; sol[49] -= b2a.y * sol[23]; sol[50] -= b2a.z * sol[23]; sol[51] -= b2a.w * sol[23]; sol[52] -= b2b.x * sol[23]; sol[53] -= b2b.y * sol[23]; sol[54] -= b2b.z * sol[23]; sol[55] -= b2b.w * sol[23]; sol[56] -= b2c.x * sol[23]; sol[57] -= b2c.y * sol[23]; sol[58] -= b2c.z * sol[23]; sol[59] -= b2c.w * sol[23]; sol[60] -= b2d.x * sol[23]; sol[61] -= b2d.y * sol[23]; sol[62] -= b2d.z * sol[23]; sol[63] -= b2d.w * sol[23];
  __builtin_amdgcn_sched_barrier(0);
  b2a = *(const float4*)(Lr + 1584); b2b = *(const float4*)(Lr + 1588); b2c = *(const float4*)(Lr + 1592); b2d = *(const float4*)(Lr + 1596);
  __builtin_amdgcn_sched_barrier(0);
  sol[25] -= b0c.y * sol[24]; sol[26] -= b0c.z * sol[24]; sol[27] -= b0c.w * sol[24]; sol[28] -= b0d.x * sol[24]; sol[29] -= b0d.y * sol[24]; sol[30] -= b0d.z * sol[24]; sol[31] -= b0d.w * sol[24];
  __builtin_amdgcn_sched_barrier(0);
  b0a = *(const float4*)(Lr + 1616); b0b = *(const float4*)(Lr + 1620); b0c = *(const float4*)(Lr + 1624); b0d = *(const float4*)(Lr + 1628);
  __builtin_amdgcn_sched_barrier(0);
  sol[32] -= b1a.x * sol[24]; sol[33] -= b1a.y * sol[24]; sol[34] -= b1a.z * sol[24]; sol[35] -= b1a.w * sol[24]; sol[36] -= b1b.x * sol[24]; sol[37] -= b1b.y * sol[24]; sol[38] -= b1b.z * sol[24]; sol[39] -= b1b.w * sol[24]; sol[40] -= b1c.x * sol[24]; sol[41] -= b1c.y * sol[24]; sol[42] -= b1c.z * sol[24]; sol[43] -= b1c.w * sol[24]; sol[44] -= b1d.x * sol[24]; sol[45] -= b1d.y * sol[24]; sol[46] -= b1d.z * sol[24]; sol[47] -= b1d.w * sol[24];
  __builtin_amdgcn_sched_barrier(0);
  b1a = *(const float4*)(Lr + 1632); b1b = *(const float4*)(Lr + 1636); b1c = *(const float4*)(Lr + 1640); b1d = *(const float4*)(Lr + 1644);
  __builtin_amdgcn_sched_barrier(0);
  sol[48] -= b2a.x * sol[24]; sol[49] -= b2a.y * sol[24]; sol[50] -= b2a.z * sol[24]; sol[51] -= b2a.w * sol[24]; sol[52] -= b2b.x * sol[24]; sol[53] -= b2b.y * sol[24]; sol[54] -= b2b.z * sol[24]; sol[55] -= b2b.w * sol[24]; sol[56] -= b2c.x * sol[24]; sol[57] -= b2c.y * sol[24]; sol[58] -= b2c.z * sol[24]; sol[59] -= b2c.w * sol[24]; sol[60] -= b2d.x * sol[24]; sol[61] -= b2d.y * sol[24]; sol[62] -= b2d.z * sol[24]; sol[63] -= b2d.w * sol[24];
  __builtin_amdgcn_sched_barrier(0);
  b2a = *(const float4*)(Lr + 1648); b2b = *(const float4*)(Lr + 1652); b2c = *(const float4*)(Lr + 1656); b2d = *(const float4*)(Lr + 1660);
  __builtin_amdgcn_sched_barrier(0);
  sol[26] -= b0c.z * sol[25]; sol[27] -= b0c.w * sol[25]; sol[28] -= b0d.x * sol[25]; sol[29] -= b0d.y * sol[25]; sol[30] -= b0d.z * sol[25]; sol[31] -= b0d.w * sol[25];
  __builtin_amdgcn_sched_barrier(0);
  b0a = *(const float4*)(Lr + 1680); b0b = *(const float4*)(Lr + 1684); b0c = *(const float4*)(Lr + 1688); b0d = *(const float4*)(Lr + 1692);
  __builtin_amdgcn_sched_barrier(0);
  sol[32] -= b1a.x * sol[25]; sol[33] -= b1a.y * sol[25]; sol[34] -= b1a.z * sol[25]; sol[35] -= b1a.w * sol[25]; sol[36] -= b1b.x * sol[25]; sol[37] -= b1b.y * sol[25]; sol[38] -= b1b.z * sol[25]; sol[39] -= b1b.w * sol[25]; sol[40] -= b1c.x * sol[25]; sol[41] -= b1c.y * sol[25]; sol[42] -= b1c.z * sol[25]; sol[43] -= b1c.w * sol[25]; sol[44] -= b1d.x * sol[25]; sol[45] -= b1d.y * sol[25]; sol[46] -= b1d.z * sol[25]; sol[47] -= b1d.w * sol[25];
  __builtin_amdgcn_sched_barrier(0);
  b1a = *(const float4*)(Lr + 1696); b1b = *(const float4*)(Lr + 1700); b1c = *(const float4*)(Lr + 1704); b1d = *(const float4*)(Lr + 1708);
  __builtin_amdgcn_sched_barrier(0);
  sol[48] -= b2a.x * sol[25]; sol[49] -= b2a.y * sol[25]; sol[50] -= b2a.z * sol[25]; sol[51] -= b2a.w * sol[25]; sol[52] -= b2b.x * sol[25]; sol[53] -= b2b.y * sol[25]; sol[54] -= b2b.z * sol[25]; sol[55] -= b2b.w * sol[25]; sol[56] -= b2c.x * sol[25]; sol[57] -= b2c.y * sol[25]; sol[58] -= b2c.z * sol[25]; sol[59] -= b2c.w * sol[25]; sol[60] -= b2d.x * sol[25]; sol[61] -= b2d.y * sol[25]; sol[62] -= b2d.z * sol[25]; sol[63] -= b2d.w * sol[25];
  __builtin_amdgcn_sched_barrier(0);
  b2a = *(const float4*)(Lr + 1712); b2b = *(const float4*)(Lr + 1716); b2c = *(const float4*)(Lr + 1720); b2d = *(const float4*)(Lr + 1724);
  __builtin_amdgcn_sched_barrier(0);
  sol[27] -= b0c.w * sol[26]; sol[28] -= b0d.x * sol[26]; sol[29] -= b0d.y * sol[26]; sol[30] -= b0d.z * sol[26]; sol[31] -= b0d.w * sol[26];
  __builtin_amdgcn_sched_barrier(0);
  b0a = *(const float4*)(Lr + 1744); b0b = *(const float4*)(Lr + 1748); b0c = *(const float4*)(Lr + 1752); b0d = *(const float4*)(Lr + 1756);
  __builtin_amdgcn_sched_barrier(0);
  sol[32] -= b1a.x * sol[26]; sol[33] -= b1a.y * sol[26]; sol[34] -= b1a.z * sol[26]; sol[35] -= b1a.w * sol[26]; sol[36] -= b1b.x * sol[26]; sol[37] -= b1b.y * sol[26]; sol[38] -= b1b.z * sol[26]; sol[39] -= b1b.w * sol[26]; sol[40] -= b1c.x * sol[26]; sol[41] -= b1c.y * sol[26]; sol[42] -= b1c.z * sol[26]; sol[43] -= b1c.w * sol[26]; sol[44] -= b1d.x * sol[26]; sol[45] -= b1d.y * sol[26]; sol[46] -= b1d.z * sol[26]; sol[47] -= b1d.w * sol[26];
  __builtin_amdgcn_sched_barrier(0);
  b1a = *(const float4*)(Lr + 1760); b1b = *(const float4*)(Lr + 1764); b1c = *(const float4*)(Lr + 1768); b1d = *(const float4*)(Lr + 1772);
  __builtin_amdgcn_sched_barrier(0);
  sol[48] -= b2a.x * sol[26]; sol[49] -= b2a.y * sol[26]; sol[50] -= b2a.z * sol[26]; sol[51] -= b2a.w * sol[26]; sol[52] -= b2b.x * sol[26]; sol[53] -= b2b.y * sol[26]; sol[54] -= b2b.z * sol[26]; sol[55] -= b2b.w * sol[26]; sol[56] -= b2c.x * sol[26]; sol[57] -= b2c.y * sol[26]; sol[58] -= b2c.z * sol[26]; sol[59] -= b2c.w * sol[26]; sol[60] -= b2d.x * sol[26]; sol[61] -= b2d.y * sol[26]; sol[62] -= b2d.z * sol[26]; sol[63] -= b2d.w * sol[26];
  __builtin_amdgcn_sched_barrier(0);
  b2a = *(const float4*)(Lr + 1776); b2b = *(const float4*)(Lr + 1780); b2c = *(const float4*)(Lr + 1784); b2d = *(const float4*)(Lr + 1788);
  __builtin_amdgcn_sched_barrier(0);
  sol[28] -= b0d.x * sol[27]; sol[29] -= b0d.y * sol[27]; sol[30] -= b0d.z * sol[27]; sol[31] -= b0d.w * sol[27];
  __builtin_amdgcn_sched_barrier(0);
  b0a = *(const float4*)(Lr + 1808); b0b = *(const float4*)(Lr + 1812); b0c = *(const float4*)(Lr + 1816); b0d = *(const float4*)(Lr + 1820);
  __builtin_amdgcn_sched_barrier(0);
  sol[32] -= b1a.x * sol[27]; sol[33] -= b1a.y * sol[27]; sol[34] -= b1a.z * sol[27]; sol[35] -= b1a.w * sol[27]; sol[36] -= b1b.x * sol[27]; sol[37] -= b1b.y * sol[27]; sol[38] -= b1b.z * sol[27]; sol[39] -= b1b.w * sol[27]; sol[40] -= b1c.x * sol[27]; sol[41] -= b1c.y * sol[27]; sol[42] -= b1c.z * sol[27]; sol[43] -= b1c.w * sol[27]; sol[44] -= b1d.x * sol[27]; sol[45] -= b1d.y * sol[27]; sol[46] -= b1d.z * sol[27]; sol[47] -= b1d.w * sol[27];
  __builtin_amdgcn_sched_barrier(0);
  b1a = *(const float4*)(Lr + 1824); b1b = *(const float4*)(Lr + 1828); b1c = *(const float4*)(Lr + 1832); b1d = *(const float4*)(Lr + 1836);
  __builtin_amdgcn_sched_barrier(0);
  sol[48] -= b2a.x * sol[27]; sol[49] -= b2a.y * sol[27]; sol[50] -= b2a.z * sol[27]; sol[51] -= b2a.w * sol[27]; sol[52] -= b2b.x * sol[27]; sol[53] -= b2b.y * sol[27]; sol[54] -= b2b.z * sol[27]; sol[55] -= b2b.w * sol[27]; sol[56] -= b2c.x * sol[27]; sol[57] -= b2c.y * sol[27]; sol[58] -= b2c.z * sol[27]; sol[59] -= b2c.w * sol[27]; sol[60] -= b2d.x * sol[27]; sol[61] -= b2d.y * sol[27]; sol[62] -= b2d.z * sol[27]; sol[63] -= b2d.w * sol[27];
  __builtin_amdgcn_sched_barrier(0);
  b2a = *(const float4*)(Lr + 1840); b2b = *(const float4*)(Lr + 1844); b2c = *(const float4*)(Lr + 1848); b2d = *(const float4*)(Lr + 1852);
  __builtin_amdgcn_sched_barrier(0);
  sol[29] -= b0d.y * sol[28]; sol[30] -= b0d.z * sol[28]; sol[31] -= b0d.w * sol[28];
  __builtin_amdgcn_sched_barrier(0);
  b0a = *(const float4*)(Lr + 1872); b0b = *(const float4*)(Lr + 1876); b0c = *(const float4*)(Lr + 1880); b0d = *(const float4*)(Lr + 1884);
  __builtin_amdgcn_sched_barrier(0);
  sol[32] -= b1a.x * sol[28]; sol[33] -= b1a.y * sol[28]; sol[34] -= b1a.z * sol[28]; sol[35] -= b1a.w * sol[28]; sol[36] -= b1b.x * sol[28]; sol[37] -= b1b.y * sol[28]; sol[38] -= b1b.z * sol[28]; sol[39] -= b1b.w * sol[28]; sol[40] -= b1c.x * sol[28]; sol[41] -= b1c.y * sol[28]; sol[42] -= b1c.z * sol[28]; sol[43] -= b1c.w * sol[28]; sol[44] -= b1d.x * sol[28]; sol[45] -= b1d.y * sol[28]; sol[46] -= b1d.z * sol[28]; sol[47] -= b1d.w * sol[28];
  __builtin_amdgcn_sched_barrier(0);
  b1a = *(const float4*)(Lr + 1888); b1b = *(const float4*)(Lr + 1892); b1c = *(const float4*)(Lr + 1896); b1d = *(const float4*)(Lr + 1900);
  __builtin_amdgcn_sched_barrier(0);
  sol[48] -= b2a.x * sol[28]; sol[49] -= b2a.y * sol[28]; sol[50] -= b2a.z * sol[28]; sol[51] -= b2a.w * sol[28]; sol[52] -= b2b.x * sol[28]; sol[53] -= b2b.y * sol[28]; sol[54] -= b2b.z * sol[28]; sol[55] -= b2b.w * sol[28]; sol[56] -= b2c.x * sol[28]; sol[57] -= b2c.y * sol[28]; sol[58] -= b2c.z * sol[28]; sol[59] -= b2c.w * sol[28]; sol[60] -= b2d.x * sol[28]; sol[61] -= b2d.y * sol[28]; sol[62] -= b2d.z * sol[28]; sol[63] -= b2d.w * sol[28];
  __builtin_amdgcn_sched_barrier(0);
  b2a = *(const float4*)(Lr + 1904); b2b = *(const float4*)(Lr + 1908); b2c = *(const float4*)(Lr + 1912); b2d = *(const float4*)(Lr + 1916);
  __builtin_amdgcn_sched_barrier(0);
  sol[30] -= b0d.z * sol[29]; sol[31] -= b0d.w * sol[29];
  __builtin_amdgcn_sched_barrier(0);
  b0a = *(const float4*)(Lr + 1936); b0b = *(const float4*)(Lr + 1940); b0c = *(const float4*)(Lr + 1944); b0d = *(const float4*)(Lr + 1948);
  __builtin_amdgcn_sched_barrier(0);
  sol[32] -= b1a.x * sol[29]; sol[33] -= b1a.y * sol[29]; sol[34] -= b1a.z * sol[29]; sol[35] -= b1a.w * sol[29]; sol[36] -= b1b.x * sol[29]; sol[37] -= b1b.y * sol[29]; sol[38] -= b1b.z * sol[29]; sol[39] -= b1b.w * sol[29]; sol[40] -= b1c.x * sol[29]; sol[41] -= b1c.y * sol[29]; sol[42] -= b1c.z * sol[29]; sol[43] -= b1c.w * sol[29]; sol[44] -= b1d.x * sol[29]; sol[45] -= b1d.y * sol[29]; sol[46] -= b1d.z * sol[29]; sol[47] -= b1d.w * sol[29];
  __builtin_amdgcn_sched_barrier(0);
  b1a = *(const float4*)(Lr + 1952); b1b = *(const float4*)(Lr + 1956); b1c = *(const float4*)(Lr + 1960); b1d = *(const float4*)(Lr + 1964);
  __builtin_amdgcn_sched_barrier(0);
  sol[48] -= b2a.x * sol[29]; sol[49] -= b2a.y * sol[29]; sol[50] -= b2a.z * sol[29]; sol[51] -= b2a.w * sol[29]; sol[52] -= b2b.x * sol[29]; sol[53] -= b2b.y * sol[29]; sol[54] -= b2b.z * sol[29]; sol[55] -= b2b.w * sol[29]; sol[56] -= b2c.x * sol[29]; sol[57] -= b2c.y * sol[29]; sol[58] -= b2c.z * sol[29]; sol[59] -= b2c.w * sol[29]; sol[60] -= b2d.x * sol[29]; sol[61] -= b2d.y * sol[29]; sol[62] -= b2d.z * sol[29]; sol[63] -= b2d.w * sol[29];
  __builtin_amdgcn_sched_barrier(0);
  b2a = *(const float4*)(Lr + 1968); b2b = *(const float4*)(Lr + 1972); b2c = *(const float4*)(Lr + 1976); b2d = *(const float4*)(Lr + 1980);
  __builtin_amdgcn_sched_barrier(0);
  sol[31] -= b0d.w * sol[30];
  __builtin_amdgcn_sched_barrier(0);
  b0a = *(const float4*)(Lr + 2016); b0b = *(const float4*)(Lr + 2020); b0c = *(const float4*)(Lr + 2024); b0d = *(const float4*)(Lr + 2028);
  __builtin_amdgcn_sched_barrier(0);
  sol[32] -= b1a.x * sol[30]; sol[33] -= b1a.y * sol[30]; sol[34] -= b1a.z * sol[30]; sol[35] -= b1a.w * sol[30]; sol[36] -= b1b.x * sol[30]; sol[37] -= b1b.y * sol[30]; sol[38] -= b1b.z * sol[30]; sol[39] -= b1b.w * sol[30]; sol[40] -= b1c.x * sol[30]; sol[41] -= b1c.y * sol[30]; sol[42] -= b1c.z * sol[30]; sol[43] -= b1c.w * sol[30]; sol[44] -= b1d.x * sol[30]; sol[45] -= b1d.y * sol[30]; sol[46] -= b1d.z * sol[30]; sol[47] -= b1d.w * sol[30];
  __builtin_amdgcn_sched_barrier(0);
  b1a = *(const float4*)(Lr + 2032); b1b = *(const float4*)(Lr + 2036); b1c = *(const float4*)(Lr + 2040); b1d = *(const float4*)(Lr + 2044);
  __builtin_amdgcn_sched_barrier(0);
  sol[48] -= b2a.x * sol[30]; sol[49] -= b2a.y * sol[30]; sol[50] -= b2a.z * sol[30]; sol[51] -= b2a.w * sol[30]; sol[52] -= b2b.x * sol[30]; sol[53] -= b2b.y * sol[30]; sol[54] -= b2b.z * sol[30]; sol[55] -= b2b.w * sol[30]; sol[56] -= b2c.x * sol[30]; sol[57] -= b2c.y * sol[30]; sol[58] -= b2c.z * sol[30]; sol[59] -= b2c.w * sol[30]; sol[60] -= b2d.x * sol[30]; sol[61] -= b2d.y * sol[30]; sol[62] -= b2d.z * sol[30]; sol[63] -= b2d.w * sol[30];
  __builtin_amdgcn_sched_barrier(0);
  b2a = *(const float4*)(Lr + 2080); b2b = *(const float4*)(Lr + 2084); b2c = *(const float4*)(Lr + 2088); b2d = *(const float4*)(Lr + 2092);
  __builtin_amdgcn_sched_barrier(0);
  sol[32] -= b0a.x * sol[31]; sol[33] -= b0a.y * sol[31]; sol[34] -= b0a.z * sol[31]; sol[35] -= b0a.w * sol[31]; sol[36] -= b0b.x * sol[31]; sol[37] -= b0b.y * sol[31]; sol[38] -= b0b.z * sol[31]; sol[39] -= b0b.w * sol[31]; sol[40] -= b0c.x * sol[31]; sol[41] -= b0c.y * sol[31]; sol[42] -= b0c.z * sol[31]; sol[43] -= b0c.w * sol[31]; sol[44] -= b0d.x * sol[31]; sol[45] -= b0d.y * sol[31]; sol[46] -= b0d.z * sol[31]; sol[47] -= b0d.w * sol[31];
  __builtin_amdgcn_sched_barrier(0);
  b0a = *(const float4*)(Lr + 2096); b0b = *(const float4*)(Lr + 2100); b0c = *(const float4*)(Lr + 2104); b0d = *(const float4*)(Lr + 2108);
  __builtin_amdgcn_sched_barrier(0);
  sol[48] -= b1a.x * sol[31]; sol[49] -= b1a.y * sol[31]; sol[50] -= b1a.z * sol[31]; sol[51] -= b1a.w * sol[31]; sol[52] -= b1b.x * sol[31]; sol[53] -= b1b.y * sol[31]; sol[54] -= b1b.z * sol[31]; sol[55] -= b1b.w * sol[31]; sol[56] -= b1c.x * sol[31]; sol[57] -= b1c.y * sol[31]; sol[58] -= b1c.z * sol[31]; sol[59] -= b1c.w * sol[31]; sol[60] -= b1d.x * sol[31]; sol[61] -= b1d.y * sol[31]; sol[62] -= b1d.z * sol[31]; sol[63] -= b1d.w * sol[31];
  __builtin_amdgcn_sched_barrier(0);
  b1a = *(const float4*)(Lr + 2144); b1b = *(const float4*)(Lr + 2148); b1c = *(const float4*)(Lr + 2152); b1d = *(const float4*)(Lr + 2156);
  __builtin_amdgcn_sched_barrier(0);
  sol[33] -= b2a.y * sol[32]; sol[34] -= b2a.z * sol[32]; sol[35] -= b2a.w * sol[32]; sol[36] -= b2b.x * sol[32]; sol[37] -= b2b.y * sol[32]; sol[38] -= b2b.z * sol[32]; sol[39] -= b2b.w * sol[32]; sol[40] -= b2c.x * sol[32]; sol[41] -= b2c.y * sol[32]; sol[42] -= b2c.z * sol[32]; sol[43] -= b2c.w * sol[32]; sol[44] -= b2d.x * sol[32]; sol[45] -= b2d.y * sol[32]; sol[46] -= b2d.z * sol[32]; sol[47] -= b2d.w * sol[32];
  __builtin_amdgcn_sched_barrier(0);
  b2a = *(const float4*)(Lr + 2160); b2b = *(const float4*)(Lr + 2164); b2c = *(const float4*)(Lr + 2168); b2d = *(const float4*)(Lr + 2172);
  __builtin_amdgcn_sched_barrier(0);
  sol[48] -= b0a.x * sol[32]; sol[49] -= b0a.y * sol[32]; sol[50] -= b0a.z * sol[32]; sol[51] -= b0a.w * sol[32]; sol[52] -= b0b.x * sol[32]; sol[53] -= b0b.y * sol[32]; sol[54] -= b0b.z * sol[32]; sol[55] -= b0b.w * sol[32]; sol[56] -= b0c.x * sol[32]; sol[57] -= b0c.y * sol[32]; sol[58] -= b0c.z * sol[32]; sol[59] -= b0c.w * sol[32]; sol[60] -= b0d.x * sol[32]; sol[61] -= b0d.y * sol[32]; sol[62] -= b0d.z * sol[32]; sol[63] -= b0d.w * sol[32];
  __builtin_amdgcn_sched_barrier(0);
  b0a = *(const float4*)(Lr + 2208); b0b = *(const float4*)(Lr + 2212); b0c = *(const float4*)(Lr + 2216); b0d = *(const float4*)(Lr + 2220);
  __builtin_amdgcn_sched_barrier(0);
  sol[34] -= b1a.z * sol[33]; sol[35] -= b1a.w * sol[33]; sol[36] -= b1b.x * sol[33]; sol[37] -= b1b.y * sol[33]; sol[38] -= b1b.z * sol[33]; sol[39] -= b1b.w * sol[33]; sol[40] -= b1c.x * sol[33]; sol[41] -= b1c.y * sol[33]; sol[42] -= b1c.z * sol[33]; sol[43] -= b1c.w * sol[33]; sol[44] -= b1d.x * sol[33]; sol[45] -= b1d.y * sol[33]; sol[46] -= b1d.z * sol[33]; sol[47] -= b1d.w * sol[33];
  __builtin_amdgcn_sched_barrier(0);
  b1a = *(const float4*)(Lr + 2224); b1b = *(const float4*)(Lr + 2228); b1c = *(const float4*)(Lr + 2232); b1d = *(const float4*)(Lr + 2236);
  __builtin_amdgcn_sched_barrier(0);
  sol[48] -= b2a.x * sol[33]; sol[49] -= b2a.y * sol[33]; sol[50] -= b2a.z * sol[33]; sol[51] -= b2a.w * sol[33]; sol[52] -= b2b.x * sol[33]; sol[53] -= b2b.y * sol[33]; sol[54] -= b2b.z * sol[33]; sol[55] -= b2b.w * sol[33]; sol[56] -= b2c.x * sol[33]; sol[57] -= b2c.y * sol[33]; sol[58] -= b2c.z * sol[33]; sol[59] -= b2c.w * sol[33]; sol[60] -= b2d.x * sol[33]; sol[61] -= b2d.y * sol[33]; sol[62] -= b2d.z * sol[33]; sol[63] -= b2d.w * sol[33];
  __builtin_amdgcn_sched_barrier(0);
  b2a = *(const float4*)(Lr + 2272); b2b = *(const float4*)(Lr + 2276); b2c = *(const float4*)(Lr + 2280); b2d = *(const float4*)(Lr + 2284);
  __builtin_amdgcn_sched_barrier(0);
  sol[35] -= b0a.w * sol[34]; sol[36] -= b0b.x * sol[34]; sol[37] -= b0b.y * sol[34]; sol[38] -= b0b.z * sol[34]; sol[39] -= b0b.w * sol[34]; sol[40] -= b0c.x * sol[34]; sol[41] -= b0c.y * sol[34]; sol[42] -= b0c.z * sol[34]; sol[43] -= b0c.w * sol[34]; sol[44] -= b0d.x * sol[34]; sol[45] -= b0d.y * sol[34]; sol[46] -= b0d.z * sol[34]; sol[47] -= b0d.w * sol[34];
  __builtin_amdgcn_sched_barrier(0);
  b0a = *(const float4*)(Lr + 2288); b0b = *(const float4*)(Lr + 2292); b0c = *(const float4*)(Lr + 2296); b0d = *(const float4*)(Lr + 2300);
  __builtin_amdgcn_sched_barrier(0);
  sol[48] -= b1a.x * sol[34]; sol[49] -= b1a.y * sol[34]; sol[50] -= b1a.z * sol[34]; sol[51] -= b1a.w * sol[34]; sol[52] -= b1b.x * sol[34]; sol[53] -= b1b.y * sol[34]; sol[54] -= b1b.z * sol[34]; sol[55] -= b1b.w * sol[34]; sol[56] -= b1c.x * sol[34]; sol[57] -= b1c.y * sol[34]; sol[58] -= b1c.z * sol[34]; sol[59] -= b1c.w * sol[34]; sol[60] -= b1d.x * sol[34]; sol[61] -= b1d.y * sol[34]; sol[62] -= b1d.z * sol[34]; sol[63] -= b1d.w * sol[34];
  __builtin_amdgcn_sched_barrier(0);
  b1a = *(const float4*)(Lr + 2336); b1b = *(const float4*)(Lr + 2340); b1c = *(const float4*)(Lr + 2344); b1d = *(const float4*)(Lr + 2348);
  __builtin_amdgcn_sched_barrier(0);
  sol[36] -= b2b.x * sol[35]; sol[37] -= b2b.y * sol[35]; sol[38] -= b2b.z * sol[35]; sol[39] -= b2b.w * sol[35]; sol[40] -= b2c.x * sol[35]; sol[41] -= b2c.y * sol[35]; sol[42] -= b2c.z * sol[35]; sol[43] -= b2c.w * sol[35]; sol[44] -= b2d.x * sol[35]; sol[45] -= b2d.y * sol[35]; sol[46] -= b2d.z * sol[35]; sol[47] -= b2d.w * sol[35];
  __builtin_amdgcn_sched_barrier(0);
  b2a = *(const float4*)(Lr + 2352); b2b = *(const float4*)(Lr + 2356); b2c = *(const float4*)(Lr + 2360); b2d = *(const float4*)(Lr + 2364);
  __builtin_amdgcn_sched_barrier(0);
  sol[48] -= b0a.x * sol[35]; sol[49] -= b0a.y * sol[35]; sol[50] -= b0a.z * sol[35]; sol[51] -= b0a.w * sol[35]; sol[52] -= b0b.x * sol[35]; sol[53] -= b0b.y * sol[35]; sol[54] -= b0b.z * sol[35]; sol[55] -= b0b.w * sol[35]; sol[56] -= b0c.x * sol[35]; sol[57] -= b0c.y * sol[35]; sol[58] -= b0c.z * sol[35]; sol[59] -= b0c.w * sol[35]; sol[60] -= b0d.x * sol[35]; sol[61] -= b0d.y * sol[35]; sol[62] -= b0d.z * sol[35]; sol[63] -= b0d.w * sol[35];
  __builtin_amdgcn_sched_barrier(0);
  b0a = *(const float4*)(Lr + 2400); b0b = *(const float4*)(Lr + 2404); b0c = *(const float4*)(Lr + 2408); b0d = *(const float4*)(Lr + 2412);
  __builtin_amdgcn_sched_barrier(0);
  sol[37] -= b1b.y * sol[36]; sol[38] -= b1b.z * sol[36]; sol[39] -= b1b.w * sol[36]; sol[40] -= b1c.x * sol[36]; sol[41] -= b1c.y * sol[36]; sol[42] -= b1c.z * sol[36]; sol[43] -= b1c.w * sol[36]; sol[44] -= b1d.x * sol[36]; sol[45] -= b1d.y * sol[36]; sol[46] -= b1d.z * sol[36]; sol[47] -= b1d.w * sol[36];
  __builtin_amdgcn_sched_barrier(0);
  b1a = *(const float4*)(Lr + 2416); b1b = *(const float4*)(Lr + 2420); b1c = *(const float4*)(Lr + 2424); b1d = *(const float4*)(Lr + 2428);
  __builtin_amdgcn_sched_barrier(0);
  sol[48] -= b2a.x * sol[36]; sol[49] -= b2a.y * sol[36]; sol[50] -= b2a.z * sol[36]; sol[51] -= b2a.w * sol[36]; sol[52] -= b2b.x * sol[36]; sol[53] -= b2b.y * sol[36]; sol[54] -= b2b.z * sol[36]; sol[55] -= b2b.w * sol[36]; sol[56] -= b2c.x * sol[36]; sol[57] -= b2c.y * sol[36]; sol[58] -= b2c.z * sol[36]; sol[59] -= b2c.w * sol[36]; sol[60] -= b2d.x * sol[36]; sol[61] -= b2d.y * sol[36]; sol[62] -= b2d.z * sol[36]; sol[63] -= b2d.w * sol[36];
  __builtin_amdgcn_sched_barrier(0);
  b2a = *(const float4*)(Lr + 2464); b2b = *(const float4*)(Lr + 2468); b2c = *(const float4*)(Lr + 2472); b2d = *(const float4*)(Lr + 2476);
  __builtin_amdgcn_sched_barrier(0);
  sol[38] -= b0b.z * sol[37]; sol[39] -= b0b.w * sol[37]; sol[40] -= b0c.x * sol[37]; sol[41] -= b0c.y * sol[37]; sol[42] -= b0c.z * sol[37]; sol[43] -= b0c.w * sol[37]; sol[44] -= b0d.x * sol[37]; sol[45] -= b0d.y * sol[37]; sol[46] -= b0d.z * sol[37]; sol[47] -= b0d.w * sol[37];
  __builtin_amdgcn_sched_barrier(0);
  b0a = *(const float4*)(Lr + 2480); b0b = *(const float4*)(Lr + 2484); b0c = *(const float4*)(Lr + 2488); b0d = *(const float4*)(Lr + 2492);
  __builtin_amdgcn_sched_barrier(0);
  sol[48] -= b1a.x * sol[37]; sol[49] -= b1a.y * sol[37]; sol[50] -= b1a.z * sol[37]; sol[51] -= b1a.w * sol[37]; sol[52] -= b1b.x * sol[37]; sol[53] -= b1b.y * sol[37]; sol[54] -= b1b.z * sol[37]; sol[55] -= b1b.w * sol[37]; sol[56] -= b1c.x * sol[37]; sol[57] -= b1c.y * sol[37]; sol[58] -= b1c.z * sol[37]; sol[59] -= b1c.w * sol[37]; sol[60] -= b1d.x * sol[37]; sol[61] -= b1d.y * sol[37]; sol[62] -= b1d.z * sol[37]; sol[63] -= b1d.w * sol[37];
  __builtin_amdgcn_sched_barrier(0);
  b1a = *(const float4*)(Lr + 2528); b1b = *(const float4*)(Lr + 2532); b1c = *(const float4*)(Lr + 2536); b1d = *(const float4*)(Lr + 2540);
  __builtin_amdgcn_sched_barrier(0);
  sol[39] -= b2b.w * sol[38]; sol[40] -= b2c.x * sol[38]; sol[41] -= b2c.y * sol[38]; sol[42] -= b2c.z * sol[38]; sol[43] -= b2c.w * sol[38]; sol[44] -= b2d.x * sol[38]; sol[45] -= b2d.y * sol[38]; sol[46] -= b2d.z * sol[38]; sol[47] -= b2d.w * sol[38];
  __builtin_amdgcn_sched_barrier(0);
  b2a = *(const float4*)(Lr + 2544); b2b = *(const float4*)(Lr + 2548); b2c = *(const float4*)(Lr + 2552); b2d = *(const float4*)(Lr + 2556);
  __builtin_amdgcn_sched_barrier(0);
  sol[48] -= b0a.x * sol[38]; sol[49] -= b0a.y * sol[38]; sol[50] -= b0a.z * sol[38]; sol[51] -= b0a.w * sol[38]; sol[52] -= b0b.x * sol[38]; sol[53] -= b0b.y * sol[38]; sol[54] -= b0b.z * sol[38]; sol[55] -= b0b.w * sol[38]; sol[56] -= b0c.x * sol[38]; sol[57] -= b0c.y * sol[38]; sol[58] -= b0c.z * sol[38]; sol[59] -= b0c.w * sol[38]; sol[60] -= b0d.x * sol[38]; sol[61] -= b0d.y * sol[38]; sol[62] -= b0d.z * sol[38]; sol[63] -= b0d.w * sol[38];
  __builtin_amdgcn_sched_barrier(0);
  b0a = *(const float4*)(Lr + 2592); b0b = *(const float4*)(Lr + 2596); b0c = *(const float4*)(Lr + 2600); b0d = *(const float4*)(Lr + 2604);
  __builtin_amdgcn_sched_barrier(0);
  sol[40] -= b1c.x * sol[39]; sol[41] -= b1c.y * sol[39]; sol[42] -= b1c.z * sol[39]; sol[43] -= b1c.w * sol[39]; sol[44] -= b1d.x * sol[39]; sol[45] -= b1d.y * sol[39]; sol[46] -= b1d.z * sol[39]; sol[47] -= b1d.w * sol[39];
  __builtin_amdgcn_sched_barrier(0);
  b1a = *(const float4*)(Lr + 2608); b1b = *(const float4*)(Lr + 2612); b1c = *(const float4*)(Lr + 2616); b1d = *(const float4*)(Lr + 2620);
  __builtin_amdgcn_sched_barrier(0);
  sol[48] -= b2a.x * sol[39]; sol[49] -= b2a.y * sol[39]; sol[50] -= b2a.z * sol[39]; sol[51] -= b2a.w * sol[39]; sol[52] -= b2b.x * sol[39]; sol[53] -= b2b.y * sol[39]; sol[54] -= b2b.z * sol[39]; sol[55] -= b2b.w * sol[39]; sol[56] -= b2c.x * sol[39]; sol[57] -= b2c.y * sol[39]; sol[58] -= b2c.z * sol[39]; sol[59] -= b2c.w * sol[39]; sol[60] -= b2d.x * sol[39]; sol[61] -= b2d.y * sol[39]; sol[62] -= b2d.z * sol[39]; sol[63] -= b2d.w * sol[39];
  __builtin_amdgcn_sched_barrier(0);
  b2a = *(const float4*)(Lr + 2656); b2b = *(const float4*)(Lr + 2660); b2c = *(const float4*)(Lr + 2664); b2d = *(const float4*)(Lr + 2668);
  __builtin_amdgcn_sched_barrier(0);
  sol[41] -= b0c.y * sol[40]; sol[42] -= b0c.z * sol[40]; sol[43] -= b0c.w * sol[40]; sol[44] -= b0d.x * sol[40]; sol[45] -= b0d.y * sol[40]; sol[46] -= b0d.z * sol[40]; sol[47] -= b0d.w * sol[40];
  __builtin_amdgcn_sched_barrier(0);
  b0a = *(const float4*)(Lr + 2672); b0b = *(const float4*)(Lr + 2676); b0c = *(const float4*)(Lr + 2680); b0d = *(const float4*)(Lr + 2684);
  __builtin_amdgcn_sched_barrier(0);
  sol[48] -= b1a.x * sol[40]; sol[49] -= b1a.y * sol[40]; sol[50] -= b1a.z * sol[40]; sol[51] -= b1a.w * sol[40]; sol[52] -= b1b.x * sol[40]; sol[53] -= b1b.y * sol[40]; sol[54] -= b1b.z * sol[40]; sol[55] -= b1b.w * sol[40]; sol[56] -= b1c.x * sol[40]; sol[57] -= b1c.y * sol[40]; sol[58] -= b1c.z * sol[40]; sol[59] -= b1c.w * sol[40]; sol[60] -= b1d.x * sol[40]; sol[61] -= b1d.y * sol[40]; sol[62] -= b1d.z * sol[40]; sol[63] -= b1d.w * sol[40];
  __builtin_amdgcn_sched_barrier(0);
  b1a = *(const float4*)(Lr + 2720); b1b = *(const float4*)(Lr + 2724); b1c = *(const float4*)(Lr + 2728); b1d = *(const float4*)(Lr + 2732);
  __builtin_amdgcn_sched_barrier(0);
  sol[42] -= b2c.z * sol[41]; sol[43] -= b2c.w * sol[41]; sol[44] -= b2d.x * sol[41]; sol[45] -= b2d.y * sol[41]; sol[46] -= b2d.z * sol[41]; sol[47] -= b2d.w * sol[41];
  __builtin_amdgcn_sched_barrier(0);
  b2a = *(const float4*)(Lr + 2736); b2b = *(const float4*)(Lr + 2740); b2c = *(const float4*)(Lr + 2744); b2d = *(const float4*)(Lr + 2748);
  __builtin_amdgcn_sched_barrier(0);
  sol[48] -= b0a.x * sol[41]; sol[49] -= b0a.y * sol[41]; sol[50] -= b0a.z * sol[41]; sol[51] -= b0a.w * sol[41]; sol[52] -= b0b.x * sol[41]; sol[53] -= b0b.y * sol[41]; sol[54] -= b0b.z * sol[41]; sol[55] -= b0b.w * sol[41]; sol[56] -= b0c.x * sol[41]; sol[57] -= b0c.y * sol[41]; sol[58] -= b0c.z * sol[41]; sol[59] -= b0c.w * sol[41]; sol[60] -= b0d.x * sol[41]; sol[61] -= b0d.y * sol[41]; sol[62] -= b0d.z * sol[41]; sol[63] -= b0d.w * sol[41];
  __builtin_amdgcn_sched_barrier(0);
  b0a = *(const float4*)(Lr + 2784); b0b = *(const float4*)(Lr + 2788); b0c = *(const float4*)(Lr + 2792); b0d = *(const float4*)(Lr + 2796);
  __builtin_amdgcn_sched_barrier(0);
  sol[43] -= b1c.w * sol[42]; sol[44] -= b1d.x * sol[42]; sol[45] -= b1d.y * sol[42]; sol[46] -= b1d.z * sol[42]; sol[47] -= b1d.w * sol[42];
  __builtin_amdgcn_sched_barrier(0);
  b1a = *(const float4*)(Lr + 2800); b1b = *(const float4*)(Lr + 2804); b1c = *(const float4*)(Lr + 2808); b1d = *(const float4*)(Lr + 2812);
  __builtin_amdgcn_sched_barrier(0);
  sol[48] -= b2a.x * sol[42]; sol[49] -= b2a.y * sol[42]; sol[50] -= b2a.z * sol[42]; sol[51] -= b2a.w * sol[42]; sol[52] -= b2b.x * sol[42]; sol[53] -= b2b.y * sol[42]; sol[54] -= b2b.z * sol[42]; sol[55] -= b2b.w * sol[42]; sol[56] -= b2c.x * sol[42]; sol[57] -= b2c.y * sol[42]; sol[58] -= b2c.z * sol[42]; sol[59] -= b2c.w * sol[42]; sol[60] -= b2d.x * sol[42]; sol[61] -= b2d.y * sol[42]; sol[62] -= b2d.z * sol[42]; sol[63] -= b2d.w * sol[42];
  __builtin_amdgcn_sched_barrier(0);
  b2a = *(const float4*)(Lr + 2848); b2b = *(const float4*)(Lr + 2852); b2c = *(const float4*)(Lr + 2856); b2d = *(const float4*)(Lr + 2860);
  __builtin_amdgcn_sched_barrier(0);
  sol[44] -= b0d.x * sol[43]; sol[45] -= b0d.y * sol[43]; sol[46] -= b0d.z * sol[43]; sol[47] -= b0d.w * sol[43];
  __builtin_amdgcn_sched_barrier(0);
  b0a = *(const float4*)(Lr + 2864); b0b = *(const float4*)(Lr + 2868); b0c = *(const float4*)(Lr + 2872); b0d = *(const float4*)(Lr + 2876);
  __builtin_amdgcn_sched_barrier(0);
  sol[48] -= b1a.x * sol[43]; sol[49] -= b1a.y * sol[43]; sol[50] -= b1a.z * sol[43]; sol[51] -= b1a.w * sol[43]; sol[52] -= b1b.x * sol[43]; sol[53] -= b1b.y * sol[43]; sol[54] -= b1b.z * sol[43]; sol[55] -= b1b.w * sol[43]; sol[56] -= b1c.x * sol[43]; sol[57] -= b1c.y * sol[43]; sol[58] -= b1c.z * sol[43]; sol[59] -= b1c.w * sol[43]; sol[60] -= b1d.x * sol[43]; sol[61] -= b1d.y * sol[43]; sol[62] -= b1d.z * sol[43]; sol[63] -= b1d.w * sol[43];
  __builtin_amdgcn_sched_barrier(0);
  b1a = *(const float4*)(Lr + 2912); b1b = *(const float4*)(Lr + 2916); b1c = *(const float4*)(Lr + 2920); b1d = *(const float4*)(Lr + 2924);
  __builtin_amdgcn_sched_barrier(0);
  sol[45] -= b2d.y * sol[44]; sol[46] -= b2d.z * sol[44]; sol[47] -= b2d.w * sol[44];
  __builtin_amdgcn_sched_barrier(0);
  b2a = *(const float4*)(Lr + 2928); b2b = *(const float4*)(Lr + 2932); b2c = *(const float4*)(Lr + 2936); b2d = *(const float4*)(Lr + 2940);
  __builtin_amdgcn_sched_barrier(0);
  sol[48] -= b0a.x * sol[44]; sol[49] -= b0a.y * sol[44]; sol[50] -= b0a.z * sol[44]; sol[51] -= b0a.w * sol[44]; sol[52] -= b0b.x * sol[44]; sol[53] -= b0b.y * sol[44]; sol[54] -= b0b.z * sol[44]; sol[55] -= b0b.w * sol[44]; sol[56] -= b0c.x * sol[44]; sol[57] -= b0c.y * sol[44]; sol[58] -= b0c.z * sol[44]; sol[59] -= b0c.w * sol[44]; sol[60] -= b0d.x * sol[44]; sol[61] -= b0d.y * sol[44]; sol[62] -= b0d.z * sol[44]; sol[63] -= b0d.w * sol[44];
  __builtin_amdgcn_sched_barrier(0);
  b0a = *(const float4*)(Lr + 2976); b0b = *(const float4*)(Lr + 2980); b0c = *(const float4*)(Lr + 2984); b0d = *(const float4*)(Lr + 2988);
  __builtin_amdgcn_sched_barrier(0);
  sol[46] -= b1d.z * sol[45]; sol[47] -= b1d.w * sol[45];
  __builtin_amdgcn_sched_barrier(0);
  b1a = *(const float4*)(Lr + 2992); b1b = *(const float4*)(Lr + 2996); b1c = *(const float4*)(Lr + 3000); b1d = *(const float4*)(Lr + 3004);
  __builtin_amdgcn_sched_barrier(0);
  sol[48] -= b2a.x * sol[45]; sol[49] -= b2a.y * sol[45]; sol[50] -= b2a.z * sol[45]; sol[51] -= b2a.w * sol[45]; sol[52] -= b2b.x * sol[45]; sol[53] -= b2b.y * sol[45]; sol[54] -= b2b.z * sol[45]; sol[55] -= b2b.w * sol[45]; sol[56] -= b2c.x * sol[45]; sol[57] -= b2c.y * sol[45]; sol[58] -= b2c.z * sol[45]; sol[59] -= b2c.w * sol[45]; sol[60] -= b2d.x * sol[45]; sol[61] -= b2d.y * sol[45]; sol[62] -= b2d.z * sol[45]; sol[63] -= b2d.w * sol[45];
  __builtin_amdgcn_sched_barrier(0);
  b2a = *(const float4*)(Lr + 3056); b2b = *(const float4*)(Lr + 3060); b2c = *(const float4*)(Lr + 3064); b2d = *(const float4*)(Lr + 3068);
  __builtin_amdgcn_sched_barrier(0);
  sol[47] -= b0d.w * sol[46];
  __builtin_amdgcn_sched_barrier(0);
  b0a = *(const float4*)(Lr + 3120); b0b = *(const float4*)(Lr + 3124); b0c = *(const float4*)(Lr + 3128); b0d = *(const float4*)(Lr + 3132);
  __builtin_amdgcn_sched_barrier(0);
  sol[48] -= b1a.x * sol[46]; sol[49] -= b1a.y * sol[46]; sol[50] -= b1a.z * sol[46]; sol[51] -= b1a.w * sol[46]; sol[52] -= b1b.x * sol[46]; sol[53] -= b1b.y * sol[46]; sol[54] -= b1b.z * sol[46]; sol[55] -= b1b.w * sol[46]; sol[56] -= b1c.x * sol[46]; sol[57] -= b1c.y * sol[46]; sol[58] -= b1c.z * sol[46]; sol[59] -= b1c.w * sol[46]; sol[60] -= b1d.x * sol[46]; sol[61] -= b1d.y * sol[46]; sol[62] -= b1d.z * sol[46]; sol[63] -= b1d.w * sol[46];
  __builtin_amdgcn_sched_barrier(0);
  b1a = *(const float4*)(Lr + 3184); b1b = *(const float4*)(Lr + 3188); b1c = *(const float4*)(Lr + 3192); b1d = *(const float4*)(Lr + 3196);
  __builtin_amdgcn_sched_barrier(0);
  sol[48] -= b2a.x * sol[47]; sol[49] -= b2a.y * sol[47]; sol[50] -= b2a.z * sol[47]; sol[51] -= b2a.w * sol[47]; sol[52] -= b2b.x * sol[47]; sol[53] -= b2b.y * sol[47]; sol[54] -= b2b.z * sol[47]; sol[55] -= b2b.w * sol[47]; sol[56] -= b2c.x * sol[47]; sol[57] -= b2c.y * sol[47]; sol[58] -= b2c.z * sol[47]; sol[59] -= b2c.w * sol[47]; sol[60] -= b2d.x * sol[47]; sol[61] -= b2d.y * sol[47]; sol[62] -= b2d.z * sol[47]; sol[63] -= b2d.w * sol[47];
  __builtin_amdgcn_sched_barrier(0);
  b2a = *(const float4*)(Lr + 3248); b2b = *(const float4*)(Lr + 3252); b2c = *(const float4*)(Lr + 3256); b2d = *(const float4*)(Lr + 3260);
  __builtin_amdgcn_sched_barrier(0);
  sol[49] -= b0a.y * sol[48]; sol[50] -= b0a.z * sol[48]; sol[51] -= b0a.w * sol[48]; sol[52] -= b0b.x * sol[48]; sol[53] -= b0b.y * sol[48]; sol[54] -= b0b.z * sol[48]; sol[55] -= b0b.w * sol[48]; sol[56] -= b0c.x * sol[48]; sol[57] -= b0c.y * sol[48]; sol[58] -= b0c.z * sol[48]; sol[59] -= b0c.w * sol[48]; sol[60] -= b0d.x * sol[48]; sol[61] -= b0d.y * sol[48]; sol[62] -= b0d.z * sol[48]; sol[63] -= b0d.w * sol[48];
  __builtin_amdgcn_sched_barrier(0);
  b0a = *(const float4*)(Lr + 3312); b0b = *(const float4*)(Lr + 3316); b0c = *(const float4*)(Lr + 3320); b0d = *(const float4*)(Lr + 3324);
  __builtin_amdgcn_sched_barrier(0);
  sol[50] -= b1a.z * sol[49]; sol[51] -= b1a.w * sol[49]; sol[52] -= b1b.x * sol[49]; sol[53] -= b1b.y * sol[49]; sol[54] -= b1b.z * sol[49]; sol[55] -= b1b.w * sol[49]; sol[56] -= b1c.x * sol[49]; sol[57] -= b1c.y * sol[49]; sol[58] -= b1c.z * sol[49]; sol[59] -= b1c.w * sol[49]; sol[60] -= b1d.x * sol[49]; sol[61] -= b1d.y * sol[49]; sol[62] -= b1d.z * sol[49]; sol[63] -= b1d.w * sol[49];
  __builtin_amdgcn_sched_barrier(0);
  b1a = *(const float4*)(Lr + 3376); b1b = *(const float4*)(Lr + 3380); b1c = *(const float4*)(Lr + 3384); b1d = *(const float4*)(Lr + 3388);
  __builtin_amdgcn_sched_barrier(0);
  sol[51] -= b2a.w * sol[50]; sol[52] -= b2b.x * sol[50]; sol[53] -= b2b.y * sol[50]; sol[54] -= b2b.z * sol[50]; sol[55] -= b2b.w * sol[50]; sol[56] -= b2c.x * sol[50]; sol[57] -= b2c.y * sol[50]; sol[58] -= b2c.z * sol[50]; sol[59] -= b2c.w * sol[50]; sol[60] -= b2d.x * sol[50]; sol[61] -= b2d.y * sol[50]; sol[62] -= b2d.z * sol[50]; sol[63] -= b2d.w * sol[50];
  __builtin_amdgcn_sched_barrier(0);
  b2a = *(const float4*)(Lr + 3440); b2b = *(const float4*)(Lr + 3444); b2c = *(const float4*)(Lr + 3448); b2d = *(const float4*)(Lr + 3452);
  __builtin_amdgcn_sched_barrier(0);
  sol[52] -= b0b.x * sol[51]; sol[53] -= b0b.y * sol[51]; sol[54] -= b0b.z * sol[51]; sol[55] -= b0b.w * sol[51]; sol[56] -= b0c.x * sol[51]; sol[57] -= b0c.y * sol[51]; sol[58] -= b0c.z * sol[51]; sol[59] -= b0c.w * sol[51]; sol[60] -= b0d.x * sol[51]; sol[61] -= b0d.y * sol[51]; sol[62] -= b0d.z * sol[51]; sol[63] -= b0d.w * sol[51];
  __builtin_amdgcn_sched_barrier(0);
  b0a = *(const float4*)(Lr + 3504); b0b = *(const float4*)(Lr + 3508); b0c = *(const float4*)(Lr + 3512); b0d = *(const float4*)(Lr + 3516);
  __builtin_amdgcn_sched_barrier(0);
  sol[53] -= b1b.y * sol[52]; sol[54] -= b1b.z * sol[52]; sol[55] -= b1b.w * sol[52]; sol[56] -= b1c.x * sol[52]; sol[57] -= b1c.y * sol[52]; sol[58] -= b1c.z * sol[52]; sol[59] -= b1c.w * sol[52]; sol[60] -= b1d.x * sol[52]; sol[61] -= b1d.y * sol[52]; sol[62] -= b1d.z * sol[52]; sol[63] -= b1d.w * sol[52];
  __builtin_amdgcn_sched_barrier(0);
  b1a = *(const float4*)(Lr + 3568); b1b = *(const float4*)(Lr + 3572); b1c = *(const float4*)(Lr + 3576); b1d = *(const float4*)(Lr + 3580);
  __builtin_amdgcn_sched_barrier(0);
  sol[54] -= b2b.z * sol[53]; sol[55] -= b2b.w * sol[53]; sol[56] -= b2c.x * sol[53]; sol[57] -= b2c.y * sol[53]; sol[58] -= b2c.z * sol[53]; sol[59] -= b2c.w * sol[53]; sol[60] -= b2d.x * sol[53]; sol[61] -= b2d.y * sol[53]; sol[62] -= b2d.z * sol[53]; sol[63] -= b2d.w * sol[53];
  __builtin_amdgcn_sched_barrier(0);
  b2a = *(const float4*)(Lr + 3632); b2b = *(const float4*)(Lr + 3636); b2c = *(const float4*)(Lr + 3640); b2d = *(const float4*)(Lr + 3644);
  __builtin_amdgcn_sched_barrier(0);
  sol[55] -= b0b.w * sol[54]; sol[56] -= b0c.x * sol[54]; sol[57] -= b0c.y * sol[54]; sol[58] -= b0c.z * sol[54]; sol[59] -= b0c.w * sol[54]; sol[60] -= b0d.x * sol[54]; sol[61] -= b0d.y * sol[54]; sol[62] -= b0d.z * sol[54]; sol[63] -= b0d.w * sol[54];
  __builtin_amdgcn_sched_barrier(0);
  b0a = *(const float4*)(Lr + 3696); b0b = *(const float4*)(Lr + 3700); b0c = *(const float4*)(Lr + 3704); b0d = *(const float4*)(Lr + 3708);
  __builtin_amdgcn_sched_barrier(0);
  sol[56] -= b1c.x * sol[55]; sol[57] -= b1c.y * sol[55]; sol[58] -= b1c.z * sol[55]; sol[59] -= b1c.w * sol[55]; sol[60] -= b1d.x * sol[55]; sol[61] -= b1d.y * sol[55]; sol[62] -= b1d.z * sol[55]; sol[63] -= b1d.w * sol[55];
  __builtin_amdgcn_sched_barrier(0);
  b1a = *(const float4*)(Lr + 3760); b1b = *(const float4*)(Lr + 3764); b1c = *(const float4*)(Lr + 3768); b1d = *(const float4*)(Lr + 3772);
  __builtin_amdgcn_sched_barrier(0);
  sol[57] -= b2c.y * sol[56]; sol[58] -= b2c.z * sol[56]; sol[59] -= b2c.w * sol[56]; sol[60] -= b2d.x * sol[56]; sol[61] -= b2d.y * sol[56]; sol[62] -= b2d.z * sol[56]; sol[63] -= b2d.w * sol[56];
  __builtin_amdgcn_sched_barrier(0);
  b2a = *(const float4*)(Lr + 3824); b2b = *(const float4*)(Lr + 3828); b2c = *(const float4*)(Lr + 3832); b2d = *(const float4*)(Lr + 3836);
  __builtin_amdgcn_sched_barrier(0);
  sol[58] -= b0c.z * sol[57]; sol[59] -= b0c.w * sol[57]; sol[60] -= b0d.x * sol[57]; sol[61] -= b0d.y * sol[57]; sol[62] -= b0d.z * sol[57]; sol[63] -= b0d.w * sol[57];
  __builtin_amdgcn_sched_barrier(0);
  b0a = *(const float4*)(Lr + 3888); b0b = *(const float4*)(Lr + 3892); b0c = *(const float4*)(Lr + 3896); b0d = *(const float4*)(Lr + 3900);
  __builtin_amdgcn_sched_barrier(0);
  sol[59] -= b1c.w * sol[58]; sol[60] -= b1d.x * sol[58]; sol[61] -= b1d.y * sol[58]; sol[62] -= b1d.z * sol[58]; sol[63] -= b1d.w * sol[58];
  __builtin_amdgcn_sched_barrier(0);
  b1a = *(const float4*)(Lr + 3952); b1b = *(const float4*)(Lr + 3956); b1c = *(const float4*)(Lr + 3960); b1d = *(const float4*)(Lr + 3964);
  __builtin_amdgcn_sched_barrier(0);
  sol[60] -= b2d.x * sol[59]; sol[61] -= b2d.y * sol[59]; sol[62] -= b2d.z * sol[59]; sol[63] -= b2d.w * sol[59];
  __builtin_amdgcn_sched_barrier(0);
  b2a = *(const float4*)(Lr + 4016); b2b = *(const float4*)(Lr + 4020); b2c = *(const float4*)(Lr + 4024); b2d = *(const float4*)(Lr + 4028);
  __builtin_amdgcn_sched_barrier(0);
  sol[61] -= b0d.y * sol[60]; sol[62] -= b0d.z * sol[60]; sol[63] -= b0d.w * sol[60];
  __builtin_amdgcn_sched_barrier(0);
  __builtin_amdgcn_sched_barrier(0);
  sol[62] -= b1d.z * sol[61]; sol[63] -= b1d.w * sol[61];
  __builtin_amdgcn_sched_barrier(0);
  __builtin_amdgcn_sched_barrier(0);
  sol[63] -= b2d.w * sol[62];
  __builtin_amdgcn_sched_barrier(0);
}

template <int DIR>
__device__ __forceinline__ void solve_cols(const Params& P, int itb, int c, const float* Lt, const float* bpp, const float* gcp,
                                           const u16* Vs, const u16* Ks) {
  float sol[64];
  const float* bp_ = bpp + DIR * 64;
  const float* gc_ = gcp + DIR * 64;
  if (c < 128) {
    const u16* vp = Vs + c;
#pragma unroll
    for (int p = 0; p < 64; ++p) sol[p] = bp_[p] * bf2f(vp[(DIR ? (63 - p) : p) * 136]);
  } else {
    const u16* kp = Ks + (c - 128);
#pragma unroll
    for (int p = 0; p < 64; ++p) sol[p] = bp_[p] * __expf(gc_[p]) * bf2f(kp[(DIR ? (63 - p) : p) * 136]);
  }
  const float* Lr = Lt + opq(DIR * 4096);
  solve_elim(sol, Lr);
  const size_t it2 = (size_t)(itb + DIR);
  if (c < 128) {
    u16* UF = (u16*)(P.ws + OFF_UF) + (it2 * 128 + c) * 64;
#pragma unroll
    for (int q = 0; q < 8; ++q) *(uint4*)(UF + q * 8) = pack8(sol + q * 8);
  } else {
    u16* Wg = (u16*)(P.ws + OFF_R2) + it2 * 8192 + (c - 128);
#pragma unroll
    for (int p = 0; p < 64; ++p) Wg[p * 128] = f2bf(-sol[p]);
  }
}

__device__ __forceinline__ void delta_prep_item(const Params& P, int item, char* lds) {
  const int tid = opq(threadIdx.x), lane = tid & 63, wv = tid >> 6, fr = lane & 15, fq = lane >> 4;
  const int cid = item >> 2, h = item & 3;
  const int row0 = cid * 64;
  int seq_lo, seq_hi;
  if (cid < 256) { seq_lo = (cid >> 6) * 4096; seq_hi = seq_lo + 4096; }
  else { seq_lo = 16384 + ((cid - 256) >> 2) * 256; seq_hi = seq_lo + 256; }
  u16* Qs = (u16*)(lds + opq(0));
  u16* Ks = (u16*)(lds + opq(17408));
  u16* Vs = (u16*)(lds + opq(34816));
  float* KKs = (float*)(lds + opq(52224));
  float* QKs = (float*)(lds + opq(69632));
  float* Lt = (float*)(lds + opq(87040));
  float* gtok = (float*)(lds + opq(119808));
  float* btok = gtok + 128;
  float* gcp = btok + 128;
  float* bpp = gcp + 128;
  u16* QKN = (u16*)((char*)P.out + OFF_QKN);
  __syncthreads();
  {
    const int j = tid >> 3, sg = tid & 7;
    const int row = row0 + j;
    const bool hm = (row - 1 >= seq_lo), hp = (row + 1 < seq_hi);
    const u16* qkv = (const u16*)(P.ws + OFF_R3);
#pragma unroll
    for (int s = 0; s < 3; ++s) {
      const int col = s * 512 + h * 128 + sg * 16;
      const u16* p0 = qkv + (size_t)row * 1536 + col;
      float y[16];
      float ssq = 0.f;
#pragma unroll
      for (int hh = 0; hh < 2; ++hh) {
        const uint4 c0 = *(const uint4*)(p0 + hh * 8);
        uint4 m0 = *(const uint4*)(p0 - (hm ? 1536 : 0) + hh * 8);
        uint4 n0 = *(const uint4*)(p0 + (hp ? 1536 : 0) + hh * 8);
        m0.x = hm ? m0.x : 0u; m0.y = hm ? m0.y : 0u; m0.z = hm ? m0.z : 0u; m0.w = hm ? m0.w : 0u;
        n0.x = hp ? n0.x : 0u; n0.y = hp ? n0.y : 0u; n0.z = hp ? n0.z : 0u; n0.w = hp ? n0.w : 0u;
        float fc[8], fm[8], fn[8];
        unpack8(c0, fc); unpack8(m0, fm); unpack8(n0, fn);
        const float* cwp = P.dn_conv_w + col + hh * 8;
        float cw0[8], cw1[8], cw2[8];
        {
          const float4 t0 = *(const float4*)(cwp), t1 = *(const float4*)(cwp + 4);
          const float4 t2 = *(const float4*)(cwp + 1536), t3 = *(const float4*)(cwp + 1540);
          const float4 t4 = *(const float4*)(cwp + 3072), t5 = *(const float4*)(cwp + 3076);
          cw0[0] = t0.x; cw0[1] = t0.y; cw0[2] = t0.z; cw0[3] = t0.w; cw0[4] = t1.x; cw0[5] = t1.y; cw0[6] = t1.z; cw0[7] = t1.w;
          cw1[0] = t2.x; cw1[1] = t2.y; cw1[2] = t2.z; cw1[3] = t2.w; cw1[4] = t3.x; cw1[5] = t3.y; cw1[6] = t3.z; cw1[7] = t3.w;
          cw2[0] = t4.x; cw2[1] = t4.y; cw2[2] = t4.z; cw2[3] = t4.w; cw2[4] = t5.x; cw2[5] = t5.y; cw2[6] = t5.z; cw2[7] = t5.w;
        }
#pragma unroll
        for (int e = 0; e < 8; ++e) {
          const float v = cw0[e] * fm[e] + cw1[e] * fc[e] + cw2[e] * fn[e];
          const float yy = v * sigm(v);
          y[hh * 8 + e] = yy;
          ssq += yy * yy;
        }
      }
      if (s < 2) {
        ssq += __shfl_xor(ssq, 1, 64); ssq += __shfl_xor(ssq, 2, 64); ssq += __shfl_xor(ssq, 4, 64);
        const float sc = rsqrtf(ssq + 1e-6f) * ((s == 0) ? 0.08838834764831845f : 1.f);
#pragma unroll
        for (int e = 0; e < 16; ++e) y[e] *= sc;
      }
      u16* dl = ((s == 0) ? Qs : ((s == 1) ? Ks : Vs)) + j * 136 + sg * 16;
      const uint4 o0 = pack8(y), o1 = pack8(y + 8);
      *(uint4*)dl = o0; *(uint4*)(dl + 8) = o1;
      if (s < 2) {
        u16* dg = QKN + (size_t)row * 1024 + s * 512 + h * 128 + sg * 16;
        *(uint4*)dg = o0; *(uint4*)(dg + 8) = o1;
      }
    }
  }
  if (tid < 128) {
    const int j = tid & 63, dir = tid >> 6;
    const float* BA = (const float*)(P.ws + OFF_BA) + (size_t)(row0 + j) * 16;
    const float bl = BA[dir * 4 + h], al = BA[8 + dir * 4 + h];
    const float xx = al + P.dn_dt_bias[dir * 4 + h];
    const float sp = (xx > 20.f) ? xx : log1pf(expf(xx));
    gtok[dir * 64 + j] = -expf(P.dn_a_log[dir * 4 + h]) * sp;
    btok[dir * 64 + j] = 1.f / (1.f + expf(-bl));
  }
  __syncthreads();
  if (tid < 2) {
    const int dir = tid;
    float a = 0.f;
    for (int p = 0; p < 64; ++p) {
      const int tk = dir ? (63 - p) : p;
      a += gtok[dir * 64 + tk];
      gcp[dir * 64 + p] = a;
      bpp[dir * 64 + p] = btok[dir * 64 + tk];
    }
  }
  {
#pragma unroll
    for (int q = 0; q < 4; ++q) {
      const int t = wv * 4 + q;
      const int which = t >> 4, mi = (t >> 2) & 3, ni = t & 3;
      const u16* Am = (which ? Qs : Ks) + (mi * 16 + fr) * 136 + fq * 8;
      const u16* Bm = Ks + (ni * 16 + fr) * 136 + fq * 8;
      f32x4 a4 = {0.f, 0.f, 0.f, 0.f};
#pragma unroll
      for (int kk = 0; kk < 4; ++kk)
        a4 = __builtin_amdgcn_mfma_f32_16x16x32_bf16(*(const bf16x8*)(Am + kk * 32), *(const bf16x8*)(Bm + kk * 32), a4, 0, 0, 0);
      float* dst = which ? QKs : KKs;
#pragma unroll
      for (int e = 0; e < 4; ++e) dst[(mi * 16 + fq * 4 + e) * 68 + ni * 16 + fr] = a4[e];
    }
  }
  __syncthreads();
  const int itb = item * 2;
  {
    u16* AQ = (u16*)((char*)P.out + OFF_AQ);
    for (int idx = tid; idx < 8192; idx += NT) {
      const int dir = idx >> 12, p = (idx >> 6) & 63, s = idx & 63;
      const int tp = dir ? (63 - p) : p, ts = dir ? (63 - s) : s;
      const float dg = gcp[dir * 64 + p] - gcp[dir * 64 + s];
      const float dec = (p >= s) ? __expf(dg) : 0.f;
      AQ[((size_t)(itb + dir) * 64 + p) * 64 + s] = f2bf(QKs[tp * 68 + ts] * dec);
    }
    for (int idx = tid; idx < 8192; idx += NT) {
      const int dir = idx >> 12, s = (idx >> 6) & 63, p = idx & 63;
      const int tp = dir ? (63 - p) : p, ts = dir ? (63 - s) : s;
      const float dg = gcp[dir * 64 + p] - gcp[dir * 64 + s];
      const float lv = (p > s) ? bpp[dir * 64 + p] * KKs[ts * 68 + tp] * __expf(dg) : 0.f;
      Lt[dir * 4096 + s * 64 + p] = lv;
    }
    if (tid < 128) {
      float* GC = (float*)(P.ws + OFF_GC);
      GC[(size_t)(itb + (tid >> 6)) * 64 + (tid & 63)] = gcp[tid];
    }
  }
  __syncthreads();
  if (tid < 256) solve_cols<0>(P, itb, tid, Lt, bpp, gcp, Vs, Ks);
  else solve_cols<1>(P, itb, tid - 256, Lt, bpp, gcp, Vs, Ks);
}

__device__ __forceinline__ void s5end_tile(const Params& P, int t, char* lds) {
  const int g = t / 6, mt = (t % 6) >> 1, nt = t & 1;
  const int m0 = mt * 256, n0 = nt * 128;
  f32x16 acc[2][2];
  acc_zero(acc);
  gemm_main((const u16*)(P.ws + OFF_U5) + ((size_t)g * 544 + m0) * 512, 512,
            (const u16*)(P.ws + OFF_MEND) + ((size_t)g * 256 + n0) * 512, 512, 512, acc, (u16*)lds);
  TILE_COORDS
  float* E = (float*)(P.ws + OFF_E);
#pragma unroll
  for (int i = 0; i < 2; ++i)
#pragma unroll
    for (int j = 0; j < 2; ++j)
#pragma unroll
      for (int e = 0; e < 16; ++e) {
        const int row = TROW(m0, i, e);
        if (row < 544) E[((size_t)g * 544 + row) * 256 + TCOL(n0, j)] = acc[i][j][e];
      }
}

__device__ __forceinline__ void scan_chunk(const u16* Wl, const u16* QTl, const u16* KTl, const u16* AQl, u16* ST, u16* VT,
                                           int wd, int wq, int fr, int fq, float gl, f32x4& av, f32x4& ao, f32x4& accS0, f32x4& accS1) {
#pragma unroll
  for (int kk = 0; kk < 4; ++kk) {
    const bf16x8 bS = *(const bf16x8*)(ST + (wd * 16 + fr) * 136 + kk * 32 + fq * 8);
    const bf16x8 a1 = *(const bf16x8*)(Wl + (wq * 16 + fr) * 136 + kk * 32 + fq * 8);
    av = __builtin_amdgcn_mfma_f32_16x16x32_bf16(a1, bS, av, 0, 0, 0);
    const bf16x8 a2 = *(const bf16x8*)(QTl + (wq * 16 + fr) * 136 + kk * 32 + fq * 8);
    ao = __builtin_amdgcn_mfma_f32_16x16x32_bf16(a2, bS, ao, 0, 0, 0);
  }
  {
    uint2 v; v.x = pack2(av[0], av[1]); v.y = pack2(av[2], av[3]);
    *(uint2*)(VT + (wd * 16 + fr) * 72 + wq * 16 + fq * 4) = v;
  }
  __syncthreads();
  accS0[0] *= gl; accS0[1] *= gl; accS0[2] *= gl; accS0[3] *= gl;
  accS1[0] *= gl; accS1[1] *= gl; accS1[2] *= gl; accS1[3] *= gl;
#pragma unroll
  for (int ks = 0; ks < 2; ++ks) {
    const bf16x8 bV = *(const bf16x8*)(VT + (wd * 16 + fr) * 72 + ks * 32 + fq * 8);
    const bf16x8 a1 = *(const bf16x8*)(AQl + (wq * 16 + fr) * 72 + ks * 32 + fq * 8);
    ao = __builtin_amdgcn_mfma_f32_16x16x32_bf16(a1, bV, ao, 0, 0, 0);
    const bf16x8 k0 = *(const bf16x8*)(KTl + ((2 * wq) * 16 + fr) * 72 + ks * 32 + fq * 8);
    accS0 = __builtin_amdgcn_mfma_f32_16x16x32_bf16(k0, bV, accS0, 0, 0, 0);
    const bf16x8 k1 = *(const bf16x8*)(KTl + ((2 * wq + 1) * 16 + fr) * 72 + ks * 32 + fq * 8);
    accS1 = __builtin_amdgcn_mfma_f32_16x16x32_bf16(k1, bV, accS1, 0, 0, 0);
  }
  {
    uint2 v; v.x = pack2(accS0[0], accS0[1]); v.y = pack2(accS0[2], accS0[3]);
    *(uint2*)(ST + (wd * 16 + fr) * 136 + (2 * wq) * 16 + fq * 4) = v;
    v.x = pack2(accS1[0], accS1[1]); v.y = pack2(accS1[2], accS1[3]);
    *(uint2*)(ST + (wd * 16 + fr) * 136 + (2 * wq + 1) * 16 + fq * 4) = v;
  }
}

__device__ __forceinline__ void delta_scan_block(const Params& P, int sb, char* lds) {
  const int tid = opq(threadIdx.x), lane = tid & 63, w = tid >> 6, fr = lane & 15, fq = lane >> 4;
  const int bhd = sb & 31, dvq = sb >> 5;
  const int b = bhd >> 3, h = (bhd >> 1) & 3, dir = bhd & 1;
  const int wd = w & 1, wq = w >> 1;
  const int dv0 = dvq * 32 + wd * 16;
  u16* Wl = (u16*)(lds + opq(0));
  u16* QTl = (u16*)(lds + opq(17408));
  u16* KTl = (u16*)(lds + opq(34816));
  u16* AQl = (u16*)(lds + opq(53248));
  u16* ST = (u16*)(lds + opq(62464));
  u16* VT = (u16*)(lds + opq(71168));
  __syncthreads();
  for (int i = tid; i < 32 * 136 / 2; i += NT) ((uint32_t*)ST)[i] = 0u;
  f32x4 accS0 = {0.f, 0.f, 0.f, 0.f}, accS1 = {0.f, 0.f, 0.f, 0.f};
  const u16* QKN = (const u16*)((const char*)P.out + OFF_QKN);
  const u16* AQg = (const u16*)((const char*)P.out + OFF_AQ);
  const u16* Wg = (const u16*)(P.ws + OFF_R2);
  const u16* UFg = (const u16*)(P.ws + OFF_UF);
  const float* GC = (const float*)(P.ws + OFF_GC);
  u16* Og = (u16*)(P.ws + OFF_O);

#define SC_DECL(S)                                                   \
  uint4 S##w0, S##w1, S##q0, S##q1, S##k0, S##k1, S##a;              \
  float S##gq0, S##gq1, S##gk, S##g63;                               \
  uint2 S##u;                                                        \
  int S##row0 = 0, S##lat = 0;
#define SC_PF_ONE(S, i)                                                                            \
    {                                                                                              \
      const int id = tid + (i) * 512;                                                              \
      const int p = id >> 4, seg = id & 15;                                                        \
      const int tk = dir ? (63 - p) : p;                                                           \
      S##w##i = *(const uint4*)(Wg + it2__ * 8192 + p * 128 + seg * 8);                            \
      S##q##i = *(const uint4*)(QKN + (size_t)(S##row0 + tk) * 1024 + h * 128 + seg * 8);          \
      S##gq##i = GC[it2__ * 64 + p];                                                               \
      const int s = id & 63, sg2 = id >> 6;                                                        \
      const int tks = dir ? (63 - s) : s;                                                          \
      S##k##i = *(const uint4*)(QKN + (size_t)(S##row0 + tks) * 1024 + 512 + h * 128 + sg2 * 8);   \
    }
#define SC_PREFETCH(S, n_)                                                                         \
  {                                                                                                \
    const int n__ = (n_);                                                                          \
    int cid__;                                                                                     \
    if (n__ < 4) { cid__ = 256 + b * 4 + (dir ? (3 - n__) : n__); S##lat = 0; }                    \
    else { const int m__ = n__ - 4; cid__ = b * 64 + (dir ? (63 - m__) : m__); S##lat = 1; }       \
    S##row0 = cid__ * 64;                                                                          \
    const size_t it2__ = (size_t)((cid__ * 4 + h) * 2 + dir);                                      \
    SC_PF_ONE(S, 0)                                                                                \
    SC_PF_ONE(S, 1)                                                                                \
    S##gk = GC[it2__ * 64 + (tid & 63)];                                                           \
    S##g63 = GC[it2__ * 64 + 63];                                                                  \
    S##a = *(const uint4*)(AQg + it2__ * 4096 + (tid >> 3) * 64 + (tid & 7) * 8);                  \
    S##u = *(const uint2*)(UFg + (it2__ * 128 + dv0 + fr) * 64 + wq * 16 + fq * 4);                \
  }
#define SC_STAGE_ONE(S, i)                                                    \
    {                                                                         \
      const int id = tid + (i) * 512;                                         \
      const int p = id >> 4, seg = id & 15;                                   \
      *(uint4*)(Wl + p * 136 + seg * 8) = S##w##i;                            \
      float f[8];                                                             \
      unpack8(S##q##i, f);                                                    \
      const float sq = __expf(S##gq##i);                                      \
      f[0] *= sq; f[1] *= sq; f[2] *= sq; f[3] *= sq; f[4] *= sq; f[5] *= sq; f[6] *= sq; f[7] *= sq; \
      *(uint4*)(QTl + p * 136 + seg * 8) = pack8(f);                          \
      const int s = id & 63, sg2 = id >> 6;                                   \
      unpack8(S##k##i, f);                                                    \
      u16* kd = KTl + (sg2 * 8) * 72 + s;                                     \
      kd[0 * 72] = f2bf(f[0] * sk); kd[1 * 72] = f2bf(f[1] * sk); kd[2 * 72] = f2bf(f[2] * sk); kd[3 * 72] = f2bf(f[3] * sk); \
      kd[4 * 72] = f2bf(f[4] * sk); kd[5 * 72] = f2bf(f[5] * sk); kd[6 * 72] = f2bf(f[6] * sk); kd[7 * 72] = f2bf(f[7] * sk); \
    }
#define SC_STEP(S, n_)                                                                                \
  {                                                                                                   \
    const int cur_row0 = S##row0, cur_lat = S##lat;                                                   \
    const float gl = __expf(S##g63);                                                                  \
    const float sk = __expf(S##g63 - S##gk);                                                          \
    SC_STAGE_ONE(S, 0)                                                                                \
    SC_STAGE_ONE(S, 1)                                                                                \
    *(uint4*)(AQl + (tid >> 3) * 72 + (tid & 7) * 8) = S##a;                                          \
    f32x4 av = f32x4{lo16(S##u.x), hi16(S##u.x), lo16(S##u.y), hi16(S##u.y)};                         \
    f32x4 ao = f32x4{0.f, 0.f, 0.f, 0.f};                                                             \
    __syncthreads();                                                                                  \
    if ((n_) + 2 < 68) SC_PREFETCH(S, (n_) + 2)                                                       \
    scan_chunk(Wl, QTl, KTl, AQl, ST, VT, wd, wq, fr, fq, gl, av, ao, accS0, accS1);                  \
    if (cur_lat) {                                                                                    \
      _Pragma("unroll") for (int e = 0; e < 4; ++e) {                                                 \
        const int p = wq * 16 + fq * 4 + e;                                                           \
        const int tk = dir ? (63 - p) : p;                                                            \
        Og[((size_t)dir * 16384 + cur_row0 + tk) * 512 + h * 128 + dv0 + fr] = f2bf(ao[e]);           \
      }                                                                                               \
    }                                                                                                 \
    __syncthreads();                                                                                  \
  }
  SC_DECL(A)
  SC_DECL(B)
  SC_PREFETCH(A, 0)
  SC_PREFETCH(B, 1)
  for (int n = 0; n < 68; n += 2) {
    SC_STEP(A, n)
    SC_STEP(B, n + 1)
  }
#undef SC_DECL
#undef SC_PF_ONE
#undef SC_PREFETCH
#undef SC_STAGE_ONE
#undef SC_STEP
}

__device__ __forceinline__ void s5_carry_block(const Params& P, int cb) {
  const int idx = cb * NT + opq(threadIdx.x);
  const int n = idx & 63, g = (idx >> 6) & 31, r = (idx >> 11) & 1, b = idx >> 12;
  const int rg = r * 32 + g;
  const float step = expf(P.s5_log_step[rg]);
  float lr, li;
  lam_pow(step, P.s5_a_re[rg * 64 + n], P.s5_a_im[rg * 64 + n], 32, lr, li);
  const float* E = (const float*)(P.ws + OFF_E) + (size_t)g * 544 * 256 + r * 128 + n;
  u16* XIN = (u16*)(P.ws + OFF_XIN) + (size_t)g * 512 * 256 + r * 128 + n;
  float xr = 0.f, xi = 0.f;
  for (int k = 0; k < 8; ++k) {
    const int cc = r ? (7 - k) : k;
    const int row = 512 + b * 8 + cc;
    const float er = E[(size_t)row * 256], ei = E[(size_t)row * 256 + 64];
    const float nr = lr * xr - li * xi + er, ni = lr * xi + li * xr + ei;
    xr = nr; xi = ni;
  }
  for (int k = 0; k < 128; ++k) {
    const int cc = r ? (127 - k) : k;
    const int row = b * 128 + cc;
    XIN[(size_t)row * 256] = f2bf(xr);
    XIN[(size_t)row * 256 + 64] = f2bf(xi);
    const float er = E[(size_t)row * 256], ei = E[(size_t)row * 256 + 64];
    const float nr = lr * xr - li * xi + er, ni = lr * xi + li * xr + ei;
    xr = nr; xi = ni;
  }
}

__device__ __forceinline__ void s5out_tile(const Params& P, int t, char* lds) {
  const int g = t >> 3, mt = (t >> 2) & 1, nt = t & 3;
  const int m0 = mt * 256, n0 = nt * 128;
  f32x16 acc[2][2];
  acc_zero(acc);
  gemm_main((const u16*)(P.ws + OFF_XIN) + ((size_t)g * 512 + m0) * 256, 256,
            (const u16*)(P.ws + OFF_MST) + ((size_t)g * 512 + n0) * 256, 256, 256, acc, (u16*)lds);
  gemm_main((const u16*)(P.ws + OFF_U5) + ((size_t)g * 544 + m0) * 512, 512,
            (const u16*)(P.ws + OFF_MINTRA) + ((size_t)g * 512 + n0) * 512, 512, 512, acc, (u16*)lds);
  TILE_COORDS
  u16* YB = (u16*)(P.ws + OFF_YB);
#pragma unroll
  for (int i = 0; i < 2; ++i)
#pragma unroll
    for (int j = 0; j < 2; ++j)
#pragma unroll
      for (int e = 0; e < 16; ++e) {
        const int row = TROW(m0, i, e), nn = TCOL(n0, j);
        const int token = row * 32 + (nn >> 4);
        YB[(size_t)token * 512 + g * 16 + (nn & 15)] = f2bf(gelu_tanh(acc[i][j][e]));
      }
}

__device__ __forceinline__ void delta_post_item(const Params& P, int item) {
  const int lane = opq(threadIdx.x) & 63, w = opq(threadIdx.x) >> 6;
  const int row = item * 8 + w;
  const u16* O = (const u16*)(P.ws + OFF_O);
  const uint4 o0 = *(const uint4*)(O + (size_t)row * 512 + lane * 8);
  const uint4 o1 = *(const uint4*)(O + ((size_t)16384 + row) * 512 + lane * 8);
  const uint4 zz = *(const uint4*)((const u16*)(P.ws + OFF_Z) + (size_t)row * 512 + lane * 8);
  float a[8], bq[8], z[8];
  unpack8(o0, a); unpack8(o1, bq); unpack8(zz, z);
  float ss = 0.f;
#pragma unroll
  for (int e = 0; e < 8; ++e) { a[e] += bq[e]; ss += a[e] * a[e]; }
  ss += __shfl_xor(ss, 1, 64); ss += __shfl_xor(ss, 2, 64); ss += __shfl_xor(ss, 4, 64); ss += __shfl_xor(ss, 8, 64);
  const float rstd = rsqrtf(ss * (1.f / 128.f) + 1e-6f);
  const float* nw = P.dn_norm_w + (lane & 15) * 8;
  float y[8];
#pragma unroll
  for (int e = 0; e < 8; ++e) y[e] = a[e] * rstd * nw[e] * (z[e] * sigm(z[e]));
  *(uint4*)((u16*)(P.ws + OFF_YA) + (size_t)row * 512 + lane * 8) = pack8(y);
}

__device__ __forceinline__ void glu_tile(const Params& P, int t, char* lds) {
  const int nt = t >> 6, mt = t & 63;
  const int m0 = mt * 256, n0 = nt * 128;
  f32x16 acc[2][2];
  acc_zero(acc);
  gemm_main((const u16*)(P.ws + OFF_YB) + (size_t)m0 * 512, 512, (const u16*)(P.ws + OFF_WT_GLU) + (size_t)n0 * 512, 512, 512, acc, (u16*)lds);
  TILE_COORDS
  u16* YG = (u16*)(P.ws + OFF_YG);
  {
    const int oc = nt * 64 + wn_ * 32 + fr_;
    const float bv = P.b_glu[oc], bg = P.b_glu[512 + oc];
#pragma unroll
    for (int i = 0; i < 2; ++i)
#pragma unroll
      for (int e = 0; e < 16; ++e) {
        const float val = acc[i][0][e] + bv, gt = acc[i][1][e] + bg;
        YG[TIDX2(m0, nt * 64 + wn_ * 32, i, e, 512)] = f2bf(val * sigm(gt));
      }
  }
}

__device__ __forceinline__ void gates_tile(const Params& P, int t, char* lds) {
  const int nt = t >> 6, mt = t & 63;
  const int m0 = mt * 256, n0 = nt * 128;
  f32x16 acc[2][2];
  acc_zero(acc);
  gemm_main((const u16*)(P.ws + OFF_R2) + (size_t)m0 * 1024, 1024, (const u16*)(P.ws + OFF_WT_IN) + (size_t)(2688 + n0) * 1024, 1024, 1024, acc, (u16*)lds);
  TILE_COORDS
  u16* SG = (u16*)(P.ws + OFF_SG);
#pragma unroll
  for (int i = 0; i < 2; ++i)
#pragma unroll
    for (int j = 0; j < 2; ++j)
#pragma unroll
      for (int e = 0; e < 16; ++e) SG[TIDX(m0, n0, i, j, e, 2048)] = f2bf(sigm(acc[i][j][e]));
}

__device__ __forceinline__ void mix_tile(const Params& P, int t, char* lds) {
  const int nt = t >> 6, mt = t & 63;
  const int m0 = mt * 256, n0 = nt * 128;
  const u16* SG = (const u16*)(P.ws + OFF_SG);
  f32x16 acc[2][2];
  u16* MIX = (u16*)(P.ws + OFF_MIX);
  acc_zero(acc);
  gemm_main((const u16*)(P.ws + OFF_YA) + (size_t)m0 * 512, 512, (const u16*)(P.ws + OFF_WT_AOUT) + (size_t)n0 * 512, 512, 512, acc, (u16*)lds);
  {
    TILE_COORDS
    u16 sv[2][2][16];
#pragma unroll
    for (int i = 0; i < 2; ++i)
#pragma unroll
      for (int j = 0; j < 2; ++j)
#pragma unroll
        for (int e = 0; e < 16; ++e) sv[i][j][e] = SG[TIDX(m0, n0, i, j, e, 2048)];
#pragma unroll
    for (int i = 0; i < 2; ++i)
#pragma unroll
      for (int j = 0; j < 2; ++j)
#pragma unroll
        for (int e = 0; e < 16; ++e) MIX[TIDX(m0, n0, i, j, e, 1024)] = f2bf(bf2f(sv[i][j][e]) * acc[i][j][e]);
  }
  acc_zero(acc);
  gemm_main((const u16*)(P.ws + OFF_YG) + (size_t)m0 * 512, 512, (const u16*)(P.ws + OFF_WT_BOUT) + (size_t)n0 * 512, 512, 512, acc, (u16*)lds);
  {
    TILE_COORDS
#pragma unroll
    for (int i = 0; i < 2; ++i) {
      u16 sv[2][16], pv[2][16];
#pragma unroll
      for (int j = 0; j < 2; ++j)
#pragma unroll
        for (int e = 0; e < 16; ++e) {
          sv[j][e] = SG[TIDX(m0, n0, i, j, e, 2048) + 1024];
          pv[j][e] = MIX[TIDX(m0, n0, i, j, e, 1024)];
        }
#pragma unroll
      for (int j = 0; j < 2; ++j)
#pragma unroll
        for (int e = 0; e < 16; ++e)
          MIX[TIDX(m0, n0, i, j, e, 1024)] = f2bf(bf2f(pv[j][e]) + bf2f(sv[j][e]) * acc[i][j][e]);
    }
  }
}

__device__ __forceinline__ void wo_tile(const Params& P, int t, char* lds) {
  const int nt = t >> 6, mt = t & 63;
  const int m0 = mt * 256, n0 = nt * 128;
  f32x16 acc[2][2];
  acc_zero(acc);
  gemm_main((const u16*)(P.ws + OFF_MIX) + (size_t)m0 * 1024, 1024, (const u16*)(P.ws + OFF_WT_O) + (size_t)n0 * 1024, 1024, 1024, acc, (u16*)lds);
  TILE_COORDS
  const float* MOD = (const float*)(P.ws + OFF_MOD) + (m0 >> 12) * 6144 + 2 * 1024;
  float xv[2][2][16];
#pragma unroll
  for (int j = 0; j < 2; ++j)
#pragma unroll
    for (int i = 0; i < 2; ++i)
#pragma unroll
      for (int e = 0; e < 16; ++e) xv[i][j][e] = P.x[TIDX(m0, n0, i, j, e, 1024)];
#pragma unroll
  for (int j = 0; j < 2; ++j) {
    const int col = TCOL(n0, j);
    const float gate = MOD[col];
#pragma unroll
    for (int i = 0; i < 2; ++i)
#pragma unroll
      for (int e = 0; e < 16; ++e) P.out[TIDX(m0, n0, i, j, e, 1024)] = xv[i][j][e] + gate * acc[i][j][e];
  }
}

__device__ __forceinline__ void norm2_item(const Params& P, int item) {
  const int lane = opq(threadIdx.x) & 63, w = opq(threadIdx.x) >> 6;
  const int row = item * 8 + w;
  const float* MOD = (const float*)(P.ws + OFF_MOD) + (row >> 12) * 6144;
  norm_row(P.out + (size_t)row * 1024, P.norm2_w, MOD + 3 * 1024, MOD + 4 * 1024, (u16*)(P.ws + OFF_R2) + (size_t)row * 1024, lane);
}

__device__ __forceinline__ void up_tile(const Params& P, int t, int hh, char* lds) {
  const int nt = t >> 6, mt = t & 63;
  const int m0 = mt * 256, n0 = nt * 128;
  f32x16 acc[2][2];
  acc_zero(acc);
  gemm_main((const u16*)(P.ws + OFF_R2) + (size_t)m0 * 1024, 1024,
            (const u16*)(P.ws + OFF_WT_UP) + ((size_t)hh * 2816 + n0) * 1024, 1024, 1024, acc, (u16*)lds);
  TILE_COORDS
  u16* UPH = (u16*)(P.ws + OFF_UPH);
#pragma unroll
  for (int i = 0; i < 2; ++i)
#pragma unroll
    for (int j = 0; j < 2; ++j)
#pragma unroll
      for (int e = 0; e < 16; ++e) UPH[TIDX(m0, n0, i, j, e, 2816)] = f2bf(acc[i][j][e]);
}

#define CG_LD(ci, dy)                                                                       \
    {                                                                                       \
      const int xc = x0 - 1 + (ci);                                                         \
      const bool cok = (xc >= 0) && (xc <= 63);                                             \
      const bool rok = ((dy) == 1) || ((dy) == 0 ? r0ok : r2ok);                            \
      const int yy = rok ? (y + (dy) - 1) : y;                                              \
      const u16* src = UPH + (base + (size_t)yy * 64 + (cok ? xc : x0)) * 2816 + c4;        \
      uint2 g__ = *(const uint2*)src;                                                       \
      uint2 v__ = *(const uint2*)(src + 1408);                                              \
      const bool ok = cok && rok;                                                           \
      g__.x = ok ? g__.x : 0u; g__.y = ok ? g__.y : 0u;                                     \
      v__.x = ok ? v__.x : 0u; v__.y = ok ? v__.y : 0u;                                     \
      gg[ci][dy] = g__; vv[ci][dy] = v__;                                                   \
    }
__device__ __forceinline__ void convgate_item(const Params& P, int item, int hh) {
  const int tid = opq(threadIdx.x);
  if (tid >= 352) return;
  const int xo = item & 15, y = (item >> 4) & 63, b = item >> 10;
  const int c4 = tid * 4;
  const u16* UPH = (const u16*)(P.ws + OFF_UPH);
  u16* G = (u16*)(P.ws + OFF_G);
  const size_t base = (size_t)b * 4096;
  const bool r0ok = (y > 0), r2ok = (y < 63);
  const int x0 = xo * 4;
  uint2 gg[6][3], vv[6][3];
#pragma unroll
  for (int ci = 0; ci < 6; ++ci) {
    CG_LD(ci, 0)
    CG_LD(ci, 1)
    CG_LD(ci, 2)
  }
  float wg[9][4], wv[9][4];
#pragma unroll
  for (int k = 0; k < 9; ++k) {
    const float4 a = *(const float4*)(P.ffn_conv_w + (size_t)k * 5632 + hh * 1408 + c4);
    const float4 bq = *(const float4*)(P.ffn_conv_w + (size_t)k * 5632 + 2816 + hh * 1408 + c4);
    wg[k][0] = a.x; wg[k][1] = a.y; wg[k][2] = a.z; wg[k][3] = a.w;
    wv[k][0] = bq.x; wv[k][1] = bq.y; wv[k][2] = bq.z; wv[k][3] = bq.w;
  }
#pragma unroll
  for (int xx = 0; xx < 4; ++xx) {
    float ag[4] = {0.f, 0.f, 0.f, 0.f}, av[4] = {0.f, 0.f, 0.f, 0.f};
#pragma unroll
    for (int dy = 0; dy < 3; ++dy)
#pragma unroll
      for (int dx = 0; dx < 3; ++dx) {
        const uint2 gq = gg[xx + dx][dy], vq = vv[xx + dx][dy];
        const int k = dy * 3 + dx;
        ag[0] += wg[k][0] * lo16(gq.x); ag[1] += wg[k][1] * hi16(gq.x); ag[2] += wg[k][2] * lo16(gq.y); ag[3] += wg[k][3] * hi16(gq.y);
        av[0] += wv[k][0] * lo16(vq.x); av[1] += wv[k][1] * hi16(vq.x); av[2] += wv[k][2] * lo16(vq.y); av[3] += wv[k][3] * hi16(vq.y);
      }
    uint2 o;
    o.x = pack2(ag[0] * sigm(ag[0]) * av[0], ag[1] * sigm(ag[1]) * av[1]);
    o.y = pack2(ag[2] * sigm(ag[2]) * av[2], ag[3] * sigm(ag[3]) * av[3]);
    *(uint2*)(G + (base + y * 64 + x0 + xx) * 2816 + hh * 1408 + c4) = o;
  }
}
#undef CG_LD

__device__ __forceinline__ void down_tile(const Params& P, int t, char* lds) {
  const int nt = t >> 6, mt = t & 63;
  const int m0 = mt * 256, n0 = nt * 128;
  f32x16 acc[2][2];
  acc_zero(acc);
  gemm_main((const u16*)(P.ws + OFF_G) + (size_t)m0 * 2816, 2816, (const u16*)(P.ws + OFF_WT_DOWN) + (size_t)n0 * 2816, 2816, 2816, acc, (u16*)lds);
  TILE_COORDS
  const float* MOD = (const float*)(P.ws + OFF_MOD) + (m0 >> 12) * 6144 + 5 * 1024;
  float xv[2][2][16];
#pragma unroll
  for (int j = 0; j < 2; ++j)
#pragma unroll
    for (int i = 0; i < 2; ++i)
#pragma unroll
      for (int e = 0; e < 16; ++e) xv[i][j][e] = P.out[TIDX(m0, n0, i, j, e, 1024)];
#pragma unroll
  for (int j = 0; j < 2; ++j) {
    const int col = TCOL(n0, j);
    const float gate = MOD[col];
#pragma unroll
    for (int i = 0; i < 2; ++i)
#pragma unroll
      for (int e = 0; e < 16; ++e) P.out[TIDX(m0, n0, i, j, e, 1024)] = xv[i][j][e] + gate * acc[i][j][e];
  }
}

__device__ __forceinline__ void final_item(const Params& P, int item) {
  const int lane = opq(threadIdx.x) & 63, w = opq(threadIdx.x) >> 6;
  const int row = item * 8 + w;
  float* xr = P.out + (size_t)row * 1024;
  float4 v[4];
  float ss = 0.f;
#pragma unroll
  for (int it = 0; it < 4; ++it) {
    v[it] = *(const float4*)(xr + (it * 64 + lane) * 4);
    ss += v[it].x * v[it].x + v[it].y * v[it].y + v[it].z * v[it].z + v[it].w * v[it].w;
  }
  ss = wsum64(ss);
  const float rstd = rsqrtf(ss * (1.f / 1024.f) + 1e-6f);
#pragma unroll
  for (int it = 0; it < 4; ++it) {
    const int c = (it * 64 + lane) * 4;
    const float4 w4 = *(const float4*)(P.norm_f_w + c);
    float4 o;
    o.x = v[it].x * rstd * w4.x; o.y = v[it].y * rstd * w4.y; o.z = v[it].z * rstd * w4.z; o.w = v[it].w * rstd * w4.w;
    *(float4*)(xr + c) = o;
  }
}

__device__ __forceinline__ void run_phase(const Params& P, int ph, char* lds) {
  const int bid = blockIdx.x, nb = gridDim.x;
#ifdef ONLY_PHASE
  if (ph != ONLY_PHASE) return;
#endif
  switch (ph) {
    case 0: {
      for (int it = bid; it < 984 + 192 + 2048; it += nb) {
        if (it < 296) convert_item(P.w_in, 1024, 4624, (u16*)(P.ws + OFF_WT_IN), 0, it, lds);
        else if (it < 328) convert_item(P.w_a_out, 512, 1024, (u16*)(P.ws + OFF_WT_AOUT), 1, it - 296, lds);
        else if (it < 360) convert_item(P.w_glu, 512, 1024, (u16*)(P.ws + OFF_WT_GLU), 2, it - 328, lds);
        else if (it < 392) convert_item(P.w_b_out, 512, 1024, (u16*)(P.ws + OFF_WT_BOUT), 3, it - 360, lds);
        else if (it < 456) convert_item(P.w_o, 1024, 1024, (u16*)(P.ws + OFF_WT_O), 4, it - 392, lds);
        else if (it < 808) convert_item(P.w_up, 1024, 5632, (u16*)(P.ws + OFF_WT_UP), 5, it - 456, lds);
        else if (it < 984) convert_item(P.w_down, 2816, 1024, (u16*)(P.ws + OFF_WT_DOWN), 6, it - 808, lds);
        else if (it < 1176) mod_item(P, it - 984, lds);
        else s5tab_item(P, it - 1176, lds);
      }
    } break;
    case 1:
      for (int it = bid; it < 2176 + 2048; it += nb) {
        if (it < 2176) norm1_item(P, it); else mintra_item(P, it - 2176);
      }
      break;
    case 2:
      for (int it = bid; it < 1396; it += nb) inproj_tile(P, it, lds);
      break;
    case 3:
      for (int it = bid; it < 1088 + 192; it += nb) {
        if (it < 1088) delta_prep_item(P, it, lds); else s5end_tile(P, it - 1088, lds);
      }
      break;
    case 4:
      if (bid < 128) delta_scan_block(P, bid, lds);
      else if (bid < 160) s5_carry_block(P, bid - 128);
      break;
    case 5:
      for (int it = bid; it < 256 + 2048 + 2048; it += nb) {
        if (it < 256) s5out_tile(P, it, lds);
        else if (it < 2304) delta_post_item(P, it - 256);
        else norm1_item(P, it - 2304);
      }
      break;
    case 6:
      for (int it = bid; it < 512 + 1024; it += nb) {
        if (it < 512) glu_tile(P, it, lds); else gates_tile(P, it - 512, lds);
      }
      break;
    case 7:
      for (int it = bid; it < 512; it += nb) mix_tile(P, it, lds);
      break;
    case 8:
      for (int it = bid; it < 512; it += nb) wo_tile(P, it, lds);
      break;
    case 9:
      for (int it = bid; it < 2048; it += nb) norm2_item(P, it);
      break;
    case 10:
      for (int it = bid; it < 1408; it += nb) up_tile(P, it, 0, lds);
      break;
    case 11:
      for (int it = bid; it < 4096; it += nb) convgate_item(P, it, 0);
      break;
    case 12:
      for (int it = bid; it < 1408; it += nb) up_tile(P, it, 1, lds);
      break;
    case 13:
      for (int it = bid; it < 4096; it += nb) convgate_item(P, it, 1);
      break;
    case 14:
      for (int it = bid; it < 512; it += nb) down_tile(P, it, lds);
      break;
    case 15:
      for (int it = bid; it < 2048; it += nb) final_item(P, it);
      break;
    default: break;
  }
}

typedef const __attribute__((address_space(4))) Params* KParamsPtr;
__global__ void __launch_bounds__(NT) fwd_megakernel(Params Pk) {
#if defined(__HIP_DEVICE_COMPILE__)
  extern __shared__ __attribute__((aligned(16))) char lds[];
  KParamsPtr pp = (KParamsPtr)__builtin_amdgcn_kernarg_segment_ptr();
  const int lo = (int)pp->ph_lo, hi = (int)pp->ph_hi;
#if MULTI_LAUNCH
  for (int ph = lo; ph < hi; ++ph) { KParamsPtr q = pp; asm volatile("" : "+s"(q)); Params P; for (int i_ = 0; i_ < (int)(sizeof(Params) / 8); ++i_) ((unsigned long long*)&P)[i_] = ((const __attribute__((address_space(4))) unsigned long long*)q)[i_]; run_phase(P, ph, lds); }
#else
  cg::grid_group grid = cg::this_grid();
  volatile LAS unsigned* xst = (volatile LAS unsigned*)(lds + (LDS_BYTES - 16));
  if (threadIdx.x == 0) { xst[0] = 0u; xst[1] = 0u; xst[2] = 0u; xst[3] = 0u; }
  __syncthreads();
  XcdBarrier xb = xcd_barrier_post((unsigned*)(pp->ws + OFF_BAR), xst);
  const unsigned rep_mask = (unsigned)pp->rep_mask;
  bool first_sync = true;
  for (int ph = lo; ph < hi; ++ph) {
    const int reps = 1 + (int)((rep_mask >> ph) & 1u);
    for (int rp = 0; rp < reps; ++rp) {
      {
        KParamsPtr q = pp;
        asm volatile("" : "+s"(q));
        Params P;
        {
          typedef __attribute__((address_space(1))) const float* GF;
          const float** dp = (const float**)&P;
          const __attribute__((address_space(4))) unsigned long long* sp = (const __attribute__((address_space(4))) unsigned long long*)q;
#pragma unroll
          for (int i_ = 0; i_ < 30; ++i_) dp[i_] = (const float*)(GF)(sp[i_]);
          P.out = (float*)(__attribute__((address_space(1))) float*)(sp[30]);
          P.ws = (char*)(__attribute__((address_space(1))) char*)(sp[31]);
          P.ph_lo = 0; P.ph_hi = 0; P.rep_mask = 0;
        }
        run_phase(P, ph, lds);
      }
      if (ph + 1 < hi || rp + 1 < reps) {
        if (first_sync) { grid.sync(); first_sync = false; }
        else xcd_barrier(xb);
      }
    }
  }
#endif
#endif
}

extern "C" void kernel_launch(void* const* d_in, const int* in_sizes, int n_in, void* d_out, int out_size, void* d_ws,
                              size_t ws_size, hipStream_t stream) {
  static int grid_blocks = 0;
  if (grid_blocks == 0) {
    if (n_in != 30 || out_size != 16384 * 1024 || ws_size < WS_NEED) {
      fprintf(stderr, "kernel_launch: unexpected shapes: n_in %d out %d ws %zu (need %zu)\n", n_in, out_size, ws_size, (size_t)WS_NEED);
      grid_blocks = -1;
      return;
    }
    int dev = 0, cus = 0, per_cu = 0;
    hipGetDevice(&dev);
    hipDeviceGetAttribute(&cus, hipDeviceAttributeMultiprocessorCount, dev);
    if (hipFuncSetAttribute((const void*)fwd_megakernel, hipFuncAttributeMaxDynamicSharedMemorySize, LDS_BYTES) != hipSuccess) {
      fprintf(stderr, "kernel_launch: hipFuncSetAttribute failed\n");
      grid_blocks = -1;
      return;
    }
    if (hipOccupancyMaxActiveBlocksPerMultiprocessor(&per_cu, (const void*)fwd_megakernel, NT, LDS_BYTES) != hipSuccess || per_cu < 1) {
      fprintf(stderr, "kernel_launch: occupancy query failed / zero (%d)\n", per_cu);
      grid_blocks = -1;
      return;
    }
    grid_blocks = cus;
    if (grid_blocks < 64) { fprintf(stderr, "kernel_launch: too few CUs (%d)\n", cus); grid_blocks = -1; return; }
  }
  if (grid_blocks < 0) return;
  (void)hipMemsetAsync((char*)d_ws + OFF_BAR, 0, XCD_BAR_WORDS * sizeof(unsigned), stream);
  Params p{};
  const float** pp = (const float**)&p;
  for (int i = 0; i < 30; ++i) pp[i] = (const float*)d_in[i];
  p.out = (float*)d_out;
  p.ws = (char*)d_ws;
#if MULTI_LAUNCH
  for (int ph = 0; ph < 16; ++ph) {
    p.ph_lo = ph; p.ph_hi = ph + 1;
    hipLaunchKernelGGL(fwd_megakernel, dim3(grid_blocks), dim3(NT), LDS_BYTES, stream, p);
  }
#else
  p.ph_lo = 0; p.ph_hi = 16;
#ifdef REPEAT_MASK
  p.rep_mask = REPEAT_MASK;
#endif
  void* args[] = {&p};
  hipError_t e = hipLaunchCooperativeKernel((const void*)fwd_megakernel, dim3(grid_blocks), dim3(NT), args, LDS_BYTES, stream);
  if (e != hipSuccess) fprintf(stderr, "cooperative launch failed: %s (grid %d)\n", hipGetErrorString(e), grid_blocks);
#endif
}
```

```cpp
#include <hip/hip_runtime.h>
#include <hip/hip_cooperative_groups.h>
#include <cstdio>
#include <cstdint>
namespace cg = cooperative_groups;

#ifndef MULTI_LAUNCH
#define MULTI_LAUNCH 0
#endif

typedef unsigned short u16;
typedef __attribute__((ext_vector_type(8))) short bf16x8;
typedef __attribute__((ext_vector_type(4))) float f32x4;
typedef __attribute__((ext_vector_type(16))) float f32x16;

#define NT 512
constexpr int LDS_BYTES = 131072 + 1024;
constexpr int NPHASE = 18;

constexpr size_t OFF_WT_IN   = 0;
constexpr size_t OFF_WT_AOUT = 9699328;
constexpr size_t OFF_WT_GLU  = 10747904;
constexpr size_t OFF_WT_BOUT = 11796480;
constexpr size_t OFF_WT_O    = 12845056;
constexpr size_t OFF_WT_UP   = 14942208;
constexpr size_t OFF_WT_DOWN = 26476544;
constexpr size_t OFF_MOD     = 32243712;
constexpr size_t OFF_BAR     = 32505856;
constexpr size_t OFF_R2      = 33554432;
constexpr size_t OFF_R1      = 69206016;
constexpr size_t OFF_KTAB    = OFF_R1;
constexpr size_t OFF_MEND    = OFF_R1 + 2097152;
constexpr size_t OFF_MST     = OFF_R1 + 10485760;
constexpr size_t OFF_MINTRA  = OFF_R1 + 18874368;
constexpr size_t OFF_R3      = 104857600;
constexpr size_t OFF_O       = OFF_R3;
constexpr size_t OFF_XIN     = OFF_R3 + 33554432;
constexpr size_t OFF_MIX     = 158334976;
constexpr size_t OFF_SG      = OFF_R1;
constexpr size_t OFF_Z       = 158334976;
constexpr size_t OFF_U5      = 175112192;
constexpr size_t OFF_BA      = 192937984;
constexpr size_t OFF_GC      = OFF_BA + 1179648;
constexpr size_t OFF_UF      = 195035136;
constexpr size_t OFF_YA      = OFF_UF;
constexpr size_t OFF_YB      = OFF_UF + 16777216;
constexpr size_t OFF_E       = 230686720;
constexpr size_t OFF_YG      = OFF_E;
constexpr size_t OFF_UPH     = OFF_R1;
constexpr size_t OFF_G       = 161480704;
constexpr size_t WS_NEED     = 253755392;
constexpr size_t OFF_QKN     = 0;
constexpr size_t OFF_AQ      = 35651584;

struct Params {
  const float *x, *c, *ctx, *c_ctx, *w_ada, *b_ada, *norm1_w, *w_in, *dn_conv_w, *dn_a_log, *dn_dt_bias, *dn_norm_w,
      *w_a_out, *s5_a_re, *s5_a_im, *s5_log_step, *s5_b_re, *s5_b_im, *s5_c_re, *s5_c_im, *s5_d, *w_glu, *b_glu,
      *w_b_out, *w_o, *norm2_w, *w_up, *ffn_conv_w, *w_down, *norm_f_w;
  float* out;
  char* ws;
  long long ph_lo, ph_hi;
  long long rep_mask;
};

#define XB_TMO      128
#define XB_XCNT(j)  (256  + 64 * (j))
#define XB_XSUB(j)  (1280 + 64 * (j))
#define XB_XGEN(j)  (2304 + 64 * (j))
#define XB_TOP      3328
#define XB_TOPGEN   3392
#define XCD_BAR_WORDS 3456
#define XB_SPIN_CAP (1u << 18)
#define LAS __attribute__((address_space(3)))

__device__ __forceinline__ unsigned xb_ld(unsigned* p)              { return __hip_atomic_load(p, __ATOMIC_RELAXED, __HIP_MEMORY_SCOPE_AGENT); }
__device__ __forceinline__ unsigned xb_add(unsigned* p, unsigned v) { return __hip_atomic_fetch_add(p, v, __ATOMIC_RELAXED, __HIP_MEMORY_SCOPE_AGENT); }
__device__ __forceinline__ unsigned xb_xcc_id() { return (unsigned)__builtin_amdgcn_s_getreg((3 << 11) | 20) & 0xFu; }
#define XB_SPIN(cond, bar) do { unsigned _sp = 0; while (cond) { __builtin_amdgcn_s_sleep(1); \
    if ((++_sp & 255u) == 0u) { if (xb_ld(&(bar)[XB_TMO])) break; if (_sp > XB_SPIN_CAP) { atomicAdd(&(bar)[XB_TMO], 1u); break; } } } } while (0)

struct XcdBarrier {
    unsigned* bar; unsigned x;
    volatile LAS unsigned* st;
};

__device__ __forceinline__ XcdBarrier xcd_barrier_post(unsigned* bar, volatile LAS unsigned* st) {
    XcdBarrier b; b.bar = bar; b.x = xb_xcc_id(); b.st = st;
    if (threadIdx.x == 0) (void)xb_add(&bar[XB_XCNT(b.x)], 1u);
    return b;
}
__device__ __forceinline__ void xcd_barrier_complete(unsigned* bar, unsigned x, unsigned& nloc, unsigned& nx) {
    const unsigned G = gridDim.x * gridDim.y * gridDim.z;
    unsigned sum, cnt, mine, sp = 0u;
    for (;;) {
        sum = 0u; cnt = 0u; mine = 0u;
#pragma unroll
        for (unsigned j = 0; j < 16; ++j) { const unsigned c = xb_ld(&bar[XB_XCNT(j)]); sum += c; cnt += (c > 0u) ? 1u : 0u; mine = (j == x) ? c : mine; }
        if (sum == G) break;
        __builtin_amdgcn_s_sleep(1);
        if ((++sp & 255u) == 0u) { if (xb_ld(&bar[XB_TMO])) break; if (sp > XB_SPIN_CAP) { atomicAdd(&bar[XB_TMO], 1u); break; } }
    }
    nloc = mine > 0u ? mine : 1u; nx = cnt > 0u ? cnt : 1u;
}

__device__ __forceinline__ void xcd_barrier(const XcdBarrier& b) {
    asm volatile("s_waitcnt vmcnt(0)" ::: "memory");
    __syncthreads();
    if (threadIdx.x == 0) {
        unsigned* bar = b.bar;
        __builtin_amdgcn_s_waitcnt(0);
        unsigned nloc = b.st[0], nx = b.st[1];
        if (nloc == 0u) { xcd_barrier_complete(bar, b.x, nloc, nx); b.st[0] = nloc; b.st[1] = nx; }
        const unsigned old = xb_add(&bar[XB_XSUB(b.x)], 1u);
        const unsigned gen = old / nloc;
        if (old + 1u == (gen + 1u) * nloc) {
            __builtin_amdgcn_fence(__ATOMIC_RELEASE, "agent");
            asm volatile("s_waitcnt vmcnt(0)" ::: "memory");
            const unsigned og = xb_add(&bar[XB_TOP], 1u);
            const unsigned tg = og / nx;
            if (og + 1u == (tg + 1u) * nx) xb_add(&bar[XB_TOPGEN], 1u);
            else XB_SPIN(xb_ld(&bar[XB_TOPGEN]) == tg, bar);
            __builtin_amdgcn_fence(__ATOMIC_ACQUIRE, "agent");
            xb_add(&bar[XB_XGEN(b.x)], 1u);
            asm volatile("s_waitcnt vmcnt(0)" ::: "memory");
        } else {
            XB_SPIN(xb_ld(&bar[XB_XGEN(b.x)]) == gen, bar);
            __builtin_amdgcn_fence(__ATOMIC_ACQUIRE, "agent");
            asm volatile("s_waitcnt vmcnt(0)" ::: "memory");
        }
    }
    __syncthreads();
}


typedef __attribute__((ext_vector_type(2))) float f32x2_t;
typedef __attribute__((ext_vector_type(2))) __bf16 bf16x2_t;
__device__ __forceinline__ u16 f2bf(float f) {
  const __bf16 h = (__bf16)f;
  return __builtin_bit_cast(u16, h);
}
__device__ __forceinline__ float bf2f(u16 h) { return __uint_as_float(((uint32_t)h) << 16); }
__device__ __forceinline__ uint32_t pack2(float a, float b) {
  const f32x2_t v = {a, b};
  const bf16x2_t r = __builtin_convertvector(v, bf16x2_t);
  return __builtin_bit_cast(uint32_t, r);
}
__device__ __forceinline__ float lo16(uint32_t w) { return __uint_as_float(w << 16); }
__device__ __forceinline__ float hi16(uint32_t w) { return __uint_as_float(w & 0xffff0000u); }
__device__ __forceinline__ int opq(int v) { asm volatile("" : "+v"(v)); return v; }
__device__ __forceinline__ float sigm(float x) { return 1.f / (1.f + __expf(-x)); }
__device__ __forceinline__ void unpack8(uint4 v, float* f) {
  f[0] = lo16(v.x); f[1] = hi16(v.x); f[2] = lo16(v.y); f[3] = hi16(v.y);
  f[4] = lo16(v.z); f[5] = hi16(v.z); f[6] = lo16(v.w); f[7] = hi16(v.w);
}
__device__ __forceinline__ uint4 pack8(const float* f) {
  uint4 v; v.x = pack2(f[0], f[1]); v.y = pack2(f[2], f[3]); v.z = pack2(f[4], f[5]); v.w = pack2(f[6], f[7]);
  return v;
}
__device__ __forceinline__ float wsum64(float v) {
#pragma unroll
  for (int o = 32; o > 0; o >>= 1) v += __shfl_xor(v, o, 64);
  return v;
}
__device__ __forceinline__ float gelu_tanh(float x) {
  float u = 0.7978845608028654f * (x + 0.044715f * x * x * x);
  float t = 1.f - 2.f / (1.f + __expf(2.f * u));
  return 0.5f * x * (1.f + t);
}

__device__ __forceinline__ void g_frag(const u16* as, const u16* bs, int ks, bf16x8 (&a)[2], bf16x8 (&b)[2]) {
  a[0] = *(const bf16x8*)(as + ks * 16);
  a[1] = *(const bf16x8*)(as + 32 * 72 + ks * 16);
  b[0] = *(const bf16x8*)(bs + ks * 16);
  b[1] = *(const bf16x8*)(bs + 32 * 72 + ks * 16);
}
__device__ __forceinline__ void g_mma(const bf16x8 (&a)[2], const bf16x8 (&b)[2], f32x16 (&acc)[2][2]) {
  acc[0][0] = __builtin_amdgcn_mfma_f32_32x32x16_bf16(a[0], b[0], acc[0][0], 0, 0, 0);
  acc[0][1] = __builtin_amdgcn_mfma_f32_32x32x16_bf16(a[0], b[1], acc[0][1], 0, 0, 0);
  acc[1][0] = __builtin_amdgcn_mfma_f32_32x32x16_bf16(a[1], b[0], acc[1][0], 0, 0, 0);
  acc[1][1] = __builtin_amdgcn_mfma_f32_32x32x16_bf16(a[1], b[1], acc[1][1], 0, 0, 0);
}
__device__ __forceinline__ void gemm_main(const u16* __restrict__ A, int lda, const u16* __restrict__ Bt, int ldb, int K,
                                          f32x16 (&acc)[2][2], u16* lds) {
  const int tid = opq(threadIdx.x), lane = tid & 63, w = tid >> 6, wm = w >> 1, wn = w & 1, fr = lane & 31, fq = lane >> 5;
  u16* As = lds;
  u16* Bs = lds + 2 * 256 * 72;
  const int nk = K >> 6;
  uint4 p0, p1, p2, p3, p4, p5;
  uint4 q0, q1, q2, q3, q4, q5;
  uint4 r0, r1, r2, r3, r4, r5;
  const int lr = tid >> 3, lc = (tid & 7) * 8;
  const unsigned oa0 = (unsigned)(lr * lda + lc) * 2u, sa2 = (unsigned)lda * 128u;
  const unsigned oa1 = oa0 + sa2, oa2 = oa0 + 2u * sa2, oa3 = oa0 + 3u * sa2;
  const unsigned ob0 = (unsigned)(lr * ldb + lc) * 2u, ob1 = ob0 + (unsigned)ldb * 128u;
#define G_LOAD(S, kt_)                                          \
  {                                                             \
    const int kc_ = ((kt_) < nk) ? (kt_) : (nk - 1);            \
    const char* a_ = (const char*)A + kc_ * 128;                \
    const char* b_ = (const char*)Bt + kc_ * 128;               \
    S##0 = *(const uint4*)(a_ + oa0);                           \
    S##1 = *(const uint4*)(a_ + oa1);                           \
    S##2 = *(const uint4*)(a_ + oa2);                           \
    S##3 = *(const uint4*)(a_ + oa3);                           \
    S##4 = *(const uint4*)(b_ + ob0);                           \
    S##5 = *(const uint4*)(b_ + ob1);                           \
  }
#define G_STORE(S, buf_)                                                     \
  {                                                                          \
    u16* as_ = As + ((buf_) * 256 + lr) * 72 + lc;                           \
    u16* bs_ = Bs + ((buf_) * 128 + lr) * 72 + lc;                           \
    *(uint4*)(as_) = S##0;                                                   \
    *(uint4*)(as_ + 64 * 72) = S##1;                                         \
    *(uint4*)(as_ + 128 * 72) = S##2;                                        \
    *(uint4*)(as_ + 192 * 72) = S##3;                                        \
    *(uint4*)(bs_) = S##4;                                                   \
    *(uint4*)(bs_ + 64 * 72) = S##5;                                         \
  }
#define G_STEP(S, BUF, kt_)                                                               \
  {                                                                                       \
    const u16* as = As + ((BUF) * 256 + wm * 64 + fr) * 72 + fq * 8;                      \
    const u16* bs = Bs + ((BUF) * 128 + wn * 64 + fr) * 72 + fq * 8;                      \
    bf16x8 fa0[2], fb0[2], fa1[2], fb1[2], fa2[2], fb2[2];                                \
    g_frag(as, bs, 0, fa0, fb0);                                                          \
    g_frag(as, bs, 1, fa1, fb1);                                                          \
    __builtin_amdgcn_sched_barrier(0);                                                    \
    G_STORE(S, (BUF) ^ 1)                                                                 \
    G_LOAD(S, (kt_) + 4)                                                                  \
    __builtin_amdgcn_sched_barrier(0);                                                    \
    g_frag(as, bs, 2, fa2, fb2);                                                          \
    __builtin_amdgcn_sched_barrier(0);                                                    \
    g_mma(fa0, fb0, acc);                                                                 \
    __builtin_amdgcn_sched_barrier(0);                                                    \
    g_frag(as, bs, 3, fa0, fb0);                                                          \
    __builtin_amdgcn_sched_barrier(0);                                                    \
    g_mma(fa1, fb1, acc);                                                                 \
    g_mma(fa2, fb2, acc);                                                                 \
    g_mma(fa0, fb0, acc);                                                                 \
    __syncthreads();                                                                      \
  }
  G_LOAD(p, 0)
  __syncthreads();
  G_STORE(p, 0)
  G_LOAD(q, 1)
  G_LOAD(r, 2)
  G_LOAD(p, 3)
  __syncthreads();
  for (int kt = 0; kt < nk; kt += 6) {
    G_STEP(q, 0, kt)
    G_STEP(r, 1, kt + 1)
    if (kt + 2 < nk) {
      G_STEP(p, 0, kt + 2)
      G_STEP(q, 1, kt + 3)
    }
    if (kt + 4 < nk) {
      G_STEP(r, 0, kt + 4)
      G_STEP(p, 1, kt + 5)
    }
  }
#undef G_STEP
#undef G_LOAD
#undef G_STORE
}

__device__ __forceinline__ void acc_zero(f32x16 (&acc)[2][2]) {
#pragma unroll
  for (int i = 0; i < 2; ++i)
#pragma unroll
    for (int j = 0; j < 2; ++j)
#pragma unroll
      for (int e = 0; e < 16; ++e) acc[i][j][e] = 0.f;
}

#define TILE_COORDS                                                                                  \
  const int tid_ = opq(threadIdx.x), lane_ = tid_ & 63, w_ = __builtin_amdgcn_readfirstlane(tid_ >> 6), \
            wm_ = w_ >> 1, wn_ = w_ & 1, fr_ = lane_ & 31, fq_ = lane_ >> 5;
#define TROW(m0, i, e) ((m0) + wm_ * 64 + (i) * 32 + ((e) & 3) + 8 * ((e) >> 2) + 4 * fq_)
#define TCOL(n0, j) ((n0) + wn_ * 64 + (j) * 32 + fr_)
#define TIDX2(m0, cb, i, e, ld) ((size_t)((m0) + wm_ * 64 + (i) * 32 + ((e) & 3) + 8 * ((e) >> 2)) * (ld) + (cb) + (size_t)(unsigned)(4 * fq_ * (ld) + fr_))
#define TIDX(m0, n0, i, j, e, ld) TIDX2(m0, (n0) + wn_ * 64 + (j) * 32, i, e, ld)

__device__ __forceinline__ int srccol(int which, int r) {
  switch (which) {
    case 0:
      if (r < 2048) return r;
      if (r < 2560) return 2064 + (r - 2048);
      if (r < 2576) return 2048 + (r - 2560);
      if (r < 2688) return -1;
      if (r < 3712) return 2576 + (r - 2688);
      return 3600 + (r - 3712);
    case 2: {
      int tile = r >> 7, wn = (r >> 6) & 1, wi = r & 63;
      return (wi < 32) ? (tile * 64 + wn * 32 + wi) : (512 + tile * 64 + wn * 32 + (wi - 32));
    }
    case 5: {
      int hh = r / 2816, cc = r % 2816;
      return (cc < 1408) ? (hh * 1408 + cc) : (2816 + hh * 1408 + (cc - 1408));
    }
    default: return r;
  }
}

__device__ __forceinline__ void convert_item(const float* __restrict__ src, int K, int N, u16* __restrict__ dst, int which, int item, char* lds) {
  float* tile = (float*)lds;
  const int tid = opq(threadIdx.x);
  const int kb = K >> 8;
  const int r0 = (item / kb) * 64, k0 = (item % kb) * 256;
  __syncthreads();
  {
    const int n4 = (tid & 15) * 4, kk = tid >> 4;
    const int sc = srccol(which, r0 + n4);
    float4 v[8];
#pragma unroll
    for (int it = 0; it < 8; ++it) {
      const int k = kk + 32 * it;
      v[it] = (sc >= 0) ? *(const float4*)(src + (size_t)(k0 + k) * N + sc) : make_float4(0.f, 0.f, 0.f, 0.f);
    }
#pragma unroll
    for (int it = 0; it < 8; ++it) {
      const int k = kk + 32 * it;
      tile[(n4 + 0) * 257 + k] = v[it].x; tile[(n4 + 1) * 257 + k] = v[it].y;
      tile[(n4 + 2) * 257 + k] = v[it].z; tile[(n4 + 3) * 257 + k] = v[it].w;
    }
  }
  __syncthreads();
  {
    const int ks = (tid & 31) * 8, rr = tid >> 5;
#pragma unroll
    for (int it = 0; it < 4; ++it) {
      const int row = rr + 16 * it;
      float f[8];
#pragma unroll
      for (int e = 0; e < 8; ++e) f[e] = tile[row * 257 + ks + e];
      *(uint4*)(dst + (size_t)(r0 + row) * K + k0 + ks) = pack8(f);
    }
  }
}

__device__ __forceinline__ void mod_item(const Params& P, int item, char* lds) {
  float* sc = (float*)lds;
  float* red = sc + 5 * 1024;
  const int tid = opq(threadIdx.x);
  __syncthreads();
  for (int i = tid; i < 5 * 1024; i += NT) {
    const int r = i >> 10, k = i & 1023;
    float v = (r < 4) ? P.c[r * 1024 + k] : P.c_ctx[k];
    sc[i] = v * sigm(v);
  }
  __syncthreads();
  const int nn = tid & 31, kg = tid >> 5;
  const int n = item * 32 + nn;
  float a0 = 0, a1 = 0, a2 = 0, a3 = 0, a4 = 0;
  for (int kk = 0; kk < 64; ++kk) {
    const int k = kg * 64 + kk;
    const float wv = P.w_ada[(size_t)k * 6144 + n];
    a0 += sc[k] * wv; a1 += sc[1024 + k] * wv; a2 += sc[2048 + k] * wv; a3 += sc[3072 + k] * wv; a4 += sc[4096 + k] * wv;
  }
  red[(kg * 5 + 0) * 32 + nn] = a0; red[(kg * 5 + 1) * 32 + nn] = a1; red[(kg * 5 + 2) * 32 + nn] = a2;
  red[(kg * 5 + 3) * 32 + nn] = a3; red[(kg * 5 + 4) * 32 + nn] = a4;
  __syncthreads();
  if (tid < 160) {
    const int r = tid >> 5, n2 = tid & 31;
    float s = 0.f;
#pragma unroll
    for (int g = 0; g < 16; ++g) s += red[(g * 5 + r) * 32 + n2];
    float* MOD = (float*)(P.ws + OFF_MOD);
    MOD[r * 6144 + item * 32 + n2] = s + P.b_ada[item * 32 + n2];
  }
}

__device__ __forceinline__ void lam_pow(float step, float are, float aim, int e, float& pr, float& pi) {
  const float mag = expf((float)e * step * are);
  double ang = (double)e * (double)step * (double)aim;
  ang -= 6.283185307179586476925 * rint(ang * 0.15915494309189533577);
  float s, c;
  __sincosf((float)ang, &s, &c);
  pr = mag * c; pi = mag * s;
}

__device__ __forceinline__ void s5tab_item(const Params& P, int item, char* lds) {
  const int tid = opq(threadIdx.x);
  const int tau = item & 31, g = (item >> 5) & 31, r = item >> 10;
  float* cfr = (float*)lds;
  float* cfi = cfr + 64;
  float* p0r = cfi + 64;
  float* p0i = p0r + 64;
  float* p1r = p0i + 64;
  float* p1i = p1r + 64;
  float* Gr = p1i + 64;
  float* Gi = Gr + 1024;
  float* Cr = Gi + 1024;
  float* Ci = Cr + 1024;
  const int rg = r * 32 + g;
  __syncthreads();
  if (tid < 64) {
    const int n = tid;
    const float step = expf(P.s5_log_step[rg]);
    const float are = P.s5_a_re[rg * 64 + n], aim = P.s5_a_im[rg * 64 + n];
    const float za = step * are;
    double zb = (double)step * (double)aim;
    zb -= 6.283185307179586476925 * rint(zb * 0.15915494309189533577);
    float sb, cb, sh, ch;
    __sincosf((float)zb, &sb, &cb);
    __sincosf((float)(0.5 * zb), &sh, &ch);
    const float em1 = expm1f(za);
    const float re1 = em1 * cb - 2.f * sh * sh;
    const float im1 = (1.f + em1) * sb;
    const float den = are * are + aim * aim;
    cfr[n] = (re1 * are + im1 * aim) / den;
    cfi[n] = (im1 * are - re1 * aim) / den;
    float pr, pi;
    lam_pow(step, are, aim, tau, pr, pi);
    p0r[n] = pr; p0i[n] = pi;
    lam_pow(step, are, aim, tau + 1, pr, pi);
    p1r[n] = pr; p1i[n] = pi;
  }
  for (int i = tid; i < 1024; i += NT) {
    Cr[i] = P.s5_c_re[(size_t)rg * 1024 + i];
    Ci[i] = P.s5_c_im[(size_t)rg * 1024 + i];
  }
  __syncthreads();
  for (int i = tid; i < 1024; i += NT) {
    const int n = i >> 4;
    const float br = P.s5_b_re[(size_t)rg * 1024 + i], bi = P.s5_b_im[(size_t)rg * 1024 + i];
    const float tr = cfr[n] * br - cfi[n] * bi, ti = cfr[n] * bi + cfi[n] * br;
    Gr[i] = p0r[n] * tr - p0i[n] * ti;
    Gi[i] = p0r[n] * ti + p0i[n] * tr;
  }
  __syncthreads();
  u16* MEND = (u16*)(P.ws + OFF_MEND);
  u16* MST = (u16*)(P.ws + OFF_MST);
  float* KTAB = (float*)(P.ws + OFF_KTAB);
  {
    const int ii = (r == 0) ? (31 - tau) : tau;
    for (int i = tid; i < 2048; i += NT) {
      const int part = i >> 10, n = (i >> 4) & 63, pi_ = i & 15;
      const float v = part ? Gi[n * 16 + pi_] : Gr[n * 16 + pi_];
      MEND[((size_t)g * 256 + r * 128 + part * 64 + n) * 512 + ii * 16 + pi_] = f2bf(v);
    }
  }
  if (tid < 256) {
    const int po = tid >> 4, pi_ = tid & 15;
    float s = 0.f;
    for (int n = 0; n < 64; ++n) s += Cr[po * 64 + n] * Gr[n * 16 + pi_] - Ci[po * 64 + n] * Gi[n * 16 + pi_];
    KTAB[(((size_t)rg) * 32 + tau) * 256 + tid] = s;
  }
  {
    const int jj = (r == 0) ? tau : (31 - tau);
    for (int i = tid; i < 2048; i += NT) {
      const int po = i >> 7, part = (i >> 6) & 1, n = i & 63;
      const float cr = Cr[po * 64 + n], ci = Ci[po * 64 + n];
      const float v = part ? -(cr * p1i[n] + ci * p1r[n]) : (cr * p1r[n] - ci * p1i[n]);
      MST[((size_t)g * 512 + jj * 16 + po) * 256 + r * 128 + part * 64 + n] = f2bf(v);
    }
  }
}

__device__ __forceinline__ void norm_row(const float* __restrict__ xr, const float* __restrict__ nw, const float* __restrict__ shift,
                                         const float* __restrict__ scale, u16* __restrict__ dst, int lane) {
  float4 v[4];
  float ss = 0.f;
#pragma unroll
  for (int it = 0; it < 4; ++it) {
    v[it] = *(const float4*)(xr + (it * 64 + lane) * 4);
    ss += v[it].x * v[it].x + v[it].y * v[it].y + v[it].z * v[it].z + v[it].w * v[it].w;
  }
  ss = wsum64(ss);
  const float rstd = rsqrtf(ss * (1.f / 1024.f) + 1e-6f);
#pragma unroll
  for (int it = 0; it < 4; ++it) {
    const int c = (it * 64 + lane) * 4;
    const float4 w4 = *(const float4*)(nw + c), sh = *(const float4*)(shift + c), sc = *(const float4*)(scale + c);
    const float y0 = v[it].x * rstd * w4.x * (1.f + sc.x) + sh.x;
    const float y1 = v[it].y * rstd * w4.y * (1.f + sc.y) + sh.y;
    const float y2 = v[it].z * rstd * w4.z * (1.f + sc.z) + sh.z;
    const float y3 = v[it].w * rstd * w4.w * (1.f + sc.w) + sh.w;
    uint2 o; o.x = pack2(y0, y1); o.y = pack2(y2, y3);
    *(uint2*)(dst + c) = o;
  }
}

__device__ __forceinline__ void norm_row2(const float* __restrict__ xa, const float* __restrict__ xb, const float* __restrict__ nw,
                                          const float* __restrict__ shA, const float* __restrict__ scA,
                                          const float* __restrict__ shB, const float* __restrict__ scB,
                                          u16* __restrict__ da, u16* __restrict__ db, int lane) {
  float4 va[4], vb[4];
#pragma unroll
  for (int it = 0; it < 4; ++it) { va[it] = *(const float4*)(xa + (it * 64 + lane) * 4); vb[it] = *(const float4*)(xb + (it * 64 + lane) * 4); }
  float sa = 0.f, sb = 0.f;
#pragma unroll
  for (int it = 0; it < 4; ++it) {
    sa += va[it].x * va[it].x + va[it].y * va[it].y + va[it].z * va[it].z + va[it].w * va[it].w;
    sb += vb[it].x * vb[it].x + vb[it].y * vb[it].y + vb[it].z * vb[it].z + vb[it].w * vb[it].w;
  }
  sa = wsum64(sa); sb = wsum64(sb);
  const float ra = rsqrtf(sa * (1.f / 1024.f) + 1e-6f), rb = rsqrtf(sb * (1.f / 1024.f) + 1e-6f);
#pragma unroll
  for (int it = 0; it < 4; ++it) {
    const int c = (it * 64 + lane) * 4;
    const float4 w4 = *(const float4*)(nw + c);
    const float4 sh = *(const float4*)(shA + c), sc = *(const float4*)(scA + c);
    const float4 sh2 = *(const float4*)(shB + c), sc2 = *(const float4*)(scB + c);
    uint2 o;
    o.x = pack2(va[it].x * ra * w4.x * (1.f + sc.x) + sh.x, va[it].y * ra * w4.y * (1.f + sc.y) + sh.y);
    o.y = pack2(va[it].z * ra * w4.z * (1.f + sc.z) + sh.z, va[it].w * ra * w4.w * (1.f + sc.w) + sh.w);
    *(uint2*)(da + c) = o;
    o.x = pack2(vb[it].x * rb * w4.x * (1.f + sc2.x) + sh2.x, vb[it].y * rb * w4.y * (1.f + sc2.y) + sh2.y);
    o.y = pack2(vb[it].z * rb * w4.z * (1.f + sc2.z) + sh2.z, vb[it].w * rb * w4.w * (1.f + sc2.w) + sh2.w);
    *(uint2*)(db + c) = o;
  }
}

__device__ __forceinline__ void norm1_item(const Params& P, int item) {
  const int lane = opq(threadIdx.x) & 63, w = opq(threadIdx.x) >> 6;
  const int rowA = item * 16 + w, rowB = rowA + 8;
  const float* MOD = (const float*)(P.ws + OFF_MOD);
  const int ba = (rowA < 16384) ? (rowA >> 12) : 4, bb = (rowB < 16384) ? (rowB >> 12) : 4;
  const float* xa = (rowA < 16384) ? (P.x + (size_t)rowA * 1024) : (P.ctx + (size_t)(rowA - 16384) * 1024);
  const float* xb = (rowB < 16384) ? (P.x + (size_t)rowB * 1024) : (P.ctx + (size_t)(rowB - 16384) * 1024);
  u16* H = (u16*)(P.ws + OFF_R2);
  norm_row2(xa, xb, P.norm1_w, MOD + ba * 6144, MOD + ba * 6144 + 1024, MOD + bb * 6144, MOD + bb * 6144 + 1024,
            H + (size_t)rowA * 1024, H + (size_t)rowB * 1024, lane);
}

__device__ __forceinline__ void mintra_item(const Params& P, int item) {
  const int tid = opq(threadIdx.x);
  const int rowg = item * 8 + (tid >> 6);
  const int g = rowg >> 9, nout = rowg & 511, j = nout >> 4, po = nout & 15;
  const int k0 = (tid & 63) * 8, i = k0 >> 4, pi0 = k0 & 15;
  const float* KTAB = (const float*)(P.ws + OFF_KTAB);
  float f[8];
#pragma unroll
  for (int e = 0; e < 8; ++e) f[e] = 0.f;
  if (i <= j) {
    const float* kp = KTAB + (((size_t)(0 * 32 + g)) * 32 + (j - i)) * 256 + po * 16 + pi0;
#pragma unroll
    for (int e = 0; e < 8; ++e) f[e] += kp[e];
  }
  if (i >= j) {
    const float* kp = KTAB + (((size_t)(1 * 32 + g)) * 32 + (i - j)) * 256 + po * 16 + pi0;
#pragma unroll
    for (int e = 0; e < 8; ++e) f[e] += kp[e];
  }
  if (i == j) {
    const float dv = P.s5_d[g * 16 + po];
#pragma unroll
    for (int e = 0; e < 8; ++e) if (pi0 + e == po) f[e] += dv;
  }
  u16* MI = (u16*)(P.ws + OFF_MINTRA);
  *(uint4*)(MI + (size_t)rowg * 512 + k0) = pack8(f);
}

__device__ __forceinline__ void inproj_tile(const Params& P, int t, char* lds) {
  int mt, nt;
  if (t < 1344) { nt = t / 64; mt = t % 64; }
  else {
    const int tt = t - 1344; mt = 64 + (tt & 3);
    const int ni = tt >> 2;
    nt = (ni < 8) ? (4 + ni) : ((ni < 12) ? (16 + ni - 8) : 20);
  }
  const int m0 = mt * 256, n0 = nt * 128;
  f32x16 acc[2][2];
  acc_zero(acc);
  gemm_main((const u16*)(P.ws + OFF_R2) + (size_t)m0 * 1024, 1024, (const u16*)(P.ws + OFF_WT_IN) + (size_t)n0 * 1024, 1024, 1024, acc, (u16*)lds);
  TILE_COORDS
  if (nt < 12) {
    u16* QKV = (u16*)(P.ws + OFF_R3);
#pragma unroll
    for (int i = 0; i < 2; ++i)
#pragma unroll
      for (int j = 0; j < 2; ++j)
#pragma unroll
        for (int e = 0; e < 16; ++e) QKV[TIDX(m0, n0, i, j, e, 1536)] = f2bf(acc[i][j][e]);
  } else if (nt < 16) {
    u16* Z = (u16*)(P.ws + OFF_Z);
#pragma unroll
    for (int i = 0; i < 2; ++i)
#pragma unroll
      for (int j = 0; j < 2; ++j)
#pragma unroll
        for (int e = 0; e < 16; ++e) Z[TIDX(m0, n0, i, j, e, 512) - 1536] = f2bf(acc[i][j][e]);
  } else if (nt < 20) {
    u16* U5 = (u16*)(P.ws + OFF_U5);
#pragma unroll
    for (int i = 0; i < 2; ++i)
#pragma unroll
      for (int j = 0; j < 2; ++j)
#pragma unroll
        for (int e = 0; e < 16; ++e) {
          const int cc = TCOL(n0, j) - 2048;
          U5[((size_t)(cc >> 4) * 17408 + TROW(m0, i, e)) * 16 + (cc & 15)] = f2bf(acc[i][j][e]);
        }
  } else {
    float* BA = (float*)(P.ws + OFF_BA);
#pragma unroll
    for (int i = 0; i < 2; ++i)
#pragma unroll
      for (int j = 0; j < 2; ++j)
#pragma unroll
        for (int e = 0; e < 16; ++e) {
          const int cc = TCOL(n0, j) - 2560;
          if (cc < 16) BA[(size_t)TROW(m0, i, e) * 16 + cc] = acc[i][j][e];
        }
  }
}

__device__ __forceinline__ void solve_elim(float (&sol)[64], const float* Lr) {
  float4 b0a, b0b, b0c, b0d, b1a, b1b, b1c, b1d, b2a, b2b, b2c, b2d;
  b0a = *(const float4*)(Lr + 0); b0b = *(const float4*)(Lr + 4); b0c = *(const float4*)(Lr + 8); b0d = *(const float4*)(Lr + 12);
  b1a = *(const float4*)(Lr + 16); b1b = *(const float4*)(Lr + 20); b1c = *(const float4*)(Lr + 24); b1d = *(const float4*)(Lr + 28);
  b2a = *(const float4*)(Lr + 32); b2b = *(const float4*)(Lr + 36); b2c = *(const float4*)(Lr + 40); b2d = *(const float4*)(Lr + 44);
  __builtin_amdgcn_sched_barrier(0);
  sol[1] -= b0a.y * sol[0]; sol[2] -= b0a.z * sol[0]; sol[3] -= b0a.w * sol[0]; sol[4] -= b0b.x * sol[0]; sol[5] -= b0b.y * sol[0]; sol[6] -= b0b.z * sol[0]; sol[7] -= b0b.w * sol[0]; sol[8] -= b0c.x * sol[0]; sol[9] -= b0c.y * sol[0]; sol[10] -= b0c.z * sol[0]; sol[11] -= b0c.w * sol[0]; sol[12] -= b0d.x * sol[0]; sol[13] -= b0d.y * sol[0]; sol[14] -= b0d.z * sol[0]; sol[15] -= b0d.w * sol[0];
  __builtin_amdgcn_sched_barrier(0);
  b0a = *(const float4*)(Lr + 48); b0b = *(const float4*)(Lr + 52); b0c = *(const float4*)(Lr + 56); b0d = *(const float4*)(Lr + 60);
  __builtin_amdgcn_sched_barrier(0);
  sol[16] -= b1a.x * sol[0]; sol[17] -= b1a.y * sol[0]; sol[18] -= b1a.z * sol[0]; sol[19] -= b1a.w * sol[0]; sol[20] -= b1b.x * sol[0]; sol[21] -= b1b.y * sol[0]; sol[22] -= b1b.z * sol[0]; sol[23] -= b1b.w * sol[0]; sol[24] -= b1c.x * sol[0]; sol[25] -= b1c.y * sol[0]; sol[26] -= b1c.z * sol[0]; sol[27] -= b1c.w * sol[0]; sol[28] -= b1d.x * sol[0]; sol[29] -= b1d.y * sol[0]; sol[30] -= b1d.z * sol[0]; sol[31] -= b1d.w * sol[0];
  __builtin_amdgcn_sched_barrier(0);
  b1a = *(const float4*)(Lr + 64); b1b = *(const float4*)(Lr + 68); b1c = *(const float4*)(Lr + 72); b1d = *(const float4*)(Lr + 76);
  __builtin_amdgcn_sched_barrier(0);
  sol[32] -= b2a.x * sol[0]; sol[33] -= b2a.y * sol[0]; sol[34] -= b2a.z * sol[0]; sol[35] -= b2a.w * sol[0]; sol[36] -= b2b.x * sol[0]; sol[37] -= b2b.y * sol[0]; sol[38] -= b2b.z * sol[0]; sol[39] -= b2b.w * sol[0]; sol[40] -= b2c.x * sol[0]; sol[41] -= b2c.y * sol[0]; sol[42] -= b2c.z * sol[0]; sol[43] -= b2c.w * sol[0]; sol[44] -= b2d.x * sol[0]; sol[45] -= b2d.y * sol[0]; sol[46] -= b2d.z * sol[0]; sol[47] -= b2d.w * sol[0];
  __builtin_amdgcn_sched_barrier(0);
  b2a = *(const float4*)(Lr + 80); b2b = *(const float4*)(Lr + 84); b2c = *(const float4*)(Lr + 88); b2d = *(const float4*)(Lr + 92);
  __builtin_amdgcn_sched_barrier(0);
  sol[48] -= b0a.x * sol[0]; sol[49] -= b0a.y * sol[0]; sol[50] -= b0a.z * sol[0]; sol[51] -= b0a.w * sol[0]; sol[52] -= b0b.x * sol[0]; sol[53] -= b0b.y * sol[0]; sol[54] -= b0b.z * sol[0]; sol[55] -= b0b.w * sol[0]; sol[56] -= b0c.x * sol[0]; sol[57] -= b0c.y * sol[0]; sol[58] -= b0c.z * sol[0]; sol[59] -= b0c.w * sol[0]; sol[60] -= b0d.x * sol[0]; sol[61] -= b0d.y * sol[0]; sol[62] -= b0d.z * sol[0]; sol[63] -= b0d.w * sol[0];
  __builtin_amdgcn_sched_barrier(0);
  b0a = *(const float4*)(Lr + 96); b0b = *(const float4*)(Lr + 100); b0c = *(const float4*)(Lr + 104); b0d = *(const float4*)(Lr + 108);
  __builtin_amdgcn_sched_barrier(0);
  sol[2] -= b1a.z * sol[1]; sol[3] -= b1a.w * sol[1]; sol[4] -= b1b.x * sol[1]; sol[5] -= b1b.y * sol[1]; sol[6] -= b1b.z * sol[1]; sol[7] -= b1b.w * sol[1]; sol[8] -= b1c.x * sol[1]; sol[9] -= b1c.y * sol[1]; sol[10] -= b1c.z * sol[1]; sol[11] -= b1c.w * sol[1]; sol[12] -= b1d.x * sol[1]; sol[13] -= b1d.y * sol[1]; sol[14] -= b1d.z * sol[1]; sol[15] -= b1d.w * sol[1];
  __builtin_amdgcn_sched_barrier(0);
  b1a = *(const float4*)(Lr + 112); b1b = *(const float4*)(Lr + 116); b1c = *(const float4*)(Lr + 120); b1d = *(const float4*)(Lr + 124);
  __builtin_amdgcn_sched_barrier(0);
  sol[16] -= b2a.x * sol[1]; sol[17] -= b2a.y * sol[1]; sol[18] -= b2a.z * sol[1]; sol[19] -= b2a.w * sol[1]; sol[20] -= b2b.x * sol[1]; sol[21] -= b2b.y * sol[1]; sol[22] -= b2b.z * sol[1]; sol[23] -= b2b.w * sol[1]; sol[24] -= b2c.x * sol[1]; sol[25] -= b2c.y * sol[1]; sol[26] -= b2c.z * sol[1]; sol[27] -= b2c.w * sol[1]; sol[28] -= b2d.x * sol[1]; sol[29] -= b2d.y * sol[1]; sol[30] -= b2d.z * sol[1]; sol[31] -= b2d.w * sol[1];
  __builtin_amdgcn_sched_barrier(0);
  b2a = *(const float4*)(Lr + 128); b2b = *(const float4*)(Lr + 132); b2c = *(const float4*)(Lr + 136); b2d = *(const float4*)(Lr + 140);
  __builtin_amdgcn_sched_barrier(0);
  sol[32] -= b0a.x * sol[1]; sol[33] -= b0a.y * sol[1]; sol[34] -= b0a.z * sol[1]; sol[35] -= b0a.w * sol[1]; sol[36] -= b0b.x * sol[1]; sol[37] -= b0b.y * sol[1]; sol[38] -= b0b.z * sol[1]; sol[39] -= b0b.w * sol[1]; sol[40] -= b0c.x * sol[1]; sol[41] -= b0c.y * sol[1]; sol[42] -= b0c.z * sol[1]; sol[43] -= b0c.w * sol[1]; sol[44] -= b0d.x * sol[1]; sol[45] -= b0d.y * sol[1]; sol[46] -= b0d.z * sol[1]; sol[47] -= b0d.w * sol[1];
  __builtin_amdgcn_sched_barrier(0);
  b0a = *(const float4*)(Lr + 144); b0b = *(const float4*)(Lr + 148); b0c = *(const float4*)(Lr + 152); b0d = *(const float4*)(Lr + 156);
  __builtin_amdgcn_sched_barrier(0);
  sol[48] -= b1a.x * sol[1]; sol[49] -= b1a.y * sol[1]; sol[50] -= b1a.z * sol[1]; sol[51] -= b1a.w * sol[1]; sol[52] -= b1b.x * sol[1]; sol[53] -= b1b.y * sol[1]; sol[54] -= b1b.z * sol[1]; sol[55] -= b1b.w * sol[1]; sol[56] -= b1c.x * sol[1]; sol[57] -= b1c.y * sol[1]; sol[58] -= b1c.z * sol[1]; sol[59] -= b1c.w * sol[1]; sol[60] -= b1d.x * sol[1]; sol[61] -= b1d.y * sol[1]; sol[62] -= b1d.z * sol[1]; sol[63] -= b1d.w * sol[1];
  __builtin_amdgcn_sched_barrier(0);
  b1a = *(const float4*)(Lr + 160); b1b = *(const float4*)(Lr + 164); b1c = *(const float4*)(Lr + 168); b1d = *(const float4*)(Lr + 172);
  __builtin_amdgcn_sched_barrier(0);
  sol[3] -= b2a.w * sol[2]; sol[4] -= b2b.x * sol[2]; sol[5] -= b2b.y * sol[2]; sol[6] -= b2b.z * sol[2]; sol[7] -= b2b.w * sol[2]; sol[8] -= b2c.x * sol[2]; sol[9] -= b2c.y * sol[2]; sol[10] -= b2c.z * sol[2]; sol[11] -= b2c.w * sol[2]; sol[12] -= b2d.x * sol[2]; sol[13] -= b2d.y * sol[2]; sol[14] -= b2d.z * sol[2]; sol[15] -= b2d.w * sol[2];
  __builtin_amdgcn_sched_barrier(0);
  b2a = *(const float4*)(Lr + 176); b2b = *(const float4*)(Lr + 180); b2c = *(const float4*)(Lr + 184); b2d = *(const float4*)(Lr + 188);
  __builtin_amdgcn_sched_barrier(0);
  sol[16] -= b0a.x * sol[2]; sol[17] -= b0a.y * sol[2]; sol[18] -= b0a.z * sol[2]; sol[19] -= b0a.w * sol[2]; sol[20] -= b0b.x * sol[2]; sol[21] -= b0b.y * sol[2]; sol[22] -= b0b.z * sol[2]; sol[23] -= b0b.w * sol[2]; sol[24] -= b0c.x * sol[2]; sol[25] -= b0c.y * sol[2]; sol[26] -= b0c.z * sol[2]; sol[27] -= b0c.w * sol[2]; sol[28] -= b0d.x * sol[2]; sol[29] -= b0d.y * sol[2]; sol[30] -= b0d.z * sol[2]; sol[31] -= b0d.w * sol[2];
  __builtin_amdgcn_sched_barrier(0);
  b0a = *(const float4*)(Lr + 192); b0b = *(const float4*)(Lr + 196); b0c = *(const float4*)(Lr + 200); b0d = *(const float4*)(Lr + 204);
  __builtin_amdgcn_sched_barrier(0);
  sol[32] -= b1a.x * sol[2]; sol[33] -= b1a.y * sol[2]; sol[34] -= b1a.z * sol[2]; sol[35] -= b1a.w * sol[2]; sol[36] -= b1b.x * sol[2]; sol[37] -= b1b.y * sol[2]; sol[38] -= b1b.z * sol[2]; sol[39] -= b1b.w * sol[2]; sol[40] -= b1c.x * sol[2]; sol[41] -= b1c.y * sol[2]; sol[42] -= b1c.z * sol[2]; sol[43] -= b1c.w * sol[2]; sol[44] -= b1d.x * sol[2]; sol[45] -= b1d.y * sol[2]; sol[46] -= b1d.z * sol[2]; sol[47] -= b1d.w * sol[2];
  __builtin_amdgcn_sched_barrier(0);
  b1a = *(const float4*)(Lr + 208); b1b = *(const float4*)(Lr + 212); b1c = *(const float4*)(Lr + 216); b1d = *(const float4*)(Lr + 220);
  __builtin_amdgcn_sched_barrier(0);
  sol[48] -= b2a.x * sol[2]; sol[49] -= b2a.y * sol[2]; sol[50] -= b2a.z * sol[2]; sol[51] -= b2a.w * sol[2]; sol[52] -= b2b.x * sol[2]; sol[53] -= b2b.y * sol[2]; sol[54] -= b2b.z * sol[2]; sol[55] -= b2b.w * sol[2]; sol[56] -= b2c.x * sol[2]; sol[57] -= b2c.y * sol[2]; sol[58] -= b2c.z * sol[2]; sol[59] -= b2c.w * sol[2]; sol[60] -= b2d.x * sol[2]; sol[61] -= b2d.y * sol[2]; sol[62] -= b2d.z * sol[2]; sol[63] -= b2d.w * sol[2];
  __builtin_amdgcn_sched_barrier(0);
  b2a = *(const float4*)(Lr + 224); b2b = *(const float4*)(Lr + 228); b2c = *(const float4*)(Lr + 232); b2d = *(const float4*)(Lr + 236);
  __builtin_amdgcn_sched_barrier(0);
  sol[4] -= b0b.x * sol[3]; sol[5] -= b0b.y * sol[3]; sol[6] -= b0b.z * sol[3]; sol[7] -= b0b.w * sol[3]; sol[8] -= b0c.x * sol[3]; sol[9] -= b0c.y * sol[3]; sol[10] -= b0c.z * sol[3]; sol[11] -= b0c.w * sol[3]; sol[12] -= b0d.x * sol[3]; sol[13] -= b0d.y * sol[3]; sol[14] -= b0d.z * sol[3]; sol[15] -= b0d.w * sol[3];
  __builtin_amdgcn_sched_barrier(0);
  b0a = *(const float4*)(Lr + 240); b0b = *(const float4*)(Lr + 244); b0c = *(const float4*)(Lr + 248); b0d = *(const float4*)(Lr + 252);
  __builtin_amdgcn_sched_barrier(0);
  sol[16] -= b1a.x * sol[3]; sol[17] -= b1a.y * sol[3]; sol[18] -= b1a.z * sol[3]; sol[19] -= b1a.w * sol[3]; sol[20] -= b1b.x * sol[3]; sol[21] -= b1b.y * sol[3]; sol[22] -= b1b.z * sol[3]; sol[23] -= b1b.w * sol[3]; sol[24] -= b1c.x * sol[3]; sol[25] -= b1c.y * sol[3]; sol[26] -= b1c.z * sol[3]; sol[27] -= b1c.w * sol[3]; sol[28] -= b1d.x * sol[3]; sol[29] -= b1d.y * sol[3]; sol[30] -= b1d.z * sol[3]; sol[31] -= b1d.w * sol[3];
  __builtin_amdgcn_sched_barrier(0);
  b1a = *(const float4*)(Lr + 256); b1b = *(const float4*)(Lr + 260); b1c = *(const float4*)(Lr + 264); b1d = *(const float4*)(Lr + 268);
  __builtin_amdgcn_sched_barrier(0);
  sol[32] -= b2a.x * sol[3]; sol[33] -= b2a.y * sol[3]; sol[34] -= b2a.z * sol[3]; sol[35] -= b2a.w * sol[3]; sol[36] -= b2b.x * sol[3]; sol[37] -= b2b.y * sol[3]; sol[38] -= b2b.z * sol[3]; sol[39] -= b2b.w * sol[3]; sol[40] -= b2c.x * sol[3]; sol[41] -= b2c.y * sol[3]; sol[42] -= b2c.z * sol[3]; sol[43] -= b2c.w * sol[3]; sol[44] -= b2d.x * sol[3]; sol[45] -= b2d.y * sol[3]; sol[46] -= b2d.z * sol[3]; sol[47] -= b2d.w * sol[3];
  __builtin_amdgcn_sched_barrier(0);
  b2a = *(const float4*)(Lr + 272); b2b = *(const float4*)(Lr + 276); b2c = *(const float4*)(Lr + 280); b2d = *(const float4*)(Lr + 284);
  __builtin_amdgcn_sched_barrier(0);
  sol[48] -= b0a.x * sol[3]; sol[49] -= b0a.y * sol[3]; sol[50] -= b0a.z * sol[3]; sol[51] -= b0a.w * sol[3]; sol[52] -= b0b.x * sol[3]; sol[53] -= b0b.y * sol[3]; sol[54] -= b0b.z * sol[3]; sol[55] -= b0b.w * sol[3]; sol[56] -= b0c.x * sol[3]; sol[57] -= b0c.y * sol[3]; sol[58] -= b0c.z * sol[3]; sol[59] -= b0c.w * sol[3]; sol[60] -= b0d.x * sol[3]; sol[61] -= b0d.y * sol[3]; sol[62] -= b0d.z * sol[3]; sol[63] -= b0d.w * sol[3];
  __builtin_amdgcn_sched_barrier(0);
  b0a = *(const float4*)(Lr + 288); b0b = *(const float4*)(Lr + 292); b0c = *(const float4*)(Lr + 296); b0d = *(const float4*)(Lr + 300);
  __builtin_amdgcn_sched_barrier(0);
  sol[5] -= b1b.y * sol[4]; sol[6] -= b1b.z * sol[4]; sol[7] -= b1b.w * sol[4]; sol[8] -= b1c.x * sol[4]; sol[9] -= b1c.y * sol[4]; sol[10] -= b1c.z * sol[4]; sol[11] -= b1c.w * sol[4]; sol[12] -= b1d.x * sol[4]; sol[13] -= b1d.y * sol[4]; sol[14] -= b1d.z * sol[4]; sol[15] -= b1d.w * sol[4];
  __builtin_amdgcn_sched_barrier(0);
  b1a = *(const float4*)(Lr + 304); b1b = *(const float4*)(Lr + 308); b1c = *(const float4*)(Lr + 312); b1d = *(const float4*)(Lr + 316);
  __builtin_amdgcn_sched_barrier(0);
  sol[16] -= b2a.x * sol[4]; sol[17] -= b2a.y * sol[4]; sol[18] -= b2a.z * sol[4]; sol[19] -= b2a.w * sol[4]; sol[20] -= b2b.x * sol[4]; sol[21] -= b2b.y * sol[4]; sol[22] -= b2b.z * sol[4]; sol[23] -= b2b.w * sol[4]; sol[24] -= b2c.x * sol[4]; sol[25] -= b2c.y * sol[4]; sol[26] -= b2c.z * sol[4]; sol[27] -= b2c.w * sol[4]; sol[28] -= b2d.x * sol[4]; sol[29] -= b2d.y * sol[4]; sol[30] -= b2d.z * sol[4]; sol[31] -= b2d.w * sol[4];
  __builtin_amdgcn_sched_barrier(0);
  b2a = *(const float4*)(Lr + 320); b2b = *(const float4*)(Lr + 324); b2c = *(const float4*)(Lr + 328); b2d = *(const float4*)(Lr + 332);
  __builtin_amdgcn_sched_barrier(0);
  sol[32] -= b0a.x * sol[4]; sol[33] -= b0a.y * sol[4]; sol[34] -= b0a.z * sol[4]; sol[35] -= b0a.w * sol[4]; sol[36] -= b0b.x * sol[4]; sol[37] -= b0b.y * sol[4]; sol[38] -= b0b.z * sol[4]; sol[39] -= b0b.w * sol[4]; sol[40] -= b0c.x * sol[4]; sol[41] -= b0c.y * sol[4]; sol[42] -= b0c.z * sol[4]; sol[43] -= b0c.w * sol[4]; sol[44] -= b0d.x * sol[4]; sol[45] -= b0d.y * sol[4]; sol[46] -= b0d.z * sol[4]; sol[47] -= b0d.w * sol[4];
  __builtin_amdgcn_sched_barrier(0);
  b0a = *(const float4*)(Lr + 336); b0b = *(const float4*)(Lr + 340); b0c = *(const float4*)(Lr + 344); b0d = *(const float4*)(Lr + 348);
  __builtin_amdgcn_sched_barrier(0);
  sol[48] -= b1a.x * sol[4]; sol[49] -= b1a.y * sol[4]; sol[50] -= b1a.z * sol[4]; sol[51] -= b1a.w * sol[4]; sol[52] -= b1b.x * sol[4]; sol[53] -= b1b.y * sol[4]; sol[54] -= b1b.z * sol[4]; sol[55] -= b1b.w * sol[4]; sol[56] -= b1c.x * sol[4]; sol[57] -= b1c.y * sol[4]; sol[58] -= b1c.z * sol[4]; sol[59] -= b1c.w * sol[4]; sol[60] -= b1d.x * sol[4]; sol[61] -= b1d.y * sol[4]; sol[62] -= b1d.z * sol[4]; sol[63] -= b1d.w * sol[4];
  __builtin_amdgcn_sched_barrier(0);
  b1a = *(const float4*)(Lr + 352); b1b = *(const float4*)(Lr + 356); b1c = *(const float4*)(Lr + 360); b1d = *(const float4*)(Lr + 364);
  __builtin_amdgcn_sched_barrier(0);
  sol[6] -= b2b.z * sol[5]; sol[7] -= b2b.w * sol[5]; sol[8] -= b2c.x * sol[5]; sol[9] -= b2c.y * sol[5]; sol[10] -= b2c.z * sol[5]; sol[11] -= b2c.w * sol[5]; sol[12] -= b2d.x * sol[5]; sol[13] -= b2d.y * sol[5]; sol[14] -= b2d.z * sol[5]; sol[15] -= b2d.w * sol[5];
  __builtin_amdgcn_sched_barrier(0);
  b2a = *(const float4*)(Lr + 368); b2b = *(const float4*)(Lr + 372); b2c = *(const float4*)(Lr + 376); b2d = *(const float4*)(Lr + 380);
  __builtin_amdgcn_sched_barrier(0);
  sol[16] -= b0a.x * sol[5]; sol[17] -= b0a.y * sol[5]; sol[18] -= b0a.z * sol[5]; sol[19] -= b0a.w * sol[5]; sol[20] -= b0b.x * sol[5]; sol[21] -= b0b.y * sol[5]; sol[22] -= b0b.z * sol[5]; sol[23] -= b0b.w * sol[5]; sol[24] -= b0c.x * sol[5]; sol[25] -= b0c.y * sol[5]; sol[26] -= b0c.z * sol[5]; sol[27] -= b0c.w * sol[5]; sol[28] -= b0d.x * sol[5]; sol[29] -= b0d.y * sol[5]; sol[30] -= b0d.z * sol[5]; sol[31] -= b0d.w * sol[5];
  __builtin_amdgcn_sched_barrier(0);
  b0a = *(const float4*)(Lr + 384); b0b = *(const float4*)(Lr + 388); b0c = *(const float4*)(Lr + 392); b0d = *(const float4*)(Lr + 396);
  __builtin_amdgcn_sched_barrier(0);
  sol[32] -= b1a.x * sol[5]; sol[33] -= b1a.y * sol[5]; sol[34] -= b1a.z * sol[5]; sol[35] -= b1a.w * sol[5]; sol[36] -= b1b.x * sol[5]; sol[37] -= b1b.y * sol[5]; sol[38] -= b1b.z * sol[5]; sol[39] -= b1b.w * sol[5]; sol[40] -= b1c.x * sol[5]; sol[41] -= b1c.y * sol[5]; sol[42] -= b1c.z * sol[5]; sol[43] -= b1c.w * sol[5]; sol[44] -= b1d.x * sol[5]; sol[45] -= b1d.y * sol[5]; sol[46] -= b1d.z * sol[5]; sol[47] -= b1d.w * sol[5];
  __builtin_amdgcn_sched_barrier(0);
  b1a = *(const float4*)(Lr + 400); b1b = *(const float4*)(Lr + 404); b1c = *(const float4*)(Lr + 408); b1d = *(const float4*)(Lr + 412);
  __builtin_amdgcn_sched_barrier(0);
  sol[48] -= b2a.x * sol[5]; sol[49] -= b2a.y * sol[5]; sol[50] -= b2a.z * sol[5]; sol[51] -= b2a.w * sol[5]; sol[52] -= b2b.x * sol[5]; sol[53] -= b2b.y * sol[5]; sol[54] -= b2b.z * sol[5]; sol[55] -= b2b.w * sol[5]; sol[56] -= b2c.x * sol[5]; sol[57] -= b2c.y * sol[5]; sol[58] -= b2c.z * sol[5]; sol[59] -= b2c.w * sol[5]; sol[60] -= b2d.x * sol[5]; sol[61] -= b2d.y * sol[5]; sol[62] -= b2d.z * sol[5]; sol[63] -= b2d.w * sol[5];
  __builtin_amdgcn_sched_barrier(0);
  b2a = *(const float4*)(Lr + 416); b2b = *(const float4*)(Lr + 420); b2c = *(const float4*)(Lr + 424); b2d = *(const float4*)(Lr + 428);
  __builtin_amdgcn_sched_barrier(0);
  sol[7] -= b0b.w * sol[6]; sol[8] -= b0c.x * sol[6]; sol[9] -= b0c.y * sol[6]; sol[10] -= b0c.z * sol[6]; sol[11] -= b0c.w * sol[6]; sol[12] -= b0d.x * sol[6]; sol[13] -= b0d.y * sol[6]; sol[14] -= b0d.z * sol[6]; sol[15] -= b0d.w * sol[6];
  __builtin_amdgcn_sched_barrier(0);
  b0a = *(const float4*)(Lr + 432); b0b = *(const float4*)(Lr + 436); b0c = *(const float4*)(Lr + 440); b0d = *(const float4*)(Lr + 444);
  __builtin_amdgcn_sched_barrier(0);
  sol[16] -= b1a.x * sol[6]; sol[17] -= b1a.y * sol[6]; sol[18] -= b1a.z * sol[6]; sol[19] -= b1a.w * sol[6]; sol[20] -= b1b.x * sol[6]; sol[21] -= b1b.y * sol[6]; sol[22] -= b1b.z * sol[6]; sol[23] -= b1b.w * sol[6]; sol[24] -= b1c.x * sol[6]; sol[25] -= b1c.y * sol[6]; sol[26] -= b1c.z * sol[6]; sol[27] -= b1c.w * sol[6]; sol[28] -= b1d.x * sol[6]; sol[29] -= b1d.y * sol[6]; sol[30] -= b1d.z * sol[6]; sol[31] -= b1d.w * sol[6];
  __builtin_amdgcn_sched_barrier(0);
  b1a = *(const float4*)(Lr + 448); b1b = *(const float4*)(Lr + 452); b1c = *(const float4*)(Lr + 456); b1d = *(const float4*)(Lr + 460);
  __builtin_amdgcn_sched_barrier(0);
  sol[32] -= b2a.x * sol[6]; sol[33] -= b2a.y * sol[6]; sol[34] -= b2a.z * sol[6]; sol[35] -= b2a.w * sol[6]; sol[36] -= b2b.x * sol[6]; sol[37] -= b2b.y * sol[6]; sol[38] -= b2b.z * sol[6]; sol[39] -= b2b.w * sol[6]; sol[40] -= b2c.x * sol[6]; sol[41] -= b2c.y * sol[6]; sol[42] -= b2c.z * sol[6]; sol[43] -= b2c.w * sol[6]; sol[44] -= b2d.x * sol[6]; sol[45] -= b2d.y * sol[6]; sol[46] -= b2d.z * sol[6]; sol[47] -= b2d.w * sol[6];
  __builtin_amdgcn_sched_barrier(0);
  b2a = *(const float4*)(Lr + 464); b2b = *(const float4*)(Lr + 468); b2c = *(const float4*)(Lr + 472); b2d = *(const float4*)(Lr + 476);
  __builtin_amdgcn_sched_barrier(0);
  sol[48] -= b0a.x * sol[6]; sol[49] -= b0a.y * sol[6]; sol[50] -= b0a.z * sol[6]; sol[51] -= b0a.w * sol[6]; sol[52] -= b0b.x * sol[6]; sol[53] -= b0b.y * sol[6]; sol[54] -= b0b.z * sol[6]; sol[55] -= b0b.w * sol[6]; sol[56] -= b0c.x * sol[6]; sol[57] -= b0c.y * sol[6]; sol[58] -= b0c.z * sol[6]; sol[59] -= b0c.w * sol[6]; sol[60] -= b0d.x * sol[6]; sol[61] -= b0d.y * sol[6]; sol[62] -= b0d.z * sol[6]; sol[63] -= b0d.w * sol[6];
  __builtin_amdgcn_sched_barrier(0);
  b0a = *(const float4*)(Lr + 480); b0b = *(const float4*)(Lr + 484); b0c = *(const float4*)(Lr + 488); b0d = *(const float4*)(Lr + 492);
  __builtin_amdgcn_sched_barrier(0);
  sol[8] -= b1c.x * sol[7]; sol[9] -= b1c.y * sol[7]; sol[10] -= b1c.z * sol[7]; sol[11] -= b1c.w * sol[7]; sol[12] -= b1d.x * sol[7]; sol[13] -= b1d.y * sol[7]; sol[14] -= b1d.z * sol[7]; sol[15] -= b1d.w * sol[7];
  __builtin_amdgcn_sched_barrier(0);
  b1a = *(const float4*)(Lr + 496); b1b = *(const float4*)(Lr + 500); b1c = *(const float4*)(Lr + 504); b1d = *(const float4*)(Lr + 508);
  __builtin_amdgcn_sched_barrier(0);
  sol[16] -= b2a.x * sol[7]; sol[17] -= b2a.y * sol[7]; sol[18] -= b2a.z * sol[7]; sol[19] -= b2a.w * sol[7]; sol[20] -= b2b.x * sol[7]; sol[21] -= b2b.y * sol[7]; sol[22] -= b2b.z * sol[7]; sol[23] -= b2b.w * sol[7]; sol[24] -= b2c.x * sol[7]; sol[25] -= b2c.y * sol[7]; sol[26] -= b2c.z * sol[7]; sol[27] -= b2c.w * sol[7]; sol[28] -= b2d.x * sol[7]; sol[29] -= b2d.y * sol[7]; sol[30] -= b2d.z * sol[7]; sol[31] -= b2d.w * sol[7];
  __builtin_amdgcn_sched_barrier(0);
  b2a = *(const float4*)(Lr + 512); b2b = *(const float4*)(Lr + 516); b2c = *(const float4*)(Lr + 520); b2d = *(const float4*)(Lr + 524);
  __builtin_amdgcn_sched_barrier(0);
  sol[32] -= b0a.x * sol[7]; sol[33] -= b0a.y * sol[7]; sol[34] -= b0a.z * sol[7]; sol[35] -= b0a.w * sol[7]; sol[36] -= b0b.x * sol[7]; sol[37] -= b0b.y * sol[7]; sol[38] -= b0b.z * sol[7]; sol[39] -= b0b.w * sol[7]; sol[40] -= b0c.x * sol[7]; sol[41] -= b0c.y * sol[7]; sol[42] -= b0c.z * sol[7]; sol[43] -= b0c.w * sol[7]; sol[44] -= b0d.x * sol[7]; sol[45] -= b0d.y * sol[7]; sol[46] -= b0d.z * sol[7]; sol[47] -= b0d.w * sol[7];
  __builtin_amdgcn_sched_barrier(0);
  b0a = *(const float4*)(Lr + 528); b0b = *(const float4*)(Lr + 532); b0c = *(const float4*)(Lr + 536); b0d = *(const float4*)(Lr + 540);
  __builtin_amdgcn_sched_barrier(0);
  sol[48] -= b1a.x * sol[7]; sol[49] -= b1a.y * sol[7]; sol[50] -= b1a.z * sol[7]; sol[51] -= b1a.w * sol[7]; sol[52] -= b1b.x * sol[7]; sol[53] -= b1b.y * sol[7]; sol[54] -= b1b.z * sol[7]; sol[55] -= b1b.w * sol[7]; sol[56] -= b1c.x * sol[7]; sol[57] -= b1c.y * sol[7]; sol[58] -= b1c.z * sol[7]; sol[59] -= b1c.w * sol[7]; sol[60] -= b1d.x * sol[7]; sol[61] -= b1d.y * sol[7]; sol[62] -= b1d.z * sol[7]; sol[63] -= b1d.w * sol[7];
  __builtin_amdgcn_sched_barrier(0);
  b1a = *(const float4*)(Lr + 544); b1b = *(const float4*)(Lr + 548); b1c = *(const float4*)(Lr + 552); b1d = *(const float4*)(Lr + 556);
  __builtin_amdgcn_sched_barrier(0);
  sol[9] -= b2c.y * sol[8]; sol[10] -= b2c.z * sol[8]; sol[11] -= b2c.w * sol[8]; sol[12] -= b2d.x * sol[8]; sol[13] -= b2d.y * sol[8]; sol[14] -= b2d.z * sol[8]; sol[15] -= b2d.w * sol[8];
  __builtin_amdgcn_sched_barrier(0);
  b2a = *(const float4*)(Lr + 560); b2b = *(const float4*)(Lr + 564); b2c = *(const float4*)(Lr + 568); b2d = *(const float4*)(Lr + 572);
  __builtin_amdgcn_sched_barrier(0);
  sol[16] -= b0a.x * sol[8]; sol[17] -= b0a.y * sol[8]; sol[18] -= b0a.z * sol[8]; sol[19] -= b0a.w * sol[8]; sol[20] -= b0b.x * sol[8]; sol[21] -= b0b.y * sol[8]; sol[22] -= b0b.z * sol[8]; sol[23] -= b0b.w * sol[8]; sol[24] -= b0c.x * sol[8]; sol[25] -= b0c.y * sol[8]; sol[26] -= b0c.z * sol[8]; sol[27] -= b0c.w * sol[8]; sol[28] -= b0d.x * sol[8]; sol[29] -= b0d.y * sol[8]; sol[30] -= b0d.z * sol[8]; sol[31] -= b0d.w * sol[8];
  __builtin_amdgcn_sched_barrier(0);
  b0a = *(const float4*)(Lr + 576); b0b = *(const float4*)(Lr + 580); b0c = *(const float4*)(Lr + 584); b0d = *(const float4*)(Lr + 588);
  __builtin_amdgcn_sched_barrier(0);
  sol[32] -= b1a.x * sol[8]; sol[33] -= b1a.y * sol[8]; sol[34] -= b1a.z * sol[8]; sol[35] -= b1a.w * sol[8]; sol[36] -= b1b.x * sol[8]; sol[37] -= b1b.y * sol[8]; sol[38] -= b1b.z * sol[8]; sol[39] -= b1b.w * sol[8]; sol[40] -= b1c.x * sol[8]; sol[41] -= b1c.y * sol[8]; sol[42] -= b1c.z * sol[8]; sol[43] -= b1c.w * sol[8]; sol[44] -= b1d.x * sol[8]; sol[45] -= b1d.y * sol[8]; sol[46] -= b1d.z * sol[8]; sol[47] -= b1d.w * sol[8];
  __builtin_amdgcn_sched_barrier(0);
  b1a = *(const float4*)(Lr + 592); b1b = *(const float4*)(Lr + 596); b1c = *(const float4*)(Lr + 600); b1d = *(const float4*)(Lr + 604);
  __builtin_amdgcn_sched_barrier(0);
  sol[48] -= b2a.x * sol[8]; sol[49] -= b2a.y * sol[8]; sol[50] -= b2a.z * sol[8]; sol[51] -= b2a.w * sol[8]; sol[52] -= b2b.x * sol[8]; sol[53] -= b2b.y * sol[8]; sol[54] -= b2b.z * sol[8]; sol[55] -= b2b.w * sol[8]; sol[56] -= b2c.x * sol[8]; sol[57] -= b2c.y * sol[8]; sol[58] -= b2c.z * sol[8]; sol[59] -= b2c.w * sol[8]; sol[60] -= b2d.x * sol[8]; sol[61] -= b2d.y * sol[8]; sol[62] -= b2d.z * sol[8]; sol[63] -= b2d.w * sol[8];
  __builtin_amdgcn_sched_barrier(0);
  b2a = *(const float4*)(Lr + 608); b2b = *(const float4*)(Lr + 612); b2c = *(const float4*)(Lr + 616); b2d = *(const float4*)(Lr + 620);
  __builtin_amdgcn_sched_barrier(0);
  sol[10] -= b0c.z * sol[9]; sol[11] -= b0c.w * sol[9]; sol[12] -= b0d.x * sol[9]; sol[13] -= b0d.y * sol[9]; sol[14] -= b0d.z * sol[9]; sol[15] -= b0d.w * sol[9];
  __builtin_amdgcn_sched_barrier(0);
  b0a = *(const float4*)(Lr + 624); b0b = *(const float4*)(Lr + 628); b0c = *(const float4*)(Lr + 632); b0d = *(const float4*)(Lr + 636);
  __builtin_amdgcn_sched_barrier(0);
  sol[16] -= b1a.x * sol[9]; sol[17] -= b1a.y * sol[9]; sol[18] -= b1a.z * sol[9]; sol[19] -= b1a.w * sol[9]; sol[20] -= b1b.x * sol[9]; sol[21] -= b1b.y * sol[9]; sol[22] -= b1b.z * sol[9]; sol[23] -= b1b.w * sol[9]; sol[24] -= b1c.x * sol[9]; sol[25] -= b1c.y * sol[9]; sol[26] -= b1c.z * sol[9]; sol[27] -= b1c.w * sol[9]; sol[28] -= b1d.x * sol[9]; sol[29] -= b1d.y * sol[9]; sol[30] -= b1d.z * sol[9]; sol[31] -= b1d.w * sol[9];
  __builtin_amdgcn_sched_barrier(0);
  b1a = *(const float4*)(Lr + 640); b1b = *(const float4*)(Lr + 644); b1c = *(const float4*)(Lr + 648); b1d = *(const float4*)(Lr + 652);
  __builtin_amdgcn_sched_barrier(0);
  sol[32] -= b2a.x * sol[9]; sol[33] -= b2a.y * sol[9]; sol[34] -= b2a.z * sol[9]; sol[35] -= b2a.w * sol[9]; sol[36] -= b2b.x * sol[9]; sol[37] -= b2b.y * sol[9]; sol[38] -= b2b.z * sol[9]; sol[39] -= b2b.w * sol[9]; sol[40] -= b2c.x * sol[9]; sol[41] -= b2c.y * sol[9]; sol[42] -= b2c.z * sol[9]; sol[43] -= b2c.w * sol[9]; sol[44] -= b2d.x * sol[9]; sol[45] -= b2d.y * sol[9]; sol[46] -= b2d.z * sol[9]; sol[47] -= b2d.w * sol[9];
  __builtin_amdgcn_sched_barrier(0);
  b2a = *(const float4*)(Lr + 656); b2b = *(const float4*)(Lr + 660); b2c = *(const float4*)(Lr + 664); b2d = *(const float4*)(Lr + 668);
  __builtin_amdgcn_sched_barrier(0);
  sol[48] -= b0a.x * sol[9]; sol[49] -= b0a.y * sol[9]; sol[50] -= b0a.z * sol[9]; sol[51] -= b0a.w * sol[9]; sol[52] -= b0b.x * sol[9]; sol[53] -= b0b.y * sol[9]; sol[54] -= b0b.z * sol[9]; sol[55] -= b0b.w * sol[9]; sol[56] -= b0c.x * sol[9]; sol[57] -= b0c.y * sol[9]; sol[58] -= b0c.z * sol[9]; sol[59] -= b0c.w * sol[9]; sol[60] -= b0d.x * sol[9]; sol[61] -= b0d.y * sol[9]; sol[62] -= b0d.z * sol[9]; sol[63] -= b0d.w * sol[9];
  __builtin_amdgcn_sched_barrier(0);
  b0a = *(const float4*)(Lr + 672); b0b = *(const float4*)(Lr + 676); b0c = *(const float4*)(Lr + 680); b0d = *(const float4*)(Lr + 684);
  __builtin_amdgcn_sched_barrier(0);
  sol[11] -= b1c.w * sol[10]; sol[12] -= b1d.x * sol[10]; sol[13] -= b1d.y * sol[10]; sol[14] -= b1d.z * sol[10]; sol[15] -= b1d.w * sol[10];
  __builtin_amdgcn_sched_barrier(0);
  b1a = *(const float4*)(Lr + 688); b1b = *(const float4*)(Lr + 692); b1c = *(const float4*)(Lr + 696); b1d = *(const float4*)(Lr + 700);
  __builtin_amdgcn_sched_barrier(0);
  sol[16] -= b2a.x * sol[10]; sol[17] -= b2a.y * sol[10]; sol[18] -= b2a.z * sol[10]; sol[19] -= b2a.w * sol[10]; sol[20] -= b2b.x * sol[10]; sol[21] -= b2b.y * sol[10]; sol[22] -= b2b.z * sol[10]; sol[23] -= b2b.w * sol[10]; sol[24] -= b2c.x * sol[10]; sol[25] -= b2c.y * sol[10]; sol[26] -= b2c.z * sol[10]; sol[27] -= b2c.w * sol[10]; sol[28] -= b2d.x * sol[10]; sol[29] -= b2d.y * sol[10]; sol[30] -= b2d.z * sol[10]; sol[31] -= b2d.w * sol[10];
  __builtin_amdgcn_sched_barrier(0);
  b2a = *(const float4*)(Lr + 704); b2b = *(const float4*)(Lr + 708); b2c = *(const float4*)(Lr + 712); b2d = *(const float4*)(Lr + 716);
  __builtin_amdgcn_sched_barrier(0);
  sol[32] -= b0a.x * sol[10]; sol[33] -= b0a.y * sol[10]; sol[34] -= b0a.z * sol[10]; sol[35] -= b0a.w * sol[10]; sol[36] -= b0b.x * sol[10]; sol[37] -= b0b.y * sol[10]; sol[38] -= b0b.z * sol[10]; sol[39] -= b0b.w * sol[10]; sol[40] -= b0c.x * sol[10]; sol[41] -= b0c.y * sol[10]; sol[42] -= b0c.z * sol[10]; sol[43] -= b0c.w * sol[10]; sol[44] -= b0d.x * sol[10]; sol[45] -= b0d.y * sol[10]; sol[46] -= b0d.z * sol[10]; sol[47] -= b0d.w * sol[10];
  __builtin_amdgcn_sched_barrier(0);
  b0a = *(const float4*)(Lr + 720); b0b = *(const float4*)(Lr + 724); b0c = *(const float4*)(Lr + 728); b0d = *(const float4*)(Lr + 732);
  __builtin_amdgcn_sched_barrier(0);
  sol[48] -= b1a.x * sol[10]; sol[49] -= b1a.y * sol[10]; sol[50] -= b1a.z * sol[10]; sol[51] -= b1a.w * sol[10]; sol[52] -= b1b.x * sol[10]; sol[53] -= b1b.y * sol[10]; sol[54] -= b1b.z * sol[10]; sol[55] -= b1b.w * sol[10]; sol[56] -= b1c.x * sol[10]; sol[57] -= b1c.y * sol[10]; sol[58] -= b1c.z * sol[10]; sol[59] -= b1c.w * sol[10]; sol[60] -= b1d.x * sol[10]; sol[61] -= b1d.y * sol[10]; sol[62] -= b1d.z * sol[10]; sol[63] -= b1d.w * sol[10];
  __builtin_amdgcn_sched_barrier(0);
  b1a = *(const float4*)(Lr + 736); b1b = *(const float4*)(Lr + 740); b1c = *(const float4*)(Lr + 744); b1d = *(const float4*)(Lr + 748);
  __builtin_amdgcn_sched_barrier(0);
  sol[12] -= b2d.x * sol[11]; sol[13] -= b2d.y * sol[11]; sol[14] -= b2d.z * sol[11]; sol[15] -= b2d.w * sol[11];
  __builtin_amdgcn_sched_barrier(0);
  b2a = *(const float4*)(Lr + 752); b2b = *(const float4*)(Lr + 756); b2c = *(const float4*)(Lr + 760); b2d = *(const float4*)(Lr + 764);
  __builtin_amdgcn_sched_barrier(0);
  sol[16] -= b0a.x * sol[11]; sol[17] -= b0a.y * sol[11]; sol[18] -= b0a.z * sol[11]; sol[19] -= b0a.w * sol[11]; sol[20] -= b0b.x * sol[11]; sol[21] -= b0b.y * sol[11]; sol[22] -= b0b.z * sol[11]; sol[23] -= b0b.w * sol[11]; sol[24] -= b0c.x * sol[11]; sol[25] -= b0c.y * sol[11]; sol[26] -= b0c.z * sol[11]; sol[27] -= b0c.w * sol[11]; sol[28] -= b0d.x * sol[11]; sol[29] -= b0d.y * sol[11]; sol[30] -= b0d.z * sol[11]; sol[31] -= b0d.w * sol[11];
  __builtin_amdgcn_sched_barrier(0);
  b0a = *(const float4*)(Lr + 768); b0b = *(const float4*)(Lr + 772); b0c = *(const float4*)(Lr + 776); b0d = *(const float4*)(Lr + 780);
  __builtin_amdgcn_sched_barrier(0);
  sol[32] -= b1a.x * sol[11]; sol[33] -= b1a.y * sol[11]; sol[34] -= b1a.z * sol[11]; sol[35] -= b1a.w * sol[11]; sol[36] -= b1b.x * sol[11]; sol[37] -= b1b.y * sol[11]; sol[38] -= b1b.z * sol[11]; sol[39] -= b1b.w * sol[11]; sol[40] -= b1c.x * sol[11]; sol[41] -= b1c.y * sol[11]; sol[42] -= b1c.z * sol[11]; sol[43] -= b1c.w * sol[11]; sol[44] -= b1d.x * sol[11]; sol[45] -= b1d.y * sol[11]; sol[46] -= b1d.z * sol[11]; sol[47] -= b1d.w * sol[11];
  __builtin_amdgcn_sched_barrier(0);
  b1a = *(const float4*)(Lr + 784); b1b = *(const float4*)(Lr + 788); b1c = *(const float4*)(Lr + 792); b1d = *(const float4*)(Lr + 796);
  __builtin_amdgcn_sched_barrier(0);
  sol[48] -= b2a.x * sol[11]; sol[49] -= b2a.y * sol[11]; sol[50] -= b2a.z * sol[11]; sol[51] -= b2a.w * sol[11]; sol[52] -= b2b.x * sol[11]; sol[53] -= b2b.y * sol[11]; sol[54] -= b2b.z * sol[11]; sol[55] -= b2b.w * sol[11]; sol[56] -= b2c.x * sol[11]; sol[57] -= b2c.y * sol[11]; sol[58] -= b2c.z * sol[11]; sol[59] -= b2c.w * sol[11]; sol[60] -= b2d.x * sol[11]; sol[61] -= b2d.y * sol[11]; sol[62] -= b2d.z * sol[11]; sol[63] -= b2d.w * sol[11];
  __builtin_amdgcn_sched_barrier(0);
  b2a = *(const float4*)(Lr + 800); b2b = *(const float4*)(Lr + 804); b2c = *(const float4*)(Lr + 808); b2d = *(const float4*)(Lr + 812);
  __builtin_amdgcn_sched_barrier(0);
  sol[13] -= b0d.y * sol[12]; sol[14] -= b0d.z * sol[12]; sol[15] -= b0d.w * sol[12];
  __builtin_amdgcn_sched_barrier(0);
  b0a = *(const float4*)(Lr + 816); b0b = *(const float4*)(Lr + 820); b0c = *(const float4*)(Lr + 824); b0d = *(const float4*)(Lr + 828);
  __builtin_amdgcn_sched_barrier(0);
  sol[16] -= b1a.x * sol[12]; sol[17] -= b1a.y * sol[12]; sol[18] -= b1a.z * sol[12]; sol[19] -= b1a.w * sol[12]; sol[20] -= b1b.x * sol[12]; sol[21] -= b1b.y * sol[12]; sol[22] -= b1b.z * sol[12]; sol[23] -= b1b.w * sol[12]; sol[24] -= b1c.x * sol[12]; sol[25] -= b1c.y * sol[12]; sol[26] -= b1c.z * sol[12]; sol[27] -= b1c.w * sol[12]; sol[28] -= b1d.x * sol[12]; sol[29] -= b1d.y * sol[12]; sol[30] -= b1d.z * sol[12]; sol[31] -= b1d.w * sol[12];
  __builtin_amdgcn_sched_barrier(0);
  b1a = *(const float4*)(Lr + 832); b1b = *(const float4*)(Lr + 836); b1c = *(const float4*)(Lr + 840); b1d = *(const float4*)(Lr + 844);
  __builtin_amdgcn_sched_barrier(0);
  sol[32] -= b2a.x * sol[12]; sol[33] -= b2a.y * sol[12]; sol[34] -= b2a.z * sol[12]; sol[35] -= b2a.w * sol[12]; sol[36] -= b2b.x * sol[12]; sol[37] -= b2b.y * sol[12]; sol[38] -= b2b.z * sol[12]; sol[39] -= b2b.w * sol[12]; sol[40] -= b2c.x * sol[12]; sol[41] -= b2c.y * sol[12]; sol[42] -= b2c.z * sol[12]; sol[43] -= b2c.w * sol[12]; sol[44] -= b2d.x * sol[12]; sol[45] -= b2d.y * sol[12]; sol[46] -= b2d.z * sol[12]; sol[47] -= b2d.w * sol[12];
  __builtin_amdgcn_sched_barrier(0);
  b2a = *(const float4*)(Lr + 848); b2b = *(const float4*)(Lr + 852); b2c = *(const float4*)(Lr + 856); b2d = *(const float4*)(Lr + 860);
  __builtin_amdgcn_sched_barrier(0);
  sol[48] -= b0a.x * sol[12]; sol[49] -= b0a.y * sol[12]; sol[50] -= b0a.z * sol[12]; sol[51] -= b0a.w * sol[12]; sol[52] -= b0b.x * sol[12]; sol[53] -= b0b.y * sol[12]; sol[54] -= b0b.z * sol[12]; sol[55] -= b0b.w * sol[12]; sol[56] -= b0c.x * sol[12]; sol[57] -= b0c.y * sol[12]; sol[58] -= b0c.z * sol[12]; sol[59] -= b0c.w * sol[12]; sol[60] -= b0d.x * sol[12]; sol[61] -= b0d.y * sol[12]; sol[62] -= b0d.z * sol[12]; sol[63] -= b0d.w * sol[12];
  __builtin_amdgcn_sched_barrier(0);
  b0a = *(const float4*)(Lr + 864); b0b = *(const float4*)(Lr + 868); b0c = *(const float4*)(Lr + 872); b0d = *(const float4*)(Lr + 876);
  __builtin_amdgcn_sched_barrier(0);
  sol[14] -= b1d.z * sol[13]; sol[15] -= b1d.w * sol[13];
  __builtin_amdgcn_sched_barrier(0);
  b1a = *(const float4*)(Lr + 880); b1b = *(const float4*)(Lr + 884); b1c = *(const float4*)(Lr + 888); b1d = *(const float4*)(Lr + 892);
  __builtin_amdgcn_sched_barrier(0);
  sol[16] -= b2a.x * sol[13]; sol[17] -= b2a.y * sol[13]; sol[18] -= b2a.z * sol[13]; sol[19] -= b2a.w * sol[13]; sol[20] -= b2b.x * sol[13]; sol[21] -= b2b.y * sol[13]; sol[22] -= b2b.z * sol[13]; sol[23] -= b2b.w * sol[13]; sol[24] -= b2c.x * sol[13]; sol[25] -= b2c.y * sol[13]; sol[26] -= b2c.z * sol[13]; sol[27] -= b2c.w * sol[13]; sol[28] -= b2d.x * sol[13]; sol[29] -= b2d.y * sol[13]; sol[30] -= b2d.z * sol[13]; sol[31] -= b2d.w * sol[13];
  __builtin_amdgcn_sched_barrier(0);
  b2a = *(const float4*)(Lr + 896); b2b = *(const float4*)(Lr + 900); b2c = *(const float4*)(Lr + 904); b2d = *(const float4*)(Lr + 908);
  __builtin_amdgcn_sched_barrier(0);
  sol[32] -= b0a.x * sol[13]; sol[33] -= b0a.y * sol[13]; sol[34] -= b0a.z * sol[13]; sol[35] -= b0a.w * sol[13]; sol[36] -= b0b.x * sol[13]; sol[37] -= b0b.y * sol[13]; sol[38] -= b0b.z * sol[13]; sol[39] -= b0b.w * sol[13]; sol[40] -= b0c.x * sol[13]; sol[41] -= b0c.y * sol[13]; sol[42] -= b0c.z * sol[13]; sol[43] -= b0c.w * sol[13]; sol[44] -= b0d.x * sol[13]; sol[45] -= b0d.y * sol[13]; sol[46] -= b0d.z * sol[13]; sol[47] -= b0d.w * sol[13];
  __builtin_amdgcn_sched_barrier(0);
  b0a = *(const float4*)(Lr + 912); b0b = *(const float4*)(Lr + 916); b0c = *(const float4*)(Lr + 920); b0d = *(const float4*)(Lr + 924);
  __builtin_amdgcn_sched_barrier(0);
  sol[48] -= b1a.x * sol[13]; sol[49] -= b1a.y * sol[13]; sol[50] -= b1a.z * sol[13]; sol[51] -= b1a.w * sol[13]; sol[52] -= b1b.x * sol[13]; sol[53] -= b1b.y * sol[13]; sol[54] -= b1b.z * sol[13]; sol[55] -= b1b.w * sol[13]; sol[56] -= b1c.x * sol[13]; sol[57] -= b1c.y * sol[13]; sol[58] -= b1c.z * sol[13]; sol[59] -= b1c.w * sol[13]; sol[60] -= b1d.x * sol[13]; sol[61] -= b1d.y * sol[13]; sol[62] -= b1d.z * sol[13]; sol[63] -= b1d.w * sol[13];
  __builtin_amdgcn_sched_barrier(0);
  b1a = *(const float4*)(Lr + 928); b1b = *(const float4*)(Lr + 932); b1c = *(const float4*)(Lr + 936); b1d = *(const float4*)(Lr + 940);
  __builtin_amdgcn_sched_barrier(0);
  sol[15] -= b2d.w * sol[14];
  __builtin_amdgcn_sched_barrier(0);
  b2a = *(const float4*)(Lr + 944); b2b = *(const float4*)(Lr + 948); b2c = *(const float4*)(Lr + 952); b2d = *(const float4*)(Lr + 956);
  __builtin_amdgcn_sched_barrier(0);
  sol[16] -= b0a.x * sol[14]; sol[17] -= b0a.y * sol[14]; sol[18] -= b0a.z * sol[14]; sol[19] -= b0a.w * sol[14]; sol[20] -= b0b.x * sol[14]; sol[21] -= b0b.y * sol[14]; sol[22] -= b0b.z * sol[14]; sol[23] -= b0b.w * sol[14]; sol[24] -= b0c.x * sol[14]; sol[25] -= b0c.y * sol[14]; sol[26] -= b0c.z * sol[14]; sol[27] -= b0c.w * sol[14]; sol[28] -= b0d.x * sol[14]; sol[29] -= b0d.y * sol[14]; sol[30] -= b0d.z * sol[14]; sol[31] -= b0d.w * sol[14];
  __builtin_amdgcn_sched_barrier(0);
  b0a = *(const float4*)(Lr + 976); b0b = *(const float4*)(Lr + 980); b0c = *(const float4*)(Lr + 984); b0d = *(const float4*)(Lr + 988);
  __builtin_amdgcn_sched_barrier(0);
  sol[32] -= b1a.x * sol[14]; sol[33] -= b1a.y * sol[14]; sol[34] -= b1a.z * sol[14]; sol[35] -= b1a.w * sol[14]; sol[36] -= b1b.x * sol[14]; sol[37] -= b1b.y * sol[14]; sol[38] -= b1b.z * sol[14]; sol[39] -= b1b.w * sol[14]; sol[40] -= b1c.x * sol[14]; sol[41] -= b1c.y * sol[14]; sol[42] -= b1c.z * sol[14]; sol[43] -= b1c.w * sol[14]; sol[44] -= b1d.x * sol[14]; sol[45] -= b1d.y * sol[14]; sol[46] -= b1d.z * sol[14]; sol[47] -= b1d.w * sol[14];
  __builtin_amdgcn_sched_barrier(0);
  b1a = *(const float4*)(Lr + 992); b1b = *(const float4*)(Lr + 996); b1c = *(const float4*)(Lr + 1000); b1d = *(const float4*)(Lr + 1004);
  __builtin_amdgcn_sched_barrier(0);
  sol[48] -= b2a.x * sol[14]; sol[49] -= b2a.y * sol[14]; sol[50] -= b2a.z * sol[14]; sol[51] -= b2a.w * sol[14]; sol[52] -= b2b.x * sol[14]; sol[53] -= b2b.y * sol[14]; sol[54] -= b2b.z * sol[14]; sol[55] -= b2b.w * sol[14]; sol[56] -= b2c.x * sol[14]; sol[57] -= b2c.y * sol[14]; sol[58] -= b2c.z * sol[14]; sol[59] -= b2c.w * sol[14]; sol[60] -= b2d.x * sol[14]; sol[61] -= b2d.y * sol[14]; sol[62] -= b2d.z * sol[14]; sol[63] -= b2d.w * sol[14];
  __builtin_amdgcn_sched_barrier(0);
  b2a = *(const float4*)(Lr + 1008); b2b = *(const float4*)(Lr + 1012); b2c = *(const float4*)(Lr + 1016); b2d = *(const float4*)(Lr + 1020);
  __builtin_amdgcn_sched_barrier(0);
  sol[16] -= b0a.x * sol[15]; sol[17] -= b0a.y * sol[15]; sol[18] -= b0a.z * sol[15]; sol[19] -= b0a.w * sol[15]; sol[20] -= b0b.x * sol[15]; sol[21] -= b0b.y * sol[15]; sol[22] -= b0b.z * sol[15]; sol[23] -= b0b.w * sol[15]; sol[24] -= b0c.x * sol[15]; sol[25] -= b0c.y * sol[15]; sol[26] -= b0c.z * sol[15]; sol[27] -= b0c.w * sol[15]; sol[28] -= b0d.x * sol[15]; sol[29] -= b0d.y * sol[15]; sol[30] -= b0d.z * sol[15]; sol[31] -= b0d.w * sol[15];
  __builtin_amdgcn_sched_barrier(0);
  b0a = *(const float4*)(Lr + 1040); b0b = *(const float4*)(Lr + 1044); b0c = *(const float4*)(Lr + 1048); b0d = *(const float4*)(Lr + 1052);
  __builtin_amdgcn_sched_barrier(0);
  sol[32] -= b1a.x * sol[15]; sol[33] -= b1a.y * sol[15]; sol[34] -= b1a.z * sol[15]; sol[35] -= b1a.w * sol[15]; sol[36] -= b1b.x * sol[15]; sol[37] -= b1b.y * sol[15]; sol[38] -= b1b.z * sol[15]; sol[39] -= b1b.w * sol[15]; sol[40] -= b1c.x * sol[15]; sol[41] -= b1c.y * sol[15]; sol[42] -= b1c.z * sol[15]; sol[43] -= b1c.w * sol[15]; sol[44] -= b1d.x * sol[15]; sol[45] -= b1d.y * sol[15]; sol[46] -= b1d.z * sol[15]; sol[47] -= b1d.w * sol[15];
  __builtin_amdgcn_sched_barrier(0);
  b1a = *(const float4*)(Lr + 1056); b1b = *(const float4*)(Lr + 1060); b1c = *(const float4*)(Lr + 1064); b1d = *(const float4*)(Lr + 1068);
  __builtin_amdgcn_sched_barrier(0);
  sol[48] -= b2a.x * sol[15]; sol[49] -= b2a.y * sol[15]; sol[50] -= b2a.z * sol[15]; sol[51] -= b2a.w * sol[15]; sol[52] -= b2b.x * sol[15]; sol[53] -= b2b.y * sol[15]; sol[54] -= b2b.z * sol[15]; sol[55] -= b2b.w * sol[15]; sol[56] -= b2c.x * sol[15]; sol[57] -= b2c.y * sol[15]; sol[58] -= b2c.z * sol[15]; sol[59] -= b2c.w * sol[15]; sol[60] -= b2d.x * sol[15]; sol[61] -= b2d.y * sol[15]; sol[62] -= b2d.z * sol[15]; sol[63] -= b2d.w * sol[15];
  __builtin_amdgcn_sched_barrier(0);
  b2a = *(const float4*)(Lr + 1072); b2b = *(const float4*)(Lr + 1076); b2c = *(const float4*)(Lr + 1080); b2d = *(const float4*)(Lr + 1084);
  __builtin_amdgcn_sched_barrier(0);
  sol[17] -= b0a.y * sol[16]; sol[18] -= b0a.z * sol[16]; sol[19] -= b0a.w * sol[16]; sol[20] -= b0b.x * sol[16]; sol[21] -= b0b.y * sol[16]; sol[22] -= b0b.z * sol[16]; sol[23] -= b0b.w * sol[16]; sol[24] -= b0c.x * sol[16]; sol[25] -= b0c.y * sol[16]; sol[26] -= b0c.z * sol[16]; sol[27] -= b0c.w * sol[16]; sol[28] -= b0d.x * sol[16]; sol[29] -= b0d.y * sol[16]; sol[30] -= b0d.z * sol[16]; sol[31] -= b0d.w * sol[16];
  __builtin_amdgcn_sched_barrier(0);
  b0a = *(const float4*)(Lr + 1104); b0b = *(const float4*)(Lr + 1108); b0c = *(const float4*)(Lr + 1112); b0d = *(const float4*)(Lr + 1116);
  __builtin_amdgcn_sched_barrier(0);
  sol[32] -= b1a.x * sol[16]; sol[33] -= b1a.y * sol[16]; sol[34] -= b1a.z * sol[16]; sol[35] -= b1a.w * sol[16]; sol[36] -= b1b.x * sol[16]; sol[37] -= b1b.y * sol[16]; sol[38] -= b1b.z * sol[16]; sol[39] -= b1b.w * sol[16]; sol[40] -= b1c.x * sol[16]; sol[41] -= b1c.y * sol[16]; sol[42] -= b1c.z * sol[16]; sol[43] -= b1c.w * sol[16]; sol[44] -= b1d.x * sol[16]; sol[45] -= b1d.y * sol[16]; sol[46] -= b1d.z * sol[16]; sol[47] -= b1d.w * sol[16];
  __builtin_amdgcn_sched_barrier(0);
  b1a = *(const float4*)(Lr + 1120); b1b = *(const float4*)(Lr + 1124); b1c = *(const float4*)(Lr + 1128); b1d = *(const float4*)(Lr + 1132);
  __builtin_amdgcn_sched_barrier(0);
  sol[48] -= b2a.x * sol[16]; sol[49] -= b2a.y * sol[16]; sol[50] -= b2a.z * sol[16]; sol[51] -= b2a.w * sol[16]; sol[52] -= b2b.x * sol[16]; sol[53] -= b2b.y * sol[16]; sol[54] -= b2b.z * sol[16]; sol[55] -= b2b.w * sol[16]; sol[56] -= b2c.x * sol[16]; sol[57] -= b2c.y * sol[16]; sol[58] -= b2c.z * sol[16]; sol[59] -= b2c.w * sol[16]; sol[60] -= b2d.x * sol[16]; sol[61] -= b2d.y * sol[16]; sol[62] -= b2d.z * sol[16]; sol[63] -= b2d.w * sol[16];
  __builtin_amdgcn_sched_barrier(0);
  b2a = *(const float4*)(Lr + 1136); b2b = *(const float4*)(Lr + 1140); b2c = *(const float4*)(Lr + 1144); b2d = *(const float4*)(Lr + 1148);
  __builtin_amdgcn_sched_barrier(0);
  sol[18] -= b0a.z * sol[17]; sol[19] -= b0a.w * sol[17]; sol[20] -= b0b.x * sol[17]; sol[21] -= b0b.y * sol[17]; sol[22] -= b0b.z * sol[17]; sol[23] -= b0b.w * sol[17]; sol[24] -= b0c.x * sol[17]; sol[25] -= b0c.y * sol[17]; sol[26] -= b0c.z * sol[17]; sol[27] -= b0c.w * sol[17]; sol[28] -= b0d.x * sol[17]; sol[29] -= b0d.y * sol[17]; sol[30] -= b0d.z * sol[17]; sol[31] -= b0d.w * sol[17];
  __builtin_amdgcn_sched_barrier(0);
  b0a = *(const float4*)(Lr + 1168); b0b = *(const float4*)(Lr + 1172); b0c = *(const float4*)(Lr + 1176); b0d = *(const float4*)(Lr + 1180);
  __builtin_amdgcn_sched_barrier(0);
  sol[32] -= b1a.x * sol[17]; sol[33] -= b1a.y * sol[17]; sol[34] -= b1a.z * sol[17]; sol[35] -= b1a.w * sol[17]; sol[36] -= b1b.x * sol[17]; sol[37] -= b1b.y * sol[17]; sol[38] -= b1b.z * sol[17]; sol[39] -= b1b.w * sol[17]; sol[40] -= b1c.x * sol[17]; sol[41] -= b1c.y * sol[17]; sol[42] -= b1c.z * sol[17]; sol[43] -= b1c.w * sol[17]; sol[44] -= b1d.x * sol[17]; sol[45] -= b1d.y * sol[17]; sol[46] -= b1d.z * sol[17]; sol[47] -= b1d.w * sol[17];
  __builtin_amdgcn_sched_barrier(0);
  b1a = *(const float4*)(Lr + 1184); b1b = *(const float4*)(Lr + 1188); b1c = *(const float4*)(Lr + 1192); b1d = *(const float4*)(Lr + 1196);
  __builtin_amdgcn_sched_barrier(0);
  sol[48] -= b2a.x * sol[17]; sol[49] -= b2a.y * sol[17]; sol[50] -= b2a.z * sol[17]; sol[51] -= b2a.w * sol[17]; sol[52] -= b2b.x * sol[17]; sol[53] -= b2b.y * sol[17]; sol[54] -= b2b.z * sol[17]; sol[55] -= b2b.w * sol[17]; sol[56] -= b2c.x * sol[17]; sol[57] -= b2c.y * sol[17]; sol[58] -= b2c.z * sol[17]; sol[59] -= b2c.w * sol[17]; sol[60] -= b2d.x * sol[17]; sol[61] -= b2d.y * sol[17]; sol[62] -= b2d.z * sol[17]; sol[63] -= b2d.w * sol[17];
  __builtin_amdgcn_sched_barrier(0);
  b2a = *(const float4*)(Lr + 1200); b2b = *(const float4*)(Lr + 1204); b2c = *(const float4*)(Lr + 1208); b2d = *(const float4*)(Lr + 1212);
  __builtin_amdgcn_sched_barrier(0);
  sol[19] -= b0a.w * sol[18]; sol[20] -= b0b.x * sol[18]; sol[21] -= b0b.y * sol[18]; sol[22] -= b0b.z * sol[18]; sol[23] -= b0b.w * sol[18]; sol[24] -= b0c.x * sol[18]; sol[25] -= b0c.y * sol[18]; sol[26] -= b0c.z * sol[18]; sol[27] -= b0c.w * sol[18]; sol[28] -= b0d.x * sol[18]; sol[29] -= b0d.y * sol[18]; sol[30] -= b0d.z * sol[18]; sol[31] -= b0d.w * sol[18];
  __builtin_amdgcn_sched_barrier(0);
  b0a = *(const float4*)(Lr + 1232); b0b = *(const float4*)(Lr + 1236); b0c = *(const float4*)(Lr + 1240); b0d = *(const float4*)(Lr + 1244);
  __builtin_amdgcn_sched_barrier(0);
  sol[32] -= b1a.x * sol[18]; sol[33] -= b1a.y * sol[18]; sol[34] -= b1a.z * sol[18]; sol[35] -= b1a.w * sol[18]; sol[36] -= b1b.x * sol[18]; sol[37] -= b1b.y * sol[18]; sol[38] -= b1b.z * sol[18]; sol[39] -= b1b.w * sol[18]; sol[40] -= b1c.x * sol[18]; sol[41] -= b1c.y * sol[18]; sol[42] -= b1c.z * sol[18]; sol[43] -= b1c.w * sol[18]; sol[44] -= b1d.x * sol[18]; sol[45] -= b1d.y * sol[18]; sol[46] -= b1d.z * sol[18]; sol[47] -= b1d.w * sol[18];
  __builtin_amdgcn_sched_barrier(0);
  b1a = *(const float4*)(Lr + 1248); b1b = *(const float4*)(Lr + 1252); b1c = *(const float4*)(Lr + 1256); b1d = *(const float4*)(Lr + 1260);
  __builtin_amdgcn_sched_barrier(0);
  sol[48] -= b2a.x * sol[18]; sol[49] -= b2a.y * sol[18]; sol[50] -= b2a.z * sol[18]; sol[51] -= b2a.w * sol[18]; sol[52] -= b2b.x * sol[18]; sol[53] -= b2b.y * sol[18]; sol[54] -= b2b.z * sol[18]; sol[55] -= b2b.w * sol[18]; sol[56] -= b2c.x * sol[18]; sol[57] -= b2c.y * sol[18]; sol[58] -= b2c.z * sol[18]; sol[59] -= b2c.w * sol[18]; sol[60] -= b2d.x * sol[18]; sol[61] -= b2d.y * sol[18]; sol[62] -= b2d.z * sol[18]; sol[63] -= b2d.w * sol[18];
  __builtin_amdgcn_sched_barrier(0);
  b2a = *(const float4*)(Lr + 1264); b2b = *(const float4*)(Lr + 1268); b2c = *(const float4*)(Lr + 1272); b2d = *(const float4*)(Lr + 1276);
  __builtin_amdgcn_sched_barrier(0);
  sol[20] -= b0b.x * sol[19]; sol[21] -= b0b.y * sol[19]; sol[22] -= b0b.z * sol[19]; sol[23] -= b0b.w * sol[19]; sol[24] -= b0c.x * sol[19]; sol[25] -= b0c.y * sol[19]; sol[26] -= b0c.z * sol[19]; sol[27] -= b0c.w * sol[19]; sol[28] -= b0d.x * sol[19]; sol[29] -= b0d.y * sol[19]; sol[30] -= b0d.z * sol[19]; sol[31] -= b0d.w * sol[19];
  __builtin_amdgcn_sched_barrier(0);
  b0a = *(const float4*)(Lr + 1296); b0b = *(const float4*)(Lr + 1300); b0c = *(const float4*)(Lr + 1304); b0d = *(const float4*)(Lr + 1308);
  __builtin_amdgcn_sched_barrier(0);
  sol[32] -= b1a.x * sol[19]; sol[33] -= b1a.y * sol[19]; sol[34] -= b1a.z * sol[19]; sol[35] -= b1a.w * sol[19]; sol[36] -= b1b.x * sol[19]; sol[37] -= b1b.y * sol[19]; sol[38] -= b1b.z * sol[19]; sol[39] -= b1b.w * sol[19]; sol[40] -= b1c.x * sol[19]; sol[41] -= b1c.y * sol[19]; sol[42] -= b1c.z * sol[19]; sol[43] -= b1c.w * sol[19]; sol[44] -= b1d.x * sol[19]; sol[45] -= b1d.y * sol[19]; sol[46] -= b1d.z * sol[19]; sol[47] -= b1d.w * sol[19];
  __builtin_amdgcn_sched_barrier(0);
  b1a = *(const float4*)(Lr + 1312); b1b = *(const float4*)(Lr + 1316); b1c = *(const float4*)(Lr + 1320); b1d = *(const float4*)(Lr + 1324);
  __builtin_amdgcn_sched_barrier(0);
  sol[48] -= b2a.x * sol[19]; sol[49] -= b2a.y * sol[19]; sol[50] -= b2a.z * sol[19]; sol[51] -= b2a.w * sol[19]; sol[52] -= b2b.x * sol[19]; sol[53] -= b2b.y * sol[19]; sol[54] -= b2b.z * sol[19]; sol[55] -= b2b.w * sol[19]; sol[56] -= b2c.x * sol[19]; sol[57] -= b2c.y * sol[19]; sol[58] -= b2c.z * sol[19]; sol[59] -= b2c.w * sol[19]; sol[60] -= b2d.x * sol[19]; sol[61] -= b2d.y * sol[19]; sol[62] -= b2d.z * sol[19]; sol[63] -= b2d.w * sol[19];
  __builtin_amdgcn_sched_barrier(0);
  b2a = *(const float4*)(Lr + 1328); b2b = *(const float4*)(Lr + 1332); b2c = *(const float4*)(Lr + 1336); b2d = *(const float4*)(Lr + 1340);
  __builtin_amdgcn_sched_barrier(0);
  sol[21] -= b0b.y * sol[20]; sol[22] -= b0b.z * sol[20]; sol[23] -= b0b.w * sol[20]; sol[24] -= b0c.x * sol[20]; sol[25] -= b0c.y * sol[20]; sol[26] -= b0c.z * sol[20]; sol[27] -= b0c.w * sol[20]; sol[28] -= b0d.x * sol[20]; sol[29] -= b0d.y * sol[20]; sol[30] -= b0d.z * sol[20]; sol[31] -= b0d.w * sol[20];
  __builtin_amdgcn_sched_barrier(0);
  b0a = *(const float4*)(Lr + 1360); b0b = *(const float4*)(Lr + 1364); b0c = *(const float4*)(Lr + 1368); b0d = *(const float4*)(Lr + 1372);
  __builtin_amdgcn_sched_barrier(0);
  sol[32] -= b1a.x * sol[20]; sol[33] -= b1a.y * sol[20]; sol[34] -= b1a.z * sol[20]; sol[35] -= b1a.w * sol[20]; sol[36] -= b1b.x * sol[20]; sol[37] -= b1b.y * sol[20]; sol[38] -= b1b.z * sol[20]; sol[39] -= b1b.w * sol[20]; sol[40] -= b1c.x * sol[20]; sol[41] -= b1c.y * sol[20]; sol[42] -= b1c.z * sol[20]; sol[43] -= b1c.w * sol[20]; sol[44] -= b1d.x * sol[20]; sol[45] -= b1d.y * sol[20]; sol[46] -= b1d.z * sol[20]; sol[47] -= b1d.w * sol[20];
  __builtin_amdgcn_sched_barrier(0);
  b1a = *(const float4*)(Lr + 1376); b1b = *(const float4*)(Lr + 1380); b1c = *(const float4*)(Lr + 1384); b1d = *(const float4*)(Lr + 1388);
  __builtin_amdgcn_sched_barrier(0);
  sol[48] -= b2a.x * sol[20]; sol[49] -= b2a.y * sol[20]; sol[50] -= b2a.z * sol[20]; sol[51] -= b2a.w * sol[20]; sol[52] -= b2b.x * sol[20]; sol[53] -= b2b.y * sol[20]; sol[54] -= b2b.z * sol[20]; sol[55] -= b2b.w * sol[20]; sol[56] -= b2c.x * sol[20]; sol[57] -= b2c.y * sol[20]; sol[58] -= b2c.z * sol[20]; sol[59] -= b2c.w * sol[20]; sol[60] -= b2d.x * sol[20]; sol[61] -= b2d.y * sol[20]; sol[62] -= b2d.z * sol[20]; sol[63] -= b2d.w * sol[20];
  __builtin_amdgcn_sched_barrier(0);
  b2a = *(const float4*)(Lr + 1392); b2b = *(const float4*)(Lr + 1396); b2c = *(const float4*)(Lr + 1400); b2d = *(const float4*)(Lr + 1404);
  __builtin_amdgcn_sched_barrier(0);
  sol[22] -= b0b.z * sol[21]; sol[23] -= b0b.w * sol[21]; sol[24] -= b0c.x * sol[21]; sol[25] -= b0c.y * sol[21]; sol[26] -= b0c.z * sol[21]; sol[27] -= b0c.w * sol[21]; sol[28] -= b0d.x * sol[21]; sol[29] -= b0d.y * sol[21]; sol[30] -= b0d.z * sol[21]; sol[31] -= b0d.w * sol[21];
  __builtin_amdgcn_sched_barrier(0);
  b0a = *(const float4*)(Lr + 1424); b0b = *(const float4*)(Lr + 1428); b0c = *(const float4*)(Lr + 1432); b0d = *(const float4*)(Lr + 1436);
  __builtin_amdgcn_sched_barrier(0);
  sol[32] -= b1a.x * sol[21]; sol[33] -= b1a.y * sol[21]; sol[34] -= b1a.z * sol[21]; sol[35] -= b1a.w * sol[21]; sol[36] -= b1b.x * sol[21]; sol[37] -= b1b.y * sol[21]; sol[38] -= b1b.z * sol[21]; sol[39] -= b1b.w * sol[21]; sol[40] -= b1c.x * sol[21]; sol[41] -= b1c.y * sol[21]; sol[42] -= b1c.z * sol[21]; sol[43] -= b1c.w * sol[21]; sol[44] -= b1d.x * sol[21]; sol[45] -= b1d.y * sol[21]; sol[46] -= b1d.z * sol[21]; sol[47] -= b1d.w * sol[21];
  __builtin_amdgcn_sched_barrier(0);
  b1a = *(const float4*)(Lr + 1440); b1b = *(const float4*)(Lr + 1444); b1c = *(const float4*)(Lr + 1448); b1d = *(const float4*)(Lr + 1452);
  __builtin_amdgcn_sched_barrier(0);
  sol[48] -= b2a.x * sol[21]; sol[49] -= b2a.y * sol[21]; sol[50] -= b2a.z * sol[21]; sol[51] -= b2a.w * sol[21]; sol[52] -= b2b.x * sol[21]; sol[53] -= b2b.y * sol[21]; sol[54] -= b2b.z * sol[21]; sol[55] -= b2b.w * sol[21]; sol[56] -= b2c.x * sol[21]; sol[57] -= b2c.y * sol[21]; sol[58] -= b2c.z * sol[21]; sol[59] -= b2c.w * sol[21]; sol[60] -= b2d.x * sol[21]; sol[61] -= b2d.y * sol[21]; sol[62] -= b2d.z * sol[21]; sol[63] -= b2d.w * sol[21];
  __builtin_amdgcn_sched_barrier(0);
  b2a = *(const float4*)(Lr + 1456); b2b = *(const float4*)(Lr + 1460); b2c = *(const float4*)(Lr + 1464); b2d = *(const float4*)(Lr + 1468);
  __builtin_amdgcn_sched_barrier(0);
  sol[23] -= b0b.w * sol[22]; sol[24] -= b0c.x * sol[22]; sol[25] -= b0c.y * sol[22]; sol[26] -= b0c.z * sol[22]; sol[27] -= b0c.w * sol[22]; sol[28] -= b0d.x * sol[22]; sol[29] -= b0d.y * sol[22]; sol[30] -= b0d.z * sol[22]; sol[31] -= b0d.w * sol[22];
  __builtin_amdgcn_sched_barrier(0);
  b0a = *(const float4*)(Lr + 1488); b0b = *(const float4*)(Lr + 1492); b0c = *(const float4*)(Lr + 1496); b0d = *(const float4*)(Lr + 1500);
  __builtin_amdgcn_sched_barrier(0);
  sol[32] -= b1a.x * sol[22]; sol[33] -= b1a.y * sol[22]; sol[34] -= b1a.z * sol[22]; sol[35] -= b1a.w * sol[22]; sol[36] -= b1b.x * sol[22]; sol[37] -= b1b.y * sol[22]; sol[38] -= b1b.z * sol[22]; sol[39] -= b1b.w * sol[22]; sol[40] -= b1c.x * sol[22]; sol[41] -= b1c.y * sol[22]; sol[42] -= b1c.z * sol[22]; sol[43] -= b1c.w * sol[22]; sol[44] -= b1d.x * sol[22]; sol[45] -= b1d.y * sol[22]; sol[46] -= b1d.z * sol[22]; sol[47] -= b1d.w * sol[22];
  __builtin_amdgcn_sched_barrier(0);
  b1a = *(const float4*)(Lr + 1504); b1b = *(const float4*)(Lr + 1508); b1c = *(const float4*)(Lr + 1512); b1d = *(const float4*)(Lr + 1516);
  __builtin_amdgcn_sched_barrier(0);
  sol[48] -= b2a.x * sol[22]; sol[49] -= b2a.y * sol[22]; sol[50] -= b2a.z * sol[22]; sol[51] -= b2a.w * sol[22]; sol[52] -= b2b.x * sol[22]; sol[53] -= b2b.y * sol[22]; sol[54] -= b2b.z * sol[22]; sol[55] -= b2b.w * sol[22]; sol[56] -= b2c.x * sol[22]; sol[57] -= b2c.y * sol[22]; sol[58] -= b2c.z * sol[22]; sol[59] -= b2c.w * sol[22]; sol[60] -= b2d.x * sol[22]; sol[61] -= b2d.y * sol[22]; sol[62] -= b2d.z * sol[22]; sol[63] -= b2d.w * sol[22];
  __builtin_amdgcn_sched_barrier(0);
  b2a = *(const float4*)(Lr + 1520); b2b = *(const float4*)(Lr + 1524); b2c = *(const float4*)(Lr + 1528); b2d = *(const float4*)(Lr + 1532);
  __builtin_amdgcn_sched_barrier(0);
  sol[24] -= b0c.x * sol[23]; sol[25] -= b0c.y * sol[23]; sol[26] -= b0c.z * sol[23]; sol[27] -= b0c.w * sol[23]; sol[28] -= b0d.x * sol[23]; sol[29] -= b0d.y * sol[23]; sol[30] -= b0d.z * sol[23]; sol[31] -= b0d.w * sol[23];
  __builtin_amdgcn_sched_barrier(0);
  b0a = *(const float4*)(Lr + 1552); b0b = *(const float4*)(Lr + 1556); b0c = *(const float4*)(Lr + 1560); b0d = *(const float4*)(Lr + 1564);
  __builtin_amdgcn_sched_barrier(0);
  sol[32] -= b1a.x * sol[23]; sol[33] -= b1a.y * sol[23]; sol[34] -= b1a.z * sol[23]; sol[35] -= b1a.w * sol[23]; sol[36] -= b1b.x * sol[23]; sol[37] -= b1b.y * sol[23]; sol[38] -= b1b.z * sol[23]; sol[39] -= b1b.w * sol[23]; sol[40] -= b1c.x * sol[23]; sol[41] -= b1c.y * sol[23]; sol[42] -= b1c.z * sol[23]; sol[43] -= b1c.w * sol[23]; sol[44] -= b1d.x * sol[23]; sol[45] -= b1d.y * sol[23]; sol[46] -= b1d.z * sol[23]; sol[47] -= b1d.w * sol[23];
  __builtin_amdgcn_sched_barrier(0);
  b1a = *(const float4*)(Lr + 1568); b1b = *(const float4*)(Lr + 1572); b1c = *(const float4*)(Lr + 1576); b1d = *(const float4*)(Lr + 1580);
  __builtin_amdgcn_sched_barrier(0);
  sol[48] -= b2a.x * sol[23]; sol[49] -= b2a.y * sol[23]; sol[50] -= b2a.z * sol[23]; sol[51] -= b2a.w * sol[23]; sol[52] -= b2b.x * sol[23]; sol[53] -= b2b.y * sol[23]; sol[54] -= b2b.z * sol[23]; sol[55] -= b2b.w * sol[23]; sol[56] -= b2c.x * sol[23]; sol[57] -= b2c.y * sol[23]; sol[58] -= b2c.z * sol[23]; sol[59] -= b2c.w * sol[23]; sol[60] -= b2d.x * sol[23]; sol[61] -= b2d.y * sol[23]; sol[62] -= b2d.z * sol[23]; sol[63] -= b2d.w * sol[23];
  __builtin_amdgcn_sched_barrier(0);
  b2a = *(const float4*)(Lr + 1584); b2b = *(const float4*)(Lr + 1588); b2c = *(const float4*)(Lr + 1592); b2d = *(const float4*)(Lr + 1596);
  __builtin_amdgcn_sched_barrier(0);
  sol[25] -= b0c.y * sol[24]; sol[26] -= b0c.z * sol[24]; sol[27] -= b0c.w * sol[24]; sol[28] -= b0d.x * sol[24]; sol[29] -= b0d.y * sol[24]; sol[30] -= b0d.z * sol[24]; sol[31] -= b0d.w * sol[24];
  __builtin_amdgcn_sched_barrier(0);
  b0a = *(const float4*)(Lr + 1616); b0b = *(const float4*)(Lr + 1620); b0c = *(const float4*)(Lr + 1624); b0d = *(const float4*)(Lr + 1628);
  __builtin_amdgcn_sched_barrier(0);
  sol[32] -= b1a.x * sol[24]; sol[33] -= b1a.y * sol[24]; sol[34] -= b1a.z * sol[24]; sol[35] -= b1a.w * sol[24]; sol[36] -= b1b.x * sol[24]; sol[37] -= b1b.y * sol[24]; sol[38] -= b1b.z * sol[24]; sol[39] -= b1b.w * sol[24]; sol[40] -= b1c.x * sol[24]; sol[41] -= b1c.y * sol[24]; sol[42] -= b1c.z * sol[24]; sol[43] -= b1c.w * sol[24]; sol[44] -= b1d.x * sol[24]; sol[45] -= b1d.y * sol[24]; sol[46] -= b1d.z * sol[24]; sol[47] -= b1d.w * sol[24];
  __builtin_amdgcn_sched_barrier(0);
  b1a = *(const float4*)(Lr + 1632); b1b = *(const float4*)(Lr + 1636); b1c = *(const float4*)(Lr + 1640); b1d = *(const float4*)(Lr + 1644);
  __builtin_amdgcn_sched_barrier(0);
  sol[48] -= b2a.x * sol[24]; sol[49] -= b2a.y * sol[24]; sol[50] -= b2a.z * sol[24]; sol[51] -= b2a.w * sol[24]; sol[52] -= b2b.x * sol[24]; sol[53] -= b2b.y * sol[24]; sol[54] -= b2b.z * sol[24]; sol[55] -= b2b.w * sol[24]; sol[56] -= b2c.x * sol[24]; sol[57] -= b2c.y * sol[24]; sol[58] -= b2c.z * sol[24]; sol[59] -= b2c.w * sol[24]; sol[60] -= b2d.x * sol[24]; sol[61] -= b2d.y * sol[24]; sol[62] -= b2d.z * sol[24]; sol[63] -= b2d.w * sol[24];
  __builtin_amdgcn_sched_barrier(0);
  b2a = *(const float4*)(Lr + 1648); b2b = *(const float4*)(Lr + 1652); b2c = *(const float4*)(Lr + 1656); b2d = *(const float4*)(Lr + 1660);
  __builtin_amdgcn_sched_barrier(0);
  sol[26] -= b0c.z * sol[25]; sol[27] -= b0c.w * sol[25]; sol[28] -= b0d.x * sol[25]; sol[29] -= b0d.y * sol[25]; sol[30] -= b0d.z * sol[25]; sol[31] -= b0d.w * sol[25];
  __builtin_amdgcn_sched_barrier(0);
  b0a = *(const float4*)(Lr + 1680); b0b = *(const float4*)(Lr + 1684); b0c = *(const float4*)(Lr + 1688); b0d = *(const float4*)(Lr + 1692);
  __builtin_amdgcn_sched_barrier(0);
  sol[32] -= b1a.x * sol[25]; sol[33] -= b1a.y * sol[25]; sol[34] -= b1a.z * sol[25]; sol[35] -= b1a.w * sol[25]; sol[36] -= b1b.x * sol[25]; sol[37] -= b1b.y * sol[25]; sol[38] -= b1b.z * sol[25]; sol[39] -= b1b.w * sol[25]; sol[40] -= b1c.x * sol[25]; sol[41] -= b1c.y * sol[25]; sol[42] -= b1c.z * sol[25]; sol[43] -= b1c.w * sol[25]; sol[44] -= b1d.x * sol[25]; sol[45] -= b1d.y * sol[25]; sol[46] -= b1d.z * sol[25]; sol[47] -= b1d.w * sol[25];
  __builtin_amdgcn_sched_barrier(0);
  b1a = *(const float4*)(Lr + 1696); b1b = *(const float4*)(Lr + 1700); b1c = *(const float4*)(Lr + 1704); b1d = *(const float4*)(Lr + 1708);
  __builtin_amdgcn_sched_barrier(0);
  sol[48] -= b2a.x * sol[25]; sol[49] -= b2a.y * sol[25]; sol[50] -= b2a.z * sol[25]; sol[51] -= b2a.w * sol[25]; sol[52] -= b2b.x * sol[25]; sol[53] -= b2b.y * sol[25]; sol[54] -= b2b.z * sol[25]; sol[55] -= b2b.w * sol[25]; sol[56] -= b2c.x * sol[25]; sol[57] -= b2c.y * sol[25]; sol[58] -= b2c.z * sol[25]; sol[59] -= b2c.w * sol[25]; sol[60] -= b2d.x * sol[25]; sol[61] -= b2d.y * sol[25]; sol[62] -= b2d.z * sol[25]; sol[63] -= b2d.w * sol[25];
  __builtin_amdgcn_sched_barrier(0);
  b2a = *(const float4*)(Lr + 1712); b2b = *(const float4*)(Lr + 1716); b2c = *(const float4*)(Lr + 1720); b2d = *(const float4*)(Lr + 1724);
  __builtin_amdgcn_sched_barrier(0);
  sol[27] -= b0c.w * sol[26]; sol[28] -= b0d.x * sol[26]; sol[29] -= b0d.y * sol[26]; sol[30] -= b0d.z * sol[26]; sol[31] -= b0d.w * sol[26];
  __builtin_amdgcn_sched_barrier(0);
  b0a = *(const float4*)(Lr + 1744); b0b = *(const float4*)(Lr + 1748); b0c = *(const float4*)(Lr + 1752); b0d = *(const float4*)(Lr + 1756);
  __builtin_amdgcn_sched_barrier(0);
  sol[32] -= b1a.x * sol[26]; sol[33] -= b1a.y * sol[26]; sol[34] -= b1a.z * sol[26]; sol[35] -= b1a.w * sol[26]; sol[36] -= b1b.x * sol[26]; sol[37] -= b1b.y * sol[26]; sol[38] -= b1b.z * sol[26]; sol[39] -= b1b.w * sol[26]; sol[40] -= b1c.x * sol[26]; sol[41] -= b1c.y * sol[26]; sol[42] -= b1c.z * sol[26]; sol[43] -= b1c.w * sol[26]; sol[44] -= b1d.x * sol[26]; sol[45] -= b1d.y * sol[26]; sol[46] -= b1d.z * sol[26]; sol[47] -= b1d.w * sol[26];
  __builtin_amdgcn_sched_barrier(0);
  b1a = *(const float4*)(Lr + 1760); b1b = *(const float4*)(Lr + 1764); b1c = *(const float4*)(Lr + 1768); b1d = *(const float4*)(Lr + 1772);
  __builtin_amdgcn_sched_barrier(0);
  sol[48] -= b2a.x * sol[26]; sol[49] -= b2a.y * sol[26]; sol[50] -= b2a.z * sol[26]; sol[51] -= b2a.w * sol[26]; sol[52] -= b2b.x * sol[26]; sol[53] -= b2b.y * sol[26]; sol[54] -= b2b.z * sol[26]; sol[55] -= b2b.w * sol[26]; sol[56] -= b2c.x * sol[26]; sol[57] -= b2c.y * sol[26]; sol[58] -= b2c.z * sol[26]; sol[59] -= b2c.w * sol[26]; sol[60] -= b2d.x * sol[26]; sol[61] -= b2d.y * sol[26]; sol[62] -= b2d.z * sol[26]; sol[63] -= b2d.w * sol[26];
  __builtin_amdgcn_sched_barrier(0);
  b2a = *(const float4*)(Lr + 1776); b2b = *(const float4*)(Lr + 1780); b2c = *(const float4*)(Lr + 1784); b2d = *(const float4*)(Lr + 1788);
  __builtin_amdgcn_sched_barrier(0);
  sol[28] -= b0d.x * sol[27]; sol[29] -= b0d.y * sol[27]; sol[30] -= b0d.z * sol[27]; sol[31] -= b0d.w * sol[27];
  __builtin_amdgcn_sched_barrier(0);
  b0a = *(const float4*)(Lr + 1808); b0b = *(const float4*)(Lr + 1812); b0c = *(const float4*)(Lr + 1816); b0d = *(const float4*)(Lr + 1820);
  __builtin_amdgcn_sched_barrier(0);
  sol[32] -= b1a.x * sol[27]; sol[33] -= b1a.y * sol[27]; sol[34] -= b1a.z * sol[27]; sol[35] -= b1a.w * sol[27]; sol[36] -= b1b.x * sol[27]; sol[37] -= b1b.y * sol[27]; sol[38] -= b1b.z * sol[27]; sol[39] -= b1b.w * sol[27]; sol[40] -= b1c.x * sol[27]; sol[41] -= b1c.y * sol[27]; sol[42] -= b1c.z * sol[27]; sol[43] -= b1c.w * sol[27]; sol[44] -= b1d.x * sol[27]; sol[45] -= b1d.y * sol[27]; sol[46] -= b1d.z * sol[27]; sol[47] -= b1d.w * sol[27];
  __builtin_amdgcn_sched_barrier(0);
  b1a = *(const float4*)(Lr + 1824); b1b = *(const float4*)(Lr + 1828); b1c = *(const float4*)(Lr + 1832); b1d = *(const float4*)(Lr + 1836);
  __builtin_amdgcn_sched_barrier(0);
  sol[48] -= b2a.x * sol[27]; sol[49] -= b2a.y * sol[27]; sol[50] -= b2a.z * sol[27]; sol[51] -= b2a.w * sol[27]; sol[52] -= b2b.x * sol[27]; sol[53] -= b2b.y * sol[27]; sol[54] -= b2b.z * sol[27]; sol[55] -= b2b.w * sol[27]; sol[56] -= b2c.x * sol[27]; sol[57] -= b2c.y * sol[27]; sol[58] -= b2c.z * sol[27]; sol[59] -= b2c.w * sol[27]; sol[60] -= b2d.x * sol[27]; sol[61] -= b2d.y * sol[27]; sol[62] -= b2d.z * sol[27]; sol[63] -= b2d.w * sol[27];
  __builtin_amdgcn_sched_barrier(0);
  b2a = *(const float4*)(Lr + 1840); b2b = *(const float4*)(Lr + 1844); b2c = *(const float4*)(Lr + 1848); b2d = *(const float4*)(Lr + 1852);
  __builtin_amdgcn_sched_barrier(0);
  sol[29] -= b0d.y * sol[28]; sol[30] -= b0d.z * sol[28]; sol[31] -= b0d.w * sol[28];
  __builtin_amdgcn_sched_barrier(0);
  b0a = *(const float4*)(Lr + 1872); b0b = *(const float4*)(Lr + 1876); b0c = *(const float4*)(Lr + 1880); b0d = *(const float4*)(Lr + 1884);
  __builtin_amdgcn_sched_barrier(0);
  sol[32] -= b1a.x * sol[28]; sol[33] -= b1a.y * sol[28]; sol[34] -= b1a.z * sol[28]; sol[35] -= b1a.w * sol[28]; sol[36] -= b1b.x * sol[28]; sol[37] -= b1b.y * sol[28]; sol[38] -= b1b.z * sol[28]; sol[39] -= b1b.w * sol[28]; sol[40] -= b1c.x * sol[28]; sol[41] -= b1c.y * sol[28]; sol[42] -= b1c.z * sol[28]; sol[43] -= b1c.w * sol[28]; sol[44] -= b1d.x * sol[28]; sol[45] -= b1d.y * sol[28]; sol[46] -= b1d.z * sol[28]; sol[47] -= b1d.w * sol[28];
  __builtin_amdgcn_sched_barrier(0);
  b1a = *(const float4*)(Lr + 1888); b1b = *(const float4*)(Lr + 1892); b1c = *(const float4*)(Lr + 1896); b1d = *(const float4*)(Lr + 1900);
  __builtin_amdgcn_sched_barrier(0);
  sol[48] -= b2a.x * sol[28]; sol[49] -= b2a.y * sol[28]; sol[50] -= b2a.z * sol[28]; sol[51] -= b2a.w * sol[28]; sol[52] -= b2b.x * sol[28]; sol[53] -= b2b.y * sol[28]; sol[54] -= b2b.z * sol[28]; sol[55] -= b2b.w * sol[28]; sol[56] -= b2c.x * sol[28]; sol[57] -= b2c.y * sol[28]; sol[58] -= b2c.z * sol[28]; sol[59] -= b2c.w * sol[28]; sol[60] -= b2d.x * sol[28]; sol[61] -= b2d.y * sol[28]; sol[62] -= b2d.z * sol[28]; sol[63] -= b2d.w * sol[28];
  __builtin_amdgcn_sched_barrier(0);
  b2a = *(const float4*)(Lr + 1904); b2b = *(const float4*)(Lr + 1908); b2c = *(const float4*)(Lr + 1912); b2d = *(const float4*)(Lr + 1916);
  __builtin_amdgcn_sched_barrier(0);
  sol[30] -= b0d.z * sol[29]; sol[31] -= b0d.w * sol[29];
  __builtin_amdgcn_sched_barrier(0);
  b0a = *(const float4*)(Lr + 1936); b0b = *(const float4*)(Lr + 1940); b0c = *(const float4*)(Lr + 1944); b0d = *(const float4*)(Lr + 1948);
  __builtin_amdgcn_sched_barrier(0);
  sol[32] -= b1a.x * sol[29]; sol[33] -= b1a.y * sol[29]; sol[34] -= b1a.z * sol[29]; sol[35] -= b1a.w * sol[29]; sol[36] -= b1b.x * sol[29]; sol[37] -= b1b.y * sol[29]; sol[38] -= b1b.z * sol[29]; sol[39] -= b1b.w * sol[29]; sol[40] -= b1c.x * sol[29]; sol[41] -= b1c.y * sol[29]; sol[42] -= b1c.z * sol[29]; sol[43] -= b1c.w * sol[29]; sol[44] -= b1d.x * sol[29]; sol[45] -= b1d.y * sol[29]; sol[46] -= b1d.z * sol[29]; sol[47] -= b1d.w * sol[29];
  __builtin_amdgcn_sched_barrier(0);
  b1a = *(const float4*)(Lr + 1952); b1b = *(const float4*)(Lr + 1956); b1c = *(const float4*)(Lr + 1960); b1d = *(const float4*)(Lr + 1964);
  __builtin_amdgcn_sched_barrier(0);
  sol[48] -= b2a.x * sol[29]; sol[49] -= b2a.y * sol[29]; sol[50] -= b2a.z * sol[29]; sol[51] -= b2a.w * sol[29]; sol[52] -= b2b.x * sol[29]; sol[53] -= b2b.y * sol[29]; sol[54] -= b2b.z * sol[29]; sol[55] -= b2b.w * sol[29]; sol[56] -= b2c.x * sol[29]; sol[57] -= b2c.y * sol[29]; sol[58] -= b2c.z * sol[29]; sol[59] -= b2c.w * sol[29]; sol[60] -= b2d.x * sol[29]; sol[61] -= b2d.y * sol[29]; sol[62] -= b2d.z * sol[29]; sol[63] -= b2d.w * sol[29];
  __builtin_amdgcn_sched_barrier(0);
  b2a = *(const float4*)(Lr + 1968); b2b = *(const float4*)(Lr + 1972); b2c = *(const float4*)(Lr + 1976); b2d = *(const float4*)(Lr + 1980);
  __builtin_amdgcn_sched_barrier(0);
  sol[31] -= b0d.w * sol[30];
  __builtin_amdgcn_sched_barrier(0);
  b0a = *(const float4*)(Lr + 2016); b0b = *(const float4*)(Lr + 2020); b0c = *(const float4*)(Lr + 2024); b0d = *(const float4*)(Lr + 2028);
  __builtin_amdgcn_sched_barrier(0);
  sol[32] -= b1a.x * sol[30]; sol[33] -= b1a.y * sol[30]; sol[34] -= b1a.z * sol[30]; sol[35] -= b1a.w * sol[30]; sol[36] -= b1b.x * sol[30]; sol[37] -= b1b.y * sol[30]; sol[38] -= b1b.z * sol[30]; sol[39] -= b1b.w * sol[30]; sol[40] -= b1c.x * sol[30]; sol[41] -= b1c.y * sol[30]; sol[42] -= b1c.z * sol[30]; sol[43] -= b1c.w * sol[30]; sol[44] -= b1d.x * sol[30]; sol[45] -= b1d.y * sol[30]; sol[46] -= b1d.z * sol[30]; sol[47] -= b1d.w * sol[30];
  __builtin_amdgcn_sched_barrier(0);
  b1a = *(const float4*)(Lr + 2032); b1b = *(const float4*)(Lr + 2036); b1c = *(const float4*)(Lr + 2040); b1d = *(const float4*)(Lr + 2044);
  __builtin_amdgcn_sched_barrier(0);
  sol[48] -= b2a.x * sol[30]; sol[49] -= b2a.y * sol[30]; sol[50] -= b2a.z * sol[30]; sol[51] -= b2a.w * sol[30]; sol[52] -= b2b.x * sol[30]; sol[53] -= b2b.y * sol[30]; sol[54] -= b2b.z * sol[30]; sol[55] -= b2b.w * sol[30]; sol[56] -= b2c.x * sol[30]; sol[57] -= b2c.y * sol[30]; sol[58] -= b2c.z * sol[30]; sol[59] -= b2c.w * sol[30]; sol[60] -= b2d.x * sol[30]; sol[61] -= b2d.y * sol[30]; sol[62] -= b2d.z * sol[30]; sol[63] -= b2d.w * sol[30];
  __builtin_amdgcn_sched_barrier(0);
  b2a = *(const float4*)(Lr + 2080); b2b = *(const float4*)(Lr + 2084); b2c = *(const float4*)(Lr + 2088); b2d = *(const float4*)(Lr + 2092);
  __builtin_amdgcn_sched_barrier(0);
  sol[32] -= b0a.x * sol[31]; sol[33] -= b0a.y * sol[31]; sol[34] -= b0a.z * sol[31]; sol[35] -= b0a.w * sol[31]; sol[36] -= b0b.x * sol[31]; sol[37] -= b0b.y * sol[31]; sol[38] -= b0b.z * sol[31]; sol[39] -= b0b.w * sol[31]; sol[40] -= b0c.x * sol[31]; sol[41] -= b0c.y * sol[31]; sol[42] -= b0c.z * sol[31]; sol[43] -= b0c.w * sol[31]; sol[44] -= b0d.x * sol[31]; sol[45] -= b0d.y * sol[31]; sol[46] -= b0d.z * sol[31]; sol[47] -= b0d.w * sol[31];
  __builtin_amdgcn_sched_barrier(0);
  b0a = *(const float4*)(Lr + 2096); b0b = *(const float4*)(Lr + 2100); b0c = *(const float4*)(Lr + 2104); b0d = *(const float4*)(Lr + 2108);
  __builtin_amdgcn_sched_barrier(0);
  sol[48] -= b1a.x * sol[31]; sol[49] -= b1a.y * sol[31]; sol[50] -= b1a.z * sol[31]; sol[51] -= b1a.w * sol[31]; sol[52] -= b1b.x * sol[31]; sol[53] -= b1b.y * sol[31]; sol[54] -= b1b.z * sol[31]; sol[55] -= b1b.w * sol[31]; sol[56] -= b1c.x * sol[31]; sol[57] -= b1c.y * sol[31]; sol[58] -= b1c.z * sol[31]; sol[59] -= b1c.w * sol[31]; sol[60] -= b1d.x * sol[31]; sol[61] -= b1d.y * sol[31]; sol[62] -= b1d.z * sol[31]; sol[63] -= b1d.w * sol[31];
  __builtin_amdgcn_sched_barrier(0);
  b1a = *(const float4*)(Lr + 2144); b1b = *(const float4*)(Lr + 2148); b1c = *(const float4*)(Lr + 2152); b1d = *(const float4*)(Lr + 2156);
  __builtin_amdgcn_sched_barrier(0);
  sol[33] -= b2a.y * sol[32]; sol[34] -= b2a.z * sol[32]; sol[35] -= b2a.w * sol[32]; sol[36] -= b2b.x * sol[32]; sol[37] -= b2b.y * sol[32]; sol[38] -= b2b.z * sol[32]; sol[39] -= b2b.w * sol[32]; sol[40] -= b2c.x * sol[32]; sol[41] -= b2c.y * sol[32]; sol[42] -= b2c.z * sol[32]; sol[43] -= b2c.w * sol[32]; sol[44] -= b2d.x * sol[32]; sol[45] -= b2d.y * sol[32]; sol[46] -= b2d.z * sol[32]; sol[47] -= b2d.w * sol[32];
  __builtin_amdgcn_sched_barrier(0);
  b2a = *(const float4*)(Lr + 2160); b2b = *(const float4*)(Lr + 2164); b2c = *(const float4*)(Lr + 2168); b2d = *(const float4*)(Lr + 2172);
  __builtin_amdgcn_sched_barrier(0);
  sol[48] -= b0a.x * sol[32]; sol[49] -= b0a.y * sol[32]; sol[50] -= b0a.z * sol[32]; sol[51] -= b0a.w * sol[32]; sol[52] -= b0b.x * sol[32]; sol[53] -= b0b.y * sol[32]; sol[54] -= b0b.z * sol[32]; sol[55] -= b0b.w * sol[32]; sol[56] -= b0c.x * sol[32]; sol[57] -= b0c.y * sol[32]; sol[58] -= b0c.z * sol[32]; sol[59] -= b0c.w * sol[32]; sol[60] -= b0d.x * sol[32]; sol[61] -= b0d.y * sol[32]; sol[62] -= b0d.z * sol[32]; sol[63] -= b0d.w * sol[32];
  __builtin_amdgcn_sched_barrier(0);
  b0a = *(const float4*)(Lr + 2208); b0b = *(const float4*)(Lr + 2212); b0c = *(const float4*)(Lr + 2216); b0d = *(const float4*)(Lr + 2220);
  __builtin_amdgcn_sched_barrier(0);
  sol[34] -= b1a.z * sol[33]; sol[35] -= b1a.w * sol[33]; sol[36] -= b1b.x * sol[33]; sol[37] -= b1b.y * sol[33]; sol[38] -= b1b.z * sol[33]; sol[39] -= b1b.w * sol[33]; sol[40] -= b1c.x * sol[33]; sol[41] -= b1c.y * sol[33]; sol[42] -= b1c.z * sol[33]; sol[43] -= b1c.w * sol[33]; sol[44] -= b1d.x * sol[33]; sol[45] -= b1d.y * sol[33]; sol[46] -= b1d.z * sol[33]; sol[47] -= b1d.w * sol[33];
  __builtin_amdgcn_sched_barrier(0);
  b1a = *(const float4*)(Lr + 2224); b1b = *(const float4*)(Lr + 2228); b1c = *(const float4*)(Lr + 2232); b1d = *(const float4*)(Lr + 2236);
  __builtin_amdgcn_sched_barrier(0);
  sol[48] -= b2a.x * sol[33]; sol[49] -= b2a.y * sol[33]; sol[50] -= b2a.z * sol[33]; sol[51] -= b2a.w * sol[33]; sol[52] -= b2b.x * sol[33]; sol[53] -= b2b.y * sol[33]; sol[54] -= b2b.z * sol[33]; sol[55] -= b2b.w * sol[33]; sol[56] -= b2c.x * sol[33]; sol[57] -= b2c.y * sol[33]; sol[58] -= b2c.z * sol[33]; sol[59] -= b2c.w * sol[33]; sol[60] -= b2d.x * sol[33]; sol[61] -= b2d.y * sol[33]; sol[62] -= b2d.z * sol[33]; sol[63] -= b2d.w * sol[33];
  __builtin_amdgcn_sched_barrier(0);
  b2a = *(const float4*)(Lr + 2272); b2b = *(const float4*)(Lr + 2276); b2c = *(const float4*)(Lr + 2280); b2d = *(const float4*)(Lr + 2284);
  __builtin_amdgcn_sched_barrier(0);
  sol[35] -= b0a.w * sol[34]; sol[36] -= b0b.x * sol[34]; sol[37] -= b0b.y * sol[34]; sol[38] -= b0b.z * sol[34]; sol[39] -= b0b.w * sol[34]; sol[40] -= b0c.x * sol[34]; sol[41] -= b0c.y * sol[34]; sol[42] -= b0c.z * sol[34]; sol[43] -= b0c.w * sol[34]; sol[44] -= b0d.x * sol[34]; sol[45] -= b0d.y * sol[34]; sol[46] -= b0d.z * sol[34]; sol[47] -= b0d.w * sol[34];
  __builtin_amdgcn_sched_barrier(0);
  b0a = *(const float4*)(Lr + 2288); b0b = *(const float4*)(Lr + 2292); b0c = *(const float4*)(Lr + 2296); b0d = *(const float4*)(Lr + 2300);
  __builtin_amdgcn_sched_barrier(0);
  sol[48] -= b1a.x * sol[34]; sol[49] -= b1a.y * sol[34]; sol[50] -= b1a.z * sol[34]; sol[51] -= b1a.w * sol[34]; sol[52] -= b1b.x * sol[34]; sol[53] -= b1b.y * sol[34]; sol[54] -= b1b.z * sol[34]; sol[55] -= b1b.w * sol[34]; sol[56] -= b1c.x * sol[34]; sol[57] -= b1c.y * sol[34]; sol[58] -= b1c.z * sol[34]; sol[59] -= b1c.w * sol[34]; sol[60] -= b1d.x * sol[34]; sol[61] -= b1d.y * sol[34]; sol[62] -= b1d.z * sol[34]; sol[63] -= b1d.w * sol[34];
  __builtin_amdgcn_sched_barrier(0);
  b1a = *(const float4*)(Lr + 2336); b1b = *(const float4*)(Lr + 2340); b1c = *(const float4*)(Lr + 2344); b1d = *(const float4*)(Lr + 2348);
  __builtin_amdgcn_sched_barrier(0);
  sol[36] -= b2b.x * sol[35]; sol[37] -= b2b.y * sol[35]; sol[38] -= b2b.z * sol[35]; sol[39] -= b2b.w * sol[35]; sol[40] -= b2c.x * sol[35]; sol[41] -= b2c.y * sol[35]; sol[42] -= b2c.z * sol[35]; sol[43] -= b2c.w * sol[35]; sol[44] -= b2d.x * sol[35]; sol[45] -= b2d.y * sol[35]; sol[46] -= b2d.z * sol[35]; sol[47] -= b2d.w * sol[35];
  __builtin_amdgcn_sched_barrier(0);
  b2a = *(const float4*)(Lr + 2352); b2b = *(const float4*)(Lr + 2356); b2c = *(const float4*)(Lr + 2360); b2d = *(const float4*)(Lr + 2364);
  __builtin_amdgcn_sched_barrier(0);
  sol[48] -= b0a.x * sol[35]; sol[49] -= b0a.y * sol[35]; sol[50] -= b0a.z * sol[35]; sol[51] -= b0a.w * sol[35]; sol[52] -= b0b.x * sol[35]; sol[53] -= b0b.y * sol[35]; sol[54] -= b0b.z * sol[35]; sol[55] -= b0b.w * sol[35]; sol[56] -= b0c.x * sol[35]; sol[57] -= b0c.y * sol[35]; sol[58] -= b0c.z * sol[35]; sol[59] -= b0c.w * sol[35]; sol[60] -= b0d.x * sol[35]; sol[61] -= b0d.y * sol[35]; sol[62] -= b0d.z * sol[35]; sol[63] -= b0d.w * sol[35];
  __builtin_amdgcn_sched_barrier(0);
  b0a = *(const float4*)(Lr + 2400); b0b = *(const float4*)(Lr + 2404); b0c = *(const float4*)(Lr + 2408); b0d = *(const float4*)(Lr + 2412);
  __builtin_amdgcn_sched_barrier(0);
  sol[37] -= b1b.y * sol[36]; sol[38] -= b1b.z * sol[36]; sol[39] -= b1b.w * sol[36]; sol[40] -= b1c.x * sol[36]; sol[41] -= b1c.y * sol[36]; sol[42] -= b1c.z * sol[36]; sol[43] -= b1c.w * sol[36]; sol[44] -= b1d.x * sol[36]; sol[45] -= b1d.y * sol[36]; sol[46] -= b1d.z * sol[36]; sol[47] -= b1d.w * sol[36];
  __builtin_amdgcn_sched_barrier(0);
  b1a = *(const float4*)(Lr + 2416); b1b = *(const float4*)(Lr + 2420); b1c = *(const float4*)(Lr + 2424); b1d = *(const float4*)(Lr + 2428);
  __builtin_amdgcn_sched_barrier(0);
  sol[48] -= b2a.x * sol[36]; sol[49] -= b2a.y * sol[36]; sol[50] -= b2a.z * sol[36]; sol[51] -= b2a.w * sol[36]; sol[52] -= b2b.x * sol[36]; sol[53] -= b2b.y * sol[36]; sol[54] -= b2b.z * sol[36]; sol[55] -= b2b.w * sol[36]; sol[56] -= b2c.x * sol[36]; sol[57] -= b2c.y * sol[36]; sol[58] -= b2c.z * sol[36]; sol[59] -= b2c.w * sol[36]; sol[60] -= b2d.x * sol[36]; sol[61] -= b2d.y * sol[36]; sol[62] -= b2d.z * sol[36]; sol[63] -= b2d.w * sol[36];
  __builtin_amdgcn_sched_barrier(0);
  b2a = *(const float4*)(Lr + 2464); b2b = *(const float4*)(Lr + 2468); b2c = *(const float4*)(Lr + 2472); b2d = *(const float4*)(Lr + 2476);
  __builtin_amdgcn_sched_barrier(0);
  sol[38] -= b0b.z * sol[37]; sol[39] -= b0b.w * sol[37]; sol[40] -= b0c.x * sol[37]; sol[41] -= b0c.y * sol[37]; sol[42] -= b0c.z * sol[37]; sol[43] -= b0c.w * sol[37]; sol[44] -= b0d.x * sol[37]; sol[45] -= b0d.y * sol[37]; sol[46] -= b0d.z * sol[37]; sol[47] -= b0d.w * sol[37];
  __builtin_amdgcn_sched_barrier(0);
  b0a = *(const float4*)(Lr + 2480); b0b = *(const float4*)(Lr + 2484); b0c = *(const float4*)(Lr + 2488); b0d = *(const float4*)(Lr + 2492);
  __builtin_amdgcn_sched_barrier(0);
  sol[48] -= b1a.x * sol[37]; sol[49] -= b1a.y * sol[37]; sol[50] -= b1a.z * sol[37]; sol[51] -= b1a.w * sol[37]; sol[52] -= b1b.x * sol[37]; sol[53] -= b1b.y * sol[37]; sol[54] -= b1b.z * sol[37]; sol[55] -= b1b.w * sol[37]; sol[56] -= b1c.x * sol[37]; sol[57] -= b1c.y * sol[37]; sol[58] -= b1c.z * sol[37]; sol[59] -= b1c.w * sol[37]; sol[60] -= b1d.x * sol[37]; sol[61] -= b1d.y * sol[37]; sol[62] -= b1d.z * sol[37]; sol[63] -= b1d.w * sol[37];
  __builtin_amdgcn_sched_barrier(0);
  b1a = *(const float4*)(Lr + 2528); b1b = *(const float4*)(Lr + 2532); b1c = *(const float4*)(Lr + 2536); b1d = *(const float4*)(Lr + 2540);
  __builtin_amdgcn_sched_barrier(0);
  sol[39] -= b2b.w * sol[38]; sol[40] -= b2c.x * sol[38]; sol[41] -= b2c.y * sol[38]; sol[42] -= b2c.z * sol[38]; sol[43] -= b2c.w * sol[38]; sol[44] -= b2d.x * sol[38]; sol[45] -= b2d.y * sol[38]; sol[46] -= b2d.z * sol[38]; sol[47] -= b2d.w * sol[38];
  __builtin_amdgcn_sched_barrier(0);
  b2a = *(const float4*)(Lr + 2544); b2b = *(const float4*)(Lr + 2548); b2c = *(const float4*)(Lr + 2552); b2d = *(const float4*)(Lr + 2556);
  __builtin_amdgcn_sched_barrier(0);
  sol[48] -= b0a.x * sol[38]; sol[49] -= b0a.y * sol[38]; sol[50] -= b0a.z * sol[38]; sol[51] -= b0a.w * sol[38]; sol[52] -= b0b.x * sol[38]; sol[53] -= b0b.y * sol[38]; sol[54] -= b0b.z * sol[38]; sol[55] -= b0b.w * sol[38]; sol[56] -= b0c.x * sol[38]; sol[57] -= b0c.y * sol[38]; sol[58] -= b0c.z * sol[38]; sol[59] -= b0c.w * sol[38]; sol[60] -= b0d.x * sol[38]; sol[61] -= b0d.y * sol[38]; sol[62] -= b0d.z * sol[38]; sol[63] -= b0d.w * sol[38];
  __builtin_amdgcn_sched_barrier(0);
  b0a = *(const float4*)(Lr + 2592); b0b = *(const float4*)(Lr + 2596); b0c = *(const float4*)(Lr + 2600); b0d = *(const float4*)(Lr + 2604);
  __builtin_amdgcn_sched_barrier(0);
  sol[40] -= b1c.x * sol[39]; sol[41] -= b1c.y * sol[39]; sol[42] -= b1c.z * sol[39]; sol[43] -= b1c.w * sol[39]; sol[44] -= b1d.x * sol[39]; sol[45] -= b1d.y * sol[39]; sol[46] -= b1d.z * sol[39]; sol[47] -= b1d.w * sol[39];
  __builtin_amdgcn_sched_barrier(0);
  b1a = *(const float4*)(Lr + 2608); b1b = *(const float4*)(Lr + 2612); b1c = *(const float4*)(Lr + 2616); b1d = *(const float4*)(Lr + 2620);
  __builtin_amdgcn_sched_barrier(0);
  sol[48] -= b2a.x * sol[39]; sol[49] -= b2a.y * sol[39]; sol[50] -= b2a.z * sol[39]; sol[51] -= b2a.w * sol[39]; sol[52] -= b2b.x * sol[39]; sol[53] -= b2b.y * sol[39]; sol[54] -= b2b.z * sol[39]; sol[55] -= b2b.w * sol[39]; sol[56] -= b2c.x * sol[39]; sol[57] -= b2c.y * sol[39]; sol[58] -= b2c.z * sol[39]; sol[59] -= b2c.w * sol[39]; sol[60] -= b2d.x * sol[39]; sol[61] -= b2d.y * sol[39]; sol[62] -= b2d.z * sol[39]; sol[63] -= b2d.w * sol[39];
  __builtin_amdgcn_sched_barrier(0);
  b2a = *(const float4*)(Lr + 2656); b2b = *(const float4*)(Lr + 2660); b2c = *(const float4*)(Lr + 2664); b2d = *(const float4*)(Lr + 2668);
  __builtin_amdgcn_sched_barrier(0);
  sol[41] -= b0c.y * sol[40]; sol[42] -= b0c.z * sol[40]; sol[43] -= b0c.w * sol[40]; sol[44] -= b0d.x * sol[40]; sol[45] -= b0d.y * sol[40]; sol[46] -= b0d.z * sol[40]; sol[47] -= b0d.w * sol[40];
  __builtin_amdgcn_sched_barrier(0);
  b0a = *(const float4*)(Lr + 2672); b0b = *(const float4*)(Lr + 2676); b0c = *(const float4*)(Lr + 2680); b0d = *(const float4*)(Lr + 2684);
  __builtin_amdgcn_sched_barrier(0);
  sol[48] -= b1a.x * sol[40]; sol[49] -= b1a.y * sol[40]; sol[50] -= b1a.z * sol[40]; sol[51] -= b1a.w * sol[40]; sol[52] -= b1b.x * sol[40]; sol[53] -= b1b.y * sol[40]; sol[54] -= b1b.z * sol[40]; sol[55] -= b1b.w * sol[40]; sol[56] -= b1c.x * sol[40]; sol[57] -= b1c.y * sol[40]; sol[58] -= b1c.z * sol[40]; sol[59] -= b1c.w * sol[40]; sol[60] -= b1d.x * sol[40]; sol[61] -= b1d.y * sol[40]; sol[62] -= b1d.z * sol[40]; sol[63] -= b1d.w * sol[40];
  __builtin_amdgcn_sched_barrier(0);
  b1a = *(const float4*)(Lr + 2720); b1b = *(const float4*)(Lr + 2724); b1c = *(const float4*)(Lr + 2728); b1d = *(const float4*)(Lr + 2732);
  __builtin_amdgcn_sched_barrier(0);
  sol[42] -= b2c.z * sol[41]; sol[43] -= b2c.w * sol[41]; sol[44] -= b2d.x * sol[41]; sol[45] -= b2d.y * sol[41]; sol[46] -= b2d.z * sol[41]; sol[47] -= b2d.w * sol[41];
  __builtin_amdgcn_sched_barrier(0);
  b2a = *(const float4*)(Lr + 2736); b2b = *(const float4*)(Lr + 2740); b2c = *(const float4*)(Lr + 2744); b2d = *(const float4*)(Lr + 2748);
  __builtin_amdgcn_sched_barrier(0);
  sol[48] -= b0a.x * sol[41]; sol[49] -= b0a.y * sol[41]; sol[50] -= b0a.z * sol[41]; sol[51] -= b0a.w * sol[41]; sol[52] -= b0b.x * sol[41]; sol[53] -= b0b.y * sol[41]; sol[54] -= b0b.z * sol[41]; sol[55] -= b0b.w * sol[41]; sol[56] -= b0c.x * sol[41]; sol[57] -= b0c.y * sol[41]; sol[58] -= b0c.z * sol[41]; sol[59] -= b0c.w * sol[41]; sol[60] -= b0d.x * sol[41]; sol[61] -= b0d.y * sol[41]; sol[62] -= b0d.z * sol[41]; sol[63] -= b0d.w * sol[41];
  __builtin_amdgcn_sched_barrier(0);
  b0a = *(const float4*)(Lr + 2784); b0b = *(const float4*)(Lr + 2788); b0c = *(const float4*)(Lr + 2792); b0d = *(const float4*)(Lr + 2796);
  __builtin_amdgcn_sched_barrier(0);
  sol[43] -= b1c.w * sol[42]; sol[44] -= b1d.x * sol[42]; sol[45] -= b1d.y * sol[42]; sol[46] -= b1d.z * sol[42]; sol[47] -= b1d.w * sol[42];
  __builtin_amdgcn_sched_barrier(0);
  b1a = *(const float4*)(Lr + 2800); b1b = *(const float4*)(Lr + 2804); b1c = *(const float4*)(Lr + 2808); b1d = *(const float4*)(Lr + 2812);
  __builtin_amdgcn_sched_barrier(0);
  sol[48] -= b2a.x * sol[42]; sol[49] -= b2a.y * sol[42]; sol[50] -= b2a.z * sol[42]; sol[51] -= b2a.w * sol[42]; sol[52] -= b2b.x * sol[42]; sol[53] -= b2b.y * sol[42]; sol[54] -= b2b.z * sol[42]; sol[55] -= b2b.w * sol[42]; sol[56] -= b2c.x * sol[42]; sol[57] -= b2c.y * sol[42]; sol[58] -= b2c.z * sol[42]; sol[59] -= b2c.w * sol[42]; sol[60] -= b2d.x * sol[42]; sol[61] -= b2d.y * sol[42]; sol[62] -= b2d.z * sol[42]; sol[63] -= b2d.w * sol[42];
  __builtin_amdgcn_sched_barrier(0);
  b2a = *(const float4*)(Lr + 2848); b2b = *(const float4*)(Lr + 2852); b2c = *(const float4*)(Lr + 2856); b2d = *(const float4*)(Lr + 2860);
  __builtin_amdgcn_sched_barrier(0);
  sol[44] -= b0d.x * sol[43]; sol[45] -= b0d.y * sol[43]; sol[46] -= b0d.z * sol[43]; sol[47] -= b0d.w * sol[43];
  __builtin_amdgcn_sched_barrier(0);
  b0a = *(const float4*)(Lr + 2864); b0b = *(const float4*)(Lr + 2868); b0c = *(const float4*)(Lr + 2872); b0d = *(const float4*)(Lr + 2876);
  __builtin_amdgcn_sched_barrier(0);
  sol[48] -= b1a.x * sol[43]; sol[49] -= b1a.y * sol[43]; sol[50] -= b1a.z * sol[43]; sol[51] -= b1a.w * sol[43]; sol[52] -= b1b.x * sol[43]; sol[53] -= b1b.y * sol[43]; sol[54] -= b1b.z * sol[43]; sol[55] -= b1b.w * sol[43]; sol[56] -= b1c.x * sol[43]; sol[57] -= b1c.y * sol[43]; sol[58] -= b1c.z * sol[43]; sol[59] -= b1c.w * sol[43]; sol[60] -= b1d.x * sol[43]; sol[61] -= b1d.y * sol[43]; sol[62] -= b1d.z * sol[43]; sol[63] -= b1d.w * sol[43];
  __builtin_amdgcn_sched_barrier(0);
  b1a = *(const float4*)(Lr + 2912); b1b = *(const float4*)(Lr + 2916); b1c = *(const float4*)(Lr + 2920); b1d = *(const float4*)(Lr + 2924);
  __builtin_amdgcn_sched_barrier(0);
  sol[45] -= b2d.y * sol[44]; sol[46] -= b2d.z * sol[44]; sol[47] -= b2d.w * sol[44];
  __builtin_amdgcn_sched_barrier(0);
  b2a = *(const float4*)(Lr + 2928); b2b = *(const float4*)(Lr + 2932); b2c = *(const float4*)(Lr + 2936); b2d = *(const float4*)(Lr + 2940);
  __builtin_amdgcn_sched_barrier(0);
  sol[48] -= b0a.x * sol[44]; sol[49] -= b0a.y * sol[44]; sol[50] -= b0a.z * sol[44]; sol[51] -= b0a.w * sol[44]; sol[52] -= b0b.x * sol[44]; sol[53] -= b0b.y * sol[44]; sol[54] -= b0b.z * sol[44]; sol[55] -= b0b.w * sol[44]; sol[56] -= b0c.x * sol[44]; sol[57] -= b0c.y * sol[44]; sol[58] -= b0c.z * sol[44]; sol[59] -= b0c.w * sol[44]; sol[60] -= b0d.x * sol[44]; sol[61] -= b0d.y * sol[44]; sol[62] -= b0d.z * sol[44]; sol[63] -= b0d.w * sol[44];
  __builtin_amdgcn_sched_barrier(0);
  b0a = *(const float4*)(Lr + 2976); b0b = *(const float4*)(Lr + 2980); b0c = *(const float4*)(Lr + 2984); b0d = *(const float4*)(Lr + 2988);
  __builtin_amdgcn_sched_barrier(0);
  sol[46] -= b1d.z * sol[45]; sol[47] -= b1d.w * sol[45];
  __builtin_amdgcn_sched_barrier(0);
  b1a = *(const float4*)(Lr + 2992); b1b = *(const float4*)(Lr + 2996); b1c = *(const float4*)(Lr + 3000); b1d = *(const float4*)(Lr + 3004);
  __builtin_amdgcn_sched_barrier(0);
  sol[48] -= b2a.x * sol[45]; sol[49] -= b2a.y * sol[45]; sol[50] -= b2a.z * sol[45]; sol[51] -= b2a.w * sol[45]; sol[52] -= b2b.x * sol[45]; sol[53] -= b2b.y * sol[45]; sol[54] -= b2b.z * sol[45]; sol[55] -= b2b.w * sol[45]; sol[56] -= b2c.x * sol[45]; sol[57] -= b2c.y * sol[45]; sol[58] -= b2c.z * sol[45]; sol[59] -= b2c.w * sol[45]; sol[60] -= b2d.x * sol[45]; sol[61] -= b2d.y * sol[45]; sol[62] -= b2d.z * sol[45]; sol[63] -= b2d.w * sol[45];
  __builtin_amdgcn_sched_barrier(0);
  b2a = *(const float4*)(Lr + 3056); b2b = *(const float4*)(Lr + 3060); b2c = *(const float4*)(Lr + 3064); b2d = *(const float4*)(Lr + 3068);
  __builtin_amdgcn_sched_barrier(0);
  sol[47] -= b0d.w * sol[46];
  __builtin_amdgcn_sched_barrier(0);
  b0a = *(const float4*)(Lr + 3120); b0b = *(const float4*)(Lr + 3124); b0c = *(const float4*)(Lr + 3128); b0d = *(const float4*)(Lr + 3132);
  __builtin_amdgcn_sched_barrier(0);
  sol[48] -= b1a.x * sol[46]; sol[49] -= b1a.y * sol[46]; sol[50] -= b1a.z * sol[46]; sol[51] -= b1a.w * sol[46]; sol[52] -= b1b.x * sol[46]; sol[53] -= b1b.y * sol[46]; sol[54] -= b1b.z * sol[46]; sol[55] -= b1b.w * sol[46]; sol[56] -= b1c.x * sol[46]; sol[57] -= b1c.y * sol[46]; sol[58] -= b1c.z * sol[46]; sol[59] -= b1c.w * sol[46]; sol[60] -= b1d.x * sol[46]; sol[61] -= b1d.y * sol[46]; sol[62] -= b1d.z * sol[46]; sol[63] -= b1d.w * sol[46];
  __builtin_amdgcn_sched_barrier(0);
  b1a = *(const float4*)(Lr + 3184); b1b = *(const float4*)(Lr + 3188); b1c = *(const float4*)(Lr + 3192); b1d = *(const float4*)(Lr + 3196);
  __builtin_amdgcn_sched_barrier(0);
  sol[48] -= b2a.x * sol[47]; sol[49] -= b2a.y * sol[47]; sol[50] -= b2a.z * sol[47]; sol[51] -= b2a.w * sol[47]; sol[52] -= b2b.x * sol[47]; sol[53] -= b2b.y * sol[47]; sol[54] -= b2b.z * sol[47]; sol[55] -= b2b.w * sol[47]; sol[56] -= b2c.x * sol[47]; sol[57] -= b2c.y * sol[47]; sol[58] -= b2c.z * sol[47]; sol[59] -= b2c.w * sol[47]; sol[60] -= b2d.x * sol[47]; sol[61] -= b2d.y * sol[47]; sol[62] -= b2d.z * sol[47]; sol[63] -= b2d.w * sol[47];
  __builtin_amdgcn_sched_barrier(0);
  b2a = *(const float4*)(Lr + 3248); b2b = *(const float4*)(Lr + 3252); b2c = *(const float4*)(Lr + 3256); b2d = *(const float4*)(Lr + 3260);
  __builtin_amdgcn_sched_barrier(0);
  sol[49] -= b0a.y * sol[48]; sol[50] -= b0a.z * sol[48]; sol[51] -= b0a.w * sol[48]; sol[52] -= b0b.x * sol[48]; sol[53] -= b0b.y * sol[48]; sol[54] -= b0b.z * sol[48]; sol[55] -= b0b.w * sol[48]; sol[56] -= b0c.x * sol[48]; sol[57] -= b0c.y * sol[48]; sol[58] -= b0c.z * sol[48]; sol[59] -= b0c.w * sol[48]; sol[60] -= b0d.x * sol[48]; sol[61] -= b0d.y * sol[48]; sol[62] -= b0d.z * sol[48]; sol[63] -= b0d.w * sol[48];
  __builtin_amdgcn_sched_barrier(0);
  b0a = *(const float4*)(Lr + 3312); b0b = *(const float4*)(Lr + 3316); b0c = *(const float4*)(Lr + 3320); b0d = *(const float4*)(Lr + 3324);
  __builtin_amdgcn_sched_barrier(0);
  sol[50] -= b1a.z * sol[49]; sol[51] -= b1a.w * sol[49]; sol[52] -= b1b.x * sol[49]; sol[53] -= b1b.y * sol[49]; sol[54] -= b1b.z * sol[49]; sol[55] -= b1b.w * sol[49]; sol[56] -= b1c.x * sol[49]; sol[57] -= b1c.y * sol[49]; sol[58] -= b1c.z * sol[49]; sol[59] -= b1c.w * sol[49]; sol[60] -= b1d.x * sol[49]; sol[61] -= b1d.y * sol[49]; sol[62] -= b1d.z * sol[49]; sol[63] -= b1d.w * sol[49];
  __builtin_amdgcn_sched_barrier(0);
  b1a = *(const float4*)(Lr + 3376); b1b = *(const float4*)(Lr + 3380); b1c = *(const float4*)(Lr + 3384); b1d = *(const float4*)(Lr + 3388);
  __builtin_amdgcn_sched_barrier(0);
  sol[51] -= b2a.w * sol[50]; sol[52] -= b2b.x * sol[50]; sol[53] -= b2b.y * sol[50]; sol[54] -= b2b.z * sol[50]; sol[55] -= b2b.w * sol[50]; sol[56] -= b2c.x * sol[50]; sol[57] -= b2c.y * sol[50]; sol[58] -= b2c.z * sol[50]; sol[59] -= b2c.w * sol[50]; sol[60] -= b2d.x * sol[50]; sol[61] -= b2d.y * sol[50]; sol[62] -= b2d.z * sol[50]; sol[63] -= b2d.w * sol[50];
  __builtin_amdgcn_sched_barrier(0);
  b2a = *(const float4*)(Lr + 3440); b2b = *(const float4*)(Lr + 3444); b2c = *(const float4*)(Lr + 3448); b2d = *(const float4*)(Lr + 3452);
  __builtin_amdgcn_sched_barrier(0);
  sol[52] -= b0b.x * sol[51]; sol[53] -= b0b.y * sol[51]; sol[54] -= b0b.z * sol[51]; sol[55] -= b0b.w * sol[51]; sol[56] -= b0c.x * sol[51]; sol[57] -= b0c.y * sol[51]; sol[58] -= b0c.z * sol[51]; sol[59] -= b0c.w * sol[51]; sol[60] -= b0d.x * sol[51]; sol[61] -= b0d.y * sol[51]; sol[62] -= b0d.z * sol[51]; sol[63] -= b0d.w * sol[51];
  __builtin_amdgcn_sched_barrier(0);
  b0a = *(const float4*)(Lr + 3504); b0b = *(const float4*)(Lr + 3508); b0c = *(const float4*)(Lr + 3512); b0d = *(const float4*)(Lr + 3516);
  __builtin_amdgcn_sched_barrier(0);
  sol[53] -= b1b.y * sol[52]; sol[54] -= b1b.z * sol[52]; sol[55] -= b1b.w * sol[52]; sol[56] -= b1c.x * sol[52]; sol[57] -= b1c.y * sol[52]; sol[58] -= b1c.z * sol[52]; sol[59] -= b1c.w * sol[52]; sol[60] -= b1d.x * sol[52]; sol[61] -= b1d.y * sol[52]; sol[62] -= b1d.z * sol[52]; sol[63] -= b1d.w * sol[52];
  __builtin_amdgcn_sched_barrier(0);
  b1a = *(const float4*)(Lr + 3568); b1b = *(const float4*)(Lr + 3572); b1c = *(const float4*)(Lr + 3576); b1d = *(const float4*)(Lr + 3580);
  __builtin_amdgcn_sched_barrier(0);
  sol[54] -= b2b.z * sol[53]; sol[55] -= b2b.w * sol[53]; sol[56] -= b2c.x * sol[53]; sol[57] -= b2c.y * sol[53]; sol[58] -= b2c.z * sol[53]; sol[59] -= b2c.w * sol[53]; sol[60] -= b2d.x * sol[53]; sol[61] -= b2d.y * sol[53]; sol[62] -= b2d.z * sol[53]; sol[63] -= b2d.w * sol[53];
  __builtin_amdgcn_sched_barrier(0);
  b2a = *(const float4*)(Lr + 3632); b2b = *(const float4*)(Lr + 3636); b2c = *(const float4*)(Lr + 3640); b2d = *(const float4*)(Lr + 3644);
  __builtin_amdgcn_sched_barrier(0);
  sol[55] -= b0b.w * sol[54]; sol[56] -= b0c.x * sol[54]; sol[57] -= b0c.y * sol[54]; sol[58] -= b0c.z * sol[54]; sol[59] -= b0c.w * sol[54]; sol[60] -= b0d.x * sol[54]; sol[61] -= b0d.y * sol[54]; sol[62] -= b0d.z * sol[54]; sol[63] -= b0d.w * sol[54];
  __builtin_amdgcn_sched_barrier(0);
  b0a = *(const float4*)(Lr + 3696); b0b = *(const float4*)(Lr + 3700); b0c = *(const float4*)(Lr + 3704); b0d = *(const float4*)(Lr + 3708);
  __builtin_amdgcn_sched_barrier(0);
  sol[56] -= b1c.x * sol[55]; sol[57] -= b1c.y * sol[55]; sol[58] -= b1c.z * sol[55]; sol[59] -= b1c.w * sol[55]; sol[60] -= b1d.x * sol[55]; sol[61] -= b1d.y * sol[55]; sol[62] -= b1d.z * sol[55]; sol[63] -= b1d.w * sol[55];
  __builtin_amdgcn_sched_barrier(0);
  b1a = *(const float4*)(Lr + 3760); b1b = *(const float4*)(Lr + 3764); b1c = *(const float4*)(Lr + 3768); b1d = *(const float4*)(Lr + 3772);
  __builtin_amdgcn_sched_barrier(0);
  sol[57] -= b2c.y * sol[56]; sol[58] -= b2c.z * sol[56]; sol[59] -= b2c.w * sol[56]; sol[60] -= b2d.x * sol[56]; sol[61] -= b2d.y * sol[56]; sol[62] -= b2d.z * sol[56]; sol[63] -= b2d.w * sol[56];
  __builtin_amdgcn_sched_barrier(0);
  b2a = *(const float4*)(Lr + 3824); b2b = *(const float4*)(Lr + 3828); b2c = *(const float4*)(Lr + 3832); b2d = *(const float4*)(Lr + 3836);
  __builtin_amdgcn_sched_barrier(0);
  sol[58] -= b0c.z * sol[57]; sol[59] -= b0c.w * sol[57]; sol[60] -= b0d.x * sol[57]; sol[61] -= b0d.y * sol[57]; sol[62] -= b0d.z * sol[57]; sol[63] -= b0d.w * sol[57];
  __builtin_amdgcn_sched_barrier(0);
  b0a = *(const float4*)(Lr + 3888); b0b = *(const float4*)(Lr + 3892); b0c = *(const float4*)(Lr + 3896); b0d = *(const float4*)(Lr + 3900);
  __builtin_amdgcn_sched_barrier(0);
  sol[59] -= b1c.w * sol[58]; sol[60] -= b1d.x * sol[58]; sol[61] -= b1d.y * sol[58]; sol[62] -= b1d.z * sol[58]; sol[63] -= b1d.w * sol[58];
  __builtin_amdgcn_sched_barrier(0);
  b1a = *(const float4*)(Lr + 3952); b1b = *(const float4*)(Lr + 3956); b1c = *(const float4*)(Lr + 3960); b1d = *(const float4*)(Lr + 3964);
  __builtin_amdgcn_sched_barrier(0);
  sol[60] -= b2d.x * sol[59]; sol[61] -= b2d.y * sol[59]; sol[62] -= b2d.z * sol[59]; sol[63] -= b2d.w * sol[59];
  __builtin_amdgcn_sched_barrier(0);
  b2a = *(const float4*)(Lr + 4016); b2b = *(const float4*)(Lr + 4020); b2c = *(const float4*)(Lr + 4024); b2d = *(const float4*)(Lr + 4028);
  __builtin_amdgcn_sched_barrier(0);
  sol[61] -= b0d.y * sol[60]; sol[62] -= b0d.z * sol[60]; sol[63] -= b0d.w * sol[60];
  __builtin_amdgcn_sched_barrier(0);
  __builtin_amdgcn_sched_barrier(0);
  sol[62] -= b1d.z * sol[61]; sol[63] -= b1d.w * sol[61];
  __builtin_amdgcn_sched_barrier(0);
  __builtin_amdgcn_sched_barrier(0);
  sol[63] -= b2d.w * sol[62];
  __builtin_amdgcn_sched_barrier(0);
}

template <int DIR>
__device__ __forceinline__ void solve_cols(const Params& P, int itb, int c, const float* Lt, const float* bpp, const float* gcp,
                                           const u16* Vs, const u16* Ks) {
  float sol[64];
  const float* bp_ = bpp + DIR * 64;
  const float* gc_ = gcp + DIR * 64;
  if (c < 128) {
    const u16* vp = Vs + c;
#pragma unroll
    for (int p = 0; p < 64; ++p) sol[p] = bp_[p] * bf2f(vp[(DIR ? (63 - p) : p) * 136]);
  } else {
    const u16* kp = Ks + (c - 128);
#pragma unroll
    for (int p = 0; p < 64; ++p) sol[p] = bp_[p] * __expf(gc_[p]) * bf2f(kp[(DIR ? (63 - p) : p) * 136]);
  }
  const float* Lr = Lt + opq(DIR * 4096);
  solve_elim(sol, Lr);
  const size_t it2 = (size_t)(itb + DIR);
  if (c < 128) {
    u16* UF = (u16*)(P.ws + OFF_UF) + (it2 * 128 + c) * 64;
#pragma unroll
    for (int q = 0; q < 8; ++q) *(uint4*)(UF + q * 8) = pack8(sol + q * 8);
  } else {
    u16* Wg = (u16*)(P.ws + OFF_R2) + it2 * 8192 + (c - 128);
#pragma unroll
    for (int p = 0; p < 64; ++p) Wg[p * 128] = f2bf(-sol[p]);
  }
}

__device__ __forceinline__ void delta_prep_item(const Params& P, int item, char* lds) {
  const int tid = opq(threadIdx.x), lane = tid & 63, wv = tid >> 6, fr = lane & 15, fq = lane >> 4;
  const int cid = item >> 2, h = item & 3;
  const int row0 = cid * 64;
  int seq_lo, seq_hi;
  if (cid < 256) { seq_lo = (cid >> 6) * 4096; seq_hi = seq_lo + 4096; }
  else { seq_lo = 16384 + ((cid - 256) >> 2) * 256; seq_hi = seq_lo + 256; }
  u16* Qs = (u16*)(lds + opq(0));
  u16* Ks = (u16*)(lds + opq(17408));
  u16* Vs = (u16*)(lds + opq(34816));
  float* KKs = (float*)(lds + opq(52224));
  float* QKs = (float*)(lds + opq(69632));
  float* Lt = (float*)(lds + opq(87040));
  float* gtok = (float*)(lds + opq(119808));
  float* btok = gtok + 128;
  float* gcp = btok + 128;
  float* bpp = gcp + 128;
  u16* QKN = (u16*)((char*)P.out + OFF_QKN);
  __syncthreads();
  {
    const int j = tid >> 3, sg = tid & 7;
    const int row = row0 + j;
    const bool hm = (row - 1 >= seq_lo), hp = (row + 1 < seq_hi);
    const u16* qkv = (const u16*)(P.ws + OFF_R3);
#pragma unroll
    for (int s = 0; s < 3; ++s) {
      const int col = s * 512 + h * 128 + sg * 16;
      const u16* p0 = qkv + (size_t)row * 1536 + col;
      float y[16];
      float ssq = 0.f;
#pragma unroll
      for (int hh = 0; hh < 2; ++hh) {
        const uint4 c0 = *(const uint4*)(p0 + hh * 8);
        uint4 m0 = *(const uint4*)(p0 - (hm ? 1536 : 0) + hh * 8);
        uint4 n0 = *(const uint4*)(p0 + (hp ? 1536 : 0) + hh * 8);
        m0.x = hm ? m0.x : 0u; m0.y = hm ? m0.y : 0u; m0.z = hm ? m0.z : 0u; m0.w = hm ? m0.w : 0u;
        n0.x = hp ? n0.x : 0u; n0.y = hp ? n0.y : 0u; n0.z = hp ? n0.z : 0u; n0.w = hp ? n0.w : 0u;
        float fc[8], fm[8], fn[8];
        unpack8(c0, fc); unpack8(m0, fm); unpack8(n0, fn);
        const float* cwp = P.dn_conv_w + col + hh * 8;
        float cw0[8], cw1[8], cw2[8];
        {
          const float4 t0 = *(const float4*)(cwp), t1 = *(const float4*)(cwp + 4);
          const float4 t2 = *(const float4*)(cwp + 1536), t3 = *(const float4*)(cwp + 1540);
          const float4 t4 = *(const float4*)(cwp + 3072), t5 = *(const float4*)(cwp + 3076);
          cw0[0] = t0.x; cw0[1] = t0.y; cw0[2] = t0.z; cw0[3] = t0.w; cw0[4] = t1.x; cw0[5] = t1.y; cw0[6] = t1.z; cw0[7] = t1.w;
          cw1[0] = t2.x; cw1[1] = t2.y; cw1[2] = t2.z; cw1[3] = t2.w; cw1[4] = t3.x; cw1[5] = t3.y; cw1[6] = t3.z; cw1[7] = t3.w;
          cw2[0] = t4.x; cw2[1] = t4.y; cw2[2] = t4.z; cw2[3] = t4.w; cw2[4] = t5.x; cw2[5] = t5.y; cw2[6] = t5.z; cw2[7] = t5.w;
        }
#pragma unroll
        for (int e = 0; e < 8; ++e) {
          const float v = cw0[e] * fm[e] + cw1[e] * fc[e] + cw2[e] * fn[e];
          const float yy = v * sigm(v);
          y[hh * 8 + e] = yy;
          ssq += yy * yy;
        }
      }
      if (s < 2) {
        ssq += __shfl_xor(ssq, 1, 64); ssq += __shfl_xor(ssq, 2, 64); ssq += __shfl_xor(ssq, 4, 64);
        const float sc = rsqrtf(ssq + 1e-6f) * ((s == 0) ? 0.08838834764831845f : 1.f);
#pragma unroll
        for (int e = 0; e < 16; ++e) y[e] *= sc;
      }
      u16* dl = ((s == 0) ? Qs : ((s == 1) ? Ks : Vs)) + j * 136 + sg * 16;
      const uint4 o0 = pack8(y), o1 = pack8(y + 8);
      *(uint4*)dl = o0; *(uint4*)(dl + 8) = o1;
      if (s < 2) {
        u16* dg = QKN + (size_t)row * 1024 + s * 512 + h * 128 + sg * 16;
        *(uint4*)dg = o0; *(uint4*)(dg + 8) = o1;
      }
    }
  }
  if (tid < 128) {
    const int j = tid & 63, dir = tid >> 6;
    const float* BA = (const float*)(P.ws + OFF_BA) + (size_t)(row0 + j) * 16;
    const float bl = BA[dir * 4 + h], al = BA[8 + dir * 4 + h];
    const float xx = al + P.dn_dt_bias[dir * 4 + h];
    const float sp = (xx > 20.f) ? xx : log1pf(expf(xx));
    gtok[dir * 64 + j] = -expf(P.dn_a_log[dir * 4 + h]) * sp;
    btok[dir * 64 + j] = 1.f / (1.f + expf(-bl));
  }
  __syncthreads();
  if (tid < 2) {
    const int dir = tid;
    float a = 0.f;
    for (int p = 0; p < 64; ++p) {
      const int tk = dir ? (63 - p) : p;
      a += gtok[dir * 64 + tk];
      gcp[dir * 64 + p] = a;
      bpp[dir * 64 + p] = btok[dir * 64 + tk];
    }
  }
  {
#pragma unroll
    for (int q = 0; q < 4; ++q) {
      const int t = wv * 4 + q;
      const int which = t >> 4, mi = (t >> 2) & 3, ni = t & 3;
      const u16* Am = (which ? Qs : Ks) + (mi * 16 + fr) * 136 + fq * 8;
      const u16* Bm = Ks + (ni * 16 + fr) * 136 + fq * 8;
      f32x4 a4 = {0.f, 0.f, 0.f, 0.f};
#pragma unroll
      for (int kk = 0; kk < 4; ++kk)
        a4 = __builtin_amdgcn_mfma_f32_16x16x32_bf16(*(const bf16x8*)(Am + kk * 32), *(const bf16x8*)(Bm + kk * 32), a4, 0, 0, 0);
      float* dst = which ? QKs : KKs;
#pragma unroll
      for (int e = 0; e < 4; ++e) dst[(mi * 16 + fq * 4 + e) * 68 + ni * 16 + fr] = a4[e];
    }
  }
  __syncthreads();
  const int itb = item * 2;
  {
    u16* AQ = (u16*)((char*)P.out + OFF_AQ);
    for (int idx = tid; idx < 8192; idx += NT) {
      const int dir = idx >> 12, p = (idx >> 6) & 63, s = idx & 63;
      const int tp = dir ? (63 - p) : p, ts = dir ? (63 - s) : s;
      const float dg = gcp[dir * 64 + p] - gcp[dir * 64 + s];
      const float dec = (p >= s) ? __expf(dg) : 0.f;
      AQ[((size_t)(itb + dir) * 64 + p) * 64 + s] = f2bf(QKs[tp * 68 + ts] * dec);
    }
    for (int idx = tid; idx < 8192; idx += NT) {
      const int dir = idx >> 12, s = (idx >> 6) & 63, p = idx & 63;
      const int tp = dir ? (63 - p) : p, ts = dir ? (63 - s) : s;
      const float dg = gcp[dir * 64 + p] - gcp[dir * 64 + s];
      const float lv = (p > s) ? bpp[dir * 64 + p] * KKs[ts * 68 + tp] * __expf(dg) : 0.f;
      Lt[dir * 4096 + s * 64 + p] = lv;
    }
    if (tid < 128) {
      float* GC = (float*)(P.ws + OFF_GC);
      GC[(size_t)(itb + (tid >> 6)) * 64 + (tid & 63)] = gcp[tid];
    }
  }
  __syncthreads();
  if (tid < 256) solve_cols<0>(P, itb, tid, Lt, bpp, gcp, Vs, Ks);
  else solve_cols<1>(P, itb, tid - 256, Lt, bpp, gcp, Vs, Ks);
}

__device__ __forceinline__ void s5end_tile(const Params& P, int t, char* lds) {
  const int g = t / 6, mt = (t % 6) >> 1, nt = t & 1;
  const int m0 = mt * 256, n0 = nt * 128;
  f32x16 acc[2][2];
  acc_zero(acc);
  gemm_main((const u16*)(P.ws + OFF_U5) + ((size_t)g * 544 + m0) * 512, 512,
            (const u16*)(P.ws + OFF_MEND) + ((size_t)g * 256 + n0) * 512, 512, 512, acc, (u16*)lds);
  TILE_COORDS
  float* E = (float*)(P.ws + OFF_E);
#pragma unroll
  for (int i = 0; i < 2; ++i)
#pragma unroll
    for (int j = 0; j < 2; ++j)
#pragma unroll
      for (int e = 0; e < 16; ++e) {
        const int row = TROW(m0, i, e);
        if (row < 544) E[((size_t)g * 544 + row) * 256 + TCOL(n0, j)] = acc[i][j][e];
      }
}

__device__ __forceinline__ void scan_chunk(const u16* Wl, const u16* QTl, const u16* KTl, const u16* AQl, u16* ST, u16* VT,
                                           int wd, int wq, int fr, int fq, float gl, f32x4& av, f32x4& ao, f32x4& accS0, f32x4& accS1) {
  {
    bf16x8 bS[4], a1[4], a2[4];
#pragma unroll
    for (int kk = 0; kk < 4; ++kk) {
      bS[kk] = *(const bf16x8*)(ST + (wd * 16 + fr) * 136 + kk * 32 + fq * 8);
      a1[kk] = *(const bf16x8*)(Wl + (wq * 16 + fr) * 136 + kk * 32 + fq * 8);
      a2[kk] = *(const bf16x8*)(QTl + (wq * 16 + fr) * 136 + kk * 32 + fq * 8);
    }
    __builtin_amdgcn_sched_barrier(0);
#pragma unroll
    for (int kk = 0; kk < 4; ++kk) {
      av = __builtin_amdgcn_mfma_f32_16x16x32_bf16(a1[kk], bS[kk], av, 0, 0, 0);
      ao = __builtin_amdgcn_mfma_f32_16x16x32_bf16(a2[kk], bS[kk], ao, 0, 0, 0);
    }
  }
  {
    uint2 v; v.x = pack2(av[0], av[1]); v.y = pack2(av[2], av[3]);
    *(uint2*)(VT + (wd * 16 + fr) * 72 + wq * 16 + fq * 4) = v;
  }
  bf16x8 qa[2], k0[2], k1[2];
#pragma unroll
  for (int ks = 0; ks < 2; ++ks) {
    qa[ks] = *(const bf16x8*)(AQl + (wq * 16 + fr) * 72 + ks * 32 + fq * 8);
    k0[ks] = *(const bf16x8*)(KTl + ((2 * wq) * 16 + fr) * 72 + ks * 32 + fq * 8);
    k1[ks] = *(const bf16x8*)(KTl + ((2 * wq + 1) * 16 + fr) * 72 + ks * 32 + fq * 8);
  }
  accS0[0] *= gl; accS0[1] *= gl; accS0[2] *= gl; accS0[3] *= gl;
  accS1[0] *= gl; accS1[1] *= gl; accS1[2] *= gl; accS1[3] *= gl;
  __syncthreads();
  {
    bf16x8 bV[2];
#pragma unroll
    for (int ks = 0; ks < 2; ++ks) bV[ks] = *(const bf16x8*)(VT + (wd * 16 + fr) * 72 + ks * 32 + fq * 8);
#pragma unroll
    for (int ks = 0; ks < 2; ++ks) {
      ao = __builtin_amdgcn_mfma_f32_16x16x32_bf16(qa[ks], bV[ks], ao, 0, 0, 0);
      accS0 = __builtin_amdgcn_mfma_f32_16x16x32_bf16(k0[ks], bV[ks], accS0, 0, 0, 0);
      accS1 = __builtin_amdgcn_mfma_f32_16x16x32_bf16(k1[ks], bV[ks], accS1, 0, 0, 0);
    }
  }
  {
    uint2 v; v.x = pack2(accS0[0], accS0[1]); v.y = pack2(accS0[2], accS0[3]);
    *(uint2*)(ST + (wd * 16 + fr) * 136 + (2 * wq) * 16 + fq * 4) = v;
    v.x = pack2(accS1[0], accS1[1]); v.y = pack2(accS1[2], accS1[3]);
    *(uint2*)(ST + (wd * 16 + fr) * 136 + (2 * wq + 1) * 16 + fq * 4) = v;
  }
}

__device__ __forceinline__ void delta_scan_block(const Params& P, int sb, char* lds) {
  const int tid = opq(threadIdx.x), lane = tid & 63, w = tid >> 6, fr = lane & 15, fq = lane >> 4;
  const int bhd = sb & 31, dvq = sb >> 5;
  const int b = bhd >> 3, h = (bhd >> 1) & 3, dir = bhd & 1;
  const int wd = w & 1, wq = w >> 1;
  const int dv0 = dvq * 32 + wd * 16;
  u16* Wl = (u16*)(lds + opq(0));
  u16* QTl = (u16*)(lds + opq(17408));
  u16* KTl = (u16*)(lds + opq(34816));
  u16* AQl = (u16*)(lds + opq(53248));
  u16* ST = (u16*)(lds + opq(62464));
  u16* VT = (u16*)(lds + opq(71168));
  __syncthreads();
  for (int i = tid; i < 32 * 136 / 2; i += NT) ((uint32_t*)ST)[i] = 0u;
  f32x4 accS0 = {0.f, 0.f, 0.f, 0.f}, accS1 = {0.f, 0.f, 0.f, 0.f};
  const u16* QKN = (const u16*)((const char*)P.out + OFF_QKN);
  const u16* AQg = (const u16*)((const char*)P.out + OFF_AQ);
  const u16* Wg = (const u16*)(P.ws + OFF_R2);
  const u16* UFg = (const u16*)(P.ws + OFF_UF);
  const float* GC = (const float*)(P.ws + OFF_GC);
  u16* Og = (u16*)(P.ws + OFF_O);

#define SC_DECL(S)                                                   \
  uint4 S##w0, S##w1, S##q0, S##q1, S##k0, S##k1, S##a;              \
  float S##gq0, S##gq1, S##gk, S##g63;                               \
  uint2 S##u;                                                        \
  int S##row0 = 0, S##lat = 0;
#define SC_PF_ONE(S, i)                                                                            \
    {                                                                                              \
      const int id = tid + (i) * 512;                                                              \
      const int p = id >> 4, seg = id & 15;                                                        \
      const int tk = dir ? (63 - p) : p;                                                           \
      S##w##i = *(const uint4*)(Wg + it2__ * 8192 + p * 128 + seg * 8);                            \
      S##q##i = *(const uint4*)(QKN + (size_t)(S##row0 + tk) * 1024 + h * 128 + seg * 8);          \
      S##gq##i = GC[it2__ * 64 + p];                                                               \
      const int s = id & 63, sg2 = id >> 6;                                                        \
      const int tks = dir ? (63 - s) : s;                                                          \
      S##k##i = *(const uint4*)(QKN + (size_t)(S##row0 + tks) * 1024 + 512 + h * 128 + sg2 * 8);   \
    }
#define SC_PREFETCH(S, n_)                                                                         \
  {                                                                                                \
    const int n__ = (n_);                                                                          \
    int cid__;                                                                                     \
    if (n__ < 4) { cid__ = 256 + b * 4 + (dir ? (3 - n__) : n__); S##lat = 0; }                    \
    else { const int m__ = n__ - 4; cid__ = b * 64 + (dir ? (63 - m__) : m__); S##lat = 1; }       \
    S##row0 = cid__ * 64;                                                                          \
    const size_t it2__ = (size_t)((cid__ * 4 + h) * 2 + dir);                                      \
    SC_PF_ONE(S, 0)                                                                                \
    SC_PF_ONE(S, 1)                                                                                \
    S##gk = GC[it2__ * 64 + (tid & 63)];                                                           \
    S##g63 = GC[it2__ * 64 + 63];                                                                  \
    S##a = *(const uint4*)(AQg + it2__ * 4096 + (tid >> 3) * 64 + (tid & 7) * 8);                  \
    S##u = *(const uint2*)(UFg + (it2__ * 128 + dv0 + fr) * 64 + wq * 16 + fq * 4);                \
  }
#define SC_STAGE_ONE(S, i)                                                    \
    {                                                                         \
      const int id = tid + (i) * 512;                                         \
      const int p = id >> 4, seg = id & 15;                                   \
      *(uint4*)(Wl + p * 136 + seg * 8) = S##w##i;                            \
      float f[8];                                                             \
      unpack8(S##q##i, f);                                                    \
      const float sq = __expf(S##gq##i);                                      \
      f[0] *= sq; f[1] *= sq; f[2] *= sq; f[3] *= sq; f[4] *= sq; f[5] *= sq; f[6] *= sq; f[7] *= sq; \
      *(uint4*)(QTl + p * 136 + seg * 8) = pack8(f);                          \
      const int s = id & 63, sg2 = id >> 6;                                   \
      unpack8(S##k##i, f);                                                    \
      u16* kd = KTl + (sg2 * 8) * 72 + s;                                     \
      kd[0 * 72] = f2bf(f[0] * sk); kd[1 * 72] = f2bf(f[1] * sk); kd[2 * 72] = f2bf(f[2] * sk); kd[3 * 72] = f2bf(f[3] * sk); \
      kd[4 * 72] = f2bf(f[4] * sk); kd[5 * 72] = f2bf(f[5] * sk); kd[6 * 72] = f2bf(f[6] * sk); kd[7 * 72] = f2bf(f[7] * sk); \
    }
#define SC_STEP(S, n_)                                                                                \
  {                                                                                                   \
    const int cur_row0 = S##row0, cur_lat = S##lat;                                                   \
    const float gl = __expf(S##g63);                                                                  \
    const float sk = __expf(S##g63 - S##gk);                                                          \
    SC_STAGE_ONE(S, 0)                                                                                \
    SC_STAGE_ONE(S, 1)                                                                                \
    *(uint4*)(AQl + (tid >> 3) * 72 + (tid & 7) * 8) = S##a;                                          \
    f32x4 av = f32x4{lo16(S##u.x), hi16(S##u.x), lo16(S##u.y), hi16(S##u.y)};                         \
    f32x4 ao = f32x4{0.f, 0.f, 0.f, 0.f};                                                             \
    __syncthreads();                                                                                  \
    if ((n_) + 2 < 68) SC_PREFETCH(S, (n_) + 2)                                                       \
    scan_chunk(Wl, QTl, KTl, AQl, ST, VT, wd, wq, fr, fq, gl, av, ao, accS0, accS1);                  \
    if (cur_lat) {                                                                                    \
      _Pragma("unroll") for (int e = 0; e < 4; ++e) {                                                 \
        const int p = wq * 16 + fq * 4 + e;                                                           \
        const int tk = dir ? (63 - p) : p;                                                            \
        Og[((size_t)dir * 16384 + cur_row0 + tk) * 512 + h * 128 + dv0 + fr] = f2bf(ao[e]);           \
      }                                                                                               \
    }                                                                                                 \
    __syncthreads();                                                                                  \
  }
  SC_DECL(A)
  SC_DECL(B)
  SC_PREFETCH(A, 0)
  SC_PREFETCH(B, 1)
  for (int n = 0; n < 68; n += 2) {
    SC_STEP(A, n)
    SC_STEP(B, n + 1)
  }
#undef SC_DECL
#undef SC_PF_ONE
#undef SC_PREFETCH
#undef SC_STAGE_ONE
#undef SC_STEP
}

__device__ __forceinline__ void s5_carry_block(const Params& P, int cb) {
  const int idx = cb * NT + opq(threadIdx.x);
  const int n = idx & 63, g = (idx >> 6) & 31, r = (idx >> 11) & 1, b = idx >> 12;
  const int rg = r * 32 + g;
  const float step = expf(P.s5_log_step[rg]);
  float lr, li;
  lam_pow(step, P.s5_a_re[rg * 64 + n], P.s5_a_im[rg * 64 + n], 32, lr, li);
  const float* E = (const float*)(P.ws + OFF_E) + (size_t)g * 544 * 256 + r * 128 + n;
  u16* XIN = (u16*)(P.ws + OFF_XIN) + (size_t)g * 512 * 256 + r * 128 + n;
  float xr = 0.f, xi = 0.f;
  for (int k = 0; k < 8; ++k) {
    const int cc = r ? (7 - k) : k;
    const int row = 512 + b * 8 + cc;
    const float er = E[(size_t)row * 256], ei = E[(size_t)row * 256 + 64];
    const float nr = lr * xr - li * xi + er, ni = lr * xi + li * xr + ei;
    xr = nr; xi = ni;
  }
  for (int k = 0; k < 128; ++k) {
    const int cc = r ? (127 - k) : k;
    const int row = b * 128 + cc;
    XIN[(size_t)row * 256] = f2bf(xr);
    XIN[(size_t)row * 256 + 64] = f2bf(xi);
    const float er = E[(size_t)row * 256], ei = E[(size_t)row * 256 + 64];
    const float nr = lr * xr - li * xi + er, ni = lr * xi + li * xr + ei;
    xr = nr; xi = ni;
  }
}

__device__ __forceinline__ void s5out_tile(const Params& P, int t, char* lds) {
  const int g = t >> 3, mt = (t >> 2) & 1, nt = t & 3;
  const int m0 = mt * 256, n0 = nt * 128;
  f32x16 acc[2][2];
  acc_zero(acc);
  gemm_main((const u16*)(P.ws + OFF_XIN) + ((size_t)g * 512 + m0) * 256, 256,
            (const u16*)(P.ws + OFF_MST) + ((size_t)g * 512 + n0) * 256, 256, 256, acc, (u16*)lds);
  gemm_main((const u16*)(P.ws + OFF_U5) + ((size_t)g * 544 + m0) * 512, 512,
            (const u16*)(P.ws + OFF_MINTRA) + ((size_t)g * 512 + n0) * 512, 512, 512, acc, (u16*)lds);
  TILE_COORDS
  u16* YB = (u16*)(P.ws + OFF_YB);
#pragma unroll
  for (int i = 0; i < 2; ++i)
#pragma unroll
    for (int j = 0; j < 2; ++j)
#pragma unroll
      for (int e = 0; e < 16; ++e) {
        const int row = TROW(m0, i, e), nn = TCOL(n0, j);
        const int token = row * 32 + (nn >> 4);
        YB[(size_t)token * 512 + g * 16 + (nn & 15)] = f2bf(gelu_tanh(acc[i][j][e]));
      }
}

__device__ __forceinline__ void delta_post_item(const Params& P, int item) {
  const int lane = opq(threadIdx.x) & 63, w = opq(threadIdx.x) >> 6;
  const int row = item * 8 + w;
  const u16* O = (const u16*)(P.ws + OFF_O);
  const uint4 o0 = *(const uint4*)(O + (size_t)row * 512 + lane * 8);
  const uint4 o1 = *(const uint4*)(O + ((size_t)16384 + row) * 512 + lane * 8);
  const uint4 zz = *(const uint4*)((const u16*)(P.ws + OFF_Z) + (size_t)row * 512 + lane * 8);
  float a[8], bq[8], z[8];
  unpack8(o0, a); unpack8(o1, bq); unpack8(zz, z);
  float ss = 0.f;
#pragma unroll
  for (int e = 0; e < 8; ++e) { a[e] += bq[e]; ss += a[e] * a[e]; }
  ss += __shfl_xor(ss, 1, 64); ss += __shfl_xor(ss, 2, 64); ss += __shfl_xor(ss, 4, 64); ss += __shfl_xor(ss, 8, 64);
  const float rstd = rsqrtf(ss * (1.f / 128.f) + 1e-6f);
  const float* nw = P.dn_norm_w + (lane & 15) * 8;
  float y[8];
#pragma unroll
  for (int e = 0; e < 8; ++e) y[e] = a[e] * rstd * nw[e] * (z[e] * sigm(z[e]));
  *(uint4*)((u16*)(P.ws + OFF_YA) + (size_t)row * 512 + lane * 8) = pack8(y);
}

__device__ __forceinline__ void glu_tile(const Params& P, int t, char* lds) {
  const int nt = t >> 6, mt = t & 63;
  const int m0 = mt * 256, n0 = nt * 128;
  f32x16 acc[2][2];
  acc_zero(acc);
  gemm_main((const u16*)(P.ws + OFF_YB) + (size_t)m0 * 512, 512, (const u16*)(P.ws + OFF_WT_GLU) + (size_t)n0 * 512, 512, 512, acc, (u16*)lds);
  TILE_COORDS
  u16* YG = (u16*)(P.ws + OFF_YG);
  {
    const int oc = nt * 64 + wn_ * 32 + fr_;
    const float bv = P.b_glu[oc], bg = P.b_glu[512 + oc];
#pragma unroll
    for (int i = 0; i < 2; ++i)
#pragma unroll
      for (int e = 0; e < 16; ++e) {
        const float val = acc[i][0][e] + bv, gt = acc[i][1][e] + bg;
        YG[TIDX2(m0, nt * 64 + wn_ * 32, i, e, 512)] = f2bf(val * sigm(gt));
      }
  }
}

__device__ __forceinline__ void gates_tile(const Params& P, int t, char* lds) {
  const int nt = t >> 6, mt = t & 63;
  const int m0 = mt * 256, n0 = nt * 128;
  f32x16 acc[2][2];
  acc_zero(acc);
  gemm_main((const u16*)(P.ws + OFF_R2) + (size_t)m0 * 1024, 1024, (const u16*)(P.ws + OFF_WT_IN) + (size_t)(2688 + n0) * 1024, 1024, 1024, acc, (u16*)lds);
  TILE_COORDS
  u16* SG = (u16*)(P.ws + OFF_SG);
#pragma unroll
  for (int i = 0; i < 2; ++i)
#pragma unroll
    for (int j = 0; j < 2; ++j)
#pragma unroll
      for (int e = 0; e < 16; ++e) SG[TIDX(m0, n0, i, j, e, 2048)] = f2bf(sigm(acc[i][j][e]));
}

__device__ __forceinline__ void mix_tile(const Params& P, int t, char* lds) {
  const int nt = t >> 6, mt = t & 63;
  const int m0 = mt * 256, n0 = nt * 128;
  const u16* SG = (const u16*)(P.ws + OFF_SG);
  f32x16 acc[2][2];
  u16* MIX = (u16*)(P.ws + OFF_MIX);
  acc_zero(acc);
  gemm_main((const u16*)(P.ws + OFF_YA) + (size_t)m0 * 512, 512, (const u16*)(P.ws + OFF_WT_AOUT) + (size_t)n0 * 512, 512, 512, acc, (u16*)lds);
  {
    TILE_COORDS
    u16 sv[2][2][16];
#pragma unroll
    for (int i = 0; i < 2; ++i)
#pragma unroll
      for (int j = 0; j < 2; ++j)
#pragma unroll
        for (int e = 0; e < 16; ++e) sv[i][j][e] = SG[TIDX(m0, n0, i, j, e, 2048)];
#pragma unroll
    for (int i = 0; i < 2; ++i)
#pragma unroll
      for (int j = 0; j < 2; ++j)
#pragma unroll
        for (int e = 0; e < 16; ++e) MIX[TIDX(m0, n0, i, j, e, 1024)] = f2bf(bf2f(sv[i][j][e]) * acc[i][j][e]);
  }
  acc_zero(acc);
  gemm_main((const u16*)(P.ws + OFF_YG) + (size_t)m0 * 512, 512, (const u16*)(P.ws + OFF_WT_BOUT) + (size_t)n0 * 512, 512, 512, acc, (u16*)lds);
  {
    TILE_COORDS
#pragma unroll
    for (int i = 0; i < 2; ++i) {
      u16 sv[2][16], pv[2][16];
#pragma unroll
      for (int j = 0; j < 2; ++j)
#pragma unroll
        for (int e = 0; e < 16; ++e) {
          sv[j][e] = SG[TIDX(m0, n0, i, j, e, 2048) + 1024];
          pv[j][e] = MIX[TIDX(m0, n0, i, j, e, 1024)];
        }
#pragma unroll
      for (int j = 0; j < 2; ++j)
#pragma unroll
        for (int e = 0; e < 16; ++e)
          MIX[TIDX(m0, n0, i, j, e, 1024)] = f2bf(bf2f(pv[j][e]) + bf2f(sv[j][e]) * acc[i][j][e]);
    }
  }
}

__device__ __forceinline__ void wo_tile(const Params& P, int t, char* lds) {
  const int nt = t >> 6, mt = t & 63;
  const int m0 = mt * 256, n0 = nt * 128;
  f32x16 acc[2][2];
  acc_zero(acc);
  gemm_main((const u16*)(P.ws + OFF_MIX) + (size_t)m0 * 1024, 1024, (const u16*)(P.ws + OFF_WT_O) + (size_t)n0 * 1024, 1024, 1024, acc, (u16*)lds);
  TILE_COORDS
  const float* MOD = (const float*)(P.ws + OFF_MOD) + (m0 >> 12) * 6144 + 2 * 1024;
  float xv[2][2][16];
#pragma unroll
  for (int j = 0; j < 2; ++j)
#pragma unroll
    for (int i = 0; i < 2; ++i)
#pragma unroll
      for (int e = 0; e < 16; ++e) xv[i][j][e] = P.x[TIDX(m0, n0, i, j, e, 1024)];
#pragma unroll
  for (int j = 0; j < 2; ++j) {
    const int col = TCOL(n0, j);
    const float gate = MOD[col];
#pragma unroll
    for (int i = 0; i < 2; ++i)
#pragma unroll
      for (int e = 0; e < 16; ++e) P.out[TIDX(m0, n0, i, j, e, 1024)] = xv[i][j][e] + gate * acc[i][j][e];
  }
}

__device__ __forceinline__ void norm2_item(const Params& P, int item) {
  const int lane = opq(threadIdx.x) & 63, w = opq(threadIdx.x) >> 6;
  const int rowA = item * 16 + w, rowB = rowA + 8;
  const float* MA = (const float*)(P.ws + OFF_MOD) + (rowA >> 12) * 6144;
  const float* MB = (const float*)(P.ws + OFF_MOD) + (rowB >> 12) * 6144;
  u16* H = (u16*)(P.ws + OFF_R2);
  norm_row2(P.out + (size_t)rowA * 1024, P.out + (size_t)rowB * 1024, P.norm2_w, MA + 3 * 1024, MA + 4 * 1024, MB + 3 * 1024, MB + 4 * 1024,
            H + (size_t)rowA * 1024, H + (size_t)rowB * 1024, lane);
}

__device__ __forceinline__ void up_tile(const Params& P, int t, int hh, char* lds) {
  const int nt = t >> 6, mt = t & 63;
  const int m0 = mt * 256, n0 = nt * 128;
  f32x16 acc[2][2];
  acc_zero(acc);
  gemm_main((const u16*)(P.ws + OFF_R2) + (size_t)m0 * 1024, 1024,
            (const u16*)(P.ws + OFF_WT_UP) + ((size_t)hh * 2816 + n0) * 1024, 1024, 1024, acc, (u16*)lds);
  TILE_COORDS
  u16* UPH = (u16*)(P.ws + OFF_UPH);
#pragma unroll
  for (int i = 0; i < 2; ++i)
#pragma unroll
    for (int j = 0; j < 2; ++j)
#pragma unroll
      for (int e = 0; e < 16; ++e) UPH[TIDX(m0, n0, i, j, e, 2816)] = f2bf(acc[i][j][e]);
}

#define CG_LD(ci, dy)                                                                       \
    {                                                                                       \
      const int xc = x0 - 1 + (ci);                                                         \
      const bool cok = (xc >= 0) && (xc <= 63);                                             \
      const bool rok = ((dy) == 1) || ((dy) == 0 ? r0ok : r2ok);                            \
      const int yy = rok ? (y + (dy) - 1) : y;                                              \
      const u16* src = UPH + (base + (size_t)yy * 64 + (cok ? xc : x0)) * 2816 + c4;        \
      uint2 g__ = *(const uint2*)src;                                                       \
      uint2 v__ = *(const uint2*)(src + 1408);                                              \
      const bool ok = cok && rok;                                                           \
      g__.x = ok ? g__.x : 0u; g__.y = ok ? g__.y : 0u;                                     \
      v__.x = ok ? v__.x : 0u; v__.y = ok ? v__.y : 0u;                                     \
      gg[ci][dy] = g__; vv[ci][dy] = v__;                                                   \
    }
__device__ __forceinline__ void convgate_item(const Params& P, int item, int hh) {
  const int tid = opq(threadIdx.x);
  if (tid >= 352) return;
  const int xo = item & 15, y = (item >> 4) & 63, b = item >> 10;
  const int c4 = tid * 4;
  const u16* UPH = (const u16*)(P.ws + OFF_UPH);
  u16* G = (u16*)(P.ws + OFF_G);
  const size_t base = (size_t)b * 4096;
  const bool r0ok = (y > 0), r2ok = (y < 63);
  const int x0 = xo * 4;
  uint2 gg[6][3], vv[6][3];
#pragma unroll
  for (int ci = 0; ci < 6; ++ci) {
    CG_LD(ci, 0)
    CG_LD(ci, 1)
    CG_LD(ci, 2)
  }
  float wg[9][4], wv[9][4];
#pragma unroll
  for (int k = 0; k < 9; ++k) {
    const float4 a = *(const float4*)(P.ffn_conv_w + (size_t)k * 5632 + hh * 1408 + c4);
    const float4 bq = *(const float4*)(P.ffn_conv_w + (size_t)k * 5632 + 2816 + hh * 1408 + c4);
    wg[k][0] = a.x; wg[k][1] = a.y; wg[k][2] = a.z; wg[k][3] = a.w;
    wv[k][0] = bq.x; wv[k][1] = bq.y; wv[k][2] = bq.z; wv[k][3] = bq.w;
  }
#pragma unroll
  for (int xx = 0; xx < 4; ++xx) {
    float ag[4] = {0.f, 0.f, 0.f, 0.f}, av[4] = {0.f, 0.f, 0.f, 0.f};
#pragma unroll
    for (int dy = 0; dy < 3; ++dy)
#pragma unroll
      for (int dx = 0; dx < 3; ++dx) {
        const uint2 gq = gg[xx + dx][dy], vq = vv[xx + dx][dy];
        const int k = dy * 3 + dx;
        ag[0] += wg[k][0] * lo16(gq.x); ag[1] += wg[k][1] * hi16(gq.x); ag[2] += wg[k][2] * lo16(gq.y); ag[3] += wg[k][3] * hi16(gq.y);
        av[0] += wv[k][0] * lo16(vq.x); av[1] += wv[k][1] * hi16(vq.x); av[2] += wv[k][2] * lo16(vq.y); av[3] += wv[k][3] * hi16(vq.y);
      }
    uint2 o;
    o.x = pack2(ag[0] * sigm(ag[0]) * av[0], ag[1] * sigm(ag[1]) * av[1]);
    o.y = pack2(ag[2] * sigm(ag[2]) * av[2], ag[3] * sigm(ag[3]) * av[3]);
    *(uint2*)(G + (base + y * 64 + x0 + xx) * 2816 + hh * 1408 + c4) = o;
  }
}
#undef CG_LD

__device__ __forceinline__ void down_tile(const Params& P, int t, char* lds) {
  const int nt = t >> 6, mt = t & 63;
  const int m0 = mt * 256, n0 = nt * 128;
  f32x16 acc[2][2];
  acc_zero(acc);
  gemm_main((const u16*)(P.ws + OFF_G) + (size_t)m0 * 2816, 2816, (const u16*)(P.ws + OFF_WT_DOWN) + (size_t)n0 * 2816, 2816, 2816, acc, (u16*)lds);
  TILE_COORDS
  const float* MOD = (const float*)(P.ws + OFF_MOD) + (m0 >> 12) * 6144 + 5 * 1024;
  float xv[2][2][16];
#pragma unroll
  for (int j = 0; j < 2; ++j)
#pragma unroll
    for (int i = 0; i < 2; ++i)
#pragma unroll
      for (int e = 0; e < 16; ++e) xv[i][j][e] = P.out[TIDX(m0, n0, i, j, e, 1024)];
#pragma unroll
  for (int j = 0; j < 2; ++j) {
    const int col = TCOL(n0, j);
    const float gate = MOD[col];
#pragma unroll
    for (int i = 0; i < 2; ++i)
#pragma unroll
      for (int e = 0; e < 16; ++e) P.out[TIDX(m0, n0, i, j, e, 1024)] = xv[i][j][e] + gate * acc[i][j][e];
  }
}

__device__ __forceinline__ void final_item(const Params& P, int item) {
  const int lane = opq(threadIdx.x) & 63, w = opq(threadIdx.x) >> 6;
  const int row = item * 8 + w;
  float* xr = P.out + (size_t)row * 1024;
  float4 v[4];
  float ss = 0.f;
#pragma unroll
  for (int it = 0; it < 4; ++it) {
    v[it] = *(const float4*)(xr + (it * 64 + lane) * 4);
    ss += v[it].x * v[it].x + v[it].y * v[it].y + v[it].z * v[it].z + v[it].w * v[it].w;
  }
  ss = wsum64(ss);
  const float rstd = rsqrtf(ss * (1.f / 1024.f) + 1e-6f);
#pragma unroll
  for (int it = 0; it < 4; ++it) {
    const int c = (it * 64 + lane) * 4;
    const float4 w4 = *(const float4*)(P.norm_f_w + c);
    float4 o;
    o.x = v[it].x * rstd * w4.x; o.y = v[it].y * rstd * w4.y; o.z = v[it].z * rstd * w4.z; o.w = v[it].w * rstd * w4.w;
    *(float4*)(xr + c) = o;
  }
}

__device__ __forceinline__ void run_phase(const Params& P, int ph, char* lds) {
  const int bid = blockIdx.x, nb = gridDim.x;
#ifdef ONLY_PHASE
  if (ph != ONLY_PHASE) return;
#endif
  switch (ph) {
    case 0: {
      for (int it = bid; it < 984 + 192 + 2048; it += nb) {
        if (it < 296) convert_item(P.w_in, 1024, 4624, (u16*)(P.ws + OFF_WT_IN), 0, it, lds);
        else if (it < 328) convert_item(P.w_a_out, 512, 1024, (u16*)(P.ws + OFF_WT_AOUT), 1, it - 296, lds);
        else if (it < 360) convert_item(P.w_glu, 512, 1024, (u16*)(P.ws + OFF_WT_GLU), 2, it - 328, lds);
        else if (it < 392) convert_item(P.w_b_out, 512, 1024, (u16*)(P.ws + OFF_WT_BOUT), 3, it - 360, lds);
        else if (it < 456) convert_item(P.w_o, 1024, 1024, (u16*)(P.ws + OFF_WT_O), 4, it - 392, lds);
        else if (it < 808) convert_item(P.w_up, 1024, 5632, (u16*)(P.ws + OFF_WT_UP), 5, it - 456, lds);
        else if (it < 984) convert_item(P.w_down, 2816, 1024, (u16*)(P.ws + OFF_WT_DOWN), 6, it - 808, lds);
        else if (it < 1176) mod_item(P, it - 984, lds);
        else s5tab_item(P, it - 1176, lds);
      }
    } break;
    case 1:
      for (int it = bid; it < 1088 + 2048; it += nb) {
        if (it < 1088) norm1_item(P, it); else mintra_item(P, it - 1088);
      }
      break;
    case 2:
      for (int it = bid; it < 1396; it += nb) inproj_tile(P, it, lds);
      break;
    case 3:
      for (int it = bid; it < 1088 + 192; it += nb) {
        if (it < 1088) delta_prep_item(P, it, lds); else s5end_tile(P, it - 1088, lds);
      }
      break;
    case 4:
      if (bid < 128) delta_scan_block(P, bid, lds);
      else if (bid < 160) s5_carry_block(P, bid - 128);
      break;
    case 5:
      for (int it = bid; it < 256 + 2048 + 1024; it += nb) {
        if (it < 256) s5out_tile(P, it, lds);
        else if (it < 2304) delta_post_item(P, it - 256);
        else norm1_item(P, it - 2304);
      }
      break;
    case 6:
      for (int it = bid; it < 512 + 1024; it += nb) {
        if (it < 512) glu_tile(P, it, lds); else gates_tile(P, it - 512, lds);
      }
      break;
    case 7:
      for (int it = bid; it < 512; it += nb) mix_tile(P, it, lds);
      break;
    case 8:
      for (int it = bid; it < 512; it += nb) wo_tile(P, it, lds);
      break;
    case 9:
      for (int it = bid; it < 1024; it += nb) norm2_item(P, it);
      break;
    case 10:
      for (int it = bid; it < 1408; it += nb) up_tile(P, it, 0, lds);
      break;
    case 11:
      for (int it = bid; it < 4096; it += nb) convgate_item(P, it, 0);
      break;
    case 12:
      for (int it = bid; it < 1408; it += nb) up_tile(P, it, 1, lds);
      break;
    case 13:
      for (int it = bid; it < 4096; it += nb) convgate_item(P, it, 1);
      break;
    case 14:
      for (int it = bid; it < 512; it += nb) down_tile(P, it, lds);
      break;
    case 15:
      for (int it = bid; it < 2048; it += nb) final_item(P, it);
      break;
    default: break;
  }
}

typedef const __attribute__((address_space(4))) Params* KParamsPtr;
__global__ void __launch_bounds__(NT) fwd_megakernel(Params Pk) {
#if defined(__HIP_DEVICE_COMPILE__)
  extern __shared__ __attribute__((aligned(16))) char lds[];
  KParamsPtr pp = (KParamsPtr)__builtin_amdgcn_kernarg_segment_ptr();
  const int lo = (int)pp->ph_lo, hi = (int)pp->ph_hi;
#if MULTI_LAUNCH
  for (int ph = lo; ph < hi; ++ph) { KParamsPtr q = pp; asm volatile("" : "+s"(q)); Params P; for (int i_ = 0; i_ < (int)(sizeof(Params) / 8); ++i_) ((unsigned long long*)&P)[i_] = ((const __attribute__((address_space(4))) unsigned long long*)q)[i_]; run_phase(P, ph, lds); }
#else
  cg::grid_group grid = cg::this_grid();
  volatile LAS unsigned* xst = (volatile LAS unsigned*)(lds + (LDS_BYTES - 16));
  if (threadIdx.x == 0) { xst[0] = 0u; xst[1] = 0u; xst[2] = 0u; xst[3] = 0u; }
  __syncthreads();
  XcdBarrier xb = xcd_barrier_post((unsigned*)(pp->ws + OFF_BAR), xst);
  const unsigned rep_mask = (unsigned)pp->rep_mask;
  bool first_sync = true;
  for (int ph = lo; ph < hi; ++ph) {
    const int reps = 1 + (int)((rep_mask >> ph) & 1u);
    for (int rp = 0; rp < reps; ++rp) {
      {
        KParamsPtr q = pp;
        asm volatile("" : "+s"(q));
        Params P;
        {
          typedef __attribute__((address_space(1))) const float* GF;
          const float** dp = (const float**)&P;
          const __attribute__((address_space(4))) unsigned long long* sp = (const __attribute__((address_space(4))) unsigned long long*)q;
#pragma unroll
          for (int i_ = 0; i_ < 30; ++i_) dp[i_] = (const float*)(GF)(sp[i_]);
          P.out = (float*)(__attribute__((address_space(1))) float*)(sp[30]);
          P.ws = (char*)(__attribute__((address_space(1))) char*)(sp[31]);
          P.ph_lo = 0; P.ph_hi = 0; P.rep_mask = 0;
        }
        run_phase(P, ph, lds);
      }
      if (ph + 1 < hi || rp + 1 < reps) {
        if (first_sync) { grid.sync(); first_sync = false; }
        else xcd_barrier(xb);
      }
    }
  }
#endif
#endif
}

extern "C" void kernel_launch(void* const* d_in, const int* in_sizes, int n_in, void* d_out, int out_size, void* d_ws,
                              size_t ws_size, hipStream_t stream) {
  static int grid_blocks = 0;
  if (grid_blocks == 0) {
    if (n_in != 30 || out_size != 16384 * 1024 || ws_size < WS_NEED) {
      fprintf(stderr, "kernel_launch: unexpected shapes: n_in %d out %d ws %zu (need %zu)\n", n_in, out_size, ws_size, (size_t)WS_NEED);
      grid_blocks = -1;
      return;
    }
    int dev = 0, cus = 0, per_cu = 0;
    hipGetDevice(&dev);
    hipDeviceGetAttribute(&cus, hipDeviceAttributeMultiprocessorCount, dev);
    if (hipFuncSetAttribute((const void*)fwd_megakernel, hipFuncAttributeMaxDynamicSharedMemorySize, LDS_BYTES) != hipSuccess) {
      fprintf(stderr, "kernel_launch: hipFuncSetAttribute failed\n");
      grid_blocks = -1;
      return;
    }
    if (hipOccupancyMaxActiveBlocksPerMultiprocessor(&per_cu, (const void*)fwd_megakernel, NT, LDS_BYTES) != hipSuccess || per_cu < 1) {
      fprintf(stderr, "kernel_launch: occupancy query failed / zero (%d)\n", per_cu);
      grid_blocks = -1;
      return;
    }
    grid_blocks = cus;
    if (grid_blocks < 64) { fprintf(stderr, "kernel_launch: too few CUs (%d)\n", cus); grid_blocks = -1; return; }
  }
  if (grid_blocks < 0) return;
  (void)hipMemsetAsync((char*)d_ws + OFF_BAR, 0, XCD_BAR_WORDS * sizeof(unsigned), stream);
  Params p{};
  const float** pp = (const float**)&p;
  for (int i = 0; i < 30; ++i) pp[i] = (const float*)d_in[i];
  p.out = (float*)d_out;
  p.ws = (char*)d_ws;
#if MULTI_LAUNCH
  for (int ph = 0; ph < 16; ++ph) {
    p.ph_lo = ph; p.ph_hi = ph + 1;
    hipLaunchKernelGGL(fwd_megakernel, dim3(grid_blocks), dim3(NT), LDS_BYTES, stream, p);
  }
#else
  p.ph_lo = 0; p.ph_hi = 16;
#ifdef REPEAT_MASK
  p.rep_mask = REPEAT_MASK;
#endif
  void* args[] = {&p};
  hipError_t e = hipLaunchCooperativeKernel((const void*)fwd_megakernel, dim3(grid_blocks), dim3(NT), args, LDS_BYTES, stream);
  if (e != hipSuccess) fprintf(stderr, "cooperative launch failed: %s (grid %d)\n", hipGetErrorString(e), grid_blocks);
#endif
}
```

```cpp
#include <hip/hip_runtime.h>
#include <hip/hip_cooperative_groups.h>
#include <cstdio>
#include <cstdint>
namespace cg = cooperative_groups;

#ifndef MULTI_LAUNCH
#define MULTI_LAUNCH 0
#endif

typedef unsigned short u16;
typedef __attribute__((ext_vector_type(8))) short bf16x8;
typedef __attribute__((ext_vector_type(4))) float f32x4;
typedef __attribute__((ext_vector_type(16))) float f32x16;

#define NT 512
constexpr int LDS_BYTES = 131072 + 1024;
constexpr int NPHASE = 18;

constexpr size_t OFF_WT_IN   = 0;
constexpr size_t OFF_WT_AOUT = 9699328;
constexpr size_t OFF_WT_GLU  = 10747904;
constexpr size_t OFF_WT_BOUT = 11796480;
constexpr size_t OFF_WT_O    = 12845056;
constexpr size_t OFF_WT_UP   = 14942208;
constexpr size_t OFF_WT_DOWN = 26476544;
constexpr size_t OFF_MOD     = 32243712;
constexpr size_t OFF_BAR     = 32505856;
constexpr size_t OFF_R2      = 33554432;
constexpr size_t OFF_R1      = 69206016;
constexpr size_t OFF_KTAB    = OFF_R1;
constexpr size_t OFF_MEND    = OFF_R1 + 2097152;
constexpr size_t OFF_MST     = OFF_R1 + 10485760;
constexpr size_t OFF_MINTRA  = OFF_R1 + 18874368;
constexpr size_t OFF_R3      = 104857600;
constexpr size_t OFF_O       = OFF_R3;
constexpr size_t OFF_XIN     = OFF_R3 + 33554432;
constexpr size_t OFF_MIX     = 158334976;
constexpr size_t OFF_SG      = OFF_R1;
constexpr size_t OFF_Z       = 158334976;
constexpr size_t OFF_U5      = 175112192;
constexpr size_t OFF_BA      = 192937984;
constexpr size_t OFF_GC      = OFF_BA + 1179648;
constexpr size_t OFF_UF      = 195035136;
constexpr size_t OFF_YA      = OFF_UF;
constexpr size_t OFF_YB      = OFF_UF + 16777216;
constexpr size_t OFF_E       = 230686720;
constexpr size_t OFF_YG      = OFF_E;
constexpr size_t OFF_UPH     = OFF_R1;
constexpr size_t OFF_G       = 161480704;
constexpr size_t WS_NEED     = 253755392;
constexpr size_t OFF_QKN     = 0;
constexpr size_t OFF_AQ      = 35651584;

struct Params {
  const float *x, *c, *ctx, *c_ctx, *w_ada, *b_ada, *norm1_w, *w_in, *dn_conv_w, *dn_a_log, *dn_dt_bias, *dn_norm_w,
      *w_a_out, *s5_a_re, *s5_a_im, *s5_log_step, *s5_b_re, *s5_b_im, *s5_c_re, *s5_c_im, *s5_d, *w_glu, *b_glu,
      *w_b_out, *w_o, *norm2_w, *w_up, *ffn_conv_w, *w_down, *norm_f_w;
  float* out;
  char* ws;
  long long ph_lo, ph_hi;
  long long rep_mask;
};

#define XB_TMO      128
#define XB_XCNT(j)  (256  + 64 * (j))
#define XB_XSUB(j)  (1280 + 64 * (j))
#define XB_XGEN(j)  (2304 + 64 * (j))
#define XB_TOP      3328
#define XB_TOPGEN   3392
#define XCD_BAR_WORDS 3456
#define XB_SPIN_CAP (1u << 18)
#define LAS __attribute__((address_space(3)))

__device__ __forceinline__ unsigned xb_ld(unsigned* p)              { return __hip_atomic_load(p, __ATOMIC_RELAXED, __HIP_MEMORY_SCOPE_AGENT); }
__device__ __forceinline__ unsigned xb_add(unsigned* p, unsigned v) { return __hip_atomic_fetch_add(p, v, __ATOMIC_RELAXED, __HIP_MEMORY_SCOPE_AGENT); }
__device__ __forceinline__ unsigned xb_xcc_id() { return (unsigned)__builtin_amdgcn_s_getreg((3 << 11) | 20) & 0xFu; }
#define XB_SPIN(cond, bar) do { unsigned _sp = 0; while (cond) { __builtin_amdgcn_s_sleep(1); \
    if ((++_sp & 255u) == 0u) { if (xb_ld(&(bar)[XB_TMO])) break; if (_sp > XB_SPIN_CAP) { atomicAdd(&(bar)[XB_TMO], 1u); break; } } } } while (0)

struct XcdBarrier {
    unsigned* bar; unsigned x;
    volatile LAS unsigned* st;
};

__device__ __forceinline__ XcdBarrier xcd_barrier_post(unsigned* bar, volatile LAS unsigned* st) {
    XcdBarrier b; b.bar = bar; b.x = xb_xcc_id(); b.st = st;
    if (threadIdx.x == 0) (void)xb_add(&bar[XB_XCNT(b.x)], 1u);
    return b;
}
__device__ __forceinline__ void xcd_barrier_complete(unsigned* bar, unsigned x, unsigned& nloc, unsigned& nx) {
    const unsigned G = gridDim.x * gridDim.y * gridDim.z;
    unsigned sum, cnt, mine, sp = 0u;
    for (;;) {
        sum = 0u; cnt = 0u; mine = 0u;
#pragma unroll
        for (unsigned j = 0; j < 16; ++j) { const unsigned c = xb_ld(&bar[XB_XCNT(j)]); sum += c; cnt += (c > 0u) ? 1u : 0u; mine = (j == x) ? c : mine; }
        if (sum == G) break;
        __builtin_amdgcn_s_sleep(1);
        if ((++sp & 255u) == 0u) { if (xb_ld(&bar[XB_TMO])) break; if (sp > XB_SPIN_CAP) { atomicAdd(&bar[XB_TMO], 1u); break; } }
    }
    nloc = mine > 0u ? mine : 1u; nx = cnt > 0u ? cnt : 1u;
}

__device__ __forceinline__ void xcd_barrier(const XcdBarrier& b) {
    asm volatile("s_waitcnt vmcnt(0)" ::: "memory");
    __syncthreads();
    if (threadIdx.x == 0) {
        unsigned* bar = b.bar;
        __builtin_amdgcn_s_waitcnt(0);
        unsigned nloc = b.st[0], nx = b.st[1];
        if (nloc == 0u) { xcd_barrier_complete(bar, b.x, nloc, nx); b.st[0] = nloc; b.st[1] = nx; }
        const unsigned old = xb_add(&bar[XB_XSUB(b.x)], 1u);
        const unsigned gen = old / nloc;
        if (old + 1u == (gen + 1u) * nloc) {
            __builtin_amdgcn_fence(__ATOMIC_RELEASE, "agent");
            asm volatile("s_waitcnt vmcnt(0)" ::: "memory");
            const unsigned og = xb_add(&bar[XB_TOP], 1u);
            const unsigned tg = og / nx;
            if (og + 1u == (tg + 1u) * nx) xb_add(&bar[XB_TOPGEN], 1u);
            else XB_SPIN(xb_ld(&bar[XB_TOPGEN]) == tg, bar);
            __builtin_amdgcn_fence(__ATOMIC_ACQUIRE, "agent");
            xb_add(&bar[XB_XGEN(b.x)], 1u);
            asm volatile("s_waitcnt vmcnt(0)" ::: "memory");
        } else {
            XB_SPIN(xb_ld(&bar[XB_XGEN(b.x)]) == gen, bar);
            __builtin_amdgcn_fence(__ATOMIC_ACQUIRE, "agent");
            asm volatile("s_waitcnt vmcnt(0)" ::: "memory");
        }
    }
    __syncthreads();
}


typedef __attribute__((ext_vector_type(2))) float f32x2_t;
typedef __attribute__((ext_vector_type(2))) __bf16 bf16x2_t;
__device__ __forceinline__ u16 f2bf(float f) {
  const __bf16 h = (__bf16)f;
  return __builtin_bit_cast(u16, h);
}
__device__ __forceinline__ float bf2f(u16 h) { return __uint_as_float(((uint32_t)h) << 16); }
__device__ __forceinline__ uint32_t pack2(float a, float b) {
  const f32x2_t v = {a, b};
  const bf16x2_t r = __builtin_convertvector(v, bf16x2_t);
  return __builtin_bit_cast(uint32_t, r);
}
__device__ __forceinline__ float lo16(uint32_t w) { return __uint_as_float(w << 16); }
__device__ __forceinline__ float hi16(uint32_t w) { return __uint_as_float(w & 0xffff0000u); }
__device__ __forceinline__ int opq(int v) { asm volatile("" : "+v"(v)); return v; }
__device__ __forceinline__ float sigm(float x) { return 1.f / (1.f + __expf(-x)); }
__device__ __forceinline__ void unpack8(uint4 v, float* f) {
  f[0] = lo16(v.x); f[1] = hi16(v.x); f[2] = lo16(v.y); f[3] = hi16(v.y);
  f[4] = lo16(v.z); f[5] = hi16(v.z); f[6] = lo16(v.w); f[7] = hi16(v.w);
}
__device__ __forceinline__ uint4 pack8(const float* f) {
  uint4 v; v.x = pack2(f[0], f[1]); v.y = pack2(f[2], f[3]); v.z = pack2(f[4], f[5]); v.w = pack2(f[6], f[7]);
  return v;
}
__device__ __forceinline__ float wsum64(float v) {
#pragma unroll
  for (int o = 32; o > 0; o >>= 1) v += __shfl_xor(v, o, 64);
  return v;
}
__device__ __forceinline__ float gelu_tanh(float x) {
  float u = 0.7978845608028654f * (x + 0.044715f * x * x * x);
  float t = 1.f - 2.f / (1.f + __expf(2.f * u));
  return 0.5f * x * (1.f + t);
}

__device__ __forceinline__ void g_frag(const u16* as, const u16* bs, int ks, bf16x8 (&a)[2], bf16x8 (&b)[2]) {
  a[0] = *(const bf16x8*)(as + ks * 16);
  a[1] = *(const bf16x8*)(as + 32 * 72 + ks * 16);
  b[0] = *(const bf16x8*)(bs + ks * 16);
  b[1] = *(const bf16x8*)(bs + 32 * 72 + ks * 16);
}
__device__ __forceinline__ void g_mma(const bf16x8 (&a)[2], const bf16x8 (&b)[2], f32x16 (&acc)[2][2]) {
  acc[0][0] = __builtin_amdgcn_mfma_f32_32x32x16_bf16(a[0], b[0], acc[0][0], 0, 0, 0);
  acc[0][1] = __builtin_amdgcn_mfma_f32_32x32x16_bf16(a[0], b[1], acc[0][1], 0, 0, 0);
  acc[1][0] = __builtin_amdgcn_mfma_f32_32x32x16_bf16(a[1], b[0], acc[1][0], 0, 0, 0);
  acc[1][1] = __builtin_amdgcn_mfma_f32_32x32x16_bf16(a[1], b[1], acc[1][1], 0, 0, 0);
}
__device__ __forceinline__ void gemm_main(const u16* __restrict__ A, int lda, const u16* __restrict__ Bt, int ldb, int K,
                                          f32x16 (&acc)[2][2], u16* lds) {
  const int tid = opq(threadIdx.x), lane = tid & 63, w = tid >> 6, wm = w >> 1, wn = w & 1, fr = lane & 31, fq = lane >> 5;
  u16* As = lds;
  u16* Bs = lds + 2 * 256 * 72;
  const int nk = K >> 6;
  uint4 p0, p1, p2, p3, p4, p5;
  uint4 q0, q1, q2, q3, q4, q5;
  uint4 r0, r1, r2, r3, r4, r5;
  const int lr = tid >> 3, lc = (tid & 7) * 8;
  const unsigned oa0 = (unsigned)(lr * lda + lc) * 2u, sa2 = (unsigned)lda * 128u;
  const unsigned oa1 = oa0 + sa2, oa2 = oa0 + 2u * sa2, oa3 = oa0 + 3u * sa2;
  const unsigned ob0 = (unsigned)(lr * ldb + lc) * 2u, ob1 = ob0 + (unsigned)ldb * 128u;
#define G_LOAD(S, kt_)                                          \
  {                                                             \
    const int kc_ = ((kt_) < nk) ? (kt_) : (nk - 1);            \
    const char* a_ = (const char*)A + kc_ * 128;                \
    const char* b_ = (const char*)Bt + kc_ * 128;               \
    S##0 = *(const uint4*)(a_ + oa0);                           \
    S##1 = *(const uint4*)(a_ + oa1);                           \
    S##2 = *(const uint4*)(a_ + oa2);                           \
    S##3 = *(const uint4*)(a_ + oa3);                           \
    S##4 = *(const uint4*)(b_ + ob0);                           \
    S##5 = *(const uint4*)(b_ + ob1);                           \
  }
#define G_STORE(S, buf_)                                                     \
  {                                                                          \
    u16* as_ = As + ((buf_) * 256 + lr) * 72 + lc;                           \
    u16* bs_ = Bs + ((buf_) * 128 + lr) * 72 + lc;                           \
    *(uint4*)(as_) = S##0;                                                   \
    *(uint4*)(as_ + 64 * 72) = S##1;                                         \
    *(uint4*)(as_ + 128 * 72) = S##2;                                        \
    *(uint4*)(as_ + 192 * 72) = S##3;                                        \
    *(uint4*)(bs_) = S##4;                                                   \
    *(uint4*)(bs_ + 64 * 72) = S##5;                                         \
  }
#define G_STEP(S, BUF, kt_)                                                               \
  {                                                                                       \
    const u16* as = As + ((BUF) * 256 + wm * 64 + fr) * 72 + fq * 8;                      \
    const u16* bs = Bs + ((BUF) * 128 + wn * 64 + fr) * 72 + fq * 8;                      \
    bf16x8 fa0[2], fb0[2], fa1[2], fb1[2], fa2[2], fb2[2];                                \
    g_frag(as, bs, 0, fa0, fb0);                                                          \
    g_frag(as, bs, 1, fa1, fb1);                                                          \
    __builtin_amdgcn_sched_barrier(0);                                                    \
    G_STORE(S, (BUF) ^ 1)                                                                 \
    G_LOAD(S, (kt_) + 4)                                                                  \
    __builtin_amdgcn_sched_barrier(0);                                                    \
    g_frag(as, bs, 2, fa2, fb2);                                                          \
    __builtin_amdgcn_sched_barrier(0);                                                    \
    g_mma(fa0, fb0, acc);                                                                 \
    __builtin_amdgcn_sched_barrier(0);                                                    \
    g_frag(as, bs, 3, fa0, fb0);                                                          \
    __builtin_amdgcn_sched_barrier(0);                                                    \
    g_mma(fa1, fb1, acc);                                                                 \
    g_mma(fa2, fb2, acc);                                                                 \
    g_mma(fa0, fb0, acc);                                                                 \
    __syncthreads();                                                                      \
  }
  G_LOAD(p, 0)
  __syncthreads();
  G_STORE(p, 0)
  G_LOAD(q, 1)
  G_LOAD(r, 2)
  G_LOAD(p, 3)
  __syncthreads();
  for (int kt = 0; kt < nk; kt += 6) {
    G_STEP(q, 0, kt)
    G_STEP(r, 1, kt + 1)
    if (kt + 2 < nk) {
      G_STEP(p, 0, kt + 2)
      G_STEP(q, 1, kt + 3)
    }
    if (kt + 4 < nk) {
      G_STEP(r, 0, kt + 4)
      G_STEP(p, 1, kt + 5)
    }
  }
#undef G_STEP
#undef G_LOAD
#undef G_STORE
}

__device__ __forceinline__ void acc_zero(f32x16 (&acc)[2][2]) {
#pragma unroll
  for (int i = 0; i < 2; ++i)
#pragma unroll
    for (int j = 0; j < 2; ++j)
#pragma unroll
      for (int e = 0; e < 16; ++e) acc[i][j][e] = 0.f;
}

#define TILE_COORDS                                                                                  \
  const int tid_ = opq(threadIdx.x), lane_ = tid_ & 63, w_ = __builtin_amdgcn_readfirstlane(tid_ >> 6), \
            wm_ = w_ >> 1, wn_ = w_ & 1, fr_ = lane_ & 31, fq_ = lane_ >> 5;
#define TROW(m0, i, e) ((m0) + wm_ * 64 + (i) * 32 + ((e) & 3) + 8 * ((e) >> 2) + 4 * fq_)
#define TCOL(n0, j) ((n0) + wn_ * 64 + (j) * 32 + fr_)
#define TIDX2(m0, cb, i, e, ld) ((size_t)((m0) + wm_ * 64 + (i) * 32 + ((e) & 3) + 8 * ((e) >> 2)) * (ld) + (cb) + (size_t)(unsigned)(4 * fq_ * (ld) + fr_))
#define TIDX(m0, n0, i, j, e, ld) TIDX2(m0, (n0) + wn_ * 64 + (j) * 32, i, e, ld)

__device__ __forceinline__ int srccol(int which, int r) {
  switch (which) {
    case 0:
      if (r < 2048) return r;
      if (r < 2560) return 2064 + (r - 2048);
      if (r < 2576) return 2048 + (r - 2560);
      if (r < 2688) return -1;
      if (r < 3712) return 2576 + (r - 2688);
      return 3600 + (r - 3712);
    case 2: {
      int tile = r >> 7, wn = (r >> 6) & 1, wi = r & 63;
      return (wi < 32) ? (tile * 64 + wn * 32 + wi) : (512 + tile * 64 + wn * 32 + (wi - 32));
    }
    case 5: {
      int hh = r / 2816, cc = r % 2816;
      return (cc < 1408) ? (hh * 1408 + cc) : (2816 + hh * 1408 + (cc - 1408));
    }
    default: return r;
  }
}

__device__ __forceinline__ void convert_item(const float* __restrict__ src, int K, int N, u16* __restrict__ dst, int which, int item, char* lds) {
  float* tile = (float*)lds;
  const int tid = opq(threadIdx.x);
  const int kb = K >> 8;
  const int r0 = (item / kb) * 64, k0 = (item % kb) * 256;
  __syncthreads();
  {
    const int n4 = (tid & 15) * 4, kk = tid >> 4;
    const int sc = srccol(which, r0 + n4);
    float4 v[8];
#pragma unroll
    for (int it = 0; it < 8; ++it) {
      const int k = kk + 32 * it;
      v[it] = (sc >= 0) ? *(const float4*)(src + (size_t)(k0 + k) * N + sc) : make_float4(0.f, 0.f, 0.f, 0.f);
    }
#pragma unroll
    for (int it = 0; it < 8; ++it) {
      const int k = kk + 32 * it;
      tile[(n4 + 0) * 257 + k] = v[it].x; tile[(n4 + 1) * 257 + k] = v[it].y;
      tile[(n4 + 2) * 257 + k] = v[it].z; tile[(n4 + 3) * 257 + k] = v[it].w;
    }
  }
  __syncthreads();
  {
    const int ks = (tid & 31) * 8, rr = tid >> 5;
#pragma unroll
    for (int it = 0; it < 4; ++it) {
      const int row = rr + 16 * it;
      float f[8];
#pragma unroll
      for (int e = 0; e < 8; ++e) f[e] = tile[row * 257 + ks + e];
      *(uint4*)(dst + (size_t)(r0 + row) * K + k0 + ks) = pack8(f);
    }
  }
}

__device__ __forceinline__ void mod_item(const Params& P, int item, char* lds) {
  float* sc = (float*)lds;
  float* red = sc + 5 * 1024;
  const int tid = opq(threadIdx.x);
  __syncthreads();
  for (int i = tid; i < 5 * 1024; i += NT) {
    const int r = i >> 10, k = i & 1023;
    float v = (r < 4) ? P.c[r * 1024 + k] : P.c_ctx[k];
    sc[i] = v * sigm(v);
  }
  __syncthreads();
  const int nn = tid & 31, kg = tid >> 5;
  const int n = item * 32 + nn;
  float a0 = 0, a1 = 0, a2 = 0, a3 = 0, a4 = 0;
  for (int kk = 0; kk < 64; ++kk) {
    const int k = kg * 64 + kk;
    const float wv = P.w_ada[(size_t)k * 6144 + n];
    a0 += sc[k] * wv; a1 += sc[1024 + k] * wv; a2 += sc[2048 + k] * wv; a3 += sc[3072 + k] * wv; a4 += sc[4096 + k] * wv;
  }
  red[(kg * 5 + 0) * 32 + nn] = a0; red[(kg * 5 + 1) * 32 + nn] = a1; red[(kg * 5 + 2) * 32 + nn] = a2;
  red[(kg * 5 + 3) * 32 + nn] = a3; red[(kg * 5 + 4) * 32 + nn] = a4;
  __syncthreads();
  if (tid < 160) {
    const int r = tid >> 5, n2 = tid & 31;
    float s = 0.f;
#pragma unroll
    for (int g = 0; g < 16; ++g) s += red[(g * 5 + r) * 32 + n2];
    float* MOD = (float*)(P.ws + OFF_MOD);
    MOD[r * 6144 + item * 32 + n2] = s + P.b_ada[item * 32 + n2];
  }
}

__device__ __forceinline__ void lam_pow(float step, float are, float aim, int e, float& pr, float& pi) {
  const float mag = expf((float)e * step * are);
  double ang = (double)e * (double)step * (double)aim;
  ang -= 6.283185307179586476925 * rint(ang * 0.15915494309189533577);
  float s, c;
  __sincosf((float)ang, &s, &c);
  pr = mag * c; pi = mag * s;
}

__device__ __forceinline__ void s5tab_item(const Params& P, int item, char* lds) {
  const int tid = opq(threadIdx.x);
  const int tau = item & 31, g = (item >> 5) & 31, r = item >> 10;
  float* cfr = (float*)lds;
  float* cfi = cfr + 64;
  float* p0r = cfi + 64;
  float* p0i = p0r + 64;
  float* p1r = p0i + 64;
  float* p1i = p1r + 64;
  float* Gr = p1i + 64;
  float* Gi = Gr + 1024;
  float* Cr = Gi + 1024;
  float* Ci = Cr + 1024;
  const int rg = r * 32 + g;
  __syncthreads();
  if (tid < 64) {
    const int n = tid;
    const float step = expf(P.s5_log_step[rg]);
    const float are = P.s5_a_re[rg * 64 + n], aim = P.s5_a_im[rg * 64 + n];
    const float za = step * are;
    double zb = (double)step * (double)aim;
    zb -= 6.283185307179586476925 * rint(zb * 0.15915494309189533577);
    float sb, cb, sh, ch;
    __sincosf((float)zb, &sb, &cb);
    __sincosf((float)(0.5 * zb), &sh, &ch);
    const float em1 = expm1f(za);
    const float re1 = em1 * cb - 2.f * sh * sh;
    const float im1 = (1.f + em1) * sb;
    const float den = are * are + aim * aim;
    cfr[n] = (re1 * are + im1 * aim) / den;
    cfi[n] = (im1 * are - re1 * aim) / den;
    float pr, pi;
    lam_pow(step, are, aim, tau, pr, pi);
    p0r[n] = pr; p0i[n] = pi;
    lam_pow(step, are, aim, tau + 1, pr, pi);
    p1r[n] = pr; p1i[n] = pi;
  }
  for (int i = tid; i < 1024; i += NT) {
    Cr[i] = P.s5_c_re[(size_t)rg * 1024 + i];
    Ci[i] = P.s5_c_im[(size_t)rg * 1024 + i];
  }
  __syncthreads();
  for (int i = tid; i < 1024; i += NT) {
    const int n = i >> 4;
    const float br = P.s5_b_re[(size_t)rg * 1024 + i], bi = P.s5_b_im[(size_t)rg * 1024 + i];
    const float tr = cfr[n] * br - cfi[n] * bi, ti = cfr[n] * bi + cfi[n] * br;
    Gr[i] = p0r[n] * tr - p0i[n] * ti;
    Gi[i] = p0r[n] * ti + p0i[n] * tr;
  }
  __syncthreads();
  u16* MEND = (u16*)(P.ws + OFF_MEND);
  u16* MST = (u16*)(P.ws + OFF_MST);
  float* KTAB = (float*)(P.ws + OFF_KTAB);
  {
    const int ii = (r == 0) ? (31 - tau) : tau;
    for (int i = tid; i < 2048; i += NT) {
      const int part = i >> 10, n = (i >> 4) & 63, pi_ = i & 15;
      const float v = part ? Gi[n * 16 + pi_] : Gr[n * 16 + pi_];
      MEND[((size_t)g * 256 + r * 128 + part * 64 + n) * 512 + ii * 16 + pi_] = f2bf(v);
    }
  }
  if (tid < 256) {
    const int po = tid >> 4, pi_ = tid & 15;
    float s = 0.f;
    for (int n = 0; n < 64; ++n) s += Cr[po * 64 + n] * Gr[n * 16 + pi_] - Ci[po * 64 + n] * Gi[n * 16 + pi_];
    KTAB[(((size_t)rg) * 32 + tau) * 256 + tid] = s;
  }
  {
    const int jj = (r == 0) ? tau : (31 - tau);
    for (int i = tid; i < 2048; i += NT) {
      const int po = i >> 7, part = (i >> 6) & 1, n = i & 63;
      const float cr = Cr[po * 64 + n], ci = Ci[po * 64 + n];
      const float v = part ? -(cr * p1i[n] + ci * p1r[n]) : (cr * p1r[n] - ci * p1i[n]);
      MST[((size_t)g * 512 + jj * 16 + po) * 256 + r * 128 + part * 64 + n] = f2bf(v);
    }
  }
}

__device__ __forceinline__ void norm_row(const float* __restrict__ xr, const float* __restrict__ nw, const float* __restrict__ shift,
                                         const float* __restrict__ scale, u16* __restrict__ dst, int lane) {
  float4 v[4];
  float ss = 0.f;
#pragma unroll
  for (int it = 0; it < 4; ++it) {
    v[it] = *(const float4*)(xr + (it * 64 + lane) * 4);
    ss += v[it].x * v[it].x + v[it].y * v[it].y + v[it].z * v[it].z + v[it].w * v[it].w;
  }
  ss = wsum64(ss);
  const float rstd = rsqrtf(ss * (1.f / 1024.f) + 1e-6f);
#pragma unroll
  for (int it = 0; it < 4; ++it) {
    const int c = (it * 64 + lane) * 4;
    const float4 w4 = *(const float4*)(nw + c), sh = *(const float4*)(shift + c), sc = *(const float4*)(scale + c);
    const float y0 = v[it].x * rstd * w4.x * (1.f + sc.x) + sh.x;
    const float y1 = v[it].y * rstd * w4.y * (1.f + sc.y) + sh.y;
    const float y2 = v[it].z * rstd * w4.z * (1.f + sc.z) + sh.z;
    const float y3 = v[it].w * rstd * w4.w * (1.f + sc.w) + sh.w;
    uint2 o; o.x = pack2(y0, y1); o.y = pack2(y2, y3);
    *(uint2*)(dst + c) = o;
  }
}

__device__ __forceinline__ void norm_row2(const float* __restrict__ xa, const float* __restrict__ xb, const float* __restrict__ nw,
                                          const float* __restrict__ shA, const float* __restrict__ scA,
                                          const float* __restrict__ shB, const float* __restrict__ scB,
                                          u16* __restrict__ da, u16* __restrict__ db, int lane) {
  float4 va[4], vb[4];
#pragma unroll
  for (int it = 0; it < 4; ++it) { va[it] = *(const float4*)(xa + (it * 64 + lane) * 4); vb[it] = *(const float4*)(xb + (it * 64 + lane) * 4); }
  float sa = 0.f, sb = 0.f;
#pragma unroll
  for (int it = 0; it < 4; ++it) {
    sa += va[it].x * va[it].x + va[it].y * va[it].y + va[it].z * va[it].z + va[it].w * va[it].w;
    sb += vb[it].x * vb[it].x + vb[it].y * vb[it].y + vb[it].z * vb[it].z + vb[it].w * vb[it].w;
  }
  sa = wsum64(sa); sb = wsum64(sb);
  const float ra = rsqrtf(sa * (1.f / 1024.f) + 1e-6f), rb = rsqrtf(sb * (1.f / 1024.f) + 1e-6f);
#pragma unroll
  for (int it = 0; it < 4; ++it) {
    const int c = (it * 64 + lane) * 4;
    const float4 w4 = *(const float4*)(nw + c);
    const float4 sh = *(const float4*)(shA + c), sc = *(const float4*)(scA + c);
    const float4 sh2 = *(const float4*)(shB + c), sc2 = *(const float4*)(scB + c);
    uint2 o;
    o.x = pack2(va[it].x * ra * w4.x * (1.f + sc.x) + sh.x, va[it].y * ra * w4.y * (1.f + sc.y) + sh.y);
    o.y = pack2(va[it].z * ra * w4.z * (1.f + sc.z) + sh.z, va[it].w * ra * w4.w * (1.f + sc.w) + sh.w);
    *(uint2*)(da + c) = o;
    o.x = pack2(vb[it].x * rb * w4.x * (1.f + sc2.x) + sh2.x, vb[it].y * rb * w4.y * (1.f + sc2.y) + sh2.y);
    o.y = pack2(vb[it].z * rb * w4.z * (1.f + sc2.z) + sh2.z, vb[it].w * rb * w4.w * (1.f + sc2.w) + sh2.w);
    *(uint2*)(db + c) = o;
  }
}

__device__ __forceinline__ void norm1_item(const Params& P, int item) {
  const int lane = opq(threadIdx.x) & 63, w = opq(threadIdx.x) >> 6;
  const int rowA = item * 16 + w, rowB = rowA + 8;
  const float* MOD = (const float*)(P.ws + OFF_MOD);
  const int ba = (rowA < 16384) ? (rowA >> 12) : 4, bb = (rowB < 16384) ? (rowB >> 12) : 4;
  const float* xa = (rowA < 16384) ? (P.x + (size_t)rowA * 1024) : (P.ctx + (size_t)(rowA - 16384) * 1024);
  const float* xb = (rowB < 16384) ? (P.x + (size_t)rowB * 1024) : (P.ctx + (size_t)(rowB - 16384) * 1024);
  u16* H = (u16*)(P.ws + OFF_R2);
  norm_row2(xa, xb, P.norm1_w, MOD + ba * 6144, MOD + ba * 6144 + 1024, MOD + bb * 6144, MOD + bb * 6144 + 1024,
            H + (size_t)rowA * 1024, H + (size_t)rowB * 1024, lane);
}

__device__ __forceinline__ void mintra_item(const Params& P, int item) {
  const int tid = opq(threadIdx.x);
  const int rowg = item * 8 + (tid >> 6);
  const int g = rowg >> 9, nout = rowg & 511, j = nout >> 4, po = nout & 15;
  const int k0 = (tid & 63) * 8, i = k0 >> 4, pi0 = k0 & 15;
  const float* KTAB = (const float*)(P.ws + OFF_KTAB);
  float f[8];
#pragma unroll
  for (int e = 0; e < 8; ++e) f[e] = 0.f;
  if (i <= j) {
    const float* kp = KTAB + (((size_t)(0 * 32 + g)) * 32 + (j - i)) * 256 + po * 16 + pi0;
#pragma unroll
    for (int e = 0; e < 8; ++e) f[e] += kp[e];
  }
  if (i >= j) {
    const float* kp = KTAB + (((size_t)(1 * 32 + g)) * 32 + (i - j)) * 256 + po * 16 + pi0;
#pragma unroll
    for (int e = 0; e < 8; ++e) f[e] += kp[e];
  }
  if (i == j) {
    const float dv = P.s5_d[g * 16 + po];
#pragma unroll
    for (int e = 0; e < 8; ++e) if (pi0 + e == po) f[e] += dv;
  }
  u16* MI = (u16*)(P.ws + OFF_MINTRA);
  *(uint4*)(MI + (size_t)rowg * 512 + k0) = pack8(f);
}

__device__ __forceinline__ void inproj_tile(const Params& P, int t, char* lds) {
  int mt, nt;
  if (t < 1344) { nt = t / 64; mt = t % 64; }
  else {
    const int tt = t - 1344; mt = 64 + (tt & 3);
    const int ni = tt >> 2;
    nt = (ni < 8) ? (4 + ni) : ((ni < 12) ? (16 + ni - 8) : 20);
  }
  const int m0 = mt * 256, n0 = nt * 128;
  f32x16 acc[2][2];
  acc_zero(acc);
  gemm_main((const u16*)(P.ws + OFF_R2) + (size_t)m0 * 1024, 1024, (const u16*)(P.ws + OFF_WT_IN) + (size_t)n0 * 1024, 1024, 1024, acc, (u16*)lds);
  TILE_COORDS
  if (nt < 12) {
    u16* QKV = (u16*)(P.ws + OFF_R3);
#pragma unroll
    for (int i = 0; i < 2; ++i)
#pragma unroll
      for (int j = 0; j < 2; ++j)
#pragma unroll
        for (int e = 0; e < 16; ++e) QKV[TIDX(m0, n0, i, j, e, 1536)] = f2bf(acc[i][j][e]);
  } else if (nt < 16) {
    u16* Z = (u16*)(P.ws + OFF_Z);
#pragma unroll
    for (int i = 0; i < 2; ++i)
#pragma unroll
      for (int j = 0; j < 2; ++j)
#pragma unroll
        for (int e = 0; e < 16; ++e) Z[TIDX(m0, n0, i, j, e, 512) - 1536] = f2bf(acc[i][j][e]);
  } else if (nt < 20) {
    u16* U5 = (u16*)(P.ws + OFF_U5);
#pragma unroll
    for (int i = 0; i < 2; ++i)
#pragma unroll
      for (int j = 0; j < 2; ++j)
#pragma unroll
        for (int e = 0; e < 16; ++e) {
          const int cc = TCOL(n0, j) - 2048;
          U5[((size_t)(cc >> 4) * 17408 + TROW(m0, i, e)) * 16 + (cc & 15)] = f2bf(acc[i][j][e]);
        }
  } else {
    float* BA = (float*)(P.ws + OFF_BA);
#pragma unroll
    for (int i = 0; i < 2; ++i)
#pragma unroll
      for (int j = 0; j < 2; ++j)
#pragma unroll
        for (int e = 0; e < 16; ++e) {
          const int cc = TCOL(n0, j) - 2560;
          if (cc < 16) BA[(size_t)TROW(m0, i, e) * 16 + cc] = acc[i][j][e];
        }
  }
}

__device__ __forceinline__ void solve_elim(float (&sol)[64], const float* Lr) {
  float4 b0a, b0b, b0c, b0d, b1a, b1b, b1c, b1d, b2a, b2b, b2c, b2d;
  b0a = *(const float4*)(Lr + 0); b0b = *(const float4*)(Lr + 4); b0c = *(const float4*)(Lr + 8); b0d = *(const float4*)(Lr + 12);
  b1a = *(const float4*)(Lr + 16); b1b = *(const float4*)(Lr + 20); b1c = *(const float4*)(Lr + 24); b1d = *(const float4*)(Lr + 28);
  b2a = *(const float4*)(Lr + 32); b2b = *(const float4*)(Lr + 36); b2c = *(const float4*)(Lr + 40); b2d = *(const float4*)(Lr + 44);
  __builtin_amdgcn_sched_barrier(0);
  sol[1] -= b0a.y * sol[0]; sol[2] -= b0a.z * sol[0]; sol[3] -= b0a.w * sol[0]; sol[4] -= b0b.x * sol[0]; sol[5] -= b0b.y * sol[0]; sol[6] -= b0b.z * sol[0]; sol[7] -= b0b.w * sol[0]; sol[8] -= b0c.x * sol[0]; sol[9] -= b0c.y * sol[0]; sol[10] -= b0c.z * sol[0]; sol[11] -= b0c.w * sol[0]; sol[12] -= b0d.x * sol[0]; sol[13] -= b0d.y * sol[0]; sol[14] -= b0d.z * sol[0]; sol[15] -= b0d.w * sol[0];
  __builtin_amdgcn_sched_barrier(0);
  b0a = *(const float4*)(Lr + 48); b0b = *(const float4*)(Lr + 52); b0c = *(const float4*)(Lr + 56); b0d = *(const float4*)(Lr + 60);
  __builtin_amdgcn_sched_barrier(0);
  sol[16] -= b1a.x * sol[0]; sol[17] -= b1a.y * sol[0]; sol[18] -= b1a.z * sol[0]; sol[19] -= b1a.w * sol[0]; sol[20] -= b1b.x * sol[0]; sol[21] -= b1b.y * sol[0]; sol[22] -= b1b.z * sol[0]; sol[23] -= b1b.w * sol[0]; sol[24] -= b1c.x * sol[0]; sol[25] -= b1c.y * sol[0]; sol[26] -= b1c.z * sol[0]; sol[27] -= b1c.w * sol[0]; sol[28] -= b1d.x * sol[0]; sol[29] -= b1d.y * sol[0]; sol[30] -= b1d.z * sol[0]; sol[31] -= b1d.w * sol[0];
  __builtin_amdgcn_sched_barrier(0);
  b1a = *(const float4*)(Lr + 64); b1b = *(const float4*)(Lr + 68); b1c = *(const float4*)(Lr + 72); b1d = *(const float4*)(Lr + 76);
  __builtin_amdgcn_sched_barrier(0);
  sol[32] -= b2a.x * sol[0]; sol[33] -= b2a.y * sol[0]; sol[34] -= b2a.z * sol[0]; sol[35] -= b2a.w * sol[0]; sol[36] -= b2b.x * sol[0]; sol[37] -= b2b.y * sol[0]; sol[38] -= b2b.z * sol[0]; sol[39] -= b2b.w * sol[0]; sol[40] -= b2c.x * sol[0]; sol[41] -= b2c.y * sol[0]; sol[42] -= b2c.z * sol[0]; sol[43] -= b2c.w * sol[0]; sol[44] -= b2d.x * sol[0]; sol[45] -= b2d.y * sol[0]; sol[46] -= b2d.z * sol[0]; sol[47] -= b2d.w * sol[0];
  __builtin_amdgcn_sched_barrier(0);
  b2a = *(const float4*)(Lr + 80); b2b = *(const float4*)(Lr + 84); b2c = *(const float4*)(Lr + 88); b2d = *(const float4*)(Lr + 92);
  __builtin_amdgcn_sched_barrier(0);
  sol[48] -= b0a.x * sol[0]; sol[49] -= b0a.y * sol[0]; sol[50] -= b0a.z * sol[0]; sol[51] -= b0a.w * sol[0]; sol[52] -= b0b.x * sol[0]; sol[53] -= b0b.y * sol[0]; sol[54] -= b0b.z * sol[0]; sol[55] -= b0b.w * sol[0]; sol[56] -= b0c.x * sol[0]; sol[57] -= b0c.y * sol[0]; sol[58] -= b0c.z * sol[0]; sol[59] -= b0c.w * sol[0]; sol[60] -= b0d.x * sol[0]; sol[61] -= b0d.y * sol[0]; sol[62] -= b0d.z * sol[0]; sol[63] -= b0d.w * sol[0];
  __builtin_amdgcn_sched_barrier(0);
  b0a = *(const float4*)(Lr + 96); b0b = *(const float4*)(Lr + 100); b0c = *(const float4*)(Lr + 104); b0d = *(const float4*)(Lr + 108);
  __builtin_amdgcn_sched_barrier(0);
  sol[2] -= b1a.z * sol[1]; sol[3] -= b1a.w * sol[1]; sol[4] -= b1b.x * sol[1]; sol[5] -= b1b.y * sol[1]; sol[6] -= b1b.z * sol[1]; sol[7] -= b1b.w * sol[1]; sol[8] -= b1c.x * sol[1]; sol[9] -= b1c.y * sol[1]; sol[10] -= b1c.z * sol[1]; sol[11] -= b1c.w * sol[1]; sol[12] -= b1d.x * sol[1]; sol[13] -= b1d.y * sol[1]; sol[14] -= b1d.z * sol[1]; sol[15] -= b1d.w * sol[1];
  __builtin_amdgcn_sched_barrier(0);
  b1a = *(const float4*)(Lr + 112); b1b = *(const float4*)(Lr + 116); b1c = *(const float4*)(Lr + 120); b1d = *(const float4*)(Lr + 124);
  __builtin_amdgcn_sched_barrier(0);
  sol[16] -= b2a.x * sol[1]; sol[17] -= b2a.y * sol[1]; sol[18] -= b2a.z * sol[1]; sol[19] -= b2a.w * sol[1]; sol[20] -= b2b.x * sol[1]; sol[21] -= b2b.y * sol[1]; sol[22] -= b2b.z * sol[1]; sol[23] -= b2b.w * sol[1]; sol[24] -= b2c.x * sol[1]; sol[25] -= b2c.y * sol[1]; sol[26] -= b2c.z * sol[1]; sol[27] -= b2c.w * sol[1]; sol[28] -= b2d.x * sol[1]; sol[29] -= b2d.y * sol[1]; sol[30] -= b2d.z * sol[1]; sol[31] -= b2d.w * sol[1];
  __builtin_amdgcn_sched_barrier(0);
  b2a = *(const float4*)(Lr + 128); b2b = *(const float4*)(Lr + 132); b2c = *(const float4*)(Lr + 136); b2d = *(const float4*)(Lr + 140);
  __builtin_amdgcn_sched_barrier(0);
  sol[32] -= b0a.x * sol[1]; sol[33] -= b0a.y * sol[1]; sol[34] -= b0a.z * sol[1]; sol[35] -= b0a.w * sol[1]; sol[36] -= b0b.x * sol[1]; sol[37] -= b0b.y * sol[1]; sol[38] -= b0b.z * sol[1]; sol[39] -= b0b.w * sol[1]; sol[40] -= b0c.x * sol[1]; sol[41] -= b0c.y * sol[1]; sol[42] -= b0c.z * sol[1]; sol[43] -= b0c.w * sol[1]; sol[44] -= b0d.x * sol[1]; sol[45] -= b0d.y * sol[1]; sol[46] -= b0d.z * sol[1]; sol[47] -= b0d.w * sol[1];
  __builtin_amdgcn_sched_barrier(0);
  b0a = *(const float4*)(Lr + 144); b0b = *(const float4*)(Lr + 148); b0c = *(const float4*)(Lr + 152); b0d = *(const float4*)(Lr + 156);
  __builtin_amdgcn_sched_barrier(0);
  sol[48] -= b1a.x * sol[1]; sol[49] -= b1a.y * sol[1]; sol[50] -= b1a.z * sol[1]; sol[51] -= b1a.w * sol[1]; sol[52] -= b1b.x * sol[1]; sol[53] -= b1b.y * sol[1]; sol[54] -= b1b.z * sol[1]; sol[55] -= b1b.w * sol[1]; sol[56] -= b1c.x * sol[1]; sol[57] -= b1c.y * sol[1]; sol[58] -= b1c.z * sol[1]; sol[59] -= b1c.w * sol[1]; sol[60] -= b1d.x * sol[1]; sol[61] -= b1d.y * sol[1]; sol[62] -= b1d.z * sol[1]; sol[63] -= b1d.w * sol[1];
  __builtin_amdgcn_sched_barrier(0);
  b1a = *(const float4*)(Lr + 160); b1b = *(const float4*)(Lr + 164); b1c = *(const float4*)(Lr + 168); b1d = *(const float4*)(Lr + 172);
  __builtin_amdgcn_sched_barrier(0);
  sol[3] -= b2a.w * sol[2]; sol[4] -= b2b.x * sol[2]; sol[5] -= b2b.y * sol[2]; sol[6] -= b2b.z * sol[2]; sol[7] -= b2b.w * sol[2]; sol[8] -= b2c.x * sol[2]; sol[9] -= b2c.y * sol[2]; sol[10] -= b2c.z * sol[2]; sol[11] -= b2c.w * sol[2]; sol[12] -= b2d.x * sol[2]; sol[13] -= b2d.y * sol[2]; sol[14] -= b2d.z * sol[2]; sol[15] -= b2d.w * sol[2];
  __builtin_amdgcn_sched_barrier(0);
  b2a = *(const float4*)(Lr + 176); b2b = *(const float4*)(Lr + 180); b2c = *(const float4*)(Lr + 184); b2d = *(const float4*)(Lr + 188);
  __builtin_amdgcn_sched_barrier(0);
  sol[16] -= b0a.x * sol[2]; sol[17] -= b0a.y * sol[2]; sol[18] -= b0a.z * sol[2]; sol[19] -= b0a.w * sol[2]; sol[20] -= b0b.x * sol[2]; sol[21] -= b0b.y * sol[2]; sol[22] -= b0b.z * sol[2]; sol[23] -= b0b.w * sol[2]; sol[24] -= b0c.x * sol[2]; sol[25] -= b0c.y * sol[2]; sol[26] -= b0c.z * sol[2]; sol[27] -= b0c.w * sol[2]; sol[28] -= b0d.x * sol[2]; sol[29] -= b0d.y * sol[2]; sol[30] -= b0d.z * sol[2]; sol[31] -= b0d.w * sol[2];
  __builtin_amdgcn_sched_barrier(0);
  b0a = *(const float4*)(Lr + 192); b0b = *(const float4*)(Lr + 196); b0c = *(const float4*)(Lr + 200); b0d = *(const float4*)(Lr + 204);
  __builtin_amdgcn_sched_barrier(0);
  sol[32] -= b1a.x * sol[2]; sol[33] -= b1a.y * sol[2]; sol[34] -= b1a.z * sol[2]; sol[35] -= b1a.w * sol[2]; sol[36] -= b1b.x * sol[2]; sol[37] -= b1b.y * sol[2]; sol[38] -= b1b.z * sol[2]; sol[39] -= b1b.w * sol[2]; sol[40] -= b1c.x * sol[2]; sol[41] -= b1c.y * sol[2]; sol[42] -= b1c.z * sol[2]; sol[43] -= b1c.w * sol[2]; sol[44] -= b1d.x * sol[2]; sol[45] -= b1d.y * sol[2]; sol[46] -= b1d.z * sol[2]; sol[47] -= b1d.w * sol[2];
  __builtin_amdgcn_sched_barrier(0);
  b1a = *(const float4*)(Lr + 208); b1b = *(const float4*)(Lr + 212); b1c = *(const float4*)(Lr + 216); b1d = *(const float4*)(Lr + 220);
  __builtin_amdgcn_sched_barrier(0);
  sol[48] -= b2a.x * sol[2]; sol[49] -= b2a.y * sol[2]; sol[50] -= b2a.z * sol[2]; sol[51] -= b2a.w * sol[2]; sol[52] -= b2b.x * sol[2]; sol[53] -= b2b.y * sol[2]; sol[54] -= b2b.z * sol[2]; sol[55] -= b2b.w * sol[2]; sol[56] -= b2c.x * sol[2]; sol[57] -= b2c.y * sol[2]; sol[58] -= b2c.z * sol[2]; sol[59] -= b2c.w * sol[2]; sol[60] -= b2d.x * sol[2]; sol[61] -= b2d.y * sol[2]; sol[62] -= b2d.z * sol[2]; sol[63] -= b2d.w * sol[2];
  __builtin_amdgcn_sched_barrier(0);
  b2a = *(const float4*)(Lr + 224); b2b = *(const float4*)(Lr + 228); b2c = *(const float4*)(Lr + 232); b2d = *(const float4*)(Lr + 236);
  __builtin_amdgcn_sched_barrier(0);
  sol[4] -= b0b.x * sol[3]; sol[5] -= b0b.y * sol[3]; sol[6] -= b0b.z * sol[3]; sol[7] -= b0b.w * sol[3]; sol[8] -= b0c.x * sol[3]; sol[9] -= b0c.y * sol[3]; sol[10] -= b0c.z * sol[3]; sol[11] -= b0c.w * sol[3]; sol[12] -= b0d.x * sol[3]; sol[13] -= b0d.y * sol[3]; sol[14] -= b0d.z * sol[3]; sol[15] -= b0d.w * sol[3];
  __builtin_amdgcn_sched_barrier(0);
  b0a = *(const float4*)(Lr + 240); b0b = *(const float4*)(Lr + 244); b0c = *(const float4*)(Lr + 248); b0d = *(const float4*)(Lr + 252);
  __builtin_amdgcn_sched_barrier(0);
  sol[16] -= b1a.x * sol[3]; sol[17] -= b1a.y * sol[3]; sol[18] -= b1a.z * sol[3]; sol[19] -= b1a.w * sol[3]; sol[20] -= b1b.x * sol[3]; sol[21] -= b1b.y * sol[3]; sol[22] -= b1b.z * sol[3]; sol[23] -= b1b.w * sol[3]; sol[24] -= b1c.x * sol[3]; sol[25] -= b1c.y * sol[3]; sol[26] -= b1c.z * sol[3]; sol[27] -= b1c.w * sol[3]; sol[28] -= b1d.x * sol[3]; sol[29] -= b1d.y * sol[3]; sol[30] -= b1d.z * sol[3]; sol[31] -= b1d.w * sol[3];
  __builtin_amdgcn_sched_barrier(0);
  b1a = *(const float4*)(Lr + 256); b1b = *(const float4*)(Lr + 260); b1c = *(const float4*)(Lr + 264); b1d = *(const float4*)(Lr + 268);
  __builtin_amdgcn_sched_barrier(0);
  sol[32] -= b2a.x * sol[3]; sol[33] -= b2a.y * sol[3]; sol[34] -= b2a.z * sol[3]; sol[35] -= b2a.w * sol[3]; sol[36] -= b2b.x * sol[3]; sol[37] -= b2b.y * sol[3]; sol[38] -= b2b.z * sol[3]; sol[39] -= b2b.w * sol[3]; sol[40] -= b2c.x * sol[3]; sol[41] -= b2c.y * sol[3]; sol[42] -= b2c.z * sol[3]; sol[43] -= b2c.w * sol[3]; sol[44] -= b2d.x * sol[3]; sol[45] -= b2d.y * sol[3]; sol[46] -= b2d.z * sol[3]; sol[47] -= b2d.w * sol[3];
  __builtin_amdgcn_sched_barrier(0);
  b2a = *(const float4*)(Lr + 272); b2b = *(const float4*)(Lr + 276); b2c = *(const float4*)(Lr + 280); b2d = *(const float4*)(Lr + 284);
  __builtin_amdgcn_sched_barrier(0);
  sol[48] -= b0a.x * sol[3]; sol[49] -= b0a.y * sol[3]; sol[50] -= b0a.z * sol[3]; sol[51] -= b0a.w * sol[3]; sol[52] -= b0b.x * sol[3]; sol[53] -= b0b.y * sol[3]; sol[54] -= b0b.z * sol[3]; sol[55] -= b0b.w * sol[3]; sol[56] -= b0c.x * sol[3]; sol[57] -= b0c.y * sol[3]; sol[58] -= b0c.z * sol[3]; sol[59] -= b0c.w * sol[3]; sol[60] -= b0d.x * sol[3]; sol[61] -= b0d.y * sol[3]; sol[62] -= b0d.z * sol[3]; sol[63] -= b0d.w * sol[3];
  __builtin_amdgcn_sched_barrier(0);
  b0a = *(const float4*)(Lr + 288); b0b = *(const float4*)(Lr + 292); b0c = *(const float4*)(Lr + 296); b0d = *(const float4*)(Lr + 300);
  __builtin_amdgcn_sched_barrier(0);
  sol[5] -= b1b.y * sol[4]; sol[6] -= b1b.z * sol[4]; sol[7] -= b1b.w * sol[4]; sol[8] -= b1c.x * sol[4]; sol[9] -= b1c.y * sol[4]; sol[10] -= b1c.z * sol[4]; sol[11] -= b1c.w * sol[4]; sol[12] -= b1d.x * sol[4]; sol[13] -= b1d.y * sol[4]; sol[14] -= b1d.z * sol[4]; sol[15] -= b1d.w * sol[4];
  __builtin_amdgcn_sched_barrier(0);
  b1a = *(const float4*)(Lr + 304); b1b = *(const float4*)(Lr + 308); b1c = *(const float4*)(Lr + 312); b1d = *(const float4*)(Lr + 316);
  __builtin_amdgcn_sched_barrier(0);
  sol[16] -= b2a.x * sol[4]; sol[17] -= b2a.y * sol[4]; sol[18] -= b2a.z * sol[4]; sol[19] -= b2a.w * sol[4]; sol[20] -= b2b.x * sol[4]; sol[21] -= b2b.y * sol[4]; sol[22] -= b2b.z * sol[4]; sol[23] -= b2b.w * sol[4]; sol[24] -= b2c.x * sol[4]; sol[25] -= b2c.y * sol[4]; sol[26] -= b2c.z * sol[4]; sol[27] -= b2c.w * sol[4]; sol[28] -= b2d.x * sol[4]; sol[29] -= b2d.y * sol[4]; sol[30] -= b2d.z * sol[4]; sol[31] -= b2d.w * sol[4];
  __builtin_amdgcn_sched_barrier(0);
  b2a = *(const float4*)(Lr + 320); b2b = *(const float4*)(Lr + 324); b2c = *(const float4*)(Lr + 328); b2d = *(const float4*)(Lr + 332);
  __builtin_amdgcn_sched_barrier(0);
  sol[32] -= b0a.x * sol[4]; sol[33] -= b0a.y * sol[4]; sol[34] -= b0a.z * sol[4]; sol[35] -= b0a.w * sol[4]; sol[36] -= b0b.x * sol[4]; sol[37] -= b0b.y * sol[4]; sol[38] -= b0b.z * sol[4]; sol[39] -= b0b.w * sol[4]; sol[40] -= b0c.x * sol[4]; sol[41] -= b0c.y * sol[4]; sol[42] -= b0c.z * sol[4]; sol[43] -= b0c.w * sol[4]; sol[44] -= b0d.x * sol[4]; sol[45] -= b0d.y * sol[4]; sol[46] -= b0d.z * sol[4]; sol[47] -= b0d.w * sol[4];
  __builtin_amdgcn_sched_barrier(0);
  b0a = *(const float4*)(Lr + 336); b0b = *(const float4*)(Lr + 340); b0c = *(const float4*)(Lr + 344); b0d = *(const float4*)(Lr + 348);
  __builtin_amdgcn_sched_barrier(0);
  sol[48] -= b1a.x * sol[4]; sol[49] -= b1a.y * sol[4]; sol[50] -= b1a.z * sol[4]; sol[51] -= b1a.w * sol[4]; sol[52] -= b1b.x * sol[4]; sol[53] -= b1b.y * sol[4]; sol[54] -= b1b.z * sol[4]; sol[55] -= b1b.w * sol[4]; sol[56] -= b1c.x * sol[4]; sol[57] -= b1c.y * sol[4]; sol[58] -= b1c.z * sol[4]; sol[59] -= b1c.w * sol[4]; sol[60] -= b1d.x * sol[4]; sol[61] -= b1d.y * sol[4]; sol[62] -= b1d.z * sol[4]; sol[63] -= b1d.w * sol[4];
  __builtin_amdgcn_sched_barrier(0);
  b1a = *(const float4*)(Lr + 352); b1b = *(const float4*)(Lr + 356); b1c = *(const float4*)(Lr + 360); b1d = *(const float4*)(Lr + 364);
  __builtin_amdgcn_sched_barrier(0);
  sol[6] -= b2b.z * sol[5]; sol[7] -= b2b.w * sol[5]; sol[8] -= b2c.x * sol[5]; sol[9] -= b2c.y * sol[5]; sol[10] -= b2c.z * sol[5]; sol[11] -= b2c.w * sol[5]; sol[12] -= b2d.x * sol[5]; sol[13] -= b2d.y * sol[5]; sol[14] -= b2d.z * sol[5]; sol[15] -= b2d.w * sol[5];
  __builtin_amdgcn_sched_barrier(0);
  b2a = *(const float4*)(Lr + 368); b2b = *(const float4*)(Lr + 372); b2c = *(const float4*)(Lr + 376); b2d = *(const float4*)(Lr + 380);
  __builtin_amdgcn_sched_barrier(0);
  sol[16] -= b0a.x * sol[5]; sol[17] -= b0a.y * sol[5]; sol[18] -= b0a.z * sol[5]; sol[19] -= b0a.w * sol[5]; sol[20] -= b0b.x * sol[5]; sol[21] -= b0b.y * sol[5]; sol[22] -= b0b.z * sol[5]; sol[23] -= b0b.w * sol[5]; sol[24] -= b0c.x * sol[5]; sol[25] -= b0c.y * sol[5]; sol[26] -= b0c.z * sol[5]; sol[27] -= b0c.w * sol[5]; sol[28] -= b0d.x * sol[5]; sol[29] -= b0d.y * sol[5]; sol[30] -= b0d.z * sol[5]; sol[31] -= b0d.w * sol[5];
  __builtin_amdgcn_sched_barrier(0);
  b0a = *(const float4*)(Lr + 384); b0b = *(const float4*)(Lr + 388); b0c = *(const float4*)(Lr + 392); b0d = *(const float4*)(Lr + 396);
  __builtin_amdgcn_sched_barrier(0);
  sol[32] -= b1a.x * sol[5]; sol[33] -= b1a.y * sol[5]; sol[34] -= b1a.z * sol[5]; sol[35] -= b1a.w * sol[5]; sol[36] -= b1b.x * sol[5]; sol[37] -= b1b.y * sol[5]; sol[38] -= b1b.z * sol[5]; sol[39] -= b1b.w * sol[5]; sol[40] -= b1c.x * sol[5]; sol[41] -= b1c.y * sol[5]; sol[42] -= b1c.z * sol[5]; sol[43] -= b1c.w * sol[5]; sol[44] -= b1d.x * sol[5]; sol[45] -= b1d.y * sol[5]; sol[46] -= b1d.z * sol[5]; sol[47] -= b1d.w * sol[5];
  __builtin_amdgcn_sched_barrier(0);
  b1a = *(const float4*)(Lr + 400); b1b = *(const float4*)(Lr + 404); b1c = *(const float4*)(Lr + 408); b1d = *(const float4*)(Lr + 412);
  __builtin_amdgcn_sched_barrier(0);
  sol[48] -= b2a.x * sol[5]; sol[49] -= b2a.y * sol[5]; sol[50] -= b2a.z * sol[5]; sol[51] -= b2a.w * sol[5]; sol[52] -= b2b.x * sol[5]; sol[53] -= b2b.y * sol[5]; sol[54] -= b2b.z * sol[5]; sol[55] -= b2b.w * sol[5]; sol[56] -= b2c.x * sol[5]; sol[57] -= b2c.y * sol[5]; sol[58] -= b2c.z * sol[5]; sol[59] -= b2c.w * sol[5]; sol[60] -= b2d.x * sol[5]; sol[61] -= b2d.y * sol[5]; sol[62] -= b2d.z * sol[5]; sol[63] -= b2d.w * sol[5];
  __builtin_amdgcn_sched_barrier(0);
  b2a = *(const float4*)(Lr + 416); b2b = *(const float4*)(Lr + 420); b2c = *(const float4*)(Lr + 424); b2d = *(const float4*)(Lr + 428);
  __builtin_amdgcn_sched_barrier(0);
  sol[7] -= b0b.w * sol[6]; sol[8] -= b0c.x * sol[6]; sol[9] -= b0c.y * sol[6]; sol[10] -= b0c.z * sol[6]; sol[11] -= b0c.w * sol[6]; sol[12] -= b0d.x * sol[6]; sol[13] -= b0d.y * sol[6]; sol[14] -= b0d.z * sol[6]; sol[15] -= b0d.w * sol[6];
  __builtin_amdgcn_sched_barrier(0);
  b0a = *(const float4*)(Lr + 432); b0b = *(const float4*)(Lr + 436); b0c = *(const float4*)(Lr + 440); b0d = *(const float4*)(Lr + 444);
  __builtin_amdgcn_sched_barrier(0);
  sol[16] -= b1a.x * sol[6]; sol[17] -= b1a.y * sol[6]; sol[18] -= b1a.z * sol[6]; sol[19] -= b1a.w * sol[6]; sol[20] -= b1b.x * sol[6]; sol[21] -= b1b.y * sol[6]; sol[22] -= b1b.z * sol[6]; sol[23] -= b1b.w * sol[6]; sol[24] -= b1c.x * sol[6]; sol[25] -= b1c.y * sol[6]; sol[26] -= b1c.z * sol[6]; sol[27] -= b1c.w * sol[6]; sol[28] -= b1d.x * sol[6]; sol[29] -= b1d.y * sol[6]; sol[30] -= b1d.z * sol[6]; sol[31] -= b1d.w * sol[6];
  __builtin_amdgcn_sched_barrier(0);
  b1a = *(const float4*)(Lr + 448); b1b = *(const float4*)(Lr + 452); b1c = *(const float4*)(Lr + 456); b1d = *(const float4*)(Lr + 460);
  __builtin_amdgcn_sched_barrier(0);
  sol[32] -= b2a.x * sol[6]; sol[33] -= b2a.y * sol[6]; sol[34] -= b2a.z * sol[6]; sol[35] -= b2a.w * sol[6]; sol[36] -= b2b.x * sol[6]; sol[37] -= b2b.y * sol[6]; sol[38] -= b2b.z * sol[6]; sol[39] -= b2b.w * sol[6]; sol[40] -= b2c.x * sol[6]; sol[41] -= b2c.y * sol[6]; sol[42] -= b2c.z * sol[6]; sol[43] -= b2c.w * sol[6]; sol[44] -= b2d.x * sol[6]; sol[45] -= b2d.y * sol[6]; sol[46] -= b2d.z * sol[6]; sol[47] -= b2d.w * sol[6];
  __builtin_amdgcn_sched_barrier(0);
  b2a = *(const float4*)(Lr + 464); b2b = *(const float4*)(Lr + 468); b2c = *(const float4*)(Lr + 472); b2d = *(const float4*)(Lr + 476);
  __builtin_amdgcn_sched_barrier(0);
  sol[48] -= b0a.x * sol[6]; sol[49] -= b0a.y * sol[6]; sol[50] -= b0a.z * sol[6]; sol[51] -= b0a.w * sol[6]; sol[52] -= b0b.x * sol[6]; sol[53] -= b0b.y * sol[6]; sol[54] -= b0b.z * sol[6]; sol[55] -= b0b.w * sol[6]; sol[56] -= b0c.x * sol[6]; sol[57] -= b0c.y * sol[6]; sol[58] -= b0c.z * sol[6]; sol[59] -= b0c.w * sol[6]; sol[60] -= b0d.x * sol[6]; sol[61] -= b0d.y * sol[6]; sol[62] -= b0d.z * sol[6]; sol[63] -= b0d.w * sol[6];
  __builtin_amdgcn_sched_barrier(0);
  b0a = *(const float4*)(Lr + 480); b0b = *(const float4*)(Lr + 484); b0c = *(const float4*)(Lr + 488); b0d = *(const float4*)(Lr + 492);
  __builtin_amdgcn_sched_barrier(0);
  sol[8] -= b1c.x * sol[7]; sol[9] -= b1c.y * sol[7]; sol[10] -= b1c.z * sol[7]; sol[11] -= b1c.w * sol[7]; sol[12] -= b1d.x * sol[7]; sol[13] -= b1d.y * sol[7]; sol[14] -= b1d.z * sol[7]; sol[15] -= b1d.w * sol[7];
  __builtin_amdgcn_sched_barrier(0);
  b1a = *(const float4*)(Lr + 496); b1b = *(const float4*)(Lr + 500); b1c = *(const float4*)(Lr + 504); b1d = *(const float4*)(Lr + 508);
  __builtin_amdgcn_sched_barrier(0);
  sol[16] -= b2a.x * sol[7]; sol[17] -= b2a.y * sol[7]; sol[18] -= b2a.z * sol[7]; sol[19] -= b2a.w * sol[7]; sol[20] -= b2b.x * sol[7]; sol[21] -= b2b.y * sol[7]; sol[22] -= b2b.z * sol[7]; sol[23] -= b2b.w * sol[7]; sol[24] -= b2c.x * sol[7]; sol[25] -= b2c.y * sol[7]; sol[26] -= b2c.z * sol[7]; sol[27] -= b2c.w * sol[7]; sol[28] -= b2d.x * sol[7]; sol[29] -= b2d.y * sol[7]; sol[30] -= b2d.z * sol[7]; sol[31] -= b2d.w * sol[7];
  __builtin_amdgcn_sched_barrier(0);
  b2a = *(const float4*)(Lr + 512); b2b = *(const float4*)(Lr + 516); b2c = *(const float4*)(Lr + 520); b2d = *(const float4*)(Lr + 524);
  __builtin_amdgcn_sched_barrier(0);
  sol[32] -= b0a.x * sol[7]; sol[33] -= b0a.y * sol[7]; sol[34] -= b0a.z * sol[7]; sol[35] -= b0a.w * sol[7]; sol[36] -= b0b.x * sol[7]; sol[37] -= b0b.y * sol[7]; sol[38] -= b0b.z * sol[7]; sol[39] -= b0b.w * sol[7]; sol[40] -= b0c.x * sol[7]; sol[41] -= b0c.y * sol[7]; sol[42] -= b0c.z * sol[7]; sol[43] -= b0c.w * sol[7]; sol[44] -= b0d.x * sol[7]; sol[45] -= b0d.y * sol[7]; sol[46] -= b0d.z * sol[7]; sol[47] -= b0d.w * sol[7];
  __builtin_amdgcn_sched_barrier(0);
  b0a = *(const float4*)(Lr + 528); b0b = *(const float4*)(Lr + 532); b0c = *(const float4*)(Lr + 536); b0d = *(const float4*)(Lr + 540);
  __builtin_amdgcn_sched_barrier(0);
  sol[48] -= b1a.x * sol[7]; sol[49] -= b1a.y * sol[7]; sol[50] -= b1a.z * sol[7]; sol[51] -= b1a.w * sol[7]; sol[52] -= b1b.x * sol[7]; sol[53] -= b1b.y * sol[7]; sol[54] -= b1b.z * sol[7]; sol[55] -= b1b.w * sol[7]; sol[56] -= b1c.x * sol[7]; sol[57] -= b1c.y * sol[7]; sol[58] -= b1c.z * sol[7]; sol[59] -= b1c.w * sol[7]; sol[60] -= b1d.x * sol[7]; sol[61] -= b1d.y * sol[7]; sol[62] -= b1d.z * sol[7]; sol[63] -= b1d.w * sol[7];
  __builtin_amdgcn_sched_barrier(0);
  b1a = *(const float4*)(Lr + 544); b1b = *(const float4*)(Lr + 548); b1c = *(const float4*)(Lr + 552); b1d = *(const float4*)(Lr + 556);
  __builtin_amdgcn_sched_barrier(0);
  sol[9] -= b2c.y * sol[8]; sol[10] -= b2c.z * sol[8]; sol[11] -= b2c.w * sol[8]; sol[12] -= b2d.x * sol[8]; sol[13] -= b2d.y * sol[8]; sol[14] -= b2d.z * sol[8]; sol[15] -= b2d.w * sol[8];
  __builtin_amdgcn_sched_barrier(0);
  b2a = *(const float4*)(Lr + 560); b2b = *(const float4*)(Lr + 564); b2c = *(const float4*)(Lr + 568); b2d = *(const float4*)(Lr + 572);
  __builtin_amdgcn_sched_barrier(0);
  sol[16] -= b0a.x * sol[8]; sol[17] -= b0a.y * sol[8]; sol[18] -= b0a.z * sol[8]; sol[19] -= b0a.w * sol[8]; sol[20] -= b0b.x * sol[8]; sol[21] -= b0b.y * sol[8]; sol[22] -= b0b.z * sol[8]; sol[23] -= b0b.w * sol[8]; sol[24] -= b0c.x * sol[8]; sol[25] -= b0c.y * sol[8]; sol[26] -= b0c.z * sol[8]; sol[27] -= b0c.w * sol[8]; sol[28] -= b0d.x * sol[8]; sol[29] -= b0d.y * sol[8]; sol[30] -= b0d.z * sol[8]; sol[31] -= b0d.w * sol[8];
  __builtin_amdgcn_sched_barrier(0);
  b0a = *(const float4*)(Lr + 576); b0b = *(const float4*)(Lr + 580); b0c = *(const float4*)(Lr + 584); b0d = *(const float4*)(Lr + 588);
  __builtin_amdgcn_sched_barrier(0);
  sol[32] -= b1a.x * sol[8]; sol[33] -= b1a.y * sol[8]; sol[34] -= b1a.z * sol[8]; sol[35] -= b1a.w * sol[8]; sol[36] -= b1b.x * sol[8]; sol[37] -= b1b.y * sol[8]; sol[38] -= b1b.z * sol[8]; sol[39] -= b1b.w * sol[8]; sol[40] -= b1c.x * sol[8]; sol[41] -= b1c.y * sol[8]; sol[42] -= b1c.z * sol[8]; sol[43] -= b1c.w * sol[8]; sol[44] -= b1d.x * sol[8]; sol[45] -= b1d.y * sol[8]; sol[46] -= b1d.z * sol[8]; sol[47] -= b1d.w * sol[8];
  __builtin_amdgcn_sched_barrier(0);
  b1a = *(const float4*)(Lr + 592); b1b = *(const float4*)(Lr + 596); b1c = *(const float4*)(Lr + 600); b1d = *(const float4*)(Lr + 604);
  __builtin_amdgcn_sched_barrier(0);
  sol[48] -= b2a.x * sol[8]; sol[49] -= b2a.y * sol[8]; sol[50] -= b2a.z * sol[8]; sol[51] -= b2a.w * sol[8]; sol[52] -= b2b.x * sol[8]; sol[53] -= b2b.y * sol[8]; sol[54] -= b2b.z * sol[8]; sol[55] -= b2b.w * sol[8]; sol[56] -= b2c.x * sol[8]; sol[57] -= b2c.y * sol[8]; sol[58] -= b2c.z * sol[8]; sol[59] -= b2c.w * sol[8]; sol[60] -= b2d.x * sol[8]; sol[61] -= b2d.y * sol[8]; sol[62] -= b2d.z * sol[8]; sol[63] -= b2d.w * sol[8];
  __builtin_amdgcn_sched_barrier(0);
  b2a = *(const float4*)(Lr + 608); b2b = *(const float4*)(Lr + 612); b2c = *(const float4*)(Lr + 616); b2d = *(const float4*)(Lr + 620);
  __builtin_amdgcn_sched_barrier(0);
  sol[10] -= b0c.z * sol[9]; sol[11] -= b0c.w * sol[9]; sol[12] -= b0d.x * sol[9]; sol[13] -= b0d.y * sol[9]; sol[14] -= b0d.z * sol[9]; sol[15] -= b0d.w * sol[9];
  __builtin_amdgcn_sched_barrier(0);
  b0a = *(const float4*)(Lr + 624); b0b = *(const float4*)(Lr + 628); b0c = *(const float4*)(Lr + 632); b0d = *(const float4*)(Lr + 636);
  __builtin_amdgcn_sched_barrier(0);
  sol[16] -= b1a.x * sol[9]; sol[17] -= b1a.y * sol[9]; sol[18] -= b1a.z * sol[9]; sol[19] -= b1a.w * sol[9]; sol[20] -= b1b.x * sol[9]; sol[21] -= b1b.y * sol[9]; sol[22] -= b1b.z * sol[9]; sol[23] -= b1b.w * sol[9]; sol[24] -= b1c.x * sol[9]; sol[25] -= b1c.y * sol[9]; sol[26] -= b1c.z * sol[9]; sol[27] -= b1c.w * sol[9]; sol[28] -= b1d.x * sol[9]; sol[29] -= b1d.y * sol[9]; sol[30] -= b1d.z * sol[9]; sol[31] -= b1d.w * sol[9];
  __builtin_amdgcn_sched_barrier(0);
  b1a = *(const float4*)(Lr + 640); b1b = *(const float4*)(Lr + 644); b1c = *(const float4*)(Lr + 648); b1d = *(const float4*)(Lr + 652);
  __builtin_amdgcn_sched_barrier(0);
  sol[32] -= b2a.x * sol[9]; sol[33] -= b2a.y * sol[9]; sol[34] -= b2a.z * sol[9]; sol[35] -= b2a.w * sol[9]; sol[36] -= b2b.x * sol[9]; sol[37] -= b2b.y * sol[9]; sol[38] -= b2b.z * sol[9]; sol[39] -= b2b.w * sol[9]; sol[40] -= b2c.x * sol[9]; sol[41] -= b2c.y * sol[9]; sol[42] -= b2c.z * sol[9]; sol[43] -= b2c.w * sol[9]; sol[44] -= b2d.x * sol[9]; sol[45] -= b2d.y * sol[9]; sol[46] -= b2d.z * sol[9]; sol[47] -= b2d.w * sol[9];
  __builtin_amdgcn_sched_barrier(0);
  b2a = *(const float4*)(Lr + 656); b2b = *(const float4*)(Lr + 660); b2c = *(const float4*)(Lr + 664); b2d = *(const float4*)(Lr + 668);
  __builtin_amdgcn_sched_barrier(0);
  sol[48] -= b0a.x * sol[9]; sol[49] -= b0a.y * sol[9]; sol[50] -= b0a.z * sol[9]; sol[51] -= b0a.w * sol[9]; sol[52] -= b0b.x * sol[9]; sol[53] -= b0b.y * sol[9]; sol[54] -= b0b.z * sol[9]; sol[55] -= b0b.w * sol[9]; sol[56] -= b0c.x * sol[9]; sol[57] -= b0c.y * sol[9]; sol[58] -= b0c.z * sol[9]; sol[59] -= b0c.w * sol[9]; sol[60] -= b0d.x * sol[9]; sol[61] -= b0d.y * sol[9]; sol[62] -= b0d.z * sol[9]; sol[63] -= b0d.w * sol[9];
  __builtin_amdgcn_sched_barrier(0);
  b0a = *(const float4*)(Lr + 672); b0b = *(const float4*)(Lr + 676); b0c = *(const float4*)(Lr + 680); b0d = *(const float4*)(Lr + 684);
  __builtin_amdgcn_sched_barrier(0);
  sol[11] -= b1c.w * sol[10]; sol[12] -= b1d.x * sol[10]; sol[13] -= b1d.y * sol[10]; sol[14] -= b1d.z * sol[10]; sol[15] -= b1d.w * sol[10];
  __builtin_amdgcn_sched_barrier(0);
  b1a = *(const float4*)(Lr + 688); b1b = *(const float4*)(Lr + 692); b1c = *(const float4*)(Lr + 696); b1d = *(const float4*)(Lr + 700);
  __builtin_amdgcn_sched_barrier(0);
  sol[16] -= b2a.x * sol[10]; sol[17] -= b2a.y * sol[10]; sol[18] -= b2a.z * sol[10]; sol[19] -= b2a.w * sol[10]; sol[20] -= b2b.x * sol[10]; sol[21] -= b2b.y * sol[10]; sol[22] -= b2b.z * sol[10]; sol[23] -= b2b.w * sol[10]; sol[24] -= b2c.x * sol[10]; sol[25] -= b2c.y * sol[10]; sol[26] -= b2c.z * sol[10]; sol[27] -= b2c.w * sol[10]; sol[28] -= b2d.x * sol[10]; sol[29] -= b2d.y * sol[10]; sol[30] -= b2d.z * sol[10]; sol[31] -= b2d.w * sol[10];
  __builtin_amdgcn_sched_barrier(0);
  b2a = *(const float4*)(Lr + 704); b2b = *(const float4*)(Lr + 708); b2c = *(const float4*)(Lr + 712); b2d = *(const float4*)(Lr + 716);
  __builtin_amdgcn_sched_barrier(0);
  sol[32] -= b0a.x * sol[10]; sol[33] -= b0a.y * sol[10]; sol[34] -= b0a.z * sol[10]; sol[35] -= b0a.w * sol[10]; sol[36] -= b0b.x * sol[10]; sol[37] -= b0b.y * sol[10]; sol[38] -= b0b.z * sol[10]; sol[39] -= b0b.w * sol[10]; sol[40] -= b0c.x * sol[10]; sol[41] -= b0c.y * sol[10]; sol[42] -= b0c.z * sol[10]; sol[43] -= b0c.w * sol[10]; sol[44] -= b0d.x * sol[10]; sol[45] -= b0d.y * sol[10]; sol[46] -= b0d.z * sol[10]; sol[47] -= b0d.w * sol[10];
  __builtin_amdgcn_sched_barrier(0);
  b0a = *(const float4*)(Lr + 720); b0b = *(const float4*)(Lr + 724); b0c = *(const float4*)(Lr + 728); b0d = *(const float4*)(Lr + 732);
  __builtin_amdgcn_sched_barrier(0);
  sol[48] -= b1a.x * sol[10]; sol[49] -= b1a.y * sol[10]; sol[50] -= b1a.z * sol[10]; sol[51] -= b1a.w * sol[10]; sol[52] -= b1b.x * sol[10]; sol[53] -= b1b.y * sol[10]; sol[54] -= b1b.z * sol[10]; sol[55] -= b1b.w * sol[10]; sol[56] -= b1c.x * sol[10]; sol[57] -= b1c.y * sol[10]; sol[58] -= b1c.z * sol[10]; sol[59] -= b1c.w * sol[10]; sol[60] -= b1d.x * sol[10]; sol[61] -= b1d.y * sol[10]; sol[62] -= b1d.z * sol[10]; sol[63] -= b1d.w * sol[10];
  __builtin_amdgcn_sched_barrier(0);
  b1a = *(const float4*)(Lr + 736); b1b = *(const float4*)(Lr + 740); b1c = *(const float4*)(Lr + 744); b1d = *(const float4*)(Lr + 748);
  __builtin_amdgcn_sched_barrier(0);
  sol[12] -= b2d.x * sol[11]; sol[13] -= b2d.y * sol[11]; sol[14] -= b2d.z * sol[11]; sol[15] -= b2d.w * sol[11];
  __builtin_amdgcn_sched_barrier(0);
  b2a = *(const float4*)(Lr + 752); b2b = *(const float4*)(Lr + 756); b2c = *(const float4*)(Lr + 760); b2d = *(const float4*)(Lr + 764);
  __builtin_amdgcn_sched_barrier(0);
  sol[16] -= b0a.x * sol[11]; sol[17] -= b0a.y * sol[11]; sol[18] -= b0a.z * sol[11]; sol[19] -= b0a.w * sol[11]; sol[20] -= b0b.x * sol[11]; sol[21] -= b0b.y * sol[11]; sol[22] -= b0b.z * sol[11]; sol[23] -= b0b.w * sol[11]; sol[24] -= b0c.x * sol[11]; sol[25] -= b0c.y * sol[11]; sol[26] -= b0c.z * sol[11]; sol[27] -= b0c.w * sol[11]; sol[28] -= b0d.x * sol[11]; sol[29] -= b0d.y * sol[11]; sol[30] -= b0d.z * sol[11]; sol[31] -= b0d.w * sol[11];
  __builtin_amdgcn_sched_barrier(0);
  b0a = *(const float4*)(Lr + 768); b0b = *(const float4*)(Lr + 772); b0c = *(const float4*)(Lr + 776); b0d = *(const float4*)(Lr + 780);
  __builtin_amdgcn_sched_barrier(0);
  sol[32] -= b1a.x * sol[11]; sol[33] -= b1a.y * sol[11]; sol[34] -= b1a.z * sol[11]; sol[35] -= b1a.w * sol[11]; sol[36] -= b1b.x * sol[11]; sol[37] -= b1b.y * sol[11]; sol[38] -= b1b.z * sol[11]; sol[39] -= b1b.w * sol[11]; sol[40] -= b1c.x * sol[11]; sol[41] -= b1c.y * sol[11]; sol[42] -= b1c.z * sol[11]; sol[43] -= b1c.w * sol[11]; sol[44] -= b1d.x * sol[11]; sol[45] -= b1d.y * sol[11]; sol[46] -= b1d.z * sol[11]; sol[47] -= b1d.w * sol[11];
  __builtin_amdgcn_sched_barrier(0);
  b1a = *(const float4*)(Lr + 784); b1b = *(const float4*)(Lr + 788); b1c = *(const float4*)(Lr + 792); b1d = *(const float4*)(Lr + 796);
  __builtin_amdgcn_sched_barrier(0);
  sol[48] -= b2a.x * sol[11]; sol[49] -= b2a.y * sol[11]; sol[50] -= b2a.z * sol[11]; sol[51] -= b2a.w * sol[11]; sol[52] -= b2b.x * sol[11]; sol[53] -= b2b.y * sol[11]; sol[54] -= b2b.z * sol[11]; sol[55] -= b2b.w * sol[11]; sol[56] -= b2c.x * sol[11]; sol[57] -= b2c.y * sol[11]; sol[58] -= b2c.z * sol[11]; sol[59] -= b2c.w * sol[11]; sol[60] -= b2d.x * sol[11]; sol[61] -= b2d.y * sol[11]; sol[62] -= b2d.z * sol[11]; sol[63] -= b2d.w * sol[11];
  __builtin_amdgcn_sched_barrier(0);
  b2a = *(const float4*)(Lr + 800); b2b = *(const float4*)(Lr + 804); b2c = *(const float4*)(Lr + 808); b2d = *(const float4*)(Lr + 812);
  __builtin_amdgcn_sched_barrier(0);
  sol[13] -= b0d.y * sol[12]; sol[14] -= b0d.z * sol[12]; sol[15] -= b0d.w * sol[12];
  __builtin_amdgcn_sched_barrier(0);
  b0a = *(const float4*)(Lr + 816); b0b = *(const float4*)(Lr + 820); b0c = *(const float4*)(Lr + 824); b0d = *(const float4*)(Lr + 828);
  __builtin_amdgcn_sched_barrier(0);
  sol[16] -= b1a.x * sol[12]; sol[17] -= b1a.y * sol[12]; sol[18] -= b1a.z * sol[12]; sol[19] -= b1a.w * sol[12]; sol[20] -= b1b.x * sol[12]; sol[21] -= b1b.y * sol[12]; sol[22] -= b1b.z * sol[12]; sol[23] -= b1b.w * sol[12]; sol[24] -= b1c.x * sol[12]; sol[25] -= b1c.y * sol[12]; sol[26] -= b1c.z * sol[12]; sol[27] -= b1c.w * sol[12]; sol[28] -= b1d.x * sol[12]; sol[29] -= b1d.y * sol[12]; sol[30] -= b1d.z * sol[12]; sol[31] -= b1d.w * sol[12];
  __builtin_amdgcn_sched_barrier(0);
  b1a = *(const float4*)(Lr + 832); b1b = *(const float4*)(Lr + 836); b1c = *(const float4*)(Lr + 840); b1d = *(const float4*)(Lr + 844);
  __builtin_amdgcn_sched_barrier(0);
  sol[32] -= b2a.x * sol[12]; sol[33] -= b2a.y * sol[12]; sol[34] -= b2a.z * sol[12]; sol[35] -= b2a.w * sol[12]; sol[36] -= b2b.x * sol[12]; sol[37] -= b2b.y * sol[12]; sol[38] -= b2b.z * sol[12]; sol[39] -= b2b.w * sol[12]; sol[40] -= b2c.x * sol[12]; sol[41] -= b2c.y * sol[12]; sol[42] -= b2c.z * sol[12]; sol[43] -= b2c.w * sol[12]; sol[44] -= b2d.x * sol[12]; sol[45] -= b2d.y * sol[12]; sol[46] -= b2d.z * sol[12]; sol[47] -= b2d.w * sol[12];
  __builtin_amdgcn_sched_barrier(0);
  b2a = *(const float4*)(Lr + 848); b2b = *(const float4*)(Lr + 852); b2c = *(const float4*)(Lr + 856); b2d = *(const float4*)(Lr + 860);
  __builtin_amdgcn_sched_barrier(0);
  sol[48] -= b0a.x * sol[12]; sol[49] -= b0a.y * sol[12]; sol[50] -= b0a.z * sol[12]; sol[51] -= b0a.w * sol[12]; sol[52] -= b0b.x * sol[12]; sol[53] -= b0b.y * sol[12]; sol[54] -= b0b.z * sol[12]; sol[55] -= b0b.w * sol[12]; sol[56] -= b0c.x * sol[12]; sol[57] -= b0c.y * sol[12]; sol[58] -= b0c.z * sol[12]; sol[59] -= b0c.w * sol[12]; sol[60] -= b0d.x * sol[12]; sol[61] -= b0d.y * sol[12]; sol[62] -= b0d.z * sol[12]; sol[63] -= b0d.w * sol[12];
  __builtin_amdgcn_sched_barrier(0);
  b0a = *(const float4*)(Lr + 864); b0b = *(const float4*)(Lr + 868); b0c = *(const float4*)(Lr + 872); b0d = *(const float4*)(Lr + 876);
  __builtin_amdgcn_sched_barrier(0);
  sol[14] -= b1d.z * sol[13]; sol[15] -= b1d.w * sol[13];
  __builtin_amdgcn_sched_barrier(0);
  b1a = *(const float4*)(Lr + 880); b1b = *(const float4*)(Lr + 884); b1c = *(const float4*)(Lr + 888); b1d = *(const float4*)(Lr + 892);
  __builtin_amdgcn_sched_barrier(0);
  sol[16] -= b2a.x * sol[13]; sol[17] -= b2a.y * sol[13]; sol[18] -= b2a.z * sol[13]; sol[19] -= b2a.w * sol[13]; sol[20] -= b2b.x * sol[13]; sol[21] -= b2b.y * sol[13]; sol[22] -= b2b.z * sol[13]; sol[23] -= b2b.w * sol[13]; sol[24] -= b2c.x * sol[13]; sol[25] -= b2c.y * sol[13]; sol[26] -= b2c.z * sol[13]; sol[27] -= b2c.w * sol[13]; sol[28] -= b2d.x * sol[13]; sol[29] -= b2d.y * sol[13]; sol[30] -= b2d.z * sol[13]; sol[31] -= b2d.w * sol[13];
  __builtin_amdgcn_sched_barrier(0);
  b2a = *(const float4*)(Lr + 896); b2b = *(const float4*)(Lr + 900); b2c = *(const float4*)(Lr + 904); b2d = *(const float4*)(Lr + 908);
  __builtin_amdgcn_sched_barrier(0);
  sol[32] -= b0a.x * sol[13]; sol[33] -= b0a.y * sol[13]; sol[34] -= b0a.z * sol[13]; sol[35] -= b0a.w * sol[13]; sol[36] -= b0b.x * sol[13]; sol[37] -= b0b.y * sol[13]; sol[38] -= b0b.z * sol[13]; sol[39] -= b0b.w * sol[13]; sol[40] -= b0c.x * sol[13]; sol[41] -= b0c.y * sol[13]; sol[42] -= b0c.z * sol[13]; sol[43] -= b0c.w * sol[13]; sol[44] -= b0d.x * sol[13]; sol[45] -= b0d.y * sol[13]; sol[46] -= b0d.z * sol[13]; sol[47] -= b0d.w * sol[13];
  __builtin_amdgcn_sched_barrier(0);
  b0a = *(const float4*)(Lr + 912); b0b = *(const float4*)(Lr + 916); b0c = *(const float4*)(Lr + 920); b0d = *(const float4*)(Lr + 924);
  __builtin_amdgcn_sched_barrier(0);
  sol[48] -= b1a.x * sol[13]; sol[49] -= b1a.y * sol[13]; sol[50] -= b1a.z * sol[13]; sol[51] -= b1a.w * sol[13]; sol[52] -= b1b.x * sol[13]; sol[53] -= b1b.y * sol[13]; sol[54] -= b1b.z * sol[13]; sol[55] -= b1b.w * sol[13]; sol[56] -= b1c.x * sol[13]; sol[57] -= b1c.y * sol[13]; sol[58] -= b1c.z * sol[13]; sol[59] -= b1c.w * sol[13]; sol[60] -= b1d.x * sol[13]; sol[61] -= b1d.y * sol[13]; sol[62] -= b1d.z * sol[13]; sol[63] -= b1d.w * sol[13];
  __builtin_amdgcn_sched_barrier(0);
  b1a = *(const float4*)(Lr + 928); b1b = *(const float4*)(Lr + 932); b1c = *(const float4*)(Lr + 936); b1d = *(const float4*)(Lr + 940);
  __builtin_amdgcn_sched_barrier(0);
  sol[15] -= b2d.w * sol[14];
  __builtin_amdgcn_sched_barrier(0);
  b2a = *(const float4*)(Lr + 944); b2b = *(const float4*)(Lr + 948); b2c = *(const float4*)(Lr + 952); b2d = *(const float4*)(Lr + 956);
  __builtin_amdgcn_sched_barrier(0);
  sol[16] -= b0a.x * sol[14]; sol[17] -= b0a.y * sol[14]; sol[18] -= b0a.z * sol[14]; sol[19] -= b0a.w * sol[14]; sol[20] -= b0b.x * sol[14]; sol[21] -= b0b.y * sol[14]; sol[22] -= b0b.z * sol[14]; sol[23] -= b0b.w * sol[14]; sol[24] -= b0c.x * sol[14]; sol[25] -= b0c.y * sol[14]; sol[26] -= b0c.z * sol[14]; sol[27] -= b0c.w * sol[14]; sol[28] -= b0d.x * sol[14]; sol[29] -= b0d.y * sol[14]; sol[30] -= b0d.z * sol[14]; sol[31] -= b0d.w * sol[14];
  __builtin_amdgcn_sched_barrier(0);
  b0a = *(const float4*)(Lr + 976); b0b = *(const float4*)(Lr + 980); b0c = *(const float4*)(Lr + 984); b0d = *(const float4*)(Lr + 988);
  __builtin_amdgcn_sched_barrier(0);
  sol[32] -= b1a.x * sol[14]; sol[33] -= b1a.y * sol[14]; sol[34] -= b1a.z * sol[14]; sol[35] -= b1a.w * sol[14]; sol[36] -= b1b.x * sol[14]; sol[37] -= b1b.y * sol[14]; sol[38] -= b1b.z * sol[14]; sol[39] -= b1b.w * sol[14]; sol[40] -= b1c.x * sol[14]; sol[41] -= b1c.y * sol[14]; sol[42] -= b1c.z * sol[14]; sol[43] -= b1c.w * sol[14]; sol[44] -= b1d.x * sol[14]; sol[45] -= b1d.y * sol[14]; sol[46] -= b1d.z * sol[14]; sol[47] -= b1d.w * sol[14];
  __builtin_amdgcn_sched_barrier(0);
  b1a = *(const float4*)(Lr + 992); b1b = *(const float4*)(Lr + 996); b1c = *(const float4*)(Lr + 1000); b1d = *(const float4*)(Lr + 1004);
  __builtin_amdgcn_sched_barrier(0);
  sol[48] -= b2a.x * sol[14]; sol[49] -= b2a.y * sol[14]; sol[50] -= b2a.z * sol[14]; sol[51] -= b2a.w * sol[14]; sol[52] -= b2b.x * sol[14]; sol[53] -= b2b.y * sol[14]; sol[54] -= b2b.z * sol[14]; sol[55] -= b2b.w * sol[14]; sol[56] -= b2c.x * sol[14]; sol[57] -= b2c.y * sol[14]; sol[58] -= b2c.z * sol[14]; sol[59] -= b2c.w * sol[14]; sol[60] -= b2d.x * sol[14]; sol[61] -= b2d.y * sol[14]; sol[62] -= b2d.z * sol[14]; sol[63] -= b2d.w * sol[14];
  __builtin_amdgcn_sched_barrier(0);
  b2a = *(const float4*)(Lr + 1008); b2b = *(const float4*)(Lr + 1012); b2c = *(const float4*)(Lr + 1016); b2d = *(const float4*)(Lr + 1020);
  __builtin_amdgcn_sched_barrier(0);
  sol[16] -= b0a.x * sol[15]; sol[17] -= b0a.y * sol[15]; sol[18] -= b0a.z * sol[15]; sol[19] -= b0a.w * sol[15]; sol[20] -= b0b.x * sol[15]; sol[21] -= b0b.y * sol[15]; sol[22] -= b0b.z * sol[15]; sol[23] -= b0b.w * sol[15]; sol[24] -= b0c.x * sol[15]; sol[25] -= b0c.y * sol[15]; sol[26] -= b0c.z * sol[15]; sol[27] -= b0c.w * sol[15]; sol[28] -= b0d.x * sol[15]; sol[29] -= b0d.y * sol[15]; sol[30] -= b0d.z * sol[15]; sol[31] -= b0d.w * sol[15];
  __builtin_amdgcn_sched_barrier(0);
  b0a = *(const float4*)(Lr + 1040); b0b = *(const float4*)(Lr + 1044); b0c = *(const float4*)(Lr + 1048); b0d = *(const float4*)(Lr + 1052);
  __builtin_amdgcn_sched_barrier(0);
  sol[32] -= b1a.x * sol[15]; sol[33] -= b1a.y * sol[15]; sol[34] -= b1a.z * sol[15]; sol[35] -= b1a.w * sol[15]; sol[36] -= b1b.x * sol[15]; sol[37] -= b1b.y * sol[15]; sol[38] -= b1b.z * sol[15]; sol[39] -= b1b.w * sol[15]; sol[40] -= b1c.x * sol[15]; sol[41] -= b1c.y * sol[15]; sol[42] -= b1c.z * sol[15]; sol[43] -= b1c.w * sol[15]; sol[44] -= b1d.x * sol[15]; sol[45] -= b1d.y * sol[15]; sol[46] -= b1d.z * sol[15]; sol[47] -= b1d.w * sol[15];
  __builtin_amdgcn_sched_barrier(0);
  b1a = *(const float4*)(Lr + 1056); b1b = *(const float4*)(Lr + 1060); b1c = *(const float4*)(Lr + 1064); b1d = *(const float4*)(Lr + 1068);
  __builtin_amdgcn_sched_barrier(0);
  sol[48] -= b2a.x * sol[15]; sol[49] -= b2a.y * sol[15]; sol[50] -= b2a.z * sol[15]; sol[51] -= b2a.w * sol[15]; sol[52] -= b2b.x * sol[15]; sol[53] -= b2b.y * sol[15]; sol[54] -= b2b.z * sol[15]; sol[55] -= b2b.w * sol[15]; sol[56] -= b2c.x * sol[15]; sol[57] -= b2c.y * sol[15]; sol[58] -= b2c.z * sol[15]; sol[59] -= b2c.w * sol[15]; sol[60] -= b2d.x * sol[15]; sol[61] -= b2d.y * sol[15]; sol[62] -= b2d.z * sol[15]; sol[63] -= b2d.w * sol[15];
  __builtin_amdgcn_sched_barrier(0);
  b2a = *(const float4*)(Lr + 1072); b2b = *(const float4*)(Lr + 1076); b2c = *(const float4*)(Lr + 1080); b2d = *(const float4*)(Lr + 1084);
  __builtin_amdgcn_sched_barrier(0);
  sol[17] -= b0a.y * sol[16]; sol[18] -= b0a.z * sol[16]; sol[19] -= b0a.w * sol[16]; sol[20] -= b0b.x * sol[16]; sol[21] -= b0b.y * sol[16]; sol[22] -= b0b.z * sol[16]; sol[23] -= b0b.w * sol[16]; sol[24] -= b0c.x * sol[16]; sol[25] -= b0c.y * sol[16]; sol[26] -= b0c.z * sol[16]; sol[27] -= b0c.w * sol[16]; sol[28] -= b0d.x * sol[16]; sol[29] -= b0d.y * sol[16]; sol[30] -= b0d.z * sol[16]; sol[31] -= b0d.w * sol[16];
  __builtin_amdgcn_sched_barrier(0);
  b0a = *(const float4*)(Lr + 1104); b0b = *(const float4*)(Lr + 1108); b0c = *(const float4*)(Lr + 1112); b0d = *(const float4*)(Lr + 1116);
  __builtin_amdgcn_sched_barrier(0);
  sol[32] -= b1a.x * sol[16]; sol[33] -= b1a.y * sol[16]; sol[34] -= b1a.z * sol[16]; sol[35] -= b1a.w * sol[16]; sol[36] -= b1b.x * sol[16]; sol[37] -= b1b.y * sol[16]; sol[38] -= b1b.z * sol[16]; sol[39] -= b1b.w * sol[16]; sol[40] -= b1c.x * sol[16]; sol[41] -= b1c.y * sol[16]; sol[42] -= b1c.z * sol[16]; sol[43] -= b1c.w * sol[16]; sol[44] -= b1d.x * sol[16]; sol[45] -= b1d.y * sol[16]; sol[46] -= b1d.z * sol[16]; sol[47] -= b1d.w * sol[16];
  __builtin_amdgcn_sched_barrier(0);
  b1a = *(const float4*)(Lr + 1120); b1b = *(const float4*)(Lr + 1124); b1c = *(const float4*)(Lr + 1128); b1d = *(const float4*)(Lr + 1132);
  __builtin_amdgcn_sched_barrier(0);
  sol[48] -= b2a.x * sol[16]; sol[49] -= b2a.y * sol[16]; sol[50] -= b2a.z * sol[16]; sol[51] -= b2a.w * sol[16]; sol[52] -= b2b.x * sol[16]; sol[53] -= b2b.y * sol[16]; sol[54] -= b2b.z * sol[16]; sol[55] -= b2b.w * sol[16]; sol[56] -= b2c.x * sol[16]; sol[57] -= b2c.y * sol[16]; sol[58] -= b2c.z * sol[16]; sol[59] -= b2c.w * sol[16]; sol[60] -= b2d.x * sol[16]; sol[61] -= b2d.y * sol[16]; sol[62] -= b2d.z * sol[16]; sol[63] -= b2d.w * sol[16];
  __builtin_amdgcn_sched_barrier(0);
  b2a = *(const float4*)(Lr + 1136); b2b = *(const float4*)(Lr + 1140); b2c = *(const float4*)(Lr + 1144); b2d = *(const float4*)(Lr + 1148);
  __builtin_amdgcn_sched_barrier(0);
  sol[18] -= b0a.z * sol[17]; sol[19] -= b0a.w * sol[17]; sol[20] -= b0b.x * sol[17]; sol[21] -= b0b.y * sol[17]; sol[22] -= b0b.z * sol[17]; sol[23] -= b0b.w * sol[17]; sol[24] -= b0c.x * sol[17]; sol[25] -= b0c.y * sol[17]; sol[26] -= b0c.z * sol[17]; sol[27] -= b0c.w * sol[17]; sol[28] -= b0d.x * sol[17]; sol[29] -= b0d.y * sol[17]; sol[30] -= b0d.z * sol[17]; sol[31] -= b0d.w * sol[17];
  __builtin_amdgcn_sched_barrier(0);
  b0a = *(const float4*)(Lr + 1168); b0b = *(const float4*)(Lr + 1172); b0c = *(const float4*)(Lr + 1176); b0d = *(const float4*)(Lr + 1180);
  __builtin_amdgcn_sched_barrier(0);
  sol[32] -= b1a.x * sol[17]; sol[33] -= b1a.y * sol[17]; sol[34] -= b1a.z * sol[17]; sol[35] -= b1a.w * sol[17]; sol[36] -= b1b.x * sol[17]; sol[37] -= b1b.y * sol[17]; sol[38] -= b1b.z * sol[17]; sol[39] -= b1b.w * sol[17]; sol[40] -= b1c.x * sol[17]; sol[41] -= b1c.y * sol[17]; sol[42] -= b1c.z * sol[17]; sol[43] -= b1c.w * sol[17]; sol[44] -= b1d.x * sol[17]; sol[45] -= b1d.y * sol[17]; sol[46] -= b1d.z * sol[17]; sol[47] -= b1d.w * sol[17];
  __builtin_amdgcn_sched_barrier(0);
  b1a = *(const float4*)(Lr + 1184); b1b = *(const float4*)(Lr + 1188); b1c = *(const float4*)(Lr + 1192); b1d = *(const float4*)(Lr + 1196);
  __builtin_amdgcn_sched_barrier(0);
  sol[48] -= b2a.x * sol[17]; sol[49] -= b2a.y * sol[17]; sol[50] -= b2a.z * sol[17]; sol[51] -= b2a.w * sol[17]; sol[52] -= b2b.x * sol[17]; sol[53] -= b2b.y * sol[17]; sol[54] -= b2b.z * sol[17]; sol[55] -= b2b.w * sol[17]; sol[56] -= b2c.x * sol[17]; sol[57] -= b2c.y * sol[17]; sol[58] -= b2c.z * sol[17]; sol[59] -= b2c.w * sol[17]; sol[60] -= b2d.x * sol[17]; sol[61] -= b2d.y * sol[17]; sol[62] -= b2d.z * sol[17]; sol[63] -= b2d.w * sol[17];
  __builtin_amdgcn_sched_barrier(0);
  b2a = *(const float4*)(Lr + 1200); b2b = *(const float4*)(Lr + 1204); b2c = *(const float4*)(Lr + 1208); b2d = *(const float4*)(Lr + 1212);
  __builtin_amdgcn_sched_barrier(0);
  sol[19] -= b0a.w * sol[18]; sol[20] -= b0b.x * sol[18]; sol[21] -= b0b.y * sol[18]; sol[22] -= b0b.z * sol[18]; sol[23] -= b0b.w * sol[18]; sol[24] -= b0c.x * sol[18]; sol[25] -= b0c.y * sol[18]; sol[26] -= b0c.z * sol[18]; sol[27] -= b0c.w * sol[18]; sol[28] -= b0d.x * sol[18]; sol[29] -= b0d.y * sol[18]; sol[30] -= b0d.z * sol[18]; sol[31] -= b0d.w * sol[18];
  __builtin_amdgcn_sched_barrier(0);
  b0a = *(const float4*)(Lr + 1232); b0b = *(const float4*)(Lr + 1236); b0c = *(const float4*)(Lr + 1240); b0d = *(const float4*)(Lr + 1244);
  __builtin_amdgcn_sched_barrier(0);
  sol[32] -= b1a.x * sol[18]; sol[33] -= b1a.y * sol[18]; sol[34] -= b1a.z * sol[18]; sol[35] -= b1a.w * sol[18]; sol[36] -= b1b.x * sol[18]; sol[37] -= b1b.y * sol[18]; sol[38] -= b1b.z * sol[18]; sol[39] -= b1b.w * sol[18]; sol[40] -= b1c.x * sol[18]; sol[41] -= b1c.y * sol[18]; sol[42] -= b1c.z * sol[18]; sol[43] -= b1c.w * sol[18]; sol[44] -= b1d.x * sol[18]; sol[45] -= b1d.y * sol[18]; sol[46] -= b1d.z * sol[18]; sol[47] -= b1d.w * sol[18];
  __builtin_amdgcn_sched_barrier(0);
  b1a = *(const float4*)(Lr + 1248); b1b = *(const float4*)(Lr + 1252); b1c = *(const float4*)(Lr + 1256); b1d = *(const float4*)(Lr + 1260);
  __builtin_amdgcn_sched_barrier(0);
  sol[48] -= b2a.x * sol[18]; sol[49] -= b2a.y * sol[18]; sol[50] -= b2a.z * sol[18]; sol[51] -= b2a.w * sol[18]; sol[52] -= b2b.x * sol[18]; sol[53] -= b2b.y * sol[18]; sol[54] -= b2b.z * sol[18]; sol[55] -= b2b.w * sol[18]; sol[56] -= b2c.x * sol[18]; sol[57] -= b2c.y * sol[18]; sol[58] -= b2c.z * sol[18]; sol[59] -= b2c.w * sol[18]; sol[60] -= b2d.x * sol[18]; sol[61] -= b2d.y * sol[18]; sol[62] -= b2d.z * sol[18]; sol[63] -= b2d.w * sol[18];
  __builtin_amdgcn_sched_barrier(0);
  b2a = *(const float4*)(Lr + 1264); b2b = *(const float4*)(Lr + 1268); b2c = *(const float4*)(Lr + 1272); b2d = *(const float4*)(Lr + 1276);
  __builtin_amdgcn_sched_barrier(0);
  sol[20] -= b0b.x * sol[19]; sol[21] -= b0b.y * sol[19]; sol[22] -= b0b.z * sol[19]; sol[23] -= b0b.w * sol[19]; sol[24] -= b0c.x * sol[19]; sol[25] -= b0c.y * sol[19]; sol[26] -= b0c.z * sol[19]; sol[27] -= b0c.w * sol[19]; sol[28] -= b0d.x * sol[19]; sol[29] -= b0d.y * sol[19]; sol[30] -= b0d.z * sol[19]; sol[31] -= b0d.w * sol[19];
  __builtin_amdgcn_sched_barrier(0);
  b0a = *(const float4*)(Lr + 1296); b0b = *(const float4*)(Lr + 1300); b0c = *(const float4*)(Lr + 1304); b0d = *(const float4*)(Lr + 1308);
  __builtin_amdgcn_sched_barrier(0);
  sol[32] -= b1a.x * sol[19]; sol[33] -= b1a.y * sol[19]; sol[34] -= b1a.z * sol[19]; sol[35] -= b1a.w * sol[19]; sol[36] -= b1b.x * sol[19]; sol[37] -= b1b.y * sol[19]; sol[38] -= b1b.z * sol[19]; sol[39] -= b1b.w * sol[19]; sol[40] -= b1c.x * sol[19]; sol[41] -= b1c.y * sol[19]; sol[42] -= b1c.z * sol[19]; sol[43] -= b1c.w * sol[19]; sol[44] -= b1d.x * sol[19]; sol[45] -= b1d.y * sol[19]; sol[46] -= b1d.z * sol[19]; sol[47] -= b1d.w * sol[19];
  __builtin_amdgcn_sched_barrier(0);
  b1a = *(const float4*)(Lr + 1312); b1b = *(const float4*)(Lr + 1316); b1c = *(const float4*)(Lr + 1320); b1d = *(const float4*)(Lr + 1324);
  __builtin_amdgcn_sched_barrier(0);
  sol[48] -= b2a.x * sol[19]; sol[49] -= b2a.y * sol[19]; sol[50] -= b2a.z * sol[19]; sol[51] -= b2a.w * sol[19]; sol[52] -= b2b.x * sol[19]; sol[53] -= b2b.y * sol[19]; sol[54] -= b2b.z * sol[19]; sol[55] -= b2b.w * sol[19]; sol[56] -= b2c.x * sol[19]; sol[57] -= b2c.y * sol[19]; sol[58] -= b2c.z * sol[19]; sol[59] -= b2c.w * sol[19]; sol[60] -= b2d.x * sol[19]; sol[61] -= b2d.y * sol[19]; sol[62] -= b2d.z * sol[19]; sol[63] -= b2d.w * sol[19];
  __builtin_amdgcn_sched_barrier(0);
  b2a = *(const float4*)(Lr + 1328); b2b = *(const float4*)(Lr + 1332); b2c = *(const float4*)(Lr + 1336); b2d = *(const float4*)(Lr + 1340);
  __builtin_amdgcn_sched_barrier(0);
  sol[21] -= b0b.y * sol[20]; sol[22] -= b0b.z * sol[20]; sol[23] -= b0b.w * sol[20]; sol[24] -= b0c.x * sol[20]; sol[25] -= b0c.y * sol[20]; sol[26] -= b0c.z * sol[20]; sol[27] -= b0c.w * sol[20]; sol[28] -= b0d.x * sol[20]; sol[29] -= b0d.y * sol[20]; sol[30] -= b0d.z * sol[20]; sol[31] -= b0d.w * sol[20];
  __builtin_amdgcn_sched_barrier(0);
  b0a = *(const float4*)(Lr + 1360); b0b = *(const float4*)(Lr + 1364); b0c = *(const float4*)(Lr + 1368); b0d = *(const float4*)(Lr + 1372);
  __builtin_amdgcn_sched_barrier(0);
  sol[32] -= b1a.x * sol[20]; sol[33] -= b1a.y * sol[20]; sol[34] -= b1a.z * sol[20]; sol[35] -= b1a.w * sol[20]; sol[36] -= b1b.x * sol[20]; sol[37] -= b1b.y * sol[20]; sol[38] -= b1b.z * sol[20]; sol[39] -= b1b.w * sol[20]; sol[40] -= b1c.x * sol[20]; sol[41] -= b1c.y * sol[20]; sol[42] -= b1c.z * sol[20]; sol[43] -= b1c.w * sol[20]; sol[44] -= b1d.x * sol[20]; sol[45] -= b1d.y * sol[20]; sol[46] -= b1d.z * sol[20]; sol[47] -= b1d.w * sol[20];
  __builtin_amdgcn_sched_barrier(0);
  b1a = *(const float4*)(Lr + 1376); b1b = *(const float4*)(Lr + 1380); b1c = *(const float4*)(Lr + 1384); b1d = *(const float4*)(Lr + 1388);
  __builtin_amdgcn_sched_barrier(0);
  sol[48] -= b2a.x * sol[20]; sol[49] -= b2a.y * sol[20]; sol[50] -= b2a.z * sol[20]; sol[51] -= b2a.w * sol[20]; sol[52] -= b2b.x * sol[20]; sol[53] -= b2b.y * sol[20]; sol[54] -= b2b.z * sol[20]; sol[55] -= b2b.w * sol[20]; sol[56] -= b2c.x * sol[20]; sol[57] -= b2c.y * sol[20]; sol[58] -= b2c.z * sol[20]; sol[59] -= b2c.w * sol[20]; sol[60] -= b2d.x * sol[20]; sol[61] -= b2d.y * sol[20]; sol[62] -= b2d.z * sol[20]; sol[63] -= b2d.w * sol[20];
  __builtin_amdgcn_sched_barrier(0);
  b2a = *(const float4*)(Lr + 1392); b2b = *(const float4*)(Lr + 1396); b2c = *(const float4*)(Lr + 1400); b2d = *(const float4*)(Lr + 1404);
  __builtin_amdgcn_sched_barrier(0);
  sol[22] -= b0b.z * sol[21]; sol[23] -= b0b.w * sol[21]; sol[24] -= b0c.x * sol[21]; sol[25] -= b0c.y * sol[21]; sol[26] -= b0c.z * sol[21]; sol[27] -= b0c.w * sol[21]; sol[28] -= b0d.x * sol[21]; sol[29] -= b0d.y * sol[21]; sol[30] -= b0d.z * sol[21]; sol[31] -= b0d.w * sol[21];
  __builtin_amdgcn_sched_barrier(0);
  b0a = *(const float4*)(Lr + 1424); b0b = *(const float4*)(Lr + 1428); b0c = *(const float4*)(Lr + 1432); b0d = *(const float4*)(Lr + 1436);
  __builtin_amdgcn_sched_barrier(0);
  sol[32] -= b1a.x * sol[21]; sol[33] -= b1a.y * sol[21]; sol[34] -= b1a.z * sol[21]; sol[35] -= b1a.w * sol[21]; sol[36] -= b1b.x * sol[21]; sol[37] -= b1b.y * sol[21]; sol[38] -= b1b.z * sol[21]; sol[39] -= b1b.w * sol[21]; sol[40] -= b1c.x * sol[21]; sol[41] -= b1c.y * sol[21]; sol[42] -= b1c.z * sol[21]; sol[43] -= b1c.w * sol[21]; sol[44] -= b1d.x * sol[21]; sol[45] -= b1d.y * sol[21]; sol[46] -= b1d.z * sol[21]; sol[47] -= b1d.w * sol[21];
  __builtin_amdgcn_sched_barrier(0);
  b1a = *(const float4*)(Lr + 1440); b1b = *(const float4*)(Lr + 1444); b1c = *(const float4*)(Lr + 1448); b1d = *(const float4*)(Lr + 1452);
  __builtin_amdgcn_sched_barrier(0);
  sol[48] -= b2a.x * sol[21]; sol[49] -= b2a.y * sol[21]; sol[50] -= b2a.z * sol[21]; sol[51] -= b2a.w * sol[21]; sol[52] -= b2b.x * sol[21]; sol[53] -= b2b.y * sol[21]; sol[54] -= b2b.z * sol[21]; sol[55] -= b2b.w * sol[21]; sol[56] -= b2c.x * sol[21]; sol[57] -= b2c.y * sol[21]; sol[58] -= b2c.z * sol[21]; sol[59] -= b2c.w * sol[21]; sol[60] -= b2d.x * sol[21]; sol[61] -= b2d.y * sol[21]; sol[62] -= b2d.z * sol[21]; sol[63] -= b2d.w * sol[21];
  __builtin_amdgcn_sched_barrier(0);
  b2a = *(const float4*)(Lr + 1456); b2b = *(const float4*)(Lr + 1460); b2c = *(const float4*)(Lr + 1464); b2d = *(const float4*)(Lr + 1468);
  __builtin_amdgcn_sched_barrier(0);
  sol[23] -= b0b.w * sol[22]; sol[24] -= b0c.x * sol[22]; sol[25] -= b0c.y * sol[22]; sol[26] -= b0c.z * sol[22]; sol[27] -= b0c.w * sol[22]; sol[28] -= b0d.x * sol[22]; sol[29] -= b0d.y * sol[22]; sol[30] -= b0d.z * sol[22]; sol[31] -= b0d.w * sol[22];
  __builtin_amdgcn_sched_barrier(0);
  b0a = *(const float4*)(Lr + 1488); b0b = *(const float4*)(Lr + 1492); b0c = *(const float4*)(Lr + 1496); b0d = *(const float4*)(Lr + 1500);
  __builtin_amdgcn_sched_barrier(0);
  sol[32] -= b1a.x * sol[22]; sol[33] -= b1a.y * sol[22]; sol[34] -= b1a.z * sol[22]; sol[35] -= b1a.w * sol[22]; sol[36] -= b1b.x * sol[22]; sol[37] -= b1b.y * sol[22]; sol[38] -= b1b.z * sol[22]; sol[39] -= b1b.w * sol[22]; sol[40] -= b1c.x * sol[22]; sol[41] -= b1c.y * sol[22]; sol[42] -= b1c.z * sol[22]; sol[43] -= b1c.w * sol[22]; sol[44] -= b1d.x * sol[22]; sol[45] -= b1d.y * sol[22]; sol[46] -= b1d.z * sol[22]; sol[47] -= b1d.w * sol[22];
  __builtin_amdgcn_sched_barrier(0);
  b1a = *(const float4*)(Lr + 1504); b1b = *(const float4*)(Lr + 1508); b1c = *(const float4*)(Lr + 1512); b1d = *(const float4*)(Lr + 1516);
  __builtin_amdgcn_sched_barrier(0);
  sol[48] -= b2a.x * sol[22]; sol[49] -= b2a.y * sol[22]; sol[50] -= b2a.z * sol[22]; sol[51] -= b2a.w * sol[22]; sol[52] -= b2b.x * sol[22]; sol[53] -= b2b.y * sol[22]; sol[54] -= b2b.z * sol[22]; sol[55] -= b2b.w * sol[22]; sol[56] -= b2c.x * sol[22]; sol[57] -= b2c.y * sol[22]; sol[58] -= b2c.z * sol[22]; sol[59] -= b2c.w * sol[22]; sol[60] -= b2d.x * sol[22]; sol[61] -= b2d.y * sol[22]; sol[62] -= b2d.z * sol[22]; sol[63] -= b2d.w * sol[22];
  __builtin_amdgcn_sched_barrier(0);
  b2a = *(const float4*)(Lr + 1520); b2b = *(const float4*)(Lr + 1524); b2c = *(const float4*)(Lr + 1528); b2d = *(const float4*)(Lr + 1532);
  __builtin_amdgcn_sched_barrier(0);
  sol[24] -= b0c.x * sol[23]; sol[25] -= b0c.y * sol[23]; sol[26] -= b0c.z * sol[23]; sol[27] -= b0c.w * sol[23]; sol[28] -= b0d.x * sol[23]; sol[29] -= b0d.y * sol[23]; sol[30] -= b0d.z * sol[23]; sol[31] -= b0d.w * sol[23];
  __builtin_amdgcn_sched_barrier(0);
  b0a = *(const float4*)(Lr + 1552); b0b = *(const float4*)(Lr + 1556); b0c = *(const float4*)(Lr + 1560); b0d = *(const float4*)(Lr + 1564);
  __builtin_amdgcn_sched_barrier(0);
  sol[32] -= b1a.x * sol[23]; sol[33] -= b1a.y * sol[23]; sol[34] -= b1a.z * sol[23]; sol[35] -= b1a.w * sol[23]; sol[36] -= b1b.x * sol[23]; sol[37] -= b1b.y * sol[23]; sol[38] -= b1b.z * sol[23]; sol[39] -= b1b.w * sol[23]; sol[40] -= b1c.x * sol[23]; sol[41] -= b1c.y * sol[23]; sol[42] -= b1c.z * sol[23]; sol[43] -= b1c.w * sol[23]; sol[44] -= b1d.x * sol[23]; sol[45] -= b1d.y * sol[23]; sol[46] -= b1d.z * sol[23]; sol[47] -= b1d.w * sol[23];
  __builtin_amdgcn_sched_barrier(0);
  b1a = *(const float4*)(Lr + 1568); b1b = *(const float4*)(Lr + 1572); b1c = *(const float4*)(Lr + 1576); b1d = *(const float4*)(Lr + 1580);
  __builtin_amdgcn_sched_barrier(0);
  sol[48] -= b2a.x * sol[23]; sol[49] -= b2a.y * sol[23]; sol[50] -= b2a.z * sol[23]; sol[51] -= b2a.w * sol[23]; sol[52] -= b2b.x * sol[23]; sol[53] -= b2b.y * sol[23]; sol[54] -= b2b.z * sol[23]; sol[55] -= b2b.w * sol[23]; sol[56] -= b2c.x * sol[23]; sol[57] -= b2c.y * sol[23]; sol[58] -= b2c.z * sol[23]; sol[59] -= b2c.w * sol[23]; sol[60] -= b2d.x * sol[23]; sol[61] -= b2d.y * sol[23]; sol[62] -= b2d.z * sol[23]; sol[63] -= b2d.w * sol[23];
  __builtin_amdgcn_sched_barrier(0);
  b2a = *(const float4*)(Lr + 1584); b2b = *(const float4*)(Lr + 1588); b2c = *(const float4*)(Lr + 1592); b2d = *(const float4*)(Lr + 1596);
  __builtin_amdgcn_sched_barrier(0);
  sol[25] -= b0c.y * sol[24]; sol[26] -= b0c.z * sol[24]; sol[27] -= b0c.w * sol[24]; sol[28] -= b0d.x * sol[24]; sol[29] -= b0d.y * sol[24]; sol[30] -= b0d.z * sol[24]; sol[31] -= b0d.w * sol[24];
  __builtin_amdgcn_sched_barrier(0);
  b0a = *(const float4*)(Lr + 1616); b0b = *(const float4*)(Lr + 1620); b0c = *(const float4*)(Lr + 1624); b0d = *(const float4*)(Lr + 1628);
  __builtin_amdgcn_sched_barrier(0);
  sol[32] -= b1a.x * sol[24]; sol[33] -= b1a.y * sol[24]; sol[34] -= b1a.z * sol[24]; sol[35] -= b1a.w * sol[24]; sol[36] -= b1b.x * sol[24]; sol[37] -= b1b.y * sol[24]; sol[38] -= b1b.z * sol[24]; sol[39] -= b1b.w * sol[24]; sol[40] -= b1c.x * sol[24]; sol[41] -= b1c.y * sol[24]; sol[42] -= b1c.z * sol[24]; sol[43] -= b1c.w * sol[24]; sol[44] -= b1d.x * sol[24]; sol[45] -= b1d.y * sol[24]; sol[46] -= b1d.z * sol[24]; sol[47] -= b1d.w * sol[24];
  __builtin_amdgcn_sched_barrier(0);
  b1a = *(const float4*)(Lr + 1632); b1b = *(const float4*)(Lr + 1636); b1c = *(const float4*)(Lr + 1640); b1d = *(const float4*)(Lr + 1644);
  __builtin_amdgcn_sched_barrier(0);
  sol[48] -= b2a.x * sol[24]; sol[49] -= b2a.y * sol[24]; sol[50] -= b2a.z * sol[24]; sol[51] -= b2a.w * sol[24]; sol[52] -= b2b.x * sol[24]; sol[53] -= b2b.y * sol[24]; sol[54] -= b2b.z * sol[24]; sol[55] -= b2b.w * sol[24]; sol[56] -= b2c.x * sol[24]; sol[57] -= b2c.y * sol[24]; sol[58] -= b2c.z * sol[24]; sol[59] -= b2c.w * sol[24]; sol[60] -= b2d.x * sol[24]; sol[61] -= b2d.y * sol[24]; sol[62] -= b2d.z * sol[24]; sol[63] -= b2d.w * sol[24];
  __builtin_amdgcn_sched_barrier(0);
  b2a = *(const float4*)(Lr + 1648); b2b = *(const float4*)(Lr + 1652); b2c = *(const float4*)(Lr + 1656); b2d = *(const float4*)(Lr + 1660);
  __builtin_amdgcn_sched_barrier(0);
  sol[26] -= b0c.z * sol[25]; sol[27] -= b0c.w * sol[25]; sol[28] -= b0d.x * sol[25]; sol[29] -= b0d.y * sol[25]; sol[30] -= b0d.z * sol[25]; sol[31] -= b0d.w * sol[25];
  __builtin_amdgcn_sched_barrier(0);
  b0a = *(const float4*)(Lr + 1680); b0b = *(const float4*)(Lr + 1684); b0c = *(const float4*)(Lr + 1688); b0d = *(const float4*)(Lr + 1692);
  __builtin_amdgcn_sched_barrier(0);
  sol[32] -= b1a.x * sol[25]; sol[33] -= b1a.y * sol[25]; sol[34] -= b1a.z * sol[25]; sol[35] -= b1a.w * sol[25]; sol[36] -= b1b.x * sol[25]; sol[37] -= b1b.y * sol[25]; sol[38] -= b1b.z * sol[25]; sol[39] -= b1b.w * sol[25]; sol[40] -= b1c.x * sol[25]; sol[41] -= b1c.y * sol[25]; sol[42] -= b1c.z * sol[25]; sol[43] -= b1c.w * sol[25]; sol[44] -= b1d.x * sol[25]; sol[45] -= b1d.y * sol[25]; sol[46] -= b1d.z * sol[25]; sol[47] -= b1d.w * sol[25];
  __builtin_amdgcn_sched_barrier(0);
  b1a = *(const float4*)(Lr + 1696); b1b = *(const float4*)(Lr + 1700); b1c = *(const float4*)(Lr + 1704); b1d = *(const float4*)(Lr + 1708);
  __builtin_amdgcn_sched_barrier(0);
  sol[48] -= b2a.x * sol[25]; sol[49] -= b2a.y * sol[25]; sol[50] -= b2a.z * sol[25]; sol[51] -= b2a.w * sol[25]; sol[52] -= b2b.x * sol[25]; sol[53] -= b2b.y * sol[25]; sol[54] -= b2b.z * sol[25]; sol[55] -= b2b.w * sol[25]; sol[56] -= b2c.x * sol[25]; sol[57] -= b2c.y * sol[25]; sol[58] -= b2c.z * sol[25]; sol[59] -= b2c.w * sol[25]; sol[60] -= b2d.x * sol[25]; sol[61] -= b2d.y * sol[25]; sol[62] -= b2d.z * sol[25]; sol[63] -= b2d.w * sol[25];
  __builtin_amdgcn_sched_barrier(0);
  b2a = *(const float4*)(Lr + 1712); b2b = *(const float4*)(Lr + 1716); b2c = *(const float4*)(Lr + 1720); b2d = *(const float4*)(Lr + 1724);
  __builtin_amdgcn_sched_barrier(0);
  sol[27] -= b0c.w * sol[26]; sol[28] -= b0d.x * sol[26]; sol[29] -= b0d.y * sol[26]; sol[30] -= b0d.z * sol[26]; sol[31] -= b0d.w * sol[26];
  __builtin_amdgcn_sched_barrier(0);
  b0a = *(const float4*)(Lr + 1744); b0b = *(const float4*)(Lr + 1748); b0c = *(const float4*)(Lr + 1752); b0d = *(const float4*)(Lr + 1756);
  __builtin_amdgcn_sched_barrier(0);
  sol[32] -= b1a.x * sol[26]; sol[33] -= b1a.y * sol[26]; sol[34] -= b1a.z * sol[26]; sol[35] -= b1a.w * sol[26]; sol[36] -= b1b.x * sol[26]; sol[37] -= b1b.y * sol[26]; sol[38] -= b1b.z * sol[26]; sol[39] -= b1b.w * sol[26]; sol[40] -= b1c.x * sol[26]; sol[41] -= b1c.y * sol[26]; sol[42] -= b1c.z * sol[26]; sol[43] -= b1c.w * sol[26]; sol[44] -= b1d.x * sol[26]; sol[45] -= b1d.y * sol[26]; sol[46] -= b1d.z * sol[26]; sol[47] -= b1d.w * sol[26];
  __builtin_amdgcn_sched_barrier(0);
  b1a = *(const float4*)(Lr + 1760); b1b = *(const float4*)(Lr + 1764); b1c = *(const float4*)(Lr + 1768); b1d = *(const float4*)(Lr + 1772);
  __builtin_amdgcn_sched_barrier(0);
  sol[48] -= b2a.x * sol[26]; sol[49] -= b2a.y * sol[26]; sol[50] -= b2a.z * sol[26]; sol[51] -= b2a.w * sol[26]; sol[52] -= b2b.x * sol[26]; sol[53] -= b2b.y * sol[26]; sol[54] -= b2b.z * sol[26]; sol[55] -= b2b.w * sol[26]; sol[56] -= b2c.x * sol[26]; sol[57] -= b2c.y * sol[26]; sol[58] -= b2c.z * sol[26]; sol[59] -= b2c.w * sol[26]; sol[60] -= b2d.x * sol[26]; sol[61] -= b2d.y * sol[26]; sol[62] -= b2d.z * sol[26]; sol[63] -= b2d.w * sol[26];
  __builtin_amdgcn_sched_barrier(0);
  b2a = *(const float4*)(Lr + 1776); b2b = *(const float4*)(Lr + 1780); b2c = *(const float4*)(Lr + 1784); b2d = *(const float4*)(Lr + 1788);
  __builtin_amdgcn_sched_barrier(0);
  sol[28] -= b0d.x * sol[27]; sol[29] -= b0d.y * sol[27]; sol[30] -= b0d.z * sol[27]; sol[31] -= b0d.w * sol[27];
  __builtin_amdgcn_sched_barrier(0);
  b0a = *(const float4*)(Lr + 1808); b0b = *(const float4*)(Lr + 1812); b0c = *(const float4*)(Lr + 1816); b0d = *(const float4*)(Lr + 1820);
  __builtin_amdgcn_sched_barrier(0);
  sol[32] -= b1a.x * sol[27]; sol[33] -= b1a.y * sol[27]; sol[34] -= b1a.z * sol[27]; sol[35] -= b1a.w * sol[27]; sol[36] -= b1b.x * sol[27]; sol[37] -= b1b.y * sol[27]; sol[38] -= b1b.z * sol[27]; sol[39] -= b1b.w * sol[27]; sol[40] -= b1c.x * sol[27]; sol[41] -= b1c.y * sol[27]; sol[42] -= b1c.z * sol[27]; sol[43] -= b1c.w * sol[27]; sol[44] -= b1d.x * sol[27]; sol[45] -= b1d.y * sol[27]; sol[46] -= b1d.z * sol[27]; sol[47] -= b1d.w * sol[27];
  __builtin_amdgcn_sched_barrier(0);
  b1a = *(const float4*)(Lr + 1824); b1b = *(const float4*)(Lr + 1828); b1c = *(const float4*)(Lr + 1832); b1d = *(const float4*)(Lr + 1836);
  __builtin_amdgcn_sched_barrier(0);
  sol[48] -= b2a.x * sol[27]; sol[49] -= b2a.y * sol[27]; sol[50] -= b2a.z * sol[27]; sol[51] -= b2a.w * sol[27]; sol[52] -= b2b.x * sol[27]; sol[53] -= b2b.y * sol[27]; sol[54] -= b2b.z * sol[27]; sol[55] -= b2b.w * sol[27]; sol[56] -= b2c.x * sol[27]; sol[57] -= b2c.y * sol[27]; sol[58] -= b2c.z * sol[27]; sol[59] -= b2c.w * sol[27]; sol[60] -= b2d.x * sol[27]; sol[61] -= b2d.y * sol[27]; sol[62] -= b2d.z * sol[27]; sol[63] -= b2d.w * sol[27];
  __builtin_amdgcn_sched_barrier(0);
  b2a = *(const float4*)(Lr + 1840); b2b = *(const float4*)(Lr + 1844); b2c = *(const float4*)(Lr + 1848); b2d = *(const float4*)(Lr + 1852);
  __builtin_amdgcn_sched_barrier(0);
  sol[29] -= b0d.y * sol[28]; sol[30] -= b0d.z * sol[28]; sol[31] -= b0d.w * sol[28];
  __builtin_amdgcn_sched_barrier(0);
  b0a = *(const float4*)(Lr + 1872); b0b = *(const float4*)(Lr + 1876); b0c = *(const float4*)(Lr + 1880); b0d = *(const float4*)(Lr + 1884);
  __builtin_amdgcn_sched_barrier(0);
  sol[32] -= b1a.x * sol[28]; sol[33] -= b1a.y * sol[28]; sol[34] -= b1a.z * sol[28]; sol[35] -= b1a.w * sol[28]; sol[36] -= b1b.x * sol[28]; sol[37] -= b1b.y * sol[28]; sol[38] -= b1b.z * sol[28]; sol[39] -= b1b.w * sol[28]; sol[40] -= b1c.x * sol[28]; sol[41] -= b1c.y * sol[28]; sol[42] -= b1c.z * sol[28]; sol[43] -= b1c.w * sol[28]; sol[44] -= b1d.x * sol[28]; sol[45] -= b1d.y * sol[28]; sol[46] -= b1d.z * sol[28]; sol[47] -= b1d.w * sol[28];
  __builtin_amdgcn_sched_barrier(0);
  b1a = *(const float4*)(Lr + 1888); b1b = *(const float4*)(Lr + 1892); b1c = *(const float4*)(Lr + 1896); b1d = *(const float4*)(Lr + 1900);
  __builtin_amdgcn_sched_barrier(0);
  sol[48] -= b2a.x * sol[28]; sol[49] -= b2a.y * sol[28]; sol[50] -= b2a.z * sol[28]; sol[51] -= b2a.w * sol[28]; sol[52] -= b2b.x * sol[28]; sol[53] -= b2b.y * sol[28]; sol[54] -= b2b.z * sol[28]; sol[55] -= b2b.w * sol[28]; sol[56] -= b2c.x * sol[28]; sol[57] -= b2c.y * sol[28]; sol[58] -= b2c.z * sol[28]; sol[59] -= b2c.w * sol[28]; sol[60] -= b2d.x * sol[28]; sol[61] -= b2d.y * sol[28]; sol[62] -= b2d.z * sol[28]; sol[63] -= b2d.w * sol[28];
  __builtin_amdgcn_sched_barrier(0);
  b2a = *(const float4*)(Lr + 1904); b2b = *(const float4*)(Lr + 1908); b2c = *(const float4*)(Lr + 1912); b2d = *(const float4*)(Lr + 1916);
  __builtin_amdgcn_sched_barrier(0);
  sol[30] -= b0d.z * sol[29]; sol[31] -= b0d.w * sol[29];
  __builtin_amdgcn_sched_barrier(0);
  b0a = *(const float4*)(Lr + 1936); b0b = *(const float4*)(Lr + 1940); b0c = *(const float4*)(Lr + 1944); b0d = *(const float4*)(Lr + 1948);
  __builtin_amdgcn_sched_barrier(0);
  sol[32] -= b1a.x * sol[29]; sol[33] -= b1a.y * sol[29]; sol[34] -= b1a.z * sol[29]; sol[35] -= b1a.w * sol[29]; sol[36] -= b1b.x * sol[29]; sol[37] -= b1b.y * sol[29]; sol[38] -= b1b.z * sol[29]; sol[39] -= b1b.w * sol[29]; sol[40] -= b1c.x * sol[29]; sol[41] -= b1c.y * sol[29]; sol[42] -= b1c.z * sol[29]; sol[43] -= b1c.w * sol[29]; sol[44] -= b1d.x * sol[29]; sol[45] -= b1d.y * sol[29]; sol[46] -= b1d.z * sol[29]; sol[47] -= b1d.w * sol[29];
  __builtin_amdgcn_sched_barrier(0);
  b1a = *(const float4*)(Lr + 1952); b1b = *(const float4*)(Lr + 1956); b1c = *(const float4*)(Lr + 1960); b1d = *(const float4*)(Lr + 1964);
  __builtin_amdgcn_sched_barrier(0);
  sol[48] -= b2a.x * sol[29]; sol[49] -= b2a.y * sol[29]; sol[50] -= b2a.z * sol[29]; sol[51] -= b2a.w * sol[29]; sol[52] -= b2b.x * sol[29]; sol[53] -= b2b.y * sol[29]; sol[54] -= b2b.z * sol[29]; sol[55] -= b2b.w * sol[29]; sol[56] -= b2c.x * sol[29]; sol[57] -= b2c.y * sol[29]; sol[58] -= b2c.z * sol[29]; sol[59] -= b2c.w * sol[29]; sol[60] -= b2d.x * sol[29]; sol[61] -= b2d.y * sol[29]; sol[62] -= b2d.z * sol[29]; sol[63] -= b2d.w * sol[29];
  __builtin_amdgcn_sched_barrier(0);
  b2a = *(const float4*)(Lr + 1968); b2b = *(const float4*)(Lr + 1972); b2c = *(const float4*)(Lr + 1976); b2d = *(const float4*)(Lr + 1980);
  __builtin_amdgcn_sched_barrier(0);
  sol[31] -= b0d.w * sol[30];
  __builtin_amdgcn_sched_barrier(0);
  b0a = *(const float4*)(Lr + 2016); b0b = *(const float4*)(Lr + 2020); b0c = *(const float4*)(Lr + 2024); b0d = *(const float4*)(Lr + 2028);
  __builtin_amdgcn_sched_barrier(0);
  sol[32] -= b1a.x * sol[30]; sol[33] -= b1a.y * sol[30]; sol[34] -= b1a.z * sol[30]; sol[35] -= b1a.w * sol[30]; sol[36] -= b1b.x * sol[30]; sol[37] -= b1b.y * sol[30]; sol[38] -= b1b.z * sol[30]; sol[39] -= b1b.w * sol[30]; sol[40] -= b1c.x * sol[30]; sol[41] -= b1c.y * sol[30]; sol[42] -= b1c.z * sol[30]; sol[43] -= b1c.w * sol[30]; sol[44] -= b1d.x * sol[30]; sol[45] -= b1d.y * sol[30]; sol[46] -= b1d.z * sol[30]; sol[47] -= b1d.w * sol[30];
  __builtin_amdgcn_sched_barrier(0);
  b1a = *(const float4*)(Lr + 2032); b1b = *(const float4*)(Lr + 2036); b1c = *(const float4*)(Lr + 2040); b1d = *(const float4*)(Lr + 2044);
  __builtin_amdgcn_sched_barrier(0);
  sol[48] -= b2a.x * sol[30]; sol[49] -= b2a.y * sol[30]; sol[50] -= b2a.z * sol[30]; sol[51] -= b2a.w * sol[30]; sol[52] -= b2b.x * sol[30]; sol[53] -= b2b.y * sol[30]; sol[54] -= b2b.z * sol[30]; sol[55] -= b2b.w * sol[30]; sol[56] -= b2c.x * sol[30]; sol[57] -= b2c.y * sol[30]; sol[58] -= b2c.z * sol[30]; sol[59] -= b2c.w * sol[30]; sol[60] -= b2d.x * sol[30]; sol[61] -= b2d.y * sol[30]; sol[62] -= b2d.z * sol[30]; sol[63] -= b2d.w * sol[30];
  __builtin_amdgcn_sched_barrier(0);
  b2a = *(const float4*)(Lr + 2080); b2b = *(const float4*)(Lr + 2084); b2c = *(const float4*)(Lr + 2088); b2d = *(const float4*)(Lr + 2092);
  __builtin_amdgcn_sched_barrier(0);
  sol[32] -= b0a.x * sol[31]; sol[33] -= b0a.y * sol[31]; sol[34] -= b0a.z * sol[31]; sol[35] -= b0a.w * sol[31]; sol[36] -= b0b.x * sol[31]; sol[37] -= b0b.y * sol[31]; sol[38] -= b0b.z * sol[31]; sol[39] -= b0b.w * sol[31]; sol[40] -= b0c.x * sol[31]; sol[41] -= b0c.y * sol[31]; sol[42] -= b0c.z * sol[31]; sol[43] -= b0c.w * sol[31]; sol[44] -= b0d.x * sol[31]; sol[45] -= b0d.y * sol[31]; sol[46] -= b0d.z * sol[31]; sol[47] -= b0d.w * sol[31];
  __builtin_amdgcn_sched_barrier(0);
  b0a = *(const float4*)(Lr + 2096); b0b = *(const float4*)(Lr + 2100); b0c = *(const float4*)(Lr + 2104); b0d = *(const float4*)(Lr + 2108);
  __builtin_amdgcn_sched_barrier(0);
  sol[48] -= b1a.x * sol[31]; sol[49] -= b1a.y * sol[31]; sol[50] -= b1a.z * sol[31]; sol[51] -= b1a.w * sol[31]; sol[52] -= b1b.x * sol[31]; sol[53] -= b1b.y * sol[31]; sol[54] -= b1b.z * sol[31]; sol[55] -= b1b.w * sol[31]; sol[56] -= b1c.x * sol[31]; sol[57] -= b1c.y * sol[31]; sol[58] -= b1c.z * sol[31]; sol[59] -= b1c.w * sol[31]; sol[60] -= b1d.x * sol[31]; sol[61] -= b1d.y * sol[31]; sol[62] -= b1d.z * sol[31]; sol[63] -= b1d.w * sol[31];
  __builtin_amdgcn_sched_barrier(0);
  b1a = *(const float4*)(Lr + 2144); b1b = *(const float4*)(Lr + 2148); b1c = *(const float4*)(Lr + 2152); b1d = *(const float4*)(Lr + 2156);
  __builtin_amdgcn_sched_barrier(0);
  sol[33] -= b2a.y * sol[32]; sol[34] -= b2a.z * sol[32]; sol[35] -= b2a.w * sol[32]; sol[36] -= b2b.x * sol[32]; sol[37] -= b2b.y * sol[32]; sol[38] -= b2b.z * sol[32]; sol[39] -= b2b.w * sol[32]; sol[40] -= b2c.x * sol[32]; sol[41] -= b2c.y * sol[32]; sol[42] -= b2c.z * sol[32]; sol[43] -= b2c.w * sol[32]; sol[44] -= b2d.x * sol[32]; sol[45] -= b2d.y * sol[32]; sol[46] -= b2d.z * sol[32]; sol[47] -= b2d.w * sol[32];
  __builtin_amdgcn_sched_barrier(0);
  b2a = *(const float4*)(Lr + 2160); b2b = *(const float4*)(Lr + 2164); b2c = *(const float4*)(Lr + 2168); b2d = *(const float4*)(Lr + 2172);
  __builtin_amdgcn_sched_barrier(0);
  sol[48] -= b0a.x * sol[32]; sol[49] -= b0a.y * sol[32]; sol[50] -= b0a.z * sol[32]; sol[51] -= b0a.w * sol[32]; sol[52] -= b0b.x * sol[32]; sol[53] -= b0b.y * sol[32]; sol[54] -= b0b.z * sol[32]; sol[55] -= b0b.w * sol[32]; sol[56] -= b0c.x * sol[32]; sol[57] -= b0c.y * sol[32]; sol[58] -= b0c.z * sol[32]; sol[59] -= b0c.w * sol[32]; sol[60] -= b0d.x * sol[32]; sol[61] -= b0d.y * sol[32]; sol[62] -= b0d.z * sol[32]; sol[63] -= b0d.w * sol[32];
  __builtin_amdgcn_sched_barrier(0);
  b0a = *(const float4*)(Lr + 2208); b0b = *(const float4*)(Lr + 2212); b0c = *(const float4*)(Lr + 2216); b0d = *(const float4*)(Lr + 2220);
  __builtin_amdgcn_sched_barrier(0);
  sol[34] -= b1a.z * sol[33]; sol[35] -= b1a.w * sol[33]; sol[36] -= b1b.x * sol[33]; sol[37] -= b1b.y * sol[33]; sol[38] -= b1b.z * sol[33]; sol[39] -= b1b.w * sol[33]; sol[40] -= b1c.x * sol[33]; sol[41] -= b1c.y * sol[33]; sol[42] -= b1c.z * sol[33]; sol[43] -= b1c.w * sol[33]; sol[44] -= b1d.x * sol[33]; sol[45] -= b1d.y * sol[33]; sol[46] -= b1d.z * sol[33]; sol[47] -= b1d.w * sol[33];
  __builtin_amdgcn_sched_barrier(0);
  b1a = *(const float4*)(Lr + 2224); b1b = *(const float4*)(Lr + 2228); b1c = *(const float4*)(Lr + 2232); b1d = *(const float4*)(Lr + 2236);
  __builtin_amdgcn_sched_barrier(0);
  sol[48] -= b2a.x * sol[33]; sol[49] -= b2a.y * sol[33]; sol[50] -= b2a.z * sol[33]; sol[51] -= b2a.w * sol[33]; sol[52] -= b2b.x * sol[33]; sol[53] -= b2b.y * sol[33]; sol[54] -= b2b.z * sol[33]; sol[55] -= b2b.w * sol[33]; sol[56] -= b2c.x * sol[33]; sol[57] -= b2c.y * sol[33]; sol[58] -= b2c.z * sol[33]; sol[59] -= b2c.w * sol[33]; sol[60] -= b2d.x * sol[33]; sol[61] -= b2d.y * sol[33]; sol[62] -= b2d.z * sol[33]; sol[63] -= b2d.w * sol[33];
  __builtin_amdgcn_sched_barrier(0);
  b2a = *(const float4*)(Lr + 2272); b2b = *(const float4*)(Lr + 2276); b2c = *(const float4*)(Lr + 2280); b2d = *(const float4*)(Lr + 2284);
  __builtin_amdgcn_sched_barrier(0);
  sol[35] -= b0a.w * sol[34]; sol[36] -= b0b.x * sol[34]; sol[37] -= b0b.y * sol[34]; sol[38] -= b0b.z * sol[34]; sol[39] -= b0b.w * sol[34]; sol[40] -= b0c.x * sol[34]; sol[41] -= b0c.y * sol[34]; sol[42] -= b0c.z * sol[34]; sol[43] -= b0c.w * sol[34]; sol[44] -= b0d.x * sol[34]; sol[45] -= b0d.y * sol[34]; sol[46] -= b0d.z * sol[34]; sol[47] -= b0d.w * sol[34];
  __builtin_amdgcn_sched_barrier(0);
  b0a = *(const float4*)(Lr + 2288); b0b = *(const float4*)(Lr + 2292); b0c = *(const float4*)(Lr + 2296); b0d = *(const float4*)(Lr + 2300);
  __builtin_amdgcn_sched_barrier(0);
  sol[48] -= b1a.x * sol[34]; sol[49] -= b1a.y * sol[34]; sol[50] -= b1a.z * sol[34]; sol[51] -= b1a.w * sol[34]; sol[52] -= b1b.x * sol[34]; sol[53] -= b1b.y * sol[34]; sol[54] -= b1b.z * sol[34]; sol[55] -= b1b.w * sol[34]; sol[56] -= b1c.x * sol[34]; sol[57] -= b1c.y * sol[34]; sol[58] -= b1c.z * sol[34]; sol[59] -= b1c.w * sol[34]; sol[60] -= b1d.x * sol[34]; sol[61] -= b1d.y * sol[34]; sol[62] -= b1d.z * sol[34]; sol[63] -= b1d.w * sol[34];
  __builtin_amdgcn_sched_barrier(0);
  b1a = *(const float4*)(Lr + 2336); b1b = *(const float4*)(Lr + 2340); b1c = *(const float4*)(Lr + 2344); b1d = *(const float4*)(Lr + 2348);
  __builtin_amdgcn_sched_barrier(0);
  sol[36] -= b2b.x * sol[35]; sol[37] -= b2b.y * sol[35]; sol[38] -= b2b.z * sol[35]; sol[39] -= b2b.w * sol[35]; sol[40] -= b2c.x * sol[35]; sol[41] -= b2c.y * sol[35]; sol[42] -= b2c.z * sol[35]; sol[43] -= b2c.w * sol[35]; sol[44] -= b2d.x * sol[35]; sol[45] -= b2d.y * sol[35]; sol[46] -= b2d.z * sol[35]; sol[47] -= b2d.w * sol[35];
  __builtin_amdgcn_sched_barrier(0);
  b2a = *(const float4*)(Lr + 2352); b2b = *(const float4*)(Lr + 2356); b2c = *(const float4*)(Lr + 2360); b2d = *(const float4*)(Lr + 2364);
  __builtin_amdgcn_sched_barrier(0);
  sol[48] -= b0a.x * sol[35]; sol[49] -= b0a.y * sol[35]; sol[50] -= b0a.z * sol[35]; sol[51] -= b0a.w * sol[35]; sol[52] -= b0b.x * sol[35]; sol[53] -= b0b.y * sol[35]; sol[54] -= b0b.z * sol[35]; sol[55] -= b0b.w * sol[35]; sol[56] -= b0c.x * sol[35]; sol[57] -= b0c.y * sol[35]; sol[58] -= b0c.z * sol[35]; sol[59] -= b0c.w * sol[35]; sol[60] -= b0d.x * sol[35]; sol[61] -= b0d.y * sol[35]; sol[62] -= b0d.z * sol[35]; sol[63] -= b0d.w * sol[35];
  __builtin_amdgcn_sched_barrier(0);
  b0a = *(const float4*)(Lr + 2400); b0b = *(const float4*)(Lr + 2404); b0c = *(const float4*)(Lr + 2408); b0d = *(const float4*)(Lr + 2412);
  __builtin_amdgcn_sched_barrier(0);
  sol[37] -= b1b.y * sol[36]; sol[38] -= b1b.z * sol[36]; sol[39] -= b1b.w * sol[36]; sol[40] -= b1c.x * sol[36]; sol[41] -= b1c.y * sol[36]; sol[42] -= b1c.z * sol[36]; sol[43] -= b1c.w * sol[36]; sol[44] -= b1d.x * sol[36]; sol[45] -= b1d.y * sol[36]; sol[46] -= b1d.z * sol[36]; sol[47] -= b1d.w * sol[36];
  __builtin_amdgcn_sched_barrier(0);
  b1a = *(const float4*)(Lr + 2416); b1b = *(const float4*)(Lr + 2420); b1c = *(const float4*)(Lr + 2424); b1d = *(const float4*)(Lr + 2428);
  __builtin_amdgcn_sched_barrier(0);
  sol[48] -= b2a.x * sol[36]; sol[49] -= b2a.y * sol[36]; sol[50] -= b2a.z * sol[36]; sol[51] -= b2a.w * sol[36]; sol[52] -= b2b.x * sol[36]; sol[53] -= b2b.y * sol[36]; sol[54] -= b2b.z * sol[36]; sol[55] -= b2b.w * sol[36]; sol[56] -= b2c.x * sol[36]; sol[57] -= b2c.y * sol[36]; sol[58] -= b2c.z * sol[36]; sol[59] -= b2c.w * sol[36]; sol[60] -= b2d.x * sol[36]; sol[61] -= b2d.y * sol[36]; sol[62] -= b2d.z * sol[36]; sol[63] -= b2d.w * sol[36];
  __builtin_amdgcn_sched_barrier(0);
  b2a = *(const float4*)(Lr + 2464); b2b = *(const float4*)(Lr + 2468); b2c = *(const float4*)(Lr + 2472); b2d = *(const float4*)(Lr + 2476);
  __builtin_amdgcn_sched_barrier(0);
  sol[38] -= b0b.z * sol[37]; sol[39] -= b0b.w * sol[37]; sol[40] -= b0c.x * sol[37]; sol[41] -= b0c.y * sol[37]; sol[42] -= b0c.z * sol[37]; sol[43] -= b0c.w * sol[37]; sol[44] -= b0d.x * sol[37]; sol[45] -= b0d.y * sol[37]; sol[46] -= b0d.z * sol[37]; sol[47] -= b0d.w * sol[37];
  __builtin_amdgcn_sched_barrier(0);
  b0a = *(const float4*)(Lr + 2480); b0b = *(const float4*)(Lr + 2484); b0c = *(const float4*)(Lr + 2488); b0d = *(const float4*)(Lr + 2492);
  __builtin_amdgcn_sched_barrier(0);
  sol[48] -= b1a.x * sol[37]; sol[49] -= b1a.y * sol[37]; sol[50] -= b1a.z * sol[37]; sol[51] -= b1a.w * sol[37]; sol[52] -= b1b.x * sol[37]; sol[53] -= b1b.y * sol[37]; sol[54] -= b1b.z * sol[37]; sol[55] -= b1b.w * sol[37]; sol[56] -= b1c.x * sol[37]; sol[57] -= b1c.y * sol[37]; sol[58] -= b1c.z * sol[37]; sol[59] -= b1c.w * sol[37]; sol[60] -= b1d.x * sol[37]; sol[61] -= b1d.y * sol[37]; sol[62] -= b1d.z * sol[37]; sol[63] -= b1d.w * sol[37];
  __builtin_amdgcn_sched_barrier(0);
  b1a = *(const float4*)(Lr + 2528); b1b = *(const float4*)(Lr + 2532); b1c = *(const float4*)(Lr + 2536); b1d = *(const float4*)(Lr + 2540);
  __builtin_amdgcn_sched_barrier(0);
  sol[39] -= b2b.w * sol[38]; sol[40] -= b2c.x * sol[38]; sol[41] -= b2c.y * sol[38]; sol[42] -= b2c.z * sol[38]; sol[43] -= b2c.w * sol[38]; sol[44] -= b2d.x * sol[38]; sol[45] -= b2d.y * sol[38]; sol[46] -= b2d.z * sol[38]; sol[47] -= b2d.w * sol[38];
  __builtin_amdgcn_sched_barrier(0);
  b2a = *(const float4*)(Lr + 2544); b2b = *(const float4*)(Lr + 2548); b2c = *(const float4*)(Lr + 2552); b2d = *(const float4*)(Lr + 2556);
  __builtin_amdgcn_sched_barrier(0);
  sol[48] -= b0a.x * sol[38]; sol[49] -= b0a.y * sol[38]; sol[50] -= b0a.z * sol[38]; sol[51] -= b0a.w * sol[38]; sol[52] -= b0b.x * sol[38]; sol[53] -= b0b.y * sol[38]; sol[54] -= b0b.z * sol[38]; sol[55] -= b0b.w * sol[38]; sol[56] -= b0c.x * sol[38]; sol[57] -= b0c.y * sol[38]; sol[58] -= b0c.z * sol[38]; sol[59] -= b0c.w * sol[38]; sol[60] -= b0d.x * sol[38]; sol[61] -= b0d.y * sol[38]; sol[62] -= b0d.z * sol[38]; sol[63] -= b0d.w * sol[38];
  __builtin_amdgcn_sched_barrier(0);
  b0a = *(const float4*)(Lr + 2592); b0b = *(const float4*)(Lr + 2596); b0c = *(const float4*)(Lr + 2600); b0d = *(const float4*)(Lr + 2604);
  __builtin_amdgcn_sched_barrier(0);
  sol[40] -= b1c.x * sol[39]; sol[41] -= b1c.y * sol[39]; sol[42] -= b1c.z * sol[39]; sol[43] -= b1c.w * sol[39]; sol[44] -= b1d.x * sol[39]; sol[45] -= b1d.y * sol[39]; sol[46] -= b1d.z * sol[39]; sol[47] -= b1d.w * sol[39];
  __builtin_amdgcn_sched_barrier(0);
  b1a = *(const float4*)(Lr + 2608); b1b = *(const float4*)(Lr + 2612); b1c = *(const float4*)(Lr + 2616); b1d = *(const float4*)(Lr + 2620);
  __builtin_amdgcn_sched_barrier(0);
  sol[48] -= b2a.x * sol[39]; sol[49] -= b2a.y * sol[39]; sol[50] -= b2a.z * sol[39]; sol[51] -= b2a.w * sol[39]; sol[52] -= b2b.x * sol[39]; sol[53] -= b2b.y * sol[39]; sol[54] -= b2b.z * sol[39]; sol[55] -= b2b.w * sol[39]; sol[56] -= b2c.x * sol[39]; sol[57] -= b2c.y * sol[39]; sol[58] -= b2c.z * sol[39]; sol[59] -= b2c.w * sol[39]; sol[60] -= b2d.x * sol[39]; sol[61] -= b2d.y * sol[39]; sol[62] -= b2d.z * sol[39]; sol[63] -= b2d.w * sol[39];
  __builtin_amdgcn_sched_barrier(0);
  b2a = *(const float4*)(Lr + 2656); b2b = *(const float4*)(Lr + 2660); b2c = *(const float4*)(Lr + 2664); b2d = *(const float4*)(Lr + 2668);
  __builtin_amdgcn_sched_barrier(0);
  sol[41] -= b0c.y * sol[40]; sol[42] -= b0c.z * sol[40]; sol[43] -= b0c.w * sol[40]; sol[44] -= b0d.x * sol[40]; sol[45] -= b0d.y * sol[40]; sol[46] -= b0d.z * sol[40]; sol[47] -= b0d.w * sol[40];
  __builtin_amdgcn_sched_barrier(0);
  b0a = *(const float4*)(Lr + 2672); b0b = *(const float4*)(Lr + 2676); b0c = *(const float4*)(Lr + 2680); b0d = *(const float4*)(Lr + 2684);
  __builtin_amdgcn_sched_barrier(0);
  sol[48] -= b1a.x * sol[40]; sol[49] -= b1a.y * sol[40]; sol[50] -= b1a.z * sol[40]; sol[51] -= b1a.w * sol[40]; sol[52] -= b1b.x * sol[40]; sol[53] -= b1b.y * sol[40]; sol[54] -= b1b.z * sol[40]; sol[55] -= b1b.w * sol[40]; sol[56] -= b1c.x * sol[40]; sol[57] -= b1c.y * sol[40]; sol[58] -= b1c.z * sol[40]; sol[59] -= b1c.w * sol[40]; sol[60] -= b1d.x * sol[40]; sol[61] -= b1d.y * sol[40]; sol[62] -= b1d.z * sol[40]; sol[63] -= b1d.w * sol[40];
  __builtin_amdgcn_sched_barrier(0);
  b1a = *(const float4*)(Lr + 2720); b1b = *(const float4*)(Lr + 2724); b1c = *(const float4*)(Lr + 2728); b1d = *(const float4*)(Lr + 2732);
  __builtin_amdgcn_sched_barrier(0);
  sol[42] -= b2c.z * sol[41]; sol[43] -= b2c.w * sol[41]; sol[44] -= b2d.x * sol[41]; sol[45] -= b2d.y * sol[41]; sol[46] -= b2d.z * sol[41]; sol[47] -= b2d.w * sol[41];
  __builtin_amdgcn_sched_barrier(0);
  b2a = *(const float4*)(Lr + 2736); b2b = *(const float4*)(Lr + 2740); b2c = *(const float4*)(Lr + 2744); b2d = *(const float4*)(Lr + 2748);
  __builtin_amdgcn_sched_barrier(0);
  sol[48] -= b0a.x * sol[41]; sol[49] -= b0a.y * sol[41]; sol[50] -= b0a.z * sol[41]; sol[51] -= b0a.w * sol[41]; sol[52] -= b0b.x * sol[41]; sol[53] -= b0b.y * sol[41]; sol[54] -= b0b.z * sol[41]; sol[55] -= b0b.w * sol[41]; sol[56] -= b0c.x * sol[41]; sol[57] -= b0c.y * sol[41]; sol[58] -= b0c.z * sol[41]; sol[59] -= b0c.w * sol[41]; sol[60] -= b0d.x * sol[41]; sol[61] -= b0d.y * sol[41]; sol[62] -= b0d.z * sol[41]; sol[63] -= b0d.w * sol[41];
  __builtin_amdgcn_sched_barrier(0);
  b0a = *(const float4*)(Lr + 2784); b0b = *(const float4*)(Lr + 2788); b0c = *(const float4*)(Lr + 2792); b0d = *(const float4*)(Lr + 2796);
  __builtin_amdgcn_sched_barrier(0);
  sol[43] -= b1c.w * sol[42]; sol[44] -= b1d.x * sol[42]; sol[45] -= b1d.y * sol[42]; sol[46] -= b1d.z * sol[42]; sol[47] -= b1d.w * sol[42];
  __builtin_amdgcn_sched_barrier(0);
  b1a = *(const float4*)(Lr + 2800); b1b = *(const float4*)(Lr + 2804); b1c = *(const float4*)(Lr + 2808); b1d = *(const float4*)(Lr + 2812);
  __builtin_amdgcn_sched_barrier(0);
  sol[48] -= b2a.x * sol[42]; sol[49] -= b2a.y * sol[42]; sol[50] -= b2a.z * sol[42]; sol[51] -= b2a.w * sol[42]; sol[52] -= b2b.x * sol[42]; sol[53] -= b2b.y * sol[42]; sol[54] -= b2b.z * sol[42]; sol[55] -= b2b.w * sol[42]; sol[56] -= b2c.x * sol[42]; sol[57] -= b2c.y * sol[42]; sol[58] -= b2c.z * sol[42]; sol[59] -= b2c.w * sol[42]; sol[60] -= b2d.x * sol[42]; sol[61] -= b2d.y * sol[42]; sol[62] -= b2d.z * sol[42]; sol[63] -= b2d.w * sol[42];
  __builtin_amdgcn_sched_barrier(0);
  b2a = *(const float4*)(Lr + 2848); b2b = *(const float4*)(Lr + 2852); b2c = *(const float4*)(Lr + 2856); b2d = *(const float4*)(Lr + 2860);
  __builtin_amdgcn_sched_barrier(0);
  sol[44] -= b0d.x * sol[43]; sol[45] -= b0d.y * sol[43]; sol[46] -= b0d.z * sol[43]; sol[47] -= b0d.w * sol[43];
  __builtin_amdgcn_sched_barrier(0);
  b0a = *(const float4*)(Lr + 2864); b0b = *(const float4*)(Lr + 2868); b0c = *(const float4*)(Lr + 2872); b0d = *(const float4*)(Lr + 2876);
  __builtin_amdgcn_sched_barrier(0);
  sol[48] -= b1a.x * sol[43]; sol[49] -= b1a.y * sol[43]; sol[50] -= b1a.z * sol[43]; sol[51] -= b1a.w * sol[43]; sol[52] -= b1b.x * sol[43]; sol[53] -= b1b.y * sol[43]; sol[54] -= b1b.z * sol[43]; sol[55] -= b1b.w * sol[43]; sol[56] -= b1c.x * sol[43]; sol[57] -= b1c.y * sol[43]; sol[58] -= b1c.z * sol[43]; sol[59] -= b1c.w * sol[43]; sol[60] -= b1d.x * sol[43]; sol[61] -= b1d.y * sol[43]; sol[62] -= b1d.z * sol[43]; sol[63] -= b1d.w * sol[43];
  __builtin_amdgcn_sched_barrier(0);
  b1a = *(const float4*)(Lr + 2912); b1b = *(const float4*)(Lr + 2916); b1c = *(const float4*)(Lr + 2920); b1d = *(const float4*)(Lr + 2924);
  __builtin_amdgcn_sched_barrier(0);
  sol[45] -= b2d.y * sol[44]; sol[46] -= b2d.z * sol[44]; sol[47] -= b2d.w * sol[44];
  __builtin_amdgcn_sched_barrier(0);
  b2a = *(const float4*)(Lr + 2928); b2b = *(const float4*)(Lr + 2932); b2c = *(const float4*)(Lr + 2936); b2d = *(const float4*)(Lr + 2940);
  __builtin_amdgcn_sched_barrier(0);
  sol[48] -= b0a.x * sol[44]; sol[49] -= b0a.y * sol[44]; sol[50] -= b0a.z * sol[44]; sol[51] -= b0a.w * sol[44]; sol[52] -= b0b.x * sol[44]; sol[53] -= b0b.y * sol[44]; sol[54] -= b0b.z * sol[44]; sol[55] -= b0b.w * sol[44]; sol[56] -= b0c.x * sol[44]; sol[57] -= b0c.y * sol[44]; sol[58] -= b0c.z * sol[44]; sol[59] -= b0c.w * sol[44]; sol[60] -= b0d.x * sol[44]; sol[61] -= b0d.y * sol[44]; sol[62] -= b0d.z * sol[44]; sol[63] -= b0d.w * sol[44];
  __builtin_amdgcn_sched_barrier(0);
  b0a = *(const float4*)(Lr + 2976); b0b = *(const float4*)(Lr + 2980); b0c = *(const float4*)(Lr + 2984); b0d = *(const float4*)(Lr + 2988);
  __builtin_amdgcn_sched_barrier(0);
  sol[46] -= b1d.z * sol[45]; sol[47] -= b1d.w * sol[45];
  __builtin_amdgcn_sched_barrier(0);
  b1a = *(const float4*)(Lr + 2992); b1b = *(const float4*)(Lr + 2996); b1c = *(const float4*)(Lr + 3000); b1d = *(const float4*)(Lr + 3004);
  __builtin_amdgcn_sched_barrier(0);
  sol[48] -= b2a.x * sol[45]; sol[49] -= b2a.y * sol[45]; sol[50] -= b2a.z * sol[45]; sol[51] -= b2a.w * sol[45]; sol[52] -= b2b.x * sol[45]; sol[53] -= b2b.y * sol[45]; sol[54] -= b2b.z * sol[45]; sol[55] -= b2b.w * sol[45]; sol[56] -= b2c.x * sol[45]; sol[57] -= b2c.y * sol[45]; sol[58] -= b2c.z * sol[45]; sol[59] -= b2c.w * sol[45]; sol[60] -= b2d.x * sol[45]; sol[61] -= b2d.y * sol[45]; sol[62] -= b2d.z * sol[45]; sol[63] -= b2d.w * sol[45];
  __builtin_amdgcn_sched_barrier(0);
  b2a = *(const float4*)(Lr + 3056); b2b = *(const float4*)(Lr + 3060); b2c = *(const float4*)(Lr + 3064); b2d = *(const float4*)(Lr + 3068);
  __builtin_amdgcn_sched_barrier(0);
  sol[47] -= b0d.w * sol[46];
  __builtin_amdgcn_sched_barrier(0);
  b0a = *(const float4*)(Lr + 3120); b0b = *(const float4*)(Lr + 3124); b0c = *(const float4*)(Lr + 3128); b0d = *(const float4*)(Lr + 3132);
  __builtin_amdgcn_sched_barrier(0);
  sol[48] -= b1a.x * sol[46]; sol[49] -= b1a.y * sol[46]; sol[50] -= b1a.z * sol[46]; sol[51] -= b1a.w * sol[46]; sol[52] -= b1b.x * sol[46]; sol[53] -= b1b.y * sol[46]; sol[54] -= b1b.z * sol[46]; sol[55] -= b1b.w * sol[46]; sol[56] -= b1c.x * sol[46]; sol[57] -= b1c.y * sol[46]; sol[58] -= b1c.z * sol[46]; sol[59] -= b1c.w * sol[46]; sol[60] -= b1d.x * sol[46]; sol[61] -= b1d.y * sol[46]; sol[62] -= b1d.z * sol[46]; sol[63] -= b1d.w * sol[46];
  __builtin_amdgcn_sched_barrier(0);
  b1a = *(const float4*)(Lr + 3184); b1b = *(const float4*)(Lr + 3188); b1c = *(const float4*)(Lr + 3192); b1d = *(const float4*)(Lr + 3196);
  __builtin_amdgcn_sched_barrier(0);
  sol[48] -= b2a.x * sol[47]; sol[49] -= b2a.y * sol[47]; sol[50] -= b2a.z * sol[47]; sol[51] -= b2a.w * sol[47]; sol[52] -= b2b.x * sol[47]; sol[53] -= b2b.y * sol[47]; sol[54] -= b2b.z * sol[47]; sol[55] -= b2b.w * sol[47]; sol[56] -= b2c.x * sol[47]; sol[57] -= b2c.y * sol[47]; sol[58] -= b2c.z * sol[47]; sol[59] -= b2c.w * sol[47]; sol[60] -= b2d.x * sol[47]; sol[61] -= b2d.y * sol[47]; sol[62] -= b2d.z * sol[47]; sol[63] -= b2d.w * sol[47];
  __builtin_amdgcn_sched_barrier(0);
  b2a = *(const float4*)(Lr + 3248); b2b = *(const float4*)(Lr + 3252); b2c = *(const float4*)(Lr + 3256); b2d = *(const float4*)(Lr + 3260);
  __builtin_amdgcn_sched_barrier(0);
  sol[49] -= b0a.y * sol[48]; sol[50] -= b0a.z * sol[48]; sol[51] -= b0a.w * sol[48]; sol[52] -= b0b.x * sol[48]; sol[53] -= b0b.y * sol[48]; sol[54] -= b0b.z * sol[48]; sol[55] -= b0b.w * sol[48]; sol[56] -= b0c.x * sol[48]; sol[57] -= b0c.y * sol[48]; sol[58] -= b0c.z * sol[48]; sol[59] -= b0c.w * sol[48]; sol[60] -= b0d.x * sol[48]; sol[61] -= b0d.y * sol[48]; sol[62] -= b0d.z * sol[48]; sol[63] -= b0d.w * sol[48];
  __builtin_amdgcn_sched_barrier(0);
  b0a = *(const float4*)(Lr + 3312); b0b = *(const float4*)(Lr + 3316); b0c = *(const float4*)(Lr + 3320); b0d = *(const float4*)(Lr + 3324);
  __builtin_amdgcn_sched_barrier(0);
  sol[50] -= b1a.z * sol[49]; sol[51] -= b1a.w * sol[49]; sol[52] -= b1b.x * sol[49]; sol[53] -= b1b.y * sol[49]; sol[54] -= b1b.z * sol[49]; sol[55] -= b1b.w * sol[49]; sol[56] -= b1c.x * sol[49]; sol[57] -= b1c.y * sol[49]; sol[58] -= b1c.z * sol[49]; sol[59] -= b1c.w * sol[49]; sol[60] -= b1d.x * sol[49]; sol[61] -= b1d.y * sol[49]; sol[62] -= b1d.z * sol[49]; sol[63] -= b1d.w * sol[49];
  __builtin_amdgcn_sched_barrier(0);
  b1a = *(const float4*)(Lr + 3376); b1b = *(const float4*)(Lr + 3380); b1c = *(const float4*)(Lr + 3384); b1d = *(const float4*)(Lr + 3388);
  __builtin_amdgcn_sched_barrier(0);
  sol[51] -= b2a.w * sol[50]; sol[52] -= b2b.x * sol[50]; sol[53] -= b2b.y * sol[50]; sol[54] -= b2b.z * sol[50]; sol[55] -= b2b.w * sol[50]; sol[56] -= b2c.x * sol[50]; sol[57] -= b2c.y * sol[50]; sol[58] -= b2c.z * sol[50]; sol[59] -= b2c.w * sol[50]; sol[60] -= b2d.x * sol[50]; sol[61] -= b2d.y * sol[50]; sol[62] -= b2d.z * sol[50]; sol[63] -= b2d.w * sol[50];
  __builtin_amdgcn_sched_barrier(0);
  b2a = *(const float4*)(Lr + 3440); b2b = *(const float4*)(Lr + 3444); b2c = *(const float4*)(Lr + 3448); b2d = *(const float4*)(Lr + 3452);
  __builtin_amdgcn_sched_barrier(0);
  sol[52] -= b0b.x * sol[51]; sol[53] -= b0b.y * sol[51]; sol[54] -= b0b.z * sol[51]; sol[55] -= b0b.w * sol[51]; sol[56] -= b0c.x * sol[51]; sol[57] -= b0c.y * sol[51]; sol[58] -= b0c.z * sol[51]; sol[59] -= b0c.w * sol[51]; sol[60] -= b0d.x * sol[51]; sol[61] -= b0d.y * sol[51]; sol[62] -= b0d.z * sol[51]; sol[63] -= b0d.w * sol[51];
  __builtin_amdgcn_sched_barrier(0);
  b0a = *(const float4*)(Lr + 3504); b0b = *(const float4*)(Lr + 3508); b0c = *(const float4*)(Lr + 3512); b0d = *(const float4*)(Lr + 3516);
  __builtin_amdgcn_sched_barrier(0);
  sol[53] -= b1b.y * sol[52]; sol[54] -= b1b.z * sol[52]; sol[55] -= b1b.w * sol[52]; sol[56] -= b1c.x * sol[52]; sol[57] -= b1c.y * sol[52]; sol[58] -= b1c.z * sol[52]; sol[59] -= b1c.w * sol[52]; sol[60] -= b1d.x * sol[52]; sol[61] -= b1d.y * sol[52]; sol[62] -= b1d.z * sol[52]; sol[63] -= b1d.w * sol[52];
  __builtin_amdgcn_sched_barrier(0);
  b1a = *(const float4*)(Lr + 3568); b1b = *(const float4*)(Lr + 3572); b1c = *(const float4*)(Lr + 3576); b1d = *(const float4*)(Lr + 3580);
  __builtin_amdgcn_sched_barrier(0);
  sol[54] -= b2b.z * sol[53]; sol[55] -= b2b.w * sol[53]; sol[56] -= b2c.x * sol[53]; sol[57] -= b2c.y * sol[53]; sol[58] -= b2c.z * sol[53]; sol[59] -= b2c.w * sol[53]; sol[60] -= b2d.x * sol[53]; sol[61] -= b2d.y * sol[53]; sol[62] -= b2d.z * sol[53]; sol[63] -= b2d.w * sol[53];
  __builtin_amdgcn_sched_barrier(0);
  b2a = *(const float4*)(Lr + 3632); b2b = *(const float4*)(Lr + 3636); b2c = *(const float4*)(Lr + 3640); b2d = *(const float4*)(Lr + 3644);
  __builtin_amdgcn_sched_barrier(0);
  sol[55] -= b0b.w * sol[54]; sol[56] -= b0c.x * sol[54]; sol[57] -= b0c.y * sol[54]; sol[58] -= b0c.z * sol[54]; sol[59] -= b0c.w * sol[54]; sol[60] -= b0d.x * sol[54]; sol[61] -= b0d.y * sol[54]; sol[62] -= b0d.z * sol[54]; sol[63] -= b0d.w * sol[54];
  __builtin_amdgcn_sched_barrier(0);
  b0a = *(const float4*)(Lr + 3696); b0b = *(const float4*)(Lr + 3700); b0c = *(const float4*)(Lr + 3704); b0d = *(const float4*)(Lr + 3708);
  __builtin_amdgcn_sched_barrier(0);
  sol[56] -= b1c.x * sol[55]; sol[57] -= b1c.y * sol[55]; sol[58] -= b1c.z * sol[55]; sol[59] -= b1c.w * sol[55]; sol[60] -= b1d.x * sol[55]; sol[61] -= b1d.y * sol[55]; sol[62] -= b1d.z * sol[55]; sol[63] -= b1d.w * sol[55];
  __builtin_amdgcn_sched_barrier(0);
  b1a = *(const float4*)(Lr + 3760); b1b = *(const float4*)(Lr + 3764); b1c = *(const float4*)(Lr + 3768); b1d = *(const float4*)(Lr + 3772);
  __builtin_amdgcn_sched_barrier(0);
  sol[57] -= b2c.y * sol[56]; sol[58] -= b2c.z * sol[56]; sol[59] -= b2c.w * sol[56]; sol[60] -= b2d.x * sol[56]; sol[61] -= b2d.y * sol[56]; sol[62] -= b2d.z * sol[56]; sol[63] -= b2d.w * sol[56];
  __builtin_amdgcn_sched_barrier(0);
  b2a = *(const float4*)(Lr + 3824); b2b = *(const float4*)(Lr + 3828); b2c = *(const float4*)(Lr + 3832); b2d = *(const float4*)(Lr + 3836);
  __builtin_amdgcn_sched_barrier(0);
  sol[58] -= b0c.z * sol[57]; sol[59] -= b0c.w * sol[57]; sol[60] -= b0d.x * sol[57]; sol[61] -= b0d.y * sol[57]; sol[62] -= b0d.z * sol[57]; sol[63] -= b0d.w * sol[57];
  __builtin_amdgcn_sched_barrier(0);
  b0a = *(const float4*)(Lr + 3888); b0b = *(const float4*)(Lr + 3892); b0c = *(const float4*)(Lr + 3896); b0d = *(const float4*)(Lr + 3900);
  __builtin_amdgcn_sched_barrier(0);
  sol[59] -= b1c.w * sol[58]; sol[60] -= b1d.x * sol[58]; sol[61] -= b1d.y * sol[58]; sol[62] -= b1d.z * sol[58]; sol[63] -= b1d.w * sol[58];
  __builtin_amdgcn_sched_barrier(0);
  b1a = *(const float4*)(Lr + 3952); b1b = *(const float4*)(Lr + 3956); b1c = *(const float4*)(Lr + 3960); b1d = *(const float4*)(Lr + 3964);
  __builtin_amdgcn_sched_barrier(0);
  sol[60] -= b2d.x * sol[59]; sol[61] -= b2d.y * sol[59]; sol[62] -= b2d.z * sol[59]; sol[63] -= b2d.w * sol[59];
  __builtin_amdgcn_sched_barrier(0);
  b2a = *(const float4*)(Lr + 4016); b2b = *(const float4*)(Lr + 4020); b2c = *(const float4*)(Lr + 4024); b2d = *(const float4*)(Lr + 4028);
  __builtin_amdgcn_sched_barrier(0);
  sol[61] -= b0d.y * sol[60]; sol[62] -= b0d.z * sol[60]; sol[63] -= b0d.w * sol[60];
  __builtin_amdgcn_sched_barrier(0);
  __builtin_amdgcn_sched_barrier(0);
  sol[62] -= b1d.z * sol[61]; sol[63] -= b1d.w * sol[61];
  __builtin_amdgcn_sched_barrier(0);
  __builtin_amdgcn_sched_barrier(0);
  sol[63] -= b2d.w * sol[62];
  __builtin_amdgcn_sched_barrier(0);
}

template <int DIR>
__device__ __forceinline__ void solve_cols(const Params& P, int itb, int c, const float* Lt, const float* bpp, const float* gcp,
                                           const u16* Vs, const u16* Ks) {
  float sol[64];
  const float* bp_ = bpp + DIR * 64;
  const float* gc_ = gcp + DIR * 64;
  if (c < 128) {
    const u16* vp = Vs + c;
#pragma unroll
    for (int p = 0; p < 64; ++p) sol[p] = bp_[p] * bf2f(vp[(DIR ? (63 - p) : p) * 136]);
  } else {
    const u16* kp = Ks + (c - 128);
#pragma unroll
    for (int p = 0; p < 64; ++p) sol[p] = bp_[p] * __expf(gc_[p]) * bf2f(kp[(DIR ? (63 - p) : p) * 136]);
  }
  const float* Lr = Lt + opq(DIR * 4096);
  solve_elim(sol, Lr);
  const size_t it2 = (size_t)(itb + DIR);
  if (c < 128) {
    u16* UF = (u16*)(P.ws + OFF_UF) + (it2 * 128 + c) * 64;
#pragma unroll
    for (int q = 0; q < 8; ++q) *(uint4*)(UF + q * 8) = pack8(sol + q * 8);
  } else {
    u16* Wg = (u16*)(P.ws + OFF_R2) + it2 * 8192 + (c - 128);
#pragma unroll
    for (int p = 0; p < 64; ++p) Wg[p * 128] = f2bf(-sol[p]);
  }
}

__device__ __forceinline__ void delta_prep_item(const Params& P, int item, char* lds) {
  const int tid = opq(threadIdx.x), lane = tid & 63, wv = tid >> 6, fr = lane & 15, fq = lane >> 4;
  const int cid = item >> 2, h = item & 3;
  const int row0 = cid * 64;
  int seq_lo, seq_hi;
  if (cid < 256) { seq_lo = (cid >> 6) * 4096; seq_hi = seq_lo + 4096; }
  else { seq_lo = 16384 + ((cid - 256) >> 2) * 256; seq_hi = seq_lo + 256; }
  u16* Qs = (u16*)(lds + opq(0));
  u16* Ks = (u16*)(lds + opq(17408));
  u16* Vs = (u16*)(lds + opq(34816));
  float* KKs = (float*)(lds + opq(52224));
  float* QKs = (float*)(lds + opq(69632));
  float* Lt = (float*)(lds + opq(87040));
  float* gtok = (float*)(lds + opq(119808));
  float* btok = gtok + 128;
  float* gcp = btok + 128;
  float* bpp = gcp + 128;
  u16* QKN = (u16*)((char*)P.out + OFF_QKN);
  __syncthreads();
  {
    const int j = tid >> 3, sg = tid & 7;
    const int row = row0 + j;
    const bool hm = (row - 1 >= seq_lo), hp = (row + 1 < seq_hi);
    const u16* qkv = (const u16*)(P.ws + OFF_R3);
#pragma unroll
    for (int s = 0; s < 3; ++s) {
      const int col = s * 512 + h * 128 + sg * 16;
      const u16* p0 = qkv + (size_t)row * 1536 + col;
      float y[16];
      float ssq = 0.f;
#pragma unroll
      for (int hh = 0; hh < 2; ++hh) {
        const uint4 c0 = *(const uint4*)(p0 + hh * 8);
        uint4 m0 = *(const uint4*)(p0 - (hm ? 1536 : 0) + hh * 8);
        uint4 n0 = *(const uint4*)(p0 + (hp ? 1536 : 0) + hh * 8);
        m0.x = hm ? m0.x : 0u; m0.y = hm ? m0.y : 0u; m0.z = hm ? m0.z : 0u; m0.w = hm ? m0.w : 0u;
        n0.x = hp ? n0.x : 0u; n0.y = hp ? n0.y : 0u; n0.z = hp ? n0.z : 0u; n0.w = hp ? n0.w : 0u;
        float fc[8], fm[8], fn[8];
        unpack8(c0, fc); unpack8(m0, fm); unpack8(n0, fn);
        const float* cwp = P.dn_conv_w + col + hh * 8;
        float cw0[8], cw1[8], cw2[8];
        {
          const float4 t0 = *(const float4*)(cwp), t1 = *(const float4*)(cwp + 4);
          const float4 t2 = *(const float4*)(cwp + 1536), t3 = *(const float4*)(cwp + 1540);
          const float4 t4 = *(const float4*)(cwp + 3072), t5 = *(const float4*)(cwp + 3076);
          cw0[0] = t0.x; cw0[1] = t0.y; cw0[2] = t0.z; cw0[3] = t0.w; cw0[4] = t1.x; cw0[5] = t1.y; cw0[6] = t1.z; cw0[7] = t1.w;
          cw1[0] = t2.x; cw1[1] = t2.y; cw1[2] = t2.z; cw1[3] = t2.w; cw1[4] = t3.x; cw1[5] = t3.y; cw1[6] = t3.z; cw1[7] = t3.w;
          cw2[0] = t4.x; cw2[1] = t4.y; cw2[2] = t4.z; cw2[3] = t4.w; cw2[4] = t5.x; cw2[5] = t5.y; cw2[6] = t5.z; cw2[7] = t5.w;
        }
#pragma unroll
        for (int e = 0; e < 8; ++e) {
          const float v = cw0[e] * fm[e] + cw1[e] * fc[e] + cw2[e] * fn[e];
          const float yy = v * sigm(v);
          y[hh * 8 + e] = yy;
          ssq += yy * yy;
        }
      }
      if (s < 2) {
        ssq += __shfl_xor(ssq, 1, 64); ssq += __shfl_xor(ssq, 2, 64); ssq += __shfl_xor(ssq, 4, 64);
        const float sc = rsqrtf(ssq + 1e-6f) * ((s == 0) ? 0.08838834764831845f : 1.f);
#pragma unroll
        for (int e = 0; e < 16; ++e) y[e] *= sc;
      }
      u16* dl = ((s == 0) ? Qs : ((s == 1) ? Ks : Vs)) + j * 136 + sg * 16;
      const uint4 o0 = pack8(y), o1 = pack8(y + 8);
      *(uint4*)dl = o0; *(uint4*)(dl + 8) = o1;
      if (s < 2) {
        u16* dg = QKN + (size_t)row * 1024 + s * 512 + h * 128 + sg * 16;
        *(uint4*)dg = o0; *(uint4*)(dg + 8) = o1;
      }
    }
  }
  if (tid < 128) {
    const int j = tid & 63, dir = tid >> 6;
    const float* BA = (const float*)(P.ws + OFF_BA) + (size_t)(row0 + j) * 16;
    const float bl = BA[dir * 4 + h], al = BA[8 + dir * 4 + h];
    const float xx = al + P.dn_dt_bias[dir * 4 + h];
    const float sp = (xx > 20.f) ? xx : log1pf(expf(xx));
    gtok[dir * 64 + j] = -expf(P.dn_a_log[dir * 4 + h]) * sp;
    btok[dir * 64 + j] = 1.f / (1.f + expf(-bl));
  }
  __syncthreads();
  if (tid < 128) {
    const int dir = tid >> 6, p = tid & 63;
    const int tk = dir ? (63 - p) : p;
    float a = gtok[dir * 64 + tk];
    const float bv = btok[dir * 64 + tk];
#pragma unroll
    for (int o = 1; o < 64; o <<= 1) {
      const float t = __shfl_up(a, o, 64);
      if (p >= o) a += t;
    }
    gcp[dir * 64 + p] = a;
    bpp[dir * 64 + p] = bv;
  }
  {
#pragma unroll
    for (int q = 0; q < 4; ++q) {
      const int t = wv * 4 + q;
      const int which = t >> 4, mi = (t >> 2) & 3, ni = t & 3;
      const u16* Am = (which ? Qs : Ks) + (mi * 16 + fr) * 136 + fq * 8;
      const u16* Bm = Ks + (ni * 16 + fr) * 136 + fq * 8;
      f32x4 a4 = {0.f, 0.f, 0.f, 0.f};
#pragma unroll
      for (int kk = 0; kk < 4; ++kk)
        a4 = __builtin_amdgcn_mfma_f32_16x16x32_bf16(*(const bf16x8*)(Am + kk * 32), *(const bf16x8*)(Bm + kk * 32), a4, 0, 0, 0);
      float* dst = which ? QKs : KKs;
#pragma unroll
      for (int e = 0; e < 4; ++e) dst[(mi * 16 + fq * 4 + e) * 68 + ni * 16 + fr] = a4[e];
    }
  }
  __syncthreads();
  const int itb = item * 2;
  {
    u16* AQ = (u16*)((char*)P.out + OFF_AQ);
#pragma unroll 8
    for (int idx = tid; idx < 8192; idx += NT) {
      const int dir = idx >> 12, p = (idx >> 6) & 63, s = idx & 63;
      const int tp = dir ? (63 - p) : p, ts = dir ? (63 - s) : s;
      const float dg = gcp[dir * 64 + p] - gcp[dir * 64 + s];
      const float dec = (p >= s) ? __expf(dg) : 0.f;
      AQ[((size_t)(itb + dir) * 64 + p) * 64 + s] = f2bf(QKs[tp * 68 + ts] * dec);
    }
#pragma unroll 8
    for (int idx = tid; idx < 8192; idx += NT) {
      const int dir = idx >> 12, s = (idx >> 6) & 63, p = idx & 63;
      const int tp = dir ? (63 - p) : p, ts = dir ? (63 - s) : s;
      const float dg = gcp[dir * 64 + p] - gcp[dir * 64 + s];
      const float lv = (p > s) ? bpp[dir * 64 + p] * KKs[ts * 68 + tp] * __expf(dg) : 0.f;
      Lt[dir * 4096 + s * 64 + p] = lv;
    }
    if (tid < 128) {
      float* GC = (float*)(P.ws + OFF_GC);
      GC[(size_t)(itb + (tid >> 6)) * 64 + (tid & 63)] = gcp[tid];
    }
  }
  __syncthreads();
  if (tid < 256) solve_cols<0>(P, itb, tid, Lt, bpp, gcp, Vs, Ks);
  else solve_cols<1>(P, itb, tid - 256, Lt, bpp, gcp, Vs, Ks);
}

__device__ __forceinline__ void s5end_tile(const Params& P, int t, char* lds) {
  const int g = t / 6, mt = (t % 6) >> 1, nt = t & 1;
  const int m0 = mt * 256, n0 = nt * 128;
  f32x16 acc[2][2];
  acc_zero(acc);
  gemm_main((const u16*)(P.ws + OFF_U5) + ((size_t)g * 544 + m0) * 512, 512,
            (const u16*)(P.ws + OFF_MEND) + ((size_t)g * 256 + n0) * 512, 512, 512, acc, (u16*)lds);
  TILE_COORDS
  float* E = (float*)(P.ws + OFF_E);
#pragma unroll
  for (int i = 0; i < 2; ++i)
#pragma unroll
    for (int j = 0; j < 2; ++j)
#pragma unroll
      for (int e = 0; e < 16; ++e) {
        const int row = TROW(m0, i, e);
        if (row < 544) E[((size_t)g * 544 + row) * 256 + TCOL(n0, j)] = acc[i][j][e];
      }
}

__device__ __forceinline__ void scan_chunk(const u16* Wl, const u16* QTl, const u16* KTl, const u16* AQl, u16* ST, u16* VT,
                                           int wd, int wq, int fr, int fq, float gl, f32x4& av, f32x4& ao, f32x4& accS0, f32x4& accS1) {
  {
    bf16x8 bS[4], a1[4], a2[4];
#pragma unroll
    for (int kk = 0; kk < 4; ++kk) {
      bS[kk] = *(const bf16x8*)(ST + (wd * 16 + fr) * 136 + kk * 32 + fq * 8);
      a1[kk] = *(const bf16x8*)(Wl + (wq * 16 + fr) * 136 + kk * 32 + fq * 8);
      a2[kk] = *(const bf16x8*)(QTl + (wq * 16 + fr) * 136 + kk * 32 + fq * 8);
    }
    __builtin_amdgcn_sched_barrier(0);
#pragma unroll
    for (int kk = 0; kk < 4; ++kk) {
      av = __builtin_amdgcn_mfma_f32_16x16x32_bf16(a1[kk], bS[kk], av, 0, 0, 0);
      ao = __builtin_amdgcn_mfma_f32_16x16x32_bf16(a2[kk], bS[kk], ao, 0, 0, 0);
    }
  }
  {
    uint2 v; v.x = pack2(av[0], av[1]); v.y = pack2(av[2], av[3]);
    *(uint2*)(VT + (wd * 16 + fr) * 72 + wq * 16 + fq * 4) = v;
  }
  bf16x8 qa[2], k0[2], k1[2];
#pragma unroll
  for (int ks = 0; ks < 2; ++ks) {
    qa[ks] = *(const bf16x8*)(AQl + (wq * 16 + fr) * 72 + ks * 32 + fq * 8);
    k0[ks] = *(const bf16x8*)(KTl + ((2 * wq) * 16 + fr) * 72 + ks * 32 + fq * 8);
    k1[ks] = *(const bf16x8*)(KTl + ((2 * wq + 1) * 16 + fr) * 72 + ks * 32 + fq * 8);
  }
  accS0[0] *= gl; accS0[1] *= gl; accS0[2] *= gl; accS0[3] *= gl;
  accS1[0] *= gl; accS1[1] *= gl; accS1[2] *= gl; accS1[3] *= gl;
  __syncthreads();
  {
    bf16x8 bV[2];
#pragma unroll
    for (int ks = 0; ks < 2; ++ks) bV[ks] = *(const bf16x8*)(VT + (wd * 16 + fr) * 72 + ks * 32 + fq * 8);
#pragma unroll
    for (int ks = 0; ks < 2; ++ks) {
      ao = __builtin_amdgcn_mfma_f32_16x16x32_bf16(qa[ks], bV[ks], ao, 0, 0, 0);
      accS0 = __builtin_amdgcn_mfma_f32_16x16x32_bf16(k0[ks], bV[ks], accS0, 0, 0, 0);
      accS1 = __builtin_amdgcn_mfma_f32_16x16x32_bf16(k1[ks], bV[ks], accS1, 0, 0, 0);
    }
  }
  {
    uint2 v; v.x = pack2(accS0[0], accS0[1]); v.y = pack2(accS0[2], accS0[3]);
    *(uint2*)(ST + (wd * 16 + fr) * 136 + (2 * wq) * 16 + fq * 4) = v;
    v.x = pack2(accS1[0], accS1[1]); v.y = pack2(accS1[2], accS1[3]);
    *(uint2*)(ST + (wd * 16 + fr) * 136 + (2 * wq + 1) * 16 + fq * 4) = v;
  }
}

__device__ __forceinline__ void delta_scan_block(const Params& P, int sb, char* lds) {
  const int tid = opq(threadIdx.x), lane = tid & 63, w = tid >> 6, fr = lane & 15, fq = lane >> 4;
  const int bhd = sb & 31, dvq = sb >> 5;
  const int b = bhd >> 3, h = (bhd >> 1) & 3, dir = bhd & 1;
  const int wd = w & 1, wq = w >> 1;
  const int dv0 = dvq * 32 + wd * 16;
  u16* Wl = (u16*)(lds + opq(0));
  u16* QTl = (u16*)(lds + opq(17408));
  u16* KTl = (u16*)(lds + opq(34816));
  u16* AQl = (u16*)(lds + opq(53248));
  u16* ST = (u16*)(lds + opq(62464));
  u16* VT = (u16*)(lds + opq(71168));
  __syncthreads();
  for (int i = tid; i < 32 * 136 / 2; i += NT) ((uint32_t*)ST)[i] = 0u;
  f32x4 accS0 = {0.f, 0.f, 0.f, 0.f}, accS1 = {0.f, 0.f, 0.f, 0.f};
  const u16* QKN = (const u16*)((const char*)P.out + OFF_QKN);
  const u16* AQg = (const u16*)((const char*)P.out + OFF_AQ);
  const u16* Wg = (const u16*)(P.ws + OFF_R2);
  const u16* UFg = (const u16*)(P.ws + OFF_UF);
  const float* GC = (const float*)(P.ws + OFF_GC);
  u16* Og = (u16*)(P.ws + OFF_O);

#define SC_DECL(S)                                                   \
  uint4 S##w0, S##w1, S##q0, S##q1, S##k0, S##k1, S##a;              \
  float S##gq0, S##gq1, S##gk, S##g63;                               \
  uint2 S##u;                                                        \
  int S##row0 = 0, S##lat = 0;
#define SC_PF_ONE(S, i)                                                                            \
    {                                                                                              \
      const int id = tid + (i) * 512;                                                              \
      const int p = id >> 4, seg = id & 15;                                                        \
      const int tk = dir ? (63 - p) : p;                                                           \
      S##w##i = *(const uint4*)(Wg + it2__ * 8192 + p * 128 + seg * 8);                            \
      S##q##i = *(const uint4*)(QKN + (size_t)(S##row0 + tk) * 1024 + h * 128 + seg * 8);          \
      S##gq##i = GC[it2__ * 64 + p];                                                               \
      const int s = id & 63, sg2 = id >> 6;                                                        \
      const int tks = dir ? (63 - s) : s;                                                          \
      S##k##i = *(const uint4*)(QKN + (size_t)(S##row0 + tks) * 1024 + 512 + h * 128 + sg2 * 8);   \
    }
#define SC_PREFETCH(S, n_)                                                                         \
  {                                                                                                \
    const int n__ = (n_);                                                                          \
    int cid__;                                                                                     \
    if (n__ < 4) { cid__ = 256 + b * 4 + (dir ? (3 - n__) : n__); S##lat = 0; }                    \
    else { const int m__ = n__ - 4; cid__ = b * 64 + (dir ? (63 - m__) : m__); S##lat = 1; }       \
    S##row0 = cid__ * 64;                                                                          \
    const size_t it2__ = (size_t)((cid__ * 4 + h) * 2 + dir);                                      \
    SC_PF_ONE(S, 0)                                                                                \
    SC_PF_ONE(S, 1)                                                                                \
    S##gk = GC[it2__ * 64 + (tid & 63)];                                                           \
    S##g63 = GC[it2__ * 64 + 63];                                                                  \
    S##a = *(const uint4*)(AQg + it2__ * 4096 + (tid >> 3) * 64 + (tid & 7) * 8);                  \
    S##u = *(const uint2*)(UFg + (it2__ * 128 + dv0 + fr) * 64 + wq * 16 + fq * 4);                \
  }
#define SC_STAGE_ONE(S, i)                                                    \
    {                                                                         \
      const int id = tid + (i) * 512;                                         \
      const int p = id >> 4, seg = id & 15;                                   \
      *(uint4*)(Wl + p * 136 + seg * 8) = S##w##i;                            \
      float f[8];                                                             \
      unpack8(S##q##i, f);                                                    \
      const float sq = __expf(S##gq##i);                                      \
      f[0] *= sq; f[1] *= sq; f[2] *= sq; f[3] *= sq; f[4] *= sq; f[5] *= sq; f[6] *= sq; f[7] *= sq; \
      *(uint4*)(QTl + p * 136 + seg * 8) = pack8(f);                          \
      const int s = id & 63, sg2 = id >> 6;                                   \
      unpack8(S##k##i, f);                                                    \
      u16* kd = KTl + (sg2 * 8) * 72 + s;                                     \
      kd[0 * 72] = f2bf(f[0] * sk); kd[1 * 72] = f2bf(f[1] * sk); kd[2 * 72] = f2bf(f[2] * sk); kd[3 * 72] = f2bf(f[3] * sk); \
      kd[4 * 72] = f2bf(f[4] * sk); kd[5 * 72] = f2bf(f[5] * sk); kd[6 * 72] = f2bf(f[6] * sk); kd[7 * 72] = f2bf(f[7] * sk); \
    }
#define SC_STEP(S, n_)                                                                                \
  {                                                                                                   \
    const int cur_row0 = S##row0, cur_lat = S##lat;                                                   \
    const float gl = __expf(S##g63);                                                                  \
    const float sk = __expf(S##g63 - S##gk);                                                          \
    SC_STAGE_ONE(S, 0)                                                                                \
    SC_STAGE_ONE(S, 1)                                                                                \
    *(uint4*)(AQl + (tid >> 3) * 72 + (tid & 7) * 8) = S##a;                                          \
    f32x4 av = f32x4{lo16(S##u.x), hi16(S##u.x), lo16(S##u.y), hi16(S##u.y)};                         \
    f32x4 ao = f32x4{0.f, 0.f, 0.f, 0.f};                                                             \
    __syncthreads();                                                                                  \
    if ((n_) + 2 < 68) SC_PREFETCH(S, (n_) + 2)                                                       \
    scan_chunk(Wl, QTl, KTl, AQl, ST, VT, wd, wq, fr, fq, gl, av, ao, accS0, accS1);                  \
    if (cur_lat) {                                                                                    \
      _Pragma("unroll") for (int e = 0; e < 4; ++e) {                                                 \
        const int p = wq * 16 + fq * 4 + e;                                                           \
        const int tk = dir ? (63 - p) : p;                                                            \
        Og[((size_t)dir * 16384 + cur_row0 + tk) * 512 + h * 128 + dv0 + fr] = f2bf(ao[e]);           \
      }                                                                                               \
    }                                                                                                 \
    __syncthreads();                                                                                  \
  }
  SC_DECL(A)
  SC_DECL(B)
  SC_PREFETCH(A, 0)
  SC_PREFETCH(B, 1)
  for (int n = 0; n < 68; n += 2) {
    SC_STEP(A, n)
    SC_STEP(B, n + 1)
  }
#undef SC_DECL
#undef SC_PF_ONE
#undef SC_PREFETCH
#undef SC_STAGE_ONE
#undef SC_STEP
}

__device__ __forceinline__ void s5_carry_block(const Params& P, int cb) {
  const int idx = cb * NT + opq(threadIdx.x);
  const int n = idx & 63, g = (idx >> 6) & 31, r = (idx >> 11) & 1, b = idx >> 12;
  const int rg = r * 32 + g;
  const float step = expf(P.s5_log_step[rg]);
  float lr, li;
  lam_pow(step, P.s5_a_re[rg * 64 + n], P.s5_a_im[rg * 64 + n], 32, lr, li);
  const float* E = (const float*)(P.ws + OFF_E) + (size_t)g * 544 * 256 + r * 128 + n;
  u16* XIN = (u16*)(P.ws + OFF_XIN) + (size_t)g * 512 * 256 + r * 128 + n;
  float xr = 0.f, xi = 0.f;
  for (int k = 0; k < 8; ++k) {
    const int cc = r ? (7 - k) : k;
    const int row = 512 + b * 8 + cc;
    const float er = E[(size_t)row * 256], ei = E[(size_t)row * 256 + 64];
    const float nr = lr * xr - li * xi + er, ni = lr * xi + li * xr + ei;
    xr = nr; xi = ni;
  }
  for (int k = 0; k < 128; ++k) {
    const int cc = r ? (127 - k) : k;
    const int row = b * 128 + cc;
    XIN[(size_t)row * 256] = f2bf(xr);
    XIN[(size_t)row * 256 + 64] = f2bf(xi);
    const float er = E[(size_t)row * 256], ei = E[(size_t)row * 256 + 64];
    const float nr = lr * xr - li * xi + er, ni = lr * xi + li * xr + ei;
    xr = nr; xi = ni;
  }
}

__device__ __forceinline__ void s5out_tile(const Params& P, int t, char* lds) {
  const int g = t >> 3, mt = (t >> 2) & 1, nt = t & 3;
  const int m0 = mt * 256, n0 = nt * 128;
  f32x16 acc[2][2];
  acc_zero(acc);
  gemm_main((const u16*)(P.ws + OFF_XIN) + ((size_t)g * 512 + m0) * 256, 256,
            (const u16*)(P.ws + OFF_MST) + ((size_t)g * 512 + n0) * 256, 256, 256, acc, (u16*)lds);
  gemm_main((const u16*)(P.ws + OFF_U5) + ((size_t)g * 544 + m0) * 512, 512,
            (const u16*)(P.ws + OFF_MINTRA) + ((size_t)g * 512 + n0) * 512, 512, 512, acc, (u16*)lds);
  TILE_COORDS
  u16* YB = (u16*)(P.ws + OFF_YB);
#pragma unroll
  for (int i = 0; i < 2; ++i)
#pragma unroll
    for (int j = 0; j < 2; ++j)
#pragma unroll
      for (int e = 0; e < 16; ++e) {
        const int row = TROW(m0, i, e), nn = TCOL(n0, j);
        const int token = row * 32 + (nn >> 4);
        YB[(size_t)token * 512 + g * 16 + (nn & 15)] = f2bf(gelu_tanh(acc[i][j][e]));
      }
}

__device__ __forceinline__ void delta_post_item(const Params& P, int item) {
  const int lane = opq(threadIdx.x) & 63, w = opq(threadIdx.x) >> 6;
  const int row = item * 8 + w;
  const u16* O = (const u16*)(P.ws + OFF_O);
  const uint4 o0 = *(const uint4*)(O + (size_t)row * 512 + lane * 8);
  const uint4 o1 = *(const uint4*)(O + ((size_t)16384 + row) * 512 + lane * 8);
  const uint4 zz = *(const uint4*)((const u16*)(P.ws + OFF_Z) + (size_t)row * 512 + lane * 8);
  float a[8], bq[8], z[8];
  unpack8(o0, a); unpack8(o1, bq); unpack8(zz, z);
  float ss = 0.f;
#pragma unroll
  for (int e = 0; e < 8; ++e) { a[e] += bq[e]; ss += a[e] * a[e]; }
  ss += __shfl_xor(ss, 1, 64); ss += __shfl_xor(ss, 2, 64); ss += __shfl_xor(ss, 4, 64); ss += __shfl_xor(ss, 8, 64);
  const float rstd = rsqrtf(ss * (1.f / 128.f) + 1e-6f);
  const float* nw = P.dn_norm_w + (lane & 15) * 8;
  float y[8];
#pragma unroll
  for (int e = 0; e < 8; ++e) y[e] = a[e] * rstd * nw[e] * (z[e] * sigm(z[e]));
  *(uint4*)((u16*)(P.ws + OFF_YA) + (size_t)row * 512 + lane * 8) = pack8(y);
}

__device__ __forceinline__ void glu_tile(const Params& P, int t, char* lds) {
  const int nt = t >> 6, mt = t & 63;
  const int m0 = mt * 256, n0 = nt * 128;
  f32x16 acc[2][2];
  acc_zero(acc);
  gemm_main((const u16*)(P.ws + OFF_YB) + (size_t)m0 * 512, 512, (const u16*)(P.ws + OFF_WT_GLU) + (size_t)n0 * 512, 512, 512, acc, (u16*)lds);
  TILE_COORDS
  u16* YG = (u16*)(P.ws + OFF_YG);
  {
    const int oc = nt * 64 + wn_ * 32 + fr_;
    const float bv = P.b_glu[oc], bg = P.b_glu[512 + oc];
#pragma unroll
    for (int i = 0; i < 2; ++i)
#pragma unroll
      for (int e = 0; e < 16; ++e) {
        const float val = acc[i][0][e] + bv, gt = acc[i][1][e] + bg;
        YG[TIDX2(m0, nt * 64 + wn_ * 32, i, e, 512)] = f2bf(val * sigm(gt));
      }
  }
}

__device__ __forceinline__ void gates_tile(const Params& P, int t, char* lds) {
  const int nt = t >> 6, mt = t & 63;
  const int m0 = mt * 256, n0 = nt * 128;
  f32x16 acc[2][2];
  acc_zero(acc);
  gemm_main((const u16*)(P.ws + OFF_R2) + (size_t)m0 * 1024, 1024, (const u16*)(P.ws + OFF_WT_IN) + (size_t)(2688 + n0) * 1024, 1024, 1024, acc, (u16*)lds);
  TILE_COORDS
  u16* SG = (u16*)(P.ws + OFF_SG);
#pragma unroll
  for (int i = 0; i < 2; ++i)
#pragma unroll
    for (int j = 0; j < 2; ++j)
#pragma unroll
      for (int e = 0; e < 16; ++e) SG[TIDX(m0, n0, i, j, e, 2048)] = f2bf(sigm(acc[i][j][e]));
}

__device__ __forceinline__ void mix_tile(const Params& P, int t, char* lds) {
  const int nt = t >> 6, mt = t & 63;
  const int m0 = mt * 256, n0 = nt * 128;
  const u16* SG = (const u16*)(P.ws + OFF_SG);
  f32x16 acc[2][2];
  u16* MIX = (u16*)(P.ws + OFF_MIX);
  acc_zero(acc);
  gemm_main((const u16*)(P.ws + OFF_YA) + (size_t)m0 * 512, 512, (const u16*)(P.ws + OFF_WT_AOUT) + (size_t)n0 * 512, 512, 512, acc, (u16*)lds);
  {
    TILE_COORDS
    u16 sv[2][2][16];
#pragma unroll
    for (int i = 0; i < 2; ++i)
#pragma unroll
      for (int j = 0; j < 2; ++j)
#pragma unroll
        for (int e = 0; e < 16; ++e) sv[i][j][e] = SG[TIDX(m0, n0, i, j, e, 2048)];
#pragma unroll
    for (int i = 0; i < 2; ++i)
#pragma unroll
      for (int j = 0; j < 2; ++j)
#pragma unroll
        for (int e = 0; e < 16; ++e) MIX[TIDX(m0, n0, i, j, e, 1024)] = f2bf(bf2f(sv[i][j][e]) * acc[i][j][e]);
  }
  acc_zero(acc);
  gemm_main((const u16*)(P.ws + OFF_YG) + (size_t)m0 * 512, 512, (const u16*)(P.ws + OFF_WT_BOUT) + (size_t)n0 * 512, 512, 512, acc, (u16*)lds);
  {
    TILE_COORDS
#pragma unroll
    for (int i = 0; i < 2; ++i) {
      u16 sv[2][16], pv[2][16];
#pragma unroll
      for (int j = 0; j < 2; ++j)
#pragma unroll
        for (int e = 0; e < 16; ++e) {
          sv[j][e] = SG[TIDX(m0, n0, i, j, e, 2048) + 1024];
          pv[j][e] = MIX[TIDX(m0, n0, i, j, e, 1024)];
        }
#pragma unroll
      for (int j = 0; j < 2; ++j)
#pragma unroll
        for (int e = 0; e < 16; ++e)
          MIX[TIDX(m0, n0, i, j, e, 1024)] = f2bf(bf2f(pv[j][e]) + bf2f(sv[j][e]) * acc[i][j][e]);
    }
  }
}

__device__ __forceinline__ void wo_tile(const Params& P, int t, char* lds) {
  const int nt = t >> 6, mt = t & 63;
  const int m0 = mt * 256, n0 = nt * 128;
  f32x16 acc[2][2];
  acc_zero(acc);
  gemm_main((const u16*)(P.ws + OFF_MIX) + (size_t)m0 * 1024, 1024, (const u16*)(P.ws + OFF_WT_O) + (size_t)n0 * 1024, 1024, 1024, acc, (u16*)lds);
  TILE_COORDS
  const float* MOD = (const float*)(P.ws + OFF_MOD) + (m0 >> 12) * 6144 + 2 * 1024;
  float xv[2][2][16];
#pragma unroll
  for (int j = 0; j < 2; ++j)
#pragma unroll
    for (int i = 0; i < 2; ++i)
#pragma unroll
      for (int e = 0; e < 16; ++e) xv[i][j][e] = P.x[TIDX(m0, n0, i, j, e, 1024)];
#pragma unroll
  for (int j = 0; j < 2; ++j) {
    const int col = TCOL(n0, j);
    const float gate = MOD[col];
#pragma unroll
    for (int i = 0; i < 2; ++i)
#pragma unroll
      for (int e = 0; e < 16; ++e) P.out[TIDX(m0, n0, i, j, e, 1024)] = xv[i][j][e] + gate * acc[i][j][e];
  }
}

__device__ __forceinline__ void norm2_item(const Params& P, int item) {
  const int lane = opq(threadIdx.x) & 63, w = opq(threadIdx.x) >> 6;
  const int rowA = item * 16 + w, rowB = rowA + 8;
  const float* MA = (const float*)(P.ws + OFF_MOD) + (rowA >> 12) * 6144;
  const float* MB = (const float*)(P.ws + OFF_MOD) + (rowB >> 12) * 6144;
  u16* H = (u16*)(P.ws + OFF_R2);
  norm_row2(P.out + (size_t)rowA * 1024, P.out + (size_t)rowB * 1024, P.norm2_w, MA + 3 * 1024, MA + 4 * 1024, MB + 3 * 1024, MB + 4 * 1024,
            H + (size_t)rowA * 1024, H + (size_t)rowB * 1024, lane);
}

__device__ __forceinline__ void up_tile(const Params& P, int t, int hh, char* lds) {
  const int nt = t >> 6, mt = t & 63;
  const int m0 = mt * 256, n0 = nt * 128;
  f32x16 acc[2][2];
  acc_zero(acc);
  gemm_main((const u16*)(P.ws + OFF_R2) + (size_t)m0 * 1024, 1024,
            (const u16*)(P.ws + OFF_WT_UP) + ((size_t)hh * 2816 + n0) * 1024, 1024, 1024, acc, (u16*)lds);
  TILE_COORDS
  u16* UPH = (u16*)(P.ws + OFF_UPH);
#pragma unroll
  for (int i = 0; i < 2; ++i)
#pragma unroll
    for (int j = 0; j < 2; ++j)
#pragma unroll
      for (int e = 0; e < 16; ++e) UPH[TIDX(m0, n0, i, j, e, 2816)] = f2bf(acc[i][j][e]);
}

#define CG_LD(ci, dy)                                                                       \
    {                                                                                       \
      const int xc = x0 - 1 + (ci);                                                         \
      const bool cok = (xc >= 0) && (xc <= 63);                                             \
      const bool rok = ((dy) == 1) || ((dy) == 0 ? r0ok : r2ok);                            \
      const int yy = rok ? (y + (dy) - 1) : y;                                              \
      const u16* src = UPH + (base + (size_t)yy * 64 + (cok ? xc : x0)) * 2816 + c4;        \
      uint2 g__ = *(const uint2*)src;                                                       \
      uint2 v__ = *(const uint2*)(src + 1408);                                              \
      const bool ok = cok && rok;                                                           \
      g__.x = ok ? g__.x : 0u; g__.y = ok ? g__.y : 0u;                                     \
      v__.x = ok ? v__.x : 0u; v__.y = ok ? v__.y : 0u;                                     \
      gg[ci][dy] = g__; vv[ci][dy] = v__;                                                   \
    }
__device__ __forceinline__ void convgate_item(const Params& P, int item, int hh) {
  const int tid = opq(threadIdx.x);
  if (tid >= 352) return;
  const int xo = item & 15, y = (item >> 4) & 63, b = item >> 10;
  const int c4 = tid * 4;
  const u16* UPH = (const u16*)(P.ws + OFF_UPH);
  u16* G = (u16*)(P.ws + OFF_G);
  const size_t base = (size_t)b * 4096;
  const bool r0ok = (y > 0), r2ok = (y < 63);
  const int x0 = xo * 4;
  uint2 gg[6][3], vv[6][3];
#pragma unroll
  for (int ci = 0; ci < 6; ++ci) {
    CG_LD(ci, 0)
    CG_LD(ci, 1)
    CG_LD(ci, 2)
  }
  float wg[9][4], wv[9][4];
#pragma unroll
  for (int k = 0; k < 9; ++k) {
    const float4 a = *(const float4*)(P.ffn_conv_w + (size_t)k * 5632 + hh * 1408 + c4);
    const float4 bq = *(const float4*)(P.ffn_conv_w + (size_t)k * 5632 + 2816 + hh * 1408 + c4);
    wg[k][0] = a.x; wg[k][1] = a.y; wg[k][2] = a.z; wg[k][3] = a.w;
    wv[k][0] = bq.x; wv[k][1] = bq.y; wv[k][2] = bq.z; wv[k][3] = bq.w;
  }
#pragma unroll
  for (int xx = 0; xx < 4; ++xx) {
    float ag[4] = {0.f, 0.f, 0.f, 0.f}, av[4] = {0.f, 0.f, 0.f, 0.f};
#pragma unroll
    for (int dy = 0; dy < 3; ++dy)
#pragma unroll
      for (int dx = 0; dx < 3; ++dx) {
        const uint2 gq = gg[xx + dx][dy], vq = vv[xx + dx][dy];
        const int k = dy * 3 + dx;
        ag[0] += wg[k][0] * lo16(gq.x); ag[1] += wg[k][1] * hi16(gq.x); ag[2] += wg[k][2] * lo16(gq.y); ag[3] += wg[k][3] * hi16(gq.y);
        av[0] += wv[k][0] * lo16(vq.x); av[1] += wv[k][1] * hi16(vq.x); av[2] += wv[k][2] * lo16(vq.y); av[3] += wv[k][3] * hi16(vq.y);
      }
    uint2 o;
    o.x = pack2(ag[0] * sigm(ag[0]) * av[0], ag[1] * sigm(ag[1]) * av[1]);
    o.y = pack2(ag[2] * sigm(ag[2]) * av[2], ag[3] * sigm(ag[3]) * av[3]);
    *(uint2*)(G + (base + y * 64 + x0 + xx) * 2816 + hh * 1408 + c4) = o;
  }
}
#undef CG_LD

__device__ __forceinline__ void down_tile(const Params& P, int t, char* lds) {
  const int nt = t >> 6, mt = t & 63;
  const int m0 = mt * 256, n0 = nt * 128;
  f32x16 acc[2][2];
  acc_zero(acc);
  gemm_main((const u16*)(P.ws + OFF_G) + (size_t)m0 * 2816, 2816, (const u16*)(P.ws + OFF_WT_DOWN) + (size_t)n0 * 2816, 2816, 2816, acc, (u16*)lds);
  TILE_COORDS
  const float* MOD = (const float*)(P.ws + OFF_MOD) + (m0 >> 12) * 6144 + 5 * 1024;
  float xv[2][2][16];
#pragma unroll
  for (int j = 0; j < 2; ++j)
#pragma unroll
    for (int i = 0; i < 2; ++i)
#pragma unroll
      for (int e = 0; e < 16; ++e) xv[i][j][e] = P.out[TIDX(m0, n0, i, j, e, 1024)];
#pragma unroll
  for (int j = 0; j < 2; ++j) {
    const int col = TCOL(n0, j);
    const float gate = MOD[col];
#pragma unroll
    for (int i = 0; i < 2; ++i)
#pragma unroll
      for (int e = 0; e < 16; ++e) P.out[TIDX(m0, n0, i, j, e, 1024)] = xv[i][j][e] + gate * acc[i][j][e];
  }
}

__device__ __forceinline__ void final_item(const Params& P, int item) {
  const int lane = opq(threadIdx.x) & 63, w = opq(threadIdx.x) >> 6;
  const int row = item * 8 + w;
  float* xr = P.out + (size_t)row * 1024;
  float4 v[4];
  float ss = 0.f;
#pragma unroll
  for (int it = 0; it < 4; ++it) {
    v[it] = *(const float4*)(xr + (it * 64 + lane) * 4);
    ss += v[it].x * v[it].x + v[it].y * v[it].y + v[it].z * v[it].z + v[it].w * v[it].w;
  }
  ss = wsum64(ss);
  const float rstd = rsqrtf(ss * (1.f / 1024.f) + 1e-6f);
#pragma unroll
  for (int it = 0; it < 4; ++it) {
    const int c = (it * 64 + lane) * 4;
    const float4 w4 = *(const float4*)(P.norm_f_w + c);
    float4 o;
    o.x = v[it].x * rstd * w4.x; o.y = v[it].y * rstd * w4.y; o.z = v[it].z * rstd * w4.z; o.w = v[it].w * rstd * w4.w;
    *(float4*)(xr + c) = o;
  }
}

__device__ __forceinline__ void run_phase(const Params& P, int ph, char* lds) {
  const int bid = blockIdx.x, nb = gridDim.x;
#ifdef ONLY_PHASE
  if (ph != ONLY_PHASE) return;
#endif
  switch (ph) {
    case 0: {
      for (int it = bid; it < 984 + 192 + 2048; it += nb) {
        if (it < 296) convert_item(P.w_in, 1024, 4624, (u16*)(P.ws + OFF_WT_IN), 0, it, lds);
        else if (it < 328) convert_item(P.w_a_out, 512, 1024, (u16*)(P.ws + OFF_WT_AOUT), 1, it - 296, lds);
        else if (it < 360) convert_item(P.w_glu, 512, 1024, (u16*)(P.ws + OFF_WT_GLU), 2, it - 328, lds);
        else if (it < 392) convert_item(P.w_b_out, 512, 1024, (u16*)(P.ws + OFF_WT_BOUT), 3, it - 360, lds);
        else if (it < 456) convert_item(P.w_o, 1024, 1024, (u16*)(P.ws + OFF_WT_O), 4, it - 392, lds);
        else if (it < 808) convert_item(P.w_up, 1024, 5632, (u16*)(P.ws + OFF_WT_UP), 5, it - 456, lds);
        else if (it < 984) convert_item(P.w_down, 2816, 1024, (u16*)(P.ws + OFF_WT_DOWN), 6, it - 808, lds);
        else if (it < 1176) mod_item(P, it - 984, lds);
        else s5tab_item(P, it - 1176, lds);
      }
    } break;
    case 1:
      for (int it = bid; it < 1088 + 2048; it += nb) {
        if (it < 1088) norm1_item(P, it); else mintra_item(P, it - 1088);
      }
      break;
    case 2:
      for (int it = bid; it < 1396; it += nb) inproj_tile(P, it, lds);
      break;
    case 3:
      for (int it = bid; it < 1088 + 192; it += nb) {
        if (it < 1088) delta_prep_item(P, it, lds); else s5end_tile(P, it - 1088, lds);
      }
      break;
    case 4:
      if (bid < 128) delta_scan_block(P, bid, lds);
      else if (bid < 160) s5_carry_block(P, bid - 128);
      break;
    case 5:
      for (int it = bid; it < 256 + 2048 + 1024; it += nb) {
        if (it < 256) s5out_tile(P, it, lds);
        else if (it < 2304) delta_post_item(P, it - 256);
        else norm1_item(P, it - 2304);
      }
      break;
    case 6:
      for (int it = bid; it < 512 + 1024; it += nb) {
        if (it < 512) glu_tile(P, it, lds); else gates_tile(P, it - 512, lds);
      }
      break;
    case 7:
      for (int it = bid; it < 512; it += nb) mix_tile(P, it, lds);
      break;
    case 8:
      for (int it = bid; it < 512; it += nb) wo_tile(P, it, lds);
      break;
    case 9:
      for (int it = bid; it < 1024; it += nb) norm2_item(P, it);
      break;
    case 10:
      for (int it = bid; it < 1408; it += nb) up_tile(P, it, 0, lds);
      break;
    case 11:
      for (int it = bid; it < 4096; it += nb) convgate_item(P, it, 0);
      break;
    case 12:
      for (int it = bid; it < 1408; it += nb) up_tile(P, it, 1, lds);
      break;
    case 13:
      for (int it = bid; it < 4096; it += nb) convgate_item(P, it, 1);
      break;
    case 14:
      for (int it = bid; it < 512; it += nb) down_tile(P, it, lds);
      break;
    case 15:
      for (int it = bid; it < 2048; it += nb) final_item(P, it);
      break;
    default: break;
  }
}

typedef const __attribute__((address_space(4))) Params* KParamsPtr;
__global__ void __launch_bounds__(NT) fwd_megakernel(Params Pk) {
#if defined(__HIP_DEVICE_COMPILE__)
  extern __shared__ __attribute__((aligned(16))) char lds[];
  KParamsPtr pp = (KParamsPtr)__builtin_amdgcn_kernarg_segment_ptr();
  const int lo = (int)pp->ph_lo, hi = (int)pp->ph_hi;
#if MULTI_LAUNCH
  for (int ph = lo; ph < hi; ++ph) { KParamsPtr q = pp; asm volatile("" : "+s"(q)); Params P; for (int i_ = 0; i_ < (int)(sizeof(Params) / 8); ++i_) ((unsigned long long*)&P)[i_] = ((const __attribute__((address_space(4))) unsigned long long*)q)[i_]; run_phase(P, ph, lds); }
#else
  cg::grid_group grid = cg::this_grid();
  volatile LAS unsigned* xst = (volatile LAS unsigned*)(lds + (LDS_BYTES - 16));
  if (threadIdx.x == 0) { xst[0] = 0u; xst[1] = 0u; xst[2] = 0u; xst[3] = 0u; }
  __syncthreads();
  XcdBarrier xb = xcd_barrier_post((unsigned*)(pp->ws + OFF_BAR), xst);
  const unsigned rep_mask = (unsigned)pp->rep_mask;
  bool first_sync = true;
  for (int ph = lo; ph < hi; ++ph) {
    const int reps = 1 + (int)((rep_mask >> ph) & 1u);
    for (int rp = 0; rp < reps; ++rp) {
      {
        KParamsPtr q = pp;
        asm volatile("" : "+s"(q));
        Params P;
        {
          typedef __attribute__((address_space(1))) const float* GF;
          const float** dp = (const float**)&P;
          const __attribute__((address_space(4))) unsigned long long* sp = (const __attribute__((address_space(4))) unsigned long long*)q;
#pragma unroll
          for (int i_ = 0; i_ < 30; ++i_) dp[i_] = (const float*)(GF)(sp[i_]);
          P.out = (float*)(__attribute__((address_space(1))) float*)(sp[30]);
          P.ws = (char*)(__attribute__((address_space(1))) char*)(sp[31]);
          P.ph_lo = 0; P.ph_hi = 0; P.rep_mask = 0;
        }
        run_phase(P, ph, lds);
      }
      if (ph + 1 < hi || rp + 1 < reps) {
        if (first_sync) { grid.sync(); first_sync = false; }
        else xcd_barrier(xb);
      }
    }
  }
#endif
#endif
}

extern "C" void kernel_launch(void* const* d_in, const int* in_sizes, int n_in, void* d_out, int out_size, void* d_ws,
                              size_t ws_size, hipStream_t stream) {
  static int grid_blocks = 0;
  if (grid_blocks == 0) {
    if (n_in != 30 || out_size != 16384 * 1024 || ws_size < WS_NEED) {
      fprintf(stderr, "kernel_launch: unexpected shapes: n_in %d out %d ws %zu (need %zu)\n", n_in, out_size, ws_size, (size_t)WS_NEED);
      grid_blocks = -1;
      return;
    }
    int dev = 0, cus = 0, per_cu = 0;
    hipGetDevice(&dev);
    hipDeviceGetAttribute(&cus, hipDeviceAttributeMultiprocessorCount, dev);
    if (hipFuncSetAttribute((const void*)fwd_megakernel, hipFuncAttributeMaxDynamicSharedMemorySize, LDS_BYTES) != hipSuccess) {
      fprintf(stderr, "kernel_launch: hipFuncSetAttribute failed\n");
      grid_blocks = -1;
      return;
    }
    if (hipOccupancyMaxActiveBlocksPerMultiprocessor(&per_cu, (const void*)fwd_megakernel, NT, LDS_BYTES) != hipSuccess || per_cu < 1) {
      fprintf(stderr, "kernel_launch: occupancy query failed / zero (%d)\n", per_cu);
      grid_blocks = -1;
      return;
    }
    grid_blocks = cus;
    if (grid_blocks < 64) { fprintf(stderr, "kernel_launch: too few CUs (%d)\n", cus); grid_blocks = -1; return; }
  }
  if (grid_blocks < 0) return;
  (void)hipMemsetAsync((char*)d_ws + OFF_BAR, 0, XCD_BAR_WORDS * sizeof(unsigned), stream);
  Params p{};
  const float** pp = (const float**)&p;
  for (int i = 0; i < 30; ++i) pp[i] = (const float*)d_in[i];
  p.out = (float*)d_out;
  p.ws = (char*)d_ws;
#if MULTI_LAUNCH
  for (int ph = 0; ph < 16; ++ph) {
    p.ph_lo = ph; p.ph_hi = ph + 1;
    hipLaunchKernelGGL(fwd_megakernel, dim3(grid_blocks), dim3(NT), LDS_BYTES, stream, p);
  }
#else
  p.ph_lo = 0; p.ph_hi = 16;
#ifdef REPEAT_MASK
  p.rep_mask = REPEAT_MASK;
#endif
  void* args[] = {&p};
  hipError_t e = hipLaunchCooperativeKernel((const void*)fwd_megakernel, dim3(grid_blocks), dim3(NT), args, LDS_BYTES, stream);
  if (e != hipSuccess) fprintf(stderr, "cooperative launch failed: %s (grid %d)\n", hipGetErrorString(e), grid_blocks);
#endif
}
```

```cpp
#include <hip/hip_runtime.h>
#include <hip/hip_cooperative_groups.h>
#include <cstdio>
#include <cstdint>
namespace cg = cooperative_groups;

#ifndef MULTI_LAUNCH
#define MULTI_LAUNCH 0
#endif

typedef unsigned short u16;
typedef __attribute__((ext_vector_type(8))) short bf16x8;
typedef __attribute__((ext_vector_type(4))) float f32x4;
typedef __attribute__((ext_vector_type(16))) float f32x16;
typedef __attribute__((ext_vector_type(4))) unsigned int u32x4;
typedef __attribute__((ext_vector_type(2))) unsigned int u32x2;

#define NT 512
constexpr int LDS_BYTES = 131072 + 1024;
constexpr int NPHASE = 18;

constexpr size_t OFF_WT_IN   = 0;
constexpr size_t OFF_WT_AOUT = 9699328;
constexpr size_t OFF_WT_GLU  = 10747904;
constexpr size_t OFF_WT_BOUT = 11796480;
constexpr size_t OFF_WT_O    = 12845056;
constexpr size_t OFF_WT_UP   = 14942208;
constexpr size_t OFF_WT_DOWN = 26476544;
constexpr size_t OFF_MOD     = 32243712;
constexpr size_t OFF_BAR     = 32505856;
constexpr size_t OFF_R2      = 33554432;
constexpr size_t OFF_R1      = 69206016;
constexpr size_t OFF_KTAB    = OFF_R1;
constexpr size_t OFF_MEND    = OFF_R1 + 2097152;
constexpr size_t OFF_MST     = OFF_R1 + 10485760;
constexpr size_t OFF_MINTRA  = OFF_R1 + 18874368;
constexpr size_t OFF_R3      = 104857600;
constexpr size_t OFF_O       = OFF_R3;
constexpr size_t OFF_XIN     = OFF_R3 + 33554432;
constexpr size_t OFF_MIX     = 158334976;
constexpr size_t OFF_SG      = OFF_R1;
constexpr size_t OFF_Z       = 158334976;
constexpr size_t OFF_U5      = 175112192;
constexpr size_t OFF_BA      = 192937984;
constexpr size_t OFF_GC      = OFF_BA + 1179648;
constexpr size_t OFF_UF      = 195035136;
constexpr size_t OFF_YA      = OFF_UF;
constexpr size_t OFF_YB      = OFF_UF + 16777216;
constexpr size_t OFF_E       = 230686720;
constexpr size_t OFF_YG      = OFF_E;
constexpr size_t OFF_UPH     = OFF_R1;
constexpr size_t OFF_G       = 161480704;
constexpr size_t WS_NEED     = 253755392;
constexpr size_t OFF_QKN     = 0;
constexpr size_t OFF_AQ      = 35651584;

struct Params {
  const float *x, *c, *ctx, *c_ctx, *w_ada, *b_ada, *norm1_w, *w_in, *dn_conv_w, *dn_a_log, *dn_dt_bias, *dn_norm_w,
      *w_a_out, *s5_a_re, *s5_a_im, *s5_log_step, *s5_b_re, *s5_b_im, *s5_c_re, *s5_c_im, *s5_d, *w_glu, *b_glu,
      *w_b_out, *w_o, *norm2_w, *w_up, *ffn_conv_w, *w_down, *norm_f_w;
  float* out;
  char* ws;
  long long ph_lo, ph_hi;
  long long rep_mask;
};

#define XB_TMO      128
#define XB_XCNT(j)  (256  + 64 * (j))
#define XB_XSUB(j)  (1280 + 64 * (j))
#define XB_XGEN(j)  (2304 + 64 * (j))
#define XB_TOP      3328
#define XB_TOPGEN   3392
#define XCD_BAR_WORDS 3456
#define XB_SPIN_CAP (1u << 18)
#define LAS __attribute__((address_space(3)))

__device__ __forceinline__ unsigned xb_ld(unsigned* p)              { return __hip_atomic_load(p, __ATOMIC_RELAXED, __HIP_MEMORY_SCOPE_AGENT); }
__device__ __forceinline__ unsigned xb_add(unsigned* p, unsigned v) { return __hip_atomic_fetch_add(p, v, __ATOMIC_RELAXED, __HIP_MEMORY_SCOPE_AGENT); }
__device__ __forceinline__ unsigned xb_xcc_id() { return (unsigned)__builtin_amdgcn_s_getreg((3 << 11) | 20) & 0xFu; }
#define XB_SPIN(cond, bar) do { unsigned _sp = 0; while (cond) { __builtin_amdgcn_s_sleep(1); \
    if ((++_sp & 255u) == 0u) { if (xb_ld(&(bar)[XB_TMO])) break; if (_sp > XB_SPIN_CAP) { atomicAdd(&(bar)[XB_TMO], 1u); break; } } } } while (0)

struct XcdBarrier {
    unsigned* bar; unsigned x;
    volatile LAS unsigned* st;
};

__device__ __forceinline__ XcdBarrier xcd_barrier_post(unsigned* bar, volatile LAS unsigned* st) {
    XcdBarrier b; b.bar = bar; b.x = xb_xcc_id(); b.st = st;
    if (threadIdx.x == 0) (void)xb_add(&bar[XB_XCNT(b.x)], 1u);
    return b;
}
__device__ __forceinline__ void xcd_barrier_complete(unsigned* bar, unsigned x, unsigned& nloc, unsigned& nx) {
    const unsigned G = gridDim.x * gridDim.y * gridDim.z;
    unsigned sum, cnt, mine, sp = 0u;
    for (;;) {
        sum = 0u; cnt = 0u; mine = 0u;
#pragma unroll
        for (unsigned j = 0; j < 16; ++j) { const unsigned c = xb_ld(&bar[XB_XCNT(j)]); sum += c; cnt += (c > 0u) ? 1u : 0u; mine = (j == x) ? c : mine; }
        if (sum == G) break;
        __builtin_amdgcn_s_sleep(1);
        if ((++sp & 255u) == 0u) { if (xb_ld(&bar[XB_TMO])) break; if (sp > XB_SPIN_CAP) { atomicAdd(&bar[XB_TMO], 1u); break; } }
    }
    nloc = mine > 0u ? mine : 1u; nx = cnt > 0u ? cnt : 1u;
}

__device__ __forceinline__ void xcd_barrier(const XcdBarrier& b) {
    asm volatile("s_waitcnt vmcnt(0)" ::: "memory");
    __syncthreads();
    if (threadIdx.x == 0) {
        unsigned* bar = b.bar;
        __builtin_amdgcn_s_waitcnt(0);
        unsigned nloc = b.st[0], nx = b.st[1];
        if (nloc == 0u) { xcd_barrier_complete(bar, b.x, nloc, nx); b.st[0] = nloc; b.st[1] = nx; }
        const unsigned old = xb_add(&bar[XB_XSUB(b.x)], 1u);
        const unsigned gen = old / nloc;
        if (old + 1u == (gen + 1u) * nloc) {
            __builtin_amdgcn_fence(__ATOMIC_RELEASE, "agent");
            asm volatile("s_waitcnt vmcnt(0)" ::: "memory");
            const unsigned og = xb_add(&bar[XB_TOP], 1u);
            const unsigned tg = og / nx;
            if (og + 1u == (tg + 1u) * nx) xb_add(&bar[XB_TOPGEN], 1u);
            else XB_SPIN(xb_ld(&bar[XB_TOPGEN]) == tg, bar);
            __builtin_amdgcn_fence(__ATOMIC_ACQUIRE, "agent");
            xb_add(&bar[XB_XGEN(b.x)], 1u);
            asm volatile("s_waitcnt vmcnt(0)" ::: "memory");
        } else {
            XB_SPIN(xb_ld(&bar[XB_XGEN(b.x)]) == gen, bar);
            __builtin_amdgcn_fence(__ATOMIC_ACQUIRE, "agent");
            asm volatile("s_waitcnt vmcnt(0)" ::: "memory");
        }
    }
    __syncthreads();
}


typedef __attribute__((ext_vector_type(2))) float f32x2_t;
typedef __attribute__((ext_vector_type(2))) __bf16 bf16x2_t;
__device__ __forceinline__ u16 f2bf(float f) {
  const __bf16 h = (__bf16)f;
  return __builtin_bit_cast(u16, h);
}
__device__ __forceinline__ float bf2f(u16 h) { return __uint_as_float(((uint32_t)h) << 16); }
__device__ __forceinline__ uint32_t pack2(float a, float b) {
  const f32x2_t v = {a, b};
  const bf16x2_t r = __builtin_convertvector(v, bf16x2_t);
  return __builtin_bit_cast(uint32_t, r);
}
__device__ __forceinline__ float lo16(uint32_t w) { return __uint_as_float(w << 16); }
__device__ __forceinline__ float hi16(uint32_t w) { return __uint_as_float(w & 0xffff0000u); }
__device__ __forceinline__ int opq(int v) { asm volatile("" : "+v"(v)); return v; }
__device__ __forceinline__ void lds_barrier() {
  asm volatile("s_waitcnt lgkmcnt(0)" ::: "memory");
  __builtin_amdgcn_s_barrier();
  asm volatile("" ::: "memory");
}
__device__ __forceinline__ float sigm(float x) { return 1.f / (1.f + __expf(-x)); }
__device__ __forceinline__ void unpack8(uint4 v, float* f) {
  f[0] = lo16(v.x); f[1] = hi16(v.x); f[2] = lo16(v.y); f[3] = hi16(v.y);
  f[4] = lo16(v.z); f[5] = hi16(v.z); f[6] = lo16(v.w); f[7] = hi16(v.w);
}
__device__ __forceinline__ uint4 pack8(const float* f) {
  uint4 v; v.x = pack2(f[0], f[1]); v.y = pack2(f[2], f[3]); v.z = pack2(f[4], f[5]); v.w = pack2(f[6], f[7]);
  return v;
}
__device__ __forceinline__ float wsum64(float v) {
#pragma unroll
  for (int o = 32; o > 0; o >>= 1) v += __shfl_xor(v, o, 64);
  return v;
}
__device__ __forceinline__ float gelu_tanh(float x) {
  float u = 0.7978845608028654f * (x + 0.044715f * x * x * x);
  float t = 1.f - 2.f / (1.f + __expf(2.f * u));
  return 0.5f * x * (1.f + t);
}

__device__ __forceinline__ void g_frag(const u16* as, const u16* bs, int ks, bf16x8 (&a)[2], bf16x8 (&b)[2]) {
  a[0] = *(const bf16x8*)(as + ks * 16);
  a[1] = *(const bf16x8*)(as + 32 * 72 + ks * 16);
  b[0] = *(const bf16x8*)(bs + ks * 16);
  b[1] = *(const bf16x8*)(bs + 32 * 72 + ks * 16);
}
__device__ __forceinline__ void g_mma(const bf16x8 (&a)[2], const bf16x8 (&b)[2], f32x16 (&acc)[2][2]) {
  acc[0][0] = __builtin_amdgcn_mfma_f32_32x32x16_bf16(a[0], b[0], acc[0][0], 0, 0, 0);
  acc[0][1] = __builtin_amdgcn_mfma_f32_32x32x16_bf16(a[0], b[1], acc[0][1], 0, 0, 0);
  acc[1][0] = __builtin_amdgcn_mfma_f32_32x32x16_bf16(a[1], b[0], acc[1][0], 0, 0, 0);
  acc[1][1] = __builtin_amdgcn_mfma_f32_32x32x16_bf16(a[1], b[1], acc[1][1], 0, 0, 0);
}
__device__ __forceinline__ void gemm_main(const u16* __restrict__ A, int lda, const u16* __restrict__ Bt, int ldb, int K,
                                          f32x16 (&acc)[2][2], u16* lds) {
  const int tid = opq(threadIdx.x), lane = tid & 63, w = tid >> 6, wm = w >> 1, wn = w & 1, fr = lane & 31, fq = lane >> 5;
  u16* As = lds;
  u16* Bs = lds + 2 * 256 * 72;
  const int nk = K >> 6;
  uint4 p0, p1, p2, p3, p4, p5;
  uint4 q0, q1, q2, q3, q4, q5;
  uint4 r0, r1, r2, r3, r4, r5;
  const int lr = tid >> 3, lc = (tid & 7) * 8;
  const unsigned oa0 = (unsigned)(lr * lda + lc) * 2u, sa2 = (unsigned)lda * 128u;
  const unsigned oa1 = oa0 + sa2, oa2 = oa0 + 2u * sa2, oa3 = oa0 + 3u * sa2;
  const unsigned ob0 = (unsigned)(lr * ldb + lc) * 2u, ob1 = ob0 + (unsigned)ldb * 128u;
#define G_LOAD(S, kt_)                                          \
  {                                                             \
    const int kc_ = ((kt_) < nk) ? (kt_) : (nk - 1);            \
    const char* a_ = (const char*)A + kc_ * 128;                \
    const char* b_ = (const char*)Bt + kc_ * 128;               \
    S##0 = *(const uint4*)(a_ + oa0);                           \
    S##1 = *(const uint4*)(a_ + oa1);                           \
    S##2 = *(const uint4*)(a_ + oa2);                           \
    S##3 = *(const uint4*)(a_ + oa3);                           \
    S##4 = *(const uint4*)(b_ + ob0);                           \
    S##5 = *(const uint4*)(b_ + ob1);                           \
  }
#define G_STORE(S, buf_)                                                     \
  {                                                                          \
    u16* as_ = As + ((buf_) * 256 + lr) * 72 + lc;                           \
    u16* bs_ = Bs + ((buf_) * 128 + lr) * 72 + lc;                           \
    *(uint4*)(as_) = S##0;                                                   \
    *(uint4*)(as_ + 64 * 72) = S##1;                                         \
    *(uint4*)(as_ + 128 * 72) = S##2;                                        \
    *(uint4*)(as_ + 192 * 72) = S##3;                                        \
    *(uint4*)(bs_) = S##4;                                                   \
    *(uint4*)(bs_ + 64 * 72) = S##5;                                         \
  }
#define G_STEP(S, BUF, kt_)                                                               \
  {                                                                                       \
    const u16* as = As + ((BUF) * 256 + wm * 64 + fr) * 72 + fq * 8;                      \
    const u16* bs = Bs + ((BUF) * 128 + wn * 64 + fr) * 72 + fq * 8;                      \
    bf16x8 fa0[2], fb0[2], fa1[2], fb1[2], fa2[2], fb2[2];                                \
    g_frag(as, bs, 0, fa0, fb0);                                                          \
    g_frag(as, bs, 1, fa1, fb1);                                                          \
    __builtin_amdgcn_sched_barrier(0);                                                    \
    G_STORE(S, (BUF) ^ 1)                                                                 \
    G_LOAD(S, (kt_) + 4)                                                                  \
    __builtin_amdgcn_sched_barrier(0);                                                    \
    g_frag(as, bs, 2, fa2, fb2);                                                          \
    __builtin_amdgcn_sched_barrier(0);                                                    \
    g_mma(fa0, fb0, acc);                                                                 \
    __builtin_amdgcn_sched_barrier(0);                                                    \
    g_frag(as, bs, 3, fa0, fb0);                                                          \
    __builtin_amdgcn_sched_barrier(0);                                                    \
    g_mma(fa1, fb1, acc);                                                                 \
    g_mma(fa2, fb2, acc);                                                                 \
    g_mma(fa0, fb0, acc);                                                                 \
    lds_barrier();                                                                      \
  }
  G_LOAD(p, 0)
  lds_barrier();
  G_STORE(p, 0)
  G_LOAD(q, 1)
  G_LOAD(r, 2)
  G_LOAD(p, 3)
  lds_barrier();
  for (int kt = 0; kt < nk; kt += 6) {
    G_STEP(q, 0, kt)
    G_STEP(r, 1, kt + 1)
    if (kt + 2 < nk) {
      G_STEP(p, 0, kt + 2)
      G_STEP(q, 1, kt + 3)
    }
    if (kt + 4 < nk) {
      G_STEP(r, 0, kt + 4)
      G_STEP(p, 1, kt + 5)
    }
  }
#undef G_STEP
#undef G_LOAD
#undef G_STORE
}

__device__ __forceinline__ void acc_zero(f32x16 (&acc)[2][2]) {
#pragma unroll
  for (int i = 0; i < 2; ++i)
#pragma unroll
    for (int j = 0; j < 2; ++j)
#pragma unroll
      for (int e = 0; e < 16; ++e) acc[i][j][e] = 0.f;
}

#define TILE_COORDS                                                                                  \
  const int tid_ = opq(threadIdx.x), lane_ = tid_ & 63, w_ = __builtin_amdgcn_readfirstlane(tid_ >> 6), \
            wm_ = w_ >> 1, wn_ = w_ & 1, fr_ = lane_ & 31, fq_ = lane_ >> 5;
#define TROW(m0, i, e) ((m0) + wm_ * 64 + (i) * 32 + ((e) & 3) + 8 * ((e) >> 2) + 4 * fq_)
#define TCOL(n0, j) ((n0) + wn_ * 64 + (j) * 32 + fr_)
#define TIDX2(m0, cb, i, e, ld) ((size_t)((m0) + wm_ * 64 + (i) * 32 + ((e) & 3) + 8 * ((e) >> 2)) * (ld) + (cb) + (size_t)(unsigned)(4 * fq_ * (ld) + fr_))
#define TIDX(m0, n0, i, j, e, ld) TIDX2(m0, (n0) + wn_ * 64 + (j) * 32, i, e, ld)

__device__ __forceinline__ int srccol(int which, int r) {
  switch (which) {
    case 0:
      if (r < 2048) return r;
      if (r < 2560) return 2064 + (r - 2048);
      if (r < 2576) return 2048 + (r - 2560);
      if (r < 2688) return -1;
      if (r < 3712) return 2576 + (r - 2688);
      return 3600 + (r - 3712);
    case 2: {
      int tile = r >> 7, wn = (r >> 6) & 1, wi = r & 63;
      return (wi < 32) ? (tile * 64 + wn * 32 + wi) : (512 + tile * 64 + wn * 32 + (wi - 32));
    }
    case 5: {
      int hh = r / 2816, cc = r % 2816;
      return (cc < 1408) ? (hh * 1408 + cc) : (2816 + hh * 1408 + (cc - 1408));
    }
    default: return r;
  }
}

__device__ __forceinline__ void convert_item(const float* __restrict__ src, int K, int N, u16* __restrict__ dst, int which, int item, char* lds) {
  float* tile = (float*)lds;
  const int tid = opq(threadIdx.x);
  const int kb = K >> 8;
  const int r0 = (item / kb) * 64, k0 = (item % kb) * 256;
  lds_barrier();
  {
    const int n4 = (tid & 15) * 4, kk = tid >> 4;
    const int sc = srccol(which, r0 + n4);
    float4 v[8];
#pragma unroll
    for (int it = 0; it < 8; ++it) {
      const int k = kk + 32 * it;
      v[it] = (sc >= 0) ? *(const float4*)(src + (size_t)(k0 + k) * N + sc) : make_float4(0.f, 0.f, 0.f, 0.f);
    }
#pragma unroll
    for (int it = 0; it < 8; ++it) {
      const int k = kk + 32 * it;
      tile[(n4 + 0) * 257 + k] = v[it].x; tile[(n4 + 1) * 257 + k] = v[it].y;
      tile[(n4 + 2) * 257 + k] = v[it].z; tile[(n4 + 3) * 257 + k] = v[it].w;
    }
  }
  lds_barrier();
  {
    const int ks = (tid & 31) * 8, rr = tid >> 5;
#pragma unroll
    for (int it = 0; it < 4; ++it) {
      const int row = rr + 16 * it;
      float f[8];
#pragma unroll
      for (int e = 0; e < 8; ++e) f[e] = tile[row * 257 + ks + e];
      *(uint4*)(dst + (size_t)(r0 + row) * K + k0 + ks) = pack8(f);
    }
  }
}

__device__ __forceinline__ void mod_item(const Params& P, int item, char* lds) {
  float* sc = (float*)lds;
  float* red = sc + 5 * 1024;
  const int tid = opq(threadIdx.x);
  lds_barrier();
  for (int i = tid; i < 5 * 1024; i += NT) {
    const int r = i >> 10, k = i & 1023;
    float v = (r < 4) ? P.c[r * 1024 + k] : P.c_ctx[k];
    sc[i] = v * sigm(v);
  }
  lds_barrier();
  const int nn = tid & 31, kg = tid >> 5;
  const int n = item * 32 + nn;
  float a0 = 0, a1 = 0, a2 = 0, a3 = 0, a4 = 0;
  for (int kk = 0; kk < 64; ++kk) {
    const int k = kg * 64 + kk;
    const float wv = P.w_ada[(size_t)k * 6144 + n];
    a0 += sc[k] * wv; a1 += sc[1024 + k] * wv; a2 += sc[2048 + k] * wv; a3 += sc[3072 + k] * wv; a4 += sc[4096 + k] * wv;
  }
  red[(kg * 5 + 0) * 32 + nn] = a0; red[(kg * 5 + 1) * 32 + nn] = a1; red[(kg * 5 + 2) * 32 + nn] = a2;
  red[(kg * 5 + 3) * 32 + nn] = a3; red[(kg * 5 + 4) * 32 + nn] = a4;
  lds_barrier();
  if (tid < 160) {
    const int r = tid >> 5, n2 = tid & 31;
    float s = 0.f;
#pragma unroll
    for (int g = 0; g < 16; ++g) s += red[(g * 5 + r) * 32 + n2];
    float* MOD = (float*)(P.ws + OFF_MOD);
    MOD[r * 6144 + item * 32 + n2] = s + P.b_ada[item * 32 + n2];
  }
}

__device__ __forceinline__ void lam_pow(float step, float are, float aim, int e, float& pr, float& pi) {
  const float mag = expf((float)e * step * are);
  double ang = (double)e * (double)step * (double)aim;
  ang -= 6.283185307179586476925 * rint(ang * 0.15915494309189533577);
  float s, c;
  __sincosf((float)ang, &s, &c);
  pr = mag * c; pi = mag * s;
}

__device__ __forceinline__ void s5tab_item(const Params& P, int item, char* lds) {
  const int tid = opq(threadIdx.x);
  const int tau = item & 31, g = (item >> 5) & 31, r = item >> 10;
  float* cfr = (float*)lds;
  float* cfi = cfr + 64;
  float* p0r = cfi + 64;
  float* p0i = p0r + 64;
  float* p1r = p0i + 64;
  float* p1i = p1r + 64;
  float* Gr = p1i + 64;
  float* Gi = Gr + 1024;
  float* Cr = Gi + 1024;
  float* Ci = Cr + 1024;
  const int rg = r * 32 + g;
  lds_barrier();
  if (tid < 64) {
    const int n = tid;
    const float step = expf(P.s5_log_step[rg]);
    const float are = P.s5_a_re[rg * 64 + n], aim = P.s5_a_im[rg * 64 + n];
    const float za = step * are;
    double zb = (double)step * (double)aim;
    zb -= 6.283185307179586476925 * rint(zb * 0.15915494309189533577);
    float sb, cb, sh, ch;
    __sincosf((float)zb, &sb, &cb);
    __sincosf((float)(0.5 * zb), &sh, &ch);
    const float em1 = expm1f(za);
    const float re1 = em1 * cb - 2.f * sh * sh;
    const float im1 = (1.f + em1) * sb;
    const float den = are * are + aim * aim;
    cfr[n] = (re1 * are + im1 * aim) / den;
    cfi[n] = (im1 * are - re1 * aim) / den;
    float pr, pi;
    lam_pow(step, are, aim, tau, pr, pi);
    p0r[n] = pr; p0i[n] = pi;
    lam_pow(step, are, aim, tau + 1, pr, pi);
    p1r[n] = pr; p1i[n] = pi;
  }
  for (int i = tid; i < 1024; i += NT) {
    Cr[i] = P.s5_c_re[(size_t)rg * 1024 + i];
    Ci[i] = P.s5_c_im[(size_t)rg * 1024 + i];
  }
  lds_barrier();
  for (int i = tid; i < 1024; i += NT) {
    const int n = i >> 4;
    const float br = P.s5_b_re[(size_t)rg * 1024 + i], bi = P.s5_b_im[(size_t)rg * 1024 + i];
    const float tr = cfr[n] * br - cfi[n] * bi, ti = cfr[n] * bi + cfi[n] * br;
    Gr[i] = p0r[n] * tr - p0i[n] * ti;
    Gi[i] = p0r[n] * ti + p0i[n] * tr;
  }
  lds_barrier();
  u16* MEND = (u16*)(P.ws + OFF_MEND);
  u16* MST = (u16*)(P.ws + OFF_MST);
  float* KTAB = (float*)(P.ws + OFF_KTAB);
  {
    const int ii = (r == 0) ? (31 - tau) : tau;
    for (int i = tid; i < 2048; i += NT) {
      const int part = i >> 10, n = (i >> 4) & 63, pi_ = i & 15;
      const float v = part ? Gi[n * 16 + pi_] : Gr[n * 16 + pi_];
      MEND[((size_t)g * 256 + r * 128 + part * 64 + n) * 512 + ii * 16 + pi_] = f2bf(v);
    }
  }
  if (tid < 256) {
    const int po = tid >> 4, pi_ = tid & 15;
    float s = 0.f;
    for (int n = 0; n < 64; ++n) s += Cr[po * 64 + n] * Gr[n * 16 + pi_] - Ci[po * 64 + n] * Gi[n * 16 + pi_];
    KTAB[(((size_t)rg) * 32 + tau) * 256 + tid] = s;
  }
  {
    const int jj = (r == 0) ? tau : (31 - tau);
    for (int i = tid; i < 2048; i += NT) {
      const int po = i >> 7, part = (i >> 6) & 1, n = i & 63;
      const float cr = Cr[po * 64 + n], ci = Ci[po * 64 + n];
      const float v = part ? -(cr * p1i[n] + ci * p1r[n]) : (cr * p1r[n] - ci * p1i[n]);
      MST[((size_t)g * 512 + jj * 16 + po) * 256 + r * 128 + part * 64 + n] = f2bf(v);
    }
  }
}

__device__ __forceinline__ void norm_row(const float* __restrict__ xr, const float* __restrict__ nw, const float* __restrict__ shift,
                                         const float* __restrict__ scale, u16* __restrict__ dst, int lane) {
  float4 v[4];
  float ss = 0.f;
#pragma unroll
  for (int it = 0; it < 4; ++it) {
    v[it] = *(const float4*)(xr + (it * 64 + lane) * 4);
    ss += v[it].x * v[it].x + v[it].y * v[it].y + v[it].z * v[it].z + v[it].w * v[it].w;
  }
  ss = wsum64(ss);
  const float rstd = rsqrtf(ss * (1.f / 1024.f) + 1e-6f);
#pragma unroll
  for (int it = 0; it < 4; ++it) {
    const int c = (it * 64 + lane) * 4;
    const float4 w4 = *(const float4*)(nw + c), sh = *(const float4*)(shift + c), sc = *(const float4*)(scale + c);
    const float y0 = v[it].x * rstd * w4.x * (1.f + sc.x) + sh.x;
    const float y1 = v[it].y * rstd * w4.y * (1.f + sc.y) + sh.y;
    const float y2 = v[it].z * rstd * w4.z * (1.f + sc.z) + sh.z;
    const float y3 = v[it].w * rstd * w4.w * (1.f + sc.w) + sh.w;
    uint2 o; o.x = pack2(y0, y1); o.y = pack2(y2, y3);
    *(uint2*)(dst + c) = o;
  }
}

__device__ __forceinline__ void norm_row2(const float* __restrict__ xa, const float* __restrict__ xb, const float* __restrict__ nw,
                                          const float* __restrict__ shA, const float* __restrict__ scA,
                                          const float* __restrict__ shB, const float* __restrict__ scB,
                                          u16* __restrict__ da, u16* __restrict__ db, int lane) {
  float4 va[4], vb[4];
#pragma unroll
  for (int it = 0; it < 4; ++it) { va[it] = *(const float4*)(xa + (it * 64 + lane) * 4); vb[it] = *(const float4*)(xb + (it * 64 + lane) * 4); }
  float sa = 0.f, sb = 0.f;
#pragma unroll
  for (int it = 0; it < 4; ++it) {
    sa += va[it].x * va[it].x + va[it].y * va[it].y + va[it].z * va[it].z + va[it].w * va[it].w;
    sb += vb[it].x * vb[it].x + vb[it].y * vb[it].y + vb[it].z * vb[it].z + vb[it].w * vb[it].w;
  }
  sa = wsum64(sa); sb = wsum64(sb);
  const float ra = rsqrtf(sa * (1.f / 1024.f) + 1e-6f), rb = rsqrtf(sb * (1.f / 1024.f) + 1e-6f);
#pragma unroll
  for (int it = 0; it < 4; ++it) {
    const int c = (it * 64 + lane) * 4;
    const float4 w4 = *(const float4*)(nw + c);
    const float4 sh = *(const float4*)(shA + c), sc = *(const float4*)(scA + c);
    const float4 sh2 = *(const float4*)(shB + c), sc2 = *(const float4*)(scB + c);
    uint2 o;
    o.x = pack2(va[it].x * ra * w4.x * (1.f + sc.x) + sh.x, va[it].y * ra * w4.y * (1.f + sc.y) + sh.y);
    o.y = pack2(va[it].z * ra * w4.z * (1.f + sc.z) + sh.z, va[it].w * ra * w4.w * (1.f + sc.w) + sh.w);
    *(uint2*)(da + c) = o;
    o.x = pack2(vb[it].x * rb * w4.x * (1.f + sc2.x) + sh2.x, vb[it].y * rb * w4.y * (1.f + sc2.y) + sh2.y);
    o.y = pack2(vb[it].z * rb * w4.z * (1.f + sc2.z) + sh2.z, vb[it].w * rb * w4.w * (1.f + sc2.w) + sh2.w);
    *(uint2*)(db + c) = o;
  }
}

__device__ __forceinline__ void norm1_item(const Params& P, int item) {
  const int lane = opq(threadIdx.x) & 63, w = opq(threadIdx.x) >> 6;
  const int rowA = item * 16 + w, rowB = rowA + 8;
  const float* MOD = (const float*)(P.ws + OFF_MOD);
  const int ba = (rowA < 16384) ? (rowA >> 12) : 4, bb = (rowB < 16384) ? (rowB >> 12) : 4;
  const float* xa = (rowA < 16384) ? (P.x + (size_t)rowA * 1024) : (P.ctx + (size_t)(rowA - 16384) * 1024);
  const float* xb = (rowB < 16384) ? (P.x + (size_t)rowB * 1024) : (P.ctx + (size_t)(rowB - 16384) * 1024);
  u16* H = (u16*)(P.ws + OFF_R2);
  norm_row2(xa, xb, P.norm1_w, MOD + ba * 6144, MOD + ba * 6144 + 1024, MOD + bb * 6144, MOD + bb * 6144 + 1024,
            H + (size_t)rowA * 1024, H + (size_t)rowB * 1024, lane);
}

__device__ __forceinline__ void mintra_item(const Params& P, int item) {
  const int tid = opq(threadIdx.x);
  const int rowg = item * 8 + (tid >> 6);
  const int g = rowg >> 9, nout = rowg & 511, j = nout >> 4, po = nout & 15;
  const int k0 = (tid & 63) * 8, i = k0 >> 4, pi0 = k0 & 15;
  const float* KTAB = (const float*)(P.ws + OFF_KTAB);
  float f[8];
#pragma unroll
  for (int e = 0; e < 8; ++e) f[e] = 0.f;
  if (i <= j) {
    const float* kp = KTAB + (((size_t)(0 * 32 + g)) * 32 + (j - i)) * 256 + po * 16 + pi0;
#pragma unroll
    for (int e = 0; e < 8; ++e) f[e] += kp[e];
  }
  if (i >= j) {
    const float* kp = KTAB + (((size_t)(1 * 32 + g)) * 32 + (i - j)) * 256 + po * 16 + pi0;
#pragma unroll
    for (int e = 0; e < 8; ++e) f[e] += kp[e];
  }
  if (i == j) {
    const float dv = P.s5_d[g * 16 + po];
#pragma unroll
    for (int e = 0; e < 8; ++e) if (pi0 + e == po) f[e] += dv;
  }
  u16* MI = (u16*)(P.ws + OFF_MINTRA);
  *(uint4*)(MI + (size_t)rowg * 512 + k0) = pack8(f);
}

__device__ __forceinline__ void inproj_tile(const Params& P, int t, char* lds) {
  int mt, nt;
  if (t < 1344) { nt = t / 64; mt = t % 64; }
  else {
    const int tt = t - 1344; mt = 64 + (tt & 3);
    const int ni = tt >> 2;
    nt = (ni < 8) ? (4 + ni) : ((ni < 12) ? (16 + ni - 8) : 20);
  }
  const int m0 = mt * 256, n0 = nt * 128;
  f32x16 acc[2][2];
  acc_zero(acc);
  gemm_main((const u16*)(P.ws + OFF_R2) + (size_t)m0 * 1024, 1024, (const u16*)(P.ws + OFF_WT_IN) + (size_t)n0 * 1024, 1024, 1024, acc, (u16*)lds);
  TILE_COORDS
  if (nt < 12) {
    u16* QKV = (u16*)(P.ws + OFF_R3);
#pragma unroll
    for (int i = 0; i < 2; ++i)
#pragma unroll
      for (int j = 0; j < 2; ++j)
#pragma unroll
        for (int e = 0; e < 16; ++e) QKV[TIDX(m0, n0, i, j, e, 1536)] = f2bf(acc[i][j][e]);
  } else if (nt < 16) {
    u16* Z = (u16*)(P.ws + OFF_Z);
#pragma unroll
    for (int i = 0; i < 2; ++i)
#pragma unroll
      for (int j = 0; j < 2; ++j)
#pragma unroll
        for (int e = 0; e < 16; ++e) Z[TIDX(m0, n0, i, j, e, 512) - 1536] = f2bf(acc[i][j][e]);
  } else if (nt < 20) {
    u16* U5 = (u16*)(P.ws + OFF_U5);
#pragma unroll
    for (int i = 0; i < 2; ++i)
#pragma unroll
      for (int j = 0; j < 2; ++j)
#pragma unroll
        for (int e = 0; e < 16; ++e) {
          const int cc = TCOL(n0, j) - 2048;
          U5[((size_t)(cc >> 4) * 17408 + TROW(m0, i, e)) * 16 + (cc & 15)] = f2bf(acc[i][j][e]);
        }
  } else {
    float* BA = (float*)(P.ws + OFF_BA);
#pragma unroll
    for (int i = 0; i < 2; ++i)
#pragma unroll
      for (int j = 0; j < 2; ++j)
#pragma unroll
        for (int e = 0; e < 16; ++e) {
          const int cc = TCOL(n0, j) - 2560;
          if (cc < 16) BA[(size_t)TROW(m0, i, e) * 16 + cc] = acc[i][j][e];
        }
  }
}

__device__ __forceinline__ void solve_elim(float (&sol)[64], const float* Lr) {
  float4 b0a, b0b, b0c, b0d, b1a, b1b, b1c, b1d, b2a, b2b, b2c, b2d;
  b0a = *(const float4*)(Lr + 0); b0b = *(const float4*)(Lr + 4); b0c = *(const float4*)(Lr + 8); b0d = *(const float4*)(Lr + 12);
  b1a = *(const float4*)(Lr + 16); b1b = *(const float4*)(Lr + 20); b1c = *(const float4*)(Lr + 24); b1d = *(const float4*)(Lr + 28);
  b2a = *(const float4*)(Lr + 32); b2b = *(const float4*)(Lr + 36); b2c = *(const float4*)(Lr + 40); b2d = *(const float4*)(Lr + 44);
  __builtin_amdgcn_sched_barrier(0);
  sol[1] -= b0a.y * sol[0]; sol[2] -= b0a.z * sol[0]; sol[3] -= b0a.w * sol[0]; sol[4] -= b0b.x * sol[0]; sol[5] -= b0b.y * sol[0]; sol[6] -= b0b.z * sol[0]; sol[7] -= b0b.w * sol[0]; sol[8] -= b0c.x * sol[0]; sol[9] -= b0c.y * sol[0]; sol[10] -= b0c.z * sol[0]; sol[11] -= b0c.w * sol[0]; sol[12] -= b0d.x * sol[0]; sol[13] -= b0d.y * sol[0]; sol[14] -= b0d.z * sol[0]; sol[15] -= b0d.w * sol[0];
  __builtin_amdgcn_sched_barrier(0);
  b0a = *(const float4*)(Lr + 48); b0b = *(const float4*)(Lr + 52); b0c = *(const float4*)(Lr + 56); b0d = *(const float4*)(Lr + 60);
  __builtin_amdgcn_sched_barrier(0);
  sol[16] -= b1a.x * sol[0]; sol[17] -= b1a.y * sol[0]; sol[18] -= b1a.z * sol[0]; sol[19] -= b1a.w * sol[0]; sol[20] -= b1b.x * sol[0]; sol[21] -= b1b.y * sol[0]; sol[22] -= b1b.z * sol[0]; sol[23] -= b1b.w * sol[0]; sol[24] -= b1c.x * sol[0]; sol[25] -= b1c.y * sol[0]; sol[26] -= b1c.z * sol[0]; sol[27] -= b1c.w * sol[0]; sol[28] -= b1d.x * sol[0]; sol[29] -= b1d.y * sol[0]; sol[30] -= b1d.z * sol[0]; sol[31] -= b1d.w * sol[0];
  __builtin_amdgcn_sched_barrier(0);
  b1a = *(const float4*)(Lr + 64); b1b = *(const float4*)(Lr + 68); b1c = *(const float4*)(Lr + 72); b1d = *(const float4*)(Lr + 76);
  __builtin_amdgcn_sched_barrier(0);
  sol[32] -= b2a.x * sol[0]; sol[33] -= b2a.y * sol[0]; sol[34] -= b2a.z * sol[0]; sol[35] -= b2a.w * sol[0]; sol[36] -= b2b.x * sol[0]; sol[37] -= b2b.y * sol[0]; sol[38] -= b2b.z * sol[0]; sol[39] -= b2b.w * sol[0]; sol[40] -= b2c.x * sol[0]; sol[41] -= b2c.y * sol[0]; sol[42] -= b2c.z * sol[0]; sol[43] -= b2c.w * sol[0]; sol[44] -= b2d.x * sol[0]; sol[45] -= b2d.y * sol[0]; sol[46] -= b2d.z * sol[0]; sol[47] -= b2d.w * sol[0];
  __builtin_amdgcn_sched_barrier(0);
  b2a = *(const float4*)(Lr + 80); b2b = *(const float4*)(Lr + 84); b2c = *(const float4*)(Lr + 88); b2d = *(const float4*)(Lr + 92);
  __builtin_amdgcn_sched_barrier(0);
  sol[48] -= b0a.x * sol[0]; sol[49] -= b0a.y * sol[0]; sol[50] -= b0a.z * sol[0]; sol[51] -= b0a.w * sol[0]; sol[52] -= b0b.x * sol[0]; sol[53] -= b0b.y * sol[0]; sol[54] -= b0b.z * sol[0]; sol[55] -= b0b.w * sol[0]; sol[56] -= b0c.x * sol[0]; sol[57] -= b0c.y * sol[0]; sol[58] -= b0c.z * sol[0]; sol[59] -= b0c.w * sol[0]; sol[60] -= b0d.x * sol[0]; sol[61] -= b0d.y * sol[0]; sol[62] -= b0d.z * sol[0]; sol[63] -= b0d.w * sol[0];
  __builtin_amdgcn_sched_barrier(0);
  b0a = *(const float4*)(Lr + 96); b0b = *(const float4*)(Lr + 100); b0c = *(const float4*)(Lr + 104); b0d = *(const float4*)(Lr + 108);
  __builtin_amdgcn_sched_barrier(0);
  sol[2] -= b1a.z * sol[1]; sol[3] -= b1a.w * sol[1]; sol[4] -= b1b.x * sol[1]; sol[5] -= b1b.y * sol[1]; sol[6] -= b1b.z * sol[1]; sol[7] -= b1b.w * sol[1]; sol[8] -= b1c.x * sol[1]; sol[9] -= b1c.y * sol[1]; sol[10] -= b1c.z * sol[1]; sol[11] -= b1c.w * sol[1]; sol[12] -= b1d.x * sol[1]; sol[13] -= b1d.y * sol[1]; sol[14] -= b1d.z * sol[1]; sol[15] -= b1d.w * sol[1];
  __builtin_amdgcn_sched_barrier(0);
  b1a = *(const float4*)(Lr + 112); b1b = *(const float4*)(Lr + 116); b1c = *(const float4*)(Lr + 120); b1d = *(const float4*)(Lr + 124);
  __builtin_amdgcn_sched_barrier(0);
  sol[16] -= b2a.x * sol[1]; sol[17] -= b2a.y * sol[1]; sol[18] -= b2a.z * sol[1]; sol[19] -= b2a.w * sol[1]; sol[20] -= b2b.x * sol[1]; sol[21] -= b2b.y * sol[1]; sol[22] -= b2b.z * sol[1]; sol[23] -= b2b.w * sol[1]; sol[24] -= b2c.x * sol[1]; sol[25] -= b2c.y * sol[1]; sol[26] -= b2c.z * sol[1]; sol[27] -= b2c.w * sol[1]; sol[28] -= b2d.x * sol[1]; sol[29] -= b2d.y * sol[1]; sol[30] -= b2d.z * sol[1]; sol[31] -= b2d.w * sol[1];
  __builtin_amdgcn_sched_barrier(0);
  b2a = *(const float4*)(Lr + 128); b2b = *(const float4*)(Lr + 132); b2c = *(const float4*)(Lr + 136); b2d = *(const float4*)(Lr + 140);
  __builtin_amdgcn_sched_barrier(0);
  sol[32] -= b0a.x * sol[1]; sol[33] -= b0a.y * sol[1]; sol[34] -= b0a.z * sol[1]; sol[35] -= b0a.w * sol[1]; sol[36] -= b0b.x * sol[1]; sol[37] -= b0b.y * sol[1]; sol[38] -= b0b.z * sol[1]; sol[39] -= b0b.w * sol[1]; sol[40] -= b0c.x * sol[1]; sol[41] -= b0c.y * sol[1]; sol[42] -= b0c.z * sol[1]; sol[43] -= b0c.w * sol[1]; sol[44] -= b0d.x * sol[1]; sol[45] -= b0d.y * sol[1]; sol[46] -= b0d.z * sol[1]; sol[47] -= b0d.w * sol[1];
  __builtin_amdgcn_sched_barrier(0);
  b0a = *(const float4*)(Lr + 144); b0b = *(const float4*)(Lr + 148); b0c = *(const float4*)(Lr + 152); b0d = *(const float4*)(Lr + 156);
  __builtin_amdgcn_sched_barrier(0);
  sol[48] -= b1a.x * sol[1]; sol[49] -= b1a.y * sol[1]; sol[50] -= b1a.z * sol[1]; sol[51] -= b1a.w * sol[1]; sol[52] -= b1b.x * sol[1]; sol[53] -= b1b.y * sol[1]; sol[54] -= b1b.z * sol[1]; sol[55] -= b1b.w * sol[1]; sol[56] -= b1c.x * sol[1]; sol[57] -= b1c.y * sol[1]; sol[58] -= b1c.z * sol[1]; sol[59] -= b1c.w * sol[1]; sol[60] -= b1d.x * sol[1]; sol[61] -= b1d.y * sol[1]; sol[62] -= b1d.z * sol[1]; sol[63] -= b1d.w * sol[1];
  __builtin_amdgcn_sched_barrier(0);
  b1a = *(const float4*)(Lr + 160); b1b = *(const float4*)(Lr + 164); b1c = *(const float4*)(Lr + 168); b1d = *(const float4*)(Lr + 172);
  __builtin_amdgcn_sched_barrier(0);
  sol[3] -= b2a.w * sol[2]; sol[4] -= b2b.x * sol[2]; sol[5] -= b2b.y * sol[2]; sol[6] -= b2b.z * sol[2]; sol[7] -= b2b.w * sol[2]; sol[8] -= b2c.x * sol[2]; sol[9] -= b2c.y * sol[2]; sol[10] -= b2c.z * sol[2]; sol[11] -= b2c.w * sol[2]; sol[12] -= b2d.x * sol[2]; sol[13] -= b2d.y * sol[2]; sol[14] -= b2d.z * sol[2]; sol[15] -= b2d.w * sol[2];
  __builtin_amdgcn_sched_barrier(0);
  b2a = *(const float4*)(Lr + 176); b2b = *(const float4*)(Lr + 180); b2c = *(const float4*)(Lr + 184); b2d = *(const float4*)(Lr + 188);
  __builtin_amdgcn_sched_barrier(0);
  sol[16] -= b0a.x * sol[2]; sol[17] -= b0a.y * sol[2]; sol[18] -= b0a.z * sol[2]; sol[19] -= b0a.w * sol[2]; sol[20] -= b0b.x * sol[2]; sol[21] -= b0b.y * sol[2]; sol[22] -= b0b.z * sol[2]; sol[23] -= b0b.w * sol[2]; sol[24] -= b0c.x * sol[2]; sol[25] -= b0c.y * sol[2]; sol[26] -= b0c.z * sol[2]; sol[27] -= b0c.w * sol[2]; sol[28] -= b0d.x * sol[2]; sol[29] -= b0d.y * sol[2]; sol[30] -= b0d.z * sol[2]; sol[31] -= b0d.w * sol[2];
  __builtin_amdgcn_sched_barrier(0);
  b0a = *(const float4*)(Lr + 192); b0b = *(const float4*)(Lr + 196); b0c = *(const float4*)(Lr + 200); b0d = *(const float4*)(Lr + 204);
  __builtin_amdgcn_sched_barrier(0);
  sol[32] -= b1a.x * sol[2]; sol[33] -= b1a.y * sol[2]; sol[34] -= b1a.z * sol[2]; sol[35] -= b1a.w * sol[2]; sol[36] -= b1b.x * sol[2]; sol[37] -= b1b.y * sol[2]; sol[38] -= b1b.z * sol[2]; sol[39] -= b1b.w * sol[2]; sol[40] -= b1c.x * sol[2]; sol[41] -= b1c.y * sol[2]; sol[42] -= b1c.z * sol[2]; sol[43] -= b1c.w * sol[2]; sol[44] -= b1d.x * sol[2]; sol[45] -= b1d.y * sol[2]; sol[46] -= b1d.z * sol[2]; sol[47] -= b1d.w * sol[2];
  __builtin_amdgcn_sched_barrier(0);
  b1a = *(const float4*)(Lr + 208); b1b = *(const float4*)(Lr + 212); b1c = *(const float4*)(Lr + 216); b1d = *(const float4*)(Lr + 220);
  __builtin_amdgcn_sched_barrier(0);
  sol[48] -= b2a.x * sol[2]; sol[49] -= b2a.y * sol[2]; sol[50] -= b2a.z * sol[2]; sol[51] -= b2a.w * sol[2]; sol[52] -= b2b.x * sol[2]; sol[53] -= b2b.y * sol[2]; sol[54] -= b2b.z * sol[2]; sol[55] -= b2b.w * sol[2]; sol[56] -= b2c.x * sol[2]; sol[57] -= b2c.y * sol[2]; sol[58] -= b2c.z * sol[2]; sol[59] -= b2c.w * sol[2]; sol[60] -= b2d.x * sol[2]; sol[61] -= b2d.y * sol[2]; sol[62] -= b2d.z * sol[2]; sol[63] -= b2d.w * sol[2];
  __builtin_amdgcn_sched_barrier(0);
  b2a = *(const float4*)(Lr + 224); b2b = *(const float4*)(Lr + 228); b2c = *(const float4*)(Lr + 232); b2d = *(const float4*)(Lr + 236);
  __builtin_amdgcn_sched_barrier(0);
  sol[4] -= b0b.x * sol[3]; sol[5] -= b0b.y * sol[3]; sol[6] -= b0b.z * sol[3]; sol[7] -= b0b.w * sol[3]; sol[8] -= b0c.x * sol[3]; sol[9] -= b0c.y * sol[3]; sol[10] -= b0c.z * sol[3]; sol[11] -= b0c.w * sol[3]; sol[12] -= b0d.x * sol[3]; sol[13] -= b0d.y * sol[3]; sol[14] -= b0d.z * sol[3]; sol[15] -= b0d.w * sol[3];
  __builtin_amdgcn_sched_barrier(0);
  b0a = *(const float4*)(Lr + 240); b0b = *(const float4*)(Lr + 244); b0c = *(const float4*)(Lr + 248); b0d = *(const float4*)(Lr + 252);
  __builtin_amdgcn_sched_barrier(0);
  sol[16] -= b1a.x * sol[3]; sol[17] -= b1a.y * sol[3]; sol[18] -= b1a.z * sol[3]; sol[19] -= b1a.w * sol[3]; sol[20] -= b1b.x * sol[3]; sol[21] -= b1b.y * sol[3]; sol[22] -= b1b.z * sol[3]; sol[23] -= b1b.w * sol[3]; sol[24] -= b1c.x * sol[3]; sol[25] -= b1c.y * sol[3]; sol[26] -= b1c.z * sol[3]; sol[27] -= b1c.w * sol[3]; sol[28] -= b1d.x * sol[3]; sol[29] -= b1d.y * sol[3]; sol[30] -= b1d.z * sol[3]; sol[31] -= b1d.w * sol[3];
  __builtin_amdgcn_sched_barrier(0);
  b1a = *(const float4*)(Lr + 256); b1b = *(const float4*)(Lr + 260); b1c = *(const float4*)(Lr + 264); b1d = *(const float4*)(Lr + 268);
  __builtin_amdgcn_sched_barrier(0);
  sol[32] -= b2a.x * sol[3]; sol[33] -= b2a.y * sol[3]; sol[34] -= b2a.z * sol[3]; sol[35] -= b2a.w * sol[3]; sol[36] -= b2b.x * sol[3]; sol[37] -= b2b.y * sol[3]; sol[38] -= b2b.z * sol[3]; sol[39] -= b2b.w * sol[3]; sol[40] -= b2c.x * sol[3]; sol[41] -= b2c.y * sol[3]; sol[42] -= b2c.z * sol[3]; sol[43] -= b2c.w * sol[3]; sol[44] -= b2d.x * sol[3]; sol[45] -= b2d.y * sol[3]; sol[46] -= b2d.z * sol[3]; sol[47] -= b2d.w * sol[3];
  __builtin_amdgcn_sched_barrier(0);
  b2a = *(const float4*)(Lr + 272); b2b = *(const float4*)(Lr + 276); b2c = *(const float4*)(Lr + 280); b2d = *(const float4*)(Lr + 284);
  __builtin_amdgcn_sched_barrier(0);
  sol[48] -= b0a.x * sol[3]; sol[49] -= b0a.y * sol[3]; sol[50] -= b0a.z * sol[3]; sol[51] -= b0a.w * sol[3]; sol[52] -= b0b.x * sol[3]; sol[53] -= b0b.y * sol[3]; sol[54] -= b0b.z * sol[3]; sol[55] -= b0b.w * sol[3]; sol[56] -= b0c.x * sol[3]; sol[57] -= b0c.y * sol[3]; sol[58] -= b0c.z * sol[3]; sol[59] -= b0c.w * sol[3]; sol[60] -= b0d.x * sol[3]; sol[61] -= b0d.y * sol[3]; sol[62] -= b0d.z * sol[3]; sol[63] -= b0d.w * sol[3];
  __builtin_amdgcn_sched_barrier(0);
  b0a = *(const float4*)(Lr + 288); b0b = *(const float4*)(Lr + 292); b0c = *(const float4*)(Lr + 296); b0d = *(const float4*)(Lr + 300);
  __builtin_amdgcn_sched_barrier(0);
  sol[5] -= b1b.y * sol[4]; sol[6] -= b1b.z * sol[4]; sol[7] -= b1b.w * sol[4]; sol[8] -= b1c.x * sol[4]; sol[9] -= b1c.y * sol[4]; sol[10] -= b1c.z * sol[4]; sol[11] -= b1c.w * sol[4]; sol[12] -= b1d.x * sol[4]; sol[13] -= b1d.y * sol[4]; sol[14] -= b1d.z * sol[4]; sol[15] -= b1d.w * sol[4];
  __builtin_amdgcn_sched_barrier(0);
  b1a = *(const float4*)(Lr + 304); b1b = *(const float4*)(Lr + 308); b1c = *(const float4*)(Lr + 312); b1d = *(const float4*)(Lr + 316);
  __builtin_amdgcn_sched_barrier(0);
  sol[16] -= b2a.x * sol[4]; sol[17] -= b2a.y * sol[4]; sol[18] -= b2a.z * sol[4]; sol[19] -= b2a.w * sol[4]; sol[20] -= b2b.x * sol[4]; sol[21] -= b2b.y * sol[4]; sol[22] -= b2b.z * sol[4]; sol[23] -= b2b.w * sol[4]; sol[24] -= b2c.x * sol[4]; sol[25] -= b2c.y * sol[4]; sol[26] -= b2c.z * sol[4]; sol[27] -= b2c.w * sol[4]; sol[28] -= b2d.x * sol[4]; sol[29] -= b2d.y * sol[4]; sol[30] -= b2d.z * sol[4]; sol[31] -= b2d.w * sol[4];
  __builtin_amdgcn_sched_barrier(0);
  b2a = *(const float4*)(Lr + 320); b2b = *(const float4*)(Lr + 324); b2c = *(const float4*)(Lr + 328); b2d = *(const float4*)(Lr + 332);
  __builtin_amdgcn_sched_barrier(0);
  sol[32] -= b0a.x * sol[4]; sol[33] -= b0a.y * sol[4]; sol[34] -= b0a.z * sol[4]; sol[35] -= b0a.w * sol[4]; sol[36] -= b0b.x * sol[4]; sol[37] -= b0b.y * sol[4]; sol[38] -= b0b.z * sol[4]; sol[39] -= b0b.w * sol[4]; sol[40] -= b0c.x * sol[4]; sol[41] -= b0c.y * sol[4]; sol[42] -= b0c.z * sol[4]; sol[43] -= b0c.w * sol[4]; sol[44] -= b0d.x * sol[4]; sol[45] -= b0d.y * sol[4]; sol[46] -= b0d.z * sol[4]; sol[47] -= b0d.w * sol[4];
  __builtin_amdgcn_sched_barrier(0);
  b0a = *(const float4*)(Lr + 336); b0b = *(const float4*)(Lr + 340); b0c = *(const float4*)(Lr + 344); b0d = *(const float4*)(Lr + 348);
  __builtin_amdgcn_sched_barrier(0);
  sol[48] -= b1a.x * sol[4]; sol[49] -= b1a.y * sol[4]; sol[50] -= b1a.z * sol[4]; sol[51] -= b1a.w * sol[4]; sol[52] -= b1b.x * sol[4]; sol[53] -= b1b.y * sol[4]; sol[54] -= b1b.z * sol[4]; sol[55] -= b1b.w * sol[4]; sol[56] -= b1c.x * sol[4]; sol[57] -= b1c.y * sol[4]; sol[58] -= b1c.z * sol[4]; sol[59] -= b1c.w * sol[4]; sol[60] -= b1d.x * sol[4]; sol[61] -= b1d.y * sol[4]; sol[62] -= b1d.z * sol[4]; sol[63] -= b1d.w * sol[4];
  __builtin_amdgcn_sched_barrier(0);
  b1a = *(const float4*)(Lr + 352); b1b = *(const float4*)(Lr + 356); b1c = *(const float4*)(Lr + 360); b1d = *(const float4*)(Lr + 364);
  __builtin_amdgcn_sched_barrier(0);
  sol[6] -= b2b.z * sol[5]; sol[7] -= b2b.w * sol[5]; sol[8] -= b2c.x * sol[5]; sol[9] -= b2c.y * sol[5]; sol[10] -= b2c.z * sol[5]; sol[11] -= b2c.w * sol[5]; sol[12] -= b2d.x * sol[5]; sol[13] -= b2d.y * sol[5]; sol[14] -= b2d.z * sol[5]; sol[15] -= b2d.w * sol[5];
  __builtin_amdgcn_sched_barrier(0);
  b2a = *(const float4*)(Lr + 368); b2b = *(const float4*)(Lr + 372); b2c = *(const float4*)(Lr + 376); b2d = *(const float4*)(Lr + 380);
  __builtin_amdgcn_sched_barrier(0);
  sol[16] -= b0a.x * sol[5]; sol[17] -= b0a.y * sol[5]; sol[18] -= b0a.z * sol[5]; sol[19] -= b0a.w * sol[5]; sol[20] -= b0b.x * sol[5]; sol[21] -= b0b.y * sol[5]; sol[22] -= b0b.z * sol[5]; sol[23] -= b0b.w * sol[5]; sol[24] -= b0c.x * sol[5]; sol[25] -= b0c.y * sol[5]; sol[26] -= b0c.z * sol[5]; sol[27] -= b0c.w * sol[5]; sol[28] -= b0d.x * sol[5]; sol[29] -= b0d.y * sol[5]; sol[30] -= b0d.z * sol[5]; sol[31] -= b0d.w * sol[5];
  __builtin_amdgcn_sched_barrier(0);
  b0a = *(const float4*)(Lr + 384); b0b = *(const float4*)(Lr + 388); b0c = *(const float4*)(Lr + 392); b0d = *(const float4*)(Lr + 396);
  __builtin_amdgcn_sched_barrier(0);
  sol[32] -= b1a.x * sol[5]; sol[33] -= b1a.y * sol[5]; sol[34] -= b1a.z * sol[5]; sol[35] -= b1a.w * sol[5]; sol[36] -= b1b.x * sol[5]; sol[37] -= b1b.y * sol[5]; sol[38] -= b1b.z * sol[5]; sol[39] -= b1b.w * sol[5]; sol[40] -= b1c.x * sol[5]; sol[41] -= b1c.y * sol[5]; sol[42] -= b1c.z * sol[5]; sol[43] -= b1c.w * sol[5]; sol[44] -= b1d.x * sol[5]; sol[45] -= b1d.y * sol[5]; sol[46] -= b1d.z * sol[5]; sol[47] -= b1d.w * sol[5];
  __builtin_amdgcn_sched_barrier(0);
  b1a = *(const float4*)(Lr + 400); b1b = *(const float4*)(Lr + 404); b1c = *(const float4*)(Lr + 408); b1d = *(const float4*)(Lr + 412);
  __builtin_amdgcn_sched_barrier(0);
  sol[48] -= b2a.x * sol[5]; sol[49] -= b2a.y * sol[5]; sol[50] -= b2a.z * sol[5]; sol[51] -= b2a.w * sol[5]; sol[52] -= b2b.x * sol[5]; sol[53] -= b2b.y * sol[5]; sol[54] -= b2b.z * sol[5]; sol[55] -= b2b.w * sol[5]; sol[56] -= b2c.x * sol[5]; sol[57] -= b2c.y * sol[5]; sol[58] -= b2c.z * sol[5]; sol[59] -= b2c.w * sol[5]; sol[60] -= b2d.x * sol[5]; sol[61] -= b2d.y * sol[5]; sol[62] -= b2d.z * sol[5]; sol[63] -= b2d.w * sol[5];
  __builtin_amdgcn_sched_barrier(0);
  b2a = *(const float4*)(Lr + 416); b2b = *(const float4*)(Lr + 420); b2c = *(const float4*)(Lr + 424); b2d = *(const float4*)(Lr + 428);
  __builtin_amdgcn_sched_barrier(0);
  sol[7] -= b0b.w * sol[6]; sol[8] -= b0c.x * sol[6]; sol[9] -= b0c.y * sol[6]; sol[10] -= b0c.z * sol[6]; sol[11] -= b0c.w * sol[6]; sol[12] -= b0d.x * sol[6]; sol[13] -= b0d.y * sol[6]; sol[14] -= b0d.z * sol[6]; sol[15] -= b0d.w * sol[6];
  __builtin_amdgcn_sched_barrier(0);
  b0a = *(const float4*)(Lr + 432); b0b = *(const float4*)(Lr + 436); b0c = *(const float4*)(Lr + 440); b0d = *(const float4*)(Lr + 444);
  __builtin_amdgcn_sched_barrier(0);
  sol[16] -= b1a.x * sol[6]; sol[17] -= b1a.y * sol[6]; sol[18] -= b1a.z * sol[6]; sol[19] -= b1a.w * sol[6]; sol[20] -= b1b.x * sol[6]; sol[21] -= b1b.y * sol[6]; sol[22] -= b1b.z * sol[6]; sol[23] -= b1b.w * sol[6]; sol[24] -= b1c.x * sol[6]; sol[25] -= b1c.y * sol[6]; sol[26] -= b1c.z * sol[6]; sol[27] -= b1c.w * sol[6]; sol[28] -= b1d.x * sol[6]; sol[29] -= b1d.y * sol[6]; sol[30] -= b1d.z * sol[6]; sol[31] -= b1d.w * sol[6];
  __builtin_amdgcn_sched_barrier(0);
  b1a = *(const float4*)(Lr + 448); b1b = *(const float4*)(Lr + 452); b1c = *(const float4*)(Lr + 456); b1d = *(const float4*)(Lr + 460);
  __builtin_amdgcn_sched_barrier(0);
  sol[32] -= b2a.x * sol[6]; sol[33] -= b2a.y * sol[6]; sol[34] -= b2a.z * sol[6]; sol[35] -= b2a.w * sol[6]; sol[36] -= b2b.x * sol[6]; sol[37] -= b2b.y * sol[6]; sol[38] -= b2b.z * sol[6]; sol[39] -= b2b.w * sol[6]; sol[40] -= b2c.x * sol[6]; sol[41] -= b2c.y * sol[6]; sol[42] -= b2c.z * sol[6]; sol[43] -= b2c.w * sol[6]; sol[44] -= b2d.x * sol[6]; sol[45] -= b2d.y * sol[6]; sol[46] -= b2d.z * sol[6]; sol[47] -= b2d.w * sol[6];
  __builtin_amdgcn_sched_barrier(0);
  b2a = *(const float4*)(Lr + 464); b2b = *(const float4*)(Lr + 468); b2c = *(const float4*)(Lr + 472); b2d = *(const float4*)(Lr + 476);
  __builtin_amdgcn_sched_barrier(0);
  sol[48] -= b0a.x * sol[6]; sol[49] -= b0a.y * sol[6]; sol[50] -= b0a.z * sol[6]; sol[51] -= b0a.w * sol[6]; sol[52] -= b0b.x * sol[6]; sol[53] -= b0b.y * sol[6]; sol[54] -= b0b.z * sol[6]; sol[55] -= b0b.w * sol[6]; sol[56] -= b0c.x * sol[6]; sol[57] -= b0c.y * sol[6]; sol[58] -= b0c.z * sol[6]; sol[59] -= b0c.w * sol[6]; sol[60] -= b0d.x * sol[6]; sol[61] -= b0d.y * sol[6]; sol[62] -= b0d.z * sol[6]; sol[63] -= b0d.w * sol[6];
  __builtin_amdgcn_sched_barrier(0);
  b0a = *(const float4*)(Lr + 480); b0b = *(const float4*)(Lr + 484); b0c = *(const float4*)(Lr + 488); b0d = *(const float4*)(Lr + 492);
  __builtin_amdgcn_sched_barrier(0);
  sol[8] -= b1c.x * sol[7]; sol[9] -= b1c.y * sol[7]; sol[10] -= b1c.z * sol[7]; sol[11] -= b1c.w * sol[7]; sol[12] -= b1d.x * sol[7]; sol[13] -= b1d.y * sol[7]; sol[14] -= b1d.z * sol[7]; sol[15] -= b1d.w * sol[7];
  __builtin_amdgcn_sched_barrier(0);
  b1a = *(const float4*)(Lr + 496); b1b = *(const float4*)(Lr + 500); b1c = *(const float4*)(Lr + 504); b1d = *(const float4*)(Lr + 508);
  __builtin_amdgcn_sched_barrier(0);
  sol[16] -= b2a.x * sol[7]; sol[17] -= b2a.y * sol[7]; sol[18] -= b2a.z * sol[7]; sol[19] -= b2a.w * sol[7]; sol[20] -= b2b.x * sol[7]; sol[21] -= b2b.y * sol[7]; sol[22] -= b2b.z * sol[7]; sol[23] -= b2b.w * sol[7]; sol[24] -= b2c.x * sol[7]; sol[25] -= b2c.y * sol[7]; sol[26] -= b2c.z * sol[7]; sol[27] -= b2c.w * sol[7]; sol[28] -= b2d.x * sol[7]; sol[29] -= b2d.y * sol[7]; sol[30] -= b2d.z * sol[7]; sol[31] -= b2d.w * sol[7];
  __builtin_amdgcn_sched_barrier(0);
  b2a = *(const float4*)(Lr + 512); b2b = *(const float4*)(Lr + 516); b2c = *(const float4*)(Lr + 520); b2d = *(const float4*)(Lr + 524);
  __builtin_amdgcn_sched_barrier(0);
  sol[32] -= b0a.x * sol[7]; sol[33] -= b0a.y * sol[7]; sol[34] -= b0a.z * sol[7]; sol[35] -= b0a.w * sol[7]; sol[36] -= b0b.x * sol[7]; sol[37] -= b0b.y * sol[7]; sol[38] -= b0b.z * sol[7]; sol[39] -= b0b.w * sol[7]; sol[40] -= b0c.x * sol[7]; sol[41] -= b0c.y * sol[7]; sol[42] -= b0c.z * sol[7]; sol[43] -= b0c.w * sol[7]; sol[44] -= b0d.x * sol[7]; sol[45] -= b0d.y * sol[7]; sol[46] -= b0d.z * sol[7]; sol[47] -= b0d.w * sol[7];
  __builtin_amdgcn_sched_barrier(0);
  b0a = *(const float4*)(Lr + 528); b0b = *(const float4*)(Lr + 532); b0c = *(const float4*)(Lr + 536); b0d = *(const float4*)(Lr + 540);
  __builtin_amdgcn_sched_barrier(0);
  sol[48] -= b1a.x * sol[7]; sol[49] -= b1a.y * sol[7]; sol[50] -= b1a.z * sol[7]; sol[51] -= b1a.w * sol[7]; sol[52] -= b1b.x * sol[7]; sol[53] -= b1b.y * sol[7]; sol[54] -= b1b.z * sol[7]; sol[55] -= b1b.w * sol[7]; sol[56] -= b1c.x * sol[7]; sol[57] -= b1c.y * sol[7]; sol[58] -= b1c.z * sol[7]; sol[59] -= b1c.w * sol[7]; sol[60] -= b1d.x * sol[7]; sol[61] -= b1d.y * sol[7]; sol[62] -= b1d.z * sol[7]; sol[63] -= b1d.w * sol[7];
  __builtin_amdgcn_sched_barrier(0);
  b1a = *(const float4*)(Lr + 544); b1b = *(const float4*)(Lr + 548); b1c = *(const float4*)(Lr + 552); b1d = *(const float4*)(Lr + 556);
  __builtin_amdgcn_sched_barrier(0);
  sol[9] -= b2c.y * sol[8]; sol[10] -= b2c.z * sol[8]; sol[11] -= b2c.w * sol[8]; sol[12] -= b2d.x * sol[8]; sol[13] -= b2d.y * sol[8]; sol[14] -= b2d.z * sol[8]; sol[15] -= b2d.w * sol[8];
  __builtin_amdgcn_sched_barrier(0);
  b2a = *(const float4*)(Lr + 560); b2b = *(const float4*)(Lr + 564); b2c = *(const float4*)(Lr + 568); b2d = *(const float4*)(Lr + 572);
  __builtin_amdgcn_sched_barrier(0);
  sol[16] -= b0a.x * sol[8]; sol[17] -= b0a.y * sol[8]; sol[18] -= b0a.z * sol[8]; sol[19] -= b0a.w * sol[8]; sol[20] -= b0b.x * sol[8]; sol[21] -= b0b.y * sol[8]; sol[22] -= b0b.z * sol[8]; sol[23] -= b0b.w * sol[8]; sol[24] -= b0c.x * sol[8]; sol[25] -= b0c.y * sol[8]; sol[26] -= b0c.z * sol[8]; sol[27] -= b0c.w * sol[8]; sol[28] -= b0d.x * sol[8]; sol[29] -= b0d.y * sol[8]; sol[30] -= b0d.z * sol[8]; sol[31] -= b0d.w * sol[8];
  __builtin_amdgcn_sched_barrier(0);
  b0a = *(const float4*)(Lr + 576); b0b = *(const float4*)(Lr + 580); b0c = *(const float4*)(Lr + 584); b0d = *(const float4*)(Lr + 588);
  __builtin_amdgcn_sched_barrier(0);
  sol[32] -= b1a.x * sol[8]; sol[33] -= b1a.y * sol[8]; sol[34] -= b1a.z * sol[8]; sol[35] -= b1a.w * sol[8]; sol[36] -= b1b.x * sol[8]; sol[37] -= b1b.y * sol[8]; sol[38] -= b1b.z * sol[8]; sol[39] -= b1b.w * sol[8]; sol[40] -= b1c.x * sol[8]; sol[41] -= b1c.y * sol[8]; sol[42] -= b1c.z * sol[8]; sol[43] -= b1c.w * sol[8]; sol[44] -= b1d.x * sol[8]; sol[45] -= b1d.y * sol[8]; sol[46] -= b1d.z * sol[8]; sol[47] -= b1d.w * sol[8];
  __builtin_amdgcn_sched_barrier(0);
  b1a = *(const float4*)(Lr + 592); b1b = *(const float4*)(Lr + 596); b1c = *(const float4*)(Lr + 600); b1d = *(const float4*)(Lr + 604);
  __builtin_amdgcn_sched_barrier(0);
  sol[48] -= b2a.x * sol[8]; sol[49] -= b2a.y * sol[8]; sol[50] -= b2a.z * sol[8]; sol[51] -= b2a.w * sol[8]; sol[52] -= b2b.x * sol[8]; sol[53] -= b2b.y * sol[8]; sol[54] -= b2b.z * sol[8]; sol[55] -= b2b.w * sol[8]; sol[56] -= b2c.x * sol[8]; sol[57] -= b2c.y * sol[8]; sol[58] -= b2c.z * sol[8]; sol[59] -= b2c.w * sol[8]; sol[60] -= b2d.x * sol[8]; sol[61] -= b2d.y * sol[8]; sol[62] -= b2d.z * sol[8]; sol[63] -= b2d.w * sol[8];
  __builtin_amdgcn_sched_barrier(0);
  b2a = *(const float4*)(Lr + 608); b2b = *(const float4*)(Lr + 612); b2c = *(const float4*)(Lr + 616); b2d = *(const float4*)(Lr + 620);
  __builtin_amdgcn_sched_barrier(0);
  sol[10] -= b0c.z * sol[9]; sol[11] -= b0c.w * sol[9]; sol[12] -= b0d.x * sol[9]; sol[13] -= b0d.y * sol[9]; sol[14] -= b0d.z * sol[9]; sol[15] -= b0d.w * sol[9];
  __builtin_amdgcn_sched_barrier(0);
  b0a = *(const float4*)(Lr + 624); b0b = *(const float4*)(Lr + 628); b0c = *(const float4*)(Lr + 632); b0d = *(const float4*)(Lr + 636);
  __builtin_amdgcn_sched_barrier(0);
  sol[16] -= b1a.x * sol[9]; sol[17] -= b1a.y * sol[9]; sol[18] -= b1a.z * sol[9]; sol[19] -= b1a.w * sol[9]; sol[20] -= b1b.x * sol[9]; sol[21] -= b1b.y * sol[9]; sol[22] -= b1b.z * sol[9]; sol[23] -= b1b.w * sol[9]; sol[24] -= b1c.x * sol[9]; sol[25] -= b1c.y * sol[9]; sol[26] -= b1c.z * sol[9]; sol[27] -= b1c.w * sol[9]; sol[28] -= b1d.x * sol[9]; sol[29] -= b1d.y * sol[9]; sol[30] -= b1d.z * sol[9]; sol[31] -= b1d.w * sol[9];
  __builtin_amdgcn_sched_barrier(0);
  b1a = *(const float4*)(Lr + 640); b1b = *(const float4*)(Lr + 644); b1c = *(const float4*)(Lr + 648); b1d = *(const float4*)(Lr + 652);
  __builtin_amdgcn_sched_barrier(0);
  sol[32] -= b2a.x * sol[9]; sol[33] -= b2a.y * sol[9]; sol[34] -= b2a.z * sol[9]; sol[35] -= b2a.w * sol[9]; sol[36] -= b2b.x * sol[9]; sol[37] -= b2b.y * sol[9]; sol[38] -= b2b.z * sol[9]; sol[39] -= b2b.w * sol[9]; sol[40] -= b2c.x * sol[9]; sol[41] -= b2c.y * sol[9]; sol[42] -= b2c.z * sol[9]; sol[43] -= b2c.w * sol[9]; sol[44] -= b2d.x * sol[9]; sol[45] -= b2d.y * sol[9]; sol[46] -= b2d.z * sol[9]; sol[47] -= b2d.w * sol[9];
  __builtin_amdgcn_sched_barrier(0);
  b2a = *(const float4*)(Lr + 656); b2b = *(const float4*)(Lr + 660); b2c = *(const float4*)(Lr + 664); b2d = *(const float4*)(Lr + 668);
  __builtin_amdgcn_sched_barrier(0);
  sol[48] -= b0a.x * sol[9]; sol[49] -= b0a.y * sol[9]; sol[50] -= b0a.z * sol[9]; sol[51] -= b0a.w * sol[9]; sol[52] -= b0b.x * sol[9]; sol[53] -= b0b.y * sol[9]; sol[54] -= b0b.z * sol[9]; sol[55] -= b0b.w * sol[9]; sol[56] -= b0c.x * sol[9]; sol[57] -= b0c.y * sol[9]; sol[58] -= b0c.z * sol[9]; sol[59] -= b0c.w * sol[9]; sol[60] -= b0d.x * sol[9]; sol[61] -= b0d.y * sol[9]; sol[62] -= b0d.z * sol[9]; sol[63] -= b0d.w * sol[9];
  __builtin_amdgcn_sched_barrier(0);
  b0a = *(const float4*)(Lr + 672); b0b = *(const float4*)(Lr + 676); b0c = *(const float4*)(Lr + 680); b0d = *(const float4*)(Lr + 684);
  __builtin_amdgcn_sched_barrier(0);
  sol[11] -= b1c.w * sol[10]; sol[12] -= b1d.x * sol[10]; sol[13] -= b1d.y * sol[10]; sol[14] -= b1d.z * sol[10]; sol[15] -= b1d.w * sol[10];
  __builtin_amdgcn_sched_barrier(0);
  b1a = *(const float4*)(Lr + 688); b1b = *(const float4*)(Lr + 692); b1c = *(const float4*)(Lr + 696); b1d = *(const float4*)(Lr + 700);
  __builtin_amdgcn_sched_barrier(0);
  sol[16] -= b2a.x * sol[10]; sol[17] -= b2a.y * sol[10]; sol[18] -= b2a.z * sol[10]; sol[19] -= b2a.w * sol[10]; sol[20] -= b2b.x * sol[10]; sol[21] -= b2b.y * sol[10]; sol[22] -= b2b.z * sol[10]; sol[23] -= b2b.w * sol[10]; sol[24] -= b2c.x * sol[10]; sol[25] -= b2c.y * sol[10]; sol[26] -= b2c.z * sol[10]; sol[27] -= b2c.w * sol[10]; sol[28] -= b2d.x * sol[10]; sol[29] -= b2d.y * sol[10]; sol[30] -= b2d.z * sol[10]; sol[31] -= b2d.w * sol[10];
  __builtin_amdgcn_sched_barrier(0);
  b2a = *(const float4*)(Lr + 704); b2b = *(const float4*)(Lr + 708); b2c = *(const float4*)(Lr + 712); b2d = *(const float4*)(Lr + 716);
  __builtin_amdgcn_sched_barrier(0);
  sol[32] -= b0a.x * sol[10]; sol[33] -= b0a.y * sol[10]; sol[34] -= b0a.z * sol[10]; sol[35] -= b0a.w * sol[10]; sol[36] -= b0b.x * sol[10]; sol[37] -= b0b.y * sol[10]; sol[38] -= b0b.z * sol[10]; sol[39] -= b0b.w * sol[10]; sol[40] -= b0c.x * sol[10]; sol[41] -= b0c.y * sol[10]; sol[42] -= b0c.z * sol[10]; sol[43] -= b0c.w * sol[10]; sol[44] -= b0d.x * sol[10]; sol[45] -= b0d.y * sol[10]; sol[46] -= b0d.z * sol[10]; sol[47] -= b0d.w * sol[10];
  __builtin_amdgcn_sched_barrier(0);
  b0a = *(const float4*)(Lr + 720); b0b = *(const float4*)(Lr + 724); b0c = *(const float4*)(Lr + 728); b0d = *(const float4*)(Lr + 732);
  __builtin_amdgcn_sched_barrier(0);
  sol[48] -= b1a.x * sol[10]; sol[49] -= b1a.y * sol[10]; sol[50] -= b1a.z * sol[10]; sol[51] -= b1a.w * sol[10]; sol[52] -= b1b.x * sol[10]; sol[53] -= b1b.y * sol[10]; sol[54] -= b1b.z * sol[10]; sol[55] -= b1b.w * sol[10]; sol[56] -= b1c.x * sol[10]; sol[57] -= b1c.y * sol[10]; sol[58] -= b1c.z * sol[10]; sol[59] -= b1c.w * sol[10]; sol[60] -= b1d.x * sol[10]; sol[61] -= b1d.y * sol[10]; sol[62] -= b1d.z * sol[10]; sol[63] -= b1d.w * sol[10];
  __builtin_amdgcn_sched_barrier(0);
  b1a = *(const float4*)(Lr + 736); b1b = *(const float4*)(Lr + 740); b1c = *(const float4*)(Lr + 744); b1d = *(const float4*)(Lr + 748);
  __builtin_amdgcn_sched_barrier(0);
  sol[12] -= b2d.x * sol[11]; sol[13] -= b2d.y * sol[11]; sol[14] -= b2d.z * sol[11]; sol[15] -= b2d.w * sol[11];
  __builtin_amdgcn_sched_barrier(0);
  b2a = *(const float4*)(Lr + 752); b2b = *(const float4*)(Lr + 756); b2c = *(const float4*)(Lr + 760); b2d = *(const float4*)(Lr + 764);
  __builtin_amdgcn_sched_barrier(0);
  sol[16] -= b0a.x * sol[11]; sol[17] -= b0a.y * sol[11]; sol[18] -= b0a.z * sol[11]; sol[19] -= b0a.w * sol[11]; sol[20] -= b0b.x * sol[11]; sol[21] -= b0b.y * sol[11]; sol[22] -= b0b.z * sol[11]; sol[23] -= b0b.w * sol[11]; sol[24] -= b0c.x * sol[11]; sol[25] -= b0c.y * sol[11]; sol[26] -= b0c.z * sol[11]; sol[27] -= b0c.w * sol[11]; sol[28] -= b0d.x * sol[11]; sol[29] -= b0d.y * sol[11]; sol[30] -= b0d.z * sol[11]; sol[31] -= b0d.w * sol[11];
  __builtin_amdgcn_sched_barrier(0);
  b0a = *(const float4*)(Lr + 768); b0b = *(const float4*)(Lr + 772); b0c = *(const float4*)(Lr + 776); b0d = *(const float4*)(Lr + 780);
  __builtin_amdgcn_sched_barrier(0);
  sol[32] -= b1a.x * sol[11]; sol[33] -= b1a.y * sol[11]; sol[34] -= b1a.z * sol[11]; sol[35] -= b1a.w * sol[11]; sol[36] -= b1b.x * sol[11]; sol[37] -= b1b.y * sol[11]; sol[38] -= b1b.z * sol[11]; sol[39] -= b1b.w * sol[11]; sol[40] -= b1c.x * sol[11]; sol[41] -= b1c.y * sol[11]; sol[42] -= b1c.z * sol[11]; sol[43] -= b1c.w * sol[11]; sol[44] -= b1d.x * sol[11]; sol[45] -= b1d.y * sol[11]; sol[46] -= b1d.z * sol[11]; sol[47] -= b1d.w * sol[11];
  __builtin_amdgcn_sched_barrier(0);
  b1a = *(const float4*)(Lr + 784); b1b = *(const float4*)(Lr + 788); b1c = *(const float4*)(Lr + 792); b1d = *(const float4*)(Lr + 796);
  __builtin_amdgcn_sched_barrier(0);
  sol[48] -= b2a.x * sol[11]; sol[49] -= b2a.y * sol[11]; sol[50] -= b2a.z * sol[11]; sol[51] -= b2a.w * sol[11]; sol[52] -= b2b.x * sol[11]; sol[53] -= b2b.y * sol[11]; sol[54] -= b2b.z * sol[11]; sol[55] -= b2b.w * sol[11]; sol[56] -= b2c.x * sol[11]; sol[57] -= b2c.y * sol[11]; sol[58] -= b2c.z * sol[11]; sol[59] -= b2c.w * sol[11]; sol[60] -= b2d.x * sol[11]; sol[61] -= b2d.y * sol[11]; sol[62] -= b2d.z * sol[11]; sol[63] -= b2d.w * sol[11];
  __builtin_amdgcn_sched_barrier(0);
  b2a = *(const float4*)(Lr + 800); b2b = *(const float4*)(Lr + 804); b2c = *(const float4*)(Lr + 808); b2d = *(const float4*)(Lr + 812);
  __builtin_amdgcn_sched_barrier(0);
  sol[13] -= b0d.y * sol[12]; sol[14] -= b0d.z * sol[12]; sol[15] -= b0d.w * sol[12];
  __builtin_amdgcn_sched_barrier(0);
  b0a = *(const float4*)(Lr + 816); b0b = *(const float4*)(Lr + 820); b0c = *(const float4*)(Lr + 824); b0d = *(const float4*)(Lr + 828);
  __builtin_amdgcn_sched_barrier(0);
  sol[16] -= b1a.x * sol[12]; sol[17] -= b1a.y * sol[12]; sol[18] -= b1a.z * sol[12]; sol[19] -= b1a.w * sol[12]; sol[20] -= b1b.x * sol[12]; sol[21] -= b1b.y * sol[12]; sol[22] -= b1b.z * sol[12]; sol[23] -= b1b.w * sol[12]; sol[24] -= b1c.x * sol[12]; sol[25] -= b1c.y * sol[12]; sol[26] -= b1c.z * sol[12]; sol[27] -= b1c.w * sol[12]; sol[28] -= b1d.x * sol[12]; sol[29] -= b1d.y * sol[12]; sol[30] -= b1d.z * sol[12]; sol[31] -= b1d.w * sol[12];
  __builtin_amdgcn_sched_barrier(0);
  b1a = *(const float4*)(Lr + 832); b1b = *(const float4*)(Lr + 836); b1c = *(const float4*)(Lr + 840); b1d = *(const float4*)(Lr + 844);
  __builtin_amdgcn_sched_barrier(0);
  sol[32] -= b2a.x * sol[12]; sol[33] -= b2a.y * sol[12]; sol[34] -= b2a.z * sol[12]; sol[35] -= b2a.w * sol[12]; sol[36] -= b2b.x * sol[12]; sol[37] -= b2b.y * sol[12]; sol[38] -= b2b.z * sol[12]; sol[39] -= b2b.w * sol[12]; sol[40] -= b2c.x * sol[12]; sol[41] -= b2c.y * sol[12]; sol[42] -= b2c.z * sol[12]; sol[43] -= b2c.w * sol[12]; sol[44] -= b2d.x * sol[12]; sol[45] -= b2d.y * sol[12]; sol[46] -= b2d.z * sol[12]; sol[47] -= b2d.w * sol[12];
  __builtin_amdgcn_sched_barrier(0);
  b2a = *(const float4*)(Lr + 848); b2b = *(const float4*)(Lr + 852); b2c = *(const float4*)(Lr + 856); b2d = *(const float4*)(Lr + 860);
  __builtin_amdgcn_sched_barrier(0);
  sol[48] -= b0a.x * sol[12]; sol[49] -= b0a.y * sol[12]; sol[50] -= b0a.z * sol[12]; sol[51] -= b0a.w * sol[12]; sol[52] -= b0b.x * sol[12]; sol[53] -= b0b.y * sol[12]; sol[54] -= b0b.z * sol[12]; sol[55] -= b0b.w * sol[12]; sol[56] -= b0c.x * sol[12]; sol[57] -= b0c.y * sol[12]; sol[58] -= b0c.z * sol[12]; sol[59] -= b0c.w * sol[12]; sol[60] -= b0d.x * sol[12]; sol[61] -= b0d.y * sol[12]; sol[62] -= b0d.z * sol[12]; sol[63] -= b0d.w * sol[12];
  __builtin_amdgcn_sched_barrier(0);
  b0a = *(const float4*)(Lr + 864); b0b = *(const float4*)(Lr + 868); b0c = *(const float4*)(Lr + 872); b0d = *(const float4*)(Lr + 876);
  __builtin_amdgcn_sched_barrier(0);
  sol[14] -= b1d.z * sol[13]; sol[15] -= b1d.w * sol[13];
  __builtin_amdgcn_sched_barrier(0);
  b1a = *(const float4*)(Lr + 880); b1b = *(const float4*)(Lr + 884); b1c = *(const float4*)(Lr + 888); b1d = *(const float4*)(Lr + 892);
  __builtin_amdgcn_sched_barrier(0);
  sol[16] -= b2a.x * sol[13]; sol[17] -= b2a.y * sol[13]; sol[18] -= b2a.z * sol[13]; sol[19] -= b2a.w * sol[13]; sol[20] -= b2b.x * sol[13]; sol[21] -= b2b.y * sol[13]; sol[22] -= b2b.z * sol[13]; sol[23] -= b2b.w * sol[13]; sol[24] -= b2c.x * sol[13]; sol[25] -= b2c.y * sol[13]; sol[26] -= b2c.z * sol[13]; sol[27] -= b2c.w * sol[13]; sol[28] -= b2d.x * sol[13]; sol[29] -= b2d.y * sol[13]; sol[30] -= b2d.z * sol[13]; sol[31] -= b2d.w * sol[13];
  __builtin_amdgcn_sched_barrier(0);
  b2a = *(const float4*)(Lr + 896); b2b = *(const float4*)(Lr + 900); b2c = *(const float4*)(Lr + 904); b2d = *(const float4*)(Lr + 908);
  __builtin_amdgcn_sched_barrier(0);
  sol[32] -= b0a.x * sol[13]; sol[33] -= b0a.y * sol[13]; sol[34] -= b0a.z * sol[13]; sol[35] -= b0a.w * sol[13]; sol[36] -= b0b.x * sol[13]; sol[37] -= b0b.y * sol[13]; sol[38] -= b0b.z * sol[13]; sol[39] -= b0b.w * sol[13]; sol[40] -= b0c.x * sol[13]; sol[41] -= b0c.y * sol[13]; sol[42] -= b0c.z * sol[13]; sol[43] -= b0c.w * sol[13]; sol[44] -= b0d.x * sol[13]; sol[45] -= b0d.y * sol[13]; sol[46] -= b0d.z * sol[13]; sol[47] -= b0d.w * sol[13];
  __builtin_amdgcn_sched_barrier(0);
  b0a = *(const float4*)(Lr + 912); b0b = *(const float4*)(Lr + 916); b0c = *(const float4*)(Lr + 920); b0d = *(const float4*)(Lr + 924);
  __builtin_amdgcn_sched_barrier(0);
  sol[48] -= b1a.x * sol[13]; sol[49] -= b1a.y * sol[13]; sol[50] -= b1a.z * sol[13]; sol[51] -= b1a.w * sol[13]; sol[52] -= b1b.x * sol[13]; sol[53] -= b1b.y * sol[13]; sol[54] -= b1b.z * sol[13]; sol[55] -= b1b.w * sol[13]; sol[56] -= b1c.x * sol[13]; sol[57] -= b1c.y * sol[13]; sol[58] -= b1c.z * sol[13]; sol[59] -= b1c.w * sol[13]; sol[60] -= b1d.x * sol[13]; sol[61] -= b1d.y * sol[13]; sol[62] -= b1d.z * sol[13]; sol[63] -= b1d.w * sol[13];
  __builtin_amdgcn_sched_barrier(0);
  b1a = *(const float4*)(Lr + 928); b1b = *(const float4*)(Lr + 932); b1c = *(const float4*)(Lr + 936); b1d = *(const float4*)(Lr + 940);
  __builtin_amdgcn_sched_barrier(0);
  sol[15] -= b2d.w * sol[14];
  __builtin_amdgcn_sched_barrier(0);
  b2a = *(const float4*)(Lr + 944); b2b = *(const float4*)(Lr + 948); b2c = *(const float4*)(Lr + 952); b2d = *(const float4*)(Lr + 956);
  __builtin_amdgcn_sched_barrier(0);
  sol[16] -= b0a.x * sol[14]; sol[17] -= b0a.y * sol[14]; sol[18] -= b0a.z * sol[14]; sol[19] -= b0a.w * sol[14]; sol[20] -= b0b.x * sol[14]; sol[21] -= b0b.y * sol[14]; sol[22] -= b0b.z * sol[14]; sol[23] -= b0b.w * sol[14]; sol[24] -= b0c.x * sol[14]; sol[25] -= b0c.y * sol[14]; sol[26] -= b0c.z * sol[14]; sol[27] -= b0c.w * sol[14]; sol[28] -= b0d.x * sol[14]; sol[29] -= b0d.y * sol[14]; sol[30] -= b0d.z * sol[14]; sol[31] -= b0d.w * sol[14];
  __builtin_amdgcn_sched_barrier(0);
  b0a = *(const float4*)(Lr + 976); b0b = *(const float4*)(Lr + 980); b0c = *(const float4*)(Lr + 984); b0d = *(const float4*)(Lr + 988);
  __builtin_amdgcn_sched_barrier(0);
  sol[32] -= b1a.x * sol[14]; sol[33] -= b1a.y * sol[14]; sol[34] -= b1a.z * sol[14]; sol[35] -= b1a.w * sol[14]; sol[36] -= b1b.x * sol[14]; sol[37] -= b1b.y * sol[14]; sol[38] -= b1b.z * sol[14]; sol[39] -= b1b.w * sol[14]; sol[40] -= b1c.x * sol[14]; sol[41] -= b1c.y * sol[14]; sol[42] -= b1c.z * sol[14]; sol[43] -= b1c.w * sol[14]; sol[44] -= b1d.x * sol[14]; sol[45] -= b1d.y * sol[14]; sol[46] -= b1d.z * sol[14]; sol[47] -= b1d.w * sol[14];
  __builtin_amdgcn_sched_barrier(0);
  b1a = *(const float4*)(Lr + 992); b1b = *(const float4*)(Lr + 996); b1c = *(const float4*)(Lr + 1000); b1d = *(const float4*)(Lr + 1004);
  __builtin_amdgcn_sched_barrier(0);
  sol[48] -= b2a.x * sol[14]; sol[49] -= b2a.y * sol[14]; sol[50] -= b2a.z * sol[14]; sol[51] -= b2a.w * sol[14]; sol[52] -= b2b.x * sol[14]; sol[53] -= b2b.y * sol[14]; sol[54] -= b2b.z * sol[14]; sol[55] -= b2b.w * sol[14]; sol[56] -= b2c.x * sol[14]; sol[57] -= b2c.y * sol[14]; sol[58] -= b2c.z * sol[14]; sol[59] -= b2c.w * sol[14]; sol[60] -= b2d.x * sol[14]; sol[61] -= b2d.y * sol[14]; sol[62] -= b2d.z * sol[14]; sol[63] -= b2d.w * sol[14];
  __builtin_amdgcn_sched_barrier(0);
  b2a = *(const float4*)(Lr + 1008); b2b = *(const float4*)(Lr + 1012); b2c = *(const float4*)(Lr + 1016); b2d = *(const float4*)(Lr + 1020);
  __builtin_amdgcn_sched_barrier(0);
  sol[16] -= b0a.x * sol[15]; sol[17] -= b0a.y * sol[15]; sol[18] -= b0a.z * sol[15]; sol[19] -= b0a.w * sol[15]; sol[20] -= b0b.x * sol[15]; sol[21] -= b0b.y * sol[15]; sol[22] -= b0b.z * sol[15]; sol[23] -= b0b.w * sol[15]; sol[24] -= b0c.x * sol[15]; sol[25] -= b0c.y * sol[15]; sol[26] -= b0c.z * sol[15]; sol[27] -= b0c.w * sol[15]; sol[28] -= b0d.x * sol[15]; sol[29] -= b0d.y * sol[15]; sol[30] -= b0d.z * sol[15]; sol[31] -= b0d.w * sol[15];
  __builtin_amdgcn_sched_barrier(0);
  b0a = *(const float4*)(Lr + 1040); b0b = *(const float4*)(Lr + 1044); b0c = *(const float4*)(Lr + 1048); b0d = *(const float4*)(Lr + 1052);
  __builtin_amdgcn_sched_barrier(0);
  sol[32] -= b1a.x * sol[15]; sol[33] -= b1a.y * sol[15]; sol[34] -= b1a.z * sol[15]; sol[35] -= b1a.w * sol[15]; sol[36] -= b1b.x * sol[15]; sol[37] -= b1b.y * sol[15]; sol[38] -= b1b.z * sol[15]; sol[39] -= b1b.w * sol[15]; sol[40] -= b1c.x * sol[15]; sol[41] -= b1c.y * sol[15]; sol[42] -= b1c.z * sol[15]; sol[43] -= b1c.w * sol[15]; sol[44] -= b1d.x * sol[15]; sol[45] -= b1d.y * sol[15]; sol[46] -= b1d.z * sol[15]; sol[47] -= b1d.w * sol[15];
  __builtin_amdgcn_sched_barrier(0);
  b1a = *(const float4*)(Lr + 1056); b1b = *(const float4*)(Lr + 1060); b1c = *(const float4*)(Lr + 1064); b1d = *(const float4*)(Lr + 1068);
  __builtin_amdgcn_sched_barrier(0);
  sol[48] -= b2a.x * sol[15]; sol[49] -= b2a.y * sol[15]; sol[50] -= b2a.z * sol[15]; sol[51] -= b2a.w * sol[15]; sol[52] -= b2b.x * sol[15]; sol[53] -= b2b.y * sol[15]; sol[54] -= b2b.z * sol[15]; sol[55] -= b2b.w * sol[15]; sol[56] -= b2c.x * sol[15]; sol[57] -= b2c.y * sol[15]; sol[58] -= b2c.z * sol[15]; sol[59] -= b2c.w * sol[15]; sol[60] -= b2d.x * sol[15]; sol[61] -= b2d.y * sol[15]; sol[62] -= b2d.z * sol[15]; sol[63] -= b2d.w * sol[15];
  __builtin_amdgcn_sched_barrier(0);
  b2a = *(const float4*)(Lr + 1072); b2b = *(const float4*)(Lr + 1076); b2c = *(const float4*)(Lr + 1080); b2d = *(const float4*)(Lr + 1084);
  __builtin_amdgcn_sched_barrier(0);
  sol[17] -= b0a.y * sol[16]; sol[18] -= b0a.z * sol[16]; sol[19] -= b0a.w * sol[16]; sol[20] -= b0b.x * sol[16]; sol[21] -= b0b.y * sol[16]; sol[22] -= b0b.z * sol[16]; sol[23] -= b0b.w * sol[16]; sol[24] -= b0c.x * sol[16]; sol[25] -= b0c.y * sol[16]; sol[26] -= b0c.z * sol[16]; sol[27] -= b0c.w * sol[16]; sol[28] -= b0d.x * sol[16]; sol[29] -= b0d.y * sol[16]; sol[30] -= b0d.z * sol[16]; sol[31] -= b0d.w * sol[16];
  __builtin_amdgcn_sched_barrier(0);
  b0a = *(const float4*)(Lr + 1104); b0b = *(const float4*)(Lr + 1108); b0c = *(const float4*)(Lr + 1112); b0d = *(const float4*)(Lr + 1116);
  __builtin_amdgcn_sched_barrier(0);
  sol[32] -= b1a.x * sol[16]; sol[33] -= b1a.y * sol[16]; sol[34] -= b1a.z * sol[16]; sol[35] -= b1a.w * sol[16]; sol[36] -= b1b.x * sol[16]; sol[37] -= b1b.y * sol[16]; sol[38] -= b1b.z * sol[16]; sol[39] -= b1b.w * sol[16]; sol[40] -= b1c.x * sol[16]; sol[41] -= b1c.y * sol[16]; sol[42] -= b1c.z * sol[16]; sol[43] -= b1c.w * sol[16]; sol[44] -= b1d.x * sol[16]; sol[45] -= b1d.y * sol[16]; sol[46] -= b1d.z * sol[16]; sol[47] -= b1d.w * sol[16];
  __builtin_amdgcn_sched_barrier(0);
  b1a = *(const float4*)(Lr + 1120); b1b = *(const float4*)(Lr + 1124); b1c = *(const float4*)(Lr + 1128); b1d = *(const float4*)(Lr + 1132);
  __builtin_amdgcn_sched_barrier(0);
  sol[48] -= b2a.x * sol[16]; sol[49] -= b2a.y * sol[16]; sol[50] -= b2a.z * sol[16]; sol[51] -= b2a.w * sol[16]; sol[52] -= b2b.x * sol[16]; sol[53] -= b2b.y * sol[16]; sol[54] -= b2b.z * sol[16]; sol[55] -= b2b.w * sol[16]; sol[56] -= b2c.x * sol[16]; sol[57] -= b2c.y * sol[16]; sol[58] -= b2c.z * sol[16]; sol[59] -= b2c.w * sol[16]; sol[60] -= b2d.x * sol[16]; sol[61] -= b2d.y * sol[16]; sol[62] -= b2d.z * sol[16]; sol[63] -= b2d.w * sol[16];
  __builtin_amdgcn_sched_barrier(0);
  b2a = *(const float4*)(Lr + 1136); b2b = *(const float4*)(Lr + 1140); b2c = *(const float4*)(Lr + 1144); b2d = *(const float4*)(Lr + 1148);
  __builtin_amdgcn_sched_barrier(0);
  sol[18] -= b0a.z * sol[17]; sol[19] -= b0a.w * sol[17]; sol[20] -= b0b.x * sol[17]; sol[21] -= b0b.y * sol[17]; sol[22] -= b0b.z * sol[17]; sol[23] -= b0b.w * sol[17]; sol[24] -= b0c.x * sol[17]; sol[25] -= b0c.y * sol[17]; sol[26] -= b0c.z * sol[17]; sol[27] -= b0c.w * sol[17]; sol[28] -= b0d.x * sol[17]; sol[29] -= b0d.y * sol[17]; sol[30] -= b0d.z * sol[17]; sol[31] -= b0d.w * sol[17];
  __builtin_amdgcn_sched_barrier(0);
  b0a = *(const float4*)(Lr + 1168); b0b = *(const float4*)(Lr + 1172); b0c = *(const float4*)(Lr + 1176); b0d = *(const float4*)(Lr + 1180);
  __builtin_amdgcn_sched_barrier(0);
  sol[32] -= b1a.x * sol[17]; sol[33] -= b1a.y * sol[17]; sol[34] -= b1a.z * sol[17]; sol[35] -= b1a.w * sol[17]; sol[36] -= b1b.x * sol[17]; sol[37] -= b1b.y * sol[17]; sol[38] -= b1b.z * sol[17]; sol[39] -= b1b.w * sol[17]; sol[40] -= b1c.x * sol[17]; sol[41] -= b1c.y * sol[17]; sol[42] -= b1c.z * sol[17]; sol[43] -= b1c.w * sol[17]; sol[44] -= b1d.x * sol[17]; sol[45] -= b1d.y * sol[17]; sol[46] -= b1d.z * sol[17]; sol[47] -= b1d.w * sol[17];
  __builtin_amdgcn_sched_barrier(0);
  b1a = *(const float4*)(Lr + 1184); b1b = *(const float4*)(Lr + 1188); b1c = *(const float4*)(Lr + 1192); b1d = *(const float4*)(Lr + 1196);
  __builtin_amdgcn_sched_barrier(0);
  sol[48] -= b2a.x * sol[17]; sol[49] -= b2a.y * sol[17]; sol[50] -= b2a.z * sol[17]; sol[51] -= b2a.w * sol[17]; sol[52] -= b2b.x * sol[17]; sol[53] -= b2b.y * sol[17]; sol[54] -= b2b.z * sol[17]; sol[55] -= b2b.w * sol[17]; sol[56] -= b2c.x * sol[17]; sol[57] -= b2c.y * sol[17]; sol[58] -= b2c.z * sol[17]; sol[59] -= b2c.w * sol[17]; sol[60] -= b2d.x * sol[17]; sol[61] -= b2d.y * sol[17]; sol[62] -= b2d.z * sol[17]; sol[63] -= b2d.w * sol[17];
  __builtin_amdgcn_sched_barrier(0);
  b2a = *(const float4*)(Lr + 1200); b2b = *(const float4*)(Lr + 1204); b2c = *(const float4*)(Lr + 1208); b2d = *(const float4*)(Lr + 1212);
  __builtin_amdgcn_sched_barrier(0);
  sol[19] -= b0a.w * sol[18]; sol[20] -= b0b.x * sol[18]; sol[21] -= b0b.y * sol[18]; sol[22] -= b0b.z * sol[18]; sol[23] -= b0b.w * sol[18]; sol[24] -= b0c.x * sol[18]; sol[25] -= b0c.y * sol[18]; sol[26] -= b0c.z * sol[18]; sol[27] -= b0c.w * sol[18]; sol[28] -= b0d.x * sol[18]; sol[29] -= b0d.y * sol[18]; sol[30] -= b0d.z * sol[18]; sol[31] -= b0d.w * sol[18];
  __builtin_amdgcn_sched_barrier(0);
  b0a = *(const float4*)(Lr + 1232); b0b = *(const float4*)(Lr + 1236); b0c = *(const float4*)(Lr + 1240); b0d = *(const float4*)(Lr + 1244);
  __builtin_amdgcn_sched_barrier(0);
  sol[32] -= b1a.x * sol[18]; sol[33] -= b1a.y * sol[18]; sol[34] -= b1a.z * sol[18]; sol[35] -= b1a.w * sol[18]; sol[36] -= b1b.x * sol[18]; sol[37] -= b1b.y * sol[18]; sol[38] -= b1b.z * sol[18]; sol[39] -= b1b.w * sol[18]; sol[40] -= b1c.x * sol[18]; sol[41] -= b1c.y * sol[18]; sol[42] -= b1c.z * sol[18]; sol[43] -= b1c.w * sol[18]; sol[44] -= b1d.x * sol[18]; sol[45] -= b1d.y * sol[18]; sol[46] -= b1d.z * sol[18]; sol[47] -= b1d.w * sol[18];
  __builtin_amdgcn_sched_barrier(0);
  b1a = *(const float4*)(Lr + 1248); b1b = *(const float4*)(Lr + 1252); b1c = *(const float4*)(Lr + 1256); b1d = *(const float4*)(Lr + 1260);
  __builtin_amdgcn_sched_barrier(0);
  sol[48] -= b2a.x * sol[18]; sol[49] -= b2a.y * sol[18]; sol[50] -= b2a.z * sol[18]; sol[51] -= b2a.w * sol[18]; sol[52] -= b2b.x * sol[18]; sol[53] -= b2b.y * sol[18]; sol[54] -= b2b.z * sol[18]; sol[55] -= b2b.w * sol[18]; sol[56] -= b2c.x * sol[18]; sol[57] -= b2c.y * sol[18]; sol[58] -= b2c.z * sol[18]; sol[59] -= b2c.w * sol[18]; sol[60] -= b2d.x * sol[18]; sol[61] -= b2d.y * sol[18]; sol[62] -= b2d.z * sol[18]; sol[63] -= b2d.w * sol[18];
  __builtin_amdgcn_sched_barrier(0);
  b2a = *(const float4*)(Lr + 1264); b2b = *(const float4*)(Lr + 1268); b2c = *(const float4*)(Lr + 1272); b2d = *(const float4*)(Lr + 1276);
  __builtin_amdgcn_sched_barrier(0);
  sol[20] -= b0b.x * sol[19]; sol[21] -= b0b.y * sol[19]; sol[22] -= b0b.z * sol[19]; sol[23] -= b0b.w * sol[19]; sol[24] -= b0c.x * sol[19]; sol[25] -= b0c.y * sol[19]; sol[26] -= b0c.z * sol[19]; sol[27] -= b0c.w * sol[19]; sol[28] -= b0d.x * sol[19]; sol[29] -= b0d.y * sol[19]; sol[30] -= b0d.z * sol[19]; sol[31] -= b0d.w * sol[19];
  __builtin_amdgcn_sched_barrier(0);
  b0a = *(const float4*)(Lr + 1296); b0b = *(const float4*)(Lr + 1300); b0c = *(const float4*)(Lr + 1304); b0d = *(const float4*)(Lr + 1308);
  __builtin_amdgcn_sched_barrier(0);
  sol[32] -= b1a.x * sol[19]; sol[33] -= b1a.y * sol[19]; sol[34] -= b1a.z * sol[19]; sol[35] -= b1a.w * sol[19]; sol[36] -= b1b.x * sol[19]; sol[37] -= b1b.y * sol[19]; sol[38] -= b1b.z * sol[19]; sol[39] -= b1b.w * sol[19]; sol[40] -= b1c.x * sol[19]; sol[41] -= b1c.y * sol[19]; sol[42] -= b1c.z * sol[19]; sol[43] -= b1c.w * sol[19]; sol[44] -= b1d.x * sol[19]; sol[45] -= b1d.y * sol[19]; sol[46] -= b1d.z * sol[19]; sol[47] -= b1d.w * sol[19];
  __builtin_amdgcn_sched_barrier(0);
  b1a = *(const float4*)(Lr + 1312); b1b = *(const float4*)(Lr + 1316); b1c = *(const float4*)(Lr + 1320); b1d = *(const float4*)(Lr + 1324);
  __builtin_amdgcn_sched_barrier(0);
  sol[48] -= b2a.x * sol[19]; sol[49] -= b2a.y * sol[19]; sol[50] -= b2a.z * sol[19]; sol[51] -= b2a.w * sol[19]; sol[52] -= b2b.x * sol[19]; sol[53] -= b2b.y * sol[19]; sol[54] -= b2b.z * sol[19]; sol[55] -= b2b.w * sol[19]; sol[56] -= b2c.x * sol[19]; sol[57] -= b2c.y * sol[19]; sol[58] -= b2c.z * sol[19]; sol[59] -= b2c.w * sol[19]; sol[60] -= b2d.x * sol[19]; sol[61] -= b2d.y * sol[19]; sol[62] -= b2d.z * sol[19]; sol[63] -= b2d.w * sol[19];
  __builtin_amdgcn_sched_barrier(0);
  b2a = *(const float4*)(Lr + 1328); b2b = *(const float4*)(Lr + 1332); b2c = *(const float4*)(Lr + 1336); b2d = *(const float4*)(Lr + 1340);
  __builtin_amdgcn_sched_barrier(0);
  sol[21] -= b0b.y * sol[20]; sol[22] -= b0b.z * sol[20]; sol[23] -= b0b.w * sol[20]; sol[24] -= b0c.x * sol[20]; sol[25] -= b0c.y * sol[20]; sol[26] -= b0c.z * sol[20]; sol[27] -= b0c.w * sol[20]; sol[28] -= b0d.x * sol[20]; sol[29] -= b0d.y * sol[20]; sol[30] -= b0d.z * sol[20]; sol[31] -= b0d.w * sol[20];
  __builtin_amdgcn_sched_barrier(0);
  b0a = *(const float4*)(Lr + 1360); b0b = *(const float4*)(Lr + 1364); b0c = *(const float4*)(Lr + 1368); b0d = *(const float4*)(Lr + 1372);
  __builtin_amdgcn_sched_barrier(0);
  sol[32] -= b1a.x * sol[20]; sol[33] -= b1a.y * sol[20]; sol[34] -= b1a.z * sol[20]; sol[35] -= b1a.w * sol[20]; sol[36] -= b1b.x * sol[20]; sol[37] -= b1b.y * sol[20]; sol[38] -= b1b.z * sol[20]; sol[39] -= b1b.w * sol[20]; sol[40] -= b1c.x * sol[20]; sol[41] -= b1c.y * sol[20]; sol[42] -= b1c.z * sol[20]; sol[43] -= b1c.w * sol[20]; sol[44] -= b1d.x * sol[20]; sol[45] -= b1d.y * sol[20]; sol[46] -= b1d.z * sol[20]; sol[47] -= b1d.w * sol[20];
  __builtin_amdgcn_sched_barrier(0);
  b1a = *(const float4*)(Lr + 1376); b1b = *(const float4*)(Lr + 1380); b1c = *(const float4*)(Lr + 1384); b1d = *(const float4*)(Lr + 1388);
  __builtin_amdgcn_sched_barrier(0);
  sol[48] -= b2a.x * sol[20]; sol[49] -= b2a.y * sol[20]; sol[50] -= b2a.z * sol[20]; sol[51] -= b2a.w * sol[20]; sol[52] -= b2b.x * sol[20]; sol[53] -= b2b.y * sol[20]; sol[54] -= b2b.z * sol[20]; sol[55] -= b2b.w * sol[20]; sol[56] -= b2c.x * sol[20]; sol[57] -= b2c.y * sol[20]; sol[58] -= b2c.z * sol[20]; sol[59] -= b2c.w * sol[20]; sol[60] -= b2d.x * sol[20]; sol[61] -= b2d.y * sol[20]; sol[62] -= b2d.z * sol[20]; sol[63] -= b2d.w * sol[20];
  __builtin_amdgcn_sched_barrier(0);
  b2a = *(const float4*)(Lr + 1392); b2b = *(const float4*)(Lr + 1396); b2c = *(const float4*)(Lr + 1400); b2d = *(const float4*)(Lr + 1404);
  __builtin_amdgcn_sched_barrier(0);
  sol[22] -= b0b.z * sol[21]; sol[23] -= b0b.w * sol[21]; sol[24] -= b0c.x * sol[21]; sol[25] -= b0c.y * sol[21]; sol[26] -= b0c.z * sol[21]; sol[27] -= b0c.w * sol[21]; sol[28] -= b0d.x * sol[21]; sol[29] -= b0d.y * sol[21]; sol[30] -= b0d.z * sol[21]; sol[31] -= b0d.w * sol[21];
  __builtin_amdgcn_sched_barrier(0);
  b0a = *(const float4*)(Lr + 1424); b0b = *(const float4*)(Lr + 1428); b0c = *(const float4*)(Lr + 1432); b0d = *(const float4*)(Lr + 1436);
  __builtin_amdgcn_sched_barrier(0);
  sol[32] -= b1a.x * sol[21]; sol[33] -= b1a.y * sol[21]; sol[34] -= b1a.z * sol[21]; sol[35] -= b1a.w * sol[21]; sol[36] -= b1b.x * sol[21]; sol[37] -= b1b.y * sol[21]; sol[38] -= b1b.z * sol[21]; sol[39] -= b1b.w * sol[21]; sol[40] -= b1c.x * sol[21]; sol[41] -= b1c.y * sol[21]; sol[42] -= b1c.z * sol[21]; sol[43] -= b1c.w * sol[21]; sol[44] -= b1d.x * sol[21]; sol[45] -= b1d.y * sol[21]; sol[46] -= b1d.z * sol[21]; sol[47] -= b1d.w * sol[21];
  __builtin_amdgcn_sched_barrier(0);
  b1a = *(const float4*)(Lr + 1440); b1b = *(const float4*)(Lr + 1444); b1c = *(const float4*)(Lr + 1448); b1d = *(const float4*)(Lr + 1452);
  __builtin_amdgcn_sched_barrier(0);
  sol[48] -= b2a.x * sol[21]; sol[49] -= b2a.y * sol[21]; sol[50] -= b2a.z * sol[21]; sol[51] -= b2a.w * sol[21]; sol[52] -= b2b.x * sol[21]; sol[53] -= b2b.y * sol[21]; sol[54] -= b2b.z * sol[21]; sol[55] -= b2b.w * sol[21]; sol[56] -= b2c.x * sol[21]; sol[57] -= b2c.y * sol[21]; sol[58] -= b2c.z * sol[21]; sol[59] -= b2c.w * sol[21]; sol[60] -= b2d.x * sol[21]; sol[61] -= b2d.y * sol[21]; sol[62] -= b2d.z * sol[21]; sol[63] -= b2d.w * sol[21];
  __builtin_amdgcn_sched_barrier(0);
  b2a = *(const float4*)(Lr + 1456); b2b = *(const float4*)(Lr + 1460); b2c = *(const float4*)(Lr + 1464); b2d = *(const float4*)(Lr + 1468);
  __builtin_amdgcn_sched_barrier(0);
  sol[23] -= b0b.w * sol[22]; sol[24] -= b0c.x * sol[22]; sol[25] -= b0c.y * sol[22]; sol[26] -= b0c.z * sol[22]; sol[27] -= b0c.w * sol[22]; sol[28] -= b0d.x * sol[22]; sol[29] -= b0d.y * sol[22]; sol[30] -= b0d.z * sol[22]; sol[31] -= b0d.w * sol[22];
  __builtin_amdgcn_sched_barrier(0);
  b0a = *(const float4*)(Lr + 1488); b0b = *(const float4*)(Lr + 1492); b0c = *(const float4*)(Lr + 1496); b0d = *(const float4*)(Lr + 1500);
  __builtin_amdgcn_sched_barrier(0);
  sol[32] -= b1a.x * sol[22]; sol[33] -= b1a.y * sol[22]; sol[34] -= b1a.z * sol[22]; sol[35] -= b1a.w * sol[22]; sol[36] -= b1b.x * sol[22]; sol[37] -= b1b.y * sol[22]; sol[38] -= b1b.z * sol[22]; sol[39] -= b1b.w * sol[22]; sol[40] -= b1c.x * sol[22]; sol[41] -= b1c.y * sol[22]; sol[42] -= b1c.z * sol[22]; sol[43] -= b1c.w * sol[22]; sol[44] -= b1d.x * sol[22]; sol[45] -= b1d.y * sol[22]; sol[46] -= b1d.z * sol[22]; sol[47] -= b1d.w * sol[22];
  __builtin_amdgcn_sched_barrier(0);
  b1a = *(const float4*)(Lr + 1504); b1b = *(const float4*)(Lr + 1508); b1c = *(const float4*)(Lr + 1512); b1d = *(const float4*)(Lr + 1516);
  __builtin_amdgcn_sched_barrier(0);
  sol[48] -= b2a.x * sol[22]; sol[49] -= b2a.y * sol[22]; sol[50] -= b2a.z * sol[22]; sol[51] -= b2a.w * sol[22]; sol[52] -= b2b.x * sol[22]; sol[53] -= b2b.y * sol[22]; sol[54] -= b2b.z * sol[22]; sol[55] -= b2b.w * sol[22]; sol[56] -= b2c.x * sol[22]; sol[57] -= b2c.y * sol[22]; sol[58] -= b2c.z * sol[22]; sol[59] -= b2c.w * sol[22]; sol[60] -= b2d.x * sol[22]; sol[61] -= b2d.y * sol[22]; sol[62] -= b2d.z * sol[22]; sol[63] -= b2d.w * sol[22];
  __builtin_amdgcn_sched_barrier(0);
  b2a = *(const float4*)(Lr + 1520); b2b = *(const float4*)(Lr + 1524); b2c = *(const float4*)(Lr + 1528); b2d = *(const float4*)(Lr + 1532);
  __builtin_amdgcn_sched_barrier(0);
  sol[24] -= b0c.x * sol[23]; sol[25] -= b0c.y * sol[23]; sol[26] -= b0c.z * sol[23]; sol[27] -= b0c.w * sol[23]; sol[28] -= b0d.x * sol[23]; sol[29] -= b0d.y * sol[23]; sol[30] -= b0d.z * sol[23]; sol[31] -= b0d.w * sol[23];
  __builtin_amdgcn_sched_barrier(0);
  b0a = *(const float4*)(Lr + 1552); b0b = *(const float4*)(Lr + 1556); b0c = *(const float4*)(Lr + 1560); b0d = *(const float4*)(Lr + 1564);
  __builtin_amdgcn_sched_barrier(0);
  sol[32] -= b1a.x * sol[23]; sol[33] -= b1a.y * sol[23]; sol[34] -= b1a.z * sol[23]; sol[35] -= b1a.w * sol[23]; sol[36] -= b1b.x * sol[23]; sol[37] -= b1b.y * sol[23]; sol[38] -= b1b.z * sol[23]; sol[39] -= b1b.w * sol[23]; sol[40] -= b1c.x * sol[23]; sol[41] -= b1c.y * sol[23]; sol[42] -= b1c.z * sol[23]; sol[43] -= b1c.w * sol[23]; sol[44] -= b1d.x * sol[23]; sol[45] -= b1d.y * sol[23]; sol[46] -= b1d.z * sol[23]; sol[47] -= b1d.w * sol[23];
  __builtin_amdgcn_sched_barrier(0);
  b1a = *(const float4*)(Lr + 1568); b1b = *(const float4*)(Lr + 1572); b1c = *(const float4*)(Lr + 1576); b1d = *(const float4*)(Lr + 1580);
  __builtin_amdgcn_sched_barrier(0);
  sol[48] -= b2a.x * sol[23]; sol[49] -= b2a.y * sol[23]; sol[50] -= b2a.z * sol[23]; sol[51] -= b2a.w * sol[23]; sol[52] -= b2b.x * sol[23]; sol[53] -= b2b.y * sol[23]; sol[54] -= b2b.z * sol[23]; sol[55] -= b2b.w * sol[23]; sol[56] -= b2c.x * sol[23]; sol[57] -= b2c.y * sol[23]; sol[58] -= b2c.z * sol[23]; sol[59] -= b2c.w * sol[23]; sol[60] -= b2d.x * sol[23]; sol[61] -= b2d.y * sol[23]; sol[62] -= b2d.z * sol[23]; sol[63] -= b2d.w * sol[23];
  __builtin_amdgcn_sched_barrier(0);
  b2a = *(const float4*)(Lr + 1584); b2b = *(const float4*)(Lr + 1588); b2c = *(const float4*)(Lr + 1592); b2d = *(const float4*)(Lr + 1596);
  __builtin_amdgcn_sched_barrier(0);
  sol[25] -= b0c.y * sol[24]; sol[26] -= b0c.z * sol[24]; sol[27] -= b0c.w * sol[24]; sol[28] -= b0d.x * sol[24]; sol[29] -= b0d.y * sol[24]; sol[30] -= b0d.z * sol[24]; sol[31] -= b0d.w * sol[24];
  __builtin_amdgcn_sched_barrier(0);
  b0a = *(const float4*)(Lr + 1616); b0b = *(const float4*)(Lr + 1620); b0c = *(const float4*)(Lr + 1624); b0d = *(const float4*)(Lr + 1628);
  __builtin_amdgcn_sched_barrier(0);
  sol[32] -= b1a.x * sol[24]; sol[33] -= b1a.y * sol[24]; sol[34] -= b1a.z * sol[24]; sol[35] -= b1a.w * sol[24]; sol[36] -= b1b.x * sol[24]; sol[37] -= b1b.y * sol[24]; sol[38] -= b1b.z * sol[24]; sol[39] -= b1b.w * sol[24]; sol[40] -= b1c.x * sol[24]; sol[41] -= b1c.y * sol[24]; sol[42] -= b1c.z * sol[24]; sol[43] -= b1c.w * sol[24]; sol[44] -= b1d.x * sol[24]; sol[45] -= b1d.y * sol[24]; sol[46] -= b1d.z * sol[24]; sol[47] -= b1d.w * sol[24];
  __builtin_amdgcn_sched_barrier(0);
  b1a = *(const float4*)(Lr + 1632); b1b = *(const float4*)(Lr + 1636); b1c = *(const float4*)(Lr + 1640); b1d = *(const float4*)(Lr + 1644);
  __builtin_amdgcn_sched_barrier(0);
  sol[48] -= b2a.x * sol[24]; sol[49] -= b2a.y * sol[24]; sol[50] -= b2a.z * sol[24]; sol[51] -= b2a.w * sol[24]; sol[52] -= b2b.x * sol[24]; sol[53] -= b2b.y * sol[24]; sol[54] -= b2b.z * sol[24]; sol[55] -= b2b.w * sol[24]; sol[56] -= b2c.x * sol[24]; sol[57] -= b2c.y * sol[24]; sol[58] -= b2c.z * sol[24]; sol[59] -= b2c.w * sol[24]; sol[60] -= b2d.x * sol[24]; sol[61] -= b2d.y * sol[24]; sol[62] -= b2d.z * sol[24]; sol[63] -= b2d.w * sol[24];
  __builtin_amdgcn_sched_barrier(0);
  b2a = *(const float4*)(Lr + 1648); b2b = *(const float4*)(Lr + 1652); b2c = *(const float4*)(Lr + 1656); b2d = *(const float4*)(Lr + 1660);
  __builtin_amdgcn_sched_barrier(0);
  sol[26] -= b0c.z * sol[25]; sol[27] -= b0c.w * sol[25]; sol[28] -= b0d.x * sol[25]; sol[29] -= b0d.y * sol[25]; sol[30] -= b0d.z * sol[25]; sol[31] -= b0d.w * sol[25];
  __builtin_amdgcn_sched_barrier(0);
  b0a = *(const float4*)(Lr + 1680); b0b = *(const float4*)(Lr + 1684); b0c = *(const float4*)(Lr + 1688); b0d = *(const float4*)(Lr + 1692);
  __builtin_amdgcn_sched_barrier(0);
  sol[32] -= b1a.x * sol[25]; sol[33] -= b1a.y * sol[25]; sol[34] -= b1a.z * sol[25]; sol[35] -= b1a.w * sol[25]; sol[36] -= b1b.x * sol[25]; sol[37] -= b1b.y * sol[25]; sol[38] -= b1b.z * sol[25]; sol[39] -= b1b.w * sol[25]; sol[40] -= b1c.x * sol[25]; sol[41] -= b1c.y * sol[25]; sol[42] -= b1c.z * sol[25]; sol[43] -= b1c.w * sol[25]; sol[44] -= b1d.x * sol[25]; sol[45] -= b1d.y * sol[25]; sol[46] -= b1d.z * sol[25]; sol[47] -= b1d.w * sol[25];
  __builtin_amdgcn_sched_barrier(0);
  b1a = *(const float4*)(Lr + 1696); b1b = *(const float4*)(Lr + 1700); b1c = *(const float4*)(Lr + 1704); b1d = *(const float4*)(Lr + 1708);
  __builtin_amdgcn_sched_barrier(0);
  sol[48] -= b2a.x * sol[25]; sol[49] -= b2a.y * sol[25]; sol[50] -= b2a.z * sol[25]; sol[51] -= b2a.w * sol[25]; sol[52] -= b2b.x * sol[25]; sol[53] -= b2b.y * sol[25]; sol[54] -= b2b.z * sol[25]; sol[55] -= b2b.w * sol[25]; sol[56] -= b2c.x * sol[25]; sol[57] -= b2c.y * sol[25]; sol[58] -= b2c.z * sol[25]; sol[59] -= b2c.w * sol[25]; sol[60] -= b2d.x * sol[25]; sol[61] -= b2d.y * sol[25]; sol[62] -= b2d.z * sol[25]; sol[63] -= b2d.w * sol[25];
  __builtin_amdgcn_sched_barrier(0);
  b2a = *(const float4*)(Lr + 1712); b2b = *(const float4*)(Lr + 1716); b2c = *(const float4*)(Lr + 1720); b2d = *(const float4*)(Lr + 1724);
  __builtin_amdgcn_sched_barrier(0);
  sol[27] -= b0c.w * sol[26]; sol[28] -= b0d.x * sol[26]; sol[29] -= b0d.y * sol[26]; sol[30] -= b0d.z * sol[26]; sol[31] -= b0d.w * sol[26];
  __builtin_amdgcn_sched_barrier(0);
  b0a = *(const float4*)(Lr + 1744); b0b = *(const float4*)(Lr + 1748); b0c = *(const float4*)(Lr + 1752); b0d = *(const float4*)(Lr + 1756);
  __builtin_amdgcn_sched_barrier(0);
  sol[32] -= b1a.x * sol[26]; sol[33] -= b1a.y * sol[26]; sol[34] -= b1a.z * sol[26]; sol[35] -= b1a.w * sol[26]; sol[36] -= b1b.x * sol[26]; sol[37] -= b1b.y * sol[26]; sol[38] -= b1b.z * sol[26]; sol[39] -= b1b.w * sol[26]; sol[40] -= b1c.x * sol[26]; sol[41] -= b1c.y * sol[26]; sol[42] -= b1c.z * sol[26]; sol[43] -= b1c.w * sol[26]; sol[44] -= b1d.x * sol[26]; sol[45] -= b1d.y * sol[26]; sol[46] -= b1d.z * sol[26]; sol[47] -= b1d.w * sol[26];
  __builtin_amdgcn_sched_barrier(0);
  b1a = *(const float4*)(Lr + 1760); b1b = *(const float4*)(Lr + 1764); b1c = *(const float4*)(Lr + 1768); b1d = *(const float4*)(Lr + 1772);
  __builtin_amdgcn_sched_barrier(0);
  sol[48] -= b2a.x * sol[26]; sol[49] -= b2a.y * sol[26]; sol[50] -= b2a.z * sol[26]; sol[51] -= b2a.w * sol[26]; sol[52] -= b2b.x * sol[26]; sol[53] -= b2b.y * sol[26]; sol[54] -= b2b.z * sol[26]; sol[55] -= b2b.w * sol[26]; sol[56] -= b2c.x * sol[26]; sol[57] -= b2c.y * sol[26]; sol[58] -= b2c.z * sol[26]; sol[59] -= b2c.w * sol[26]; sol[60] -= b2d.x * sol[26]; sol[61] -= b2d.y * sol[26]; sol[62] -= b2d.z * sol[26]; sol[63] -= b2d.w * sol[26];
  __builtin_amdgcn_sched_barrier(0);
  b2a = *(const float4*)(Lr + 1776); b2b = *(const float4*)(Lr + 1780); b2c = *(const float4*)(Lr + 1784); b2d = *(const float4*)(Lr + 1788);
  __builtin_amdgcn_sched_barrier(0);
  sol[28] -= b0d.x * sol[27]; sol[29] -= b0d.y * sol[27]; sol[30] -= b0d.z * sol[27]; sol[31] -= b0d.w * sol[27];
  __builtin_amdgcn_sched_barrier(0);
  b0a = *(const float4*)(Lr + 1808); b0b = *(const float4*)(Lr + 1812); b0c = *(const float4*)(Lr + 1816); b0d = *(const float4*)(Lr + 1820);
  __builtin_amdgcn_sched_barrier(0);
  sol[32] -= b1a.x * sol[27]; sol[33] -= b1a.y * sol[27]; sol[34] -= b1a.z * sol[27]; sol[35] -= b1a.w * sol[27]; sol[36] -= b1b.x * sol[27]; sol[37] -= b1b.y * sol[27]; sol[38] -= b1b.z * sol[27]; sol[39] -= b1b.w * sol[27]; sol[40] -= b1c.x * sol[27]; sol[41] -= b1c.y * sol[27]; sol[42] -= b1c.z * sol[27]; sol[43] -= b1c.w * sol[27]; sol[44] -= b1d.x * sol[27]; sol[45] -= b1d.y * sol[27]; sol[46] -= b1d.z * sol[27]; sol[47] -= b1d.w * sol[27];
  __builtin_amdgcn_sched_barrier(0);
  b1a = *(const float4*)(Lr + 1824); b1b = *(const float4*)(Lr + 1828); b1c = *(const float4*)(Lr + 1832); b1d = *(const float4*)(Lr + 1836);
  __builtin_amdgcn_sched_barrier(0);
  sol[48] -= b2a.x * sol[27]; sol[49] -= b2a.y * sol[27]; sol[50] -= b2a.z * sol[27]; sol[51] -= b2a.w * sol[27]; sol[52] -= b2b.x * sol[27]; sol[53] -= b2b.y * sol[27]; sol[54] -= b2b.z * sol[27]; sol[55] -= b2b.w * sol[27]; sol[56] -= b2c.x * sol[27]; sol[57] -= b2c.y * sol[27]; sol[58] -= b2c.z * sol[27]; sol[59] -= b2c.w * sol[27]; sol[60] -= b2d.x * sol[27]; sol[61] -= b2d.y * sol[27]; sol[62] -= b2d.z * sol[27]; sol[63] -= b2d.w * sol[27];
  __builtin_amdgcn_sched_barrier(0);
  b2a = *(const float4*)(Lr + 1840); b2b = *(const float4*)(Lr + 1844); b2c = *(const float4*)(Lr + 1848); b2d = *(const float4*)(Lr + 1852);
  __builtin_amdgcn_sched_barrier(0);
  sol[29] -= b0d.y * sol[28]; sol[30] -= b0d.z * sol[28]; sol[31] -= b0d.w * sol[28];
  __builtin_amdgcn_sched_barrier(0);
  b0a = *(const float4*)(Lr + 1872); b0b = *(const float4*)(Lr + 1876); b0c = *(const float4*)(Lr + 1880); b0d = *(const float4*)(Lr + 1884);
  __builtin_amdgcn_sched_barrier(0);
  sol[32] -= b1a.x * sol[28]; sol[33] -= b1a.y * sol[28]; sol[34] -= b1a.z * sol[28]; sol[35] -= b1a.w * sol[28]; sol[36] -= b1b.x * sol[28]; sol[37] -= b1b.y * sol[28]; sol[38] -= b1b.z * sol[28]; sol[39] -= b1b.w * sol[28]; sol[40] -= b1c.x * sol[28]; sol[41] -= b1c.y * sol[28]; sol[42] -= b1c.z * sol[28]; sol[43] -= b1c.w * sol[28]; sol[44] -= b1d.x * sol[28]; sol[45] -= b1d.y * sol[28]; sol[46] -= b1d.z * sol[28]; sol[47] -= b1d.w * sol[28];
  __builtin_amdgcn_sched_barrier(0);
  b1a = *(const float4*)(Lr + 1888); b1b = *(const float4*)(Lr + 1892); b1c = *(const float4*)(Lr + 1896); b1d = *(const float4*)(Lr + 1900);
  __builtin_amdgcn_sched_barrier(0);
  sol[48] -= b2a.x * sol[28]; sol[49] -= b2a.y * sol[28]; sol[50] -= b2a.z * sol[28]; sol[51] -= b2a.w * sol[28]; sol[52] -= b2b.x * sol[28]; sol[53] -= b2b.y * sol[28]; sol[54] -= b2b.z * sol[28]; sol[55] -= b2b.w * sol[28]; sol[56] -= b2c.x * sol[28]; sol[57] -= b2c.y * sol[28]; sol[58] -= b2c.z * sol[28]; sol[59] -= b2c.w * sol[28]; sol[60] -= b2d.x * sol[28]; sol[61] -= b2d.y * sol[28]; sol[62] -= b2d.z * sol[28]; sol[63] -= b2d.w * sol[28];
  __builtin_amdgcn_sched_barrier(0);
  b2a = *(const float4*)(Lr + 1904); b2b = *(const float4*)(Lr + 1908); b2c = *(const float4*)(Lr + 1912); b2d = *(const float4*)(Lr + 1916);
  __builtin_amdgcn_sched_barrier(0);
  sol[30] -= b0d.z * sol[29]; sol[31] -= b0d.w * sol[29];
  __builtin_amdgcn_sched_barrier(0);
  b0a = *(const float4*)(Lr + 1936); b0b = *(const float4*)(Lr + 1940); b0c = *(const float4*)(Lr + 1944); b0d = *(const float4*)(Lr + 1948);
  __builtin_amdgcn_sched_barrier(0);
  sol[32] -= b1a.x * sol[29]; sol[33] -= b1a.y * sol[29]; sol[34] -= b1a.z * sol[29]; sol[35] -= b1a.w * sol[29]; sol[36] -= b1b.x * sol[29]; sol[37] -= b1b.y * sol[29]; sol[38] -= b1b.z * sol[29]; sol[39] -= b1b.w * sol[29]; sol[40] -= b1c.x * sol[29]; sol[41] -= b1c.y * sol[29]; sol[42] -= b1c.z * sol[29]; sol[43] -= b1c.w * sol[29]; sol[44] -= b1d.x * sol[29]; sol[45] -= b1d.y * sol[29]; sol[46] -= b1d.z * sol[29]; sol[47] -= b1d.w * sol[29];
  __builtin_amdgcn_sched_barrier(0);
  b1a = *(const float4*)(Lr + 1952); b1b = *(const float4*)(Lr + 1956); b1c = *(const float4*)(Lr + 1960); b1d = *(const float4*)(Lr + 1964);
  __builtin_amdgcn_sched_barrier(0);
  sol[48] -= b2a.x * sol[29]; sol[49] -= b2a.y * sol[29]; sol[50] -= b2a.z * sol[29]; sol[51] -= b2a.w * sol[29]; sol[52] -= b2b.x * sol[29]; sol[53] -= b2b.y * sol[29]; sol[54] -= b2b.z * sol[29]; sol[55] -= b2b.w * sol[29]; sol[56] -= b2c.x * sol[29]; sol[57] -= b2c.y * sol[29]; sol[58] -= b2c.z * sol[29]; sol[59] -= b2c.w * sol[29]; sol[60] -= b2d.x * sol[29]; sol[61] -= b2d.y * sol[29]; sol[62] -= b2d.z * sol[29]; sol[63] -= b2d.w * sol[29];
  __builtin_amdgcn_sched_barrier(0);
  b2a = *(const float4*)(Lr + 1968); b2b = *(const float4*)(Lr + 1972); b2c = *(const float4*)(Lr + 1976); b2d = *(const float4*)(Lr + 1980);
  __builtin_amdgcn_sched_barrier(0);
  sol[31] -= b0d.w * sol[30];
  __builtin_amdgcn_sched_barrier(0);
  b0a = *(const float4*)(Lr + 2016); b0b = *(const float4*)(Lr + 2020); b0c = *(const float4*)(Lr + 2024); b0d = *(const float4*)(Lr + 2028);
  __builtin_amdgcn_sched_barrier(0);
  sol[32] -= b1a.x * sol[30]; sol[33] -= b1a.y * sol[30]; sol[34] -= b1a.z * sol[30]; sol[35] -= b1a.w * sol[30]; sol[36] -= b1b.x * sol[30]; sol[37] -= b1b.y * sol[30]; sol[38] -= b1b.z * sol[30]; sol[39] -= b1b.w * sol[30]; sol[40] -= b1c.x * sol[30]; sol[41] -= b1c.y * sol[30]; sol[42] -= b1c.z * sol[30]; sol[43] -= b1c.w * sol[30]; sol[44] -= b1d.x * sol[30]; sol[45] -= b1d.y * sol[30]; sol[46] -= b1d.z * sol[30]; sol[47] -= b1d.w * sol[30];
  __builtin_amdgcn_sched_barrier(0);
  b1a = *(const float4*)(Lr + 2032); b1b = *(const float4*)(Lr + 2036); b1c = *(const float4*)(Lr + 2040); b1d = *(const float4*)(Lr + 2044);
  __builtin_amdgcn_sched_barrier(0);
  sol[48] -= b2a.x * sol[30]; sol[49] -= b2a.y * sol[30]; sol[50] -= b2a.z * sol[30]; sol[51] -= b2a.w * sol[30]; sol[52] -= b2b.x * sol[30]; sol[53] -= b2b.y * sol[30]; sol[54] -= b2b.z * sol[30]; sol[55] -= b2b.w * sol[30]; sol[56] -= b2c.x * sol[30]; sol[57] -= b2c.y * sol[30]; sol[58] -= b2c.z * sol[30]; sol[59] -= b2c.w * sol[30]; sol[60] -= b2d.x * sol[30]; sol[61] -= b2d.y * sol[30]; sol[62] -= b2d.z * sol[30]; sol[63] -= b2d.w * sol[30];
  __builtin_amdgcn_sched_barrier(0);
  b2a = *(const float4*)(Lr + 2080); b2b = *(const float4*)(Lr + 2084); b2c = *(const float4*)(Lr + 2088); b2d = *(const float4*)(Lr + 2092);
  __builtin_amdgcn_sched_barrier(0);
  sol[32] -= b0a.x * sol[31]; sol[33] -= b0a.y * sol[31]; sol[34] -= b0a.z * sol[31]; sol[35] -= b0a.w * sol[31]; sol[36] -= b0b.x * sol[31]; sol[37] -= b0b.y * sol[31]; sol[38] -= b0b.z * sol[31]; sol[39] -= b0b.w * sol[31]; sol[40] -= b0c.x * sol[31]; sol[41] -= b0c.y * sol[31]; sol[42] -= b0c.z * sol[31]; sol[43] -= b0c.w * sol[31]; sol[44] -= b0d.x * sol[31]; sol[45] -= b0d.y * sol[31]; sol[46] -= b0d.z * sol[31]; sol[47] -= b0d.w * sol[31];
  __builtin_amdgcn_sched_barrier(0);
  b0a = *(const float4*)(Lr + 2096); b0b = *(const float4*)(Lr + 2100); b0c = *(const float4*)(Lr + 2104); b0d = *(const float4*)(Lr + 2108);
  __builtin_amdgcn_sched_barrier(0);
  sol[48] -= b1a.x * sol[31]; sol[49] -= b1a.y * sol[31]; sol[50] -= b1a.z * sol[31]; sol[51] -= b1a.w * sol[31]; sol[52] -= b1b.x * sol[31]; sol[53] -= b1b.y * sol[31]; sol[54] -= b1b.z * sol[31]; sol[55] -= b1b.w * sol[31]; sol[56] -= b1c.x * sol[31]; sol[57] -= b1c.y * sol[31]; sol[58] -= b1c.z * sol[31]; sol[59] -= b1c.w * sol[31]; sol[60] -= b1d.x * sol[31]; sol[61] -= b1d.y * sol[31]; sol[62] -= b1d.z * sol[31]; sol[63] -= b1d.w * sol[31];
  __builtin_amdgcn_sched_barrier(0);
  b1a = *(const float4*)(Lr + 2144); b1b = *(const float4*)(Lr + 2148); b1c = *(const float4*)(Lr + 2152); b1d = *(const float4*)(Lr + 2156);
  __builtin_amdgcn_sched_barrier(0);
  sol[33] -= b2a.y * sol[32]; sol[34] -= b2a.z * sol[32]; sol[35] -= b2a.w * sol[32]; sol[36] -= b2b.x * sol[32]; sol[37] -= b2b.y * sol[32]; sol[38] -= b2b.z * sol[32]; sol[39] -= b2b.w * sol[32]; sol[40] -= b2c.x * sol[32]; sol[41] -= b2c.y * sol[32]; sol[42] -= b2c.z * sol[32]; sol[43] -= b2c.w * sol[32]; sol[44] -= b2d.x * sol[32]; sol[45] -= b2d.y * sol[32]; sol[46] -= b2d.z * sol[32]; sol[47] -= b2d.w * sol[32];
  __builtin_amdgcn_sched_barrier(0);
  b2a = *(const float4*)(Lr + 2160); b2b = *(const float4*)(Lr + 2164); b2c = *(const float4*)(Lr + 2168); b2d = *(const float4*)(Lr + 2172);
  __builtin_amdgcn_sched_barrier(0);
  sol[48] -= b0a.x * sol[32]; sol[49] -= b0a.y * sol[32]; sol[50] -= b0a.z * sol[32]; sol[51] -= b0a.w * sol[32]; sol[52] -= b0b.x * sol[32]; sol[53] -= b0b.y * sol[32]; sol[54] -= b0b.z * sol[32]; sol[55] -= b0b.w * sol[32]; sol[56] -= b0c.x * sol[32]; sol[57] -= b0c.y * sol[32]; sol[58] -= b0c.z * sol[32]; sol[59] -= b0c.w * sol[32]; sol[60] -= b0d.x * sol[32]; sol[61] -= b0d.y * sol[32]; sol[62] -= b0d.z * sol[32]; sol[63] -= b0d.w * sol[32];
  __builtin_amdgcn_sched_barrier(0);
  b0a = *(const float4*)(Lr + 2208); b0b = *(const float4*)(Lr + 2212); b0c = *(const float4*)(Lr + 2216); b0d = *(const float4*)(Lr + 2220);
  __builtin_amdgcn_sched_barrier(0);
  sol[34] -= b1a.z * sol[33]; sol[35] -= b1a.w * sol[33]; sol[36] -= b1b.x * sol[33]; sol[37] -= b1b.y * sol[33]; sol[38] -= b1b.z * sol[33]; sol[39] -= b1b.w * sol[33]; sol[40] -= b1c.x * sol[33]; sol[41] -= b1c.y * sol[33]; sol[42] -= b1c.z * sol[33]; sol[43] -= b1c.w * sol[33]; sol[44] -= b1d.x * sol[33]; sol[45] -= b1d.y * sol[33]; sol[46] -= b1d.z * sol[33]; sol[47] -= b1d.w * sol[33];
  __builtin_amdgcn_sched_barrier(0);
  b1a = *(const float4*)(Lr + 2224); b1b = *(const float4*)(Lr + 2228); b1c = *(const float4*)(Lr + 2232); b1d = *(const float4*)(Lr + 2236);
  __builtin_amdgcn_sched_barrier(0);
  sol[48] -= b2a.x * sol[33]; sol[49] -= b2a.y * sol[33]; sol[50] -= b2a.z * sol[33]; sol[51] -= b2a.w * sol[33]; sol[52] -= b2b.x * sol[33]; sol[53] -= b2b.y * sol[33]; sol[54] -= b2b.z * sol[33]; sol[55] -= b2b.w * sol[33]; sol[56] -= b2c.x * sol[33]; sol[57] -= b2c.y * sol[33]; sol[58] -= b2c.z * sol[33]; sol[59] -= b2c.w * sol[33]; sol[60] -= b2d.x * sol[33]; sol[61] -= b2d.y * sol[33]; sol[62] -= b2d.z * sol[33]; sol[63] -= b2d.w * sol[33];
  __builtin_amdgcn_sched_barrier(0);
  b2a = *(const float4*)(Lr + 2272); b2b = *(const float4*)(Lr + 2276); b2c = *(const float4*)(Lr + 2280); b2d = *(const float4*)(Lr + 2284);
  __builtin_amdgcn_sched_barrier(0);
  sol[35] -= b0a.w * sol[34]; sol[36] -= b0b.x * sol[34]; sol[37] -= b0b.y * sol[34]; sol[38] -= b0b.z * sol[34]; sol[39] -= b0b.w * sol[34]; sol[40] -= b0c.x * sol[34]; sol[41] -= b0c.y * sol[34]; sol[42] -= b0c.z * sol[34]; sol[43] -= b0c.w * sol[34]; sol[44] -= b0d.x * sol[34]; sol[45] -= b0d.y * sol[34]; sol[46] -= b0d.z * sol[34]; sol[47] -= b0d.w * sol[34];
  __builtin_amdgcn_sched_barrier(0);
  b0a = *(const float4*)(Lr + 2288); b0b = *(const float4*)(Lr + 2292); b0c = *(const float4*)(Lr + 2296); b0d = *(const float4*)(Lr + 2300);
  __builtin_amdgcn_sched_barrier(0);
  sol[48] -= b1a.x * sol[34]; sol[49] -= b1a.y * sol[34]; sol[50] -= b1a.z * sol[34]; sol[51] -= b1a.w * sol[34]; sol[52] -= b1b.x * sol[34]; sol[53] -= b1b.y * sol[34]; sol[54] -= b1b.z * sol[34]; sol[55] -= b1b.w * sol[34]; sol[56] -= b1c.x * sol[34]; sol[57] -= b1c.y * sol[34]; sol[58] -= b1c.z * sol[34]; sol[59] -= b1c.w * sol[34]; sol[60] -= b1d.x * sol[34]; sol[61] -= b1d.y * sol[34]; sol[62] -= b1d.z * sol[34]; sol[63] -= b1d.w * sol[34];
  __builtin_amdgcn_sched_barrier(0);
  b1a = *(const float4*)(Lr + 2336); b1b = *(const float4*)(Lr + 2340); b1c = *(const float4*)(Lr + 2344); b1d = *(const float4*)(Lr + 2348);
  __builtin_amdgcn_sched_barrier(0);
  sol[36] -= b2b.x * sol[35]; sol[37] -= b2b.y * sol[35]; sol[38] -= b2b.z * sol[35]; sol[39] -= b2b.w * sol[35]; sol[40] -= b2c.x * sol[35]; sol[41] -= b2c.y * sol[35]; sol[42] -= b2c.z * sol[35]; sol[43] -= b2c.w * sol[35]; sol[44] -= b2d.x * sol[35]; sol[45] -= b2d.y * sol[35]; sol[46] -= b2d.z * sol[35]; sol[47] -= b2d.w * sol[35];
  __builtin_amdgcn_sched_barrier(0);
  b2a = *(const float4*)(Lr + 2352); b2b = *(const float4*)(Lr + 2356); b2c = *(const float4*)(Lr + 2360); b2d = *(const float4*)(Lr + 2364);
  __builtin_amdgcn_sched_barrier(0);
  sol[48] -= b0a.x * sol[35]; sol[49] -= b0a.y * sol[35]; sol[50] -= b0a.z * sol[35]; sol[51] -= b0a.w * sol[35]; sol[52] -= b0b.x * sol[35]; sol[53] -= b0b.y * sol[35]; sol[54] -= b0b.z * sol[35]; sol[55] -= b0b.w * sol[35]; sol[56] -= b0c.x * sol[35]; sol[57] -= b0c.y * sol[35]; sol[58] -= b0c.z * sol[35]; sol[59] -= b0c.w * sol[35]; sol[60] -= b0d.x * sol[35]; sol[61] -= b0d.y * sol[35]; sol[62] -= b0d.z * sol[35]; sol[63] -= b0d.w * sol[35];
  __builtin_amdgcn_sched_barrier(0);
  b0a = *(const float4*)(Lr + 2400); b0b = *(const float4*)(Lr + 2404); b0c = *(const float4*)(Lr + 2408); b0d = *(const float4*)(Lr + 2412);
  __builtin_amdgcn_sched_barrier(0);
  sol[37] -= b1b.y * sol[36]; sol[38] -= b1b.z * sol[36]; sol[39] -= b1b.w * sol[36]; sol[40] -= b1c.x * sol[36]; sol[41] -= b1c.y * sol[36]; sol[42] -= b1c.z * sol[36]; sol[43] -= b1c.w * sol[36]; sol[44] -= b1d.x * sol[36]; sol[45] -= b1d.y * sol[36]; sol[46] -= b1d.z * sol[36]; sol[47] -= b1d.w * sol[36];
  __builtin_amdgcn_sched_barrier(0);
  b1a = *(const float4*)(Lr + 2416); b1b = *(const float4*)(Lr + 2420); b1c = *(const float4*)(Lr + 2424); b1d = *(const float4*)(Lr + 2428);
  __builtin_amdgcn_sched_barrier(0);
  sol[48] -= b2a.x * sol[36]; sol[49] -= b2a.y * sol[36]; sol[50] -= b2a.z * sol[36]; sol[51] -= b2a.w * sol[36]; sol[52] -= b2b.x * sol[36]; sol[53] -= b2b.y * sol[36]; sol[54] -= b2b.z * sol[36]; sol[55] -= b2b.w * sol[36]; sol[56] -= b2c.x * sol[36]; sol[57] -= b2c.y * sol[36]; sol[58] -= b2c.z * sol[36]; sol[59] -= b2c.w * sol[36]; sol[60] -= b2d.x * sol[36]; sol[61] -= b2d.y * sol[36]; sol[62] -= b2d.z * sol[36]; sol[63] -= b2d.w * sol[36];
  __builtin_amdgcn_sched_barrier(0);
  b2a = *(const float4*)(Lr + 2464); b2b = *(const float4*)(Lr + 2468); b2c = *(const float4*)(Lr + 2472); b2d = *(const float4*)(Lr + 2476);
  __builtin_amdgcn_sched_barrier(0);
  sol[38] -= b0b.z * sol[37]; sol[39] -= b0b.w * sol[37]; sol[40] -= b0c.x * sol[37]; sol[41] -= b0c.y * sol[37]; sol[42] -= b0c.z * sol[37]; sol[43] -= b0c.w * sol[37]; sol[44] -= b0d.x * sol[37]; sol[45] -= b0d.y * sol[37]; sol[46] -= b0d.z * sol[37]; sol[47] -= b0d.w * sol[37];
  __builtin_amdgcn_sched_barrier(0);
  b0a = *(const float4*)(Lr + 2480); b0b = *(const float4*)(Lr + 2484); b0c = *(const float4*)(Lr + 2488); b0d = *(const float4*)(Lr + 2492);
  __builtin_amdgcn_sched_barrier(0);
  sol[48] -= b1a.x * sol[37]; sol[49] -= b1a.y * sol[37]; sol[50] -= b1a.z * sol[37]; sol[51] -= b1a.w * sol[37]; sol[52] -= b1b.x * sol[37]; sol[53] -= b1b.y * sol[37]; sol[54] -= b1b.z * sol[37]; sol[55] -= b1b.w * sol[37]; sol[56] -= b1c.x * sol[37]; sol[57] -= b1c.y * sol[37]; sol[58] -= b1c.z * sol[37]; sol[59] -= b1c.w * sol[37]; sol[60] -= b1d.x * sol[37]; sol[61] -= b1d.y * sol[37]; sol[62] -= b1d.z * sol[37]; sol[63] -= b1d.w * sol[37];
  __builtin_amdgcn_sched_barrier(0);
  b1a = *(const float4*)(Lr + 2528); b1b = *(const float4*)(Lr + 2532); b1c = *(const float4*)(Lr + 2536); b1d = *(const float4*)(Lr + 2540);
  __builtin_amdgcn_sched_barrier(0);
  sol[39] -= b2b.w * sol[38]; sol[40] -= b2c.x * sol[38]; sol[41] -= b2c.y * sol[38]; sol[42] -= b2c.z * sol[38]; sol[43] -= b2c.w * sol[38]; sol[44] -= b2d.x * sol[38]; sol[45] -= b2d.y * sol[38]; sol[46] -= b2d.z * sol[38]; sol[47] -= b2d.w * sol[38];
  __builtin_amdgcn_sched_barrier(0);
  b2a = *(const float4*)(Lr + 2544); b2b = *(const float4*)(Lr + 2548); b2c = *(const float4*)(Lr + 2552); b2d = *(const float4*)(Lr + 2556);
  __builtin_amdgcn_sched_barrier(0);
  sol[48] -= b0a.x * sol[38]; sol[49] -= b0a.y * sol[38]; sol[50] -= b0a.z * sol[38]; sol[51] -= b0a.w * sol[38]; sol[52] -= b0b.x * sol[38]; sol[53] -= b0b.y * sol[38]; sol[54] -= b0b.z * sol[38]; sol[55] -= b0b.w * sol[38]; sol[56] -= b0c.x * sol[38]; sol[57] -= b0c.y * sol[38]; sol[58] -= b0c.z * sol[38]; sol[59] -= b0c.w * sol[38]; sol[60] -= b0d.x * sol[38]; sol[61] -= b0d.y * sol[38]; sol[62] -= b0d.z * sol[38]; sol[63] -= b0d.w * sol[38];
  __builtin_amdgcn_sched_barrier(0);
  b0a = *(const float4*)(Lr + 2592); b0b = *(const float4*)(Lr + 2596); b0c = *(const float4*)(Lr + 2600); b0d = *(const float4*)(Lr + 2604);
  __builtin_amdgcn_sched_barrier(0);
  sol[40] -= b1c.x * sol[39]; sol[41] -= b1c.y * sol[39]; sol[42] -= b1c.z * sol[39]; sol[43] -= b1c.w * sol[39]; sol[44] -= b1d.x * sol[39]; sol[45] -= b1d.y * sol[39]; sol[46] -= b1d.z * sol[39]; sol[47] -= b1d.w * sol[39];
  __builtin_amdgcn_sched_barrier(0);
  b1a = *(const float4*)(Lr + 2608); b1b = *(const float4*)(Lr + 2612); b1c = *(const float4*)(Lr + 2616); b1d = *(const float4*)(Lr + 2620);
  __builtin_amdgcn_sched_barrier(0);
  sol[48] -= b2a.x * sol[39]; sol[49] -= b2a.y * sol[39]; sol[50] -= b2a.z * sol[39]; sol[51] -= b2a.w * sol[39]; sol[52] -= b2b.x * sol[39]; sol[53] -= b2b.y * sol[39]; sol[54] -= b2b.z * sol[39]; sol[55] -= b2b.w * sol[39]; sol[56] -= b2c.x * sol[39]; sol[57] -= b2c.y * sol[39]; sol[58] -= b2c.z * sol[39]; sol[59] -= b2c.w * sol[39]; sol[60] -= b2d.x * sol[39]; sol[61] -= b2d.y * sol[39]; sol[62] -= b2d.z * sol[39]; sol[63] -= b2d.w * sol[39];
  __builtin_amdgcn_sched_barrier(0);
  b2a = *(const float4*)(Lr + 2656); b2b = *(const float4*)(Lr + 2660); b2c = *(const float4*)(Lr + 2664); b2d = *(const float4*)(Lr + 2668);
  __builtin_amdgcn_sched_barrier(0);
  sol[41] -= b0c.y * sol[40]; sol[42] -= b0c.z * sol[40]; sol[43] -= b0c.w * sol[40]; sol[44] -= b0d.x * sol[40]; sol[45] -= b0d.y * sol[40]; sol[46] -= b0d.z * sol[40]; sol[47] -= b0d.w * sol[40];
  __builtin_amdgcn_sched_barrier(0);
  b0a = *(const float4*)(Lr + 2672); b0b = *(const float4*)(Lr + 2676); b0c = *(const float4*)(Lr + 2680); b0d = *(const float4*)(Lr + 2684);
  __builtin_amdgcn_sched_barrier(0);
  sol[48] -= b1a.x * sol[40]; sol[49] -= b1a.y * sol[40]; sol[50] -= b1a.z * sol[40]; sol[51] -= b1a.w * sol[40]; sol[52] -= b1b.x * sol[40]; sol[53] -= b1b.y * sol[40]; sol[54] -= b1b.z * sol[40]; sol[55] -= b1b.w * sol[40]; sol[56] -= b1c.x * sol[40]; sol[57] -= b1c.y * sol[40]; sol[58] -= b1c.z * sol[40]; sol[59] -= b1c.w * sol[40]; sol[60] -= b1d.x * sol[40]; sol[61] -= b1d.y * sol[40]; sol[62] -= b1d.z * sol[40]; sol[63] -= b1d.w * sol[40];
  __builtin_amdgcn_sched_barrier(0);
  b1a = *(const float4*)(Lr + 2720); b1b = *(const float4*)(Lr + 2724); b1c = *(const float4*)(Lr + 2728); b1d = *(const float4*)(Lr + 2732);
  __builtin_amdgcn_sched_barrier(0);
  sol[42] -= b2c.z * sol[41]; sol[43] -= b2c.w * sol[41]; sol[44] -= b2d.x * sol[41]; sol[45] -= b2d.y * sol[41]; sol[46] -= b2d.z * sol[41]; sol[47] -= b2d.w * sol[41];
  __builtin_amdgcn_sched_barrier(0);
  b2a = *(const float4*)(Lr + 2736); b2b = *(const float4*)(Lr + 2740); b2c = *(const float4*)(Lr + 2744); b2d = *(const float4*)(Lr + 2748);
  __builtin_amdgcn_sched_barrier(0);
  sol[48] -= b0a.x * sol[41]; sol[49] -= b0a.y * sol[41]; sol[50] -= b0a.z * sol[41]; sol[51] -= b0a.w * sol[41]; sol[52] -= b0b.x * sol[41]; sol[53] -= b0b.y * sol[41]; sol[54] -= b0b.z * sol[41]; sol[55] -= b0b.w * sol[41]; sol[56] -= b0c.x * sol[41]; sol[57] -= b0c.y * sol[41]; sol[58] -= b0c.z * sol[41]; sol[59] -= b0c.w * sol[41]; sol[60] -= b0d.x * sol[41]; sol[61] -= b0d.y * sol[41]; sol[62] -= b0d.z * sol[41]; sol[63] -= b0d.w * sol[41];
  __builtin_amdgcn_sched_barrier(0);
  b0a = *(const float4*)(Lr + 2784); b0b = *(const float4*)(Lr + 2788); b0c = *(const float4*)(Lr + 2792); b0d = *(const float4*)(Lr + 2796);
  __builtin_amdgcn_sched_barrier(0);
  sol[43] -= b1c.w * sol[42]; sol[44] -= b1d.x * sol[42]; sol[45] -= b1d.y * sol[42]; sol[46] -= b1d.z * sol[42]; sol[47] -= b1d.w * sol[42];
  __builtin_amdgcn_sched_barrier(0);
  b1a = *(const float4*)(Lr + 2800); b1b = *(const float4*)(Lr + 2804); b1c = *(const float4*)(Lr + 2808); b1d = *(const float4*)(Lr + 2812);
  __builtin_amdgcn_sched_barrier(0);
  sol[48] -= b2a.x * sol[42]; sol[49] -= b2a.y * sol[42]; sol[50] -= b2a.z * sol[42]; sol[51] -= b2a.w * sol[42]; sol[52] -= b2b.x * sol[42]; sol[53] -= b2b.y * sol[42]; sol[54] -= b2b.z * sol[42]; sol[55] -= b2b.w * sol[42]; sol[56] -= b2c.x * sol[42]; sol[57] -= b2c.y * sol[42]; sol[58] -= b2c.z * sol[42]; sol[59] -= b2c.w * sol[42]; sol[60] -= b2d.x * sol[42]; sol[61] -= b2d.y * sol[42]; sol[62] -= b2d.z * sol[42]; sol[63] -= b2d.w * sol[42];
  __builtin_amdgcn_sched_barrier(0);
  b2a = *(const float4*)(Lr + 2848); b2b = *(const float4*)(Lr + 2852); b2c = *(const float4*)(Lr + 2856); b2d = *(const float4*)(Lr + 2860);
  __builtin_amdgcn_sched_barrier(0);
  sol[44] -= b0d.x * sol[43]; sol[45] -= b0d.y * sol[43]; sol[46] -= b0d.z * sol[43]; sol[47] -= b0d.w * sol[43];
  __builtin_amdgcn_sched_barrier(0);
  b0a = *(const float4*)(Lr + 2864); b0b = *(const float4*)(Lr + 2868); b0c = *(const float4*)(Lr + 2872); b0d = *(const float4*)(Lr + 2876);
  __builtin_amdgcn_sched_barrier(0);
  sol[48] -= b1a.x * sol[43]; sol[49] -= b1a.y * sol[43]; sol[50] -= b1a.z * sol[43]; sol[51] -= b1a.w * sol[43]; sol[52] -= b1b.x * sol[43]; sol[53] -= b1b.y * sol[43]; sol[54] -= b1b.z * sol[43]; sol[55] -= b1b.w * sol[43]; sol[56] -= b1c.x * sol[43]; sol[57] -= b1c.y * sol[43]; sol[58] -= b1c.z * sol[43]; sol[59] -= b1c.w * sol[43]; sol[60] -= b1d.x * sol[43]; sol[61] -= b1d.y * sol[43]; sol[62] -= b1d.z * sol[43]; sol[63] -= b1d.w * sol[43];
  __builtin_amdgcn_sched_barrier(0);
  b1a = *(const float4*)(Lr + 2912); b1b = *(const float4*)(Lr + 2916); b1c = *(const float4*)(Lr + 2920); b1d = *(const float4*)(Lr + 2924);
  __builtin_amdgcn_sched_barrier(0);
  sol[45] -= b2d.y * sol[44]; sol[46] -= b2d.z * sol[44]; sol[47] -= b2d.w * sol[44];
  __builtin_amdgcn_sched_barrier(0);
  b2a = *(const float4*)(Lr + 2928); b2b = *(const float4*)(Lr + 2932); b2c = *(const float4*)(Lr + 2936); b2d = *(const float4*)(Lr + 2940);
  __builtin_amdgcn_sched_barrier(0);
  sol[48] -= b0a.x * sol[44]; sol[49] -= b0a.y * sol[44]; sol[50] -= b0a.z * sol[44]; sol[51] -= b0a.w * sol[44]; sol[52] -= b0b.x * sol[44]; sol[53] -= b0b.y * sol[44]; sol[54] -= b0b.z * sol[44]; sol[55] -= b0b.w * sol[44]; sol[56] -= b0c.x * sol[44]; sol[57] -= b0c.y * sol[44]; sol[58] -= b0c.z * sol[44]; sol[59] -= b0c.w * sol[44]; sol[60] -= b0d.x * sol[44]; sol[61] -= b0d.y * sol[44]; sol[62] -= b0d.z * sol[44]; sol[63] -= b0d.w * sol[44];
  __builtin_amdgcn_sched_barrier(0);
  b0a = *(const float4*)(Lr + 2976); b0b = *(const float4*)(Lr + 2980); b0c = *(const float4*)(Lr + 2984); b0d = *(const float4*)(Lr + 2988);
  __builtin_amdgcn_sched_barrier(0);
  sol[46] -= b1d.z * sol[45]; sol[47] -= b1d.w * sol[45];
  __builtin_amdgcn_sched_barrier(0);
  b1a = *(const float4*)(Lr + 2992); b1b = *(const float4*)(Lr + 2996); b1c = *(const float4*)(Lr + 3000); b1d = *(const float4*)(Lr + 3004);
  __builtin_amdgcn_sched_barrier(0);
  sol[48] -= b2a.x * sol[45]; sol[49] -= b2a.y * sol[45]; sol[50] -= b2a.z * sol[45]; sol[51] -= b2a.w * sol[45]; sol[52] -= b2b.x * sol[45]; sol[53] -= b2b.y * sol[45]; sol[54] -= b2b.z * sol[45]; sol[55] -= b2b.w * sol[45]; sol[56] -= b2c.x * sol[45]; sol[57] -= b2c.y * sol[45]; sol[58] -= b2c.z * sol[45]; sol[59] -= b2c.w * sol[45]; sol[60] -= b2d.x * sol[45]; sol[61] -= b2d.y * sol[45]; sol[62] -= b2d.z * sol[45]; sol[63] -= b2d.w * sol[45];
  __builtin_amdgcn_sched_barrier(0);
  b2a = *(const float4*)(Lr + 3056); b2b = *(const float4*)(Lr + 3060); b2c = *(const float4*)(Lr + 3064); b2d = *(const float4*)(Lr + 3068);
  __builtin_amdgcn_sched_barrier(0);
  sol[47] -= b0d.w * sol[46];
  __builtin_amdgcn_sched_barrier(0);
  b0a = *(const float4*)(Lr + 3120); b0b = *(const float4*)(Lr + 3124); b0c = *(const float4*)(Lr + 3128); b0d = *(const float4*)(Lr + 3132);
  __builtin_amdgcn_sched_barrier(0);
  sol[48] -= b1a.x * sol[46]; sol[49] -= b1a.y * sol[46]; sol[50] -= b1a.z * sol[46]; sol[51] -= b1a.w * sol[46]; sol[52] -= b1b.x * sol[46]; sol[53] -= b1b.y * sol[46]; sol[54] -= b1b.z * sol[46]; sol[55] -= b1b.w * sol[46]; sol[56] -= b1c.x * sol[46]; sol[57] -= b1c.y * sol[46]; sol[58] -= b1c.z * sol[46]; sol[59] -= b1c.w * sol[46]; sol[60] -= b1d.x * sol[46]; sol[61] -= b1d.y * sol[46]; sol[62] -= b1d.z * sol[46]; sol[63] -= b1d.w * sol[46];
  __builtin_amdgcn_sched_barrier(0);
  b1a = *(const float4*)(Lr + 3184); b1b = *(const float4*)(Lr + 3188); b1c = *(const float4*)(Lr + 3192); b1d = *(const float4*)(Lr + 3196);
  __builtin_amdgcn_sched_barrier(0);
  sol[48] -= b2a.x * sol[47]; sol[49] -= b2a.y * sol[47]; sol[50] -= b2a.z * sol[47]; sol[51] -= b2a.w * sol[47]; sol[52] -= b2b.x * sol[47]; sol[53] -= b2b.y * sol[47]; sol[54] -= b2b.z * sol[47]; sol[55] -= b2b.w * sol[47]; sol[56] -= b2c.x * sol[47]; sol[57] -= b2c.y * sol[47]; sol[58] -= b2c.z * sol[47]; sol[59] -= b2c.w * sol[47]; sol[60] -= b2d.x * sol[47]; sol[61] -= b2d.y * sol[47]; sol[62] -= b2d.z * sol[47]; sol[63] -= b2d.w * sol[47];
  __builtin_amdgcn_sched_barrier(0);
  b2a = *(const float4*)(Lr + 3248); b2b = *(const float4*)(Lr + 3252); b2c = *(const float4*)(Lr + 3256); b2d = *(const float4*)(Lr + 3260);
  __builtin_amdgcn_sched_barrier(0);
  sol[49] -= b0a.y * sol[48]; sol[50] -= b0a.z * sol[48]; sol[51] -= b0a.w * sol[48]; sol[52] -= b0b.x * sol[48]; sol[53] -= b0b.y * sol[48]; sol[54] -= b0b.z * sol[48]; sol[55] -= b0b.w * sol[48]; sol[56] -= b0c.x * sol[48]; sol[57] -= b0c.y * sol[48]; sol[58] -= b0c.z * sol[48]; sol[59] -= b0c.w * sol[48]; sol[60] -= b0d.x * sol[48]; sol[61] -= b0d.y * sol[48]; sol[62] -= b0d.z * sol[48]; sol[63] -= b0d.w * sol[48];
  __builtin_amdgcn_sched_barrier(0);
  b0a = *(const float4*)(Lr + 3312); b0b = *(const float4*)(Lr + 3316); b0c = *(const float4*)(Lr + 3320); b0d = *(const float4*)(Lr + 3324);
  __builtin_amdgcn_sched_barrier(0);
  sol[50] -= b1a.z * sol[49]; sol[51] -= b1a.w * sol[49]; sol[52] -= b1b.x * sol[49]; sol[53] -= b1b.y * sol[49]; sol[54] -= b1b.z * sol[49]; sol[55] -= b1b.w * sol[49]; sol[56] -= b1c.x * sol[49]; sol[57] -= b1c.y * sol[49]; sol[58] -= b1c.z * sol[49]; sol[59] -= b1c.w * sol[49]; sol[60] -= b1d.x * sol[49]; sol[61] -= b1d.y * sol[49]; sol[62] -= b1d.z * sol[49]; sol[63] -= b1d.w * sol[49];
  __builtin_amdgcn_sched_barrier(0);
  b1a = *(const float4*)(Lr + 3376); b1b = *(const float4*)(Lr + 3380); b1c = *(const float4*)(Lr + 3384); b1d = *(const float4*)(Lr + 3388);
  __builtin_amdgcn_sched_barrier(0);
  sol[51] -= b2a.w * sol[50]; sol[52] -= b2b.x * sol[50]; sol[53] -= b2b.y * sol[50]; sol[54] -= b2b.z * sol[50]; sol[55] -= b2b.w * sol[50]; sol[56] -= b2c.x * sol[50]; sol[57] -= b2c.y * sol[50]; sol[58] -= b2c.z * sol[50]; sol[59] -= b2c.w * sol[50]; sol[60] -= b2d.x * sol[50]; sol[61] -= b2d.y * sol[50]; sol[62] -= b2d.z * sol[50]; sol[63] -= b2d.w * sol[50];
  __builtin_amdgcn_sched_barrier(0);
  b2a = *(const float4*)(Lr + 3440); b2b = *(const float4*)(Lr + 3444); b2c = *(const float4*)(Lr + 3448); b2d = *(const float4*)(Lr + 3452);
  __builtin_amdgcn_sched_barrier(0);
  sol[52] -= b0b.x * sol[51]; sol[53] -= b0b.y * sol[51]; sol[54] -= b0b.z * sol[51]; sol[55] -= b0b.w * sol[51]; sol[56] -= b0c.x * sol[51]; sol[57] -= b0c.y * sol[51]; sol[58] -= b0c.z * sol[51]; sol[59] -= b0c.w * sol[51]; sol[60] -= b0d.x * sol[51]; sol[61] -= b0d.y * sol[51]; sol[62] -= b0d.z * sol[51]; sol[63] -= b0d.w * sol[51];
  __builtin_amdgcn_sched_barrier(0);
  b0a = *(const float4*)(Lr + 3504); b0b = *(const float4*)(Lr + 3508); b0c = *(const float4*)(Lr + 3512); b0d = *(const float4*)(Lr + 3516);
  __builtin_amdgcn_sched_barrier(0);
  sol[53] -= b1b.y * sol[52]; sol[54] -= b1b.z * sol[52]; sol[55] -= b1b.w * sol[52]; sol[56] -= b1c.x * sol[52]; sol[57] -= b1c.y * sol[52]; sol[58] -= b1c.z * sol[52]; sol[59] -= b1c.w * sol[52]; sol[60] -= b1d.x * sol[52]; sol[61] -= b1d.y * sol[52]; sol[62] -= b1d.z * sol[52]; sol[63] -= b1d.w * sol[52];
  __builtin_amdgcn_sched_barrier(0);
  b1a = *(const float4*)(Lr + 3568); b1b = *(const float4*)(Lr + 3572); b1c = *(const float4*)(Lr + 3576); b1d = *(const float4*)(Lr + 3580);
  __builtin_amdgcn_sched_barrier(0);
  sol[54] -= b2b.z * sol[53]; sol[55] -= b2b.w * sol[53]; sol[56] -= b2c.x * sol[53]; sol[57] -= b2c.y * sol[53]; sol[58] -= b2c.z * sol[53]; sol[59] -= b2c.w * sol[53]; sol[60] -= b2d.x * sol[53]; sol[61] -= b2d.y * sol[53]; sol[62] -= b2d.z * sol[53]; sol[63] -= b2d.w * sol[53];
  __builtin_amdgcn_sched_barrier(0);
  b2a = *(const float4*)(Lr + 3632); b2b = *(const float4*)(Lr + 3636); b2c = *(const float4*)(Lr + 3640); b2d = *(const float4*)(Lr + 3644);
  __builtin_amdgcn_sched_barrier(0);
  sol[55] -= b0b.w * sol[54]; sol[56] -= b0c.x * sol[54]; sol[57] -= b0c.y * sol[54]; sol[58] -= b0c.z * sol[54]; sol[59] -= b0c.w * sol[54]; sol[60] -= b0d.x * sol[54]; sol[61] -= b0d.y * sol[54]; sol[62] -= b0d.z * sol[54]; sol[63] -= b0d.w * sol[54];
  __builtin_amdgcn_sched_barrier(0);
  b0a = *(const float4*)(Lr + 3696); b0b = *(const float4*)(Lr + 3700); b0c = *(const float4*)(Lr + 3704); b0d = *(const float4*)(Lr + 3708);
  __builtin_amdgcn_sched_barrier(0);
  sol[56] -= b1c.x * sol[55]; sol[57] -= b1c.y * sol[55]; sol[58] -= b1c.z * sol[55]; sol[59] -= b1c.w * sol[55]; sol[60] -= b1d.x * sol[55]; sol[61] -= b1d.y * sol[55]; sol[62] -= b1d.z * sol[55]; sol[63] -= b1d.w * sol[55];
  __builtin_amdgcn_sched_barrier(0);
  b1a = *(const float4*)(Lr + 3760); b1b = *(const float4*)(Lr + 3764); b1c = *(const float4*)(Lr + 3768); b1d = *(const float4*)(Lr + 3772);
  __builtin_amdgcn_sched_barrier(0);
  sol[57] -= b2c.y * sol[56]; sol[58] -= b2c.z * sol[56]; sol[59] -= b2c.w * sol[56]; sol[60] -= b2d.x * sol[56]; sol[61] -= b2d.y * sol[56]; sol[62] -= b2d.z * sol[56]; sol[63] -= b2d.w * sol[56];
  __builtin_amdgcn_sched_barrier(0);
  b2a = *(const float4*)(Lr + 3824); b2b = *(const float4*)(Lr + 3828); b2c = *(const float4*)(Lr + 3832); b2d = *(const float4*)(Lr + 3836);
  __builtin_amdgcn_sched_barrier(0);
  sol[58] -= b0c.z * sol[57]; sol[59] -= b0c.w * sol[57]; sol[60] -= b0d.x * sol[57]; sol[61] -= b0d.y * sol[57]; sol[62] -= b0d.z * sol[57]; sol[63] -= b0d.w * sol[57];
  __builtin_amdgcn_sched_barrier(0);
  b0a = *(const float4*)(Lr + 3888); b0b = *(const float4*)(Lr + 3892); b0c = *(const float4*)(Lr + 3896); b0d = *(const float4*)(Lr + 3900);
  __builtin_amdgcn_sched_barrier(0);
  sol[59] -= b1c.w * sol[58]; sol[60] -= b1d.x * sol[58]; sol[61] -= b1d.y * sol[58]; sol[62] -= b1d.z * sol[58]; sol[63] -= b1d.w * sol[58];
  __builtin_amdgcn_sched_barrier(0);
  b1a = *(const float4*)(Lr + 3952); b1b = *(const float4*)(Lr + 3956); b1c = *(const float4*)(Lr + 3960); b1d = *(const float4*)(Lr + 3964);
  __builtin_amdgcn_sched_barrier(0);
  sol[60] -= b2d.x * sol[59]; sol[61] -= b2d.y * sol[59]; sol[62] -= b2d.z * sol[59]; sol[63] -= b2d.w * sol[59];
  __builtin_amdgcn_sched_barrier(0);
  b2a = *(const float4*)(Lr + 4016); b2b = *(const float4*)(Lr + 4020); b2c = *(const float4*)(Lr + 4024); b2d = *(const float4*)(Lr + 4028);
  __builtin_amdgcn_sched_barrier(0);
  sol[61] -= b0d.y * sol[60]; sol[62] -= b0d.z * sol[60]; sol[63] -= b0d.w * sol[60];
  __builtin_amdgcn_sched_barrier(0);
  __builtin_amdgcn_sched_barrier(0);
  sol[62] -= b1d.z * sol[61]; sol[63] -= b1d.w * sol[61];
  __builtin_amdgcn_sched_barrier(0);
  __builtin_amdgcn_sched_barrier(0);
  sol[63] -= b2d.w * sol[62];
  __builtin_amdgcn_sched_barrier(0);
}

template <int DIR>
__device__ __forceinline__ void solve_cols(const Params& P, int itb, int c, const float* Lt, const float* bpp, const float* gcp,
                                           const u16* Vs, const u16* Ks) {
  float sol[64];
  const float* bp_ = bpp + DIR * 64;
  const float* gc_ = gcp + DIR * 64;
  if (c < 128) {
    const u16* vp = Vs + c;
#pragma unroll
    for (int p = 0; p < 64; ++p) sol[p] = bp_[p] * bf2f(vp[(DIR ? (63 - p) : p) * 136]);
  } else {
    const u16* kp = Ks + (c - 128);
#pragma unroll
    for (int p = 0; p < 64; ++p) sol[p] = bp_[p] * __expf(gc_[p]) * bf2f(kp[(DIR ? (63 - p) : p) * 136]);
  }
  const float* Lr = Lt + opq(DIR * 4096);
  solve_elim(sol, Lr);
  const size_t it2 = (size_t)(itb + DIR);
  if (c < 128) {
    u16* UF = (u16*)(P.ws + OFF_UF) + (it2 * 128 + c) * 64;
#pragma unroll
    for (int q = 0; q < 8; ++q) *(uint4*)(UF + q * 8) = pack8(sol + q * 8);
  } else {
    u16* Wg = (u16*)(P.ws + OFF_R2) + it2 * 8192 + (c - 128);
#pragma unroll
    for (int p = 0; p < 64; ++p) Wg[p * 128] = f2bf(-sol[p]);
  }
}

__device__ __forceinline__ void delta_prep_item(const Params& P, int item, char* lds) {
  const int tid = opq(threadIdx.x), lane = tid & 63, wv = tid >> 6, fr = lane & 15, fq = lane >> 4;
  const int cid = item >> 2, h = item & 3;
  const int row0 = cid * 64;
  int seq_lo, seq_hi;
  if (cid < 256) { seq_lo = (cid >> 6) * 4096; seq_hi = seq_lo + 4096; }
  else { seq_lo = 16384 + ((cid - 256) >> 2) * 256; seq_hi = seq_lo + 256; }
  u16* Qs = (u16*)(lds + opq(0));
  u16* Ks = (u16*)(lds + opq(17408));
  u16* Vs = (u16*)(lds + opq(34816));
  float* KKs = (float*)(lds + opq(52224));
  float* QKs = (float*)(lds + opq(69632));
  float* Lt = (float*)(lds + opq(87040));
  float* gtok = (float*)(lds + opq(119808));
  float* btok = gtok + 128;
  float* gcp = btok + 128;
  float* bpp = gcp + 128;
  u16* QKN = (u16*)((char*)P.out + OFF_QKN);
  lds_barrier();
  {
    const int j = tid >> 3, sg = tid & 7;
    const int row = row0 + j;
    const bool hm = (row - 1 >= seq_lo), hp = (row + 1 < seq_hi);
    const u16* qkv = (const u16*)(P.ws + OFF_R3);
#pragma unroll
    for (int s = 0; s < 3; ++s) {
      const int col = s * 512 + h * 128 + sg * 16;
      const u16* p0 = qkv + (size_t)row * 1536 + col;
      float y[16];
      float ssq = 0.f;
#pragma unroll
      for (int hh = 0; hh < 2; ++hh) {
        const uint4 c0 = *(const uint4*)(p0 + hh * 8);
        uint4 m0 = *(const uint4*)(p0 - (hm ? 1536 : 0) + hh * 8);
        uint4 n0 = *(const uint4*)(p0 + (hp ? 1536 : 0) + hh * 8);
        m0.x = hm ? m0.x : 0u; m0.y = hm ? m0.y : 0u; m0.z = hm ? m0.z : 0u; m0.w = hm ? m0.w : 0u;
        n0.x = hp ? n0.x : 0u; n0.y = hp ? n0.y : 0u; n0.z = hp ? n0.z : 0u; n0.w = hp ? n0.w : 0u;
        float fc[8], fm[8], fn[8];
        unpack8(c0, fc); unpack8(m0, fm); unpack8(n0, fn);
        const float* cwp = P.dn_conv_w + col + hh * 8;
        float cw0[8], cw1[8], cw2[8];
        {
          const float4 t0 = *(const float4*)(cwp), t1 = *(const float4*)(cwp + 4);
          const float4 t2 = *(const float4*)(cwp + 1536), t3 = *(const float4*)(cwp + 1540);
          const float4 t4 = *(const float4*)(cwp + 3072), t5 = *(const float4*)(cwp + 3076);
          cw0[0] = t0.x; cw0[1] = t0.y; cw0[2] = t0.z; cw0[3] = t0.w; cw0[4] = t1.x; cw0[5] = t1.y; cw0[6] = t1.z; cw0[7] = t1.w;
          cw1[0] = t2.x; cw1[1] = t2.y; cw1[2] = t2.z; cw1[3] = t2.w; cw1[4] = t3.x; cw1[5] = t3.y; cw1[6] = t3.z; cw1[7] = t3.w;
          cw2[0] = t4.x; cw2[1] = t4.y; cw2[2] = t4.z; cw2[3] = t4.w; cw2[4] = t5.x; cw2[5] = t5.y; cw2[6] = t5.z; cw2[7] = t5.w;
        }
#pragma unroll
        for (int e = 0; e < 8; ++e) {
          const float v = cw0[e] * fm[e] + cw1[e] * fc[e] + cw2[e] * fn[e];
          const float yy = v * sigm(v);
          y[hh * 8 + e] = yy;
          ssq += yy * yy;
        }
      }
      if (s < 2) {
        ssq += __shfl_xor(ssq, 1, 64); ssq += __shfl_xor(ssq, 2, 64); ssq += __shfl_xor(ssq, 4, 64);
        const float sc = rsqrtf(ssq + 1e-6f) * ((s == 0) ? 0.08838834764831845f : 1.f);
#pragma unroll
        for (int e = 0; e < 16; ++e) y[e] *= sc;
      }
      u16* dl = ((s == 0) ? Qs : ((s == 1) ? Ks : Vs)) + j * 136 + sg * 16;
      const uint4 o0 = pack8(y), o1 = pack8(y + 8);
      *(uint4*)dl = o0; *(uint4*)(dl + 8) = o1;
      if (s < 2) {
        u16* dg = QKN + (size_t)row * 1024 + s * 512 + h * 128 + sg * 16;
        *(uint4*)dg = o0; *(uint4*)(dg + 8) = o1;
      }
    }
  }
  if (tid < 128) {
    const int j = tid & 63, dir = tid >> 6;
    const float* BA = (const float*)(P.ws + OFF_BA) + (size_t)(row0 + j) * 16;
    const float bl = BA[dir * 4 + h], al = BA[8 + dir * 4 + h];
    const float xx = al + P.dn_dt_bias[dir * 4 + h];
    const float sp = (xx > 20.f) ? xx : log1pf(expf(xx));
    gtok[dir * 64 + j] = -expf(P.dn_a_log[dir * 4 + h]) * sp;
    btok[dir * 64 + j] = 1.f / (1.f + expf(-bl));
  }
  lds_barrier();
  if (tid < 128) {
    const int dir = tid >> 6, p = tid & 63;
    const int tk = dir ? (63 - p) : p;
    float a = gtok[dir * 64 + tk];
    const float bv = btok[dir * 64 + tk];
#pragma unroll
    for (int o = 1; o < 64; o <<= 1) {
      const float t = __shfl_up(a, o, 64);
      if (p >= o) a += t;
    }
    gcp[dir * 64 + p] = a;
    bpp[dir * 64 + p] = bv;
  }
  {
#pragma unroll
    for (int q = 0; q < 4; ++q) {
      const int t = wv * 4 + q;
      const int which = t >> 4, mi = (t >> 2) & 3, ni = t & 3;
      const u16* Am = (which ? Qs : Ks) + (mi * 16 + fr) * 136 + fq * 8;
      const u16* Bm = Ks + (ni * 16 + fr) * 136 + fq * 8;
      f32x4 a4 = {0.f, 0.f, 0.f, 0.f};
#pragma unroll
      for (int kk = 0; kk < 4; ++kk)
        a4 = __builtin_amdgcn_mfma_f32_16x16x32_bf16(*(const bf16x8*)(Am + kk * 32), *(const bf16x8*)(Bm + kk * 32), a4, 0, 0, 0);
      float* dst = which ? QKs : KKs;
#pragma unroll
      for (int e = 0; e < 4; ++e) dst[(mi * 16 + fq * 4 + e) * 68 + ni * 16 + fr] = a4[e];
    }
  }
  lds_barrier();
  const int itb = item * 2;
  {
    u16* AQ = (u16*)((char*)P.out + OFF_AQ);
#pragma unroll 8
    for (int idx = tid; idx < 8192; idx += NT) {
      const int dir = idx >> 12, p = (idx >> 6) & 63, s = idx & 63;
      const int tp = dir ? (63 - p) : p, ts = dir ? (63 - s) : s;
      const float dg = gcp[dir * 64 + p] - gcp[dir * 64 + s];
      const float dec = (p >= s) ? __expf(dg) : 0.f;
      AQ[((size_t)(itb + dir) * 64 + p) * 64 + s] = f2bf(QKs[tp * 68 + ts] * dec);
    }
#pragma unroll 8
    for (int idx = tid; idx < 8192; idx += NT) {
      const int dir = idx >> 12, s = (idx >> 6) & 63, p = idx & 63;
      const int tp = dir ? (63 - p) : p, ts = dir ? (63 - s) : s;
      const float dg = gcp[dir * 64 + p] - gcp[dir * 64 + s];
      const float lv = (p > s) ? bpp[dir * 64 + p] * KKs[ts * 68 + tp] * __expf(dg) : 0.f;
      Lt[dir * 4096 + s * 64 + p] = lv;
    }
    if (tid < 128) {
      float* GC = (float*)(P.ws + OFF_GC);
      GC[(size_t)(itb + (tid >> 6)) * 64 + (tid & 63)] = gcp[tid];
    }
  }
  lds_barrier();
  if (tid < 256) solve_cols<0>(P, itb, tid, Lt, bpp, gcp, Vs, Ks);
  else solve_cols<1>(P, itb, tid - 256, Lt, bpp, gcp, Vs, Ks);
}

__device__ __forceinline__ void s5end_tile(const Params& P, int t, char* lds) {
  const int g = t / 6, mt = (t % 6) >> 1, nt = t & 1;
  const int m0 = mt * 256, n0 = nt * 128;
  f32x16 acc[2][2];
  acc_zero(acc);
  gemm_main((const u16*)(P.ws + OFF_U5) + ((size_t)g * 544 + m0) * 512, 512,
            (const u16*)(P.ws + OFF_MEND) + ((size_t)g * 256 + n0) * 512, 512, 512, acc, (u16*)lds);
  TILE_COORDS
  float* E = (float*)(P.ws + OFF_E);
#pragma unroll
  for (int i = 0; i < 2; ++i)
#pragma unroll
    for (int j = 0; j < 2; ++j)
#pragma unroll
      for (int e = 0; e < 16; ++e) {
        const int row = TROW(m0, i, e);
        if (row < 544) E[((size_t)g * 544 + row) * 256 + TCOL(n0, j)] = acc[i][j][e];
      }
}

__device__ __forceinline__ void scan_chunk(const u16* Wl, const u16* QTl, const u16* KTl, const u16* AQl, u16* ST, u16* VT,
                                           int wd, int wq, int fr, int fq, float gl, f32x4& av, f32x4& ao, f32x4& accS0, f32x4& accS1) {
  {
    bf16x8 bS[4], a1[4], a2[4];
#pragma unroll
    for (int kk = 0; kk < 4; ++kk) {
      bS[kk] = *(const bf16x8*)(ST + (wd * 16 + fr) * 136 + kk * 32 + fq * 8);
      a1[kk] = *(const bf16x8*)(Wl + (wq * 16 + fr) * 136 + kk * 32 + fq * 8);
      a2[kk] = *(const bf16x8*)(QTl + (wq * 16 + fr) * 136 + kk * 32 + fq * 8);
    }
    __builtin_amdgcn_sched_barrier(0);
#pragma unroll
    for (int kk = 0; kk < 4; ++kk) {
      av = __builtin_amdgcn_mfma_f32_16x16x32_bf16(a1[kk], bS[kk], av, 0, 0, 0);
      ao = __builtin_amdgcn_mfma_f32_16x16x32_bf16(a2[kk], bS[kk], ao, 0, 0, 0);
    }
  }
  {
    uint2 v; v.x = pack2(av[0], av[1]); v.y = pack2(av[2], av[3]);
    *(uint2*)(VT + (wd * 16 + fr) * 72 + wq * 16 + fq * 4) = v;
  }
  bf16x8 qa[2], k0[2], k1[2];
#pragma unroll
  for (int ks = 0; ks < 2; ++ks) {
    qa[ks] = *(const bf16x8*)(AQl + (wq * 16 + fr) * 72 + ks * 32 + fq * 8);
    k0[ks] = *(const bf16x8*)(KTl + ((2 * wq) * 16 + fr) * 72 + ks * 32 + fq * 8);
    k1[ks] = *(const bf16x8*)(KTl + ((2 * wq + 1) * 16 + fr) * 72 + ks * 32 + fq * 8);
  }
  accS0[0] *= gl; accS0[1] *= gl; accS0[2] *= gl; accS0[3] *= gl;
  accS1[0] *= gl; accS1[1] *= gl; accS1[2] *= gl; accS1[3] *= gl;
  lds_barrier();
  {
    bf16x8 bV[2];
#pragma unroll
    for (int ks = 0; ks < 2; ++ks) bV[ks] = *(const bf16x8*)(VT + (wd * 16 + fr) * 72 + ks * 32 + fq * 8);
#pragma unroll
    for (int ks = 0; ks < 2; ++ks) {
      ao = __builtin_amdgcn_mfma_f32_16x16x32_bf16(qa[ks], bV[ks], ao, 0, 0, 0);
      accS0 = __builtin_amdgcn_mfma_f32_16x16x32_bf16(k0[ks], bV[ks], accS0, 0, 0, 0);
      accS1 = __builtin_amdgcn_mfma_f32_16x16x32_bf16(k1[ks], bV[ks], accS1, 0, 0, 0);
    }
  }
  {
    uint2 v; v.x = pack2(accS0[0], accS0[1]); v.y = pack2(accS0[2], accS0[3]);
    *(uint2*)(ST + (wd * 16 + fr) * 136 + (2 * wq) * 16 + fq * 4) = v;
    v.x = pack2(accS1[0], accS1[1]); v.y = pack2(accS1[2], accS1[3]);
    *(uint2*)(ST + (wd * 16 + fr) * 136 + (2 * wq + 1) * 16 + fq * 4) = v;
  }
}

__device__ __forceinline__ void delta_scan_block(const Params& P, int sb, char* lds) {
  const int tid = opq(threadIdx.x), lane = tid & 63, w = tid >> 6, fr = lane & 15, fq = lane >> 4;
  const int bhd = sb & 31, dvq = sb >> 5;
  const int b = bhd >> 3, h = (bhd >> 1) & 3, dir = bhd & 1;
  const int wd = w & 1, wq = w >> 1;
  const int dv0 = dvq * 32 + wd * 16;
  u16* Wl = (u16*)(lds + opq(0));
  u16* QTl = (u16*)(lds + opq(17408));
  u16* KTl = (u16*)(lds + opq(34816));
  u16* AQl = (u16*)(lds + opq(53248));
  u16* ST = (u16*)(lds + opq(62464));
  u16* VT = (u16*)(lds + opq(71168));
  lds_barrier();
  for (int i = tid; i < 32 * 136 / 2; i += NT) ((uint32_t*)ST)[i] = 0u;
  f32x4 accS0 = {0.f, 0.f, 0.f, 0.f}, accS1 = {0.f, 0.f, 0.f, 0.f};
  const u16* QKN = (const u16*)((const char*)P.out + OFF_QKN);
  const u16* AQg = (const u16*)((const char*)P.out + OFF_AQ);
  const u16* Wg = (const u16*)(P.ws + OFF_R2);
  const u16* UFg = (const u16*)(P.ws + OFF_UF);
  const float* GC = (const float*)(P.ws + OFF_GC);
  u16* Og = (u16*)(P.ws + OFF_O);

#define GLD16(dst, ptr) asm volatile("global_load_dwordx4 %0, %1, off" : "=v"(dst) : "v"(ptr) : "memory")
#define GLD8(dst, ptr) asm volatile("global_load_dwordx2 %0, %1, off" : "=v"(dst) : "v"(ptr) : "memory")
#define GLD4(dst, ptr) asm volatile("global_load_dword %0, %1, off" : "=v"(dst) : "v"(ptr) : "memory")
#define SC_DECL(S)                                                   \
  u32x4 S##w0, S##w1, S##q0, S##q1, S##k0, S##k1, S##a;              \
  float S##gq0, S##gq1, S##gk, S##g63;                               \
  u32x2 S##u;                                                        \
  int S##row0 = 0, S##lat = 0;
#define SC_PF_ONE(S, i)                                                                            \
    {                                                                                              \
      const int id = tid + (i) * 512;                                                              \
      const int p = id >> 4, seg = id & 15;                                                        \
      const int tk = dir ? (63 - p) : p;                                                           \
      GLD16(S##w##i, Wg + it2__ * 8192 + p * 128 + seg * 8);                                       \
      GLD16(S##q##i, QKN + (size_t)(S##row0 + tk) * 1024 + h * 128 + seg * 8);                     \
      GLD4(S##gq##i, GC + it2__ * 64 + p);                                                         \
      const int s = id & 63, sg2 = id >> 6;                                                        \
      const int tks = dir ? (63 - s) : s;                                                          \
      GLD16(S##k##i, QKN + (size_t)(S##row0 + tks) * 1024 + 512 + h * 128 + sg2 * 8);              \
    }
#define SC_PREFETCH(S, n_)                                                                         \
  {                                                                                                \
    const int n__ = (n_);                                                                          \
    int cid__;                                                                                     \
    if (n__ < 4) { cid__ = 256 + b * 4 + (dir ? (3 - n__) : n__); S##lat = 0; }                    \
    else { const int m__ = n__ - 4; cid__ = b * 64 + (dir ? (63 - m__) : m__); S##lat = 1; }       \
    S##row0 = cid__ * 64;                                                                          \
    const size_t it2__ = (size_t)((cid__ * 4 + h) * 2 + dir);                                      \
    SC_PF_ONE(S, 0)                                                                                \
    SC_PF_ONE(S, 1)                                                                                \
    GLD4(S##gk, GC + it2__ * 64 + (tid & 63));                                                     \
    GLD4(S##g63, GC + it2__ * 64 + 63);                                                            \
    GLD16(S##a, AQg + it2__ * 4096 + (tid >> 3) * 64 + (tid & 7) * 8);                             \
    GLD8(S##u, UFg + (it2__ * 128 + dv0 + fr) * 64 + wq * 16 + fq * 4);                            \
  }
#define SC_WAIT(S, CNT)                                                                            \
  asm volatile("s_waitcnt vmcnt(" #CNT ")"                                                         \
               : "+v"(S##w0), "+v"(S##w1), "+v"(S##q0), "+v"(S##q1), "+v"(S##k0), "+v"(S##k1), "+v"(S##a), \
                 "+v"(S##gq0), "+v"(S##gq1), "+v"(S##gk), "+v"(S##g63), "+v"(S##u)                 \
               :: "memory");
#define SC_STAGE_ONE(S, i)                                                    \
    {                                                                         \
      const int id = tid + (i) * 512;                                         \
      const int p = id >> 4, seg = id & 15;                                   \
      *(u32x4*)(Wl + p * 136 + seg * 8) = S##w##i;                            \
      float f[8];                                                             \
      unpack8(make_uint4(S##q##i.x, S##q##i.y, S##q##i.z, S##q##i.w), f);     \
      const float sq = __expf(S##gq##i);                                      \
      f[0] *= sq; f[1] *= sq; f[2] *= sq; f[3] *= sq; f[4] *= sq; f[5] *= sq; f[6] *= sq; f[7] *= sq; \
      *(uint4*)(QTl + p * 136 + seg * 8) = pack8(f);                          \
      const int s = id & 63, sg2 = id >> 6;                                   \
      unpack8(make_uint4(S##k##i.x, S##k##i.y, S##k##i.z, S##k##i.w), f);     \
      u16* kd = KTl + (sg2 * 8) * 72 + s;                                     \
      kd[0 * 72] = f2bf(f[0] * sk); kd[1 * 72] = f2bf(f[1] * sk); kd[2 * 72] = f2bf(f[2] * sk); kd[3 * 72] = f2bf(f[3] * sk); \
      kd[4 * 72] = f2bf(f[4] * sk); kd[5 * 72] = f2bf(f[5] * sk); kd[6 * 72] = f2bf(f[6] * sk); kd[7 * 72] = f2bf(f[7] * sk); \
    }
#define SC_STEP(S, n_, WCNT, DO_PF)                                                                   \
  {                                                                                                   \
    SC_WAIT(S, WCNT)                                                                                  \
    const int cur_row0 = S##row0, cur_lat = S##lat;                                                   \
    const float gl = __expf(S##g63);                                                                  \
    const float sk = __expf(S##g63 - S##gk);                                                          \
    SC_STAGE_ONE(S, 0)                                                                                \
    SC_STAGE_ONE(S, 1)                                                                                \
    *(u32x4*)(AQl + (tid >> 3) * 72 + (tid & 7) * 8) = S##a;                                          \
    f32x4 av = f32x4{lo16(S##u.x), hi16(S##u.x), lo16(S##u.y), hi16(S##u.y)};                         \
    f32x4 ao = f32x4{0.f, 0.f, 0.f, 0.f};                                                             \
    lds_barrier();                                                                                    \
    if (DO_PF) SC_PREFETCH(S, (n_) + 2)                                                               \
    scan_chunk(Wl, QTl, KTl, AQl, ST, VT, wd, wq, fr, fq, gl, av, ao, accS0, accS1);                  \
    if (cur_lat) {                                                                                    \
      const int p0 = wq * 16 + fq * 4;                                                                \
      u16* og = Og + ((size_t)dir * 16384 + cur_row0) * 512 + h * 128 + dv0 + fr;                     \
      og[(size_t)(dir ? (63 - (p0 + 0)) : (p0 + 0)) * 512] = f2bf(ao[0]);                             \
      og[(size_t)(dir ? (63 - (p0 + 1)) : (p0 + 1)) * 512] = f2bf(ao[1]);                             \
      og[(size_t)(dir ? (63 - (p0 + 2)) : (p0 + 2)) * 512] = f2bf(ao[2]);                             \
      og[(size_t)(dir ? (63 - (p0 + 3)) : (p0 + 3)) * 512] = f2bf(ao[3]);                             \
    }                                                                                                 \
    lds_barrier();                                                                                    \
  }
  SC_DECL(A)
  SC_DECL(B)
  SC_PREFETCH(A, 0)
  SC_PREFETCH(B, 1)
  for (int n = 0; n < 66; n += 2) {
    SC_STEP(A, n, 12, true)
    SC_STEP(B, n + 1, 12, true)
  }
  SC_STEP(A, 66, 0, false)
  SC_STEP(B, 67, 0, false)
#undef SC_DECL
#undef SC_PF_ONE
#undef SC_PREFETCH
#undef SC_WAIT
#undef SC_STAGE_ONE
#undef SC_STEP
#undef GLD16
#undef GLD8
#undef GLD4
}

__device__ __forceinline__ void s5_carry_block(const Params& P, int cb) {
  const int idx = cb * NT + opq(threadIdx.x);
  const int n = idx & 63, g = (idx >> 6) & 31, r = (idx >> 11) & 1, b = idx >> 12;
  const int rg = r * 32 + g;
  const float step = expf(P.s5_log_step[rg]);
  float lr, li;
  lam_pow(step, P.s5_a_re[rg * 64 + n], P.s5_a_im[rg * 64 + n], 32, lr, li);
  const float* __restrict__ E = (const float*)(P.ws + OFF_E) + (size_t)g * 544 * 256 + r * 128 + n;
  u16* __restrict__ XIN = (u16*)(P.ws + OFF_XIN) + (size_t)g * 512 * 256 + r * 128 + n;
  float xr = 0.f, xi = 0.f;
  {
    float er[8], ei[8];
#pragma unroll
    for (int k = 0; k < 8; ++k) {
      const int row = 512 + b * 8 + (r ? (7 - k) : k);
      er[k] = E[(size_t)row * 256]; ei[k] = E[(size_t)row * 256 + 64];
    }
#pragma unroll
    for (int k = 0; k < 8; ++k) {
      const float nr = lr * xr - li * xi + er[k], ni = lr * xi + li * xr + ei[k];
      xr = nr; xi = ni;
    }
  }
  for (int k0 = 0; k0 < 128; k0 += 8) {
    float er[8], ei[8];
#pragma unroll
    for (int k = 0; k < 8; ++k) {
      const int row = b * 128 + (r ? (127 - (k0 + k)) : (k0 + k));
      er[k] = E[(size_t)row * 256]; ei[k] = E[(size_t)row * 256 + 64];
    }
#pragma unroll
    for (int k = 0; k < 8; ++k) {
      const int row = b * 128 + (r ? (127 - (k0 + k)) : (k0 + k));
      XIN[(size_t)row * 256] = f2bf(xr);
      XIN[(size_t)row * 256 + 64] = f2bf(xi);
      const float nr = lr * xr - li * xi + er[k], ni = lr * xi + li * xr + ei[k];
      xr = nr; xi = ni;
    }
  }
}

__device__ __forceinline__ void s5out_tile(const Params& P, int t, char* lds) {
  const int g = t >> 3, mt = (t >> 2) & 1, nt = t & 3;
  const int m0 = mt * 256, n0 = nt * 128;
  f32x16 acc[2][2];
  acc_zero(acc);
  gemm_main((const u16*)(P.ws + OFF_XIN) + ((size_t)g * 512 + m0) * 256, 256,
            (const u16*)(P.ws + OFF_MST) + ((size_t)g * 512 + n0) * 256, 256, 256, acc, (u16*)lds);
  gemm_main((const u16*)(P.ws + OFF_U5) + ((size_t)g * 544 + m0) * 512, 512,
            (const u16*)(P.ws + OFF_MINTRA) + ((size_t)g * 512 + n0) * 512, 512, 512, acc, (u16*)lds);
  TILE_COORDS
  u16* YB = (u16*)(P.ws + OFF_YB);
#pragma unroll
  for (int i = 0; i < 2; ++i)
#pragma unroll
    for (int j = 0; j < 2; ++j)
#pragma unroll
      for (int e = 0; e < 16; ++e) {
        const int row = TROW(m0, i, e), nn = TCOL(n0, j);
        const int token = row * 32 + (nn >> 4);
        YB[(size_t)token * 512 + g * 16 + (nn & 15)] = f2bf(gelu_tanh(acc[i][j][e]));
      }
}

__device__ __forceinline__ void delta_post_item(const Params& P, int item) {
  const int lane = opq(threadIdx.x) & 63, w = opq(threadIdx.x) >> 6;
  const int row = item * 8 + w;
  const u16* O = (const u16*)(P.ws + OFF_O);
  const uint4 o0 = *(const uint4*)(O + (size_t)row * 512 + lane * 8);
  const uint4 o1 = *(const uint4*)(O + ((size_t)16384 + row) * 512 + lane * 8);
  const uint4 zz = *(const uint4*)((const u16*)(P.ws + OFF_Z) + (size_t)row * 512 + lane * 8);
  float a[8], bq[8], z[8];
  unpack8(o0, a); unpack8(o1, bq); unpack8(zz, z);
  float ss = 0.f;
#pragma unroll
  for (int e = 0; e < 8; ++e) { a[e] += bq[e]; ss += a[e] * a[e]; }
  ss += __shfl_xor(ss, 1, 64); ss += __shfl_xor(ss, 2, 64); ss += __shfl_xor(ss, 4, 64); ss += __shfl_xor(ss, 8, 64);
  const float rstd = rsqrtf(ss * (1.f / 128.f) + 1e-6f);
  const float* nw = P.dn_norm_w + (lane & 15) * 8;
  float y[8];
#pragma unroll
  for (int e = 0; e < 8; ++e) y[e] = a[e] * rstd * nw[e] * (z[e] * sigm(z[e]));
  *(uint4*)((u16*)(P.ws + OFF_YA) + (size_t)row * 512 + lane * 8) = pack8(y);
}

__device__ __forceinline__ void glu_tile(const Params& P, int t, char* lds) {
  const int nt = t >> 6, mt = t & 63;
  const int m0 = mt * 256, n0 = nt * 128;
  f32x16 acc[2][2];
  acc_zero(acc);
  gemm_main((const u16*)(P.ws + OFF_YB) + (size_t)m0 * 512, 512, (const u16*)(P.ws + OFF_WT_GLU) + (size_t)n0 * 512, 512, 512, acc, (u16*)lds);
  TILE_COORDS
  u16* YG = (u16*)(P.ws + OFF_YG);
  {
    const int oc = nt * 64 + wn_ * 32 + fr_;
    const float bv = P.b_glu[oc], bg = P.b_glu[512 + oc];
#pragma unroll
    for (int i = 0; i < 2; ++i)
#pragma unroll
      for (int e = 0; e < 16; ++e) {
        const float val = acc[i][0][e] + bv, gt = acc[i][1][e] + bg;
        YG[TIDX2(m0, nt * 64 + wn_ * 32, i, e, 512)] = f2bf(val * sigm(gt));
      }
  }
}

__device__ __forceinline__ void gates_tile(const Params& P, int t, char* lds) {
  const int nt = t >> 6, mt = t & 63;
  const int m0 = mt * 256, n0 = nt * 128;
  f32x16 acc[2][2];
  acc_zero(acc);
  gemm_main((const u16*)(P.ws + OFF_R2) + (size_t)m0 * 1024, 1024, (const u16*)(P.ws + OFF_WT_IN) + (size_t)(2688 + n0) * 1024, 1024, 1024, acc, (u16*)lds);
  TILE_COORDS
  u16* SG = (u16*)(P.ws + OFF_SG);
#pragma unroll
  for (int i = 0; i < 2; ++i)
#pragma unroll
    for (int j = 0; j < 2; ++j)
#pragma unroll
      for (int e = 0; e < 16; ++e) SG[TIDX(m0, n0, i, j, e, 2048)] = f2bf(sigm(acc[i][j][e]));
}

__device__ __forceinline__ void mix_tile(const Params& P, int t, char* lds) {
  const int nt = t >> 6, mt = t & 63;
  const int m0 = mt * 256, n0 = nt * 128;
  const u16* SG = (const u16*)(P.ws + OFF_SG);
  f32x16 acc[2][2];
  u16* MIX = (u16*)(P.ws + OFF_MIX);
  acc_zero(acc);
  gemm_main((const u16*)(P.ws + OFF_YA) + (size_t)m0 * 512, 512, (const u16*)(P.ws + OFF_WT_AOUT) + (size_t)n0 * 512, 512, 512, acc, (u16*)lds);
  {
    TILE_COORDS
    u16 sv[2][2][16];
#pragma unroll
    for (int i = 0; i < 2; ++i)
#pragma unroll
      for (int j = 0; j < 2; ++j)
#pragma unroll
        for (int e = 0; e < 16; ++e) sv[i][j][e] = SG[TIDX(m0, n0, i, j, e, 2048)];
#pragma unroll
    for (int i = 0; i < 2; ++i)
#pragma unroll
      for (int j = 0; j < 2; ++j)
#pragma unroll
        for (int e = 0; e < 16; ++e) MIX[TIDX(m0, n0, i, j, e, 1024)] = f2bf(bf2f(sv[i][j][e]) * acc[i][j][e]);
  }
  acc_zero(acc);
  gemm_main((const u16*)(P.ws + OFF_YG) + (size_t)m0 * 512, 512, (const u16*)(P.ws + OFF_WT_BOUT) + (size_t)n0 * 512, 512, 512, acc, (u16*)lds);
  {
    TILE_COORDS
#pragma unroll
    for (int i = 0; i < 2; ++i) {
      u16 sv[2][16], pv[2][16];
#pragma unroll
      for (int j = 0; j < 2; ++j)
#pragma unroll
        for (int e = 0; e < 16; ++e) {
          sv[j][e] = SG[TIDX(m0, n0, i, j, e, 2048) + 1024];
          pv[j][e] = MIX[TIDX(m0, n0, i, j, e, 1024)];
        }
#pragma unroll
      for (int j = 0; j < 2; ++j)
#pragma unroll
        for (int e = 0; e < 16; ++e)
          MIX[TIDX(m0, n0, i, j, e, 1024)] = f2bf(bf2f(pv[j][e]) + bf2f(sv[j][e]) * acc[i][j][e]);
    }
  }
}

__device__ __forceinline__ void wo_tile(const Params& P, int t, char* lds) {
  const int nt = t >> 6, mt = t & 63;
  const int m0 = mt * 256, n0 = nt * 128;
  f32x16 acc[2][2];
  acc_zero(acc);
  gemm_main((const u16*)(P.ws + OFF_MIX) + (size_t)m0 * 1024, 1024, (const u16*)(P.ws + OFF_WT_O) + (size_t)n0 * 1024, 1024, 1024, acc, (u16*)lds);
  TILE_COORDS
  const float* MOD = (const float*)(P.ws + OFF_MOD) + (m0 >> 12) * 6144 + 2 * 1024;
  float xv[2][2][16];
#pragma unroll
  for (int j = 0; j < 2; ++j)
#pragma unroll
    for (int i = 0; i < 2; ++i)
#pragma unroll
      for (int e = 0; e < 16; ++e) xv[i][j][e] = P.x[TIDX(m0, n0, i, j, e, 1024)];
#pragma unroll
  for (int j = 0; j < 2; ++j) {
    const int col = TCOL(n0, j);
    const float gate = MOD[col];
#pragma unroll
    for (int i = 0; i < 2; ++i)
#pragma unroll
      for (int e = 0; e < 16; ++e) P.out[TIDX(m0, n0, i, j, e, 1024)] = xv[i][j][e] + gate * acc[i][j][e];
  }
}

__device__ __forceinline__ void norm2_item(const Params& P, int item) {
  const int lane = opq(threadIdx.x) & 63, w = opq(threadIdx.x) >> 6;
  const int rowA = item * 16 + w, rowB = rowA + 8;
  const float* MA = (const float*)(P.ws + OFF_MOD) + (rowA >> 12) * 6144;
  const float* MB = (const float*)(P.ws + OFF_MOD) + (rowB >> 12) * 6144;
  u16* H = (u16*)(P.ws + OFF_R2);
  norm_row2(P.out + (size_t)rowA * 1024, P.out + (size_t)rowB * 1024, P.norm2_w, MA + 3 * 1024, MA + 4 * 1024, MB + 3 * 1024, MB + 4 * 1024,
            H + (size_t)rowA * 1024, H + (size_t)rowB * 1024, lane);
}

__device__ __forceinline__ void up_tile(const Params& P, int t, int hh, char* lds) {
  const int nt = t >> 6, mt = t & 63;
  const int m0 = mt * 256, n0 = nt * 128;
  f32x16 acc[2][2];
  acc_zero(acc);
  gemm_main((const u16*)(P.ws + OFF_R2) + (size_t)m0 * 1024, 1024,
            (const u16*)(P.ws + OFF_WT_UP) + ((size_t)hh * 2816 + n0) * 1024, 1024, 1024, acc, (u16*)lds);
  TILE_COORDS
  u16* UPH = (u16*)(P.ws + OFF_UPH);
#pragma unroll
  for (int i = 0; i < 2; ++i)
#pragma unroll
    for (int j = 0; j < 2; ++j)
#pragma unroll
      for (int e = 0; e < 16; ++e) UPH[TIDX(m0, n0, i, j, e, 2816)] = f2bf(acc[i][j][e]);
}

#define CG_LD(ci, dy)                                                                       \
    {                                                                                       \
      const int xc = x0 - 1 + (ci);                                                         \
      const bool cok = (xc >= 0) && (xc <= 63);                                             \
      const bool rok = ((dy) == 1) || ((dy) == 0 ? r0ok : r2ok);                            \
      const int yy = rok ? (y + (dy) - 1) : y;                                              \
      const u16* src = UPH + (base + (size_t)yy * 64 + (cok ? xc : x0)) * 2816 + c4;        \
      uint2 g__ = *(const uint2*)src;                                                       \
      uint2 v__ = *(const uint2*)(src + 1408);                                              \
      const bool ok = cok && rok;                                                           \
      g__.x = ok ? g__.x : 0u; g__.y = ok ? g__.y : 0u;                                     \
      v__.x = ok ? v__.x : 0u; v__.y = ok ? v__.y : 0u;                                     \
      gg[ci][dy] = g__; vv[ci][dy] = v__;                                                   \
    }
__device__ __forceinline__ void convgate_item(const Params& P, int item, int hh) {
  const int tid = opq(threadIdx.x);
  if (tid >= 352) return;
  const int xo = item & 15, y = (item >> 4) & 63, b = item >> 10;
  const int c4 = tid * 4;
  const u16* UPH = (const u16*)(P.ws + OFF_UPH);
  u16* G = (u16*)(P.ws + OFF_G);
  const size_t base = (size_t)b * 4096;
  const bool r0ok = (y > 0), r2ok = (y < 63);
  const int x0 = xo * 4;
  uint2 gg[6][3], vv[6][3];
#pragma unroll
  for (int ci = 0; ci < 6; ++ci) {
    CG_LD(ci, 0)
    CG_LD(ci, 1)
    CG_LD(ci, 2)
  }
  float wg[9][4], wv[9][4];
#pragma unroll
  for (int k = 0; k < 9; ++k) {
    const float4 a = *(const float4*)(P.ffn_conv_w + (size_t)k * 5632 + hh * 1408 + c4);
    const float4 bq = *(const float4*)(P.ffn_conv_w + (size_t)k * 5632 + 2816 + hh * 1408 + c4);
    wg[k][0] = a.x; wg[k][1] = a.y; wg[k][2] = a.z; wg[k][3] = a.w;
    wv[k][0] = bq.x; wv[k][1] = bq.y; wv[k][2] = bq.z; wv[k][3] = bq.w;
  }
#pragma unroll
  for (int xx = 0; xx < 4; ++xx) {
    float ag[4] = {0.f, 0.f, 0.f, 0.f}, av[4] = {0.f, 0.f, 0.f, 0.f};
#pragma unroll
    for (int dy = 0; dy < 3; ++dy)
#pragma unroll
      for (int dx = 0; dx < 3; ++dx) {
        const uint2 gq = gg[xx + dx][dy], vq = vv[xx + dx][dy];
        const int k = dy * 3 + dx;
        ag[0] += wg[k][0] * lo16(gq.x); ag[1] += wg[k][1] * hi16(gq.x); ag[2] += wg[k][2] * lo16(gq.y); ag[3] += wg[k][3] * hi16(gq.y);
        av[0] += wv[k][0] * lo16(vq.x); av[1] += wv[k][1] * hi16(vq.x); av[2] += wv[k][2] * lo16(vq.y); av[3] += wv[k][3] * hi16(vq.y);
      }
    uint2 o;
    o.x = pack2(ag[0] * sigm(ag[0]) * av[0], ag[1] * sigm(ag[1]) * av[1]);
    o.y = pack2(ag[2] * sigm(ag[2]) * av[2], ag[3] * sigm(ag[3]) * av[3]);
    *(uint2*)(G + (base + y * 64 + x0 + xx) * 2816 + hh * 1408 + c4) = o;
  }
}
#undef CG_LD

__device__ __forceinline__ void down_tile(const Params& P, int t, char* lds) {
  const int nt = t >> 6, mt = t & 63;
  const int m0 = mt * 256, n0 = nt * 128;
  f32x16 acc[2][2];
  acc_zero(acc);
  gemm_main((const u16*)(P.ws + OFF_G) + (size_t)m0 * 2816, 2816, (const u16*)(P.ws + OFF_WT_DOWN) + (size_t)n0 * 2816, 2816, 2816, acc, (u16*)lds);
  TILE_COORDS
  const float* MOD = (const float*)(P.ws + OFF_MOD) + (m0 >> 12) * 6144 + 5 * 1024;
  float xv[2][2][16];
#pragma unroll
  for (int j = 0; j < 2; ++j)
#pragma unroll
    for (int i = 0; i < 2; ++i)
#pragma unroll
      for (int e = 0; e < 16; ++e) xv[i][j][e] = P.out[TIDX(m0, n0, i, j, e, 1024)];
#pragma unroll
  for (int j = 0; j < 2; ++j) {
    const int col = TCOL(n0, j);
    const float gate = MOD[col];
#pragma unroll
    for (int i = 0; i < 2; ++i)
#pragma unroll
      for (int e = 0; e < 16; ++e) P.out[TIDX(m0, n0, i, j, e, 1024)] = xv[i][j][e] + gate * acc[i][j][e];
  }
}

__device__ __forceinline__ void final_item(const Params& P, int item) {
  const int lane = opq(threadIdx.x) & 63, w = opq(threadIdx.x) >> 6;
  const int row = item * 8 + w;
  float* xr = P.out + (size_t)row * 1024;
  float4 v[4];
  float ss = 0.f;
#pragma unroll
  for (int it = 0; it < 4; ++it) {
    v[it] = *(const float4*)(xr + (it * 64 + lane) * 4);
    ss += v[it].x * v[it].x + v[it].y * v[it].y + v[it].z * v[it].z + v[it].w * v[it].w;
  }
  ss = wsum64(ss);
  const float rstd = rsqrtf(ss * (1.f / 1024.f) + 1e-6f);
#pragma unroll
  for (int it = 0; it < 4; ++it) {
    const int c = (it * 64 + lane) * 4;
    const float4 w4 = *(const float4*)(P.norm_f_w + c);
    float4 o;
    o.x = v[it].x * rstd * w4.x; o.y = v[it].y * rstd * w4.y; o.z = v[it].z * rstd * w4.z; o.w = v[it].w * rstd * w4.w;
    *(float4*)(xr + c) = o;
  }
}

__device__ __forceinline__ void run_phase(const Params& P, int ph, char* lds) {
  const int bid = blockIdx.x, nb = gridDim.x;
#ifdef ONLY_PHASE
  if (ph != ONLY_PHASE) return;
#endif
  switch (ph) {
    case 0: {
      for (int it = bid; it < 984 + 192 + 2048; it += nb) {
        if (it < 296) convert_item(P.w_in, 1024, 4624, (u16*)(P.ws + OFF_WT_IN), 0, it, lds);
        else if (it < 328) convert_item(P.w_a_out, 512, 1024, (u16*)(P.ws + OFF_WT_AOUT), 1, it - 296, lds);
        else if (it < 360) convert_item(P.w_glu, 512, 1024, (u16*)(P.ws + OFF_WT_GLU), 2, it - 328, lds);
        else if (it < 392) convert_item(P.w_b_out, 512, 1024, (u16*)(P.ws + OFF_WT_BOUT), 3, it - 360, lds);
        else if (it < 456) convert_item(P.w_o, 1024, 1024, (u16*)(P.ws + OFF_WT_O), 4, it - 392, lds);
        else if (it < 808) convert_item(P.w_up, 1024, 5632, (u16*)(P.ws + OFF_WT_UP), 5, it - 456, lds);
        else if (it < 984) convert_item(P.w_down, 2816, 1024, (u16*)(P.ws + OFF_WT_DOWN), 6, it - 808, lds);
        else if (it < 1176) mod_item(P, it - 984, lds);
        else s5tab_item(P, it - 1176, lds);
      }
    } break;
    case 1:
      for (int it = bid; it < 1088 + 2048; it += nb) {
        if (it < 1088) norm1_item(P, it); else mintra_item(P, it - 1088);
      }
      break;
    case 2:
      for (int it = bid; it < 1396; it += nb) inproj_tile(P, it, lds);
      break;
    case 3:
      for (int it = bid; it < 1088 + 192; it += nb) {
        if (it < 1088) delta_prep_item(P, it, lds); else s5end_tile(P, it - 1088, lds);
      }
      break;
    case 4:
      if (bid < 128) delta_scan_block(P, bid, lds);
      else if (bid < 160) s5_carry_block(P, bid - 128);
      break;
    case 5:
      for (int it = bid; it < 256 + 2048 + 1024; it += nb) {
        if (it < 256) s5out_tile(P, it, lds);
        else if (it < 2304) delta_post_item(P, it - 256);
        else norm1_item(P, it - 2304);
      }
      break;
    case 6:
      for (int it = bid; it < 512 + 1024; it += nb) {
        if (it < 512) glu_tile(P, it, lds); else gates_tile(P, it - 512, lds);
      }
      break;
    case 7:
      for (int it = bid; it < 512; it += nb) mix_tile(P, it, lds);
      break;
    case 8:
      for (int it = bid; it < 512; it += nb) wo_tile(P, it, lds);
      break;
    case 9:
      for (int it = bid; it < 1024; it += nb) norm2_item(P, it);
      break;
    case 10:
      for (int it = bid; it < 1408; it += nb) up_tile(P, it, 0, lds);
      break;
    case 11:
      for (int it = bid; it < 4096; it += nb) convgate_item(P, it, 0);
      break;
    case 12:
      for (int it = bid; it < 1408; it += nb) up_tile(P, it, 1, lds);
      break;
    case 13:
      for (int it = bid; it < 4096; it += nb) convgate_item(P, it, 1);
      break;
    case 14:
      for (int it = bid; it < 512; it += nb) down_tile(P, it, lds);
      break;
    case 15:
      for (int it = bid; it < 2048; it += nb) final_item(P, it);
      break;
    default: break;
  }
}

typedef const __attribute__((address_space(4))) Params* KParamsPtr;
__global__ void __launch_bounds__(NT) fwd_megakernel(Params Pk) {
#if defined(__HIP_DEVICE_COMPILE__)
  extern __shared__ __attribute__((aligned(16))) char lds[];
  KParamsPtr pp = (KParamsPtr)__builtin_amdgcn_kernarg_segment_ptr();
  const int lo = (int)pp->ph_lo, hi = (int)pp->ph_hi;
#if MULTI_LAUNCH
  for (int ph = lo; ph < hi; ++ph) { KParamsPtr q = pp; asm volatile("" : "+s"(q)); Params P; for (int i_ = 0; i_ < (int)(sizeof(Params) / 8); ++i_) ((unsigned long long*)&P)[i_] = ((const __attribute__((address_space(4))) unsigned long long*)q)[i_]; run_phase(P, ph, lds); }
#else
  cg::grid_group grid = cg::this_grid();
  volatile LAS unsigned* xst = (volatile LAS unsigned*)(lds + (LDS_BYTES - 16));
  if (threadIdx.x == 0) { xst[0] = 0u; xst[1] = 0u; xst[2] = 0u; xst[3] = 0u; }
  __syncthreads();
  XcdBarrier xb = xcd_barrier_post((unsigned*)(pp->ws + OFF_BAR), xst);
  const unsigned rep_mask = (unsigned)pp->rep_mask;
  bool first_sync = true;
  for (int ph = lo; ph < hi; ++ph) {
    const int reps = 1 + (int)((rep_mask >> ph) & 1u);
    for (int rp = 0; rp < reps; ++rp) {
      {
        KParamsPtr q = pp;
        asm volatile("" : "+s"(q));
        Params P;
        {
          typedef __attribute__((address_space(1))) const float* GF;
          const float** dp = (const float**)&P;
          const __attribute__((address_space(4))) unsigned long long* sp = (const __attribute__((address_space(4))) unsigned long long*)q;
#pragma unroll
          for (int i_ = 0; i_ < 30; ++i_) dp[i_] = (const float*)(GF)(sp[i_]);
          P.out = (float*)(__attribute__((address_space(1))) float*)(sp[30]);
          P.ws = (char*)(__attribute__((address_space(1))) char*)(sp[31]);
          P.ph_lo = 0; P.ph_hi = 0; P.rep_mask = 0;
        }
        run_phase(P, ph, lds);
      }
      if (ph + 1 < hi || rp + 1 < reps) {
        if (first_sync) { grid.sync(); first_sync = false; }
        else xcd_barrier(xb);
      }
    }
  }
#endif
#endif
}

extern "C" void kernel_launch(void* const* d_in, const int* in_sizes, int n_in, void* d_out, int out_size, void* d_ws,
                              size_t ws_size, hipStream_t stream) {
  static int grid_blocks = 0;
  if (grid_blocks == 0) {
    if (n_in != 30 || out_size != 16384 * 1024 || ws_size < WS_NEED) {
      fprintf(stderr, "kernel_launch: unexpected shapes: n_in %d out %d ws %zu (need %zu)\n", n_in, out_size, ws_size, (size_t)WS_NEED);
      grid_blocks = -1;
      return;
    }
    int dev = 0, cus = 0, per_cu = 0;
    hipGetDevice(&dev);
    hipDeviceGetAttribute(&cus, hipDeviceAttributeMultiprocessorCount, dev);
    if (hipFuncSetAttribute((const void*)fwd_megakernel, hipFuncAttributeMaxDynamicSharedMemorySize, LDS_BYTES) != hipSuccess) {
      fprintf(stderr, "kernel_launch: hipFuncSetAttribute failed\n");
      grid_blocks = -1;
      return;
    }
    if (hipOccupancyMaxActiveBlocksPerMultiprocessor(&per_cu, (const void*)fwd_megakernel, NT, LDS_BYTES) != hipSuccess || per_cu < 1) {
      fprintf(stderr, "kernel_launch: occupancy query failed / zero (%d)\n", per_cu);
      grid_blocks = -1;
      return;
    }
    grid_blocks = cus;
    if (grid_blocks < 64) { fprintf(stderr, "kernel_launch: too few CUs (%d)\n", cus); grid_blocks = -1; return; }
  }
  if (grid_blocks < 0) return;
  (void)hipMemsetAsync((char*)d_ws + OFF_BAR, 0, XCD_BAR_WORDS * sizeof(unsigned), stream);
  Params p{};
  const float** pp = (const float**)&p;
  for (int i = 0; i < 30; ++i) pp[i] = (const float*)d_in[i];
  p.out = (float*)d_out;
  p.ws = (char*)d_ws;
#if MULTI_LAUNCH
  for (int ph = 0; ph < 16; ++ph) {
    p.ph_lo = ph; p.ph_hi = ph + 1;
    hipLaunchKernelGGL(fwd_megakernel, dim3(grid_blocks), dim3(NT), LDS_BYTES, stream, p);
  }
#else
  p.ph_lo = 0; p.ph_hi = 16;
#ifdef REPEAT_MASK
  p.rep_mask = REPEAT_MASK;
#endif
  void* args[] = {&p};
  hipError_t e = hipLaunchCooperativeKernel((const void*)fwd_megakernel, dim3(grid_blocks), dim3(NT), args, LDS_BYTES, stream);
  if (e != hipSuccess) fprintf(stderr, "cooperative launch failed: %s (grid %d)\n", hipGetErrorString(e), grid_blocks);
#endif
}
```

```cpp
#include <hip/hip_runtime.h>
#include <hip/hip_cooperative_groups.h>
#include <cstdio>
#include <cstdint>
namespace cg = cooperative_groups;

#ifndef MULTI_LAUNCH
#define MULTI_LAUNCH 0
#endif

typedef unsigned short u16;
typedef __attribute__((ext_vector_type(8))) short bf16x8;
typedef __attribute__((ext_vector_type(4))) float f32x4;
typedef __attribute__((ext_vector_type(16))) float f32x16;
typedef __attribute__((ext_vector_type(4))) unsigned int u32x4;
typedef __attribute__((ext_vector_type(2))) unsigned int u32x2;

#define NT 512
constexpr int LDS_BYTES = 131072 + 1024;
constexpr int NPHASE = 18;

constexpr size_t OFF_WT_IN   = 0;
constexpr size_t OFF_WT_AOUT = 9699328;
constexpr size_t OFF_WT_GLU  = 10747904;
constexpr size_t OFF_WT_BOUT = 11796480;
constexpr size_t OFF_WT_O    = 12845056;
constexpr size_t OFF_WT_UP   = 14942208;
constexpr size_t OFF_WT_DOWN = 26476544;
constexpr size_t OFF_MOD     = 32243712;
constexpr size_t OFF_BAR     = 32505856;
constexpr size_t OFF_R2      = 33554432;
constexpr size_t OFF_R1      = 69206016;
constexpr size_t OFF_KTAB    = OFF_R1;
constexpr size_t OFF_MEND    = OFF_R1 + 2097152;
constexpr size_t OFF_MST     = OFF_R1 + 10485760;
constexpr size_t OFF_MINTRA  = OFF_R1 + 18874368;
constexpr size_t OFF_R3      = 104857600;
constexpr size_t OFF_O       = OFF_R3;
constexpr size_t OFF_XIN     = OFF_R3 + 33554432;
constexpr size_t OFF_MIX     = 158334976;
constexpr size_t OFF_SG      = OFF_R1;
constexpr size_t OFF_Z       = 158334976;
constexpr size_t OFF_U5      = 175112192;
constexpr size_t OFF_BA      = 192937984;
constexpr size_t OFF_GC      = OFF_BA + 1179648;
constexpr size_t OFF_UF      = 195035136;
constexpr size_t OFF_YA      = OFF_UF;
constexpr size_t OFF_YB      = OFF_UF + 16777216;
constexpr size_t OFF_E       = 230686720;
constexpr size_t OFF_YG      = OFF_E;
constexpr size_t OFF_UPH     = OFF_R1;
constexpr size_t OFF_G       = 161480704;
constexpr size_t WS_NEED     = 253755392;
constexpr size_t OFF_QKN     = 0;
constexpr size_t OFF_AQ      = 35651584;

struct Params {
  const float *x, *c, *ctx, *c_ctx, *w_ada, *b_ada, *norm1_w, *w_in, *dn_conv_w, *dn_a_log, *dn_dt_bias, *dn_norm_w,
      *w_a_out, *s5_a_re, *s5_a_im, *s5_log_step, *s5_b_re, *s5_b_im, *s5_c_re, *s5_c_im, *s5_d, *w_glu, *b_glu,
      *w_b_out, *w_o, *norm2_w, *w_up, *ffn_conv_w, *w_down, *norm_f_w;
  float* out;
  char* ws;
  long long ph_lo, ph_hi;
  long long rep_mask;
};

#define XB_TMO      128
#define XB_XCNT(j)  (256  + 64 * (j))
#define XB_XSUB(j)  (1280 + 64 * (j))
#define XB_XGEN(j)  (2304 + 64 * (j))
#define XB_TOP      3328
#define XB_TOPGEN   3392
#define XCD_BAR_WORDS 3456
#define XB_SPIN_CAP (1u << 18)
#define LAS __attribute__((address_space(3)))

__device__ __forceinline__ unsigned xb_ld(unsigned* p)              { return __hip_atomic_load(p, __ATOMIC_RELAXED, __HIP_MEMORY_SCOPE_AGENT); }
__device__ __forceinline__ unsigned xb_add(unsigned* p, unsigned v) { return __hip_atomic_fetch_add(p, v, __ATOMIC_RELAXED, __HIP_MEMORY_SCOPE_AGENT); }
__device__ __forceinline__ unsigned xb_xcc_id() { return (unsigned)__builtin_amdgcn_s_getreg((3 << 11) | 20) & 0xFu; }
#define XB_SPIN(cond, bar) do { unsigned _sp = 0; while (cond) { __builtin_amdgcn_s_sleep(1); \
    if ((++_sp & 255u) == 0u) { if (xb_ld(&(bar)[XB_TMO])) break; if (_sp > XB_SPIN_CAP) { atomicAdd(&(bar)[XB_TMO], 1u); break; } } } } while (0)

struct XcdBarrier {
    unsigned* bar; unsigned x;
    volatile LAS unsigned* st;
};

__device__ __forceinline__ XcdBarrier xcd_barrier_post(unsigned* bar, volatile LAS unsigned* st) {
    XcdBarrier b; b.bar = bar; b.x = xb_xcc_id(); b.st = st;
    if (threadIdx.x == 0) (void)xb_add(&bar[XB_XCNT(b.x)], 1u);
    return b;
}
__device__ __forceinline__ void xcd_barrier_complete(unsigned* bar, unsigned x, unsigned& nloc, unsigned& nx) {
    const unsigned G = gridDim.x * gridDim.y * gridDim.z;
    unsigned sum, cnt, mine, sp = 0u;
    for (;;) {
        sum = 0u; cnt = 0u; mine = 0u;
#pragma unroll
        for (unsigned j = 0; j < 16; ++j) { const unsigned c = xb_ld(&bar[XB_XCNT(j)]); sum += c; cnt += (c > 0u) ? 1u : 0u; mine = (j == x) ? c : mine; }
        if (sum == G) break;
        __builtin_amdgcn_s_sleep(1);
        if ((++sp & 255u) == 0u) { if (xb_ld(&bar[XB_TMO])) break; if (sp > XB_SPIN_CAP) { atomicAdd(&bar[XB_TMO], 1u); break; } }
    }
    nloc = mine > 0u ? mine : 1u; nx = cnt > 0u ? cnt : 1u;
}

__device__ __forceinline__ void xcd_barrier(const XcdBarrier& b) {
    asm volatile("s_waitcnt vmcnt(0)" ::: "memory");
    __syncthreads();
    if (threadIdx.x == 0) {
        unsigned* bar = b.bar;
        __builtin_amdgcn_s_waitcnt(0);
        unsigned nloc = b.st[0], nx = b.st[1];
        if (nloc == 0u) { xcd_barrier_complete(bar, b.x, nloc, nx); b.st[0] = nloc; b.st[1] = nx; }
        const unsigned old = xb_add(&bar[XB_XSUB(b.x)], 1u);
        const unsigned gen = old / nloc;
        if (old + 1u == (gen + 1u) * nloc) {
            __builtin_amdgcn_fence(__ATOMIC_RELEASE, "agent");
            asm volatile("s_waitcnt vmcnt(0)" ::: "memory");
            const unsigned og = xb_add(&bar[XB_TOP], 1u);
            const unsigned tg = og / nx;
            if (og + 1u == (tg + 1u) * nx) xb_add(&bar[XB_TOPGEN], 1u);
            else XB_SPIN(xb_ld(&bar[XB_TOPGEN]) == tg, bar);
            __builtin_amdgcn_fence(__ATOMIC_ACQUIRE, "agent");
            xb_add(&bar[XB_XGEN(b.x)], 1u);
            asm volatile("s_waitcnt vmcnt(0)" ::: "memory");
        } else {
            XB_SPIN(xb_ld(&bar[XB_XGEN(b.x)]) == gen, bar);
            __builtin_amdgcn_fence(__ATOMIC_ACQUIRE, "agent");
            asm volatile("s_waitcnt vmcnt(0)" ::: "memory");
        }
    }
    __syncthreads();
}


typedef __attribute__((ext_vector_type(2))) float f32x2_t;
typedef __attribute__((ext_vector_type(2))) __bf16 bf16x2_t;
__device__ __forceinline__ u16 f2bf(float f) {
  const __bf16 h = (__bf16)f;
  return __builtin_bit_cast(u16, h);
}
__device__ __forceinline__ float bf2f(u16 h) { return __uint_as_float(((uint32_t)h) << 16); }
__device__ __forceinline__ uint32_t pack2(float a, float b) {
  const f32x2_t v = {a, b};
  const bf16x2_t r = __builtin_convertvector(v, bf16x2_t);
  return __builtin_bit_cast(uint32_t, r);
}
__device__ __forceinline__ float lo16(uint32_t w) { return __uint_as_float(w << 16); }
__device__ __forceinline__ float hi16(uint32_t w) { return __uint_as_float(w & 0xffff0000u); }
__device__ __forceinline__ int opq(int v) { asm volatile("" : "+v"(v)); return v; }
__device__ __forceinline__ void lds_barrier() {
  asm volatile("s_waitcnt lgkmcnt(0)" ::: "memory");
  __builtin_amdgcn_s_barrier();
  asm volatile("" ::: "memory");
}
__device__ __forceinline__ float sigm(float x) { return 1.f / (1.f + __expf(-x)); }
__device__ __forceinline__ void unpack8(uint4 v, float* f) {
  f[0] = lo16(v.x); f[1] = hi16(v.x); f[2] = lo16(v.y); f[3] = hi16(v.y);
  f[4] = lo16(v.z); f[5] = hi16(v.z); f[6] = lo16(v.w); f[7] = hi16(v.w);
}
__device__ __forceinline__ uint4 pack8(const float* f) {
  uint4 v; v.x = pack2(f[0], f[1]); v.y = pack2(f[2], f[3]); v.z = pack2(f[4], f[5]); v.w = pack2(f[6], f[7]);
  return v;
}
__device__ __forceinline__ float wsum64(float v) {
#pragma unroll
  for (int o = 32; o > 0; o >>= 1) v += __shfl_xor(v, o, 64);
  return v;
}
__device__ __forceinline__ float gelu_tanh(float x) {
  float u = 0.7978845608028654f * (x + 0.044715f * x * x * x);
  float t = 1.f - 2.f / (1.f + __expf(2.f * u));
  return 0.5f * x * (1.f + t);
}

__device__ __forceinline__ void g_frag(const u16* as, const u16* bs, int ks, bf16x8 (&a)[2], bf16x8 (&b)[2]) {
  a[0] = *(const bf16x8*)(as + ks * 16);
  a[1] = *(const bf16x8*)(as + 32 * 72 + ks * 16);
  b[0] = *(const bf16x8*)(bs + ks * 16);
  b[1] = *(const bf16x8*)(bs + 32 * 72 + ks * 16);
}
__device__ __forceinline__ void g_mma(const bf16x8 (&a)[2], const bf16x8 (&b)[2], f32x16 (&acc)[2][2]) {
  acc[0][0] = __builtin_amdgcn_mfma_f32_32x32x16_bf16(a[0], b[0], acc[0][0], 0, 0, 0);
  acc[0][1] = __builtin_amdgcn_mfma_f32_32x32x16_bf16(a[0], b[1], acc[0][1], 0, 0, 0);
  acc[1][0] = __builtin_amdgcn_mfma_f32_32x32x16_bf16(a[1], b[0], acc[1][0], 0, 0, 0);
  acc[1][1] = __builtin_amdgcn_mfma_f32_32x32x16_bf16(a[1], b[1], acc[1][1], 0, 0, 0);
}
__device__ __forceinline__ void gemm_main(const u16* __restrict__ A, int lda, const u16* __restrict__ Bt, int ldb, int K,
                                          f32x16 (&acc)[2][2], u16* lds) {
  const int tid = opq(threadIdx.x), lane = tid & 63, w = tid >> 6, wm = w >> 1, wn = w & 1, fr = lane & 31, fq = lane >> 5;
  u16* As = lds;
  u16* Bs = lds + 2 * 256 * 72;
  const int nk = K >> 6;
  uint4 p0, p1, p2, p3, p4, p5;
  uint4 q0, q1, q2, q3, q4, q5;
  uint4 r0, r1, r2, r3, r4, r5;
  const int lr = tid >> 3, lc = (tid & 7) * 8;
  const unsigned oa0 = (unsigned)(lr * lda + lc) * 2u, sa2 = (unsigned)lda * 128u;
  const unsigned oa1 = oa0 + sa2, oa2 = oa0 + 2u * sa2, oa3 = oa0 + 3u * sa2;
  const unsigned ob0 = (unsigned)(lr * ldb + lc) * 2u, ob1 = ob0 + (unsigned)ldb * 128u;
#define G_LOAD(S, kt_)                                          \
  {                                                             \
    const int kc_ = ((kt_) < nk) ? (kt_) : (nk - 1);            \
    const char* a_ = (const char*)A + kc_ * 128;                \
    const char* b_ = (const char*)Bt + kc_ * 128;               \
    S##0 = *(const uint4*)(a_ + oa0);                           \
    S##1 = *(const uint4*)(a_ + oa1);                           \
    S##2 = *(const uint4*)(a_ + oa2);                           \
    S##3 = *(const uint4*)(a_ + oa3);                           \
    S##4 = *(const uint4*)(b_ + ob0);                           \
    S##5 = *(const uint4*)(b_ + ob1);                           \
  }
#define G_STORE(S, buf_)                                                     \
  {                                                                          \
    u16* as_ = As + ((buf_) * 256 + lr) * 72 + lc;                           \
    u16* bs_ = Bs + ((buf_) * 128 + lr) * 72 + lc;                           \
    *(uint4*)(as_) = S##0;                                                   \
    *(uint4*)(as_ + 64 * 72) = S##1;                                         \
    *(uint4*)(as_ + 128 * 72) = S##2;                                        \
    *(uint4*)(as_ + 192 * 72) = S##3;                                        \
    *(uint4*)(bs_) = S##4;                                                   \
    *(uint4*)(bs_ + 64 * 72) = S##5;                                         \
  }
#define G_STEP(S, BUF, kt_)                                                               \
  {                                                                                       \
    const u16* as = As + ((BUF) * 256 + wm * 64 + fr) * 72 + fq * 8;                      \
    const u16* bs = Bs + ((BUF) * 128 + wn * 64 + fr) * 72 + fq * 8;                      \
    bf16x8 fa0[2], fb0[2], fa1[2], fb1[2], fa2[2], fb2[2];                                \
    g_frag(as, bs, 0, fa0, fb0);                                                          \
    g_frag(as, bs, 1, fa1, fb1);                                                          \
    __builtin_amdgcn_sched_barrier(0);                                                    \
    G_STORE(S, (BUF) ^ 1)                                                                 \
    G_LOAD(S, (kt_) + 4)                                                                  \
    __builtin_amdgcn_sched_barrier(0);                                                    \
    g_frag(as, bs, 2, fa2, fb2);                                                          \
    __builtin_amdgcn_sched_barrier(0);                                                    \
    g_mma(fa0, fb0, acc);                                                                 \
    __builtin_amdgcn_sched_barrier(0);                                                    \
    g_frag(as, bs, 3, fa0, fb0);                                                          \
    __builtin_amdgcn_sched_barrier(0);                                                    \
    g_mma(fa1, fb1, acc);                                                                 \
    g_mma(fa2, fb2, acc);                                                                 \
    g_mma(fa0, fb0, acc);                                                                 \
    lds_barrier();                                                                      \
  }
  G_LOAD(p, 0)
  lds_barrier();
  G_STORE(p, 0)
  G_LOAD(q, 1)
  G_LOAD(r, 2)
  G_LOAD(p, 3)
  lds_barrier();
  for (int kt = 0; kt < nk; kt += 6) {
    G_STEP(q, 0, kt)
    G_STEP(r, 1, kt + 1)
    if (kt + 2 < nk) {
      G_STEP(p, 0, kt + 2)
      G_STEP(q, 1, kt + 3)
    }
    if (kt + 4 < nk) {
      G_STEP(r, 0, kt + 4)
      G_STEP(p, 1, kt + 5)
    }
  }
#undef G_STEP
#undef G_LOAD
#undef G_STORE
}

__device__ __forceinline__ void acc_zero(f32x16 (&acc)[2][2]) {
#pragma unroll
  for (int i = 0; i < 2; ++i)
#pragma unroll
    for (int j = 0; j < 2; ++j)
#pragma unroll
      for (int e = 0; e < 16; ++e) acc[i][j][e] = 0.f;
}

#define TILE_COORDS                                                                                  \
  const int tid_ = opq(threadIdx.x), lane_ = tid_ & 63, w_ = __builtin_amdgcn_readfirstlane(tid_ >> 6), \
            wm_ = w_ >> 1, wn_ = w_ & 1, fr_ = lane_ & 31, fq_ = lane_ >> 5;
#define TROW(m0, i, e) ((m0) + wm_ * 64 + (i) * 32 + ((e) & 3) + 8 * ((e) >> 2) + 4 * fq_)
#define TCOL(n0, j) ((n0) + wn_ * 64 + (j) * 32 + fr_)
#define TIDX2(m0, cb, i, e, ld) ((size_t)((m0) + wm_ * 64 + (i) * 32 + ((e) & 3) + 8 * ((e) >> 2)) * (ld) + (cb) + (size_t)(unsigned)(4 * fq_ * (ld) + fr_))
#define TIDX(m0, n0, i, j, e, ld) TIDX2(m0, (n0) + wn_ * 64 + (j) * 32, i, e, ld)

__device__ __forceinline__ int srccol(int which, int r) {
  switch (which) {
    case 0:
      if (r < 2048) return r;
      if (r < 2560) return 2064 + (r - 2048);
      if (r < 2576) return 2048 + (r - 2560);
      if (r < 2688) return -1;
      if (r < 3712) return 2576 + (r - 2688);
      return 3600 + (r - 3712);
    case 2: {
      int tile = r >> 7, wn = (r >> 6) & 1, wi = r & 63;
      return (wi < 32) ? (tile * 64 + wn * 32 + wi) : (512 + tile * 64 + wn * 32 + (wi - 32));
    }
    case 5: {
      int hh = r / 2816, cc = r % 2816;
      return (cc < 1408) ? (hh * 1408 + cc) : (2816 + hh * 1408 + (cc - 1408));
    }
    default: return r;
  }
}

__device__ __forceinline__ void convert_item(const float* __restrict__ src, int K, int N, u16* __restrict__ dst, int which, int item, char* lds) {
  float* tile = (float*)lds;
  const int tid = opq(threadIdx.x);
  const int kb = K >> 8;
  const int r0 = (item / kb) * 64, k0 = (item % kb) * 256;
  lds_barrier();
  {
    const int n4 = (tid & 15) * 4, kk = tid >> 4;
    const int sc = srccol(which, r0 + n4);
    float4 v[8];
#pragma unroll
    for (int it = 0; it < 8; ++it) {
      const int k = kk + 32 * it;
      v[it] = (sc >= 0) ? *(const float4*)(src + (size_t)(k0 + k) * N + sc) : make_float4(0.f, 0.f, 0.f, 0.f);
    }
#pragma unroll
    for (int it = 0; it < 8; ++it) {
      const int k = kk + 32 * it;
      tile[(n4 + 0) * 257 + k] = v[it].x; tile[(n4 + 1) * 257 + k] = v[it].y;
      tile[(n4 + 2) * 257 + k] = v[it].z; tile[(n4 + 3) * 257 + k] = v[it].w;
    }
  }
  lds_barrier();
  {
    const int ks = (tid & 31) * 8, rr = tid >> 5;
#pragma unroll
    for (int it = 0; it < 4; ++it) {
      const int row = rr + 16 * it;
      float f[8];
#pragma unroll
      for (int e = 0; e < 8; ++e) f[e] = tile[row * 257 + ks + e];
      *(uint4*)(dst + (size_t)(r0 + row) * K + k0 + ks) = pack8(f);
    }
  }
}

__device__ __forceinline__ void mod_item(const Params& P, int item, char* lds) {
  float* sc = (float*)lds;
  float* red = sc + 5 * 1024;
  const int tid = opq(threadIdx.x);
  lds_barrier();
  for (int i = tid; i < 5 * 1024; i += NT) {
    const int r = i >> 10, k = i & 1023;
    float v = (r < 4) ? P.c[r * 1024 + k] : P.c_ctx[k];
    sc[i] = v * sigm(v);
  }
  lds_barrier();
  const int nn = tid & 31, kg = tid >> 5;
  const int n = item * 32 + nn;
  float a0 = 0, a1 = 0, a2 = 0, a3 = 0, a4 = 0;
  for (int kk = 0; kk < 64; ++kk) {
    const int k = kg * 64 + kk;
    const float wv = P.w_ada[(size_t)k * 6144 + n];
    a0 += sc[k] * wv; a1 += sc[1024 + k] * wv; a2 += sc[2048 + k] * wv; a3 += sc[3072 + k] * wv; a4 += sc[4096 + k] * wv;
  }
  red[(kg * 5 + 0) * 32 + nn] = a0; red[(kg * 5 + 1) * 32 + nn] = a1; red[(kg * 5 + 2) * 32 + nn] = a2;
  red[(kg * 5 + 3) * 32 + nn] = a3; red[(kg * 5 + 4) * 32 + nn] = a4;
  lds_barrier();
  if (tid < 160) {
    const int r = tid >> 5, n2 = tid & 31;
    float s = 0.f;
#pragma unroll
    for (int g = 0; g < 16; ++g) s += red[(g * 5 + r) * 32 + n2];
    float* MOD = (float*)(P.ws + OFF_MOD);
    MOD[r * 6144 + item * 32 + n2] = s + P.b_ada[item * 32 + n2];
  }
}

__device__ __forceinline__ void lam_pow(float step, float are, float aim, int e, float& pr, float& pi) {
  const float mag = expf((float)e * step * are);
  double ang = (double)e * (double)step * (double)aim;
  ang -= 6.283185307179586476925 * rint(ang * 0.15915494309189533577);
  float s, c;
  __sincosf((float)ang, &s, &c);
  pr = mag * c; pi = mag * s;
}

__device__ __forceinline__ void s5tab_item(const Params& P, int item, char* lds) {
  const int tid = opq(threadIdx.x);
  const int tau = item & 31, g = (item >> 5) & 31, r = item >> 10;
  float* cfr = (float*)lds;
  float* cfi = cfr + 64;
  float* p0r = cfi + 64;
  float* p0i = p0r + 64;
  float* p1r = p0i + 64;
  float* p1i = p1r + 64;
  float* Gr = p1i + 64;
  float* Gi = Gr + 1024;
  float* Cr = Gi + 1024;
  float* Ci = Cr + 1024;
  const int rg = r * 32 + g;
  lds_barrier();
  if (tid < 64) {
    const int n = tid;
    const float step = expf(P.s5_log_step[rg]);
    const float are = P.s5_a_re[rg * 64 + n], aim = P.s5_a_im[rg * 64 + n];
    const float za = step * are;
    double zb = (double)step * (double)aim;
    zb -= 6.283185307179586476925 * rint(zb * 0.15915494309189533577);
    float sb, cb, sh, ch;
    __sincosf((float)zb, &sb, &cb);
    __sincosf((float)(0.5 * zb), &sh, &ch);
    const float em1 = expm1f(za);
    const float re1 = em1 * cb - 2.f * sh * sh;
    const float im1 = (1.f + em1) * sb;
    const float den = are * are + aim * aim;
    cfr[n] = (re1 * are + im1 * aim) / den;
    cfi[n] = (im1 * are - re1 * aim) / den;
    float pr, pi;
    lam_pow(step, are, aim, tau, pr, pi);
    p0r[n] = pr; p0i[n] = pi;
    lam_pow(step, are, aim, tau + 1, pr, pi);
    p1r[n] = pr; p1i[n] = pi;
  }
  for (int i = tid; i < 1024; i += NT) {
    Cr[i] = P.s5_c_re[(size_t)rg * 1024 + i];
    Ci[i] = P.s5_c_im[(size_t)rg * 1024 + i];
  }
  lds_barrier();
  for (int i = tid; i < 1024; i += NT) {
    const int n = i >> 4;
    const float br = P.s5_b_re[(size_t)rg * 1024 + i], bi = P.s5_b_im[(size_t)rg * 1024 + i];
    const float tr = cfr[n] * br - cfi[n] * bi, ti = cfr[n] * bi + cfi[n] * br;
    Gr[i] = p0r[n] * tr - p0i[n] * ti;
    Gi[i] = p0r[n] * ti + p0i[n] * tr;
  }
  lds_barrier();
  u16* MEND = (u16*)(P.ws + OFF_MEND);
  u16* MST = (u16*)(P.ws + OFF_MST);
  float* KTAB = (float*)(P.ws + OFF_KTAB);
  {
    const int ii = (r == 0) ? (31 - tau) : tau;
    for (int i = tid; i < 2048; i += NT) {
      const int part = i >> 10, n = (i >> 4) & 63, pi_ = i & 15;
      const float v = part ? Gi[n * 16 + pi_] : Gr[n * 16 + pi_];
      MEND[((size_t)g * 256 + r * 128 + part * 64 + n) * 512 + ii * 16 + pi_] = f2bf(v);
    }
  }
  if (tid < 256) {
    const int po = tid >> 4, pi_ = tid & 15;
    float s = 0.f;
    for (int n = 0; n < 64; ++n) s += Cr[po * 64 + n] * Gr[n * 16 + pi_] - Ci[po * 64 + n] * Gi[n * 16 + pi_];
    KTAB[(((size_t)rg) * 32 + tau) * 256 + tid] = s;
  }
  {
    const int jj = (r == 0) ? tau : (31 - tau);
    for (int i = tid; i < 2048; i += NT) {
      const int po = i >> 7, part = (i >> 6) & 1, n = i & 63;
      const float cr = Cr[po * 64 + n], ci = Ci[po * 64 + n];
      const float v = part ? -(cr * p1i[n] + ci * p1r[n]) : (cr * p1r[n] - ci * p1i[n]);
      MST[((size_t)g * 512 + jj * 16 + po) * 256 + r * 128 + part * 64 + n] = f2bf(v);
    }
  }
}

__device__ __forceinline__ void norm_row(const float* __restrict__ xr, const float* __restrict__ nw, const float* __restrict__ shift,
                                         const float* __restrict__ scale, u16* __restrict__ dst, int lane) {
  float4 v[4];
  float ss = 0.f;
#pragma unroll
  for (int it = 0; it < 4; ++it) {
    v[it] = *(const float4*)(xr + (it * 64 + lane) * 4);
    ss += v[it].x * v[it].x + v[it].y * v[it].y + v[it].z * v[it].z + v[it].w * v[it].w;
  }
  ss = wsum64(ss);
  const float rstd = rsqrtf(ss * (1.f / 1024.f) + 1e-6f);
#pragma unroll
  for (int it = 0; it < 4; ++it) {
    const int c = (it * 64 + lane) * 4;
    const float4 w4 = *(const float4*)(nw + c), sh = *(const float4*)(shift + c), sc = *(const float4*)(scale + c);
    const float y0 = v[it].x * rstd * w4.x * (1.f + sc.x) + sh.x;
    const float y1 = v[it].y * rstd * w4.y * (1.f + sc.y) + sh.y;
    const float y2 = v[it].z * rstd * w4.z * (1.f + sc.z) + sh.z;
    const float y3 = v[it].w * rstd * w4.w * (1.f + sc.w) + sh.w;
    uint2 o; o.x = pack2(y0, y1); o.y = pack2(y2, y3);
    *(uint2*)(dst + c) = o;
  }
}

__device__ __forceinline__ void norm_row2(const float* __restrict__ xa, const float* __restrict__ xb, const float* __restrict__ nw,
                                          const float* __restrict__ shA, const float* __restrict__ scA,
                                          const float* __restrict__ shB, const float* __restrict__ scB,
                                          u16* __restrict__ da, u16* __restrict__ db, int lane) {
  float4 va[4], vb[4];
#pragma unroll
  for (int it = 0; it < 4; ++it) { va[it] = *(const float4*)(xa + (it * 64 + lane) * 4); vb[it] = *(const float4*)(xb + (it * 64 + lane) * 4); }
  float sa = 0.f, sb = 0.f;
#pragma unroll
  for (int it = 0; it < 4; ++it) {
    sa += va[it].x * va[it].x + va[it].y * va[it].y + va[it].z * va[it].z + va[it].w * va[it].w;
    sb += vb[it].x * vb[it].x + vb[it].y * vb[it].y + vb[it].z * vb[it].z + vb[it].w * vb[it].w;
  }
  sa = wsum64(sa); sb = wsum64(sb);
  const float ra = rsqrtf(sa * (1.f / 1024.f) + 1e-6f), rb = rsqrtf(sb * (1.f / 1024.f) + 1e-6f);
#pragma unroll
  for (int it = 0; it < 4; ++it) {
    const int c = (it * 64 + lane) * 4;
    const float4 w4 = *(const float4*)(nw + c);
    const float4 sh = *(const float4*)(shA + c), sc = *(const float4*)(scA + c);
    const float4 sh2 = *(const float4*)(shB + c), sc2 = *(const float4*)(scB + c);
    uint2 o;
    o.x = pack2(va[it].x * ra * w4.x * (1.f + sc.x) + sh.x, va[it].y * ra * w4.y * (1.f + sc.y) + sh.y);
    o.y = pack2(va[it].z * ra * w4.z * (1.f + sc.z) + sh.z, va[it].w * ra * w4.w * (1.f + sc.w) + sh.w);
    *(uint2*)(da + c) = o;
    o.x = pack2(vb[it].x * rb * w4.x * (1.f + sc2.x) + sh2.x, vb[it].y * rb * w4.y * (1.f + sc2.y) + sh2.y);
    o.y = pack2(vb[it].z * rb * w4.z * (1.f + sc2.z) + sh2.z, vb[it].w * rb * w4.w * (1.f + sc2.w) + sh2.w);
    *(uint2*)(db + c) = o;
  }
}

__device__ __forceinline__ void norm1_item(const Params& P, int item) {
  const int lane = opq(threadIdx.x) & 63, w = opq(threadIdx.x) >> 6;
  const int rowA = item * 16 + w, rowB = rowA + 8;
  const float* MOD = (const float*)(P.ws + OFF_MOD);
  const int ba = (rowA < 16384) ? (rowA >> 12) : 4, bb = (rowB < 16384) ? (rowB >> 12) : 4;
  const float* xa = (rowA < 16384) ? (P.x + (size_t)rowA * 1024) : (P.ctx + (size_t)(rowA - 16384) * 1024);
  const float* xb = (rowB < 16384) ? (P.x + (size_t)rowB * 1024) : (P.ctx + (size_t)(rowB - 16384) * 1024);
  u16* H = (u16*)(P.ws + OFF_R2);
  norm_row2(xa, xb, P.norm1_w, MOD + ba * 6144, MOD + ba * 6144 + 1024, MOD + bb * 6144, MOD + bb * 6144 + 1024,
            H + (size_t)rowA * 1024, H + (size_t)rowB * 1024, lane);
}

__device__ __forceinline__ void mintra_item(const Params& P, int item) {
  const int tid = opq(threadIdx.x);
  const int rowg = item * 8 + (tid >> 6);
  const int g = rowg >> 9, nout = rowg & 511, j = nout >> 4, po = nout & 15;
  const int k0 = (tid & 63) * 8, i = k0 >> 4, pi0 = k0 & 15;
  const float* KTAB = (const float*)(P.ws + OFF_KTAB);
  float f[8];
#pragma unroll
  for (int e = 0; e < 8; ++e) f[e] = 0.f;
  if (i <= j) {
    const float* kp = KTAB + (((size_t)(0 * 32 + g)) * 32 + (j - i)) * 256 + po * 16 + pi0;
#pragma unroll
    for (int e = 0; e < 8; ++e) f[e] += kp[e];
  }
  if (i >= j) {
    const float* kp = KTAB + (((size_t)(1 * 32 + g)) * 32 + (i - j)) * 256 + po * 16 + pi0;
#pragma unroll
    for (int e = 0; e < 8; ++e) f[e] += kp[e];
  }
  if (i == j) {
    const float dv = P.s5_d[g * 16 + po];
#pragma unroll
    for (int e = 0; e < 8; ++e) if (pi0 + e == po) f[e] += dv;
  }
  u16* MI = (u16*)(P.ws + OFF_MINTRA);
  *(uint4*)(MI + (size_t)rowg * 512 + k0) = pack8(f);
}

__device__ __forceinline__ void inproj_tile(const Params& P, int t, char* lds) {
  int mt, nt;
  if (t < 1344) { nt = t / 64; mt = t % 64; }
  else {
    const int tt = t - 1344; mt = 64 + (tt & 3);
    const int ni = tt >> 2;
    nt = (ni < 8) ? (4 + ni) : ((ni < 12) ? (16 + ni - 8) : 20);
  }
  const int m0 = mt * 256, n0 = nt * 128;
  f32x16 acc[2][2];
  acc_zero(acc);
  gemm_main((const u16*)(P.ws + OFF_R2) + (size_t)m0 * 1024, 1024, (const u16*)(P.ws + OFF_WT_IN) + (size_t)n0 * 1024, 1024, 1024, acc, (u16*)lds);
  TILE_COORDS
  if (nt < 12) {
    u16* QKV = (u16*)(P.ws + OFF_R3);
#pragma unroll
    for (int i = 0; i < 2; ++i)
#pragma unroll
      for (int j = 0; j < 2; ++j)
#pragma unroll
        for (int e = 0; e < 16; ++e) QKV[TIDX(m0, n0, i, j, e, 1536)] = f2bf(acc[i][j][e]);
  } else if (nt < 16) {
    u16* Z = (u16*)(P.ws + OFF_Z);
#pragma unroll
    for (int i = 0; i < 2; ++i)
#pragma unroll
      for (int j = 0; j < 2; ++j)
#pragma unroll
        for (int e = 0; e < 16; ++e) Z[TIDX(m0, n0, i, j, e, 512) - 1536] = f2bf(acc[i][j][e]);
  } else if (nt < 20) {
    u16* U5 = (u16*)(P.ws + OFF_U5);
#pragma unroll
    for (int i = 0; i < 2; ++i)
#pragma unroll
      for (int j = 0; j < 2; ++j)
#pragma unroll
        for (int e = 0; e < 16; ++e) {
          const int cc = TCOL(n0, j) - 2048;
          U5[((size_t)(cc >> 4) * 17408 + TROW(m0, i, e)) * 16 + (cc & 15)] = f2bf(acc[i][j][e]);
        }
  } else {
    float* BA = (float*)(P.ws + OFF_BA);
#pragma unroll
    for (int i = 0; i < 2; ++i)
#pragma unroll
      for (int j = 0; j < 2; ++j)
#pragma unroll
        for (int e = 0; e < 16; ++e) {
          const int cc = TCOL(n0, j) - 2560;
          if (cc < 16) BA[(size_t)TROW(m0, i, e) * 16 + cc] = acc[i][j][e];
        }
  }
}

__device__ __forceinline__ void solve_elim(float (&sol)[64], const float* Lr) {
  float4 b0a, b0b, b0c, b0d, b1a, b1b, b1c, b1d, b2a, b2b, b2c, b2d;
  b0a = *(const float4*)(Lr + 0); b0b = *(const float4*)(Lr + 4); b0c = *(const float4*)(Lr + 8); b0d = *(const float4*)(Lr + 12);
  b1a = *(const float4*)(Lr + 16); b1b = *(const float4*)(Lr + 20); b1c = *(const float4*)(Lr + 24); b1d = *(const float4*)(Lr + 28);
  b2a = *(const float4*)(Lr + 32); b2b = *(const float4*)(Lr + 36); b2c = *(const float4*)(Lr + 40); b2d = *(const float4*)(Lr + 44);
  __builtin_amdgcn_sched_barrier(0);
  sol[1] -= b0a.y * sol[0]; sol[2] -= b0a.z * sol[0]; sol[3] -= b0a.w * sol[0]; sol[4] -= b0b.x * sol[0]; sol[5] -= b0b.y * sol[0]; sol[6] -= b0b.z * sol[0]; sol[7] -= b0b.w * sol[0]; sol[8] -= b0c.x * sol[0]; sol[9] -= b0c.y * sol[0]; sol[10] -= b0c.z * sol[0]; sol[11] -= b0c.w * sol[0]; sol[12] -= b0d.x * sol[0]; sol[13] -= b0d.y * sol[0]; sol[14] -= b0d.z * sol[0]; sol[15] -= b0d.w * sol[0];
  __builtin_amdgcn_sched_barrier(0);
  b0a = *(const float4*)(Lr + 48); b0b = *(const float4*)(Lr + 52); b0c = *(const float4*)(Lr + 56); b0d = *(const float4*)(Lr + 60);
  __builtin_amdgcn_sched_barrier(0);
  sol[16] -= b1a.x * sol[0]; sol[17] -= b1a.y * sol[0]; sol[18] -= b1a.z * sol[0]; sol[19] -= b1a.w * sol[0]; sol[20] -= b1b.x * sol[0]; sol[21] -= b1b.y * sol[0]; sol[22] -= b1b.z * sol[0]; sol[23] -= b1b.w * sol[0]; sol[24] -= b1c.x * sol[0]; sol[25] -= b1c.y * sol[0]; sol[26] -= b1c.z * sol[0]; sol[27] -= b1c.w * sol[0]; sol[28] -= b1d.x * sol[0]; sol[29] -= b1d.y * sol[0]; sol[30] -= b1d.z * sol[0]; sol[31] -= b1d.w * sol[0];
  __builtin_amdgcn_sched_barrier(0);
  b1a = *(const float4*)(Lr + 64); b1b = *(const float4*)(Lr + 68); b1c = *(const float4*)(Lr + 72); b1d = *(const float4*)(Lr + 76);
  __builtin_amdgcn_sched_barrier(0);
  sol[32] -= b2a.x * sol[0]; sol[33] -= b2a.y * sol[0]; sol[34] -= b2a.z * sol[0]; sol[35] -= b2a.w * sol[0]; sol[36] -= b2b.x * sol[0]; sol[37] -= b2b.y * sol[0]; sol[38] -= b2b.z * sol[0]; sol[39] -= b2b.w * sol[0]; sol[40] -= b2c.x * sol[0]; sol[41] -= b2c.y * sol[0]; sol[42] -= b2c.z * sol[0]; sol[43] -= b2c.w * sol[0]; sol[44] -= b2d.x * sol[0]; sol[45] -= b2d.y * sol[0]; sol[46] -= b2d.z * sol[0]; sol[47] -= b2d.w * sol[0];
  __builtin_amdgcn_sched_barrier(0);
  b2a = *(const float4*)(Lr + 80); b2b = *(const float4*)(Lr + 84); b2c = *(const float4*)(Lr + 88); b2d = *(const float4*)(Lr + 92);
  __builtin_amdgcn_sched_barrier(0);
  sol[48] -= b0a.x * sol[0]; sol[49] -= b0a.y * sol[0]; sol[50] -= b0a.z * sol[0]; sol[51] -= b0a.w * sol[0]; sol[52] -= b0b.x * sol[0]; sol[53] -= b0b.y * sol[0]; sol[54] -= b0b.z * sol[0]; sol[55] -= b0b.w * sol[0]; sol[56] -= b0c.x * sol[0]; sol[57] -= b0c.y * sol[0]; sol[58] -= b0c.z * sol[0]; sol[59] -= b0c.w * sol[0]; sol[60] -= b0d.x * sol[0]; sol[61] -= b0d.y * sol[0]; sol[62] -= b0d.z * sol[0]; sol[63] -= b0d.w * sol[0];
  __builtin_amdgcn_sched_barrier(0);
  b0a = *(const float4*)(Lr + 96); b0b = *(const float4*)(Lr + 100); b0c = *(const float4*)(Lr + 104); b0d = *(const float4*)(Lr + 108);
  __builtin_amdgcn_sched_barrier(0);
  sol[2] -= b1a.z * sol[1]; sol[3] -= b1a.w * sol[1]; sol[4] -= b1b.x * sol[1]; sol[5] -= b1b.y * sol[1]; sol[6] -= b1b.z * sol[1]; sol[7] -= b1b.w * sol[1]; sol[8] -= b1c.x * sol[1]; sol[9] -= b1c.y * sol[1]; sol[10] -= b1c.z * sol[1]; sol[11] -= b1c.w * sol[1]; sol[12] -= b1d.x * sol[1]; sol[13] -= b1d.y * sol[1]; sol[14] -= b1d.z * sol[1]; sol[15] -= b1d.w * sol[1];
  __builtin_amdgcn_sched_barrier(0);
  b1a = *(const float4*)(Lr + 112); b1b = *(const float4*)(Lr + 116); b1c = *(const float4*)(Lr + 120); b1d = *(const float4*)(Lr + 124);
  __builtin_amdgcn_sched_barrier(0);
  sol[16] -= b2a.x * sol[1]; sol[17] -= b2a.y * sol[1]; sol[18] -= b2a.z * sol[1]; sol[19] -= b2a.w * sol[1]; sol[20] -= b2b.x * sol[1]; sol[21] -= b2b.y * sol[1]; sol[22] -= b2b.z * sol[1]; sol[23] -= b2b.w * sol[1]; sol[24] -= b2c.x * sol[1]; sol[25] -= b2c.y * sol[1]; sol[26] -= b2c.z * sol[1]; sol[27] -= b2c.w * sol[1]; sol[28] -= b2d.x * sol[1]; sol[29] -= b2d.y * sol[1]; sol[30] -= b2d.z * sol[1]; sol[31] -= b2d.w * sol[1];
  __builtin_amdgcn_sched_barrier(0);
  b2a = *(const float4*)(Lr + 128); b2b = *(const float4*)(Lr + 132); b2c = *(const float4*)(Lr + 136); b2d = *(const float4*)(Lr + 140);
  __builtin_amdgcn_sched_barrier(0);
  sol[32] -= b0a.x * sol[1]; sol[33] -= b0a.y * sol[1]; sol[34] -= b0a.z * sol[1]; sol[35] -= b0a.w * sol[1]; sol[36] -= b0b.x * sol[1]; sol[37] -= b0b.y * sol[1]; sol[38] -= b0b.z * sol[1]; sol[39] -= b0b.w * sol[1]; sol[40] -= b0c.x * sol[1]; sol[41] -= b0c.y * sol[1]; sol[42] -= b0c.z * sol[1]; sol[43] -= b0c.w * sol[1]; sol[44] -= b0d.x * sol[1]; sol[45] -= b0d.y * sol[1]; sol[46] -= b0d.z * sol[1]; sol[47] -= b0d.w * sol[1];
  __builtin_amdgcn_sched_barrier(0);
  b0a = *(const float4*)(Lr + 144); b0b = *(const float4*)(Lr + 148); b0c = *(const float4*)(Lr + 152); b0d = *(const float4*)(Lr + 156);
  __builtin_amdgcn_sched_barrier(0);
  sol[48] -= b1a.x * sol[1]; sol[49] -= b1a.y * sol[1]; sol[50] -= b1a.z * sol[1]; sol[51] -= b1a.w * sol[1]; sol[52] -= b1b.x * sol[1]; sol[53] -= b1b.y * sol[1]; sol[54] -= b1b.z * sol[1]; sol[55] -= b1b.w * sol[1]; sol[56] -= b1c.x * sol[1]; sol[57] -= b1c.y * sol[1]; sol[58] -= b1c.z * sol[1]; sol[59] -= b1c.w * sol[1]; sol[60] -= b1d.x * sol[1]; sol[61] -= b1d.y * sol[1]; sol[62] -= b1d.z * sol[1]; sol[63] -= b1d.w * sol[1];
  __builtin_amdgcn_sched_barrier(0);
  b1a = *(const float4*)(Lr + 160); b1b = *(const float4*)(Lr + 164); b1c = *(const float4*)(Lr + 168); b1d = *(const float4*)(Lr + 172);
  __builtin_amdgcn_sched_barrier(0);
  sol[3] -= b2a.w * sol[2]; sol[4] -= b2b.x * sol[2]; sol[5] -= b2b.y * sol[2]; sol[6] -= b2b.z * sol[2]; sol[7] -= b2b.w * sol[2]; sol[8] -= b2c.x * sol[2]; sol[9] -= b2c.y * sol[2]; sol[10] -= b2c.z * sol[2]; sol[11] -= b2c.w * sol[2]; sol[12] -= b2d.x * sol[2]; sol[13] -= b2d.y * sol[2]; sol[14] -= b2d.z * sol[2]; sol[15] -= b2d.w * sol[2];
  __builtin_amdgcn_sched_barrier(0);
  b2a = *(const float4*)(Lr + 176); b2b = *(const float4*)(Lr + 180); b2c = *(const float4*)(Lr + 184); b2d = *(const float4*)(Lr + 188);
  __builtin_amdgcn_sched_barrier(0);
  sol[16] -= b0a.x * sol[2]; sol[17] -= b0a.y * sol[2]; sol[18] -= b0a.z * sol[2]; sol[19] -= b0a.w * sol[2]; sol[20] -= b0b.x * sol[2]; sol[21] -= b0b.y * sol[2]; sol[22] -= b0b.z * sol[2]; sol[23] -= b0b.w * sol[2]; sol[24] -= b0c.x * sol[2]; sol[25] -= b0c.y * sol[2]; sol[26] -= b0c.z * sol[2]; sol[27] -= b0c.w * sol[2]; sol[28] -= b0d.x * sol[2]; sol[29] -= b0d.y * sol[2]; sol[30] -= b0d.z * sol[2]; sol[31] -= b0d.w * sol[2];
  __builtin_amdgcn_sched_barrier(0);
  b0a = *(const float4*)(Lr + 192); b0b = *(const float4*)(Lr + 196); b0c = *(const float4*)(Lr + 200); b0d = *(const float4*)(Lr + 204);
  __builtin_amdgcn_sched_barrier(0);
  sol[32] -= b1a.x * sol[2]; sol[33] -= b1a.y * sol[2]; sol[34] -= b1a.z * sol[2]; sol[35] -= b1a.w * sol[2]; sol[36] -= b1b.x * sol[2]; sol[37] -= b1b.y * sol[2]; sol[38] -= b1b.z * sol[2]; sol[39] -= b1b.w * sol[2]; sol[40] -= b1c.x * sol[2]; sol[41] -= b1c.y * sol[2]; sol[42] -= b1c.z * sol[2]; sol[43] -= b1c.w * sol[2]; sol[44] -= b1d.x * sol[2]; sol[45] -= b1d.y * sol[2]; sol[46] -= b1d.z * sol[2]; sol[47] -= b1d.w * sol[2];
  __builtin_amdgcn_sched_barrier(0);
  b1a = *(const float4*)(Lr + 208); b1b = *(const float4*)(Lr + 212); b1c = *(const float4*)(Lr + 216); b1d = *(const float4*)(Lr + 220);
  __builtin_amdgcn_sched_barrier(0);
  sol[48] -= b2a.x * sol[2]; sol[49] -= b2a.y * sol[2]; sol[50] -= b2a.z * sol[2]; sol[51] -= b2a.w * sol[2]; sol[52] -= b2b.x * sol[2]; sol[53] -= b2b.y * sol[2]; sol[54] -= b2b.z * sol[2]; sol[55] -= b2b.w * sol[2]; sol[56] -= b2c.x * sol[2]; sol[57] -= b2c.y * sol[2]; sol[58] -= b2c.z * sol[2]; sol[59] -= b2c.w * sol[2]; sol[60] -= b2d.x * sol[2]; sol[61] -= b2d.y * sol[2]; sol[62] -= b2d.z * sol[2]; sol[63] -= b2d.w * sol[2];
  __builtin_amdgcn_sched_barrier(0);
  b2a = *(const float4*)(Lr + 224); b2b = *(const float4*)(Lr + 228); b2c = *(const float4*)(Lr + 232); b2d = *(const float4*)(Lr + 236);
  __builtin_amdgcn_sched_barrier(0);
  sol[4] -= b0b.x * sol[3]; sol[5] -= b0b.y * sol[3]; sol[6] -= b0b.z * sol[3]; sol[7] -= b0b.w * sol[3]; sol[8] -= b0c.x * sol[3]; sol[9] -= b0c.y * sol[3]; sol[10] -= b0c.z * sol[3]; sol[11] -= b0c.w * sol[3]; sol[12] -= b0d.x * sol[3]; sol[13] -= b0d.y * sol[3]; sol[14] -= b0d.z * sol[3]; sol[15] -= b0d.w * sol[3];
  __builtin_amdgcn_sched_barrier(0);
  b0a = *(const float4*)(Lr + 240); b0b = *(const float4*)(Lr + 244); b0c = *(const float4*)(Lr + 248); b0d = *(const float4*)(Lr + 252);
  __builtin_amdgcn_sched_barrier(0);
  sol[16] -= b1a.x * sol[3]; sol[17] -= b1a.y * sol[3]; sol[18] -= b1a.z * sol[3]; sol[19] -= b1a.w * sol[3]; sol[20] -= b1b.x * sol[3]; sol[21] -= b1b.y * sol[3]; sol[22] -= b1b.z * sol[3]; sol[23] -= b1b.w * sol[3]; sol[24] -= b1c.x * sol[3]; sol[25] -= b1c.y * sol[3]; sol[26] -= b1c.z * sol[3]; sol[27] -= b1c.w * sol[3]; sol[28] -= b1d.x * sol[3]; sol[29] -= b1d.y * sol[3]; sol[30] -= b1d.z * sol[3]; sol[31] -= b1d.w * sol[3];
  __builtin_amdgcn_sched_barrier(0);
  b1a = *(const float4*)(Lr + 256); b1b = *(const float4*)(Lr + 260); b1c = *(const float4*)(Lr + 264); b1d = *(const float4*)(Lr + 268);
  __builtin_amdgcn_sched_barrier(0);
  sol[32] -= b2a.x * sol[3]; sol[33] -= b2a.y * sol[3]; sol[34] -= b2a.z * sol[3]; sol[35] -= b2a.w * sol[3]; sol[36] -= b2b.x * sol[3]; sol[37] -= b2b.y * sol[3]; sol[38] -= b2b.z * sol[3]; sol[39] -= b2b.w * sol[3]; sol[40] -= b2c.x * sol[3]; sol[41] -= b2c.y * sol[3]; sol[42] -= b2c.z * sol[3]; sol[43] -= b2c.w * sol[3]; sol[44] -= b2d.x * sol[3]; sol[45] -= b2d.y * sol[3]; sol[46] -= b2d.z * sol[3]; sol[47] -= b2d.w * sol[3];
  __builtin_amdgcn_sched_barrier(0);
  b2a = *(const float4*)(Lr + 272); b2b = *(const float4*)(Lr + 276); b2c = *(const float4*)(Lr + 280); b2d = *(const float4*)(Lr + 284);
  __builtin_amdgcn_sched_barrier(0);
  sol[48] -= b0a.x * sol[3]; sol[49] -= b0a.y * sol[3]; sol[50] -= b0a.z * sol[3]; sol[51] -= b0a.w * sol[3]; sol[52] -= b0b.x * sol[3]; sol[53] -= b0b.y * sol[3]; sol[54] -= b0b.z * sol[3]; sol[55] -= b0b.w * sol[3]; sol[56] -= b0c.x * sol[3]; sol[57] -= b0c.y * sol[3]; sol[58] -= b0c.z * sol[3]; sol[59] -= b0c.w * sol[3]; sol[60] -= b0d.x * sol[3]; sol[61] -= b0d.y * sol[3]; sol[62] -= b0d.z * sol[3]; sol[63] -= b0d.w * sol[3];
  __builtin_amdgcn_sched_barrier(0);
  b0a = *(const float4*)(Lr + 288); b0b = *(const float4*)(Lr + 292); b0c = *(const float4*)(Lr + 296); b0d = *(const float4*)(Lr + 300);
  __builtin_amdgcn_sched_barrier(0);
  sol[5] -= b1b.y * sol[4]; sol[6] -= b1b.z * sol[4]; sol[7] -= b1b.w * sol[4]; sol[8] -= b1c.x * sol[4]; sol[9] -= b1c.y * sol[4]; sol[10] -= b1c.z * sol[4]; sol[11] -= b1c.w * sol[4]; sol[12] -= b1d.x * sol[4]; sol[13] -= b1d.y * sol[4]; sol[14] -= b1d.z * sol[4]; sol[15] -= b1d.w * sol[4];
  __builtin_amdgcn_sched_barrier(0);
  b1a = *(const float4*)(Lr + 304); b1b = *(const float4*)(Lr + 308); b1c = *(const float4*)(Lr + 312); b1d = *(const float4*)(Lr + 316);
  __builtin_amdgcn_sched_barrier(0);
  sol[16] -= b2a.x * sol[4]; sol[17] -= b2a.y * sol[4]; sol[18] -= b2a.z * sol[4]; sol[19] -= b2a.w * sol[4]; sol[20] -= b2b.x * sol[4]; sol[21] -= b2b.y * sol[4]; sol[22] -= b2b.z * sol[4]; sol[23] -= b2b.w * sol[4]; sol[24] -= b2c.x * sol[4]; sol[25] -= b2c.y * sol[4]; sol[26] -= b2c.z * sol[4]; sol[27] -= b2c.w * sol[4]; sol[28] -= b2d.x * sol[4]; sol[29] -= b2d.y * sol[4]; sol[30] -= b2d.z * sol[4]; sol[31] -= b2d.w * sol[4];
  __builtin_amdgcn_sched_barrier(0);
  b2a = *(const float4*)(Lr + 320); b2b = *(const float4*)(Lr + 324); b2c = *(const float4*)(Lr + 328); b2d = *(const float4*)(Lr + 332);
  __builtin_amdgcn_sched_barrier(0);
  sol[32] -= b0a.x * sol[4]; sol[33] -= b0a.y * sol[4]; sol[34] -= b0a.z * sol[4]; sol[35] -= b0a.w * sol[4]; sol[36] -= b0b.x * sol[4]; sol[37] -= b0b.y * sol[4]; sol[38] -= b0b.z * sol[4]; sol[39] -= b0b.w * sol[4]; sol[40] -= b0c.x * sol[4]; sol[41] -= b0c.y * sol[4]; sol[42] -= b0c.z * sol[4]; sol[43] -= b0c.w * sol[4]; sol[44] -= b0d.x * sol[4]; sol[45] -= b0d.y * sol[4]; sol[46] -= b0d.z * sol[4]; sol[47] -= b0d.w * sol[4];
  __builtin_amdgcn_sched_barrier(0);
  b0a = *(const float4*)(Lr + 336); b0b = *(const float4*)(Lr + 340); b0c = *(const float4*)(Lr + 344); b0d = *(const float4*)(Lr + 348);
  __builtin_amdgcn_sched_barrier(0);
  sol[48] -= b1a.x * sol[4]; sol[49] -= b1a.y * sol[4]; sol[50] -= b1a.z * sol[4]; sol[51] -= b1a.w * sol[4]; sol[52] -= b1b.x * sol[4]; sol[53] -= b1b.y * sol[4]; sol[54] -= b1b.z * sol[4]; sol[55] -= b1b.w * sol[4]; sol[56] -= b1c.x * sol[4]; sol[57] -= b1c.y * sol[4]; sol[58] -= b1c.z * sol[4]; sol[59] -= b1c.w * sol[4]; sol[60] -= b1d.x * sol[4]; sol[61] -= b1d.y * sol[4]; sol[62] -= b1d.z * sol[4]; sol[63] -= b1d.w * sol[4];
  __builtin_amdgcn_sched_barrier(0);
  b1a = *(const float4*)(Lr + 352); b1b = *(const float4*)(Lr + 356); b1c = *(const float4*)(Lr + 360); b1d = *(const float4*)(Lr + 364);
  __builtin_amdgcn_sched_barrier(0);
  sol[6] -= b2b.z * sol[5]; sol[7] -= b2b.w * sol[5]; sol[8] -= b2c.x * sol[5]; sol[9] -= b2c.y * sol[5]; sol[10] -= b2c.z * sol[5]; sol[11] -= b2c.w * sol[5]; sol[12] -= b2d.x * sol[5]; sol[13] -= b2d.y * sol[5]; sol[14] -= b2d.z * sol[5]; sol[15] -= b2d.w * sol[5];
  __builtin_amdgcn_sched_barrier(0);
  b2a = *(const float4*)(Lr + 368); b2b = *(const float4*)(Lr + 372); b2c = *(const float4*)(Lr + 376); b2d = *(const float4*)(Lr + 380);
  __builtin_amdgcn_sched_barrier(0);
  sol[16] -= b0a.x * sol[5]; sol[17] -= b0a.y * sol[5]; sol[18] -= b0a.z * sol[5]; sol[19] -= b0a.w * sol[5]; sol[20] -= b0b.x * sol[5]; sol[21] -= b0b.y * sol[5]; sol[22] -= b0b.z * sol[5]; sol[23] -= b0b.w * sol[5]; sol[24] -= b0c.x * sol[5]; sol[25] -= b0c.y * sol[5]; sol[26] -= b0c.z * sol[5]; sol[27] -= b0c.w * sol[5]; sol[28] -= b0d.x * sol[5]; sol[29] -= b0d.y * sol[5]; sol[30] -= b0d.z * sol[5]; sol[31] -= b0d.w * sol[5];
  __builtin_amdgcn_sched_barrier(0);
  b0a = *(const float4*)(Lr + 384); b0b = *(const float4*)(Lr + 388); b0c = *(const float4*)(Lr + 392); b0d = *(const float4*)(Lr + 396);
  __builtin_amdgcn_sched_barrier(0);
  sol[32] -= b1a.x * sol[5]; sol[33] -= b1a.y * sol[5]; sol[34] -= b1a.z * sol[5]; sol[35] -= b1a.w * sol[5]; sol[36] -= b1b.x * sol[5]; sol[37] -= b1b.y * sol[5]; sol[38] -= b1b.z * sol[5]; sol[39] -= b1b.w * sol[5]; sol[40] -= b1c.x * sol[5]; sol[41] -= b1c.y * sol[5]; sol[42] -= b1c.z * sol[5]; sol[43] -= b1c.w * sol[5]; sol[44] -= b1d.x * sol[5]; sol[45] -= b1d.y * sol[5]; sol[46] -= b1d.z * sol[5]; sol[47] -= b1d.w * sol[5];
  __builtin_amdgcn_sched_barrier(0);
  b1a = *(const float4*)(Lr + 400); b1b = *(const float4*)(Lr + 404); b1c = *(const float4*)(Lr + 408); b1d = *(const float4*)(Lr + 412);
  __builtin_amdgcn_sched_barrier(0);
  sol[48] -= b2a.x * sol[5]; sol[49] -= b2a.y * sol[5]; sol[50] -= b2a.z * sol[5]; sol[51] -= b2a.w * sol[5]; sol[52] -= b2b.x * sol[5]; sol[53] -= b2b.y * sol[5]; sol[54] -= b2b.z * sol[5]; sol[55] -= b2b.w * sol[5]; sol[56] -= b2c.x * sol[5]; sol[57] -= b2c.y * sol[5]; sol[58] -= b2c.z * sol[5]; sol[59] -= b2c.w * sol[5]; sol[60] -= b2d.x * sol[5]; sol[61] -= b2d.y * sol[5]; sol[62] -= b2d.z * sol[5]; sol[63] -= b2d.w * sol[5];
  __builtin_amdgcn_sched_barrier(0);
  b2a = *(const float4*)(Lr + 416); b2b = *(const float4*)(Lr + 420); b2c = *(const float4*)(Lr + 424); b2d = *(const float4*)(Lr + 428);
  __builtin_amdgcn_sched_barrier(0);
  sol[7] -= b0b.w * sol[6]; sol[8] -= b0c.x * sol[6]; sol[9] -= b0c.y * sol[6]; sol[10] -= b0c.z * sol[6]; sol[11] -= b0c.w * sol[6]; sol[12] -= b0d.x * sol[6]; sol[13] -= b0d.y * sol[6]; sol[14] -= b0d.z * sol[6]; sol[15] -= b0d.w * sol[6];
  __builtin_amdgcn_sched_barrier(0);
  b0a = *(const float4*)(Lr + 432); b0b = *(const float4*)(Lr + 436); b0c = *(const float4*)(Lr + 440); b0d = *(const float4*)(Lr + 444);
  __builtin_amdgcn_sched_barrier(0);
  sol[16] -= b1a.x * sol[6]; sol[17] -= b1a.y * sol[6]; sol[18] -= b1a.z * sol[6]; sol[19] -= b1a.w * sol[6]; sol[20] -= b1b.x * sol[6]; sol[21] -= b1b.y * sol[6]; sol[22] -= b1b.z * sol[6]; sol[23] -= b1b.w * sol[6]; sol[24] -= b1c.x * sol[6]; sol[25] -= b1c.y * sol[6]; sol[26] -= b1c.z * sol[6]; sol[27] -= b1c.w * sol[6]; sol[28] -= b1d.x * sol[6]; sol[29] -= b1d.y * sol[6]; sol[30] -= b1d.z * sol[6]; sol[31] -= b1d.w * sol[6];
  __builtin_amdgcn_sched_barrier(0);
  b1a = *(const float4*)(Lr + 448); b1b = *(const float4*)(Lr + 452); b1c = *(const float4*)(Lr + 456); b1d = *(const float4*)(Lr + 460);
  __builtin_amdgcn_sched_barrier(0);
  sol[32] -= b2a.x * sol[6]; sol[33] -= b2a.y * sol[6]; sol[34] -= b2a.z * sol[6]; sol[35] -= b2a.w * sol[6]; sol[36] -= b2b.x * sol[6]; sol[37] -= b2b.y * sol[6]; sol[38] -= b2b.z * sol[6]; sol[39] -= b2b.w * sol[6]; sol[40] -= b2c.x * sol[6]; sol[41] -= b2c.y * sol[6]; sol[42] -= b2c.z * sol[6]; sol[43] -= b2c.w * sol[6]; sol[44] -= b2d.x * sol[6]; sol[45] -= b2d.y * sol[6]; sol[46] -= b2d.z * sol[6]; sol[47] -= b2d.w * sol[6];
  __builtin_amdgcn_sched_barrier(0);
  b2a = *(const float4*)(Lr + 464); b2b = *(const float4*)(Lr + 468); b2c = *(const float4*)(Lr + 472); b2d = *(const float4*)(Lr + 476);
  __builtin_amdgcn_sched_barrier(0);
  sol[48] -= b0a.x * sol[6]; sol[49] -= b0a.y * sol[6]; sol[50] -= b0a.z * sol[6]; sol[51] -= b0a.w * sol[6]; sol[52] -= b0b.x * sol[6]; sol[53] -= b0b.y * sol[6]; sol[54] -= b0b.z * sol[6]; sol[55] -= b0b.w * sol[6]; sol[56] -= b0c.x * sol[6]; sol[57] -= b0c.y * sol[6]; sol[58] -= b0c.z * sol[6]; sol[59] -= b0c.w * sol[6]; sol[60] -= b0d.x * sol[6]; sol[61] -= b0d.y * sol[6]; sol[62] -= b0d.z * sol[6]; sol[63] -= b0d.w * sol[6];
  __builtin_amdgcn_sched_barrier(0);
  b0a = *(const float4*)(Lr + 480); b0b = *(const float4*)(Lr + 484); b0c = *(const float4*)(Lr + 488); b0d = *(const float4*)(Lr + 492);
  __builtin_amdgcn_sched_barrier(0);
  sol[8] -= b1c.x * sol[7]; sol[9] -= b1c.y * sol[7]; sol[10] -= b1c.z * sol[7]; sol[11] -= b1c.w * sol[7]; sol[12] -= b1d.x * sol[7]; sol[13] -= b1d.y * sol[7]; sol[14] -= b1d.z * sol[7]; sol[15] -= b1d.w * sol[7];
  __builtin_amdgcn_sched_barrier(0);
  b1a = *(const float4*)(Lr + 496); b1b = *(const float4*)(Lr + 500); b1c = *(const float4*)(Lr + 504); b1d = *(const float4*)(Lr + 508);
  __builtin_amdgcn_sched_barrier(0);
  sol[16] -= b2a.x * sol[7]; sol[17] -= b2a.y * sol[7]; sol[18] -= b2a.z * sol[7]; sol[19] -= b2a.w * sol[7]; sol[20] -= b2b.x * sol[7]; sol[21] -= b2b.y * sol[7]; sol[22] -= b2b.z * sol[7]; sol[23] -= b2b.w * sol[7]; sol[24] -= b2c.x * sol[7]; sol[25] -= b2c.y * sol[7]; sol[26] -= b2c.z * sol[7]; sol[27] -= b2c.w * sol[7]; sol[28] -= b2d.x * sol[7]; sol[29] -= b2d.y * sol[7]; sol[30] -= b2d.z * sol[7]; sol[31] -= b2d.w * sol[7];
  __builtin_amdgcn_sched_barrier(0);
  b2a = *(const float4*)(Lr + 512); b2b = *(const float4*)(Lr + 516); b2c = *(const float4*)(Lr + 520); b2d = *(const float4*)(Lr + 524);
  __builtin_amdgcn_sched_barrier(0);
  sol[32] -= b0a.x * sol[7]; sol[33] -= b0a.y * sol[7]; sol[34] -= b0a.z * sol[7]; sol[35] -= b0a.w * sol[7]; sol[36] -= b0b.x * sol[7]; sol[37] -= b0b.y * sol[7]; sol[38] -= b0b.z * sol[7]; sol[39] -= b0b.w * sol[7]; sol[40] -= b0c.x * sol[7]; sol[41] -= b0c.y * sol[7]; sol[42] -= b0c.z * sol[7]; sol[43] -= b0c.w * sol[7]; sol[44] -= b0d.x * sol[7]; sol[45] -= b0d.y * sol[7]; sol[46] -= b0d.z * sol[7]; sol[47] -= b0d.w * sol[7];
  __builtin_amdgcn_sched_barrier(0);
  b0a = *(const float4*)(Lr + 528); b0b = *(const float4*)(Lr + 532); b0c = *(const float4*)(Lr + 536); b0d = *(const float4*)(Lr + 540);
  __builtin_amdgcn_sched_barrier(0);
  sol[48] -= b1a.x * sol[7]; sol[49] -= b1a.y * sol[7]; sol[50] -= b1a.z * sol[7]; sol[51] -= b1a.w * sol[7]; sol[52] -= b1b.x * sol[7]; sol[53] -= b1b.y * sol[7]; sol[54] -= b1b.z * sol[7]; sol[55] -= b1b.w * sol[7]; sol[56] -= b1c.x * sol[7]; sol[57] -= b1c.y * sol[7]; sol[58] -= b1c.z * sol[7]; sol[59] -= b1c.w * sol[7]; sol[60] -= b1d.x * sol[7]; sol[61] -= b1d.y * sol[7]; sol[62] -= b1d.z * sol[7]; sol[63] -= b1d.w * sol[7];
  __builtin_amdgcn_sched_barrier(0);
  b1a = *(const float4*)(Lr + 544); b1b = *(const float4*)(Lr + 548); b1c = *(const float4*)(Lr + 552); b1d = *(const float4*)(Lr + 556);
  __builtin_amdgcn_sched_barrier(0);
  sol[9] -= b2c.y * sol[8]; sol[10] -= b2c.z * sol[8]; sol[11] -= b2c.w * sol[8]; sol[12] -= b2d.x * sol[8]; sol[13] -= b2d.y * sol[8]; sol[14] -= b2d.z * sol[8]; sol[15] -= b2d.w * sol[8];
  __builtin_amdgcn_sched_barrier(0);
  b2a = *(const float4*)(Lr + 560); b2b = *(const float4*)(Lr + 564); b2c = *(const float4*)(Lr + 568); b2d = *(const float4*)(Lr + 572);
  __builtin_amdgcn_sched_barrier(0);
  sol[16] -= b0a.x * sol[8]; sol[17] -= b0a.y * sol[8]; sol[18] -= b0a.z * sol[8]; sol[19] -= b0a.w * sol[8]; sol[20] -= b0b.x * sol[8]; sol[21] -= b0b.y * sol[8]; sol[22] -= b0b.z * sol[8]; sol[23] -= b0b.w * sol[8]; sol[24] -= b0c.x * sol[8]; sol[25] -= b0c.y * sol[8]; sol[26] -= b0c.z * sol[8]; sol[27] -= b0c.w * sol[8]; sol[28] -= b0d.x * sol[8]; sol[29] -= b0d.y * sol[8]; sol[30] -= b0d.z * sol[8]; sol[31] -= b0d.w * sol[8];
  __builtin_amdgcn_sched_barrier(0);
  b0a = *(const float4*)(Lr + 576); b0b = *(const float4*)(Lr + 580); b0c = *(const float4*)(Lr + 584); b0d = *(const float4*)(Lr + 588);
  __builtin_amdgcn_sched_barrier(0);
  sol[32] -= b1a.x * sol[8]; sol[33] -= b1a.y * sol[8]; sol[34] -= b1a.z * sol[8]; sol[35] -= b1a.w * sol[8]; sol[36] -= b1b.x * sol[8]; sol[37] -= b1b.y * sol[8]; sol[38] -= b1b.z * sol[8]; sol[39] -= b1b.w * sol[8]; sol[40] -= b1c.x * sol[8]; sol[41] -= b1c.y * sol[8]; sol[42] -= b1c.z * sol[8]; sol[43] -= b1c.w * sol[8]; sol[44] -= b1d.x * sol[8]; sol[45] -= b1d.y * sol[8]; sol[46] -= b1d.z * sol[8]; sol[47] -= b1d.w * sol[8];
  __builtin_amdgcn_sched_barrier(0);
  b1a = *(const float4*)(Lr + 592); b1b = *(const float4*)(Lr + 596); b1c = *(const float4*)(Lr + 600); b1d = *(const float4*)(Lr + 604);
  __builtin_amdgcn_sched_barrier(0);
  sol[48] -= b2a.x * sol[8]; sol[49] -= b2a.y * sol[8]; sol[50] -= b2a.z * sol[8]; sol[51] -= b2a.w * sol[8]; sol[52] -= b2b.x * sol[8]; sol[53] -= b2b.y * sol[8]; sol[54] -= b2b.z * sol[8]; sol[55] -= b2b.w * sol[8]; sol[56] -= b2c.x * sol[8]; sol[57] -= b2c.y * sol[8]; sol[58] -= b2c.z * sol[8]; sol[59] -= b2c.w * sol[8]; sol[60] -= b2d.x * sol[8]; sol[61] -= b2d.y * sol[8]; sol[62] -= b2d.z * sol[8]; sol[63] -= b2d.w * sol[8];
  __builtin_amdgcn_sched_barrier(0);
  b2a = *(const float4*)(Lr + 608); b2b = *(const float4*)(Lr + 612); b2c = *(const float4*)(Lr + 616); b2d = *(const float4*)(Lr + 620);
  __builtin_amdgcn_sched_barrier(0);
  sol[10] -= b0c.z * sol[9]; sol[11] -= b0c.w * sol[9]; sol[12] -= b0d.x * sol[9]; sol[13] -= b0d.y * sol[9]; sol[14] -= b0d.z * sol[9]; sol[15] -= b0d.w * sol[9];
  __builtin_amdgcn_sched_barrier(0);
  b0a = *(const float4*)(Lr + 624); b0b = *(const float4*)(Lr + 628); b0c = *(const float4*)(Lr + 632); b0d = *(const float4*)(Lr + 636);
  __builtin_amdgcn_sched_barrier(0);
  sol[16] -= b1a.x * sol[9]; sol[17] -= b1a.y * sol[9]; sol[18] -= b1a.z * sol[9]; sol[19] -= b1a.w * sol[9]; sol[20] -= b1b.x * sol[9]; sol[21] -= b1b.y * sol[9]; sol[22] -= b1b.z * sol[9]; sol[23] -= b1b.w * sol[9]; sol[24] -= b1c.x * sol[9]; sol[25] -= b1c.y * sol[9]; sol[26] -= b1c.z * sol[9]; sol[27] -= b1c.w * sol[9]; sol[28] -= b1d.x * sol[9]; sol[29] -= b1d.y * sol[9]; sol[30] -= b1d.z * sol[9]; sol[31] -= b1d.w * sol[9];
  __builtin_amdgcn_sched_barrier(0);
  b1a = *(const float4*)(Lr + 640); b1b = *(const float4*)(Lr + 644); b1c = *(const float4*)(Lr + 648); b1d = *(const float4*)(Lr + 652);
  __builtin_amdgcn_sched_barrier(0);
  sol[32] -= b2a.x * sol[9]; sol[33] -= b2a.y * sol[9]; sol[34] -= b2a.z * sol[9]; sol[35] -= b2a.w * sol[9]; sol[36] -= b2b.x * sol[9]; sol[37] -= b2b.y * sol[9]; sol[38] -= b2b.z * sol[9]; sol[39] -= b2b.w * sol[9]; sol[40] -= b2c.x * sol[9]; sol[41] -= b2c.y * sol[9]; sol[42] -= b2c.z * sol[9]; sol[43] -= b2c.w * sol[9]; sol[44] -= b2d.x * sol[9]; sol[45] -= b2d.y * sol[9]; sol[46] -= b2d.z * sol[9]; sol[47] -= b2d.w * sol[9];
  __builtin_amdgcn_sched_barrier(0);
  b2a = *(const float4*)(Lr + 656); b2b = *(const float4*)(Lr + 660); b2c = *(const float4*)(Lr + 664); b2d = *(const float4*)(Lr + 668);
  __builtin_amdgcn_sched_barrier(0);
  sol[48] -= b0a.x * sol[9]; sol[49] -= b0a.y * sol[9]; sol[50] -= b0a.z * sol[9]; sol[51] -= b0a.w * sol[9]; sol[52] -= b0b.x * sol[9]; sol[53] -= b0b.y * sol[9]; sol[54] -= b0b.z * sol[9]; sol[55] -= b0b.w * sol[9]; sol[56] -= b0c.x * sol[9]; sol[57] -= b0c.y * sol[9]; sol[58] -= b0c.z * sol[9]; sol[59] -= b0c.w * sol[9]; sol[60] -= b0d.x * sol[9]; sol[61] -= b0d.y * sol[9]; sol[62] -= b0d.z * sol[9]; sol[63] -= b0d.w * sol[9];
  __builtin_amdgcn_sched_barrier(0);
  b0a = *(const float4*)(Lr + 672); b0b = *(const float4*)(Lr + 676); b0c = *(const float4*)(Lr + 680); b0d = *(const float4*)(Lr + 684);
  __builtin_amdgcn_sched_barrier(0);
  sol[11] -= b1c.w * sol[10]; sol[12] -= b1d.x * sol[10]; sol[13] -= b1d.y * sol[10]; sol[14] -= b1d.z * sol[10]; sol[15] -= b1d.w * sol[10];
  __builtin_amdgcn_sched_barrier(0);
  b1a = *(const float4*)(Lr + 688); b1b = *(const float4*)(Lr + 692); b1c = *(const float4*)(Lr + 696); b1d = *(const float4*)(Lr + 700);
  __builtin_amdgcn_sched_barrier(0);
  sol[16] -= b2a.x * sol[10]; sol[17] -= b2a.y * sol[10]; sol[18] -= b2a.z * sol[10]; sol[19] -= b2a.w * sol[10]; sol[20] -= b2b.x * sol[10]; sol[21] -= b2b.y * sol[10]; sol[22] -= b2b.z * sol[10]; sol[23] -= b2b.w * sol[10]; sol[24] -= b2c.x * sol[10]; sol[25] -= b2c.y * sol[10]; sol[26] -= b2c.z * sol[10]; sol[27] -= b2c.w * sol[10]; sol[28] -= b2d.x * sol[10]; sol[29] -= b2d.y * sol[10]; sol[30] -= b2d.z * sol[10]; sol[31] -= b2d.w * sol[10];
  __builtin_amdgcn_sched_barrier(0);
  b2a = *(const float4*)(Lr + 704); b2b = *(const float4*)(Lr + 708); b2c = *(const float4*)(Lr + 712); b2d = *(const float4*)(Lr + 716);
  __builtin_amdgcn_sched_barrier(0);
  sol[32] -= b0a.x * sol[10]; sol[33] -= b0a.y * sol[10]; sol[34] -= b0a.z * sol[10]; sol[35] -= b0a.w * sol[10]; sol[36] -= b0b.x * sol[10]; sol[37] -= b0b.y * sol[10]; sol[38] -= b0b.z * sol[10]; sol[39] -= b0b.w * sol[10]; sol[40] -= b0c.x * sol[10]; sol[41] -= b0c.y * sol[10]; sol[42] -= b0c.z * sol[10]; sol[43] -= b0c.w * sol[10]; sol[44] -= b0d.x * sol[10]; sol[45] -= b0d.y * sol[10]; sol[46] -= b0d.z * sol[10]; sol[47] -= b0d.w * sol[10];
  __builtin_amdgcn_sched_barrier(0);
  b0a = *(const float4*)(Lr + 720); b0b = *(const float4*)(Lr + 724); b0c = *(const float4*)(Lr + 728); b0d = *(const float4*)(Lr + 732);
  __builtin_amdgcn_sched_barrier(0);
  sol[48] -= b1a.x * sol[10]; sol[49] -= b1a.y * sol[10]; sol[50] -= b1a.z * sol[10]; sol[51] -= b1a.w * sol[10]; sol[52] -= b1b.x * sol[10]; sol[53] -= b1b.y * sol[10]; sol[54] -= b1b.z * sol[10]; sol[55] -= b1b.w * sol[10]; sol[56] -= b1c.x * sol[10]; sol[57] -= b1c.y * sol[10]; sol[58] -= b1c.z * sol[10]; sol[59] -= b1c.w * sol[10]; sol[60] -= b1d.x * sol[10]; sol[61] -= b1d.y * sol[10]; sol[62] -= b1d.z * sol[10]; sol[63] -= b1d.w * sol[10];
  __builtin_amdgcn_sched_barrier(0);
  b1a = *(const float4*)(Lr + 736); b1b = *(const float4*)(Lr + 740); b1c = *(const float4*)(Lr + 744); b1d = *(const float4*)(Lr + 748);
  __builtin_amdgcn_sched_barrier(0);
  sol[12] -= b2d.x * sol[11]; sol[13] -= b2d.y * sol[11]; sol[14] -= b2d.z * sol[11]; sol[15] -= b2d.w * sol[11];
  __builtin_amdgcn_sched_barrier(0);
  b2a = *(const float4*)(Lr + 752); b2b = *(const float4*)(Lr + 756); b2c = *(const float4*)(Lr + 760); b2d = *(const float4*)(Lr + 764);
  __builtin_amdgcn_sched_barrier(0);
  sol[16] -= b0a.x * sol[11]; sol[17] -= b0a.y * sol[11]; sol[18] -= b0a.z * sol[11]; sol[19] -= b0a.w * sol[11]; sol[20] -= b0b.x * sol[11]; sol[21] -= b0b.y * sol[11]; sol[22] -= b0b.z * sol[11]; sol[23] -= b0b.w * sol[11]; sol[24] -= b0c.x * sol[11]; sol[25] -= b0c.y * sol[11]; sol[26] -= b0c.z * sol[11]; sol[27] -= b0c.w * sol[11]; sol[28] -= b0d.x * sol[11]; sol[29] -= b0d.y * sol[11]; sol[30] -= b0d.z * sol[11]; sol[31] -= b0d.w * sol[11];
  __builtin_amdgcn_sched_barrier(0);
  b0a = *(const float4*)(Lr + 768); b0b = *(const float4*)(Lr + 772); b0c = *(const float4*)(Lr + 776); b0d = *(const float4*)(Lr + 780);
  __builtin_amdgcn_sched_barrier(0);
  sol[32] -= b1a.x * sol[11]; sol[33] -= b1a.y * sol[11]; sol[34] -= b1a.z * sol[11]; sol[35] -= b1a.w * sol[11]; sol[36] -= b1b.x * sol[11]; sol[37] -= b1b.y * sol[11]; sol[38] -= b1b.z * sol[11]; sol[39] -= b1b.w * sol[11]; sol[40] -= b1c.x * sol[11]; sol[41] -= b1c.y * sol[11]; sol[42] -= b1c.z * sol[11]; sol[43] -= b1c.w * sol[11]; sol[44] -= b1d.x * sol[11]; sol[45] -= b1d.y * sol[11]; sol[46] -= b1d.z * sol[11]; sol[47] -= b1d.w * sol[11];
  __builtin_amdgcn_sched_barrier(0);
  b1a = *(const float4*)(Lr + 784); b1b = *(const float4*)(Lr + 788); b1c = *(const float4*)(Lr + 792); b1d = *(const float4*)(Lr + 796);
  __builtin_amdgcn_sched_barrier(0);
  sol[48] -= b2a.x * sol[11]; sol[49] -= b2a.y * sol[11]; sol[50] -= b2a.z * sol[11]; sol[51] -= b2a.w * sol[11]; sol[52] -= b2b.x * sol[11]; sol[53] -= b2b.y * sol[11]; sol[54] -= b2b.z * sol[11]; sol[55] -= b2b.w * sol[11]; sol[56] -= b2c.x * sol[11]; sol[57] -= b2c.y * sol[11]; sol[58] -= b2c.z * sol[11]; sol[59] -= b2c.w * sol[11]; sol[60] -= b2d.x * sol[11]; sol[61] -= b2d.y * sol[11]; sol[62] -= b2d.z * sol[11]; sol[63] -= b2d.w * sol[11];
  __builtin_amdgcn_sched_barrier(0);
  b2a = *(const float4*)(Lr + 800); b2b = *(const float4*)(Lr + 804); b2c = *(const float4*)(Lr + 808); b2d = *(const float4*)(Lr + 812);
  __builtin_amdgcn_sched_barrier(0);
  sol[13] -= b0d.y * sol[12]; sol[14] -= b0d.z * sol[12]; sol[15] -= b0d.w * sol[12];
  __builtin_amdgcn_sched_barrier(0);
  b0a = *(const float4*)(Lr + 816); b0b = *(const float4*)(Lr + 820); b0c = *(const float4*)(Lr + 824); b0d = *(const float4*)(Lr + 828);
  __builtin_amdgcn_sched_barrier(0);
  sol[16] -= b1a.x * sol[12]; sol[17] -= b1a.y * sol[12]; sol[18] -= b1a.z * sol[12]; sol[19] -= b1a.w * sol[12]; sol[20] -= b1b.x * sol[12]; sol[21] -= b1b.y * sol[12]; sol[22] -= b1b.z * sol[12]; sol[23] -= b1b.w * sol[12]; sol[24] -= b1c.x * sol[12]; sol[25] -= b1c.y * sol[12]; sol[26] -= b1c.z * sol[12]; sol[27] -= b1c.w * sol[12]; sol[28] -= b1d.x * sol[12]; sol[29] -= b1d.y * sol[12]; sol[30] -= b1d.z * sol[12]; sol[31] -= b1d.w * sol[12];
  __builtin_amdgcn_sched_barrier(0);
  b1a = *(const float4*)(Lr + 832); b1b = *(const float4*)(Lr + 836); b1c = *(const float4*)(Lr + 840); b1d = *(const float4*)(Lr + 844);
  __builtin_amdgcn_sched_barrier(0);
  sol[32] -= b2a.x * sol[12]; sol[33] -= b2a.y * sol[12]; sol[34] -= b2a.z * sol[12]; sol[35] -= b2a.w * sol[12]; sol[36] -= b2b.x * sol[12]; sol[37] -= b2b.y * sol[12]; sol[38] -= b2b.z * sol[12]; sol[39] -= b2b.w * sol[12]; sol[40] -= b2c.x * sol[12]; sol[41] -= b2c.y * sol[12]; sol[42] -= b2c.z * sol[12]; sol[43] -= b2c.w * sol[12]; sol[44] -= b2d.x * sol[12]; sol[45] -= b2d.y * sol[12]; sol[46] -= b2d.z * sol[12]; sol[47] -= b2d.w * sol[12];
  __builtin_amdgcn_sched_barrier(0);
  b2a = *(const float4*)(Lr + 848); b2b = *(const float4*)(Lr + 852); b2c = *(const float4*)(Lr + 856); b2d = *(const float4*)(Lr + 860);
  __builtin_amdgcn_sched_barrier(0);
  sol[48] -= b0a.x * sol[12]; sol[49] -= b0a.y * sol[12]; sol[50] -= b0a.z * sol[12]; sol[51] -= b0a.w * sol[12]; sol[52] -= b0b.x * sol[12]; sol[53] -= b0b.y * sol[12]; sol[54] -= b0b.z * sol[12]; sol[55] -= b0b.w * sol[12]; sol[56] -= b0c.x * sol[12]; sol[57] -= b0c.y * sol[12]; sol[58] -= b0c.z * sol[12]; sol[59] -= b0c.w * sol[12]; sol[60] -= b0d.x * sol[12]; sol[61] -= b0d.y * sol[12]; sol[62] -= b0d.z * sol[12]; sol[63] -= b0d.w * sol[12];
  __builtin_amdgcn_sched_barrier(0);
  b0a = *(const float4*)(Lr + 864); b0b = *(const float4*)(Lr + 868); b0c = *(const float4*)(Lr + 872); b0d = *(const float4*)(Lr + 876);
  __builtin_amdgcn_sched_barrier(0);
  sol[14] -= b1d.z * sol[13]; sol[15] -= b1d.w * sol[13];
  __builtin_amdgcn_sched_barrier(0);
  b1a = *(const float4*)(Lr + 880); b1b = *(const float4*)(Lr + 884); b1c = *(const float4*)(Lr + 888); b1d = *(const float4*)(Lr + 892);
  __builtin_amdgcn_sched_barrier(0);
  sol[16] -= b2a.x * sol[13]; sol[17] -= b2a.y * sol[13]; sol[18] -= b2a.z * sol[13]; sol[19] -= b2a.w * sol[13]; sol[20] -= b2b.x * sol[13]; sol[21] -= b2b.y * sol[13]; sol[22] -= b2b.z * sol[13]; sol[23] -= b2b.w * sol[13]; sol[24] -= b2c.x * sol[13]; sol[25] -= b2c.y * sol[13]; sol[26] -= b2c.z * sol[13]; sol[27] -= b2c.w * sol[13]; sol[28] -= b2d.x * sol[13]; sol[29] -= b2d.y * sol[13]; sol[30] -= b2d.z * sol[13]; sol[31] -= b2d.w * sol[13];
  __builtin_amdgcn_sched_barrier(0);
  b2a = *(const float4*)(Lr + 896); b2b = *(const float4*)(Lr + 900); b2c = *(const float4*)(Lr + 904); b2d = *(const float4*)(Lr + 908);
  __builtin_amdgcn_sched_barrier(0);
  sol[32] -= b0a.x * sol[13]; sol[33] -= b0a.y * sol[13]; sol[34] -= b0a.z * sol[13]; sol[35] -= b0a.w * sol[13]; sol[36] -= b0b.x * sol[13]; sol[37] -= b0b.y * sol[13]; sol[38] -= b0b.z * sol[13]; sol[39] -= b0b.w * sol[13]; sol[40] -= b0c.x * sol[13]; sol[41] -= b0c.y * sol[13]; sol[42] -= b0c.z * sol[13]; sol[43] -= b0c.w * sol[13]; sol[44] -= b0d.x * sol[13]; sol[45] -= b0d.y * sol[13]; sol[46] -= b0d.z * sol[13]; sol[47] -= b0d.w * sol[13];
  __builtin_amdgcn_sched_barrier(0);
  b0a = *(const float4*)(Lr + 912); b0b = *(const float4*)(Lr + 916); b0c = *(const float4*)(Lr + 920); b0d = *(const float4*)(Lr + 924);
  __builtin_amdgcn_sched_barrier(0);
  sol[48] -= b1a.x * sol[13]; sol[49] -= b1a.y * sol[13]; sol[50] -= b1a.z * sol[13]; sol[51] -= b1a.w * sol[13]; sol[52] -= b1b.x * sol[13]; sol[53] -= b1b.y * sol[13]; sol[54] -= b1b.z * sol[13]; sol[55] -= b1b.w * sol[13]; sol[56] -= b1c.x * sol[13]; sol[57] -= b1c.y * sol[13]; sol[58] -= b1c.z * sol[13]; sol[59] -= b1c.w * sol[13]; sol[60] -= b1d.x * sol[13]; sol[61] -= b1d.y * sol[13]; sol[62] -= b1d.z * sol[13]; sol[63] -= b1d.w * sol[13];
  __builtin_amdgcn_sched_barrier(0);
  b1a = *(const float4*)(Lr + 928); b1b = *(const float4*)(Lr + 932); b1c = *(const float4*)(Lr + 936); b1d = *(const float4*)(Lr + 940);
  __builtin_amdgcn_sched_barrier(0);
  sol[15] -= b2d.w * sol[14];
  __builtin_amdgcn_sched_barrier(0);
  b2a = *(const float4*)(Lr + 944); b2b = *(const float4*)(Lr + 948); b2c = *(const float4*)(Lr + 952); b2d = *(const float4*)(Lr + 956);
  __builtin_amdgcn_sched_barrier(0);
  sol[16] -= b0a.x * sol[14]; sol[17] -= b0a.y * sol[14]; sol[18] -= b0a.z * sol[14]; sol[19] -= b0a.w * sol[14]; sol[20] -= b0b.x * sol[14]; sol[21] -= b0b.y * sol[14]; sol[22] -= b0b.z * sol[14]; sol[23] -= b0b.w * sol[14]; sol[24] -= b0c.x * sol[14]; sol[25] -= b0c.y * sol[14]; sol[26] -= b0c.z * sol[14]; sol[27] -= b0c.w * sol[14]; sol[28] -= b0d.x * sol[14]; sol[29] -= b0d.y * sol[14]; sol[30] -= b0d.z * sol[14]; sol[31] -= b0d.w * sol[14];
  __builtin_amdgcn_sched_barrier(0);
  b0a = *(const float4*)(Lr + 976); b0b = *(const float4*)(Lr + 980); b0c = *(const float4*)(Lr + 984); b0d = *(const float4*)(Lr + 988);
  __builtin_amdgcn_sched_barrier(0);
  sol[32] -= b1a.x * sol[14]; sol[33] -= b1a.y * sol[14]; sol[34] -= b1a.z * sol[14]; sol[35] -= b1a.w * sol[14]; sol[36] -= b1b.x * sol[14]; sol[37] -= b1b.y * sol[14]; sol[38] -= b1b.z * sol[14]; sol[39] -= b1b.w * sol[14]; sol[40] -= b1c.x * sol[14]; sol[41] -= b1c.y * sol[14]; sol[42] -= b1c.z * sol[14]; sol[43] -= b1c.w * sol[14]; sol[44] -= b1d.x * sol[14]; sol[45] -= b1d.y * sol[14]; sol[46] -= b1d.z * sol[14]; sol[47] -= b1d.w * sol[14];
  __builtin_amdgcn_sched_barrier(0);
  b1a = *(const float4*)(Lr + 992); b1b = *(const float4*)(Lr + 996); b1c = *(const float4*)(Lr + 1000); b1d = *(const float4*)(Lr + 1004);
  __builtin_amdgcn_sched_barrier(0);
  sol[48] -= b2a.x * sol[14]; sol[49] -= b2a.y * sol[14]; sol[50] -= b2a.z * sol[14]; sol[51] -= b2a.w * sol[14]; sol[52] -= b2b.x * sol[14]; sol[53] -= b2b.y * sol[14]; sol[54] -= b2b.z * sol[14]; sol[55] -= b2b.w * sol[14]; sol[56] -= b2c.x * sol[14]; sol[57] -= b2c.y * sol[14]; sol[58] -= b2c.z * sol[14]; sol[59] -= b2c.w * sol[14]; sol[60] -= b2d.x * sol[14]; sol[61] -= b2d.y * sol[14]; sol[62] -= b2d.z * sol[14]; sol[63] -= b2d.w * sol[14];
  __builtin_amdgcn_sched_barrier(0);
  b2a = *(const float4*)(Lr + 1008); b2b = *(const float4*)(Lr + 1012); b2c = *(const float4*)(Lr + 1016); b2d = *(const float4*)(Lr + 1020);
  __builtin_amdgcn_sched_barrier(0);
  sol[16] -= b0a.x * sol[15]; sol[17] -= b0a.y * sol[15]; sol[18] -= b0a.z * sol[15]; sol[19] -= b0a.w * sol[15]; sol[20] -= b0b.x * sol[15]; sol[21] -= b0b.y * sol[15]; sol[22] -= b0b.z * sol[15]; sol[23] -= b0b.w * sol[15]; sol[24] -= b0c.x * sol[15]; sol[25] -= b0c.y * sol[15]; sol[26] -= b0c.z * sol[15]; sol[27] -= b0c.w * sol[15]; sol[28] -= b0d.x * sol[15]; sol[29] -= b0d.y * sol[15]; sol[30] -= b0d.z * sol[15]; sol[31] -= b0d.w * sol[15];
  __builtin_amdgcn_sched_barrier(0);
  b0a = *(const float4*)(Lr + 1040); b0b = *(const float4*)(Lr + 1044); b0c = *(const float4*)(Lr + 1048); b0d = *(const float4*)(Lr + 1052);
  __builtin_amdgcn_sched_barrier(0);
  sol[32] -= b1a.x * sol[15]; sol[33] -= b1a.y * sol[15]; sol[34] -= b1a.z * sol[15]; sol[35] -= b1a.w * sol[15]; sol[36] -= b1b.x * sol[15]; sol[37] -= b1b.y * sol[15]; sol[38] -= b1b.z * sol[15]; sol[39] -= b1b.w * sol[15]; sol[40] -= b1c.x * sol[15]; sol[41] -= b1c.y * sol[15]; sol[42] -= b1c.z * sol[15]; sol[43] -= b1c.w * sol[15]; sol[44] -= b1d.x * sol[15]; sol[45] -= b1d.y * sol[15]; sol[46] -= b1d.z * sol[15]; sol[47] -= b1d.w * sol[15];
  __builtin_amdgcn_sched_barrier(0);
  b1a = *(const float4*)(Lr + 1056); b1b = *(const float4*)(Lr + 1060); b1c = *(const float4*)(Lr + 1064); b1d = *(const float4*)(Lr + 1068);
  __builtin_amdgcn_sched_barrier(0);
  sol[48] -= b2a.x * sol[15]; sol[49] -= b2a.y * sol[15]; sol[50] -= b2a.z * sol[15]; sol[51] -= b2a.w * sol[15]; sol[52] -= b2b.x * sol[15]; sol[53] -= b2b.y * sol[15]; sol[54] -= b2b.z * sol[15]; sol[55] -= b2b.w * sol[15]; sol[56] -= b2c.x * sol[15]; sol[57] -= b2c.y * sol[15]; sol[58] -= b2c.z * sol[15]; sol[59] -= b2c.w * sol[15]; sol[60] -= b2d.x * sol[15]; sol[61] -= b2d.y * sol[15]; sol[62] -= b2d.z * sol[15]; sol[63] -= b2d.w * sol[15];
  __builtin_amdgcn_sched_barrier(0);
  b2a = *(const float4*)(Lr + 1072); b2b = *(const float4*)(Lr + 1076); b2c = *(const float4*)(Lr + 1080); b2d = *(const float4*)(Lr + 1084);
  __builtin_amdgcn_sched_barrier(0);
  sol[17] -= b0a.y * sol[16]; sol[18] -= b0a.z * sol[16]; sol[19] -= b0a.w * sol[16]; sol[20] -= b0b.x * sol[16]; sol[21] -= b0b.y * sol[16]; sol[22] -= b0b.z * sol[16]; sol[23] -= b0b.w * sol[16]; sol[24] -= b0c.x * sol[16]; sol[25] -= b0c.y * sol[16]; sol[26] -= b0c.z * sol[16]; sol[27] -= b0c.w * sol[16]; sol[28] -= b0d.x * sol[16]; sol[29] -= b0d.y * sol[16]; sol[30] -= b0d.z * sol[16]; sol[31] -= b0d.w * sol[16];
  __builtin_amdgcn_sched_barrier(0);
  b0a = *(const float4*)(Lr + 1104); b0b = *(const float4*)(Lr + 1108); b0c = *(const float4*)(Lr + 1112); b0d = *(const float4*)(Lr + 1116);
  __builtin_amdgcn_sched_barrier(0);
  sol[32] -= b1a.x * sol[16]; sol[33] -= b1a.y * sol[16]; sol[34] -= b1a.z * sol[16]; sol[35] -= b1a.w * sol[16]; sol[36] -= b1b.x * sol[16]; sol[37] -= b1b.y * sol[16]; sol[38] -= b1b.z * sol[16]; sol[39] -= b1b.w * sol[16]; sol[40] -= b1c.x * sol[16]; sol[41] -= b1c.y * sol[16]; sol[42] -= b1c.z * sol[16]; sol[43] -= b1c.w * sol[16]; sol[44] -= b1d.x * sol[16]; sol[45] -= b1d.y * sol[16]; sol[46] -= b1d.z * sol[16]; sol[47] -= b1d.w * sol[16];
  __builtin_amdgcn_sched_barrier(0);
  b1a = *(const float4*)(Lr + 1120); b1b = *(const float4*)(Lr + 1124); b1c = *(const float4*)(Lr + 1128); b1d = *(const float4*)(Lr + 1132);
  __builtin_amdgcn_sched_barrier(0);
  sol[48] -= b2a.x * sol[16]; sol[49] -= b2a.y * sol[16]; sol[50] -= b2a.z * sol[16]; sol[51] -= b2a.w * sol[16]; sol[52] -= b2b.x * sol[16]; sol[53] -= b2b.y * sol[16]; sol[54] -= b2b.z * sol[16]; sol[55] -= b2b.w * sol[16]; sol[56] -= b2c.x * sol[16]; sol[57] -= b2c.y * sol[16]; sol[58] -= b2c.z * sol[16]; sol[59] -= b2c.w * sol[16]; sol[60] -= b2d.x * sol[16]; sol[61] -= b2d.y * sol[16]; sol[62] -= b2d.z * sol[16]; sol[63] -= b2d.w * sol[16];
  __builtin_amdgcn_sched_barrier(0);
  b2a = *(const float4*)(Lr + 1136); b2b = *(const float4*)(Lr + 1140); b2c = *(const float4*)(Lr + 1144); b2d = *(const float4*)(Lr + 1148);
  __builtin_amdgcn_sched_barrier(0);
  sol[18] -= b0a.z * sol[17]; sol[19] -= b0a.w * sol[17]; sol[20] -= b0b.x * sol[17]; sol[21] -= b0b.y * sol[17]; sol[22] -= b0b.z * sol[17]; sol[23] -= b0b.w * sol[17]; sol[24] -= b0c.x * sol[17]; sol[25] -= b0c.y * sol[17]; sol[26] -= b0c.z * sol[17]; sol[27] -= b0c.w * sol[17]; sol[28] -= b0d.x * sol[17]; sol[29] -= b0d.y * sol[17]; sol[30] -= b0d.z * sol[17]; sol[31] -= b0d.w * sol[17];
  __builtin_amdgcn_sched_barrier(0);
  b0a = *(const float4*)(Lr + 1168); b0b = *(const float4*)(Lr + 1172); b0c = *(const float4*)(Lr + 1176); b0d = *(const float4*)(Lr + 1180);
  __builtin_amdgcn_sched_barrier(0);
  sol[32] -= b1a.x * sol[17]; sol[33] -= b1a.y * sol[17]; sol[34] -= b1a.z * sol[17]; sol[35] -= b1a.w * sol[17]; sol[36] -= b1b.x * sol[17]; sol[37] -= b1b.y * sol[17]; sol[38] -= b1b.z * sol[17]; sol[39] -= b1b.w * sol[17]; sol[40] -= b1c.x * sol[17]; sol[41] -= b1c.y * sol[17]; sol[42] -= b1c.z * sol[17]; sol[43] -= b1c.w * sol[17]; sol[44] -= b1d.x * sol[17]; sol[45] -= b1d.y * sol[17]; sol[46] -= b1d.z * sol[17]; sol[47] -= b1d.w * sol[17];
  __builtin_amdgcn_sched_barrier(0);
  b1a = *(const float4*)(Lr + 1184); b1b = *(const float4*)(Lr + 1188); b1c = *(const float4*)(Lr + 1192); b1d = *(const float4*)(Lr + 1196);
  __builtin_amdgcn_sched_barrier(0);
  sol[48] -= b2a.x * sol[17]; sol[49] -= b2a.y * sol[17]; sol[50] -= b2a.z * sol[17]; sol[51] -= b2a.w * sol[17]; sol[52] -= b2b.x * sol[17]; sol[53] -= b2b.y * sol[17]; sol[54] -= b2b.z * sol[17]; sol[55] -= b2b.w * sol[17]; sol[56] -= b2c.x * sol[17]; sol[57] -= b2c.y * sol[17]; sol[58] -= b2c.z * sol[17]; sol[59] -= b2c.w * sol[17]; sol[60] -= b2d.x * sol[17]; sol[61] -= b2d.y * sol[17]; sol[62] -= b2d.z * sol[17]; sol[63] -= b2d.w * sol[17];
  __builtin_amdgcn_sched_barrier(0);
  b2a = *(const float4*)(Lr + 1200); b2b = *(const float4*)(Lr + 1204); b2c = *(const float4*)(Lr + 1208); b2d = *(const float4*)(Lr + 1212);
  __builtin_amdgcn_sched_barrier(0);
  sol[19] -= b0a.w * sol[18]; sol[20] -= b0b.x * sol[18]; sol[21] -= b0b.y * sol[18]; sol[22] -= b0b.z * sol[18]; sol[23] -= b0b.w * sol[18]; sol[24] -= b0c.x * sol[18]; sol[25] -= b0c.y * sol[18]; sol[26] -= b0c.z * sol[18]; sol[27] -= b0c.w * sol[18]; sol[28] -= b0d.x * sol[18]; sol[29] -= b0d.y * sol[18]; sol[30] -= b0d.z * sol[18]; sol[31] -= b0d.w * sol[18];
  __builtin_amdgcn_sched_barrier(0);
  b0a = *(const float4*)(Lr + 1232); b0b = *(const float4*)(Lr + 1236); b0c = *(const float4*)(Lr + 1240); b0d = *(const float4*)(Lr + 1244);
  __builtin_amdgcn_sched_barrier(0);
  sol[32] -= b1a.x * sol[18]; sol[33] -= b1a.y * sol[18]; sol[34] -= b1a.z * sol[18]; sol[35] -= b1a.w * sol[18]; sol[36] -= b1b.x * sol[18]; sol[37] -= b1b.y * sol[18]; sol[38] -= b1b.z * sol[18]; sol[39] -= b1b.w * sol[18]; sol[40] -= b1c.x * sol[18]; sol[41] -= b1c.y * sol[18]; sol[42] -= b1c.z * sol[18]; sol[43] -= b1c.w * sol[18]; sol[44] -= b1d.x * sol[18]; sol[45] -= b1d.y * sol[18]; sol[46] -= b1d.z * sol[18]; sol[47] -= b1d.w * sol[18];
  __builtin_amdgcn_sched_barrier(0);
  b1a = *(const float4*)(Lr + 1248); b1b = *(const float4*)(Lr + 1252); b1c = *(const float4*)(Lr + 1256); b1d = *(const float4*)(Lr + 1260);
  __builtin_amdgcn_sched_barrier(0);
  sol[48] -= b2a.x * sol[18]; sol[49] -= b2a.y * sol[18]; sol[50] -= b2a.z * sol[18]; sol[51] -= b2a.w * sol[18]; sol[52] -= b2b.x * sol[18]; sol[53] -= b2b.y * sol[18]; sol[54] -= b2b.z * sol[18]; sol[55] -= b2b.w * sol[18]; sol[56] -= b2c.x * sol[18]; sol[57] -= b2c.y * sol[18]; sol[58] -= b2c.z * sol[18]; sol[59] -= b2c.w * sol[18]; sol[60] -= b2d.x * sol[18]; sol[61] -= b2d.y * sol[18]; sol[62] -= b2d.z * sol[18]; sol[63] -= b2d.w * sol[18];
  __builtin_amdgcn_sched_barrier(0);
  b2a = *(const float4*)(Lr + 1264); b2b = *(const float4*)(Lr + 1268); b2c = *(const float4*)(Lr + 1272); b2d = *(const float4*)(Lr + 1276);
  __builtin_amdgcn_sched_barrier(0);
  sol[20] -= b0b.x * sol[19]; sol[21] -= b0b.y * sol[19]; sol[22] -= b0b.z * sol[19]; sol[23] -= b0b.w * sol[19]; sol[24] -= b0c.x * sol[19]; sol[25] -= b0c.y * sol[19]; sol[26] -= b0c.z * sol[19]; sol[27] -= b0c.w * sol[19]; sol[28] -= b0d.x * sol[19]; sol[29] -= b0d.y * sol[19]; sol[30] -= b0d.z * sol[19]; sol[31] -= b0d.w * sol[19];
  __builtin_amdgcn_sched_barrier(0);
  b0a = *(const float4*)(Lr + 1296); b0b = *(const float4*)(Lr + 1300); b0c = *(const float4*)(Lr + 1304); b0d = *(const float4*)(Lr + 1308);
  __builtin_amdgcn_sched_barrier(0);
  sol[32] -= b1a.x * sol[19]; sol[33] -= b1a.y * sol[19]; sol[34] -= b1a.z * sol[19]; sol[35] -= b1a.w * sol[19]; sol[36] -= b1b.x * sol[19]; sol[37] -= b1b.y * sol[19]; sol[38] -= b1b.z * sol[19]; sol[39] -= b1b.w * sol[19]; sol[40] -= b1c.x * sol[19]; sol[41] -= b1c.y * sol[19]; sol[42] -= b1c.z * sol[19]; sol[43] -= b1c.w * sol[19]; sol[44] -= b1d.x * sol[19]; sol[45] -= b1d.y * sol[19]; sol[46] -= b1d.z * sol[19]; sol[47] -= b1d.w * sol[19];
  __builtin_amdgcn_sched_barrier(0);
  b1a = *(const float4*)(Lr + 1312); b1b = *(const float4*)(Lr + 1316); b1c = *(const float4*)(Lr + 1320); b1d = *(const float4*)(Lr + 1324);
  __builtin_amdgcn_sched_barrier(0);
  sol[48] -= b2a.x * sol[19]; sol[49] -= b2a.y * sol[19]; sol[50] -= b2a.z * sol[19]; sol[51] -= b2a.w * sol[19]; sol[52] -= b2b.x * sol[19]; sol[53] -= b2b.y * sol[19]; sol[54] -= b2b.z * sol[19]; sol[55] -= b2b.w * sol[19]; sol[56] -= b2c.x * sol[19]; sol[57] -= b2c.y * sol[19]; sol[58] -= b2c.z * sol[19]; sol[59] -= b2c.w * sol[19]; sol[60] -= b2d.x * sol[19]; sol[61] -= b2d.y * sol[19]; sol[62] -= b2d.z * sol[19]; sol[63] -= b2d.w * sol[19];
  __builtin_amdgcn_sched_barrier(0);
  b2a = *(const float4*)(Lr + 1328); b2b = *(const float4*)(Lr + 1332); b2c = *(const float4*)(Lr + 1336); b2d = *(const float4*)(Lr + 1340);
  __builtin_amdgcn_sched_barrier(0);
  sol[21] -= b0b.y * sol[20]; sol[22] -= b0b.z * sol[20]; sol[23] -= b0b.w * sol[20]; sol[24] -= b0c.x * sol[20]; sol[25] -= b0c.y * sol[20]; sol[26] -= b0c.z * sol[20]; sol[27] -= b0c.w * sol[20]; sol[28] -= b0d.x * sol[20]; sol[29] -= b0d.y * sol[20]; sol[30] -= b0d.z * sol[20]; sol[31] -= b0d.w * sol[20];
  __builtin_amdgcn_sched_barrier(0);
  b0a = *(const float4*)(Lr + 1360); b0b = *(const float4*)(Lr + 1364); b0c = *(const float4*)(Lr + 1368); b0d = *(const float4*)(Lr + 1372);
  __builtin_amdgcn_sched_barrier(0);
  sol[32] -= b1a.x * sol[20]; sol[33] -= b1a.y * sol[20]; sol[34] -= b1a.z * sol[20]; sol[35] -= b1a.w * sol[20]; sol[36] -= b1b.x * sol[20]; sol[37] -= b1b.y * sol[20]; sol[38] -= b1b.z * sol[20]; sol[39] -= b1b.w * sol[20]; sol[40] -= b1c.x * sol[20]; sol[41] -= b1c.y * sol[20]; sol[42] -= b1c.z * sol[20]; sol[43] -= b1c.w * sol[20]; sol[44] -= b1d.x * sol[20]; sol[45] -= b1d.y * sol[20]; sol[46] -= b1d.z * sol[20]; sol[47] -= b1d.w * sol[20];
  __builtin_amdgcn_sched_barrier(0);
  b1a = *(const float4*)(Lr + 1376); b1b = *(const float4*)(Lr + 1380); b1c = *(const float4*)(Lr + 1384); b1d = *(const float4*)(Lr + 1388);
  __builtin_amdgcn_sched_barrier(0);
  sol[48] -= b2a.x * sol[20]; sol[49] -= b2a.y * sol[20]; sol[50] -= b2a.z * sol[20]; sol[51] -= b2a.w * sol[20]; sol[52] -= b2b.x * sol[20]; sol[53] -= b2b.y * sol[20]; sol[54] -= b2b.z * sol[20]; sol[55] -= b2b.w * sol[20]; sol[56] -= b2c.x * sol[20]; sol[57] -= b2c.y * sol[20]; sol[58] -= b2c.z * sol[20]; sol[59] -= b2c.w * sol[20]; sol[60] -= b2d.x * sol[20]; sol[61] -= b2d.y * sol[20]; sol[62] -= b2d.z * sol[20]; sol[63] -= b2d.w * sol[20];
  __builtin_amdgcn_sched_barrier(0);
  b2a = *(const float4*)(Lr + 1392); b2b = *(const float4*)(Lr + 1396); b2c = *(const float4*)(Lr + 1400); b2d = *(const float4*)(Lr + 1404);
  __builtin_amdgcn_sched_barrier(0);
  sol[22] -= b0b.z * sol[21]; sol[23] -= b0b.w * sol[21]; sol[24] -= b0c.x * sol[21]; sol[25] -= b0c.y * sol[21]; sol[26] -= b0c.z * sol[21]; sol[27] -= b0c.w * sol[21]; sol[28] -= b0d.x * sol[21]; sol[29] -= b0d.y * sol[21]; sol[30] -= b0d.z * sol[21]; sol[31] -= b0d.w * sol[21];
  __builtin_amdgcn_sched_barrier(0);
  b0a = *(const float4*)(Lr + 1424); b0b = *(const float4*)(Lr + 1428); b0c = *(const float4*)(Lr + 1432); b0d = *(const float4*)(Lr + 1436);
  __builtin_amdgcn_sched_barrier(0);
  sol[32] -= b1a.x * sol[21]; sol[33] -= b1a.y * sol[21]; sol[34] -= b1a.z * sol[21]; sol[35] -= b1a.w * sol[21]; sol[36] -= b1b.x * sol[21]; sol[37] -= b1b.y * sol[21]; sol[38] -= b1b.z * sol[21]; sol[39] -= b1b.w * sol[21]; sol[40] -= b1c.x * sol[21]; sol[41] -= b1c.y * sol[21]; sol[42] -= b1c.z * sol[21]; sol[43] -= b1c.w * sol[21]; sol[44] -= b1d.x * sol[21]; sol[45] -= b1d.y * sol[21]; sol[46] -= b1d.z * sol[21]; sol[47] -= b1d.w * sol[21];
  __builtin_amdgcn_sched_barrier(0);
  b1a = *(const float4*)(Lr + 1440); b1b = *(const float4*)(Lr + 1444); b1c = *(const float4*)(Lr + 1448); b1d = *(const float4*)(Lr + 1452);
  __builtin_amdgcn_sched_barrier(0);
  sol[48] -= b2a.x * sol[21]; sol[49] -= b2a.y * sol[21]; sol[50] -= b2a.z * sol[21]; sol[51] -= b2a.w * sol[21]; sol[52] -= b2b.x * sol[21]; sol[53] -= b2b.y * sol[21]; sol[54] -= b2b.z * sol[21]; sol[55] -= b2b.w * sol[21]; sol[56] -= b2c.x * sol[21]; sol[57] -= b2c.y * sol[21]; sol[58] -= b2c.z * sol[21]; sol[59] -= b2c.w * sol[21]; sol[60] -= b2d.x * sol[21]; sol[61] -= b2d.y * sol[21]; sol[62] -= b2d.z * sol[21]; sol[63] -= b2d.w * sol[21];
  __builtin_amdgcn_sched_barrier(0);
  b2a = *(const float4*)(Lr + 1456); b2b = *(const float4*)(Lr + 1460); b2c = *(const float4*)(Lr + 1464); b2d = *(const float4*)(Lr + 1468);
  __builtin_amdgcn_sched_barrier(0);
  sol[23] -= b0b.w * sol[22]; sol[24] -= b0c.x * sol[22]; sol[25] -= b0c.y * sol[22]; sol[26] -= b0c.z * sol[22]; sol[27] -= b0c.w * sol[22]; sol[28] -= b0d.x * sol[22]; sol[29] -= b0d.y * sol[22]; sol[30] -= b0d.z * sol[22]; sol[31] -= b0d.w * sol[22];
  __builtin_amdgcn_sched_barrier(0);
  b0a = *(const float4*)(Lr + 1488); b0b = *(const float4*)(Lr + 1492); b0c = *(const float4*)(Lr + 1496); b0d = *(const float4*)(Lr + 1500);
  __builtin_amdgcn_sched_barrier(0);
  sol[32] -= b1a.x * sol[22]; sol[33] -= b1a.y * sol[22]; sol[34] -= b1a.z * sol[22]; sol[35] -= b1a.w * sol[22]; sol[36] -= b1b.x * sol[22]; sol[37] -= b1b.y * sol[22]; sol[38] -= b1b.z * sol[22]; sol[39] -= b1b.w * sol[22]; sol[40] -= b1c.x * sol[22]; sol[41] -= b1c.y * sol[22]; sol[42] -= b1c.z * sol[22]; sol[43] -= b1c.w * sol[22]; sol[44] -= b1d.x * sol[22]; sol[45] -= b1d.y * sol[22]; sol[46] -= b1d.z * sol[22]; sol[47] -= b1d.w * sol[22];
  __builtin_amdgcn_sched_barrier(0);
  b1a = *(const float4*)(Lr + 1504); b1b = *(const float4*)(Lr + 1508); b1c = *(const float4*)(Lr + 1512); b1d = *(const float4*)(Lr + 1516);
  __builtin_amdgcn_sched_barrier(0);
  sol[48] -= b2a.x * sol[22]; sol[49] -= b2a.y * sol[22]; sol[50] -= b2a.z * sol[22]; sol[51] -= b2a.w * sol[22]; sol[52] -= b2b.x * sol[22]; sol[53] -= b2b.y * sol[22]; sol[54] -= b2b.z * sol[22]; sol[55] -= b2b.w * sol[22]; sol[56] -= b2c.x * sol[22]; sol[57] -= b2c.y * sol[22]; sol[58] -= b2c.z * sol[22]; sol[59] -= b2c.w * sol[22]; sol[60] -= b2d.x * sol[22]; sol[61] -= b2d.y * sol[22]; sol[62] -= b2d.z * sol[22]; sol[63] -= b2d.w * sol[22];
  __builtin_amdgcn_sched_barrier(0);
  b2a = *(const float4*)(Lr + 1520); b2b = *(const float4*)(Lr + 1524); b2c = *(const float4*)(Lr + 1528); b2d = *(const float4*)(Lr + 1532);
  __builtin_amdgcn_sched_barrier(0);
  sol[24] -= b0c.x * sol[23]; sol[25] -= b0c.y * sol[23]; sol[26] -= b0c.z * sol[23]; sol[27] -= b0c.w * sol[23]; sol[28] -= b0d.x * sol[23]; sol[29] -= b0d.y * sol[23]; sol[30] -= b0d.z * sol[23]; sol[31] -= b0d.w * sol[23];
  __builtin_amdgcn_sched_barrier(0);
  b0a = *(const float4*)(Lr + 1552); b0b = *(const float4*)(Lr + 1556); b0c = *(const float4*)(Lr + 1560); b0d = *(const float4*)(Lr + 1564);
  __builtin_amdgcn_sched_barrier(0);
  sol[32] -= b1a.x * sol[23]; sol[33] -= b1a.y * sol[23]; sol[34] -= b1a.z * sol[23]; sol[35] -= b1a.w * sol[23]; sol[36] -= b1b.x * sol[23]; sol[37] -= b1b.y * sol[23]; sol[38] -= b1b.z * sol[23]; sol[39] -= b1b.w * sol[23]; sol[40] -= b1c.x * sol[23]; sol[41] -= b1c.y * sol[23]; sol[42] -= b1c.z * sol[23]; sol[43] -= b1c.w * sol[23]; sol[44] -= b1d.x * sol[23]; sol[45] -= b1d.y * sol[23]; sol[46] -= b1d.z * sol[23]; sol[47] -= b1d.w * sol[23];
  __builtin_amdgcn_sched_barrier(0);
  b1a = *(const float4*)(Lr + 1568); b1b = *(const float4*)(Lr + 1572); b1c = *(const float4*)(Lr + 1576); b1d = *(const float4*)(Lr + 1580);
  __builtin_amdgcn_sched_barrier(0);
  sol[48] -= b2a.x * sol[23]; sol[49] -= b2a.y * sol[23]; sol[50] -= b2a.z * sol[23]; sol[51] -= b2a.w * sol[23]; sol[52] -= b2b.x * sol[23]; sol[53] -= b2b.y * sol[23]; sol[54] -= b2b.z * sol[23]; sol[55] -= b2b.w * sol[23]; sol[56] -= b2c.x * sol[23]; sol[57] -= b2c.y * sol[23]; sol[58] -= b2c.z * sol[23]; sol[59] -= b2c.w * sol[23]; sol[60] -= b2d.x * sol[23]; sol[61] -= b2d.y * sol[23]; sol[62] -= b2d.z * sol[23]; sol[63] -= b2d.w * sol[23];
  __builtin_amdgcn_sched_barrier(0);
  b2a = *(const float4*)(Lr + 1584); b2b = *(const float4*)(Lr + 1588); b2c = *(const float4*)(Lr + 1592); b2d = *(const float4*)(Lr + 1596);
  __builtin_amdgcn_sched_barrier(0);
  sol[25] -= b0c.y * sol[24]; sol[26] -= b0c.z * sol[24]; sol[27] -= b0c.w * sol[24]; sol[28] -= b0d.x * sol[24]; sol[29] -= b0d.y * sol[24]; sol[30] -= b0d.z * sol[24]; sol[31] -= b0d.w * sol[24];
  __builtin_amdgcn_sched_barrier(0);
  b0a = *(const float4*)(Lr + 1616); b0b = *(const float4*)(Lr + 1620); b0c = *(const float4*)(Lr + 1624); b0d = *(const float4*)(Lr + 1628);
  __builtin_amdgcn_sched_barrier(0);
  sol[32] -= b1a.x * sol[24]; sol[33] -= b1a.y * sol[24]; sol[34] -= b1a.z * sol[24]; sol[35] -= b1a.w * sol[24]; sol[36] -= b1b.x * sol[24]; sol[37] -= b1b.y * sol[24]; sol[38] -= b1b.z * sol[24]; sol[39] -= b1b.w * sol[24]; sol[40] -= b1c.x * sol[24]; sol[41] -= b1c.y * sol[24]; sol[42] -= b1c.z * sol[24]; sol[43] -= b1c.w * sol[24]; sol[44] -= b1d.x * sol[24]; sol[45] -= b1d.y * sol[24]; sol[46] -= b1d.z * sol[24]; sol[47] -= b1d.w * sol[24];
  __builtin_amdgcn_sched_barrier(0);
  b1a = *(const float4*)(Lr + 1632); b1b = *(const float4*)(Lr + 1636); b1c = *(const float4*)(Lr + 1640); b1d = *(const float4*)(Lr + 1644);
  __builtin_amdgcn_sched_barrier(0);
  sol[48] -= b2a.x * sol[24]; sol[49] -= b2a.y * sol[24]; sol[50] -= b2a.z * sol[24]; sol[51] -= b2a.w * sol[24]; sol[52] -= b2b.x * sol[24]; sol[53] -= b2b.y * sol[24]; sol[54] -= b2b.z * sol[24]; sol[55] -= b2b.w * sol[24]; sol[56] -= b2c.x * sol[24]; sol[57] -= b2c.y * sol[24]; sol[58] -= b2c.z * sol[24]; sol[59] -= b2c.w * sol[24]; sol[60] -= b2d.x * sol[24]; sol[61] -= b2d.y * sol[24]; sol[62] -= b2d.z * sol[24]; sol[63] -= b2d.w * sol[24];
  __builtin_amdgcn_sched_barrier(0);
  b2a = *(const float4*)(Lr + 1648); b2b = *(const float4*)(Lr + 1652); b2c = *(const float4*)(Lr + 1656); b2d = *(const float4*)(Lr + 1660);
  __builtin_amdgcn_sched_barrier(0);
  sol[26] -= b0c.z * sol[25]; sol[27] -= b0c.w * sol[25]; sol[28] -= b0d.x * sol[25]; sol[29] -= b0d.y * sol[25]; sol[30] -= b0d.z * sol[25]; sol[31] -= b0d.w * sol[25];
  __builtin_amdgcn_sched_barrier(0);
  b0a = *(const float4*)(Lr + 1680); b0b = *(const float4*)(Lr + 1684); b0c = *(const float4*)(Lr + 1688); b0d = *(const float4*)(Lr + 1692);
  __builtin_amdgcn_sched_barrier(0);
  sol[32] -= b1a.x * sol[25]; sol[33] -= b1a.y * sol[25]; sol[34] -= b1a.z * sol[25]; sol[35] -= b1a.w * sol[25]; sol[36] -= b1b.x * sol[25]; sol[37] -= b1b.y * sol[25]; sol[38] -= b1b.z * sol[25]; sol[39] -= b1b.w * sol[25]; sol[40] -= b1c.x * sol[25]; sol[41] -= b1c.y * sol[25]; sol[42] -= b1c.z * sol[25]; sol[43] -= b1c.w * sol[25]; sol[44] -= b1d.x * sol[25]; sol[45] -= b1d.y * sol[25]; sol[46] -= b1d.z * sol[25]; sol[47] -= b1d.w * sol[25];
  __builtin_amdgcn_sched_barrier(0);
  b1a = *(const float4*)(Lr + 1696); b1b = *(const float4*)(Lr + 1700); b1c = *(const float4*)(Lr + 1704); b1d = *(const float4*)(Lr + 1708);
  __builtin_amdgcn_sched_barrier(0);
  sol[48] -= b2a.x * sol[25]; sol[49] -= b2a.y * sol[25]; sol[50] -= b2a.z * sol[25]; sol[51] -= b2a.w * sol[25]; sol[52] -= b2b.x * sol[25]; sol[53] -= b2b.y * sol[25]; sol[54] -= b2b.z * sol[25]; sol[55] -= b2b.w * sol[25]; sol[56] -= b2c.x * sol[25]; sol[57] -= b2c.y * sol[25]; sol[58] -= b2c.z * sol[25]; sol[59] -= b2c.w * sol[25]; sol[60] -= b2d.x * sol[25]; sol[61] -= b2d.y * sol[25]; sol[62] -= b2d.z * sol[25]; sol[63] -= b2d.w * sol[25];
  __builtin_amdgcn_sched_barrier(0);
  b2a = *(const float4*)(Lr + 1712); b2b = *(const float4*)(Lr + 1716); b2c = *(const float4*)(Lr + 1720); b2d = *(const float4*)(Lr + 1724);
  __builtin_amdgcn_sched_barrier(0);
  sol[27] -= b0c.w * sol[26]; sol[28] -= b0d.x * sol[26]; sol[29] -= b0d.y * sol[26]; sol[30] -= b0d.z * sol[26]; sol[31] -= b0d.w * sol[26];
  __builtin_amdgcn_sched_barrier(0);
  b0a = *(const float4*)(Lr + 1744); b0b = *(const float4*)(Lr + 1748); b0c = *(const float4*)(Lr + 1752); b0d = *(const float4*)(Lr + 1756);
  __builtin_amdgcn_sched_barrier(0);
  sol[32] -= b1a.x * sol[26]; sol[33] -= b1a.y * sol[26]; sol[34] -= b1a.z * sol[26]; sol[35] -= b1a.w * sol[26]; sol[36] -= b1b.x * sol[26]; sol[37] -= b1b.y * sol[26]; sol[38] -= b1b.z * sol[26]; sol[39] -= b1b.w * sol[26]; sol[40] -= b1c.x * sol[26]; sol[41] -= b1c.y * sol[26]; sol[42] -= b1c.z * sol[26]; sol[43] -= b1c.w * sol[26]; sol[44] -= b1d.x * sol[26]; sol[45] -= b1d.y * sol[26]; sol[46] -= b1d.z * sol[26]; sol[47] -= b1d.w * sol[26];
  __builtin_amdgcn_sched_barrier(0);
  b1a = *(const float4*)(Lr + 1760); b1b = *(const float4*)(Lr + 1764); b1c = *(const float4*)(Lr + 1768); b1d = *(const float4*)(Lr + 1772);
  __builtin_amdgcn_sched_barrier(0);
  sol[48] -= b2a.x * sol[26]; sol[49] -= b2a.y * sol[26]; sol[50] -= b2a.z * sol[26]; sol[51] -= b2a.w * sol[26]; sol[52] -= b2b.x * sol[26]; sol[53] -= b2b.y * sol[26]; sol[54] -= b2b.z * sol[26]; sol[55] -= b2b.w * sol[26]; sol[56] -= b2c.x * sol[26]; sol[57] -= b2c.y * sol[26]; sol[58] -= b2c.z * sol[26]; sol[59] -= b2c.w * sol[26]; sol[60] -= b2d.x * sol[26]; sol[61] -= b2d.y * sol[26]; sol[62] -= b2d.z * sol[26]; sol[63] -= b2d.w * sol[26];
  __builtin_amdgcn_sched_barrier(0);
  b2a = *(const float4*)(Lr + 1776); b2b = *(const float4*)(Lr + 1780); b2c = *(const float4*)(Lr + 1784); b2d = *(const float4*)(Lr + 1788);
  __builtin_amdgcn_sched_barrier(0);
  sol[28] -= b0d.x * sol[27]; sol[29] -= b0d.y * sol[27]; sol[30] -= b0d.z * sol[27]; sol[31] -= b0d.w * sol[27];
  __builtin_amdgcn_sched_barrier(0);
  b0a = *(const float4*)(Lr + 1808); b0b = *(const float4*)(Lr + 1812); b0c = *(const float4*)(Lr + 1816); b0d = *(const float4*)(Lr + 1820);
  __builtin_amdgcn_sched_barrier(0);
  sol[32] -= b1a.x * sol[27]; sol[33] -= b1a.y * sol[27]; sol[34] -= b1a.z * sol[27]; sol[35] -= b1a.w * sol[27]; sol[36] -= b1b.x * sol[27]; sol[37] -= b1b.y * sol[27]; sol[38] -= b1b.z * sol[27]; sol[39] -= b1b.w * sol[27]; sol[40] -= b1c.x * sol[27]; sol[41] -= b1c.y * sol[27]; sol[42] -= b1c.z * sol[27]; sol[43] -= b1c.w * sol[27]; sol[44] -= b1d.x * sol[27]; sol[45] -= b1d.y * sol[27]; sol[46] -= b1d.z * sol[27]; sol[47] -= b1d.w * sol[27];
  __builtin_amdgcn_sched_barrier(0);
  b1a = *(const float4*)(Lr + 1824); b1b = *(const float4*)(Lr + 1828); b1c = *(const float4*)(Lr + 1832); b1d = *(const float4*)(Lr + 1836);
  __builtin_amdgcn_sched_barrier(0);
  sol[48] -= b2a.x * sol[27]; sol[49] -= b2a.y * sol[27]; sol[50] -= b2a.z * sol[27]; sol[51] -= b2a.w * sol[27]; sol[52] -= b2b.x * sol[27]; sol[53] -= b2b.y * sol[27]; sol[54] -= b2b.z * sol[27]; sol[55] -= b2b.w * sol[27]; sol[56] -= b2c.x * sol[27]; sol[57] -= b2c.y * sol[27]; sol[58] -= b2c.z * sol[27]; sol[59] -= b2c.w * sol[27]; sol[60] -= b2d.x * sol[27]; sol[61] -= b2d.y * sol[27]; sol[62] -= b2d.z * sol[27]; sol[63] -= b2d.w * sol[27];
  __builtin_amdgcn_sched_barrier(0);
  b2a = *(const float4*)(Lr + 1840); b2b = *(const float4*)(Lr + 1844); b2c = *(const float4*)(Lr + 1848); b2d = *(const float4*)(Lr + 1852);
  __builtin_amdgcn_sched_barrier(0);
  sol[29] -= b0d.y * sol[28]; sol[30] -= b0d.z * sol[28]; sol[31] -= b0d.w * sol[28];
  __builtin_amdgcn_sched_barrier(0);
  b0a = *(const float4*)(Lr + 1872); b0b = *(const float4*)(Lr + 1876); b0c = *(const float4*)(Lr + 1880); b0d = *(const float4*)(Lr + 1884);
  __builtin_amdgcn_sched_barrier(0);
  sol[32] -= b1a.x * sol[28]; sol[33] -= b1a.y * sol[28]; sol[34] -= b1a.z * sol[28]; sol[35] -= b1a.w * sol[28]; sol[36] -= b1b.x * sol[28]; sol[37] -= b1b.y * sol[28]; sol[38] -= b1b.z * sol[28]; sol[39] -= b1b.w * sol[28]; sol[40] -= b1c.x * sol[28]; sol[41] -= b1c.y * sol[28]; sol[42] -= b1c.z * sol[28]; sol[43] -= b1c.w * sol[28]; sol[44] -= b1d.x * sol[28]; sol[45] -= b1d.y * sol[28]; sol[46] -= b1d.z * sol[28]; sol[47] -= b1d.w * sol[28];
  __builtin_amdgcn_sched_barrier(0);
  b1a = *(const float4*)(Lr + 1888); b1b = *(const float4*)(Lr + 1892); b1c = *(const float4*)(Lr + 1896); b1d = *(const float4*)(Lr + 1900);
  __builtin_amdgcn_sched_barrier(0);
  sol[48] -= b2a.x * sol[28]; sol[49] -= b2a.y * sol[28]; sol[50] -= b2a.z * sol[28]; sol[51] -= b2a.w * sol[28]; sol[52] -= b2b.x * sol[28]; sol[53] -= b2b.y * sol[28]; sol[54] -= b2b.z * sol[28]; sol[55] -= b2b.w * sol[28]; sol[56] -= b2c.x * sol[28]; sol[57] -= b2c.y * sol[28]; sol[58] -= b2c.z * sol[28]; sol[59] -= b2c.w * sol[28]; sol[60] -= b2d.x * sol[28]; sol[61] -= b2d.y * sol[28]; sol[62] -= b2d.z * sol[28]; sol[63] -= b2d.w * sol[28];
  __builtin_amdgcn_sched_barrier(0);
  b2a = *(const float4*)(Lr + 1904); b2b = *(const float4*)(Lr + 1908); b2c = *(const float4*)(Lr + 1912); b2d = *(const float4*)(Lr + 1916);
  __builtin_amdgcn_sched_barrier(0);
  sol[30] -= b0d.z * sol[29]; sol[31] -= b0d.w * sol[29];
  __builtin_amdgcn_sched_barrier(0);
  b0a = *(const float4*)(Lr + 1936); b0b = *(const float4*)(Lr + 1940); b0c = *(const float4*)(Lr + 1944); b0d = *(const float4*)(Lr + 1948);
  __builtin_amdgcn_sched_barrier(0);
  sol[32] -= b1a.x * sol[29]; sol[33] -= b1a.y * sol[29]; sol[34] -= b1a.z * sol[29]; sol[35] -= b1a.w * sol[29]; sol[36] -= b1b.x * sol[29]; sol[37] -= b1b.y * sol[29]; sol[38] -= b1b.z * sol[29]; sol[39] -= b1b.w * sol[29]; sol[40] -= b1c.x * sol[29]; sol[41] -= b1c.y * sol[29]; sol[42] -= b1c.z * sol[29]; sol[43] -= b1c.w * sol[29]; sol[44] -= b1d.x * sol[29]; sol[45] -= b1d.y * sol[29]; sol[46] -= b1d.z * sol[29]; sol[47] -= b1d.w * sol[29];
  __builtin_amdgcn_sched_barrier(0);
  b1a = *(const float4*)(Lr + 1952); b1b = *(const float4*)(Lr + 1956); b1c = *(const float4*)(Lr + 1960); b1d = *(const float4*)(Lr + 1964);
  __builtin_amdgcn_sched_barrier(0);
  sol[48] -= b2a.x * sol[29]; sol[49] -= b2a.y * sol[29]; sol[50] -= b2a.z * sol[29]; sol[51] -= b2a.w * sol[29]; sol[52] -= b2b.x * sol[29]; sol[53] -= b2b.y * sol[29]; sol[54] -= b2b.z * sol[29]; sol[55] -= b2b.w * sol[29]; sol[56] -= b2c.x * sol[29]; sol[57] -= b2c.y * sol[29]; sol[58] -= b2c.z * sol[29]; sol[59] -= b2c.w * sol[29]; sol[60] -= b2d.x * sol[29]; sol[61] -= b2d.y * sol[29]; sol[62] -= b2d.z * sol[29]; sol[63] -= b2d.w * sol[29];
  __builtin_amdgcn_sched_barrier(0);
  b2a = *(const float4*)(Lr + 1968); b2b = *(const float4*)(Lr + 1972); b2c = *(const float4*)(Lr + 1976); b2d = *(const float4*)(Lr + 1980);
  __builtin_amdgcn_sched_barrier(0);
  sol[31] -= b0d.w * sol[30];
  __builtin_amdgcn_sched_barrier(0);
  b0a = *(const float4*)(Lr + 2016); b0b = *(const float4*)(Lr + 2020); b0c = *(const float4*)(Lr + 2024); b0d = *(const float4*)(Lr + 2028);
  __builtin_amdgcn_sched_barrier(0);
  sol[32] -= b1a.x * sol[30]; sol[33] -= b1a.y * sol[30]; sol[34] -= b1a.z * sol[30]; sol[35] -= b1a.w * sol[30]; sol[36] -= b1b.x * sol[30]; sol[37] -= b1b.y * sol[30]; sol[38] -= b1b.z * sol[30]; sol[39] -= b1b.w * sol[30]; sol[40] -= b1c.x * sol[30]; sol[41] -= b1c.y * sol[30]; sol[42] -= b1c.z * sol[30]; sol[43] -= b1c.w * sol[30]; sol[44] -= b1d.x * sol[30]; sol[45] -= b1d.y * sol[30]; sol[46] -= b1d.z * sol[30]; sol[47] -= b1d.w * sol[30];
  __builtin_amdgcn_sched_barrier(0);
  b1a = *(const float4*)(Lr + 2032); b1b = *(const float4*)(Lr + 2036); b1c = *(const float4*)(Lr + 2040); b1d = *(const float4*)(Lr + 2044);
  __builtin_amdgcn_sched_barrier(0);
  sol[48] -= b2a.x * sol[30]; sol[49] -= b2a.y * sol[30]; sol[50] -= b2a.z * sol[30]; sol[51] -= b2a.w * sol[30]; sol[52] -= b2b.x * sol[30]; sol[53] -= b2b.y * sol[30]; sol[54] -= b2b.z * sol[30]; sol[55] -= b2b.w * sol[30]; sol[56] -= b2c.x * sol[30]; sol[57] -= b2c.y * sol[30]; sol[58] -= b2c.z * sol[30]; sol[59] -= b2c.w * sol[30]; sol[60] -= b2d.x * sol[30]; sol[61] -= b2d.y * sol[30]; sol[62] -= b2d.z * sol[30]; sol[63] -= b2d.w * sol[30];
  __builtin_amdgcn_sched_barrier(0);
  b2a = *(const float4*)(Lr + 2080); b2b = *(const float4*)(Lr + 2084); b2c = *(const float4*)(Lr + 2088); b2d = *(const float4*)(Lr + 2092);
  __builtin_amdgcn_sched_barrier(0);
  sol[32] -= b0a.x * sol[31]; sol[33] -= b0a.y * sol[31]; sol[34] -= b0a.z * sol[31]; sol[35] -= b0a.w * sol[31]; sol[36] -= b0b.x * sol[31]; sol[37] -= b0b.y * sol[31]; sol[38] -= b0b.z * sol[31]; sol[39] -= b0b.w * sol[31]; sol[40] -= b0c.x * sol[31]; sol[41] -= b0c.y * sol[31]; sol[42] -= b0c.z * sol[31]; sol[43] -= b0c.w * sol[31]; sol[44] -= b0d.x * sol[31]; sol[45] -= b0d.y * sol[31]; sol[46] -= b0d.z * sol[31]; sol[47] -= b0d.w * sol[31];
  __builtin_amdgcn_sched_barrier(0);
  b0a = *(const float4*)(Lr + 2096); b0b = *(const float4*)(Lr + 2100); b0c = *(const float4*)(Lr + 2104); b0d = *(const float4*)(Lr + 2108);
  __builtin_amdgcn_sched_barrier(0);
  sol[48] -= b1a.x * sol[31]; sol[49] -= b1a.y * sol[31]; sol[50] -= b1a.z * sol[31]; sol[51] -= b1a.w * sol[31]; sol[52] -= b1b.x * sol[31]; sol[53] -= b1b.y * sol[31]; sol[54] -= b1b.z * sol[31]; sol[55] -= b1b.w * sol[31]; sol[56] -= b1c.x * sol[31]; sol[57] -= b1c.y * sol[31]; sol[58] -= b1c.z * sol[31]; sol[59] -= b1c.w * sol[31]; sol[60] -= b1d.x * sol[31]; sol[61] -= b1d.y * sol[31]; sol[62] -= b1d.z * sol[31]; sol[63] -= b1d.w * sol[31];
  __builtin_amdgcn_sched_barrier(0);
  b1a = *(const float4*)(Lr + 2144); b1b = *(const float4*)(Lr + 2148); b1c = *(const float4*)(Lr + 2152); b1d = *(const float4*)(Lr + 2156);
  __builtin_amdgcn_sched_barrier(0);
  sol[33] -= b2a.y * sol[32]; sol[34] -= b2a.z * sol[32]; sol[35] -= b2a.w * sol[32]; sol[36] -= b2b.x * sol[32]; sol[37] -= b2b.y * sol[32]; sol[38] -= b2b.z * sol[32]; sol[39] -= b2b.w * sol[32]; sol[40] -= b2c.x * sol[32]; sol[41] -= b2c.y * sol[32]; sol[42] -= b2c.z * sol[32]; sol[43] -= b2c.w * sol[32]; sol[44] -= b2d.x * sol[32]; sol[45] -= b2d.y * sol[32]; sol[46] -= b2d.z * sol[32]; sol[47] -= b2d.w * sol[32];
  __builtin_amdgcn_sched_barrier(0);
  b2a = *(const float4*)(Lr + 2160); b2b = *(const float4*)(Lr + 2164); b2c = *(const float4*)(Lr + 2168); b2d = *(const float4*)(Lr + 2172);
  __builtin_amdgcn_sched_barrier(0);
  sol[48] -= b0a.x * sol[32]; sol[49] -= b0a.y * sol[32]; sol[50] -= b0a.z * sol[32]; sol[51] -= b0a.w * sol[32]; sol[52] -= b0b.x * sol[32]; sol[53] -= b0b.y * sol[32]; sol[54] -= b0b.z * sol[32]; sol[55] -= b0b.w * sol[32]; sol[56] -= b0c.x * sol[32]; sol[57] -= b0c.y * sol[32]; sol[58] -= b0c.z * sol[32]; sol[59] -= b0c.w * sol[32]; sol[60] -= b0d.x * sol[32]; sol[61] -= b0d.y * sol[32]; sol[62] -= b0d.z * sol[32]; sol[63] -= b0d.w * sol[32];
  __builtin_amdgcn_sched_barrier(0);
  b0a = *(const float4*)(Lr + 2208); b0b = *(const float4*)(Lr + 2212); b0c = *(const float4*)(Lr + 2216); b0d = *(const float4*)(Lr + 2220);
  __builtin_amdgcn_sched_barrier(0);
  sol[34] -= b1a.z * sol[33]; sol[35] -= b1a.w * sol[33]; sol[36] -= b1b.x * sol[33]; sol[37] -= b1b.y * sol[33]; sol[38] -= b1b.z * sol[33]; sol[39] -= b1b.w * sol[33]; sol[40] -= b1c.x * sol[33]; sol[41] -= b1c.y * sol[33]; sol[42] -= b1c.z * sol[33]; sol[43] -= b1c.w * sol[33]; sol[44] -= b1d.x * sol[33]; sol[45] -= b1d.y * sol[33]; sol[46] -= b1d.z * sol[33]; sol[47] -= b1d.w * sol[33];
  __builtin_amdgcn_sched_barrier(0);
  b1a = *(const float4*)(Lr + 2224); b1b = *(const float4*)(Lr + 2228); b1c = *(const float4*)(Lr + 2232); b1d = *(const float4*)(Lr + 2236);
  __builtin_amdgcn_sched_barrier(0);
  sol[48] -= b2a.x * sol[33]; sol[49] -= b2a.y * sol[33]; sol[50] -= b2a.z * sol[33]; sol[51] -= b2a.w * sol[33]; sol[52] -= b2b.x * sol[33]; sol[53] -= b2b.y * sol[33]; sol[54] -= b2b.z * sol[33]; sol[55] -= b2b.w * sol[33]; sol[56] -= b2c.x * sol[33]; sol[57] -= b2c.y * sol[33]; sol[58] -= b2c.z * sol[33]; sol[59] -= b2c.w * sol[33]; sol[60] -= b2d.x * sol[33]; sol[61] -= b2d.y * sol[33]; sol[62] -= b2d.z * sol[33]; sol[63] -= b2d.w * sol[33];
  __builtin_amdgcn_sched_barrier(0);
  b2a = *(const float4*)(Lr + 2272); b2b = *(const float4*)(Lr + 2276); b2c = *(const float4*)(Lr + 2280); b2d = *(const float4*)(Lr + 2284);
  __builtin_amdgcn_sched_barrier(0);
  sol[35] -= b0a.w * sol[34]; sol[36] -= b0b.x * sol[34]; sol[37] -= b0b.y * sol[34]; sol[38] -= b0b.z * sol[34]; sol[39] -= b0b.w * sol[34]; sol[40] -= b0c.x * sol[34]; sol[41] -= b0c.y * sol[34]; sol[42] -= b0c.z * sol[34]; sol[43] -= b0c.w * sol[34]; sol[44] -= b0d.x * sol[34]; sol[45] -= b0d.y * sol[34]; sol[46] -= b0d.z * sol[34]; sol[47] -= b0d.w * sol[34];
  __builtin_amdgcn_sched_barrier(0);
  b0a = *(const float4*)(Lr + 2288); b0b = *(const float4*)(Lr + 2292); b0c = *(const float4*)(Lr + 2296); b0d = *(const float4*)(Lr + 2300);
  __builtin_amdgcn_sched_barrier(0);
  sol[48] -= b1a.x * sol[34]; sol[49] -= b1a.y * sol[34]; sol[50] -= b1a.z * sol[34]; sol[51] -= b1a.w * sol[34]; sol[52] -= b1b.x * sol[34]; sol[53] -= b1b.y * sol[34]; sol[54] -= b1b.z * sol[34]; sol[55] -= b1b.w * sol[34]; sol[56] -= b1c.x * sol[34]; sol[57] -= b1c.y * sol[34]; sol[58] -= b1c.z * sol[34]; sol[59] -= b1c.w * sol[34]; sol[60] -= b1d.x * sol[34]; sol[61] -= b1d.y * sol[34]; sol[62] -= b1d.z * sol[34]; sol[63] -= b1d.w * sol[34];
  __builtin_amdgcn_sched_barrier(0);
  b1a = *(const float4*)(Lr + 2336); b1b = *(const float4*)(Lr + 2340); b1c = *(const float4*)(Lr + 2344); b1d = *(const float4*)(Lr + 2348);
  __builtin_amdgcn_sched_barrier(0);
  sol[36] -= b2b.x * sol[35]; sol[37] -= b2b.y * sol[35]; sol[38] -= b2b.z * sol[35]; sol[39] -= b2b.w * sol[35]; sol[40] -= b2c.x * sol[35]; sol[41] -= b2c.y * sol[35]; sol[42] -= b2c.z * sol[35]; sol[43] -= b2c.w * sol[35]; sol[44] -= b2d.x * sol[35]; sol[45] -= b2d.y * sol[35]; sol[46] -= b2d.z * sol[35]; sol[47] -= b2d.w * sol[35];
  __builtin_amdgcn_sched_barrier(0);
  b2a = *(const float4*)(Lr + 2352); b2b = *(const float4*)(Lr + 2356); b2c = *(const float4*)(Lr + 2360); b2d = *(const float4*)(Lr + 2364);
  __builtin_amdgcn_sched_barrier(0);
  sol[48] -= b0a.x * sol[35]; sol[49] -= b0a.y * sol[35]; sol[50] -= b0a.z * sol[35]; sol[51] -= b0a.w * sol[35]; sol[52] -= b0b.x * sol[35]; sol[53] -= b0b.y * sol[35]; sol[54] -= b0b.z * sol[35]; sol[55] -= b0b.w * sol[35]; sol[56] -= b0c.x * sol[35]; sol[57] -= b0c.y * sol[35]; sol[58] -= b0c.z * sol[35]; sol[59] -= b0c.w * sol[35]; sol[60] -= b0d.x * sol[35]; sol[61] -= b0d.y * sol[35]; sol[62] -= b0d.z * sol[35]; sol[63] -= b0d.w * sol[35];
  __builtin_amdgcn_sched_barrier(0);
  b0a = *(const float4*)(Lr + 2400); b0b = *(const float4*)(Lr + 2404); b0c = *(const float4*)(Lr + 2408); b0d = *(const float4*)(Lr + 2412);
  __builtin_amdgcn_sched_barrier(0);
  sol[37] -= b1b.y * sol[36]; sol[38] -= b1b.z * sol[36]; sol[39] -= b1b.w * sol[36]; sol[40] -= b1c.x * sol[36]; sol[41] -= b1c.y * sol[36]; sol[42] -= b1c.z * sol[36]; sol[43] -= b1c.w * sol[36]; sol[44] -= b1d.x * sol[36]; sol[45] -= b1d.y * sol[36]; sol[46] -= b1d.z * sol[36]; sol[47] -= b1d.w * sol[36];
  __builtin_amdgcn_sched_barrier(0);
  b1a = *(const float4*)(Lr + 2416); b1b = *(const float4*)(Lr + 2420); b1c = *(const float4*)(Lr + 2424); b1d = *(const float4*)(Lr + 2428);
  __builtin_amdgcn_sched_barrier(0);
  sol[48] -= b2a.x * sol[36]; sol[49] -= b2a.y * sol[36]; sol[50] -= b2a.z * sol[36]; sol[51] -= b2a.w * sol[36]; sol[52] -= b2b.x * sol[36]; sol[53] -= b2b.y * sol[36]; sol[54] -= b2b.z * sol[36]; sol[55] -= b2b.w * sol[36]; sol[56] -= b2c.x * sol[36]; sol[57] -= b2c.y * sol[36]; sol[58] -= b2c.z * sol[36]; sol[59] -= b2c.w * sol[36]; sol[60] -= b2d.x * sol[36]; sol[61] -= b2d.y * sol[36]; sol[62] -= b2d.z * sol[36]; sol[63] -= b2d.w * sol[36];
  __builtin_amdgcn_sched_barrier(0);
  b2a = *(const float4*)(Lr + 2464); b2b = *(const float4*)(Lr + 2468); b2c = *(const float4*)(Lr + 2472); b2d = *(const float4*)(Lr + 2476);
  __builtin_amdgcn_sched_barrier(0);
  sol[38] -= b0b.z * sol[37]; sol[39] -= b0b.w * sol[37]; sol[40] -= b0c.x * sol[37]; sol[41] -= b0c.y * sol[37]; sol[42] -= b0c.z * sol[37]; sol[43] -= b0c.w * sol[37]; sol[44] -= b0d.x * sol[37]; sol[45] -= b0d.y * sol[37]; sol[46] -= b0d.z * sol[37]; sol[47] -= b0d.w * sol[37];
  __builtin_amdgcn_sched_barrier(0);
  b0a = *(const float4*)(Lr + 2480); b0b = *(const float4*)(Lr + 2484); b0c = *(const float4*)(Lr + 2488); b0d = *(const float4*)(Lr + 2492);
  __builtin_amdgcn_sched_barrier(0);
  sol[48] -= b1a.x * sol[37]; sol[49] -= b1a.y * sol[37]; sol[50] -= b1a.z * sol[37]; sol[51] -= b1a.w * sol[37]; sol[52] -= b1b.x * sol[37]; sol[53] -= b1b.y * sol[37]; sol[54] -= b1b.z * sol[37]; sol[55] -= b1b.w * sol[37]; sol[56] -= b1c.x * sol[37]; sol[57] -= b1c.y * sol[37]; sol[58] -= b1c.z * sol[37]; sol[59] -= b1c.w * sol[37]; sol[60] -= b1d.x * sol[37]; sol[61] -= b1d.y * sol[37]; sol[62] -= b1d.z * sol[37]; sol[63] -= b1d.w * sol[37];
  __builtin_amdgcn_sched_barrier(0);
  b1a = *(const float4*)(Lr + 2528); b1b = *(const float4*)(Lr + 2532); b1c = *(const float4*)(Lr + 2536); b1d = *(const float4*)(Lr + 2540);
  __builtin_amdgcn_sched_barrier(0);
  sol[39] -= b2b.w * sol[38]; sol[40] -= b2c.x * sol[38]; sol[41] -= b2c.y * sol[38]; sol[42] -= b2c.z * sol[38]; sol[43] -= b2c.w * sol[38]; sol[44] -= b2d.x * sol[38]; sol[45] -= b2d.y * sol[38]; sol[46] -= b2d.z * sol[38]; sol[47] -= b2d.w * sol[38];
  __builtin_amdgcn_sched_barrier(0);
  b2a = *(const float4*)(Lr + 2544); b2b = *(const float4*)(Lr + 2548); b2c = *(const float4*)(Lr + 2552); b2d = *(const float4*)(Lr + 2556);
  __builtin_amdgcn_sched_barrier(0);
  sol[48] -= b0a.x * sol[38]; sol[49] -= b0a.y * sol[38]; sol[50] -= b0a.z * sol[38]; sol[51] -= b0a.w * sol[38]; sol[52] -= b0b.x * sol[38]; sol[53] -= b0b.y * sol[38]; sol[54] -= b0b.z * sol[38]; sol[55] -= b0b.w * sol[38]; sol[56] -= b0c.x * sol[38]; sol[57] -= b0c.y * sol[38]; sol[58] -= b0c.z * sol[38]; sol[59] -= b0c.w * sol[38]; sol[60] -= b0d.x * sol[38]; sol[61] -= b0d.y * sol[38]; sol[62] -= b0d.z * sol[38]; sol[63] -= b0d.w * sol[38];
  __builtin_amdgcn_sched_barrier(0);
  b0a = *(const float4*)(Lr + 2592); b0b = *(const float4*)(Lr + 2596); b0c = *(const float4*)(Lr + 2600); b0d = *(const float4*)(Lr + 2604);
  __builtin_amdgcn_sched_barrier(0);
  sol[40] -= b1c.x * sol[39]; sol[41] -= b1c.y * sol[39]; sol[42] -= b1c.z * sol[39]; sol[43] -= b1c.w * sol[39]; sol[44] -= b1d.x * sol[39]; sol[45] -= b1d.y * sol[39]; sol[46] -= b1d.z * sol[39]; sol[47] -= b1d.w * sol[39];
  __builtin_amdgcn_sched_barrier(0);
  b1a = *(const float4*)(Lr + 2608); b1b = *(const float4*)(Lr + 2612); b1c = *(const float4*)(Lr + 2616); b1d = *(const float4*)(Lr + 2620);
  __builtin_amdgcn_sched_barrier(0);
  sol[48] -= b2a.x * sol[39]; sol[49] -= b2a.y * sol[39]; sol[50] -= b2a.z * sol[39]; sol[51] -= b2a.w * sol[39]; sol[52] -= b2b.x * sol[39]; sol[53] -= b2b.y * sol[39]; sol[54] -= b2b.z * sol[39]; sol[55] -= b2b.w * sol[39]; sol[56] -= b2c.x * sol[39]; sol[57] -= b2c.y * sol[39]; sol[58] -= b2c.z * sol[39]; sol[59] -= b2c.w * sol[39]; sol[60] -= b2d.x * sol[39]; sol[61] -= b2d.y * sol[39]; sol[62] -= b2d.z * sol[39]; sol[63] -= b2d.w * sol[39];
  __builtin_amdgcn_sched_barrier(0);
  b2a = *(const float4*)(Lr + 2656); b2b = *(const float4*)(Lr + 2660); b2c = *(const float4*)(Lr + 2664); b2d = *(const float4*)(Lr + 2668);
  __builtin_amdgcn_sched_barrier(0);
  sol[41] -= b0c.y * sol[40]; sol[42] -= b0c.z * sol[40]; sol[43] -= b0c.w * sol[40]; sol[44] -= b0d.x * sol[40]; sol[45] -= b0d.y * sol[40]; sol[46] -= b0d.z * sol[40]; sol[47] -= b0d.w * sol[40];
  __builtin_amdgcn_sched_barrier(0);
  b0a = *(const float4*)(Lr + 2672); b0b = *(const float4*)(Lr + 2676); b0c = *(const float4*)(Lr + 2680); b0d = *(const float4*)(Lr + 2684);
  __builtin_amdgcn_sched_barrier(0);
  sol[48] -= b1a.x * sol[40]; sol[49] -= b1a.y * sol[40]; sol[50] -= b1a.z * sol[40]; sol[51] -= b1a.w * sol[40]; sol[52] -= b1b.x * sol[40]; sol[53] -= b1b.y * sol[40]; sol[54] -= b1b.z * sol[40]; sol[55] -= b1b.w * sol[40]; sol[56] -= b1c.x * sol[40]; sol[57] -= b1c.y * sol[40]; sol[58] -= b1c.z * sol[40]; sol[59] -= b1c.w * sol[40]; sol[60] -= b1d.x * sol[40]; sol[61] -= b1d.y * sol[40]; sol[62] -= b1d.z * sol[40]; sol[63] -= b1d.w * sol[40];
  __builtin_amdgcn_sched_barrier(0);
  b1a = *(const float4*)(Lr + 2720); b1b = *(const float4*)(Lr + 2724); b1c = *(const float4*)(Lr + 2728); b1d = *(const float4*)(Lr + 2732);
  __builtin_amdgcn_sched_barrier(0);
  sol[42] -= b2c.z * sol[41]; sol[43] -= b2c.w * sol[41]; sol[44] -= b2d.x * sol[41]; sol[45] -= b2d.y * sol[41]; sol[46] -= b2d.z * sol[41]; sol[47] -= b2d.w * sol[41];
  __builtin_amdgcn_sched_barrier(0);
  b2a = *(const float4*)(Lr + 2736); b2b = *(const float4*)(Lr + 2740); b2c = *(const float4*)(Lr + 2744); b2d = *(const float4*)(Lr + 2748);
  __builtin_amdgcn_sched_barrier(0);
  sol[48] -= b0a.x * sol[41]; sol[49] -= b0a.y * sol[41]; sol[50] -= b0a.z * sol[41]; sol[51] -= b0a.w * sol[41]; sol[52] -= b0b.x * sol[41]; sol[53] -= b0b.y * sol[41]; sol[54] -= b0b.z * sol[41]; sol[55] -= b0b.w * sol[41]; sol[56] -= b0c.x * sol[41]; sol[57] -= b0c.y * sol[41]; sol[58] -= b0c.z * sol[41]; sol[59] -= b0c.w * sol[41]; sol[60] -= b0d.x * sol[41]; sol[61] -= b0d.y * sol[41]; sol[62] -= b0d.z * sol[41]; sol[63] -= b0d.w * sol[41];
  __builtin_amdgcn_sched_barrier(0);
  b0a = *(const float4*)(Lr + 2784); b0b = *(const float4*)(Lr + 2788); b0c = *(const float4*)(Lr + 2792); b0d = *(const float4*)(Lr + 2796);
  __builtin_amdgcn_sched_barrier(0);
  sol[43] -= b1c.w * sol[42]; sol[44] -= b1d.x * sol[42]; sol[45] -= b1d.y * sol[42]; sol[46] -= b1d.z * sol[42]; sol[47] -= b1d.w * sol[42];
  __builtin_amdgcn_sched_barrier(0);
  b1a = *(const float4*)(Lr + 2800); b1b = *(const float4*)(Lr + 2804); b1c = *(const float4*)(Lr + 2808); b1d = *(const float4*)(Lr + 2812);
  __builtin_amdgcn_sched_barrier(0);
  sol[48] -= b2a.x * sol[42]; sol[49] -= b2a.y * sol[42]; sol[50] -= b2a.z * sol[42]; sol[51] -= b2a.w * sol[42]; sol[52] -= b2b.x * sol[42]; sol[53] -= b2b.y * sol[42]; sol[54] -= b2b.z * sol[42]; sol[55] -= b2b.w * sol[42]; sol[56] -= b2c.x * sol[42]; sol[57] -= b2c.y * sol[42]; sol[58] -= b2c.z * sol[42]; sol[59] -= b2c.w * sol[42]; sol[60] -= b2d.x * sol[42]; sol[61] -= b2d.y * sol[42]; sol[62] -= b2d.z * sol[42]; sol[63] -= b2d.w * sol[42];
  __builtin_amdgcn_sched_barrier(0);
  b2a = *(const float4*)(Lr + 2848); b2b = *(const float4*)(Lr + 2852); b2c = *(const float4*)(Lr + 2856); b2d = *(const float4*)(Lr + 2860);
  __builtin_amdgcn_sched_barrier(0);
  sol[44] -= b0d.x * sol[43]; sol[45] -= b0d.y * sol[43]; sol[46] -= b0d.z * sol[43]; sol[47] -= b0d.w * sol[43];
  __builtin_amdgcn_sched_barrier(0);
  b0a = *(const float4*)(Lr + 2864); b0b = *(const float4*)(Lr + 2868); b0c = *(const float4*)(Lr + 2872); b0d = *(const float4*)(Lr + 2876);
  __builtin_amdgcn_sched_barrier(0);
  sol[48] -= b1a.x * sol[43]; sol[49] -= b1a.y * sol[43]; sol[50] -= b1a.z * sol[43]; sol[51] -= b1a.w * sol[43]; sol[52] -= b1b.x * sol[43]; sol[53] -= b1b.y * sol[43]; sol[54] -= b1b.z * sol[43]; sol[55] -= b1b.w * sol[43]; sol[56] -= b1c.x * sol[43]; sol[57] -= b1c.y * sol[43]; sol[58] -= b1c.z * sol[43]; sol[59] -= b1c.w * sol[43]; sol[60] -= b1d.x * sol[43]; sol[61] -= b1d.y * sol[43]; sol[62] -= b1d.z * sol[43]; sol[63] -= b1d.w * sol[43];
  __builtin_amdgcn_sched_barrier(0);
  b1a = *(const float4*)(Lr + 2912); b1b = *(const float4*)(Lr + 2916); b1c = *(const float4*)(Lr + 2920); b1d = *(const float4*)(Lr + 2924);
  __builtin_amdgcn_sched_barrier(0);
  sol[45] -= b2d.y * sol[44]; sol[46] -= b2d.z * sol[44]; sol[47] -= b2d.w * sol[44];
  __builtin_amdgcn_sched_barrier(0);
  b2a = *(const float4*)(Lr + 2928); b2b = *(const float4*)(Lr + 2932); b2c = *(const float4*)(Lr + 2936); b2d = *(const float4*)(Lr + 2940);
  __builtin_amdgcn_sched_barrier(0);
  sol[48] -= b0a.x * sol[44]; sol[49] -= b0a.y * sol[44]; sol[50] -= b0a.z * sol[44]; sol[51] -= b0a.w * sol[44]; sol[52] -= b0b.x * sol[44]; sol[53] -= b0b.y * sol[44]; sol[54] -= b0b.z * sol[44]; sol[55] -= b0b.w * sol[44]; sol[56] -= b0c.x * sol[44]; sol[57] -= b0c.y * sol[44]; sol[58] -= b0c.z * sol[44]; sol[59] -= b0c.w * sol[44]; sol[60] -= b0d.x * sol[44]; sol[61] -= b0d.y * sol[44]; sol[62] -= b0d.z * sol[44]; sol[63] -= b0d.w * sol[44];
  __builtin_amdgcn_sched_barrier(0);
  b0a = *(const float4*)(Lr + 2976); b0b = *(const float4*)(Lr + 2980); b0c = *(const float4*)(Lr + 2984); b0d = *(const float4*)(Lr + 2988);
  __builtin_amdgcn_sched_barrier(0);
  sol[46] -= b1d.z * sol[45]; sol[47] -= b1d.w * sol[45];
  __builtin_amdgcn_sched_barrier(0);
  b1a = *(const float4*)(Lr + 2992); b1b = *(const float4*)(Lr + 2996); b1c = *(const float4*)(Lr + 3000); b1d = *(const float4*)(Lr + 3004);
  __builtin_amdgcn_sched_barrier(0);
  sol[48] -= b2a.x * sol[45]; sol[49] -= b2a.y * sol[45]; sol[50] -= b2a.z * sol[45]; sol[51] -= b2a.w * sol[45]; sol[52] -= b2b.x * sol[45]; sol[53] -= b2b.y * sol[45]; sol[54] -= b2b.z * sol[45]; sol[55] -= b2b.w * sol[45]; sol[56] -= b2c.x * sol[45]; sol[57] -= b2c.y * sol[45]; sol[58] -= b2c.z * sol[45]; sol[59] -= b2c.w * sol[45]; sol[60] -= b2d.x * sol[45]; sol[61] -= b2d.y * sol[45]; sol[62] -= b2d.z * sol[45]; sol[63] -= b2d.w * sol[45];
  __builtin_amdgcn_sched_barrier(0);
  b2a = *(const float4*)(Lr + 3056); b2b = *(const float4*)(Lr + 3060); b2c = *(const float4*)(Lr + 3064); b2d = *(const float4*)(Lr + 3068);
  __builtin_amdgcn_sched_barrier(0);
  sol[47] -= b0d.w * sol[46];
  __builtin_amdgcn_sched_barrier(0);
  b0a = *(const float4*)(Lr + 3120); b0b = *(const float4*)(Lr + 3124); b0c = *(const float4*)(Lr + 3128); b0d = *(const float4*)(Lr + 3132);
  __builtin_amdgcn_sched_barrier(0);
  sol[48] -= b1a.x * sol[46]; sol[49] -= b1a.y * sol[46]; sol[50] -= b1a.z * sol[46]; sol[51] -= b1a.w * sol[46]; sol[52] -= b1b.x * sol[46]; sol[53] -= b1b.y * sol[46]; sol[54] -= b1b.z * sol[46]; sol[55] -= b1b.w * sol[46]; sol[56] -= b1c.x * sol[46]; sol[57] -= b1c.y * sol[46]; sol[58] -= b1c.z * sol[46]; sol[59] -= b1c.w * sol[46]; sol[60] -= b1d.x * sol[46]; sol[61] -= b1d.y * sol[46]; sol[62] -= b1d.z * sol[46]; sol[63] -= b1d.w * sol[46];
  __builtin_amdgcn_sched_barrier(0);
  b1a = *(const float4*)(Lr + 3184); b1b = *(const float4*)(Lr + 3188); b1c = *(const float4*)(Lr + 3192); b1d = *(const float4*)(Lr + 3196);
  __builtin_amdgcn_sched_barrier(0);
  sol[48] -= b2a.x * sol[47]; sol[49] -= b2a.y * sol[47]; sol[50] -= b2a.z * sol[47]; sol[51] -= b2a.w * sol[47]; sol[52] -= b2b.x * sol[47]; sol[53] -= b2b.y * sol[47]; sol[54] -= b2b.z * sol[47]; sol[55] -= b2b.w * sol[47]; sol[56] -= b2c.x * sol[47]; sol[57] -= b2c.y * sol[47]; sol[58] -= b2c.z * sol[47]; sol[59] -= b2c.w * sol[47]; sol[60] -= b2d.x * sol[47]; sol[61] -= b2d.y * sol[47]; sol[62] -= b2d.z * sol[47]; sol[63] -= b2d.w * sol[47];
  __builtin_amdgcn_sched_barrier(0);
  b2a = *(const float4*)(Lr + 3248); b2b = *(const float4*)(Lr + 3252); b2c = *(const float4*)(Lr + 3256); b2d = *(const float4*)(Lr + 3260);
  __builtin_amdgcn_sched_barrier(0);
  sol[49] -= b0a.y * sol[48]; sol[50] -= b0a.z * sol[48]; sol[51] -= b0a.w * sol[48]; sol[52] -= b0b.x * sol[48]; sol[53] -= b0b.y * sol[48]; sol[54] -= b0b.z * sol[48]; sol[55] -= b0b.w * sol[48]; sol[56] -= b0c.x * sol[48]; sol[57] -= b0c.y * sol[48]; sol[58] -= b0c.z * sol[48]; sol[59] -= b0c.w * sol[48]; sol[60] -= b0d.x * sol[48]; sol[61] -= b0d.y * sol[48]; sol[62] -= b0d.z * sol[48]; sol[63] -= b0d.w * sol[48];
  __builtin_amdgcn_sched_barrier(0);
  b0a = *(const float4*)(Lr + 3312); b0b = *(const float4*)(Lr + 3316); b0c = *(const float4*)(Lr + 3320); b0d = *(const float4*)(Lr + 3324);
  __builtin_amdgcn_sched_barrier(0);
  sol[50] -= b1a.z * sol[49]; sol[51] -= b1a.w * sol[49]; sol[52] -= b1b.x * sol[49]; sol[53] -= b1b.y * sol[49]; sol[54] -= b1b.z * sol[49]; sol[55] -= b1b.w * sol[49]; sol[56] -= b1c.x * sol[49]; sol[57] -= b1c.y * sol[49]; sol[58] -= b1c.z * sol[49]; sol[59] -= b1c.w * sol[49]; sol[60] -= b1d.x * sol[49]; sol[61] -= b1d.y * sol[49]; sol[62] -= b1d.z * sol[49]; sol[63] -= b1d.w * sol[49];
  __builtin_amdgcn_sched_barrier(0);
  b1a = *(const float4*)(Lr + 3376); b1b = *(const float4*)(Lr + 3380); b1c = *(const float4*)(Lr + 3384); b1d = *(const float4*)(Lr + 3388);
  __builtin_amdgcn_sched_barrier(0);
  sol[51] -= b2a.w * sol[50]; sol[52] -= b2b.x * sol[50]; sol[53] -= b2b.y * sol[50]; sol[54] -= b2b.z * sol[50]; sol[55] -= b2b.w * sol[50]; sol[56] -= b2c.x * sol[50]; sol[57] -= b2c.y * sol[50]; sol[58] -= b2c.z * sol[50]; sol[59] -= b2c.w * sol[50]; sol[60] -= b2d.x * sol[50]; sol[61] -= b2d.y * sol[50]; sol[62] -= b2d.z * sol[50]; sol[63] -= b2d.w * sol[50];
  __builtin_amdgcn_sched_barrier(0);
  b2a = *(const float4*)(Lr + 3440); b2b = *(const float4*)(Lr + 3444); b2c = *(const float4*)(Lr + 3448); b2d = *(const float4*)(Lr + 3452);
  __builtin_amdgcn_sched_barrier(0);
  sol[52] -= b0b.x * sol[51]; sol[53] -= b0b.y * sol[51]; sol[54] -= b0b.z * sol[51]; sol[55] -= b0b.w * sol[51]; sol[56] -= b0c.x * sol[51]; sol[57] -= b0c.y * sol[51]; sol[58] -= b0c.z * sol[51]; sol[59] -= b0c.w * sol[51]; sol[60] -= b0d.x * sol[51]; sol[61] -= b0d.y * sol[51]; sol[62] -= b0d.z * sol[51]; sol[63] -= b0d.w * sol[51];
  __builtin_amdgcn_sched_barrier(0);
  b0a = *(const float4*)(Lr + 3504); b0b = *(const float4*)(Lr + 3508); b0c = *(const float4*)(Lr + 3512); b0d = *(const float4*)(Lr + 3516);
  __builtin_amdgcn_sched_barrier(0);
  sol[53] -= b1b.y * sol[52]; sol[54] -= b1b.z * sol[52]; sol[55] -= b1b.w * sol[52]; sol[56] -= b1c.x * sol[52]; sol[57] -= b1c.y * sol[52]; sol[58] -= b1c.z * sol[52]; sol[59] -= b1c.w * sol[52]; sol[60] -= b1d.x * sol[52]; sol[61] -= b1d.y * sol[52]; sol[62] -= b1d.z * sol[52]; sol[63] -= b1d.w * sol[52];
  __builtin_amdgcn_sched_barrier(0);
  b1a = *(const float4*)(Lr + 3568); b1b = *(const float4*)(Lr + 3572); b1c = *(const float4*)(Lr + 3576); b1d = *(const float4*)(Lr + 3580);
  __builtin_amdgcn_sched_barrier(0);
  sol[54] -= b2b.z * sol[53]; sol[55] -= b2b.w * sol[53]; sol[56] -= b2c.x * sol[53]; sol[57] -= b2c.y * sol[53]; sol[58] -= b2c.z * sol[53]; sol[59] -= b2c.w * sol[53]; sol[60] -= b2d.x * sol[53]; sol[61] -= b2d.y * sol[53]; sol[62] -= b2d.z * sol[53]; sol[63] -= b2d.w * sol[53];
  __builtin_amdgcn_sched_barrier(0);
  b2a = *(const float4*)(Lr + 3632); b2b = *(const float4*)(Lr + 3636); b2c = *(const float4*)(Lr + 3640); b2d = *(const float4*)(Lr + 3644);
  __builtin_amdgcn_sched_barrier(0);
  sol[55] -= b0b.w * sol[54]; sol[56] -= b0c.x * sol[54]; sol[57] -= b0c.y * sol[54]; sol[58] -= b0c.z * sol[54]; sol[59] -= b0c.w * sol[54]; sol[60] -= b0d.x * sol[54]; sol[61] -= b0d.y * sol[54]; sol[62] -= b0d.z * sol[54]; sol[63] -= b0d.w * sol[54];
  __builtin_amdgcn_sched_barrier(0);
  b0a = *(const float4*)(Lr + 3696); b0b = *(const float4*)(Lr + 3700); b0c = *(const float4*)(Lr + 3704); b0d = *(const float4*)(Lr + 3708);
  __builtin_amdgcn_sched_barrier(0);
  sol[56] -= b1c.x * sol[55]; sol[57] -= b1c.y * sol[55]; sol[58] -= b1c.z * sol[55]; sol[59] -= b1c.w * sol[55]; sol[60] -= b1d.x * sol[55]; sol[61] -= b1d.y * sol[55]; sol[62] -= b1d.z * sol[55]; sol[63] -= b1d.w * sol[55];
  __builtin_amdgcn_sched_barrier(0);
  b1a = *(const float4*)(Lr + 3760); b1b = *(const float4*)(Lr + 3764); b1c = *(const float4*)(Lr + 3768); b1d = *(const float4*)(Lr + 3772);
  __builtin_amdgcn_sched_barrier(0);
  sol[57] -= b2c.y * sol[56]; sol[58] -= b2c.z * sol[56]; sol[59] -= b2c.w * sol[56]; sol[60] -= b2d.x * sol[56]; sol[61] -= b2d.y * sol[56]; sol[62] -= b2d.z * sol[56]; sol[63] -= b2d.w * sol[56];
  __builtin_amdgcn_sched_barrier(0);
  b2a = *(const float4*)(Lr + 3824); b2b = *(const float4*)(Lr + 3828); b2c = *(const float4*)(Lr + 3832); b2d = *(const float4*)(Lr + 3836);
  __builtin_amdgcn_sched_barrier(0);
  sol[58] -= b0c.z * sol[57]; sol[59] -= b0c.w * sol[57]; sol[60] -= b0d.x * sol[57]; sol[61] -= b0d.y * sol[57]; sol[62] -= b0d.z * sol[57]; sol[63] -= b0d.w * sol[57];
  __builtin_amdgcn_sched_barrier(0);
  b0a = *(const float4*)(Lr + 3888); b0b = *(const float4*)(Lr + 3892); b0c = *(const float4*)(Lr + 3896); b0d = *(const float4*)(Lr + 3900);
  __builtin_amdgcn_sched_barrier(0);
  sol[59] -= b1c.w * sol[58]; sol[60] -= b1d.x * sol[58]; sol[61] -= b1d.y * sol[58]; sol[62] -= b1d.z * sol[58]; sol[63] -= b1d.w * sol[58];
  __builtin_amdgcn_sched_barrier(0);
  b1a = *(const float4*)(Lr + 3952); b1b = *(const float4*)(Lr + 3956); b1c = *(const float4*)(Lr + 3960); b1d = *(const float4*)(Lr + 3964);
  __builtin_amdgcn_sched_barrier(0);
  sol[60] -= b2d.x * sol[59]; sol[61] -= b2d.y * sol[59]; sol[62] -= b2d.z * sol[59]; sol[63] -= b2d.w * sol[59];
  __builtin_amdgcn_sched_barrier(0);
  b2a = *(const float4*)(Lr + 4016); b2b = *(const float4*)(Lr + 4020); b2c = *(const float4*)(Lr + 4024); b2d = *(const float4*)(Lr + 4028);
  __builtin_amdgcn_sched_barrier(0);
  sol[61] -= b0d.y * sol[60]; sol[62] -= b0d.z * sol[60]; sol[63] -= b0d.w * sol[60];
  __builtin_amdgcn_sched_barrier(0);
  __builtin_amdgcn_sched_barrier(0);
  sol[62] -= b1d.z * sol[61]; sol[63] -= b1d.w * sol[61];
  __builtin_amdgcn_sched_barrier(0);
  __builtin_amdgcn_sched_barrier(0);
  sol[63] -= b2d.w * sol[62];
  __builtin_amdgcn_sched_barrier(0);
}

template <int DIR>
__device__ __forceinline__ void solve_cols(const Params& P, int itb, int c, const float* Lt, const float* bpp, const float* gcp,
                                           const u16* Vs, const u16* Ks) {
  float sol[64];
  const float* bp_ = bpp + DIR * 64;
  const float* gc_ = gcp + DIR * 64;
  if (c < 128) {
    const u16* vp = Vs + c;
#pragma unroll
    for (int p = 0; p < 64; ++p) sol[p] = bp_[p] * bf2f(vp[(DIR ? (63 - p) : p) * 136]);
  } else {
    const u16* kp = Ks + (c - 128);
#pragma unroll
    for (int p = 0; p < 64; ++p) sol[p] = bp_[p] * __expf(gc_[p]) * bf2f(kp[(DIR ? (63 - p) : p) * 136]);
  }
  const float* Lr = Lt + opq(DIR * 4096);
  solve_elim(sol, Lr);
  const size_t it2 = (size_t)(itb + DIR);
  if (c < 128) {
    u16* UF = (u16*)(P.ws + OFF_UF) + (it2 * 128 + c) * 64;
#pragma unroll
    for (int q = 0; q < 8; ++q) *(uint4*)(UF + q * 8) = pack8(sol + q * 8);
  } else {
    u16* Wg = (u16*)(P.ws + OFF_R2) + it2 * 8192 + (c - 128);
#pragma unroll
    for (int p = 0; p < 64; ++p) Wg[p * 128] = f2bf(-sol[p]);
  }
}

__device__ __forceinline__ void delta_prep_item(const Params& P, int item, char* lds) {
  const int tid = opq(threadIdx.x), lane = tid & 63, wv = tid >> 6, fr = lane & 15, fq = lane >> 4;
  const int cid = item >> 2, h = item & 3;
  const int row0 = cid * 64;
  int seq_lo, seq_hi;
  if (cid < 256) { seq_lo = (cid >> 6) * 4096; seq_hi = seq_lo + 4096; }
  else { seq_lo = 16384 + ((cid - 256) >> 2) * 256; seq_hi = seq_lo + 256; }
  u16* Qs = (u16*)(lds + opq(0));
  u16* Ks = (u16*)(lds + opq(17408));
  u16* Vs = (u16*)(lds + opq(34816));
  float* KKs = (float*)(lds + opq(52224));
  float* QKs = (float*)(lds + opq(69632));
  float* Lt = (float*)(lds + opq(87040));
  float* gtok = (float*)(lds + opq(119808));
  float* btok = gtok + 128;
  float* gcp = btok + 128;
  float* bpp = gcp + 128;
  u16* QKN = (u16*)((char*)P.out + OFF_QKN);
  lds_barrier();
  {
    const int j = tid >> 3, sg = tid & 7;
    const int row = row0 + j;
    const bool hm = (row - 1 >= seq_lo), hp = (row + 1 < seq_hi);
    const u16* qkv = (const u16*)(P.ws + OFF_R3);
#pragma unroll
    for (int s = 0; s < 3; ++s) {
      const int col = s * 512 + h * 128 + sg * 16;
      const u16* p0 = qkv + (size_t)row * 1536 + col;
      float y[16];
      float ssq = 0.f;
#pragma unroll
      for (int hh = 0; hh < 2; ++hh) {
        const uint4 c0 = *(const uint4*)(p0 + hh * 8);
        uint4 m0 = *(const uint4*)(p0 - (hm ? 1536 : 0) + hh * 8);
        uint4 n0 = *(const uint4*)(p0 + (hp ? 1536 : 0) + hh * 8);
        m0.x = hm ? m0.x : 0u; m0.y = hm ? m0.y : 0u; m0.z = hm ? m0.z : 0u; m0.w = hm ? m0.w : 0u;
        n0.x = hp ? n0.x : 0u; n0.y = hp ? n0.y : 0u; n0.z = hp ? n0.z : 0u; n0.w = hp ? n0.w : 0u;
        float fc[8], fm[8], fn[8];
        unpack8(c0, fc); unpack8(m0, fm); unpack8(n0, fn);
        const float* cwp = P.dn_conv_w + col + hh * 8;
        float cw0[8], cw1[8], cw2[8];
        {
          const float4 t0 = *(const float4*)(cwp), t1 = *(const float4*)(cwp + 4);
          const float4 t2 = *(const float4*)(cwp + 1536), t3 = *(const float4*)(cwp + 1540);
          const float4 t4 = *(const float4*)(cwp + 3072), t5 = *(const float4*)(cwp + 3076);
          cw0[0] = t0.x; cw0[1] = t0.y; cw0[2] = t0.z; cw0[3] = t0.w; cw0[4] = t1.x; cw0[5] = t1.y; cw0[6] = t1.z; cw0[7] = t1.w;
          cw1[0] = t2.x; cw1[1] = t2.y; cw1[2] = t2.z; cw1[3] = t2.w; cw1[4] = t3.x; cw1[5] = t3.y; cw1[6] = t3.z; cw1[7] = t3.w;
          cw2[0] = t4.x; cw2[1] = t4.y; cw2[2] = t4.z; cw2[3] = t4.w; cw2[4] = t5.x; cw2[5] = t5.y; cw2[6] = t5.z; cw2[7] = t5.w;
        }
#pragma unroll
        for (int e = 0; e < 8; ++e) {
          const float v = cw0[e] * fm[e] + cw1[e] * fc[e] + cw2[e] * fn[e];
          const float yy = v * sigm(v);
          y[hh * 8 + e] = yy;
          ssq += yy * yy;
        }
      }
      if (s < 2) {
        ssq += __shfl_xor(ssq, 1, 64); ssq += __shfl_xor(ssq, 2, 64); ssq += __shfl_xor(ssq, 4, 64);
        const float sc = rsqrtf(ssq + 1e-6f) * ((s == 0) ? 0.08838834764831845f : 1.f);
#pragma unroll
        for (int e = 0; e < 16; ++e) y[e] *= sc;
      }
      u16* dl = ((s == 0) ? Qs : ((s == 1) ? Ks : Vs)) + j * 136 + sg * 16;
      const uint4 o0 = pack8(y), o1 = pack8(y + 8);
      *(uint4*)dl = o0; *(uint4*)(dl + 8) = o1;
      if (s < 2) {
        u16* dg = QKN + (size_t)row * 1024 + s * 512 + h * 128 + sg * 16;
        *(uint4*)dg = o0; *(uint4*)(dg + 8) = o1;
      }
    }
  }
  if (tid < 128) {
    const int j = tid & 63, dir = tid >> 6;
    const float* BA = (const float*)(P.ws + OFF_BA) + (size_t)(row0 + j) * 16;
    const float bl = BA[dir * 4 + h], al = BA[8 + dir * 4 + h];
    const float xx = al + P.dn_dt_bias[dir * 4 + h];
    const float sp = (xx > 20.f) ? xx : log1pf(expf(xx));
    gtok[dir * 64 + j] = -expf(P.dn_a_log[dir * 4 + h]) * sp;
    btok[dir * 64 + j] = 1.f / (1.f + expf(-bl));
  }
  lds_barrier();
  if (tid < 128) {
    const int dir = tid >> 6, p = tid & 63;
    const int tk = dir ? (63 - p) : p;
    float a = gtok[dir * 64 + tk];
    const float bv = btok[dir * 64 + tk];
#pragma unroll
    for (int o = 1; o < 64; o <<= 1) {
      const float t = __shfl_up(a, o, 64);
      if (p >= o) a += t;
    }
    gcp[dir * 64 + p] = a;
    bpp[dir * 64 + p] = bv;
  }
  {
#pragma unroll
    for (int q = 0; q < 4; ++q) {
      const int t = wv * 4 + q;
      const int which = t >> 4, mi = (t >> 2) & 3, ni = t & 3;
      const u16* Am = (which ? Qs : Ks) + (mi * 16 + fr) * 136 + fq * 8;
      const u16* Bm = Ks + (ni * 16 + fr) * 136 + fq * 8;
      f32x4 a4 = {0.f, 0.f, 0.f, 0.f};
#pragma unroll
      for (int kk = 0; kk < 4; ++kk)
        a4 = __builtin_amdgcn_mfma_f32_16x16x32_bf16(*(const bf16x8*)(Am + kk * 32), *(const bf16x8*)(Bm + kk * 32), a4, 0, 0, 0);
      float* dst = which ? QKs : KKs;
#pragma unroll
      for (int e = 0; e < 4; ++e) dst[(mi * 16 + fq * 4 + e) * 68 + ni * 16 + fr] = a4[e];
    }
  }
  lds_barrier();
  const int itb = item * 2;
  {
    u16* AQ = (u16*)((char*)P.out + OFF_AQ);
#pragma unroll 8
    for (int idx = tid; idx < 8192; idx += NT) {
      const int dir = idx >> 12, p = (idx >> 6) & 63, s = idx & 63;
      const int tp = dir ? (63 - p) : p, ts = dir ? (63 - s) : s;
      const float dg = gcp[dir * 64 + p] - gcp[dir * 64 + s];
      const float dec = (p >= s) ? __expf(dg) : 0.f;
      AQ[((size_t)(itb + dir) * 64 + p) * 64 + s] = f2bf(QKs[tp * 68 + ts] * dec);
    }
#pragma unroll 8
    for (int idx = tid; idx < 8192; idx += NT) {
      const int dir = idx >> 12, s = (idx >> 6) & 63, p = idx & 63;
      const int tp = dir ? (63 - p) : p, ts = dir ? (63 - s) : s;
      const float dg = gcp[dir * 64 + p] - gcp[dir * 64 + s];
      const float lv = (p > s) ? bpp[dir * 64 + p] * KKs[ts * 68 + tp] * __expf(dg) : 0.f;
      Lt[dir * 4096 + s * 64 + p] = lv;
    }
    if (tid < 128) {
      float* GC = (float*)(P.ws + OFF_GC);
      GC[(size_t)(itb + (tid >> 6)) * 64 + (tid & 63)] = gcp[tid];
    }
  }
  lds_barrier();
  if (tid < 256) solve_cols<0>(P, itb, tid, Lt, bpp, gcp, Vs, Ks);
  else solve_cols<1>(P, itb, tid - 256, Lt, bpp, gcp, Vs, Ks);
}

__device__ __forceinline__ void s5end_tile(const Params& P, int t, char* lds) {
  const int g = t / 6, mt = (t % 6) >> 1, nt = t & 1;
  const int m0 = mt * 256, n0 = nt * 128;
  f32x16 acc[2][2];
  acc_zero(acc);
  gemm_main((const u16*)(P.ws + OFF_U5) + ((size_t)g * 544 + m0) * 512, 512,
            (const u16*)(P.ws + OFF_MEND) + ((size_t)g * 256 + n0) * 512, 512, 512, acc, (u16*)lds);
  TILE_COORDS
  float* E = (float*)(P.ws + OFF_E);
#pragma unroll
  for (int i = 0; i < 2; ++i)
#pragma unroll
    for (int j = 0; j < 2; ++j)
#pragma unroll
      for (int e = 0; e < 16; ++e) {
        const int row = TROW(m0, i, e);
        if (row < 544) E[((size_t)g * 544 + row) * 256 + TCOL(n0, j)] = acc[i][j][e];
      }
}

__device__ __forceinline__ void scan_chunk(const u16* Wl, const u16* QTl, const u16* KTl, const u16* AQl, u16* ST, u16* VT,
                                           int wd, int wq, int fr, int fq, float gl, f32x4& av, f32x4& ao, f32x4& accS0, f32x4& accS1) {
  {
    bf16x8 bS[4], a1[4], a2[4];
#pragma unroll
    for (int kk = 0; kk < 4; ++kk) {
      bS[kk] = *(const bf16x8*)(ST + (wd * 16 + fr) * 136 + kk * 32 + fq * 8);
      a1[kk] = *(const bf16x8*)(Wl + (wq * 16 + fr) * 136 + kk * 32 + fq * 8);
      a2[kk] = *(const bf16x8*)(QTl + (wq * 16 + fr) * 136 + kk * 32 + fq * 8);
    }
    __builtin_amdgcn_sched_barrier(0);
#pragma unroll
    for (int kk = 0; kk < 4; ++kk) {
      av = __builtin_amdgcn_mfma_f32_16x16x32_bf16(a1[kk], bS[kk], av, 0, 0, 0);
      ao = __builtin_amdgcn_mfma_f32_16x16x32_bf16(a2[kk], bS[kk], ao, 0, 0, 0);
    }
  }
  {
    uint2 v; v.x = pack2(av[0], av[1]); v.y = pack2(av[2], av[3]);
    *(uint2*)(VT + (wd * 16 + fr) * 72 + wq * 16 + fq * 4) = v;
  }
  bf16x8 qa[2], k0[2], k1[2];
#pragma unroll
  for (int ks = 0; ks < 2; ++ks) {
    qa[ks] = *(const bf16x8*)(AQl + (wq * 16 + fr) * 72 + ks * 32 + fq * 8);
    const int r0_ = (2 * wq) * 16 + fr, r1_ = (2 * wq + 1) * 16 + fr;
    k0[ks] = *(const bf16x8*)(KTl + r0_ * 72 + ((ks * 32 + fq * 8) ^ (((r0_ >> 3) & 7) << 3)));
    k1[ks] = *(const bf16x8*)(KTl + r1_ * 72 + ((ks * 32 + fq * 8) ^ (((r1_ >> 3) & 7) << 3)));
  }
  accS0[0] *= gl; accS0[1] *= gl; accS0[2] *= gl; accS0[3] *= gl;
  accS1[0] *= gl; accS1[1] *= gl; accS1[2] *= gl; accS1[3] *= gl;
  lds_barrier();
  {
    bf16x8 bV[2];
#pragma unroll
    for (int ks = 0; ks < 2; ++ks) bV[ks] = *(const bf16x8*)(VT + (wd * 16 + fr) * 72 + ks * 32 + fq * 8);
#pragma unroll
    for (int ks = 0; ks < 2; ++ks) {
      ao = __builtin_amdgcn_mfma_f32_16x16x32_bf16(qa[ks], bV[ks], ao, 0, 0, 0);
      accS0 = __builtin_amdgcn_mfma_f32_16x16x32_bf16(k0[ks], bV[ks], accS0, 0, 0, 0);
      accS1 = __builtin_amdgcn_mfma_f32_16x16x32_bf16(k1[ks], bV[ks], accS1, 0, 0, 0);
    }
  }
  {
    uint2 v; v.x = pack2(accS0[0], accS0[1]); v.y = pack2(accS0[2], accS0[3]);
    *(uint2*)(ST + (wd * 16 + fr) * 136 + (2 * wq) * 16 + fq * 4) = v;
    v.x = pack2(accS1[0], accS1[1]); v.y = pack2(accS1[2], accS1[3]);
    *(uint2*)(ST + (wd * 16 + fr) * 136 + (2 * wq + 1) * 16 + fq * 4) = v;
  }
}

__device__ __forceinline__ void delta_scan_block(const Params& P, int sb, char* lds) {
  const int tid = opq(threadIdx.x), lane = tid & 63, w = tid >> 6, fr = lane & 15, fq = lane >> 4;
  const int bhd = sb & 31, dvq = sb >> 5;
  const int b = bhd >> 3, h = (bhd >> 1) & 3, dir = bhd & 1;
  const int wd = w & 1, wq = w >> 1;
  const int dv0 = dvq * 32 + wd * 16;
  u16* Wl = (u16*)(lds + opq(0));
  u16* QTl = (u16*)(lds + opq(17408));
  u16* KTl = (u16*)(lds + opq(34816));
  u16* AQl = (u16*)(lds + opq(53248));
  u16* ST = (u16*)(lds + opq(62464));
  u16* VT = (u16*)(lds + opq(71168));
  lds_barrier();
  for (int i = tid; i < 32 * 136 / 2; i += NT) ((uint32_t*)ST)[i] = 0u;
  f32x4 accS0 = {0.f, 0.f, 0.f, 0.f}, accS1 = {0.f, 0.f, 0.f, 0.f};
  const u16* QKN = (const u16*)((const char*)P.out + OFF_QKN);
  const u16* AQg = (const u16*)((const char*)P.out + OFF_AQ);
  const u16* Wg = (const u16*)(P.ws + OFF_R2);
  const u16* UFg = (const u16*)(P.ws + OFF_UF);
  const float* GC = (const float*)(P.ws + OFF_GC);
  u16* Og = (u16*)(P.ws + OFF_O);

#define GLD16(dst, ptr) asm volatile("global_load_dwordx4 %0, %1, off" : "=v"(dst) : "v"(ptr) : "memory")
#define GLD8(dst, ptr) asm volatile("global_load_dwordx2 %0, %1, off" : "=v"(dst) : "v"(ptr) : "memory")
#define GLD4(dst, ptr) asm volatile("global_load_dword %0, %1, off" : "=v"(dst) : "v"(ptr) : "memory")
#define SC_DECL(S)                                                   \
  u32x4 S##w0, S##w1, S##q0, S##q1, S##k0, S##k1, S##a;              \
  float S##gq0, S##gq1, S##g63;                                      \
  u32x2 S##u;                                                        \
  int S##row0 = 0, S##lat = 0;
#define SC_PF_ONE(S, i)                                                                            \
    {                                                                                              \
      const int id = tid + (i) * 512;                                                              \
      const int p = id >> 4, seg = id & 15;                                                        \
      const int tk = dir ? (63 - p) : p;                                                           \
      GLD16(S##w##i, Wg + it2__ * 8192 + p * 128 + seg * 8);                                       \
      GLD16(S##q##i, QKN + (size_t)(S##row0 + tk) * 1024 + h * 128 + seg * 8);                     \
      GLD4(S##gq##i, GC + it2__ * 64 + p);                                                         \
      GLD16(S##k##i, QKN + (size_t)(S##row0 + tk) * 1024 + 512 + h * 128 + seg * 8);               \
    }
#define SC_PREFETCH(S, n_)                                                                         \
  {                                                                                                \
    const int n__ = (n_);                                                                          \
    int cid__;                                                                                     \
    if (n__ < 4) { cid__ = 256 + b * 4 + (dir ? (3 - n__) : n__); S##lat = 0; }                    \
    else { const int m__ = n__ - 4; cid__ = b * 64 + (dir ? (63 - m__) : m__); S##lat = 1; }       \
    S##row0 = cid__ * 64;                                                                          \
    const size_t it2__ = (size_t)((cid__ * 4 + h) * 2 + dir);                                      \
    SC_PF_ONE(S, 0)                                                                                \
    SC_PF_ONE(S, 1)                                                                                \
    GLD4(S##g63, GC + it2__ * 64 + 63);                                                            \
    GLD16(S##a, AQg + it2__ * 4096 + (tid >> 3) * 64 + (tid & 7) * 8);                             \
    GLD8(S##u, UFg + (it2__ * 128 + dv0 + fr) * 64 + wq * 16 + fq * 4);                            \
  }
#define SC_WAIT(S, CNT)                                                                            \
  asm volatile("s_waitcnt vmcnt(" #CNT ")"                                                         \
               : "+v"(S##w0), "+v"(S##w1), "+v"(S##q0), "+v"(S##q1), "+v"(S##k0), "+v"(S##k1), "+v"(S##a), \
                 "+v"(S##gq0), "+v"(S##gq1), "+v"(S##g63), "+v"(S##u)                              \
               :: "memory");
#define SC_STAGE_ONE(S, i)                                                    \
    {                                                                         \
      const int id = tid + (i) * 512;                                         \
      const int p = id >> 4, seg = id & 15;                                   \
      *(u32x4*)(Wl + p * 136 + seg * 8) = S##w##i;                            \
      float f[8];                                                             \
      unpack8(make_uint4(S##q##i.x, S##q##i.y, S##q##i.z, S##q##i.w), f);     \
      const float sq = __expf(S##gq##i);                                      \
      f[0] *= sq; f[1] *= sq; f[2] *= sq; f[3] *= sq; f[4] *= sq; f[5] *= sq; f[6] *= sq; f[7] *= sq; \
      *(uint4*)(QTl + p * 136 + seg * 8) = pack8(f);                          \
      unpack8(make_uint4(S##k##i.x, S##k##i.y, S##k##i.z, S##k##i.w), f);     \
      const float sk = __expf(S##g63 - S##gq##i);                             \
      u16* kd = KTl + (seg * 8) * 72 + (p ^ ((seg & 7) << 3));                \
      kd[0 * 72] = f2bf(f[0] * sk); kd[1 * 72] = f2bf(f[1] * sk); kd[2 * 72] = f2bf(f[2] * sk); kd[3 * 72] = f2bf(f[3] * sk); \
      kd[4 * 72] = f2bf(f[4] * sk); kd[5 * 72] = f2bf(f[5] * sk); kd[6 * 72] = f2bf(f[6] * sk); kd[7 * 72] = f2bf(f[7] * sk); \
    }
#define SC_STEP(S, n_, WCNT, DO_PF)                                                                   \
  {                                                                                                   \
    SC_WAIT(S, WCNT)                                                                                  \
    const int cur_row0 = S##row0, cur_lat = S##lat;                                                   \
    const float gl = __expf(S##g63);                                                                  \
    SC_STAGE_ONE(S, 0)                                                                                \
    SC_STAGE_ONE(S, 1)                                                                                \
    *(u32x4*)(AQl + (tid >> 3) * 72 + (tid & 7) * 8) = S##a;                                          \
    f32x4 av = f32x4{lo16(S##u.x), hi16(S##u.x), lo16(S##u.y), hi16(S##u.y)};                         \
    f32x4 ao = f32x4{0.f, 0.f, 0.f, 0.f};                                                             \
    lds_barrier();                                                                                    \
    if (DO_PF) SC_PREFETCH(S, (n_) + 2)                                                               \
    scan_chunk(Wl, QTl, KTl, AQl, ST, VT, wd, wq, fr, fq, gl, av, ao, accS0, accS1);                  \
    if (cur_lat) {                                                                                    \
      const int p0 = wq * 16 + fq * 4;                                                                \
      u16* og = Og + ((size_t)dir * 16384 + cur_row0) * 512 + h * 128 + dv0 + fr;                     \
      og[(size_t)(dir ? (63 - (p0 + 0)) : (p0 + 0)) * 512] = f2bf(ao[0]);                             \
      og[(size_t)(dir ? (63 - (p0 + 1)) : (p0 + 1)) * 512] = f2bf(ao[1]);                             \
      og[(size_t)(dir ? (63 - (p0 + 2)) : (p0 + 2)) * 512] = f2bf(ao[2]);                             \
      og[(size_t)(dir ? (63 - (p0 + 3)) : (p0 + 3)) * 512] = f2bf(ao[3]);                             \
    }                                                                                                 \
    lds_barrier();                                                                                    \
  }
  SC_DECL(A)
  SC_DECL(B)
  SC_PREFETCH(A, 0)
  SC_PREFETCH(B, 1)
  for (int n = 0; n < 66; n += 2) {
    SC_STEP(A, n, 11, true)
    SC_STEP(B, n + 1, 11, true)
  }
  SC_STEP(A, 66, 0, false)
  SC_STEP(B, 67, 0, false)
#undef SC_DECL
#undef SC_PF_ONE
#undef SC_PREFETCH
#undef SC_WAIT
#undef SC_STAGE_ONE
#undef SC_STEP
#undef GLD16
#undef GLD8
#undef GLD4
}

__device__ __forceinline__ void s5_carry_block(const Params& P, int cb) {
  const int idx = cb * NT + opq(threadIdx.x);
  const int n = idx & 63, g = (idx >> 6) & 31, r = (idx >> 11) & 1, b = idx >> 12;
  const int rg = r * 32 + g;
  const float step = expf(P.s5_log_step[rg]);
  float lr, li;
  lam_pow(step, P.s5_a_re[rg * 64 + n], P.s5_a_im[rg * 64 + n], 32, lr, li);
  const float* __restrict__ E = (const float*)(P.ws + OFF_E) + (size_t)g * 544 * 256 + r * 128 + n;
  u16* __restrict__ XIN = (u16*)(P.ws + OFF_XIN) + (size_t)g * 512 * 256 + r * 128 + n;
  float xr = 0.f, xi = 0.f;
  {
    float er[8], ei[8];
#pragma unroll
    for (int k = 0; k < 8; ++k) {
      const int row = 512 + b * 8 + (r ? (7 - k) : k);
      er[k] = E[(size_t)row * 256]; ei[k] = E[(size_t)row * 256 + 64];
    }
#pragma unroll
    for (int k = 0; k < 8; ++k) {
      const float nr = lr * xr - li * xi + er[k], ni = lr * xi + li * xr + ei[k];
      xr = nr; xi = ni;
    }
  }
  for (int k0 = 0; k0 < 128; k0 += 8) {
    float er[8], ei[8];
#pragma unroll
    for (int k = 0; k < 8; ++k) {
      const int row = b * 128 + (r ? (127 - (k0 + k)) : (k0 + k));
      er[k] = E[(size_t)row * 256]; ei[k] = E[(size_t)row * 256 + 64];
    }
#pragma unroll
    for (int k = 0; k < 8; ++k) {
      const int row = b * 128 + (r ? (127 - (k0 + k)) : (k0 + k));
      XIN[(size_t)row * 256] = f2bf(xr);
      XIN[(size_t)row * 256 + 64] = f2bf(xi);
      const float nr = lr * xr - li * xi + er[k], ni = lr * xi + li * xr + ei[k];
      xr = nr; xi = ni;
    }
  }
}

__device__ __forceinline__ void s5out_tile(const Params& P, int t, char* lds) {
  const int g = t >> 3, mt = (t >> 2) & 1, nt = t & 3;
  const int m0 = mt * 256, n0 = nt * 128;
  f32x16 acc[2][2];
  acc_zero(acc);
  gemm_main((const u16*)(P.ws + OFF_XIN) + ((size_t)g * 512 + m0) * 256, 256,
            (const u16*)(P.ws + OFF_MST) + ((size_t)g * 512 + n0) * 256, 256, 256, acc, (u16*)lds);
  gemm_main((const u16*)(P.ws + OFF_U5) + ((size_t)g * 544 + m0) * 512, 512,
            (const u16*)(P.ws + OFF_MINTRA) + ((size_t)g * 512 + n0) * 512, 512, 512, acc, (u16*)lds);
  TILE_COORDS
  u16* YB = (u16*)(P.ws + OFF_YB);
#pragma unroll
  for (int i = 0; i < 2; ++i)
#pragma unroll
    for (int j = 0; j < 2; ++j)
#pragma unroll
      for (int e = 0; e < 16; ++e) {
        const int row = TROW(m0, i, e), nn = TCOL(n0, j);
        const int token = row * 32 + (nn >> 4);
        YB[(size_t)token * 512 + g * 16 + (nn & 15)] = f2bf(gelu_tanh(acc[i][j][e]));
      }
}

__device__ __forceinline__ void delta_post_item(const Params& P, int item) {
  const int lane = opq(threadIdx.x) & 63, w = opq(threadIdx.x) >> 6;
  const int row = item * 8 + w;
  const u16* O = (const u16*)(P.ws + OFF_O);
  const uint4 o0 = *(const uint4*)(O + (size_t)row * 512 + lane * 8);
  const uint4 o1 = *(const uint4*)(O + ((size_t)16384 + row) * 512 + lane * 8);
  const uint4 zz = *(const uint4*)((const u16*)(P.ws + OFF_Z) + (size_t)row * 512 + lane * 8);
  float a[8], bq[8], z[8];
  unpack8(o0, a); unpack8(o1, bq); unpack8(zz, z);
  float ss = 0.f;
#pragma unroll
  for (int e = 0; e < 8; ++e) { a[e] += bq[e]; ss += a[e] * a[e]; }
  ss += __shfl_xor(ss, 1, 64); ss += __shfl_xor(ss, 2, 64); ss += __shfl_xor(ss, 4, 64); ss += __shfl_xor(ss, 8, 64);
  const float rstd = rsqrtf(ss * (1.f / 128.f) + 1e-6f);
  const float* nw = P.dn_norm_w + (lane & 15) * 8;
  float y[8];
#pragma unroll
  for (int e = 0; e < 8; ++e) y[e] = a[e] * rstd * nw[e] * (z[e] * sigm(z[e]));
  *(uint4*)((u16*)(P.ws + OFF_YA) + (size_t)row * 512 + lane * 8) = pack8(y);
}

__device__ __forceinline__ void glu_tile(const Params& P, int t, char* lds) {
  const int nt = t >> 6, mt = t & 63;
  const int m0 = mt * 256, n0 = nt * 128;
  f32x16 acc[2][2];
  acc_zero(acc);
  gemm_main((const u16*)(P.ws + OFF_YB) + (size_t)m0 * 512, 512, (const u16*)(P.ws + OFF_WT_GLU) + (size_t)n0 * 512, 512, 512, acc, (u16*)lds);
  TILE_COORDS
  u16* YG = (u16*)(P.ws + OFF_YG);
  {
    const int oc = nt * 64 + wn_ * 32 + fr_;
    const float bv = P.b_glu[oc], bg = P.b_glu[512 + oc];
#pragma unroll
    for (int i = 0; i < 2; ++i)
#pragma unroll
      for (int e = 0; e < 16; ++e) {
        const float val = acc[i][0][e] + bv, gt = acc[i][1][e] + bg;
        YG[TIDX2(m0, nt * 64 + wn_ * 32, i, e, 512)] = f2bf(val * sigm(gt));
      }
  }
}

__device__ __forceinline__ void gates_tile(const Params& P, int t, char* lds) {
  const int nt = t >> 6, mt = t & 63;
  const int m0 = mt * 256, n0 = nt * 128;
  f32x16 acc[2][2];
  acc_zero(acc);
  gemm_main((const u16*)(P.ws + OFF_R2) + (size_t)m0 * 1024, 1024, (const u16*)(P.ws + OFF_WT_IN) + (size_t)(2688 + n0) * 1024, 1024, 1024, acc, (u16*)lds);
  TILE_COORDS
  u16* SG = (u16*)(P.ws + OFF_SG);
#pragma unroll
  for (int i = 0; i < 2; ++i)
#pragma unroll
    for (int j = 0; j < 2; ++j)
#pragma unroll
      for (int e = 0; e < 16; ++e) SG[TIDX(m0, n0, i, j, e, 2048)] = f2bf(sigm(acc[i][j][e]));
}

__device__ __forceinline__ void mix_tile(const Params& P, int t, char* lds) {
  const int nt = t >> 6, mt = t & 63;
  const int m0 = mt * 256, n0 = nt * 128;
  const u16* SG = (const u16*)(P.ws + OFF_SG);
  f32x16 acc[2][2];
  u16* MIX = (u16*)(P.ws + OFF_MIX);
  acc_zero(acc);
  gemm_main((const u16*)(P.ws + OFF_YA) + (size_t)m0 * 512, 512, (const u16*)(P.ws + OFF_WT_AOUT) + (size_t)n0 * 512, 512, 512, acc, (u16*)lds);
  {
    TILE_COORDS
    u16 sv[2][2][16];
#pragma unroll
    for (int i = 0; i < 2; ++i)
#pragma unroll
      for (int j = 0; j < 2; ++j)
#pragma unroll
        for (int e = 0; e < 16; ++e) sv[i][j][e] = SG[TIDX(m0, n0, i, j, e, 2048)];
#pragma unroll
    for (int i = 0; i < 2; ++i)
#pragma unroll
      for (int j = 0; j < 2; ++j)
#pragma unroll
        for (int e = 0; e < 16; ++e) MIX[TIDX(m0, n0, i, j, e, 1024)] = f2bf(bf2f(sv[i][j][e]) * acc[i][j][e]);
  }
  acc_zero(acc);
  gemm_main((const u16*)(P.ws + OFF_YG) + (size_t)m0 * 512, 512, (const u16*)(P.ws + OFF_WT_BOUT) + (size_t)n0 * 512, 512, 512, acc, (u16*)lds);
  {
    TILE_COORDS
#pragma unroll
    for (int i = 0; i < 2; ++i) {
      u16 sv[2][16], pv[2][16];
#pragma unroll
      for (int j = 0; j < 2; ++j)
#pragma unroll
        for (int e = 0; e < 16; ++e) {
          sv[j][e] = SG[TIDX(m0, n0, i, j, e, 2048) + 1024];
          pv[j][e] = MIX[TIDX(m0, n0, i, j, e, 1024)];
        }
#pragma unroll
      for (int j = 0; j < 2; ++j)
#pragma unroll
        for (int e = 0; e < 16; ++e)
          MIX[TIDX(m0, n0, i, j, e, 1024)] = f2bf(bf2f(pv[j][e]) + bf2f(sv[j][e]) * acc[i][j][e]);
    }
  }
}

__device__ __forceinline__ void wo_tile(const Params& P, int t, char* lds) {
  const int nt = t >> 6, mt = t & 63;
  const int m0 = mt * 256, n0 = nt * 128;
  f32x16 acc[2][2];
  acc_zero(acc);
  gemm_main((const u16*)(P.ws + OFF_MIX) + (size_t)m0 * 1024, 1024, (const u16*)(P.ws + OFF_WT_O) + (size_t)n0 * 1024, 1024, 1024, acc, (u16*)lds);
  TILE_COORDS
  const float* MOD = (const float*)(P.ws + OFF_MOD) + (m0 >> 12) * 6144 + 2 * 1024;
  float xv[2][2][16];
#pragma unroll
  for (int j = 0; j < 2; ++j)
#pragma unroll
    for (int i = 0; i < 2; ++i)
#pragma unroll
      for (int e = 0; e < 16; ++e) xv[i][j][e] = P.x[TIDX(m0, n0, i, j, e, 1024)];
#pragma unroll
  for (int j = 0; j < 2; ++j) {
    const int col = TCOL(n0, j);
    const float gate = MOD[col];
#pragma unroll
    for (int i = 0; i < 2; ++i)
#pragma unroll
      for (int e = 0; e < 16; ++e) P.out[TIDX(m0, n0, i, j, e, 1024)] = xv[i][j][e] + gate * acc[i][j][e];
  }
}

__device__ __forceinline__ void norm2_item(const Params& P, int item) {
  const int lane = opq(threadIdx.x) & 63, w = opq(threadIdx.x) >> 6;
  const int rowA = item * 16 + w, rowB = rowA + 8;
  const float* MA = (const float*)(P.ws + OFF_MOD) + (rowA >> 12) * 6144;
  const float* MB = (const float*)(P.ws + OFF_MOD) + (rowB >> 12) * 6144;
  u16* H = (u16*)(P.ws + OFF_R2);
  norm_row2(P.out + (size_t)rowA * 1024, P.out + (size_t)rowB * 1024, P.norm2_w, MA + 3 * 1024, MA + 4 * 1024, MB + 3 * 1024, MB + 4 * 1024,
            H + (size_t)rowA * 1024, H + (size_t)rowB * 1024, lane);
}

__device__ __forceinline__ void up_tile(const Params& P, int t, int hh, char* lds) {
  const int nt = t >> 6, mt = t & 63;
  const int m0 = mt * 256, n0 = nt * 128;
  f32x16 acc[2][2];
  acc_zero(acc);
  gemm_main((const u16*)(P.ws + OFF_R2) + (size_t)m0 * 1024, 1024,
            (const u16*)(P.ws + OFF_WT_UP) + ((size_t)hh * 2816 + n0) * 1024, 1024, 1024, acc, (u16*)lds);
  TILE_COORDS
  u16* UPH = (u16*)(P.ws + OFF_UPH);
#pragma unroll
  for (int i = 0; i < 2; ++i)
#pragma unroll
    for (int j = 0; j < 2; ++j)
#pragma unroll
      for (int e = 0; e < 16; ++e) UPH[TIDX(m0, n0, i, j, e, 2816)] = f2bf(acc[i][j][e]);
}

#define CG_LD(ci, dy)                                                                       \
    {                                                                                       \
      const int xc = x0 - 1 + (ci);                                                         \
      const bool cok = (xc >= 0) && (xc <= 63);                                             \
      const bool rok = ((dy) == 1) || ((dy) == 0 ? r0ok : r2ok);                            \
      const int yy = rok ? (y + (dy) - 1) : y;                                              \
      const u16* src = UPH + (base + (size_t)yy * 64 + (cok ? xc : x0)) * 2816 + c4;        \
      uint2 g__ = *(const uint2*)src;                                                       \
      uint2 v__ = *(const uint2*)(src + 1408);                                              \
      const bool ok = cok && rok;                                                           \
      g__.x = ok ? g__.x : 0u; g__.y = ok ? g__.y : 0u;                                     \
      v__.x = ok ? v__.x : 0u; v__.y = ok ? v__.y : 0u;                                     \
      gg[ci][dy] = g__; vv[ci][dy] = v__;                                                   \
    }
__device__ __forceinline__ void convgate_item(const Params& P, int item, int hh) {
  const int tid = opq(threadIdx.x);
  if (tid >= 352) return;
  const int xo = item & 15, y = (item >> 4) & 63, b = item >> 10;
  const int c4 = tid * 4;
  const u16* UPH = (const u16*)(P.ws + OFF_UPH);
  u16* G = (u16*)(P.ws + OFF_G);
  const size_t base = (size_t)b * 4096;
  const bool r0ok = (y > 0), r2ok = (y < 63);
  const int x0 = xo * 4;
  uint2 gg[6][3], vv[6][3];
#pragma unroll
  for (int ci = 0; ci < 6; ++ci) {
    CG_LD(ci, 0)
    CG_LD(ci, 1)
    CG_LD(ci, 2)
  }
  float wg[9][4], wv[9][4];
#pragma unroll
  for (int k = 0; k < 9; ++k) {
    const float4 a = *(const float4*)(P.ffn_conv_w + (size_t)k * 5632 + hh * 1408 + c4);
    const float4 bq = *(const float4*)(P.ffn_conv_w + (size_t)k * 5632 + 2816 + hh * 1408 + c4);
    wg[k][0] = a.x; wg[k][1] = a.y; wg[k][2] = a.z; wg[k][3] = a.w;
    wv[k][0] = bq.x; wv[k][1] = bq.y; wv[k][2] = bq.z; wv[k][3] = bq.w;
  }
#pragma unroll
  for (int xx = 0; xx < 4; ++xx) {
    float ag[4] = {0.f, 0.f, 0.f, 0.f}, av[4] = {0.f, 0.f, 0.f, 0.f};
#pragma unroll
    for (int dy = 0; dy < 3; ++dy)
#pragma unroll
      for (int dx = 0; dx < 3; ++dx) {
        const uint2 gq = gg[xx + dx][dy], vq = vv[xx + dx][dy];
        const int k = dy * 3 + dx;
        ag[0] += wg[k][0] * lo16(gq.x); ag[1] += wg[k][1] * hi16(gq.x); ag[2] += wg[k][2] * lo16(gq.y); ag[3] += wg[k][3] * hi16(gq.y);
        av[0] += wv[k][0] * lo16(vq.x); av[1] += wv[k][1] * hi16(vq.x); av[2] += wv[k][2] * lo16(vq.y); av[3] += wv[k][3] * hi16(vq.y);
      }
    uint2 o;
    o.x = pack2(ag[0] * sigm(ag[0]) * av[0], ag[1] * sigm(ag[1]) * av[1]);
    o.y = pack2(ag[2] * sigm(ag[2]) * av[2], ag[3] * sigm(ag[3]) * av[3]);
    *(uint2*)(G + (base + y * 64 + x0 + xx) * 2816 + hh * 1408 + c4) = o;
  }
}
#undef CG_LD

__device__ __forceinline__ void down_tile(const Params& P, int t, char* lds) {
  const int nt = t >> 6, mt = t & 63;
  const int m0 = mt * 256, n0 = nt * 128;
  f32x16 acc[2][2];
  acc_zero(acc);
  gemm_main((const u16*)(P.ws + OFF_G) + (size_t)m0 * 2816, 2816, (const u16*)(P.ws + OFF_WT_DOWN) + (size_t)n0 * 2816, 2816, 2816, acc, (u16*)lds);
  TILE_COORDS
  const float* MOD = (const float*)(P.ws + OFF_MOD) + (m0 >> 12) * 6144 + 5 * 1024;
  float xv[2][2][16];
#pragma unroll
  for (int j = 0; j < 2; ++j)
#pragma unroll
    for (int i = 0; i < 2; ++i)
#pragma unroll
      for (int e = 0; e < 16; ++e) xv[i][j][e] = P.out[TIDX(m0, n0, i, j, e, 1024)];
#pragma unroll
  for (int j = 0; j < 2; ++j) {
    const int col = TCOL(n0, j);
    const float gate = MOD[col];
#pragma unroll
    for (int i = 0; i < 2; ++i)
#pragma unroll
      for (int e = 0; e < 16; ++e) P.out[TIDX(m0, n0, i, j, e, 1024)] = xv[i][j][e] + gate * acc[i][j][e];
  }
}

__device__ __forceinline__ void final_item(const Params& P, int item) {
  const int lane = opq(threadIdx.x) & 63, w = opq(threadIdx.x) >> 6;
  const int row = item * 8 + w;
  float* xr = P.out + (size_t)row * 1024;
  float4 v[4];
  float ss = 0.f;
#pragma unroll
  for (int it = 0; it < 4; ++it) {
    v[it] = *(const float4*)(xr + (it * 64 + lane) * 4);
    ss += v[it].x * v[it].x + v[it].y * v[it].y + v[it].z * v[it].z + v[it].w * v[it].w;
  }
  ss = wsum64(ss);
  const float rstd = rsqrtf(ss * (1.f / 1024.f) + 1e-6f);
#pragma unroll
  for (int it = 0; it < 4; ++it) {
    const int c = (it * 64 + lane) * 4;
    const float4 w4 = *(const float4*)(P.norm_f_w + c);
    float4 o;
    o.x = v[it].x * rstd * w4.x; o.y = v[it].y * rstd * w4.y; o.z = v[it].z * rstd * w4.z; o.w = v[it].w * rstd * w4.w;
    *(float4*)(xr + c) = o;
  }
}

__device__ __forceinline__ void run_phase(const Params& P, int ph, char* lds) {
  const int bid = blockIdx.x, nb = gridDim.x;
#ifdef ONLY_PHASE
  if (ph != ONLY_PHASE) return;
#endif
  switch (ph) {
    case 0: {
      for (int it = bid; it < 984 + 192 + 2048; it += nb) {
        if (it < 296) convert_item(P.w_in, 1024, 4624, (u16*)(P.ws + OFF_WT_IN), 0, it, lds);
        else if (it < 328) convert_item(P.w_a_out, 512, 1024, (u16*)(P.ws + OFF_WT_AOUT), 1, it - 296, lds);
        else if (it < 360) convert_item(P.w_glu, 512, 1024, (u16*)(P.ws + OFF_WT_GLU), 2, it - 328, lds);
        else if (it < 392) convert_item(P.w_b_out, 512, 1024, (u16*)(P.ws + OFF_WT_BOUT), 3, it - 360, lds);
        else if (it < 456) convert_item(P.w_o, 1024, 1024, (u16*)(P.ws + OFF_WT_O), 4, it - 392, lds);
        else if (it < 808) convert_item(P.w_up, 1024, 5632, (u16*)(P.ws + OFF_WT_UP), 5, it - 456, lds);
        else if (it < 984) convert_item(P.w_down, 2816, 1024, (u16*)(P.ws + OFF_WT_DOWN), 6, it - 808, lds);
        else if (it < 1176) mod_item(P, it - 984, lds);
        else s5tab_item(P, it - 1176, lds);
      }
    } break;
    case 1:
      for (int it = bid; it < 1088 + 2048; it += nb) {
        if (it < 1088) norm1_item(P, it); else mintra_item(P, it - 1088);
      }
      break;
    case 2:
      for (int it = bid; it < 1396; it += nb) inproj_tile(P, it, lds);
      break;
    case 3:
      for (int it = bid; it < 1088 + 192; it += nb) {
        if (it < 1088) delta_prep_item(P, it, lds); else s5end_tile(P, it - 1088, lds);
      }
      break;
    case 4:
      if (bid < 128) delta_scan_block(P, bid, lds);
      else if (bid < 160) s5_carry_block(P, bid - 128);
      break;
    case 5:
      for (int it = bid; it < 256 + 2048 + 1024; it += nb) {
        if (it < 256) s5out_tile(P, it, lds);
        else if (it < 2304) delta_post_item(P, it - 256);
        else norm1_item(P, it - 2304);
      }
      break;
    case 6:
      for (int it = bid; it < 512 + 1024; it += nb) {
        if (it < 512) glu_tile(P, it, lds); else gates_tile(P, it - 512, lds);
      }
      break;
    case 7:
      for (int it = bid; it < 512; it += nb) mix_tile(P, it, lds);
      break;
    case 8:
      for (int it = bid; it < 512; it += nb) wo_tile(P, it, lds);
      break;
    case 9:
      for (int it = bid; it < 1024; it += nb) norm2_item(P, it);
      break;
    case 10:
      for (int it = bid; it < 1408; it += nb) up_tile(P, it, 0, lds);
      break;
    case 11:
      for (int it = bid; it < 4096; it += nb) convgate_item(P, it, 0);
      break;
    case 12:
      for (int it = bid; it < 1408; it += nb) up_tile(P, it, 1, lds);
      break;
    case 13:
      for (int it = bid; it < 4096; it += nb) convgate_item(P, it, 1);
      break;
    case 14:
      for (int it = bid; it < 512; it += nb) down_tile(P, it, lds);
      break;
    case 15:
      for (int it = bid; it < 2048; it += nb) final_item(P, it);
      break;
    default: break;
  }
}

typedef const __attribute__((address_space(4))) Params* KParamsPtr;
__global__ void __launch_bounds__(NT) fwd_megakernel(Params Pk) {
#if defined(__HIP_DEVICE_COMPILE__)
  extern __shared__ __attribute__((aligned(16))) char lds[];
  KParamsPtr pp = (KParamsPtr)__builtin_amdgcn_kernarg_segment_ptr();
  const int lo = (int)pp->ph_lo, hi = (int)pp->ph_hi;
#if MULTI_LAUNCH
  for (int ph = lo; ph < hi; ++ph) { KParamsPtr q = pp; asm volatile("" : "+s"(q)); Params P; for (int i_ = 0; i_ < (int)(sizeof(Params) / 8); ++i_) ((unsigned long long*)&P)[i_] = ((const __attribute__((address_space(4))) unsigned long long*)q)[i_]; run_phase(P, ph, lds); }
#else
  cg::grid_group grid = cg::this_grid();
  volatile LAS unsigned* xst = (volatile LAS unsigned*)(lds + (LDS_BYTES - 16));
  if (threadIdx.x == 0) { xst[0] = 0u; xst[1] = 0u; xst[2] = 0u; xst[3] = 0u; }
  __syncthreads();
  XcdBarrier xb = xcd_barrier_post((unsigned*)(pp->ws + OFF_BAR), xst);
  const unsigned rep_mask = (unsigned)pp->rep_mask;
  bool first_sync = true;
  for (int ph = lo; ph < hi; ++ph) {
    const int reps = 1 + (int)((rep_mask >> ph) & 1u);
    for (int rp = 0; rp < reps; ++rp) {
      {
        KParamsPtr q = pp;
        asm volatile("" : "+s"(q));
        Params P;
        {
          typedef __attribute__((address_space(1))) const float* GF;
          const float** dp = (const float**)&P;
          const __attribute__((address_space(4))) unsigned long long* sp = (const __attribute__((address_space(4))) unsigned long long*)q;
#pragma unroll
          for (int i_ = 0; i_ < 30; ++i_) dp[i_] = (const float*)(GF)(sp[i_]);
          P.out = (float*)(__attribute__((address_space(1))) float*)(sp[30]);
          P.ws = (char*)(__attribute__((address_space(1))) char*)(sp[31]);
          P.ph_lo = 0; P.ph_hi = 0; P.rep_mask = 0;
        }
        run_phase(P, ph, lds);
      }
      if (ph + 1 < hi || rp + 1 < reps) {
        if (first_sync) { grid.sync(); first_sync = false; }
        else xcd_barrier(xb);
      }
    }
  }
#endif
#endif
}

extern "C" void kernel_launch(void* const* d_in, const int* in_sizes, int n_in, void* d_out, int out_size, void* d_ws,
                              size_t ws_size, hipStream_t stream) {
  static int grid_blocks = 0;
  if (grid_blocks == 0) {
    if (n_in != 30 || out_size != 16384 * 1024 || ws_size < WS_NEED) {
      fprintf(stderr, "kernel_launch: unexpected shapes: n_in %d out %d ws %zu (need %zu)\n", n_in, out_size, ws_size, (size_t)WS_NEED);
      grid_blocks = -1;
      return;
    }
    int dev = 0, cus = 0, per_cu = 0;
    hipGetDevice(&dev);
    hipDeviceGetAttribute(&cus, hipDeviceAttributeMultiprocessorCount, dev);
    if (hipFuncSetAttribute((const void*)fwd_megakernel, hipFuncAttributeMaxDynamicSharedMemorySize, LDS_BYTES) != hipSuccess) {
      fprintf(stderr, "kernel_launch: hipFuncSetAttribute failed\n");
      grid_blocks = -1;
      return;
    }
    if (hipOccupancyMaxActiveBlocksPerMultiprocessor(&per_cu, (const void*)fwd_megakernel, NT, LDS_BYTES) != hipSuccess || per_cu < 1) {
      fprintf(stderr, "kernel_launch: occupancy query failed / zero (%d)\n", per_cu);
      grid_blocks = -1;
      return;
    }
    grid_blocks = cus;
    if (grid_blocks < 64) { fprintf(stderr, "kernel_launch: too few CUs (%d)\n", cus); grid_blocks = -1; return; }
  }
  if (grid_blocks < 0) return;
  (void)hipMemsetAsync((char*)d_ws + OFF_BAR, 0, XCD_BAR_WORDS * sizeof(unsigned), stream);
  Params p{};
  const float** pp = (const float**)&p;
  for (int i = 0; i < 30; ++i) pp[i] = (const float*)d_in[i];
  p.out = (float*)d_out;
  p.ws = (char*)d_ws;
#if MULTI_LAUNCH
  for (int ph = 0; ph < 16; ++ph) {
    p.ph_lo = ph; p.ph_hi = ph + 1;
    hipLaunchKernelGGL(fwd_megakernel, dim3(grid_blocks), dim3(NT), LDS_BYTES, stream, p);
  }
#else
  p.ph_lo = 0; p.ph_hi = 16;
#ifdef REPEAT_MASK
  p.rep_mask = REPEAT_MASK;
#endif
  void* args[] = {&p};
  hipError_t e = hipLaunchCooperativeKernel((const void*)fwd_megakernel, dim3(grid_blocks), dim3(NT), args, LDS_BYTES, stream);
  if (e != hipSuccess) fprintf(stderr, "cooperative launch failed: %s (grid %d)\n", hipGetErrorString(e), grid_blocks);
#endif
}
```

```cpp
#include <hip/hip_runtime.h>
#include <hip/hip_cooperative_groups.h>
#include <cstdio>
#include <cstdint>
namespace cg = cooperative_groups;

#ifndef MULTI_LAUNCH
#define MULTI_LAUNCH 0
#endif

typedef unsigned short u16;
typedef __attribute__((ext_vector_type(8))) short bf16x8;
typedef __attribute__((ext_vector_type(4))) float f32x4;
typedef __attribute__((ext_vector_type(16))) float f32x16;
typedef __attribute__((ext_vector_type(4))) unsigned int u32x4;
typedef __attribute__((ext_vector_type(2))) unsigned int u32x2;

#define NT 512
constexpr int LDS_BYTES = 131072 + 1024;
constexpr int NPHASE = 18;

constexpr size_t OFF_WT_IN   = 0;
constexpr size_t OFF_WT_AOUT = 9699328;
constexpr size_t OFF_WT_GLU  = 10747904;
constexpr size_t OFF_WT_BOUT = 11796480;
constexpr size_t OFF_WT_O    = 12845056;
constexpr size_t OFF_WT_UP   = 14942208;
constexpr size_t OFF_WT_DOWN = 26476544;
constexpr size_t OFF_MOD     = 32243712;
constexpr size_t OFF_BAR     = 32505856;
constexpr size_t OFF_R2      = 33554432;
constexpr size_t OFF_R1      = 69206016;
constexpr size_t OFF_KTAB    = OFF_R1;
constexpr size_t OFF_MEND    = OFF_R1 + 2097152;
constexpr size_t OFF_MST     = OFF_R1 + 10485760;
constexpr size_t OFF_MINTRA  = OFF_R1 + 18874368;
constexpr size_t OFF_R3      = 104857600;
constexpr size_t OFF_O       = OFF_R3;
constexpr size_t OFF_XIN     = OFF_R3 + 33554432;
constexpr size_t OFF_MIX     = 158334976;
constexpr size_t OFF_SG      = OFF_R1;
constexpr size_t OFF_Z       = 158334976;
constexpr size_t OFF_U5      = 175112192;
constexpr size_t OFF_BA      = 192937984;
constexpr size_t OFF_GC      = OFF_BA + 1179648;
constexpr size_t OFF_UF      = 195035136;
constexpr size_t OFF_YA      = OFF_UF;
constexpr size_t OFF_YB      = OFF_UF + 16777216;
constexpr size_t OFF_E       = 230686720;
constexpr size_t OFF_YG      = OFF_E;
constexpr size_t OFF_UPH     = OFF_R1;
constexpr size_t OFF_G       = 161480704;
constexpr size_t WS_NEED     = 253755392;
constexpr size_t OFF_QKN     = 0;
constexpr size_t OFF_AQ      = 35651584;

struct Params {
  const float *x, *c, *ctx, *c_ctx, *w_ada, *b_ada, *norm1_w, *w_in, *dn_conv_w, *dn_a_log, *dn_dt_bias, *dn_norm_w,
      *w_a_out, *s5_a_re, *s5_a_im, *s5_log_step, *s5_b_re, *s5_b_im, *s5_c_re, *s5_c_im, *s5_d, *w_glu, *b_glu,
      *w_b_out, *w_o, *norm2_w, *w_up, *ffn_conv_w, *w_down, *norm_f_w;
  float* out;
  char* ws;
  long long ph_lo, ph_hi;
  long long rep_mask;
};

#define XB_TMO      128
#define XB_XCNT(j)  (256  + 64 * (j))
#define XB_XSUB(j)  (1280 + 64 * (j))
#define XB_XGEN(j)  (2304 + 64 * (j))
#define XB_TOP      3328
#define XB_TOPGEN   3392
#define XCD_BAR_WORDS 3456
#define XB_SPIN_CAP (1u << 18)
#define LAS __attribute__((address_space(3)))

__device__ __forceinline__ unsigned xb_ld(unsigned* p)              { return __hip_atomic_load(p, __ATOMIC_RELAXED, __HIP_MEMORY_SCOPE_AGENT); }
__device__ __forceinline__ unsigned xb_add(unsigned* p, unsigned v) { return __hip_atomic_fetch_add(p, v, __ATOMIC_RELAXED, __HIP_MEMORY_SCOPE_AGENT); }
__device__ __forceinline__ unsigned xb_xcc_id() { return (unsigned)__builtin_amdgcn_s_getreg((3 << 11) | 20) & 0xFu; }
#define XB_SPIN(cond, bar) do { unsigned _sp = 0; while (cond) { __builtin_amdgcn_s_sleep(1); \
    if ((++_sp & 255u) == 0u) { if (xb_ld(&(bar)[XB_TMO])) break; if (_sp > XB_SPIN_CAP) { atomicAdd(&(bar)[XB_TMO], 1u); break; } } } } while (0)

struct XcdBarrier {
    unsigned* bar; unsigned x;
    volatile LAS unsigned* st;
};

__device__ __forceinline__ XcdBarrier xcd_barrier_post(unsigned* bar, volatile LAS unsigned* st) {
    XcdBarrier b; b.bar = bar; b.x = xb_xcc_id(); b.st = st;
    if (threadIdx.x == 0) (void)xb_add(&bar[XB_XCNT(b.x)], 1u);
    return b;
}
__device__ __forceinline__ void xcd_barrier_complete(unsigned* bar, unsigned x, unsigned& nloc, unsigned& nx) {
    const unsigned G = gridDim.x * gridDim.y * gridDim.z;
    unsigned sum, cnt, mine, sp = 0u;
    for (;;) {
        sum = 0u; cnt = 0u; mine = 0u;
#pragma unroll
        for (unsigned j = 0; j < 16; ++j) { const unsigned c = xb_ld(&bar[XB_XCNT(j)]); sum += c; cnt += (c > 0u) ? 1u : 0u; mine = (j == x) ? c : mine; }
        if (sum == G) break;
        __builtin_amdgcn_s_sleep(1);
        if ((++sp & 255u) == 0u) { if (xb_ld(&bar[XB_TMO])) break; if (sp > XB_SPIN_CAP) { atomicAdd(&bar[XB_TMO], 1u); break; } }
    }
    nloc = mine > 0u ? mine : 1u; nx = cnt > 0u ? cnt : 1u;
}

__device__ __forceinline__ void xcd_barrier(const XcdBarrier& b) {
    asm volatile("s_waitcnt vmcnt(0)" ::: "memory");
    __syncthreads();
    if (threadIdx.x == 0) {
        unsigned* bar = b.bar;
        __builtin_amdgcn_s_waitcnt(0);
        unsigned nloc = b.st[0], nx = b.st[1];
        if (nloc == 0u) { xcd_barrier_complete(bar, b.x, nloc, nx); b.st[0] = nloc; b.st[1] = nx; }
        const unsigned old = xb_add(&bar[XB_XSUB(b.x)], 1u);
        const unsigned gen = old / nloc;
        if (old + 1u == (gen + 1u) * nloc) {
            __builtin_amdgcn_fence(__ATOMIC_RELEASE, "agent");
            asm volatile("s_waitcnt vmcnt(0)" ::: "memory");
            const unsigned og = xb_add(&bar[XB_TOP], 1u);
            const unsigned tg = og / nx;
            if (og + 1u == (tg + 1u) * nx) xb_add(&bar[XB_TOPGEN], 1u);
            else XB_SPIN(xb_ld(&bar[XB_TOPGEN]) == tg, bar);
            __builtin_amdgcn_fence(__ATOMIC_ACQUIRE, "agent");
            xb_add(&bar[XB_XGEN(b.x)], 1u);
            asm volatile("s_waitcnt vmcnt(0)" ::: "memory");
        } else {
            XB_SPIN(xb_ld(&bar[XB_XGEN(b.x)]) == gen, bar);
            __builtin_amdgcn_fence(__ATOMIC_ACQUIRE, "agent");
            asm volatile("s_waitcnt vmcnt(0)" ::: "memory");
        }
    }
    __syncthreads();
}


typedef __attribute__((ext_vector_type(2))) float f32x2_t;
typedef __attribute__((ext_vector_type(2))) __bf16 bf16x2_t;
__device__ __forceinline__ u16 f2bf(float f) {
  const __bf16 h = (__bf16)f;
  return __builtin_bit_cast(u16, h);
}
__device__ __forceinline__ float bf2f(u16 h) { return __uint_as_float(((uint32_t)h) << 16); }
__device__ __forceinline__ uint32_t pack2(float a, float b) {
  const f32x2_t v = {a, b};
  const bf16x2_t r = __builtin_convertvector(v, bf16x2_t);
  return __builtin_bit_cast(uint32_t, r);
}
__device__ __forceinline__ float lo16(uint32_t w) { return __uint_as_float(w << 16); }
__device__ __forceinline__ float hi16(uint32_t w) { return __uint_as_float(w & 0xffff0000u); }
__device__ __forceinline__ int opq(int v) { asm volatile("" : "+v"(v)); return v; }
__device__ __forceinline__ void lds_barrier() {
  asm volatile("s_waitcnt lgkmcnt(0)" ::: "memory");
  __builtin_amdgcn_s_barrier();
  asm volatile("" ::: "memory");
}
__device__ __forceinline__ float sigm(float x) { return 1.f / (1.f + __expf(-x)); }
__device__ __forceinline__ void unpack8(uint4 v, float* f) {
  f[0] = lo16(v.x); f[1] = hi16(v.x); f[2] = lo16(v.y); f[3] = hi16(v.y);
  f[4] = lo16(v.z); f[5] = hi16(v.z); f[6] = lo16(v.w); f[7] = hi16(v.w);
}
__device__ __forceinline__ uint4 pack8(const float* f) {
  uint4 v; v.x = pack2(f[0], f[1]); v.y = pack2(f[2], f[3]); v.z = pack2(f[4], f[5]); v.w = pack2(f[6], f[7]);
  return v;
}
__device__ __forceinline__ float wsum64(float v) {
#pragma unroll
  for (int o = 32; o > 0; o >>= 1) v += __shfl_xor(v, o, 64);
  return v;
}
__device__ __forceinline__ float gelu_tanh(float x) {
  float u = 0.7978845608028654f * (x + 0.044715f * x * x * x);
  float t = 1.f - 2.f / (1.f + __expf(2.f * u));
  return 0.5f * x * (1.f + t);
}

__device__ __forceinline__ void g_frag(const u16* as, const u16* bs, int ks, bf16x8 (&a)[2], bf16x8 (&b)[2]) {
  a[0] = *(const bf16x8*)(as + ks * 16);
  a[1] = *(const bf16x8*)(as + 32 * 72 + ks * 16);
  b[0] = *(const bf16x8*)(bs + ks * 16);
  b[1] = *(const bf16x8*)(bs + 32 * 72 + ks * 16);
}
__device__ __forceinline__ void g_mma(const bf16x8 (&a)[2], const bf16x8 (&b)[2], f32x16 (&acc)[2][2]) {
  acc[0][0] = __builtin_amdgcn_mfma_f32_32x32x16_bf16(a[0], b[0], acc[0][0], 0, 0, 0);
  acc[0][1] = __builtin_amdgcn_mfma_f32_32x32x16_bf16(a[0], b[1], acc[0][1], 0, 0, 0);
  acc[1][0] = __builtin_amdgcn_mfma_f32_32x32x16_bf16(a[1], b[0], acc[1][0], 0, 0, 0);
  acc[1][1] = __builtin_amdgcn_mfma_f32_32x32x16_bf16(a[1], b[1], acc[1][1], 0, 0, 0);
}
__device__ __forceinline__ void gemm_main(const u16* __restrict__ A, int lda, const u16* __restrict__ Bt, int ldb, int K,
                                          f32x16 (&acc)[2][2], u16* lds) {
  const int tid = opq(threadIdx.x), lane = tid & 63, w = tid >> 6, wm = w >> 1, wn = w & 1, fr = lane & 31, fq = lane >> 5;
  u16* As = lds;
  u16* Bs = lds + 2 * 256 * 72;
  const int nk = K >> 6;
  uint4 p0, p1, p2, p3, p4, p5;
  uint4 q0, q1, q2, q3, q4, q5;
  uint4 r0, r1, r2, r3, r4, r5;
  const int lr = tid >> 3, lc = (tid & 7) * 8;
  const unsigned oa0 = (unsigned)(lr * lda + lc) * 2u, sa2 = (unsigned)lda * 128u;
  const unsigned oa1 = oa0 + sa2, oa2 = oa0 + 2u * sa2, oa3 = oa0 + 3u * sa2;
  const unsigned ob0 = (unsigned)(lr * ldb + lc) * 2u, ob1 = ob0 + (unsigned)ldb * 128u;
#define G_LOAD(S, kt_)                                          \
  {                                                             \
    const int kc_ = ((kt_) < nk) ? (kt_) : (nk - 1);            \
    const char* a_ = (const char*)A + kc_ * 128;                \
    const char* b_ = (const char*)Bt + kc_ * 128;               \
    S##0 = *(const uint4*)(a_ + oa0);                           \
    S##1 = *(const uint4*)(a_ + oa1);                           \
    S##2 = *(const uint4*)(a_ + oa2);                           \
    S##3 = *(const uint4*)(a_ + oa3);                           \
    S##4 = *(const uint4*)(b_ + ob0);                           \
    S##5 = *(const uint4*)(b_ + ob1);                           \
  }
#define G_STORE(S, buf_)                                                     \
  {                                                                          \
    u16* as_ = As + ((buf_) * 256 + lr) * 72 + lc;                           \
    u16* bs_ = Bs + ((buf_) * 128 + lr) * 72 + lc;                           \
    *(uint4*)(as_) = S##0;                                                   \
    *(uint4*)(as_ + 64 * 72) = S##1;                                         \
    *(uint4*)(as_ + 128 * 72) = S##2;                                        \
    *(uint4*)(as_ + 192 * 72) = S##3;                                        \
    *(uint4*)(bs_) = S##4;                                                   \
    *(uint4*)(bs_ + 64 * 72) = S##5;                                         \
  }
#define G_STEP(S, BUF, kt_)                                                               \
  {                                                                                       \
    const u16* as = As + ((BUF) * 256 + wm * 64 + fr) * 72 + fq * 8;                      \
    const u16* bs = Bs + ((BUF) * 128 + wn * 64 + fr) * 72 + fq * 8;                      \
    bf16x8 fa0[2], fb0[2], fa1[2], fb1[2], fa2[2], fb2[2];                                \
    g_frag(as, bs, 0, fa0, fb0);                                                          \
    g_frag(as, bs, 1, fa1, fb1);                                                          \
    __builtin_amdgcn_sched_barrier(0);                                                    \
    G_STORE(S, (BUF) ^ 1)                                                                 \
    G_LOAD(S, (kt_) + 4)                                                                  \
    __builtin_amdgcn_sched_barrier(0);                                                    \
    g_frag(as, bs, 2, fa2, fb2);                                                          \
    __builtin_amdgcn_sched_barrier(0);                                                    \
    g_mma(fa0, fb0, acc);                                                                 \
    __builtin_amdgcn_sched_barrier(0);                                                    \
    g_frag(as, bs, 3, fa0, fb0);                                                          \
    __builtin_amdgcn_sched_barrier(0);                                                    \
    g_mma(fa1, fb1, acc);                                                                 \
    g_mma(fa2, fb2, acc);                                                                 \
    g_mma(fa0, fb0, acc);                                                                 \
    lds_barrier();                                                                      \
  }
  G_LOAD(p, 0)
  lds_barrier();
  G_STORE(p, 0)
  G_LOAD(q, 1)
  G_LOAD(r, 2)
  G_LOAD(p, 3)
  lds_barrier();
  for (int kt = 0; kt < nk; kt += 6) {
    G_STEP(q, 0, kt)
    G_STEP(r, 1, kt + 1)
    if (kt + 2 < nk) {
      G_STEP(p, 0, kt + 2)
      G_STEP(q, 1, kt + 3)
    }
    if (kt + 4 < nk) {
      G_STEP(r, 0, kt + 4)
      G_STEP(p, 1, kt + 5)
    }
  }
#undef G_STEP
#undef G_LOAD
#undef G_STORE
}

__device__ __forceinline__ void acc_zero(f32x16 (&acc)[2][2]) {
#pragma unroll
  for (int i = 0; i < 2; ++i)
#pragma unroll
    for (int j = 0; j < 2; ++j)
#pragma unroll
      for (int e = 0; e < 16; ++e) acc[i][j][e] = 0.f;
}

#define TILE_COORDS                                                                                  \
  const int tid_ = opq(threadIdx.x), lane_ = tid_ & 63, w_ = __builtin_amdgcn_readfirstlane(tid_ >> 6), \
            wm_ = w_ >> 1, wn_ = w_ & 1, fr_ = lane_ & 31, fq_ = lane_ >> 5;
#define TROW(m0, i, e) ((m0) + wm_ * 64 + (i) * 32 + ((e) & 3) + 8 * ((e) >> 2) + 4 * fq_)
#define TCOL(n0, j) ((n0) + wn_ * 64 + (j) * 32 + fr_)
#define TIDX2(m0, cb, i, e, ld) ((size_t)((m0) + wm_ * 64 + (i) * 32 + ((e) & 3) + 8 * ((e) >> 2)) * (ld) + (cb) + (size_t)(unsigned)(4 * fq_ * (ld) + fr_))
#define TIDX(m0, n0, i, j, e, ld) TIDX2(m0, (n0) + wn_ * 64 + (j) * 32, i, e, ld)

__device__ __forceinline__ int srccol(int which, int r) {
  switch (which) {
    case 0:
      if (r < 2048) return r;
      if (r < 2560) return 2064 + (r - 2048);
      if (r < 2576) return 2048 + (r - 2560);
      if (r < 2688) return -1;
      if (r < 3712) return 2576 + (r - 2688);
      return 3600 + (r - 3712);
    case 2: {
      int tile = r >> 7, wn = (r >> 6) & 1, wi = r & 63;
      return (wi < 32) ? (tile * 64 + wn * 32 + wi) : (512 + tile * 64 + wn * 32 + (wi - 32));
    }
    case 5: {
      int hh = r / 2816, cc = r % 2816;
      return (cc < 1408) ? (hh * 1408 + cc) : (2816 + hh * 1408 + (cc - 1408));
    }
    default: return r;
  }
}

__device__ __forceinline__ void convert_item(const float* __restrict__ src, int K, int N, u16* __restrict__ dst, int which, int item, char* lds) {
  float* tile = (float*)lds;
  const int tid = opq(threadIdx.x);
  const int kb = K >> 8;
  const int r0 = (item / kb) * 64, k0 = (item % kb) * 256;
  lds_barrier();
  {
    const int n4 = (tid & 15) * 4, kk = tid >> 4;
    const int sc = srccol(which, r0 + n4);
    float4 v[8];
#pragma unroll
    for (int it = 0; it < 8; ++it) {
      const int k = kk + 32 * it;
      v[it] = (sc >= 0) ? *(const float4*)(src + (size_t)(k0 + k) * N + sc) : make_float4(0.f, 0.f, 0.f, 0.f);
    }
#pragma unroll
    for (int it = 0; it < 8; ++it) {
      const int k = kk + 32 * it;
      tile[(n4 + 0) * 257 + k] = v[it].x; tile[(n4 + 1) * 257 + k] = v[it].y;
      tile[(n4 + 2) * 257 + k] = v[it].z; tile[(n4 + 3) * 257 + k] = v[it].w;
    }
  }
  lds_barrier();
  {
    const int ks = (tid & 31) * 8, rr = tid >> 5;
#pragma unroll
    for (int it = 0; it < 4; ++it) {
      const int row = rr + 16 * it;
      float f[8];
#pragma unroll
      for (int e = 0; e < 8; ++e) f[e] = tile[row * 257 + ks + e];
      *(uint4*)(dst + (size_t)(r0 + row) * K + k0 + ks) = pack8(f);
    }
  }
}

__device__ __forceinline__ void mod_item(const Params& P, int item, char* lds) {
  float* sc = (float*)lds;
  float* red = sc + 5 * 1024;
  const int tid = opq(threadIdx.x);
  lds_barrier();
  for (int i = tid; i < 5 * 1024; i += NT) {
    const int r = i >> 10, k = i & 1023;
    float v = (r < 4) ? P.c[r * 1024 + k] : P.c_ctx[k];
    sc[i] = v * sigm(v);
  }
  lds_barrier();
  const int nn = tid & 31, kg = tid >> 5;
  const int n = item * 32 + nn;
  float a0 = 0, a1 = 0, a2 = 0, a3 = 0, a4 = 0;
  for (int kk = 0; kk < 64; ++kk) {
    const int k = kg * 64 + kk;
    const float wv = P.w_ada[(size_t)k * 6144 + n];
    a0 += sc[k] * wv; a1 += sc[1024 + k] * wv; a2 += sc[2048 + k] * wv; a3 += sc[3072 + k] * wv; a4 += sc[4096 + k] * wv;
  }
  red[(kg * 5 + 0) * 32 + nn] = a0; red[(kg * 5 + 1) * 32 + nn] = a1; red[(kg * 5 + 2) * 32 + nn] = a2;
  red[(kg * 5 + 3) * 32 + nn] = a3; red[(kg * 5 + 4) * 32 + nn] = a4;
  lds_barrier();
  if (tid < 160) {
    const int r = tid >> 5, n2 = tid & 31;
    float s = 0.f;
#pragma unroll
    for (int g = 0; g < 16; ++g) s += red[(g * 5 + r) * 32 + n2];
    float* MOD = (float*)(P.ws + OFF_MOD);
    MOD[r * 6144 + item * 32 + n2] = s + P.b_ada[item * 32 + n2];
  }
}

__device__ __forceinline__ void lam_pow(float step, float are, float aim, int e, float& pr, float& pi) {
  const float mag = expf((float)e * step * are);
  double ang = (double)e * (double)step * (double)aim;
  ang -= 6.283185307179586476925 * rint(ang * 0.15915494309189533577);
  float s, c;
  __sincosf((float)ang, &s, &c);
  pr = mag * c; pi = mag * s;
}

__device__ __forceinline__ void s5tab_item(const Params& P, int item, char* lds) {
  const int tid = opq(threadIdx.x);
  const int tau = item & 31, g = (item >> 5) & 31, r = item >> 10;
  float* cfr = (float*)lds;
  float* cfi = cfr + 64;
  float* p0r = cfi + 64;
  float* p0i = p0r + 64;
  float* p1r = p0i + 64;
  float* p1i = p1r + 64;
  float* Gr = p1i + 64;
  float* Gi = Gr + 1024;
  float* Cr = Gi + 1024;
  float* Ci = Cr + 1024;
  const int rg = r * 32 + g;
  lds_barrier();
  if (tid < 64) {
    const int n = tid;
    const float step = expf(P.s5_log_step[rg]);
    const float are = P.s5_a_re[rg * 64 + n], aim = P.s5_a_im[rg * 64 + n];
    const float za = step * are;
    double zb = (double)step * (double)aim;
    zb -= 6.283185307179586476925 * rint(zb * 0.15915494309189533577);
    float sb, cb, sh, ch;
    __sincosf((float)zb, &sb, &cb);
    __sincosf((float)(0.5 * zb), &sh, &ch);
    const float em1 = expm1f(za);
    const float re1 = em1 * cb - 2.f * sh * sh;
    const float im1 = (1.f + em1) * sb;
    const float den = are * are + aim * aim;
    cfr[n] = (re1 * are + im1 * aim) / den;
    cfi[n] = (im1 * are - re1 * aim) / den;
    float pr, pi;
    lam_pow(step, are, aim, tau, pr, pi);
    p0r[n] = pr; p0i[n] = pi;
    lam_pow(step, are, aim, tau + 1, pr, pi);
    p1r[n] = pr; p1i[n] = pi;
  }
  for (int i = tid; i < 1024; i += NT) {
    Cr[i] = P.s5_c_re[(size_t)rg * 1024 + i];
    Ci[i] = P.s5_c_im[(size_t)rg * 1024 + i];
  }
  lds_barrier();
  for (int i = tid; i < 1024; i += NT) {
    const int n = i >> 4;
    const float br = P.s5_b_re[(size_t)rg * 1024 + i], bi = P.s5_b_im[(size_t)rg * 1024 + i];
    const float tr = cfr[n] * br - cfi[n] * bi, ti = cfr[n] * bi + cfi[n] * br;
    Gr[i] = p0r[n] * tr - p0i[n] * ti;
    Gi[i] = p0r[n] * ti + p0i[n] * tr;
  }
  lds_barrier();
  u16* MEND = (u16*)(P.ws + OFF_MEND);
  u16* MST = (u16*)(P.ws + OFF_MST);
  float* KTAB = (float*)(P.ws + OFF_KTAB);
  {
    const int ii = (r == 0) ? (31 - tau) : tau;
    for (int i = tid; i < 2048; i += NT) {
      const int part = i >> 10, n = (i >> 4) & 63, pi_ = i & 15;
      const float v = part ? Gi[n * 16 + pi_] : Gr[n * 16 + pi_];
      MEND[((size_t)g * 256 + r * 128 + part * 64 + n) * 512 + ii * 16 + pi_] = f2bf(v);
    }
  }
  if (tid < 256) {
    const int po = tid >> 4, pi_ = tid & 15;
    float s = 0.f;
    for (int n = 0; n < 64; ++n) s += Cr[po * 64 + n] * Gr[n * 16 + pi_] - Ci[po * 64 + n] * Gi[n * 16 + pi_];
    KTAB[(((size_t)rg) * 32 + tau) * 256 + tid] = s;
  }
  {
    const int jj = (r == 0) ? tau : (31 - tau);
    for (int i = tid; i < 2048; i += NT) {
      const int po = i >> 7, part = (i >> 6) & 1, n = i & 63;
      const float cr = Cr[po * 64 + n], ci = Ci[po * 64 + n];
      const float v = part ? -(cr * p1i[n] + ci * p1r[n]) : (cr * p1r[n] - ci * p1i[n]);
      MST[((size_t)g * 512 + jj * 16 + po) * 256 + r * 128 + part * 64 + n] = f2bf(v);
    }
  }
}

__device__ __forceinline__ void norm_row(const float* __restrict__ xr, const float* __restrict__ nw, const float* __restrict__ shift,
                                         const float* __restrict__ scale, u16* __restrict__ dst, int lane) {
  float4 v[4];
  float ss = 0.f;
#pragma unroll
  for (int it = 0; it < 4; ++it) {
    v[it] = *(const float4*)(xr + (it * 64 + lane) * 4);
    ss += v[it].x * v[it].x + v[it].y * v[it].y + v[it].z * v[it].z + v[it].w * v[it].w;
  }
  ss = wsum64(ss);
  const float rstd = rsqrtf(ss * (1.f / 1024.f) + 1e-6f);
#pragma unroll
  for (int it = 0; it < 4; ++it) {
    const int c = (it * 64 + lane) * 4;
    const float4 w4 = *(const float4*)(nw + c), sh = *(const float4*)(shift + c), sc = *(const float4*)(scale + c);
    const float y0 = v[it].x * rstd * w4.x * (1.f + sc.x) + sh.x;
    const float y1 = v[it].y * rstd * w4.y * (1.f + sc.y) + sh.y;
    const float y2 = v[it].z * rstd * w4.z * (1.f + sc.z) + sh.z;
    const float y3 = v[it].w * rstd * w4.w * (1.f + sc.w) + sh.w;
    uint2 o; o.x = pack2(y0, y1); o.y = pack2(y2, y3);
    *(uint2*)(dst + c) = o;
  }
}

__device__ __forceinline__ void norm_row2(const float* __restrict__ xa, const float* __restrict__ xb, const float* __restrict__ nw,
                                          const float* __restrict__ shA, const float* __restrict__ scA,
                                          const float* __restrict__ shB, const float* __restrict__ scB,
                                          u16* __restrict__ da, u16* __restrict__ db, int lane) {
  float4 va[4], vb[4];
#pragma unroll
  for (int it = 0; it < 4; ++it) { va[it] = *(const float4*)(xa + (it * 64 + lane) * 4); vb[it] = *(const float4*)(xb + (it * 64 + lane) * 4); }
  float sa = 0.f, sb = 0.f;
#pragma unroll
  for (int it = 0; it < 4; ++it) {
    sa += va[it].x * va[it].x + va[it].y * va[it].y + va[it].z * va[it].z + va[it].w * va[it].w;
    sb += vb[it].x * vb[it].x + vb[it].y * vb[it].y + vb[it].z * vb[it].z + vb[it].w * vb[it].w;
  }
  sa = wsum64(sa); sb = wsum64(sb);
  const float ra = rsqrtf(sa * (1.f / 1024.f) + 1e-6f), rb = rsqrtf(sb * (1.f / 1024.f) + 1e-6f);
#pragma unroll
  for (int it = 0; it < 4; ++it) {
    const int c = (it * 64 + lane) * 4;
    const float4 w4 = *(const float4*)(nw + c);
    const float4 sh = *(const float4*)(shA + c), sc = *(const float4*)(scA + c);
    const float4 sh2 = *(const float4*)(shB + c), sc2 = *(const float4*)(scB + c);
    uint2 o;
    o.x = pack2(va[it].x * ra * w4.x * (1.f + sc.x) + sh.x, va[it].y * ra * w4.y * (1.f + sc.y) + sh.y);
    o.y = pack2(va[it].z * ra * w4.z * (1.f + sc.z) + sh.z, va[it].w * ra * w4.w * (1.f + sc.w) + sh.w);
    *(uint2*)(da + c) = o;
    o.x = pack2(vb[it].x * rb * w4.x * (1.f + sc2.x) + sh2.x, vb[it].y * rb * w4.y * (1.f + sc2.y) + sh2.y);
    o.y = pack2(vb[it].z * rb * w4.z * (1.f + sc2.z) + sh2.z, vb[it].w * rb * w4.w * (1.f + sc2.w) + sh2.w);
    *(uint2*)(db + c) = o;
  }
}

__device__ __forceinline__ void norm1_item(const Params& P, int item) {
  const int lane = opq(threadIdx.x) & 63, w = opq(threadIdx.x) >> 6;
  const int rowA = item * 16 + w, rowB = rowA + 8;
  const float* MOD = (const float*)(P.ws + OFF_MOD);
  const int ba = (rowA < 16384) ? (rowA >> 12) : 4, bb = (rowB < 16384) ? (rowB >> 12) : 4;
  const float* xa = (rowA < 16384) ? (P.x + (size_t)rowA * 1024) : (P.ctx + (size_t)(rowA - 16384) * 1024);
  const float* xb = (rowB < 16384) ? (P.x + (size_t)rowB * 1024) : (P.ctx + (size_t)(rowB - 16384) * 1024);
  u16* H = (u16*)(P.ws + OFF_R2);
  norm_row2(xa, xb, P.norm1_w, MOD + ba * 6144, MOD + ba * 6144 + 1024, MOD + bb * 6144, MOD + bb * 6144 + 1024,
            H + (size_t)rowA * 1024, H + (size_t)rowB * 1024, lane);
}

__device__ __forceinline__ void mintra_item(const Params& P, int item) {
  const int tid = opq(threadIdx.x);
  const int rowg = item * 8 + (tid >> 6);
  const int g = rowg >> 9, nout = rowg & 511, j = nout >> 4, po = nout & 15;
  const int k0 = (tid & 63) * 8, i = k0 >> 4, pi0 = k0 & 15;
  const float* KTAB = (const float*)(P.ws + OFF_KTAB);
  float f[8];
#pragma unroll
  for (int e = 0; e < 8; ++e) f[e] = 0.f;
  if (i <= j) {
    const float* kp = KTAB + (((size_t)(0 * 32 + g)) * 32 + (j - i)) * 256 + po * 16 + pi0;
#pragma unroll
    for (int e = 0; e < 8; ++e) f[e] += kp[e];
  }
  if (i >= j) {
    const float* kp = KTAB + (((size_t)(1 * 32 + g)) * 32 + (i - j)) * 256 + po * 16 + pi0;
#pragma unroll
    for (int e = 0; e < 8; ++e) f[e] += kp[e];
  }
  if (i == j) {
    const float dv = P.s5_d[g * 16 + po];
#pragma unroll
    for (int e = 0; e < 8; ++e) if (pi0 + e == po) f[e] += dv;
  }
  u16* MI = (u16*)(P.ws + OFF_MINTRA);
  *(uint4*)(MI + (size_t)rowg * 512 + k0) = pack8(f);
}

__device__ __forceinline__ void inproj_tile(const Params& P, int t, char* lds) {
  int mt, nt;
  if (t < 1344) { nt = t / 64; mt = t % 64; }
  else {
    const int tt = t - 1344; mt = 64 + (tt & 3);
    const int ni = tt >> 2;
    nt = (ni < 8) ? (4 + ni) : ((ni < 12) ? (16 + ni - 8) : 20);
  }
  const int m0 = mt * 256, n0 = nt * 128;
  f32x16 acc[2][2];
  acc_zero(acc);
  gemm_main((const u16*)(P.ws + OFF_R2) + (size_t)m0 * 1024, 1024, (const u16*)(P.ws + OFF_WT_IN) + (size_t)n0 * 1024, 1024, 1024, acc, (u16*)lds);
  TILE_COORDS
  if (nt < 12) {
    u16* QKV = (u16*)(P.ws + OFF_R3);
#pragma unroll
    for (int i = 0; i < 2; ++i)
#pragma unroll
      for (int j = 0; j < 2; ++j)
#pragma unroll
        for (int e = 0; e < 16; ++e) QKV[TIDX(m0, n0, i, j, e, 1536)] = f2bf(acc[i][j][e]);
  } else if (nt < 16) {
    u16* Z = (u16*)(P.ws + OFF_Z);
#pragma unroll
    for (int i = 0; i < 2; ++i)
#pragma unroll
      for (int j = 0; j < 2; ++j)
#pragma unroll
        for (int e = 0; e < 16; ++e) Z[TIDX(m0, n0, i, j, e, 512) - 1536] = f2bf(acc[i][j][e]);
  } else if (nt < 20) {
    u16* U5 = (u16*)(P.ws + OFF_U5);
#pragma unroll
    for (int i = 0; i < 2; ++i)
#pragma unroll
      for (int j = 0; j < 2; ++j)
#pragma unroll
        for (int e = 0; e < 16; ++e) {
          const int cc = TCOL(n0, j) - 2048;
          U5[((size_t)(cc >> 4) * 17408 + TROW(m0, i, e)) * 16 + (cc & 15)] = f2bf(acc[i][j][e]);
        }
  } else {
    float* BA = (float*)(P.ws + OFF_BA);
#pragma unroll
    for (int i = 0; i < 2; ++i)
#pragma unroll
      for (int j = 0; j < 2; ++j)
#pragma unroll
        for (int e = 0; e < 16; ++e) {
          const int cc = TCOL(n0, j) - 2560;
          if (cc < 16) BA[(size_t)TROW(m0, i, e) * 16 + cc] = acc[i][j][e];
        }
  }
}

__device__ __forceinline__ void solve_elim(float (&sol)[64], const float* Lr) {
  float4 b0a, b0b, b0c, b0d, b1a, b1b, b1c, b1d, b2a, b2b, b2c, b2d;
  b0a = *(const float4*)(Lr + 0); b0b = *(const float4*)(Lr + 4); b0c = *(const float4*)(Lr + 8); b0d = *(const float4*)(Lr + 12);
  b1a = *(const float4*)(Lr + 16); b1b = *(const float4*)(Lr + 20); b1c = *(const float4*)(Lr + 24); b1d = *(const float4*)(Lr + 28);
  b2a = *(const float4*)(Lr + 32); b2b = *(const float4*)(Lr + 36); b2c = *(const float4*)(Lr + 40); b2d = *(const float4*)(Lr + 44);
  __builtin_amdgcn_sched_barrier(0);
  sol[1] -= b0a.y * sol[0]; sol[2] -= b0a.z * sol[0]; sol[3] -= b0a.w * sol[0]; sol[4] -= b0b.x * sol[0]; sol[5] -= b0b.y * sol[0]; sol[6] -= b0b.z * sol[0]; sol[7] -= b0b.w * sol[0]; sol[8] -= b0c.x * sol[0]; sol[9] -= b0c.y * sol[0]; sol[10] -= b0c.z * sol[0]; sol[11] -= b0c.w * sol[0]; sol[12] -= b0d.x * sol[0]; sol[13] -= b0d.y * sol[0]; sol[14] -= b0d.z * sol[0]; sol[15] -= b0d.w * sol[0];
  __builtin_amdgcn_sched_barrier(0);
  b0a = *(const float4*)(Lr + 48); b0b = *(const float4*)(Lr + 52); b0c = *(const float4*)(Lr + 56); b0d = *(const float4*)(Lr + 60);
  __builtin_amdgcn_sched_barrier(0);
  sol[16] -= b1a.x * sol[0]; sol[17] -= b1a.y * sol[0]; sol[18] -= b1a.z * sol[0]; sol[19] -= b1a.w * sol[0]; sol[20] -= b1b.x * sol[0]; sol[21] -= b1b.y * sol[0]; sol[22] -= b1b.z * sol[0]; sol[23] -= b1b.w * sol[0]; sol[24] -= b1c.x * sol[0]; sol[25] -= b1c.y * sol[0]; sol[26] -= b1c.z * sol[0]; sol[27] -= b1c.w * sol[0]; sol[28] -= b1d.x * sol[0]; sol[29] -= b1d.y * sol[0]; sol[30] -= b1d.z * sol[0]; sol[31] -= b1d.w * sol[0];
  __builtin_amdgcn_sched_barrier(0);
  b1a = *(const float4*)(Lr + 64); b1b = *(const float4*)(Lr + 68); b1c = *(const float4*)(Lr + 72); b1d = *(const float4*)(Lr + 76);
  __builtin_amdgcn_sched_barrier(0);
  sol[32] -= b2a.x * sol[0]; sol[33] -= b2a.y * sol[0]; sol[34] -= b2a.z * sol[0]; sol[35] -= b2a.w * sol[0]; sol[36] -= b2b.x * sol[0]; sol[37] -= b2b.y * sol[0]; sol[38] -= b2b.z * sol[0]; sol[39] -= b2b.w * sol[0]; sol[40] -= b2c.x * sol[0]; sol[41] -= b2c.y * sol[0]; sol[42] -= b2c.z * sol[0]; sol[43] -= b2c.w * sol[0]; sol[44] -= b2d.x * sol[0]; sol[45] -= b2d.y * sol[0]; sol[46] -= b2d.z * sol[0]; sol[47] -= b2d.w * sol[0];
  __builtin_amdgcn_sched_barrier(0);
  b2a = *(const float4*)(Lr + 80); b2b = *(const float4*)(Lr + 84); b2c = *(const float4*)(Lr + 88); b2d = *(const float4*)(Lr + 92);
  __builtin_amdgcn_sched_barrier(0);
  sol[48] -= b0a.x * sol[0]; sol[49] -= b0a.y * sol[0]; sol[50] -= b0a.z * sol[0]; sol[51] -= b0a.w * sol[0]; sol[52] -= b0b.x * sol[0]; sol[53] -= b0b.y * sol[0]; sol[54] -= b0b.z * sol[0]; sol[55] -= b0b.w * sol[0]; sol[56] -= b0c.x * sol[0]; sol[57] -= b0c.y * sol[0]; sol[58] -= b0c.z * sol[0]; sol[59] -= b0c.w * sol[0]; sol[60] -= b0d.x * sol[0]; sol[61] -= b0d.y * sol[0]; sol[62] -= b0d.z * sol[0]; sol[63] -= b0d.w * sol[0];
  __builtin_amdgcn_sched_barrier(0);
  b0a = *(const float4*)(Lr + 96); b0b = *(const float4*)(Lr + 100); b0c = *(const float4*)(Lr + 104); b0d = *(const float4*)(Lr + 108);
  __builtin_amdgcn_sched_barrier(0);
  sol[2] -= b1a.z * sol[1]; sol[3] -= b1a.w * sol[1]; sol[4] -= b1b.x * sol[1]; sol[5] -= b1b.y * sol[1]; sol[6] -= b1b.z * sol[1]; sol[7] -= b1b.w * sol[1]; sol[8] -= b1c.x * sol[1]; sol[9] -= b1c.y * sol[1]; sol[10] -= b1c.z * sol[1]; sol[11] -= b1c.w * sol[1]; sol[12] -= b1d.x * sol[1]; sol[13] -= b1d.y * sol[1]; sol[14] -= b1d.z * sol[1]; sol[15] -= b1d.w * sol[1];
  __builtin_amdgcn_sched_barrier(0);
  b1a = *(const float4*)(Lr + 112); b1b = *(const float4*)(Lr + 116); b1c = *(const float4*)(Lr + 120); b1d = *(const float4*)(Lr + 124);
  __builtin_amdgcn_sched_barrier(0);
  sol[16] -= b2a.x * sol[1]; sol[17] -= b2a.y * sol[1]; sol[18] -= b2a.z * sol[1]; sol[19] -= b2a.w * sol[1]; sol[20] -= b2b.x * sol[1]; sol[21] -= b2b.y * sol[1]; sol[22] -= b2b.z * sol[1]; sol[23] -= b2b.w * sol[1]; sol[24] -= b2c.x * sol[1]; sol[25] -= b2c.y * sol[1]; sol[26] -= b2c.z * sol[1]; sol[27] -= b2c.w * sol[1]; sol[28] -= b2d.x * sol[1]; sol[29] -= b2d.y * sol[1]; sol[30] -= b2d.z * sol[1]; sol[31] -= b2d.w * sol[1];
  __builtin_amdgcn_sched_barrier(0);
  b2a = *(const float4*)(Lr + 128); b2b = *(const float4*)(Lr + 132); b2c = *(const float4*)(Lr + 136); b2d = *(const float4*)(Lr + 140);
  __builtin_amdgcn_sched_barrier(0);
  sol[32] -= b0a.x * sol[1]; sol[33] -= b0a.y * sol[1]; sol[34] -= b0a.z * sol[1]; sol[35] -= b0a.w * sol[1]; sol[36] -= b0b.x * sol[1]; sol[37] -= b0b.y * sol[1]; sol[38] -= b0b.z * sol[1]; sol[39] -= b0b.w * sol[1]; sol[40] -= b0c.x * sol[1]; sol[41] -= b0c.y * sol[1]; sol[42] -= b0c.z * sol[1]; sol[43] -= b0c.w * sol[1]; sol[44] -= b0d.x * sol[1]; sol[45] -= b0d.y * sol[1]; sol[46] -= b0d.z * sol[1]; sol[47] -= b0d.w * sol[1];
  __builtin_amdgcn_sched_barrier(0);
  b0a = *(const float4*)(Lr + 144); b0b = *(const float4*)(Lr + 148); b0c = *(const float4*)(Lr + 152); b0d = *(const float4*)(Lr + 156);
  __builtin_amdgcn_sched_barrier(0);
  sol[48] -= b1a.x * sol[1]; sol[49] -= b1a.y * sol[1]; sol[50] -= b1a.z * sol[1]; sol[51] -= b1a.w * sol[1]; sol[52] -= b1b.x * sol[1]; sol[53] -= b1b.y * sol[1]; sol[54] -= b1b.z * sol[1]; sol[55] -= b1b.w * sol[1]; sol[56] -= b1c.x * sol[1]; sol[57] -= b1c.y * sol[1]; sol[58] -= b1c.z * sol[1]; sol[59] -= b1c.w * sol[1]; sol[60] -= b1d.x * sol[1]; sol[61] -= b1d.y * sol[1]; sol[62] -= b1d.z * sol[1]; sol[63] -= b1d.w * sol[1];
  __builtin_amdgcn_sched_barrier(0);
  b1a = *(const float4*)(Lr + 160); b1b = *(const float4*)(Lr + 164); b1c = *(const float4*)(Lr + 168); b1d = *(const float4*)(Lr + 172);
  __builtin_amdgcn_sched_barrier(0);
  sol[3] -= b2a.w * sol[2]; sol[4] -= b2b.x * sol[2]; sol[5] -= b2b.y * sol[2]; sol[6] -= b2b.z * sol[2]; sol[7] -= b2b.w * sol[2]; sol[8] -= b2c.x * sol[2]; sol[9] -= b2c.y * sol[2]; sol[10] -= b2c.z * sol[2]; sol[11] -= b2c.w * sol[2]; sol[12] -= b2d.x * sol[2]; sol[13] -= b2d.y * sol[2]; sol[14] -= b2d.z * sol[2]; sol[15] -= b2d.w * sol[2];
  __builtin_amdgcn_sched_barrier(0);
  b2a = *(const float4*)(Lr + 176); b2b = *(const float4*)(Lr + 180); b2c = *(const float4*)(Lr + 184); b2d = *(const float4*)(Lr + 188);
  __builtin_amdgcn_sched_barrier(0);
  sol[16] -= b0a.x * sol[2]; sol[17] -= b0a.y * sol[2]; sol[18] -= b0a.z * sol[2]; sol[19] -= b0a.w * sol[2]; sol[20] -= b0b.x * sol[2]; sol[21] -= b0b.y * sol[2]; sol[22] -= b0b.z * sol[2]; sol[23] -= b0b.w * sol[2]; sol[24] -= b0c.x * sol[2]; sol[25] -= b0c.y * sol[2]; sol[26] -= b0c.z * sol[2]; sol[27] -= b0c.w * sol[2]; sol[28] -= b0d.x * sol[2]; sol[29] -= b0d.y * sol[2]; sol[30] -= b0d.z * sol[2]; sol[31] -= b0d.w * sol[2];
  __builtin_amdgcn_sched_barrier(0);
  b0a = *(const float4*)(Lr + 192); b0b = *(const float4*)(Lr + 196); b0c = *(const float4*)(Lr + 200); b0d = *(const float4*)(Lr + 204);
  __builtin_amdgcn_sched_barrier(0);
  sol[32] -= b1a.x * sol[2]; sol[33] -= b1a.y * sol[2]; sol[34] -= b1a.z * sol[2]; sol[35] -= b1a.w * sol[2]; sol[36] -= b1b.x * sol[2]; sol[37] -= b1b.y * sol[2]; sol[38] -= b1b.z * sol[2]; sol[39] -= b1b.w * sol[2]; sol[40] -= b1c.x * sol[2]; sol[41] -= b1c.y * sol[2]; sol[42] -= b1c.z * sol[2]; sol[43] -= b1c.w * sol[2]; sol[44] -= b1d.x * sol[2]; sol[45] -= b1d.y * sol[2]; sol[46] -= b1d.z * sol[2]; sol[47] -= b1d.w * sol[2];
  __builtin_amdgcn_sched_barrier(0);
  b1a = *(const float4*)(Lr + 208); b1b = *(const float4*)(Lr + 212); b1c = *(const float4*)(Lr + 216); b1d = *(const float4*)(Lr + 220);
  __builtin_amdgcn_sched_barrier(0);
  sol[48] -= b2a.x * sol[2]; sol[49] -= b2a.y * sol[2]; sol[50] -= b2a.z * sol[2]; sol[51] -= b2a.w * sol[2]; sol[52] -= b2b.x * sol[2]; sol[53] -= b2b.y * sol[2]; sol[54] -= b2b.z * sol[2]; sol[55] -= b2b.w * sol[2]; sol[56] -= b2c.x * sol[2]; sol[57] -= b2c.y * sol[2]; sol[58] -= b2c.z * sol[2]; sol[59] -= b2c.w * sol[2]; sol[60] -= b2d.x * sol[2]; sol[61] -= b2d.y * sol[2]; sol[62] -= b2d.z * sol[2]; sol[63] -= b2d.w * sol[2];
  __builtin_amdgcn_sched_barrier(0);
  b2a = *(const float4*)(Lr + 224); b2b = *(const float4*)(Lr + 228); b2c = *(const float4*)(Lr + 232); b2d = *(const float4*)(Lr + 236);
  __builtin_amdgcn_sched_barrier(0);
  sol[4] -= b0b.x * sol[3]; sol[5] -= b0b.y * sol[3]; sol[6] -= b0b.z * sol[3]; sol[7] -= b0b.w * sol[3]; sol[8] -= b0c.x * sol[3]; sol[9] -= b0c.y * sol[3]; sol[10] -= b0c.z * sol[3]; sol[11] -= b0c.w * sol[3]; sol[12] -= b0d.x * sol[3]; sol[13] -= b0d.y * sol[3]; sol[14] -= b0d.z * sol[3]; sol[15] -= b0d.w * sol[3];
  __builtin_amdgcn_sched_barrier(0);
  b0a = *(const float4*)(Lr + 240); b0b = *(const float4*)(Lr + 244); b0c = *(const float4*)(Lr + 248); b0d = *(const float4*)(Lr + 252);
  __builtin_amdgcn_sched_barrier(0);
  sol[16] -= b1a.x * sol[3]; sol[17] -= b1a.y * sol[3]; sol[18] -= b1a.z * sol[3]; sol[19] -= b1a.w * sol[3]; sol[20] -= b1b.x * sol[3]; sol[21] -= b1b.y * sol[3]; sol[22] -= b1b.z * sol[3]; sol[23] -= b1b.w * sol[3]; sol[24] -= b1c.x * sol[3]; sol[25] -= b1c.y * sol[3]; sol[26] -= b1c.z * sol[3]; sol[27] -= b1c.w * sol[3]; sol[28] -= b1d.x * sol[3]; sol[29] -= b1d.y * sol[3]; sol[30] -= b1d.z * sol[3]; sol[31] -= b1d.w * sol[3];
  __builtin_amdgcn_sched_barrier(0);
  b1a = *(const float4*)(Lr + 256); b1b = *(const float4*)(Lr + 260); b1c = *(const float4*)(Lr + 264); b1d = *(const float4*)(Lr + 268);
  __builtin_amdgcn_sched_barrier(0);
  sol[32] -= b2a.x * sol[3]; sol[33] -= b2a.y * sol[3]; sol[34] -= b2a.z * sol[3]; sol[35] -= b2a.w * sol[3]; sol[36] -= b2b.x * sol[3]; sol[37] -= b2b.y * sol[3]; sol[38] -= b2b.z * sol[3]; sol[39] -= b2b.w * sol[3]; sol[40] -= b2c.x * sol[3]; sol[41] -= b2c.y * sol[3]; sol[42] -= b2c.z * sol[3]; sol[43] -= b2c.w * sol[3]; sol[44] -= b2d.x * sol[3]; sol[45] -= b2d.y * sol[3]; sol[46] -= b2d.z * sol[3]; sol[47] -= b2d.w * sol[3];
  __builtin_amdgcn_sched_barrier(0);
  b2a = *(const float4*)(Lr + 272); b2b = *(const float4*)(Lr + 276); b2c = *(const float4*)(Lr + 280); b2d = *(const float4*)(Lr + 284);
  __builtin_amdgcn_sched_barrier(0);
  sol[48] -= b0a.x * sol[3]; sol[49] -= b0a.y * sol[3]; sol[50] -= b0a.z * sol[3]; sol[51] -= b0a.w * sol[3]; sol[52] -= b0b.x * sol[3]; sol[53] -= b0b.y * sol[3]; sol[54] -= b0b.z * sol[3]; sol[55] -= b0b.w * sol[3]; sol[56] -= b0c.x * sol[3]; sol[57] -= b0c.y * sol[3]; sol[58] -= b0c.z * sol[3]; sol[59] -= b0c.w * sol[3]; sol[60] -= b0d.x * sol[3]; sol[61] -= b0d.y * sol[3]; sol[62] -= b0d.z * sol[3]; sol[63] -= b0d.w * sol[3];
  __builtin_amdgcn_sched_barrier(0);
  b0a = *(const float4*)(Lr + 288); b0b = *(const float4*)(Lr + 292); b0c = *(const float4*)(Lr + 296); b0d = *(const float4*)(Lr + 300);
  __builtin_amdgcn_sched_barrier(0);
  sol[5] -= b1b.y * sol[4]; sol[6] -= b1b.z * sol[4]; sol[7] -= b1b.w * sol[4]; sol[8] -= b1c.x * sol[4]; sol[9] -= b1c.y * sol[4]; sol[10] -= b1c.z * sol[4]; sol[11] -= b1c.w * sol[4]; sol[12] -= b1d.x * sol[4]; sol[13] -= b1d.y * sol[4]; sol[14] -= b1d.z * sol[4]; sol[15] -= b1d.w * sol[4];
  __builtin_amdgcn_sched_barrier(0);
  b1a = *(const float4*)(Lr + 304); b1b = *(const float4*)(Lr + 308); b1c = *(const float4*)(Lr + 312); b1d = *(const float4*)(Lr + 316);
  __builtin_amdgcn_sched_barrier(0);
  sol[16] -= b2a.x * sol[4]; sol[17] -= b2a.y * sol[4]; sol[18] -= b2a.z * sol[4]; sol[19] -= b2a.w * sol[4]; sol[20] -= b2b.x * sol[4]; sol[21] -= b2b.y * sol[4]; sol[22] -= b2b.z * sol[4]; sol[23] -= b2b.w * sol[4]; sol[24] -= b2c.x * sol[4]; sol[25] -= b2c.y * sol[4]; sol[26] -= b2c.z * sol[4]; sol[27] -= b2c.w * sol[4]; sol[28] -= b2d.x * sol[4]; sol[29] -= b2d.y * sol[4]; sol[30] -= b2d.z * sol[4]; sol[31] -= b2d.w * sol[4];
  __builtin_amdgcn_sched_barrier(0);
  b2a = *(const float4*)(Lr + 320); b2b = *(const float4*)(Lr + 324); b2c = *(const float4*)(Lr + 328); b2d = *(const float4*)(Lr + 332);
  __builtin_amdgcn_sched_barrier(0);
  sol[32] -= b0a.x * sol[4]; sol[33] -= b0a.y * sol[4]; sol[34] -= b0a.z * sol[4]; sol[35] -= b0a.w * sol[4]; sol[36] -= b0b.x * sol[4]; sol[37] -= b0b.y * sol[4]; sol[38] -= b0b.z * sol[4]; sol[39] -= b0b.w * sol[4]; sol[40] -= b0c.x * sol[4]; sol[41] -= b0c.y * sol[4]; sol[42] -= b0c.z * sol[4]; sol[43] -= b0c.w * sol[4]; sol[44] -= b0d.x * sol[4]; sol[45] -= b0d.y * sol[4]; sol[46] -= b0d.z * sol[4]; sol[47] -= b0d.w * sol[4];
  __builtin_amdgcn_sched_barrier(0);
  b0a = *(const float4*)(Lr + 336); b0b = *(const float4*)(Lr + 340); b0c = *(const float4*)(Lr + 344); b0d = *(const float4*)(Lr + 348);
  __builtin_amdgcn_sched_barrier(0);
  sol[48] -= b1a.x * sol[4]; sol[49] -= b1a.y * sol[4]; sol[50] -= b1a.z * sol[4]; sol[51] -= b1a.w * sol[4]; sol[52] -= b1b.x * sol[4]; sol[53] -= b1b.y * sol[4]; sol[54] -= b1b.z * sol[4]; sol[55] -= b1b.w * sol[4]; sol[56] -= b1c.x * sol[4]; sol[57] -= b1c.y * sol[4]; sol[58] -= b1c.z * sol[4]; sol[59] -= b1c.w * sol[4]; sol[60] -= b1d.x * sol[4]; sol[61] -= b1d.y * sol[4]; sol[62] -= b1d.z * sol[4]; sol[63] -= b1d.w * sol[4];
  __builtin_amdgcn_sched_barrier(0);
  b1a = *(const float4*)(Lr + 352); b1b = *(const float4*)(Lr + 356); b1c = *(const float4*)(Lr + 360); b1d = *(const float4*)(Lr + 364);
  __builtin_amdgcn_sched_barrier(0);
  sol[6] -= b2b.z * sol[5]; sol[7] -= b2b.w * sol[5]; sol[8] -= b2c.x * sol[5]; sol[9] -= b2c.y * sol[5]; sol[10] -= b2c.z * sol[5]; sol[11] -= b2c.w * sol[5]; sol[12] -= b2d.x * sol[5]; sol[13] -= b2d.y * sol[5]; sol[14] -= b2d.z * sol[5]; sol[15] -= b2d.w * sol[5];
  __builtin_amdgcn_sched_barrier(0);
  b2a = *(const float4*)(Lr + 368); b2b = *(const float4*)(Lr + 372); b2c = *(const float4*)(Lr + 376); b2d = *(const float4*)(Lr + 380);
  __builtin_amdgcn_sched_barrier(0);
  sol[16] -= b0a.x * sol[5]; sol[17] -= b0a.y * sol[5]; sol[18] -= b0a.z * sol[5]; sol[19] -= b0a.w * sol[5]; sol[20] -= b0b.x * sol[5]; sol[21] -= b0b.y * sol[5]; sol[22] -= b0b.z * sol[5]; sol[23] -= b0b.w * sol[5]; sol[24] -= b0c.x * sol[5]; sol[25] -= b0c.y * sol[5]; sol[26] -= b0c.z * sol[5]; sol[27] -= b0c.w * sol[5]; sol[28] -= b0d.x * sol[5]; sol[29] -= b0d.y * sol[5]; sol[30] -= b0d.z * sol[5]; sol[31] -= b0d.w * sol[5];
  __builtin_amdgcn_sched_barrier(0);
  b0a = *(const float4*)(Lr + 384); b0b = *(const float4*)(Lr + 388); b0c = *(const float4*)(Lr + 392); b0d = *(const float4*)(Lr + 396);
  __builtin_amdgcn_sched_barrier(0);
  sol[32] -= b1a.x * sol[5]; sol[33] -= b1a.y * sol[5]; sol[34] -= b1a.z * sol[5]; sol[35] -= b1a.w * sol[5]; sol[36] -= b1b.x * sol[5]; sol[37] -= b1b.y * sol[5]; sol[38] -= b1b.z * sol[5]; sol[39] -= b1b.w * sol[5]; sol[40] -= b1c.x * sol[5]; sol[41] -= b1c.y * sol[5]; sol[42] -= b1c.z * sol[5]; sol[43] -= b1c.w * sol[5]; sol[44] -= b1d.x * sol[5]; sol[45] -= b1d.y * sol[5]; sol[46] -= b1d.z * sol[5]; sol[47] -= b1d.w * sol[5];
  __builtin_amdgcn_sched_barrier(0);
  b1a = *(const float4*)(Lr + 400); b1b = *(const float4*)(Lr + 404); b1c = *(const float4*)(Lr + 408); b1d = *(const float4*)(Lr + 412);
  __builtin_amdgcn_sched_barrier(0);
  sol[48] -= b2a.x * sol[5]; sol[49] -= b2a.y * sol[5]; sol[50] -= b2a.z * sol[5]; sol[51] -= b2a.w * sol[5]; sol[52] -= b2b.x * sol[5]; sol[53] -= b2b.y * sol[5]; sol[54] -= b2b.z * sol[5]; sol[55] -= b2b.w * sol[5]; sol[56] -= b2c.x * sol[5]; sol[57] -= b2c.y * sol[5]; sol[58] -= b2c.z * sol[5]; sol[59] -= b2c.w * sol[5]; sol[60] -= b2d.x * sol[5]; sol[61] -= b2d.y * sol[5]; sol[62] -= b2d.z * sol[5]; sol[63] -= b2d.w * sol[5];
  __builtin_amdgcn_sched_barrier(0);
  b2a = *(const float4*)(Lr + 416); b2b = *(const float4*)(Lr + 420); b2c = *(const float4*)(Lr + 424); b2d = *(const float4*)(Lr + 428);
  __builtin_amdgcn_sched_barrier(0);
  sol[7] -= b0b.w * sol[6]; sol[8] -= b0c.x * sol[6]; sol[9] -= b0c.y * sol[6]; sol[10] -= b0c.z * sol[6]; sol[11] -= b0c.w * sol[6]; sol[12] -= b0d.x * sol[6]; sol[13] -= b0d.y * sol[6]; sol[14] -= b0d.z * sol[6]; sol[15] -= b0d.w * sol[6];
  __builtin_amdgcn_sched_barrier(0);
  b0a = *(const float4*)(Lr + 432); b0b = *(const float4*)(Lr + 436); b0c = *(const float4*)(Lr + 440); b0d = *(const float4*)(Lr + 444);
  __builtin_amdgcn_sched_barrier(0);
  sol[16] -= b1a.x * sol[6]; sol[17] -= b1a.y * sol[6]; sol[18] -= b1a.z * sol[6]; sol[19] -= b1a.w * sol[6]; sol[20] -= b1b.x * sol[6]; sol[21] -= b1b.y * sol[6]; sol[22] -= b1b.z * sol[6]; sol[23] -= b1b.w * sol[6]; sol[24] -= b1c.x * sol[6]; sol[25] -= b1c.y * sol[6]; sol[26] -= b1c.z * sol[6]; sol[27] -= b1c.w * sol[6]; sol[28] -= b1d.x * sol[6]; sol[29] -= b1d.y * sol[6]; sol[30] -= b1d.z * sol[6]; sol[31] -= b1d.w * sol[6];
  __builtin_amdgcn_sched_barrier(0);
  b1a = *(const float4*)(Lr + 448); b1b = *(const float4*)(Lr + 452); b1c = *(const float4*)(Lr + 456); b1d = *(const float4*)(Lr + 460);
  __builtin_amdgcn_sched_barrier(0);
  sol[32] -= b2a.x * sol[6]; sol[33] -= b2a.y * sol[6]; sol[34] -= b2a.z * sol[6]; sol[35] -= b2a.w * sol[6]; sol[36] -= b2b.x * sol[6]; sol[37] -= b2b.y * sol[6]; sol[38] -= b2b.z * sol[6]; sol[39] -= b2b.w * sol[6]; sol[40] -= b2c.x * sol[6]; sol[41] -= b2c.y * sol[6]; sol[42] -= b2c.z * sol[6]; sol[43] -= b2c.w * sol[6]; sol[44] -= b2d.x * sol[6]; sol[45] -= b2d.y * sol[6]; sol[46] -= b2d.z * sol[6]; sol[47] -= b2d.w * sol[6];
  __builtin_amdgcn_sched_barrier(0);
  b2a = *(const float4*)(Lr + 464); b2b = *(const float4*)(Lr + 468); b2c = *(const float4*)(Lr + 472); b2d = *(const float4*)(Lr + 476);
  __builtin_amdgcn_sched_barrier(0);
  sol[48] -= b0a.x * sol[6]; sol[49] -= b0a.y * sol[6]; sol[50] -= b0a.z * sol[6]; sol[51] -= b0a.w * sol[6]; sol[52] -= b0b.x * sol[6]; sol[53] -= b0b.y * sol[6]; sol[54] -= b0b.z * sol[6]; sol[55] -= b0b.w * sol[6]; sol[56] -= b0c.x * sol[6]; sol[57] -= b0c.y * sol[6]; sol[58] -= b0c.z * sol[6]; sol[59] -= b0c.w * sol[6]; sol[60] -= b0d.x * sol[6]; sol[61] -= b0d.y * sol[6]; sol[62] -= b0d.z * sol[6]; sol[63] -= b0d.w * sol[6];
  __builtin_amdgcn_sched_barrier(0);
  b0a = *(const float4*)(Lr + 480); b0b = *(const float4*)(Lr + 484); b0c = *(const float4*)(Lr + 488); b0d = *(const float4*)(Lr + 492);
  __builtin_amdgcn_sched_barrier(0);
  sol[8] -= b1c.x * sol[7]; sol[9] -= b1c.y * sol[7]; sol[10] -= b1c.z * sol[7]; sol[11] -= b1c.w * sol[7]; sol[12] -= b1d.x * sol[7]; sol[13] -= b1d.y * sol[7]; sol[14] -= b1d.z * sol[7]; sol[15] -= b1d.w * sol[7];
  __builtin_amdgcn_sched_barrier(0);
  b1a = *(const float4*)(Lr + 496); b1b = *(const float4*)(Lr + 500); b1c = *(const float4*)(Lr + 504); b1d = *(const float4*)(Lr + 508);
  __builtin_amdgcn_sched_barrier(0);
  sol[16] -= b2a.x * sol[7]; sol[17] -= b2a.y * sol[7]; sol[18] -= b2a.z * sol[7]; sol[19] -= b2a.w * sol[7]; sol[20] -= b2b.x * sol[7]; sol[21] -= b2b.y * sol[7]; sol[22] -= b2b.z * sol[7]; sol[23] -= b2b.w * sol[7]; sol[24] -= b2c.x * sol[7]; sol[25] -= b2c.y * sol[7]; sol[26] -= b2c.z * sol[7]; sol[27] -= b2c.w * sol[7]; sol[28] -= b2d.x * sol[7]; sol[29] -= b2d.y * sol[7]; sol[30] -= b2d.z * sol[7]; sol[31] -= b2d.w * sol[7];
  __builtin_amdgcn_sched_barrier(0);
  b2a = *(const float4*)(Lr + 512); b2b = *(const float4*)(Lr + 516); b2c = *(const float4*)(Lr + 520); b2d = *(const float4*)(Lr + 524);
  __builtin_amdgcn_sched_barrier(0);
  sol[32] -= b0a.x * sol[7]; sol[33] -= b0a.y * sol[7]; sol[34] -= b0a.z * sol[7]; sol[35] -= b0a.w * sol[7]; sol[36] -= b0b.x * sol[7]; sol[37] -= b0b.y * sol[7]; sol[38] -= b0b.z * sol[7]; sol[39] -= b0b.w * sol[7]; sol[40] -= b0c.x * sol[7]; sol[41] -= b0c.y * sol[7]; sol[42] -= b0c.z * sol[7]; sol[43] -= b0c.w * sol[7]; sol[44] -= b0d.x * sol[7]; sol[45] -= b0d.y * sol[7]; sol[46] -= b0d.z * sol[7]; sol[47] -= b0d.w * sol[7];
  __builtin_amdgcn_sched_barrier(0);
  b0a = *(const float4*)(Lr + 528); b0b = *(const float4*)(Lr + 532); b0c = *(const float4*)(Lr + 536); b0d = *(const float4*)(Lr + 540);
  __builtin_amdgcn_sched_barrier(0);
  sol[48] -= b1a.x * sol[7]; sol[49] -= b1a.y * sol[7]; sol[50] -= b1a.z * sol[7]; sol[51] -= b1a.w * sol[7]; sol[52] -= b1b.x * sol[7]; sol[53] -= b1b.y * sol[7]; sol[54] -= b1b.z * sol[7]; sol[55] -= b1b.w * sol[7]; sol[56] -= b1c.x * sol[7]; sol[57] -= b1c.y * sol[7]; sol[58] -= b1c.z * sol[7]; sol[59] -= b1c.w * sol[7]; sol[60] -= b1d.x * sol[7]; sol[61] -= b1d.y * sol[7]; sol[62] -= b1d.z * sol[7]; sol[63] -= b1d.w * sol[7];
  __builtin_amdgcn_sched_barrier(0);
  b1a = *(const float4*)(Lr + 544); b1b = *(const float4*)(Lr + 548); b1c = *(const float4*)(Lr + 552); b1d = *(const float4*)(Lr + 556);
  __builtin_amdgcn_sched_barrier(0);
  sol[9] -= b2c.y * sol[8]; sol[10] -= b2c.z * sol[8]; sol[11] -= b2c.w * sol[8]; sol[12] -= b2d.x * sol[8]; sol[13] -= b2d.y * sol[8]; sol[14] -= b2d.z * sol[8]; sol[15] -= b2d.w * sol[8];
  __builtin_amdgcn_sched_barrier(0);
  b2a = *(const float4*)(Lr + 560); b2b = *(const float4*)(Lr + 564); b2c = *(const float4*)(Lr + 568); b2d = *(const float4*)(Lr + 572);
  __builtin_amdgcn_sched_barrier(0);
  sol[16] -= b0a.x * sol[8]; sol[17] -= b0a.y * sol[8]; sol[18] -= b0a.z * sol[8]; sol[19] -= b0a.w * sol[8]; sol[20] -= b0b.x * sol[8]; sol[21] -= b0b.y * sol[8]; sol[22] -= b0b.z * sol[8]; sol[23] -= b0b.w * sol[8]; sol[24] -= b0c.x * sol[8]; sol[25] -= b0c.y * sol[8]; sol[26] -= b0c.z * sol[8]; sol[27] -= b0c.w * sol[8]; sol[28] -= b0d.x * sol[8]; sol[29] -= b0d.y * sol[8]; sol[30] -= b0d.z * sol[8]; sol[31] -= b0d.w * sol[8];
  __builtin_amdgcn_sched_barrier(0);
  b0a = *(const float4*)(Lr + 576); b0b = *(const float4*)(Lr + 580); b0c = *(const float4*)(Lr + 584); b0d = *(const float4*)(Lr + 588);
  __builtin_amdgcn_sched_barrier(0);
  sol[32] -= b1a.x * sol[8]; sol[33] -= b1a.y * sol[8]; sol[34] -= b1a.z * sol[8]; sol[35] -= b1a.w * sol[8]; sol[36] -= b1b.x * sol[8]; sol[37] -= b1b.y * sol[8]; sol[38] -= b1b.z * sol[8]; sol[39] -= b1b.w * sol[8]; sol[40] -= b1c.x * sol[8]; sol[41] -= b1c.y * sol[8]; sol[42] -= b1c.z * sol[8]; sol[43] -= b1c.w * sol[8]; sol[44] -= b1d.x * sol[8]; sol[45] -= b1d.y * sol[8]; sol[46] -= b1d.z * sol[8]; sol[47] -= b1d.w * sol[8];
  __builtin_amdgcn_sched_barrier(0);
  b1a = *(const float4*)(Lr + 592); b1b = *(const float4*)(Lr + 596); b1c = *(const float4*)(Lr + 600); b1d = *(const float4*)(Lr + 604);
  __builtin_amdgcn_sched_barrier(0);
  sol[48] -= b2a.x * sol[8]; sol[49] -= b2a.y * sol[8]; sol[50] -= b2a.z * sol[8]; sol[51] -= b2a.w * sol[8]; sol[52] -= b2b.x * sol[8]; sol[53] -= b2b.y * sol[8]; sol[54] -= b2b.z * sol[8]; sol[55] -= b2b.w * sol[8]; sol[56] -= b2c.x * sol[8]; sol[57] -= b2c.y * sol[8]; sol[58] -= b2c.z * sol[8]; sol[59] -= b2c.w * sol[8]; sol[60] -= b2d.x * sol[8]; sol[61] -= b2d.y * sol[8]; sol[62] -= b2d.z * sol[8]; sol[63] -= b2d.w * sol[8];
  __builtin_amdgcn_sched_barrier(0);
  b2a = *(const float4*)(Lr + 608); b2b = *(const float4*)(Lr + 612); b2c = *(const float4*)(Lr + 616); b2d = *(const float4*)(Lr + 620);
  __builtin_amdgcn_sched_barrier(0);
  sol[10] -= b0c.z * sol[9]; sol[11] -= b0c.w * sol[9]; sol[12] -= b0d.x * sol[9]; sol[13] -= b0d.y * sol[9]; sol[14] -= b0d.z * sol[9]; sol[15] -= b0d.w * sol[9];
  __builtin_amdgcn_sched_barrier(0);
  b0a = *(const float4*)(Lr + 624); b0b = *(const float4*)(Lr + 628); b0c = *(const float4*)(Lr + 632); b0d = *(const float4*)(Lr + 636);
  __builtin_amdgcn_sched_barrier(0);
  sol[16] -= b1a.x * sol[9]; sol[17] -= b1a.y * sol[9]; sol[18] -= b1a.z * sol[9]; sol[19] -= b1a.w * sol[9]; sol[20] -= b1b.x * sol[9]; sol[21] -= b1b.y * sol[9]; sol[22] -= b1b.z * sol[9]; sol[23] -= b1b.w * sol[9]; sol[24] -= b1c.x * sol[9]; sol[25] -= b1c.y * sol[9]; sol[26] -= b1c.z * sol[9]; sol[27] -= b1c.w * sol[9]; sol[28] -= b1d.x * sol[9]; sol[29] -= b1d.y * sol[9]; sol[30] -= b1d.z * sol[9]; sol[31] -= b1d.w * sol[9];
  __builtin_amdgcn_sched_barrier(0);
  b1a = *(const float4*)(Lr + 640); b1b = *(const float4*)(Lr + 644); b1c = *(const float4*)(Lr + 648); b1d = *(const float4*)(Lr + 652);
  __builtin_amdgcn_sched_barrier(0);
  sol[32] -= b2a.x * sol[9]; sol[33] -= b2a.y * sol[9]; sol[34] -= b2a.z * sol[9]; sol[35] -= b2a.w * sol[9]; sol[36] -= b2b.x * sol[9]; sol[37] -= b2b.y * sol[9]; sol[38] -= b2b.z * sol[9]; sol[39] -= b2b.w * sol[9]; sol[40] -= b2c.x * sol[9]; sol[41] -= b2c.y * sol[9]; sol[42] -= b2c.z * sol[9]; sol[43] -= b2c.w * sol[9]; sol[44] -= b2d.x * sol[9]; sol[45] -= b2d.y * sol[9]; sol[46] -= b2d.z * sol[9]; sol[47] -= b2d.w * sol[9];
  __builtin_amdgcn_sched_barrier(0);
  b2a = *(const float4*)(Lr + 656); b2b = *(const float4*)(Lr + 660); b2c = *(const float4*)(Lr + 664); b2d = *(const float4*)(Lr + 668);
  __builtin_amdgcn_sched_barrier(0);
  sol[48] -= b0a.x * sol[9]; sol[49] -= b0a.y * sol[9]; sol[50] -= b0a.z * sol[9]; sol[51] -= b0a.w * sol[9]; sol[52] -= b0b.x * sol[9]; sol[53] -= b0b.y * sol[9]; sol[54] -= b0b.z * sol[9]; sol[55] -= b0b.w * sol[9]; sol[56] -= b0c.x * sol[9]; sol[57] -= b0c.y * sol[9]; sol[58] -= b0c.z * sol[9]; sol[59] -= b0c.w * sol[9]; sol[60] -= b0d.x * sol[9]; sol[61] -= b0d.y * sol[9]; sol[62] -= b0d.z * sol[9]; sol[63] -= b0d.w * sol[9];
  __builtin_amdgcn_sched_barrier(0);
  b0a = *(const float4*)(Lr + 672); b0b = *(const float4*)(Lr + 676); b0c = *(const float4*)(Lr + 680); b0d = *(const float4*)(Lr + 684);
  __builtin_amdgcn_sched_barrier(0);
  sol[11] -= b1c.w * sol[10]; sol[12] -= b1d.x * sol[10]; sol[13] -= b1d.y * sol[10]; sol[14] -= b1d.z * sol[10]; sol[15] -= b1d.w * sol[10];
  __builtin_amdgcn_sched_barrier(0);
  b1a = *(const float4*)(Lr + 688); b1b = *(const float4*)(Lr + 692); b1c = *(const float4*)(Lr + 696); b1d = *(const float4*)(Lr + 700);
  __builtin_amdgcn_sched_barrier(0);
  sol[16] -= b2a.x * sol[10]; sol[17] -= b2a.y * sol[10]; sol[18] -= b2a.z * sol[10]; sol[19] -= b2a.w * sol[10]; sol[20] -= b2b.x * sol[10]; sol[21] -= b2b.y * sol[10]; sol[22] -= b2b.z * sol[10]; sol[23] -= b2b.w * sol[10]; sol[24] -= b2c.x * sol[10]; sol[25] -= b2c.y * sol[10]; sol[26] -= b2c.z * sol[10]; sol[27] -= b2c.w * sol[10]; sol[28] -= b2d.x * sol[10]; sol[29] -= b2d.y * sol[10]; sol[30] -= b2d.z * sol[10]; sol[31] -= b2d.w * sol[10];
  __builtin_amdgcn_sched_barrier(0);
  b2a = *(const float4*)(Lr + 704); b2b = *(const float4*)(Lr + 708); b2c = *(const float4*)(Lr + 712); b2d = *(const float4*)(Lr + 716);
  __builtin_amdgcn_sched_barrier(0);
  sol[32] -= b0a.x * sol[10]; sol[33] -= b0a.y * sol[10]; sol[34] -= b0a.z * sol[10]; sol[35] -= b0a.w * sol[10]; sol[36] -= b0b.x * sol[10]; sol[37] -= b0b.y * sol[10]; sol[38] -= b0b.z * sol[10]; sol[39] -= b0b.w * sol[10]; sol[40] -= b0c.x * sol[10]; sol[41] -= b0c.y * sol[10]; sol[42] -= b0c.z * sol[10]; sol[43] -= b0c.w * sol[10]; sol[44] -= b0d.x * sol[10]; sol[45] -= b0d.y * sol[10]; sol[46] -= b0d.z * sol[10]; sol[47] -= b0d.w * sol[10];
  __builtin_amdgcn_sched_barrier(0);
  b0a = *(const float4*)(Lr + 720); b0b = *(const float4*)(Lr + 724); b0c = *(const float4*)(Lr + 728); b0d = *(const float4*)(Lr + 732);
  __builtin_amdgcn_sched_barrier(0);
  sol[48] -= b1a.x * sol[10]; sol[49] -= b1a.y * sol[10]; sol[50] -= b1a.z * sol[10]; sol[51] -= b1a.w * sol[10]; sol[52] -= b1b.x * sol[10]; sol[53] -= b1b.y * sol[10]; sol[54] -= b1b.z * sol[10]; sol[55] -= b1b.w * sol[10]; sol[56] -= b1c.x * sol[10]; sol[57] -= b1c.y * sol[10]; sol[58] -= b1c.z * sol[10]; sol[59] -= b1c.w * sol[10]; sol[60] -= b1d.x * sol[10]; sol[61] -= b1d.y * sol[10]; sol[62] -= b1d.z * sol[10]; sol[63] -= b1d.w * sol[10];
  __builtin_amdgcn_sched_barrier(0);
  b1a = *(const float4*)(Lr + 736); b1b = *(const float4*)(Lr + 740); b1c = *(const float4*)(Lr + 744); b1d = *(const float4*)(Lr + 748);
  __builtin_amdgcn_sched_barrier(0);
  sol[12] -= b2d.x * sol[11]; sol[13] -= b2d.y * sol[11]; sol[14] -= b2d.z * sol[11]; sol[15] -= b2d.w * sol[11];
  __builtin_amdgcn_sched_barrier(0);
  b2a = *(const float4*)(Lr + 752); b2b = *(const float4*)(Lr + 756); b2c = *(const float4*)(Lr + 760); b2d = *(const float4*)(Lr + 764);
  __builtin_amdgcn_sched_barrier(0);
  sol[16] -= b0a.x * sol[11]; sol[17] -= b0a.y * sol[11]; sol[18] -= b0a.z * sol[11]; sol[19] -= b0a.w * sol[11]; sol[20] -= b0b.x * sol[11]; sol[21] -= b0b.y * sol[11]; sol[22] -= b0b.z * sol[11]; sol[23] -= b0b.w * sol[11]; sol[24] -= b0c.x * sol[11]; sol[25] -= b0c.y * sol[11]; sol[26] -= b0c.z * sol[11]; sol[27] -= b0c.w * sol[11]; sol[28] -= b0d.x * sol[11]; sol[29] -= b0d.y * sol[11]; sol[30] -= b0d.z * sol[11]; sol[31] -= b0d.w * sol[11];
  __builtin_amdgcn_sched_barrier(0);
  b0a = *(const float4*)(Lr + 768); b0b = *(const float4*)(Lr + 772); b0c = *(const float4*)(Lr + 776); b0d = *(const float4*)(Lr + 780);
  __builtin_amdgcn_sched_barrier(0);
  sol[32] -= b1a.x * sol[11]; sol[33] -= b1a.y * sol[11]; sol[34] -= b1a.z * sol[11]; sol[35] -= b1a.w * sol[11]; sol[36] -= b1b.x * sol[11]; sol[37] -= b1b.y * sol[11]; sol[38] -= b1b.z * sol[11]; sol[39] -= b1b.w * sol[11]; sol[40] -= b1c.x * sol[11]; sol[41] -= b1c.y * sol[11]; sol[42] -= b1c.z * sol[11]; sol[43] -= b1c.w * sol[11]; sol[44] -= b1d.x * sol[11]; sol[45] -= b1d.y * sol[11]; sol[46] -= b1d.z * sol[11]; sol[47] -= b1d.w * sol[11];
  __builtin_amdgcn_sched_barrier(0);
  b1a = *(const float4*)(Lr + 784); b1b = *(const float4*)(Lr + 788); b1c = *(const float4*)(Lr + 792); b1d = *(const float4*)(Lr + 796);
  __builtin_amdgcn_sched_barrier(0);
  sol[48] -= b2a.x * sol[11]; sol[49] -= b2a.y * sol[11]; sol[50] -= b2a.z * sol[11]; sol[51] -= b2a.w * sol[11]; sol[52] -= b2b.x * sol[11]; sol[53] -= b2b.y * sol[11]; sol[54] -= b2b.z * sol[11]; sol[55] -= b2b.w * sol[11]; sol[56] -= b2c.x * sol[11]; sol[57] -= b2c.y * sol[11]; sol[58] -= b2c.z * sol[11]; sol[59] -= b2c.w * sol[11]; sol[60] -= b2d.x * sol[11]; sol[61] -= b2d.y * sol[11]; sol[62] -= b2d.z * sol[11]; sol[63] -= b2d.w * sol[11];
  __builtin_amdgcn_sched_barrier(0);
  b2a = *(const float4*)(Lr + 800); b2b = *(const float4*)(Lr + 804); b2c = *(const float4*)(Lr + 808); b2d = *(const float4*)(Lr + 812);
  __builtin_amdgcn_sched_barrier(0);
  sol[13] -= b0d.y * sol[12]; sol[14] -= b0d.z * sol[12]; sol[15] -= b0d.w * sol[12];
  __builtin_amdgcn_sched_barrier(0);
  b0a = *(const float4*)(Lr + 816); b0b = *(const float4*)(Lr + 820); b0c = *(const float4*)(Lr + 824); b0d = *(const float4*)(Lr + 828);
  __builtin_amdgcn_sched_barrier(0);
  sol[16] -= b1a.x * sol[12]; sol[17] -= b1a.y * sol[12]; sol[18] -= b1a.z * sol[12]; sol[19] -= b1a.w * sol[12]; sol[20] -= b1b.x * sol[12]; sol[21] -= b1b.y * sol[12]; sol[22] -= b1b.z * sol[12]; sol[23] -= b1b.w * sol[12]; sol[24] -= b1c.x * sol[12]; sol[25] -= b1c.y * sol[12]; sol[26] -= b1c.z * sol[12]; sol[27] -= b1c.w * sol[12]; sol[28] -= b1d.x * sol[12]; sol[29] -= b1d.y * sol[12]; sol[30] -= b1d.z * sol[12]; sol[31] -= b1d.w * sol[12];
  __builtin_amdgcn_sched_barrier(0);
  b1a = *(const float4*)(Lr + 832); b1b = *(const float4*)(Lr + 836); b1c = *(const float4*)(Lr + 840); b1d = *(const float4*)(Lr + 844);
  __builtin_amdgcn_sched_barrier(0);
  sol[32] -= b2a.x * sol[12]; sol[33] -= b2a.y * sol[12]; sol[34] -= b2a.z * sol[12]; sol[35] -= b2a.w * sol[12]; sol[36] -= b2b.x * sol[12]; sol[37] -= b2b.y * sol[12]; sol[38] -= b2b.z * sol[12]; sol[39] -= b2b.w * sol[12]; sol[40] -= b2c.x * sol[12]; sol[41] -= b2c.y * sol[12]; sol[42] -= b2c.z * sol[12]; sol[43] -= b2c.w * sol[12]; sol[44] -= b2d.x * sol[12]; sol[45] -= b2d.y * sol[12]; sol[46] -= b2d.z * sol[12]; sol[47] -= b2d.w * sol[12];
  __builtin_amdgcn_sched_barrier(0);
  b2a = *(const float4*)(Lr + 848); b2b = *(const float4*)(Lr + 852); b2c = *(const float4*)(Lr + 856); b2d = *(const float4*)(Lr + 860);
  __builtin_amdgcn_sched_barrier(0);
  sol[48] -= b0a.x * sol[12]; sol[49] -= b0a.y * sol[12]; sol[50] -= b0a.z * sol[12]; sol[51] -= b0a.w * sol[12]; sol[52] -= b0b.x * sol[12]; sol[53] -= b0b.y * sol[12]; sol[54] -= b0b.z * sol[12]; sol[55] -= b0b.w * sol[12]; sol[56] -= b0c.x * sol[12]; sol[57] -= b0c.y * sol[12]; sol[58] -= b0c.z * sol[12]; sol[59] -= b0c.w * sol[12]; sol[60] -= b0d.x * sol[12]; sol[61] -= b0d.y * sol[12]; sol[62] -= b0d.z * sol[12]; sol[63] -= b0d.w * sol[12];
  __builtin_amdgcn_sched_barrier(0);
  b0a = *(const float4*)(Lr + 864); b0b = *(const float4*)(Lr + 868); b0c = *(const float4*)(Lr + 872); b0d = *(const float4*)(Lr + 876);
  __builtin_amdgcn_sched_barrier(0);
  sol[14] -= b1d.z * sol[13]; sol[15] -= b1d.w * sol[13];
  __builtin_amdgcn_sched_barrier(0);
  b1a = *(const float4*)(Lr + 880); b1b = *(const float4*)(Lr + 884); b1c = *(const float4*)(Lr + 888); b1d = *(const float4*)(Lr + 892);
  __builtin_amdgcn_sched_barrier(0);
  sol[16] -= b2a.x * sol[13]; sol[17] -= b2a.y * sol[13]; sol[18] -= b2a.z * sol[13]; sol[19] -= b2a.w * sol[13]; sol[20] -= b2b.x * sol[13]; sol[21] -= b2b.y * sol[13]; sol[22] -= b2b.z * sol[13]; sol[23] -= b2b.w * sol[13]; sol[24] -= b2c.x * sol[13]; sol[25] -= b2c.y * sol[13]; sol[26] -= b2c.z * sol[13]; sol[27] -= b2c.w * sol[13]; sol[28] -= b2d.x * sol[13]; sol[29] -= b2d.y * sol[13]; sol[30] -= b2d.z * sol[13]; sol[31] -= b2d.w * sol[13];
  __builtin_amdgcn_sched_barrier(0);
  b2a = *(const float4*)(Lr + 896); b2b = *(const float4*)(Lr + 900); b2c = *(const float4*)(Lr + 904); b2d = *(const float4*)(Lr + 908);
  __builtin_amdgcn_sched_barrier(0);
  sol[32] -= b0a.x * sol[13]; sol[33] -= b0a.y * sol[13]; sol[34] -= b0a.z * sol[13]; sol[35] -= b0a.w * sol[13]; sol[36] -= b0b.x * sol[13]; sol[37] -= b0b.y * sol[13]; sol[38] -= b0b.z * sol[13]; sol[39] -= b0b.w * sol[13]; sol[40] -= b0c.x * sol[13]; sol[41] -= b0c.y * sol[13]; sol[42] -= b0c.z * sol[13]; sol[43] -= b0c.w * sol[13]; sol[44] -= b0d.x * sol[13]; sol[45] -= b0d.y * sol[13]; sol[46] -= b0d.z * sol[13]; sol[47] -= b0d.w * sol[13];
  __builtin_amdgcn_sched_barrier(0);
  b0a = *(const float4*)(Lr + 912); b0b = *(const float4*)(Lr + 916); b0c = *(const float4*)(Lr + 920); b0d = *(const float4*)(Lr + 924);
  __builtin_amdgcn_sched_barrier(0);
  sol[48] -= b1a.x * sol[13]; sol[49] -= b1a.y * sol[13]; sol[50] -= b1a.z * sol[13]; sol[51] -= b1a.w * sol[13]; sol[52] -= b1b.x * sol[13]; sol[53] -= b1b.y * sol[13]; sol[54] -= b1b.z * sol[13]; sol[55] -= b1b.w * sol[13]; sol[56] -= b1c.x * sol[13]; sol[57] -= b1c.y * sol[13]; sol[58] -= b1c.z * sol[13]; sol[59] -= b1c.w * sol[13]; sol[60] -= b1d.x * sol[13]; sol[61] -= b1d.y * sol[13]; sol[62] -= b1d.z * sol[13]; sol[63] -= b1d.w * sol[13];
  __builtin_amdgcn_sched_barrier(0);
  b1a = *(const float4*)(Lr + 928); b1b = *(const float4*)(Lr + 932); b1c = *(const float4*)(Lr + 936); b1d = *(const float4*)(Lr + 940);
  __builtin_amdgcn_sched_barrier(0);
  sol[15] -= b2d.w * sol[14];
  __builtin_amdgcn_sched_barrier(0);
  b2a = *(const float4*)(Lr + 944); b2b = *(const float4*)(Lr + 948); b2c = *(const float4*)(Lr + 952); b2d = *(const float4*)(Lr + 956);
  __builtin_amdgcn_sched_barrier(0);
  sol[16] -= b0a.x * sol[14]; sol[17] -= b0a.y * sol[14]; sol[18] -= b0a.z * sol[14]; sol[19] -= b0a.w * sol[14]; sol[20] -= b0b.x * sol[14]; sol[21] -= b0b.y * sol[14]; sol[22] -= b0b.z * sol[14]; sol[23] -= b0b.w * sol[14]; sol[24] -= b0c.x * sol[14]; sol[25] -= b0c.y * sol[14]; sol[26] -= b0c.z * sol[14]; sol[27] -= b0c.w * sol[14]; sol[28] -= b0d.x * sol[14]; sol[29] -= b0d.y * sol[14]; sol[30] -= b0d.z * sol[14]; sol[31] -= b0d.w * sol[14];
  __builtin_amdgcn_sched_barrier(0);
  b0a = *(const float4*)(Lr + 976); b0b = *(const float4*)(Lr + 980); b0c = *(const float4*)(Lr + 984); b0d = *(const float4*)(Lr + 988);
  __builtin_amdgcn_sched_barrier(0);
  sol[32] -= b1a.x * sol[14]; sol[33] -= b1a.y * sol[14]; sol[34] -= b1a.z * sol[14]; sol[35] -= b1a.w * sol[14]; sol[36] -= b1b.x * sol[14]; sol[37] -= b1b.y * sol[14]; sol[38] -= b1b.z * sol[14]; sol[39] -= b1b.w * sol[14]; sol[40] -= b1c.x * sol[14]; sol[41] -= b1c.y * sol[14]; sol[42] -= b1c.z * sol[14]; sol[43] -= b1c.w * sol[14]; sol[44] -= b1d.x * sol[14]; sol[45] -= b1d.y * sol[14]; sol[46] -= b1d.z * sol[14]; sol[47] -= b1d.w * sol[14];
  __builtin_amdgcn_sched_barrier(0);
  b1a = *(const float4*)(Lr + 992); b1b = *(const float4*)(Lr + 996); b1c = *(const float4*)(Lr + 1000); b1d = *(const float4*)(Lr + 1004);
  __builtin_amdgcn_sched_barrier(0);
  sol[48] -= b2a.x * sol[14]; sol[49] -= b2a.y * sol[14]; sol[50] -= b2a.z * sol[14]; sol[51] -= b2a.w * sol[14]; sol[52] -= b2b.x * sol[14]; sol[53] -= b2b.y * sol[14]; sol[54] -= b2b.z * sol[14]; sol[55] -= b2b.w * sol[14]; sol[56] -= b2c.x * sol[14]; sol[57] -= b2c.y * sol[14]; sol[58] -= b2c.z * sol[14]; sol[59] -= b2c.w * sol[14]; sol[60] -= b2d.x * sol[14]; sol[61] -= b2d.y * sol[14]; sol[62] -= b2d.z * sol[14]; sol[63] -= b2d.w * sol[14];
  __builtin_amdgcn_sched_barrier(0);
  b2a = *(const float4*)(Lr + 1008); b2b = *(const float4*)(Lr + 1012); b2c = *(const float4*)(Lr + 1016); b2d = *(const float4*)(Lr + 1020);
  __builtin_amdgcn_sched_barrier(0);
  sol[16] -= b0a.x * sol[15]; sol[17] -= b0a.y * sol[15]; sol[18] -= b0a.z * sol[15]; sol[19] -= b0a.w * sol[15]; sol[20] -= b0b.x * sol[15]; sol[21] -= b0b.y * sol[15]; sol[22] -= b0b.z * sol[15]; sol[23] -= b0b.w * sol[15]; sol[24] -= b0c.x * sol[15]; sol[25] -= b0c.y * sol[15]; sol[26] -= b0c.z * sol[15]; sol[27] -= b0c.w * sol[15]; sol[28] -= b0d.x * sol[15]; sol[29] -= b0d.y * sol[15]; sol[30] -= b0d.z * sol[15]; sol[31] -= b0d.w * sol[15];
  __builtin_amdgcn_sched_barrier(0);
  b0a = *(const float4*)(Lr + 1040); b0b = *(const float4*)(Lr + 1044); b0c = *(const float4*)(Lr + 1048); b0d = *(const float4*)(Lr + 1052);
  __builtin_amdgcn_sched_barrier(0);
  sol[32] -= b1a.x * sol[15]; sol[33] -= b1a.y * sol[15]; sol[34] -= b1a.z * sol[15]; sol[35] -= b1a.w * sol[15]; sol[36] -= b1b.x * sol[15]; sol[37] -= b1b.y * sol[15]; sol[38] -= b1b.z * sol[15]; sol[39] -= b1b.w * sol[15]; sol[40] -= b1c.x * sol[15]; sol[41] -= b1c.y * sol[15]; sol[42] -= b1c.z * sol[15]; sol[43] -= b1c.w * sol[15]; sol[44] -= b1d.x * sol[15]; sol[45] -= b1d.y * sol[15]; sol[46] -= b1d.z * sol[15]; sol[47] -= b1d.w * sol[15];
  __builtin_amdgcn_sched_barrier(0);
  b1a = *(const float4*)(Lr + 1056); b1b = *(const float4*)(Lr + 1060); b1c = *(const float4*)(Lr + 1064); b1d = *(const float4*)(Lr + 1068);
  __builtin_amdgcn_sched_barrier(0);
  sol[48] -= b2a.x * sol[15]; sol[49] -= b2a.y * sol[15]; sol[50] -= b2a.z * sol[15]; sol[51] -= b2a.w * sol[15]; sol[52] -= b2b.x * sol[15]; sol[53] -= b2b.y * sol[15]; sol[54] -= b2b.z * sol[15]; sol[55] -= b2b.w * sol[15]; sol[56] -= b2c.x * sol[15]; sol[57] -= b2c.y * sol[15]; sol[58] -= b2c.z * sol[15]; sol[59] -= b2c.w * sol[15]; sol[60] -= b2d.x * sol[15]; sol[61] -= b2d.y * sol[15]; sol[62] -= b2d.z * sol[15]; sol[63] -= b2d.w * sol[15];
  __builtin_amdgcn_sched_barrier(0);
  b2a = *(const float4*)(Lr + 1072); b2b = *(const float4*)(Lr + 1076); b2c = *(const float4*)(Lr + 1080); b2d = *(const float4*)(Lr + 1084);
  __builtin_amdgcn_sched_barrier(0);
  sol[17] -= b0a.y * sol[16]; sol[18] -= b0a.z * sol[16]; sol[19] -= b0a.w * sol[16]; sol[20] -= b0b.x * sol[16]; sol[21] -= b0b.y * sol[16]; sol[22] -= b0b.z * sol[16]; sol[23] -= b0b.w * sol[16]; sol[24] -= b0c.x * sol[16]; sol[25] -= b0c.y * sol[16]; sol[26] -= b0c.z * sol[16]; sol[27] -= b0c.w * sol[16]; sol[28] -= b0d.x * sol[16]; sol[29] -= b0d.y * sol[16]; sol[30] -= b0d.z * sol[16]; sol[31] -= b0d.w * sol[16];
  __builtin_amdgcn_sched_barrier(0);
  b0a = *(const float4*)(Lr + 1104); b0b = *(const float4*)(Lr + 1108); b0c = *(const float4*)(Lr + 1112); b0d = *(const float4*)(Lr + 1116);
  __builtin_amdgcn_sched_barrier(0);
  sol[32] -= b1a.x * sol[16]; sol[33] -= b1a.y * sol[16]; sol[34] -= b1a.z * sol[16]; sol[35] -= b1a.w * sol[16]; sol[36] -= b1b.x * sol[16]; sol[37] -= b1b.y * sol[16]; sol[38] -= b1b.z * sol[16]; sol[39] -= b1b.w * sol[16]; sol[40] -= b1c.x * sol[16]; sol[41] -= b1c.y * sol[16]; sol[42] -= b1c.z * sol[16]; sol[43] -= b1c.w * sol[16]; sol[44] -= b1d.x * sol[16]; sol[45] -= b1d.y * sol[16]; sol[46] -= b1d.z * sol[16]; sol[47] -= b1d.w * sol[16];
  __builtin_amdgcn_sched_barrier(0);
  b1a = *(const float4*)(Lr + 1120); b1b = *(const float4*)(Lr + 1124); b1c = *(const float4*)(Lr + 1128); b1d = *(const float4*)(Lr + 1132);
  __builtin_amdgcn_sched_barrier(0);
  sol[48] -= b2a.x * sol[16]; sol[49] -= b2a.y * sol[16]; sol[50] -= b2a.z * sol[16]; sol[51] -= b2a.w * sol[16]; sol[52] -= b2b.x * sol[16]; sol[53] -= b2b.y * sol[16]; sol[54] -= b2b.z * sol[16]; sol[55] -= b2b.w * sol[16]; sol[56] -= b2c.x * sol[16]; sol[57] -= b2c.y * sol[16]; sol[58] -= b2c.z * sol[16]; sol[59] -= b2c.w * sol[16]; sol[60] -= b2d.x * sol[16]; sol[61] -= b2d.y * sol[16]; sol[62] -= b2d.z * sol[16]; sol[63] -= b2d.w * sol[16];
  __builtin_amdgcn_sched_barrier(0);
  b2a = *(const float4*)(Lr + 1136); b2b = *(const float4*)(Lr + 1140); b2c = *(const float4*)(Lr + 1144); b2d = *(const float4*)(Lr + 1148);
  __builtin_amdgcn_sched_barrier(0);
  sol[18] -= b0a.z * sol[17]; sol[19] -= b0a.w * sol[17]; sol[20] -= b0b.x * sol[17]; sol[21] -= b0b.y * sol[17]; sol[22] -= b0b.z * sol[17]; sol[23] -= b0b.w * sol[17]; sol[24] -= b0c.x * sol[17]; sol[25] -= b0c.y * sol[17]; sol[26] -= b0c.z * sol[17]; sol[27] -= b0c.w * sol[17]; sol[28] -= b0d.x * sol[17]; sol[29] -= b0d.y * sol[17]; sol[30] -= b0d.z * sol[17]; sol[31] -= b0d.w * sol[17];
  __builtin_amdgcn_sched_barrier(0);
  b0a = *(const float4*)(Lr + 1168); b0b = *(const float4*)(Lr + 1172); b0c = *(const float4*)(Lr + 1176); b0d = *(const float4*)(Lr + 1180);
  __builtin_amdgcn_sched_barrier(0);
  sol[32] -= b1a.x * sol[17]; sol[33] -= b1a.y * sol[17]; sol[34] -= b1a.z * sol[17]; sol[35] -= b1a.w * sol[17]; sol[36] -= b1b.x * sol[17]; sol[37] -= b1b.y * sol[17]; sol[38] -= b1b.z * sol[17]; sol[39] -= b1b.w * sol[17]; sol[40] -= b1c.x * sol[17]; sol[41] -= b1c.y * sol[17]; sol[42] -= b1c.z * sol[17]; sol[43] -= b1c.w * sol[17]; sol[44] -= b1d.x * sol[17]; sol[45] -= b1d.y * sol[17]; sol[46] -= b1d.z * sol[17]; sol[47] -= b1d.w * sol[17];
  __builtin_amdgcn_sched_barrier(0);
  b1a = *(const float4*)(Lr + 1184); b1b = *(const float4*)(Lr + 1188); b1c = *(const float4*)(Lr + 1192); b1d = *(const float4*)(Lr + 1196);
  __builtin_amdgcn_sched_barrier(0);
  sol[48] -= b2a.x * sol[17]; sol[49] -= b2a.y * sol[17]; sol[50] -= b2a.z * sol[17]; sol[51] -= b2a.w * sol[17]; sol[52] -= b2b.x * sol[17]; sol[53] -= b2b.y * sol[17]; sol[54] -= b2b.z * sol[17]; sol[55] -= b2b.w * sol[17]; sol[56] -= b2c.x * sol[17]; sol[57] -= b2c.y * sol[17]; sol[58] -= b2c.z * sol[17]; sol[59] -= b2c.w * sol[17]; sol[60] -= b2d.x * sol[17]; sol[61] -= b2d.y * sol[17]; sol[62] -= b2d.z * sol[17]; sol[63] -= b2d.w * sol[17];
  __builtin_amdgcn_sched_barrier(0);
  b2a = *(const float4*)(Lr + 1200); b2b = *(const float4*)(Lr + 1204); b2c = *(const float4*)(Lr + 1208); b2d = *(const float4*)(Lr + 1212);
  __builtin_amdgcn_sched_barrier(0);
  sol[19] -= b0a.w * sol[18]; sol[20] -= b0b.x * sol[18]; sol[21] -= b0b.y * sol[18]; sol[22] -= b0b.z * sol[18]; sol[23] -= b0b.w * sol[18]; sol[24] -= b0c.x * sol[18]; sol[25] -= b0c.y * sol[18]; sol[26] -= b0c.z * sol[18]; sol[27] -= b0c.w * sol[18]; sol[28] -= b0d.x * sol[18]; sol[29] -= b0d.y * sol[18]; sol[30] -= b0d.z * sol[18]; sol[31] -= b0d.w * sol[18];
  __builtin_amdgcn_sched_barrier(0);
  b0a = *(const float4*)(Lr + 1232); b0b = *(const float4*)(Lr + 1236); b0c = *(const float4*)(Lr + 1240); b0d = *(const float4*)(Lr + 1244);
  __builtin_amdgcn_sched_barrier(0);
  sol[32] -= b1a.x * sol[18]; sol[33] -= b1a.y * sol[18]; sol[34] -= b1a.z * sol[18]; sol[35] -= b1a.w * sol[18]; sol[36] -= b1b.x * sol[18]; sol[37] -= b1b.y * sol[18]; sol[38] -= b1b.z * sol[18]; sol[39] -= b1b.w * sol[18]; sol[40] -= b1c.x * sol[18]; sol[41] -= b1c.y * sol[18]; sol[42] -= b1c.z * sol[18]; sol[43] -= b1c.w * sol[18]; sol[44] -= b1d.x * sol[18]; sol[45] -= b1d.y * sol[18]; sol[46] -= b1d.z * sol[18]; sol[47] -= b1d.w * sol[18];
  __builtin_amdgcn_sched_barrier(0);
  b1a = *(const float4*)(Lr + 1248); b1b = *(const float4*)(Lr + 1252); b1c = *(const float4*)(Lr + 1256); b1d = *(const float4*)(Lr + 1260);
  __builtin_amdgcn_sched_barrier(0);
  sol[48] -= b2a.x * sol[18]; sol[49] -= b2a.y * sol[18]; sol[50] -= b2a.z * sol[18]; sol[51] -= b2a.w * sol[18]; sol[52] -= b2b.x * sol[18]; sol[53] -= b2b.y * sol[18]; sol[54] -= b2b.z * sol[18]; sol[55] -= b2b.w * sol[18]; sol[56] -= b2c.x * sol[18]; sol[57] -= b2c.y * sol[18]; sol[58] -= b2c.z * sol[18]; sol[59] -= b2c.w * sol[18]; sol[60] -= b2d.x * sol[18]; sol[61] -= b2d.y * sol[18]; sol[62] -= b2d.z * sol[18]; sol[63] -= b2d.w * sol[18];
  __builtin_amdgcn_sched_barrier(0);
  b2a = *(const float4*)(Lr + 1264); b2b = *(const float4*)(Lr + 1268); b2c = *(const float4*)(Lr + 1272); b2d = *(const float4*)(Lr + 1276);
  __builtin_amdgcn_sched_barrier(0);
  sol[20] -= b0b.x * sol[19]; sol[21] -= b0b.y * sol[19]; sol[22] -= b0b.z * sol[19]; sol[23] -= b0b.w * sol[19]; sol[24] -= b0c.x * sol[19]; sol[25] -= b0c.y * sol[19]; sol[26] -= b0c.z * sol[19]; sol[27] -= b0c.w * sol[19]; sol[28] -= b0d.x * sol[19]; sol[29] -= b0d.y * sol[19]; sol[30] -= b0d.z * sol[19]; sol[31] -= b0d.w * sol[19];
  __builtin_amdgcn_sched_barrier(0);
  b0a = *(const float4*)(Lr + 1296); b0b = *(const float4*)(Lr + 1300); b0c = *(const float4*)(Lr + 1304); b0d = *(const float4*)(Lr + 1308);
  __builtin_amdgcn_sched_barrier(0);
  sol[32] -= b1a.x * sol[19]; sol[33] -= b1a.y * sol[19]; sol[34] -= b1a.z * sol[19]; sol[35] -= b1a.w * sol[19]; sol[36] -= b1b.x * sol[19]; sol[37] -= b1b.y * sol[19]; sol[38] -= b1b.z * sol[19]; sol[39] -= b1b.w * sol[19]; sol[40] -= b1c.x * sol[19]; sol[41] -= b1c.y * sol[19]; sol[42] -= b1c.z * sol[19]; sol[43] -= b1c.w * sol[19]; sol[44] -= b1d.x * sol[19]; sol[45] -= b1d.y * sol[19]; sol[46] -= b1d.z * sol[19]; sol[47] -= b1d.w * sol[19];
  __builtin_amdgcn_sched_barrier(0);
  b1a = *(const float4*)(Lr + 1312); b1b = *(const float4*)(Lr + 1316); b1c = *(const float4*)(Lr + 1320); b1d = *(const float4*)(Lr + 1324);
  __builtin_amdgcn_sched_barrier(0);
  sol[48] -= b2a.x * sol[19]; sol[49] -= b2a.y * sol[19]; sol[50] -= b2a.z * sol[19]; sol[51] -= b2a.w * sol[19]; sol[52] -= b2b.x * sol[19]; sol[53] -= b2b.y * sol[19]; sol[54] -= b2b.z * sol[19]; sol[55] -= b2b.w * sol[19]; sol[56] -= b2c.x * sol[19]; sol[57] -= b2c.y * sol[19]; sol[58] -= b2c.z * sol[19]; sol[59] -= b2c.w * sol[19]; sol[60] -= b2d.x * sol[19]; sol[61] -= b2d.y * sol[19]; sol[62] -= b2d.z * sol[19]; sol[63] -= b2d.w * sol[19];
  __builtin_amdgcn_sched_barrier(0);
  b2a = *(const float4*)(Lr + 1328); b2b = *(const float4*)(Lr + 1332); b2c = *(const float4*)(Lr + 1336); b2d = *(const float4*)(Lr + 1340);
  __builtin_amdgcn_sched_barrier(0);
  sol[21] -= b0b.y * sol[20]; sol[22] -= b0b.z * sol[20]; sol[23] -= b0b.w * sol[20]; sol[24] -= b0c.x * sol[20]; sol[25] -= b0c.y * sol[20]; sol[26] -= b0c.z * sol[20]; sol[27] -= b0c.w * sol[20]; sol[28] -= b0d.x * sol[20]; sol[29] -= b0d.y * sol[20]; sol[30] -= b0d.z * sol[20]; sol[31] -= b0d.w * sol[20];
  __builtin_amdgcn_sched_barrier(0);
  b0a = *(const float4*)(Lr + 1360); b0b = *(const float4*)(Lr + 1364); b0c = *(const float4*)(Lr + 1368); b0d = *(const float4*)(Lr + 1372);
  __builtin_amdgcn_sched_barrier(0);
  sol[32] -= b1a.x * sol[20]; sol[33] -= b1a.y * sol[20]; sol[34] -= b1a.z * sol[20]; sol[35] -= b1a.w * sol[20]; sol[36] -= b1b.x * sol[20]; sol[37] -= b1b.y * sol[20]; sol[38] -= b1b.z * sol[20]; sol[39] -= b1b.w * sol[20]; sol[40] -= b1c.x * sol[20]; sol[41] -= b1c.y * sol[20]; sol[42] -= b1c.z * sol[20]; sol[43] -= b1c.w * sol[20]; sol[44] -= b1d.x * sol[20]; sol[45] -= b1d.y * sol[20]; sol[46] -= b1d.z * sol[20]; sol[47] -= b1d.w * sol[20];
  __builtin_amdgcn_sched_barrier(0);
  b1a = *(const float4*)(Lr + 1376); b1b = *(const float4*)(Lr + 1380); b1c = *(const float4*)(Lr + 1384); b1d = *(const float4*)(Lr + 1388);
  __builtin_amdgcn_sched_barrier(0);
  sol[48] -= b2a.x * sol[20]; sol[49] -= b2a.y * sol[20]; sol[50] -= b2a.z * sol[20]; sol[51] -= b2a.w * sol[20]; sol[52] -= b2b.x * sol[20]; sol[53] -= b2b.y * sol[20]; sol[54] -= b2b.z * sol[20]; sol[55] -= b2b.w * sol[20]; sol[56] -= b2c.x * sol[20]; sol[57] -= b2c.y * sol[20]; sol[58] -= b2c.z * sol[20]; sol[59] -= b2c.w * sol[20]; sol[60] -= b2d.x * sol[20]; sol[61] -= b2d.y * sol[20]; sol[62] -= b2d.z * sol[20]; sol[63] -= b2d.w * sol[20];
  __builtin_amdgcn_sched_barrier(0);
  b2a = *(const float4*)(Lr + 1392); b2b = *(const float4*)(Lr + 1396); b2c = *(const float4*)(Lr + 1400); b2d = *(const float4*)(Lr + 1404);
  __builtin_amdgcn_sched_barrier(0);
  sol[22] -= b0b.z * sol[21]; sol[23] -= b0b.w * sol[21]; sol[24] -= b0c.x * sol[21]; sol[25] -= b0c.y * sol[21]; sol[26] -= b0c.z * sol[21]; sol[27] -= b0c.w * sol[21]; sol[28] -= b0d.x * sol[21]; sol[29] -= b0d.y * sol[21]; sol[30] -= b0d.z * sol[21]; sol[31] -= b0d.w * sol[21];
  __builtin_amdgcn_sched_barrier(0);
  b0a = *(const float4*)(Lr + 1424); b0b = *(const float4*)(Lr + 1428); b0c = *(const float4*)(Lr + 1432); b0d = *(const float4*)(Lr + 1436);
  __builtin_amdgcn_sched_barrier(0);
  sol[32] -= b1a.x * sol[21]; sol[33] -= b1a.y * sol[21]; sol[34] -= b1a.z * sol[21]; sol[35] -= b1a.w * sol[21]; sol[36] -= b1b.x * sol[21]; sol[37] -= b1b.y * sol[21]; sol[38] -= b1b.z * sol[21]; sol[39] -= b1b.w * sol[21]; sol[40] -= b1c.x * sol[21]; sol[41] -= b1c.y * sol[21]; sol[42] -= b1c.z * sol[21]; sol[43] -= b1c.w * sol[21]; sol[44] -= b1d.x * sol[21]; sol[45] -= b1d.y * sol[21]; sol[46] -= b1d.z * sol[21]; sol[47] -= b1d.w * sol[21];
  __builtin_amdgcn_sched_barrier(0);
  b1a = *(const float4*)(Lr + 1440); b1b = *(const float4*)(Lr + 1444); b1c = *(const float4*)(Lr + 1448); b1d = *(const float4*)(Lr + 1452);
  __builtin_amdgcn_sched_barrier(0);
  sol[48] -= b2a.x * sol[21]; sol[49] -= b2a.y * sol[21]; sol[50] -= b2a.z * sol[21]; sol[51] -= b2a.w * sol[21]; sol[52] -= b2b.x * sol[21]; sol[53] -= b2b.y * sol[21]; sol[54] -= b2b.z * sol[21]; sol[55] -= b2b.w * sol[21]; sol[56] -= b2c.x * sol[21]; sol[57] -= b2c.y * sol[21]; sol[58] -= b2c.z * sol[21]; sol[59] -= b2c.w * sol[21]; sol[60] -= b2d.x * sol[21]; sol[61] -= b2d.y * sol[21]; sol[62] -= b2d.z * sol[21]; sol[63] -= b2d.w * sol[21];
  __builtin_amdgcn_sched_barrier(0);
  b2a = *(const float4*)(Lr + 1456); b2b = *(const float4*)(Lr + 1460); b2c = *(const float4*)(Lr + 1464); b2d = *(const float4*)(Lr + 1468);
  __builtin_amdgcn_sched_barrier(0);
  sol[23] -= b0b.w * sol[22]; sol[24] -= b0c.x * sol[22]; sol[25] -= b0c.y * sol[22]; sol[26] -= b0c.z * sol[22]; sol[27] -= b0c.w * sol[22]; sol[28] -= b0d.x * sol[22]; sol[29] -= b0d.y * sol[22]; sol[30] -= b0d.z * sol[22]; sol[31] -= b0d.w * sol[22];
  __builtin_amdgcn_sched_barrier(0);
  b0a = *(const float4*)(Lr + 1488); b0b = *(const float4*)(Lr + 1492); b0c = *(const float4*)(Lr + 1496); b0d = *(const float4*)(Lr + 1500);
  __builtin_amdgcn_sched_barrier(0);
  sol[32] -= b1a.x * sol[22]; sol[33] -= b1a.y * sol[22]; sol[34] -= b1a.z * sol[22]; sol[35] -= b1a.w * sol[22]; sol[36] -= b1b.x * sol[22]; sol[37] -= b1b.y * sol[22]; sol[38] -= b1b.z * sol[22]; sol[39] -= b1b.w * sol[22]; sol[40] -= b1c.x * sol[22]; sol[41] -= b1c.y * sol[22]; sol[42] -= b1c.z * sol[22]; sol[43] -= b1c.w * sol[22]; sol[44] -= b1d.x * sol[22]; sol[45] -= b1d.y * sol[22]; sol[46] -= b1d.z * sol[22]; sol[47] -= b1d.w * sol[22];
  __builtin_amdgcn_sched_barrier(0);
  b1a = *(const float4*)(Lr + 1504); b1b = *(const float4*)(Lr + 1508); b1c = *(const float4*)(Lr + 1512); b1d = *(const float4*)(Lr + 1516);
  __builtin_amdgcn_sched_barrier(0);
  sol[48] -= b2a.x * sol[22]; sol[49] -= b2a.y * sol[22]; sol[50] -= b2a.z * sol[22]; sol[51] -= b2a.w * sol[22]; sol[52] -= b2b.x * sol[22]; sol[53] -= b2b.y * sol[22]; sol[54] -= b2b.z * sol[22]; sol[55] -= b2b.w * sol[22]; sol[56] -= b2c.x * sol[22]; sol[57] -= b2c.y * sol[22]; sol[58] -= b2c.z * sol[22]; sol[59] -= b2c.w * sol[22]; sol[60] -= b2d.x * sol[22]; sol[61] -= b2d.y * sol[22]; sol[62] -= b2d.z * sol[22]; sol[63] -= b2d.w * sol[22];
  __builtin_amdgcn_sched_barrier(0);
  b2a = *(const float4*)(Lr + 1520); b2b = *(const float4*)(Lr + 1524); b2c = *(const float4*)(Lr + 1528); b2d = *(const float4*)(Lr + 1532);
  __builtin_amdgcn_sched_barrier(0);
  sol[24] -= b0c.x * sol[23]; sol[25] -= b0c.y * sol[23]; sol[26] -= b0c.z * sol[23]; sol[27] -= b0c.w * sol[23]; sol[28] -= b0d.x * sol[23]; sol[29] -= b0d.y * sol[23]; sol[30] -= b0d.z * sol[23]; sol[31] -= b0d.w * sol[23];
  __builtin_amdgcn_sched_barrier(0);
  b0a = *(const float4*)(Lr + 1552); b0b = *(const float4*)(Lr + 1556); b0c = *(const float4*)(Lr + 1560); b0d = *(const float4*)(Lr + 1564);
  __builtin_amdgcn_sched_barrier(0);
  sol[32] -= b1a.x * sol[23]; sol[33] -= b1a.y * sol[23]; sol[34] -= b1a.z * sol[23]; sol[35] -= b1a.w * sol[23]; sol[36] -= b1b.x * sol[23]; sol[37] -= b1b.y * sol[23]; sol[38] -= b1b.z * sol[23]; sol[39] -= b1b.w * sol[23]; sol[40] -= b1c.x * sol[23]; sol[41] -= b1c.y * sol[23]; sol[42] -= b1c.z * sol[23]; sol[43] -= b1c.w * sol[23]; sol[44] -= b1d.x * sol[23]; sol[45] -= b1d.y * sol[23]; sol[46] -= b1d.z * sol[23]; sol[47] -= b1d.w * sol[23];
  __builtin_amdgcn_sched_barrier(0);
  b1a = *(const float4*)(Lr + 1568); b1b = *(const float4*)(Lr + 1572); b1c = *(const float4*)(Lr + 1576); b1d = *(const float4*)(Lr + 1580);
  __builtin_amdgcn_sched_barrier(0);
  sol[48] -= b2a.x * sol[23]; sol[49] -= b2a.y * sol[23]; sol[50] -= b2a.z * sol[23]; sol[51] -= b2a.w * sol[23]; sol[52] -= b2b.x * sol[23]; sol[53] -= b2b.y * sol[23]; sol[54] -= b2b.z * sol[23]; sol[55] -= b2b.w * sol[23]; sol[56] -= b2c.x * sol[23]; sol[57] -= b2c.y * sol[23]; sol[58] -= b2c.z * sol[23]; sol[59] -= b2c.w * sol[23]; sol[60] -= b2d.x * sol[23]; sol[61] -= b2d.y * sol[23]; sol[62] -= b2d.z * sol[23]; sol[63] -= b2d.w * sol[23];
  __builtin_amdgcn_sched_barrier(0);
  b2a = *(const float4*)(Lr + 1584); b2b = *(const float4*)(Lr + 1588); b2c = *(const float4*)(Lr + 1592); b2d = *(const float4*)(Lr + 1596);
  __builtin_amdgcn_sched_barrier(0);
  sol[25] -= b0c.y * sol[24]; sol[26] -= b0c.z * sol[24]; sol[27] -= b0c.w * sol[24]; sol[28] -= b0d.x * sol[24]; sol[29] -= b0d.y * sol[24]; sol[30] -= b0d.z * sol[24]; sol[31] -= b0d.w * sol[24];
  __builtin_amdgcn_sched_barrier(0);
  b0a = *(const float4*)(Lr + 1616); b0b = *(const float4*)(Lr + 1620); b0c = *(const float4*)(Lr + 1624); b0d = *(const float4*)(Lr + 1628);
  __builtin_amdgcn_sched_barrier(0);
  sol[32] -= b1a.x * sol[24]; sol[33] -= b1a.y * sol[24]; sol[34] -= b1a.z * sol[24]; sol[35] -= b1a.w * sol[24]; sol[36] -= b1b.x * sol[24]; sol[37] -= b1b.y * sol[24]; sol[38] -= b1b.z * sol[24]; sol[39] -= b1b.w * sol[24]; sol[40] -= b1c.x * sol[24]; sol[41] -= b1c.y * sol[24]; sol[42] -= b1c.z * sol[24]; sol[43] -= b1c.w * sol[24]; sol[44] -= b1d.x * sol[24]; sol[45] -= b1d.y * sol[24]; sol[46] -= b1d.z * sol[24]; sol[47] -= b1d.w * sol[24];
  __builtin_amdgcn_sched_barrier(0);
  b1a = *(const float4*)(Lr + 1632); b1b = *(const float4*)(Lr + 1636); b1c = *(const float4*)(Lr + 1640); b1d = *(const float4*)(Lr + 1644);
  __builtin_amdgcn_sched_barrier(0);
  sol[48] -= b2a.x * sol[24]; sol[49] -= b2a.y * sol[24]; sol[50] -= b2a.z * sol[24]; sol[51] -= b2a.w * sol[24]; sol[52] -= b2b.x * sol[24]; sol[53] -= b2b.y * sol[24]; sol[54] -= b2b.z * sol[24]; sol[55] -= b2b.w * sol[24]; sol[56] -= b2c.x * sol[24]; sol[57] -= b2c.y * sol[24]; sol[58] -= b2c.z * sol[24]; sol[59] -= b2c.w * sol[24]; sol[60] -= b2d.x * sol[24]; sol[61] -= b2d.y * sol[24]; sol[62] -= b2d.z * sol[24]; sol[63] -= b2d.w * sol[24];
  __builtin_amdgcn_sched_barrier(0);
  b2a = *(const float4*)(Lr + 1648); b2b = *(const float4*)(Lr + 1652); b2c = *(const float4*)(Lr + 1656); b2d = *(const float4*)(Lr + 1660);
  __builtin_amdgcn_sched_barrier(0);
  sol[26] -= b0c.z * sol[25]; sol[27] -= b0c.w * sol[25]; sol[28] -= b0d.x * sol[25]; sol[29] -= b0d.y * sol[25]; sol[30] -= b0d.z * sol[25]; sol[31] -= b0d.w * sol[25];
  __builtin_amdgcn_sched_barrier(0);
  b0a = *(const float4*)(Lr + 1680); b0b = *(const float4*)(Lr + 1684); b0c = *(const float4*)(Lr + 1688); b0d = *(const float4*)(Lr + 1692);
  __builtin_amdgcn_sched_barrier(0);
  sol[32] -= b1a.x * sol[25]; sol[33] -= b1a.y * sol[25]; sol[34] -= b1a.z * sol[25]; sol[35] -= b1a.w * sol[25]; sol[36] -= b1b.x * sol[25]; sol[37] -= b1b.y * sol[25]; sol[38] -= b1b.z * sol[25]; sol[39] -= b1b.w * sol[25]; sol[40] -= b1c.x * sol[25]; sol[41] -= b1c.y * sol[25]; sol[42] -= b1c.z * sol[25]; sol[43] -= b1c.w * sol[25]; sol[44] -= b1d.x * sol[25]; sol[45] -= b1d.y * sol[25]; sol[46] -= b1d.z * sol[25]; sol[47] -= b1d.w * sol[25];
  __builtin_amdgcn_sched_barrier(0);
  b1a = *(const float4*)(Lr + 1696); b1b = *(const float4*)(Lr + 1700); b1c = *(const float4*)(Lr + 1704); b1d = *(const float4*)(Lr + 1708);
  __builtin_amdgcn_sched_barrier(0);
  sol[48] -= b2a.x * sol[25]; sol[49] -= b2a.y * sol[25]; sol[50] -= b2a.z * sol[25]; sol[51] -= b2a.w * sol[25]; sol[52] -= b2b.x * sol[25]; sol[53] -= b2b.y * sol[25]; sol[54] -= b2b.z * sol[25]; sol[55] -= b2b.w * sol[25]; sol[56] -= b2c.x * sol[25]; sol[57] -= b2c.y * sol[25]; sol[58] -= b2c.z * sol[25]; sol[59] -= b2c.w * sol[25]; sol[60] -= b2d.x * sol[25]; sol[61] -= b2d.y * sol[25]; sol[62] -= b2d.z * sol[25]; sol[63] -= b2d.w * sol[25];
  __builtin_amdgcn_sched_barrier(0);
  b2a = *(const float4*)(Lr + 1712); b2b = *(const float4*)(Lr + 1716); b2c = *(const float4*)(Lr + 1720); b2d = *(const float4*)(Lr + 1724);
  __builtin_amdgcn_sched_barrier(0);
  sol[27] -= b0c.w * sol[26]; sol[28] -= b0d.x * sol[26]; sol[29] -= b0d.y * sol[26]; sol[30] -= b0d.z * sol[26]; sol[31] -= b0d.w * sol[26];
  __builtin_amdgcn_sched_barrier(0);
  b0a = *(const float4*)(Lr + 1744); b0b = *(const float4*)(Lr + 1748); b0c = *(const float4*)(Lr + 1752); b0d = *(const float4*)(Lr + 1756);
  __builtin_amdgcn_sched_barrier(0);
  sol[32] -= b1a.x * sol[26]; sol[33] -= b1a.y * sol[26]; sol[34] -= b1a.z * sol[26]; sol[35] -= b1a.w * sol[26]; sol[36] -= b1b.x * sol[26]; sol[37] -= b1b.y * sol[26]; sol[38] -= b1b.z * sol[26]; sol[39] -= b1b.w * sol[26]; sol[40] -= b1c.x * sol[26]; sol[41] -= b1c.y * sol[26]; sol[42] -= b1c.z * sol[26]; sol[43] -= b1c.w * sol[26]; sol[44] -= b1d.x * sol[26]; sol[45] -= b1d.y * sol[26]; sol[46] -= b1d.z * sol[26]; sol[47] -= b1d.w * sol[26];
  __builtin_amdgcn_sched_barrier(0);
  b1a = *(const float4*)(Lr + 1760); b1b = *(const float4*)(Lr + 1764); b1c = *(const float4*)(Lr + 1768); b1d = *(const float4*)(Lr + 1772);
  __builtin_amdgcn_sched_barrier(0);
  sol[48] -= b2a.x * sol[26]; sol[49] -= b2a.y * sol[26]; sol[50] -= b2a.z * sol[26]; sol[51] -= b2a.w * sol[26]; sol[52] -= b2b.x * sol[26]; sol[53] -= b2b.y * sol[26]; sol[54] -= b2b.z * sol[26]; sol[55] -= b2b.w * sol[26]; sol[56] -= b2c.x * sol[26]; sol[57] -= b2c.y * sol[26]; sol[58] -= b2c.z * sol[26]; sol[59] -= b2c.w * sol[26]; sol[60] -= b2d.x * sol[26]; sol[61] -= b2d.y * sol[26]; sol[62] -= b2d.z * sol[26]; sol[63] -= b2d.w * sol[26];
  __builtin_amdgcn_sched_barrier(0);
  b2a = *(const float4*)(Lr + 1776); b2b = *(const float4*)(Lr + 1780); b2c = *(const float4*)(Lr + 1784); b2d = *(const float4*)(Lr + 1788);
  __builtin_amdgcn_sched_barrier(0);
  sol[28] -= b0d.x * sol[27]; sol[29] -= b0d.y * sol[27]; sol[30] -= b0d.z * sol[27]; sol[31] -= b0d.w * sol[27];
  __builtin_amdgcn_sched_barrier(0);
  b0a = *(const float4*)(Lr + 1808); b0b = *(const float4*)(Lr + 1812); b0c = *(const float4*)(Lr + 1816); b0d = *(const float4*)(Lr + 1820);
  __builtin_amdgcn_sched_barrier(0);
  sol[32] -= b1a.x * sol[27]; sol[33] -= b1a.y * sol[27]; sol[34] -= b1a.z * sol[27]; sol[35] -= b1a.w * sol[27]; sol[36] -= b1b.x * sol[27]; sol[37] -= b1b.y * sol[27]; sol[38] -= b1b.z * sol[27]; sol[39] -= b1b.w * sol[27]; sol[40] -= b1c.x * sol[27]; sol[41] -= b1c.y * sol[27]; sol[42] -= b1c.z * sol[27]; sol[43] -= b1c.w * sol[27]; sol[44] -= b1d.x * sol[27]; sol[45] -= b1d.y * sol[27]; sol[46] -= b1d.z * sol[27]; sol[47] -= b1d.w * sol[27];
  __builtin_amdgcn_sched_barrier(0);
  b1a = *(const float4*)(Lr + 1824); b1b = *(const float4*)(Lr + 1828); b1c = *(const float4*)(Lr + 1832); b1d = *(const float4*)(Lr + 1836);
  __builtin_amdgcn_sched_barrier(0);
  sol[48] -= b2a.x * sol[27]; sol[49] -= b2a.y * sol[27]; sol[50] -= b2a.z * sol[27]; sol[51] -= b2a.w * sol[27]; sol[52] -= b2b.x * sol[27]; sol[53] -= b2b.y * sol[27]; sol[54] -= b2b.z * sol[27]; sol[55] -= b2b.w * sol[27]; sol[56] -= b2c.x * sol[27]; sol[57] -= b2c.y * sol[27]; sol[58] -= b2c.z * sol[27]; sol[59] -= b2c.w * sol[27]; sol[60] -= b2d.x * sol[27]; sol[61] -= b2d.y * sol[27]; sol[62] -= b2d.z * sol[27]; sol[63] -= b2d.w * sol[27];
  __builtin_amdgcn_sched_barrier(0);
  b2a = *(const float4*)(Lr + 1840); b2b = *(const float4*)(Lr + 1844); b2c = *(const float4*)(Lr + 1848); b2d = *(const float4*)(Lr + 1852);
  __builtin_amdgcn_sched_barrier(0);
  sol[29] -= b0d.y * sol[28]; sol[30] -= b0d.z * sol[28]; sol[31] -= b0d.w * sol[28];
  __builtin_amdgcn_sched_barrier(0);
  b0a = *(const float4*)(Lr + 1872); b0b = *(const float4*)(Lr + 1876); b0c = *(const float4*)(Lr + 1880); b0d = *(const float4*)(Lr + 1884);
  __builtin_amdgcn_sched_barrier(0);
  sol[32] -= b1a.x * sol[28]; sol[33] -= b1a.y * sol[28]; sol[34] -= b1a.z * sol[28]; sol[35] -= b1a.w * sol[28]; sol[36] -= b1b.x * sol[28]; sol[37] -= b1b.y * sol[28]; sol[38] -= b1b.z * sol[28]; sol[39] -= b1b.w * sol[28]; sol[40] -= b1c.x * sol[28]; sol[41] -= b1c.y * sol[28]; sol[42] -= b1c.z * sol[28]; sol[43] -= b1c.w * sol[28]; sol[44] -= b1d.x * sol[28]; sol[45] -= b1d.y * sol[28]; sol[46] -= b1d.z * sol[28]; sol[47] -= b1d.w * sol[28];
  __builtin_amdgcn_sched_barrier(0);
  b1a = *(const float4*)(Lr + 1888); b1b = *(const float4*)(Lr + 1892); b1c = *(const float4*)(Lr + 1896); b1d = *(const float4*)(Lr + 1900);
  __builtin_amdgcn_sched_barrier(0);
  sol[48] -= b2a.x * sol[28]; sol[49] -= b2a.y * sol[28]; sol[50] -= b2a.z * sol[28]; sol[51] -= b2a.w * sol[28]; sol[52] -= b2b.x * sol[28]; sol[53] -= b2b.y * sol[28]; sol[54] -= b2b.z * sol[28]; sol[55] -= b2b.w * sol[28]; sol[56] -= b2c.x * sol[28]; sol[57] -= b2c.y * sol[28]; sol[58] -= b2c.z * sol[28]; sol[59] -= b2c.w * sol[28]; sol[60] -= b2d.x * sol[28]; sol[61] -= b2d.y * sol[28]; sol[62] -= b2d.z * sol[28]; sol[63] -= b2d.w * sol[28];
  __builtin_amdgcn_sched_barrier(0);
  b2a = *(const float4*)(Lr + 1904); b2b = *(const float4*)(Lr + 1908); b2c = *(const float4*)(Lr + 1912); b2d = *(const float4*)(Lr + 1916);
  __builtin_amdgcn_sched_barrier(0);
  sol[30] -= b0d.z * sol[29]; sol[31] -= b0d.w * sol[29];
  __builtin_amdgcn_sched_barrier(0);
  b0a = *(const float4*)(Lr + 1936); b0b = *(const float4*)(Lr + 1940); b0c = *(const float4*)(Lr + 1944); b0d = *(const float4*)(Lr + 1948);
  __builtin_amdgcn_sched_barrier(0);
  sol[32] -= b1a.x * sol[29]; sol[33] -= b1a.y * sol[29]; sol[34] -= b1a.z * sol[29]; sol[35] -= b1a.w * sol[29]; sol[36] -= b1b.x * sol[29]; sol[37] -= b1b.y * sol[29]; sol[38] -= b1b.z * sol[29]; sol[39] -= b1b.w * sol[29]; sol[40] -= b1c.x * sol[29]; sol[41] -= b1c.y * sol[29]; sol[42] -= b1c.z * sol[29]; sol[43] -= b1c.w * sol[29]; sol[44] -= b1d.x * sol[29]; sol[45] -= b1d.y * sol[29]; sol[46] -= b1d.z * sol[29]; sol[47] -= b1d.w * sol[29];
  __builtin_amdgcn_sched_barrier(0);
  b1a = *(const float4*)(Lr + 1952); b1b = *(const float4*)(Lr + 1956); b1c = *(const float4*)(Lr + 1960); b1d = *(const float4*)(Lr + 1964);
  __builtin_amdgcn_sched_barrier(0);
  sol[48] -= b2a.x * sol[29]; sol[49] -= b2a.y * sol[29]; sol[50] -= b2a.z * sol[29]; sol[51] -= b2a.w * sol[29]; sol[52] -= b2b.x * sol[29]; sol[53] -= b2b.y * sol[29]; sol[54] -= b2b.z * sol[29]; sol[55] -= b2b.w * sol[29]; sol[56] -= b2c.x * sol[29]; sol[57] -= b2c.y * sol[29]; sol[58] -= b2c.z * sol[29]; sol[59] -= b2c.w * sol[29]; sol[60] -= b2d.x * sol[29]; sol[61] -= b2d.y * sol[29]; sol[62] -= b2d.z * sol[29]; sol[63] -= b2d.w * sol[29];
  __builtin_amdgcn_sched_barrier(0);
  b2a = *(const float4*)(Lr + 1968); b2b = *(const float4*)(Lr + 1972); b2c = *(const float4*)(Lr + 1976); b2d = *(const float4*)(Lr + 1980);
  __builtin_amdgcn_sched_barrier(0);
  sol[31] -= b0d.w * sol[30];
  __builtin_amdgcn_sched_barrier(0);
  b0a = *(const float4*)(Lr + 2016); b0b = *(const float4*)(Lr + 2020); b0c = *(const float4*)(Lr + 2024); b0d = *(const float4*)(Lr + 2028);
  __builtin_amdgcn_sched_barrier(0);
  sol[32] -= b1a.x * sol[30]; sol[33] -= b1a.y * sol[30]; sol[34] -= b1a.z * sol[30]; sol[35] -= b1a.w * sol[30]; sol[36] -= b1b.x * sol[30]; sol[37] -= b1b.y * sol[30]; sol[38] -= b1b.z * sol[30]; sol[39] -= b1b.w * sol[30]; sol[40] -= b1c.x * sol[30]; sol[41] -= b1c.y * sol[30]; sol[42] -= b1c.z * sol[30]; sol[43] -= b1c.w * sol[30]; sol[44] -= b1d.x * sol[30]; sol[45] -= b1d.y * sol[30]; sol[46] -= b1d.z * sol[30]; sol[47] -= b1d.w * sol[30];
  __builtin_amdgcn_sched_barrier(0);
  b1a = *(const float4*)(Lr + 2032); b1b = *(const float4*)(Lr + 2036); b1c = *(const float4*)(Lr + 2040); b1d = *(const float4*)(Lr + 2044);
  __builtin_amdgcn_sched_barrier(0);
  sol[48] -= b2a.x * sol[30]; sol[49] -= b2a.y * sol[30]; sol[50] -= b2a.z * sol[30]; sol[51] -= b2a.w * sol[30]; sol[52] -= b2b.x * sol[30]; sol[53] -= b2b.y * sol[30]; sol[54] -= b2b.z * sol[30]; sol[55] -= b2b.w * sol[30]; sol[56] -= b2c.x * sol[30]; sol[57] -= b2c.y * sol[30]; sol[58] -= b2c.z * sol[30]; sol[59] -= b2c.w * sol[30]; sol[60] -= b2d.x * sol[30]; sol[61] -= b2d.y * sol[30]; sol[62] -= b2d.z * sol[30]; sol[63] -= b2d.w * sol[30];
  __builtin_amdgcn_sched_barrier(0);
  b2a = *(const float4*)(Lr + 2080); b2b = *(const float4*)(Lr + 2084); b2c = *(const float4*)(Lr + 2088); b2d = *(const float4*)(Lr + 2092);
  __builtin_amdgcn_sched_barrier(0);
  sol[32] -= b0a.x * sol[31]; sol[33] -= b0a.y * sol[31]; sol[34] -= b0a.z * sol[31]; sol[35] -= b0a.w * sol[31]; sol[36] -= b0b.x * sol[31]; sol[37] -= b0b.y * sol[31]; sol[38] -= b0b.z * sol[31]; sol[39] -= b0b.w * sol[31]; sol[40] -= b0c.x * sol[31]; sol[41] -= b0c.y * sol[31]; sol[42] -= b0c.z * sol[31]; sol[43] -= b0c.w * sol[31]; sol[44] -= b0d.x * sol[31]; sol[45] -= b0d.y * sol[31]; sol[46] -= b0d.z * sol[31]; sol[47] -= b0d.w * sol[31];
  __builtin_amdgcn_sched_barrier(0);
  b0a = *(const float4*)(Lr + 2096); b0b = *(const float4*)(Lr + 2100); b0c = *(const float4*)(Lr + 2104); b0d = *(const float4*)(Lr + 2108);
  __builtin_amdgcn_sched_barrier(0);
  sol[48] -= b1a.x * sol[31]; sol[49] -= b1a.y * sol[31]; sol[50] -= b1a.z * sol[31]; sol[51] -= b1a.w * sol[31]; sol[52] -= b1b.x * sol[31]; sol[53] -= b1b.y * sol[31]; sol[54] -= b1b.z * sol[31]; sol[55] -= b1b.w * sol[31]; sol[56] -= b1c.x * sol[31]; sol[57] -= b1c.y * sol[31]; sol[58] -= b1c.z * sol[31]; sol[59] -= b1c.w * sol[31]; sol[60] -= b1d.x * sol[31]; sol[61] -= b1d.y * sol[31]; sol[62] -= b1d.z * sol[31]; sol[63] -= b1d.w * sol[31];
  __builtin_amdgcn_sched_barrier(0);
  b1a = *(const float4*)(Lr + 2144); b1b = *(const float4*)(Lr + 2148); b1c = *(const float4*)(Lr + 2152); b1d = *(const float4*)(Lr + 2156);
  __builtin_amdgcn_sched_barrier(0);
  sol[33] -= b2a.y * sol[32]; sol[34] -= b2a.z * sol[32]; sol[35] -= b2a.w * sol[32]; sol[36] -= b2b.x * sol[32]; sol[37] -= b2b.y * sol[32]; sol[38] -= b2b.z * sol[32]; sol[39] -= b2b.w * sol[32]; sol[40] -= b2c.x * sol[32]; sol[41] -= b2c.y * sol[32]; sol[42] -= b2c.z * sol[32]; sol[43] -= b2c.w * sol[32]; sol[44] -= b2d.x * sol[32]; sol[45] -= b2d.y * sol[32]; sol[46] -= b2d.z * sol[32]; sol[47] -= b2d.w * sol[32];
  __builtin_amdgcn_sched_barrier(0);
  b2a = *(const float4*)(Lr + 2160); b2b = *(const float4*)(Lr + 2164); b2c = *(const float4*)(Lr + 2168); b2d = *(const float4*)(Lr + 2172);
  __builtin_amdgcn_sched_barrier(0);
  sol[48] -= b0a.x * sol[32]; sol[49] -= b0a.y * sol[32]; sol[50] -= b0a.z * sol[32]; sol[51] -= b0a.w * sol[32]; sol[52] -= b0b.x * sol[32]; sol[53] -= b0b.y * sol[32]; sol[54] -= b0b.z * sol[32]; sol[55] -= b0b.w * sol[32]; sol[56] -= b0c.x * sol[32]; sol[57] -= b0c.y * sol[32]; sol[58] -= b0c.z * sol[32]; sol[59] -= b0c.w * sol[32]; sol[60] -= b0d.x * sol[32]; sol[61] -= b0d.y * sol[32]; sol[62] -= b0d.z * sol[32]; sol[63] -= b0d.w * sol[32];
  __builtin_amdgcn_sched_barrier(0);
  b0a = *(const float4*)(Lr + 2208); b0b = *(const float4*)(Lr + 2212); b0c = *(const float4*)(Lr + 2216); b0d = *(const float4*)(Lr + 2220);
  __builtin_amdgcn_sched_barrier(0);
  sol[34] -= b1a.z * sol[33]; sol[35] -= b1a.w * sol[33]; sol[36] -= b1b.x * sol[33]; sol[37] -= b1b.y * sol[33]; sol[38] -= b1b.z * sol[33]; sol[39] -= b1b.w * sol[33]; sol[40] -= b1c.x * sol[33]; sol[41] -= b1c.y * sol[33]; sol[42] -= b1c.z * sol[33]; sol[43] -= b1c.w * sol[33]; sol[44] -= b1d.x * sol[33]; sol[45] -= b1d.y * sol[33]; sol[46] -= b1d.z * sol[33]; sol[47] -= b1d.w * sol[33];
  __builtin_amdgcn_sched_barrier(0);
  b1a = *(const float4*)(Lr + 2224); b1b = *(const float4*)(Lr + 2228); b1c = *(const float4*)(Lr + 2232); b1d = *(const float4*)(Lr + 2236);
  __builtin_amdgcn_sched_barrier(0);
  sol[48] -= b2a.x * sol[33]; sol[49] -= b2a.y * sol[33]; sol[50] -= b2a.z * sol[33]; sol[51] -= b2a.w * sol[33]; sol[52] -= b2b.x * sol[33]; sol[53] -= b2b.y * sol[33]; sol[54] -= b2b.z * sol[33]; sol[55] -= b2b.w * sol[33]; sol[56] -= b2c.x * sol[33]; sol[57] -= b2c.y * sol[33]; sol[58] -= b2c.z * sol[33]; sol[59] -= b2c.w * sol[33]; sol[60] -= b2d.x * sol[33]; sol[61] -= b2d.y * sol[33]; sol[62] -= b2d.z * sol[33]; sol[63] -= b2d.w * sol[33];
  __builtin_amdgcn_sched_barrier(0);
  b2a = *(const float4*)(Lr + 2272); b2b = *(const float4*)(Lr + 2276); b2c = *(const float4*)(Lr + 2280); b2d = *(const float4*)(Lr + 2284);
  __builtin_amdgcn_sched_barrier(0);
  sol[35] -= b0a.w * sol[34]; sol[36] -= b0b.x * sol[34]; sol[37] -= b0b.y * sol[34]; sol[38] -= b0b.z * sol[34]; sol[39] -= b0b.w * sol[34]; sol[40] -= b0c.x * sol[34]; sol[41] -= b0c.y * sol[34]; sol[42] -= b0c.z * sol[34]; sol[43] -= b0c.w * sol[34]; sol[44] -= b0d.x * sol[34]; sol[45] -= b0d.y * sol[34]; sol[46] -= b0d.z * sol[34]; sol[47] -= b0d.w * sol[34];
  __builtin_amdgcn_sched_barrier(0);
  b0a = *(const float4*)(Lr + 2288); b0b = *(const float4*)(Lr + 2292); b0c = *(const float4*)(Lr + 2296); b0d = *(const float4*)(Lr + 2300);
  __builtin_amdgcn_sched_barrier(0);
  sol[48] -= b1a.x * sol[34]; sol[49] -= b1a.y * sol[34]; sol[50] -= b1a.z * sol[34]; sol[51] -= b1a.w * sol[34]; sol[52] -= b1b.x * sol[34]; sol[53] -= b1b.y * sol[34]; sol[54] -= b1b.z * sol[34]; sol[55] -= b1b.w * sol[34]; sol[56] -= b1c.x * sol[34]; sol[57] -= b1c.y * sol[34]; sol[58] -= b1c.z * sol[34]; sol[59] -= b1c.w * sol[34]; sol[60] -= b1d.x * sol[34]; sol[61] -= b1d.y * sol[34]; sol[62] -= b1d.z * sol[34]; sol[63] -= b1d.w * sol[34];
  __builtin_amdgcn_sched_barrier(0);
  b1a = *(const float4*)(Lr + 2336); b1b = *(const float4*)(Lr + 2340); b1c = *(const float4*)(Lr + 2344); b1d = *(const float4*)(Lr + 2348);
  __builtin_amdgcn_sched_barrier(0);
  sol[36] -= b2b.x * sol[35]; sol[37] -= b2b.y * sol[35]; sol[38] -= b2b.z * sol[35]; sol[39] -= b2b.w * sol[35]; sol[40] -= b2c.x * sol[35]; sol[41] -= b2c.y * sol[35]; sol[42] -= b2c.z * sol[35]; sol[43] -= b2c.w * sol[35]; sol[44] -= b2d.x * sol[35]; sol[45] -= b2d.y * sol[35]; sol[46] -= b2d.z * sol[35]; sol[47] -= b2d.w * sol[35];
  __builtin_amdgcn_sched_barrier(0);
  b2a = *(const float4*)(Lr + 2352); b2b = *(const float4*)(Lr + 2356); b2c = *(const float4*)(Lr + 2360); b2d = *(const float4*)(Lr + 2364);
  __builtin_amdgcn_sched_barrier(0);
  sol[48] -= b0a.x * sol[35]; sol[49] -= b0a.y * sol[35]; sol[50] -= b0a.z * sol[35]; sol[51] -= b0a.w * sol[35]; sol[52] -= b0b.x * sol[35]; sol[53] -= b0b.y * sol[35]; sol[54] -= b0b.z * sol[35]; sol[55] -= b0b.w * sol[35]; sol[56] -= b0c.x * sol[35]; sol[57] -= b0c.y * sol[35]; sol[58] -= b0c.z * sol[35]; sol[59] -= b0c.w * sol[35]; sol[60] -= b0d.x * sol[35]; sol[61] -= b0d.y * sol[35]; sol[62] -= b0d.z * sol[35]; sol[63] -= b0d.w * sol[35];
  __builtin_amdgcn_sched_barrier(0);
  b0a = *(const float4*)(Lr + 2400); b0b = *(const float4*)(Lr + 2404); b0c = *(const float4*)(Lr + 2408); b0d = *(const float4*)(Lr + 2412);
  __builtin_amdgcn_sched_barrier(0);
  sol[37] -= b1b.y * sol[36]; sol[38] -= b1b.z * sol[36]; sol[39] -= b1b.w * sol[36]; sol[40] -= b1c.x * sol[36]; sol[41] -= b1c.y * sol[36]; sol[42] -= b1c.z * sol[36]; sol[43] -= b1c.w * sol[36]; sol[44] -= b1d.x * sol[36]; sol[45] -= b1d.y * sol[36]; sol[46] -= b1d.z * sol[36]; sol[47] -= b1d.w * sol[36];
  __builtin_amdgcn_sched_barrier(0);
  b1a = *(const float4*)(Lr + 2416); b1b = *(const float4*)(Lr + 2420); b1c = *(const float4*)(Lr + 2424); b1d = *(const float4*)(Lr + 2428);
  __builtin_amdgcn_sched_barrier(0);
  sol[48] -= b2a.x * sol[36]; sol[49] -= b2a.y * sol[36]; sol[50] -= b2a.z * sol[36]; sol[51] -= b2a.w * sol[36]; sol[52] -= b2b.x * sol[36]; sol[53] -= b2b.y * sol[36]; sol[54] -= b2b.z * sol[36]; sol[55] -= b2b.w * sol[36]; sol[56] -= b2c.x * sol[36]; sol[57] -= b2c.y * sol[36]; sol[58] -= b2c.z * sol[36]; sol[59] -= b2c.w * sol[36]; sol[60] -= b2d.x * sol[36]; sol[61] -= b2d.y * sol[36]; sol[62] -= b2d.z * sol[36]; sol[63] -= b2d.w * sol[36];
  __builtin_amdgcn_sched_barrier(0);
  b2a = *(const float4*)(Lr + 2464); b2b = *(const float4*)(Lr + 2468); b2c = *(const float4*)(Lr + 2472); b2d = *(const float4*)(Lr + 2476);
  __builtin_amdgcn_sched_barrier(0);
  sol[38] -= b0b.z * sol[37]; sol[39] -= b0b.w * sol[37]; sol[40] -= b0c.x * sol[37]; sol[41] -= b0c.y * sol[37]; sol[42] -= b0c.z * sol[37]; sol[43] -= b0c.w * sol[37]; sol[44] -= b0d.x * sol[37]; sol[45] -= b0d.y * sol[37]; sol[46] -= b0d.z * sol[37]; sol[47] -= b0d.w * sol[37];
  __builtin_amdgcn_sched_barrier(0);
  b0a = *(const float4*)(Lr + 2480); b0b = *(const float4*)(Lr + 2484); b0c = *(const float4*)(Lr + 2488); b0d = *(const float4*)(Lr + 2492);
  __builtin_amdgcn_sched_barrier(0);
  sol[48] -= b1a.x * sol[37]; sol[49] -= b1a.y * sol[37]; sol[50] -= b1a.z * sol[37]; sol[51] -= b1a.w * sol[37]; sol[52] -= b1b.x * sol[37]; sol[53] -= b1b.y * sol[37]; sol[54] -= b1b.z * sol[37]; sol[55] -= b1b.w * sol[37]; sol[56] -= b1c.x * sol[37]; sol[57] -= b1c.y * sol[37]; sol[58] -= b1c.z * sol[37]; sol[59] -= b1c.w * sol[37]; sol[60] -= b1d.x * sol[37]; sol[61] -= b1d.y * sol[37]; sol[62] -= b1d.z * sol[37]; sol[63] -= b1d.w * sol[37];
  __builtin_amdgcn_sched_barrier(0);
  b1a = *(const float4*)(Lr + 2528); b1b = *(const float4*)(Lr + 2532); b1c = *(const float4*)(Lr + 2536); b1d = *(const float4*)(Lr + 2540);
  __builtin_amdgcn_sched_barrier(0);
  sol[39] -= b2b.w * sol[38]; sol[40] -= b2c.x * sol[38]; sol[41] -= b2c.y * sol[38]; sol[42] -= b2c.z * sol[38]; sol[43] -= b2c.w * sol[38]; sol[44] -= b2d.x * sol[38]; sol[45] -= b2d.y * sol[38]; sol[46] -= b2d.z * sol[38]; sol[47] -= b2d.w * sol[38];
  __builtin_amdgcn_sched_barrier(0);
  b2a = *(const float4*)(Lr + 2544); b2b = *(const float4*)(Lr + 2548); b2c = *(const float4*)(Lr + 2552); b2d = *(const float4*)(Lr + 2556);
  __builtin_amdgcn_sched_barrier(0);
  sol[48] -= b0a.x * sol[38]; sol[49] -= b0a.y * sol[38]; sol[50] -= b0a.z * sol[38]; sol[51] -= b0a.w * sol[38]; sol[52] -= b0b.x * sol[38]; sol[53] -= b0b.y * sol[38]; sol[54] -= b0b.z * sol[38]; sol[55] -= b0b.w * sol[38]; sol[56] -= b0c.x * sol[38]; sol[57] -= b0c.y * sol[38]; sol[58] -= b0c.z * sol[38]; sol[59] -= b0c.w * sol[38]; sol[60] -= b0d.x * sol[38]; sol[61] -= b0d.y * sol[38]; sol[62] -= b0d.z * sol[38]; sol[63] -= b0d.w * sol[38];
  __builtin_amdgcn_sched_barrier(0);
  b0a = *(const float4*)(Lr + 2592); b0b = *(const float4*)(Lr + 2596); b0c = *(const float4*)(Lr + 2600); b0d = *(const float4*)(Lr + 2604);
  __builtin_amdgcn_sched_barrier(0);
  sol[40] -= b1c.x * sol[39]; sol[41] -= b1c.y * sol[39]; sol[42] -= b1c.z * sol[39]; sol[43] -= b1c.w * sol[39]; sol[44] -= b1d.x * sol[39]; sol[45] -= b1d.y * sol[39]; sol[46] -= b1d.z * sol[39]; sol[47] -= b1d.w * sol[39];
  __builtin_amdgcn_sched_barrier(0);
  b1a = *(const float4*)(Lr + 2608); b1b = *(const float4*)(Lr + 2612); b1c = *(const float4*)(Lr + 2616); b1d = *(const float4*)(Lr + 2620);
  __builtin_amdgcn_sched_barrier(0);
  sol[48] -= b2a.x * sol[39]; sol[49] -= b2a.y * sol[39]; sol[50] -= b2a.z * sol[39]; sol[51] -= b2a.w * sol[39]; sol[52] -= b2b.x * sol[39]; sol[53] -= b2b.y * sol[39]; sol[54] -= b2b.z * sol[39]; sol[55] -= b2b.w * sol[39]; sol[56] -= b2c.x * sol[39]; sol[57] -= b2c.y * sol[39]; sol[58] -= b2c.z * sol[39]; sol[59] -= b2c.w * sol[39]; sol[60] -= b2d.x * sol[39]; sol[61] -= b2d.y * sol[39]; sol[62] -= b2d.z * sol[39]; sol[63] -= b2d.w * sol[39];
  __builtin_amdgcn_sched_barrier(0);
  b2a = *(const float4*)(Lr + 2656); b2b = *(const float4*)(Lr + 2660); b2c = *(const float4*)(Lr + 2664); b2d = *(const float4*)(Lr + 2668);
  __builtin_amdgcn_sched_barrier(0);
  sol[41] -= b0c.y * sol[40]; sol[42] -= b0c.z * sol[40]; sol[43] -= b0c.w * sol[40]; sol[44] -= b0d.x * sol[40]; sol[45] -= b0d.y * sol[40]; sol[46] -= b0d.z * sol[40]; sol[47] -= b0d.w * sol[40];
  __builtin_amdgcn_sched_barrier(0);
  b0a = *(const float4*)(Lr + 2672); b0b = *(const float4*)(Lr + 2676); b0c = *(const float4*)(Lr + 2680); b0d = *(const float4*)(Lr + 2684);
  __builtin_amdgcn_sched_barrier(0);
  sol[48] -= b1a.x * sol[40]; sol[49] -= b1a.y * sol[40]; sol[50] -= b1a.z * sol[40]; sol[51] -= b1a.w * sol[40]; sol[52] -= b1b.x * sol[40]; sol[53] -= b1b.y * sol[40]; sol[54] -= b1b.z * sol[40]; sol[55] -= b1b.w * sol[40]; sol[56] -= b1c.x * sol[40]; sol[57] -= b1c.y * sol[40]; sol[58] -= b1c.z * sol[40]; sol[59] -= b1c.w * sol[40]; sol[60] -= b1d.x * sol[40]; sol[61] -= b1d.y * sol[40]; sol[62] -= b1d.z * sol[40]; sol[63] -= b1d.w * sol[40];
  __builtin_amdgcn_sched_barrier(0);
  b1a = *(const float4*)(Lr + 2720); b1b = *(const float4*)(Lr + 2724); b1c = *(const float4*)(Lr + 2728); b1d = *(const float4*)(Lr + 2732);
  __builtin_amdgcn_sched_barrier(0);
  sol[42] -= b2c.z * sol[41]; sol[43] -= b2c.w * sol[41]; sol[44] -= b2d.x * sol[41]; sol[45] -= b2d.y * sol[41]; sol[46] -= b2d.z * sol[41]; sol[47] -= b2d.w * sol[41];
  __builtin_amdgcn_sched_barrier(0);
  b2a = *(const float4*)(Lr + 2736); b2b = *(const float4*)(Lr + 2740); b2c = *(const float4*)(Lr + 2744); b2d = *(const float4*)(Lr + 2748);
  __builtin_amdgcn_sched_barrier(0);
  sol[48] -= b0a.x * sol[41]; sol[49] -= b0a.y * sol[41]; sol[50] -= b0a.z * sol[41]; sol[51] -= b0a.w * sol[41]; sol[52] -= b0b.x * sol[41]; sol[53] -= b0b.y * sol[41]; sol[54] -= b0b.z * sol[41]; sol[55] -= b0b.w * sol[41]; sol[56] -= b0c.x * sol[41]; sol[57] -= b0c.y * sol[41]; sol[58] -= b0c.z * sol[41]; sol[59] -= b0c.w * sol[41]; sol[60] -= b0d.x * sol[41]; sol[61] -= b0d.y * sol[41]; sol[62] -= b0d.z * sol[41]; sol[63] -= b0d.w * sol[41];
  __builtin_amdgcn_sched_barrier(0);
  b0a = *(const float4*)(Lr + 2784); b0b = *(const float4*)(Lr + 2788); b0c = *(const float4*)(Lr + 2792); b0d = *(const float4*)(Lr + 2796);
  __builtin_amdgcn_sched_barrier(0);
  sol[43] -= b1c.w * sol[42]; sol[44] -= b1d.x * sol[42]; sol[45] -= b1d.y * sol[42]; sol[46] -= b1d.z * sol[42]; sol[47] -= b1d.w * sol[42];
  __builtin_amdgcn_sched_barrier(0);
  b1a = *(const float4*)(Lr + 2800); b1b = *(const float4*)(Lr + 2804); b1c = *(const float4*)(Lr + 2808); b1d = *(const float4*)(Lr + 2812);
  __builtin_amdgcn_sched_barrier(0);
  sol[48] -= b2a.x * sol[42]; sol[49] -= b2a.y * sol[42]; sol[50] -= b2a.z * sol[42]; sol[51] -= b2a.w * sol[42]; sol[52] -= b2b.x * sol[42]; sol[53] -= b2b.y * sol[42]; sol[54] -= b2b.z * sol[42]; sol[55] -= b2b.w * sol[42]; sol[56] -= b2c.x * sol[42]; sol[57] -= b2c.y * sol[42]; sol[58] -= b2c.z * sol[42]; sol[59] -= b2c.w * sol[42]; sol[60] -= b2d.x * sol[42]; sol[61] -= b2d.y * sol[42]; sol[62] -= b2d.z * sol[42]; sol[63] -= b2d.w * sol[42];
  __builtin_amdgcn_sched_barrier(0);
  b2a = *(const float4*)(Lr + 2848); b2b = *(const float4*)(Lr + 2852); b2c = *(const float4*)(Lr + 2856); b2d = *(const float4*)(Lr + 2860);
  __builtin_amdgcn_sched_barrier(0);
  sol[44] -= b0d.x * sol[43]; sol[45] -= b0d.y * sol[43]; sol[46] -= b0d.z * sol[43]; sol[47] -= b0d.w * sol[43];
  __builtin_amdgcn_sched_barrier(0);
  b0a = *(const float4*)(Lr + 2864); b0b = *(const float4*)(Lr + 2868); b0c = *(const float4*)(Lr + 2872); b0d = *(const float4*)(Lr + 2876);
  __builtin_amdgcn_sched_barrier(0);
  sol[48] -= b1a.x * sol[43]; sol[49] -= b1a.y * sol[43]; sol[50] -= b1a.z * sol[43]; sol[51] -= b1a.w * sol[43]; sol[52] -= b1b.x * sol[43]; sol[53] -= b1b.y * sol[43]; sol[54] -= b1b.z * sol[43]; sol[55] -= b1b.w * sol[43]; sol[56] -= b1c.x * sol[43]; sol[57] -= b1c.y * sol[43]; sol[58] -= b1c.z * sol[43]; sol[59] -= b1c.w * sol[43]; sol[60] -= b1d.x * sol[43]; sol[61] -= b1d.y * sol[43]; sol[62] -= b1d.z * sol[43]; sol[63] -= b1d.w * sol[43];
  __builtin_amdgcn_sched_barrier(0);
  b1a = *(const float4*)(Lr + 2912); b1b = *(const float4*)(Lr + 2916); b1c = *(const float4*)(Lr + 2920); b1d = *(const float4*)(Lr + 2924);
  __builtin_amdgcn_sched_barrier(0);
  sol[45] -= b2d.y * sol[44]; sol[46] -= b2d.z * sol[44]; sol[47] -= b2d.w * sol[44];
  __builtin_amdgcn_sched_barrier(0);
  b2a = *(const float4*)(Lr + 2928); b2b = *(const float4*)(Lr + 2932); b2c = *(const float4*)(Lr + 2936); b2d = *(const float4*)(Lr + 2940);
  __builtin_amdgcn_sched_barrier(0);
  sol[48] -= b0a.x * sol[44]; sol[49] -= b0a.y * sol[44]; sol[50] -= b0a.z * sol[44]; sol[51] -= b0a.w * sol[44]; sol[52] -= b0b.x * sol[44]; sol[53] -= b0b.y * sol[44]; sol[54] -= b0b.z * sol[44]; sol[55] -= b0b.w * sol[44]; sol[56] -= b0c.x * sol[44]; sol[57] -= b0c.y * sol[44]; sol[58] -= b0c.z * sol[44]; sol[59] -= b0c.w * sol[44]; sol[60] -= b0d.x * sol[44]; sol[61] -= b0d.y * sol[44]; sol[62] -= b0d.z * sol[44]; sol[63] -= b0d.w * sol[44];
  __builtin_amdgcn_sched_barrier(0);
  b0a = *(const float4*)(Lr + 2976); b0b = *(const float4*)(Lr + 2980); b0c = *(const float4*)(Lr + 2984); b0d = *(const float4*)(Lr + 2988);
  __builtin_amdgcn_sched_barrier(0);
  sol[46] -= b1d.z * sol[45]; sol[47] -= b1d.w * sol[45];
  __builtin_amdgcn_sched_barrier(0);
  b1a = *(const float4*)(Lr + 2992); b1b = *(const float4*)(Lr + 2996); b1c = *(const float4*)(Lr + 3000); b1d = *(const float4*)(Lr + 3004);
  __builtin_amdgcn_sched_barrier(0);
  sol[48] -= b2a.x * sol[45]; sol[49] -= b2a.y * sol[45]; sol[50] -= b2a.z * sol[45]; sol[51] -= b2a.w * sol[45]; sol[52] -= b2b.x * sol[45]; sol[53] -= b2b.y * sol[45]; sol[54] -= b2b.z * sol[45]; sol[55] -= b2b.w * sol[45]; sol[56] -= b2c.x * sol[45]; sol[57] -= b2c.y * sol[45]; sol[58] -= b2c.z * sol[45]; sol[59] -= b2c.w * sol[45]; sol[60] -= b2d.x * sol[45]; sol[61] -= b2d.y * sol[45]; sol[62] -= b2d.z * sol[45]; sol[63] -= b2d.w * sol[45];
  __builtin_amdgcn_sched_barrier(0);
  b2a = *(const float4*)(Lr + 3056); b2b = *(const float4*)(Lr + 3060); b2c = *(const float4*)(Lr + 3064); b2d = *(const float4*)(Lr + 3068);
  __builtin_amdgcn_sched_barrier(0);
  sol[47] -= b0d.w * sol[46];
  __builtin_amdgcn_sched_barrier(0);
  b0a = *(const float4*)(Lr + 3120); b0b = *(const float4*)(Lr + 3124); b0c = *(const float4*)(Lr + 3128); b0d = *(const float4*)(Lr + 3132);
  __builtin_amdgcn_sched_barrier(0);
  sol[48] -= b1a.x * sol[46]; sol[49] -= b1a.y * sol[46]; sol[50] -= b1a.z * sol[46]; sol[51] -= b1a.w * sol[46]; sol[52] -= b1b.x * sol[46]; sol[53] -= b1b.y * sol[46]; sol[54] -= b1b.z * sol[46]; sol[55] -= b1b.w * sol[46]; sol[56] -= b1c.x * sol[46]; sol[57] -= b1c.y * sol[46]; sol[58] -= b1c.z * sol[46]; sol[59] -= b1c.w * sol[46]; sol[60] -= b1d.x * sol[46]; sol[61] -= b1d.y * sol[46]; sol[62] -= b1d.z * sol[46]; sol[63] -= b1d.w * sol[46];
  __builtin_amdgcn_sched_barrier(0);
  b1a = *(const float4*)(Lr + 3184); b1b = *(const float4*)(Lr + 3188); b1c = *(const float4*)(Lr + 3192); b1d = *(const float4*)(Lr + 3196);
  __builtin_amdgcn_sched_barrier(0);
  sol[48] -= b2a.x * sol[47]; sol[49] -= b2a.y * sol[47]; sol[50] -= b2a.z * sol[47]; sol[51] -= b2a.w * sol[47]; sol[52] -= b2b.x * sol[47]; sol[53] -= b2b.y * sol[47]; sol[54] -= b2b.z * sol[47]; sol[55] -= b2b.w * sol[47]; sol[56] -= b2c.x * sol[47]; sol[57] -= b2c.y * sol[47]; sol[58] -= b2c.z * sol[47]; sol[59] -= b2c.w * sol[47]; sol[60] -= b2d.x * sol[47]; sol[61] -= b2d.y * sol[47]; sol[62] -= b2d.z * sol[47]; sol[63] -= b2d.w * sol[47];
  __builtin_amdgcn_sched_barrier(0);
  b2a = *(const float4*)(Lr + 3248); b2b = *(const float4*)(Lr + 3252); b2c = *(const float4*)(Lr + 3256); b2d = *(const float4*)(Lr + 3260);
  __builtin_amdgcn_sched_barrier(0);
  sol[49] -= b0a.y * sol[48]; sol[50] -= b0a.z * sol[48]; sol[51] -= b0a.w * sol[48]; sol[52] -= b0b.x * sol[48]; sol[53] -= b0b.y * sol[48]; sol[54] -= b0b.z * sol[48]; sol[55] -= b0b.w * sol[48]; sol[56] -= b0c.x * sol[48]; sol[57] -= b0c.y * sol[48]; sol[58] -= b0c.z * sol[48]; sol[59] -= b0c.w * sol[48]; sol[60] -= b0d.x * sol[48]; sol[61] -= b0d.y * sol[48]; sol[62] -= b0d.z * sol[48]; sol[63] -= b0d.w * sol[48];
  __builtin_amdgcn_sched_barrier(0);
  b0a = *(const float4*)(Lr + 3312); b0b = *(const float4*)(Lr + 3316); b0c = *(const float4*)(Lr + 3320); b0d = *(const float4*)(Lr + 3324);
  __builtin_amdgcn_sched_barrier(0);
  sol[50] -= b1a.z * sol[49]; sol[51] -= b1a.w * sol[49]; sol[52] -= b1b.x * sol[49]; sol[53] -= b1b.y * sol[49]; sol[54] -= b1b.z * sol[49]; sol[55] -= b1b.w * sol[49]; sol[56] -= b1c.x * sol[49]; sol[57] -= b1c.y * sol[49]; sol[58] -= b1c.z * sol[49]; sol[59] -= b1c.w * sol[49]; sol[60] -= b1d.x * sol[49]; sol[61] -= b1d.y * sol[49]; sol[62] -= b1d.z * sol[49]; sol[63] -= b1d.w * sol[49];
  __builtin_amdgcn_sched_barrier(0);
  b1a = *(const float4*)(Lr + 3376); b1b = *(const float4*)(Lr + 3380); b1c = *(const float4*)(Lr + 3384); b1d = *(const float4*)(Lr + 3388);
  __builtin_amdgcn_sched_barrier(0);
  sol[51] -= b2a.w * sol[50]; sol[52] -= b2b.x * sol[50]; sol[53] -= b2b.y * sol[50]; sol[54] -= b2b.z * sol[50]; sol[55] -= b2b.w * sol[50]; sol[56] -= b2c.x * sol[50]; sol[57] -= b2c.y * sol[50]; sol[58] -= b2c.z * sol[50]; sol[59] -= b2c.w * sol[50]; sol[60] -= b2d.x * sol[50]; sol[61] -= b2d.y * sol[50]; sol[62] -= b2d.z * sol[50]; sol[63] -= b2d.w * sol[50];
  __builtin_amdgcn_sched_barrier(0);
  b2a = *(const float4*)(Lr + 3440); b2b = *(const float4*)(Lr + 3444); b2c = *(const float4*)(Lr + 3448); b2d = *(const float4*)(Lr + 3452);
  __builtin_amdgcn_sched_barrier(0);
  sol[52] -= b0b.x * sol[51]; sol[53] -= b0b.y * sol[51]; sol[54] -= b0b.z * sol[51]; sol[55] -= b0b.w * sol[51]; sol[56] -= b0c.x * sol[51]; sol[57] -= b0c.y * sol[51]; sol[58] -= b0c.z * sol[51]; sol[59] -= b0c.w * sol[51]; sol[60] -= b0d.x * sol[51]; sol[61] -= b0d.y * sol[51]; sol[62] -= b0d.z * sol[51]; sol[63] -= b0d.w * sol[51];
  __builtin_amdgcn_sched_barrier(0);
  b0a = *(const float4*)(Lr + 3504); b0b = *(const float4*)(Lr + 3508); b0c = *(const float4*)(Lr + 3512); b0d = *(const float4*)(Lr + 3516);
  __builtin_amdgcn_sched_barrier(0);
  sol[53] -= b1b.y * sol[52]; sol[54] -= b1b.z * sol[52]; sol[55] -= b1b.w * sol[52]; sol[56] -= b1c.x * sol[52]; sol[57] -= b1c.y * sol[52]; sol[58] -= b1c.z * sol[52]; sol[59] -= b1c.w * sol[52]; sol[60] -= b1d.x * sol[52]; sol[61] -= b1d.y * sol[52]; sol[62] -= b1d.z * sol[52]; sol[63] -= b1d.w * sol[52];
  __builtin_amdgcn_sched_barrier(0);
  b1a = *(const float4*)(Lr + 3568); b1b = *(const float4*)(Lr + 3572); b1c = *(const float4*)(Lr + 3576); b1d = *(const float4*)(Lr + 3580);
  __builtin_amdgcn_sched_barrier(0);
  sol[54] -= b2b.z * sol[53]; sol[55] -= b2b.w * sol[53]; sol[56] -= b2c.x * sol[53]; sol[57] -= b2c.y * sol[53]; sol[58] -= b2c.z * sol[53]; sol[59] -= b2c.w * sol[53]; sol[60] -= b2d.x * sol[53]; sol[61] -= b2d.y * sol[53]; sol[62] -= b2d.z * sol[53]; sol[63] -= b2d.w * sol[53];
  __builtin_amdgcn_sched_barrier(0);
  b2a = *(const float4*)(Lr + 3632); b2b = *(const float4*)(Lr + 3636); b2c = *(const float4*)(Lr + 3640); b2d = *(const float4*)(Lr + 3644);
  __builtin_amdgcn_sched_barrier(0);
  sol[55] -= b0b.w * sol[54]; sol[56] -= b0c.x * sol[54]; sol[57] -= b0c.y * sol[54]; sol[58] -= b0c.z * sol[54]; sol[59] -= b0c.w * sol[54]; sol[60] -= b0d.x * sol[54]; sol[61] -= b0d.y * sol[54]; sol[62] -= b0d.z * sol[54]; sol[63] -= b0d.w * sol[54];
  __builtin_amdgcn_sched_barrier(0);
  b0a = *(const float4*)(Lr + 3696); b0b = *(const float4*)(Lr + 3700); b0c = *(const float4*)(Lr + 3704); b0d = *(const float4*)(Lr + 3708);
  __builtin_amdgcn_sched_barrier(0);
  sol[56] -= b1c.x * sol[55]; sol[57] -= b1c.y * sol[55]; sol[58] -= b1c.z * sol[55]; sol[59] -= b1c.w * sol[55]; sol[60] -= b1d.x * sol[55]; sol[61] -= b1d.y * sol[55]; sol[62] -= b1d.z * sol[55]; sol[63] -= b1d.w * sol[55];
  __builtin_amdgcn_sched_barrier(0);
  b1a = *(const float4*)(Lr + 3760); b1b = *(const float4*)(Lr + 3764); b1c = *(const float4*)(Lr + 3768); b1d = *(const float4*)(Lr + 3772);
  __builtin_amdgcn_sched_barrier(0);
  sol[57] -= b2c.y * sol[56]; sol[58] -= b2c.z * sol[56]; sol[59] -= b2c.w * sol[56]; sol[60] -= b2d.x * sol[56]; sol[61] -= b2d.y * sol[56]; sol[62] -= b2d.z * sol[56]; sol[63] -= b2d.w * sol[56];
  __builtin_amdgcn_sched_barrier(0);
  b2a = *(const float4*)(Lr + 3824); b2b = *(const float4*)(Lr + 3828); b2c = *(const float4*)(Lr + 3832); b2d = *(const float4*)(Lr + 3836);
  __builtin_amdgcn_sched_barrier(0);
  sol[58] -= b0c.z * sol[57]; sol[59] -= b0c.w * sol[57]; sol[60] -= b0d.x * sol[57]; sol[61] -= b0d.y * sol[57]; sol[62] -= b0d.z * sol[57]; sol[63] -= b0d.w * sol[57];
  __builtin_amdgcn_sched_barrier(0);
  b0a = *(const float4*)(Lr + 3888); b0b = *(const float4*)(Lr + 3892); b0c = *(const float4*)(Lr + 3896); b0d = *(const float4*)(Lr + 3900);
  __builtin_amdgcn_sched_barrier(0);
  sol[59] -= b1c.w * sol[58]; sol[60] -= b1d.x * sol[58]; sol[61] -= b1d.y * sol[58]; sol[62] -= b1d.z * sol[58]; sol[63] -= b1d.w * sol[58];
  __builtin_amdgcn_sched_barrier(0);
  b1a = *(const float4*)(Lr + 3952); b1b = *(const float4*)(Lr + 3956); b1c = *(const float4*)(Lr + 3960); b1d = *(const float4*)(Lr + 3964);
  __builtin_amdgcn_sched_barrier(0);
  sol[60] -= b2d.x * sol[59]; sol[61] -= b2d.y * sol[59]; sol[62] -= b2d.z * sol[59]; sol[63] -= b2d.w * sol[59];
  __builtin_amdgcn_sched_barrier(0);
  b2a = *(const float4*)(Lr + 4016); b2b = *(const float4*)(Lr + 4020); b2c = *(const float4*)(Lr + 4024); b2d = *(const float4*)(Lr + 4028);
  __builtin_amdgcn_sched_barrier(0);
  sol[61] -= b0d.y * sol[60]; sol[62] -= b0d.z * sol[60]; sol[63] -= b0d.w * sol[60];
  __builtin_amdgcn_sched_barrier(0);
  __builtin_amdgcn_sched_barrier(0);
  sol[62] -= b1d.z * sol[61]; sol[63] -= b1d.w * sol[61];
  __builtin_amdgcn_sched_barrier(0);
  __builtin_amdgcn_sched_barrier(0);
  sol[63] -= b2d.w * sol[62];
  __builtin_amdgcn_sched_barrier(0);
}

template <int DIR>
__device__ __forceinline__ void solve_cols(const Params& P, int itb, int c, const float* Lt, const float* bpp, const float* gcp,
                                           const u16* Vs, const u16* Ks) {
  float sol[64];
  const float* bp_ = bpp + DIR * 64;
  const float* gc_ = gcp + DIR * 64;
  if (c < 128) {
    const u16* vp = Vs + c;
#pragma unroll
    for (int p = 0; p < 64; ++p) sol[p] = bp_[p] * bf2f(vp[(DIR ? (63 - p) : p) * 136]);
  } else {
    const u16* kp = Ks + (c - 128);
#pragma unroll
    for (int p = 0; p < 64; ++p) sol[p] = bp_[p] * __expf(gc_[p]) * bf2f(kp[(DIR ? (63 - p) : p) * 136]);
  }
  const float* Lr = Lt + opq(DIR * 4096);
  solve_elim(sol, Lr);
  const size_t it2 = (size_t)(itb + DIR);
  if (c < 128) {
    u16* UF = (u16*)(P.ws + OFF_UF) + (it2 * 128 + c) * 64;
#pragma unroll
    for (int q = 0; q < 8; ++q) *(uint4*)(UF + q * 8) = pack8(sol + q * 8);
  } else {
    u16* Wg = (u16*)(P.ws + OFF_R2) + it2 * 8192 + (c - 128);
#pragma unroll
    for (int p = 0; p < 64; ++p) Wg[p * 128] = f2bf(-sol[p]);
  }
}

__device__ __forceinline__ void delta_prep_item(const Params& P, int item, char* lds) {
  const int tid = opq(threadIdx.x), lane = tid & 63, wv = tid >> 6, fr = lane & 15, fq = lane >> 4;
  const int cid = item >> 2, h = item & 3;
  const int row0 = cid * 64;
  int seq_lo, seq_hi;
  if (cid < 256) { seq_lo = (cid >> 6) * 4096; seq_hi = seq_lo + 4096; }
  else { seq_lo = 16384 + ((cid - 256) >> 2) * 256; seq_hi = seq_lo + 256; }
  u16* Qs = (u16*)(lds + opq(0));
  u16* Ks = (u16*)(lds + opq(17408));
  u16* Vs = (u16*)(lds + opq(34816));
  float* KKs = (float*)(lds + opq(52224));
  float* QKs = (float*)(lds + opq(69632));
  float* Lt = (float*)(lds + opq(87040));
  float* gtok = (float*)(lds + opq(119808));
  float* btok = gtok + 128;
  float* gcp = btok + 128;
  float* bpp = gcp + 128;
  u16* QKN = (u16*)((char*)P.out + OFF_QKN);
  lds_barrier();
  {
    const int j = tid >> 3, sg = tid & 7;
    const int row = row0 + j;
    const bool hm = (row - 1 >= seq_lo), hp = (row + 1 < seq_hi);
    const u16* qkv = (const u16*)(P.ws + OFF_R3);
#pragma unroll
    for (int s = 0; s < 3; ++s) {
      const int col = s * 512 + h * 128 + sg * 16;
      const u16* p0 = qkv + (size_t)row * 1536 + col;
      float y[16];
      float ssq = 0.f;
#pragma unroll
      for (int hh = 0; hh < 2; ++hh) {
        const uint4 c0 = *(const uint4*)(p0 + hh * 8);
        uint4 m0 = *(const uint4*)(p0 - (hm ? 1536 : 0) + hh * 8);
        uint4 n0 = *(const uint4*)(p0 + (hp ? 1536 : 0) + hh * 8);
        m0.x = hm ? m0.x : 0u; m0.y = hm ? m0.y : 0u; m0.z = hm ? m0.z : 0u; m0.w = hm ? m0.w : 0u;
        n0.x = hp ? n0.x : 0u; n0.y = hp ? n0.y : 0u; n0.z = hp ? n0.z : 0u; n0.w = hp ? n0.w : 0u;
        float fc[8], fm[8], fn[8];
        unpack8(c0, fc); unpack8(m0, fm); unpack8(n0, fn);
        const float* cwp = P.dn_conv_w + col + hh * 8;
        float cw0[8], cw1[8], cw2[8];
        {
          const float4 t0 = *(const float4*)(cwp), t1 = *(const float4*)(cwp + 4);
          const float4 t2 = *(const float4*)(cwp + 1536), t3 = *(const float4*)(cwp + 1540);
          const float4 t4 = *(const float4*)(cwp + 3072), t5 = *(const float4*)(cwp + 3076);
          cw0[0] = t0.x; cw0[1] = t0.y; cw0[2] = t0.z; cw0[3] = t0.w; cw0[4] = t1.x; cw0[5] = t1.y; cw0[6] = t1.z; cw0[7] = t1.w;
          cw1[0] = t2.x; cw1[1] = t2.y; cw1[2] = t2.z; cw1[3] = t2.w; cw1[4] = t3.x; cw1[5] = t3.y; cw1[6] = t3.z; cw1[7] = t3.w;
          cw2[0] = t4.x; cw2[1] = t4.y; cw2[2] = t4.z; cw2[3] = t4.w; cw2[4] = t5.x; cw2[5] = t5.y; cw2[6] = t5.z; cw2[7] = t5.w;
        }
#pragma unroll
        for (int e = 0; e < 8; ++e) {
          const float v = cw0[e] * fm[e] + cw1[e] * fc[e] + cw2[e] * fn[e];
          const float yy = v * sigm(v);
          y[hh * 8 + e] = yy;
          ssq += yy * yy;
        }
      }
      if (s < 2) {
        ssq += __shfl_xor(ssq, 1, 64); ssq += __shfl_xor(ssq, 2, 64); ssq += __shfl_xor(ssq, 4, 64);
        const float sc = rsqrtf(ssq + 1e-6f) * ((s == 0) ? 0.08838834764831845f : 1.f);
#pragma unroll
        for (int e = 0; e < 16; ++e) y[e] *= sc;
      }
      u16* dl = ((s == 0) ? Qs : ((s == 1) ? Ks : Vs)) + j * 136 + sg * 16;
      const uint4 o0 = pack8(y), o1 = pack8(y + 8);
      *(uint4*)dl = o0; *(uint4*)(dl + 8) = o1;
      if (s < 2) {
        u16* dg = QKN + (size_t)row * 1024 + s * 512 + h * 128 + sg * 16;
        *(uint4*)dg = o0; *(uint4*)(dg + 8) = o1;
      }
    }
  }
  if (tid < 128) {
    const int j = tid & 63, dir = tid >> 6;
    const float* BA = (const float*)(P.ws + OFF_BA) + (size_t)(row0 + j) * 16;
    const float bl = BA[dir * 4 + h], al = BA[8 + dir * 4 + h];
    const float xx = al + P.dn_dt_bias[dir * 4 + h];
    const float sp = (xx > 20.f) ? xx : log1pf(expf(xx));
    gtok[dir * 64 + j] = -expf(P.dn_a_log[dir * 4 + h]) * sp;
    btok[dir * 64 + j] = 1.f / (1.f + expf(-bl));
  }
  lds_barrier();
  if (tid < 128) {
    const int dir = tid >> 6, p = tid & 63;
    const int tk = dir ? (63 - p) : p;
    float a = gtok[dir * 64 + tk];
    const float bv = btok[dir * 64 + tk];
#pragma unroll
    for (int o = 1; o < 64; o <<= 1) {
      const float t = __shfl_up(a, o, 64);
      if (p >= o) a += t;
    }
    gcp[dir * 64 + p] = a;
    bpp[dir * 64 + p] = bv;
  }
  {
#pragma unroll
    for (int q = 0; q < 4; ++q) {
      const int t = wv * 4 + q;
      const int which = t >> 4, mi = (t >> 2) & 3, ni = t & 3;
      const u16* Am = (which ? Qs : Ks) + (mi * 16 + fr) * 136 + fq * 8;
      const u16* Bm = Ks + (ni * 16 + fr) * 136 + fq * 8;
      f32x4 a4 = {0.f, 0.f, 0.f, 0.f};
#pragma unroll
      for (int kk = 0; kk < 4; ++kk)
        a4 = __builtin_amdgcn_mfma_f32_16x16x32_bf16(*(const bf16x8*)(Am + kk * 32), *(const bf16x8*)(Bm + kk * 32), a4, 0, 0, 0);
      float* dst = which ? QKs : KKs;
#pragma unroll
      for (int e = 0; e < 4; ++e) dst[(mi * 16 + fq * 4 + e) * 68 + ni * 16 + fr] = a4[e];
    }
  }
  lds_barrier();
  const int itb = item * 2;
  {
    u16* AQ = (u16*)((char*)P.out + OFF_AQ);
#pragma unroll 8
    for (int idx = tid; idx < 8192; idx += NT) {
      const int dir = idx >> 12, p = (idx >> 6) & 63, s = idx & 63;
      const int tp = dir ? (63 - p) : p, ts = dir ? (63 - s) : s;
      const float dg = gcp[dir * 64 + p] - gcp[dir * 64 + s];
      const float dec = (p >= s) ? __expf(dg) : 0.f;
      AQ[((size_t)(itb + dir) * 64 + p) * 64 + s] = f2bf(QKs[tp * 68 + ts] * dec);
    }
#pragma unroll 8
    for (int idx = tid; idx < 8192; idx += NT) {
      const int dir = idx >> 12, s = (idx >> 6) & 63, p = idx & 63;
      const int tp = dir ? (63 - p) : p, ts = dir ? (63 - s) : s;
      const float dg = gcp[dir * 64 + p] - gcp[dir * 64 + s];
      const float lv = (p > s) ? bpp[dir * 64 + p] * KKs[ts * 68 + tp] * __expf(dg) : 0.f;
      Lt[dir * 4096 + s * 64 + p] = lv;
    }
    if (tid < 128) {
      float* GC = (float*)(P.ws + OFF_GC);
      GC[(size_t)(itb + (tid >> 6)) * 64 + (tid & 63)] = gcp[tid];
    }
  }
  lds_barrier();
  if (tid < 256) solve_cols<0>(P, itb, tid, Lt, bpp, gcp, Vs, Ks);
  else solve_cols<1>(P, itb, tid - 256, Lt, bpp, gcp, Vs, Ks);
}

__device__ __forceinline__ void s5end_tile(const Params& P, int t, char* lds) {
  const int g = t / 6, mt = (t % 6) >> 1, nt = t & 1;
  const int m0 = mt * 256, n0 = nt * 128;
  f32x16 acc[2][2];
  acc_zero(acc);
  gemm_main((const u16*)(P.ws + OFF_U5) + ((size_t)g * 544 + m0) * 512, 512,
            (const u16*)(P.ws + OFF_MEND) + ((size_t)g * 256 + n0) * 512, 512, 512, acc, (u16*)lds);
  TILE_COORDS
  float* E = (float*)(P.ws + OFF_E);
#pragma unroll
  for (int i = 0; i < 2; ++i)
#pragma unroll
    for (int j = 0; j < 2; ++j)
#pragma unroll
      for (int e = 0; e < 16; ++e) {
        const int row = TROW(m0, i, e);
        if (row < 544) E[((size_t)g * 544 + row) * 256 + TCOL(n0, j)] = acc[i][j][e];
      }
}

__device__ __forceinline__ void scan_chunk(const u16* Wl, const u16* QTl, const u16* KTl, const u16* AQl, u16* ST, u16* VT,
                                           int wd, int wq, int fr, int fq, float gl, f32x4& av, f32x4& ao, f32x4& accS0, f32x4& accS1) {
  {
    bf16x8 bS[4], a1[4], a2[4];
#pragma unroll
    for (int kk = 0; kk < 4; ++kk) {
      bS[kk] = *(const bf16x8*)(ST + (wd * 16 + fr) * 136 + kk * 32 + fq * 8);
      a1[kk] = *(const bf16x8*)(Wl + (wq * 16 + fr) * 136 + kk * 32 + fq * 8);
      a2[kk] = *(const bf16x8*)(QTl + (wq * 16 + fr) * 136 + kk * 32 + fq * 8);
    }
    __builtin_amdgcn_sched_barrier(0);
#pragma unroll
    for (int kk = 0; kk < 4; ++kk) {
      av = __builtin_amdgcn_mfma_f32_16x16x32_bf16(a1[kk], bS[kk], av, 0, 0, 0);
      ao = __builtin_amdgcn_mfma_f32_16x16x32_bf16(a2[kk], bS[kk], ao, 0, 0, 0);
    }
  }
  {
    uint2 v; v.x = pack2(av[0], av[1]); v.y = pack2(av[2], av[3]);
    *(uint2*)(VT + (wd * 16 + fr) * 72 + wq * 16 + fq * 4) = v;
  }
  bf16x8 qa[2], k0[2], k1[2];
#pragma unroll
  for (int ks = 0; ks < 2; ++ks) {
    qa[ks] = *(const bf16x8*)(AQl + (wq * 16 + fr) * 72 + ks * 32 + fq * 8);
    const int r0_ = (2 * wq) * 16 + fr, r1_ = (2 * wq + 1) * 16 + fr;
    k0[ks] = *(const bf16x8*)(KTl + r0_ * 72 + ((ks * 32 + fq * 8) ^ (((r0_ >> 3) & 7) << 3)));
    k1[ks] = *(const bf16x8*)(KTl + r1_ * 72 + ((ks * 32 + fq * 8) ^ (((r1_ >> 3) & 7) << 3)));
  }
  accS0[0] *= gl; accS0[1] *= gl; accS0[2] *= gl; accS0[3] *= gl;
  accS1[0] *= gl; accS1[1] *= gl; accS1[2] *= gl; accS1[3] *= gl;
  lds_barrier();
  {
    bf16x8 bV[2];
#pragma unroll
    for (int ks = 0; ks < 2; ++ks) bV[ks] = *(const bf16x8*)(VT + (wd * 16 + fr) * 72 + ks * 32 + fq * 8);
#pragma unroll
    for (int ks = 0; ks < 2; ++ks) {
      ao = __builtin_amdgcn_mfma_f32_16x16x32_bf16(qa[ks], bV[ks], ao, 0, 0, 0);
      accS0 = __builtin_amdgcn_mfma_f32_16x16x32_bf16(k0[ks], bV[ks], accS0, 0, 0, 0);
      accS1 = __builtin_amdgcn_mfma_f32_16x16x32_bf16(k1[ks], bV[ks], accS1, 0, 0, 0);
    }
  }
  {
    uint2 v; v.x = pack2(accS0[0], accS0[1]); v.y = pack2(accS0[2], accS0[3]);
    *(uint2*)(ST + (wd * 16 + fr) * 136 + (2 * wq) * 16 + fq * 4) = v;
    v.x = pack2(accS1[0], accS1[1]); v.y = pack2(accS1[2], accS1[3]);
    *(uint2*)(ST + (wd * 16 + fr) * 136 + (2 * wq + 1) * 16 + fq * 4) = v;
  }
}

__device__ __forceinline__ void delta_scan_block(const Params& P, int sb, char* lds) {
  const int tid = opq(threadIdx.x), lane = tid & 63, w = tid >> 6, fr = lane & 15, fq = lane >> 4;
  const int bhd = sb & 31, dvq = sb >> 5;
  const int b = bhd >> 3, h = (bhd >> 1) & 3, dir = bhd & 1;
  const int wd = w & 1, wq = w >> 1;
  const int dv0 = dvq * 32 + wd * 16;
  u16* Wl = (u16*)(lds + opq(0));
  u16* QTl = (u16*)(lds + opq(17408));
  u16* KTl = (u16*)(lds + opq(34816));
  u16* AQl = (u16*)(lds + opq(53248));
  u16* ST = (u16*)(lds + opq(62464));
  u16* VT = (u16*)(lds + opq(71168));
  lds_barrier();
  for (int i = tid; i < 32 * 136 / 2; i += NT) ((uint32_t*)ST)[i] = 0u;
  f32x4 accS0 = {0.f, 0.f, 0.f, 0.f}, accS1 = {0.f, 0.f, 0.f, 0.f};
  const u16* QKN = (const u16*)((const char*)P.out + OFF_QKN);
  const u16* AQg = (const u16*)((const char*)P.out + OFF_AQ);
  const u16* Wg = (const u16*)(P.ws + OFF_R2);
  const u16* UFg = (const u16*)(P.ws + OFF_UF);
  const float* GC = (const float*)(P.ws + OFF_GC);
  u16* Og = (u16*)(P.ws + OFF_O);

#define GLD16(dst, ptr) asm volatile("global_load_dwordx4 %0, %1, off" : "=v"(dst) : "v"(ptr) : "memory")
#define GLD8(dst, ptr) asm volatile("global_load_dwordx2 %0, %1, off" : "=v"(dst) : "v"(ptr) : "memory")
#define GLD4(dst, ptr) asm volatile("global_load_dword %0, %1, off" : "=v"(dst) : "v"(ptr) : "memory")
#define SC_DECL(S)                                                   \
  u32x4 S##w0, S##w1, S##q0, S##q1, S##k0, S##k1, S##a;              \
  float S##gq0, S##gq1, S##g63;                                      \
  u32x2 S##u;                                                        \
  int S##row0 = 0, S##lat = 0;
#define SC_PF_ONE(S, i)                                                                            \
    {                                                                                              \
      const int id = tid + (i) * 512;                                                              \
      const int p = id >> 4, seg = id & 15;                                                        \
      const int tk = dir ? (63 - p) : p;                                                           \
      GLD16(S##w##i, Wg + it2__ * 8192 + p * 128 + seg * 8);                                       \
      GLD16(S##q##i, QKN + (size_t)(S##row0 + tk) * 1024 + h * 128 + seg * 8);                     \
      GLD4(S##gq##i, GC + it2__ * 64 + p);                                                         \
      GLD16(S##k##i, QKN + (size_t)(S##row0 + tk) * 1024 + 512 + h * 128 + seg * 8);               \
    }
#define SC_PREFETCH(S, n_)                                                                         \
  {                                                                                                \
    const int n__ = (n_);                                                                          \
    int cid__;                                                                                     \
    if (n__ < 4) { cid__ = 256 + b * 4 + (dir ? (3 - n__) : n__); S##lat = 0; }                    \
    else { const int m__ = n__ - 4; cid__ = b * 64 + (dir ? (63 - m__) : m__); S##lat = 1; }       \
    S##row0 = cid__ * 64;                                                                          \
    const size_t it2__ = (size_t)((cid__ * 4 + h) * 2 + dir);                                      \
    SC_PF_ONE(S, 0)                                                                                \
    SC_PF_ONE(S, 1)                                                                                \
    GLD4(S##g63, GC + it2__ * 64 + 63);                                                            \
    GLD16(S##a, AQg + it2__ * 4096 + (tid >> 3) * 64 + (tid & 7) * 8);                             \
    GLD8(S##u, UFg + (it2__ * 128 + dv0 + fr) * 64 + wq * 16 + fq * 4);                            \
  }
#define SC_WAIT(S, CNT)                                                                            \
  asm volatile("s_waitcnt vmcnt(" #CNT ")"                                                         \
               : "+v"(S##w0), "+v"(S##w1), "+v"(S##q0), "+v"(S##q1), "+v"(S##k0), "+v"(S##k1), "+v"(S##a), \
                 "+v"(S##gq0), "+v"(S##gq1), "+v"(S##g63), "+v"(S##u)                              \
               :: "memory");
#define SC_STAGE_ONE(S, i)                                                    \
    {                                                                         \
      const int id = tid + (i) * 512;                                         \
      const int p = id >> 4, seg = id & 15;                                   \
      *(u32x4*)(Wl + p * 136 + seg * 8) = S##w##i;                            \
      float f[8];                                                             \
      unpack8(make_uint4(S##q##i.x, S##q##i.y, S##q##i.z, S##q##i.w), f);     \
      const float sq = __expf(S##gq##i);                                      \
      f[0] *= sq; f[1] *= sq; f[2] *= sq; f[3] *= sq; f[4] *= sq; f[5] *= sq; f[6] *= sq; f[7] *= sq; \
      *(uint4*)(QTl + p * 136 + seg * 8) = pack8(f);                          \
      unpack8(make_uint4(S##k##i.x, S##k##i.y, S##k##i.z, S##k##i.w), f);     \
      const float sk = __expf(S##g63 - S##gq##i);                             \
      u16* kd = KTl + (seg * 8) * 72 + (p ^ ((seg & 7) << 3));                \
      kd[0 * 72] = f2bf(f[0] * sk); kd[1 * 72] = f2bf(f[1] * sk); kd[2 * 72] = f2bf(f[2] * sk); kd[3 * 72] = f2bf(f[3] * sk); \
      kd[4 * 72] = f2bf(f[4] * sk); kd[5 * 72] = f2bf(f[5] * sk); kd[6 * 72] = f2bf(f[6] * sk); kd[7 * 72] = f2bf(f[7] * sk); \
    }
#define SC_STEP(S, n_, WCNT, DO_PF)                                                                   \
  {                                                                                                   \
    SC_WAIT(S, WCNT)                                                                                  \
    const int cur_row0 = S##row0, cur_lat = S##lat;                                                   \
    const float gl = __expf(S##g63);                                                                  \
    SC_STAGE_ONE(S, 0)                                                                                \
    SC_STAGE_ONE(S, 1)                                                                                \
    *(u32x4*)(AQl + (tid >> 3) * 72 + (tid & 7) * 8) = S##a;                                          \
    f32x4 av = f32x4{lo16(S##u.x), hi16(S##u.x), lo16(S##u.y), hi16(S##u.y)};                         \
    f32x4 ao = f32x4{0.f, 0.f, 0.f, 0.f};                                                             \
    lds_barrier();                                                                                    \
    if (DO_PF) SC_PREFETCH(S, (n_) + 2)                                                               \
    scan_chunk(Wl, QTl, KTl, AQl, ST, VT, wd, wq, fr, fq, gl, av, ao, accS0, accS1);                  \
    if (cur_lat) {                                                                                    \
      const int p0 = wq * 16 + fq * 4;                                                                \
      u16* og = Og + ((size_t)dir * 16384 + cur_row0) * 512 + h * 128 + dv0 + fr;                     \
      og[(size_t)(dir ? (63 - (p0 + 0)) : (p0 + 0)) * 512] = f2bf(ao[0]);                             \
      og[(size_t)(dir ? (63 - (p0 + 1)) : (p0 + 1)) * 512] = f2bf(ao[1]);                             \
      og[(size_t)(dir ? (63 - (p0 + 2)) : (p0 + 2)) * 512] = f2bf(ao[2]);                             \
      og[(size_t)(dir ? (63 - (p0 + 3)) : (p0 + 3)) * 512] = f2bf(ao[3]);                             \
    }                                                                                                 \
    lds_barrier();                                                                                    \
  }
  SC_DECL(A)
  SC_DECL(B)
  SC_PREFETCH(A, 0)
  SC_PREFETCH(B, 1)
  for (int n = 0; n < 66; n += 2) {
    SC_STEP(A, n, 11, true)
    SC_STEP(B, n + 1, 11, true)
  }
  SC_STEP(A, 66, 0, false)
  SC_STEP(B, 67, 0, false)
#undef SC_DECL
#undef SC_PF_ONE
#undef SC_PREFETCH
#undef SC_WAIT
#undef SC_STAGE_ONE
#undef SC_STEP
#undef GLD16
#undef GLD8
#undef GLD4
}

__device__ __forceinline__ void s5_carry_block(const Params& P, int cb) {
  const int idx = cb * NT + opq(threadIdx.x);
  const int n = idx & 63, g = (idx >> 6) & 31, r = (idx >> 11) & 1, b = idx >> 12;
  const int rg = r * 32 + g;
  const float step = expf(P.s5_log_step[rg]);
  float lr, li;
  lam_pow(step, P.s5_a_re[rg * 64 + n], P.s5_a_im[rg * 64 + n], 32, lr, li);
  const float* __restrict__ E = (const float*)(P.ws + OFF_E) + (size_t)g * 544 * 256 + r * 128 + n;
  u16* __restrict__ XIN = (u16*)(P.ws + OFF_XIN) + (size_t)g * 512 * 256 + r * 128 + n;
  float xr = 0.f, xi = 0.f;
  {
    float er[8], ei[8];
#pragma unroll
    for (int k = 0; k < 8; ++k) {
      const int row = 512 + b * 8 + (r ? (7 - k) : k);
      er[k] = E[(size_t)row * 256]; ei[k] = E[(size_t)row * 256 + 64];
    }
#pragma unroll
    for (int k = 0; k < 8; ++k) {
      const float nr = lr * xr - li * xi + er[k], ni = lr * xi + li * xr + ei[k];
      xr = nr; xi = ni;
    }
  }
  for (int k0 = 0; k0 < 128; k0 += 8) {
    float er[8], ei[8];
#pragma unroll
    for (int k = 0; k < 8; ++k) {
      const int row = b * 128 + (r ? (127 - (k0 + k)) : (k0 + k));
      er[k] = E[(size_t)row * 256]; ei[k] = E[(size_t)row * 256 + 64];
    }
#pragma unroll
    for (int k = 0; k < 8; ++k) {
      const int row = b * 128 + (r ? (127 - (k0 + k)) : (k0 + k));
      XIN[(size_t)row * 256] = f2bf(xr);
      XIN[(size_t)row * 256 + 64] = f2bf(xi);
      const float nr = lr * xr - li * xi + er[k], ni = lr * xi + li * xr + ei[k];
      xr = nr; xi = ni;
    }
  }
}

__device__ __forceinline__ void s5out_tile(const Params& P, int t, char* lds) {
  const int g = t >> 3, mt = (t >> 2) & 1, nt = t & 3;
  const int m0 = mt * 256, n0 = nt * 128;
  f32x16 acc[2][2];
  acc_zero(acc);
  gemm_main((const u16*)(P.ws + OFF_XIN) + ((size_t)g * 512 + m0) * 256, 256,
            (const u16*)(P.ws + OFF_MST) + ((size_t)g * 512 + n0) * 256, 256, 256, acc, (u16*)lds);
  gemm_main((const u16*)(P.ws + OFF_U5) + ((size_t)g * 544 + m0) * 512, 512,
            (const u16*)(P.ws + OFF_MINTRA) + ((size_t)g * 512 + n0) * 512, 512, 512, acc, (u16*)lds);
  TILE_COORDS
  u16* YB = (u16*)(P.ws + OFF_YB);
#pragma unroll
  for (int i = 0; i < 2; ++i)
#pragma unroll
    for (int j = 0; j < 2; ++j)
#pragma unroll
      for (int e = 0; e < 16; ++e) {
        const int row = TROW(m0, i, e), nn = TCOL(n0, j);
        const int token = row * 32 + (nn >> 4);
        YB[(size_t)token * 512 + g * 16 + (nn & 15)] = f2bf(gelu_tanh(acc[i][j][e]));
      }
}

__device__ __forceinline__ void delta_post_item(const Params& P, int item) {
  const int lane = opq(threadIdx.x) & 63, w = opq(threadIdx.x) >> 6;
  const int row = item * 8 + w;
  const u16* O = (const u16*)(P.ws + OFF_O);
  const uint4 o0 = *(const uint4*)(O + (size_t)row * 512 + lane * 8);
  const uint4 o1 = *(const uint4*)(O + ((size_t)16384 + row) * 512 + lane * 8);
  const uint4 zz = *(const uint4*)((const u16*)(P.ws + OFF_Z) + (size_t)row * 512 + lane * 8);
  float a[8], bq[8], z[8];
  unpack8(o0, a); unpack8(o1, bq); unpack8(zz, z);
  float ss = 0.f;
#pragma unroll
  for (int e = 0; e < 8; ++e) { a[e] += bq[e]; ss += a[e] * a[e]; }
  ss += __shfl_xor(ss, 1, 64); ss += __shfl_xor(ss, 2, 64); ss += __shfl_xor(ss, 4, 64); ss += __shfl_xor(ss, 8, 64);
  const float rstd = rsqrtf(ss * (1.f / 128.f) + 1e-6f);
  const float* nw = P.dn_norm_w + (lane & 15) * 8;
  float y[8];
#pragma unroll
  for (int e = 0; e < 8; ++e) y[e] = a[e] * rstd * nw[e] * (z[e] * sigm(z[e]));
  *(uint4*)((u16*)(P.ws + OFF_YA) + (size_t)row * 512 + lane * 8) = pack8(y);
}

__device__ __forceinline__ void glu_tile(const Params& P, int t, char* lds) {
  const int nt = t >> 6, mt = t & 63;
  const int m0 = mt * 256, n0 = nt * 128;
  f32x16 acc[2][2];
  acc_zero(acc);
  gemm_main((const u16*)(P.ws + OFF_YB) + (size_t)m0 * 512, 512, (const u16*)(P.ws + OFF_WT_GLU) + (size_t)n0 * 512, 512, 512, acc, (u16*)lds);
  TILE_COORDS
  u16* YG = (u16*)(P.ws + OFF_YG);
  {
    const int oc = nt * 64 + wn_ * 32 + fr_;
    const float bv = P.b_glu[oc], bg = P.b_glu[512 + oc];
#pragma unroll
    for (int i = 0; i < 2; ++i)
#pragma unroll
      for (int e = 0; e < 16; ++e) {
        const float val = acc[i][0][e] + bv, gt = acc[i][1][e] + bg;
        YG[TIDX2(m0, nt * 64 + wn_ * 32, i, e, 512)] = f2bf(val * sigm(gt));
      }
  }
}

__device__ __forceinline__ void gates_tile(const Params& P, int t, char* lds) {
  const int nt = t >> 6, mt = t & 63;
  const int m0 = mt * 256, n0 = nt * 128;
  f32x16 acc[2][2];
  acc_zero(acc);
  gemm_main((const u16*)(P.ws + OFF_R2) + (size_t)m0 * 1024, 1024, (const u16*)(P.ws + OFF_WT_IN) + (size_t)(2688 + n0) * 1024, 1024, 1024, acc, (u16*)lds);
  TILE_COORDS
  u16* SG = (u16*)(P.ws + OFF_SG);
#pragma unroll
  for (int i = 0; i < 2; ++i)
#pragma unroll
    for (int j = 0; j < 2; ++j)
#pragma unroll
      for (int e = 0; e < 16; ++e) SG[TIDX(m0, n0, i, j, e, 2048)] = f2bf(sigm(acc[i][j][e]));
}

__device__ __forceinline__ void mix_tile(const Params& P, int t, char* lds) {
  const int nt = t >> 6, mt = t & 63;
  const int m0 = mt * 256, n0 = nt * 128;
  const u16* SG = (const u16*)(P.ws + OFF_SG);
  f32x16 acc[2][2];
  u16* MIX = (u16*)(P.ws + OFF_MIX);
  acc_zero(acc);
  gemm_main((const u16*)(P.ws + OFF_YA) + (size_t)m0 * 512, 512, (const u16*)(P.ws + OFF_WT_AOUT) + (size_t)n0 * 512, 512, 512, acc, (u16*)lds);
  {
    TILE_COORDS
    u16 sv[2][2][16];
#pragma unroll
    for (int i = 0; i < 2; ++i)
#pragma unroll
      for (int j = 0; j < 2; ++j)
#pragma unroll
        for (int e = 0; e < 16; ++e) sv[i][j][e] = SG[TIDX(m0, n0, i, j, e, 2048)];
#pragma unroll
    for (int i = 0; i < 2; ++i)
#pragma unroll
      for (int j = 0; j < 2; ++j)
#pragma unroll
        for (int e = 0; e < 16; ++e) MIX[TIDX(m0, n0, i, j, e, 1024)] = f2bf(bf2f(sv[i][j][e]) * acc[i][j][e]);
  }
  acc_zero(acc);
  gemm_main((const u16*)(P.ws + OFF_YG) + (size_t)m0 * 512, 512, (const u16*)(P.ws + OFF_WT_BOUT) + (size_t)n0 * 512, 512, 512, acc, (u16*)lds);
  {
    TILE_COORDS
#pragma unroll
    for (int i = 0; i < 2; ++i) {
      u16 sv[2][16], pv[2][16];
#pragma unroll
      for (int j = 0; j < 2; ++j)
#pragma unroll
        for (int e = 0; e < 16; ++e) {
          sv[j][e] = SG[TIDX(m0, n0, i, j, e, 2048) + 1024];
          pv[j][e] = MIX[TIDX(m0, n0, i, j, e, 1024)];
        }
#pragma unroll
      for (int j = 0; j < 2; ++j)
#pragma unroll
        for (int e = 0; e < 16; ++e)
          MIX[TIDX(m0, n0, i, j, e, 1024)] = f2bf(bf2f(pv[j][e]) + bf2f(sv[j][e]) * acc[i][j][e]);
    }
  }
}

__device__ __forceinline__ void wo_tile(const Params& P, int t, char* lds) {
  const int nt = t >> 6, mt = t & 63;
  const int m0 = mt * 256, n0 = nt * 128;
  f32x16 acc[2][2];
  acc_zero(acc);
  gemm_main((const u16*)(P.ws + OFF_MIX) + (size_t)m0 * 1024, 1024, (const u16*)(P.ws + OFF_WT_O) + (size_t)n0 * 1024, 1024, 1024, acc, (u16*)lds);
  TILE_COORDS
  const float* MOD = (const float*)(P.ws + OFF_MOD) + (m0 >> 12) * 6144 + 2 * 1024;
  float xv[2][2][16];
#pragma unroll
  for (int j = 0; j < 2; ++j)
#pragma unroll
    for (int i = 0; i < 2; ++i)
#pragma unroll
      for (int e = 0; e < 16; ++e) xv[i][j][e] = P.x[TIDX(m0, n0, i, j, e, 1024)];
#pragma unroll
  for (int j = 0; j < 2; ++j) {
    const int col = TCOL(n0, j);
    const float gate = MOD[col];
#pragma unroll
    for (int i = 0; i < 2; ++i)
#pragma unroll
      for (int e = 0; e < 16; ++e) P.out[TIDX(m0, n0, i, j, e, 1024)] = xv[i][j][e] + gate * acc[i][j][e];
  }
}

__device__ __forceinline__ void norm2_item(const Params& P, int item) {
  const int lane = opq(threadIdx.x) & 63, w = opq(threadIdx.x) >> 6;
  const int rowA = item * 16 + w, rowB = rowA + 8;
  const float* MA = (const float*)(P.ws + OFF_MOD) + (rowA >> 12) * 6144;
  const float* MB = (const float*)(P.ws + OFF_MOD) + (rowB >> 12) * 6144;
  u16* H = (u16*)(P.ws + OFF_R2);
  norm_row2(P.out + (size_t)rowA * 1024, P.out + (size_t)rowB * 1024, P.norm2_w, MA + 3 * 1024, MA + 4 * 1024, MB + 3 * 1024, MB + 4 * 1024,
            H + (size_t)rowA * 1024, H + (size_t)rowB * 1024, lane);
}

__device__ __forceinline__ void up_tile(const Params& P, int t, int hh, char* lds) {
  const int nt = t >> 6, mt = t & 63;
  const int m0 = mt * 256, n0 = nt * 128;
  f32x16 acc[2][2];
  acc_zero(acc);
  gemm_main((const u16*)(P.ws + OFF_R2) + (size_t)m0 * 1024, 1024,
            (const u16*)(P.ws + OFF_WT_UP) + ((size_t)hh * 2816 + n0) * 1024, 1024, 1024, acc, (u16*)lds);
  TILE_COORDS
  u16* UPH = (u16*)(P.ws + OFF_UPH);
#pragma unroll
  for (int i = 0; i < 2; ++i)
#pragma unroll
    for (int j = 0; j < 2; ++j)
#pragma unroll
      for (int e = 0; e < 16; ++e) UPH[TIDX(m0, n0, i, j, e, 2816)] = f2bf(acc[i][j][e]);
}

#define CG_LD(ci, dy)                                                                       \
    {                                                                                       \
      const int xc = x0 - 1 + (ci);                                                         \
      const bool cok = (xc >= 0) && (xc <= 63);                                             \
      const bool rok = ((dy) == 1) || ((dy) == 0 ? r0ok : r2ok);                            \
      const int yy = rok ? (y + (dy) - 1) : y;                                              \
      const u16* src = UPH + (base + (size_t)yy * 64 + (cok ? xc : x0)) * 2816 + c4;        \
      uint2 g__ = *(const uint2*)src;                                                       \
      uint2 v__ = *(const uint2*)(src + 1408);                                              \
      const bool ok = cok && rok;                                                           \
      g__.x = ok ? g__.x : 0u; g__.y = ok ? g__.y : 0u;                                     \
      v__.x = ok ? v__.x : 0u; v__.y = ok ? v__.y : 0u;                                     \
      gg[ci][dy] = g__; vv[ci][dy] = v__;                                                   \
    }
__device__ __forceinline__ void convgate_phase(const Params& P, int hh) {
  const int tid = opq(threadIdx.x);
  if (tid >= 352) return;
  const int c4 = tid * 4;
  const u16* UPH = (const u16*)(P.ws + OFF_UPH);
  u16* G = (u16*)(P.ws + OFF_G);
  float wg[9][4], wv[9][4];
#pragma unroll
  for (int k = 0; k < 9; ++k) {
    const float4 a = *(const float4*)(P.ffn_conv_w + (size_t)k * 5632 + hh * 1408 + c4);
    const float4 bq = *(const float4*)(P.ffn_conv_w + (size_t)k * 5632 + 2816 + hh * 1408 + c4);
    wg[k][0] = a.x; wg[k][1] = a.y; wg[k][2] = a.z; wg[k][3] = a.w;
    wv[k][0] = bq.x; wv[k][1] = bq.y; wv[k][2] = bq.z; wv[k][3] = bq.w;
  }
  for (int item = blockIdx.x; item < 4096; item += gridDim.x) {
  const int xo = item & 15, y = (item >> 4) & 63, b = item >> 10;
  const size_t base = (size_t)b * 4096;
  const bool r0ok = (y > 0), r2ok = (y < 63);
  const int x0 = xo * 4;
  uint2 gg[6][3], vv[6][3];
#pragma unroll
  for (int ci = 0; ci < 6; ++ci) {
    CG_LD(ci, 0)
    CG_LD(ci, 1)
    CG_LD(ci, 2)
  }
#pragma unroll
  for (int xx = 0; xx < 4; ++xx) {
    float ag[4] = {0.f, 0.f, 0.f, 0.f}, av[4] = {0.f, 0.f, 0.f, 0.f};
#pragma unroll
    for (int dy = 0; dy < 3; ++dy)
#pragma unroll
      for (int dx = 0; dx < 3; ++dx) {
        const uint2 gq = gg[xx + dx][dy], vq = vv[xx + dx][dy];
        const int k = dy * 3 + dx;
        ag[0] += wg[k][0] * lo16(gq.x); ag[1] += wg[k][1] * hi16(gq.x); ag[2] += wg[k][2] * lo16(gq.y); ag[3] += wg[k][3] * hi16(gq.y);
        av[0] += wv[k][0] * lo16(vq.x); av[1] += wv[k][1] * hi16(vq.x); av[2] += wv[k][2] * lo16(vq.y); av[3] += wv[k][3] * hi16(vq.y);
      }
    uint2 o;
    o.x = pack2(ag[0] * sigm(ag[0]) * av[0], ag[1] * sigm(ag[1]) * av[1]);
    o.y = pack2(ag[2] * sigm(ag[2]) * av[2], ag[3] * sigm(ag[3]) * av[3]);
    *(uint2*)(G + (base + y * 64 + x0 + xx) * 2816 + hh * 1408 + c4) = o;
  }
  }
}
#undef CG_LD

__device__ __forceinline__ void down_tile(const Params& P, int t, char* lds) {
  const int nt = t >> 6, mt = t & 63;
  const int m0 = mt * 256, n0 = nt * 128;
  f32x16 acc[2][2];
  acc_zero(acc);
  gemm_main((const u16*)(P.ws + OFF_G) + (size_t)m0 * 2816, 2816, (const u16*)(P.ws + OFF_WT_DOWN) + (size_t)n0 * 2816, 2816, 2816, acc, (u16*)lds);
  TILE_COORDS
  const float* MOD = (const float*)(P.ws + OFF_MOD) + (m0 >> 12) * 6144 + 5 * 1024;
  float xv[2][2][16];
#pragma unroll
  for (int j = 0; j < 2; ++j)
#pragma unroll
    for (int i = 0; i < 2; ++i)
#pragma unroll
      for (int e = 0; e < 16; ++e) xv[i][j][e] = P.out[TIDX(m0, n0, i, j, e, 1024)];
#pragma unroll
  for (int j = 0; j < 2; ++j) {
    const int col = TCOL(n0, j);
    const float gate = MOD[col];
#pragma unroll
    for (int i = 0; i < 2; ++i)
#pragma unroll
      for (int e = 0; e < 16; ++e) P.out[TIDX(m0, n0, i, j, e, 1024)] = xv[i][j][e] + gate * acc[i][j][e];
  }
}

__device__ __forceinline__ void final_item(const Params& P, int item) {
  const int lane = opq(threadIdx.x) & 63, w = opq(threadIdx.x) >> 6;
  const int row = item * 8 + w;
  float* xr = P.out + (size_t)row * 1024;
  float4 v[4];
  float ss = 0.f;
#pragma unroll
  for (int it = 0; it < 4; ++it) {
    v[it] = *(const float4*)(xr + (it * 64 + lane) * 4);
    ss += v[it].x * v[it].x + v[it].y * v[it].y + v[it].z * v[it].z + v[it].w * v[it].w;
  }
  ss = wsum64(ss);
  const float rstd = rsqrtf(ss * (1.f / 1024.f) + 1e-6f);
#pragma unroll
  for (int it = 0; it < 4; ++it) {
    const int c = (it * 64 + lane) * 4;
    const float4 w4 = *(const float4*)(P.norm_f_w + c);
    float4 o;
    o.x = v[it].x * rstd * w4.x; o.y = v[it].y * rstd * w4.y; o.z = v[it].z * rstd * w4.z; o.w = v[it].w * rstd * w4.w;
    *(float4*)(xr + c) = o;
  }
}

__device__ __forceinline__ void run_phase(const Params& P, int ph, char* lds) {
  const int bid = blockIdx.x, nb = gridDim.x;
#ifdef ONLY_PHASE
  if (ph != ONLY_PHASE) return;
#endif
  switch (ph) {
    case 0: {
      for (int it = bid; it < 984 + 192 + 2048; it += nb) {
        if (it < 296) convert_item(P.w_in, 1024, 4624, (u16*)(P.ws + OFF_WT_IN), 0, it, lds);
        else if (it < 328) convert_item(P.w_a_out, 512, 1024, (u16*)(P.ws + OFF_WT_AOUT), 1, it - 296, lds);
        else if (it < 360) convert_item(P.w_glu, 512, 1024, (u16*)(P.ws + OFF_WT_GLU), 2, it - 328, lds);
        else if (it < 392) convert_item(P.w_b_out, 512, 1024, (u16*)(P.ws + OFF_WT_BOUT), 3, it - 360, lds);
        else if (it < 456) convert_item(P.w_o, 1024, 1024, (u16*)(P.ws + OFF_WT_O), 4, it - 392, lds);
        else if (it < 808) convert_item(P.w_up, 1024, 5632, (u16*)(P.ws + OFF_WT_UP), 5, it - 456, lds);
        else if (it < 984) convert_item(P.w_down, 2816, 1024, (u16*)(P.ws + OFF_WT_DOWN), 6, it - 808, lds);
        else if (it < 1176) mod_item(P, it - 984, lds);
        else s5tab_item(P, it - 1176, lds);
      }
    } break;
    case 1:
      for (int it = bid; it < 1088 + 2048; it += nb) {
        if (it < 1088) norm1_item(P, it); else mintra_item(P, it - 1088);
      }
      break;
    case 2:
      for (int it = bid; it < 1396; it += nb) inproj_tile(P, it, lds);
      break;
    case 3:
      for (int it = bid; it < 1088 + 192; it += nb) {
        if (it < 1088) delta_prep_item(P, it, lds); else s5end_tile(P, it - 1088, lds);
      }
      break;
    case 4:
      if (bid < 128) delta_scan_block(P, bid, lds);
      else if (bid < 160) s5_carry_block(P, bid - 128);
      break;
    case 5:
      for (int it = bid; it < 256 + 2048 + 1024; it += nb) {
        if (it < 256) s5out_tile(P, it, lds);
        else if (it < 2304) delta_post_item(P, it - 256);
        else norm1_item(P, it - 2304);
      }
      break;
    case 6:
      for (int it = bid; it < 512 + 1024; it += nb) {
        if (it < 512) glu_tile(P, it, lds); else gates_tile(P, it - 512, lds);
      }
      break;
    case 7:
      for (int it = bid; it < 512; it += nb) mix_tile(P, it, lds);
      break;
    case 8:
      for (int it = bid; it < 512; it += nb) wo_tile(P, it, lds);
      break;
    case 9:
      for (int it = bid; it < 1024; it += nb) norm2_item(P, it);
      break;
    case 10:
      for (int it = bid; it < 1408; it += nb) up_tile(P, it, 0, lds);
      break;
    case 11:
      convgate_phase(P, 0);
      break;
    case 12:
      for (int it = bid; it < 1408; it += nb) up_tile(P, it, 1, lds);
      break;
    case 13:
      convgate_phase(P, 1);
      break;
    case 14:
      for (int it = bid; it < 512; it += nb) down_tile(P, it, lds);
      break;
    case 15:
      for (int it = bid; it < 2048; it += nb) final_item(P, it);
      break;
    default: break;
  }
}

typedef const __attribute__((address_space(4))) Params* KParamsPtr;
__global__ void __launch_bounds__(NT) fwd_megakernel(Params Pk) {
#if defined(__HIP_DEVICE_COMPILE__)
  extern __shared__ __attribute__((aligned(16))) char lds[];
  KParamsPtr pp = (KParamsPtr)__builtin_amdgcn_kernarg_segment_ptr();
  const int lo = (int)pp->ph_lo, hi = (int)pp->ph_hi;
#if MULTI_LAUNCH
  for (int ph = lo; ph < hi; ++ph) { KParamsPtr q = pp; asm volatile("" : "+s"(q)); Params P; for (int i_ = 0; i_ < (int)(sizeof(Params) / 8); ++i_) ((unsigned long long*)&P)[i_] = ((const __attribute__((address_space(4))) unsigned long long*)q)[i_]; run_phase(P, ph, lds); }
#else
  cg::grid_group grid = cg::this_grid();
  volatile LAS unsigned* xst = (volatile LAS unsigned*)(lds + (LDS_BYTES - 16));
  if (threadIdx.x == 0) { xst[0] = 0u; xst[1] = 0u; xst[2] = 0u; xst[3] = 0u; }
  __syncthreads();
  XcdBarrier xb = xcd_barrier_post((unsigned*)(pp->ws + OFF_BAR), xst);
  const unsigned rep_mask = (unsigned)pp->rep_mask;
  bool first_sync = true;
  for (int ph = lo; ph < hi; ++ph) {
    const int reps = 1 + (int)((rep_mask >> ph) & 1u);
    for (int rp = 0; rp < reps; ++rp) {
      {
        KParamsPtr q = pp;
        asm volatile("" : "+s"(q));
        Params P;
        {
          typedef __attribute__((address_space(1))) const float* GF;
          const float** dp = (const float**)&P;
          const __attribute__((address_space(4))) unsigned long long* sp = (const __attribute__((address_space(4))) unsigned long long*)q;
#pragma unroll
          for (int i_ = 0; i_ < 30; ++i_) dp[i_] = (const float*)(GF)(sp[i_]);
          P.out = (float*)(__attribute__((address_space(1))) float*)(sp[30]);
          P.ws = (char*)(__attribute__((address_space(1))) char*)(sp[31]);
          P.ph_lo = 0; P.ph_hi = 0; P.rep_mask = 0;
        }
        run_phase(P, ph, lds);
      }
      if (ph + 1 < hi || rp + 1 < reps) {
        if (first_sync) { grid.sync(); first_sync = false; }
        else xcd_barrier(xb);
      }
    }
  }
#endif
#endif
}

extern "C" void kernel_launch(void* const* d_in, const int* in_sizes, int n_in, void* d_out, int out_size, void* d_ws,
                              size_t ws_size, hipStream_t stream) {
  static int grid_blocks = 0;
  if (grid_blocks == 0) {
    if (n_in != 30 || out_size != 16384 * 1024 || ws_size < WS_NEED) {
      fprintf(stderr, "kernel_launch: unexpected shapes: n_in %d out %d ws %zu (need %zu)\n", n_in, out_size, ws_size, (size_t)WS_NEED);
      grid_blocks = -1;
      return;
    }
    int dev = 0, cus = 0, per_cu = 0;
    hipGetDevice(&dev);
    hipDeviceGetAttribute(&cus, hipDeviceAttributeMultiprocessorCount, dev);
    if (hipFuncSetAttribute((const void*)fwd_megakernel, hipFuncAttributeMaxDynamicSharedMemorySize, LDS_BYTES) != hipSuccess) {
      fprintf(stderr, "kernel_launch: hipFuncSetAttribute failed\n");
      grid_blocks = -1;
      return;
    }
    if (hipOccupancyMaxActiveBlocksPerMultiprocessor(&per_cu, (const void*)fwd_megakernel, NT, LDS_BYTES) != hipSuccess || per_cu < 1) {
      fprintf(stderr, "kernel_launch: occupancy query failed / zero (%d)\n", per_cu);
      grid_blocks = -1;
      return;
    }
    grid_blocks = cus;
    if (grid_blocks < 64) { fprintf(stderr, "kernel_launch: too few CUs (%d)\n", cus); grid_blocks = -1; return; }
  }
  if (grid_blocks < 0) return;
  (void)hipMemsetAsync((char*)d_ws + OFF_BAR, 0, XCD_BAR_WORDS * sizeof(unsigned), stream);
  Params p{};
  const float** pp = (const float**)&p;
  for (int i = 0; i < 30; ++i) pp[i] = (const float*)d_in[i];
  p.out = (float*)d_out;
  p.ws = (char*)d_ws;
#if MULTI_LAUNCH
  for (int ph = 0; ph < 16; ++ph) {
    p.ph_lo = ph; p.ph_hi = ph + 1;
    hipLaunchKernelGGL(fwd_megakernel, dim3(grid_blocks), dim3(NT), LDS_BYTES, stream, p);
  }
#else
  p.ph_lo = 0; p.ph_hi = 16;
#ifdef REPEAT_MASK
  p.rep_mask = REPEAT_MASK;
#endif
  void* args[] = {&p};
  hipError_t e = hipLaunchCooperativeKernel((const void*)fwd_megakernel, dim3(grid_blocks), dim3(NT), args, LDS_BYTES, stream);
  if (e != hipSuccess) fprintf(stderr, "cooperative launch failed: %s (grid %d)\n", hipGetErrorString(e), grid_blocks);
#endif
}
```

```cpp
#include <hip/hip_runtime.h>
#include <hip/hip_cooperative_groups.h>
#include <cstdio>
#include <cstdint>
namespace cg = cooperative_groups;

#ifndef MULTI_LAUNCH
#define MULTI_LAUNCH 0
#endif

typedef unsigned short u16;
typedef __attribute__((ext_vector_type(8))) short bf16x8;
typedef __attribute__((ext_vector_type(4))) float f32x4;
typedef __attribute__((ext_vector_type(16))) float f32x16;
typedef __attribute__((ext_vector_type(4))) unsigned int u32x4;
typedef __attribute__((ext_vector_type(2))) unsigned int u32x2;

#define NT 512
constexpr int LDS_BYTES = 131072 + 1024;
constexpr int NPHASE = 18;

constexpr size_t OFF_WT_IN   = 0;
constexpr size_t OFF_WT_AOUT = 9699328;
constexpr size_t OFF_WT_GLU  = 10747904;
constexpr size_t OFF_WT_BOUT = 11796480;
constexpr size_t OFF_WT_O    = 12845056;
constexpr size_t OFF_WT_UP   = 14942208;
constexpr size_t OFF_WT_DOWN = 26476544;
constexpr size_t OFF_MOD     = 32243712;
constexpr size_t OFF_BAR     = 32505856;
constexpr size_t OFF_R2      = 33554432;
constexpr size_t OFF_R1      = 69206016;
constexpr size_t OFF_KTAB    = OFF_R1;
constexpr size_t OFF_MEND    = OFF_R1 + 2097152;
constexpr size_t OFF_MST     = OFF_R1 + 10485760;
constexpr size_t OFF_MINTRA  = OFF_R1 + 18874368;
constexpr size_t OFF_R3      = 104857600;
constexpr size_t OFF_O       = OFF_R3;
constexpr size_t OFF_XIN     = OFF_R3 + 33554432;
constexpr size_t OFF_MIX     = 158334976;
constexpr size_t OFF_SG      = OFF_R1;
constexpr size_t OFF_Z       = 158334976;
constexpr size_t OFF_U5      = 175112192;
constexpr size_t OFF_BA      = 192937984;
constexpr size_t OFF_GC      = OFF_BA + 1179648;
constexpr size_t OFF_UF      = 195035136;
constexpr size_t OFF_YA      = OFF_UF;
constexpr size_t OFF_YB      = OFF_UF + 16777216;
constexpr size_t OFF_E       = 230686720;
constexpr size_t OFF_YG      = OFF_E;
constexpr size_t OFF_UPH     = OFF_R1;
constexpr size_t OFF_G       = 161480704;
constexpr size_t WS_NEED     = 253755392;
constexpr size_t OFF_QKN     = 0;
constexpr size_t OFF_AQ      = 35651584;

struct Params {
  const float *x, *c, *ctx, *c_ctx, *w_ada, *b_ada, *norm1_w, *w_in, *dn_conv_w, *dn_a_log, *dn_dt_bias, *dn_norm_w,
      *w_a_out, *s5_a_re, *s5_a_im, *s5_log_step, *s5_b_re, *s5_b_im, *s5_c_re, *s5_c_im, *s5_d, *w_glu, *b_glu,
      *w_b_out, *w_o, *norm2_w, *w_up, *ffn_conv_w, *w_down, *norm_f_w;
  float* out;
  char* ws;
  long long ph_lo, ph_hi;
  long long rep_mask;
};

#define XB_TMO      128
#define XB_XCNT(j)  (256  + 64 * (j))
#define XB_XSUB(j)  (1280 + 64 * (j))
#define XB_XGEN(j)  (2304 + 64 * (j))
#define XB_TOP      3328
#define XB_TOPGEN   3392
#define XCD_BAR_WORDS 3456
#define XB_SPIN_CAP (1u << 18)
#define LAS __attribute__((address_space(3)))

__device__ __forceinline__ unsigned xb_ld(unsigned* p)              { return __hip_atomic_load(p, __ATOMIC_RELAXED, __HIP_MEMORY_SCOPE_AGENT); }
__device__ __forceinline__ unsigned xb_add(unsigned* p, unsigned v) { return __hip_atomic_fetch_add(p, v, __ATOMIC_RELAXED, __HIP_MEMORY_SCOPE_AGENT); }
__device__ __forceinline__ unsigned xb_xcc_id() { return (unsigned)__builtin_amdgcn_s_getreg((3 << 11) | 20) & 0xFu; }
#define XB_SPIN(cond, bar) do { unsigned _sp = 0; while (cond) { __builtin_amdgcn_s_sleep(1); \
    if ((++_sp & 255u) == 0u) { if (xb_ld(&(bar)[XB_TMO])) break; if (_sp > XB_SPIN_CAP) { atomicAdd(&(bar)[XB_TMO], 1u); break; } } } } while (0)

struct XcdBarrier {
    unsigned* bar; unsigned x;
    volatile LAS unsigned* st;
};

__device__ __forceinline__ XcdBarrier xcd_barrier_post(unsigned* bar, volatile LAS unsigned* st) {
    XcdBarrier b; b.bar = bar; b.x = xb_xcc_id(); b.st = st;
    if (threadIdx.x == 0) (void)xb_add(&bar[XB_XCNT(b.x)], 1u);
    return b;
}
__device__ __forceinline__ void xcd_barrier_complete(unsigned* bar, unsigned x, unsigned& nloc, unsigned& nx) {
    const unsigned G = gridDim.x * gridDim.y * gridDim.z;
    unsigned sum, cnt, mine, sp = 0u;
    for (;;) {
        sum = 0u; cnt = 0u; mine = 0u;
#pragma unroll
        for (unsigned j = 0; j < 16; ++j) { const unsigned c = xb_ld(&bar[XB_XCNT(j)]); sum += c; cnt += (c > 0u) ? 1u : 0u; mine = (j == x) ? c : mine; }
        if (sum == G) break;
        __builtin_amdgcn_s_sleep(1);
        if ((++sp & 255u) == 0u) { if (xb_ld(&bar[XB_TMO])) break; if (sp > XB_SPIN_CAP) { atomicAdd(&bar[XB_TMO], 1u); break; } }
    }
    nloc = mine > 0u ? mine : 1u; nx = cnt > 0u ? cnt : 1u;
}

__device__ __forceinline__ void xcd_barrier(const XcdBarrier& b) {
    asm volatile("s_waitcnt vmcnt(0)" ::: "memory");
    __syncthreads();
    if (threadIdx.x == 0) {
        unsigned* bar = b.bar;
        __builtin_amdgcn_s_waitcnt(0);
        unsigned nloc = b.st[0], nx = b.st[1];
        if (nloc == 0u) { xcd_barrier_complete(bar, b.x, nloc, nx); b.st[0] = nloc; b.st[1] = nx; }
        const unsigned old = xb_add(&bar[XB_XSUB(b.x)], 1u);
        const unsigned gen = old / nloc;
        if (old + 1u == (gen + 1u) * nloc) {
            __builtin_amdgcn_fence(__ATOMIC_RELEASE, "agent");
            asm volatile("s_waitcnt vmcnt(0)" ::: "memory");
            const unsigned og = xb_add(&bar[XB_TOP], 1u);
            const unsigned tg = og / nx;
            if (og + 1u == (tg + 1u) * nx) xb_add(&bar[XB_TOPGEN], 1u);
            else XB_SPIN(xb_ld(&bar[XB_TOPGEN]) == tg, bar);
            __builtin_amdgcn_fence(__ATOMIC_ACQUIRE, "agent");
            xb_add(&bar[XB_XGEN(b.x)], 1u);
            asm volatile("s_waitcnt vmcnt(0)" ::: "memory");
        } else {
            XB_SPIN(xb_ld(&bar[XB_XGEN(b.x)]) == gen, bar);
            __builtin_amdgcn_fence(__ATOMIC_ACQUIRE, "agent");
            asm volatile("s_waitcnt vmcnt(0)" ::: "memory");
        }
    }
    __syncthreads();
}


typedef __attribute__((ext_vector_type(2))) float f32x2_t;
typedef __attribute__((ext_vector_type(2))) __bf16 bf16x2_t;
__device__ __forceinline__ u16 f2bf(float f) {
  const __bf16 h = (__bf16)f;
  return __builtin_bit_cast(u16, h);
}
__device__ __forceinline__ float bf2f(u16 h) { return __uint_as_float(((uint32_t)h) << 16); }
__device__ __forceinline__ uint32_t pack2(float a, float b) {
  const f32x2_t v = {a, b};
  const bf16x2_t r = __builtin_convertvector(v, bf16x2_t);
  return __builtin_bit_cast(uint32_t, r);
}
__device__ __forceinline__ float lo16(uint32_t w) { return __uint_as_float(w << 16); }
__device__ __forceinline__ float hi16(uint32_t w) { return __uint_as_float(w & 0xffff0000u); }
__device__ __forceinline__ int opq(int v) { asm volatile("" : "+v"(v)); return v; }
__device__ __forceinline__ void lds_barrier() {
  asm volatile("s_waitcnt lgkmcnt(0)" ::: "memory");
  __builtin_amdgcn_s_barrier();
  asm volatile("" ::: "memory");
}
__device__ __forceinline__ float sigm(float x) { return 1.f / (1.f + __expf(-x)); }
__device__ __forceinline__ void unpack8(uint4 v, float* f) {
  f[0] = lo16(v.x); f[1] = hi16(v.x); f[2] = lo16(v.y); f[3] = hi16(v.y);
  f[4] = lo16(v.z); f[5] = hi16(v.z); f[6] = lo16(v.w); f[7] = hi16(v.w);
}
__device__ __forceinline__ uint4 pack8(const float* f) {
  uint4 v; v.x = pack2(f[0], f[1]); v.y = pack2(f[2], f[3]); v.z = pack2(f[4], f[5]); v.w = pack2(f[6], f[7]);
  return v;
}
__device__ __forceinline__ float wsum64(float v) {
#pragma unroll
  for (int o = 32; o > 0; o >>= 1) v += __shfl_xor(v, o, 64);
  return v;
}
__device__ __forceinline__ float gelu_tanh(float x) {
  float u = 0.7978845608028654f * (x + 0.044715f * x * x * x);
  float t = 1.f - 2.f / (1.f + __expf(2.f * u));
  return 0.5f * x * (1.f + t);
}

__device__ __forceinline__ void g_frag(const u16* as, const u16* bs, int ks, bf16x8 (&a)[2], bf16x8 (&b)[2]) {
  a[0] = *(const bf16x8*)(as + ks * 16);
  a[1] = *(const bf16x8*)(as + 32 * 72 + ks * 16);
  b[0] = *(const bf16x8*)(bs + ks * 16);
  b[1] = *(const bf16x8*)(bs + 32 * 72 + ks * 16);
}
__device__ __forceinline__ void g_mma(const bf16x8 (&a)[2], const bf16x8 (&b)[2], f32x16 (&acc)[2][2]) {
  acc[0][0] = __builtin_amdgcn_mfma_f32_32x32x16_bf16(a[0], b[0], acc[0][0], 0, 0, 0);
  acc[0][1] = __builtin_amdgcn_mfma_f32_32x32x16_bf16(a[0], b[1], acc[0][1], 0, 0, 0);
  acc[1][0] = __builtin_amdgcn_mfma_f32_32x32x16_bf16(a[1], b[0], acc[1][0], 0, 0, 0);
  acc[1][1] = __builtin_amdgcn_mfma_f32_32x32x16_bf16(a[1], b[1], acc[1][1], 0, 0, 0);
}
__device__ __forceinline__ void gemm_main(const u16* __restrict__ A, int lda, const u16* __restrict__ Bt, int ldb, int K,
                                          f32x16 (&acc)[2][2], u16* lds) {
  const int tid = opq(threadIdx.x), lane = tid & 63, w = tid >> 6, wm = w >> 1, wn = w & 1, fr = lane & 31, fq = lane >> 5;
  u16* As = lds;
  u16* Bs = lds + 2 * 256 * 72;
  const int nk = K >> 6;
  uint4 p0, p1, p2, p3, p4, p5;
  uint4 q0, q1, q2, q3, q4, q5;
  uint4 r0, r1, r2, r3, r4, r5;
  const int lr = tid >> 3, lc = (tid & 7) * 8;
  const unsigned oa0 = (unsigned)(lr * lda + lc) * 2u, sa2 = (unsigned)lda * 128u;
  const unsigned oa1 = oa0 + sa2, oa2 = oa0 + 2u * sa2, oa3 = oa0 + 3u * sa2;
  const unsigned ob0 = (unsigned)(lr * ldb + lc) * 2u, ob1 = ob0 + (unsigned)ldb * 128u;
#define G_LOAD(S, kt_)                                          \
  {                                                             \
    const int kc_ = ((kt_) < nk) ? (kt_) : (nk - 1);            \
    const char* a_ = (const char*)A + kc_ * 128;                \
    const char* b_ = (const char*)Bt + kc_ * 128;               \
    S##0 = *(const uint4*)(a_ + oa0);                           \
    S##1 = *(const uint4*)(a_ + oa1);                           \
    S##2 = *(const uint4*)(a_ + oa2);                           \
    S##3 = *(const uint4*)(a_ + oa3);                           \
    S##4 = *(const uint4*)(b_ + ob0);                           \
    S##5 = *(const uint4*)(b_ + ob1);                           \
  }
#define G_STORE(S, buf_)                                                     \
  {                                                                          \
    u16* as_ = As + ((buf_) * 256 + lr) * 72 + lc;                           \
    u16* bs_ = Bs + ((buf_) * 128 + lr) * 72 + lc;                           \
    *(uint4*)(as_) = S##0;                                                   \
    *(uint4*)(as_ + 64 * 72) = S##1;                                         \
    *(uint4*)(as_ + 128 * 72) = S##2;                                        \
    *(uint4*)(as_ + 192 * 72) = S##3;                                        \
    *(uint4*)(bs_) = S##4;                                                   \
    *(uint4*)(bs_ + 64 * 72) = S##5;                                         \
  }
#define G_STEP(S, BUF, kt_)                                                               \
  {                                                                                       \
    const u16* as = As + ((BUF) * 256 + wm * 64 + fr) * 72 + fq * 8;                      \
    const u16* bs = Bs + ((BUF) * 128 + wn * 64 + fr) * 72 + fq * 8;                      \
    bf16x8 fa0[2], fb0[2], fa1[2], fb1[2], fa2[2], fb2[2];                                \
    g_frag(as, bs, 0, fa0, fb0);                                                          \
    g_frag(as, bs, 1, fa1, fb1);                                                          \
    __builtin_amdgcn_sched_barrier(0);                                                    \
    G_STORE(S, (BUF) ^ 1)                                                                 \
    G_LOAD(S, (kt_) + 4)                                                                  \
    __builtin_amdgcn_sched_barrier(0);                                                    \
    g_frag(as, bs, 2, fa2, fb2);                                                          \
    __builtin_amdgcn_sched_barrier(0);                                                    \
    g_mma(fa0, fb0, acc);                                                                 \
    __builtin_amdgcn_sched_barrier(0);                                                    \
    g_frag(as, bs, 3, fa0, fb0);                                                          \
    __builtin_amdgcn_sched_barrier(0);                                                    \
    g_mma(fa1, fb1, acc);                                                                 \
    g_mma(fa2, fb2, acc);                                                                 \
    g_mma(fa0, fb0, acc);                                                                 \
    lds_barrier();                                                                      \
  }
  G_LOAD(p, 0)
  lds_barrier();
  G_STORE(p, 0)
  G_LOAD(q, 1)
  G_LOAD(r, 2)
  G_LOAD(p, 3)
  lds_barrier();
  for (int kt = 0; kt < nk; kt += 6) {
    G_STEP(q, 0, kt)
    G_STEP(r, 1, kt + 1)
    if (kt + 2 < nk) {
      G_STEP(p, 0, kt + 2)
      G_STEP(q, 1, kt + 3)
    }
    if (kt + 4 < nk) {
      G_STEP(r, 0, kt + 4)
      G_STEP(p, 1, kt + 5)
    }
  }
#undef G_STEP
#undef G_LOAD
#undef G_STORE
}

__device__ __forceinline__ void acc_zero(f32x16 (&acc)[2][2]) {
#pragma unroll
  for (int i = 0; i < 2; ++i)
#pragma unroll
    for (int j = 0; j < 2; ++j)
#pragma unroll
      for (int e = 0; e < 16; ++e) acc[i][j][e] = 0.f;
}

#define TILE_COORDS                                                                                  \
  const int tid_ = opq(threadIdx.x), lane_ = tid_ & 63, w_ = __builtin_amdgcn_readfirstlane(tid_ >> 6), \
            wm_ = w_ >> 1, wn_ = w_ & 1, fr_ = lane_ & 31, fq_ = lane_ >> 5;
#define TROW(m0, i, e) ((m0) + wm_ * 64 + (i) * 32 + ((e) & 3) + 8 * ((e) >> 2) + 4 * fq_)
#define TCOL(n0, j) ((n0) + wn_ * 64 + (j) * 32 + fr_)
#define TIDX2(m0, cb, i, e, ld) ((size_t)((m0) + wm_ * 64 + (i) * 32 + ((e) & 3) + 8 * ((e) >> 2)) * (ld) + (cb) + (size_t)(unsigned)(4 * fq_ * (ld) + fr_))
#define TIDX(m0, n0, i, j, e, ld) TIDX2(m0, (n0) + wn_ * 64 + (j) * 32, i, e, ld)

__device__ __forceinline__ int srccol(int which, int r) {
  switch (which) {
    case 0:
      if (r < 2048) return r;
      if (r < 2560) return 2064 + (r - 2048);
      if (r < 2576) return 2048 + (r - 2560);
      if (r < 2688) return -1;
      if (r < 3712) return 2576 + (r - 2688);
      return 3600 + (r - 3712);
    case 2: {
      int tile = r >> 7, wn = (r >> 6) & 1, wi = r & 63;
      return (wi < 32) ? (tile * 64 + wn * 32 + wi) : (512 + tile * 64 + wn * 32 + (wi - 32));
    }
    case 5: {
      int hh = r / 2816, cc = r % 2816;
      int grp = cc >> 3, wi = cc & 7;
      return (wi < 4) ? (hh * 1408 + grp * 4 + wi) : (2816 + hh * 1408 + grp * 4 + (wi - 4));
    }
    default: return r;
  }
}

__device__ __forceinline__ void convert_item(const float* __restrict__ src, int K, int N, u16* __restrict__ dst, int which, int item, char* lds) {
  float* tile = (float*)lds;
  const int tid = opq(threadIdx.x);
  const int kb = K >> 8;
  const int r0 = (item / kb) * 64, k0 = (item % kb) * 256;
  lds_barrier();
  {
    const int n4 = (tid & 15) * 4, kk = tid >> 4;
    const int sc = srccol(which, r0 + n4);
    float4 v[8];
#pragma unroll
    for (int it = 0; it < 8; ++it) {
      const int k = kk + 32 * it;
      v[it] = (sc >= 0) ? *(const float4*)(src + (size_t)(k0 + k) * N + sc) : make_float4(0.f, 0.f, 0.f, 0.f);
    }
#pragma unroll
    for (int it = 0; it < 8; ++it) {
      const int k = kk + 32 * it;
      tile[(n4 + 0) * 257 + k] = v[it].x; tile[(n4 + 1) * 257 + k] = v[it].y;
      tile[(n4 + 2) * 257 + k] = v[it].z; tile[(n4 + 3) * 257 + k] = v[it].w;
    }
  }
  lds_barrier();
  {
    const int ks = (tid & 31) * 8, rr = tid >> 5;
#pragma unroll
    for (int it = 0; it < 4; ++it) {
      const int row = rr + 16 * it;
      float f[8];
#pragma unroll
      for (int e = 0; e < 8; ++e) f[e] = tile[row * 257 + ks + e];
      *(uint4*)(dst + (size_t)(r0 + row) * K + k0 + ks) = pack8(f);
    }
  }
}

__device__ __forceinline__ void mod_item(const Params& P, int item, char* lds) {
  float* sc = (float*)lds;
  float* red = sc + 5 * 1024;
  const int tid = opq(threadIdx.x);
  lds_barrier();
  for (int i = tid; i < 5 * 1024; i += NT) {
    const int r = i >> 10, k = i & 1023;
    float v = (r < 4) ? P.c[r * 1024 + k] : P.c_ctx[k];
    sc[i] = v * sigm(v);
  }
  lds_barrier();
  const int nn = tid & 31, kg = tid >> 5;
  const int n = item * 32 + nn;
  float a0 = 0, a1 = 0, a2 = 0, a3 = 0, a4 = 0;
  for (int kk = 0; kk < 64; ++kk) {
    const int k = kg * 64 + kk;
    const float wv = P.w_ada[(size_t)k * 6144 + n];
    a0 += sc[k] * wv; a1 += sc[1024 + k] * wv; a2 += sc[2048 + k] * wv; a3 += sc[3072 + k] * wv; a4 += sc[4096 + k] * wv;
  }
  red[(kg * 5 + 0) * 32 + nn] = a0; red[(kg * 5 + 1) * 32 + nn] = a1; red[(kg * 5 + 2) * 32 + nn] = a2;
  red[(kg * 5 + 3) * 32 + nn] = a3; red[(kg * 5 + 4) * 32 + nn] = a4;
  lds_barrier();
  if (tid < 160) {
    const int r = tid >> 5, n2 = tid & 31;
    float s = 0.f;
#pragma unroll
    for (int g = 0; g < 16; ++g) s += red[(g * 5 + r) * 32 + n2];
    float* MOD = (float*)(P.ws + OFF_MOD);
    MOD[r * 6144 + item * 32 + n2] = s + P.b_ada[item * 32 + n2];
  }
}

__device__ __forceinline__ void lam_pow(float step, float are, float aim, int e, float& pr, float& pi) {
  const float mag = expf((float)e * step * are);
  double ang = (double)e * (double)step * (double)aim;
  ang -= 6.283185307179586476925 * rint(ang * 0.15915494309189533577);
  float s, c;
  __sincosf((float)ang, &s, &c);
  pr = mag * c; pi = mag * s;
}

__device__ __forceinline__ void s5tab_item(const Params& P, int item, char* lds) {
  const int tid = opq(threadIdx.x);
  const int tau = item & 31, g = (item >> 5) & 31, r = item >> 10;
  float* cfr = (float*)lds;
  float* cfi = cfr + 64;
  float* p0r = cfi + 64;
  float* p0i = p0r + 64;
  float* p1r = p0i + 64;
  float* p1i = p1r + 64;
  float* Gr = p1i + 64;
  float* Gi = Gr + 1024;
  float* Cr = Gi + 1024;
  float* Ci = Cr + 1024;
  const int rg = r * 32 + g;
  lds_barrier();
  if (tid < 64) {
    const int n = tid;
    const float step = expf(P.s5_log_step[rg]);
    const float are = P.s5_a_re[rg * 64 + n], aim = P.s5_a_im[rg * 64 + n];
    const float za = step * are;
    double zb = (double)step * (double)aim;
    zb -= 6.283185307179586476925 * rint(zb * 0.15915494309189533577);
    float sb, cb, sh, ch;
    __sincosf((float)zb, &sb, &cb);
    __sincosf((float)(0.5 * zb), &sh, &ch);
    const float em1 = expm1f(za);
    const float re1 = em1 * cb - 2.f * sh * sh;
    const float im1 = (1.f + em1) * sb;
    const float den = are * are + aim * aim;
    cfr[n] = (re1 * are + im1 * aim) / den;
    cfi[n] = (im1 * are - re1 * aim) / den;
    float pr, pi;
    lam_pow(step, are, aim, tau, pr, pi);
    p0r[n] = pr; p0i[n] = pi;
    lam_pow(step, are, aim, tau + 1, pr, pi);
    p1r[n] = pr; p1i[n] = pi;
  }
  for (int i = tid; i < 1024; i += NT) {
    Cr[i] = P.s5_c_re[(size_t)rg * 1024 + i];
    Ci[i] = P.s5_c_im[(size_t)rg * 1024 + i];
  }
  lds_barrier();
  for (int i = tid; i < 1024; i += NT) {
    const int n = i >> 4;
    const float br = P.s5_b_re[(size_t)rg * 1024 + i], bi = P.s5_b_im[(size_t)rg * 1024 + i];
    const float tr = cfr[n] * br - cfi[n] * bi, ti = cfr[n] * bi + cfi[n] * br;
    Gr[i] = p0r[n] * tr - p0i[n] * ti;
    Gi[i] = p0r[n] * ti + p0i[n] * tr;
  }
  lds_barrier();
  u16* MEND = (u16*)(P.ws + OFF_MEND);
  u16* MST = (u16*)(P.ws + OFF_MST);
  float* KTAB = (float*)(P.ws + OFF_KTAB);
  {
    const int ii = (r == 0) ? (31 - tau) : tau;
    for (int i = tid; i < 2048; i += NT) {
      const int part = i >> 10, n = (i >> 4) & 63, pi_ = i & 15;
      const float v = part ? Gi[n * 16 + pi_] : Gr[n * 16 + pi_];
      MEND[((size_t)g * 256 + r * 128 + part * 64 + n) * 512 + ii * 16 + pi_] = f2bf(v);
    }
  }
  if (tid < 256) {
    const int po = tid >> 4, pi_ = tid & 15;
    float s = 0.f;
    for (int n = 0; n < 64; ++n) s += Cr[po * 64 + n] * Gr[n * 16 + pi_] - Ci[po * 64 + n] * Gi[n * 16 + pi_];
    KTAB[(((size_t)rg) * 32 + tau) * 256 + tid] = s;
  }
  {
    const int jj = (r == 0) ? tau : (31 - tau);
    for (int i = tid; i < 2048; i += NT) {
      const int po = i >> 7, part = (i >> 6) & 1, n = i & 63;
      const float cr = Cr[po * 64 + n], ci = Ci[po * 64 + n];
      const float v = part ? -(cr * p1i[n] + ci * p1r[n]) : (cr * p1r[n] - ci * p1i[n]);
      MST[((size_t)g * 512 + jj * 16 + po) * 256 + r * 128 + part * 64 + n] = f2bf(v);
    }
  }
}

__device__ __forceinline__ void norm_row(const float* __restrict__ xr, const float* __restrict__ nw, const float* __restrict__ shift,
                                         const float* __restrict__ scale, u16* __restrict__ dst, int lane) {
  float4 v[4];
  float ss = 0.f;
#pragma unroll
  for (int it = 0; it < 4; ++it) {
    v[it] = *(const float4*)(xr + (it * 64 + lane) * 4);
    ss += v[it].x * v[it].x + v[it].y * v[it].y + v[it].z * v[it].z + v[it].w * v[it].w;
  }
  ss = wsum64(ss);
  const float rstd = rsqrtf(ss * (1.f / 1024.f) + 1e-6f);
#pragma unroll
  for (int it = 0; it < 4; ++it) {
    const int c = (it * 64 + lane) * 4;
    const float4 w4 = *(const float4*)(nw + c), sh = *(const float4*)(shift + c), sc = *(const float4*)(scale + c);
    const float y0 = v[it].x * rstd * w4.x * (1.f + sc.x) + sh.x;
    const float y1 = v[it].y * rstd * w4.y * (1.f + sc.y) + sh.y;
    const float y2 = v[it].z * rstd * w4.z * (1.f + sc.z) + sh.z;
    const float y3 = v[it].w * rstd * w4.w * (1.f + sc.w) + sh.w;
    uint2 o; o.x = pack2(y0, y1); o.y = pack2(y2, y3);
    *(uint2*)(dst + c) = o;
  }
}

__device__ __forceinline__ void norm_row2(const float* __restrict__ xa, const float* __restrict__ xb, const float* __restrict__ nw,
                                          const float* __restrict__ shA, const float* __restrict__ scA,
                                          const float* __restrict__ shB, const float* __restrict__ scB,
                                          u16* __restrict__ da, u16* __restrict__ db, int lane) {
  float4 va[4], vb[4];
#pragma unroll
  for (int it = 0; it < 4; ++it) { va[it] = *(const float4*)(xa + (it * 64 + lane) * 4); vb[it] = *(const float4*)(xb + (it * 64 + lane) * 4); }
  float sa = 0.f, sb = 0.f;
#pragma unroll
  for (int it = 0; it < 4; ++it) {
    sa += va[it].x * va[it].x + va[it].y * va[it].y + va[it].z * va[it].z + va[it].w * va[it].w;
    sb += vb[it].x * vb[it].x + vb[it].y * vb[it].y + vb[it].z * vb[it].z + vb[it].w * vb[it].w;
  }
  sa = wsum64(sa); sb = wsum64(sb);
  const float ra = rsqrtf(sa * (1.f / 1024.f) + 1e-6f), rb = rsqrtf(sb * (1.f / 1024.f) + 1e-6f);
#pragma unroll
  for (int it = 0; it < 4; ++it) {
    const int c = (it * 64 + lane) * 4;
    const float4 w4 = *(const float4*)(nw + c);
    const float4 sh = *(const float4*)(shA + c), sc = *(const float4*)(scA + c);
    const float4 sh2 = *(const float4*)(shB + c), sc2 = *(const float4*)(scB + c);
    uint2 o;
    o.x = pack2(va[it].x * ra * w4.x * (1.f + sc.x) + sh.x, va[it].y * ra * w4.y * (1.f + sc.y) + sh.y);
    o.y = pack2(va[it].z * ra * w4.z * (1.f + sc.z) + sh.z, va[it].w * ra * w4.w * (1.f + sc.w) + sh.w);
    *(uint2*)(da + c) = o;
    o.x = pack2(vb[it].x * rb * w4.x * (1.f + sc2.x) + sh2.x, vb[it].y * rb * w4.y * (1.f + sc2.y) + sh2.y);
    o.y = pack2(vb[it].z * rb * w4.z * (1.f + sc2.z) + sh2.z, vb[it].w * rb * w4.w * (1.f + sc2.w) + sh2.w);
    *(uint2*)(db + c) = o;
  }
}

__device__ __forceinline__ void norm1_item(const Params& P, int item) {
  const int lane = opq(threadIdx.x) & 63, w = opq(threadIdx.x) >> 6;
  const int rowA = item * 16 + w, rowB = rowA + 8;
  const float* MOD = (const float*)(P.ws + OFF_MOD);
  const int ba = (rowA < 16384) ? (rowA >> 12) : 4, bb = (rowB < 16384) ? (rowB >> 12) : 4;
  const float* xa = (rowA < 16384) ? (P.x + (size_t)rowA * 1024) : (P.ctx + (size_t)(rowA - 16384) * 1024);
  const float* xb = (rowB < 16384) ? (P.x + (size_t)rowB * 1024) : (P.ctx + (size_t)(rowB - 16384) * 1024);
  u16* H = (u16*)(P.ws + OFF_R2);
  norm_row2(xa, xb, P.norm1_w, MOD + ba * 6144, MOD + ba * 6144 + 1024, MOD + bb * 6144, MOD + bb * 6144 + 1024,
            H + (size_t)rowA * 1024, H + (size_t)rowB * 1024, lane);
}

__device__ __forceinline__ void mintra_item(const Params& P, int item) {
  const int tid = opq(threadIdx.x);
  const int rowg = item * 8 + (tid >> 6);
  const int g = rowg >> 9, nout = rowg & 511, j = nout >> 4, po = nout & 15;
  const int k0 = (tid & 63) * 8, i = k0 >> 4, pi0 = k0 & 15;
  const float* KTAB = (const float*)(P.ws + OFF_KTAB);
  float f[8];
#pragma unroll
  for (int e = 0; e < 8; ++e) f[e] = 0.f;
  if (i <= j) {
    const float* kp = KTAB + (((size_t)(0 * 32 + g)) * 32 + (j - i)) * 256 + po * 16 + pi0;
#pragma unroll
    for (int e = 0; e < 8; ++e) f[e] += kp[e];
  }
  if (i >= j) {
    const float* kp = KTAB + (((size_t)(1 * 32 + g)) * 32 + (i - j)) * 256 + po * 16 + pi0;
#pragma unroll
    for (int e = 0; e < 8; ++e) f[e] += kp[e];
  }
  if (i == j) {
    const float dv = P.s5_d[g * 16 + po];
#pragma unroll
    for (int e = 0; e < 8; ++e) if (pi0 + e == po) f[e] += dv;
  }
  u16* MI = (u16*)(P.ws + OFF_MINTRA);
  *(uint4*)(MI + (size_t)rowg * 512 + k0) = pack8(f);
}

__device__ __forceinline__ void inproj_tile(const Params& P, int t, char* lds) {
  int mt, nt;
  if (t < 1344) { nt = t / 64; mt = t % 64; }
  else {
    const int tt = t - 1344; mt = 64 + (tt & 3);
    const int ni = tt >> 2;
    nt = (ni < 8) ? (4 + ni) : ((ni < 12) ? (16 + ni - 8) : 20);
  }
  const int m0 = mt * 256, n0 = nt * 128;
  f32x16 acc[2][2];
  acc_zero(acc);
  gemm_main((const u16*)(P.ws + OFF_R2) + (size_t)m0 * 1024, 1024, (const u16*)(P.ws + OFF_WT_IN) + (size_t)n0 * 1024, 1024, 1024, acc, (u16*)lds);
  TILE_COORDS
  if (nt < 12) {
    u16* QKV = (u16*)(P.ws + OFF_R3);
#pragma unroll
    for (int i = 0; i < 2; ++i)
#pragma unroll
      for (int j = 0; j < 2; ++j)
#pragma unroll
        for (int e = 0; e < 16; ++e) QKV[TIDX(m0, n0, i, j, e, 1536)] = f2bf(acc[i][j][e]);
  } else if (nt < 16) {
    u16* Z = (u16*)(P.ws + OFF_Z);
#pragma unroll
    for (int i = 0; i < 2; ++i)
#pragma unroll
      for (int j = 0; j < 2; ++j)
#pragma unroll
        for (int e = 0; e < 16; ++e) Z[TIDX(m0, n0, i, j, e, 512) - 1536] = f2bf(acc[i][j][e]);
  } else if (nt < 20) {
    u16* U5 = (u16*)(P.ws + OFF_U5);
#pragma unroll
    for (int i = 0; i < 2; ++i)
#pragma unroll
      for (int j = 0; j < 2; ++j)
#pragma unroll
        for (int e = 0; e < 16; ++e) {
          const int cc = TCOL(n0, j) - 2048;
          U5[((size_t)(cc >> 4) * 17408 + TROW(m0, i, e)) * 16 + (cc & 15)] = f2bf(acc[i][j][e]);
        }
  } else {
    float* BA = (float*)(P.ws + OFF_BA);
#pragma unroll
    for (int i = 0; i < 2; ++i)
#pragma unroll
      for (int j = 0; j < 2; ++j)
#pragma unroll
        for (int e = 0; e < 16; ++e) {
          const int cc = TCOL(n0, j) - 2560;
          if (cc < 16) BA[(size_t)TROW(m0, i, e) * 16 + cc] = acc[i][j][e];
        }
  }
}

__device__ __forceinline__ void solve_elim(float (&sol)[64], const float* Lr) {
  float4 b0a, b0b, b0c, b0d, b1a, b1b, b1c, b1d, b2a, b2b, b2c, b2d;
  b0a = *(const float4*)(Lr + 0); b0b = *(const float4*)(Lr + 4); b0c = *(const float4*)(Lr + 8); b0d = *(const float4*)(Lr + 12);
  b1a = *(const float4*)(Lr + 16); b1b = *(const float4*)(Lr + 20); b1c = *(const float4*)(Lr + 24); b1d = *(const float4*)(Lr + 28);
  b2a = *(const float4*)(Lr + 32); b2b = *(const float4*)(Lr + 36); b2c = *(const float4*)(Lr + 40); b2d = *(const float4*)(Lr + 44);
  __builtin_amdgcn_sched_barrier(0);
  sol[1] -= b0a.y * sol[0]; sol[2] -= b0a.z * sol[0]; sol[3] -= b0a.w * sol[0]; sol[4] -= b0b.x * sol[0]; sol[5] -= b0b.y * sol[0]; sol[6] -= b0b.z * sol[0]; sol[7] -= b0b.w * sol[0]; sol[8] -= b0c.x * sol[0]; sol[9] -= b0c.y * sol[0]; sol[10] -= b0c.z * sol[0]; sol[11] -= b0c.w * sol[0]; sol[12] -= b0d.x * sol[0]; sol[13] -= b0d.y * sol[0]; sol[14] -= b0d.z * sol[0]; sol[15] -= b0d.w * sol[0];
  __builtin_amdgcn_sched_barrier(0);
  b0a = *(const float4*)(Lr + 48); b0b = *(const float4*)(Lr + 52); b0c = *(const float4*)(Lr + 56); b0d = *(const float4*)(Lr + 60);
  __builtin_amdgcn_sched_barrier(0);
  sol[16] -= b1a.x * sol[0]; sol[17] -= b1a.y * sol[0]; sol[18] -= b1a.z * sol[0]; sol[19] -= b1a.w * sol[0]; sol[20] -= b1b.x * sol[0]; sol[21] -= b1b.y * sol[0]; sol[22] -= b1b.z * sol[0]; sol[23] -= b1b.w * sol[0]; sol[24] -= b1c.x * sol[0]; sol[25] -= b1c.y * sol[0]; sol[26] -= b1c.z * sol[0]; sol[27] -= b1c.w * sol[0]; sol[28] -= b1d.x * sol[0]; sol[29] -= b1d.y * sol[0]; sol[30] -= b1d.z * sol[0]; sol[31] -= b1d.w * sol[0];
  __builtin_amdgcn_sched_barrier(0);
  b1a = *(const float4*)(Lr + 64); b1b = *(const float4*)(Lr + 68); b1c = *(const float4*)(Lr + 72); b1d = *(const float4*)(Lr + 76);
  __builtin_amdgcn_sched_barrier(0);
  sol[32] -= b2a.x * sol[0]; sol[33] -= b2a.y * sol[0]; sol[34] -= b2a.z * sol[0]; sol[35] -= b2a.w * sol[0]; sol[36] -= b2b.x * sol[0]; sol[37] -= b2b.y * sol[0]; sol[38] -= b2b.z * sol[0]; sol[39] -= b2b.w * sol[0]; sol[40] -= b2c.x * sol[0]; sol[41] -= b2c.y * sol[0]; sol[42] -= b2c.z * sol[0]; sol[43] -= b2c.w * sol[0]; sol[44] -= b2d.x * sol[0]; sol[45] -= b2d.y * sol[0]; sol[46] -= b2d.z * sol[0]; sol[47] -= b2d.w * sol[0];
  __builtin_amdgcn_sched_barrier(0);
  b2a = *(const float4*)(Lr + 80); b2b = *(const float4*)(Lr + 84); b2c = *(const float4*)(Lr + 88); b2d = *(const float4*)(Lr + 92);
  __builtin_amdgcn_sched_barrier(0);
  sol[48] -= b0a.x * sol[0]; sol[49] -= b0a.y * sol[0]; sol[50] -= b0a.z * sol[0]; sol[51] -= b0a.w * sol[0]; sol[52] -= b0b.x * sol[0]; sol[53] -= b0b.y * sol[0]; sol[54] -= b0b.z * sol[0]; sol[55] -= b0b.w * sol[0]; sol[56] -= b0c.x * sol[0]; sol[57] -= b0c.y * sol[0]; sol[58] -= b0c.z * sol[0]; sol[59] -= b0c.w * sol[0]; sol[60] -= b0d.x * sol[0]; sol[61] -= b0d.y * sol[0]; sol[62] -= b0d.z * sol[0]; sol[63] -= b0d.w * sol[0];
  __builtin_amdgcn_sched_barrier(0);
  b0a = *(const float4*)(Lr + 96); b0b = *(const float4*)(Lr + 100); b0c = *(const float4*)(Lr + 104); b0d = *(const float4*)(Lr + 108);
  __builtin_amdgcn_sched_barrier(0);
  sol[2] -= b1a.z * sol[1]; sol[3] -= b1a.w * sol[1]; sol[4] -= b1b.x * sol[1]; sol[5] -= b1b.y * sol[1]; sol[6] -= b1b.z * sol[1]; sol[7] -= b1b.w * sol[1]; sol[8] -= b1c.x * sol[1]; sol[9] -= b1c.y * sol[1]; sol[10] -= b1c.z * sol[1]; sol[11] -= b1c.w * sol[1]; sol[12] -= b1d.x * sol[1]; sol[13] -= b1d.y * sol[1]; sol[14] -= b1d.z * sol[1]; sol[15] -= b1d.w * sol[1];
  __builtin_amdgcn_sched_barrier(0);
  b1a = *(const float4*)(Lr + 112); b1b = *(const float4*)(Lr + 116); b1c = *(const float4*)(Lr + 120); b1d = *(const float4*)(Lr + 124);
  __builtin_amdgcn_sched_barrier(0);
  sol[16] -= b2a.x * sol[1]; sol[17] -= b2a.y * sol[1]; sol[18] -= b2a.z * sol[1]; sol[19] -= b2a.w * sol[1]; sol[20] -= b2b.x * sol[1]; sol[21] -= b2b.y * sol[1]; sol[22] -= b2b.z * sol[1]; sol[23] -= b2b.w * sol[1]; sol[24] -= b2c.x * sol[1]; sol[25] -= b2c.y * sol[1]; sol[26] -= b2c.z * sol[1]; sol[27] -= b2c.w * sol[1]; sol[28] -= b2d.x * sol[1]; sol[29] -= b2d.y * sol[1]; sol[30] -= b2d.z * sol[1]; sol[31] -= b2d.w * sol[1];
  __builtin_amdgcn_sched_barrier(0);
  b2a = *(const float4*)(Lr + 128); b2b = *(const float4*)(Lr + 132); b2c = *(const float4*)(Lr + 136); b2d = *(const float4*)(Lr + 140);
  __builtin_amdgcn_sched_barrier(0);
  sol[32] -= b0a.x * sol[1]; sol[33] -= b0a.y * sol[1]; sol[34] -= b0a.z * sol[1]; sol[35] -= b0a.w * sol[1]; sol[36] -= b0b.x * sol[1]; sol[37] -= b0b.y * sol[1]; sol[38] -= b0b.z * sol[1]; sol[39] -= b0b.w * sol[1]; sol[40] -= b0c.x * sol[1]; sol[41] -= b0c.y * sol[1]; sol[42] -= b0c.z * sol[1]; sol[43] -= b0c.w * sol[1]; sol[44] -= b0d.x * sol[1]; sol[45] -= b0d.y * sol[1]; sol[46] -= b0d.z * sol[1]; sol[47] -= b0d.w * sol[1];
  __builtin_amdgcn_sched_barrier(0);
  b0a = *(const float4*)(Lr + 144); b0b = *(const float4*)(Lr + 148); b0c = *(const float4*)(Lr + 152); b0d = *(const float4*)(Lr + 156);
  __builtin_amdgcn_sched_barrier(0);
  sol[48] -= b1a.x * sol[1]; sol[49] -= b1a.y * sol[1]; sol[50] -= b1a.z * sol[1]; sol[51] -= b1a.w * sol[1]; sol[52] -= b1b.x * sol[1]; sol[53] -= b1b.y * sol[1]; sol[54] -= b1b.z * sol[1]; sol[55] -= b1b.w * sol[1]; sol[56] -= b1c.x * sol[1]; sol[57] -= b1c.y * sol[1]; sol[58] -= b1c.z * sol[1]; sol[59] -= b1c.w * sol[1]; sol[60] -= b1d.x * sol[1]; sol[61] -= b1d.y * sol[1]; sol[62] -= b1d.z * sol[1]; sol[63] -= b1d.w * sol[1];
  __builtin_amdgcn_sched_barrier(0);
  b1a = *(const float4*)(Lr + 160); b1b = *(const float4*)(Lr + 164); b1c = *(const float4*)(Lr + 168); b1d = *(const float4*)(Lr + 172);
  __builtin_amdgcn_sched_barrier(0);
  sol[3] -= b2a.w * sol[2]; sol[4] -= b2b.x * sol[2]; sol[5] -= b2b.y * sol[2]; sol[6] -= b2b.z * sol[2]; sol[7] -= b2b.w * sol[2]; sol[8] -= b2c.x * sol[2]; sol[9] -= b2c.y * sol[2]; sol[10] -= b2c.z * sol[2]; sol[11] -= b2c.w * sol[2]; sol[12] -= b2d.x * sol[2]; sol[13] -= b2d.y * sol[2]; sol[14] -= b2d.z * sol[2]; sol[15] -= b2d.w * sol[2];
  __builtin_amdgcn_sched_barrier(0);
  b2a = *(const float4*)(Lr + 176); b2b = *(const float4*)(Lr + 180); b2c = *(const float4*)(Lr + 184); b2d = *(const float4*)(Lr + 188);
  __builtin_amdgcn_sched_barrier(0);
  sol[16] -= b0a.x * sol[2]; sol[17] -= b0a.y * sol[2]; sol[18] -= b0a.z * sol[2]; sol[19] -= b0a.w * sol[2]; sol[20] -= b0b.x * sol[2]; sol[21] -= b0b.y * sol[2]; sol[22] -= b0b.z * sol[2]; sol[23] -= b0b.w * sol[2]; sol[24] -= b0c.x * sol[2]; sol[25] -= b0c.y * sol[2]; sol[26] -= b0c.z * sol[2]; sol[27] -= b0c.w * sol[2]; sol[28] -= b0d.x * sol[2]; sol[29] -= b0d.y * sol[2]; sol[30] -= b0d.z * sol[2]; sol[31] -= b0d.w * sol[2];
  __builtin_amdgcn_sched_barrier(0);
  b0a = *(const float4*)(Lr + 192); b0b = *(const float4*)(Lr + 196); b0c = *(const float4*)(Lr + 200); b0d = *(const float4*)(Lr + 204);
  __builtin_amdgcn_sched_barrier(0);
  sol[32] -= b1a.x * sol[2]; sol[33] -= b1a.y * sol[2]; sol[34] -= b1a.z * sol[2]; sol[35] -= b1a.w * sol[2]; sol[36] -= b1b.x * sol[2]; sol[37] -= b1b.y * sol[2]; sol[38] -= b1b.z * sol[2]; sol[39] -= b1b.w * sol[2]; sol[40] -= b1c.x * sol[2]; sol[41] -= b1c.y * sol[2]; sol[42] -= b1c.z * sol[2]; sol[43] -= b1c.w * sol[2]; sol[44] -= b1d.x * sol[2]; sol[45] -= b1d.y * sol[2]; sol[46] -= b1d.z * sol[2]; sol[47] -= b1d.w * sol[2];
  __builtin_amdgcn_sched_barrier(0);
  b1a = *(const float4*)(Lr + 208); b1b = *(const float4*)(Lr + 212); b1c = *(const float4*)(Lr + 216); b1d = *(const float4*)(Lr + 220);
  __builtin_amdgcn_sched_barrier(0);
  sol[48] -= b2a.x * sol[2]; sol[49] -= b2a.y * sol[2]; sol[50] -= b2a.z * sol[2]; sol[51] -= b2a.w * sol[2]; sol[52] -= b2b.x * sol[2]; sol[53] -= b2b.y * sol[2]; sol[54] -= b2b.z * sol[2]; sol[55] -= b2b.w * sol[2]; sol[56] -= b2c.x * sol[2]; sol[57] -= b2c.y * sol[2]; sol[58] -= b2c.z * sol[2]; sol[59] -= b2c.w * sol[2]; sol[60] -= b2d.x * sol[2]; sol[61] -= b2d.y * sol[2]; sol[62] -= b2d.z * sol[2]; sol[63] -= b2d.w * sol[2];
  __builtin_amdgcn_sched_barrier(0);
  b2a = *(const float4*)(Lr + 224); b2b = *(const float4*)(Lr + 228); b2c = *(const float4*)(Lr + 232); b2d = *(const float4*)(Lr + 236);
  __builtin_amdgcn_sched_barrier(0);
  sol[4] -= b0b.x * sol[3]; sol[5] -= b0b.y * sol[3]; sol[6] -= b0b.z * sol[3]; sol[7] -= b0b.w * sol[3]; sol[8] -= b0c.x * sol[3]; sol[9] -= b0c.y * sol[3]; sol[10] -= b0c.z * sol[3]; sol[11] -= b0c.w * sol[3]; sol[12] -= b0d.x * sol[3]; sol[13] -= b0d.y * sol[3]; sol[14] -= b0d.z * sol[3]; sol[15] -= b0d.w * sol[3];
  __builtin_amdgcn_sched_barrier(0);
  b0a = *(const float4*)(Lr + 240); b0b = *(const float4*)(Lr + 244); b0c = *(const float4*)(Lr + 248); b0d = *(const float4*)(Lr + 252);
  __builtin_amdgcn_sched_barrier(0);
  sol[16] -= b1a.x * sol[3]; sol[17] -= b1a.y * sol[3]; sol[18] -= b1a.z * sol[3]; sol[19] -= b1a.w * sol[3]; sol[20] -= b1b.x * sol[3]; sol[21] -= b1b.y * sol[3]; sol[22] -= b1b.z * sol[3]; sol[23] -= b1b.w * sol[3]; sol[24] -= b1c.x * sol[3]; sol[25] -= b1c.y * sol[3]; sol[26] -= b1c.z * sol[3]; sol[27] -= b1c.w * sol[3]; sol[28] -= b1d.x * sol[3]; sol[29] -= b1d.y * sol[3]; sol[30] -= b1d.z * sol[3]; sol[31] -= b1d.w * sol[3];
  __builtin_amdgcn_sched_barrier(0);
  b1a = *(const float4*)(Lr + 256); b1b = *(const float4*)(Lr + 260); b1c = *(const float4*)(Lr + 264); b1d = *(const float4*)(Lr + 268);
  __builtin_amdgcn_sched_barrier(0);
  sol[32] -= b2a.x * sol[3]; sol[33] -= b2a.y * sol[3]; sol[34] -= b2a.z * sol[3]; sol[35] -= b2a.w * sol[3]; sol[36] -= b2b.x * sol[3]; sol[37] -= b2b.y * sol[3]; sol[38] -= b2b.z * sol[3]; sol[39] -= b2b.w * sol[3]; sol[40] -= b2c.x * sol[3]; sol[41] -= b2c.y * sol[3]; sol[42] -= b2c.z * sol[3]; sol[43] -= b2c.w * sol[3]; sol[44] -= b2d.x * sol[3]; sol[45] -= b2d.y * sol[3]; sol[46] -= b2d.z * sol[3]; sol[47] -= b2d.w * sol[3];
  __builtin_amdgcn_sched_barrier(0);
  b2a = *(const float4*)(Lr + 272); b2b = *(const float4*)(Lr + 276); b2c = *(const float4*)(Lr + 280); b2d = *(const float4*)(Lr + 284);
  __builtin_amdgcn_sched_barrier(0);
  sol[48] -= b0a.x * sol[3]; sol[49] -= b0a.y * sol[3]; sol[50] -= b0a.z * sol[3]; sol[51] -= b0a.w * sol[3]; sol[52] -= b0b.x * sol[3]; sol[53] -= b0b.y * sol[3]; sol[54] -= b0b.z * sol[3]; sol[55] -= b0b.w * sol[3]; sol[56] -= b0c.x * sol[3]; sol[57] -= b0c.y * sol[3]; sol[58] -= b0c.z * sol[3]; sol[59] -= b0c.w * sol[3]; sol[60] -= b0d.x * sol[3]; sol[61] -= b0d.y * sol[3]; sol[62] -= b0d.z * sol[3]; sol[63] -= b0d.w * sol[3];
  __builtin_amdgcn_sched_barrier(0);
  b0a = *(const float4*)(Lr + 288); b0b = *(const float4*)(Lr + 292); b0c = *(const float4*)(Lr + 296); b0d = *(const float4*)(Lr + 300);
  __builtin_amdgcn_sched_barrier(0);
  sol[5] -= b1b.y * sol[4]; sol[6] -= b1b.z * sol[4]; sol[7] -= b1b.w * sol[4]; sol[8] -= b1c.x * sol[4]; sol[9] -= b1c.y * sol[4]; sol[10] -= b1c.z * sol[4]; sol[11] -= b1c.w * sol[4]; sol[12] -= b1d.x * sol[4]; sol[13] -= b1d.y * sol[4]; sol[14] -= b1d.z * sol[4]; sol[15] -= b1d.w * sol[4];
  __builtin_amdgcn_sched_barrier(0);
  b1a = *(const float4*)(Lr + 304); b1b = *(const float4*)(Lr + 308); b1c = *(const float4*)(Lr + 312); b1d = *(const float4*)(Lr + 316);
  __builtin_amdgcn_sched_barrier(0);
  sol[16] -= b2a.x * sol[4]; sol[17] -= b2a.y * sol[4]; sol[18] -= b2a.z * sol[4]; sol[19] -= b2a.w * sol[4]; sol[20] -= b2b.x * sol[4]; sol[21] -= b2b.y * sol[4]; sol[22] -= b2b.z * sol[4]; sol[23] -= b2b.w * sol[4]; sol[24] -= b2c.x * sol[4]; sol[25] -= b2c.y * sol[4]; sol[26] -= b2c.z * sol[4]; sol[27] -= b2c.w * sol[4]; sol[28] -= b2d.x * sol[4]; sol[29] -= b2d.y * sol[4]; sol[30] -= b2d.z * sol[4]; sol[31] -= b2d.w * sol[4];
  __builtin_amdgcn_sched_barrier(0);
  b2a = *(const float4*)(Lr + 320); b2b = *(const float4*)(Lr + 324); b2c = *(const float4*)(Lr + 328); b2d = *(const float4*)(Lr + 332);
  __builtin_amdgcn_sched_barrier(0);
  sol[32] -= b0a.x * sol[4]; sol[33] -= b0a.y * sol[4]; sol[34] -= b0a.z * sol[4]; sol[35] -= b0a.w * sol[4]; sol[36] -= b0b.x * sol[4]; sol[37] -= b0b.y * sol[4]; sol[38] -= b0b.z * sol[4]; sol[39] -= b0b.w * sol[4]; sol[40] -= b0c.x * sol[4]; sol[41] -= b0c.y * sol[4]; sol[42] -= b0c.z * sol[4]; sol[43] -= b0c.w * sol[4]; sol[44] -= b0d.x * sol[4]; sol[45] -= b0d.y * sol[4]; sol[46] -= b0d.z * sol[4]; sol[47] -= b0d.w * sol[4];
  __builtin_amdgcn_sched_barrier(0);
  b0a = *(const float4*)(Lr + 336); b0b = *(const float4*)(Lr + 340); b0c = *(const float4*)(Lr + 344); b0d = *(const float4*)(Lr + 348);
  __builtin_amdgcn_sched_barrier(0);
  sol[48] -= b1a.x * sol[4]; sol[49] -= b1a.y * sol[4]; sol[50] -= b1a.z * sol[4]; sol[51] -= b1a.w * sol[4]; sol[52] -= b1b.x * sol[4]; sol[53] -= b1b.y * sol[4]; sol[54] -= b1b.z * sol[4]; sol[55] -= b1b.w * sol[4]; sol[56] -= b1c.x * sol[4]; sol[57] -= b1c.y * sol[4]; sol[58] -= b1c.z * sol[4]; sol[59] -= b1c.w * sol[4]; sol[60] -= b1d.x * sol[4]; sol[61] -= b1d.y * sol[4]; sol[62] -= b1d.z * sol[4]; sol[63] -= b1d.w * sol[4];
  __builtin_amdgcn_sched_barrier(0);
  b1a = *(const float4*)(Lr + 352); b1b = *(const float4*)(Lr + 356); b1c = *(const float4*)(Lr + 360); b1d = *(const float4*)(Lr + 364);
  __builtin_amdgcn_sched_barrier(0);
  sol[6] -= b2b.z * sol[5]; sol[7] -= b2b.w * sol[5]; sol[8] -= b2c.x * sol[5]; sol[9] -= b2c.y * sol[5]; sol[10] -= b2c.z * sol[5]; sol[11] -= b2c.w * sol[5]; sol[12] -= b2d.x * sol[5]; sol[13] -= b2d.y * sol[5]; sol[14] -= b2d.z * sol[5]; sol[15] -= b2d.w * sol[5];
  __builtin_amdgcn_sched_barrier(0);
  b2a = *(const float4*)(Lr + 368); b2b = *(const float4*)(Lr + 372); b2c = *(const float4*)(Lr + 376); b2d = *(const float4*)(Lr + 380);
  __builtin_amdgcn_sched_barrier(0);
  sol[16] -= b0a.x * sol[5]; sol[17] -= b0a.y * sol[5]; sol[18] -= b0a.z * sol[5]; sol[19] -= b0a.w * sol[5]; sol[20] -= b0b.x * sol[5]; sol[21] -= b0b.y * sol[5]; sol[22] -= b0b.z * sol[5]; sol[23] -= b0b.w * sol[5]; sol[24] -= b0c.x * sol[5]; sol[25] -= b0c.y * sol[5]; sol[26] -= b0c.z * sol[5]; sol[27] -= b0c.w * sol[5]; sol[28] -= b0d.x * sol[5]; sol[29] -= b0d.y * sol[5]; sol[30] -= b0d.z * sol[5]; sol[31] -= b0d.w * sol[5];
  __builtin_amdgcn_sched_barrier(0);
  b0a = *(const float4*)(Lr + 384); b0b = *(const float4*)(Lr + 388); b0c = *(const float4*)(Lr + 392); b0d = *(const float4*)(Lr + 396);
  __builtin_amdgcn_sched_barrier(0);
  sol[32] -= b1a.x * sol[5]; sol[33] -= b1a.y * sol[5]; sol[34] -= b1a.z * sol[5]; sol[35] -= b1a.w * sol[5]; sol[36] -= b1b.x * sol[5]; sol[37] -= b1b.y * sol[5]; sol[38] -= b1b.z * sol[5]; sol[39] -= b1b.w * sol[5]; sol[40] -= b1c.x * sol[5]; sol[41] -= b1c.y * sol[5]; sol[42] -= b1c.z * sol[5]; sol[43] -= b1c.w * sol[5]; sol[44] -= b1d.x * sol[5]; sol[45] -= b1d.y * sol[5]; sol[46] -= b1d.z * sol[5]; sol[47] -= b1d.w * sol[5];
  __builtin_amdgcn_sched_barrier(0);
  b1a = *(const float4*)(Lr + 400); b1b = *(const float4*)(Lr + 404); b1c = *(const float4*)(Lr + 408); b1d = *(const float4*)(Lr + 412);
  __builtin_amdgcn_sched_barrier(0);
  sol[48] -= b2a.x * sol[5]; sol[49] -= b2a.y * sol[5]; sol[50] -= b2a.z * sol[5]; sol[51] -= b2a.w * sol[5]; sol[52] -= b2b.x * sol[5]; sol[53] -= b2b.y * sol[5]; sol[54] -= b2b.z * sol[5]; sol[55] -= b2b.w * sol[5]; sol[56] -= b2c.x * sol[5]; sol[57] -= b2c.y * sol[5]; sol[58] -= b2c.z * sol[5]; sol[59] -= b2c.w * sol[5]; sol[60] -= b2d.x * sol[5]; sol[61] -= b2d.y * sol[5]; sol[62] -= b2d.z * sol[5]; sol[63] -= b2d.w * sol[5];
  __builtin_amdgcn_sched_barrier(0);
  b2a = *(const float4*)(Lr + 416); b2b = *(const float4*)(Lr + 420); b2c = *(const float4*)(Lr + 424); b2d = *(const float4*)(Lr + 428);
  __builtin_amdgcn_sched_barrier(0);
  sol[7] -= b0b.w * sol[6]; sol[8] -= b0c.x * sol[6]; sol[9] -= b0c.y * sol[6]; sol[10] -= b0c.z * sol[6]; sol[11] -= b0c.w * sol[6]; sol[12] -= b0d.x * sol[6]; sol[13] -= b0d.y * sol[6]; sol[14] -= b0d.z * sol[6]; sol[15] -= b0d.w * sol[6];
  __builtin_amdgcn_sched_barrier(0);
  b0a = *(const float4*)(Lr + 432); b0b = *(const float4*)(Lr + 436); b0c = *(const float4*)(Lr + 440); b0d = *(const float4*)(Lr + 444);
  __builtin_amdgcn_sched_barrier(0);
  sol[16] -= b1a.x * sol[6]; sol[17] -= b1a.y * sol[6]; sol[18] -= b1a.z * sol[6]; sol[19] -= b1a.w * sol[6]; sol[20] -= b1b.x * sol[6]; sol[21] -= b1b.y * sol[6]; sol[22] -= b1b.z * sol[6]; sol[23] -= b1b.w * sol[6]; sol[24] -= b1c.x * sol[6]; sol[25] -= b1c.y * sol[6]; sol[26] -= b1c.z * sol[6]; sol[27] -= b1c.w * sol[6]; sol[28] -= b1d.x * sol[6]; sol[29] -= b1d.y * sol[6]; sol[30] -= b1d.z * sol[6]; sol[31] -= b1d.w * sol[6];
  __builtin_amdgcn_sched_barrier(0);
  b1a = *(const float4*)(Lr + 448); b1b = *(const float4*)(Lr + 452); b1c = *(const float4*)(Lr + 456); b1d = *(const float4*)(Lr + 460);
  __builtin_amdgcn_sched_barrier(0);
  sol[32] -= b2a.x * sol[6]; sol[33] -= b2a.y * sol[6]; sol[34] -= b2a.z * sol[6]; sol[35] -= b2a.w * sol[6]; sol[36] -= b2b.x * sol[6]; sol[37] -= b2b.y * sol[6]; sol[38] -= b2b.z * sol[6]; sol[39] -= b2b.w * sol[6]; sol[40] -= b2c.x * sol[6]; sol[41] -= b2c.y * sol[6]; sol[42] -= b2c.z * sol[6]; sol[43] -= b2c.w * sol[6]; sol[44] -= b2d.x * sol[6]; sol[45] -= b2d.y * sol[6]; sol[46] -= b2d.z * sol[6]; sol[47] -= b2d.w * sol[6];
  __builtin_amdgcn_sched_barrier(0);
  b2a = *(const float4*)(Lr + 464); b2b = *(const float4*)(Lr + 468); b2c = *(const float4*)(Lr + 472); b2d = *(const float4*)(Lr + 476);
  __builtin_amdgcn_sched_barrier(0);
  sol[48] -= b0a.x * sol[6]; sol[49] -= b0a.y * sol[6]; sol[50] -= b0a.z * sol[6]; sol[51] -= b0a.w * sol[6]; sol[52] -= b0b.x * sol[6]; sol[53] -= b0b.y * sol[6]; sol[54] -= b0b.z * sol[6]; sol[55] -= b0b.w * sol[6]; sol[56] -= b0c.x * sol[6]; sol[57] -= b0c.y * sol[6]; sol[58] -= b0c.z * sol[6]; sol[59] -= b0c.w * sol[6]; sol[60] -= b0d.x * sol[6]; sol[61] -= b0d.y * sol[6]; sol[62] -= b0d.z * sol[6]; sol[63] -= b0d.w * sol[6];
  __builtin_amdgcn_sched_barrier(0);
  b0a = *(const float4*)(Lr + 480); b0b = *(const float4*)(Lr + 484); b0c = *(const float4*)(Lr + 488); b0d = *(const float4*)(Lr + 492);
  __builtin_amdgcn_sched_barrier(0);
  sol[8] -= b1c.x * sol[7]; sol[9] -= b1c.y * sol[7]; sol[10] -= b1c.z * sol[7]; sol[11] -= b1c.w * sol[7]; sol[12] -= b1d.x * sol[7]; sol[13] -= b1d.y * sol[7]; sol[14] -= b1d.z * sol[7]; sol[15] -= b1d.w * sol[7];
  __builtin_amdgcn_sched_barrier(0);
  b1a = *(const float4*)(Lr + 496); b1b = *(const float4*)(Lr + 500); b1c = *(const float4*)(Lr + 504); b1d = *(const float4*)(Lr + 508);
  __builtin_amdgcn_sched_barrier(0);
  sol[16] -= b2a.x * sol[7]; sol[17] -= b2a.y * sol[7]; sol[18] -= b2a.z * sol[7]; sol[19] -= b2a.w * sol[7]; sol[20] -= b2b.x * sol[7]; sol[21] -= b2b.y * sol[7]; sol[22] -= b2b.z * sol[7]; sol[23] -= b2b.w * sol[7]; sol[24] -= b2c.x * sol[7]; sol[25] -= b2c.y * sol[7]; sol[26] -= b2c.z * sol[7]; sol[27] -= b2c.w * sol[7]; sol[28] -= b2d.x * sol[7]; sol[29] -= b2d.y * sol[7]; sol[30] -= b2d.z * sol[7]; sol[31] -= b2d.w * sol[7];
  __builtin_amdgcn_sched_barrier(0);
  b2a = *(const float4*)(Lr + 512); b2b = *(const float4*)(Lr + 516); b2c = *(const float4*)(Lr + 520); b2d = *(const float4*)(Lr + 524);
  __builtin_amdgcn_sched_barrier(0);
  sol[32] -= b0a.x * sol[7]; sol[33] -= b0a.y * sol[7]; sol[34] -= b0a.z * sol[7]; sol[35] -= b0a.w * sol[7]; sol[36] -= b0b.x * sol[7]; sol[37] -= b0b.y * sol[7]; sol[38] -= b0b.z * sol[7]; sol[39] -= b0b.w * sol[7]; sol[40] -= b0c.x * sol[7]; sol[41] -= b0c.y * sol[7]; sol[42] -= b0c.z * sol[7]; sol[43] -= b0c.w * sol[7]; sol[44] -= b0d.x * sol[7]; sol[45] -= b0d.y * sol[7]; sol[46] -= b0d.z * sol[7]; sol[47] -= b0d.w * sol[7];
  __builtin_amdgcn_sched_barrier(0);
  b0a = *(const float4*)(Lr + 528); b0b = *(const float4*)(Lr + 532); b0c = *(const float4*)(Lr + 536); b0d = *(const float4*)(Lr + 540);
  __builtin_amdgcn_sched_barrier(0);
  sol[48] -= b1a.x * sol[7]; sol[49] -= b1a.y * sol[7]; sol[50] -= b1a.z * sol[7]; sol[51] -= b1a.w * sol[7]; sol[52] -= b1b.x * sol[7]; sol[53] -= b1b.y * sol[7]; sol[54] -= b1b.z * sol[7]; sol[55] -= b1b.w * sol[7]; sol[56] -= b1c.x * sol[7]; sol[57] -= b1c.y * sol[7]; sol[58] -= b1c.z * sol[7]; sol[59] -= b1c.w * sol[7]; sol[60] -= b1d.x * sol[7]; sol[61] -= b1d.y * sol[7]; sol[62] -= b1d.z * sol[7]; sol[63] -= b1d.w * sol[7];
  __builtin_amdgcn_sched_barrier(0);
  b1a = *(const float4*)(Lr + 544); b1b = *(const float4*)(Lr + 548); b1c = *(const float4*)(Lr + 552); b1d = *(const float4*)(Lr + 556);
  __builtin_amdgcn_sched_barrier(0);
  sol[9] -= b2c.y * sol[8]; sol[10] -= b2c.z * sol[8]; sol[11] -= b2c.w * sol[8]; sol[12] -= b2d.x * sol[8]; sol[13] -= b2d.y * sol[8]; sol[14] -= b2d.z * sol[8]; sol[15] -= b2d.w * sol[8];
  __builtin_amdgcn_sched_barrier(0);
  b2a = *(const float4*)(Lr + 560); b2b = *(const float4*)(Lr + 564); b2c = *(const float4*)(Lr + 568); b2d = *(const float4*)(Lr + 572);
  __builtin_amdgcn_sched_barrier(0);
  sol[16] -= b0a.x * sol[8]; sol[17] -= b0a.y * sol[8]; sol[18] -= b0a.z * sol[8]; sol[19] -= b0a.w * sol[8]; sol[20] -= b0b.x * sol[8]; sol[21] -= b0b.y * sol[8]; sol[22] -= b0b.z * sol[8]; sol[23] -= b0b.w * sol[8]; sol[24] -= b0c.x * sol[8]; sol[25] -= b0c.y * sol[8]; sol[26] -= b0c.z * sol[8]; sol[27] -= b0c.w * sol[8]; sol[28] -= b0d.x * sol[8]; sol[29] -= b0d.y * sol[8]; sol[30] -= b0d.z * sol[8]; sol[31] -= b0d.w * sol[8];
  __builtin_amdgcn_sched_barrier(0);
  b0a = *(const float4*)(Lr + 576); b0b = *(const float4*)(Lr + 580); b0c = *(const float4*)(Lr + 584); b0d = *(const float4*)(Lr + 588);
  __builtin_amdgcn_sched_barrier(0);
  sol[32] -= b1a.x * sol[8]; sol[33] -= b1a.y * sol[8]; sol[34] -= b1a.z * sol[8]; sol[35] -= b1a.w * sol[8]; sol[36] -= b1b.x * sol[8]; sol[37] -= b1b.y * sol[8]; sol[38] -= b1b.z * sol[8]; sol[39] -= b1b.w * sol[8]; sol[40] -= b1c.x * sol[8]; sol[41] -= b1c.y * sol[8]; sol[42] -= b1c.z * sol[8]; sol[43] -= b1c.w * sol[8]; sol[44] -= b1d.x * sol[8]; sol[45] -= b1d.y * sol[8]; sol[46] -= b1d.z * sol[8]; sol[47] -= b1d.w * sol[8];
  __builtin_amdgcn_sched_barrier(0);
  b1a = *(const float4*)(Lr + 592); b1b = *(const float4*)(Lr + 596); b1c = *(const float4*)(Lr + 600); b1d = *(const float4*)(Lr + 604);
  __builtin_amdgcn_sched_barrier(0);
  sol[48] -= b2a.x * sol[8]; sol[49] -= b2a.y * sol[8]; sol[50] -= b2a.z * sol[8]; sol[51] -= b2a.w * sol[8]; sol[52] -= b2b.x * sol[8]; sol[53] -= b2b.y * sol[8]; sol[54] -= b2b.z * sol[8]; sol[55] -= b2b.w * sol[8]; sol[56] -= b2c.x * sol[8]; sol[57] -= b2c.y * sol[8]; sol[58] -= b2c.z * sol[8]; sol[59] -= b2c.w * sol[8]; sol[60] -= b2d.x * sol[8]; sol[61] -= b2d.y * sol[8]; sol[62] -= b2d.z * sol[8]; sol[63] -= b2d.w * sol[8];
  __builtin_amdgcn_sched_barrier(0);
  b2a = *(const float4*)(Lr + 608); b2b = *(const float4*)(Lr + 612); b2c = *(const float4*)(Lr + 616); b2d = *(const float4*)(Lr + 620);
  __builtin_amdgcn_sched_barrier(0);
  sol[10] -= b0c.z * sol[9]; sol[11] -= b0c.w * sol[9]; sol[12] -= b0d.x * sol[9]; sol[13] -= b0d.y * sol[9]; sol[14] -= b0d.z * sol[9]; sol[15] -= b0d.w * sol[9];
  __builtin_amdgcn_sched_barrier(0);
  b0a = *(const float4*)(Lr + 624); b0b = *(const float4*)(Lr + 628); b0c = *(const float4*)(Lr + 632); b0d = *(const float4*)(Lr + 636);
  __builtin_amdgcn_sched_barrier(0);
  sol[16] -= b1a.x * sol[9]; sol[17] -= b1a.y * sol[9]; sol[18] -= b1a.z * sol[9]; sol[19] -= b1a.w * sol[9]; sol[20] -= b1b.x * sol[9]; sol[21] -= b1b.y * sol[9]; sol[22] -= b1b.z * sol[9]; sol[23] -= b1b.w * sol[9]; sol[24] -= b1c.x * sol[9]; sol[25] -= b1c.y * sol[9]; sol[26] -= b1c.z * sol[9]; sol[27] -= b1c.w * sol[9]; sol[28] -= b1d.x * sol[9]; sol[29] -= b1d.y * sol[9]; sol[30] -= b1d.z * sol[9]; sol[31] -= b1d.w * sol[9];
  __builtin_amdgcn_sched_barrier(0);
  b1a = *(const float4*)(Lr + 640); b1b = *(const float4*)(Lr + 644); b1c = *(const float4*)(Lr + 648); b1d = *(const float4*)(Lr + 652);
  __builtin_amdgcn_sched_barrier(0);
  sol[32] -= b2a.x * sol[9]; sol[33] -= b2a.y * sol[9]; sol[34] -= b2a.z * sol[9]; sol[35] -= b2a.w * sol[9]; sol[36] -= b2b.x * sol[9]; sol[37] -= b2b.y * sol[9]; sol[38] -= b2b.z * sol[9]; sol[39] -= b2b.w * sol[9]; sol[40] -= b2c.x * sol[9]; sol[41] -= b2c.y * sol[9]; sol[42] -= b2c.z * sol[9]; sol[43] -= b2c.w * sol[9]; sol[44] -= b2d.x * sol[9]; sol[45] -= b2d.y * sol[9]; sol[46] -= b2d.z * sol[9]; sol[47] -= b2d.w * sol[9];
  __builtin_amdgcn_sched_barrier(0);
  b2a = *(const float4*)(Lr + 656); b2b = *(const float4*)(Lr + 660); b2c = *(const float4*)(Lr + 664); b2d = *(const float4*)(Lr + 668);
  __builtin_amdgcn_sched_barrier(0);
  sol[48] -= b0a.x * sol[9]; sol[49] -= b0a.y * sol[9]; sol[50] -= b0a.z * sol[9]; sol[51] -= b0a.w * sol[9]; sol[52] -= b0b.x * sol[9]; sol[53] -= b0b.y * sol[9]; sol[54] -= b0b.z * sol[9]; sol[55] -= b0b.w * sol[9]; sol[56] -= b0c.x * sol[9]; sol[57] -= b0c.y * sol[9]; sol[58] -= b0c.z * sol[9]; sol[59] -= b0c.w * sol[9]; sol[60] -= b0d.x * sol[9]; sol[61] -= b0d.y * sol[9]; sol[62] -= b0d.z * sol[9]; sol[63] -= b0d.w * sol[9];
  __builtin_amdgcn_sched_barrier(0);
  b0a = *(const float4*)(Lr + 672); b0b = *(const float4*)(Lr + 676); b0c = *(const float4*)(Lr + 680); b0d = *(const float4*)(Lr + 684);
  __builtin_amdgcn_sched_barrier(0);
  sol[11] -= b1c.w * sol[10]; sol[12] -= b1d.x * sol[10]; sol[13] -= b1d.y * sol[10]; sol[14] -= b1d.z * sol[10]; sol[15] -= b1d.w * sol[10];
  __builtin_amdgcn_sched_barrier(0);
  b1a = *(const float4*)(Lr + 688); b1b = *(const float4*)(Lr + 692); b1c = *(const float4*)(Lr + 696); b1d = *(const float4*)(Lr + 700);
  __builtin_amdgcn_sched_barrier(0);
  sol[16] -= b2a.x * sol[10]; sol[17] -= b2a.y * sol[10]; sol[18] -= b2a.z * sol[10]; sol[19] -= b2a.w * sol[10]; sol[20] -= b2b.x * sol[10]; sol[21] -= b2b.y * sol[10]; sol[22] -= b2b.z * sol[10]; sol[23] -= b2b.w * sol[10]; sol[24] -= b2c.x * sol[10]; sol[25] -= b2c.y * sol[10]; sol[26] -= b2c.z * sol[10]; sol[27] -= b2c.w * sol[10]; sol[28] -= b2d.x * sol[10]; sol[29] -= b2d.y * sol[10]; sol[30] -= b2d.z * sol[10]; sol[31] -= b2d.w * sol[10];
  __builtin_amdgcn_sched_barrier(0);
  b2a = *(const float4*)(Lr + 704); b2b = *(const float4*)(Lr + 708); b2c = *(const float4*)(Lr + 712); b2d = *(const float4*)(Lr + 716);
  __builtin_amdgcn_sched_barrier(0);
  sol[32] -= b0a.x * sol[10]; sol[33] -= b0a.y * sol[10]; sol[34] -= b0a.z * sol[10]; sol[35] -= b0a.w * sol[10]; sol[36] -= b0b.x * sol[10]; sol[37] -= b0b.y * sol[10]; sol[38] -= b0b.z * sol[10]; sol[39] -= b0b.w * sol[10]; sol[40] -= b0c.x * sol[10]; sol[41] -= b0c.y * sol[10]; sol[42] -= b0c.z * sol[10]; sol[43] -= b0c.w * sol[10]; sol[44] -= b0d.x * sol[10]; sol[45] -= b0d.y * sol[10]; sol[46] -= b0d.z * sol[10]; sol[47] -= b0d.w * sol[10];
  __builtin_amdgcn_sched_barrier(0);
  b0a = *(const float4*)(Lr + 720); b0b = *(const float4*)(Lr + 724); b0c = *(const float4*)(Lr + 728); b0d = *(const float4*)(Lr + 732);
  __builtin_amdgcn_sched_barrier(0);
  sol[48] -= b1a.x * sol[10]; sol[49] -= b1a.y * sol[10]; sol[50] -= b1a.z * sol[10]; sol[51] -= b1a.w * sol[10]; sol[52] -= b1b.x * sol[10]; sol[53] -= b1b.y * sol[10]; sol[54] -= b1b.z * sol[10]; sol[55] -= b1b.w * sol[10]; sol[56] -= b1c.x * sol[10]; sol[57] -= b1c.y * sol[10]; sol[58] -= b1c.z * sol[10]; sol[59] -= b1c.w * sol[10]; sol[60] -= b1d.x * sol[10]; sol[61] -= b1d.y * sol[10]; sol[62] -= b1d.z * sol[10]; sol[63] -= b1d.w * sol[10];
  __builtin_amdgcn_sched_barrier(0);
  b1a = *(const float4*)(Lr + 736); b1b = *(const float4*)(Lr + 740); b1c = *(const float4*)(Lr + 744); b1d = *(const float4*)(Lr + 748);
  __builtin_amdgcn_sched_barrier(0);
  sol[12] -= b2d.x * sol[11]; sol[13] -= b2d.y * sol[11]; sol[14] -= b2d.z * sol[11]; sol[15] -= b2d.w * sol[11];
  __builtin_amdgcn_sched_barrier(0);
  b2a = *(const float4*)(Lr + 752); b2b = *(const float4*)(Lr + 756); b2c = *(const float4*)(Lr + 760); b2d = *(const float4*)(Lr + 764);
  __builtin_amdgcn_sched_barrier(0);
  sol[16] -= b0a.x * sol[11]; sol[17] -= b0a.y * sol[11]; sol[18] -= b0a.z * sol[11]; sol[19] -= b0a.w * sol[11]; sol[20] -= b0b.x * sol[11]; sol[21] -= b0b.y * sol[11]; sol[22] -= b0b.z * sol[11]; sol[23] -= b0b.w * sol[11]; sol[24] -= b0c.x * sol[11]; sol[25] -= b0c.y * sol[11]; sol[26] -= b0c.z * sol[11]; sol[27] -= b0c.w * sol[11]; sol[28] -= b0d.x * sol[11]; sol[29] -= b0d.y * sol[11]; sol[30] -= b0d.z * sol[11]; sol[31] -= b0d.w * sol[11];
  __builtin_amdgcn_sched_barrier(0);
  b0a = *(const float4*)(Lr + 768); b0b = *(const float4*)(Lr + 772); b0c = *(const float4*)(Lr + 776); b0d = *(const float4*)(Lr + 780);
  __builtin_amdgcn_sched_barrier(0);
  sol[32] -= b1a.x * sol[11]; sol[33] -= b1a.y * sol[11]; sol[34] -= b1a.z * sol[11]; sol[35] -= b1a.w * sol[11]; sol[36] -= b1b.x * sol[11]; sol[37] -= b1b.y * sol[11]; sol[38] -= b1b.z * sol[11]; sol[39] -= b1b.w * sol[11]; sol[40] -= b1c.x * sol[11]; sol[41] -= b1c.y * sol[11]; sol[42] -= b1c.z * sol[11]; sol[43] -= b1c.w * sol[11]; sol[44] -= b1d.x * sol[11]; sol[45] -= b1d.y * sol[11]; sol[46] -= b1d.z * sol[11]; sol[47] -= b1d.w * sol[11];
  __builtin_amdgcn_sched_barrier(0);
  b1a = *(const float4*)(Lr + 784); b1b = *(const float4*)(Lr + 788); b1c = *(const float4*)(Lr + 792); b1d = *(const float4*)(Lr + 796);
  __builtin_amdgcn_sched_barrier(0);
  sol[48] -= b2a.x * sol[11]; sol[49] -= b2a.y * sol[11]; sol[50] -= b2a.z * sol[11]; sol[51] -= b2a.w * sol[11]; sol[52] -= b2b.x * sol[11]; sol[53] -= b2b.y * sol[11]; sol[54] -= b2b.z * sol[11]; sol[55] -= b2b.w * sol[11]; sol[56] -= b2c.x * sol[11]; sol[57] -= b2c.y * sol[11]; sol[58] -= b2c.z * sol[11]; sol[59] -= b2c.w * sol[11]; sol[60] -= b2d.x * sol[11]; sol[61] -= b2d.y * sol[11]; sol[62] -= b2d.z * sol[11]; sol[63] -= b2d.w * sol[11];
  __builtin_amdgcn_sched_barrier(0);
  b2a = *(const float4*)(Lr + 800); b2b = *(const float4*)(Lr + 804); b2c = *(const float4*)(Lr + 808); b2d = *(const float4*)(Lr + 812);
  __builtin_amdgcn_sched_barrier(0);
  sol[13] -= b0d.y * sol[12]; sol[14] -= b0d.z * sol[12]; sol[15] -= b0d.w * sol[12];
  __builtin_amdgcn_sched_barrier(0);
  b0a = *(const float4*)(Lr + 816); b0b = *(const float4*)(Lr + 820); b0c = *(const float4*)(Lr + 824); b0d = *(const float4*)(Lr + 828);
  __builtin_amdgcn_sched_barrier(0);
  sol[16] -= b1a.x * sol[12]; sol[17] -= b1a.y * sol[12]; sol[18] -= b1a.z * sol[12]; sol[19] -= b1a.w * sol[12]; sol[20] -= b1b.x * sol[12]; sol[21] -= b1b.y * sol[12]; sol[22] -= b1b.z * sol[12]; sol[23] -= b1b.w * sol[12]; sol[24] -= b1c.x * sol[12]; sol[25] -= b1c.y * sol[12]; sol[26] -= b1c.z * sol[12]; sol[27] -= b1c.w * sol[12]; sol[28] -= b1d.x * sol[12]; sol[29] -= b1d.y * sol[12]; sol[30] -= b1d.z * sol[12]; sol[31] -= b1d.w * sol[12];
  __builtin_amdgcn_sched_barrier(0);
  b1a = *(const float4*)(Lr + 832); b1b = *(const float4*)(Lr + 836); b1c = *(const float4*)(Lr + 840); b1d = *(const float4*)(Lr + 844);
  __builtin_amdgcn_sched_barrier(0);
  sol[32] -= b2a.x * sol[12]; sol[33] -= b2a.y * sol[12]; sol[34] -= b2a.z * sol[12]; sol[35] -= b2a.w * sol[12]; sol[36] -= b2b.x * sol[12]; sol[37] -= b2b.y * sol[12]; sol[38] -= b2b.z * sol[12]; sol[39] -= b2b.w * sol[12]; sol[40] -= b2c.x * sol[12]; sol[41] -= b2c.y * sol[12]; sol[42] -= b2c.z * sol[12]; sol[43] -= b2c.w * sol[12]; sol[44] -= b2d.x * sol[12]; sol[45] -= b2d.y * sol[12]; sol[46] -= b2d.z * sol[12]; sol[47] -= b2d.w * sol[12];
  __builtin_amdgcn_sched_barrier(0);
  b2a = *(const float4*)(Lr + 848); b2b = *(const float4*)(Lr + 852); b2c = *(const float4*)(Lr + 856); b2d = *(const float4*)(Lr + 860);
  __builtin_amdgcn_sched_barrier(0);
  sol[48] -= b0a.x * sol[12]; sol[49] -= b0a.y * sol[12]; sol[50] -= b0a.z * sol[12]; sol[51] -= b0a.w * sol[12]; sol[52] -= b0b.x * sol[12]; sol[53] -= b0b.y * sol[12]; sol[54] -= b0b.z * sol[12]; sol[55] -= b0b.w * sol[12]; sol[56] -= b0c.x * sol[12]; sol[57] -= b0c.y * sol[12]; sol[58] -= b0c.z * sol[12]; sol[59] -= b0c.w * sol[12]; sol[60] -= b0d.x * sol[12]; sol[61] -= b0d.y * sol[12]; sol[62] -= b0d.z * sol[12]; sol[63] -= b0d.w * sol[12];
  __builtin_amdgcn_sched_barrier(0);
  b0a = *(const float4*)(Lr + 864); b0b = *(const float4*)(Lr + 868); b0c = *(const float4*)(Lr + 872); b0d = *(const float4*)(Lr + 876);
  __builtin_amdgcn_sched_barrier(0);
  sol[14] -= b1d.z * sol[13]; sol[15] -= b1d.w * sol[13];
  __builtin_amdgcn_sched_barrier(0);
  b1a = *(const float4*)(Lr + 880); b1b = *(const float4*)(Lr + 884); b1c = *(const float4*)(Lr + 888); b1d = *(const float4*)(Lr + 892);
  __builtin_amdgcn_sched_barrier(0);
  sol[16] -= b2a.x * sol[13]; sol[17] -= b2a.y * sol[13]; sol[18] -= b2a.z * sol[13]; sol[19] -= b2a.w * sol[13]; sol[20] -= b2b.x * sol[13]; sol[21] -= b2b.y * sol[13]; sol[22] -= b2b.z * sol[13]; sol[23] -= b2b.w * sol[13]; sol[24] -= b2c.x * sol[13]; sol[25] -= b2c.y * sol[13]; sol[26] -= b2c.z * sol[13]; sol[27] -= b2c.w * sol[13]; sol[28] -= b2d.x * sol[13]; sol[29] -= b2d.y * sol[13]; sol[30] -= b2d.z * sol[13]; sol[31] -= b2d.w * sol[13];
  __builtin_amdgcn_sched_barrier(0);
  b2a = *(const float4*)(Lr + 896); b2b = *(const float4*)(Lr + 900); b2c = *(const float4*)(Lr + 904); b2d = *(const float4*)(Lr + 908);
  __builtin_amdgcn_sched_barrier(0);
  sol[32] -= b0a.x * sol[13]; sol[33] -= b0a.y * sol[13]; sol[34] -= b0a.z * sol[13]; sol[35] -= b0a.w * sol[13]; sol[36] -= b0b.x * sol[13]; sol[37] -= b0b.y * sol[13]; sol[38] -= b0b.z * sol[13]; sol[39] -= b0b.w * sol[13]; sol[40] -= b0c.x * sol[13]; sol[41] -= b0c.y * sol[13]; sol[42] -= b0c.z * sol[13]; sol[43] -= b0c.w * sol[13]; sol[44] -= b0d.x * sol[13]; sol[45] -= b0d.y * sol[13]; sol[46] -= b0d.z * sol[13]; sol[47] -= b0d.w * sol[13];
  __builtin_amdgcn_sched_barrier(0);
  b0a = *(const float4*)(Lr + 912); b0b = *(const float4*)(Lr + 916); b0c = *(const float4*)(Lr + 920); b0d = *(const float4*)(Lr + 924);
  __builtin_amdgcn_sched_barrier(0);
  sol[48] -= b1a.x * sol[13]; sol[49] -= b1a.y * sol[13]; sol[50] -= b1a.z * sol[13]; sol[51] -= b1a.w * sol[13]; sol[52] -= b1b.x * sol[13]; sol[53] -= b1b.y * sol[13]; sol[54] -= b1b.z * sol[13]; sol[55] -= b1b.w * sol[13]; sol[56] -= b1c.x * sol[13]; sol[57] -= b1c.y * sol[13]; sol[58] -= b1c.z * sol[13]; sol[59] -= b1c.w * sol[13]; sol[60] -= b1d.x * sol[13]; sol[61] -= b1d.y * sol[13]; sol[62] -= b1d.z * sol[13]; sol[63] -= b1d.w * sol[13];
  __builtin_amdgcn_sched_barrier(0);
  b1a = *(const float4*)(Lr + 928); b1b = *(const float4*)(Lr + 932); b1c = *(const float4*)(Lr + 936); b1d = *(const float4*)(Lr + 940);
  __builtin_amdgcn_sched_barrier(0);
  sol[15] -= b2d.w * sol[14];
  __builtin_amdgcn_sched_barrier(0);
  b2a = *(const float4*)(Lr + 944); b2b = *(const float4*)(Lr + 948); b2c = *(const float4*)(Lr + 952); b2d = *(const float4*)(Lr + 956);
  __builtin_amdgcn_sched_barrier(0);
  sol[16] -= b0a.x * sol[14]; sol[17] -= b0a.y * sol[14]; sol[18] -= b0a.z * sol[14]; sol[19] -= b0a.w * sol[14]; sol[20] -= b0b.x * sol[14]; sol[21] -= b0b.y * sol[14]; sol[22] -= b0b.z * sol[14]; sol[23] -= b0b.w * sol[14]; sol[24] -= b0c.x * sol[14]; sol[25] -= b0c.y * sol[14]; sol[26] -= b0c.z * sol[14]; sol[27] -= b0c.w * sol[14]; sol[28] -= b0d.x * sol[14]; sol[29] -= b0d.y * sol[14]; sol[30] -= b0d.z * sol[14]; sol[31] -= b0d.w * sol[14];
  __builtin_amdgcn_sched_barrier(0);
  b0a = *(const float4*)(Lr + 976); b0b = *(const float4*)(Lr + 980); b0c = *(const float4*)(Lr + 984); b0d = *(const float4*)(Lr + 988);
  __builtin_amdgcn_sched_barrier(0);
  sol[32] -= b1a.x * sol[14]; sol[33] -= b1a.y * sol[14]; sol[34] -= b1a.z * sol[14]; sol[35] -= b1a.w * sol[14]; sol[36] -= b1b.x * sol[14]; sol[37] -= b1b.y * sol[14]; sol[38] -= b1b.z * sol[14]; sol[39] -= b1b.w * sol[14]; sol[40] -= b1c.x * sol[14]; sol[41] -= b1c.y * sol[14]; sol[42] -= b1c.z * sol[14]; sol[43] -= b1c.w * sol[14]; sol[44] -= b1d.x * sol[14]; sol[45] -= b1d.y * sol[14]; sol[46] -= b1d.z * sol[14]; sol[47] -= b1d.w * sol[14];
  __builtin_amdgcn_sched_barrier(0);
  b1a = *(const float4*)(Lr + 992); b1b = *(const float4*)(Lr + 996); b1c = *(const float4*)(Lr + 1000); b1d = *(const float4*)(Lr + 1004);
  __builtin_amdgcn_sched_barrier(0);
  sol[48] -= b2a.x * sol[14]; sol[49] -= b2a.y * sol[14]; sol[50] -= b2a.z * sol[14]; sol[51] -= b2a.w * sol[14]; sol[52] -= b2b.x * sol[14]; sol[53] -= b2b.y * sol[14]; sol[54] -= b2b.z * sol[14]; sol[55] -= b2b.w * sol[14]; sol[56] -= b2c.x * sol[14]; sol[57] -= b2c.y * sol[14]; sol[58] -= b2c.z * sol[14]; sol[59] -= b2c.w * sol[14]; sol[60] -= b2d.x * sol[14]; sol[61] -= b2d.y * sol[14]; sol[62] -= b2d.z * sol[14]; sol[63] -= b2d.w * sol[14];
  __builtin_amdgcn_sched_barrier(0);
  b2a = *(const float4*)(Lr + 1008); b2b = *(const float4*)(Lr + 1012); b2c = *(const float4*)(Lr + 1016); b2d = *(const float4*)(Lr + 1020);
  __builtin_amdgcn_sched_barrier(0);
  sol[16] -= b0a.x * sol[15]; sol[17] -= b0a.y * sol[15]; sol[18] -= b0a.z * sol[15]; sol[19] -= b0a.w * sol[15]; sol[20] -= b0b.x * sol[15]; sol[21] -= b0b.y * sol[15]; sol[22] -= b0b.z * sol[15]; sol[23] -= b0b.w * sol[15]; sol[24] -= b0c.x * sol[15]; sol[25] -= b0c.y * sol[15]; sol[26] -= b0c.z * sol[15]; sol[27] -= b0c.w * sol[15]; sol[28] -= b0d.x * sol[15]; sol[29] -= b0d.y * sol[15]; sol[30] -= b0d.z * sol[15]; sol[31] -= b0d.w * sol[15];
  __builtin_amdgcn_sched_barrier(0);
  b0a = *(const float4*)(Lr + 1040); b0b = *(const float4*)(Lr + 1044); b0c = *(const float4*)(Lr + 1048); b0d = *(const float4*)(Lr + 1052);
  __builtin_amdgcn_sched_barrier(0);
  sol[32] -= b1a.x * sol[15]; sol[33] -= b1a.y * sol[15]; sol[34] -= b1a.z * sol[15]; sol[35] -= b1a.w * sol[15]; sol[36] -= b1b.x * sol[15]; sol[37] -= b1b.y * sol[15]; sol[38] -= b1b.z * sol[15]; sol[39] -= b1b.w * sol[15]; sol[40] -= b1c.x * sol[15]; sol[41] -= b1c.y * sol[15]; sol[42] -= b1c.z * sol[15]; sol[43] -= b1c.w * sol[15]; sol[44] -= b1d.x * sol[15]; sol[45] -= b1d.y * sol[15]; sol[46] -= b1d.z * sol[15]; sol[47] -= b1d.w * sol[15];
  __builtin_amdgcn_sched_barrier(0);
  b1a = *(const float4*)(Lr + 1056); b1b = *(const float4*)(Lr + 1060); b1c = *(const float4*)(Lr + 1064); b1d = *(const float4*)(Lr + 1068);
  __builtin_amdgcn_sched_barrier(0);
  sol[48] -= b2a.x * sol[15]; sol[49] -= b2a.y * sol[15]; sol[50] -= b2a.z * sol[15]; sol[51] -= b2a.w * sol[15]; sol[52] -= b2b.x * sol[15]; sol[53] -= b2b.y * sol[15]; sol[54] -= b2b.z * sol[15]; sol[55] -= b2b.w * sol[15]; sol[56] -= b2c.x * sol[15]; sol[57] -= b2c.y * sol[15]; sol[58] -= b2c.z * sol[15]; sol[59] -= b2c.w * sol[15]; sol[60] -= b2d.x * sol[15]; sol[61] -= b2d.y * sol[15]; sol[62] -= b2d.z * sol[15]; sol[63] -= b2d.w * sol[15];
  __builtin_amdgcn_sched_barrier(0);
  b2a = *(const float4*)(Lr + 1072); b2b = *(const float4*)(Lr + 1076); b2c = *(const float4*)(Lr + 1080); b2d = *(const float4*)(Lr + 1084);
  __builtin_amdgcn_sched_barrier(0);
  sol[17] -= b0a.y * sol[16]; sol[18] -= b0a.z * sol[16]; sol[19] -= b0a.w * sol[16]; sol[20] -= b0b.x * sol[16]; sol[21] -= b0b.y * sol[16]; sol[22] -= b0b.z * sol[16]; sol[23] -= b0b.w * sol[16]; sol[24] -= b0c.x * sol[16]; sol[25] -= b0c.y * sol[16]; sol[26] -= b0c.z * sol[16]; sol[27] -= b0c.w * sol[16]; sol[28] -= b0d.x * sol[16]; sol[29] -= b0d.y * sol[16]; sol[30] -= b0d.z * sol[16]; sol[31] -= b0d.w * sol[16];
  __builtin_amdgcn_sched_barrier(0);
  b0a = *(const float4*)(Lr + 1104); b0b = *(const float4*)(Lr + 1108); b0c = *(const float4*)(Lr + 1112); b0d = *(const float4*)(Lr + 1116);
  __builtin_amdgcn_sched_barrier(0);
  sol[32] -= b1a.x * sol[16]; sol[33] -= b1a.y * sol[16]; sol[34] -= b1a.z * sol[16]; sol[35] -= b1a.w * sol[16]; sol[36] -= b1b.x * sol[16]; sol[37] -= b1b.y * sol[16]; sol[38] -= b1b.z * sol[16]; sol[39] -= b1b.w * sol[16]; sol[40] -= b1c.x * sol[16]; sol[41] -= b1c.y * sol[16]; sol[42] -= b1c.z * sol[16]; sol[43] -= b1c.w * sol[16]; sol[44] -= b1d.x * sol[16]; sol[45] -= b1d.y * sol[16]; sol[46] -= b1d.z * sol[16]; sol[47] -= b1d.w * sol[16];
  __builtin_amdgcn_sched_barrier(0);
  b1a = *(const float4*)(Lr + 1120); b1b = *(const float4*)(Lr + 1124); b1c = *(const float4*)(Lr + 1128); b1d = *(const float4*)(Lr + 1132);
  __builtin_amdgcn_sched_barrier(0);
  sol[48] -= b2a.x * sol[16]; sol[49] -= b2a.y * sol[16]; sol[50] -= b2a.z * sol[16]; sol[51] -= b2a.w * sol[16]; sol[52] -= b2b.x * sol[16]; sol[53] -= b2b.y * sol[16]; sol[54] -= b2b.z * sol[16]; sol[55] -= b2b.w * sol[16]; sol[56] -= b2c.x * sol[16]; sol[57] -= b2c.y * sol[16]; sol[58] -= b2c.z * sol[16]; sol[59] -= b2c.w * sol[16]; sol[60] -= b2d.x * sol[16]; sol[61] -= b2d.y * sol[16]; sol[62] -= b2d.z * sol[16]; sol[63] -= b2d.w * sol[16];
  __builtin_amdgcn_sched_barrier(0);
  b2a = *(const float4*)(Lr + 1136); b2b = *(const float4*)(Lr + 1140); b2c = *(const float4*)(Lr + 1144); b2d = *(const float4*)(Lr + 1148);
  __builtin_amdgcn_sched_barrier(0);
  sol[18] -= b0a.z * sol[17]; sol[19] -= b0a.w * sol[17]; sol[20] -= b0b.x * sol[17]; sol[21] -= b0b.y * sol[17]; sol[22] -= b0b.z * sol[17]; sol[23] -= b0b.w * sol[17]; sol[24] -= b0c.x * sol[17]; sol[25] -= b0c.y * sol[17]; sol[26] -= b0c.z * sol[17]; sol[27] -= b0c.w * sol[17]; sol[28] -= b0d.x * sol[17]; sol[29] -= b0d.y * sol[17]; sol[30] -= b0d.z * sol[17]; sol[31] -= b0d.w * sol[17];
  __builtin_amdgcn_sched_barrier(0);
  b0a = *(const float4*)(Lr + 1168); b0b = *(const float4*)(Lr + 1172); b0c = *(const float4*)(Lr + 1176); b0d = *(const float4*)(Lr + 1180);
  __builtin_amdgcn_sched_barrier(0);
  sol[32] -= b1a.x * sol[17]; sol[33] -= b1a.y * sol[17]; sol[34] -= b1a.z * sol[17]; sol[35] -= b1a.w * sol[17]; sol[36] -= b1b.x * sol[17]; sol[37] -= b1b.y * sol[17]; sol[38] -= b1b.z * sol[17]; sol[39] -= b1b.w * sol[17]; sol[40] -= b1c.x * sol[17]; sol[41] -= b1c.y * sol[17]; sol[42] -= b1c.z * sol[17]; sol[43] -= b1c.w * sol[17]; sol[44] -= b1d.x * sol[17]; sol[45] -= b1d.y * sol[17]; sol[46] -= b1d.z * sol[17]; sol[47] -= b1d.w * sol[17];
  __builtin_amdgcn_sched_barrier(0);
  b1a = *(const float4*)(Lr + 1184); b1b = *(const float4*)(Lr + 1188); b1c = *(const float4*)(Lr + 1192); b1d = *(const float4*)(Lr + 1196);
  __builtin_amdgcn_sched_barrier(0);
  sol[48] -= b2a.x * sol[17]; sol[49] -= b2a.y * sol[17]; sol[50] -= b2a.z * sol[17]; sol[51] -= b2a.w * sol[17]; sol[52] -= b2b.x * sol[17]; sol[53] -= b2b.y * sol[17]; sol[54] -= b2b.z * sol[17]; sol[55] -= b2b.w * sol[17]; sol[56] -= b2c.x * sol[17]; sol[57] -= b2c.y * sol[17]; sol[58] -= b2c.z * sol[17]; sol[59] -= b2c.w * sol[17]; sol[60] -= b2d.x * sol[17]; sol[61] -= b2d.y * sol[17]; sol[62] -= b2d.z * sol[17]; sol[63] -= b2d.w * sol[17];
  __builtin_amdgcn_sched_barrier(0);
  b2a = *(const float4*)(Lr + 1200); b2b = *(const float4*)(Lr + 1204); b2c = *(const float4*)(Lr + 1208); b2d = *(const float4*)(Lr + 1212);
  __builtin_amdgcn_sched_barrier(0);
  sol[19] -= b0a.w * sol[18]; sol[20] -= b0b.x * sol[18]; sol[21] -= b0b.y * sol[18]; sol[22] -= b0b.z * sol[18]; sol[23] -= b0b.w * sol[18]; sol[24] -= b0c.x * sol[18]; sol[25] -= b0c.y * sol[18]; sol[26] -= b0c.z * sol[18]; sol[27] -= b0c.w * sol[18]; sol[28] -= b0d.x * sol[18]; sol[29] -= b0d.y * sol[18]; sol[30] -= b0d.z * sol[18]; sol[31] -= b0d.w * sol[18];
  __builtin_amdgcn_sched_barrier(0);
  b0a = *(const float4*)(Lr + 1232); b0b = *(const float4*)(Lr + 1236); b0c = *(const float4*)(Lr + 1240); b0d = *(const float4*)(Lr + 1244);
  __builtin_amdgcn_sched_barrier(0);
  sol[32] -= b1a.x * sol[18]; sol[33] -= b1a.y * sol[18]; sol[34] -= b1a.z * sol[18]; sol[35] -= b1a.w * sol[18]; sol[36] -= b1b.x * sol[18]; sol[37] -= b1b.y * sol[18]; sol[38] -= b1b.z * sol[18]; sol[39] -= b1b.w * sol[18]; sol[40] -= b1c.x * sol[18]; sol[41] -= b1c.y * sol[18]; sol[42] -= b1c.z * sol[18]; sol[43] -= b1c.w * sol[18]; sol[44] -= b1d.x * sol[18]; sol[45] -= b1d.y * sol[18]; sol[46] -= b1d.z * sol[18]; sol[47] -= b1d.w * sol[18];
  __builtin_amdgcn_sched_barrier(0);
  b1a = *(const float4*)(Lr + 1248); b1b = *(const float4*)(Lr + 1252); b1c = *(const float4*)(Lr + 1256); b1d = *(const float4*)(Lr + 1260);
  __builtin_amdgcn_sched_barrier(0);
  sol[48] -= b2a.x * sol[18]; sol[49] -= b2a.y * sol[18]; sol[50] -= b2a.z * sol[18]; sol[51] -= b2a.w * sol[18]; sol[52] -= b2b.x * sol[18]; sol[53] -= b2b.y * sol[18]; sol[54] -= b2b.z * sol[18]; sol[55] -= b2b.w * sol[18]; sol[56] -= b2c.x * sol[18]; sol[57] -= b2c.y * sol[18]; sol[58] -= b2c.z * sol[18]; sol[59] -= b2c.w * sol[18]; sol[60] -= b2d.x * sol[18]; sol[61] -= b2d.y * sol[18]; sol[62] -= b2d.z * sol[18]; sol[63] -= b2d.w * sol[18];
  __builtin_amdgcn_sched_barrier(0);
  b2a = *(const float4*)(Lr + 1264); b2b = *(const float4*)(Lr + 1268); b2c = *(const float4*)(Lr + 1272); b2d = *(const float4*)(Lr + 1276);
  __builtin_amdgcn_sched_barrier(0);
  sol[20] -= b0b.x * sol[19]; sol[21] -= b0b.y * sol[19]; sol[22] -= b0b.z * sol[19]; sol[23] -= b0b.w * sol[19]; sol[24] -= b0c.x * sol[19]; sol[25] -= b0c.y * sol[19]; sol[26] -= b0c.z * sol[19]; sol[27] -= b0c.w * sol[19]; sol[28] -= b0d.x * sol[19]; sol[29] -= b0d.y * sol[19]; sol[30] -= b0d.z * sol[19]; sol[31] -= b0d.w * sol[19];
  __builtin_amdgcn_sched_barrier(0);
  b0a = *(const float4*)(Lr + 1296); b0b = *(const float4*)(Lr + 1300); b0c = *(const float4*)(Lr + 1304); b0d = *(const float4*)(Lr + 1308);
  __builtin_amdgcn_sched_barrier(0);
  sol[32] -= b1a.x * sol[19]; sol[33] -= b1a.y * sol[19]; sol[34] -= b1a.z * sol[19]; sol[35] -= b1a.w * sol[19]; sol[36] -= b1b.x * sol[19]; sol[37] -= b1b.y * sol[19]; sol[38] -= b1b.z * sol[19]; sol[39] -= b1b.w * sol[19]; sol[40] -= b1c.x * sol[19]; sol[41] -= b1c.y * sol[19]; sol[42] -= b1c.z * sol[19]; sol[43] -= b1c.w * sol[19]; sol[44] -= b1d.x * sol[19]; sol[45] -= b1d.y * sol[19]; sol[46] -= b1d.z * sol[19]; sol[47] -= b1d.w * sol[19];
  __builtin_amdgcn_sched_barrier(0);
  b1a = *(const float4*)(Lr + 1312); b1b = *(const float4*)(Lr + 1316); b1c = *(const float4*)(Lr + 1320); b1d = *(const float4*)(Lr + 1324);
  __builtin_amdgcn_sched_barrier(0);
  sol[48] -= b2a.x * sol[19]; sol[49] -= b2a.y * sol[19]; sol[50] -= b2a.z * sol[19]; sol[51] -= b2a.w * sol[19]; sol[52] -= b2b.x * sol[19]; sol[53] -= b2b.y * sol[19]; sol[54] -= b2b.z * sol[19]; sol[55] -= b2b.w * sol[19]; sol[56] -= b2c.x * sol[19]; sol[57] -= b2c.y * sol[19]; sol[58] -= b2c.z * sol[19]; sol[59] -= b2c.w * sol[19]; sol[60] -= b2d.x * sol[19]; sol[61] -= b2d.y * sol[19]; sol[62] -= b2d.z * sol[19]; sol[63] -= b2d.w * sol[19];
  __builtin_amdgcn_sched_barrier(0);
  b2a = *(const float4*)(Lr + 1328); b2b = *(const float4*)(Lr + 1332); b2c = *(const float4*)(Lr + 1336); b2d = *(const float4*)(Lr + 1340);
  __builtin_amdgcn_sched_barrier(0);
  sol[21] -= b0b.y * sol[20]; sol[22] -= b0b.z * sol[20]; sol[23] -= b0b.w * sol[20]; sol[24] -= b0c.x * sol[20]; sol[25] -= b0c.y * sol[20]; sol[26] -= b0c.z * sol[20]; sol[27] -= b0c.w * sol[20]; sol[28] -= b0d.x * sol[20]; sol[29] -= b0d.y * sol[20]; sol[30] -= b0d.z * sol[20]; sol[31] -= b0d.w * sol[20];
  __builtin_amdgcn_sched_barrier(0);
  b0a = *(const float4*)(Lr + 1360); b0b = *(const float4*)(Lr + 1364); b0c = *(const float4*)(Lr + 1368); b0d = *(const float4*)(Lr + 1372);
  __builtin_amdgcn_sched_barrier(0);
  sol[32] -= b1a.x * sol[20]; sol[33] -= b1a.y * sol[20]; sol[34] -= b1a.z * sol[20]; sol[35] -= b1a.w * sol[20]; sol[36] -= b1b.x * sol[20]; sol[37] -= b1b.y * sol[20]; sol[38] -= b1b.z * sol[20]; sol[39] -= b1b.w * sol[20]; sol[40] -= b1c.x * sol[20]; sol[41] -= b1c.y * sol[20]; sol[42] -= b1c.z * sol[20]; sol[43] -= b1c.w * sol[20]; sol[44] -= b1d.x * sol[20]; sol[45] -= b1d.y * sol[20]; sol[46] -= b1d.z * sol[20]; sol[47] -= b1d.w * sol[20];
  __builtin_amdgcn_sched_barrier(0);
  b1a = *(const float4*)(Lr + 1376); b1b = *(const float4*)(Lr + 1380); b1c = *(const float4*)(Lr + 1384); b1d = *(const float4*)(Lr + 1388);
  __builtin_amdgcn_sched_barrier(0);
  sol[48] -= b2a.x * sol[20]; sol[49] -= b2a.y * sol[20]; sol[50] -= b2a.z * sol[20]; sol[51] -= b2a.w * sol[20]; sol[52] -= b2b.x * sol[20]; sol[53] -= b2b.y * sol[20]; sol[54] -= b2b.z * sol[20]; sol[55] -= b2b.w * sol[20]; sol[56] -= b2c.x * sol[20]; sol[57] -= b2c.y * sol[20]; sol[58] -= b2c.z * sol[20]; sol[59] -= b2c.w * sol[20]; sol[60] -= b2d.x * sol[20]; sol[61] -= b2d.y * sol[20]; sol[62] -= b2d.z * sol[20]; sol[63] -= b2d.w * sol[20];
  __builtin_amdgcn_sched_barrier(0);
  b2a = *(const float4*)(Lr + 1392); b2b = *(const float4*)(Lr + 1396); b2c = *(const float4*)(Lr + 1400); b2d = *(const float4*)(Lr + 1404);
  __builtin_amdgcn_sched_barrier(0);
  sol[22] -= b0b.z * sol[21]; sol[23] -= b0b.w * sol[21]; sol[24] -= b0c.x * sol[21]; sol[25] -= b0c.y * sol[21]; sol[26] -= b0c.z * sol[21]; sol[27] -= b0c.w * sol[21]; sol[28] -= b0d.x * sol[21]; sol[29] -= b0d.y * sol[21]; sol[30] -= b0d.z * sol[21]; sol[31] -= b0d.w * sol[21];
  __builtin_amdgcn_sched_barrier(0);
  b0a = *(const float4*)(Lr + 1424); b0b = *(const float4*)(Lr + 1428); b0c = *(const float4*)(Lr + 1432); b0d = *(const float4*)(Lr + 1436);
  __builtin_amdgcn_sched_barrier(0);
  sol[32] -= b1a.x * sol[21]; sol[33] -= b1a.y * sol[21]; sol[34] -= b1a.z * sol[21]; sol[35] -= b1a.w * sol[21]; sol[36] -= b1b.x * sol[21]; sol[37] -= b1b.y * sol[21]; sol[38] -= b1b.z * sol[21]; sol[39] -= b1b.w * sol[21]; sol[40] -= b1c.x * sol[21]; sol[41] -= b1c.y * sol[21]; sol[42] -= b1c.z * sol[21]; sol[43] -= b1c.w * sol[21]; sol[44] -= b1d.x * sol[21]; sol[45] -= b1d.y * sol[21]; sol[46] -= b1d.z * sol[21]; sol[47] -= b1d.w * sol[21];
  __builtin_amdgcn_sched_barrier(0);
  b1a = *(const float4*)(Lr + 1440); b1b = *(const float4*)(Lr + 1444); b1c = *(const float4*)(Lr + 1448); b1d = *(const float4*)(Lr + 1452);
  __builtin_amdgcn_sched_barrier(0);
  sol[48] -= b2a.x * sol[21]; sol[49] -= b2a.y * sol[21]; sol[50] -= b2a.z * sol[21]; sol[51] -= b2a.w * sol[21]; sol[52] -= b2b.x * sol[21]; sol[53] -= b2b.y * sol[21]; sol[54] -= b2b.z * sol[21]; sol[55] -= b2b.w * sol[21]; sol[56] -= b2c.x * sol[21]; sol[57] -= b2c.y * sol[21]; sol[58] -= b2c.z * sol[21]; sol[59] -= b2c.w * sol[21]; sol[60] -= b2d.x * sol[21]; sol[61] -= b2d.y * sol[21]; sol[62] -= b2d.z * sol[21]; sol[63] -= b2d.w * sol[21];
  __builtin_amdgcn_sched_barrier(0);
  b2a = *(const float4*)(Lr + 1456); b2b = *(const float4*)(Lr + 1460); b2c = *(const float4*)(Lr + 1464); b2d = *(const float4*)(Lr + 1468);
  __builtin_amdgcn_sched_barrier(0);
  sol[23] -= b0b.w * sol[22]; sol[24] -= b0c.x * sol[22]; sol[25] -= b0c.y * sol[22]; sol[26] -= b0c.z * sol[22]; sol[27] -= b0c.w * sol[22]; sol[28] -= b0d.x * sol[22]; sol[29] -= b0d.y * sol[22]; sol[30] -= b0d.z * sol[22]; sol[31] -= b0d.w * sol[22];
  __builtin_amdgcn_sched_barrier(0);
  b0a = *(const float4*)(Lr + 1488); b0b = *(const float4*)(Lr + 1492); b0c = *(const float4*)(Lr + 1496); b0d = *(const float4*)(Lr + 1500);
  __builtin_amdgcn_sched_barrier(0);
  sol[32] -= b1a.x * sol[22]; sol[33] -= b1a.y * sol[22]; sol[34] -= b1a.z * sol[22]; sol[35] -= b1a.w * sol[22]; sol[36] -= b1b.x * sol[22]; sol[37] -= b1b.y * sol[22]; sol[38] -= b1b.z * sol[22]; sol[39] -= b1b.w * sol[22]; sol[40] -= b1c.x * sol[22]; sol[41] -= b1c.y * sol[22]; sol[42] -= b1c.z * sol[22]; sol[43] -= b1c.w * sol[22]; sol[44] -= b1d.x * sol[22]; sol[45] -= b1d.y * sol[22]; sol[46] -= b1d.z * sol[22]; sol[47] -= b1d.w * sol[22];
  __builtin_amdgcn_sched_barrier(0);
  b1a = *(const float4*)(Lr + 1504); b1b = *(const float4*)(Lr + 1508); b1c = *(const float4*)(Lr + 1512); b1d = *(const float4*)(Lr + 1516);
  __builtin_amdgcn_sched_barrier(0);
  sol[48] -= b2a.x * sol[22]; sol[49] -= b2a.y * sol[22]; sol[50] -= b2a.z * sol[22]; sol[51] -= b2a.w * sol[22]; sol[52] -= b2b.x * sol[22]; sol[53] -= b2b.y * sol[22]; sol[54] -= b2b.z * sol[22]; sol[55] -= b2b.w * sol[22]; sol[56] -= b2c.x * sol[22]; sol[57] -= b2c.y * sol[22]; sol[58] -= b2c.z * sol[22]; sol[59] -= b2c.w * sol[22]; sol[60] -= b2d.x * sol[22]; sol[61] -= b2d.y * sol[22]; sol[62] -= b2d.z * sol[22]; sol[63] -= b2d.w * sol[22];
  __builtin_amdgcn_sched_barrier(0);
  b2a = *(const float4*)(Lr + 1520); b2b = *(const float4*)(Lr + 1524); b2c = *(const float4*)(Lr + 1528); b2d = *(const float4*)(Lr + 1532);
  __builtin_amdgcn_sched_barrier(0);
  sol[24] -= b0c.x * sol[23]; sol[25] -= b0c.y * sol[23]; sol[26] -= b0c.z * sol[23]; sol[27] -= b0c.w * sol[23]; sol[28] -= b0d.x * sol[23]; sol[29] -= b0d.y * sol[23]; sol[30] -= b0d.z * sol[23]; sol[31] -= b0d.w * sol[23];
  __builtin_amdgcn_sched_barrier(0);
  b0a = *(const float4*)(Lr + 1552); b0b = *(const float4*)(Lr + 1556); b0c = *(const float4*)(Lr + 1560); b0d = *(const float4*)(Lr + 1564);
  __builtin_amdgcn_sched_barrier(0);
  sol[32] -= b1a.x * sol[23]; sol[33] -= b1a.y * sol[23]; sol[34] -= b1a.z * sol[23]; sol[35] -= b1a.w * sol[23]; sol[36] -= b1b.x * sol[23]; sol[37] -= b1b.y * sol[23]; sol[38] -= b1b.z * sol[23]; sol[39] -= b1b.w * sol[23]; sol[40] -= b1c.x * sol[23]; sol[41] -= b1c.y * sol[23]; sol[42] -= b1c.z * sol[23]; sol[43] -= b1c.w * sol[23]; sol[44] -= b1d.x * sol[23]; sol[45] -= b1d.y * sol[23]; sol[46] -= b1d.z * sol[23]; sol[47] -= b1d.w * sol[23];
  __builtin_amdgcn_sched_barrier(0);
  b1a = *(const float4*)(Lr + 1568); b1b = *(const float4*)(Lr + 1572); b1c = *(const float4*)(Lr + 1576); b1d = *(const float4*)(Lr + 1580);
  __builtin_amdgcn_sched_barrier(0);
  sol[48] -= b2a.x * sol[23]; sol[49] -= b2a.y * sol[23]; sol[50] -= b2a.z * sol[23]; sol[51] -= b2a.w * sol[23]; sol[52] -= b2b.x * sol[23]; sol[53] -= b2b.y * sol[23]; sol[54] -= b2b.z * sol[23]; sol[55] -= b2b.w * sol[23]; sol[56] -= b2c.x * sol[23]; sol[57] -= b2c.y * sol[23]; sol[58] -= b2c.z * sol[23]; sol[59] -= b2c.w * sol[23]; sol[60] -= b2d.x * sol[23]; sol[61] -= b2d.y * sol[23]; sol[62] -= b2d.z * sol[23]; sol[63] -= b2d.w * sol[23];
  __builtin_amdgcn_sched_barrier(0);
  b2a = *(const float4*)(Lr + 1584); b2b = *(const float4*)(Lr + 1588); b2c = *(const float4*)(Lr + 1592); b2d = *(const float4*)(Lr + 1596);
  __builtin_amdgcn_sched_barrier(0);
  sol[25] -= b0c.y * sol[24]; sol[26] -= b0c.z * sol[24]; sol[27] -= b0c.w * sol[24]; sol[28] -= b0d.x * sol[24]; sol[29] -= b0d.y * sol[24]; sol[30] -= b0d.z * sol[24]; sol[31] -= b0d.w * sol[24];
  __builtin_amdgcn_sched_barrier(0);
  b0a = *(const float4*)(Lr + 1616); b0b = *(const float4*)(Lr + 1620); b0c = *(const float4*)(Lr + 1624); b0d = *(const float4*)(Lr + 1628);
  __builtin_amdgcn_sched_barrier(0);
  sol[32] -= b1a.x * sol[24]; sol[33] -= b1a.y * sol[24]; sol[34] -= b1a.z * sol[24]; sol[35] -= b1a.w * sol[24]; sol[36] -= b1b.x * sol[24]; sol[37] -= b1b.y * sol[24]; sol[38] -= b1b.z * sol[24]; sol[39] -= b1b.w * sol[24]; sol[40] -= b1c.x * sol[24]; sol[41] -= b1c.y * sol[24]; sol[42] -= b1c.z * sol[24]; sol[43] -= b1c.w * sol[24]; sol[44] -= b1d.x * sol[24]; sol[45] -= b1d.y * sol[24]; sol[46] -= b1d.z * sol[24]; sol[47] -= b1d.w * sol[24];
  __builtin_amdgcn_sched_barrier(0);
  b1a = *(const float4*)(Lr + 1632); b1b = *(const float4*)(Lr + 1636); b1c = *(const float4*)(Lr + 1640); b1d = *(const float4*)(Lr + 1644);
  __builtin_amdgcn_sched_barrier(0);
  sol[48] -= b2a.x * sol[24]; sol[49] -= b2a.y * sol[24]; sol[50] -= b2a.z * sol[24]; sol[51] -= b2a.w * sol[24]; sol[52] -= b2b.x * sol[24]; sol[53] -= b2b.y * sol[24]; sol[54] -= b2b.z * sol[24]; sol[55] -= b2b.w * sol[24]; sol[56] -= b2c.x * sol[24]; sol[57] -= b2c.y * sol[24]; sol[58] -= b2c.z * sol[24]; sol[59] -= b2c.w * sol[24]; sol[60] -= b2d.x * sol[24]; sol[61] -= b2d.y * sol[24]; sol[62] -= b2d.z * sol[24]; sol[63] -= b2d.w * sol[24];
  __builtin_amdgcn_sched_barrier(0);
  b2a = *(const float4*)(Lr + 1648); b2b = *(const float4*)(Lr + 1652); b2c = *(const float4*)(Lr + 1656); b2d = *(const float4*)(Lr + 1660);
  __builtin_amdgcn_sched_barrier(0);
  sol[26] -= b0c.z * sol[25]; sol[27] -= b0c.w * sol[25]; sol[28] -= b0d.x * sol[25]; sol[29] -= b0d.y * sol[25]; sol[30] -= b0d.z * sol[25]; sol[31] -= b0d.w * sol[25];
  __builtin_amdgcn_sched_barrier(0);
  b0a = *(const float4*)(Lr + 1680); b0b = *(const float4*)(Lr + 1684); b0c = *(const float4*)(Lr + 1688); b0d = *(const float4*)(Lr + 1692);
  __builtin_amdgcn_sched_barrier(0);
  sol[32] -= b1a.x * sol[25]; sol[33] -= b1a.y * sol[25]; sol[34] -= b1a.z * sol[25]; sol[35] -= b1a.w * sol[25]; sol[36] -= b1b.x * sol[25]; sol[37] -= b1b.y * sol[25]; sol[38] -= b1b.z * sol[25]; sol[39] -= b1b.w * sol[25]; sol[40] -= b1c.x * sol[25]; sol[41] -= b1c.y * sol[25]; sol[42] -= b1c.z * sol[25]; sol[43] -= b1c.w * sol[25]; sol[44] -= b1d.x * sol[25]; sol[45] -= b1d.y * sol[25]; sol[46] -= b1d.z * sol[25]; sol[47] -= b1d.w * sol[25];
  __builtin_amdgcn_sched_barrier(0);
  b1a = *(const float4*)(Lr + 1696); b1b = *(const float4*)(Lr + 1700); b1c = *(const float4*)(Lr + 1704); b1d = *(const float4*)(Lr + 1708);
  __builtin_amdgcn_sched_barrier(0);
  sol[48] -= b2a.x * sol[25]; sol[49] -= b2a.y * sol[25]; sol[50] -= b2a.z * sol[25]; sol[51] -= b2a.w * sol[25]; sol[52] -= b2b.x * sol[25]; sol[53] -= b2b.y * sol[25]; sol[54] -= b2b.z * sol[25]; sol[55] -= b2b.w * sol[25]; sol[56] -= b2c.x * sol[25]; sol[57] -= b2c.y * sol[25]; sol[58] -= b2c.z * sol[25]; sol[59] -= b2c.w * sol[25]; sol[60] -= b2d.x * sol[25]; sol[61] -= b2d.y * sol[25]; sol[62] -= b2d.z * sol[25]; sol[63] -= b2d.w * sol[25];
  __builtin_amdgcn_sched_barrier(0);
  b2a = *(const float4*)(Lr + 1712); b2b = *(const float4*)(Lr + 1716); b2c = *(const float4*)(Lr + 1720); b2d = *(const float4*)(Lr + 1724);
  __builtin_amdgcn_sched_barrier(0);
  sol[27] -= b0c.w * sol[26]; sol[28] -= b0d.x * sol[26]; sol[29] -= b0d.y * sol[26]; sol[30] -= b0d.z * sol[26]; sol[31] -= b0d.w * sol[26];
  __builtin_amdgcn_sched_barrier(0);
  b0a = *(const float4*)(Lr + 1744); b0b = *(const float4*)(Lr + 1748); b0c = *(const float4*)(Lr + 1752); b0d = *(const float4*)(Lr + 1756);
  __builtin_amdgcn_sched_barrier(0);
  sol[32] -= b1a.x * sol[26]; sol[33] -= b1a.y * sol[26]; sol[34] -= b1a.z * sol[26]; sol[35] -= b1a.w * sol[26]; sol[36] -= b1b.x * sol[26]; sol[37] -= b1b.y * sol[26]; sol[38] -= b1b.z * sol[26]; sol[39] -= b1b.w * sol[26]; sol[40] -= b1c.x * sol[26]; sol[41] -= b1c.y * sol[26]; sol[42] -= b1c.z * sol[26]; sol[43] -= b1c.w * sol[26]; sol[44] -= b1d.x * sol[26]; sol[45] -= b1d.y * sol[26]; sol[46] -= b1d.z * sol[26]; sol[47] -= b1d.w * sol[26];
  __builtin_amdgcn_sched_barrier(0);
  b1a = *(const float4*)(Lr + 1760); b1b = *(const float4*)(Lr + 1764); b1c = *(const float4*)(Lr + 1768); b1d = *(const float4*)(Lr + 1772);
  __builtin_amdgcn_sched_barrier(0);
  sol[48] -= b2a.x * sol[26]; sol[49] -= b2a.y * sol[26]; sol[50] -= b2a.z * sol[26]; sol[51] -= b2a.w * sol[26]; sol[52] -= b2b.x * sol[26]; sol[53] -= b2b.y * sol[26]; sol[54] -= b2b.z * sol[26]; sol[55] -= b2b.w * sol[26]; sol[56] -= b2c.x * sol[26]; sol[57] -= b2c.y * sol[26]; sol[58] -= b2c.z * sol[26]; sol[59] -= b2c.w * sol[26]; sol[60] -= b2d.x * sol[26]; sol[61] -= b2d.y * sol[26]; sol[62] -= b2d.z * sol[26]; sol[63] -= b2d.w * sol[26];
  __builtin_amdgcn_sched_barrier(0);
  b2a = *(const float4*)(Lr + 1776); b2b = *(const float4*)(Lr + 1780); b2c = *(const float4*)(Lr + 1784); b2d = *(const float4*)(Lr + 1788);
  __builtin_amdgcn_sched_barrier(0);
  sol[28] -= b0d.x * sol[27]; sol[29] -= b0d.y * sol[27]; sol[30] -= b0d.z * sol[27]; sol[31] -= b0d.w * sol[27];
  __builtin_amdgcn_sched_barrier(0);
  b0a = *(const float4*)(Lr + 1808); b0b = *(const float4*)(Lr + 1812); b0c = *(const float4*)(Lr + 1816); b0d = *(const float4*)(Lr + 1820);
  __builtin_amdgcn_sched_barrier(0);
  sol[32] -= b1a.x * sol[27]; sol[33] -= b1a.y * sol[27]; sol[34] -= b1a.z * sol[27]; sol[35] -= b1a.w * sol[27]; sol[36] -= b1b.x * sol[27]; sol[37] -= b1b.y * sol[27]; sol[38] -= b1b.z * sol[27]; sol[39] -= b1b.w * sol[27]; sol[40] -= b1c.x * sol[27]; sol[41] -= b1c.y * sol[27]; sol[42] -= b1c.z * sol[27]; sol[43] -= b1c.w * sol[27]; sol[44] -= b1d.x * sol[27]; sol[45] -= b1d.y * sol[27]; sol[46] -= b1d.z * sol[27]; sol[47] -= b1d.w * sol[27];
  __builtin_amdgcn_sched_barrier(0);
  b1a = *(const float4*)(Lr + 1824); b1b = *(const float4*)(Lr + 1828); b1c = *(const float4*)(Lr + 1832); b1d = *(const float4*)(Lr + 1836);
  __builtin_amdgcn_sched_barrier(0);
  sol[48] -= b2a.x * sol[27]; sol[49] -= b2a.y * sol[27]; sol[50] -= b2a.z * sol[27]; sol[51] -= b2a.w * sol[27]; sol[52] -= b2b.x * sol[27]; sol[53] -= b2b.y * sol[27]; sol[54] -= b2b.z * sol[27]; sol[55] -= b2b.w * sol[27]; sol[56] -= b2c.x * sol[27]; sol[57] -= b2c.y * sol[27]; sol[58] -= b2c.z * sol[27]; sol[59] -= b2c.w * sol[27]; sol[60] -= b2d.x * sol[27]; sol[61] -= b2d.y * sol[27]; sol[62] -= b2d.z * sol[27]; sol[63] -= b2d.w * sol[27];
  __builtin_amdgcn_sched_barrier(0);
  b2a = *(const float4*)(Lr + 1840); b2b = *(const float4*)(Lr + 1844); b2c = *(const float4*)(Lr + 1848); b2d = *(const float4*)(Lr + 1852);
  __builtin_amdgcn_sched_barrier(0);
  sol[29] -= b0d.y * sol[28]; sol[30] -= b0d.z * sol[28]; sol[31] -= b0d.w * sol[28];
  __builtin_amdgcn_sched_barrier(0);
  b0a = *(const float4*)(Lr + 1872); b0b = *(const float4*)(Lr + 1876); b0c = *(const float4*)(Lr + 1880); b0d = *(const float4*)(Lr + 1884);
  __builtin_amdgcn_sched_barrier(0);
  sol[32] -= b1a.x * sol[28]; sol[33] -= b1a.y * sol[28]; sol[34] -= b1a.z * sol[28]; sol[35] -= b1a.w * sol[28]; sol[36] -= b1b.x * sol[28]; sol[37] -= b1b.y * sol[28]; sol[38] -= b1b.z * sol[28]; sol[39] -= b1b.w * sol[28]; sol[40] -= b1c.x * sol[28]; sol[41] -= b1c.y * sol[28]; sol[42] -= b1c.z * sol[28]; sol[43] -= b1c.w * sol[28]; sol[44] -= b1d.x * sol[28]; sol[45] -= b1d.y * sol[28]; sol[46] -= b1d.z * sol[28]; sol[47] -= b1d.w * sol[28];
  __builtin_amdgcn_sched_barrier(0);
  b1a = *(const float4*)(Lr + 1888); b1b = *(const float4*)(Lr + 1892); b1c = *(const float4*)(Lr + 1896); b1d = *(const float4*)(Lr + 1900);
  __builtin_amdgcn_sched_barrier(0);
  sol[48] -= b2a.x * sol[28]; sol[49] -= b2a.y * sol[28]; sol[50] -= b2a.z * sol[28]; sol[51] -= b2a.w * sol[28]; sol[52] -= b2b.x * sol[28]; sol[53] -= b2b.y * sol[28]; sol[54] -= b2b.z * sol[28]; sol[55] -= b2b.w * sol[28]; sol[56] -= b2c.x * sol[28]; sol[57] -= b2c.y * sol[28]; sol[58] -= b2c.z * sol[28]; sol[59] -= b2c.w * sol[28]; sol[60] -= b2d.x * sol[28]; sol[61] -= b2d.y * sol[28]; sol[62] -= b2d.z * sol[28]; sol[63] -= b2d.w * sol[28];
  __builtin_amdgcn_sched_barrier(0);
  b2a = *(const float4*)(Lr + 1904); b2b = *(const float4*)(Lr + 1908); b2c = *(const float4*)(Lr + 1912); b2d = *(const float4*)(Lr + 1916);
  __builtin_amdgcn_sched_barrier(0);
  sol[30] -= b0d.z * sol[29]; sol[31] -= b0d.w * sol[29];
  __builtin_amdgcn_sched_barrier(0);
  b0a = *(const float4*)(Lr + 1936); b0b = *(const float4*)(Lr + 1940); b0c = *(const float4*)(Lr + 1944); b0d = *(const float4*)(Lr + 1948);
  __builtin_amdgcn_sched_barrier(0);
  sol[32] -= b1a.x * sol[29]; sol[33] -= b1a.y * sol[29]; sol[34] -= b1a.z * sol[29]; sol[35] -= b1a.w * sol[29]; sol[36] -= b1b.x * sol[29]; sol[37] -= b1b.y * sol[29]; sol[38] -= b1b.z * sol[29]; sol[39] -= b1b.w * sol[29]; sol[40] -= b1c.x * sol[29]; sol[41] -= b1c.y * sol[29]; sol[42] -= b1c.z * sol[29]; sol[43] -= b1c.w * sol[29]; sol[44] -= b1d.x * sol[29]; sol[45] -= b1d.y * sol[29]; sol[46] -= b1d.z * sol[29]; sol[47] -= b1d.w * sol[29];
  __builtin_amdgcn_sched_barrier(0);
  b1a = *(const float4*)(Lr + 1952); b1b = *(const float4*)(Lr + 1956); b1c = *(const float4*)(Lr + 1960); b1d = *(const float4*)(Lr + 1964);
  __builtin_amdgcn_sched_barrier(0);
  sol[48] -= b2a.x * sol[29]; sol[49] -= b2a.y * sol[29]; sol[50] -= b2a.z * sol[29]; sol[51] -= b2a.w * sol[29]; sol[52] -= b2b.x * sol[29]; sol[53] -= b2b.y * sol[29]; sol[54] -= b2b.z * sol[29]; sol[55] -= b2b.w * sol[29]; sol[56] -= b2c.x * sol[29]; sol[57] -= b2c.y * sol[29]; sol[58] -= b2c.z * sol[29]; sol[59] -= b2c.w * sol[29]; sol[60] -= b2d.x * sol[29]; sol[61] -= b2d.y * sol[29]; sol[62] -= b2d.z * sol[29]; sol[63] -= b2d.w * sol[29];
  __builtin_amdgcn_sched_barrier(0);
  b2a = *(const float4*)(Lr + 1968); b2b = *(const float4*)(Lr + 1972); b2c = *(const float4*)(Lr + 1976); b2d = *(const float4*)(Lr + 1980);
  __builtin_amdgcn_sched_barrier(0);
  sol[31] -= b0d.w * sol[30];
  __builtin_amdgcn_sched_barrier(0);
  b0a = *(const float4*)(Lr + 2016); b0b = *(const float4*)(Lr + 2020); b0c = *(const float4*)(Lr + 2024); b0d = *(const float4*)(Lr + 2028);
  __builtin_amdgcn_sched_barrier(0);
  sol[32] -= b1a.x * sol[30]; sol[33] -= b1a.y * sol[30]; sol[34] -= b1a.z * sol[30]; sol[35] -= b1a.w * sol[30]; sol[36] -= b1b.x * sol[30]; sol[37] -= b1b.y * sol[30]; sol[38] -= b1b.z * sol[30]; sol[39] -= b1b.w * sol[30]; sol[40] -= b1c.x * sol[30]; sol[41] -= b1c.y * sol[30]; sol[42] -= b1c.z * sol[30]; sol[43] -= b1c.w * sol[30]; sol[44] -= b1d.x * sol[30]; sol[45] -= b1d.y * sol[30]; sol[46] -= b1d.z * sol[30]; sol[47] -= b1d.w * sol[30];
  __builtin_amdgcn_sched_barrier(0);
  b1a = *(const float4*)(Lr + 2032); b1b = *(const float4*)(Lr + 2036); b1c = *(const float4*)(Lr + 2040); b1d = *(const float4*)(Lr + 2044);
  __builtin_amdgcn_sched_barrier(0);
  sol[48] -= b2a.x * sol[30]; sol[49] -= b2a.y * sol[30]; sol[50] -= b2a.z * sol[30]; sol[51] -= b2a.w * sol[30]; sol[52] -= b2b.x * sol[30]; sol[53] -= b2b.y * sol[30]; sol[54] -= b2b.z * sol[30]; sol[55] -= b2b.w * sol[30]; sol[56] -= b2c.x * sol[30]; sol[57] -= b2c.y * sol[30]; sol[58] -= b2c.z * sol[30]; sol[59] -= b2c.w * sol[30]; sol[60] -= b2d.x * sol[30]; sol[61] -= b2d.y * sol[30]; sol[62] -= b2d.z * sol[30]; sol[63] -= b2d.w * sol[30];
  __builtin_amdgcn_sched_barrier(0);
  b2a = *(const float4*)(Lr + 2080); b2b = *(const float4*)(Lr + 2084); b2c = *(const float4*)(Lr + 2088); b2d = *(const float4*)(Lr + 2092);
  __builtin_amdgcn_sched_barrier(0);
  sol[32] -= b0a.x * sol[31]; sol[33] -= b0a.y * sol[31]; sol[34] -= b0a.z * sol[31]; sol[35] -= b0a.w * sol[31]; sol[36] -= b0b.x * sol[31]; sol[37] -= b0b.y * sol[31]; sol[38] -= b0b.z * sol[31]; sol[39] -= b0b.w * sol[31]; sol[40] -= b0c.x * sol[31]; sol[41] -= b0c.y * sol[31]; sol[42] -= b0c.z * sol[31]; sol[43] -= b0c.w * sol[31]; sol[44] -= b0d.x * sol[31]; sol[45] -= b0d.y * sol[31]; sol[46] -= b0d.z * sol[31]; sol[47] -= b0d.w * sol[31];
  __builtin_amdgcn_sched_barrier(0);
  b0a = *(const float4*)(Lr + 2096); b0b = *(const float4*)(Lr + 2100); b0c = *(const float4*)(Lr + 2104); b0d = *(const float4*)(Lr + 2108);
  __builtin_amdgcn_sched_barrier(0);
  sol[48] -= b1a.x * sol[31]; sol[49] -= b1a.y * sol[31]; sol[50] -= b1a.z * sol[31]; sol[51] -= b1a.w * sol[31]; sol[52] -= b1b.x * sol[31]; sol[53] -= b1b.y * sol[31]; sol[54] -= b1b.z * sol[31]; sol[55] -= b1b.w * sol[31]; sol[56] -= b1c.x * sol[31]; sol[57] -= b1c.y * sol[31]; sol[58] -= b1c.z * sol[31]; sol[59] -= b1c.w * sol[31]; sol[60] -= b1d.x * sol[31]; sol[61] -= b1d.y * sol[31]; sol[62] -= b1d.z * sol[31]; sol[63] -= b1d.w * sol[31];
  __builtin_amdgcn_sched_barrier(0);
  b1a = *(const float4*)(Lr + 2144); b1b = *(const float4*)(Lr + 2148); b1c = *(const float4*)(Lr + 2152); b1d = *(const float4*)(Lr + 2156);
  __builtin_amdgcn_sched_barrier(0);
  sol[33] -= b2a.y * sol[32]; sol[34] -= b2a.z * sol[32]; sol[35] -= b2a.w * sol[32]; sol[36] -= b2b.x * sol[32]; sol[37] -= b2b.y * sol[32]; sol[38] -= b2b.z * sol[32]; sol[39] -= b2b.w * sol[32]; sol[40] -= b2c.x * sol[32]; sol[41] -= b2c.y * sol[32]; sol[42] -= b2c.z * sol[32]; sol[43] -= b2c.w * sol[32]; sol[44] -= b2d.x * sol[32]; sol[45] -= b2d.y * sol[32]; sol[46] -= b2d.z * sol[32]; sol[47] -= b2d.w * sol[32];
  __builtin_amdgcn_sched_barrier(0);
  b2a = *(const float4*)(Lr + 2160); b2b = *(const float4*)(Lr + 2164); b2c = *(const float4*)(Lr + 2168); b2d = *(const float4*)(Lr + 2172);
  __builtin_amdgcn_sched_barrier(0);
  sol[48] -= b0a.x * sol[32]; sol[49] -= b0a.y * sol[32]; sol[50] -= b0a.z * sol[32]; sol[51] -= b0a.w * sol[32]; sol[52] -= b0b.x * sol[32]; sol[53] -= b0b.y * sol[32]; sol[54] -= b0b.z * sol[32]; sol[55] -= b0b.w * sol[32]; sol[56] -= b0c.x * sol[32]; sol[57] -= b0c.y * sol[32]; sol[58] -= b0c.z * sol[32]; sol[59] -= b0c.w * sol[32]; sol[60] -= b0d.x * sol[32]; sol[61] -= b0d.y * sol[32]; sol[62] -= b0d.z * sol[32]; sol[63] -= b0d.w * sol[32];
  __builtin_amdgcn_sched_barrier(0);
  b0a = *(const float4*)(Lr + 2208); b0b = *(const float4*)(Lr + 2212); b0c = *(const float4*)(Lr + 2216); b0d = *(const float4*)(Lr + 2220);
  __builtin_amdgcn_sched_barrier(0);
  sol[34] -= b1a.z * sol[33]; sol[35] -= b1a.w * sol[33]; sol[36] -= b1b.x * sol[33]; sol[37] -= b1b.y * sol[33]; sol[38] -= b1b.z * sol[33]; sol[39] -= b1b.w * sol[33]; sol[40] -= b1c.x * sol[33]; sol[41] -= b1c.y * sol[33]; sol[42] -= b1c.z * sol[33]; sol[43] -= b1c.w * sol[33]; sol[44] -= b1d.x * sol[33]; sol[45] -= b1d.y * sol[33]; sol[46] -= b1d.z * sol[33]; sol[47] -= b1d.w * sol[33];
  __builtin_amdgcn_sched_barrier(0);
  b1a = *(const float4*)(Lr + 2224); b1b = *(const float4*)(Lr + 2228); b1c = *(const float4*)(Lr + 2232); b1d = *(const float4*)(Lr + 2236);
  __builtin_amdgcn_sched_barrier(0);
  sol[48] -= b2a.x * sol[33]; sol[49] -= b2a.y * sol[33]; sol[50] -= b2a.z * sol[33]; sol[51] -= b2a.w * sol[33]; sol[52] -= b2b.x * sol[33]; sol[53] -= b2b.y * sol[33]; sol[54] -= b2b.z * sol[33]; sol[55] -= b2b.w * sol[33]; sol[56] -= b2c.x * sol[33]; sol[57] -= b2c.y * sol[33]; sol[58] -= b2c.z * sol[33]; sol[59] -= b2c.w * sol[33]; sol[60] -= b2d.x * sol[33]; sol[61] -= b2d.y * sol[33]; sol[62] -= b2d.z * sol[33]; sol[63] -= b2d.w * sol[33];
  __builtin_amdgcn_sched_barrier(0);
  b2a = *(const float4*)(Lr + 2272); b2b = *(const float4*)(Lr + 2276); b2c = *(const float4*)(Lr + 2280); b2d = *(const float4*)(Lr + 2284);
  __builtin_amdgcn_sched_barrier(0);
  sol[35] -= b0a.w * sol[34]; sol[36] -= b0b.x * sol[34]; sol[37] -= b0b.y * sol[34]; sol[38] -= b0b.z * sol[34]; sol[39] -= b0b.w * sol[34]; sol[40] -= b0c.x * sol[34]; sol[41] -= b0c.y * sol[34]; sol[42] -= b0c.z * sol[34]; sol[43] -= b0c.w * sol[34]; sol[44] -= b0d.x * sol[34]; sol[45] -= b0d.y * sol[34]; sol[46] -= b0d.z * sol[34]; sol[47] -= b0d.w * sol[34];
  __builtin_amdgcn_sched_barrier(0);
  b0a = *(const float4*)(Lr + 2288); b0b = *(const float4*)(Lr + 2292); b0c = *(const float4*)(Lr + 2296); b0d = *(const float4*)(Lr + 2300);
  __builtin_amdgcn_sched_barrier(0);
  sol[48] -= b1a.x * sol[34]; sol[49] -= b1a.y * sol[34]; sol[50] -= b1a.z * sol[34]; sol[51] -= b1a.w * sol[34]; sol[52] -= b1b.x * sol[34]; sol[53] -= b1b.y * sol[34]; sol[54] -= b1b.z * sol[34]; sol[55] -= b1b.w * sol[34]; sol[56] -= b1c.x * sol[34]; sol[57] -= b1c.y * sol[34]; sol[58] -= b1c.z * sol[34]; sol[59] -= b1c.w * sol[34]; sol[60] -= b1d.x * sol[34]; sol[61] -= b1d.y * sol[34]; sol[62] -= b1d.z * sol[34]; sol[63] -= b1d.w * sol[34];
  __builtin_amdgcn_sched_barrier(0);
  b1a = *(const float4*)(Lr + 2336); b1b = *(const float4*)(Lr + 2340); b1c = *(const float4*)(Lr + 2344); b1d = *(const float4*)(Lr + 2348);
  __builtin_amdgcn_sched_barrier(0);
  sol[36] -= b2b.x * sol[35]; sol[37] -= b2b.y * sol[35]; sol[38] -= b2b.z * sol[35]; sol[39] -= b2b.w * sol[35]; sol[40] -= b2c.x * sol[35]; sol[41] -= b2c.y * sol[35]; sol[42] -= b2c.z * sol[35]; sol[43] -= b2c.w * sol[35]; sol[44] -= b2d.x * sol[35]; sol[45] -= b2d.y * sol[35]; sol[46] -= b2d.z * sol[35]; sol[47] -= b2d.w * sol[35];
  __builtin_amdgcn_sched_barrier(0);
  b2a = *(const float4*)(Lr + 2352); b2b = *(const float4*)(Lr + 2356); b2c = *(const float4*)(Lr + 2360); b2d = *(const float4*)(Lr + 2364);
  __builtin_amdgcn_sched_barrier(0);
  sol[48] -= b0a.x * sol[35]; sol[49] -= b0a.y * sol[35]; sol[50] -= b0a.z * sol[35]; sol[51] -= b0a.w * sol[35]; sol[52] -= b0b.x * sol[35]; sol[53] -= b0b.y * sol[35]; sol[54] -= b0b.z * sol[35]; sol[55] -= b0b.w * sol[35]; sol[56] -= b0c.x * sol[35]; sol[57] -= b0c.y * sol[35]; sol[58] -= b0c.z * sol[35]; sol[59] -= b0c.w * sol[35]; sol[60] -= b0d.x * sol[35]; sol[61] -= b0d.y * sol[35]; sol[62] -= b0d.z * sol[35]; sol[63] -= b0d.w * sol[35];
  __builtin_amdgcn_sched_barrier(0);
  b0a = *(const float4*)(Lr + 2400); b0b = *(const float4*)(Lr + 2404); b0c = *(const float4*)(Lr + 2408); b0d = *(const float4*)(Lr + 2412);
  __builtin_amdgcn_sched_barrier(0);
  sol[37] -= b1b.y * sol[36]; sol[38] -= b1b.z * sol[36]; sol[39] -= b1b.w * sol[36]; sol[40] -= b1c.x * sol[36]; sol[41] -= b1c.y * sol[36]; sol[42] -= b1c.z * sol[36]; sol[43] -= b1c.w * sol[36]; sol[44] -= b1d.x * sol[36]; sol[45] -= b1d.y * sol[36]; sol[46] -= b1d.z * sol[36]; sol[47] -= b1d.w * sol[36];
  __builtin_amdgcn_sched_barrier(0);
  b1a = *(const float4*)(Lr + 2416); b1b = *(const float4*)(Lr + 2420); b1c = *(const float4*)(Lr + 2424); b1d = *(const float4*)(Lr + 2428);
  __builtin_amdgcn_sched_barrier(0);
  sol[48] -= b2a.x * sol[36]; sol[49] -= b2a.y * sol[36]; sol[50] -= b2a.z * sol[36]; sol[51] -= b2a.w * sol[36]; sol[52] -= b2b.x * sol[36]; sol[53] -= b2b.y * sol[36]; sol[54] -= b2b.z * sol[36]; sol[55] -= b2b.w * sol[36]; sol[56] -= b2c.x * sol[36]; sol[57] -= b2c.y * sol[36]; sol[58] -= b2c.z * sol[36]; sol[59] -= b2c.w * sol[36]; sol[60] -= b2d.x * sol[36]; sol[61] -= b2d.y * sol[36]; sol[62] -= b2d.z * sol[36]; sol[63] -= b2d.w * sol[36];
  __builtin_amdgcn_sched_barrier(0);
  b2a = *(const float4*)(Lr + 2464); b2b = *(const float4*)(Lr + 2468); b2c = *(const float4*)(Lr + 2472); b2d = *(const float4*)(Lr + 2476);
  __builtin_amdgcn_sched_barrier(0);
  sol[38] -= b0b.z * sol[37]; sol[39] -= b0b.w * sol[37]; sol[40] -= b0c.x * sol[37]; sol[41] -= b0c.y * sol[37]; sol[42] -= b0c.z * sol[37]; sol[43] -= b0c.w * sol[37]; sol[44] -= b0d.x * sol[37]; sol[45] -= b0d.y * sol[37]; sol[46] -= b0d.z * sol[37]; sol[47] -= b0d.w * sol[37];
  __builtin_amdgcn_sched_barrier(0);
  b0a = *(const float4*)(Lr + 2480); b0b = *(const float4*)(Lr + 2484); b0c = *(const float4*)(Lr + 2488); b0d = *(const float4*)(Lr + 2492);
  __builtin_amdgcn_sched_barrier(0);
  sol[48] -= b1a.x * sol[37]; sol[49] -= b1a.y * sol[37]; sol[50] -= b1a.z * sol[37]; sol[51] -= b1a.w * sol[37]; sol[52] -= b1b.x * sol[37]; sol[53] -= b1b.y * sol[37]; sol[54] -= b1b.z * sol[37]; sol[55] -= b1b.w * sol[37]; sol[56] -= b1c.x * sol[37]; sol[57] -= b1c.y * sol[37]; sol[58] -= b1c.z * sol[37]; sol[59] -= b1c.w * sol[37]; sol[60] -= b1d.x * sol[37]; sol[61] -= b1d.y * sol[37]; sol[62] -= b1d.z * sol[37]; sol[63] -= b1d.w * sol[37];
  __builtin_amdgcn_sched_barrier(0);
  b1a = *(const float4*)(Lr + 2528); b1b = *(const float4*)(Lr + 2532); b1c = *(const float4*)(Lr + 2536); b1d = *(const float4*)(Lr + 2540);
  __builtin_amdgcn_sched_barrier(0);
  sol[39] -= b2b.w * sol[38]; sol[40] -= b2c.x * sol[38]; sol[41] -= b2c.y * sol[38]; sol[42] -= b2c.z * sol[38]; sol[43] -= b2c.w * sol[38]; sol[44] -= b2d.x * sol[38]; sol[45] -= b2d.y * sol[38]; sol[46] -= b2d.z * sol[38]; sol[47] -= b2d.w * sol[38];
  __builtin_amdgcn_sched_barrier(0);
  b2a = *(const float4*)(Lr + 2544); b2b = *(const float4*)(Lr + 2548); b2c = *(const float4*)(Lr + 2552); b2d = *(const float4*)(Lr + 2556);
  __builtin_amdgcn_sched_barrier(0);
  sol[48] -= b0a.x * sol[38]; sol[49] -= b0a.y * sol[38]; sol[50] -= b0a.z * sol[38]; sol[51] -= b0a.w * sol[38]; sol[52] -= b0b.x * sol[38]; sol[53] -= b0b.y * sol[38]; sol[54] -= b0b.z * sol[38]; sol[55] -= b0b.w * sol[38]; sol[56] -= b0c.x * sol[38]; sol[57] -= b0c.y * sol[38]; sol[58] -= b0c.z * sol[38]; sol[59] -= b0c.w * sol[38]; sol[60] -= b0d.x * sol[38]; sol[61] -= b0d.y * sol[38]; sol[62] -= b0d.z * sol[38]; sol[63] -= b0d.w * sol[38];
  __builtin_amdgcn_sched_barrier(0);
  b0a = *(const float4*)(Lr + 2592); b0b = *(const float4*)(Lr + 2596); b0c = *(const float4*)(Lr + 2600); b0d = *(const float4*)(Lr + 2604);
  __builtin_amdgcn_sched_barrier(0);
  sol[40] -= b1c.x * sol[39]; sol[41] -= b1c.y * sol[39]; sol[42] -= b1c.z * sol[39]; sol[43] -= b1c.w * sol[39]; sol[44] -= b1d.x * sol[39]; sol[45] -= b1d.y * sol[39]; sol[46] -= b1d.z * sol[39]; sol[47] -= b1d.w * sol[39];
  __builtin_amdgcn_sched_barrier(0);
  b1a = *(const float4*)(Lr + 2608); b1b = *(const float4*)(Lr + 2612); b1c = *(const float4*)(Lr + 2616); b1d = *(const float4*)(Lr + 2620);
  __builtin_amdgcn_sched_barrier(0);
  sol[48] -= b2a.x * sol[39]; sol[49] -= b2a.y * sol[39]; sol[50] -= b2a.z * sol[39]; sol[51] -= b2a.w * sol[39]; sol[52] -= b2b.x * sol[39]; sol[53] -= b2b.y * sol[39]; sol[54] -= b2b.z * sol[39]; sol[55] -= b2b.w * sol[39]; sol[56] -= b2c.x * sol[39]; sol[57] -= b2c.y * sol[39]; sol[58] -= b2c.z * sol[39]; sol[59] -= b2c.w * sol[39]; sol[60] -= b2d.x * sol[39]; sol[61] -= b2d.y * sol[39]; sol[62] -= b2d.z * sol[39]; sol[63] -= b2d.w * sol[39];
  __builtin_amdgcn_sched_barrier(0);
  b2a = *(const float4*)(Lr + 2656); b2b = *(const float4*)(Lr + 2660); b2c = *(const float4*)(Lr + 2664); b2d = *(const float4*)(Lr + 2668);
  __builtin_amdgcn_sched_barrier(0);
  sol[41] -= b0c.y * sol[40]; sol[42] -= b0c.z * sol[40]; sol[43] -= b0c.w * sol[40]; sol[44] -= b0d.x * sol[40]; sol[45] -= b0d.y * sol[40]; sol[46] -= b0d.z * sol[40]; sol[47] -= b0d.w * sol[40];
  __builtin_amdgcn_sched_barrier(0);
  b0a = *(const float4*)(Lr + 2672); b0b = *(const float4*)(Lr + 2676); b0c = *(const float4*)(Lr + 2680); b0d = *(const float4*)(Lr + 2684);
  __builtin_amdgcn_sched_barrier(0);
  sol[48] -= b1a.x * sol[40]; sol[49] -= b1a.y * sol[40]; sol[50] -= b1a.z * sol[40]; sol[51] -= b1a.w * sol[40]; sol[52] -= b1b.x * sol[40]; sol[53] -= b1b.y * sol[40]; sol[54] -= b1b.z * sol[40]; sol[55] -= b1b.w * sol[40]; sol[56] -= b1c.x * sol[40]; sol[57] -= b1c.y * sol[40]; sol[58] -= b1c.z * sol[40]; sol[59] -= b1c.w * sol[40]; sol[60] -= b1d.x * sol[40]; sol[61] -= b1d.y * sol[40]; sol[62] -= b1d.z * sol[40]; sol[63] -= b1d.w * sol[40];
  __builtin_amdgcn_sched_barrier(0);
  b1a = *(const float4*)(Lr + 2720); b1b = *(const float4*)(Lr + 2724); b1c = *(const float4*)(Lr + 2728); b1d = *(const float4*)(Lr + 2732);
  __builtin_amdgcn_sched_barrier(0);
  sol[42] -= b2c.z * sol[41]; sol[43] -= b2c.w * sol[41]; sol[44] -= b2d.x * sol[41]; sol[45] -= b2d.y * sol[41]; sol[46] -= b2d.z * sol[41]; sol[47] -= b2d.w * sol[41];
  __builtin_amdgcn_sched_barrier(0);
  b2a = *(const float4*)(Lr + 2736); b2b = *(const float4*)(Lr + 2740); b2c = *(const float4*)(Lr + 2744); b2d = *(const float4*)(Lr + 2748);
  __builtin_amdgcn_sched_barrier(0);
  sol[48] -= b0a.x * sol[41]; sol[49] -= b0a.y * sol[41]; sol[50] -= b0a.z * sol[41]; sol[51] -= b0a.w * sol[41]; sol[52] -= b0b.x * sol[41]; sol[53] -= b0b.y * sol[41]; sol[54] -= b0b.z * sol[41]; sol[55] -= b0b.w * sol[41]; sol[56] -= b0c.x * sol[41]; sol[57] -= b0c.y * sol[41]; sol[58] -= b0c.z * sol[41]; sol[59] -= b0c.w * sol[41]; sol[60] -= b0d.x * sol[41]; sol[61] -= b0d.y * sol[41]; sol[62] -= b0d.z * sol[41]; sol[63] -= b0d.w * sol[41];
  __builtin_amdgcn_sched_barrier(0);
  b0a = *(const float4*)(Lr + 2784); b0b = *(const float4*)(Lr + 2788); b0c = *(const float4*)(Lr + 2792); b0d = *(const float4*)(Lr + 2796);
  __builtin_amdgcn_sched_barrier(0);
  sol[43] -= b1c.w * sol[42]; sol[44] -= b1d.x * sol[42]; sol[45] -= b1d.y * sol[42]; sol[46] -= b1d.z * sol[42]; sol[47] -= b1d.w * sol[42];
  __builtin_amdgcn_sched_barrier(0);
  b1a = *(const float4*)(Lr + 2800); b1b = *(const float4*)(Lr + 2804); b1c = *(const float4*)(Lr + 2808); b1d = *(const float4*)(Lr + 2812);
  __builtin_amdgcn_sched_barrier(0);
  sol[48] -= b2a.x * sol[42]; sol[49] -= b2a.y * sol[42]; sol[50] -= b2a.z * sol[42]; sol[51] -= b2a.w * sol[42]; sol[52] -= b2b.x * sol[42]; sol[53] -= b2b.y * sol[42]; sol[54] -= b2b.z * sol[42]; sol[55] -= b2b.w * sol[42]; sol[56] -= b2c.x * sol[42]; sol[57] -= b2c.y * sol[42]; sol[58] -= b2c.z * sol[42]; sol[59] -= b2c.w * sol[42]; sol[60] -= b2d.x * sol[42]; sol[61] -= b2d.y * sol[42]; sol[62] -= b2d.z * sol[42]; sol[63] -= b2d.w * sol[42];
  __builtin_amdgcn_sched_barrier(0);
  b2a = *(const float4*)(Lr + 2848); b2b = *(const float4*)(Lr + 2852); b2c = *(const float4*)(Lr + 2856); b2d = *(const float4*)(Lr + 2860);
  __builtin_amdgcn_sched_barrier(0);
  sol[44] -= b0d.x * sol[43]; sol[45] -= b0d.y * sol[43]; sol[46] -= b0d.z * sol[43]; sol[47] -= b0d.w * sol[43];
  __builtin_amdgcn_sched_barrier(0);
  b0a = *(const float4*)(Lr + 2864); b0b = *(const float4*)(Lr + 2868); b0c = *(const float4*)(Lr + 2872); b0d = *(const float4*)(Lr + 2876);
  __builtin_amdgcn_sched_barrier(0);
  sol[48] -= b1a.x * sol[43]; sol[49] -= b1a.y * sol[43]; sol[50] -= b1a.z * sol[43]; sol[51] -= b1a.w * sol[43]; sol[52] -= b1b.x * sol[43]; sol[53] -= b1b.y * sol[43]; sol[54] -= b1b.z * sol[43]; sol[55] -= b1b.w * sol[43]; sol[56] -= b1c.x * sol[43]; sol[57] -= b1c.y * sol[43]; sol[58] -= b1c.z * sol[43]; sol[59] -= b1c.w * sol[43]; sol[60] -= b1d.x * sol[43]; sol[61] -= b1d.y * sol[43]; sol[62] -= b1d.z * sol[43]; sol[63] -= b1d.w * sol[43];
  __builtin_amdgcn_sched_barrier(0);
  b1a = *(const float4*)(Lr + 2912); b1b = *(const float4*)(Lr + 2916); b1c = *(const float4*)(Lr + 2920); b1d = *(const float4*)(Lr + 2924);
  __builtin_amdgcn_sched_barrier(0);
  sol[45] -= b2d.y * sol[44]; sol[46] -= b2d.z * sol[44]; sol[47] -= b2d.w * sol[44];
  __builtin_amdgcn_sched_barrier(0);
  b2a = *(const float4*)(Lr + 2928); b2b = *(const float4*)(Lr + 2932); b2c = *(const float4*)(Lr + 2936); b2d = *(const float4*)(Lr + 2940);
  __builtin_amdgcn_sched_barrier(0);
  sol[48] -= b0a.x * sol[44]; sol[49] -= b0a.y * sol[44]; sol[50] -= b0a.z * sol[44]; sol[51] -= b0a.w * sol[44]; sol[52] -= b0b.x * sol[44]; sol[53] -= b0b.y * sol[44]; sol[54] -= b0b.z * sol[44]; sol[55] -= b0b.w * sol[44]; sol[56] -= b0c.x * sol[44]; sol[57] -= b0c.y * sol[44]; sol[58] -= b0c.z * sol[44]; sol[59] -= b0c.w * sol[44]; sol[60] -= b0d.x * sol[44]; sol[61] -= b0d.y * sol[44]; sol[62] -= b0d.z * sol[44]; sol[63] -= b0d.w * sol[44];
  __builtin_amdgcn_sched_barrier(0);
  b0a = *(const float4*)(Lr + 2976); b0b = *(const float4*)(Lr + 2980); b0c = *(const float4*)(Lr + 2984); b0d = *(const float4*)(Lr + 2988);
  __builtin_amdgcn_sched_barrier(0);
  sol[46] -= b1d.z * sol[45]; sol[47] -= b1d.w * sol[45];
  __builtin_amdgcn_sched_barrier(0);
  b1a = *(const float4*)(Lr + 2992); b1b = *(const float4*)(Lr + 2996); b1c = *(const float4*)(Lr + 3000); b1d = *(const float4*)(Lr + 3004);
  __builtin_amdgcn_sched_barrier(0);
  sol[48] -= b2a.x * sol[45]; sol[49] -= b2a.y * sol[45]; sol[50] -= b2a.z * sol[45]; sol[51] -= b2a.w * sol[45]; sol[52] -= b2b.x * sol[45]; sol[53] -= b2b.y * sol[45]; sol[54] -= b2b.z * sol[45]; sol[55] -= b2b.w * sol[45]; sol[56] -= b2c.x * sol[45]; sol[57] -= b2c.y * sol[45]; sol[58] -= b2c.z * sol[45]; sol[59] -= b2c.w * sol[45]; sol[60] -= b2d.x * sol[45]; sol[61] -= b2d.y * sol[45]; sol[62] -= b2d.z * sol[45]; sol[63] -= b2d.w * sol[45];
  __builtin_amdgcn_sched_barrier(0);
  b2a = *(const float4*)(Lr + 3056); b2b = *(const float4*)(Lr + 3060); b2c = *(const float4*)(Lr + 3064); b2d = *(const float4*)(Lr + 3068);
  __builtin_amdgcn_sched_barrier(0);
  sol[47] -= b0d.w * sol[46];
  __builtin_amdgcn_sched_barrier(0);
  b0a = *(const float4*)(Lr + 3120); b0b = *(const float4*)(Lr + 3124); b0c = *(const float4*)(Lr + 3128); b0d = *(const float4*)(Lr + 3132);
  __builtin_amdgcn_sched_barrier(0);
  sol[48] -= b1a.x * sol[46]; sol[49] -= b1a.y * sol[46]; sol[50] -= b1a.z * sol[46]; sol[51] -= b1a.w * sol[46]; sol[52] -= b1b.x * sol[46]; sol[53] -= b1b.y * sol[46]; sol[54] -= b1b.z * sol[46]; sol[55] -= b1b.w * sol[46]; sol[56] -= b1c.x * sol[46]; sol[57] -= b1c.y * sol[46]; sol[58] -= b1c.z * sol[46]; sol[59] -= b1c.w * sol[46]; sol[60] -= b1d.x * sol[46]; sol[61] -= b1d.y * sol[46]; sol[62] -= b1d.z * sol[46]; sol[63] -= b1d.w * sol[46];
  __builtin_amdgcn_sched_barrier(0);
  b1a = *(const float4*)(Lr + 3184); b1b = *(const float4*)(Lr + 3188); b1c = *(const float4*)(Lr + 3192); b1d = *(const float4*)(Lr + 3196);
  __builtin_amdgcn_sched_barrier(0);
  sol[48] -= b2a.x * sol[47]; sol[49] -= b2a.y * sol[47]; sol[50] -= b2a.z * sol[47]; sol[51] -= b2a.w * sol[47]; sol[52] -= b2b.x * sol[47]; sol[53] -= b2b.y * sol[47]; sol[54] -= b2b.z * sol[47]; sol[55] -= b2b.w * sol[47]; sol[56] -= b2c.x * sol[47]; sol[57] -= b2c.y * sol[47]; sol[58] -= b2c.z * sol[47]; sol[59] -= b2c.w * sol[47]; sol[60] -= b2d.x * sol[47]; sol[61] -= b2d.y * sol[47]; sol[62] -= b2d.z * sol[47]; sol[63] -= b2d.w * sol[47];
  __builtin_amdgcn_sched_barrier(0);
  b2a = *(const float4*)(Lr + 3248); b2b = *(const float4*)(Lr + 3252); b2c = *(const float4*)(Lr + 3256); b2d = *(const float4*)(Lr + 3260);
  __builtin_amdgcn_sched_barrier(0);
  sol[49] -= b0a.y * sol[48]; sol[50] -= b0a.z * sol[48]; sol[51] -= b0a.w * sol[48]; sol[52] -= b0b.x * sol[48]; sol[53] -= b0b.y * sol[48]; sol[54] -= b0b.z * sol[48]; sol[55] -= b0b.w * sol[48]; sol[56] -= b0c.x * sol[48]; sol[57] -= b0c.y * sol[48]; sol[58] -= b0c.z * sol[48]; sol[59] -= b0c.w * sol[48]; sol[60] -= b0d.x * sol[48]; sol[61] -= b0d.y * sol[48]; sol[62] -= b0d.z * sol[48]; sol[63] -= b0d.w * sol[48];
  __builtin_amdgcn_sched_barrier(0);
  b0a = *(const float4*)(Lr + 3312); b0b = *(const float4*)(Lr + 3316); b0c = *(const float4*)(Lr + 3320); b0d = *(const float4*)(Lr + 3324);
  __builtin_amdgcn_sched_barrier(0);
  sol[50] -= b1a.z * sol[49]; sol[51] -= b1a.w * sol[49]; sol[52] -= b1b.x * sol[49]; sol[53] -= b1b.y * sol[49]; sol[54] -= b1b.z * sol[49]; sol[55] -= b1b.w * sol[49]; sol[56] -= b1c.x * sol[49]; sol[57] -= b1c.y * sol[49]; sol[58] -= b1c.z * sol[49]; sol[59] -= b1c.w * sol[49]; sol[60] -= b1d.x * sol[49]; sol[61] -= b1d.y * sol[49]; sol[62] -= b1d.z * sol[49]; sol[63] -= b1d.w * sol[49];
  __builtin_amdgcn_sched_barrier(0);
  b1a = *(const float4*)(Lr + 3376); b1b = *(const float4*)(Lr + 3380); b1c = *(const float4*)(Lr + 3384); b1d = *(const float4*)(Lr + 3388);
  __builtin_amdgcn_sched_barrier(0);
  sol[51] -= b2a.w * sol[50]; sol[52] -= b2b.x * sol[50]; sol[53] -= b2b.y * sol[50]; sol[54] -= b2b.z * sol[50]; sol[55] -= b2b.w * sol[50]; sol[56] -= b2c.x * sol[50]; sol[57] -= b2c.y * sol[50]; sol[58] -= b2c.z * sol[50]; sol[59] -= b2c.w * sol[50]; sol[60] -= b2d.x * sol[50]; sol[61] -= b2d.y * sol[50]; sol[62] -= b2d.z * sol[50]; sol[63] -= b2d.w * sol[50];
  __builtin_amdgcn_sched_barrier(0);
  b2a = *(const float4*)(Lr + 3440); b2b = *(const float4*)(Lr + 3444); b2c = *(const float4*)(Lr + 3448); b2d = *(const float4*)(Lr + 3452);
  __builtin_amdgcn_sched_barrier(0);
  sol[52] -= b0b.x * sol[51]; sol[53] -= b0b.y * sol[51]; sol[54] -= b0b.z * sol[51]; sol[55] -= b0b.w * sol[51]; sol[56] -= b0c.x * sol[51]; sol[57] -= b0c.y * sol[51]; sol[58] -= b0c.z * sol[51]; sol[59] -= b0c.w * sol[51]; sol[60] -= b0d.x * sol[51]; sol[61] -= b0d.y * sol[51]; sol[62] -= b0d.z * sol[51]; sol[63] -= b0d.w * sol[51];
  __builtin_amdgcn_sched_barrier(0);
  b0a = *(const float4*)(Lr + 3504); b0b = *(const float4*)(Lr + 3508); b0c = *(const float4*)(Lr + 3512); b0d = *(const float4*)(Lr + 3516);
  __builtin_amdgcn_sched_barrier(0);
  sol[53] -= b1b.y * sol[52]; sol[54] -= b1b.z * sol[52]; sol[55] -= b1b.w * sol[52]; sol[56] -= b1c.x * sol[52]; sol[57] -= b1c.y * sol[52]; sol[58] -= b1c.z * sol[52]; sol[59] -= b1c.w * sol[52]; sol[60] -= b1d.x * sol[52]; sol[61] -= b1d.y * sol[52]; sol[62] -= b1d.z * sol[52]; sol[63] -= b1d.w * sol[52];
  __builtin_amdgcn_sched_barrier(0);
  b1a = *(const float4*)(Lr + 3568); b1b = *(const float4*)(Lr + 3572); b1c = *(const float4*)(Lr + 3576); b1d = *(const float4*)(Lr + 3580);
  __builtin_amdgcn_sched_barrier(0);
  sol[54] -= b2b.z * sol[53]; sol[55] -= b2b.w * sol[53]; sol[56] -= b2c.x * sol[53]; sol[57] -= b2c.y * sol[53]; sol[58] -= b2c.z * sol[53]; sol[59] -= b2c.w * sol[53]; sol[60] -= b2d.x * sol[53]; sol[61] -= b2d.y * sol[53]; sol[62] -= b2d.z * sol[53]; sol[63] -= b2d.w * sol[53];
  __builtin_amdgcn_sched_barrier(0);
  b2a = *(const float4*)(Lr + 3632); b2b = *(const float4*)(Lr + 3636); b2c = *(const float4*)(Lr + 3640); b2d = *(const float4*)(Lr + 3644);
  __builtin_amdgcn_sched_barrier(0);
  sol[55] -= b0b.w * sol[54]; sol[56] -= b0c.x * sol[54]; sol[57] -= b0c.y * sol[54]; sol[58] -= b0c.z * sol[54]; sol[59] -= b0c.w * sol[54]; sol[60] -= b0d.x * sol[54]; sol[61] -= b0d.y * sol[54]; sol[62] -= b0d.z * sol[54]; sol[63] -= b0d.w * sol[54];
  __builtin_amdgcn_sched_barrier(0);
  b0a = *(const float4*)(Lr + 3696); b0b = *(const float4*)(Lr + 3700); b0c = *(const float4*)(Lr + 3704); b0d = *(const float4*)(Lr + 3708);
  __builtin_amdgcn_sched_barrier(0);
  sol[56] -= b1c.x * sol[55]; sol[57] -= b1c.y * sol[55]; sol[58] -= b1c.z * sol[55]; sol[59] -= b1c.w * sol[55]; sol[60] -= b1d.x * sol[55]; sol[61] -= b1d.y * sol[55]; sol[62] -= b1d.z * sol[55]; sol[63] -= b1d.w * sol[55];
  __builtin_amdgcn_sched_barrier(0);
  b1a = *(const float4*)(Lr + 3760); b1b = *(const float4*)(Lr + 3764); b1c = *(const float4*)(Lr + 3768); b1d = *(const float4*)(Lr + 3772);
  __builtin_amdgcn_sched_barrier(0);
  sol[57] -= b2c.y * sol[56]; sol[58] -= b2c.z * sol[56]; sol[59] -= b2c.w * sol[56]; sol[60] -= b2d.x * sol[56]; sol[61] -= b2d.y * sol[56]; sol[62] -= b2d.z * sol[56]; sol[63] -= b2d.w * sol[56];
  __builtin_amdgcn_sched_barrier(0);
  b2a = *(const float4*)(Lr + 3824); b2b = *(const float4*)(Lr + 3828); b2c = *(const float4*)(Lr + 3832); b2d = *(const float4*)(Lr + 3836);
  __builtin_amdgcn_sched_barrier(0);
  sol[58] -= b0c.z * sol[57]; sol[59] -= b0c.w * sol[57]; sol[60] -= b0d.x * sol[57]; sol[61] -= b0d.y * sol[57]; sol[62] -= b0d.z * sol[57]; sol[63] -= b0d.w * sol[57];
  __builtin_amdgcn_sched_barrier(0);
  b0a = *(const float4*)(Lr + 3888); b0b = *(const float4*)(Lr + 3892); b0c = *(const float4*)(Lr + 3896); b0d = *(const float4*)(Lr + 3900);
  __builtin_amdgcn_sched_barrier(0);
  sol[59] -= b1c.w * sol[58]; sol[60] -= b1d.x * sol[58]; sol[61] -= b1d.y * sol[58]; sol[62] -= b1d.z * sol[58]; sol[63] -= b1d.w * sol[58];
  __builtin_amdgcn_sched_barrier(0);
  b1a = *(const float4*)(Lr + 3952); b1b = *(const float4*)(Lr + 3956); b1c = *(const float4*)(Lr + 3960); b1d = *(const float4*)(Lr + 3964);
  __builtin_amdgcn_sched_barrier(0);
  sol[60] -= b2d.x * sol[59]; sol[61] -= b2d.y * sol[59]; sol[62] -= b2d.z * sol[59]; sol[63] -= b2d.w * sol[59];
  __builtin_amdgcn_sched_barrier(0);
  b2a = *(const float4*)(Lr + 4016); b2b = *(const float4*)(Lr + 4020); b2c = *(const float4*)(Lr + 4024); b2d = *(const float4*)(Lr + 4028);
  __builtin_amdgcn_sched_barrier(0);
  sol[61] -= b0d.y * sol[60]; sol[62] -= b0d.z * sol[60]; sol[63] -= b0d.w * sol[60];
  __builtin_amdgcn_sched_barrier(0);
  __builtin_amdgcn_sched_barrier(0);
  sol[62] -= b1d.z * sol[61]; sol[63] -= b1d.w * sol[61];
  __builtin_amdgcn_sched_barrier(0);
  __builtin_amdgcn_sched_barrier(0);
  sol[63] -= b2d.w * sol[62];
  __builtin_amdgcn_sched_barrier(0);
}

template <int DIR>
__device__ __forceinline__ void solve_cols(const Params& P, int itb, int c, const float* Lt, const float* bpp, const float* gcp,
                                           const u16* Vs, const u16* Ks) {
  float sol[64];
  const float* bp_ = bpp + DIR * 64;
  const float* gc_ = gcp + DIR * 64;
  if (c < 128) {
    const u16* vp = Vs + c;
#pragma unroll
    for (int p = 0; p < 64; ++p) sol[p] = bp_[p] * bf2f(vp[(DIR ? (63 - p) : p) * 136]);
  } else {
    const u16* kp = Ks + (c - 128);
#pragma unroll
    for (int p = 0; p < 64; ++p) sol[p] = bp_[p] * __expf(gc_[p]) * bf2f(kp[(DIR ? (63 - p) : p) * 136]);
  }
  const float* Lr = Lt + opq(DIR * 4096);
  solve_elim(sol, Lr);
  const size_t it2 = (size_t)(itb + DIR);
  if (c < 128) {
    u16* UF = (u16*)(P.ws + OFF_UF) + (it2 * 128 + c) * 64;
#pragma unroll
    for (int q = 0; q < 8; ++q) *(uint4*)(UF + q * 8) = pack8(sol + q * 8);
  } else {
    u16* Wg = (u16*)(P.ws + OFF_R2) + it2 * 8192 + (c - 128);
#pragma unroll
    for (int p = 0; p < 64; ++p) Wg[p * 128] = f2bf(-sol[p]);
  }
}

__device__ __forceinline__ void delta_prep_item(const Params& P, int item, char* lds) {
  const int tid = opq(threadIdx.x), lane = tid & 63, wv = tid >> 6, fr = lane & 15, fq = lane >> 4;
  const int cid = item >> 2, h = item & 3;
  const int row0 = cid * 64;
  int seq_lo, seq_hi;
  if (cid < 256) { seq_lo = (cid >> 6) * 4096; seq_hi = seq_lo + 4096; }
  else { seq_lo = 16384 + ((cid - 256) >> 2) * 256; seq_hi = seq_lo + 256; }
  u16* Qs = (u16*)(lds + opq(0));
  u16* Ks = (u16*)(lds + opq(17408));
  u16* Vs = (u16*)(lds + opq(34816));
  float* KKs = (float*)(lds + opq(52224));
  float* QKs = (float*)(lds + opq(69632));
  float* Lt = (float*)(lds + opq(87040));
  float* gtok = (float*)(lds + opq(119808));
  float* btok = gtok + 128;
  float* gcp = btok + 128;
  float* bpp = gcp + 128;
  u16* QKN = (u16*)((char*)P.out + OFF_QKN);
  lds_barrier();
  {
    const int j = tid >> 3, sg = tid & 7;
    const int row = row0 + j;
    const bool hm = (row - 1 >= seq_lo), hp = (row + 1 < seq_hi);
    const u16* qkv = (const u16*)(P.ws + OFF_R3);
#pragma unroll
    for (int s = 0; s < 3; ++s) {
      const int col = s * 512 + h * 128 + sg * 16;
      const u16* p0 = qkv + (size_t)row * 1536 + col;
      float y[16];
      float ssq = 0.f;
#pragma unroll
      for (int hh = 0; hh < 2; ++hh) {
        const uint4 c0 = *(const uint4*)(p0 + hh * 8);
        uint4 m0 = *(const uint4*)(p0 - (hm ? 1536 : 0) + hh * 8);
        uint4 n0 = *(const uint4*)(p0 + (hp ? 1536 : 0) + hh * 8);
        m0.x = hm ? m0.x : 0u; m0.y = hm ? m0.y : 0u; m0.z = hm ? m0.z : 0u; m0.w = hm ? m0.w : 0u;
        n0.x = hp ? n0.x : 0u; n0.y = hp ? n0.y : 0u; n0.z = hp ? n0.z : 0u; n0.w = hp ? n0.w : 0u;
        float fc[8], fm[8], fn[8];
        unpack8(c0, fc); unpack8(m0, fm); unpack8(n0, fn);
        const float* cwp = P.dn_conv_w + col + hh * 8;
        float cw0[8], cw1[8], cw2[8];
        {
          const float4 t0 = *(const float4*)(cwp), t1 = *(const float4*)(cwp + 4);
          const float4 t2 = *(const float4*)(cwp + 1536), t3 = *(const float4*)(cwp + 1540);
          const float4 t4 = *(const float4*)(cwp + 3072), t5 = *(const float4*)(cwp + 3076);
          cw0[0] = t0.x; cw0[1] = t0.y; cw0[2] = t0.z; cw0[3] = t0.w; cw0[4] = t1.x; cw0[5] = t1.y; cw0[6] = t1.z; cw0[7] = t1.w;
          cw1[0] = t2.x; cw1[1] = t2.y; cw1[2] = t2.z; cw1[3] = t2.w; cw1[4] = t3.x; cw1[5] = t3.y; cw1[6] = t3.z; cw1[7] = t3.w;
          cw2[0] = t4.x; cw2[1] = t4.y; cw2[2] = t4.z; cw2[3] = t4.w; cw2[4] = t5.x; cw2[5] = t5.y; cw2[6] = t5.z; cw2[7] = t5.w;
        }
#pragma unroll
        for (int e = 0; e < 8; ++e) {
          const float v = cw0[e] * fm[e] + cw1[e] * fc[e] + cw2[e] * fn[e];
          const float yy = v * sigm(v);
          y[hh * 8 + e] = yy;
          ssq += yy * yy;
        }
      }
      if (s < 2) {
        ssq += __shfl_xor(ssq, 1, 64); ssq += __shfl_xor(ssq, 2, 64); ssq += __shfl_xor(ssq, 4, 64);
        const float sc = rsqrtf(ssq + 1e-6f) * ((s == 0) ? 0.08838834764831845f : 1.f);
#pragma unroll
        for (int e = 0; e < 16; ++e) y[e] *= sc;
      }
      u16* dl = ((s == 0) ? Qs : ((s == 1) ? Ks : Vs)) + j * 136 + sg * 16;
      const uint4 o0 = pack8(y), o1 = pack8(y + 8);
      *(uint4*)dl = o0; *(uint4*)(dl + 8) = o1;
      if (s < 2) {
        u16* dg = QKN + (size_t)row * 1024 + s * 512 + h * 128 + sg * 16;
        *(uint4*)dg = o0; *(uint4*)(dg + 8) = o1;
      }
    }
  }
  if (tid < 128) {
    const int j = tid & 63, dir = tid >> 6;
    const float* BA = (const float*)(P.ws + OFF_BA) + (size_t)(row0 + j) * 16;
    const float bl = BA[dir * 4 + h], al = BA[8 + dir * 4 + h];
    const float xx = al + P.dn_dt_bias[dir * 4 + h];
    const float sp = (xx > 20.f) ? xx : log1pf(expf(xx));
    gtok[dir * 64 + j] = -expf(P.dn_a_log[dir * 4 + h]) * sp;
    btok[dir * 64 + j] = 1.f / (1.f + expf(-bl));
  }
  lds_barrier();
  if (tid < 128) {
    const int dir = tid >> 6, p = tid & 63;
    const int tk = dir ? (63 - p) : p;
    float a = gtok[dir * 64 + tk];
    const float bv = btok[dir * 64 + tk];
#pragma unroll
    for (int o = 1; o < 64; o <<= 1) {
      const float t = __shfl_up(a, o, 64);
      if (p >= o) a += t;
    }
    gcp[dir * 64 + p] = a;
    bpp[dir * 64 + p] = bv;
  }
  {
#pragma unroll
    for (int q = 0; q < 4; ++q) {
      const int t = wv * 4 + q;
      const int which = t >> 4, mi = (t >> 2) & 3, ni = t & 3;
      const u16* Am = (which ? Qs : Ks) + (mi * 16 + fr) * 136 + fq * 8;
      const u16* Bm = Ks + (ni * 16 + fr) * 136 + fq * 8;
      f32x4 a4 = {0.f, 0.f, 0.f, 0.f};
#pragma unroll
      for (int kk = 0; kk < 4; ++kk)
        a4 = __builtin_amdgcn_mfma_f32_16x16x32_bf16(*(const bf16x8*)(Am + kk * 32), *(const bf16x8*)(Bm + kk * 32), a4, 0, 0, 0);
      float* dst = which ? QKs : KKs;
#pragma unroll
      for (int e = 0; e < 4; ++e) dst[(mi * 16 + fq * 4 + e) * 68 + ni * 16 + fr] = a4[e];
    }
  }
  lds_barrier();
  const int itb = item * 2;
  {
    u16* AQ = (u16*)((char*)P.out + OFF_AQ);
#pragma unroll 8
    for (int idx = tid; idx < 8192; idx += NT) {
      const int dir = idx >> 12, p = (idx >> 6) & 63, s = idx & 63;
      const int tp = dir ? (63 - p) : p, ts = dir ? (63 - s) : s;
      const float dg = gcp[dir * 64 + p] - gcp[dir * 64 + s];
      const float dec = (p >= s) ? __expf(dg) : 0.f;
      AQ[((size_t)(itb + dir) * 64 + p) * 64 + s] = f2bf(QKs[tp * 68 + ts] * dec);
    }
#pragma unroll 8
    for (int idx = tid; idx < 8192; idx += NT) {
      const int dir = idx >> 12, s = (idx >> 6) & 63, p = idx & 63;
      const int tp = dir ? (63 - p) : p, ts = dir ? (63 - s) : s;
      const float dg = gcp[dir * 64 + p] - gcp[dir * 64 + s];
      const float lv = (p > s) ? bpp[dir * 64 + p] * KKs[ts * 68 + tp] * __expf(dg) : 0.f;
      Lt[dir * 4096 + s * 64 + p] = lv;
    }
    if (tid < 128) {
      float* GC = (float*)(P.ws + OFF_GC);
      GC[(size_t)(itb + (tid >> 6)) * 64 + (tid & 63)] = gcp[tid];
    }
  }
  lds_barrier();
  if (tid < 256) solve_cols<0>(P, itb, tid, Lt, bpp, gcp, Vs, Ks);
  else solve_cols<1>(P, itb, tid - 256, Lt, bpp, gcp, Vs, Ks);
}

__device__ __forceinline__ void s5end_tile(const Params& P, int t, char* lds) {
  const int g = t / 6, mt = (t % 6) >> 1, nt = t & 1;
  const int m0 = mt * 256, n0 = nt * 128;
  f32x16 acc[2][2];
  acc_zero(acc);
  gemm_main((const u16*)(P.ws + OFF_U5) + ((size_t)g * 544 + m0) * 512, 512,
            (const u16*)(P.ws + OFF_MEND) + ((size_t)g * 256 + n0) * 512, 512, 512, acc, (u16*)lds);
  TILE_COORDS
  float* E = (float*)(P.ws + OFF_E);
#pragma unroll
  for (int i = 0; i < 2; ++i)
#pragma unroll
    for (int j = 0; j < 2; ++j)
#pragma unroll
      for (int e = 0; e < 16; ++e) {
        const int row = TROW(m0, i, e);
        if (row < 544) E[((size_t)g * 544 + row) * 256 + TCOL(n0, j)] = acc[i][j][e];
      }
}

__device__ __forceinline__ void scan_chunk(const u16* Wl, const u16* QTl, const u16* KTl, const u16* AQl, u16* ST, u16* VT,
                                           int wd, int wq, int fr, int fq, float gl, f32x4& av, f32x4& ao, f32x4& accS0, f32x4& accS1) {
  {
    bf16x8 bS[4], a1[4], a2[4];
#pragma unroll
    for (int kk = 0; kk < 4; ++kk) {
      bS[kk] = *(const bf16x8*)(ST + (wd * 16 + fr) * 136 + kk * 32 + fq * 8);
      a1[kk] = *(const bf16x8*)(Wl + (wq * 16 + fr) * 136 + kk * 32 + fq * 8);
      a2[kk] = *(const bf16x8*)(QTl + (wq * 16 + fr) * 136 + kk * 32 + fq * 8);
    }
    __builtin_amdgcn_sched_barrier(0);
#pragma unroll
    for (int kk = 0; kk < 4; ++kk) {
      av = __builtin_amdgcn_mfma_f32_16x16x32_bf16(a1[kk], bS[kk], av, 0, 0, 0);
      ao = __builtin_amdgcn_mfma_f32_16x16x32_bf16(a2[kk], bS[kk], ao, 0, 0, 0);
    }
  }
  {
    uint2 v; v.x = pack2(av[0], av[1]); v.y = pack2(av[2], av[3]);
    *(uint2*)(VT + (wd * 16 + fr) * 72 + wq * 16 + fq * 4) = v;
  }
  bf16x8 qa[2], k0[2], k1[2];
#pragma unroll
  for (int ks = 0; ks < 2; ++ks) {
    qa[ks] = *(const bf16x8*)(AQl + (wq * 16 + fr) * 72 + ks * 32 + fq * 8);
    const int r0_ = (2 * wq) * 16 + fr, r1_ = (2 * wq + 1) * 16 + fr;
    k0[ks] = *(const bf16x8*)(KTl + r0_ * 72 + ((ks * 32 + fq * 8) ^ (((r0_ >> 3) & 7) << 3)));
    k1[ks] = *(const bf16x8*)(KTl + r1_ * 72 + ((ks * 32 + fq * 8) ^ (((r1_ >> 3) & 7) << 3)));
  }
  accS0[0] *= gl; accS0[1] *= gl; accS0[2] *= gl; accS0[3] *= gl;
  accS1[0] *= gl; accS1[1] *= gl; accS1[2] *= gl; accS1[3] *= gl;
  lds_barrier();
  {
    bf16x8 bV[2];
#pragma unroll
    for (int ks = 0; ks < 2; ++ks) bV[ks] = *(const bf16x8*)(VT + (wd * 16 + fr) * 72 + ks * 32 + fq * 8);
#pragma unroll
    for (int ks = 0; ks < 2; ++ks) {
      ao = __builtin_amdgcn_mfma_f32_16x16x32_bf16(qa[ks], bV[ks], ao, 0, 0, 0);
      accS0 = __builtin_amdgcn_mfma_f32_16x16x32_bf16(k0[ks], bV[ks], accS0, 0, 0, 0);
      accS1 = __builtin_amdgcn_mfma_f32_16x16x32_bf16(k1[ks], bV[ks], accS1, 0, 0, 0);
    }
  }
  {
    uint2 v; v.x = pack2(accS0[0], accS0[1]); v.y = pack2(accS0[2], accS0[3]);
    *(uint2*)(ST + (wd * 16 + fr) * 136 + (2 * wq) * 16 + fq * 4) = v;
    v.x = pack2(accS1[0], accS1[1]); v.y = pack2(accS1[2], accS1[3]);
    *(uint2*)(ST + (wd * 16 + fr) * 136 + (2 * wq + 1) * 16 + fq * 4) = v;
  }
}

__device__ __forceinline__ void delta_scan_block(const Params& P, int sb, char* lds) {
  const int tid = opq(threadIdx.x), lane = tid & 63, w = tid >> 6, fr = lane & 15, fq = lane >> 4;
  const int bhd = sb & 31, dvq = sb >> 5;
  const int b = bhd >> 3, h = (bhd >> 1) & 3, dir = bhd & 1;
  const int wd = w & 1, wq = w >> 1;
  const int dv0 = dvq * 32 + wd * 16;
  u16* Wl = (u16*)(lds + opq(0));
  u16* QTl = (u16*)(lds + opq(17408));
  u16* KTl = (u16*)(lds + opq(34816));
  u16* AQl = (u16*)(lds + opq(53248));
  u16* ST = (u16*)(lds + opq(62464));
  u16* VT = (u16*)(lds + opq(71168));
  lds_barrier();
  for (int i = tid; i < 32 * 136 / 2; i += NT) ((uint32_t*)ST)[i] = 0u;
  f32x4 accS0 = {0.f, 0.f, 0.f, 0.f}, accS1 = {0.f, 0.f, 0.f, 0.f};
  const u16* QKN = (const u16*)((const char*)P.out + OFF_QKN);
  const u16* AQg = (const u16*)((const char*)P.out + OFF_AQ);
  const u16* Wg = (const u16*)(P.ws + OFF_R2);
  const u16* UFg = (const u16*)(P.ws + OFF_UF);
  const float* GC = (const float*)(P.ws + OFF_GC);
  u16* Og = (u16*)(P.ws + OFF_O);

#define GLD16(dst, ptr) asm volatile("global_load_dwordx4 %0, %1, off" : "=v"(dst) : "v"(ptr) : "memory")
#define GLD8(dst, ptr) asm volatile("global_load_dwordx2 %0, %1, off" : "=v"(dst) : "v"(ptr) : "memory")
#define GLD4(dst, ptr) asm volatile("global_load_dword %0, %1, off" : "=v"(dst) : "v"(ptr) : "memory")
#define SC_DECL(S)                                                   \
  u32x4 S##w0, S##w1, S##q0, S##q1, S##k0, S##k1, S##a;              \
  float S##gq0, S##gq1, S##g63;                                      \
  u32x2 S##u;                                                        \
  int S##row0 = 0, S##lat = 0;
#define SC_PF_ONE(S, i)                                                                            \
    {                                                                                              \
      const int id = tid + (i) * 512;                                                              \
      const int p = id >> 4, seg = id & 15;                                                        \
      const int tk = dir ? (63 - p) : p;                                                           \
      GLD16(S##w##i, Wg + it2__ * 8192 + p * 128 + seg * 8);                                       \
      GLD16(S##q##i, QKN + (size_t)(S##row0 + tk) * 1024 + h * 128 + seg * 8);                     \
      GLD4(S##gq##i, GC + it2__ * 64 + p);                                                         \
      GLD16(S##k##i, QKN + (size_t)(S##row0 + tk) * 1024 + 512 + h * 128 + seg * 8);               \
    }
#define SC_PREFETCH(S, n_)                                                                         \
  {                                                                                                \
    const int n__ = (n_);                                                                          \
    int cid__;                                                                                     \
    if (n__ < 4) { cid__ = 256 + b * 4 + (dir ? (3 - n__) : n__); S##lat = 0; }                    \
    else { const int m__ = n__ - 4; cid__ = b * 64 + (dir ? (63 - m__) : m__); S##lat = 1; }       \
    S##row0 = cid__ * 64;                                                                          \
    const size_t it2__ = (size_t)((cid__ * 4 + h) * 2 + dir);                                      \
    SC_PF_ONE(S, 0)                                                                                \
    SC_PF_ONE(S, 1)                                                                                \
    GLD4(S##g63, GC + it2__ * 64 + 63);                                                            \
    GLD16(S##a, AQg + it2__ * 4096 + (tid >> 3) * 64 + (tid & 7) * 8);                             \
    GLD8(S##u, UFg + (it2__ * 128 + dv0 + fr) * 64 + wq * 16 + fq * 4);                            \
  }
#define SC_WAIT(S, CNT)                                                                            \
  asm volatile("s_waitcnt vmcnt(" #CNT ")"                                                         \
               : "+v"(S##w0), "+v"(S##w1), "+v"(S##q0), "+v"(S##q1), "+v"(S##k0), "+v"(S##k1), "+v"(S##a), \
                 "+v"(S##gq0), "+v"(S##gq1), "+v"(S##g63), "+v"(S##u)                              \
               :: "memory");
#define SC_STAGE_ONE(S, i)                                                    \
    {                                                                         \
      const int id = tid + (i) * 512;                                         \
      const int p = id >> 4, seg = id & 15;                                   \
      *(u32x4*)(Wl + p * 136 + seg * 8) = S##w##i;                            \
      float f[8];                                                             \
      unpack8(make_uint4(S##q##i.x, S##q##i.y, S##q##i.z, S##q##i.w), f);     \
      const float sq = __expf(S##gq##i);                                      \
      f[0] *= sq; f[1] *= sq; f[2] *= sq; f[3] *= sq; f[4] *= sq; f[5] *= sq; f[6] *= sq; f[7] *= sq; \
      *(uint4*)(QTl + p * 136 + seg * 8) = pack8(f);                          \
      unpack8(make_uint4(S##k##i.x, S##k##i.y, S##k##i.z, S##k##i.w), f);     \
      const float sk = __expf(S##g63 - S##gq##i);                             \
      u16* kd = KTl + (seg * 8) * 72 + (p ^ ((seg & 7) << 3));                \
      kd[0 * 72] = f2bf(f[0] * sk); kd[1 * 72] = f2bf(f[1] * sk); kd[2 * 72] = f2bf(f[2] * sk); kd[3 * 72] = f2bf(f[3] * sk); \
      kd[4 * 72] = f2bf(f[4] * sk); kd[5 * 72] = f2bf(f[5] * sk); kd[6 * 72] = f2bf(f[6] * sk); kd[7 * 72] = f2bf(f[7] * sk); \
    }
#define SC_STEP(S, n_, WCNT, DO_PF)                                                                   \
  {                                                                                                   \
    SC_WAIT(S, WCNT)                                                                                  \
    const int cur_row0 = S##row0, cur_lat = S##lat;                                                   \
    const float gl = __expf(S##g63);                                                                  \
    SC_STAGE_ONE(S, 0)                                                                                \
    SC_STAGE_ONE(S, 1)                                                                                \
    *(u32x4*)(AQl + (tid >> 3) * 72 + (tid & 7) * 8) = S##a;                                          \
    f32x4 av = f32x4{lo16(S##u.x), hi16(S##u.x), lo16(S##u.y), hi16(S##u.y)};                         \
    f32x4 ao = f32x4{0.f, 0.f, 0.f, 0.f};                                                             \
    lds_barrier();                                                                                    \
    if (DO_PF) SC_PREFETCH(S, (n_) + 2)                                                               \
    scan_chunk(Wl, QTl, KTl, AQl, ST, VT, wd, wq, fr, fq, gl, av, ao, accS0, accS1);                  \
    if (cur_lat) {                                                                                    \
      const int p0 = wq * 16 + fq * 4;                                                                \
      u16* og = Og + ((size_t)dir * 16384 + cur_row0) * 512 + h * 128 + dv0 + fr;                     \
      og[(size_t)(dir ? (63 - (p0 + 0)) : (p0 + 0)) * 512] = f2bf(ao[0]);                             \
      og[(size_t)(dir ? (63 - (p0 + 1)) : (p0 + 1)) * 512] = f2bf(ao[1]);                             \
      og[(size_t)(dir ? (63 - (p0 + 2)) : (p0 + 2)) * 512] = f2bf(ao[2]);                             \
      og[(size_t)(dir ? (63 - (p0 + 3)) : (p0 + 3)) * 512] = f2bf(ao[3]);                             \
    }                                                                                                 \
    lds_barrier();                                                                                    \
  }
  SC_DECL(A)
  SC_DECL(B)
  SC_PREFETCH(A, 0)
  SC_PREFETCH(B, 1)
  for (int n = 0; n < 66; n += 2) {
    SC_STEP(A, n, 11, true)
    SC_STEP(B, n + 1, 11, true)
  }
  SC_STEP(A, 66, 0, false)
  SC_STEP(B, 67, 0, false)
#undef SC_DECL
#undef SC_PF_ONE
#undef SC_PREFETCH
#undef SC_WAIT
#undef SC_STAGE_ONE
#undef SC_STEP
#undef GLD16
#undef GLD8
#undef GLD4
}

__device__ __forceinline__ void s5_carry_block(const Params& P, int cb) {
  const int idx = cb * NT + opq(threadIdx.x);
  const int n = idx & 63, g = (idx >> 6) & 31, r = (idx >> 11) & 1, b = idx >> 12;
  const int rg = r * 32 + g;
  const float step = expf(P.s5_log_step[rg]);
  float lr, li;
  lam_pow(step, P.s5_a_re[rg * 64 + n], P.s5_a_im[rg * 64 + n], 32, lr, li);
  const float* __restrict__ E = (const float*)(P.ws + OFF_E) + (size_t)g * 544 * 256 + r * 128 + n;
  u16* __restrict__ XIN = (u16*)(P.ws + OFF_XIN) + (size_t)g * 512 * 256 + r * 128 + n;
  float xr = 0.f, xi = 0.f;
  {
    float er[8], ei[8];
#pragma unroll
    for (int k = 0; k < 8; ++k) {
      const int row = 512 + b * 8 + (r ? (7 - k) : k);
      er[k] = E[(size_t)row * 256]; ei[k] = E[(size_t)row * 256 + 64];
    }
#pragma unroll
    for (int k = 0; k < 8; ++k) {
      const float nr = lr * xr - li * xi + er[k], ni = lr * xi + li * xr + ei[k];
      xr = nr; xi = ni;
    }
  }
  for (int k0 = 0; k0 < 128; k0 += 8) {
    float er[8], ei[8];
#pragma unroll
    for (int k = 0; k < 8; ++k) {
      const int row = b * 128 + (r ? (127 - (k0 + k)) : (k0 + k));
      er[k] = E[(size_t)row * 256]; ei[k] = E[(size_t)row * 256 + 64];
    }
#pragma unroll
    for (int k = 0; k < 8; ++k) {
      const int row = b * 128 + (r ? (127 - (k0 + k)) : (k0 + k));
      XIN[(size_t)row * 256] = f2bf(xr);
      XIN[(size_t)row * 256 + 64] = f2bf(xi);
      const float nr = lr * xr - li * xi + er[k], ni = lr * xi + li * xr + ei[k];
      xr = nr; xi = ni;
    }
  }
}

__device__ __forceinline__ void s5out_tile(const Params& P, int t, char* lds) {
  const int g = t >> 3, mt = (t >> 2) & 1, nt = t & 3;
  const int m0 = mt * 256, n0 = nt * 128;
  f32x16 acc[2][2];
  acc_zero(acc);
  gemm_main((const u16*)(P.ws + OFF_XIN) + ((size_t)g * 512 + m0) * 256, 256,
            (const u16*)(P.ws + OFF_MST) + ((size_t)g * 512 + n0) * 256, 256, 256, acc, (u16*)lds);
  gemm_main((const u16*)(P.ws + OFF_U5) + ((size_t)g * 544 + m0) * 512, 512,
            (const u16*)(P.ws + OFF_MINTRA) + ((size_t)g * 512 + n0) * 512, 512, 512, acc, (u16*)lds);
  TILE_COORDS
  u16* YB = (u16*)(P.ws + OFF_YB);
#pragma unroll
  for (int i = 0; i < 2; ++i)
#pragma unroll
    for (int j = 0; j < 2; ++j)
#pragma unroll
      for (int e = 0; e < 16; ++e) {
        const int row = TROW(m0, i, e), nn = TCOL(n0, j);
        const int token = row * 32 + (nn >> 4);
        YB[(size_t)token * 512 + g * 16 + (nn & 15)] = f2bf(gelu_tanh(acc[i][j][e]));
      }
}

__device__ __forceinline__ void delta_post_item(const Params& P, int item) {
  const int lane = opq(threadIdx.x) & 63, w = opq(threadIdx.x) >> 6;
  const int row = item * 8 + w;
  const u16* O = (const u16*)(P.ws + OFF_O);
  const uint4 o0 = *(const uint4*)(O + (size_t)row * 512 + lane * 8);
  const uint4 o1 = *(const uint4*)(O + ((size_t)16384 + row) * 512 + lane * 8);
  const uint4 zz = *(const uint4*)((const u16*)(P.ws + OFF_Z) + (size_t)row * 512 + lane * 8);
  float a[8], bq[8], z[8];
  unpack8(o0, a); unpack8(o1, bq); unpack8(zz, z);
  float ss = 0.f;
#pragma unroll
  for (int e = 0; e < 8; ++e) { a[e] += bq[e]; ss += a[e] * a[e]; }
  ss += __shfl_xor(ss, 1, 64); ss += __shfl_xor(ss, 2, 64); ss += __shfl_xor(ss, 4, 64); ss += __shfl_xor(ss, 8, 64);
  const float rstd = rsqrtf(ss * (1.f / 128.f) + 1e-6f);
  const float* nw = P.dn_norm_w + (lane & 15) * 8;
  float y[8];
#pragma unroll
  for (int e = 0; e < 8; ++e) y[e] = a[e] * rstd * nw[e] * (z[e] * sigm(z[e]));
  *(uint4*)((u16*)(P.ws + OFF_YA) + (size_t)row * 512 + lane * 8) = pack8(y);
}

__device__ __forceinline__ void glu_tile(const Params& P, int t, char* lds) {
  const int nt = t >> 6, mt = t & 63;
  const int m0 = mt * 256, n0 = nt * 128;
  f32x16 acc[2][2];
  acc_zero(acc);
  gemm_main((const u16*)(P.ws + OFF_YB) + (size_t)m0 * 512, 512, (const u16*)(P.ws + OFF_WT_GLU) + (size_t)n0 * 512, 512, 512, acc, (u16*)lds);
  TILE_COORDS
  u16* YG = (u16*)(P.ws + OFF_YG);
  {
    const int oc = nt * 64 + wn_ * 32 + fr_;
    const float bv = P.b_glu[oc], bg = P.b_glu[512 + oc];
#pragma unroll
    for (int i = 0; i < 2; ++i)
#pragma unroll
      for (int e = 0; e < 16; ++e) {
        const float val = acc[i][0][e] + bv, gt = acc[i][1][e] + bg;
        YG[TIDX2(m0, nt * 64 + wn_ * 32, i, e, 512)] = f2bf(val * sigm(gt));
      }
  }
}

__device__ __forceinline__ void gates_tile(const Params& P, int t, char* lds) {
  const int nt = t >> 6, mt = t & 63;
  const int m0 = mt * 256, n0 = nt * 128;
  f32x16 acc[2][2];
  acc_zero(acc);
  gemm_main((const u16*)(P.ws + OFF_R2) + (size_t)m0 * 1024, 1024, (const u16*)(P.ws + OFF_WT_IN) + (size_t)(2688 + n0) * 1024, 1024, 1024, acc, (u16*)lds);
  TILE_COORDS
  u16* SG = (u16*)(P.ws + OFF_SG);
#pragma unroll
  for (int i = 0; i < 2; ++i)
#pragma unroll
    for (int j = 0; j < 2; ++j)
#pragma unroll
      for (int e = 0; e < 16; ++e) SG[TIDX(m0, n0, i, j, e, 2048)] = f2bf(sigm(acc[i][j][e]));
}

__device__ __forceinline__ void mix_tile(const Params& P, int t, char* lds) {
  const int nt = t >> 6, mt = t & 63;
  const int m0 = mt * 256, n0 = nt * 128;
  const u16* SG = (const u16*)(P.ws + OFF_SG);
  f32x16 acc[2][2];
  u16* MIX = (u16*)(P.ws + OFF_MIX);
  acc_zero(acc);
  gemm_main((const u16*)(P.ws + OFF_YA) + (size_t)m0 * 512, 512, (const u16*)(P.ws + OFF_WT_AOUT) + (size_t)n0 * 512, 512, 512, acc, (u16*)lds);
  {
    TILE_COORDS
    u16 sv[2][2][16];
#pragma unroll
    for (int i = 0; i < 2; ++i)
#pragma unroll
      for (int j = 0; j < 2; ++j)
#pragma unroll
        for (int e = 0; e < 16; ++e) sv[i][j][e] = SG[TIDX(m0, n0, i, j, e, 2048)];
#pragma unroll
    for (int i = 0; i < 2; ++i)
#pragma unroll
      for (int j = 0; j < 2; ++j)
#pragma unroll
        for (int e = 0; e < 16; ++e) MIX[TIDX(m0, n0, i, j, e, 1024)] = f2bf(bf2f(sv[i][j][e]) * acc[i][j][e]);
  }
  acc_zero(acc);
  gemm_main((const u16*)(P.ws + OFF_YG) + (size_t)m0 * 512, 512, (const u16*)(P.ws + OFF_WT_BOUT) + (size_t)n0 * 512, 512, 512, acc, (u16*)lds);
  {
    TILE_COORDS
#pragma unroll
    for (int i = 0; i < 2; ++i) {
      u16 sv[2][16], pv[2][16];
#pragma unroll
      for (int j = 0; j < 2; ++j)
#pragma unroll
        for (int e = 0; e < 16; ++e) {
          sv[j][e] = SG[TIDX(m0, n0, i, j, e, 2048) + 1024];
          pv[j][e] = MIX[TIDX(m0, n0, i, j, e, 1024)];
        }
#pragma unroll
      for (int j = 0; j < 2; ++j)
#pragma unroll
        for (int e = 0; e < 16; ++e)
          MIX[TIDX(m0, n0, i, j, e, 1024)] = f2bf(bf2f(pv[j][e]) + bf2f(sv[j][e]) * acc[i][j][e]);
    }
  }
}

__device__ __forceinline__ void wo_tile(const Params& P, int t, char* lds) {
  const int nt = t >> 6, mt = t & 63;
  const int m0 = mt * 256, n0 = nt * 128;
  f32x16 acc[2][2];
  acc_zero(acc);
  gemm_main((const u16*)(P.ws + OFF_MIX) + (size_t)m0 * 1024, 1024, (const u16*)(P.ws + OFF_WT_O) + (size_t)n0 * 1024, 1024, 1024, acc, (u16*)lds);
  TILE_COORDS
  const float* MOD = (const float*)(P.ws + OFF_MOD) + (m0 >> 12) * 6144 + 2 * 1024;
  float xv[2][2][16];
#pragma unroll
  for (int j = 0; j < 2; ++j)
#pragma unroll
    for (int i = 0; i < 2; ++i)
#pragma unroll
      for (int e = 0; e < 16; ++e) xv[i][j][e] = P.x[TIDX(m0, n0, i, j, e, 1024)];
#pragma unroll
  for (int j = 0; j < 2; ++j) {
    const int col = TCOL(n0, j);
    const float gate = MOD[col];
#pragma unroll
    for (int i = 0; i < 2; ++i)
#pragma unroll
      for (int e = 0; e < 16; ++e) P.out[TIDX(m0, n0, i, j, e, 1024)] = xv[i][j][e] + gate * acc[i][j][e];
  }
}

__device__ __forceinline__ void norm2_item(const Params& P, int item) {
  const int lane = opq(threadIdx.x) & 63, w = opq(threadIdx.x) >> 6;
  const int rowA = item * 16 + w, rowB = rowA + 8;
  const float* MA = (const float*)(P.ws + OFF_MOD) + (rowA >> 12) * 6144;
  const float* MB = (const float*)(P.ws + OFF_MOD) + (rowB >> 12) * 6144;
  u16* H = (u16*)(P.ws + OFF_R2);
  norm_row2(P.out + (size_t)rowA * 1024, P.out + (size_t)rowB * 1024, P.norm2_w, MA + 3 * 1024, MA + 4 * 1024, MB + 3 * 1024, MB + 4 * 1024,
            H + (size_t)rowA * 1024, H + (size_t)rowB * 1024, lane);
}

__device__ __forceinline__ void up_tile(const Params& P, int t, int hh, char* lds) {
  const int nt = t >> 6, mt = t & 63;
  const int m0 = mt * 256, n0 = nt * 128;
  f32x16 acc[2][2];
  acc_zero(acc);
  gemm_main((const u16*)(P.ws + OFF_R2) + (size_t)m0 * 1024, 1024,
            (const u16*)(P.ws + OFF_WT_UP) + ((size_t)hh * 2816 + n0) * 1024, 1024, 1024, acc, (u16*)lds);
  TILE_COORDS
  u16* UPH = (u16*)(P.ws + OFF_UPH);
#pragma unroll
  for (int i = 0; i < 2; ++i)
#pragma unroll
    for (int j = 0; j < 2; ++j)
#pragma unroll
      for (int e = 0; e < 16; ++e) UPH[TIDX(m0, n0, i, j, e, 2816)] = f2bf(acc[i][j][e]);
}

#define CG_LD(ci, dy)                                                                       \
    {                                                                                       \
      const int xc = x0 - 1 + (ci);                                                         \
      const bool cok = (xc >= 0) && (xc <= 63);                                             \
      const bool rok = ((dy) == 1) || ((dy) == 0 ? r0ok : r2ok);                            \
      const int yy = rok ? (y + (dy) - 1) : y;                                              \
      const u16* src = UPH + (base + (size_t)yy * 64 + (cok ? xc : x0)) * 2816 + c4 * 2;    \
      const uint4 q__ = *(const uint4*)src;               \
      uint2 g__ = make_uint2(q__.x, q__.y);                                                 \
      uint2 v__ = make_uint2(q__.z, q__.w);                                                 \
      const bool ok = cok && rok;                                                           \
      g__.x = ok ? g__.x : 0u; g__.y = ok ? g__.y : 0u;                                     \
      v__.x = ok ? v__.x : 0u; v__.y = ok ? v__.y : 0u;                                     \
      gg[ci][dy] = g__; vv[ci][dy] = v__;                                                   \
    }
__device__ __forceinline__ void convgate_phase(const Params& P, int hh) {
  const int tid = opq(threadIdx.x);
  if (tid >= 352) return;
  const int c4 = tid * 4;
  const u16* UPH = (const u16*)(P.ws + OFF_UPH);
  u16* G = (u16*)(P.ws + OFF_G);
  float wg[9][4], wv[9][4];
#pragma unroll
  for (int k = 0; k < 9; ++k) {
    const float4 a = *(const float4*)(P.ffn_conv_w + (size_t)k * 5632 + hh * 1408 + c4);
    const float4 bq = *(const float4*)(P.ffn_conv_w + (size_t)k * 5632 + 2816 + hh * 1408 + c4);
    wg[k][0] = a.x; wg[k][1] = a.y; wg[k][2] = a.z; wg[k][3] = a.w;
    wv[k][0] = bq.x; wv[k][1] = bq.y; wv[k][2] = bq.z; wv[k][3] = bq.w;
  }
  for (int item = blockIdx.x; item < 4096; item += gridDim.x) {
  const int xo = item & 15, y = (item >> 4) & 63, b = item >> 10;
  const size_t base = (size_t)b * 4096;
  const bool r0ok = (y > 0), r2ok = (y < 63);
  const int x0 = xo * 4;
  uint2 gg[6][3], vv[6][3];
#pragma unroll
  for (int ci = 0; ci < 6; ++ci) {
    CG_LD(ci, 0)
    CG_LD(ci, 1)
    CG_LD(ci, 2)
  }
#pragma unroll
  for (int xx = 0; xx < 4; ++xx) {
    float ag[4] = {0.f, 0.f, 0.f, 0.f}, av[4] = {0.f, 0.f, 0.f, 0.f};
#pragma unroll
    for (int dy = 0; dy < 3; ++dy)
#pragma unroll
      for (int dx = 0; dx < 3; ++dx) {
        const uint2 gq = gg[xx + dx][dy], vq = vv[xx + dx][dy];
        const int k = dy * 3 + dx;
        ag[0] += wg[k][0] * lo16(gq.x); ag[1] += wg[k][1] * hi16(gq.x); ag[2] += wg[k][2] * lo16(gq.y); ag[3] += wg[k][3] * hi16(gq.y);
        av[0] += wv[k][0] * lo16(vq.x); av[1] += wv[k][1] * hi16(vq.x); av[2] += wv[k][2] * lo16(vq.y); av[3] += wv[k][3] * hi16(vq.y);
      }
    uint2 o;
    o.x = pack2(ag[0] * sigm(ag[0]) * av[0], ag[1] * sigm(ag[1]) * av[1]);
    o.y = pack2(ag[2] * sigm(ag[2]) * av[2], ag[3] * sigm(ag[3]) * av[3]);
    *(uint2*)(G + (base + y * 64 + x0 + xx) * 2816 + hh * 1408 + c4) = o;
  }
  }
}
#undef CG_LD

__device__ __forceinline__ void down_tile(const Params& P, int t, char* lds) {
  const int nt = t >> 6, mt = t & 63;
  const int m0 = mt * 256, n0 = nt * 128;
  f32x16 acc[2][2];
  acc_zero(acc);
  gemm_main((const u16*)(P.ws + OFF_G) + (size_t)m0 * 2816, 2816, (const u16*)(P.ws + OFF_WT_DOWN) + (size_t)n0 * 2816, 2816, 2816, acc, (u16*)lds);
  TILE_COORDS
  const float* MOD = (const float*)(P.ws + OFF_MOD) + (m0 >> 12) * 6144 + 5 * 1024;
  float xv[2][2][16];
#pragma unroll
  for (int j = 0; j < 2; ++j)
#pragma unroll
    for (int i = 0; i < 2; ++i)
#pragma unroll
      for (int e = 0; e < 16; ++e) xv[i][j][e] = P.out[TIDX(m0, n0, i, j, e, 1024)];
#pragma unroll
  for (int j = 0; j < 2; ++j) {
    const int col = TCOL(n0, j);
    const float gate = MOD[col];
#pragma unroll
    for (int i = 0; i < 2; ++i)
#pragma unroll
      for (int e = 0; e < 16; ++e) P.out[TIDX(m0, n0, i, j, e, 1024)] = xv[i][j][e] + gate * acc[i][j][e];
  }
}

__device__ __forceinline__ void final_item(const Params& P, int item) {
  const int lane = opq(threadIdx.x) & 63, w = opq(threadIdx.x) >> 6;
  const int row = item * 8 + w;
  float* xr = P.out + (size_t)row * 1024;
  float4 v[4];
  float ss = 0.f;
#pragma unroll
  for (int it = 0; it < 4; ++it) {
    v[it] = *(const float4*)(xr + (it * 64 + lane) * 4);
    ss += v[it].x * v[it].x + v[it].y * v[it].y + v[it].z * v[it].z + v[it].w * v[it].w;
  }
  ss = wsum64(ss);
  const float rstd = rsqrtf(ss * (1.f / 1024.f) + 1e-6f);
#pragma unroll
  for (int it = 0; it < 4; ++it) {
    const int c = (it * 64 + lane) * 4;
    const float4 w4 = *(const float4*)(P.norm_f_w + c);
    float4 o;
    o.x = v[it].x * rstd * w4.x; o.y = v[it].y * rstd * w4.y; o.z = v[it].z * rstd * w4.z; o.w = v[it].w * rstd * w4.w;
    *(float4*)(xr + c) = o;
  }
}

__device__ __forceinline__ void run_phase(const Params& P, int ph, char* lds) {
  const int bid = blockIdx.x, nb = gridDim.x;
#ifdef ONLY_PHASE
  if (ph != ONLY_PHASE) return;
#endif
  switch (ph) {
    case 0: {
      for (int it = bid; it < 984 + 192 + 2048; it += nb) {
        if (it < 296) convert_item(P.w_in, 1024, 4624, (u16*)(P.ws + OFF_WT_IN), 0, it, lds);
        else if (it < 328) convert_item(P.w_a_out, 512, 1024, (u16*)(P.ws + OFF_WT_AOUT), 1, it - 296, lds);
        else if (it < 360) convert_item(P.w_glu, 512, 1024, (u16*)(P.ws + OFF_WT_GLU), 2, it - 328, lds);
        else if (it < 392) convert_item(P.w_b_out, 512, 1024, (u16*)(P.ws + OFF_WT_BOUT), 3, it - 360, lds);
        else if (it < 456) convert_item(P.w_o, 1024, 1024, (u16*)(P.ws + OFF_WT_O), 4, it - 392, lds);
        else if (it < 808) convert_item(P.w_up, 1024, 5632, (u16*)(P.ws + OFF_WT_UP), 5, it - 456, lds);
        else if (it < 984) convert_item(P.w_down, 2816, 1024, (u16*)(P.ws + OFF_WT_DOWN), 6, it - 808, lds);
        else if (it < 1176) mod_item(P, it - 984, lds);
        else s5tab_item(P, it - 1176, lds);
      }
    } break;
    case 1:
      for (int it = bid; it < 1088 + 2048; it += nb) {
        if (it < 1088) norm1_item(P, it); else mintra_item(P, it - 1088);
      }
      break;
    case 2:
      for (int it = bid; it < 1396; it += nb) inproj_tile(P, it, lds);
      break;
    case 3:
      for (int it = bid; it < 1088 + 192; it += nb) {
        if (it < 1088) delta_prep_item(P, it, lds); else s5end_tile(P, it - 1088, lds);
      }
      break;
    case 4:
      if (bid < 128) delta_scan_block(P, bid, lds);
      else if (bid < 160) s5_carry_block(P, bid - 128);
      break;
    case 5:
      for (int it = bid; it < 256 + 2048 + 1024; it += nb) {
        if (it < 256) s5out_tile(P, it, lds);
        else if (it < 2304) delta_post_item(P, it - 256);
        else norm1_item(P, it - 2304);
      }
      break;
    case 6:
      for (int it = bid; it < 512 + 1024; it += nb) {
        if (it < 512) glu_tile(P, it, lds); else gates_tile(P, it - 512, lds);
      }
      break;
    case 7:
      for (int it = bid; it < 512; it += nb) mix_tile(P, it, lds);
      break;
    case 8:
      for (int it = bid; it < 512; it += nb) wo_tile(P, it, lds);
      break;
    case 9:
      for (int it = bid; it < 1024; it += nb) norm2_item(P, it);
      break;
    case 10:
      for (int it = bid; it < 1408; it += nb) up_tile(P, it, 0, lds);
      break;
    case 11:
      convgate_phase(P, 0);
      break;
    case 12:
      for (int it = bid; it < 1408; it += nb) up_tile(P, it, 1, lds);
      break;
    case 13:
      convgate_phase(P, 1);
      break;
    case 14:
      for (int it = bid; it < 512; it += nb) down_tile(P, it, lds);
      break;
    case 15:
      for (int it = bid; it < 2048; it += nb) final_item(P, it);
      break;
    default: break;
  }
}

typedef const __attribute__((address_space(4))) Params* KParamsPtr;
__global__ void __launch_bounds__(NT) fwd_megakernel(Params Pk) {
#if defined(__HIP_DEVICE_COMPILE__)
  extern __shared__ __attribute__((aligned(16))) char lds[];
  KParamsPtr pp = (KParamsPtr)__builtin_amdgcn_kernarg_segment_ptr();
  const int lo = (int)pp->ph_lo, hi = (int)pp->ph_hi;
#if MULTI_LAUNCH
  for (int ph = lo; ph < hi; ++ph) { KParamsPtr q = pp; asm volatile("" : "+s"(q)); Params P; for (int i_ = 0; i_ < (int)(sizeof(Params) / 8); ++i_) ((unsigned long long*)&P)[i_] = ((const __attribute__((address_space(4))) unsigned long long*)q)[i_]; run_phase(P, ph, lds); }
#else
  cg::grid_group grid = cg::this_grid();
  volatile LAS unsigned* xst = (volatile LAS unsigned*)(lds + (LDS_BYTES - 16));
  if (threadIdx.x == 0) { xst[0] = 0u; xst[1] = 0u; xst[2] = 0u; xst[3] = 0u; }
  __syncthreads();
  XcdBarrier xb = xcd_barrier_post((unsigned*)(pp->ws + OFF_BAR), xst);
  const unsigned rep_mask = (unsigned)pp->rep_mask;
  bool first_sync = true;
  for (int ph = lo; ph < hi; ++ph) {
    const int reps = 1 + (int)((rep_mask >> ph) & 1u);
    for (int rp = 0; rp < reps; ++rp) {
      {
        KParamsPtr q = pp;
        asm volatile("" : "+s"(q));
        Params P;
        {
          typedef __attribute__((address_space(1))) const float* GF;
          const float** dp = (const float**)&P;
          const __attribute__((address_space(4))) unsigned long long* sp = (const __attribute__((address_space(4))) unsigned long long*)q;
#pragma unroll
          for (int i_ = 0; i_ < 30; ++i_) dp[i_] = (const float*)(GF)(sp[i_]);
          P.out = (float*)(__attribute__((address_space(1))) float*)(sp[30]);
          P.ws = (char*)(__attribute__((address_space(1))) char*)(sp[31]);
          P.ph_lo = 0; P.ph_hi = 0; P.rep_mask = 0;
        }
        run_phase(P, ph, lds);
      }
      if (ph + 1 < hi || rp + 1 < reps) {
        if (first_sync) { grid.sync(); first_sync = false; }
        else xcd_barrier(xb);
      }
    }
  }
#endif
#endif
}

extern "C" void kernel_launch(void* const* d_in, const int* in_sizes, int n_in, void* d_out, int out_size, void* d_ws,
                              size_t ws_size, hipStream_t stream) {
  static int grid_blocks = 0;
  if (grid_blocks == 0) {
    if (n_in != 30 || out_size != 16384 * 1024 || ws_size < WS_NEED) {
      fprintf(stderr, "kernel_launch: unexpected shapes: n_in %d out %d ws %zu (need %zu)\n", n_in, out_size, ws_size, (size_t)WS_NEED);
      grid_blocks = -1;
      return;
    }
    int dev = 0, cus = 0, per_cu = 0;
    hipGetDevice(&dev);
    hipDeviceGetAttribute(&cus, hipDeviceAttributeMultiprocessorCount, dev);
    if (hipFuncSetAttribute((const void*)fwd_megakernel, hipFuncAttributeMaxDynamicSharedMemorySize, LDS_BYTES) != hipSuccess) {
      fprintf(stderr, "kernel_launch: hipFuncSetAttribute failed\n");
      grid_blocks = -1;
      return;
    }
    if (hipOccupancyMaxActiveBlocksPerMultiprocessor(&per_cu, (const void*)fwd_megakernel, NT, LDS_BYTES) != hipSuccess || per_cu < 1) {
      fprintf(stderr, "kernel_launch: occupancy query failed / zero (%d)\n", per_cu);
      grid_blocks = -1;
      return;
    }
    grid_blocks = cus;
    if (grid_blocks < 64) { fprintf(stderr, "kernel_launch: too few CUs (%d)\n", cus); grid_blocks = -1; return; }
  }
  if (grid_blocks < 0) return;
  (void)hipMemsetAsync((char*)d_ws + OFF_BAR, 0, XCD_BAR_WORDS * sizeof(unsigned), stream);
  Params p{};
  const float** pp = (const float**)&p;
  for (int i = 0; i < 30; ++i) pp[i] = (const float*)d_in[i];
  p.out = (float*)d_out;
  p.ws = (char*)d_ws;
#if MULTI_LAUNCH
  for (int ph = 0; ph < 16; ++ph) {
    p.ph_lo = ph; p.ph_hi = ph + 1;
    hipLaunchKernelGGL(fwd_megakernel, dim3(grid_blocks), dim3(NT), LDS_BYTES, stream, p);
  }
#else
  p.ph_lo = 0; p.ph_hi = 16;
#ifdef REPEAT_MASK
  p.rep_mask = REPEAT_MASK;
#endif
  void* args[] = {&p};
  hipError_t e = hipLaunchCooperativeKernel((const void*)fwd_megakernel, dim3(grid_blocks), dim3(NT), args, LDS_BYTES, stream);
  if (e != hipSuccess) fprintf(stderr, "cooperative launch failed: %s (grid %d)\n", hipGetErrorString(e), grid_blocks);
#endif
}
```

```cpp
#include <hip/hip_runtime.h>
#include <hip/hip_cooperative_groups.h>
#include <cstdio>
#include <cstdint>
namespace cg = cooperative_groups;

#ifndef MULTI_LAUNCH
#define MULTI_LAUNCH 0
#endif

typedef unsigned short u16;
typedef __attribute__((ext_vector_type(8))) short bf16x8;
typedef __attribute__((ext_vector_type(4))) float f32x4;
typedef __attribute__((ext_vector_type(16))) float f32x16;
typedef __attribute__((ext_vector_type(4))) unsigned int u32x4;
typedef __attribute__((ext_vector_type(2))) unsigned int u32x2;

#define NT 512
constexpr int LDS_BYTES = 131072 + 1024;
constexpr int NPHASE = 18;

constexpr size_t OFF_WT_IN   = 0;
constexpr size_t OFF_WT_AOUT = 9699328;
constexpr size_t OFF_WT_GLU  = 10747904;
constexpr size_t OFF_WT_BOUT = 11796480;
constexpr size_t OFF_WT_O    = 12845056;
constexpr size_t OFF_WT_UP   = 14942208;
constexpr size_t OFF_WT_DOWN = 26476544;
constexpr size_t OFF_MOD     = 32243712;
constexpr size_t OFF_BAR     = 32505856;
constexpr size_t OFF_R2      = 33554432;
constexpr size_t OFF_R1      = 69206016;
constexpr size_t OFF_KTAB    = OFF_R1;
constexpr size_t OFF_MEND    = OFF_R1 + 2097152;
constexpr size_t OFF_MST     = OFF_R1 + 10485760;
constexpr size_t OFF_MINTRA  = OFF_R1 + 18874368;
constexpr size_t OFF_R3      = 104857600;
constexpr size_t OFF_O       = OFF_R3;
constexpr size_t OFF_XIN     = OFF_R3 + 33554432;
constexpr size_t OFF_MIX     = 158334976;
constexpr size_t OFF_SG      = OFF_R1;
constexpr size_t OFF_Z       = 158334976;
constexpr size_t OFF_U5      = 175112192;
constexpr size_t OFF_BA      = 192937984;
constexpr size_t OFF_GC      = OFF_BA + 1179648;
constexpr size_t OFF_UF      = 195035136;
constexpr size_t OFF_YA      = OFF_UF;
constexpr size_t OFF_YB      = OFF_UF + 16777216;
constexpr size_t OFF_E       = 230686720;
constexpr size_t OFF_YG      = OFF_E;
constexpr size_t OFF_UPH     = OFF_R1;
constexpr size_t OFF_G       = 161480704;
constexpr size_t WS_NEED     = 253755392;
constexpr size_t OFF_QKN     = 0;
constexpr size_t OFF_AQ      = 35651584;

struct Params {
  const float *x, *c, *ctx, *c_ctx, *w_ada, *b_ada, *norm1_w, *w_in, *dn_conv_w, *dn_a_log, *dn_dt_bias, *dn_norm_w,
      *w_a_out, *s5_a_re, *s5_a_im, *s5_log_step, *s5_b_re, *s5_b_im, *s5_c_re, *s5_c_im, *s5_d, *w_glu, *b_glu,
      *w_b_out, *w_o, *norm2_w, *w_up, *ffn_conv_w, *w_down, *norm_f_w;
  float* out;
  char* ws;
  long long ph_lo, ph_hi;
  long long rep_mask;
};

#define XB_TMO      128
#define XB_XCNT(j)  (256  + 64 * (j))
#define XB_XSUB(j)  (1280 + 64 * (j))
#define XB_XGEN(j)  (2304 + 64 * (j))
#define XB_TOP      3328
#define XB_TOPGEN   3392
#define XCD_BAR_WORDS 3456
#define XB_SPIN_CAP (1u << 18)
#define LAS __attribute__((address_space(3)))

__device__ __forceinline__ unsigned xb_ld(unsigned* p)              { return __hip_atomic_load(p, __ATOMIC_RELAXED, __HIP_MEMORY_SCOPE_AGENT); }
__device__ __forceinline__ unsigned xb_add(unsigned* p, unsigned v) { return __hip_atomic_fetch_add(p, v, __ATOMIC_RELAXED, __HIP_MEMORY_SCOPE_AGENT); }
__device__ __forceinline__ unsigned xb_xcc_id() { return (unsigned)__builtin_amdgcn_s_getreg((3 << 11) | 20) & 0xFu; }
#define XB_SPIN(cond, bar) do { unsigned _sp = 0; while (cond) { __builtin_amdgcn_s_sleep(1); \
    if ((++_sp & 255u) == 0u) { if (xb_ld(&(bar)[XB_TMO])) break; if (_sp > XB_SPIN_CAP) { atomicAdd(&(bar)[XB_TMO], 1u); break; } } } } while (0)

struct XcdBarrier {
    unsigned* bar; unsigned x;
    volatile LAS unsigned* st;
};

__device__ __forceinline__ XcdBarrier xcd_barrier_post(unsigned* bar, volatile LAS unsigned* st) {
    XcdBarrier b; b.bar = bar; b.x = xb_xcc_id(); b.st = st;
    if (threadIdx.x == 0) (void)xb_add(&bar[XB_XCNT(b.x)], 1u);
    return b;
}
__device__ __forceinline__ void xcd_barrier_complete(unsigned* bar, unsigned x, unsigned& nloc, unsigned& nx) {
    const unsigned G = gridDim.x * gridDim.y * gridDim.z;
    unsigned sum, cnt, mine, sp = 0u;
    for (;;) {
        sum = 0u; cnt = 0u; mine = 0u;
#pragma unroll
        for (unsigned j = 0; j < 16; ++j) { const unsigned c = xb_ld(&bar[XB_XCNT(j)]); sum += c; cnt += (c > 0u) ? 1u : 0u; mine = (j == x) ? c : mine; }
        if (sum == G) break;
        __builtin_amdgcn_s_sleep(1);
        if ((++sp & 255u) == 0u) { if (xb_ld(&bar[XB_TMO])) break; if (sp > XB_SPIN_CAP) { atomicAdd(&bar[XB_TMO], 1u); break; } }
    }
    nloc = mine > 0u ? mine : 1u; nx = cnt > 0u ? cnt : 1u;
}

__device__ __forceinline__ void xcd_barrier(const XcdBarrier& b) {
    asm volatile("s_waitcnt vmcnt(0)" ::: "memory");
    __syncthreads();
    if (threadIdx.x == 0) {
        unsigned* bar = b.bar;
        __builtin_amdgcn_s_waitcnt(0);
        unsigned nloc = b.st[0], nx = b.st[1];
        if (nloc == 0u) { xcd_barrier_complete(bar, b.x, nloc, nx); b.st[0] = nloc; b.st[1] = nx; }
        const unsigned old = xb_add(&bar[XB_XSUB(b.x)], 1u);
        const unsigned gen = old / nloc;
        if (old + 1u == (gen + 1u) * nloc) {
            __builtin_amdgcn_fence(__ATOMIC_RELEASE, "agent");
            asm volatile("s_waitcnt vmcnt(0)" ::: "memory");
            const unsigned og = xb_add(&bar[XB_TOP], 1u);
            const unsigned tg = og / nx;
            if (og + 1u == (tg + 1u) * nx) xb_add(&bar[XB_TOPGEN], 1u);
            else XB_SPIN(xb_ld(&bar[XB_TOPGEN]) == tg, bar);
            __builtin_amdgcn_fence(__ATOMIC_ACQUIRE, "agent");
            xb_add(&bar[XB_XGEN(b.x)], 1u);
            asm volatile("s_waitcnt vmcnt(0)" ::: "memory");
        } else {
            XB_SPIN(xb_ld(&bar[XB_XGEN(b.x)]) == gen, bar);
            __builtin_amdgcn_fence(__ATOMIC_ACQUIRE, "agent");
            asm volatile("s_waitcnt vmcnt(0)" ::: "memory");
        }
    }
    __syncthreads();
}


typedef __attribute__((ext_vector_type(2))) float f32x2_t;
typedef __attribute__((ext_vector_type(2))) __bf16 bf16x2_t;
__device__ __forceinline__ u16 f2bf(float f) {
  const __bf16 h = (__bf16)f;
  return __builtin_bit_cast(u16, h);
}
__device__ __forceinline__ float bf2f(u16 h) { return __uint_as_float(((uint32_t)h) << 16); }
__device__ __forceinline__ uint32_t pack2(float a, float b) {
  const f32x2_t v = {a, b};
  const bf16x2_t r = __builtin_convertvector(v, bf16x2_t);
  return __builtin_bit_cast(uint32_t, r);
}
__device__ __forceinline__ float lo16(uint32_t w) { return __uint_as_float(w << 16); }
__device__ __forceinline__ float hi16(uint32_t w) { return __uint_as_float(w & 0xffff0000u); }
__device__ __forceinline__ int opq(int v) { asm volatile("" : "+v"(v)); return v; }
__device__ __forceinline__ void lds_barrier() {
  asm volatile("s_waitcnt lgkmcnt(0)" ::: "memory");
  __builtin_amdgcn_s_barrier();
  asm volatile("" ::: "memory");
}
__device__ __forceinline__ float sigm(float x) { return 1.f / (1.f + __expf(-x)); }
__device__ __forceinline__ void unpack8(uint4 v, float* f) {
  f[0] = lo16(v.x); f[1] = hi16(v.x); f[2] = lo16(v.y); f[3] = hi16(v.y);
  f[4] = lo16(v.z); f[5] = hi16(v.z); f[6] = lo16(v.w); f[7] = hi16(v.w);
}
__device__ __forceinline__ uint4 pack8(const float* f) {
  uint4 v; v.x = pack2(f[0], f[1]); v.y = pack2(f[2], f[3]); v.z = pack2(f[4], f[5]); v.w = pack2(f[6], f[7]);
  return v;
}
__device__ __forceinline__ float wsum64(float v) {
#pragma unroll
  for (int o = 32; o > 0; o >>= 1) v += __shfl_xor(v, o, 64);
  return v;
}
__device__ __forceinline__ float gelu_tanh(float x) {
  float u = 0.7978845608028654f * (x + 0.044715f * x * x * x);
  float t = 1.f - 2.f / (1.f + __expf(2.f * u));
  return 0.5f * x * (1.f + t);
}

__device__ __forceinline__ void g_frag(const u16* as, const u16* bs, int ks, bf16x8 (&a)[2], bf16x8 (&b)[2]) {
  a[0] = *(const bf16x8*)(as + ks * 16);
  a[1] = *(const bf16x8*)(as + 32 * 72 + ks * 16);
  b[0] = *(const bf16x8*)(bs + ks * 16);
  b[1] = *(const bf16x8*)(bs + 32 * 72 + ks * 16);
}
__device__ __forceinline__ void g_mma(const bf16x8 (&a)[2], const bf16x8 (&b)[2], f32x16 (&acc)[2][2]) {
  acc[0][0] = __builtin_amdgcn_mfma_f32_32x32x16_bf16(a[0], b[0], acc[0][0], 0, 0, 0);
  acc[0][1] = __builtin_amdgcn_mfma_f32_32x32x16_bf16(a[0], b[1], acc[0][1], 0, 0, 0);
  acc[1][0] = __builtin_amdgcn_mfma_f32_32x32x16_bf16(a[1], b[0], acc[1][0], 0, 0, 0);
  acc[1][1] = __builtin_amdgcn_mfma_f32_32x32x16_bf16(a[1], b[1], acc[1][1], 0, 0, 0);
}
__device__ __forceinline__ void gemm_main(const u16* __restrict__ A, int lda, const u16* __restrict__ Bt, int ldb, int K,
                                          f32x16 (&acc)[2][2], u16* lds) {
  const int tid = opq(threadIdx.x), lane = tid & 63, w = tid >> 6, wm = w >> 1, wn = w & 1, fr = lane & 31, fq = lane >> 5;
  u16* As = lds;
  u16* Bs = lds + 2 * 256 * 72;
  const int nk = K >> 6;
  uint4 p0, p1, p2, p3, p4, p5;
  uint4 q0, q1, q2, q3, q4, q5;
  uint4 r0, r1, r2, r3, r4, r5;
  const int lr = tid >> 3, lc = (tid & 7) * 8;
  const unsigned oa0 = (unsigned)(lr * lda + lc) * 2u, sa2 = (unsigned)lda * 128u;
  const unsigned oa1 = oa0 + sa2, oa2 = oa0 + 2u * sa2, oa3 = oa0 + 3u * sa2;
  const unsigned ob0 = (unsigned)(lr * ldb + lc) * 2u, ob1 = ob0 + (unsigned)ldb * 128u;
#define G_LOAD(S, kt_)                                          \
  {                                                             \
    const int kc_ = ((kt_) < nk) ? (kt_) : (nk - 1);            \
    const char* a_ = (const char*)A + kc_ * 128;                \
    const char* b_ = (const char*)Bt + kc_ * 128;               \
    S##0 = *(const uint4*)(a_ + oa0);                           \
    S##1 = *(const uint4*)(a_ + oa1);                           \
    S##2 = *(const uint4*)(a_ + oa2);                           \
    S##3 = *(const uint4*)(a_ + oa3);                           \
    S##4 = *(const uint4*)(b_ + ob0);                           \
    S##5 = *(const uint4*)(b_ + ob1);                           \
  }
#define G_STORE(S, buf_)                                                     \
  {                                                                          \
    u16* as_ = As + ((buf_) * 256 + lr) * 72 + lc;                           \
    u16* bs_ = Bs + ((buf_) * 128 + lr) * 72 + lc;                           \
    *(uint4*)(as_) = S##0;                                                   \
    *(uint4*)(as_ + 64 * 72) = S##1;                                         \
    *(uint4*)(as_ + 128 * 72) = S##2;                                        \
    *(uint4*)(as_ + 192 * 72) = S##3;                                        \
    *(uint4*)(bs_) = S##4;                                                   \
    *(uint4*)(bs_ + 64 * 72) = S##5;                                         \
  }
#define G_STEP(S, BUF, kt_)                                                               \
  {                                                                                       \
    const u16* as = As + ((BUF) * 256 + wm * 64 + fr) * 72 + fq * 8;                      \
    const u16* bs = Bs + ((BUF) * 128 + wn * 64 + fr) * 72 + fq * 8;                      \
    bf16x8 fa0[2], fb0[2], fa1[2], fb1[2], fa2[2], fb2[2];                                \
    g_frag(as, bs, 0, fa0, fb0);                                                          \
    g_frag(as, bs, 1, fa1, fb1);                                                          \
    __builtin_amdgcn_sched_barrier(0);                                                    \
    G_STORE(S, (BUF) ^ 1)                                                                 \
    G_LOAD(S, (kt_) + 4)                                                                  \
    __builtin_amdgcn_sched_barrier(0);                                                    \
    g_frag(as, bs, 2, fa2, fb2);                                                          \
    __builtin_amdgcn_sched_barrier(0);                                                    \
    g_mma(fa0, fb0, acc);                                                                 \
    __builtin_amdgcn_sched_barrier(0);                                                    \
    g_frag(as, bs, 3, fa0, fb0);                                                          \
    __builtin_amdgcn_sched_barrier(0);                                                    \
    g_mma(fa1, fb1, acc);                                                                 \
    g_mma(fa2, fb2, acc);                                                                 \
    g_mma(fa0, fb0, acc);                                                                 \
    lds_barrier();                                                                      \
  }
  G_LOAD(p, 0)
  lds_barrier();
  G_STORE(p, 0)
  G_LOAD(q, 1)
  G_LOAD(r, 2)
  G_LOAD(p, 3)
  lds_barrier();
  for (int kt = 0; kt < nk; kt += 6) {
    G_STEP(q, 0, kt)
    G_STEP(r, 1, kt + 1)
    if (kt + 2 < nk) {
      G_STEP(p, 0, kt + 2)
      G_STEP(q, 1, kt + 3)
    }
    if (kt + 4 < nk) {
      G_STEP(r, 0, kt + 4)
      G_STEP(p, 1, kt + 5)
    }
  }
#undef G_STEP
#undef G_LOAD
#undef G_STORE
}

__device__ __forceinline__ void acc_zero(f32x16 (&acc)[2][2]) {
#pragma unroll
  for (int i = 0; i < 2; ++i)
#pragma unroll
    for (int j = 0; j < 2; ++j)
#pragma unroll
      for (int e = 0; e < 16; ++e) acc[i][j][e] = 0.f;
}

#define TILE_COORDS                                                                                  \
  const int tid_ = opq(threadIdx.x), lane_ = tid_ & 63, w_ = __builtin_amdgcn_readfirstlane(tid_ >> 6), \
            wm_ = w_ >> 1, wn_ = w_ & 1, fr_ = lane_ & 31, fq_ = lane_ >> 5;
#define TROW(m0, i, e) ((m0) + wm_ * 64 + (i) * 32 + ((e) & 3) + 8 * ((e) >> 2) + 4 * fq_)
#define TCOL(n0, j) ((n0) + wn_ * 64 + (j) * 32 + fr_)
#define TIDX2(m0, cb, i, e, ld) ((size_t)((m0) + wm_ * 64 + (i) * 32 + ((e) & 3) + 8 * ((e) >> 2)) * (ld) + (cb) + (size_t)(unsigned)(4 * fq_ * (ld) + fr_))
#define TIDX(m0, n0, i, j, e, ld) TIDX2(m0, (n0) + wn_ * 64 + (j) * 32, i, e, ld)

__device__ __forceinline__ int srccol(int which, int r) {
  switch (which) {
    case 0:
      if (r < 2048) return r;
      if (r < 2560) return 2064 + (r - 2048);
      if (r < 2576) return 2048 + (r - 2560);
      if (r < 2688) return -1;
      if (r < 3712) return 2576 + (r - 2688);
      return 3600 + (r - 3712);
    case 2: {
      int tile = r >> 7, wn = (r >> 6) & 1, wi = r & 63;
      return (wi < 32) ? (tile * 64 + wn * 32 + wi) : (512 + tile * 64 + wn * 32 + (wi - 32));
    }
    case 5: {
      int hh = r / 2816, cc = r % 2816;
      int grp = cc >> 3, wi = cc & 7;
      return (wi < 4) ? (hh * 1408 + grp * 4 + wi) : (2816 + hh * 1408 + grp * 4 + (wi - 4));
    }
    default: return r;
  }
}

__device__ __forceinline__ void convert_item(const float* __restrict__ src, int K, int N, u16* __restrict__ dst, int which, int item, char* lds) {
  float* tile = (float*)lds;
  const int tid = opq(threadIdx.x);
  const int kb = K >> 8;
  const int r0 = (item / kb) * 64, k0 = (item % kb) * 256;
  lds_barrier();
  {
    const int n4 = (tid & 15) * 4, kk = tid >> 4;
    const int sc = srccol(which, r0 + n4);
    float4 v[8];
#pragma unroll
    for (int it = 0; it < 8; ++it) {
      const int k = kk + 32 * it;
      v[it] = (sc >= 0) ? *(const float4*)(src + (size_t)(k0 + k) * N + sc) : make_float4(0.f, 0.f, 0.f, 0.f);
    }
#pragma unroll
    for (int it = 0; it < 8; ++it) {
      const int k = kk + 32 * it;
      tile[(n4 + 0) * 257 + k] = v[it].x; tile[(n4 + 1) * 257 + k] = v[it].y;
      tile[(n4 + 2) * 257 + k] = v[it].z; tile[(n4 + 3) * 257 + k] = v[it].w;
    }
  }
  lds_barrier();
  {
    const int ks = (tid & 31) * 8, rr = tid >> 5;
#pragma unroll
    for (int it = 0; it < 4; ++it) {
      const int row = rr + 16 * it;
      float f[8];
#pragma unroll
      for (int e = 0; e < 8; ++e) f[e] = tile[row * 257 + ks + e];
      *(uint4*)(dst + (size_t)(r0 + row) * K + k0 + ks) = pack8(f);
    }
  }
}

__device__ __forceinline__ void mod_item(const Params& P, int item, char* lds) {
  float* sc = (float*)lds;
  float* red = sc + 5 * 1024;
  const int tid = opq(threadIdx.x);
  lds_barrier();
  for (int i = tid; i < 5 * 1024; i += NT) {
    const int r = i >> 10, k = i & 1023;
    float v = (r < 4) ? P.c[r * 1024 + k] : P.c_ctx[k];
    sc[i] = v * sigm(v);
  }
  lds_barrier();
  const int nn = tid & 31, kg = tid >> 5;
  const int n = item * 32 + nn;
  float a0 = 0, a1 = 0, a2 = 0, a3 = 0, a4 = 0;
  for (int kk = 0; kk < 64; ++kk) {
    const int k = kg * 64 + kk;
    const float wv = P.w_ada[(size_t)k * 6144 + n];
    a0 += sc[k] * wv; a1 += sc[1024 + k] * wv; a2 += sc[2048 + k] * wv; a3 += sc[3072 + k] * wv; a4 += sc[4096 + k] * wv;
  }
  red[(kg * 5 + 0) * 32 + nn] = a0; red[(kg * 5 + 1) * 32 + nn] = a1; red[(kg * 5 + 2) * 32 + nn] = a2;
  red[(kg * 5 + 3) * 32 + nn] = a3; red[(kg * 5 + 4) * 32 + nn] = a4;
  lds_barrier();
  if (tid < 160) {
    const int r = tid >> 5, n2 = tid & 31;
    float s = 0.f;
#pragma unroll
    for (int g = 0; g < 16; ++g) s += red[(g * 5 + r) * 32 + n2];
    float* MOD = (float*)(P.ws + OFF_MOD);
    MOD[r * 6144 + item * 32 + n2] = s + P.b_ada[item * 32 + n2];
  }
}

__device__ __forceinline__ void lam_pow(float step, float are, float aim, int e, float& pr, float& pi) {
  const float mag = expf((float)e * step * are);
  double ang = (double)e * (double)step * (double)aim;
  ang -= 6.283185307179586476925 * rint(ang * 0.15915494309189533577);
  float s, c;
  __sincosf((float)ang, &s, &c);
  pr = mag * c; pi = mag * s;
}

__device__ __forceinline__ void s5tab_item(const Params& P, int item, char* lds) {
  const int tid = opq(threadIdx.x);
  const int tq = item & 7, g = (item >> 3) & 31, r = item >> 8;
  float* cfr = (float*)lds;
  float* cfi = cfr + 64;
  float* p0r = cfi + 64;
  float* p0i = p0r + 64;
  float* p1r = p0i + 64;
  float* p1i = p1r + 64;
  float* Gr = p1i + 64;
  float* Gi = Gr + 1024;
  float* Cr = Gi + 1024;
  float* Ci = Cr + 1024;
  const int rg = r * 32 + g;
  u16* MEND = (u16*)(P.ws + OFF_MEND);
  u16* MST = (u16*)(P.ws + OFF_MST);
  float* KTAB = (float*)(P.ws + OFF_KTAB);
  lds_barrier();
  float step = 0.f, are = 0.f, aim = 0.f;
  if (tid < 64) {
    const int n = tid;
    step = expf(P.s5_log_step[rg]);
    are = P.s5_a_re[rg * 64 + n]; aim = P.s5_a_im[rg * 64 + n];
    const float za = step * are;
    double zb = (double)step * (double)aim;
    zb -= 6.283185307179586476925 * rint(zb * 0.15915494309189533577);
    float sb, cb, sh, ch;
    __sincosf((float)zb, &sb, &cb);
    __sincosf((float)(0.5 * zb), &sh, &ch);
    const float em1 = expm1f(za);
    const float re1 = em1 * cb - 2.f * sh * sh;
    const float im1 = (1.f + em1) * sb;
    const float den = are * are + aim * aim;
    cfr[n] = (re1 * are + im1 * aim) / den;
    cfi[n] = (im1 * are - re1 * aim) / den;
  }
  for (int i = tid; i < 1024; i += NT) {
    Cr[i] = P.s5_c_re[(size_t)rg * 1024 + i];
    Ci[i] = P.s5_c_im[(size_t)rg * 1024 + i];
  }
  const float br0 = P.s5_b_re[(size_t)rg * 1024 + tid], bi0 = P.s5_b_im[(size_t)rg * 1024 + tid];
  const float br1 = P.s5_b_re[(size_t)rg * 1024 + 512 + tid], bi1 = P.s5_b_im[(size_t)rg * 1024 + 512 + tid];
  for (int t4 = 0; t4 < 4; ++t4) {
    const int tau = tq * 4 + t4;
    if (tid < 64) {
      float pr, pi;
      lam_pow(step, are, aim, tau, pr, pi);
      p0r[tid] = pr; p0i[tid] = pi;
      lam_pow(step, are, aim, tau + 1, pr, pi);
      p1r[tid] = pr; p1i[tid] = pi;
    }
    lds_barrier();
    {
      const int i0 = tid, n0 = i0 >> 4;
      float tr = cfr[n0] * br0 - cfi[n0] * bi0, ti = cfr[n0] * bi0 + cfi[n0] * br0;
      Gr[i0] = p0r[n0] * tr - p0i[n0] * ti;
      Gi[i0] = p0r[n0] * ti + p0i[n0] * tr;
      const int i1 = tid + 512, n1 = i1 >> 4;
      tr = cfr[n1] * br1 - cfi[n1] * bi1; ti = cfr[n1] * bi1 + cfi[n1] * br1;
      Gr[i1] = p0r[n1] * tr - p0i[n1] * ti;
      Gi[i1] = p0r[n1] * ti + p0i[n1] * tr;
    }
    lds_barrier();
    {
      const int ii = (r == 0) ? (31 - tau) : tau;
      for (int i = tid; i < 2048; i += NT) {
        const int part = i >> 10, n = (i >> 4) & 63, pi_ = i & 15;
        const float v = part ? Gi[n * 16 + pi_] : Gr[n * 16 + pi_];
        MEND[((size_t)g * 256 + r * 128 + part * 64 + n) * 512 + ii * 16 + pi_] = f2bf(v);
      }
    }
    if (tid < 256) {
      const int po = tid >> 4, pi_ = tid & 15;
      float s = 0.f;
      for (int n = 0; n < 64; ++n) s += Cr[po * 64 + n] * Gr[n * 16 + pi_] - Ci[po * 64 + n] * Gi[n * 16 + pi_];
      KTAB[(((size_t)rg) * 32 + tau) * 256 + tid] = s;
    }
    {
      const int jj = (r == 0) ? tau : (31 - tau);
      for (int i = tid; i < 2048; i += NT) {
        const int po = i >> 7, part = (i >> 6) & 1, n = i & 63;
        const float cr = Cr[po * 64 + n], ci = Ci[po * 64 + n];
        const float v = part ? -(cr * p1i[n] + ci * p1r[n]) : (cr * p1r[n] - ci * p1i[n]);
        MST[((size_t)g * 512 + jj * 16 + po) * 256 + r * 128 + part * 64 + n] = f2bf(v);
      }
    }
    lds_barrier();
  }
}

__device__ __forceinline__ void norm_row(const float* __restrict__ xr, const float* __restrict__ nw, const float* __restrict__ shift,
                                         const float* __restrict__ scale, u16* __restrict__ dst, int lane) {
  float4 v[4];
  float ss = 0.f;
#pragma unroll
  for (int it = 0; it < 4; ++it) {
    v[it] = *(const float4*)(xr + (it * 64 + lane) * 4);
    ss += v[it].x * v[it].x + v[it].y * v[it].y + v[it].z * v[it].z + v[it].w * v[it].w;
  }
  ss = wsum64(ss);
  const float rstd = rsqrtf(ss * (1.f / 1024.f) + 1e-6f);
#pragma unroll
  for (int it = 0; it < 4; ++it) {
    const int c = (it * 64 + lane) * 4;
    const float4 w4 = *(const float4*)(nw + c), sh = *(const float4*)(shift + c), sc = *(const float4*)(scale + c);
    const float y0 = v[it].x * rstd * w4.x * (1.f + sc.x) + sh.x;
    const float y1 = v[it].y * rstd * w4.y * (1.f + sc.y) + sh.y;
    const float y2 = v[it].z * rstd * w4.z * (1.f + sc.z) + sh.z;
    const float y3 = v[it].w * rstd * w4.w * (1.f + sc.w) + sh.w;
    uint2 o; o.x = pack2(y0, y1); o.y = pack2(y2, y3);
    *(uint2*)(dst + c) = o;
  }
}

__device__ __forceinline__ void norm_row2(const float* __restrict__ xa, const float* __restrict__ xb, const float* __restrict__ nw,
                                          const float* __restrict__ shA, const float* __restrict__ scA,
                                          const float* __restrict__ shB, const float* __restrict__ scB,
                                          u16* __restrict__ da, u16* __restrict__ db, int lane) {
  float4 va[4], vb[4];
#pragma unroll
  for (int it = 0; it < 4; ++it) { va[it] = *(const float4*)(xa + (it * 64 + lane) * 4); vb[it] = *(const float4*)(xb + (it * 64 + lane) * 4); }
  float sa = 0.f, sb = 0.f;
#pragma unroll
  for (int it = 0; it < 4; ++it) {
    sa += va[it].x * va[it].x + va[it].y * va[it].y + va[it].z * va[it].z + va[it].w * va[it].w;
    sb += vb[it].x * vb[it].x + vb[it].y * vb[it].y + vb[it].z * vb[it].z + vb[it].w * vb[it].w;
  }
  sa = wsum64(sa); sb = wsum64(sb);
  const float ra = rsqrtf(sa * (1.f / 1024.f) + 1e-6f), rb = rsqrtf(sb * (1.f / 1024.f) + 1e-6f);
#pragma unroll
  for (int it = 0; it < 4; ++it) {
    const int c = (it * 64 + lane) * 4;
    const float4 w4 = *(const float4*)(nw + c);
    const float4 sh = *(const float4*)(shA + c), sc = *(const float4*)(scA + c);
    const float4 sh2 = *(const float4*)(shB + c), sc2 = *(const float4*)(scB + c);
    uint2 o;
    o.x = pack2(va[it].x * ra * w4.x * (1.f + sc.x) + sh.x, va[it].y * ra * w4.y * (1.f + sc.y) + sh.y);
    o.y = pack2(va[it].z * ra * w4.z * (1.f + sc.z) + sh.z, va[it].w * ra * w4.w * (1.f + sc.w) + sh.w);
    *(uint2*)(da + c) = o;
    o.x = pack2(vb[it].x * rb * w4.x * (1.f + sc2.x) + sh2.x, vb[it].y * rb * w4.y * (1.f + sc2.y) + sh2.y);
    o.y = pack2(vb[it].z * rb * w4.z * (1.f + sc2.z) + sh2.z, vb[it].w * rb * w4.w * (1.f + sc2.w) + sh2.w);
    *(uint2*)(db + c) = o;
  }
}

__device__ __forceinline__ void norm1_item(const Params& P, int item) {
  const int lane = opq(threadIdx.x) & 63, w = opq(threadIdx.x) >> 6;
  const int rowA = item * 16 + w, rowB = rowA + 8;
  const float* MOD = (const float*)(P.ws + OFF_MOD);
  const int ba = (rowA < 16384) ? (rowA >> 12) : 4, bb = (rowB < 16384) ? (rowB >> 12) : 4;
  const float* xa = (rowA < 16384) ? (P.x + (size_t)rowA * 1024) : (P.ctx + (size_t)(rowA - 16384) * 1024);
  const float* xb = (rowB < 16384) ? (P.x + (size_t)rowB * 1024) : (P.ctx + (size_t)(rowB - 16384) * 1024);
  u16* H = (u16*)(P.ws + OFF_R2);
  norm_row2(xa, xb, P.norm1_w, MOD + ba * 6144, MOD + ba * 6144 + 1024, MOD + bb * 6144, MOD + bb * 6144 + 1024,
            H + (size_t)rowA * 1024, H + (size_t)rowB * 1024, lane);
}

__device__ __forceinline__ void mintra_item(const Params& P, int item) {
  const int tid = opq(threadIdx.x);
  const int rowg = item * 8 + (tid >> 6);
  const int g = rowg >> 9, nout = rowg & 511, j = nout >> 4, po = nout & 15;
  const int k0 = (tid & 63) * 8, i = k0 >> 4, pi0 = k0 & 15;
  const float* KTAB = (const float*)(P.ws + OFF_KTAB);
  float f[8];
#pragma unroll
  for (int e = 0; e < 8; ++e) f[e] = 0.f;
  if (i <= j) {
    const float* kp = KTAB + (((size_t)(0 * 32 + g)) * 32 + (j - i)) * 256 + po * 16 + pi0;
#pragma unroll
    for (int e = 0; e < 8; ++e) f[e] += kp[e];
  }
  if (i >= j) {
    const float* kp = KTAB + (((size_t)(1 * 32 + g)) * 32 + (i - j)) * 256 + po * 16 + pi0;
#pragma unroll
    for (int e = 0; e < 8; ++e) f[e] += kp[e];
  }
  if (i == j) {
    const float dv = P.s5_d[g * 16 + po];
#pragma unroll
    for (int e = 0; e < 8; ++e) if (pi0 + e == po) f[e] += dv;
  }
  u16* MI = (u16*)(P.ws + OFF_MINTRA);
  *(uint4*)(MI + (size_t)rowg * 512 + k0) = pack8(f);
}

__device__ __forceinline__ void inproj_tile(const Params& P, int t, char* lds) {
  int mt, nt;
  if (t < 1344) { nt = t / 64; mt = t % 64; }
  else {
    const int tt = t - 1344; mt = 64 + (tt & 3);
    const int ni = tt >> 2;
    nt = (ni < 8) ? (4 + ni) : ((ni < 12) ? (16 + ni - 8) : 20);
  }
  const int m0 = mt * 256, n0 = nt * 128;
  f32x16 acc[2][2];
  acc_zero(acc);
  gemm_main((const u16*)(P.ws + OFF_R2) + (size_t)m0 * 1024, 1024, (const u16*)(P.ws + OFF_WT_IN) + (size_t)n0 * 1024, 1024, 1024, acc, (u16*)lds);
  TILE_COORDS
  if (nt < 12) {
    u16* QKV = (u16*)(P.ws + OFF_R3);
#pragma unroll
    for (int i = 0; i < 2; ++i)
#pragma unroll
      for (int j = 0; j < 2; ++j)
#pragma unroll
        for (int e = 0; e < 16; ++e) QKV[TIDX(m0, n0, i, j, e, 1536)] = f2bf(acc[i][j][e]);
  } else if (nt < 16) {
    u16* Z = (u16*)(P.ws + OFF_Z);
#pragma unroll
    for (int i = 0; i < 2; ++i)
#pragma unroll
      for (int j = 0; j < 2; ++j)
#pragma unroll
        for (int e = 0; e < 16; ++e) Z[TIDX(m0, n0, i, j, e, 512) - 1536] = f2bf(acc[i][j][e]);
  } else if (nt < 20) {
    u16* U5 = (u16*)(P.ws + OFF_U5);
#pragma unroll
    for (int i = 0; i < 2; ++i)
#pragma unroll
      for (int j = 0; j < 2; ++j)
#pragma unroll
        for (int e = 0; e < 16; ++e) {
          const int cc = TCOL(n0, j) - 2048;
          U5[((size_t)(cc >> 4) * 17408 + TROW(m0, i, e)) * 16 + (cc & 15)] = f2bf(acc[i][j][e]);
        }
  } else {
    float* BA = (float*)(P.ws + OFF_BA);
#pragma unroll
    for (int i = 0; i < 2; ++i)
#pragma unroll
      for (int j = 0; j < 2; ++j)
#pragma unroll
        for (int e = 0; e < 16; ++e) {
          const int cc = TCOL(n0, j) - 2560;
          if (cc < 16) BA[(size_t)TROW(m0, i, e) * 16 + cc] = acc[i][j][e];
        }
  }
}

__device__ __forceinline__ void solve_elim(float (&sol)[64], const float* Lr) {
  float4 b0a, b0b, b0c, b0d, b1a, b1b, b1c, b1d, b2a, b2b, b2c, b2d;
  b0a = *(const float4*)(Lr + 0); b0b = *(const float4*)(Lr + 4); b0c = *(const float4*)(Lr + 8); b0d = *(const float4*)(Lr + 12);
  b1a = *(const float4*)(Lr + 16); b1b = *(const float4*)(Lr + 20); b1c = *(const float4*)(Lr + 24); b1d = *(const float4*)(Lr + 28);
  b2a = *(const float4*)(Lr + 32); b2b = *(const float4*)(Lr + 36); b2c = *(const float4*)(Lr + 40); b2d = *(const float4*)(Lr + 44);
  __builtin_amdgcn_sched_barrier(0);
  sol[1] -= b0a.y * sol[0]; sol[2] -= b0a.z * sol[0]; sol[3] -= b0a.w * sol[0]; sol[4] -= b0b.x * sol[0]; sol[5] -= b0b.y * sol[0]; sol[6] -= b0b.z * sol[0]; sol[7] -= b0b.w * sol[0]; sol[8] -= b0c.x * sol[0]; sol[9] -= b0c.y * sol[0]; sol[10] -= b0c.z * sol[0]; sol[11] -= b0c.w * sol[0]; sol[12] -= b0d.x * sol[0]; sol[13] -= b0d.y * sol[0]; sol[14] -= b0d.z * sol[0]; sol[15] -= b0d.w * sol[0];
  __builtin_amdgcn_sched_barrier(0);
  b0a = *(const float4*)(Lr + 48); b0b = *(const float4*)(Lr + 52); b0c = *(const float4*)(Lr + 56); b0d = *(const float4*)(Lr + 60);
  __builtin_amdgcn_sched_barrier(0);
  sol[16] -= b1a.x * sol[0]; sol[17] -= b1a.y * sol[0]; sol[18] -= b1a.z * sol[0]; sol[19] -= b1a.w * sol[0]; sol[20] -= b1b.x * sol[0]; sol[21] -= b1b.y * sol[0]; sol[22] -= b1b.z * sol[0]; sol[23] -= b1b.w * sol[0]; sol[24] -= b1c.x * sol[0]; sol[25] -= b1c.y * sol[0]; sol[26] -= b1c.z * sol[0]; sol[27] -= b1c.w * sol[0]; sol[28] -= b1d.x * sol[0]; sol[29] -= b1d.y * sol[0]; sol[30] -= b1d.z * sol[0]; sol[31] -= b1d.w * sol[0];
  __builtin_amdgcn_sched_barrier(0);
  b1a = *(const float4*)(Lr + 64); b1b = *(const float4*)(Lr + 68); b1c = *(const float4*)(Lr + 72); b1d = *(const float4*)(Lr + 76);
  __builtin_amdgcn_sched_barrier(0);
  sol[32] -= b2a.x * sol[0]; sol[33] -= b2a.y * sol[0]; sol[34] -= b2a.z * sol[0]; sol[35] -= b2a.w * sol[0]; sol[36] -= b2b.x * sol[0]; sol[37] -= b2b.y * sol[0]; sol[38] -= b2b.z * sol[0]; sol[39] -= b2b.w * sol[0]; sol[40] -= b2c.x * sol[0]; sol[41] -= b2c.y * sol[0]; sol[42] -= b2c.z * sol[0]; sol[43] -= b2c.w * sol[0]; sol[44] -= b2d.x * sol[0]; sol[45] -= b2d.y * sol[0]; sol[46] -= b2d.z * sol[0]; sol[47] -= b2d.w * sol[0];
  __builtin_amdgcn_sched_barrier(0);
  b2a = *(const float4*)(Lr + 80); b2b = *(const float4*)(Lr + 84); b2c = *(const float4*)(Lr + 88); b2d = *(const float4*)(Lr + 92);
  __builtin_amdgcn_sched_barrier(0);
  sol[48] -= b0a.x * sol[0]; sol[49] -= b0a.y * sol[0]; sol[50] -= b0a.z * sol[0]; sol[51] -= b0a.w * sol[0]; sol[52] -= b0b.x * sol[0]; sol[53] -= b0b.y * sol[0]; sol[54] -= b0b.z * sol[0]; sol[55] -= b0b.w * sol[0]; sol[56] -= b0c.x * sol[0]; sol[57] -= b0c.y * sol[0]; sol[58] -= b0c.z * sol[0]; sol[59] -= b0c.w * sol[0]; sol[60] -= b0d.x * sol[0]; sol[61] -= b0d.y * sol[0]; sol[62] -= b0d.z * sol[0]; sol[63] -= b0d.w * sol[0];
  __builtin_amdgcn_sched_barrier(0);
  b0a = *(const float4*)(Lr + 96); b0b = *(const float4*)(Lr + 100); b0c = *(const float4*)(Lr + 104); b0d = *(const float4*)(Lr + 108);
  __builtin_amdgcn_sched_barrier(0);
  sol[2] -= b1a.z * sol[1]; sol[3] -= b1a.w * sol[1]; sol[4] -= b1b.x * sol[1]; sol[5] -= b1b.y * sol[1]; sol[6] -= b1b.z * sol[1]; sol[7] -= b1b.w * sol[1]; sol[8] -= b1c.x * sol[1]; sol[9] -= b1c.y * sol[1]; sol[10] -= b1c.z * sol[1]; sol[11] -= b1c.w * sol[1]; sol[12] -= b1d.x * sol[1]; sol[13] -= b1d.y * sol[1]; sol[14] -= b1d.z * sol[1]; sol[15] -= b1d.w * sol[1];
  __builtin_amdgcn_sched_barrier(0);
  b1a = *(const float4*)(Lr + 112); b1b = *(const float4*)(Lr + 116); b1c = *(const float4*)(Lr + 120); b1d = *(const float4*)(Lr + 124);
  __builtin_amdgcn_sched_barrier(0);
  sol[16] -= b2a.x * sol[1]; sol[17] -= b2a.y * sol[1]; sol[18] -= b2a.z * sol[1]; sol[19] -= b2a.w * sol[1]; sol[20] -= b2b.x * sol[1]; sol[21] -= b2b.y * sol[1]; sol[22] -= b2b.z * sol[1]; sol[23] -= b2b.w * sol[1]; sol[24] -= b2c.x * sol[1]; sol[25] -= b2c.y * sol[1]; sol[26] -= b2c.z * sol[1]; sol[27] -= b2c.w * sol[1]; sol[28] -= b2d.x * sol[1]; sol[29] -= b2d.y * sol[1]; sol[30] -= b2d.z * sol[1]; sol[31] -= b2d.w * sol[1];
  __builtin_amdgcn_sched_barrier(0);
  b2a = *(const float4*)(Lr + 128); b2b = *(const float4*)(Lr + 132); b2c = *(const float4*)(Lr + 136); b2d = *(const float4*)(Lr + 140);
  __builtin_amdgcn_sched_barrier(0);
  sol[32] -= b0a.x * sol[1]; sol[33] -= b0a.y * sol[1]; sol[34] -= b0a.z * sol[1]; sol[35] -= b0a.w * sol[1]; sol[36] -= b0b.x * sol[1]; sol[37] -= b0b.y * sol[1]; sol[38] -= b0b.z * sol[1]; sol[39] -= b0b.w * sol[1]; sol[40] -= b0c.x * sol[1]; sol[41] -= b0c.y * sol[1]; sol[42] -= b0c.z * sol[1]; sol[43] -= b0c.w * sol[1]; sol[44] -= b0d.x * sol[1]; sol[45] -= b0d.y * sol[1]; sol[46] -= b0d.z * sol[1]; sol[47] -= b0d.w * sol[1];
  __builtin_amdgcn_sched_barrier(0);
  b0a = *(const float4*)(Lr + 144); b0b = *(const float4*)(Lr + 148); b0c = *(const float4*)(Lr + 152); b0d = *(const float4*)(Lr + 156);
  __builtin_amdgcn_sched_barrier(0);
  sol[48] -= b1a.x * sol[1]; sol[49] -= b1a.y * sol[1]; sol[50] -= b1a.z * sol[1]; sol[51] -= b1a.w * sol[1]; sol[52] -= b1b.x * sol[1]; sol[53] -= b1b.y * sol[1]; sol[54] -= b1b.z * sol[1]; sol[55] -= b1b.w * sol[1]; sol[56] -= b1c.x * sol[1]; sol[57] -= b1c.y * sol[1]; sol[58] -= b1c.z * sol[1]; sol[59] -= b1c.w * sol[1]; sol[60] -= b1d.x * sol[1]; sol[61] -= b1d.y * sol[1]; sol[62] -= b1d.z * sol[1]; sol[63] -= b1d.w * sol[1];
  __builtin_amdgcn_sched_barrier(0);
  b1a = *(const float4*)(Lr + 160); b1b = *(const float4*)(Lr + 164); b1c = *(const float4*)(Lr + 168); b1d = *(const float4*)(Lr + 172);
  __builtin_amdgcn_sched_barrier(0);
  sol[3] -= b2a.w * sol[2]; sol[4] -= b2b.x * sol[2]; sol[5] -= b2b.y * sol[2]; sol[6] -= b2b.z * sol[2]; sol[7] -= b2b.w * sol[2]; sol[8] -= b2c.x * sol[2]; sol[9] -= b2c.y * sol[2]; sol[10] -= b2c.z * sol[2]; sol[11] -= b2c.w * sol[2]; sol[12] -= b2d.x * sol[2]; sol[13] -= b2d.y * sol[2]; sol[14] -= b2d.z * sol[2]; sol[15] -= b2d.w * sol[2];
  __builtin_amdgcn_sched_barrier(0);
  b2a = *(const float4*)(Lr + 176); b2b = *(const float4*)(Lr + 180); b2c = *(const float4*)(Lr + 184); b2d = *(const float4*)(Lr + 188);
  __builtin_amdgcn_sched_barrier(0);
  sol[16] -= b0a.x * sol[2]; sol[17] -= b0a.y * sol[2]; sol[18] -= b0a.z * sol[2]; sol[19] -= b0a.w * sol[2]; sol[20] -= b0b.x * sol[2]; sol[21] -= b0b.y * sol[2]; sol[22] -= b0b.z * sol[2]; sol[23] -= b0b.w * sol[2]; sol[24] -= b0c.x * sol[2]; sol[25] -= b0c.y * sol[2]; sol[26] -= b0c.z * sol[2]; sol[27] -= b0c.w * sol[2]; sol[28] -= b0d.x * sol[2]; sol[29] -= b0d.y * sol[2]; sol[30] -= b0d.z * sol[2]; sol[31] -= b0d.w * sol[2];
  __builtin_amdgcn_sched_barrier(0);
  b0a = *(const float4*)(Lr + 192); b0b = *(const float4*)(Lr + 196); b0c = *(const float4*)(Lr + 200); b0d = *(const float4*)(Lr + 204);
  __builtin_amdgcn_sched_barrier(0);
  sol[32] -= b1a.x * sol[2]; sol[33] -= b1a.y * sol[2]; sol[34] -= b1a.z * sol[2]; sol[35] -= b1a.w * sol[2]; sol[36] -= b1b.x * sol[2]; sol[37] -= b1b.y * sol[2]; sol[38] -= b1b.z * sol[2]; sol[39] -= b1b.w * sol[2]; sol[40] -= b1c.x * sol[2]; sol[41] -= b1c.y * sol[2]; sol[42] -= b1c.z * sol[2]; sol[43] -= b1c.w * sol[2]; sol[44] -= b1d.x * sol[2]; sol[45] -= b1d.y * sol[2]; sol[46] -= b1d.z * sol[2]; sol[47] -= b1d.w * sol[2];
  __builtin_amdgcn_sched_barrier(0);
  b1a = *(const float4*)(Lr + 208); b1b = *(const float4*)(Lr + 212); b1c = *(const float4*)(Lr + 216); b1d = *(const float4*)(Lr + 220);
  __builtin_amdgcn_sched_barrier(0);
  sol[48] -= b2a.x * sol[2]; sol[49] -= b2a.y * sol[2]; sol[50] -= b2a.z * sol[2]; sol[51] -= b2a.w * sol[2]; sol[52] -= b2b.x * sol[2]; sol[53] -= b2b.y * sol[2]; sol[54] -= b2b.z * sol[2]; sol[55] -= b2b.w * sol[2]; sol[56] -= b2c.x * sol[2]; sol[57] -= b2c.y * sol[2]; sol[58] -= b2c.z * sol[2]; sol[59] -= b2c.w * sol[2]; sol[60] -= b2d.x * sol[2]; sol[61] -= b2d.y * sol[2]; sol[62] -= b2d.z * sol[2]; sol[63] -= b2d.w * sol[2];
  __builtin_amdgcn_sched_barrier(0);
  b2a = *(const float4*)(Lr + 224); b2b = *(const float4*)(Lr + 228); b2c = *(const float4*)(Lr + 232); b2d = *(const float4*)(Lr + 236);
  __builtin_amdgcn_sched_barrier(0);
  sol[4] -= b0b.x * sol[3]; sol[5] -= b0b.y * sol[3]; sol[6] -= b0b.z * sol[3]; sol[7] -= b0b.w * sol[3]; sol[8] -= b0c.x * sol[3]; sol[9] -= b0c.y * sol[3]; sol[10] -= b0c.z * sol[3]; sol[11] -= b0c.w * sol[3]; sol[12] -= b0d.x * sol[3]; sol[13] -= b0d.y * sol[3]; sol[14] -= b0d.z * sol[3]; sol[15] -= b0d.w * sol[3];
  __builtin_amdgcn_sched_barrier(0);
  b0a = *(const float4*)(Lr + 240); b0b = *(const float4*)(Lr + 244); b0c = *(const float4*)(Lr + 248); b0d = *(const float4*)(Lr + 252);
  __builtin_amdgcn_sched_barrier(0);
  sol[16] -= b1a.x * sol[3]; sol[17] -= b1a.y * sol[3]; sol[18] -= b1a.z * sol[3]; sol[19] -= b1a.w * sol[3]; sol[20] -= b1b.x * sol[3]; sol[21] -= b1b.y * sol[3]; sol[22] -= b1b.z * sol[3]; sol[23] -= b1b.w * sol[3]; sol[24] -= b1c.x * sol[3]; sol[25] -= b1c.y * sol[3]; sol[26] -= b1c.z * sol[3]; sol[27] -= b1c.w * sol[3]; sol[28] -= b1d.x * sol[3]; sol[29] -= b1d.y * sol[3]; sol[30] -= b1d.z * sol[3]; sol[31] -= b1d.w * sol[3];
  __builtin_amdgcn_sched_barrier(0);
  b1a = *(const float4*)(Lr + 256); b1b = *(const float4*)(Lr + 260); b1c = *(const float4*)(Lr + 264); b1d = *(const float4*)(Lr + 268);
  __builtin_amdgcn_sched_barrier(0);
  sol[32] -= b2a.x * sol[3]; sol[33] -= b2a.y * sol[3]; sol[34] -= b2a.z * sol[3]; sol[35] -= b2a.w * sol[3]; sol[36] -= b2b.x * sol[3]; sol[37] -= b2b.y * sol[3]; sol[38] -= b2b.z * sol[3]; sol[39] -= b2b.w * sol[3]; sol[40] -= b2c.x * sol[3]; sol[41] -= b2c.y * sol[3]; sol[42] -= b2c.z * sol[3]; sol[43] -= b2c.w * sol[3]; sol[44] -= b2d.x * sol[3]; sol[45] -= b2d.y * sol[3]; sol[46] -= b2d.z * sol[3]; sol[47] -= b2d.w * sol[3];
  __builtin_amdgcn_sched_barrier(0);
  b2a = *(const float4*)(Lr + 272); b2b = *(const float4*)(Lr + 276); b2c = *(const float4*)(Lr + 280); b2d = *(const float4*)(Lr + 284);
  __builtin_amdgcn_sched_barrier(0);
  sol[48] -= b0a.x * sol[3]; sol[49] -= b0a.y * sol[3]; sol[50] -= b0a.z * sol[3]; sol[51] -= b0a.w * sol[3]; sol[52] -= b0b.x * sol[3]; sol[53] -= b0b.y * sol[3]; sol[54] -= b0b.z * sol[3]; sol[55] -= b0b.w * sol[3]; sol[56] -= b0c.x * sol[3]; sol[57] -= b0c.y * sol[3]; sol[58] -= b0c.z * sol[3]; sol[59] -= b0c.w * sol[3]; sol[60] -= b0d.x * sol[3]; sol[61] -= b0d.y * sol[3]; sol[62] -= b0d.z * sol[3]; sol[63] -= b0d.w * sol[3];
  __builtin_amdgcn_sched_barrier(0);
  b0a = *(const float4*)(Lr + 288); b0b = *(const float4*)(Lr + 292); b0c = *(const float4*)(Lr + 296); b0d = *(const float4*)(Lr + 300);
  __builtin_amdgcn_sched_barrier(0);
  sol[5] -= b1b.y * sol[4]; sol[6] -= b1b.z * sol[4]; sol[7] -= b1b.w * sol[4]; sol[8] -= b1c.x * sol[4]; sol[9] -= b1c.y * sol[4]; sol[10] -= b1c.z * sol[4]; sol[11] -= b1c.w * sol[4]; sol[12] -= b1d.x * sol[4]; sol[13] -= b1d.y * sol[4]; sol[14] -= b1d.z * sol[4]; sol[15] -= b1d.w * sol[4];
  __builtin_amdgcn_sched_barrier(0);
  b1a = *(const float4*)(Lr + 304); b1b = *(const float4*)(Lr + 308); b1c = *(const float4*)(Lr + 312); b1d = *(const float4*)(Lr + 316);
  __builtin_amdgcn_sched_barrier(0);
  sol[16] -= b2a.x * sol[4]; sol[17] -= b2a.y * sol[4]; sol[18] -= b2a.z * sol[4]; sol[19] -= b2a.w * sol[4]; sol[20] -= b2b.x * sol[4]; sol[21] -= b2b.y * sol[4]; sol[22] -= b2b.z * sol[4]; sol[23] -= b2b.w * sol[4]; sol[24] -= b2c.x * sol[4]; sol[25] -= b2c.y * sol[4]; sol[26] -= b2c.z * sol[4]; sol[27] -= b2c.w * sol[4]; sol[28] -= b2d.x * sol[4]; sol[29] -= b2d.y * sol[4]; sol[30] -= b2d.z * sol[4]; sol[31] -= b2d.w * sol[4];
  __builtin_amdgcn_sched_barrier(0);
  b2a = *(const float4*)(Lr + 320); b2b = *(const float4*)(Lr + 324); b2c = *(const float4*)(Lr + 328); b2d = *(const float4*)(Lr + 332);
  __builtin_amdgcn_sched_barrier(0);
  sol[32] -= b0a.x * sol[4]; sol[33] -= b0a.y * sol[4]; sol[34] -= b0a.z * sol[4]; sol[35] -= b0a.w * sol[4]; sol[36] -= b0b.x * sol[4]; sol[37] -= b0b.y * sol[4]; sol[38] -= b0b.z * sol[4]; sol[39] -= b0b.w * sol[4]; sol[40] -= b0c.x * sol[4]; sol[41] -= b0c.y * sol[4]; sol[42] -= b0c.z * sol[4]; sol[43] -= b0c.w * sol[4]; sol[44] -= b0d.x * sol[4]; sol[45] -= b0d.y * sol[4]; sol[46] -= b0d.z * sol[4]; sol[47] -= b0d.w * sol[4];
  __builtin_amdgcn_sched_barrier(0);
  b0a = *(const float4*)(Lr + 336); b0b = *(const float4*)(Lr + 340); b0c = *(const float4*)(Lr + 344); b0d = *(const float4*)(Lr + 348);
  __builtin_amdgcn_sched_barrier(0);
  sol[48] -= b1a.x * sol[4]; sol[49] -= b1a.y * sol[4]; sol[50] -= b1a.z * sol[4]; sol[51] -= b1a.w * sol[4]; sol[52] -= b1b.x * sol[4]; sol[53] -= b1b.y * sol[4]; sol[54] -= b1b.z * sol[4]; sol[55] -= b1b.w * sol[4]; sol[56] -= b1c.x * sol[4]; sol[57] -= b1c.y * sol[4]; sol[58] -= b1c.z * sol[4]; sol[59] -= b1c.w * sol[4]; sol[60] -= b1d.x * sol[4]; sol[61] -= b1d.y * sol[4]; sol[62] -= b1d.z * sol[4]; sol[63] -= b1d.w * sol[4];
  __builtin_amdgcn_sched_barrier(0);
  b1a = *(const float4*)(Lr + 352); b1b = *(const float4*)(Lr + 356); b1c = *(const float4*)(Lr + 360); b1d = *(const float4*)(Lr + 364);
  __builtin_amdgcn_sched_barrier(0);
  sol[6] -= b2b.z * sol[5]; sol[7] -= b2b.w * sol[5]; sol[8] -= b2c.x * sol[5]; sol[9] -= b2c.y * sol[5]; sol[10] -= b2c.z * sol[5]; sol[11] -= b2c.w * sol[5]; sol[12] -= b2d.x * sol[5]; sol[13] -= b2d.y * sol[5]; sol[14] -= b2d.z * sol[5]; sol[15] -= b2d.w * sol[5];
  __builtin_amdgcn_sched_barrier(0);
  b2a = *(const float4*)(Lr + 368); b2b = *(const float4*)(Lr + 372); b2c = *(const float4*)(Lr + 376); b2d = *(const float4*)(Lr + 380);
  __builtin_amdgcn_sched_barrier(0);
  sol[16] -= b0a.x * sol[5]; sol[17] -= b0a.y * sol[5]; sol[18] -= b0a.z * sol[5]; sol[19] -= b0a.w * sol[5]; sol[20] -= b0b.x * sol[5]; sol[21] -= b0b.y * sol[5]; sol[22] -= b0b.z * sol[5]; sol[23] -= b0b.w * sol[5]; sol[24] -= b0c.x * sol[5]; sol[25] -= b0c.y * sol[5]; sol[26] -= b0c.z * sol[5]; sol[27] -= b0c.w * sol[5]; sol[28] -= b0d.x * sol[5]; sol[29] -= b0d.y * sol[5]; sol[30] -= b0d.z * sol[5]; sol[31] -= b0d.w * sol[5];
  __builtin_amdgcn_sched_barrier(0);
  b0a = *(const float4*)(Lr + 384); b0b = *(const float4*)(Lr + 388); b0c = *(const float4*)(Lr + 392); b0d = *(const float4*)(Lr + 396);
  __builtin_amdgcn_sched_barrier(0);
  sol[32] -= b1a.x * sol[5]; sol[33] -= b1a.y * sol[5]; sol[34] -= b1a.z * sol[5]; sol[35] -= b1a.w * sol[5]; sol[36] -= b1b.x * sol[5]; sol[37] -= b1b.y * sol[5]; sol[38] -= b1b.z * sol[5]; sol[39] -= b1b.w * sol[5]; sol[40] -= b1c.x * sol[5]; sol[41] -= b1c.y * sol[5]; sol[42] -= b1c.z * sol[5]; sol[43] -= b1c.w * sol[5]; sol[44] -= b1d.x * sol[5]; sol[45] -= b1d.y * sol[5]; sol[46] -= b1d.z * sol[5]; sol[47] -= b1d.w * sol[5];
  __builtin_amdgcn_sched_barrier(0);
  b1a = *(const float4*)(Lr + 400); b1b = *(const float4*)(Lr + 404); b1c = *(const float4*)(Lr + 408); b1d = *(const float4*)(Lr + 412);
  __builtin_amdgcn_sched_barrier(0);
  sol[48] -= b2a.x * sol[5]; sol[49] -= b2a.y * sol[5]; sol[50] -= b2a.z * sol[5]; sol[51] -= b2a.w * sol[5]; sol[52] -= b2b.x * sol[5]; sol[53] -= b2b.y * sol[5]; sol[54] -= b2b.z * sol[5]; sol[55] -= b2b.w * sol[5]; sol[56] -= b2c.x * sol[5]; sol[57] -= b2c.y * sol[5]; sol[58] -= b2c.z * sol[5]; sol[59] -= b2c.w * sol[5]; sol[60] -= b2d.x * sol[5]; sol[61] -= b2d.y * sol[5]; sol[62] -= b2d.z * sol[5]; sol[63] -= b2d.w * sol[5];
  __builtin_amdgcn_sched_barrier(0);
  b2a = *(const float4*)(Lr + 416); b2b = *(const float4*)(Lr + 420); b2c = *(const float4*)(Lr + 424); b2d = *(const float4*)(Lr + 428);
  __builtin_amdgcn_sched_barrier(0);
  sol[7] -= b0b.w * sol[6]; sol[8] -= b0c.x * sol[6]; sol[9] -= b0c.y * sol[6]; sol[10] -= b0c.z * sol[6]; sol[11] -= b0c.w * sol[6]; sol[12] -= b0d.x * sol[6]; sol[13] -= b0d.y * sol[6]; sol[14] -= b0d.z * sol[6]; sol[15] -= b0d.w * sol[6];
  __builtin_amdgcn_sched_barrier(0);
  b0a = *(const float4*)(Lr + 432); b0b = *(const float4*)(Lr + 436); b0c = *(const float4*)(Lr + 440); b0d = *(const float4*)(Lr + 444);
  __builtin_amdgcn_sched_barrier(0);
  sol[16] -= b1a.x * sol[6]; sol[17] -= b1a.y * sol[6]; sol[18] -= b1a.z * sol[6]; sol[19] -= b1a.w * sol[6]; sol[20] -= b1b.x * sol[6]; sol[21] -= b1b.y * sol[6]; sol[22] -= b1b.z * sol[6]; sol[23] -= b1b.w * sol[6]; sol[24] -= b1c.x * sol[6]; sol[25] -= b1c.y * sol[6]; sol[26] -= b1c.z * sol[6]; sol[27] -= b1c.w * sol[6]; sol[28] -= b1d.x * sol[6]; sol[29] -= b1d.y * sol[6]; sol[30] -= b1d.z * sol[6]; sol[31] -= b1d.w * sol[6];
  __builtin_amdgcn_sched_barrier(0);
  b1a = *(const float4*)(Lr + 448); b1b = *(const float4*)(Lr + 452); b1c = *(const float4*)(Lr + 456); b1d = *(const float4*)(Lr + 460);
  __builtin_amdgcn_sched_barrier(0);
  sol[32] -= b2a.x * sol[6]; sol[33] -= b2a.y * sol[6]; sol[34] -= b2a.z * sol[6]; sol[35] -= b2a.w * sol[6]; sol[36] -= b2b.x * sol[6]; sol[37] -= b2b.y * sol[6]; sol[38] -= b2b.z * sol[6]; sol[39] -= b2b.w * sol[6]; sol[40] -= b2c.x * sol[6]; sol[41] -= b2c.y * sol[6]; sol[42] -= b2c.z * sol[6]; sol[43] -= b2c.w * sol[6]; sol[44] -= b2d.x * sol[6]; sol[45] -= b2d.y * sol[6]; sol[46] -= b2d.z * sol[6]; sol[47] -= b2d.w * sol[6];
  __builtin_amdgcn_sched_barrier(0);
  b2a = *(const float4*)(Lr + 464); b2b = *(const float4*)(Lr + 468); b2c = *(const float4*)(Lr + 472); b2d = *(const float4*)(Lr + 476);
  __builtin_amdgcn_sched_barrier(0);
  sol[48] -= b0a.x * sol[6]; sol[49] -= b0a.y * sol[6]; sol[50] -= b0a.z * sol[6]; sol[51] -= b0a.w * sol[6]; sol[52] -= b0b.x * sol[6]; sol[53] -= b0b.y * sol[6]; sol[54] -= b0b.z * sol[6]; sol[55] -= b0b.w * sol[6]; sol[56] -= b0c.x * sol[6]; sol[57] -= b0c.y * sol[6]; sol[58] -= b0c.z * sol[6]; sol[59] -= b0c.w * sol[6]; sol[60] -= b0d.x * sol[6]; sol[61] -= b0d.y * sol[6]; sol[62] -= b0d.z * sol[6]; sol[63] -= b0d.w * sol[6];
  __builtin_amdgcn_sched_barrier(0);
  b0a = *(const float4*)(Lr + 480); b0b = *(const float4*)(Lr + 484); b0c = *(const float4*)(Lr + 488); b0d = *(const float4*)(Lr + 492);
  __builtin_amdgcn_sched_barrier(0);
  sol[8] -= b1c.x * sol[7]; sol[9] -= b1c.y * sol[7]; sol[10] -= b1c.z * sol[7]; sol[11] -= b1c.w * sol[7]; sol[12] -= b1d.x * sol[7]; sol[13] -= b1d.y * sol[7]; sol[14] -= b1d.z * sol[7]; sol[15] -= b1d.w * sol[7];
  __builtin_amdgcn_sched_barrier(0);
  b1a = *(const float4*)(Lr + 496); b1b = *(const float4*)(Lr + 500); b1c = *(const float4*)(Lr + 504); b1d = *(const float4*)(Lr + 508);
  __builtin_amdgcn_sched_barrier(0);
  sol[16] -= b2a.x * sol[7]; sol[17] -= b2a.y * sol[7]; sol[18] -= b2a.z * sol[7]; sol[19] -= b2a.w * sol[7]; sol[20] -= b2b.x * sol[7]; sol[21] -= b2b.y * sol[7]; sol[22] -= b2b.z * sol[7]; sol[23] -= b2b.w * sol[7]; sol[24] -= b2c.x * sol[7]; sol[25] -= b2c.y * sol[7]; sol[26] -= b2c.z * sol[7]; sol[27] -= b2c.w * sol[7]; sol[28] -= b2d.x * sol[7]; sol[29] -= b2d.y * sol[7]; sol[30] -= b2d.z * sol[7]; sol[31] -= b2d.w * sol[7];
  __builtin_amdgcn_sched_barrier(0);
  b2a = *(const float4*)(Lr + 512); b2b = *(const float4*)(Lr + 516); b2c = *(const float4*)(Lr + 520); b2d = *(const float4*)(Lr + 524);
  __builtin_amdgcn_sched_barrier(0);
  sol[32] -= b0a.x * sol[7]; sol[33] -= b0a.y * sol[7]; sol[34] -= b0a.z * sol[7]; sol[35] -= b0a.w * sol[7]; sol[36] -= b0b.x * sol[7]; sol[37] -= b0b.y * sol[7]; sol[38] -= b0b.z * sol[7]; sol[39] -= b0b.w * sol[7]; sol[40] -= b0c.x * sol[7]; sol[41] -= b0c.y * sol[7]; sol[42] -= b0c.z * sol[7]; sol[43] -= b0c.w * sol[7]; sol[44] -= b0d.x * sol[7]; sol[45] -= b0d.y * sol[7]; sol[46] -= b0d.z * sol[7]; sol[47] -= b0d.w * sol[7];
  __builtin_amdgcn_sched_barrier(0);
  b0a = *(const float4*)(Lr + 528); b0b = *(const float4*)(Lr + 532); b0c = *(const float4*)(Lr + 536); b0d = *(const float4*)(Lr + 540);
  __builtin_amdgcn_sched_barrier(0);
  sol[48] -= b1a.x * sol[7]; sol[49] -= b1a.y * sol[7]; sol[50] -= b1a.z * sol[7]; sol[51] -= b1a.w * sol[7]; sol[52] -= b1b.x * sol[7]; sol[53] -= b1b.y * sol[7]; sol[54] -= b1b.z * sol[7]; sol[55] -= b1b.w * sol[7]; sol[56] -= b1c.x * sol[7]; sol[57] -= b1c.y * sol[7]; sol[58] -= b1c.z * sol[7]; sol[59] -= b1c.w * sol[7]; sol[60] -= b1d.x * sol[7]; sol[61] -= b1d.y * sol[7]; sol[62] -= b1d.z * sol[7]; sol[63] -= b1d.w * sol[7];
  __builtin_amdgcn_sched_barrier(0);
  b1a = *(const float4*)(Lr + 544); b1b = *(const float4*)(Lr + 548); b1c = *(const float4*)(Lr + 552); b1d = *(const float4*)(Lr + 556);
  __builtin_amdgcn_sched_barrier(0);
  sol[9] -= b2c.y * sol[8]; sol[10] -= b2c.z * sol[8]; sol[11] -= b2c.w * sol[8]; sol[12] -= b2d.x * sol[8]; sol[13] -= b2d.y * sol[8]; sol[14] -= b2d.z * sol[8]; sol[15] -= b2d.w * sol[8];
  __builtin_amdgcn_sched_barrier(0);
  b2a = *(const float4*)(Lr + 560); b2b = *(const float4*)(Lr + 564); b2c = *(const float4*)(Lr + 568); b2d = *(const float4*)(Lr + 572);
  __builtin_amdgcn_sched_barrier(0);
  sol[16] -= b0a.x * sol[8]; sol[17] -= b0a.y * sol[8]; sol[18] -= b0a.z * sol[8]; sol[19] -= b0a.w * sol[8]; sol[20] -= b0b.x * sol[8]; sol[21] -= b0b.y * sol[8]; sol[22] -= b0b.z * sol[8]; sol[23] -= b0b.w * sol[8]; sol[24] -= b0c.x * sol[8]; sol[25] -= b0c.y * sol[8]; sol[26] -= b0c.z * sol[8]; sol[27] -= b0c.w * sol[8]; sol[28] -= b0d.x * sol[8]; sol[29] -= b0d.y * sol[8]; sol[30] -= b0d.z * sol[8]; sol[31] -= b0d.w * sol[8];
  __builtin_amdgcn_sched_barrier(0);
  b0a = *(const float4*)(Lr + 576); b0b = *(const float4*)(Lr + 580); b0c = *(const float4*)(Lr + 584); b0d = *(const float4*)(Lr + 588);
  __builtin_amdgcn_sched_barrier(0);
  sol[32] -= b1a.x * sol[8]; sol[33] -= b1a.y * sol[8]; sol[34] -= b1a.z * sol[8]; sol[35] -= b1a.w * sol[8]; sol[36] -= b1b.x * sol[8]; sol[37] -= b1b.y * sol[8]; sol[38] -= b1b.z * sol[8]; sol[39] -= b1b.w * sol[8]; sol[40] -= b1c.x * sol[8]; sol[41] -= b1c.y * sol[8]; sol[42] -= b1c.z * sol[8]; sol[43] -= b1c.w * sol[8]; sol[44] -= b1d.x * sol[8]; sol[45] -= b1d.y * sol[8]; sol[46] -= b1d.z * sol[8]; sol[47] -= b1d.w * sol[8];
  __builtin_amdgcn_sched_barrier(0);
  b1a = *(const float4*)(Lr + 592); b1b = *(const float4*)(Lr + 596); b1c = *(const float4*)(Lr + 600); b1d = *(const float4*)(Lr + 604);
  __builtin_amdgcn_sched_barrier(0);
  sol[48] -= b2a.x * sol[8]; sol[49] -= b2a.y * sol[8]; sol[50] -= b2a.z * sol[8]; sol[51] -= b2a.w * sol[8]; sol[52] -= b2b.x * sol[8]; sol[53] -= b2b.y * sol[8]; sol[54] -= b2b.z * sol[8]; sol[55] -= b2b.w * sol[8]; sol[56] -= b2c.x * sol[8]; sol[57] -= b2c.y * sol[8]; sol[58] -= b2c.z * sol[8]; sol[59] -= b2c.w * sol[8]; sol[60] -= b2d.x * sol[8]; sol[61] -= b2d.y * sol[8]; sol[62] -= b2d.z * sol[8]; sol[63] -= b2d.w * sol[8];
  __builtin_amdgcn_sched_barrier(0);
  b2a = *(const float4*)(Lr + 608); b2b = *(const float4*)(Lr + 612); b2c = *(const float4*)(Lr + 616); b2d = *(const float4*)(Lr + 620);
  __builtin_amdgcn_sched_barrier(0);
  sol[10] -= b0c.z * sol[9]; sol[11] -= b0c.w * sol[9]; sol[12] -= b0d.x * sol[9]; sol[13] -= b0d.y * sol[9]; sol[14] -= b0d.z * sol[9]; sol[15] -= b0d.w * sol[9];
  __builtin_amdgcn_sched_barrier(0);
  b0a = *(const float4*)(Lr + 624); b0b = *(const float4*)(Lr + 628); b0c = *(const float4*)(Lr + 632); b0d = *(const float4*)(Lr + 636);
  __builtin_amdgcn_sched_barrier(0);
  sol[16] -= b1a.x * sol[9]; sol[17] -= b1a.y * sol[9]; sol[18] -= b1a.z * sol[9]; sol[19] -= b1a.w * sol[9]; sol[20] -= b1b.x * sol[9]; sol[21] -= b1b.y * sol[9]; sol[22] -= b1b.z * sol[9]; sol[23] -= b1b.w * sol[9]; sol[24] -= b1c.x * sol[9]; sol[25] -= b1c.y * sol[9]; sol[26] -= b1c.z * sol[9]; sol[27] -= b1c.w * sol[9]; sol[28] -= b1d.x * sol[9]; sol[29] -= b1d.y * sol[9]; sol[30] -= b1d.z * sol[9]; sol[31] -= b1d.w * sol[9];
  __builtin_amdgcn_sched_barrier(0);
  b1a = *(const float4*)(Lr + 640); b1b = *(const float4*)(Lr + 644); b1c = *(const float4*)(Lr + 648); b1d = *(const float4*)(Lr + 652);
  __builtin_amdgcn_sched_barrier(0);
  sol[32] -= b2a.x * sol[9]; sol[33] -= b2a.y * sol[9]; sol[34] -= b2a.z * sol[9]; sol[35] -= b2a.w * sol[9]; sol[36] -= b2b.x * sol[9]; sol[37] -= b2b.y * sol[9]; sol[38] -= b2b.z * sol[9]; sol[39] -= b2b.w * sol[9]; sol[40] -= b2c.x * sol[9]; sol[41] -= b2c.y * sol[9]; sol[42] -= b2c.z * sol[9]; sol[43] -= b2c.w * sol[9]; sol[44] -= b2d.x * sol[9]; sol[45] -= b2d.y * sol[9]; sol[46] -= b2d.z * sol[9]; sol[47] -= b2d.w * sol[9];
  __builtin_amdgcn_sched_barrier(0);
  b2a = *(const float4*)(Lr + 656); b2b = *(const float4*)(Lr + 660); b2c = *(const float4*)(Lr + 664); b2d = *(const float4*)(Lr + 668);
  __builtin_amdgcn_sched_barrier(0);
  sol[48] -= b0a.x * sol[9]; sol[49] -= b0a.y * sol[9]; sol[50] -= b0a.z * sol[9]; sol[51] -= b0a.w * sol[9]; sol[52] -= b0b.x * sol[9]; sol[53] -= b0b.y * sol[9]; sol[54] -= b0b.z * sol[9]; sol[55] -= b0b.w * sol[9]; sol[56] -= b0c.x * sol[9]; sol[57] -= b0c.y * sol[9]; sol[58] -= b0c.z * sol[9]; sol[59] -= b0c.w * sol[9]; sol[60] -= b0d.x * sol[9]; sol[61] -= b0d.y * sol[9]; sol[62] -= b0d.z * sol[9]; sol[63] -= b0d.w * sol[9];
  __builtin_amdgcn_sched_barrier(0);
  b0a = *(const float4*)(Lr + 672); b0b = *(const float4*)(Lr + 676); b0c = *(const float4*)(Lr + 680); b0d = *(const float4*)(Lr + 684);
  __builtin_amdgcn_sched_barrier(0);
  sol[11] -= b1c.w * sol[10]; sol[12] -= b1d.x * sol[10]; sol[13] -= b1d.y * sol[10]; sol[14] -= b1d.z * sol[10]; sol[15] -= b1d.w * sol[10];
  __builtin_amdgcn_sched_barrier(0);
  b1a = *(const float4*)(Lr + 688); b1b = *(const float4*)(Lr + 692); b1c = *(const float4*)(Lr + 696); b1d = *(const float4*)(Lr + 700);
  __builtin_amdgcn_sched_barrier(0);
  sol[16] -= b2a.x * sol[10]; sol[17] -= b2a.y * sol[10]; sol[18] -= b2a.z * sol[10]; sol[19] -= b2a.w * sol[10]; sol[20] -= b2b.x * sol[10]; sol[21] -= b2b.y * sol[10]; sol[22] -= b2b.z * sol[10]; sol[23] -= b2b.w * sol[10]; sol[24] -= b2c.x * sol[10]; sol[25] -= b2c.y * sol[10]; sol[26] -= b2c.z * sol[10]; sol[27] -= b2c.w * sol[10]; sol[28] -= b2d.x * sol[10]; sol[29] -= b2d.y * sol[10]; sol[30] -= b2d.z * sol[10]; sol[31] -= b2d.w * sol[10];
  __builtin_amdgcn_sched_barrier(0);
  b2a = *(const float4*)(Lr + 704); b2b = *(const float4*)(Lr + 708); b2c = *(const float4*)(Lr + 712); b2d = *(const float4*)(Lr + 716);
  __builtin_amdgcn_sched_barrier(0);
  sol[32] -= b0a.x * sol[10]; sol[33] -= b0a.y * sol[10]; sol[34] -= b0a.z * sol[10]; sol[35] -= b0a.w * sol[10]; sol[36] -= b0b.x * sol[10]; sol[37] -= b0b.y * sol[10]; sol[38] -= b0b.z * sol[10]; sol[39] -= b0b.w * sol[10]; sol[40] -= b0c.x * sol[10]; sol[41] -= b0c.y * sol[10]; sol[42] -= b0c.z * sol[10]; sol[43] -= b0c.w * sol[10]; sol[44] -= b0d.x * sol[10]; sol[45] -= b0d.y * sol[10]; sol[46] -= b0d.z * sol[10]; sol[47] -= b0d.w * sol[10];
  __builtin_amdgcn_sched_barrier(0);
  b0a = *(const float4*)(Lr + 720); b0b = *(const float4*)(Lr + 724); b0c = *(const float4*)(Lr + 728); b0d = *(const float4*)(Lr + 732);
  __builtin_amdgcn_sched_barrier(0);
  sol[48] -= b1a.x * sol[10]; sol[49] -= b1a.y * sol[10]; sol[50] -= b1a.z * sol[10]; sol[51] -= b1a.w * sol[10]; sol[52] -= b1b.x * sol[10]; sol[53] -= b1b.y * sol[10]; sol[54] -= b1b.z * sol[10]; sol[55] -= b1b.w * sol[10]; sol[56] -= b1c.x * sol[10]; sol[57] -= b1c.y * sol[10]; sol[58] -= b1c.z * sol[10]; sol[59] -= b1c.w * sol[10]; sol[60] -= b1d.x * sol[10]; sol[61] -= b1d.y * sol[10]; sol[62] -= b1d.z * sol[10]; sol[63] -= b1d.w * sol[10];
  __builtin_amdgcn_sched_barrier(0);
  b1a = *(const float4*)(Lr + 736); b1b = *(const float4*)(Lr + 740); b1c = *(const float4*)(Lr + 744); b1d = *(const float4*)(Lr + 748);
  __builtin_amdgcn_sched_barrier(0);
  sol[12] -= b2d.x * sol[11]; sol[13] -= b2d.y * sol[11]; sol[14] -= b2d.z * sol[11]; sol[15] -= b2d.w * sol[11];
  __builtin_amdgcn_sched_barrier(0);
  b2a = *(const float4*)(Lr + 752); b2b = *(const float4*)(Lr + 756); b2c = *(const float4*)(Lr + 760); b2d = *(const float4*)(Lr + 764);
  __builtin_amdgcn_sched_barrier(0);
  sol[16] -= b0a.x * sol[11]; sol[17] -= b0a.y * sol[11]; sol[18] -= b0a.z * sol[11]; sol[19] -= b0a.w * sol[11]; sol[20] -= b0b.x * sol[11]; sol[21] -= b0b.y * sol[11]; sol[22] -= b0b.z * sol[11]; sol[23] -= b0b.w * sol[11]; sol[24] -= b0c.x * sol[11]; sol[25] -= b0c.y * sol[11]; sol[26] -= b0c.z * sol[11]; sol[27] -= b0c.w * sol[11]; sol[28] -= b0d.x * sol[11]; sol[29] -= b0d.y * sol[11]; sol[30] -= b0d.z * sol[11]; sol[31] -= b0d.w * sol[11];
  __builtin_amdgcn_sched_barrier(0);
  b0a = *(const float4*)(Lr + 768); b0b = *(const float4*)(Lr + 772); b0c = *(const float4*)(Lr + 776); b0d = *(const float4*)(Lr + 780);
  __builtin_amdgcn_sched_barrier(0);
  sol[32] -= b1a.x * sol[11]; sol[33] -= b1a.y * sol[11]; sol[34] -= b1a.z * sol[11]; sol[35] -= b1a.w * sol[11]; sol[36] -= b1b.x * sol[11]; sol[37] -= b1b.y * sol[11]; sol[38] -= b1b.z * sol[11]; sol[39] -= b1b.w * sol[11]; sol[40] -= b1c.x * sol[11]; sol[41] -= b1c.y * sol[11]; sol[42] -= b1c.z * sol[11]; sol[43] -= b1c.w * sol[11]; sol[44] -= b1d.x * sol[11]; sol[45] -= b1d.y * sol[11]; sol[46] -= b1d.z * sol[11]; sol[47] -= b1d.w * sol[11];
  __builtin_amdgcn_sched_barrier(0);
  b1a = *(const float4*)(Lr + 784); b1b = *(const float4*)(Lr + 788); b1c = *(const float4*)(Lr + 792); b1d = *(const float4*)(Lr + 796);
  __builtin_amdgcn_sched_barrier(0);
  sol[48] -= b2a.x * sol[11]; sol[49] -= b2a.y * sol[11]; sol[50] -= b2a.z * sol[11]; sol[51] -= b2a.w * sol[11]; sol[52] -= b2b.x * sol[11]; sol[53] -= b2b.y * sol[11]; sol[54] -= b2b.z * sol[11]; sol[55] -= b2b.w * sol[11]; sol[56] -= b2c.x * sol[11]; sol[57] -= b2c.y * sol[11]; sol[58] -= b2c.z * sol[11]; sol[59] -= b2c.w * sol[11]; sol[60] -= b2d.x * sol[11]; sol[61] -= b2d.y * sol[11]; sol[62] -= b2d.z * sol[11]; sol[63] -= b2d.w * sol[11];
  __builtin_amdgcn_sched_barrier(0);
  b2a = *(const float4*)(Lr + 800); b2b = *(const float4*)(Lr + 804); b2c = *(const float4*)(Lr + 808); b2d = *(const float4*)(Lr + 812);
  __builtin_amdgcn_sched_barrier(0);
  sol[13] -= b0d.y * sol[12]; sol[14] -= b0d.z * sol[12]; sol[15] -= b0d.w * sol[12];
  __builtin_amdgcn_sched_barrier(0);
  b0a = *(const float4*)(Lr + 816); b0b = *(const float4*)(Lr + 820); b0c = *(const float4*)(Lr + 824); b0d = *(const float4*)(Lr + 828);
  __builtin_amdgcn_sched_barrier(0);
  sol[16] -= b1a.x * sol[12]; sol[17] -= b1a.y * sol[12]; sol[18] -= b1a.z * sol[12]; sol[19] -= b1a.w * sol[12]; sol[20] -= b1b.x * sol[12]; sol[21] -= b1b.y * sol[12]; sol[22] -= b1b.z * sol[12]; sol[23] -= b1b.w * sol[12]; sol[24] -= b1c.x * sol[12]; sol[25] -= b1c.y * sol[12]; sol[26] -= b1c.z * sol[12]; sol[27] -= b1c.w * sol[12]; sol[28] -= b1d.x * sol[12]; sol[29] -= b1d.y * sol[12]; sol[30] -= b1d.z * sol[12]; sol[31] -= b1d.w * sol[12];
  __builtin_amdgcn_sched_barrier(0);
  b1a = *(const float4*)(Lr + 832); b1b = *(const float4*)(Lr + 836); b1c = *(const float4*)(Lr + 840); b1d = *(const float4*)(Lr + 844);
  __builtin_amdgcn_sched_barrier(0);
  sol[32] -= b2a.x * sol[12]; sol[33] -= b2a.y * sol[12]; sol[34] -= b2a.z * sol[12]; sol[35] -= b2a.w * sol[12]; sol[36] -= b2b.x * sol[12]; sol[37] -= b2b.y * sol[12]; sol[38] -= b2b.z * sol[12]; sol[39] -= b2b.w * sol[12]; sol[40] -= b2c.x * sol[12]; sol[41] -= b2c.y * sol[12]; sol[42] -= b2c.z * sol[12]; sol[43] -= b2c.w * sol[12]; sol[44] -= b2d.x * sol[12]; sol[45] -= b2d.y * sol[12]; sol[46] -= b2d.z * sol[12]; sol[47] -= b2d.w * sol[12];
  __builtin_amdgcn_sched_barrier(0);
  b2a = *(const float4*)(Lr + 848); b2b = *(const float4*)(Lr + 852); b2c = *(const float4*)(Lr + 856); b2d = *(const float4*)(Lr + 860);
  __builtin_amdgcn_sched_barrier(0);
  sol[48] -= b0a.x * sol[12]; sol[49] -= b0a.y * sol[12]; sol[50] -= b0a.z * sol[12]; sol[51] -= b0a.w * sol[12]; sol[52] -= b0b.x * sol[12]; sol[53] -= b0b.y * sol[12]; sol[54] -= b0b.z * sol[12]; sol[55] -= b0b.w * sol[12]; sol[56] -= b0c.x * sol[12]; sol[57] -= b0c.y * sol[12]; sol[58] -= b0c.z * sol[12]; sol[59] -= b0c.w * sol[12]; sol[60] -= b0d.x * sol[12]; sol[61] -= b0d.y * sol[12]; sol[62] -= b0d.z * sol[12]; sol[63] -= b0d.w * sol[12];
  __builtin_amdgcn_sched_barrier(0);
  b0a = *(const float4*)(Lr + 864); b0b = *(const float4*)(Lr + 868); b0c = *(const float4*)(Lr + 872); b0d = *(const float4*)(Lr + 876);
  __builtin_amdgcn_sched_barrier(0);
  sol[14] -= b1d.z * sol[13]; sol[15] -= b1d.w * sol[13];
  __builtin_amdgcn_sched_barrier(0);
  b1a = *(const float4*)(Lr + 880); b1b = *(const float4*)(Lr + 884); b1c = *(const float4*)(Lr + 888); b1d = *(const float4*)(Lr + 892);
  __builtin_amdgcn_sched_barrier(0);
  sol[16] -= b2a.x * sol[13]; sol[17] -= b2a.y * sol[13]; sol[18] -= b2a.z * sol[13]; sol[19] -= b2a.w * sol[13]; sol[20] -= b2b.x * sol[13]; sol[21] -= b2b.y * sol[13]; sol[22] -= b2b.z * sol[13]; sol[23] -= b2b.w * sol[13]; sol[24] -= b2c.x * sol[13]; sol[25] -= b2c.y * sol[13]; sol[26] -= b2c.z * sol[13]; sol[27] -= b2c.w * sol[13]; sol[28] -= b2d.x * sol[13]; sol[29] -= b2d.y * sol[13]; sol[30] -= b2d.z * sol[13]; sol[31] -= b2d.w * sol[13];
  __builtin_amdgcn_sched_barrier(0);
  b2a = *(const float4*)(Lr + 896); b2b = *(const float4*)(Lr + 900); b2c = *(const float4*)(Lr + 904); b2d = *(const float4*)(Lr + 908);
  __builtin_amdgcn_sched_barrier(0);
  sol[32] -= b0a.x * sol[13]; sol[33] -= b0a.y * sol[13]; sol[34] -= b0a.z * sol[13]; sol[35] -= b0a.w * sol[13]; sol[36] -= b0b.x * sol[13]; sol[37] -= b0b.y * sol[13]; sol[38] -= b0b.z * sol[13]; sol[39] -= b0b.w * sol[13]; sol[40] -= b0c.x * sol[13]; sol[41] -= b0c.y * sol[13]; sol[42] -= b0c.z * sol[13]; sol[43] -= b0c.w * sol[13]; sol[44] -= b0d.x * sol[13]; sol[45] -= b0d.y * sol[13]; sol[46] -= b0d.z * sol[13]; sol[47] -= b0d.w * sol[13];
  __builtin_amdgcn_sched_barrier(0);
  b0a = *(const float4*)(Lr + 912); b0b = *(const float4*)(Lr + 916); b0c = *(const float4*)(Lr + 920); b0d = *(const float4*)(Lr + 924);
  __builtin_amdgcn_sched_barrier(0);
  sol[48] -= b1a.x * sol[13]; sol[49] -= b1a.y * sol[13]; sol[50] -= b1a.z * sol[13]; sol[51] -= b1a.w * sol[13]; sol[52] -= b1b.x * sol[13]; sol[53] -= b1b.y * sol[13]; sol[54] -= b1b.z * sol[13]; sol[55] -= b1b.w * sol[13]; sol[56] -= b1c.x * sol[13]; sol[57] -= b1c.y * sol[13]; sol[58] -= b1c.z * sol[13]; sol[59] -= b1c.w * sol[13]; sol[60] -= b1d.x * sol[13]; sol[61] -= b1d.y * sol[13]; sol[62] -= b1d.z * sol[13]; sol[63] -= b1d.w * sol[13];
  __builtin_amdgcn_sched_barrier(0);
  b1a = *(const float4*)(Lr + 928); b1b = *(const float4*)(Lr + 932); b1c = *(const float4*)(Lr + 936); b1d = *(const float4*)(Lr + 940);
  __builtin_amdgcn_sched_barrier(0);
  sol[15] -= b2d.w * sol[14];
  __builtin_amdgcn_sched_barrier(0);
  b2a = *(const float4*)(Lr + 944); b2b = *(const float4*)(Lr + 948); b2c = *(const float4*)(Lr + 952); b2d = *(const float4*)(Lr + 956);
  __builtin_amdgcn_sched_barrier(0);
  sol[16] -= b0a.x * sol[14]; sol[17] -= b0a.y * sol[14]; sol[18] -= b0a.z * sol[14]; sol[19] -= b0a.w * sol[14]; sol[20] -= b0b.x * sol[14]; sol[21] -= b0b.y * sol[14]; sol[22] -= b0b.z * sol[14]; sol[23] -= b0b.w * sol[14]; sol[24] -= b0c.x * sol[14]; sol[25] -= b0c.y * sol[14]; sol[26] -= b0c.z * sol[14]; sol[27] -= b0c.w * sol[14]; sol[28] -= b0d.x * sol[14]; sol[29] -= b0d.y * sol[14]; sol[30] -= b0d.z * sol[14]; sol[31] -= b0d.w * sol[14];
  __builtin_amdgcn_sched_barrier(0);
  b0a = *(const float4*)(Lr + 976); b0b = *(const float4*)(Lr + 980); b0c = *(const float4*)(Lr + 984); b0d = *(const float4*)(Lr + 988);
  __builtin_amdgcn_sched_barrier(0);
  sol[32] -= b1a.x * sol[14]; sol[33] -= b1a.y * sol[14]; sol[34] -= b1a.z * sol[14]; sol[35] -= b1a.w * sol[14]; sol[36] -= b1b.x * sol[14]; sol[37] -= b1b.y * sol[14]; sol[38] -= b1b.z * sol[14]; sol[39] -= b1b.w * sol[14]; sol[40] -= b1c.x * sol[14]; sol[41] -= b1c.y * sol[14]; sol[42] -= b1c.z * sol[14]; sol[43] -= b1c.w * sol[14]; sol[44] -= b1d.x * sol[14]; sol[45] -= b1d.y * sol[14]; sol[46] -= b1d.z * sol[14]; sol[47] -= b1d.w * sol[14];
  __builtin_amdgcn_sched_barrier(0);
  b1a = *(const float4*)(Lr + 992); b1b = *(const float4*)(Lr + 996); b1c = *(const float4*)(Lr + 1000); b1d = *(const float4*)(Lr + 1004);
  __builtin_amdgcn_sched_barrier(0);
  sol[48] -= b2a.x * sol[14]; sol[49] -= b2a.y * sol[14]; sol[50] -= b2a.z * sol[14]; sol[51] -= b2a.w * sol[14]; sol[52] -= b2b.x * sol[14]; sol[53] -= b2b.y * sol[14]; sol[54] -= b2b.z * sol[14]; sol[55] -= b2b.w * sol[14]; sol[56] -= b2c.x * sol[14]; sol[57] -= b2c.y * sol[14]; sol[58] -= b2c.z * sol[14]; sol[59] -= b2c.w * sol[14]; sol[60] -= b2d.x * sol[14]; sol[61] -= b2d.y * sol[14]; sol[62] -= b2d.z * sol[14]; sol[63] -= b2d.w * sol[14];
  __builtin_amdgcn_sched_barrier(0);
  b2a = *(const float4*)(Lr + 1008); b2b = *(const float4*)(Lr + 1012); b2c = *(const float4*)(Lr + 1016); b2d = *(const float4*)(Lr + 1020);
  __builtin_amdgcn_sched_barrier(0);
  sol[16] -= b0a.x * sol[15]; sol[17] -= b0a.y * sol[15]; sol[18] -= b0a.z * sol[15]; sol[19] -= b0a.w * sol[15]; sol[20] -= b0b.x * sol[15]; sol[21] -= b0b.y * sol[15]; sol[22] -= b0b.z * sol[15]; sol[23] -= b0b.w * sol[15]; sol[24] -= b0c.x * sol[15]; sol[25] -= b0c.y * sol[15]; sol[26] -= b0c.z * sol[15]; sol[27] -= b0c.w * sol[15]; sol[28] -= b0d.x * sol[15]; sol[29] -= b0d.y * sol[15]; sol[30] -= b0d.z * sol[15]; sol[31] -= b0d.w * sol[15];
  __builtin_amdgcn_sched_barrier(0);
  b0a = *(const float4*)(Lr + 1040); b0b = *(const float4*)(Lr + 1044); b0c = *(const float4*)(Lr + 1048); b0d = *(const float4*)(Lr + 1052);
  __builtin_amdgcn_sched_barrier(0);
  sol[32] -= b1a.x * sol[15]; sol[33] -= b1a.y * sol[15]; sol[34] -= b1a.z * sol[15]; sol[35] -= b1a.w * sol[15]; sol[36] -= b1b.x * sol[15]; sol[37] -= b1b.y * sol[15]; sol[38] -= b1b.z * sol[15]; sol[39] -= b1b.w * sol[15]; sol[40] -= b1c.x * sol[15]; sol[41] -= b1c.y * sol[15]; sol[42] -= b1c.z * sol[15]; sol[43] -= b1c.w * sol[15]; sol[44] -= b1d.x * sol[15]; sol[45] -= b1d.y * sol[15]; sol[46] -= b1d.z * sol[15]; sol[47] -= b1d.w * sol[15];
  __builtin_amdgcn_sched_barrier(0);
  b1a = *(const float4*)(Lr + 1056); b1b = *(const float4*)(Lr + 1060); b1c = *(const float4*)(Lr + 1064); b1d = *(const float4*)(Lr + 1068);
  __builtin_amdgcn_sched_barrier(0);
  sol[48] -= b2a.x * sol[15]; sol[49] -= b2a.y * sol[15]; sol[50] -= b2a.z * sol[15]; sol[51] -= b2a.w * sol[15]; sol[52] -= b2b.x * sol[15]; sol[53] -= b2b.y * sol[15]; sol[54] -= b2b.z * sol[15]; sol[55] -= b2b.w * sol[15]; sol[56] -= b2c.x * sol[15]; sol[57] -= b2c.y * sol[15]; sol[58] -= b2c.z * sol[15]; sol[59] -= b2c.w * sol[15]; sol[60] -= b2d.x * sol[15]; sol[61] -= b2d.y * sol[15]; sol[62] -= b2d.z * sol[15]; sol[63] -= b2d.w * sol[15];
  __builtin_amdgcn_sched_barrier(0);
  b2a = *(const float4*)(Lr + 1072); b2b = *(const float4*)(Lr + 1076); b2c = *(const float4*)(Lr + 1080); b2d = *(const float4*)(Lr + 1084);
  __builtin_amdgcn_sched_barrier(0);
  sol[17] -= b0a.y * sol[16]; sol[18] -= b0a.z * sol[16]; sol[19] -= b0a.w * sol[16]; sol[20] -= b0b.x * sol[16]; sol[21] -= b0b.y * sol[16]; sol[22] -= b0b.z * sol[16]; sol[23] -= b0b.w * sol[16]; sol[24] -= b0c.x * sol[16]; sol[25] -= b0c.y * sol[16]; sol[26] -= b0c.z * sol[16]; sol[27] -= b0c.w * sol[16]; sol[28] -= b0d.x * sol[16]; sol[29] -= b0d.y * sol[16]; sol[30] -= b0d.z * sol[16]; sol[31] -= b0d.w * sol[16];
  __builtin_amdgcn_sched_barrier(0);
  b0a = *(const float4*)(Lr + 1104); b0b = *(const float4*)(Lr + 1108); b0c = *(const float4*)(Lr + 1112); b0d = *(const float4*)(Lr + 1116);
  __builtin_amdgcn_sched_barrier(0);
  sol[32] -= b1a.x * sol[16]; sol[33] -= b1a.y * sol[16]; sol[34] -= b1a.z * sol[16]; sol[35] -= b1a.w * sol[16]; sol[36] -= b1b.x * sol[16]; sol[37] -= b1b.y * sol[16]; sol[38] -= b1b.z * sol[16]; sol[39] -= b1b.w * sol[16]; sol[40] -= b1c.x * sol[16]; sol[41] -= b1c.y * sol[16]; sol[42] -= b1c.z * sol[16]; sol[43] -= b1c.w * sol[16]; sol[44] -= b1d.x * sol[16]; sol[45] -= b1d.y * sol[16]; sol[46] -= b1d.z * sol[16]; sol[47] -= b1d.w * sol[16];
  __builtin_amdgcn_sched_barrier(0);
  b1a = *(const float4*)(Lr + 1120); b1b = *(const float4*)(Lr + 1124); b1c = *(const float4*)(Lr + 1128); b1d = *(const float4*)(Lr + 1132);
  __builtin_amdgcn_sched_barrier(0);
  sol[48] -= b2a.x * sol[16]; sol[49] -= b2a.y * sol[16]; sol[50] -= b2a.z * sol[16]; sol[51] -= b2a.w * sol[16]; sol[52] -= b2b.x * sol[16]; sol[53] -= b2b.y * sol[16]; sol[54] -= b2b.z * sol[16]; sol[55] -= b2b.w * sol[16]; sol[56] -= b2c.x * sol[16]; sol[57] -= b2c.y * sol[16]; sol[58] -= b2c.z * sol[16]; sol[59] -= b2c.w * sol[16]; sol[60] -= b2d.x * sol[16]; sol[61] -= b2d.y * sol[16]; sol[62] -= b2d.z * sol[16]; sol[63] -= b2d.w * sol[16];
  __builtin_amdgcn_sched_barrier(0);
  b2a = *(const float4*)(Lr + 1136); b2b = *(const float4*)(Lr + 1140); b2c = *(const float4*)(Lr + 1144); b2d = *(const float4*)(Lr + 1148);
  __builtin_amdgcn_sched_barrier(0);
  sol[18] -= b0a.z * sol[17]; sol[19] -= b0a.w * sol[17]; sol[20] -= b0b.x * sol[17]; sol[21] -= b0b.y * sol[17]; sol[22] -= b0b.z * sol[17]; sol[23] -= b0b.w * sol[17]; sol[24] -= b0c.x * sol[17]; sol[25] -= b0c.y * sol[17]; sol[26] -= b0c.z * sol[17]; sol[27] -= b0c.w * sol[17]; sol[28] -= b0d.x * sol[17]; sol[29] -= b0d.y * sol[17]; sol[30] -= b0d.z * sol[17]; sol[31] -= b0d.w * sol[17];
  __builtin_amdgcn_sched_barrier(0);
  b0a = *(const float4*)(Lr + 1168); b0b = *(const float4*)(Lr + 1172); b0c = *(const float4*)(Lr + 1176); b0d = *(const float4*)(Lr + 1180);
  __builtin_amdgcn_sched_barrier(0);
  sol[32] -= b1a.x * sol[17]; sol[33] -= b1a.y * sol[17]; sol[34] -= b1a.z * sol[17]; sol[35] -= b1a.w * sol[17]; sol[36] -= b1b.x * sol[17]; sol[37] -= b1b.y * sol[17]; sol[38] -= b1b.z * sol[17]; sol[39] -= b1b.w * sol[17]; sol[40] -= b1c.x * sol[17]; sol[41] -= b1c.y * sol[17]; sol[42] -= b1c.z * sol[17]; sol[43] -= b1c.w * sol[17]; sol[44] -= b1d.x * sol[17]; sol[45] -= b1d.y * sol[17]; sol[46] -= b1d.z * sol[17]; sol[47] -= b1d.w * sol[17];
  __builtin_amdgcn_sched_barrier(0);
  b1a = *(const float4*)(Lr + 1184); b1b = *(const float4*)(Lr + 1188); b1c = *(const float4*)(Lr + 1192); b1d = *(const float4*)(Lr + 1196);
  __builtin_amdgcn_sched_barrier(0);
  sol[48] -= b2a.x * sol[17]; sol[49] -= b2a.y * sol[17]; sol[50] -= b2a.z * sol[17]; sol[51] -= b2a.w * sol[17]; sol[52] -= b2b.x * sol[17]; sol[53] -= b2b.y * sol[17]; sol[54] -= b2b.z * sol[17]; sol[55] -= b2b.w * sol[17]; sol[56] -= b2c.x * sol[17]; sol[57] -= b2c.y * sol[17]; sol[58] -= b2c.z * sol[17]; sol[59] -= b2c.w * sol[17]; sol[60] -= b2d.x * sol[17]; sol[61] -= b2d.y * sol[17]; sol[62] -= b2d.z * sol[17]; sol[63] -= b2d.w * sol[17];
  __builtin_amdgcn_sched_barrier(0);
  b2a = *(const float4*)(Lr + 1200); b2b = *(const float4*)(Lr + 1204); b2c = *(const float4*)(Lr + 1208); b2d = *(const float4*)(Lr + 1212);
  __builtin_amdgcn_sched_barrier(0);
  sol[19] -= b0a.w * sol[18]; sol[20] -= b0b.x * sol[18]; sol[21] -= b0b.y * sol[18]; sol[22] -= b0b.z * sol[18]; sol[23] -= b0b.w * sol[18]; sol[24] -= b0c.x * sol[18]; sol[25] -= b0c.y * sol[18]; sol[26] -= b0c.z * sol[18]; sol[27] -= b0c.w * sol[18]; sol[28] -= b0d.x * sol[18]; sol[29] -= b0d.y * sol[18]; sol[30] -= b0d.z * sol[18]; sol[31] -= b0d.w * sol[18];
  __builtin_amdgcn_sched_barrier(0);
  b0a = *(const float4*)(Lr + 1232); b0b = *(const float4*)(Lr + 1236); b0c = *(const float4*)(Lr + 1240); b0d = *(const float4*)(Lr + 1244);
  __builtin_amdgcn_sched_barrier(0);
  sol[32] -= b1a.x * sol[18]; sol[33] -= b1a.y * sol[18]; sol[34] -= b1a.z * sol[18]; sol[35] -= b1a.w * sol[18]; sol[36] -= b1b.x * sol[18]; sol[37] -= b1b.y * sol[18]; sol[38] -= b1b.z * sol[18]; sol[39] -= b1b.w * sol[18]; sol[40] -= b1c.x * sol[18]; sol[41] -= b1c.y * sol[18]; sol[42] -= b1c.z * sol[18]; sol[43] -= b1c.w * sol[18]; sol[44] -= b1d.x * sol[18]; sol[45] -= b1d.y * sol[18]; sol[46] -= b1d.z * sol[18]; sol[47] -= b1d.w * sol[18];
  __builtin_amdgcn_sched_barrier(0);
  b1a = *(const float4*)(Lr + 1248); b1b = *(const float4*)(Lr + 1252); b1c = *(const float4*)(Lr + 1256); b1d = *(const float4*)(Lr + 1260);
  __builtin_amdgcn_sched_barrier(0);
  sol[48] -= b2a.x * sol[18]; sol[49] -= b2a.y * sol[18]; sol[50] -= b2a.z * sol[18]; sol[51] -= b2a.w * sol[18]; sol[52] -= b2b.x * sol[18]; sol[53] -= b2b.y * sol[18]; sol[54] -= b2b.z * sol[18]; sol[55] -= b2b.w * sol[18]; sol[56] -= b2c.x * sol[18]; sol[57] -= b2c.y * sol[18]; sol[58] -= b2c.z * sol[18]; sol[59] -= b2c.w * sol[18]; sol[60] -= b2d.x * sol[18]; sol[61] -= b2d.y * sol[18]; sol[62] -= b2d.z * sol[18]; sol[63] -= b2d.w * sol[18];
  __builtin_amdgcn_sched_barrier(0);
  b2a = *(const float4*)(Lr + 1264); b2b = *(const float4*)(Lr + 1268); b2c = *(const float4*)(Lr + 1272); b2d = *(const float4*)(Lr + 1276);
  __builtin_amdgcn_sched_barrier(0);
  sol[20] -= b0b.x * sol[19]; sol[21] -= b0b.y * sol[19]; sol[22] -= b0b.z * sol[19]; sol[23] -= b0b.w * sol[19]; sol[24] -= b0c.x * sol[19]; sol[25] -= b0c.y * sol[19]; sol[26] -= b0c.z * sol[19]; sol[27] -= b0c.w * sol[19]; sol[28] -= b0d.x * sol[19]; sol[29] -= b0d.y * sol[19]; sol[30] -= b0d.z * sol[19]; sol[31] -= b0d.w * sol[19];
  __builtin_amdgcn_sched_barrier(0);
  b0a = *(const float4*)(Lr + 1296); b0b = *(const float4*)(Lr + 1300); b0c = *(const float4*)(Lr + 1304); b0d = *(const float4*)(Lr + 1308);
  __builtin_amdgcn_sched_barrier(0);
  sol[32] -= b1a.x * sol[19]; sol[33] -= b1a.y * sol[19]; sol[34] -= b1a.z * sol[19]; sol[35] -= b1a.w * sol[19]; sol[36] -= b1b.x * sol[19]; sol[37] -= b1b.y * sol[19]; sol[38] -= b1b.z * sol[19]; sol[39] -= b1b.w * sol[19]; sol[40] -= b1c.x * sol[19]; sol[41] -= b1c.y * sol[19]; sol[42] -= b1c.z * sol[19]; sol[43] -= b1c.w * sol[19]; sol[44] -= b1d.x * sol[19]; sol[45] -= b1d.y * sol[19]; sol[46] -= b1d.z * sol[19]; sol[47] -= b1d.w * sol[19];
  __builtin_amdgcn_sched_barrier(0);
  b1a = *(const float4*)(Lr + 1312); b1b = *(const float4*)(Lr + 1316); b1c = *(const float4*)(Lr + 1320); b1d = *(const float4*)(Lr + 1324);
  __builtin_amdgcn_sched_barrier(0);
  sol[48] -= b2a.x * sol[19]; sol[49] -= b2a.y * sol[19]; sol[50] -= b2a.z * sol[19]; sol[51] -= b2a.w * sol[19]; sol[52] -= b2b.x * sol[19]; sol[53] -= b2b.y * sol[19]; sol[54] -= b2b.z * sol[19]; sol[55] -= b2b.w * sol[19]; sol[56] -= b2c.x * sol[19]; sol[57] -= b2c.y * sol[19]; sol[58] -= b2c.z * sol[19]; sol[59] -= b2c.w * sol[19]; sol[60] -= b2d.x * sol[19]; sol[61] -= b2d.y * sol[19]; sol[62] -= b2d.z * sol[19]; sol[63] -= b2d.w * sol[19];
  __builtin_amdgcn_sched_barrier(0);
  b2a = *(const float4*)(Lr + 1328); b2b = *(const float4*)(Lr + 1332); b2c = *(const float4*)(Lr + 1336); b2d = *(const float4*)(Lr + 1340);
  __builtin_amdgcn_sched_barrier(0);
  sol[21] -= b0b.y * sol[20]; sol[22] -= b0b.z * sol[20]; sol[23] -= b0b.w * sol[20]; sol[24] -= b0c.x * sol[20]; sol[25] -= b0c.y * sol[20]; sol[26] -= b0c.z * sol[20]; sol[27] -= b0c.w * sol[20]; sol[28] -= b0d.x * sol[20]; sol[29] -= b0d.y * sol[20]; sol[30] -= b0d.z * sol[20]; sol[31] -= b0d.w * sol[20];
  __builtin_amdgcn_sched_barrier(0);
  b0a = *(const float4*)(Lr + 1360); b0b = *(const float4*)(Lr + 1364); b0c = *(const float4*)(Lr + 1368); b0d = *(const float4*)(Lr + 1372);
  __builtin_amdgcn_sched_barrier(0);
  sol[32] -= b1a.x * sol[20]; sol[33] -= b1a.y * sol[20]; sol[34] -= b1a.z * sol[20]; sol[35] -= b1a.w * sol[20]; sol[36] -= b1b.x * sol[20]; sol[37] -= b1b.y * sol[20]; sol[38] -= b1b.z * sol[20]; sol[39] -= b1b.w * sol[20]; sol[40] -= b1c.x * sol[20]; sol[41] -= b1c.y * sol[20]; sol[42] -= b1c.z * sol[20]; sol[43] -= b1c.w * sol[20]; sol[44] -= b1d.x * sol[20]; sol[45] -= b1d.y * sol[20]; sol[46] -= b1d.z * sol[20]; sol[47] -= b1d.w * sol[20];
  __builtin_amdgcn_sched_barrier(0);
  b1a = *(const float4*)(Lr + 1376); b1b = *(const float4*)(Lr + 1380); b1c = *(const float4*)(Lr + 1384); b1d = *(const float4*)(Lr + 1388);
  __builtin_amdgcn_sched_barrier(0);
  sol[48] -= b2a.x * sol[20]; sol[49] -= b2a.y * sol[20]; sol[50] -= b2a.z * sol[20]; sol[51] -= b2a.w * sol[20]; sol[52] -= b2b.x * sol[20]; sol[53] -= b2b.y * sol[20]; sol[54] -= b2b.z * sol[20]; sol[55] -= b2b.w * sol[20]; sol[56] -= b2c.x * sol[20]; sol[57] -= b2c.y * sol[20]; sol[58] -= b2c.z * sol[20]; sol[59] -= b2c.w * sol[20]; sol[60] -= b2d.x * sol[20]; sol[61] -= b2d.y * sol[20]; sol[62] -= b2d.z * sol[20]; sol[63] -= b2d.w * sol[20];
  __builtin_amdgcn_sched_barrier(0);
  b2a = *(const float4*)(Lr + 1392); b2b = *(const float4*)(Lr + 1396); b2c = *(const float4*)(Lr + 1400); b2d = *(const float4*)(Lr + 1404);
  __builtin_amdgcn_sched_barrier(0);
  sol[22] -= b0b.z * sol[21]; sol[23] -= b0b.w * sol[21]; sol[24] -= b0c.x * sol[21]; sol[25] -= b0c.y * sol[21]; sol[26] -= b0c.z * sol[21]; sol[27] -= b0c.w * sol[21]; sol[28] -= b0d.x * sol[21]; sol[29] -= b0d.y * sol[21]; sol[30] -= b0d.z * sol[21]; sol[31] -= b0d.w * sol[21];
  __builtin_amdgcn_sched_barrier(0);
  b0a = *(const float4*)(Lr + 1424); b0b = *(const float4*)(Lr + 1428); b0c = *(const float4*)(Lr + 1432); b0d = *(const float4*)(Lr + 1436);
  __builtin_amdgcn_sched_barrier(0);
  sol[32] -= b1a.x * sol[21]; sol[33] -= b1a.y * sol[21]; sol[34] -= b1a.z * sol[21]; sol[35] -= b1a.w * sol[21]; sol[36] -= b1b.x * sol[21]; sol[37] -= b1b.y * sol[21]; sol[38] -= b1b.z * sol[21]; sol[39] -= b1b.w * sol[21]; sol[40] -= b1c.x * sol[21]; sol[41] -= b1c.y * sol[21]; sol[42] -= b1c.z * sol[21]; sol[43] -= b1c.w * sol[21]; sol[44] -= b1d.x * sol[21]; sol[45] -= b1d.y * sol[21]; sol[46] -= b1d.z * sol[21]; sol[47] -= b1d.w * sol[21];
  __builtin_amdgcn_sched_barrier(0);
  b1a = *(const float4*)(Lr + 1440); b1b = *(const float4*)(Lr + 1444); b1c = *(const float4*)(Lr + 1448); b1d = *(const float4*)(Lr + 1452);
  __builtin_amdgcn_sched_barrier(0);
  sol[48] -= b2a.x * sol[21]; sol[49] -= b2a.y * sol[21]; sol[50] -= b2a.z * sol[21]; sol[51] -= b2a.w * sol[21]; sol[52] -= b2b.x * sol[21]; sol[53] -= b2b.y * sol[21]; sol[54] -= b2b.z * sol[21]; sol[55] -= b2b.w * sol[21]; sol[56] -= b2c.x * sol[21]; sol[57] -= b2c.y * sol[21]; sol[58] -= b2c.z * sol[21]; sol[59] -= b2c.w * sol[21]; sol[60] -= b2d.x * sol[21]; sol[61] -= b2d.y * sol[21]; sol[62] -= b2d.z * sol[21]; sol[63] -= b2d.w * sol[21];
  __builtin_amdgcn_sched_barrier(0);
  b2a = *(const float4*)(Lr + 1456); b2b = *(const float4*)(Lr + 1460); b2c = *(const float4*)(Lr + 1464); b2d = *(const float4*)(Lr + 1468);
  __builtin_amdgcn_sched_barrier(0);
  sol[23] -= b0b.w * sol[22]; sol[24] -= b0c.x * sol[22]; sol[25] -= b0c.y * sol[22]; sol[26] -= b0c.z * sol[22]; sol[27] -= b0c.w * sol[22]; sol[28] -= b0d.x * sol[22]; sol[29] -= b0d.y * sol[22]; sol[30] -= b0d.z * sol[22]; sol[31] -= b0d.w * sol[22];
  __builtin_amdgcn_sched_barrier(0);
  b0a = *(const float4*)(Lr + 1488); b0b = *(const float4*)(Lr + 1492); b0c = *(const float4*)(Lr + 1496); b0d = *(const float4*)(Lr + 1500);
  __builtin_amdgcn_sched_barrier(0);
  sol[32] -= b1a.x * sol[22]; sol[33] -= b1a.y * sol[22]; sol[34] -= b1a.z * sol[22]; sol[35] -= b1a.w * sol[22]; sol[36] -= b1b.x * sol[22]; sol[37] -= b1b.y * sol[22]; sol[38] -= b1b.z * sol[22]; sol[39] -= b1b.w * sol[22]; sol[40] -= b1c.x * sol[22]; sol[41] -= b1c.y * sol[22]; sol[42] -= b1c.z * sol[22]; sol[43] -= b1c.w * sol[22]; sol[44] -= b1d.x * sol[22]; sol[45] -= b1d.y * sol[22]; sol[46] -= b1d.z * sol[22]; sol[47] -= b1d.w * sol[22];
  __builtin_amdgcn_sched_barrier(0);
  b1a = *(const float4*)(Lr + 1504); b1b = *(const float4*)(Lr + 1508); b1c = *(const float4*)(Lr + 1512); b1d = *(const float4*)(Lr + 1516);
  __builtin_amdgcn_sched_barrier(0);
  sol[48] -= b2a.x * sol[22]; sol[49] -= b2a.y * sol[22]; sol[50] -= b2a.z * sol[22]; sol[51] -= b2a.w * sol[22]; sol[52] -= b2b.x * sol[22]; sol[53] -= b2b.y * sol[22]; sol[54] -= b2b.z * sol[22]; sol[55] -= b2b.w * sol[22]; sol[56] -= b2c.x * sol[22]; sol[57] -= b2c.y * sol[22]; sol[58] -= b2c.z * sol[22]; sol[59] -= b2c.w * sol[22]; sol[60] -= b2d.x * sol[22]; sol[61] -= b2d.y * sol[22]; sol[62] -= b2d.z * sol[22]; sol[63] -= b2d.w * sol[22];
  __builtin_amdgcn_sched_barrier(0);
  b2a = *(const float4*)(Lr + 1520); b2b = *(const float4*)(Lr + 1524); b2c = *(const float4*)(Lr + 1528); b2d = *(const float4*)(Lr + 1532);
  __builtin_amdgcn_sched_barrier(0);
  sol[24] -= b0c.x * sol[23]; sol[25] -= b0c.y * sol[23]; sol[26] -= b0c.z * sol[23]; sol[27] -= b0c.w * sol[23]; sol[28] -= b0d.x * sol[23]; sol[29] -= b0d.y * sol[23]; sol[30] -= b0d.z * sol[23]; sol[31] -= b0d.w * sol[23];
  __builtin_amdgcn_sched_barrier(0);
  b0a = *(const float4*)(Lr + 1552); b0b = *(const float4*)(Lr + 1556); b0c = *(const float4*)(Lr + 1560); b0d = *(const float4*)(Lr + 1564);
  __builtin_amdgcn_sched_barrier(0);
  sol[32] -= b1a.x * sol[23]; sol[33] -= b1a.y * sol[23]; sol[34] -= b1a.z * sol[23]; sol[35] -= b1a.w * sol[23]; sol[36] -= b1b.x * sol[23]; sol[37] -= b1b.y * sol[23]; sol[38] -= b1b.z * sol[23]; sol[39] -= b1b.w * sol[23]; sol[40] -= b1c.x * sol[23]; sol[41] -= b1c.y * sol[23]; sol[42] -= b1c.z * sol[23]; sol[43] -= b1c.w * sol[23]; sol[44] -= b1d.x * sol[23]; sol[45] -= b1d.y * sol[23]; sol[46] -= b1d.z * sol[23]; sol[47] -= b1d.w * sol[23];
  __builtin_amdgcn_sched_barrier(0);
  b1a = *(const float4*)(Lr + 1568); b1b = *(const float4*)(Lr + 1572); b1c = *(const float4*)(Lr + 1576); b1d = *(const float4*)(Lr + 1580);
  __builtin_amdgcn_sched_barrier(0);
  sol[48] -= b2a.x * sol[23]; sol[49] -= b2a.y * sol[23]; sol[50] -= b2a.z * sol[23]; sol[51] -= b2a.w * sol[23]; sol[52] -= b2b.x * sol[23]; sol[53] -= b2b.y * sol[23]; sol[54] -= b2b.z * sol[23]; sol[55] -= b2b.w * sol[23]; sol[56] -= b2c.x * sol[23]; sol[57] -= b2c.y * sol[23]; sol[58] -= b2c.z * sol[23]; sol[59] -= b2c.w * sol[23]; sol[60] -= b2d.x * sol[23]; sol[61] -= b2d.y * sol[23]; sol[62] -= b2d.z * sol[23]; sol[63] -= b2d.w * sol[23];
  __builtin_amdgcn_sched_barrier(0);
  b2a = *(const float4*)(Lr + 1584); b2b = *(const float4*)(Lr + 1588); b2c = *(const float4*)(Lr + 1592); b2d = *(const float4*)(Lr + 1596);
  __builtin_amdgcn_sched_barrier(0);
  sol[25] -= b0c.y * sol[24]; sol[26] -= b0c.z * sol[24]; sol[27] -= b0c.w * sol[24]; sol[28] -= b0d.x * sol[24]; sol[29] -= b0d.y * sol[24]; sol[30] -= b0d.z * sol[24]; sol[31] -= b0d.w * sol[24];
  __builtin_amdgcn_sched_barrier(0);
  b0a = *(const float4*)(Lr + 1616); b0b = *(const float4*)(Lr + 1620); b0c = *(const float4*)(Lr + 1624); b0d = *(const float4*)(Lr + 1628);
  __builtin_amdgcn_sched_barrier(0);
  sol[32] -= b1a.x * sol[24]; sol[33] -= b1a.y * sol[24]; sol[34] -= b1a.z * sol[24]; sol[35] -= b1a.w * sol[24]; sol[36] -= b1b.x * sol[24]; sol[37] -= b1b.y * sol[24]; sol[38] -= b1b.z * sol[24]; sol[39] -= b1b.w * sol[24]; sol[40] -= b1c.x * sol[24]; sol[41] -= b1c.y * sol[24]; sol[42] -= b1c.z * sol[24]; sol[43] -= b1c.w * sol[24]; sol[44] -= b1d.x * sol[24]; sol[45] -= b1d.y * sol[24]; sol[46] -= b1d.z * sol[24]; sol[47] -= b1d.w * sol[24];
  __builtin_amdgcn_sched_barrier(0);
  b1a = *(const float4*)(Lr + 1632); b1b = *(const float4*)(Lr + 1636); b1c = *(const float4*)(Lr + 1640); b1d = *(const float4*)(Lr + 1644);
  __builtin_amdgcn_sched_barrier(0);
  sol[48] -= b2a.x * sol[24]; sol[49] -= b2a.y * sol[24]; sol[50] -= b2a.z * sol[24]; sol[51] -= b2a.w * sol[24]; sol[52] -= b2b.x * sol[24]; sol[53] -= b2b.y * sol[24]; sol[54] -= b2b.z * sol[24]; sol[55] -= b2b.w * sol[24]; sol[56] -= b2c.x * sol[24]; sol[57] -= b2c.y * sol[24]; sol[58] -= b2c.z * sol[24]; sol[59] -= b2c.w * sol[24]; sol[60] -= b2d.x * sol[24]; sol[61] -= b2d.y * sol[24]; sol[62] -= b2d.z * sol[24]; sol[63] -= b2d.w * sol[24];
  __builtin_amdgcn_sched_barrier(0);
  b2a = *(const float4*)(Lr + 1648); b2b = *(const float4*)(Lr + 1652); b2c = *(const float4*)(Lr + 1656); b2d = *(const float4*)(Lr + 1660);
  __builtin_amdgcn_sched_barrier(0);
  sol[26] -= b0c.z * sol[25]; sol[27] -= b0c.w * sol[25]; sol[28] -= b0d.x * sol[25]; sol[29] -= b0d.y * sol[25]; sol[30] -= b0d.z * sol[25]; sol[31] -= b0d.w * sol[25];
  __builtin_amdgcn_sched_barrier(0);
  b0a = *(const float4*)(Lr + 1680); b0b = *(const float4*)(Lr + 1684); b0c = *(const float4*)(Lr + 1688); b0d = *(const float4*)(Lr + 1692);
  __builtin_amdgcn_sched_barrier(0);
  sol[32] -= b1a.x * sol[25]; sol[33] -= b1a.y * sol[25]; sol[34] -= b1a.z * sol[25]; sol[35] -= b1a.w * sol[25]; sol[36] -= b1b.x * sol[25]; sol[37] -= b1b.y * sol[25]; sol[38] -= b1b.z * sol[25]; sol[39] -= b1b.w * sol[25]; sol[40] -= b1c.x * sol[25]; sol[41] -= b1c.y * sol[25]; sol[42] -= b1c.z * sol[25]; sol[43] -= b1c.w * sol[25]; sol[44] -= b1d.x * sol[25]; sol[45] -= b1d.y * sol[25]; sol[46] -= b1d.z * sol[25]; sol[47] -= b1d.w * sol[25];
  __builtin_amdgcn_sched_barrier(0);
  b1a = *(const float4*)(Lr + 1696); b1b = *(const float4*)(Lr + 1700); b1c = *(const float4*)(Lr + 1704); b1d = *(const float4*)(Lr + 1708);
  __builtin_amdgcn_sched_barrier(0);
  sol[48] -= b2a.x * sol[25]; sol[49] -= b2a.y * sol[25]; sol[50] -= b2a.z * sol[25]; sol[51] -= b2a.w * sol[25]; sol[52] -= b2b.x * sol[25]; sol[53] -= b2b.y * sol[25]; sol[54] -= b2b.z * sol[25]; sol[55] -= b2b.w * sol[25]; sol[56] -= b2c.x * sol[25]; sol[57] -= b2c.y * sol[25]; sol[58] -= b2c.z * sol[25]; sol[59] -= b2c.w * sol[25]; sol[60] -= b2d.x * sol[25]; sol[61] -= b2d.y * sol[25]; sol[62] -= b2d.z * sol[25]; sol[63] -= b2d.w * sol[25];
  __builtin_amdgcn_sched_barrier(0);
  b2a = *(const float4*)(Lr + 1712); b2b = *(const float4*)(Lr + 1716); b2c = *(const float4*)(Lr + 1720); b2d = *(const float4*)(Lr + 1724);
  __builtin_amdgcn_sched_barrier(0);
  sol[27] -= b0c.w * sol[26]; sol[28] -= b0d.x * sol[26]; sol[29] -= b0d.y * sol[26]; sol[30] -= b0d.z * sol[26]; sol[31] -= b0d.w * sol[26];
  __builtin_amdgcn_sched_barrier(0);
  b0a = *(const float4*)(Lr + 1744); b0b = *(const float4*)(Lr + 1748); b0c = *(const float4*)(Lr + 1752); b0d = *(const float4*)(Lr + 1756);
  __builtin_amdgcn_sched_barrier(0);
  sol[32] -= b1a.x * sol[26]; sol[33] -= b1a.y * sol[26]; sol[34] -= b1a.z * sol[26]; sol[35] -= b1a.w * sol[26]; sol[36] -= b1b.x * sol[26]; sol[37] -= b1b.y * sol[26]; sol[38] -= b1b.z * sol[26]; sol[39] -= b1b.w * sol[26]; sol[40] -= b1c.x * sol[26]; sol[41] -= b1c.y * sol[26]; sol[42] -= b1c.z * sol[26]; sol[43] -= b1c.w * sol[26]; sol[44] -= b1d.x * sol[26]; sol[45] -= b1d.y * sol[26]; sol[46] -= b1d.z * sol[26]; sol[47] -= b1d.w * sol[26];
  __builtin_amdgcn_sched_barrier(0);
  b1a = *(const float4*)(Lr + 1760); b1b = *(const float4*)(Lr + 1764); b1c = *(const float4*)(Lr + 1768); b1d = *(const float4*)(Lr + 1772);
  __builtin_amdgcn_sched_barrier(0);
  sol[48] -= b2a.x * sol[26]; sol[49] -= b2a.y * sol[26]; sol[50] -= b2a.z * sol[26]; sol[51] -= b2a.w * sol[26]; sol[52] -= b2b.x * sol[26]; sol[53] -= b2b.y * sol[26]; sol[54] -= b2b.z * sol[26]; sol[55] -= b2b.w * sol[26]; sol[56] -= b2c.x * sol[26]; sol[57] -= b2c.y * sol[26]; sol[58] -= b2c.z * sol[26]; sol[59] -= b2c.w * sol[26]; sol[60] -= b2d.x * sol[26]; sol[61] -= b2d.y * sol[26]; sol[62] -= b2d.z * sol[26]; sol[63] -= b2d.w * sol[26];
  __builtin_amdgcn_sched_barrier(0);
  b2a = *(const float4*)(Lr + 1776); b2b = *(const float4*)(Lr + 1780); b2c = *(const float4*)(Lr + 1784); b2d = *(const float4*)(Lr + 1788);
  __builtin_amdgcn_sched_barrier(0);
  sol[28] -= b0d.x * sol[27]; sol[29] -= b0d.y * sol[27]; sol[30] -= b0d.z * sol[27]; sol[31] -= b0d.w * sol[27];
  __builtin_amdgcn_sched_barrier(0);
  b0a = *(const float4*)(Lr + 1808); b0b = *(const float4*)(Lr + 1812); b0c = *(const float4*)(Lr + 1816); b0d = *(const float4*)(Lr + 1820);
  __builtin_amdgcn_sched_barrier(0);
  sol[32] -= b1a.x * sol[27]; sol[33] -= b1a.y * sol[27]; sol[34] -= b1a.z * sol[27]; sol[35] -= b1a.w * sol[27]; sol[36] -= b1b.x * sol[27]; sol[37] -= b1b.y * sol[27]; sol[38] -= b1b.z * sol[27]; sol[39] -= b1b.w * sol[27]; sol[40] -= b1c.x * sol[27]; sol[41] -= b1c.y * sol[27]; sol[42] -= b1c.z * sol[27]; sol[43] -= b1c.w * sol[27]; sol[44] -= b1d.x * sol[27]; sol[45] -= b1d.y * sol[27]; sol[46] -= b1d.z * sol[27]; sol[47] -= b1d.w * sol[27];
  __builtin_amdgcn_sched_barrier(0);
  b1a = *(const float4*)(Lr + 1824); b1b = *(const float4*)(Lr + 1828); b1c = *(const float4*)(Lr + 1832); b1d = *(const float4*)(Lr + 1836);
  __builtin_amdgcn_sched_barrier(0);
  sol[48] -= b2a.x * sol[27]; sol[49] -= b2a.y * sol[27]; sol[50] -= b2a.z * sol[27]; sol[51] -= b2a.w * sol[27]; sol[52] -= b2b.x * sol[27]; sol[53] -= b2b.y * sol[27]; sol[54] -= b2b.z * sol[27]; sol[55] -= b2b.w * sol[27]; sol[56] -= b2c.x * sol[27]; sol[57] -= b2c.y * sol[27]; sol[58] -= b2c.z * sol[27]; sol[59] -= b2c.w * sol[27]; sol[60] -= b2d.x * sol[27]; sol[61] -= b2d.y * sol[27]; sol[62] -= b2d.z * sol[27]; sol[63] -= b2d.w * sol[27];
  __builtin_amdgcn_sched_barrier(0);
  b2a = *(const float4*)(Lr + 1840); b2b = *(const float4*)(Lr + 1844); b2c = *(const float4*)(Lr + 1848); b2d = *(const float4*)(Lr + 1852);
  __builtin_amdgcn_sched_barrier(0);
  sol[29] -= b0d.y * sol[28]; sol[30] -= b0d.z * sol[28]; sol[31] -= b0d.w * sol[28];
  __builtin_amdgcn_sched_barrier(0);
  b0a = *(const float4*)(Lr + 1872); b0b = *(const float4*)(Lr + 1876); b0c = *(const float4*)(Lr + 1880); b0d = *(const float4*)(Lr + 1884);
  __builtin_amdgcn_sched_barrier(0);
  sol[32] -= b1a.x * sol[28]; sol[33] -= b1a.y * sol[28]; sol[34] -= b1a.z * sol[28]; sol[35] -= b1a.w * sol[28]; sol[36] -= b1b.x * sol[28]; sol[37] -= b1b.y * sol[28]; sol[38] -= b1b.z * sol[28]; sol[39] -= b1b.w * sol[28]; sol[40] -= b1c.x * sol[28]; sol[41] -= b1c.y * sol[28]; sol[42] -= b1c.z * sol[28]; sol[43] -= b1c.w * sol[28]; sol[44] -= b1d.x * sol[28]; sol[45] -= b1d.y * sol[28]; sol[46] -= b1d.z * sol[28]; sol[47] -= b1d.w * sol[28];
  __builtin_amdgcn_sched_barrier(0);
  b1a = *(const float4*)(Lr + 1888); b1b = *(const float4*)(Lr + 1892); b1c = *(const float4*)(Lr + 1896); b1d = *(const float4*)(Lr + 1900);
  __builtin_amdgcn_sched_barrier(0);
  sol[48] -= b2a.x * sol[28]; sol[49] -= b2a.y * sol[28]; sol[50] -= b2a.z * sol[28]; sol[51] -= b2a.w * sol[28]; sol[52] -= b2b.x * sol[28]; sol[53] -= b2b.y * sol[28]; sol[54] -= b2b.z * sol[28]; sol[55] -= b2b.w * sol[28]; sol[56] -= b2c.x * sol[28]; sol[57] -= b2c.y * sol[28]; sol[58] -= b2c.z * sol[28]; sol[59] -= b2c.w * sol[28]; sol[60] -= b2d.x * sol[28]; sol[61] -= b2d.y * sol[28]; sol[62] -= b2d.z * sol[28]; sol[63] -= b2d.w * sol[28];
  __builtin_amdgcn_sched_barrier(0);
  b2a = *(const float4*)(Lr + 1904); b2b = *(const float4*)(Lr + 1908); b2c = *(const float4*)(Lr + 1912); b2d = *(const float4*)(Lr + 1916);
  __builtin_amdgcn_sched_barrier(0);
  sol[30] -= b0d.z * sol[29]; sol[31] -= b0d.w * sol[29];
  __builtin_amdgcn_sched_barrier(0);
  b0a = *(const float4*)(Lr + 1936); b0b = *(const float4*)(Lr + 1940); b0c = *(const float4*)(Lr + 1944); b0d = *(const float4*)(Lr + 1948);
  __builtin_amdgcn_sched_barrier(0);
  sol[32] -= b1a.x * sol[29]; sol[33] -= b1a.y * sol[29]; sol[34] -= b1a.z * sol[29]; sol[35] -= b1a.w * sol[29]; sol[36] -= b1b.x * sol[29]; sol[37] -= b1b.y * sol[29]; sol[38] -= b1b.z * sol[29]; sol[39] -= b1b.w * sol[29]; sol[40] -= b1c.x * sol[29]; sol[41] -= b1c.y * sol[29]; sol[42] -= b1c.z * sol[29]; sol[43] -= b1c.w * sol[29]; sol[44] -= b1d.x * sol[29]; sol[45] -= b1d.y * sol[29]; sol[46] -= b1d.z * sol[29]; sol[47] -= b1d.w * sol[29];
  __builtin_amdgcn_sched_barrier(0);
  b1a = *(const float4*)(Lr + 1952); b1b = *(const float4*)(Lr + 1956); b1c = *(const float4*)(Lr + 1960); b1d = *(const float4*)(Lr + 1964);
  __builtin_amdgcn_sched_barrier(0);
  sol[48] -= b2a.x * sol[29]; sol[49] -= b2a.y * sol[29]; sol[50] -= b2a.z * sol[29]; sol[51] -= b2a.w * sol[29]; sol[52] -= b2b.x * sol[29]; sol[53] -= b2b.y * sol[29]; sol[54] -= b2b.z * sol[29]; sol[55] -= b2b.w * sol[29]; sol[56] -= b2c.x * sol[29]; sol[57] -= b2c.y * sol[29]; sol[58] -= b2c.z * sol[29]; sol[59] -= b2c.w * sol[29]; sol[60] -= b2d.x * sol[29]; sol[61] -= b2d.y * sol[29]; sol[62] -= b2d.z * sol[29]; sol[63] -= b2d.w * sol[29];
  __builtin_amdgcn_sched_barrier(0);
  b2a = *(const float4*)(Lr + 1968); b2b = *(const float4*)(Lr + 1972); b2c = *(const float4*)(Lr + 1976); b2d = *(const float4*)(Lr + 1980);
  __builtin_amdgcn_sched_barrier(0);
  sol[31] -= b0d.w * sol[30];
  __builtin_amdgcn_sched_barrier(0);
  b0a = *(const float4*)(Lr + 2016); b0b = *(const float4*)(Lr + 2020); b0c = *(const float4*)(Lr + 2024); b0d = *(const float4*)(Lr + 2028);
  __builtin_amdgcn_sched_barrier(0);
  sol[32] -= b1a.x * sol[30]; sol[33] -= b1a.y * sol[30]; sol[34] -= b1a.z * sol[30]; sol[35] -= b1a.w * sol[30]; sol[36] -= b1b.x * sol[30]; sol[37] -= b1b.y * sol[30]; sol[38] -= b1b.z * sol[30]; sol[39] -= b1b.w * sol[30]; sol[40] -= b1c.x * sol[30]; sol[41] -= b1c.y * sol[30]; sol[42] -= b1c.z * sol[30]; sol[43] -= b1c.w * sol[30]; sol[44] -= b1d.x * sol[30]; sol[45] -= b1d.y * sol[30]; sol[46] -= b1d.z * sol[30]; sol[47] -= b1d.w * sol[30];
  __builtin_amdgcn_sched_barrier(0);
  b1a = *(const float4*)(Lr + 2032); b1b = *(const float4*)(Lr + 2036); b1c = *(const float4*)(Lr + 2040); b1d = *(const float4*)(Lr + 2044);
  __builtin_amdgcn_sched_barrier(0);
  sol[48] -= b2a.x * sol[30]; sol[49] -= b2a.y * sol[30]; sol[50] -= b2a.z * sol[30]; sol[51] -= b2a.w * sol[30]; sol[52] -= b2b.x * sol[30]; sol[53] -= b2b.y * sol[30]; sol[54] -= b2b.z * sol[30]; sol[55] -= b2b.w * sol[30]; sol[56] -= b2c.x * sol[30]; sol[57] -= b2c.y * sol[30]; sol[58] -= b2c.z * sol[30]; sol[59] -= b2c.w * sol[30]; sol[60] -= b2d.x * sol[30]; sol[61] -= b2d.y * sol[30]; sol[62] -= b2d.z * sol[30]; sol[63] -= b2d.w * sol[30];
  __builtin_amdgcn_sched_barrier(0);
  b2a = *(const float4*)(Lr + 2080); b2b = *(const float4*)(Lr + 2084); b2c = *(const float4*)(Lr + 2088); b2d = *(const float4*)(Lr + 2092);
  __builtin_amdgcn_sched_barrier(0);
  sol[32] -= b0a.x * sol[31]; sol[33] -= b0a.y * sol[31]; sol[34] -= b0a.z * sol[31]; sol[35] -= b0a.w * sol[31]; sol[36] -= b0b.x * sol[31]; sol[37] -= b0b.y * sol[31]; sol[38] -= b0b.z * sol[31]; sol[39] -= b0b.w * sol[31]; sol[40] -= b0c.x * sol[31]; sol[41] -= b0c.y * sol[31]; sol[42] -= b0c.z * sol[31]; sol[43] -= b0c.w * sol[31]; sol[44] -= b0d.x * sol[31]; sol[45] -= b0d.y * sol[31]; sol[46] -= b0d.z * sol[31]; sol[47] -= b0d.w * sol[31];
  __builtin_amdgcn_sched_barrier(0);
  b0a = *(const float4*)(Lr + 2096); b0b = *(const float4*)(Lr + 2100); b0c = *(const float4*)(Lr + 2104); b0d = *(const float4*)(Lr + 2108);
  __builtin_amdgcn_sched_barrier(0);
  sol[48] -= b1a.x * sol[31]; sol[49] -= b1a.y * sol[31]; sol[50] -= b1a.z * sol[31]; sol[51] -= b1a.w * sol[31]; sol[52] -= b1b.x * sol[31]; sol[53] -= b1b.y * sol[31]; sol[54] -= b1b.z * sol[31]; sol[55] -= b1b.w * sol[31]; sol[56] -= b1c.x * sol[31]; sol[57] -= b1c.y * sol[31]; sol[58] -= b1c.z * sol[31]; sol[59] -= b1c.w * sol[31]; sol[60] -= b1d.x * sol[31]; sol[61] -= b1d.y * sol[31]; sol[62] -= b1d.z * sol[31]; sol[63] -= b1d.w * sol[31];
  __builtin_amdgcn_sched_barrier(0);
  b1a = *(const float4*)(Lr + 2144); b1b = *(const float4*)(Lr + 2148); b1c = *(const float4*)(Lr + 2152); b1d = *(const float4*)(Lr + 2156);
  __builtin_amdgcn_sched_barrier(0);
  sol[33] -= b2a.y * sol[32]; sol[34] -= b2a.z * sol[32]; sol[35] -= b2a.w * sol[32]; sol[36] -= b2b.x * sol[32]; sol[37] -= b2b.y * sol[32]; sol[38] -= b2b.z * sol[32]; sol[39] -= b2b.w * sol[32]; sol[40] -= b2c.x * sol[32]; sol[41] -= b2c.y * sol[32]; sol[42] -= b2c.z * sol[32]; sol[43] -= b2c.w * sol[32]; sol[44] -= b2d.x * sol[32]; sol[45] -= b2d.y * sol[32]; sol[46] -= b2d.z * sol[32]; sol[47] -= b2d.w * sol[32];
  __builtin_amdgcn_sched_barrier(0);
  b2a = *(const float4*)(Lr + 2160); b2b = *(const float4*)(Lr + 2164); b2c = *(const float4*)(Lr + 2168); b2d = *(const float4*)(Lr + 2172);
  __builtin_amdgcn_sched_barrier(0);
  sol[48] -= b0a.x * sol[32]; sol[49] -= b0a.y * sol[32]; sol[50] -= b0a.z * sol[32]; sol[51] -= b0a.w * sol[32]; sol[52] -= b0b.x * sol[32]; sol[53] -= b0b.y * sol[32]; sol[54] -= b0b.z * sol[32]; sol[55] -= b0b.w * sol[32]; sol[56] -= b0c.x * sol[32]; sol[57] -= b0c.y * sol[32]; sol[58] -= b0c.z * sol[32]; sol[59] -= b0c.w * sol[32]; sol[60] -= b0d.x * sol[32]; sol[61] -= b0d.y * sol[32]; sol[62] -= b0d.z * sol[32]; sol[63] -= b0d.w * sol[32];
  __builtin_amdgcn_sched_barrier(0);
  b0a = *(const float4*)(Lr + 2208); b0b = *(const float4*)(Lr + 2212); b0c = *(const float4*)(Lr + 2216); b0d = *(const float4*)(Lr + 2220);
  __builtin_amdgcn_sched_barrier(0);
  sol[34] -= b1a.z * sol[33]; sol[35] -= b1a.w * sol[33]; sol[36] -= b1b.x * sol[33]; sol[37] -= b1b.y * sol[33]; sol[38] -= b1b.z * sol[33]; sol[39] -= b1b.w * sol[33]; sol[40] -= b1c.x * sol[33]; sol[41] -= b1c.y * sol[33]; sol[42] -= b1c.z * sol[33]; sol[43] -= b1c.w * sol[33]; sol[44] -= b1d.x * sol[33]; sol[45] -= b1d.y * sol[33]; sol[46] -= b1d.z * sol[33]; sol[47] -= b1d.w * sol[33];
  __builtin_amdgcn_sched_barrier(0);
  b1a = *(const float4*)(Lr + 2224); b1b = *(const float4*)(Lr + 2228); b1c = *(const float4*)(Lr + 2232); b1d = *(const float4*)(Lr + 2236);
  __builtin_amdgcn_sched_barrier(0);
  sol[48] -= b2a.x * sol[33]; sol[49] -= b2a.y * sol[33]; sol[50] -= b2a.z * sol[33]; sol[51] -= b2a.w * sol[33]; sol[52] -= b2b.x * sol[33]; sol[53] -= b2b.y * sol[33]; sol[54] -= b2b.z * sol[33]; sol[55] -= b2b.w * sol[33]; sol[56] -= b2c.x * sol[33]; sol[57] -= b2c.y * sol[33]; sol[58] -= b2c.z * sol[33]; sol[59] -= b2c.w * sol[33]; sol[60] -= b2d.x * sol[33]; sol[61] -= b2d.y * sol[33]; sol[62] -= b2d.z * sol[33]; sol[63] -= b2d.w * sol[33];
  __builtin_amdgcn_sched_barrier(0);
  b2a = *(const float4*)(Lr + 2272); b2b = *(const float4*)(Lr + 2276); b2c = *(const float4*)(Lr + 2280); b2d = *(const float4*)(Lr + 2284);
  __builtin_amdgcn_sched_barrier(0);
  sol[35] -= b0a.w * sol[34]; sol[36] -= b0b.x * sol[34]; sol[37] -= b0b.y * sol[34]; sol[38] -= b0b.z * sol[34]; sol[39] -= b0b.w * sol[34]; sol[40] -= b0c.x * sol[34]; sol[41] -= b0c.y * sol[34]; sol[42] -= b0c.z * sol[34]; sol[43] -= b0c.w * sol[34]; sol[44] -= b0d.x * sol[34]; sol[45] -= b0d.y * sol[34]; sol[46] -= b0d.z * sol[34]; sol[47] -= b0d.w * sol[34];
  __builtin_amdgcn_sched_barrier(0);
  b0a = *(const float4*)(Lr + 2288); b0b = *(const float4*)(Lr + 2292); b0c = *(const float4*)(Lr + 2296); b0d = *(const float4*)(Lr + 2300);
  __builtin_amdgcn_sched_barrier(0);
  sol[48] -= b1a.x * sol[34]; sol[49] -= b1a.y * sol[34]; sol[50] -= b1a.z * sol[34]; sol[51] -= b1a.w * sol[34]; sol[52] -= b1b.x * sol[34]; sol[53] -= b1b.y * sol[34]; sol[54] -= b1b.z * sol[34]; sol[55] -= b1b.w * sol[34]; sol[56] -= b1c.x * sol[34]; sol[57] -= b1c.y * sol[34]; sol[58] -= b1c.z * sol[34]; sol[59] -= b1c.w * sol[34]; sol[60] -= b1d.x * sol[34]; sol[61] -= b1d.y * sol[34]; sol[62] -= b1d.z * sol[34]; sol[63] -= b1d.w * sol[34];
  __builtin_amdgcn_sched_barrier(0);
  b1a = *(const float4*)(Lr + 2336); b1b = *(const float4*)(Lr + 2340); b1c = *(const float4*)(Lr + 2344); b1d = *(const float4*)(Lr + 2348);
  __builtin_amdgcn_sched_barrier(0);
  sol[36] -= b2b.x * sol[35]; sol[37] -= b2b.y * sol[35]; sol[38] -= b2b.z * sol[35]; sol[39] -= b2b.w * sol[35]; sol[40] -= b2c.x * sol[35]; sol[41] -= b2c.y * sol[35]; sol[42] -= b2c.z * sol[35]; sol[43] -= b2c.w * sol[35]; sol[44] -= b2d.x * sol[35]; sol[45] -= b2d.y * sol[35]; sol[46] -= b2d.z * sol[35]; sol[47] -= b2d.w * sol[35];
  __builtin_amdgcn_sched_barrier(0);
  b2a = *(const float4*)(Lr + 2352); b2b = *(const float4*)(Lr + 2356); b2c = *(const float4*)(Lr + 2360); b2d = *(const float4*)(Lr + 2364);
  __builtin_amdgcn_sched_barrier(0);
  sol[48] -= b0a.x * sol[35]; sol[49] -= b0a.y * sol[35]; sol[50] -= b0a.z * sol[35]; sol[51] -= b0a.w * sol[35]; sol[52] -= b0b.x * sol[35]; sol[53] -= b0b.y * sol[35]; sol[54] -= b0b.z * sol[35]; sol[55] -= b0b.w * sol[35]; sol[56] -= b0c.x * sol[35]; sol[57] -= b0c.y * sol[35]; sol[58] -= b0c.z * sol[35]; sol[59] -= b0c.w * sol[35]; sol[60] -= b0d.x * sol[35]; sol[61] -= b0d.y * sol[35]; sol[62] -= b0d.z * sol[35]; sol[63] -= b0d.w * sol[35];
  __builtin_amdgcn_sched_barrier(0);
  b0a = *(const float4*)(Lr + 2400); b0b = *(const float4*)(Lr + 2404); b0c = *(const float4*)(Lr + 2408); b0d = *(const float4*)(Lr + 2412);
  __builtin_amdgcn_sched_barrier(0);
  sol[37] -= b1b.y * sol[36]; sol[38] -= b1b.z * sol[36]; sol[39] -= b1b.w * sol[36]; sol[40] -= b1c.x * sol[36]; sol[41] -= b1c.y * sol[36]; sol[42] -= b1c.z * sol[36]; sol[43] -= b1c.w * sol[36]; sol[44] -= b1d.x * sol[36]; sol[45] -= b1d.y * sol[36]; sol[46] -= b1d.z * sol[36]; sol[47] -= b1d.w * sol[36];
  __builtin_amdgcn_sched_barrier(0);
  b1a = *(const float4*)(Lr + 2416); b1b = *(const float4*)(Lr + 2420); b1c = *(const float4*)(Lr + 2424); b1d = *(const float4*)(Lr + 2428);
  __builtin_amdgcn_sched_barrier(0);
  sol[48] -= b2a.x * sol[36]; sol[49] -= b2a.y * sol[36]; sol[50] -= b2a.z * sol[36]; sol[51] -= b2a.w * sol[36]; sol[52] -= b2b.x * sol[36]; sol[53] -= b2b.y * sol[36]; sol[54] -= b2b.z * sol[36]; sol[55] -= b2b.w * sol[36]; sol[56] -= b2c.x * sol[36]; sol[57] -= b2c.y * sol[36]; sol[58] -= b2c.z * sol[36]; sol[59] -= b2c.w * sol[36]; sol[60] -= b2d.x * sol[36]; sol[61] -= b2d.y * sol[36]; sol[62] -= b2d.z * sol[36]; sol[63] -= b2d.w * sol[36];
  __builtin_amdgcn_sched_barrier(0);
  b2a = *(const float4*)(Lr + 2464); b2b = *(const float4*)(Lr + 2468); b2c = *(const float4*)(Lr + 2472); b2d = *(const float4*)(Lr + 2476);
  __builtin_amdgcn_sched_barrier(0);
  sol[38] -= b0b.z * sol[37]; sol[39] -= b0b.w * sol[37]; sol[40] -= b0c.x * sol[37]; sol[41] -= b0c.y * sol[37]; sol[42] -= b0c.z * sol[37]; sol[43] -= b0c.w * sol[37]; sol[44] -= b0d.x * sol[37]; sol[45] -= b0d.y * sol[37]; sol[46] -= b0d.z * sol[37]; sol[47] -= b0d.w * sol[37];
  __builtin_amdgcn_sched_barrier(0);
  b0a = *(const float4*)(Lr + 2480); b0b = *(const float4*)(Lr + 2484); b0c = *(const float4*)(Lr + 2488); b0d = *(const float4*)(Lr + 2492);
  __builtin_amdgcn_sched_barrier(0);
  sol[48] -= b1a.x * sol[37]; sol[49] -= b1a.y * sol[37]; sol[50] -= b1a.z * sol[37]; sol[51] -= b1a.w * sol[37]; sol[52] -= b1b.x * sol[37]; sol[53] -= b1b.y * sol[37]; sol[54] -= b1b.z * sol[37]; sol[55] -= b1b.w * sol[37]; sol[56] -= b1c.x * sol[37]; sol[57] -= b1c.y * sol[37]; sol[58] -= b1c.z * sol[37]; sol[59] -= b1c.w * sol[37]; sol[60] -= b1d.x * sol[37]; sol[61] -= b1d.y * sol[37]; sol[62] -= b1d.z * sol[37]; sol[63] -= b1d.w * sol[37];
  __builtin_amdgcn_sched_barrier(0);
  b1a = *(const float4*)(Lr + 2528); b1b = *(const float4*)(Lr + 2532); b1c = *(const float4*)(Lr + 2536); b1d = *(const float4*)(Lr + 2540);
  __builtin_amdgcn_sched_barrier(0);
  sol[39] -= b2b.w * sol[38]; sol[40] -= b2c.x * sol[38]; sol[41] -= b2c.y * sol[38]; sol[42] -= b2c.z * sol[38]; sol[43] -= b2c.w * sol[38]; sol[44] -= b2d.x * sol[38]; sol[45] -= b2d.y * sol[38]; sol[46] -= b2d.z * sol[38]; sol[47] -= b2d.w * sol[38];
  __builtin_amdgcn_sched_barrier(0);
  b2a = *(const float4*)(Lr + 2544); b2b = *(const float4*)(Lr + 2548); b2c = *(const float4*)(Lr + 2552); b2d = *(const float4*)(Lr + 2556);
  __builtin_amdgcn_sched_barrier(0);
  sol[48] -= b0a.x * sol[38]; sol[49] -= b0a.y * sol[38]; sol[50] -= b0a.z * sol[38]; sol[51] -= b0a.w * sol[38]; sol[52] -= b0b.x * sol[38]; sol[53] -= b0b.y * sol[38]; sol[54] -= b0b.z * sol[38]; sol[55] -= b0b.w * sol[38]; sol[56] -= b0c.x * sol[38]; sol[57] -= b0c.y * sol[38]; sol[58] -= b0c.z * sol[38]; sol[59] -= b0c.w * sol[38]; sol[60] -= b0d.x * sol[38]; sol[61] -= b0d.y * sol[38]; sol[62] -= b0d.z * sol[38]; sol[63] -= b0d.w * sol[38];
  __builtin_amdgcn_sched_barrier(0);
  b0a = *(const float4*)(Lr + 2592); b0b = *(const float4*)(Lr + 2596); b0c = *(const float4*)(Lr + 2600); b0d = *(const float4*)(Lr + 2604);
  __builtin_amdgcn_sched_barrier(0);
  sol[40] -= b1c.x * sol[39]; sol[41] -= b1c.y * sol[39]; sol[42] -= b1c.z * sol[39]; sol[43] -= b1c.w * sol[39]; sol[44] -= b1d.x * sol[39]; sol[45] -= b1d.y * sol[39]; sol[46] -= b1d.z * sol[39]; sol[47] -= b1d.w * sol[39];
  __builtin_amdgcn_sched_barrier(0);
  b1a = *(const float4*)(Lr + 2608); b1b = *(const float4*)(Lr + 2612); b1c = *(const float4*)(Lr + 2616); b1d = *(const float4*)(Lr + 2620);
  __builtin_amdgcn_sched_barrier(0);
  sol[48] -= b2a.x * sol[39]; sol[49] -= b2a.y * sol[39]; sol[50] -= b2a.z * sol[39]; sol[51] -= b2a.w * sol[39]; sol[52] -= b2b.x * sol[39]; sol[53] -= b2b.y * sol[39]; sol[54] -= b2b.z * sol[39]; sol[55] -= b2b.w * sol[39]; sol[56] -= b2c.x * sol[39]; sol[57] -= b2c.y * sol[39]; sol[58] -= b2c.z * sol[39]; sol[59] -= b2c.w * sol[39]; sol[60] -= b2d.x * sol[39]; sol[61] -= b2d.y * sol[39]; sol[62] -= b2d.z * sol[39]; sol[63] -= b2d.w * sol[39];
  __builtin_amdgcn_sched_barrier(0);
  b2a = *(const float4*)(Lr + 2656); b2b = *(const float4*)(Lr + 2660); b2c = *(const float4*)(Lr + 2664); b2d = *(const float4*)(Lr + 2668);
  __builtin_amdgcn_sched_barrier(0);
  sol[41] -= b0c.y * sol[40]; sol[42] -= b0c.z * sol[40]; sol[43] -= b0c.w * sol[40]; sol[44] -= b0d.x * sol[40]; sol[45] -= b0d.y * sol[40]; sol[46] -= b0d.z * sol[40]; sol[47] -= b0d.w * sol[40];
  __builtin_amdgcn_sched_barrier(0);
  b0a = *(const float4*)(Lr + 2672); b0b = *(const float4*)(Lr + 2676); b0c = *(const float4*)(Lr + 2680); b0d = *(const float4*)(Lr + 2684);
  __builtin_amdgcn_sched_barrier(0);
  sol[48] -= b1a.x * sol[40]; sol[49] -= b1a.y * sol[40]; sol[50] -= b1a.z * sol[40]; sol[51] -= b1a.w * sol[40]; sol[52] -= b1b.x * sol[40]; sol[53] -= b1b.y * sol[40]; sol[54] -= b1b.z * sol[40]; sol[55] -= b1b.w * sol[40]; sol[56] -= b1c.x * sol[40]; sol[57] -= b1c.y * sol[40]; sol[58] -= b1c.z * sol[40]; sol[59] -= b1c.w * sol[40]; sol[60] -= b1d.x * sol[40]; sol[61] -= b1d.y * sol[40]; sol[62] -= b1d.z * sol[40]; sol[63] -= b1d.w * sol[40];
  __builtin_amdgcn_sched_barrier(0);
  b1a = *(const float4*)(Lr + 2720); b1b = *(const float4*)(Lr + 2724); b1c = *(const float4*)(Lr + 2728); b1d = *(const float4*)(Lr + 2732);
  __builtin_amdgcn_sched_barrier(0);
  sol[42] -= b2c.z * sol[41]; sol[43] -= b2c.w * sol[41]; sol[44] -= b2d.x * sol[41]; sol[45] -= b2d.y * sol[41]; sol[46] -= b2d.z * sol[41]; sol[47] -= b2d.w * sol[41];
  __builtin_amdgcn_sched_barrier(0);
  b2a = *(const float4*)(Lr + 2736); b2b = *(const float4*)(Lr + 2740); b2c = *(const float4*)(Lr + 2744); b2d = *(const float4*)(Lr + 2748);
  __builtin_amdgcn_sched_barrier(0);
  sol[48] -= b0a.x * sol[41]; sol[49] -= b0a.y * sol[41]; sol[50] -= b0a.z * sol[41]; sol[51] -= b0a.w * sol[41]; sol[52] -= b0b.x * sol[41]; sol[53] -= b0b.y * sol[41]; sol[54] -= b0b.z * sol[41]; sol[55] -= b0b.w * sol[41]; sol[56] -= b0c.x * sol[41]; sol[57] -= b0c.y * sol[41]; sol[58] -= b0c.z * sol[41]; sol[59] -= b0c.w * sol[41]; sol[60] -= b0d.x * sol[41]; sol[61] -= b0d.y * sol[41]; sol[62] -= b0d.z * sol[41]; sol[63] -= b0d.w * sol[41];
  __builtin_amdgcn_sched_barrier(0);
  b0a = *(const float4*)(Lr + 2784); b0b = *(const float4*)(Lr + 2788); b0c = *(const float4*)(Lr + 2792); b0d = *(const float4*)(Lr + 2796);
  __builtin_amdgcn_sched_barrier(0);
  sol[43] -= b1c.w * sol[42]; sol[44] -= b1d.x * sol[42]; sol[45] -= b1d.y * sol[42]; sol[46] -= b1d.z * sol[42]; sol[47] -= b1d.w * sol[42];
  __builtin_amdgcn_sched_barrier(0);
  b1a = *(const float4*)(Lr + 2800); b1b = *(const float4*)(Lr + 2804); b1c = *(const float4*)(Lr + 2808); b1d = *(const float4*)(Lr + 2812);
  __builtin_amdgcn_sched_barrier(0);
  sol[48] -= b2a.x * sol[42]; sol[49] -= b2a.y * sol[42]; sol[50] -= b2a.z * sol[42]; sol[51] -= b2a.w * sol[42]; sol[52] -= b2b.x * sol[42]; sol[53] -= b2b.y * sol[42]; sol[54] -= b2b.z * sol[42]; sol[55] -= b2b.w * sol[42]; sol[56] -= b2c.x * sol[42]; sol[57] -= b2c.y * sol[42]; sol[58] -= b2c.z * sol[42]; sol[59] -= b2c.w * sol[42]; sol[60] -= b2d.x * sol[42]; sol[61] -= b2d.y * sol[42]; sol[62] -= b2d.z * sol[42]; sol[63] -= b2d.w * sol[42];
  __builtin_amdgcn_sched_barrier(0);
  b2a = *(const float4*)(Lr + 2848); b2b = *(const float4*)(Lr + 2852); b2c = *(const float4*)(Lr + 2856); b2d = *(const float4*)(Lr + 2860);
  __builtin_amdgcn_sched_barrier(0);
  sol[44] -= b0d.x * sol[43]; sol[45] -= b0d.y * sol[43]; sol[46] -= b0d.z * sol[43]; sol[47] -= b0d.w * sol[43];
  __builtin_amdgcn_sched_barrier(0);
  b0a = *(const float4*)(Lr + 2864); b0b = *(const float4*)(Lr + 2868); b0c = *(const float4*)(Lr + 2872); b0d = *(const float4*)(Lr + 2876);
  __builtin_amdgcn_sched_barrier(0);
  sol[48] -= b1a.x * sol[43]; sol[49] -= b1a.y * sol[43]; sol[50] -= b1a.z * sol[43]; sol[51] -= b1a.w * sol[43]; sol[52] -= b1b.x * sol[43]; sol[53] -= b1b.y * sol[43]; sol[54] -= b1b.z * sol[43]; sol[55] -= b1b.w * sol[43]; sol[56] -= b1c.x * sol[43]; sol[57] -= b1c.y * sol[43]; sol[58] -= b1c.z * sol[43]; sol[59] -= b1c.w * sol[43]; sol[60] -= b1d.x * sol[43]; sol[61] -= b1d.y * sol[43]; sol[62] -= b1d.z * sol[43]; sol[63] -= b1d.w * sol[43];
  __builtin_amdgcn_sched_barrier(0);
  b1a = *(const float4*)(Lr + 2912); b1b = *(const float4*)(Lr + 2916); b1c = *(const float4*)(Lr + 2920); b1d = *(const float4*)(Lr + 2924);
  __builtin_amdgcn_sched_barrier(0);
  sol[45] -= b2d.y * sol[44]; sol[46] -= b2d.z * sol[44]; sol[47] -= b2d.w * sol[44];
  __builtin_amdgcn_sched_barrier(0);
  b2a = *(const float4*)(Lr + 2928); b2b = *(const float4*)(Lr + 2932); b2c = *(const float4*)(Lr + 2936); b2d = *(const float4*)(Lr + 2940);
  __builtin_amdgcn_sched_barrier(0);
  sol[48] -= b0a.x * sol[44]; sol[49] -= b0a.y * sol[44]; sol[50] -= b0a.z * sol[44]; sol[51] -= b0a.w * sol[44]; sol[52] -= b0b.x * sol[44]; sol[53] -= b0b.y * sol[44]; sol[54] -= b0b.z * sol[44]; sol[55] -= b0b.w * sol[44]; sol[56] -= b0c.x * sol[44]; sol[57] -= b0c.y * sol[44]; sol[58] -= b0c.z * sol[44]; sol[59] -= b0c.w * sol[44]; sol[60] -= b0d.x * sol[44]; sol[61] -= b0d.y * sol[44]; sol[62] -= b0d.z * sol[44]; sol[63] -= b0d.w * sol[44];
  __builtin_amdgcn_sched_barrier(0);
  b0a = *(const float4*)(Lr + 2976); b0b = *(const float4*)(Lr + 2980); b0c = *(const float4*)(Lr + 2984); b0d = *(const float4*)(Lr + 2988);
  __builtin_amdgcn_sched_barrier(0);
  sol[46] -= b1d.z * sol[45]; sol[47] -= b1d.w * sol[45];
  __builtin_amdgcn_sched_barrier(0);
  b1a = *(const float4*)(Lr + 2992); b1b = *(const float4*)(Lr + 2996); b1c = *(const float4*)(Lr + 3000); b1d = *(const float4*)(Lr + 3004);
  __builtin_amdgcn_sched_barrier(0);
  sol[48] -= b2a.x * sol[45]; sol[49] -= b2a.y * sol[45]; sol[50] -= b2a.z * sol[45]; sol[51] -= b2a.w * sol[45]; sol[52] -= b2b.x * sol[45]; sol[53] -= b2b.y * sol[45]; sol[54] -= b2b.z * sol[45]; sol[55] -= b2b.w * sol[45]; sol[56] -= b2c.x * sol[45]; sol[57] -= b2c.y * sol[45]; sol[58] -= b2c.z * sol[45]; sol[59] -= b2c.w * sol[45]; sol[60] -= b2d.x * sol[45]; sol[61] -= b2d.y * sol[45]; sol[62] -= b2d.z * sol[45]; sol[63] -= b2d.w * sol[45];
  __builtin_amdgcn_sched_barrier(0);
  b2a = *(const float4*)(Lr + 3056); b2b = *(const float4*)(Lr + 3060); b2c = *(const float4*)(Lr + 3064); b2d = *(const float4*)(Lr + 3068);
  __builtin_amdgcn_sched_barrier(0);
  sol[47] -= b0d.w * sol[46];
  __builtin_amdgcn_sched_barrier(0);
  b0a = *(const float4*)(Lr + 3120); b0b = *(const float4*)(Lr + 3124); b0c = *(const float4*)(Lr + 3128); b0d = *(const float4*)(Lr + 3132);
  __builtin_amdgcn_sched_barrier(0);
  sol[48] -= b1a.x * sol[46]; sol[49] -= b1a.y * sol[46]; sol[50] -= b1a.z * sol[46]; sol[51] -= b1a.w * sol[46]; sol[52] -= b1b.x * sol[46]; sol[53] -= b1b.y * sol[46]; sol[54] -= b1b.z * sol[46]; sol[55] -= b1b.w * sol[46]; sol[56] -= b1c.x * sol[46]; sol[57] -= b1c.y * sol[46]; sol[58] -= b1c.z * sol[46]; sol[59] -= b1c.w * sol[46]; sol[60] -= b1d.x * sol[46]; sol[61] -= b1d.y * sol[46]; sol[62] -= b1d.z * sol[46]; sol[63] -= b1d.w * sol[46];
  __builtin_amdgcn_sched_barrier(0);
  b1a = *(const float4*)(Lr + 3184); b1b = *(const float4*)(Lr + 3188); b1c = *(const float4*)(Lr + 3192); b1d = *(const float4*)(Lr + 3196);
  __builtin_amdgcn_sched_barrier(0);
  sol[48] -= b2a.x * sol[47]; sol[49] -= b2a.y * sol[47]; sol[50] -= b2a.z * sol[47]; sol[51] -= b2a.w * sol[47]; sol[52] -= b2b.x * sol[47]; sol[53] -= b2b.y * sol[47]; sol[54] -= b2b.z * sol[47]; sol[55] -= b2b.w * sol[47]; sol[56] -= b2c.x * sol[47]; sol[57] -= b2c.y * sol[47]; sol[58] -= b2c.z * sol[47]; sol[59] -= b2c.w * sol[47]; sol[60] -= b2d.x * sol[47]; sol[61] -= b2d.y * sol[47]; sol[62] -= b2d.z * sol[47]; sol[63] -= b2d.w * sol[47];
  __builtin_amdgcn_sched_barrier(0);
  b2a = *(const float4*)(Lr + 3248); b2b = *(const float4*)(Lr + 3252); b2c = *(const float4*)(Lr + 3256); b2d = *(const float4*)(Lr + 3260);
  __builtin_amdgcn_sched_barrier(0);
  sol[49] -= b0a.y * sol[48]; sol[50] -= b0a.z * sol[48]; sol[51] -= b0a.w * sol[48]; sol[52] -= b0b.x * sol[48]; sol[53] -= b0b.y * sol[48]; sol[54] -= b0b.z * sol[48]; sol[55] -= b0b.w * sol[48]; sol[56] -= b0c.x * sol[48]; sol[57] -= b0c.y * sol[48]; sol[58] -= b0c.z * sol[48]; sol[59] -= b0c.w * sol[48]; sol[60] -= b0d.x * sol[48]; sol[61] -= b0d.y * sol[48]; sol[62] -= b0d.z * sol[48]; sol[63] -= b0d.w * sol[48];
  __builtin_amdgcn_sched_barrier(0);
  b0a = *(const float4*)(Lr + 3312); b0b = *(const float4*)(Lr + 3316); b0c = *(const float4*)(Lr + 3320); b0d = *(const float4*)(Lr + 3324);
  __builtin_amdgcn_sched_barrier(0);
  sol[50] -= b1a.z * sol[49]; sol[51] -= b1a.w * sol[49]; sol[52] -= b1b.x * sol[49]; sol[53] -= b1b.y * sol[49]; sol[54] -= b1b.z * sol[49]; sol[55] -= b1b.w * sol[49]; sol[56] -= b1c.x * sol[49]; sol[57] -= b1c.y * sol[49]; sol[58] -= b1c.z * sol[49]; sol[59] -= b1c.w * sol[49]; sol[60] -= b1d.x * sol[49]; sol[61] -= b1d.y * sol[49]; sol[62] -= b1d.z * sol[49]; sol[63] -= b1d.w * sol[49];
  __builtin_amdgcn_sched_barrier(0);
  b1a = *(const float4*)(Lr + 3376); b1b = *(const float4*)(Lr + 3380); b1c = *(const float4*)(Lr + 3384); b1d = *(const float4*)(Lr + 3388);
  __builtin_amdgcn_sched_barrier(0);
  sol[51] -= b2a.w * sol[50]; sol[52] -= b2b.x * sol[50]; sol[53] -= b2b.y * sol[50]; sol[54] -= b2b.z * sol[50]; sol[55] -= b2b.w * sol[50]; sol[56] -= b2c.x * sol[50]; sol[57] -= b2c.y * sol[50]; sol[58] -= b2c.z * sol[50]; sol[59] -= b2c.w * sol[50]; sol[60] -= b2d.x * sol[50]; sol[61] -= b2d.y * sol[50]; sol[62] -= b2d.z * sol[50]; sol[63] -= b2d.w * sol[50];
  __builtin_amdgcn_sched_barrier(0);
  b2a = *(const float4*)(Lr + 3440); b2b = *(const float4*)(Lr + 3444); b2c = *(const float4*)(Lr + 3448); b2d = *(const float4*)(Lr + 3452);
  __builtin_amdgcn_sched_barrier(0);
  sol[52] -= b0b.x * sol[51]; sol[53] -= b0b.y * sol[51]; sol[54] -= b0b.z * sol[51]; sol[55] -= b0b.w * sol[51]; sol[56] -= b0c.x * sol[51]; sol[57] -= b0c.y * sol[51]; sol[58] -= b0c.z * sol[51]; sol[59] -= b0c.w * sol[51]; sol[60] -= b0d.x * sol[51]; sol[61] -= b0d.y * sol[51]; sol[62] -= b0d.z * sol[51]; sol[63] -= b0d.w * sol[51];
  __builtin_amdgcn_sched_barrier(0);
  b0a = *(const float4*)(Lr + 3504); b0b = *(const float4*)(Lr + 3508); b0c = *(const float4*)(Lr + 3512); b0d = *(const float4*)(Lr + 3516);
  __builtin_amdgcn_sched_barrier(0);
  sol[53] -= b1b.y * sol[52]; sol[54] -= b1b.z * sol[52]; sol[55] -= b1b.w * sol[52]; sol[56] -= b1c.x * sol[52]; sol[57] -= b1c.y * sol[52]; sol[58] -= b1c.z * sol[52]; sol[59] -= b1c.w * sol[52]; sol[60] -= b1d.x * sol[52]; sol[61] -= b1d.y * sol[52]; sol[62] -= b1d.z * sol[52]; sol[63] -= b1d.w * sol[52];
  __builtin_amdgcn_sched_barrier(0);
  b1a = *(const float4*)(Lr + 3568); b1b = *(const float4*)(Lr + 3572); b1c = *(const float4*)(Lr + 3576); b1d = *(const float4*)(Lr + 3580);
  __builtin_amdgcn_sched_barrier(0);
  sol[54] -= b2b.z * sol[53]; sol[55] -= b2b.w * sol[53]; sol[56] -= b2c.x * sol[53]; sol[57] -= b2c.y * sol[53]; sol[58] -= b2c.z * sol[53]; sol[59] -= b2c.w * sol[53]; sol[60] -= b2d.x * sol[53]; sol[61] -= b2d.y * sol[53]; sol[62] -= b2d.z * sol[53]; sol[63] -= b2d.w * sol[53];
  __builtin_amdgcn_sched_barrier(0);
  b2a = *(const float4*)(Lr + 3632); b2b = *(const float4*)(Lr + 3636); b2c = *(const float4*)(Lr + 3640); b2d = *(const float4*)(Lr + 3644);
  __builtin_amdgcn_sched_barrier(0);
  sol[55] -= b0b.w * sol[54]; sol[56] -= b0c.x * sol[54]; sol[57] -= b0c.y * sol[54]; sol[58] -= b0c.z * sol[54]; sol[59] -= b0c.w * sol[54]; sol[60] -= b0d.x * sol[54]; sol[61] -= b0d.y * sol[54]; sol[62] -= b0d.z * sol[54]; sol[63] -= b0d.w * sol[54];
  __builtin_amdgcn_sched_barrier(0);
  b0a = *(const float4*)(Lr + 3696); b0b = *(const float4*)(Lr + 3700); b0c = *(const float4*)(Lr + 3704); b0d = *(const float4*)(Lr + 3708);
  __builtin_amdgcn_sched_barrier(0);
  sol[56] -= b1c.x * sol[55]; sol[57] -= b1c.y * sol[55]; sol[58] -= b1c.z * sol[55]; sol[59] -= b1c.w * sol[55]; sol[60] -= b1d.x * sol[55]; sol[61] -= b1d.y * sol[55]; sol[62] -= b1d.z * sol[55]; sol[63] -= b1d.w * sol[55];
  __builtin_amdgcn_sched_barrier(0);
  b1a = *(const float4*)(Lr + 3760); b1b = *(const float4*)(Lr + 3764); b1c = *(const float4*)(Lr + 3768); b1d = *(const float4*)(Lr + 3772);
  __builtin_amdgcn_sched_barrier(0);
  sol[57] -= b2c.y * sol[56]; sol[58] -= b2c.z * sol[56]; sol[59] -= b2c.w * sol[56]; sol[60] -= b2d.x * sol[56]; sol[61] -= b2d.y * sol[56]; sol[62] -= b2d.z * sol[56]; sol[63] -= b2d.w * sol[56];
  __builtin_amdgcn_sched_barrier(0);
  b2a = *(const float4*)(Lr + 3824); b2b = *(const float4*)(Lr + 3828); b2c = *(const float4*)(Lr + 3832); b2d = *(const float4*)(Lr + 3836);
  __builtin_amdgcn_sched_barrier(0);
  sol[58] -= b0c.z * sol[57]; sol[59] -= b0c.w * sol[57]; sol[60] -= b0d.x * sol[57]; sol[61] -= b0d.y * sol[57]; sol[62] -= b0d.z * sol[57]; sol[63] -= b0d.w * sol[57];
  __builtin_amdgcn_sched_barrier(0);
  b0a = *(const float4*)(Lr + 3888); b0b = *(const float4*)(Lr + 3892); b0c = *(const float4*)(Lr + 3896); b0d = *(const float4*)(Lr + 3900);
  __builtin_amdgcn_sched_barrier(0);
  sol[59] -= b1c.w * sol[58]; sol[60] -= b1d.x * sol[58]; sol[61] -= b1d.y * sol[58]; sol[62] -= b1d.z * sol[58]; sol[63] -= b1d.w * sol[58];
  __builtin_amdgcn_sched_barrier(0);
  b1a = *(const float4*)(Lr + 3952); b1b = *(const float4*)(Lr + 3956); b1c = *(const float4*)(Lr + 3960); b1d = *(const float4*)(Lr + 3964);
  __builtin_amdgcn_sched_barrier(0);
  sol[60] -= b2d.x * sol[59]; sol[61] -= b2d.y * sol[59]; sol[62] -= b2d.z * sol[59]; sol[63] -= b2d.w * sol[59];
  __builtin_amdgcn_sched_barrier(0);
  b2a = *(const float4*)(Lr + 4016); b2b = *(const float4*)(Lr + 4020); b2c = *(const float4*)(Lr + 4024); b2d = *(const float4*)(Lr + 4028);
  __builtin_amdgcn_sched_barrier(0);
  sol[61] -= b0d.y * sol[60]; sol[62] -= b0d.z * sol[60]; sol[63] -= b0d.w * sol[60];
  __builtin_amdgcn_sched_barrier(0);
  __builtin_amdgcn_sched_barrier(0);
  sol[62] -= b1d.z * sol[61]; sol[63] -= b1d.w * sol[61];
  __builtin_amdgcn_sched_barrier(0);
  __builtin_amdgcn_sched_barrier(0);
  sol[63] -= b2d.w * sol[62];
  __builtin_amdgcn_sched_barrier(0);
}

template <int DIR>
__device__ __forceinline__ void solve_cols(const Params& P, int itb, int c, const float* Lt, const float* bpp, const float* gcp,
                                           const u16* Vs, const u16* Ks) {
  float sol[64];
  const float* bp_ = bpp + DIR * 64;
  const float* gc_ = gcp + DIR * 64;
  if (c < 128) {
    const u16* vp = Vs + c;
#pragma unroll
    for (int p = 0; p < 64; ++p) sol[p] = bp_[p] * bf2f(vp[(DIR ? (63 - p) : p) * 136]);
  } else {
    const u16* kp = Ks + (c - 128);
#pragma unroll
    for (int p = 0; p < 64; ++p) sol[p] = bp_[p] * __expf(gc_[p]) * bf2f(kp[(DIR ? (63 - p) : p) * 136]);
  }
  const float* Lr = Lt + opq(DIR * 4096);
  solve_elim(sol, Lr);
  const size_t it2 = (size_t)(itb + DIR);
  if (c < 128) {
    u16* UF = (u16*)(P.ws + OFF_UF) + (it2 * 128 + c) * 64;
#pragma unroll
    for (int q = 0; q < 8; ++q) *(uint4*)(UF + q * 8) = pack8(sol + q * 8);
  } else {
    u16* Wg = (u16*)(P.ws + OFF_R2) + it2 * 8192 + (c - 128);
#pragma unroll
    for (int p = 0; p < 64; ++p) Wg[p * 128] = f2bf(-sol[p]);
  }
}

__device__ __forceinline__ void delta_prep_item(const Params& P, int item, char* lds) {
  const int tid = opq(threadIdx.x), lane = tid & 63, wv = tid >> 6, fr = lane & 15, fq = lane >> 4;
  const int cid = item >> 2, h = item & 3;
  const int row0 = cid * 64;
  int seq_lo, seq_hi;
  if (cid < 256) { seq_lo = (cid >> 6) * 4096; seq_hi = seq_lo + 4096; }
  else { seq_lo = 16384 + ((cid - 256) >> 2) * 256; seq_hi = seq_lo + 256; }
  u16* Qs = (u16*)(lds + opq(0));
  u16* Ks = (u16*)(lds + opq(17408));
  u16* Vs = (u16*)(lds + opq(34816));
  float* KKs = (float*)(lds + opq(52224));
  float* QKs = (float*)(lds + opq(69632));
  float* Lt = (float*)(lds + opq(87040));
  float* gtok = (float*)(lds + opq(119808));
  float* btok = gtok + 128;
  float* gcp = btok + 128;
  float* bpp = gcp + 128;
  u16* QKN = (u16*)((char*)P.out + OFF_QKN);
  lds_barrier();
  {
    const int j = tid >> 3, sg = tid & 7;
    const int row = row0 + j;
    const bool hm = (row - 1 >= seq_lo), hp = (row + 1 < seq_hi);
    const u16* qkv = (const u16*)(P.ws + OFF_R3);
#pragma unroll
    for (int s = 0; s < 3; ++s) {
      const int col = s * 512 + h * 128 + sg * 16;
      const u16* p0 = qkv + (size_t)row * 1536 + col;
      float y[16];
      float ssq = 0.f;
#pragma unroll
      for (int hh = 0; hh < 2; ++hh) {
        const uint4 c0 = *(const uint4*)(p0 + hh * 8);
        uint4 m0 = *(const uint4*)(p0 - (hm ? 1536 : 0) + hh * 8);
        uint4 n0 = *(const uint4*)(p0 + (hp ? 1536 : 0) + hh * 8);
        m0.x = hm ? m0.x : 0u; m0.y = hm ? m0.y : 0u; m0.z = hm ? m0.z : 0u; m0.w = hm ? m0.w : 0u;
        n0.x = hp ? n0.x : 0u; n0.y = hp ? n0.y : 0u; n0.z = hp ? n0.z : 0u; n0.w = hp ? n0.w : 0u;
        float fc[8], fm[8], fn[8];
        unpack8(c0, fc); unpack8(m0, fm); unpack8(n0, fn);
        const float* cwp = P.dn_conv_w + col + hh * 8;
        float cw0[8], cw1[8], cw2[8];
        {
          const float4 t0 = *(const float4*)(cwp), t1 = *(const float4*)(cwp + 4);
          const float4 t2 = *(const float4*)(cwp + 1536), t3 = *(const float4*)(cwp + 1540);
          const float4 t4 = *(const float4*)(cwp + 3072), t5 = *(const float4*)(cwp + 3076);
          cw0[0] = t0.x; cw0[1] = t0.y; cw0[2] = t0.z; cw0[3] = t0.w; cw0[4] = t1.x; cw0[5] = t1.y; cw0[6] = t1.z; cw0[7] = t1.w;
          cw1[0] = t2.x; cw1[1] = t2.y; cw1[2] = t2.z; cw1[3] = t2.w; cw1[4] = t3.x; cw1[5] = t3.y; cw1[6] = t3.z; cw1[7] = t3.w;
          cw2[0] = t4.x; cw2[1] = t4.y; cw2[2] = t4.z; cw2[3] = t4.w; cw2[4] = t5.x; cw2[5] = t5.y; cw2[6] = t5.z; cw2[7] = t5.w;
        }
#pragma unroll
        for (int e = 0; e < 8; ++e) {
          const float v = cw0[e] * fm[e] + cw1[e] * fc[e] + cw2[e] * fn[e];
          const float yy = v * sigm(v);
          y[hh * 8 + e] = yy;
          ssq += yy * yy;
        }
      }
      if (s < 2) {
        ssq += __shfl_xor(ssq, 1, 64); ssq += __shfl_xor(ssq, 2, 64); ssq += __shfl_xor(ssq, 4, 64);
        const float sc = rsqrtf(ssq + 1e-6f) * ((s == 0) ? 0.08838834764831845f : 1.f);
#pragma unroll
        for (int e = 0; e < 16; ++e) y[e] *= sc;
      }
      u16* dl = ((s == 0) ? Qs : ((s == 1) ? Ks : Vs)) + j * 136 + sg * 16;
      const uint4 o0 = pack8(y), o1 = pack8(y + 8);
      *(uint4*)dl = o0; *(uint4*)(dl + 8) = o1;
      if (s < 2) {
        u16* dg = QKN + (size_t)row * 1024 + s * 512 + h * 128 + sg * 16;
        *(uint4*)dg = o0; *(uint4*)(dg + 8) = o1;
      }
    }
  }
  if (tid < 128) {
    const int j = tid & 63, dir = tid >> 6;
    const float* BA = (const float*)(P.ws + OFF_BA) + (size_t)(row0 + j) * 16;
    const float bl = BA[dir * 4 + h], al = BA[8 + dir * 4 + h];
    const float xx = al + P.dn_dt_bias[dir * 4 + h];
    const float sp = (xx > 20.f) ? xx : log1pf(expf(xx));
    gtok[dir * 64 + j] = -expf(P.dn_a_log[dir * 4 + h]) * sp;
    btok[dir * 64 + j] = 1.f / (1.f + expf(-bl));
  }
  lds_barrier();
  if (tid < 128) {
    const int dir = tid >> 6, p = tid & 63;
    const int tk = dir ? (63 - p) : p;
    float a = gtok[dir * 64 + tk];
    const float bv = btok[dir * 64 + tk];
#pragma unroll
    for (int o = 1; o < 64; o <<= 1) {
      const float t = __shfl_up(a, o, 64);
      if (p >= o) a += t;
    }
    gcp[dir * 64 + p] = a;
    bpp[dir * 64 + p] = bv;
  }
  {
#pragma unroll
    for (int q = 0; q < 4; ++q) {
      const int t = wv * 4 + q;
      const int which = t >> 4, mi = (t >> 2) & 3, ni = t & 3;
      const u16* Am = (which ? Qs : Ks) + (mi * 16 + fr) * 136 + fq * 8;
      const u16* Bm = Ks + (ni * 16 + fr) * 136 + fq * 8;
      f32x4 a4 = {0.f, 0.f, 0.f, 0.f};
#pragma unroll
      for (int kk = 0; kk < 4; ++kk)
        a4 = __builtin_amdgcn_mfma_f32_16x16x32_bf16(*(const bf16x8*)(Am + kk * 32), *(const bf16x8*)(Bm + kk * 32), a4, 0, 0, 0);
      float* dst = which ? QKs : KKs;
#pragma unroll
      for (int e = 0; e < 4; ++e) dst[(mi * 16 + fq * 4 + e) * 68 + ni * 16 + fr] = a4[e];
    }
  }
  lds_barrier();
  const int itb = item * 2;
  {
    u16* AQ = (u16*)((char*)P.out + OFF_AQ);
#pragma unroll 8
    for (int idx = tid; idx < 8192; idx += NT) {
      const int dir = idx >> 12, p = (idx >> 6) & 63, s = idx & 63;
      const int tp = dir ? (63 - p) : p, ts = dir ? (63 - s) : s;
      const float dg = gcp[dir * 64 + p] - gcp[dir * 64 + s];
      const float dec = (p >= s) ? __expf(dg) : 0.f;
      AQ[((size_t)(itb + dir) * 64 + p) * 64 + s] = f2bf(QKs[tp * 68 + ts] * dec);
    }
#pragma unroll 8
    for (int idx = tid; idx < 8192; idx += NT) {
      const int dir = idx >> 12, s = (idx >> 6) & 63, p = idx & 63;
      const int tp = dir ? (63 - p) : p, ts = dir ? (63 - s) : s;
      const float dg = gcp[dir * 64 + p] - gcp[dir * 64 + s];
      const float lv = (p > s) ? bpp[dir * 64 + p] * KKs[ts * 68 + tp] * __expf(dg) : 0.f;
      Lt[dir * 4096 + s * 64 + p] = lv;
    }
    if (tid < 128) {
      float* GC = (float*)(P.ws + OFF_GC);
      GC[(size_t)(itb + (tid >> 6)) * 64 + (tid & 63)] = gcp[tid];
    }
  }
  lds_barrier();
  if (tid < 256) solve_cols<0>(P, itb, tid, Lt, bpp, gcp, Vs, Ks);
  else solve_cols<1>(P, itb, tid - 256, Lt, bpp, gcp, Vs, Ks);
}

__device__ __forceinline__ void s5end_tile(const Params& P, int t, char* lds) {
  const int g = t / 6, mt = (t % 6) >> 1, nt = t & 1;
  const int m0 = mt * 256, n0 = nt * 128;
  f32x16 acc[2][2];
  acc_zero(acc);
  gemm_main((const u16*)(P.ws + OFF_U5) + ((size_t)g * 544 + m0) * 512, 512,
            (const u16*)(P.ws + OFF_MEND) + ((size_t)g * 256 + n0) * 512, 512, 512, acc, (u16*)lds);
  TILE_COORDS
  float* E = (float*)(P.ws + OFF_E);
#pragma unroll
  for (int i = 0; i < 2; ++i)
#pragma unroll
    for (int j = 0; j < 2; ++j)
#pragma unroll
      for (int e = 0; e < 16; ++e) {
        const int row = TROW(m0, i, e);
        if (row < 544) E[((size_t)g * 544 + row) * 256 + TCOL(n0, j)] = acc[i][j][e];
      }
}

__device__ __forceinline__ void scan_chunk(const u16* Wl, const u16* QTl, const u16* KTl, const u16* AQl, u16* ST, u16* VT,
                                           int wd, int wq, int fr, int fq, float gl, f32x4& av, f32x4& ao, f32x4& accS0, f32x4& accS1) {
  {
    bf16x8 bS[4], a1[4], a2[4];
#pragma unroll
    for (int kk = 0; kk < 4; ++kk) {
      bS[kk] = *(const bf16x8*)(ST + (wd * 16 + fr) * 136 + kk * 32 + fq * 8);
      a1[kk] = *(const bf16x8*)(Wl + (wq * 16 + fr) * 136 + kk * 32 + fq * 8);
      a2[kk] = *(const bf16x8*)(QTl + (wq * 16 + fr) * 136 + kk * 32 + fq * 8);
    }
    __builtin_amdgcn_sched_barrier(0);
#pragma unroll
    for (int kk = 0; kk < 4; ++kk) {
      av = __builtin_amdgcn_mfma_f32_16x16x32_bf16(a1[kk], bS[kk], av, 0, 0, 0);
      ao = __builtin_amdgcn_mfma_f32_16x16x32_bf16(a2[kk], bS[kk], ao, 0, 0, 0);
    }
  }
  {
    uint2 v; v.x = pack2(av[0], av[1]); v.y = pack2(av[2], av[3]);
    *(uint2*)(VT + (wd * 16 + fr) * 72 + wq * 16 + fq * 4) = v;
  }
  bf16x8 qa[2], k0[2], k1[2];
#pragma unroll
  for (int ks = 0; ks < 2; ++ks) {
    qa[ks] = *(const bf16x8*)(AQl + (wq * 16 + fr) * 72 + ks * 32 + fq * 8);
    const int r0_ = (2 * wq) * 16 + fr, r1_ = (2 * wq + 1) * 16 + fr;
    k0[ks] = *(const bf16x8*)(KTl + r0_ * 72 + ((ks * 32 + fq * 8) ^ (((r0_ >> 3) & 7) << 3)));
    k1[ks] = *(const bf16x8*)(KTl + r1_ * 72 + ((ks * 32 + fq * 8) ^ (((r1_ >> 3) & 7) << 3)));
  }
  accS0[0] *= gl; accS0[1] *= gl; accS0[2] *= gl; accS0[3] *= gl;
  accS1[0] *= gl; accS1[1] *= gl; accS1[2] *= gl; accS1[3] *= gl;
  lds_barrier();
  {
    bf16x8 bV[2];
#pragma unroll
    for (int ks = 0; ks < 2; ++ks) bV[ks] = *(const bf16x8*)(VT + (wd * 16 + fr) * 72 + ks * 32 + fq * 8);
#pragma unroll
    for (int ks = 0; ks < 2; ++ks) {
      ao = __builtin_amdgcn_mfma_f32_16x16x32_bf16(qa[ks], bV[ks], ao, 0, 0, 0);
      accS0 = __builtin_amdgcn_mfma_f32_16x16x32_bf16(k0[ks], bV[ks], accS0, 0, 0, 0);
      accS1 = __builtin_amdgcn_mfma_f32_16x16x32_bf16(k1[ks], bV[ks], accS1, 0, 0, 0);
    }
  }
  {
    uint2 v; v.x = pack2(accS0[0], accS0[1]); v.y = pack2(accS0[2], accS0[3]);
    *(uint2*)(ST + (wd * 16 + fr) * 136 + (2 * wq) * 16 + fq * 4) = v;
    v.x = pack2(accS1[0], accS1[1]); v.y = pack2(accS1[2], accS1[3]);
    *(uint2*)(ST + (wd * 16 + fr) * 136 + (2 * wq + 1) * 16 + fq * 4) = v;
  }
}

__device__ __forceinline__ void delta_scan_block(const Params& P, int sb, char* lds) {
  const int tid = opq(threadIdx.x), lane = tid & 63, w = tid >> 6, fr = lane & 15, fq = lane >> 4;
  const int bhd = sb & 31, dvq = sb >> 5;
  const int b = bhd >> 3, h = (bhd >> 1) & 3, dir = bhd & 1;
  const int wd = w & 1, wq = w >> 1;
  const int dv0 = dvq * 32 + wd * 16;
  u16* Wl = (u16*)(lds + opq(0));
  u16* QTl = (u16*)(lds + opq(17408));
  u16* KTl = (u16*)(lds + opq(34816));
  u16* AQl = (u16*)(lds + opq(53248));
  u16* ST = (u16*)(lds + opq(62464));
  u16* VT = (u16*)(lds + opq(71168));
  lds_barrier();
  for (int i = tid; i < 32 * 136 / 2; i += NT) ((uint32_t*)ST)[i] = 0u;
  f32x4 accS0 = {0.f, 0.f, 0.f, 0.f}, accS1 = {0.f, 0.f, 0.f, 0.f};
  const u16* QKN = (const u16*)((const char*)P.out + OFF_QKN);
  const u16* AQg = (const u16*)((const char*)P.out + OFF_AQ);
  const u16* Wg = (const u16*)(P.ws + OFF_R2);
  const u16* UFg = (const u16*)(P.ws + OFF_UF);
  const float* GC = (const float*)(P.ws + OFF_GC);
  u16* Og = (u16*)(P.ws + OFF_O);

#define GLD16(dst, ptr) asm volatile("global_load_dwordx4 %0, %1, off" : "=v"(dst) : "v"(ptr) : "memory")
#define GLD8(dst, ptr) asm volatile("global_load_dwordx2 %0, %1, off" : "=v"(dst) : "v"(ptr) : "memory")
#define GLD4(dst, ptr) asm volatile("global_load_dword %0, %1, off" : "=v"(dst) : "v"(ptr) : "memory")
#define SC_DECL(S)                                                   \
  u32x4 S##w0, S##w1, S##q0, S##q1, S##k0, S##k1, S##a;              \
  float S##gq0, S##gq1, S##g63;                                      \
  u32x2 S##u;                                                        \
  int S##row0 = 0, S##lat = 0;
#define SC_PF_ONE(S, i)                                                                            \
    {                                                                                              \
      const int id = tid + (i) * 512;                                                              \
      const int p = id >> 4, seg = id & 15;                                                        \
      const int tk = dir ? (63 - p) : p;                                                           \
      GLD16(S##w##i, Wg + it2__ * 8192 + p * 128 + seg * 8);                                       \
      GLD16(S##q##i, QKN + (size_t)(S##row0 + tk) * 1024 + h * 128 + seg * 8);                     \
      GLD4(S##gq##i, GC + it2__ * 64 + p);                                                         \
      GLD16(S##k##i, QKN + (size_t)(S##row0 + tk) * 1024 + 512 + h * 128 + seg * 8);               \
    }
#define SC_PREFETCH(S, n_)                                                                         \
  {                                                                                                \
    const int n__ = (n_);                                                                          \
    int cid__;                                                                                     \
    if (n__ < 4) { cid__ = 256 + b * 4 + (dir ? (3 - n__) : n__); S##lat = 0; }                    \
    else { const int m__ = n__ - 4; cid__ = b * 64 + (dir ? (63 - m__) : m__); S##lat = 1; }       \
    S##row0 = cid__ * 64;                                                                          \
    const size_t it2__ = (size_t)((cid__ * 4 + h) * 2 + dir);                                      \
    SC_PF_ONE(S, 0)                                                                                \
    SC_PF_ONE(S, 1)                                                                                \
    GLD4(S##g63, GC + it2__ * 64 + 63);                                                            \
    GLD16(S##a, AQg + it2__ * 4096 + (tid >> 3) * 64 + (tid & 7) * 8);                             \
    GLD8(S##u, UFg + (it2__ * 128 + dv0 + fr) * 64 + wq * 16 + fq * 4);                            \
  }
#define SC_WAIT(S, CNT)                                                                            \
  asm volatile("s_waitcnt vmcnt(" #CNT ")"                                                         \
               : "+v"(S##w0), "+v"(S##w1), "+v"(S##q0), "+v"(S##q1), "+v"(S##k0), "+v"(S##k1), "+v"(S##a), \
                 "+v"(S##gq0), "+v"(S##gq1), "+v"(S##g63), "+v"(S##u)                              \
               :: "memory");
#define SC_STAGE_ONE(S, i)                                                    \
    {                                                                         \
      const int id = tid + (i) * 512;                                         \
      const int p = id >> 4, seg = id & 15;                                   \
      *(u32x4*)(Wl + p * 136 + seg * 8) = S##w##i;                            \
      float f[8];                                                             \
      unpack8(make_uint4(S##q##i.x, S##q##i.y, S##q##i.z, S##q##i.w), f);     \
      const float sq = __expf(S##gq##i);                                      \
      f[0] *= sq; f[1] *= sq; f[2] *= sq; f[3] *= sq; f[4] *= sq; f[5] *= sq; f[6] *= sq; f[7] *= sq; \
      *(uint4*)(QTl + p * 136 + seg * 8) = pack8(f);                          \
      unpack8(make_uint4(S##k##i.x, S##k##i.y, S##k##i.z, S##k##i.w), f);     \
      const float sk = __expf(S##g63 - S##gq##i);                             \
      u16* kd = KTl + (seg * 8) * 72 + (p ^ ((seg & 7) << 3));                \
      kd[0 * 72] = f2bf(f[0] * sk); kd[1 * 72] = f2bf(f[1] * sk); kd[2 * 72] = f2bf(f[2] * sk); kd[3 * 72] = f2bf(f[3] * sk); \
      kd[4 * 72] = f2bf(f[4] * sk); kd[5 * 72] = f2bf(f[5] * sk); kd[6 * 72] = f2bf(f[6] * sk); kd[7 * 72] = f2bf(f[7] * sk); \
    }
#define SC_STEP(S, n_, WCNT, DO_PF)                                                                   \
  {                                                                                                   \
    SC_WAIT(S, WCNT)                                                                                  \
    const int cur_row0 = S##row0, cur_lat = S##lat;                                                   \
    const float gl = __expf(S##g63);                                                                  \
    SC_STAGE_ONE(S, 0)                                                                                \
    SC_STAGE_ONE(S, 1)                                                                                \
    *(u32x4*)(AQl + (tid >> 3) * 72 + (tid & 7) * 8) = S##a;                                          \
    f32x4 av = f32x4{lo16(S##u.x), hi16(S##u.x), lo16(S##u.y), hi16(S##u.y)};                         \
    f32x4 ao = f32x4{0.f, 0.f, 0.f, 0.f};                                                             \
    lds_barrier();                                                                                    \
    if (DO_PF) SC_PREFETCH(S, (n_) + 2)                                                               \
    scan_chunk(Wl, QTl, KTl, AQl, ST, VT, wd, wq, fr, fq, gl, av, ao, accS0, accS1);                  \
    if (cur_lat) {                                                                                    \
      const int p0 = wq * 16 + fq * 4;                                                                \
      u16* og = Og + ((size_t)dir * 16384 + cur_row0) * 512 + h * 128 + dv0 + fr;                     \
      og[(size_t)(dir ? (63 - (p0 + 0)) : (p0 + 0)) * 512] = f2bf(ao[0]);                             \
      og[(size_t)(dir ? (63 - (p0 + 1)) : (p0 + 1)) * 512] = f2bf(ao[1]);                             \
      og[(size_t)(dir ? (63 - (p0 + 2)) : (p0 + 2)) * 512] = f2bf(ao[2]);                             \
      og[(size_t)(dir ? (63 - (p0 + 3)) : (p0 + 3)) * 512] = f2bf(ao[3]);                             \
    }                                                                                                 \
    lds_barrier();                                                                                    \
  }
  SC_DECL(A)
  SC_DECL(B)
  SC_PREFETCH(A, 0)
  SC_PREFETCH(B, 1)
  for (int n = 0; n < 66; n += 2) {
    SC_STEP(A, n, 11, true)
    SC_STEP(B, n + 1, 11, true)
  }
  SC_STEP(A, 66, 0, false)
  SC_STEP(B, 67, 0, false)
#undef SC_DECL
#undef SC_PF_ONE
#undef SC_PREFETCH
#undef SC_WAIT
#undef SC_STAGE_ONE
#undef SC_STEP
#undef GLD16
#undef GLD8
#undef GLD4
}

__device__ __forceinline__ void s5_carry_block(const Params& P, int cb) {
  const int idx = cb * NT + opq(threadIdx.x);
  const int n = idx & 63, g = (idx >> 6) & 31, r = (idx >> 11) & 1, b = idx >> 12;
  const int rg = r * 32 + g;
  const float step = expf(P.s5_log_step[rg]);
  float lr, li;
  lam_pow(step, P.s5_a_re[rg * 64 + n], P.s5_a_im[rg * 64 + n], 32, lr, li);
  const float* __restrict__ E = (const float*)(P.ws + OFF_E) + (size_t)g * 544 * 256 + r * 128 + n;
  u16* __restrict__ XIN = (u16*)(P.ws + OFF_XIN) + (size_t)g * 512 * 256 + r * 128 + n;
  float xr = 0.f, xi = 0.f;
  {
    float er[8], ei[8];
#pragma unroll
    for (int k = 0; k < 8; ++k) {
      const int row = 512 + b * 8 + (r ? (7 - k) : k);
      er[k] = E[(size_t)row * 256]; ei[k] = E[(size_t)row * 256 + 64];
    }
#pragma unroll
    for (int k = 0; k < 8; ++k) {
      const float nr = lr * xr - li * xi + er[k], ni = lr * xi + li * xr + ei[k];
      xr = nr; xi = ni;
    }
  }
  for (int k0 = 0; k0 < 128; k0 += 8) {
    float er[8], ei[8];
#pragma unroll
    for (int k = 0; k < 8; ++k) {
      const int row = b * 128 + (r ? (127 - (k0 + k)) : (k0 + k));
      er[k] = E[(size_t)row * 256]; ei[k] = E[(size_t)row * 256 + 64];
    }
#pragma unroll
    for (int k = 0; k < 8; ++k) {
      const int row = b * 128 + (r ? (127 - (k0 + k)) : (k0 + k));
      XIN[(size_t)row * 256] = f2bf(xr);
      XIN[(size_t)row * 256 + 64] = f2bf(xi);
      const float nr = lr * xr - li * xi + er[k], ni = lr * xi + li * xr + ei[k];
      xr = nr; xi = ni;
    }
  }
}

__device__ __forceinline__ void s5out_tile(const Params& P, int t, char* lds) {
  const int g = t >> 3, mt = (t >> 2) & 1, nt = t & 3;
  const int m0 = mt * 256, n0 = nt * 128;
  f32x16 acc[2][2];
  acc_zero(acc);
  gemm_main((const u16*)(P.ws + OFF_XIN) + ((size_t)g * 512 + m0) * 256, 256,
            (const u16*)(P.ws + OFF_MST) + ((size_t)g * 512 + n0) * 256, 256, 256, acc, (u16*)lds);
  gemm_main((const u16*)(P.ws + OFF_U5) + ((size_t)g * 544 + m0) * 512, 512,
            (const u16*)(P.ws + OFF_MINTRA) + ((size_t)g * 512 + n0) * 512, 512, 512, acc, (u16*)lds);
  TILE_COORDS
  u16* YB = (u16*)(P.ws + OFF_YB);
#pragma unroll
  for (int i = 0; i < 2; ++i)
#pragma unroll
    for (int j = 0; j < 2; ++j)
#pragma unroll
      for (int e = 0; e < 16; ++e) {
        const int row = TROW(m0, i, e), nn = TCOL(n0, j);
        const int token = row * 32 + (nn >> 4);
        YB[(size_t)token * 512 + g * 16 + (nn & 15)] = f2bf(gelu_tanh(acc[i][j][e]));
      }
}

__device__ __forceinline__ void delta_post_item(const Params& P, int item) {
  const int lane = opq(threadIdx.x) & 63, w = opq(threadIdx.x) >> 6;
  const int row = item * 8 + w;
  const u16* O = (const u16*)(P.ws + OFF_O);
  const uint4 o0 = *(const uint4*)(O + (size_t)row * 512 + lane * 8);
  const uint4 o1 = *(const uint4*)(O + ((size_t)16384 + row) * 512 + lane * 8);
  const uint4 zz = *(const uint4*)((const u16*)(P.ws + OFF_Z) + (size_t)row * 512 + lane * 8);
  float a[8], bq[8], z[8];
  unpack8(o0, a); unpack8(o1, bq); unpack8(zz, z);
  float ss = 0.f;
#pragma unroll
  for (int e = 0; e < 8; ++e) { a[e] += bq[e]; ss += a[e] * a[e]; }
  ss += __shfl_xor(ss, 1, 64); ss += __shfl_xor(ss, 2, 64); ss += __shfl_xor(ss, 4, 64); ss += __shfl_xor(ss, 8, 64);
  const float rstd = rsqrtf(ss * (1.f / 128.f) + 1e-6f);
  const float* nw = P.dn_norm_w + (lane & 15) * 8;
  float y[8];
#pragma unroll
  for (int e = 0; e < 8; ++e) y[e] = a[e] * rstd * nw[e] * (z[e] * sigm(z[e]));
  *(uint4*)((u16*)(P.ws + OFF_YA) + (size_t)row * 512 + lane * 8) = pack8(y);
}

__device__ __forceinline__ void glu_tile(const Params& P, int t, char* lds) {
  const int nt = t >> 6, mt = t & 63;
  const int m0 = mt * 256, n0 = nt * 128;
  f32x16 acc[2][2];
  acc_zero(acc);
  gemm_main((const u16*)(P.ws + OFF_YB) + (size_t)m0 * 512, 512, (const u16*)(P.ws + OFF_WT_GLU) + (size_t)n0 * 512, 512, 512, acc, (u16*)lds);
  TILE_COORDS
  u16* YG = (u16*)(P.ws + OFF_YG);
  {
    const int oc = nt * 64 + wn_ * 32 + fr_;
    const float bv = P.b_glu[oc], bg = P.b_glu[512 + oc];
#pragma unroll
    for (int i = 0; i < 2; ++i)
#pragma unroll
      for (int e = 0; e < 16; ++e) {
        const float val = acc[i][0][e] + bv, gt = acc[i][1][e] + bg;
        YG[TIDX2(m0, nt * 64 + wn_ * 32, i, e, 512)] = f2bf(val * sigm(gt));
      }
  }
}

__device__ __forceinline__ void gates_tile(const Params& P, int t, char* lds) {
  const int nt = t >> 6, mt = t & 63;
  const int m0 = mt * 256, n0 = nt * 128;
  f32x16 acc[2][2];
  acc_zero(acc);
  gemm_main((const u16*)(P.ws + OFF_R2) + (size_t)m0 * 1024, 1024, (const u16*)(P.ws + OFF_WT_IN) + (size_t)(2688 + n0) * 1024, 1024, 1024, acc, (u16*)lds);
  TILE_COORDS
  u16* SG = (u16*)(P.ws + OFF_SG);
#pragma unroll
  for (int i = 0; i < 2; ++i)
#pragma unroll
    for (int j = 0; j < 2; ++j)
#pragma unroll
      for (int e = 0; e < 16; ++e) SG[TIDX(m0, n0, i, j, e, 2048)] = f2bf(sigm(acc[i][j][e]));
}

__device__ __forceinline__ void mix_tile(const Params& P, int t, char* lds) {
  const int nt = t >> 6, mt = t & 63;
  const int m0 = mt * 256, n0 = nt * 128;
  const u16* SG = (const u16*)(P.ws + OFF_SG);
  f32x16 acc[2][2];
  u16* MIX = (u16*)(P.ws + OFF_MIX);
  acc_zero(acc);
  gemm_main((const u16*)(P.ws + OFF_YA) + (size_t)m0 * 512, 512, (const u16*)(P.ws + OFF_WT_AOUT) + (size_t)n0 * 512, 512, 512, acc, (u16*)lds);
  {
    TILE_COORDS
    u16 sv[2][2][16];
#pragma unroll
    for (int i = 0; i < 2; ++i)
#pragma unroll
      for (int j = 0; j < 2; ++j)
#pragma unroll
        for (int e = 0; e < 16; ++e) sv[i][j][e] = SG[TIDX(m0, n0, i, j, e, 2048)];
#pragma unroll
    for (int i = 0; i < 2; ++i)
#pragma unroll
      for (int j = 0; j < 2; ++j)
#pragma unroll
        for (int e = 0; e < 16; ++e) MIX[TIDX(m0, n0, i, j, e, 1024)] = f2bf(bf2f(sv[i][j][e]) * acc[i][j][e]);
  }
  acc_zero(acc);
  gemm_main((const u16*)(P.ws + OFF_YG) + (size_t)m0 * 512, 512, (const u16*)(P.ws + OFF_WT_BOUT) + (size_t)n0 * 512, 512, 512, acc, (u16*)lds);
  {
    TILE_COORDS
#pragma unroll
    for (int i = 0; i < 2; ++i) {
      u16 sv[2][16], pv[2][16];
#pragma unroll
      for (int j = 0; j < 2; ++j)
#pragma unroll
        for (int e = 0; e < 16; ++e) {
          sv[j][e] = SG[TIDX(m0, n0, i, j, e, 2048) + 1024];
          pv[j][e] = MIX[TIDX(m0, n0, i, j, e, 1024)];
        }
#pragma unroll
      for (int j = 0; j < 2; ++j)
#pragma unroll
        for (int e = 0; e < 16; ++e)
          MIX[TIDX(m0, n0, i, j, e, 1024)] = f2bf(bf2f(pv[j][e]) + bf2f(sv[j][e]) * acc[i][j][e]);
    }
  }
}

__device__ __forceinline__ void wo_tile(const Params& P, int t, char* lds) {
  const int nt = t >> 6, mt = t & 63;
  const int m0 = mt * 256, n0 = nt * 128;
  f32x16 acc[2][2];
  acc_zero(acc);
  gemm_main((const u16*)(P.ws + OFF_MIX) + (size_t)m0 * 1024, 1024, (const u16*)(P.ws + OFF_WT_O) + (size_t)n0 * 1024, 1024, 1024, acc, (u16*)lds);
  TILE_COORDS
  const float* MOD = (const float*)(P.ws + OFF_MOD) + (m0 >> 12) * 6144 + 2 * 1024;
  float xv[2][2][16];
#pragma unroll
  for (int j = 0; j < 2; ++j)
#pragma unroll
    for (int i = 0; i < 2; ++i)
#pragma unroll
      for (int e = 0; e < 16; ++e) xv[i][j][e] = P.x[TIDX(m0, n0, i, j, e, 1024)];
#pragma unroll
  for (int j = 0; j < 2; ++j) {
    const int col = TCOL(n0, j);
    const float gate = MOD[col];
#pragma unroll
    for (int i = 0; i < 2; ++i)
#pragma unroll
      for (int e = 0; e < 16; ++e) P.out[TIDX(m0, n0, i, j, e, 1024)] = xv[i][j][e] + gate * acc[i][j][e];
  }
}

__device__ __forceinline__ void norm2_item(const Params& P, int item) {
  const int lane = opq(threadIdx.x) & 63, w = opq(threadIdx.x) >> 6;
  const int rowA = item * 16 + w, rowB = rowA + 8;
  const float* MA = (const float*)(P.ws + OFF_MOD) + (rowA >> 12) * 6144;
  const float* MB = (const float*)(P.ws + OFF_MOD) + (rowB >> 12) * 6144;
  u16* H = (u16*)(P.ws + OFF_R2);
  norm_row2(P.out + (size_t)rowA * 1024, P.out + (size_t)rowB * 1024, P.norm2_w, MA + 3 * 1024, MA + 4 * 1024, MB + 3 * 1024, MB + 4 * 1024,
            H + (size_t)rowA * 1024, H + (size_t)rowB * 1024, lane);
}

__device__ __forceinline__ void up_tile(const Params& P, int t, int hh, char* lds) {
  const int nt = t >> 6, mt = t & 63;
  const int m0 = mt * 256, n0 = nt * 128;
  f32x16 acc[2][2];
  acc_zero(acc);
  gemm_main((const u16*)(P.ws + OFF_R2) + (size_t)m0 * 1024, 1024,
            (const u16*)(P.ws + OFF_WT_UP) + ((size_t)hh * 2816 + n0) * 1024, 1024, 1024, acc, (u16*)lds);
  TILE_COORDS
  u16* UPH = (u16*)(P.ws + OFF_UPH);
#pragma unroll
  for (int i = 0; i < 2; ++i)
#pragma unroll
    for (int j = 0; j < 2; ++j)
#pragma unroll
      for (int e = 0; e < 16; ++e) UPH[TIDX(m0, n0, i, j, e, 2816)] = f2bf(acc[i][j][e]);
}

#define CG_LD(ci, dy)                                                                       \
    {                                                                                       \
      const int xc = x0 - 1 + (ci);                                                         \
      const bool cok = (xc >= 0) && (xc <= 63);                                             \
      const bool rok = ((dy) == 1) || ((dy) == 0 ? r0ok : r2ok);                            \
      const int yy = rok ? (y + (dy) - 1) : y;                                              \
      const u16* src = UPH + (base + (size_t)yy * 64 + (cok ? xc : x0)) * 2816 + c4 * 2;    \
      const uint4 q__ = *(const uint4*)src;               \
      uint2 g__ = make_uint2(q__.x, q__.y);                                                 \
      uint2 v__ = make_uint2(q__.z, q__.w);                                                 \
      const bool ok = cok && rok;                                                           \
      g__.x = ok ? g__.x : 0u; g__.y = ok ? g__.y : 0u;                                     \
      v__.x = ok ? v__.x : 0u; v__.y = ok ? v__.y : 0u;                                     \
      gg[ci][dy] = g__; vv[ci][dy] = v__;                                                   \
    }
__device__ __forceinline__ void convgate_phase(const Params& P, int hh) {
  const int tid = opq(threadIdx.x);
  if (tid >= 352) return;
  const int c4 = tid * 4;
  const u16* UPH = (const u16*)(P.ws + OFF_UPH);
  u16* G = (u16*)(P.ws + OFF_G);
  float wg[9][4], wv[9][4];
#pragma unroll
  for (int k = 0; k < 9; ++k) {
    const float4 a = *(const float4*)(P.ffn_conv_w + (size_t)k * 5632 + hh * 1408 + c4);
    const float4 bq = *(const float4*)(P.ffn_conv_w + (size_t)k * 5632 + 2816 + hh * 1408 + c4);
    wg[k][0] = a.x; wg[k][1] = a.y; wg[k][2] = a.z; wg[k][3] = a.w;
    wv[k][0] = bq.x; wv[k][1] = bq.y; wv[k][2] = bq.z; wv[k][3] = bq.w;
  }
  for (int item = blockIdx.x; item < 4096; item += gridDim.x) {
  const int xo = item & 15, y = (item >> 4) & 63, b = item >> 10;
  const size_t base = (size_t)b * 4096;
  const bool r0ok = (y > 0), r2ok = (y < 63);
  const int x0 = xo * 4;
  uint2 gg[6][3], vv[6][3];
#pragma unroll
  for (int ci = 0; ci < 6; ++ci) {
    CG_LD(ci, 0)
    CG_LD(ci, 1)
    CG_LD(ci, 2)
  }
#pragma unroll
  for (int xx = 0; xx < 4; ++xx) {
    float ag[4] = {0.f, 0.f, 0.f, 0.f}, av[4] = {0.f, 0.f, 0.f, 0.f};
#pragma unroll
    for (int dy = 0; dy < 3; ++dy)
#pragma unroll
      for (int dx = 0; dx < 3; ++dx) {
        const uint2 gq = gg[xx + dx][dy], vq = vv[xx + dx][dy];
        const int k = dy * 3 + dx;
        ag[0] += wg[k][0] * lo16(gq.x); ag[1] += wg[k][1] * hi16(gq.x); ag[2] += wg[k][2] * lo16(gq.y); ag[3] += wg[k][3] * hi16(gq.y);
        av[0] += wv[k][0] * lo16(vq.x); av[1] += wv[k][1] * hi16(vq.x); av[2] += wv[k][2] * lo16(vq.y); av[3] += wv[k][3] * hi16(vq.y);
      }
    uint2 o;
    o.x = pack2(ag[0] * sigm(ag[0]) * av[0], ag[1] * sigm(ag[1]) * av[1]);
    o.y = pack2(ag[2] * sigm(ag[2]) * av[2], ag[3] * sigm(ag[3]) * av[3]);
    *(uint2*)(G + (base + y * 64 + x0 + xx) * 2816 + hh * 1408 + c4) = o;
  }
  }
}
#undef CG_LD

__device__ __forceinline__ void down_tile(const Params& P, int t, char* lds) {
  const int nt = t >> 6, mt = t & 63;
  const int m0 = mt * 256, n0 = nt * 128;
  f32x16 acc[2][2];
  acc_zero(acc);
  gemm_main((const u16*)(P.ws + OFF_G) + (size_t)m0 * 2816, 2816, (const u16*)(P.ws + OFF_WT_DOWN) + (size_t)n0 * 2816, 2816, 2816, acc, (u16*)lds);
  TILE_COORDS
  const float* MOD = (const float*)(P.ws + OFF_MOD) + (m0 >> 12) * 6144 + 5 * 1024;
  float xv[2][2][16];
#pragma unroll
  for (int j = 0; j < 2; ++j)
#pragma unroll
    for (int i = 0; i < 2; ++i)
#pragma unroll
      for (int e = 0; e < 16; ++e) xv[i][j][e] = P.out[TIDX(m0, n0, i, j, e, 1024)];
#pragma unroll
  for (int j = 0; j < 2; ++j) {
    const int col = TCOL(n0, j);
    const float gate = MOD[col];
#pragma unroll
    for (int i = 0; i < 2; ++i)
#pragma unroll
      for (int e = 0; e < 16; ++e) P.out[TIDX(m0, n0, i, j, e, 1024)] = xv[i][j][e] + gate * acc[i][j][e];
  }
}

__device__ __forceinline__ void final_item(const Params& P, int item) {
  const int lane = opq(threadIdx.x) & 63, w = opq(threadIdx.x) >> 6;
  const int row = item * 8 + w;
  float* xr = P.out + (size_t)row * 1024;
  float4 v[4];
  float ss = 0.f;
#pragma unroll
  for (int it = 0; it < 4; ++it) {
    v[it] = *(const float4*)(xr + (it * 64 + lane) * 4);
    ss += v[it].x * v[it].x + v[it].y * v[it].y + v[it].z * v[it].z + v[it].w * v[it].w;
  }
  ss = wsum64(ss);
  const float rstd = rsqrtf(ss * (1.f / 1024.f) + 1e-6f);
#pragma unroll
  for (int it = 0; it < 4; ++it) {
    const int c = (it * 64 + lane) * 4;
    const float4 w4 = *(const float4*)(P.norm_f_w + c);
    float4 o;
    o.x = v[it].x * rstd * w4.x; o.y = v[it].y * rstd * w4.y; o.z = v[it].z * rstd * w4.z; o.w = v[it].w * rstd * w4.w;
    *(float4*)(xr + c) = o;
  }
}

__device__ __forceinline__ void run_phase(const Params& P, int ph, char* lds) {
  const int bid = blockIdx.x, nb = gridDim.x;
#ifdef ONLY_PHASE
  if (ph != ONLY_PHASE) return;
#endif
  switch (ph) {
    case 0: {
      for (int it = bid; it < 984 + 192 + 512; it += nb) {
        if (it < 296) convert_item(P.w_in, 1024, 4624, (u16*)(P.ws + OFF_WT_IN), 0, it, lds);
        else if (it < 328) convert_item(P.w_a_out, 512, 1024, (u16*)(P.ws + OFF_WT_AOUT), 1, it - 296, lds);
        else if (it < 360) convert_item(P.w_glu, 512, 1024, (u16*)(P.ws + OFF_WT_GLU), 2, it - 328, lds);
        else if (it < 392) convert_item(P.w_b_out, 512, 1024, (u16*)(P.ws + OFF_WT_BOUT), 3, it - 360, lds);
        else if (it < 456) convert_item(P.w_o, 1024, 1024, (u16*)(P.ws + OFF_WT_O), 4, it - 392, lds);
        else if (it < 808) convert_item(P.w_up, 1024, 5632, (u16*)(P.ws + OFF_WT_UP), 5, it - 456, lds);
        else if (it < 984) convert_item(P.w_down, 2816, 1024, (u16*)(P.ws + OFF_WT_DOWN), 6, it - 808, lds);
        else if (it < 1176) mod_item(P, it - 984, lds);
        else s5tab_item(P, it - 1176, lds);
      }
    } break;
    case 1:
      for (int it = bid; it < 1088 + 2048; it += nb) {
        if (it < 1088) norm1_item(P, it); else mintra_item(P, it - 1088);
      }
      break;
    case 2:
      for (int it = bid; it < 1396; it += nb) inproj_tile(P, it, lds);
      break;
    case 3:
      for (int it = bid; it < 1088 + 192; it += nb) {
        if (it < 1088) delta_prep_item(P, it, lds); else s5end_tile(P, it - 1088, lds);
      }
      break;
    case 4:
      if (bid < 128) delta_scan_block(P, bid, lds);
      else if (bid < 160) s5_carry_block(P, bid - 128);
      break;
    case 5:
      for (int it = bid; it < 256 + 2048 + 1024; it += nb) {
        if (it < 256) s5out_tile(P, it, lds);
        else if (it < 2304) delta_post_item(P, it - 256);
        else norm1_item(P, it - 2304);
      }
      break;
    case 6:
      for (int it = bid; it < 512 + 1024; it += nb) {
        if (it < 512) glu_tile(P, it, lds); else gates_tile(P, it - 512, lds);
      }
      break;
    case 7:
      for (int it = bid; it < 512; it += nb) mix_tile(P, it, lds);
      break;
    case 8:
      for (int it = bid; it < 512; it += nb) wo_tile(P, it, lds);
      break;
    case 9:
      for (int it = bid; it < 1024; it += nb) norm2_item(P, it);
      break;
    case 10:
      for (int it = bid; it < 1408; it += nb) up_tile(P, it, 0, lds);
      break;
    case 11:
      convgate_phase(P, 0);
      break;
    case 12:
      for (int it = bid; it < 1408; it += nb) up_tile(P, it, 1, lds);
      break;
    case 13:
      convgate_phase(P, 1);
      break;
    case 14:
      for (int it = bid; it < 512; it += nb) down_tile(P, it, lds);
      break;
    case 15:
      for (int it = bid; it < 2048; it += nb) final_item(P, it);
      break;
    default: break;
  }
}

typedef const __attribute__((address_space(4))) Params* KParamsPtr;
__global__ void __launch_bounds__(NT) fwd_megakernel(Params Pk) {
#if defined(__HIP_DEVICE_COMPILE__)
  extern __shared__ __attribute__((aligned(16))) char lds[];
  KParamsPtr pp = (KParamsPtr)__builtin_amdgcn_kernarg_segment_ptr();
  const int lo = (int)pp->ph_lo, hi = (int)pp->ph_hi;
#if MULTI_LAUNCH
  for (int ph = lo; ph < hi; ++ph) { KParamsPtr q = pp; asm volatile("" : "+s"(q)); Params P; for (int i_ = 0; i_ < (int)(sizeof(Params) / 8); ++i_) ((unsigned long long*)&P)[i_] = ((const __attribute__((address_space(4))) unsigned long long*)q)[i_]; run_phase(P, ph, lds); }
#else
  cg::grid_group grid = cg::this_grid();
  volatile LAS unsigned* xst = (volatile LAS unsigned*)(lds + (LDS_BYTES - 16));
  if (threadIdx.x == 0) { xst[0] = 0u; xst[1] = 0u; xst[2] = 0u; xst[3] = 0u; }
  __syncthreads();
  XcdBarrier xb = xcd_barrier_post((unsigned*)(pp->ws + OFF_BAR), xst);
  const unsigned rep_mask = (unsigned)pp->rep_mask;
  bool first_sync = true;
  for (int ph = lo; ph < hi; ++ph) {
    const int reps = 1 + (int)((rep_mask >> ph) & 1u);
    for (int rp = 0; rp < reps; ++rp) {
      {
        KParamsPtr q = pp;
        asm volatile("" : "+s"(q));
        Params P;
        {
          typedef __attribute__((address_space(1))) const float* GF;
          const float** dp = (const float**)&P;
          const __attribute__((address_space(4))) unsigned long long* sp = (const __attribute__((address_space(4))) unsigned long long*)q;
#pragma unroll
          for (int i_ = 0; i_ < 30; ++i_) dp[i_] = (const float*)(GF)(sp[i_]);
          P.out = (float*)(__attribute__((address_space(1))) float*)(sp[30]);
          P.ws = (char*)(__attribute__((address_space(1))) char*)(sp[31]);
          P.ph_lo = 0; P.ph_hi = 0; P.rep_mask = 0;
        }
        run_phase(P, ph, lds);
      }
      if (ph + 1 < hi || rp + 1 < reps) {
        if (first_sync) { grid.sync(); first_sync = false; }
        else xcd_barrier(xb);
      }
    }
  }
#endif
#endif
}

extern "C" void kernel_launch(void* const* d_in, const int* in_sizes, int n_in, void* d_out, int out_size, void* d_ws,
                              size_t ws_size, hipStream_t stream) {
  static int grid_blocks = 0;
  if (grid_blocks == 0) {
    if (n_in != 30 || out_size != 16384 * 1024 || ws_size < WS_NEED) {
      fprintf(stderr, "kernel_launch: unexpected shapes: n_in %d out %d ws %zu (need %zu)\n", n_in, out_size, ws_size, (size_t)WS_NEED);
      grid_blocks = -1;
      return;
    }
    int dev = 0, cus = 0, per_cu = 0;
    hipGetDevice(&dev);
    hipDeviceGetAttribute(&cus, hipDeviceAttributeMultiprocessorCount, dev);
    if (hipFuncSetAttribute((const void*)fwd_megakernel, hipFuncAttributeMaxDynamicSharedMemorySize, LDS_BYTES) != hipSuccess) {
      fprintf(stderr, "kernel_launch: hipFuncSetAttribute failed\n");
      grid_blocks = -1;
      return;
    }
    if (hipOccupancyMaxActiveBlocksPerMultiprocessor(&per_cu, (const void*)fwd_megakernel, NT, LDS_BYTES) != hipSuccess || per_cu < 1) {
      fprintf(stderr, "kernel_launch: occupancy query failed / zero (%d)\n", per_cu);
      grid_blocks = -1;
      return;
    }
    grid_blocks = cus;
    if (grid_blocks < 64) { fprintf(stderr, "kernel_launch: too few CUs (%d)\n", cus); grid_blocks = -1; return; }
  }
  if (grid_blocks < 0) return;
  (void)hipMemsetAsync((char*)d_ws + OFF_BAR, 0, XCD_BAR_WORDS * sizeof(unsigned), stream);
  Params p{};
  const float** pp = (const float**)&p;
  for (int i = 0; i < 30; ++i) pp[i] = (const float*)d_in[i];
  p.out = (float*)d_out;
  p.ws = (char*)d_ws;
#if MULTI_LAUNCH
  for (int ph = 0; ph < 16; ++ph) {
    p.ph_lo = ph; p.ph_hi = ph + 1;
    hipLaunchKernelGGL(fwd_megakernel, dim3(grid_blocks), dim3(NT), LDS_BYTES, stream, p);
  }
#else
  p.ph_lo = 0; p.ph_hi = 16;
#ifdef REPEAT_MASK
  p.rep_mask = REPEAT_MASK;
#endif
  void* args[] = {&p};
  hipError_t e = hipLaunchCooperativeKernel((const void*)fwd_megakernel, dim3(grid_blocks), dim3(NT), args, LDS_BYTES, stream);
  if (e != hipSuccess) fprintf(stderr, "cooperative launch failed: %s (grid %d)\n", hipGetErrorString(e), grid_blocks);
#endif
}
```

```cpp
#include <hip/hip_runtime.h>
#include <hip/hip_cooperative_groups.h>
#include <cstdio>
#include <cstdint>
namespace cg = cooperative_groups;

#ifndef MULTI_LAUNCH
#define MULTI_LAUNCH 0
#endif

typedef unsigned short u16;
typedef __attribute__((ext_vector_type(8))) short bf16x8;
typedef __attribute__((ext_vector_type(4))) float f32x4;
typedef __attribute__((ext_vector_type(16))) float f32x16;
typedef __attribute__((ext_vector_type(4))) unsigned int u32x4;
typedef __attribute__((ext_vector_type(2))) unsigned int u32x2;

#define NT 512
constexpr int LDS_BYTES = 131072 + 1024;
constexpr int NPHASE = 18;

constexpr size_t OFF_WT_IN   = 0;
constexpr size_t OFF_WT_AOUT = 9699328;
constexpr size_t OFF_WT_GLU  = 10747904;
constexpr size_t OFF_WT_BOUT = 11796480;
constexpr size_t OFF_WT_O    = 12845056;
constexpr size_t OFF_WT_UP   = 14942208;
constexpr size_t OFF_WT_DOWN = 26476544;
constexpr size_t OFF_MOD     = 32243712;
constexpr size_t OFF_BAR     = 32505856;
constexpr size_t OFF_R2      = 33554432;
constexpr size_t OFF_R1      = 69206016;
constexpr size_t OFF_KTAB    = OFF_R1;
constexpr size_t OFF_MEND    = OFF_R1 + 2097152;
constexpr size_t OFF_MST     = OFF_R1 + 10485760;
constexpr size_t OFF_MINTRA  = OFF_R1 + 18874368;
constexpr size_t OFF_R3      = 104857600;
constexpr size_t OFF_O       = OFF_R3;
constexpr size_t OFF_XIN     = OFF_R3 + 33554432;
constexpr size_t OFF_MIX     = 158334976;
constexpr size_t OFF_SG      = OFF_R1;
constexpr size_t OFF_Z       = 158334976;
constexpr size_t OFF_U5      = 175112192;
constexpr size_t OFF_BA      = 192937984;
constexpr size_t OFF_GC      = OFF_BA + 1179648;
constexpr size_t OFF_UF      = 195035136;
constexpr size_t OFF_YA      = OFF_UF;
constexpr size_t OFF_YB      = OFF_UF + 16777216;
constexpr size_t OFF_E       = 230686720;
constexpr size_t OFF_YG      = OFF_E;
constexpr size_t OFF_UPH     = OFF_R1;
constexpr size_t OFF_G       = 161480704;
constexpr size_t WS_NEED     = 253755392;
constexpr size_t OFF_QKN     = 0;
constexpr size_t OFF_AQ      = 35651584;

struct Params {
  const float *x, *c, *ctx, *c_ctx, *w_ada, *b_ada, *norm1_w, *w_in, *dn_conv_w, *dn_a_log, *dn_dt_bias, *dn_norm_w,
      *w_a_out, *s5_a_re, *s5_a_im, *s5_log_step, *s5_b_re, *s5_b_im, *s5_c_re, *s5_c_im, *s5_d, *w_glu, *b_glu,
      *w_b_out, *w_o, *norm2_w, *w_up, *ffn_conv_w, *w_down, *norm_f_w;
  float* out;
  char* ws;
  long long ph_lo, ph_hi;
  long long rep_mask;
};

#define XB_TMO      128
#define XB_XCNT(j)  (256  + 64 * (j))
#define XB_XSUB(j)  (1280 + 64 * (j))
#define XB_XGEN(j)  (2304 + 64 * (j))
#define XB_TOP      3328
#define XB_TOPGEN   3392
#define XCD_BAR_WORDS 3456
#define XB_SPIN_CAP (1u << 18)
#define LAS __attribute__((address_space(3)))

__device__ __forceinline__ unsigned xb_ld(unsigned* p)              { return __hip_atomic_load(p, __ATOMIC_RELAXED, __HIP_MEMORY_SCOPE_AGENT); }
__device__ __forceinline__ unsigned xb_add(unsigned* p, unsigned v) { return __hip_atomic_fetch_add(p, v, __ATOMIC_RELAXED, __HIP_MEMORY_SCOPE_AGENT); }
__device__ __forceinline__ unsigned xb_xcc_id() { return (unsigned)__builtin_amdgcn_s_getreg((3 << 11) | 20) & 0xFu; }
#define XB_SPIN(cond, bar) do { unsigned _sp = 0; while (cond) { __builtin_amdgcn_s_sleep(1); \
    if ((++_sp & 255u) == 0u) { if (xb_ld(&(bar)[XB_TMO])) break; if (_sp > XB_SPIN_CAP) { atomicAdd(&(bar)[XB_TMO], 1u); break; } } } } while (0)

struct XcdBarrier {
    unsigned* bar; unsigned x;
    volatile LAS unsigned* st;
};

__device__ __forceinline__ XcdBarrier xcd_barrier_post(unsigned* bar, volatile LAS unsigned* st) {
    XcdBarrier b; b.bar = bar; b.x = xb_xcc_id(); b.st = st;
    if (threadIdx.x == 0) (void)xb_add(&bar[XB_XCNT(b.x)], 1u);
    return b;
}
__device__ __forceinline__ void xcd_barrier_complete(unsigned* bar, unsigned x, unsigned& nloc, unsigned& nx) {
    const unsigned G = gridDim.x * gridDim.y * gridDim.z;
    unsigned sum, cnt, mine, sp = 0u;
    for (;;) {
        sum = 0u; cnt = 0u; mine = 0u;
#pragma unroll
        for (unsigned j = 0; j < 16; ++j) { const unsigned c = xb_ld(&bar[XB_XCNT(j)]); sum += c; cnt += (c > 0u) ? 1u : 0u; mine = (j == x) ? c : mine; }
        if (sum == G) break;
        __builtin_amdgcn_s_sleep(1);
        if ((++sp & 255u) == 0u) { if (xb_ld(&bar[XB_TMO])) break; if (sp > XB_SPIN_CAP) { atomicAdd(&bar[XB_TMO], 1u); break; } }
    }
    nloc = mine > 0u ? mine : 1u; nx = cnt > 0u ? cnt : 1u;
}

__device__ __forceinline__ void xcd_barrier(const XcdBarrier& b) {
    asm volatile("s_waitcnt vmcnt(0)" ::: "memory");
    __syncthreads();
    if (threadIdx.x == 0) {
        unsigned* bar = b.bar;
        __builtin_amdgcn_s_waitcnt(0);
        unsigned nloc = b.st[0], nx = b.st[1];
        if (nloc == 0u) { xcd_barrier_complete(bar, b.x, nloc, nx); b.st[0] = nloc; b.st[1] = nx; }
        const unsigned old = xb_add(&bar[XB_XSUB(b.x)], 1u);
        const unsigned gen = old / nloc;
        if (old + 1u == (gen + 1u) * nloc) {
            __builtin_amdgcn_fence(__ATOMIC_RELEASE, "agent");
            asm volatile("s_waitcnt vmcnt(0)" ::: "memory");
            const unsigned og = xb_add(&bar[XB_TOP], 1u);
            const unsigned tg = og / nx;
            if (og + 1u == (tg + 1u) * nx) xb_add(&bar[XB_TOPGEN], 1u);
            else XB_SPIN(xb_ld(&bar[XB_TOPGEN]) == tg, bar);
            __builtin_amdgcn_fence(__ATOMIC_ACQUIRE, "agent");
            xb_add(&bar[XB_XGEN(b.x)], 1u);
            asm volatile("s_waitcnt vmcnt(0)" ::: "memory");
        } else {
            XB_SPIN(xb_ld(&bar[XB_XGEN(b.x)]) == gen, bar);
            __builtin_amdgcn_fence(__ATOMIC_ACQUIRE, "agent");
            asm volatile("s_waitcnt vmcnt(0)" ::: "memory");
        }
    }
    __syncthreads();
}


typedef __attribute__((ext_vector_type(2))) float f32x2_t;
typedef __attribute__((ext_vector_type(2))) __bf16 bf16x2_t;
__device__ __forceinline__ u16 f2bf(float f) {
  const __bf16 h = (__bf16)f;
  return __builtin_bit_cast(u16, h);
}
__device__ __forceinline__ float bf2f(u16 h) { return __uint_as_float(((uint32_t)h) << 16); }
__device__ __forceinline__ uint32_t pack2(float a, float b) {
  const f32x2_t v = {a, b};
  const bf16x2_t r = __builtin_convertvector(v, bf16x2_t);
  return __builtin_bit_cast(uint32_t, r);
}
__device__ __forceinline__ float lo16(uint32_t w) { return __uint_as_float(w << 16); }
__device__ __forceinline__ float hi16(uint32_t w) { return __uint_as_float(w & 0xffff0000u); }
__device__ __forceinline__ int opq(int v) { asm volatile("" : "+v"(v)); return v; }
__device__ __forceinline__ void lds_barrier() {
  asm volatile("s_waitcnt lgkmcnt(0)" ::: "memory");
  __builtin_amdgcn_s_barrier();
  asm volatile("" ::: "memory");
}
__device__ __forceinline__ float sigm(float x) { return 1.f / (1.f + __expf(-x)); }
__device__ __forceinline__ void unpack8(uint4 v, float* f) {
  f[0] = lo16(v.x); f[1] = hi16(v.x); f[2] = lo16(v.y); f[3] = hi16(v.y);
  f[4] = lo16(v.z); f[5] = hi16(v.z); f[6] = lo16(v.w); f[7] = hi16(v.w);
}
__device__ __forceinline__ uint4 pack8(const float* f) {
  uint4 v; v.x = pack2(f[0], f[1]); v.y = pack2(f[2], f[3]); v.z = pack2(f[4], f[5]); v.w = pack2(f[6], f[7]);
  return v;
}
__device__ __forceinline__ float wsum64(float v) {
#pragma unroll
  for (int o = 32; o > 0; o >>= 1) v += __shfl_xor(v, o, 64);
  return v;
}
__device__ __forceinline__ float gelu_tanh(float x) {
  float u = 0.7978845608028654f * (x + 0.044715f * x * x * x);
  float t = 1.f - 2.f / (1.f + __expf(2.f * u));
  return 0.5f * x * (1.f + t);
}

__device__ __forceinline__ void g_frag(const u16* as, const u16* bs, int ks, bf16x8 (&a)[2], bf16x8 (&b)[2]) {
  a[0] = *(const bf16x8*)(as + ks * 16);
  a[1] = *(const bf16x8*)(as + 32 * 72 + ks * 16);
  b[0] = *(const bf16x8*)(bs + ks * 16);
  b[1] = *(const bf16x8*)(bs + 32 * 72 + ks * 16);
}
__device__ __forceinline__ void g_mma(const bf16x8 (&a)[2], const bf16x8 (&b)[2], f32x16 (&acc)[2][2]) {
  acc[0][0] = __builtin_amdgcn_mfma_f32_32x32x16_bf16(a[0], b[0], acc[0][0], 0, 0, 0);
  acc[0][1] = __builtin_amdgcn_mfma_f32_32x32x16_bf16(a[0], b[1], acc[0][1], 0, 0, 0);
  acc[1][0] = __builtin_amdgcn_mfma_f32_32x32x16_bf16(a[1], b[0], acc[1][0], 0, 0, 0);
  acc[1][1] = __builtin_amdgcn_mfma_f32_32x32x16_bf16(a[1], b[1], acc[1][1], 0, 0, 0);
}
__device__ __forceinline__ void gemm_main(const u16* __restrict__ A, int lda, const u16* __restrict__ Bt, int ldb, int K,
                                          f32x16 (&acc)[2][2], u16* lds) {
  const int tid = opq(threadIdx.x), lane = tid & 63, w = tid >> 6, wm = w >> 1, wn = w & 1, fr = lane & 31, fq = lane >> 5;
  u16* As = lds;
  u16* Bs = lds + 2 * 256 * 72;
  const int nk = K >> 6;
  uint4 p0, p1, p2, p3, p4, p5;
  uint4 q0, q1, q2, q3, q4, q5;
  uint4 r0, r1, r2, r3, r4, r5;
  const int lr = tid >> 3, lc = (tid & 7) * 8;
  const unsigned oa0 = (unsigned)(lr * lda + lc) * 2u, sa2 = (unsigned)lda * 128u;
  const unsigned oa1 = oa0 + sa2, oa2 = oa0 + 2u * sa2, oa3 = oa0 + 3u * sa2;
  const unsigned ob0 = (unsigned)(lr * ldb + lc) * 2u, ob1 = ob0 + (unsigned)ldb * 128u;
#define G_LOAD(S, kt_)                                          \
  {                                                             \
    const int kc_ = ((kt_) < nk) ? (kt_) : (nk - 1);            \
    const char* a_ = (const char*)A + kc_ * 128;                \
    const char* b_ = (const char*)Bt + kc_ * 128;               \
    S##0 = *(const uint4*)(a_ + oa0);                           \
    S##1 = *(const uint4*)(a_ + oa1);                           \
    S##2 = *(const uint4*)(a_ + oa2);                           \
    S##3 = *(const uint4*)(a_ + oa3);                           \
    S##4 = *(const uint4*)(b_ + ob0);                           \
    S##5 = *(const uint4*)(b_ + ob1);                           \
  }
#define G_STORE(S, buf_)                                                     \
  {                                                                          \
    u16* as_ = As + ((buf_) * 256 + lr) * 72 + lc;                           \
    u16* bs_ = Bs + ((buf_) * 128 + lr) * 72 + lc;                           \
    *(uint4*)(as_) = S##0;                                                   \
    *(uint4*)(as_ + 64 * 72) = S##1;                                         \
    *(uint4*)(as_ + 128 * 72) = S##2;                                        \
    *(uint4*)(as_ + 192 * 72) = S##3;                                        \
    *(uint4*)(bs_) = S##4;                                                   \
    *(uint4*)(bs_ + 64 * 72) = S##5;                                         \
  }
#define G_STEP(S, BUF, kt_)                                                               \
  {                                                                                       \
    const u16* as = As + ((BUF) * 256 + wm * 64 + fr) * 72 + fq * 8;                      \
    const u16* bs = Bs + ((BUF) * 128 + wn * 64 + fr) * 72 + fq * 8;                      \
    bf16x8 fa0[2], fb0[2], fa1[2], fb1[2], fa2[2], fb2[2];                                \
    g_frag(as, bs, 0, fa0, fb0);                                                          \
    g_frag(as, bs, 1, fa1, fb1);                                                          \
    __builtin_amdgcn_sched_barrier(0);                                                    \
    G_STORE(S, (BUF) ^ 1)                                                                 \
    G_LOAD(S, (kt_) + 4)                                                                  \
    __builtin_amdgcn_sched_barrier(0);                                                    \
    g_frag(as, bs, 2, fa2, fb2);                                                          \
    __builtin_amdgcn_sched_barrier(0);                                                    \
    g_mma(fa0, fb0, acc);                                                                 \
    __builtin_amdgcn_sched_barrier(0);                                                    \
    g_frag(as, bs, 3, fa0, fb0);                                                          \
    __builtin_amdgcn_sched_barrier(0);                                                    \
    g_mma(fa1, fb1, acc);                                                                 \
    g_mma(fa2, fb2, acc);                                                                 \
    g_mma(fa0, fb0, acc);                                                                 \
    lds_barrier();                                                                      \
  }
  G_LOAD(p, 0)
  lds_barrier();
  G_STORE(p, 0)
  G_LOAD(q, 1)
  G_LOAD(r, 2)
  G_LOAD(p, 3)
  lds_barrier();
  for (int kt = 0; kt < nk; kt += 6) {
    G_STEP(q, 0, kt)
    G_STEP(r, 1, kt + 1)
    if (kt + 2 < nk) {
      G_STEP(p, 0, kt + 2)
      G_STEP(q, 1, kt + 3)
    }
    if (kt + 4 < nk) {
      G_STEP(r, 0, kt + 4)
      G_STEP(p, 1, kt + 5)
    }
  }
#undef G_STEP
#undef G_LOAD
#undef G_STORE
}

__device__ __forceinline__ void acc_zero(f32x16 (&acc)[2][2]) {
#pragma unroll
  for (int i = 0; i < 2; ++i)
#pragma unroll
    for (int j = 0; j < 2; ++j)
#pragma unroll
      for (int e = 0; e < 16; ++e) acc[i][j][e] = 0.f;
}

#define TILE_COORDS                                                                                  \
  const int tid_ = opq(threadIdx.x), lane_ = tid_ & 63, w_ = __builtin_amdgcn_readfirstlane(tid_ >> 6), \
            wm_ = w_ >> 1, wn_ = w_ & 1, fr_ = lane_ & 31, fq_ = lane_ >> 5;
#define TROW(m0, i, e) ((m0) + wm_ * 64 + (i) * 32 + ((e) & 3) + 8 * ((e) >> 2) + 4 * fq_)
#define TCOL(n0, j) ((n0) + wn_ * 64 + (j) * 32 + fr_)
#define TIDX2(m0, cb, i, e, ld) ((size_t)((m0) + wm_ * 64 + (i) * 32 + ((e) & 3) + 8 * ((e) >> 2)) * (ld) + (cb) + (size_t)(unsigned)(4 * fq_ * (ld) + fr_))
#define TIDX(m0, n0, i, j, e, ld) TIDX2(m0, (n0) + wn_ * 64 + (j) * 32, i, e, ld)

__device__ __forceinline__ void tile_map8(int t, int& nt, int& mt) {
  const int sr = t >> 9, u = t & 511, rnd = u >> 8, idx = u & 255, xcd = idx & 7, slot = idx >> 3;
  mt = ((rnd * 8 + xcd) << 2) + (slot & 3);
  nt = sr * 8 + (slot >> 2);
}

__device__ __forceinline__ int srccol(int which, int r) {
  switch (which) {
    case 0:
      if (r < 2048) return r;
      if (r < 2560) return 2064 + (r - 2048);
      if (r < 2576) return 2048 + (r - 2560);
      if (r < 2688) return -1;
      if (r < 3712) return 2576 + (r - 2688);
      return 3600 + (r - 3712);
    case 2: {
      int tile = r >> 7, wn = (r >> 6) & 1, wi = r & 63;
      return (wi < 32) ? (tile * 64 + wn * 32 + wi) : (512 + tile * 64 + wn * 32 + (wi - 32));
    }
    case 5: {
      int hh = r / 2816, cc = r % 2816;
      int grp = cc >> 3, wi = cc & 7;
      return (wi < 4) ? (hh * 1408 + grp * 4 + wi) : (2816 + hh * 1408 + grp * 4 + (wi - 4));
    }
    default: return r;
  }
}

__device__ __forceinline__ void convert_item(const float* __restrict__ src, int K, int N, u16* __restrict__ dst, int which, int item, char* lds) {
  float* tile = (float*)lds;
  const int tid = opq(threadIdx.x);
  const int kb = K >> 8;
  const int r0 = (item / kb) * 64, k0 = (item % kb) * 256;
  lds_barrier();
  {
    const int n4 = (tid & 15) * 4, kk = tid >> 4;
    const int sc = srccol(which, r0 + n4);
    float4 v[8];
#pragma unroll
    for (int it = 0; it < 8; ++it) {
      const int k = kk + 32 * it;
      v[it] = (sc >= 0) ? *(const float4*)(src + (size_t)(k0 + k) * N + sc) : make_float4(0.f, 0.f, 0.f, 0.f);
    }
#pragma unroll
    for (int it = 0; it < 8; ++it) {
      const int k = kk + 32 * it;
      tile[(n4 + 0) * 257 + k] = v[it].x; tile[(n4 + 1) * 257 + k] = v[it].y;
      tile[(n4 + 2) * 257 + k] = v[it].z; tile[(n4 + 3) * 257 + k] = v[it].w;
    }
  }
  lds_barrier();
  {
    const int ks = (tid & 31) * 8, rr = tid >> 5;
#pragma unroll
    for (int it = 0; it < 4; ++it) {
      const int row = rr + 16 * it;
      float f[8];
#pragma unroll
      for (int e = 0; e < 8; ++e) f[e] = tile[row * 257 + ks + e];
      *(uint4*)(dst + (size_t)(r0 + row) * K + k0 + ks) = pack8(f);
    }
  }
}

__device__ __forceinline__ void mod_item(const Params& P, int item, char* lds) {
  float* sc = (float*)lds;
  float* red = sc + 5 * 1024;
  const int tid = opq(threadIdx.x);
  lds_barrier();
  for (int i = tid; i < 5 * 1024; i += NT) {
    const int r = i >> 10, k = i & 1023;
    float v = (r < 4) ? P.c[r * 1024 + k] : P.c_ctx[k];
    sc[i] = v * sigm(v);
  }
  lds_barrier();
  const int nn = tid & 31, kg = tid >> 5;
  const int n = item * 32 + nn;
  float a0 = 0, a1 = 0, a2 = 0, a3 = 0, a4 = 0;
  for (int kk = 0; kk < 64; ++kk) {
    const int k = kg * 64 + kk;
    const float wv = P.w_ada[(size_t)k * 6144 + n];
    a0 += sc[k] * wv; a1 += sc[1024 + k] * wv; a2 += sc[2048 + k] * wv; a3 += sc[3072 + k] * wv; a4 += sc[4096 + k] * wv;
  }
  red[(kg * 5 + 0) * 32 + nn] = a0; red[(kg * 5 + 1) * 32 + nn] = a1; red[(kg * 5 + 2) * 32 + nn] = a2;
  red[(kg * 5 + 3) * 32 + nn] = a3; red[(kg * 5 + 4) * 32 + nn] = a4;
  lds_barrier();
  if (tid < 160) {
    const int r = tid >> 5, n2 = tid & 31;
    float s = 0.f;
#pragma unroll
    for (int g = 0; g < 16; ++g) s += red[(g * 5 + r) * 32 + n2];
    float* MOD = (float*)(P.ws + OFF_MOD);
    MOD[r * 6144 + item * 32 + n2] = s + P.b_ada[item * 32 + n2];
  }
}

__device__ __forceinline__ void lam_pow(float step, float are, float aim, int e, float& pr, float& pi) {
  const float mag = expf((float)e * step * are);
  double ang = (double)e * (double)step * (double)aim;
  ang -= 6.283185307179586476925 * rint(ang * 0.15915494309189533577);
  float s, c;
  __sincosf((float)ang, &s, &c);
  pr = mag * c; pi = mag * s;
}

__device__ __forceinline__ void s5tab_item(const Params& P, int item, char* lds) {
  const int tid = opq(threadIdx.x);
  const int tq = item & 7, g = (item >> 3) & 31, r = item >> 8;
  float* cfr = (float*)lds;
  float* cfi = cfr + 64;
  float* p0r = cfi + 64;
  float* p0i = p0r + 64;
  float* p1r = p0i + 64;
  float* p1i = p1r + 64;
  float* Gr = p1i + 64;
  float* Gi = Gr + 1024;
  float* Cr = Gi + 1024;
  float* Ci = Cr + 1024;
  const int rg = r * 32 + g;
  u16* MEND = (u16*)(P.ws + OFF_MEND);
  u16* MST = (u16*)(P.ws + OFF_MST);
  float* KTAB = (float*)(P.ws + OFF_KTAB);
  lds_barrier();
  float step = 0.f, are = 0.f, aim = 0.f;
  if (tid < 64) {
    const int n = tid;
    step = expf(P.s5_log_step[rg]);
    are = P.s5_a_re[rg * 64 + n]; aim = P.s5_a_im[rg * 64 + n];
    const float za = step * are;
    double zb = (double)step * (double)aim;
    zb -= 6.283185307179586476925 * rint(zb * 0.15915494309189533577);
    float sb, cb, sh, ch;
    __sincosf((float)zb, &sb, &cb);
    __sincosf((float)(0.5 * zb), &sh, &ch);
    const float em1 = expm1f(za);
    const float re1 = em1 * cb - 2.f * sh * sh;
    const float im1 = (1.f + em1) * sb;
    const float den = are * are + aim * aim;
    cfr[n] = (re1 * are + im1 * aim) / den;
    cfi[n] = (im1 * are - re1 * aim) / den;
  }
  for (int i = tid; i < 1024; i += NT) {
    Cr[i] = P.s5_c_re[(size_t)rg * 1024 + i];
    Ci[i] = P.s5_c_im[(size_t)rg * 1024 + i];
  }
  const float br0 = P.s5_b_re[(size_t)rg * 1024 + tid], bi0 = P.s5_b_im[(size_t)rg * 1024 + tid];
  const float br1 = P.s5_b_re[(size_t)rg * 1024 + 512 + tid], bi1 = P.s5_b_im[(size_t)rg * 1024 + 512 + tid];
  for (int t4 = 0; t4 < 4; ++t4) {
    const int tau = tq * 4 + t4;
    if (tid < 64) {
      float pr, pi;
      lam_pow(step, are, aim, tau, pr, pi);
      p0r[tid] = pr; p0i[tid] = pi;
      lam_pow(step, are, aim, tau + 1, pr, pi);
      p1r[tid] = pr; p1i[tid] = pi;
    }
    lds_barrier();
    {
      const int i0 = tid, n0 = i0 >> 4;
      float tr = cfr[n0] * br0 - cfi[n0] * bi0, ti = cfr[n0] * bi0 + cfi[n0] * br0;
      Gr[i0] = p0r[n0] * tr - p0i[n0] * ti;
      Gi[i0] = p0r[n0] * ti + p0i[n0] * tr;
      const int i1 = tid + 512, n1 = i1 >> 4;
      tr = cfr[n1] * br1 - cfi[n1] * bi1; ti = cfr[n1] * bi1 + cfi[n1] * br1;
      Gr[i1] = p0r[n1] * tr - p0i[n1] * ti;
      Gi[i1] = p0r[n1] * ti + p0i[n1] * tr;
    }
    lds_barrier();
    {
      const int ii = (r == 0) ? (31 - tau) : tau;
      for (int i = tid; i < 2048; i += NT) {
        const int part = i >> 10, n = (i >> 4) & 63, pi_ = i & 15;
        const float v = part ? Gi[n * 16 + pi_] : Gr[n * 16 + pi_];
        MEND[((size_t)g * 256 + r * 128 + part * 64 + n) * 512 + ii * 16 + pi_] = f2bf(v);
      }
    }
    if (tid < 256) {
      const int po = tid >> 4, pi_ = tid & 15;
      float s = 0.f;
      for (int n = 0; n < 64; ++n) s += Cr[po * 64 + n] * Gr[n * 16 + pi_] - Ci[po * 64 + n] * Gi[n * 16 + pi_];
      KTAB[(((size_t)rg) * 32 + tau) * 256 + tid] = s;
    }
    {
      const int jj = (r == 0) ? tau : (31 - tau);
      for (int i = tid; i < 2048; i += NT) {
        const int po = i >> 7, part = (i >> 6) & 1, n = i & 63;
        const float cr = Cr[po * 64 + n], ci = Ci[po * 64 + n];
        const float v = part ? -(cr * p1i[n] + ci * p1r[n]) : (cr * p1r[n] - ci * p1i[n]);
        MST[((size_t)g * 512 + jj * 16 + po) * 256 + r * 128 + part * 64 + n] = f2bf(v);
      }
    }
    lds_barrier();
  }
}

__device__ __forceinline__ void norm_row(const float* __restrict__ xr, const float* __restrict__ nw, const float* __restrict__ shift,
                                         const float* __restrict__ scale, u16* __restrict__ dst, int lane) {
  float4 v[4];
  float ss = 0.f;
#pragma unroll
  for (int it = 0; it < 4; ++it) {
    v[it] = *(const float4*)(xr + (it * 64 + lane) * 4);
    ss += v[it].x * v[it].x + v[it].y * v[it].y + v[it].z * v[it].z + v[it].w * v[it].w;
  }
  ss = wsum64(ss);
  const float rstd = rsqrtf(ss * (1.f / 1024.f) + 1e-6f);
#pragma unroll
  for (int it = 0; it < 4; ++it) {
    const int c = (it * 64 + lane) * 4;
    const float4 w4 = *(const float4*)(nw + c), sh = *(const float4*)(shift + c), sc = *(const float4*)(scale + c);
    const float y0 = v[it].x * rstd * w4.x * (1.f + sc.x) + sh.x;
    const float y1 = v[it].y * rstd * w4.y * (1.f + sc.y) + sh.y;
    const float y2 = v[it].z * rstd * w4.z * (1.f + sc.z) + sh.z;
    const float y3 = v[it].w * rstd * w4.w * (1.f + sc.w) + sh.w;
    uint2 o; o.x = pack2(y0, y1); o.y = pack2(y2, y3);
    *(uint2*)(dst + c) = o;
  }
}

__device__ __forceinline__ void norm_row2(const float* __restrict__ xa, const float* __restrict__ xb, const float* __restrict__ nw,
                                          const float* __restrict__ shA, const float* __restrict__ scA,
                                          const float* __restrict__ shB, const float* __restrict__ scB,
                                          u16* __restrict__ da, u16* __restrict__ db, int lane) {
  float4 va[4], vb[4];
#pragma unroll
  for (int it = 0; it < 4; ++it) { va[it] = *(const float4*)(xa + (it * 64 + lane) * 4); vb[it] = *(const float4*)(xb + (it * 64 + lane) * 4); }
  float sa = 0.f, sb = 0.f;
#pragma unroll
  for (int it = 0; it < 4; ++it) {
    sa += va[it].x * va[it].x + va[it].y * va[it].y + va[it].z * va[it].z + va[it].w * va[it].w;
    sb += vb[it].x * vb[it].x + vb[it].y * vb[it].y + vb[it].z * vb[it].z + vb[it].w * vb[it].w;
  }
  sa = wsum64(sa); sb = wsum64(sb);
  const float ra = rsqrtf(sa * (1.f / 1024.f) + 1e-6f), rb = rsqrtf(sb * (1.f / 1024.f) + 1e-6f);
#pragma unroll
  for (int it = 0; it < 4; ++it) {
    const int c = (it * 64 + lane) * 4;
    const float4 w4 = *(const float4*)(nw + c);
    const float4 sh = *(const float4*)(shA + c), sc = *(const float4*)(scA + c);
    const float4 sh2 = *(const float4*)(shB + c), sc2 = *(const float4*)(scB + c);
    uint2 o;
    o.x = pack2(va[it].x * ra * w4.x * (1.f + sc.x) + sh.x, va[it].y * ra * w4.y * (1.f + sc.y) + sh.y);
    o.y = pack2(va[it].z * ra * w4.z * (1.f + sc.z) + sh.z, va[it].w * ra * w4.w * (1.f + sc.w) + sh.w);
    *(uint2*)(da + c) = o;
    o.x = pack2(vb[it].x * rb * w4.x * (1.f + sc2.x) + sh2.x, vb[it].y * rb * w4.y * (1.f + sc2.y) + sh2.y);
    o.y = pack2(vb[it].z * rb * w4.z * (1.f + sc2.z) + sh2.z, vb[it].w * rb * w4.w * (1.f + sc2.w) + sh2.w);
    *(uint2*)(db + c) = o;
  }
}

__device__ __forceinline__ void norm1_item(const Params& P, int item) {
  const int lane = opq(threadIdx.x) & 63, w = opq(threadIdx.x) >> 6;
  const int rowA = item * 16 + w, rowB = rowA + 8;
  const float* MOD = (const float*)(P.ws + OFF_MOD);
  const int ba = (rowA < 16384) ? (rowA >> 12) : 4, bb = (rowB < 16384) ? (rowB >> 12) : 4;
  const float* xa = (rowA < 16384) ? (P.x + (size_t)rowA * 1024) : (P.ctx + (size_t)(rowA - 16384) * 1024);
  const float* xb = (rowB < 16384) ? (P.x + (size_t)rowB * 1024) : (P.ctx + (size_t)(rowB - 16384) * 1024);
  u16* H = (u16*)(P.ws + OFF_R2);
  norm_row2(xa, xb, P.norm1_w, MOD + ba * 6144, MOD + ba * 6144 + 1024, MOD + bb * 6144, MOD + bb * 6144 + 1024,
            H + (size_t)rowA * 1024, H + (size_t)rowB * 1024, lane);
}

__device__ __forceinline__ void mintra_item(const Params& P, int item) {
  const int tid = opq(threadIdx.x);
  const int rowg = item * 8 + (tid >> 6);
  const int g = rowg >> 9, nout = rowg & 511, j = nout >> 4, po = nout & 15;
  const int k0 = (tid & 63) * 8, i = k0 >> 4, pi0 = k0 & 15;
  const float* KTAB = (const float*)(P.ws + OFF_KTAB);
  float f[8];
#pragma unroll
  for (int e = 0; e < 8; ++e) f[e] = 0.f;
  if (i <= j) {
    const float* kp = KTAB + (((size_t)(0 * 32 + g)) * 32 + (j - i)) * 256 + po * 16 + pi0;
#pragma unroll
    for (int e = 0; e < 8; ++e) f[e] += kp[e];
  }
  if (i >= j) {
    const float* kp = KTAB + (((size_t)(1 * 32 + g)) * 32 + (i - j)) * 256 + po * 16 + pi0;
#pragma unroll
    for (int e = 0; e < 8; ++e) f[e] += kp[e];
  }
  if (i == j) {
    const float dv = P.s5_d[g * 16 + po];
#pragma unroll
    for (int e = 0; e < 8; ++e) if (pi0 + e == po) f[e] += dv;
  }
  u16* MI = (u16*)(P.ws + OFF_MINTRA);
  *(uint4*)(MI + (size_t)rowg * 512 + k0) = pack8(f);
}

__device__ __forceinline__ void inproj_tile(const Params& P, int t, char* lds) {
  int mt, nt;
  if (t < 1344) { nt = t / 64; mt = t % 64; }
  else {
    const int tt = t - 1344; mt = 64 + (tt & 3);
    const int ni = tt >> 2;
    nt = (ni < 8) ? (4 + ni) : ((ni < 12) ? (16 + ni - 8) : 20);
  }
  const int m0 = mt * 256, n0 = nt * 128;
  f32x16 acc[2][2];
  acc_zero(acc);
  gemm_main((const u16*)(P.ws + OFF_R2) + (size_t)m0 * 1024, 1024, (const u16*)(P.ws + OFF_WT_IN) + (size_t)n0 * 1024, 1024, 1024, acc, (u16*)lds);
  TILE_COORDS
  if (nt < 12) {
    u16* QKV = (u16*)(P.ws + OFF_R3);
#pragma unroll
    for (int i = 0; i < 2; ++i)
#pragma unroll
      for (int j = 0; j < 2; ++j)
#pragma unroll
        for (int e = 0; e < 16; ++e) QKV[TIDX(m0, n0, i, j, e, 1536)] = f2bf(acc[i][j][e]);
  } else if (nt < 16) {
    u16* Z = (u16*)(P.ws + OFF_Z);
#pragma unroll
    for (int i = 0; i < 2; ++i)
#pragma unroll
      for (int j = 0; j < 2; ++j)
#pragma unroll
        for (int e = 0; e < 16; ++e) Z[TIDX(m0, n0, i, j, e, 512) - 1536] = f2bf(acc[i][j][e]);
  } else if (nt < 20) {
    u16* U5 = (u16*)(P.ws + OFF_U5);
#pragma unroll
    for (int i = 0; i < 2; ++i)
#pragma unroll
      for (int j = 0; j < 2; ++j)
#pragma unroll
        for (int e = 0; e < 16; ++e) {
          const int cc = TCOL(n0, j) - 2048;
          U5[((size_t)(cc >> 4) * 17408 + TROW(m0, i, e)) * 16 + (cc & 15)] = f2bf(acc[i][j][e]);
        }
  } else {
    float* BA = (float*)(P.ws + OFF_BA);
#pragma unroll
    for (int i = 0; i < 2; ++i)
#pragma unroll
      for (int j = 0; j < 2; ++j)
#pragma unroll
        for (int e = 0; e < 16; ++e) {
          const int cc = TCOL(n0, j) - 2560;
          if (cc < 16) BA[(size_t)TROW(m0, i, e) * 16 + cc] = acc[i][j][e];
        }
  }
}

__device__ __forceinline__ void solve_elim(float (&sol)[64], const float* Lr) {
  float4 b0a, b0b, b0c, b0d, b1a, b1b, b1c, b1d, b2a, b2b, b2c, b2d;
  b0a = *(const float4*)(Lr + 0); b0b = *(const float4*)(Lr + 4); b0c = *(const float4*)(Lr + 8); b0d = *(const float4*)(Lr + 12);
  b1a = *(const float4*)(Lr + 16); b1b = *(const float4*)(Lr + 20); b1c = *(const float4*)(Lr + 24); b1d = *(const float4*)(Lr + 28);
  b2a = *(const float4*)(Lr + 32); b2b = *(const float4*)(Lr + 36); b2c = *(const float4*)(Lr + 40); b2d = *(const float4*)(Lr + 44);
  __builtin_amdgcn_sched_barrier(0);
  sol[1] -= b0a.y * sol[0]; sol[2] -= b0a.z * sol[0]; sol[3] -= b0a.w * sol[0]; sol[4] -= b0b.x * sol[0]; sol[5] -= b0b.y * sol[0]; sol[6] -= b0b.z * sol[0]; sol[7] -= b0b.w * sol[0]; sol[8] -= b0c.x * sol[0]; sol[9] -= b0c.y * sol[0]; sol[10] -= b0c.z * sol[0]; sol[11] -= b0c.w * sol[0]; sol[12] -= b0d.x * sol[0]; sol[13] -= b0d.y * sol[0]; sol[14] -= b0d.z * sol[0]; sol[15] -= b0d.w * sol[0];
  __builtin_amdgcn_sched_barrier(0);
  b0a = *(const float4*)(Lr + 48); b0b = *(const float4*)(Lr + 52); b0c = *(const float4*)(Lr + 56); b0d = *(const float4*)(Lr + 60);
  __builtin_amdgcn_sched_barrier(0);
  sol[16] -= b1a.x * sol[0]; sol[17] -= b1a.y * sol[0]; sol[18] -= b1a.z * sol[0]; sol[19] -= b1a.w * sol[0]; sol[20] -= b1b.x * sol[0]; sol[21] -= b1b.y * sol[0]; sol[22] -= b1b.z * sol[0]; sol[23] -= b1b.w * sol[0]; sol[24] -= b1c.x * sol[0]; sol[25] -= b1c.y * sol[0]; sol[26] -= b1c.z * sol[0]; sol[27] -= b1c.w * sol[0]; sol[28] -= b1d.x * sol[0]; sol[29] -= b1d.y * sol[0]; sol[30] -= b1d.z * sol[0]; sol[31] -= b1d.w * sol[0];
  __builtin_amdgcn_sched_barrier(0);
  b1a = *(const float4*)(Lr + 64); b1b = *(const float4*)(Lr + 68); b1c = *(const float4*)(Lr + 72); b1d = *(const float4*)(Lr + 76);
  __builtin_amdgcn_sched_barrier(0);
  sol[32] -= b2a.x * sol[0]; sol[33] -= b2a.y * sol[0]; sol[34] -= b2a.z * sol[0]; sol[35] -= b2a.w * sol[0]; sol[36] -= b2b.x * sol[0]; sol[37] -= b2b.y * sol[0]; sol[38] -= b2b.z * sol[0]; sol[39] -= b2b.w * sol[0]; sol[40] -= b2c.x * sol[0]; sol[41] -= b2c.y * sol[0]; sol[42] -= b2c.z * sol[0]; sol[43] -= b2c.w * sol[0]; sol[44] -= b2d.x * sol[0]; sol[45] -= b2d.y * sol[0]; sol[46] -= b2d.z * sol[0]; sol[47] -= b2d.w * sol[0];
  __builtin_amdgcn_sched_barrier(0);
  b2a = *(const float4*)(Lr + 80); b2b = *(const float4*)(Lr + 84); b2c = *(const float4*)(Lr + 88); b2d = *(const float4*)(Lr + 92);
  __builtin_amdgcn_sched_barrier(0);
  sol[48] -= b0a.x * sol[0]; sol[49] -= b0a.y * sol[0]; sol[50] -= b0a.z * sol[0]; sol[51] -= b0a.w * sol[0]; sol[52] -= b0b.x * sol[0]; sol[53] -= b0b.y * sol[0]; sol[54] -= b0b.z * sol[0]; sol[55] -= b0b.w * sol[0]; sol[56] -= b0c.x * sol[0]; sol[57] -= b0c.y * sol[0]; sol[58] -= b0c.z * sol[0]; sol[59] -= b0c.w * sol[0]; sol[60] -= b0d.x * sol[0]; sol[61] -= b0d.y * sol[0]; sol[62] -= b0d.z * sol[0]; sol[63] -= b0d.w * sol[0];
  __builtin_amdgcn_sched_barrier(0);
  b0a = *(const float4*)(Lr + 96); b0b = *(const float4*)(Lr + 100); b0c = *(const float4*)(Lr + 104); b0d = *(const float4*)(Lr + 108);
  __builtin_amdgcn_sched_barrier(0);
  sol[2] -= b1a.z * sol[1]; sol[3] -= b1a.w * sol[1]; sol[4] -= b1b.x * sol[1]; sol[5] -= b1b.y * sol[1]; sol[6] -= b1b.z * sol[1]; sol[7] -= b1b.w * sol[1]; sol[8] -= b1c.x * sol[1]; sol[9] -= b1c.y * sol[1]; sol[10] -= b1c.z * sol[1]; sol[11] -= b1c.w * sol[1]; sol[12] -= b1d.x * sol[1]; sol[13] -= b1d.y * sol[1]; sol[14] -= b1d.z * sol[1]; sol[15] -= b1d.w * sol[1];
  __builtin_amdgcn_sched_barrier(0);
  b1a = *(const float4*)(Lr + 112); b1b = *(const float4*)(Lr + 116); b1c = *(const float4*)(Lr + 120); b1d = *(const float4*)(Lr + 124);
  __builtin_amdgcn_sched_barrier(0);
  sol[16] -= b2a.x * sol[1]; sol[17] -= b2a.y * sol[1]; sol[18] -= b2a.z * sol[1]; sol[19] -= b2a.w * sol[1]; sol[20] -= b2b.x * sol[1]; sol[21] -= b2b.y * sol[1]; sol[22] -= b2b.z * sol[1]; sol[23] -= b2b.w * sol[1]; sol[24] -= b2c.x * sol[1]; sol[25] -= b2c.y * sol[1]; sol[26] -= b2c.z * sol[1]; sol[27] -= b2c.w * sol[1]; sol[28] -= b2d.x * sol[1]; sol[29] -= b2d.y * sol[1]; sol[30] -= b2d.z * sol[1]; sol[31] -= b2d.w * sol[1];
  __builtin_amdgcn_sched_barrier(0);
  b2a = *(const float4*)(Lr + 128); b2b = *(const float4*)(Lr + 132); b2c = *(const float4*)(Lr + 136); b2d = *(const float4*)(Lr + 140);
  __builtin_amdgcn_sched_barrier(0);
  sol[32] -= b0a.x * sol[1]; sol[33] -= b0a.y * sol[1]; sol[34] -= b0a.z * sol[1]; sol[35] -= b0a.w * sol[1]; sol[36] -= b0b.x * sol[1]; sol[37] -= b0b.y * sol[1]; sol[38] -= b0b.z * sol[1]; sol[39] -= b0b.w * sol[1]; sol[40] -= b0c.x * sol[1]; sol[41] -= b0c.y * sol[1]; sol[42] -= b0c.z * sol[1]; sol[43] -= b0c.w * sol[1]; sol[44] -= b0d.x * sol[1]; sol[45] -= b0d.y * sol[1]; sol[46] -= b0d.z * sol[1]; sol[47] -= b0d.w * sol[1];
  __builtin_amdgcn_sched_barrier(0);
  b0a = *(const float4*)(Lr + 144); b0b = *(const float4*)(Lr + 148); b0c = *(const float4*)(Lr + 152); b0d = *(const float4*)(Lr + 156);
  __builtin_amdgcn_sched_barrier(0);
  sol[48] -= b1a.x * sol[1]; sol[49] -= b1a.y * sol[1]; sol[50] -= b1a.z * sol[1]; sol[51] -= b1a.w * sol[1]; sol[52] -= b1b.x * sol[1]; sol[53] -= b1b.y * sol[1]; sol[54] -= b1b.z * sol[1]; sol[55] -= b1b.w * sol[1]; sol[56] -= b1c.x * sol[1]; sol[57] -= b1c.y * sol[1]; sol[58] -= b1c.z * sol[1]; sol[59] -= b1c.w * sol[1]; sol[60] -= b1d.x * sol[1]; sol[61] -= b1d.y * sol[1]; sol[62] -= b1d.z * sol[1]; sol[63] -= b1d.w * sol[1];
  __builtin_amdgcn_sched_barrier(0);
  b1a = *(const float4*)(Lr + 160); b1b = *(const float4*)(Lr + 164); b1c = *(const float4*)(Lr + 168); b1d = *(const float4*)(Lr + 172);
  __builtin_amdgcn_sched_barrier(0);
  sol[3] -= b2a.w * sol[2]; sol[4] -= b2b.x * sol[2]; sol[5] -= b2b.y * sol[2]; sol[6] -= b2b.z * sol[2]; sol[7] -= b2b.w * sol[2]; sol[8] -= b2c.x * sol[2]; sol[9] -= b2c.y * sol[2]; sol[10] -= b2c.z * sol[2]; sol[11] -= b2c.w * sol[2]; sol[12] -= b2d.x * sol[2]; sol[13] -= b2d.y * sol[2]; sol[14] -= b2d.z * sol[2]; sol[15] -= b2d.w * sol[2];
  __builtin_amdgcn_sched_barrier(0);
  b2a = *(const float4*)(Lr + 176); b2b = *(const float4*)(Lr + 180); b2c = *(const float4*)(Lr + 184); b2d = *(const float4*)(Lr + 188);
  __builtin_amdgcn_sched_barrier(0);
  sol[16] -= b0a.x * sol[2]; sol[17] -= b0a.y * sol[2]; sol[18] -= b0a.z * sol[2]; sol[19] -= b0a.w * sol[2]; sol[20] -= b0b.x * sol[2]; sol[21] -= b0b.y * sol[2]; sol[22] -= b0b.z * sol[2]; sol[23] -= b0b.w * sol[2]; sol[24] -= b0c.x * sol[2]; sol[25] -= b0c.y * sol[2]; sol[26] -= b0c.z * sol[2]; sol[27] -= b0c.w * sol[2]; sol[28] -= b0d.x * sol[2]; sol[29] -= b0d.y * sol[2]; sol[30] -= b0d.z * sol[2]; sol[31] -= b0d.w * sol[2];
  __builtin_amdgcn_sched_barrier(0);
  b0a = *(const float4*)(Lr + 192); b0b = *(const float4*)(Lr + 196); b0c = *(const float4*)(Lr + 200); b0d = *(const float4*)(Lr + 204);
  __builtin_amdgcn_sched_barrier(0);
  sol[32] -= b1a.x * sol[2]; sol[33] -= b1a.y * sol[2]; sol[34] -= b1a.z * sol[2]; sol[35] -= b1a.w * sol[2]; sol[36] -= b1b.x * sol[2]; sol[37] -= b1b.y * sol[2]; sol[38] -= b1b.z * sol[2]; sol[39] -= b1b.w * sol[2]; sol[40] -= b1c.x * sol[2]; sol[41] -= b1c.y * sol[2]; sol[42] -= b1c.z * sol[2]; sol[43] -= b1c.w * sol[2]; sol[44] -= b1d.x * sol[2]; sol[45] -= b1d.y * sol[2]; sol[46] -= b1d.z * sol[2]; sol[47] -= b1d.w * sol[2];
  __builtin_amdgcn_sched_barrier(0);
  b1a = *(const float4*)(Lr + 208); b1b = *(const float4*)(Lr + 212); b1c = *(const float4*)(Lr + 216); b1d = *(const float4*)(Lr + 220);
  __builtin_amdgcn_sched_barrier(0);
  sol[48] -= b2a.x * sol[2]; sol[49] -= b2a.y * sol[2]; sol[50] -= b2a.z * sol[2]; sol[51] -= b2a.w * sol[2]; sol[52] -= b2b.x * sol[2]; sol[53] -= b2b.y * sol[2]; sol[54] -= b2b.z * sol[2]; sol[55] -= b2b.w * sol[2]; sol[56] -= b2c.x * sol[2]; sol[57] -= b2c.y * sol[2]; sol[58] -= b2c.z * sol[2]; sol[59] -= b2c.w * sol[2]; sol[60] -= b2d.x * sol[2]; sol[61] -= b2d.y * sol[2]; sol[62] -= b2d.z * sol[2]; sol[63] -= b2d.w * sol[2];
  __builtin_amdgcn_sched_barrier(0);
  b2a = *(const float4*)(Lr + 224); b2b = *(const float4*)(Lr + 228); b2c = *(const float4*)(Lr + 232); b2d = *(const float4*)(Lr + 236);
  __builtin_amdgcn_sched_barrier(0);
  sol[4] -= b0b.x * sol[3]; sol[5] -= b0b.y * sol[3]; sol[6] -= b0b.z * sol[3]; sol[7] -= b0b.w * sol[3]; sol[8] -= b0c.x * sol[3]; sol[9] -= b0c.y * sol[3]; sol[10] -= b0c.z * sol[3]; sol[11] -= b0c.w * sol[3]; sol[12] -= b0d.x * sol[3]; sol[13] -= b0d.y * sol[3]; sol[14] -= b0d.z * sol[3]; sol[15] -= b0d.w * sol[3];
  __builtin_amdgcn_sched_barrier(0);
  b0a = *(const float4*)(Lr + 240); b0b = *(const float4*)(Lr + 244); b0c = *(const float4*)(Lr + 248); b0d = *(const float4*)(Lr + 252);
  __builtin_amdgcn_sched_barrier(0);
  sol[16] -= b1a.x * sol[3]; sol[17] -= b1a.y * sol[3]; sol[18] -= b1a.z * sol[3]; sol[19] -= b1a.w * sol[3]; sol[20] -= b1b.x * sol[3]; sol[21] -= b1b.y * sol[3]; sol[22] -= b1b.z * sol[3]; sol[23] -= b1b.w * sol[3]; sol[24] -= b1c.x * sol[3]; sol[25] -= b1c.y * sol[3]; sol[26] -= b1c.z * sol[3]; sol[27] -= b1c.w * sol[3]; sol[28] -= b1d.x * sol[3]; sol[29] -= b1d.y * sol[3]; sol[30] -= b1d.z * sol[3]; sol[31] -= b1d.w * sol[3];
  __builtin_amdgcn_sched_barrier(0);
  b1a = *(const float4*)(Lr + 256); b1b = *(const float4*)(Lr + 260); b1c = *(const float4*)(Lr + 264); b1d = *(const float4*)(Lr + 268);
  __builtin_amdgcn_sched_barrier(0);
  sol[32] -= b2a.x * sol[3]; sol[33] -= b2a.y * sol[3]; sol[34] -= b2a.z * sol[3]; sol[35] -= b2a.w * sol[3]; sol[36] -= b2b.x * sol[3]; sol[37] -= b2b.y * sol[3]; sol[38] -= b2b.z * sol[3]; sol[39] -= b2b.w * sol[3]; sol[40] -= b2c.x * sol[3]; sol[41] -= b2c.y * sol[3]; sol[42] -= b2c.z * sol[3]; sol[43] -= b2c.w * sol[3]; sol[44] -= b2d.x * sol[3]; sol[45] -= b2d.y * sol[3]; sol[46] -= b2d.z * sol[3]; sol[47] -= b2d.w * sol[3];
  __builtin_amdgcn_sched_barrier(0);
  b2a = *(const float4*)(Lr + 272); b2b = *(const float4*)(Lr + 276); b2c = *(const float4*)(Lr + 280); b2d = *(const float4*)(Lr + 284);
  __builtin_amdgcn_sched_barrier(0);
  sol[48] -= b0a.x * sol[3]; sol[49] -= b0a.y * sol[3]; sol[50] -= b0a.z * sol[3]; sol[51] -= b0a.w * sol[3]; sol[52] -= b0b.x * sol[3]; sol[53] -= b0b.y * sol[3]; sol[54] -= b0b.z * sol[3]; sol[55] -= b0b.w * sol[3]; sol[56] -= b0c.x * sol[3]; sol[57] -= b0c.y * sol[3]; sol[58] -= b0c.z * sol[3]; sol[59] -= b0c.w * sol[3]; sol[60] -= b0d.x * sol[3]; sol[61] -= b0d.y * sol[3]; sol[62] -= b0d.z * sol[3]; sol[63] -= b0d.w * sol[3];
  __builtin_amdgcn_sched_barrier(0);
  b0a = *(const float4*)(Lr + 288); b0b = *(const float4*)(Lr + 292); b0c = *(const float4*)(Lr + 296); b0d = *(const float4*)(Lr + 300);
  __builtin_amdgcn_sched_barrier(0);
  sol[5] -= b1b.y * sol[4]; sol[6] -= b1b.z * sol[4]; sol[7] -= b1b.w * sol[4]; sol[8] -= b1c.x * sol[4]; sol[9] -= b1c.y * sol[4]; sol[10] -= b1c.z * sol[4]; sol[11] -= b1c.w * sol[4]; sol[12] -= b1d.x * sol[4]; sol[13] -= b1d.y * sol[4]; sol[14] -= b1d.z * sol[4]; sol[15] -= b1d.w * sol[4];
  __builtin_amdgcn_sched_barrier(0);
  b1a = *(const float4*)(Lr + 304); b1b = *(const float4*)(Lr + 308); b1c = *(const float4*)(Lr + 312); b1d = *(const float4*)(Lr + 316);
  __builtin_amdgcn_sched_barrier(0);
  sol[16] -= b2a.x * sol[4]; sol[17] -= b2a.y * sol[4]; sol[18] -= b2a.z * sol[4]; sol[19] -= b2a.w * sol[4]; sol[20] -= b2b.x * sol[4]; sol[21] -= b2b.y * sol[4]; sol[22] -= b2b.z * sol[4]; sol[23] -= b2b.w * sol[4]; sol[24] -= b2c.x * sol[4]; sol[25] -= b2c.y * sol[4]; sol[26] -= b2c.z * sol[4]; sol[27] -= b2c.w * sol[4]; sol[28] -= b2d.x * sol[4]; sol[29] -= b2d.y * sol[4]; sol[30] -= b2d.z * sol[4]; sol[31] -= b2d.w * sol[4];
  __builtin_amdgcn_sched_barrier(0);
  b2a = *(const float4*)(Lr + 320); b2b = *(const float4*)(Lr + 324); b2c = *(const float4*)(Lr + 328); b2d = *(const float4*)(Lr + 332);
  __builtin_amdgcn_sched_barrier(0);
  sol[32] -= b0a.x * sol[4]; sol[33] -= b0a.y * sol[4]; sol[34] -= b0a.z * sol[4]; sol[35] -= b0a.w * sol[4]; sol[36] -= b0b.x * sol[4]; sol[37] -= b0b.y * sol[4]; sol[38] -= b0b.z * sol[4]; sol[39] -= b0b.w * sol[4]; sol[40] -= b0c.x * sol[4]; sol[41] -= b0c.y * sol[4]; sol[42] -= b0c.z * sol[4]; sol[43] -= b0c.w * sol[4]; sol[44] -= b0d.x * sol[4]; sol[45] -= b0d.y * sol[4]; sol[46] -= b0d.z * sol[4]; sol[47] -= b0d.w * sol[4];
  __builtin_amdgcn_sched_barrier(0);
  b0a = *(const float4*)(Lr + 336); b0b = *(const float4*)(Lr + 340); b0c = *(const float4*)(Lr + 344); b0d = *(const float4*)(Lr + 348);
  __builtin_amdgcn_sched_barrier(0);
  sol[48] -= b1a.x * sol[4]; sol[49] -= b1a.y * sol[4]; sol[50] -= b1a.z * sol[4]; sol[51] -= b1a.w * sol[4]; sol[52] -= b1b.x * sol[4]; sol[53] -= b1b.y * sol[4]; sol[54] -= b1b.z * sol[4]; sol[55] -= b1b.w * sol[4]; sol[56] -= b1c.x * sol[4]; sol[57] -= b1c.y * sol[4]; sol[58] -= b1c.z * sol[4]; sol[59] -= b1c.w * sol[4]; sol[60] -= b1d.x * sol[4]; sol[61] -= b1d.y * sol[4]; sol[62] -= b1d.z * sol[4]; sol[63] -= b1d.w * sol[4];
  __builtin_amdgcn_sched_barrier(0);
  b1a = *(const float4*)(Lr + 352); b1b = *(const float4*)(Lr + 356); b1c = *(const float4*)(Lr + 360); b1d = *(const float4*)(Lr + 364);
  __builtin_amdgcn_sched_barrier(0);
  sol[6] -= b2b.z * sol[5]; sol[7] -= b2b.w * sol[5]; sol[8] -= b2c.x * sol[5]; sol[9] -= b2c.y * sol[5]; sol[10] -= b2c.z * sol[5]; sol[11] -= b2c.w * sol[5]; sol[12] -= b2d.x * sol[5]; sol[13] -= b2d.y * sol[5]; sol[14] -= b2d.z * sol[5]; sol[15] -= b2d.w * sol[5];
  __builtin_amdgcn_sched_barrier(0);
  b2a = *(const float4*)(Lr + 368); b2b = *(const float4*)(Lr + 372); b2c = *(const float4*)(Lr + 376); b2d = *(const float4*)(Lr + 380);
  __builtin_amdgcn_sched_barrier(0);
  sol[16] -= b0a.x * sol[5]; sol[17] -= b0a.y * sol[5]; sol[18] -= b0a.z * sol[5]; sol[19] -= b0a.w * sol[5]; sol[20] -= b0b.x * sol[5]; sol[21] -= b0b.y * sol[5]; sol[22] -= b0b.z * sol[5]; sol[23] -= b0b.w * sol[5]; sol[24] -= b0c.x * sol[5]; sol[25] -= b0c.y * sol[5]; sol[26] -= b0c.z * sol[5]; sol[27] -= b0c.w * sol[5]; sol[28] -= b0d.x * sol[5]; sol[29] -= b0d.y * sol[5]; sol[30] -= b0d.z * sol[5]; sol[31] -= b0d.w * sol[5];
  __builtin_amdgcn_sched_barrier(0);
  b0a = *(const float4*)(Lr + 384); b0b = *(const float4*)(Lr + 388); b0c = *(const float4*)(Lr + 392); b0d = *(const float4*)(Lr + 396);
  __builtin_amdgcn_sched_barrier(0);
  sol[32] -= b1a.x * sol[5]; sol[33] -= b1a.y * sol[5]; sol[34] -= b1a.z * sol[5]; sol[35] -= b1a.w * sol[5]; sol[36] -= b1b.x * sol[5]; sol[37] -= b1b.y * sol[5]; sol[38] -= b1b.z * sol[5]; sol[39] -= b1b.w * sol[5]; sol[40] -= b1c.x * sol[5]; sol[41] -= b1c.y * sol[5]; sol[42] -= b1c.z * sol[5]; sol[43] -= b1c.w * sol[5]; sol[44] -= b1d.x * sol[5]; sol[45] -= b1d.y * sol[5]; sol[46] -= b1d.z * sol[5]; sol[47] -= b1d.w * sol[5];
  __builtin_amdgcn_sched_barrier(0);
  b1a = *(const float4*)(Lr + 400); b1b = *(const float4*)(Lr + 404); b1c = *(const float4*)(Lr + 408); b1d = *(const float4*)(Lr + 412);
  __builtin_amdgcn_sched_barrier(0);
  sol[48] -= b2a.x * sol[5]; sol[49] -= b2a.y * sol[5]; sol[50] -= b2a.z * sol[5]; sol[51] -= b2a.w * sol[5]; sol[52] -= b2b.x * sol[5]; sol[53] -= b2b.y * sol[5]; sol[54] -= b2b.z * sol[5]; sol[55] -= b2b.w * sol[5]; sol[56] -= b2c.x * sol[5]; sol[57] -= b2c.y * sol[5]; sol[58] -= b2c.z * sol[5]; sol[59] -= b2c.w * sol[5]; sol[60] -= b2d.x * sol[5]; sol[61] -= b2d.y * sol[5]; sol[62] -= b2d.z * sol[5]; sol[63] -= b2d.w * sol[5];
  __builtin_amdgcn_sched_barrier(0);
  b2a = *(const float4*)(Lr + 416); b2b = *(const float4*)(Lr + 420); b2c = *(const float4*)(Lr + 424); b2d = *(const float4*)(Lr + 428);
  __builtin_amdgcn_sched_barrier(0);
  sol[7] -= b0b.w * sol[6]; sol[8] -= b0c.x * sol[6]; sol[9] -= b0c.y * sol[6]; sol[10] -= b0c.z * sol[6]; sol[11] -= b0c.w * sol[6]; sol[12] -= b0d.x * sol[6]; sol[13] -= b0d.y * sol[6]; sol[14] -= b0d.z * sol[6]; sol[15] -= b0d.w * sol[6];
  __builtin_amdgcn_sched_barrier(0);
  b0a = *(const float4*)(Lr + 432); b0b = *(const float4*)(Lr + 436); b0c = *(const float4*)(Lr + 440); b0d = *(const float4*)(Lr + 444);
  __builtin_amdgcn_sched_barrier(0);
  sol[16] -= b1a.x * sol[6]; sol[17] -= b1a.y * sol[6]; sol[18] -= b1a.z * sol[6]; sol[19] -= b1a.w * sol[6]; sol[20] -= b1b.x * sol[6]; sol[21] -= b1b.y * sol[6]; sol[22] -= b1b.z * sol[6]; sol[23] -= b1b.w * sol[6]; sol[24] -= b1c.x * sol[6]; sol[25] -= b1c.y * sol[6]; sol[26] -= b1c.z * sol[6]; sol[27] -= b1c.w * sol[6]; sol[28] -= b1d.x * sol[6]; sol[29] -= b1d.y * sol[6]; sol[30] -= b1d.z * sol[6]; sol[31] -= b1d.w * sol[6];
  __builtin_amdgcn_sched_barrier(0);
  b1a = *(const float4*)(Lr + 448); b1b = *(const float4*)(Lr + 452); b1c = *(const float4*)(Lr + 456); b1d = *(const float4*)(Lr + 460);
  __builtin_amdgcn_sched_barrier(0);
  sol[32] -= b2a.x * sol[6]; sol[33] -= b2a.y * sol[6]; sol[34] -= b2a.z * sol[6]; sol[35] -= b2a.w * sol[6]; sol[36] -= b2b.x * sol[6]; sol[37] -= b2b.y * sol[6]; sol[38] -= b2b.z * sol[6]; sol[39] -= b2b.w * sol[6]; sol[40] -= b2c.x * sol[6]; sol[41] -= b2c.y * sol[6]; sol[42] -= b2c.z * sol[6]; sol[43] -= b2c.w * sol[6]; sol[44] -= b2d.x * sol[6]; sol[45] -= b2d.y * sol[6]; sol[46] -= b2d.z * sol[6]; sol[47] -= b2d.w * sol[6];
  __builtin_amdgcn_sched_barrier(0);
  b2a = *(const float4*)(Lr + 464); b2b = *(const float4*)(Lr + 468); b2c = *(const float4*)(Lr + 472); b2d = *(const float4*)(Lr + 476);
  __builtin_amdgcn_sched_barrier(0);
  sol[48] -= b0a.x * sol[6]; sol[49] -= b0a.y * sol[6]; sol[50] -= b0a.z * sol[6]; sol[51] -= b0a.w * sol[6]; sol[52] -= b0b.x * sol[6]; sol[53] -= b0b.y * sol[6]; sol[54] -= b0b.z * sol[6]; sol[55] -= b0b.w * sol[6]; sol[56] -= b0c.x * sol[6]; sol[57] -= b0c.y * sol[6]; sol[58] -= b0c.z * sol[6]; sol[59] -= b0c.w * sol[6]; sol[60] -= b0d.x * sol[6]; sol[61] -= b0d.y * sol[6]; sol[62] -= b0d.z * sol[6]; sol[63] -= b0d.w * sol[6];
  __builtin_amdgcn_sched_barrier(0);
  b0a = *(const float4*)(Lr + 480); b0b = *(const float4*)(Lr + 484); b0c = *(const float4*)(Lr + 488); b0d = *(const float4*)(Lr + 492);
  __builtin_amdgcn_sched_barrier(0);
  sol[8] -= b1c.x * sol[7]; sol[9] -= b1c.y * sol[7]; sol[10] -= b1c.z * sol[7]; sol[11] -= b1c.w * sol[7]; sol[12] -= b1d.x * sol[7]; sol[13] -= b1d.y * sol[7]; sol[14] -= b1d.z * sol[7]; sol[15] -= b1d.w * sol[7];
  __builtin_amdgcn_sched_barrier(0);
  b1a = *(const float4*)(Lr + 496); b1b = *(const float4*)(Lr + 500); b1c = *(const float4*)(Lr + 504); b1d = *(const float4*)(Lr + 508);
  __builtin_amdgcn_sched_barrier(0);
  sol[16] -= b2a.x * sol[7]; sol[17] -= b2a.y * sol[7]; sol[18] -= b2a.z * sol[7]; sol[19] -= b2a.w * sol[7]; sol[20] -= b2b.x * sol[7]; sol[21] -= b2b.y * sol[7]; sol[22] -= b2b.z * sol[7]; sol[23] -= b2b.w * sol[7]; sol[24] -= b2c.x * sol[7]; sol[25] -= b2c.y * sol[7]; sol[26] -= b2c.z * sol[7]; sol[27] -= b2c.w * sol[7]; sol[28] -= b2d.x * sol[7]; sol[29] -= b2d.y * sol[7]; sol[30] -= b2d.z * sol[7]; sol[31] -= b2d.w * sol[7];
  __builtin_amdgcn_sched_barrier(0);
  b2a = *(const float4*)(Lr + 512); b2b = *(const float4*)(Lr + 516); b2c = *(const float4*)(Lr + 520); b2d = *(const float4*)(Lr + 524);
  __builtin_amdgcn_sched_barrier(0);
  sol[32] -= b0a.x * sol[7]; sol[33] -= b0a.y * sol[7]; sol[34] -= b0a.z * sol[7]; sol[35] -= b0a.w * sol[7]; sol[36] -= b0b.x * sol[7]; sol[37] -= b0b.y * sol[7]; sol[38] -= b0b.z * sol[7]; sol[39] -= b0b.w * sol[7]; sol[40] -= b0c.x * sol[7]; sol[41] -= b0c.y * sol[7]; sol[42] -= b0c.z * sol[7]; sol[43] -= b0c.w * sol[7]; sol[44] -= b0d.x * sol[7]; sol[45] -= b0d.y * sol[7]; sol[46] -= b0d.z * sol[7]; sol[47] -= b0d.w * sol[7];
  __builtin_amdgcn_sched_barrier(0);
  b0a = *(const float4*)(Lr + 528); b0b = *(const float4*)(Lr + 532); b0c = *(const float4*)(Lr + 536); b0d = *(const float4*)(Lr + 540);
  __builtin_amdgcn_sched_barrier(0);
  sol[48] -= b1a.x * sol[7]; sol[49] -= b1a.y * sol[7]; sol[50] -= b1a.z * sol[7]; sol[51] -= b1a.w * sol[7]; sol[52] -= b1b.x * sol[7]; sol[53] -= b1b.y * sol[7]; sol[54] -= b1b.z * sol[7]; sol[55] -= b1b.w * sol[7]; sol[56] -= b1c.x * sol[7]; sol[57] -= b1c.y * sol[7]; sol[58] -= b1c.z * sol[7]; sol[59] -= b1c.w * sol[7]; sol[60] -= b1d.x * sol[7]; sol[61] -= b1d.y * sol[7]; sol[62] -= b1d.z * sol[7]; sol[63] -= b1d.w * sol[7];
  __builtin_amdgcn_sched_barrier(0);
  b1a = *(const float4*)(Lr + 544); b1b = *(const float4*)(Lr + 548); b1c = *(const float4*)(Lr + 552); b1d = *(const float4*)(Lr + 556);
  __builtin_amdgcn_sched_barrier(0);
  sol[9] -= b2c.y * sol[8]; sol[10] -= b2c.z * sol[8]; sol[11] -= b2c.w * sol[8]; sol[12] -= b2d.x * sol[8]; sol[13] -= b2d.y * sol[8]; sol[14] -= b2d.z * sol[8]; sol[15] -= b2d.w * sol[8];
  __builtin_amdgcn_sched_barrier(0);
  b2a = *(const float4*)(Lr + 560); b2b = *(const float4*)(Lr + 564); b2c = *(const float4*)(Lr + 568); b2d = *(const float4*)(Lr + 572);
  __builtin_amdgcn_sched_barrier(0);
  sol[16] -= b0a.x * sol[8]; sol[17] -= b0a.y * sol[8]; sol[18] -= b0a.z * sol[8]; sol[19] -= b0a.w * sol[8]; sol[20] -= b0b.x * sol[8]; sol[21] -= b0b.y * sol[8]; sol[22] -= b0b.z * sol[8]; sol[23] -= b0b.w * sol[8]; sol[24] -= b0c.x * sol[8]; sol[25] -= b0c.y * sol[8]; sol[26] -= b0c.z * sol[8]; sol[27] -= b0c.w * sol[8]; sol[28] -= b0d.x * sol[8]; sol[29] -= b0d.y * sol[8]; sol[30] -= b0d.z * sol[8]; sol[31] -= b0d.w * sol[8];
  __builtin_amdgcn_sched_barrier(0);
  b0a = *(const float4*)(Lr + 576); b0b = *(const float4*)(Lr + 580); b0c = *(const float4*)(Lr + 584); b0d = *(const float4*)(Lr + 588);
  __builtin_amdgcn_sched_barrier(0);
  sol[32] -= b1a.x * sol[8]; sol[33] -= b1a.y * sol[8]; sol[34] -= b1a.z * sol[8]; sol[35] -= b1a.w * sol[8]; sol[36] -= b1b.x * sol[8]; sol[37] -= b1b.y * sol[8]; sol[38] -= b1b.z * sol[8]; sol[39] -= b1b.w * sol[8]; sol[40] -= b1c.x * sol[8]; sol[41] -= b1c.y * sol[8]; sol[42] -= b1c.z * sol[8]; sol[43] -= b1c.w * sol[8]; sol[44] -= b1d.x * sol[8]; sol[45] -= b1d.y * sol[8]; sol[46] -= b1d.z * sol[8]; sol[47] -= b1d.w * sol[8];
  __builtin_amdgcn_sched_barrier(0);
  b1a = *(const float4*)(Lr + 592); b1b = *(const float4*)(Lr + 596); b1c = *(const float4*)(Lr + 600); b1d = *(const float4*)(Lr + 604);
  __builtin_amdgcn_sched_barrier(0);
  sol[48] -= b2a.x * sol[8]; sol[49] -= b2a.y * sol[8]; sol[50] -= b2a.z * sol[8]; sol[51] -= b2a.w * sol[8]; sol[52] -= b2b.x * sol[8]; sol[53] -= b2b.y * sol[8]; sol[54] -= b2b.z * sol[8]; sol[55] -= b2b.w * sol[8]; sol[56] -= b2c.x * sol[8]; sol[57] -= b2c.y * sol[8]; sol[58] -= b2c.z * sol[8]; sol[59] -= b2c.w * sol[8]; sol[60] -= b2d.x * sol[8]; sol[61] -= b2d.y * sol[8]; sol[62] -= b2d.z * sol[8]; sol[63] -= b2d.w * sol[8];
  __builtin_amdgcn_sched_barrier(0);
  b2a = *(const float4*)(Lr + 608); b2b = *(const float4*)(Lr + 612); b2c = *(const float4*)(Lr + 616); b2d = *(const float4*)(Lr + 620);
  __builtin_amdgcn_sched_barrier(0);
  sol[10] -= b0c.z * sol[9]; sol[11] -= b0c.w * sol[9]; sol[12] -= b0d.x * sol[9]; sol[13] -= b0d.y * sol[9]; sol[14] -= b0d.z * sol[9]; sol[15] -= b0d.w * sol[9];
  __builtin_amdgcn_sched_barrier(0);
  b0a = *(const float4*)(Lr + 624); b0b = *(const float4*)(Lr + 628); b0c = *(const float4*)(Lr + 632); b0d = *(const float4*)(Lr + 636);
  __builtin_amdgcn_sched_barrier(0);
  sol[16] -= b1a.x * sol[9]; sol[17] -= b1a.y * sol[9]; sol[18] -= b1a.z * sol[9]; sol[19] -= b1a.w * sol[9]; sol[20] -= b1b.x * sol[9]; sol[21] -= b1b.y * sol[9]; sol[22] -= b1b.z * sol[9]; sol[23] -= b1b.w * sol[9]; sol[24] -= b1c.x * sol[9]; sol[25] -= b1c.y * sol[9]; sol[26] -= b1c.z * sol[9]; sol[27] -= b1c.w * sol[9]; sol[28] -= b1d.x * sol[9]; sol[29] -= b1d.y * sol[9]; sol[30] -= b1d.z * sol[9]; sol[31] -= b1d.w * sol[9];
  __builtin_amdgcn_sched_barrier(0);
  b1a = *(const float4*)(Lr + 640); b1b = *(const float4*)(Lr + 644); b1c = *(const float4*)(Lr + 648); b1d = *(const float4*)(Lr + 652);
  __builtin_amdgcn_sched_barrier(0);
  sol[32] -= b2a.x * sol[9]; sol[33] -= b2a.y * sol[9]; sol[34] -= b2a.z * sol[9]; sol[35] -= b2a.w * sol[9]; sol[36] -= b2b.x * sol[9]; sol[37] -= b2b.y * sol[9]; sol[38] -= b2b.z * sol[9]; sol[39] -= b2b.w * sol[9]; sol[40] -= b2c.x * sol[9]; sol[41] -= b2c.y * sol[9]; sol[42] -= b2c.z * sol[9]; sol[43] -= b2c.w * sol[9]; sol[44] -= b2d.x * sol[9]; sol[45] -= b2d.y * sol[9]; sol[46] -= b2d.z * sol[9]; sol[47] -= b2d.w * sol[9];
  __builtin_amdgcn_sched_barrier(0);
  b2a = *(const float4*)(Lr + 656); b2b = *(const float4*)(Lr + 660); b2c = *(const float4*)(Lr + 664); b2d = *(const float4*)(Lr + 668);
  __builtin_amdgcn_sched_barrier(0);
  sol[48] -= b0a.x * sol[9]; sol[49] -= b0a.y * sol[9]; sol[50] -= b0a.z * sol[9]; sol[51] -= b0a.w * sol[9]; sol[52] -= b0b.x * sol[9]; sol[53] -= b0b.y * sol[9]; sol[54] -= b0b.z * sol[9]; sol[55] -= b0b.w * sol[9]; sol[56] -= b0c.x * sol[9]; sol[57] -= b0c.y * sol[9]; sol[58] -= b0c.z * sol[9]; sol[59] -= b0c.w * sol[9]; sol[60] -= b0d.x * sol[9]; sol[61] -= b0d.y * sol[9]; sol[62] -= b0d.z * sol[9]; sol[63] -= b0d.w * sol[9];
  __builtin_amdgcn_sched_barrier(0);
  b0a = *(const float4*)(Lr + 672); b0b = *(const float4*)(Lr + 676); b0c = *(const float4*)(Lr + 680); b0d = *(const float4*)(Lr + 684);
  __builtin_amdgcn_sched_barrier(0);
  sol[11] -= b1c.w * sol[10]; sol[12] -= b1d.x * sol[10]; sol[13] -= b1d.y * sol[10]; sol[14] -= b1d.z * sol[10]; sol[15] -= b1d.w * sol[10];
  __builtin_amdgcn_sched_barrier(0);
  b1a = *(const float4*)(Lr + 688); b1b = *(const float4*)(Lr + 692); b1c = *(const float4*)(Lr + 696); b1d = *(const float4*)(Lr + 700);
  __builtin_amdgcn_sched_barrier(0);
  sol[16] -= b2a.x * sol[10]; sol[17] -= b2a.y * sol[10]; sol[18] -= b2a.z * sol[10]; sol[19] -= b2a.w * sol[10]; sol[20] -= b2b.x * sol[10]; sol[21] -= b2b.y * sol[10]; sol[22] -= b2b.z * sol[10]; sol[23] -= b2b.w * sol[10]; sol[24] -= b2c.x * sol[10]; sol[25] -= b2c.y * sol[10]; sol[26] -= b2c.z * sol[10]; sol[27] -= b2c.w * sol[10]; sol[28] -= b2d.x * sol[10]; sol[29] -= b2d.y * sol[10]; sol[30] -= b2d.z * sol[10]; sol[31] -= b2d.w * sol[10];
  __builtin_amdgcn_sched_barrier(0);
  b2a = *(const float4*)(Lr + 704); b2b = *(const float4*)(Lr + 708); b2c = *(const float4*)(Lr + 712); b2d = *(const float4*)(Lr + 716);
  __builtin_amdgcn_sched_barrier(0);
  sol[32] -= b0a.x * sol[10]; sol[33] -= b0a.y * sol[10]; sol[34] -= b0a.z * sol[10]; sol[35] -= b0a.w * sol[10]; sol[36] -= b0b.x * sol[10]; sol[37] -= b0b.y * sol[10]; sol[38] -= b0b.z * sol[10]; sol[39] -= b0b.w * sol[10]; sol[40] -= b0c.x * sol[10]; sol[41] -= b0c.y * sol[10]; sol[42] -= b0c.z * sol[10]; sol[43] -= b0c.w * sol[10]; sol[44] -= b0d.x * sol[10]; sol[45] -= b0d.y * sol[10]; sol[46] -= b0d.z * sol[10]; sol[47] -= b0d.w * sol[10];
  __builtin_amdgcn_sched_barrier(0);
  b0a = *(const float4*)(Lr + 720); b0b = *(const float4*)(Lr + 724); b0c = *(const float4*)(Lr + 728); b0d = *(const float4*)(Lr + 732);
  __builtin_amdgcn_sched_barrier(0);
  sol[48] -= b1a.x * sol[10]; sol[49] -= b1a.y * sol[10]; sol[50] -= b1a.z * sol[10]; sol[51] -= b1a.w * sol[10]; sol[52] -= b1b.x * sol[10]; sol[53] -= b1b.y * sol[10]; sol[54] -= b1b.z * sol[10]; sol[55] -= b1b.w * sol[10]; sol[56] -= b1c.x * sol[10]; sol[57] -= b1c.y * sol[10]; sol[58] -= b1c.z * sol[10]; sol[59] -= b1c.w * sol[10]; sol[60] -= b1d.x * sol[10]; sol[61] -= b1d.y * sol[10]; sol[62] -= b1d.z * sol[10]; sol[63] -= b1d.w * sol[10];
  __builtin_amdgcn_sched_barrier(0);
  b1a = *(const float4*)(Lr + 736); b1b = *(const float4*)(Lr + 740); b1c = *(const float4*)(Lr + 744); b1d = *(const float4*)(Lr + 748);
  __builtin_amdgcn_sched_barrier(0);
  sol[12] -= b2d.x * sol[11]; sol[13] -= b2d.y * sol[11]; sol[14] -= b2d.z * sol[11]; sol[15] -= b2d.w * sol[11];
  __builtin_amdgcn_sched_barrier(0);
  b2a = *(const float4*)(Lr + 752); b2b = *(const float4*)(Lr + 756); b2c = *(const float4*)(Lr + 760); b2d = *(const float4*)(Lr + 764);
  __builtin_amdgcn_sched_barrier(0);
  sol[16] -= b0a.x * sol[11]; sol[17] -= b0a.y * sol[11]; sol[18] -= b0a.z * sol[11]; sol[19] -= b0a.w * sol[11]; sol[20] -= b0b.x * sol[11]; sol[21] -= b0b.y * sol[11]; sol[22] -= b0b.z * sol[11]; sol[23] -= b0b.w * sol[11]; sol[24] -= b0c.x * sol[11]; sol[25] -= b0c.y * sol[11]; sol[26] -= b0c.z * sol[11]; sol[27] -= b0c.w * sol[11]; sol[28] -= b0d.x * sol[11]; sol[29] -= b0d.y * sol[11]; sol[30] -= b0d.z * sol[11]; sol[31] -= b0d.w * sol[11];
  __builtin_amdgcn_sched_barrier(0);
  b0a = *(const float4*)(Lr + 768); b0b = *(const float4*)(Lr + 772); b0c = *(const float4*)(Lr + 776); b0d = *(const float4*)(Lr + 780);
  __builtin_amdgcn_sched_barrier(0);
  sol[32] -= b1a.x * sol[11]; sol[33] -= b1a.y * sol[11]; sol[34] -= b1a.z * sol[11]; sol[35] -= b1a.w * sol[11]; sol[36] -= b1b.x * sol[11]; sol[37] -= b1b.y * sol[11]; sol[38] -= b1b.z * sol[11]; sol[39] -= b1b.w * sol[11]; sol[40] -= b1c.x * sol[11]; sol[41] -= b1c.y * sol[11]; sol[42] -= b1c.z * sol[11]; sol[43] -= b1c.w * sol[11]; sol[44] -= b1d.x * sol[11]; sol[45] -= b1d.y * sol[11]; sol[46] -= b1d.z * sol[11]; sol[47] -= b1d.w * sol[11];
  __builtin_amdgcn_sched_barrier(0);
  b1a = *(const float4*)(Lr + 784); b1b = *(const float4*)(Lr + 788); b1c = *(const float4*)(Lr + 792); b1d = *(const float4*)(Lr + 796);
  __builtin_amdgcn_sched_barrier(0);
  sol[48] -= b2a.x * sol[11]; sol[49] -= b2a.y * sol[11]; sol[50] -= b2a.z * sol[11]; sol[51] -= b2a.w * sol[11]; sol[52] -= b2b.x * sol[11]; sol[53] -= b2b.y * sol[11]; sol[54] -= b2b.z * sol[11]; sol[55] -= b2b.w * sol[11]; sol[56] -= b2c.x * sol[11]; sol[57] -= b2c.y * sol[11]; sol[58] -= b2c.z * sol[11]; sol[59] -= b2c.w * sol[11]; sol[60] -= b2d.x * sol[11]; sol[61] -= b2d.y * sol[11]; sol[62] -= b2d.z * sol[11]; sol[63] -= b2d.w * sol[11];
  __builtin_amdgcn_sched_barrier(0);
  b2a = *(const float4*)(Lr + 800); b2b = *(const float4*)(Lr + 804); b2c = *(const float4*)(Lr + 808); b2d = *(const float4*)(Lr + 812);
  __builtin_amdgcn_sched_barrier(0);
  sol[13] -= b0d.y * sol[12]; sol[14] -= b0d.z * sol[12]; sol[15] -= b0d.w * sol[12];
  __builtin_amdgcn_sched_barrier(0);
  b0a = *(const float4*)(Lr + 816); b0b = *(const float4*)(Lr + 820); b0c = *(const float4*)(Lr + 824); b0d = *(const float4*)(Lr + 828);
  __builtin_amdgcn_sched_barrier(0);
  sol[16] -= b1a.x * sol[12]; sol[17] -= b1a.y * sol[12]; sol[18] -= b1a.z * sol[12]; sol[19] -= b1a.w * sol[12]; sol[20] -= b1b.x * sol[12]; sol[21] -= b1b.y * sol[12]; sol[22] -= b1b.z * sol[12]; sol[23] -= b1b.w * sol[12]; sol[24] -= b1c.x * sol[12]; sol[25] -= b1c.y * sol[12]; sol[26] -= b1c.z * sol[12]; sol[27] -= b1c.w * sol[12]; sol[28] -= b1d.x * sol[12]; sol[29] -= b1d.y * sol[12]; sol[30] -= b1d.z * sol[12]; sol[31] -= b1d.w * sol[12];
  __builtin_amdgcn_sched_barrier(0);
  b1a = *(const float4*)(Lr + 832); b1b = *(const float4*)(Lr + 836); b1c = *(const float4*)(Lr + 840); b1d = *(const float4*)(Lr + 844);
  __builtin_amdgcn_sched_barrier(0);
  sol[32] -= b2a.x * sol[12]; sol[33] -= b2a.y * sol[12]; sol[34] -= b2a.z * sol[12]; sol[35] -= b2a.w * sol[12]; sol[36] -= b2b.x * sol[12]; sol[37] -= b2b.y * sol[12]; sol[38] -= b2b.z * sol[12]; sol[39] -= b2b.w * sol[12]; sol[40] -= b2c.x * sol[12]; sol[41] -= b2c.y * sol[12]; sol[42] -= b2c.z * sol[12]; sol[43] -= b2c.w * sol[12]; sol[44] -= b2d.x * sol[12]; sol[45] -= b2d.y * sol[12]; sol[46] -= b2d.z * sol[12]; sol[47] -= b2d.w * sol[12];
  __builtin_amdgcn_sched_barrier(0);
  b2a = *(const float4*)(Lr + 848); b2b = *(const float4*)(Lr + 852); b2c = *(const float4*)(Lr + 856); b2d = *(const float4*)(Lr + 860);
  __builtin_amdgcn_sched_barrier(0);
  sol[48] -= b0a.x * sol[12]; sol[49] -= b0a.y * sol[12]; sol[50] -= b0a.z * sol[12]; sol[51] -= b0a.w * sol[12]; sol[52] -= b0b.x * sol[12]; sol[53] -= b0b.y * sol[12]; sol[54] -= b0b.z * sol[12]; sol[55] -= b0b.w * sol[12]; sol[56] -= b0c.x * sol[12]; sol[57] -= b0c.y * sol[12]; sol[58] -= b0c.z * sol[12]; sol[59] -= b0c.w * sol[12]; sol[60] -= b0d.x * sol[12]; sol[61] -= b0d.y * sol[12]; sol[62] -= b0d.z * sol[12]; sol[63] -= b0d.w * sol[12];
  __builtin_amdgcn_sched_barrier(0);
  b0a = *(const float4*)(Lr + 864); b0b = *(const float4*)(Lr + 868); b0c = *(const float4*)(Lr + 872); b0d = *(const float4*)(Lr + 876);
  __builtin_amdgcn_sched_barrier(0);
  sol[14] -= b1d.z * sol[13]; sol[15] -= b1d.w * sol[13];
  __builtin_amdgcn_sched_barrier(0);
  b1a = *(const float4*)(Lr + 880); b1b = *(const float4*)(Lr + 884); b1c = *(const float4*)(Lr + 888); b1d = *(const float4*)(Lr + 892);
  __builtin_amdgcn_sched_barrier(0);
  sol[16] -= b2a.x * sol[13]; sol[17] -= b2a.y * sol[13]; sol[18] -= b2a.z * sol[13]; sol[19] -= b2a.w * sol[13]; sol[20] -= b2b.x * sol[13]; sol[21] -= b2b.y * sol[13]; sol[22] -= b2b.z * sol[13]; sol[23] -= b2b.w * sol[13]; sol[24] -= b2c.x * sol[13]; sol[25] -= b2c.y * sol[13]; sol[26] -= b2c.z * sol[13]; sol[27] -= b2c.w * sol[13]; sol[28] -= b2d.x * sol[13]; sol[29] -= b2d.y * sol[13]; sol[30] -= b2d.z * sol[13]; sol[31] -= b2d.w * sol[13];
  __builtin_amdgcn_sched_barrier(0);
  b2a = *(const float4*)(Lr + 896); b2b = *(const float4*)(Lr + 900); b2c = *(const float4*)(Lr + 904); b2d = *(const float4*)(Lr + 908);
  __builtin_amdgcn_sched_barrier(0);
  sol[32] -= b0a.x * sol[13]; sol[33] -= b0a.y * sol[13]; sol[34] -= b0a.z * sol[13]; sol[35] -= b0a.w * sol[13]; sol[36] -= b0b.x * sol[13]; sol[37] -= b0b.y * sol[13]; sol[38] -= b0b.z * sol[13]; sol[39] -= b0b.w * sol[13]; sol[40] -= b0c.x * sol[13]; sol[41] -= b0c.y * sol[13]; sol[42] -= b0c.z * sol[13]; sol[43] -= b0c.w * sol[13]; sol[44] -= b0d.x * sol[13]; sol[45] -= b0d.y * sol[13]; sol[46] -= b0d.z * sol[13]; sol[47] -= b0d.w * sol[13];
  __builtin_amdgcn_sched_barrier(0);
  b0a = *(const float4*)(Lr + 912); b0b = *(const float4*)(Lr + 916); b0c = *(const float4*)(Lr + 920); b0d = *(const float4*)(Lr + 924);
  __builtin_amdgcn_sched_barrier(0);
  sol[48] -= b1a.x * sol[13]; sol[49] -= b1a.y * sol[13]; sol[50] -= b1a.z * sol[13]; sol[51] -= b1a.w * sol[13]; sol[52] -= b1b.x * sol[13]; sol[53] -= b1b.y * sol[13]; sol[54] -= b1b.z * sol[13]; sol[55] -= b1b.w * sol[13]; sol[56] -= b1c.x * sol[13]; sol[57] -= b1c.y * sol[13]; sol[58] -= b1c.z * sol[13]; sol[59] -= b1c.w * sol[13]; sol[60] -= b1d.x * sol[13]; sol[61] -= b1d.y * sol[13]; sol[62] -= b1d.z * sol[13]; sol[63] -= b1d.w * sol[13];
  __builtin_amdgcn_sched_barrier(0);
  b1a = *(const float4*)(Lr + 928); b1b = *(const float4*)(Lr + 932); b1c = *(const float4*)(Lr + 936); b1d = *(const float4*)(Lr + 940);
  __builtin_amdgcn_sched_barrier(0);
  sol[15] -= b2d.w * sol[14];
  __builtin_amdgcn_sched_barrier(0);
  b2a = *(const float4*)(Lr + 944); b2b = *(const float4*)(Lr + 948); b2c = *(const float4*)(Lr + 952); b2d = *(const float4*)(Lr + 956);
  __builtin_amdgcn_sched_barrier(0);
  sol[16] -= b0a.x * sol[14]; sol[17] -= b0a.y * sol[14]; sol[18] -= b0a.z * sol[14]; sol[19] -= b0a.w * sol[14]; sol[20] -= b0b.x * sol[14]; sol[21] -= b0b.y * sol[14]; sol[22] -= b0b.z * sol[14]; sol[23] -= b0b.w * sol[14]; sol[24] -= b0c.x * sol[14]; sol[25] -= b0c.y * sol[14]; sol[26] -= b0c.z * sol[14]; sol[27] -= b0c.w * sol[14]; sol[28] -= b0d.x * sol[14]; sol[29] -= b0d.y * sol[14]; sol[30] -= b0d.z * sol[14]; sol[31] -= b0d.w * sol[14];
  __builtin_amdgcn_sched_barrier(0);
  b0a = *(const float4*)(Lr + 976); b0b = *(const float4*)(Lr + 980); b0c = *(const float4*)(Lr + 984); b0d = *(const float4*)(Lr + 988);
  __builtin_amdgcn_sched_barrier(0);
  sol[32] -= b1a.x * sol[14]; sol[33] -= b1a.y * sol[14]; sol[34] -= b1a.z * sol[14]; sol[35] -= b1a.w * sol[14]; sol[36] -= b1b.x * sol[14]; sol[37] -= b1b.y * sol[14]; sol[38] -= b1b.z * sol[14]; sol[39] -= b1b.w * sol[14]; sol[40] -= b1c.x * sol[14]; sol[41] -= b1c.y * sol[14]; sol[42] -= b1c.z * sol[14]; sol[43] -= b1c.w * sol[14]; sol[44] -= b1d.x * sol[14]; sol[45] -= b1d.y * sol[14]; sol[46] -= b1d.z * sol[14]; sol[47] -= b1d.w * sol[14];
  __builtin_amdgcn_sched_barrier(0);
  b1a = *(const float4*)(Lr + 992); b1b = *(const float4*)(Lr + 996); b1c = *(const float4*)(Lr + 1000); b1d = *(const float4*)(Lr + 1004);
  __builtin_amdgcn_sched_barrier(0);
  sol[48] -= b2a.x * sol[14]; sol[49] -= b2a.y * sol[14]; sol[50] -= b2a.z * sol[14]; sol[51] -= b2a.w * sol[14]; sol[52] -= b2b.x * sol[14]; sol[53] -= b2b.y * sol[14]; sol[54] -= b2b.z * sol[14]; sol[55] -= b2b.w * sol[14]; sol[56] -= b2c.x * sol[14]; sol[57] -= b2c.y * sol[14]; sol[58] -= b2c.z * sol[14]; sol[59] -= b2c.w * sol[14]; sol[60] -= b2d.x * sol[14]; sol[61] -= b2d.y * sol[14]; sol[62] -= b2d.z * sol[14]; sol[63] -= b2d.w * sol[14];
  __builtin_amdgcn_sched_barrier(0);
  b2a = *(const float4*)(Lr + 1008); b2b = *(const float4*)(Lr + 1012); b2c = *(const float4*)(Lr + 1016); b2d = *(const float4*)(Lr + 1020);
  __builtin_amdgcn_sched_barrier(0);
  sol[16] -= b0a.x * sol[15]; sol[17] -= b0a.y * sol[15]; sol[18] -= b0a.z * sol[15]; sol[19] -= b0a.w * sol[15]; sol[20] -= b0b.x * sol[15]; sol[21] -= b0b.y * sol[15]; sol[22] -= b0b.z * sol[15]; sol[23] -= b0b.w * sol[15]; sol[24] -= b0c.x * sol[15]; sol[25] -= b0c.y * sol[15]; sol[26] -= b0c.z * sol[15]; sol[27] -= b0c.w * sol[15]; sol[28] -= b0d.x * sol[15]; sol[29] -= b0d.y * sol[15]; sol[30] -= b0d.z * sol[15]; sol[31] -= b0d.w * sol[15];
  __builtin_amdgcn_sched_barrier(0);
  b0a = *(const float4*)(Lr + 1040); b0b = *(const float4*)(Lr + 1044); b0c = *(const float4*)(Lr + 1048); b0d = *(const float4*)(Lr + 1052);
  __builtin_amdgcn_sched_barrier(0);
  sol[32] -= b1a.x * sol[15]; sol[33] -= b1a.y * sol[15]; sol[34] -= b1a.z * sol[15]; sol[35] -= b1a.w * sol[15]; sol[36] -= b1b.x * sol[15]; sol[37] -= b1b.y * sol[15]; sol[38] -= b1b.z * sol[15]; sol[39] -= b1b.w * sol[15]; sol[40] -= b1c.x * sol[15]; sol[41] -= b1c.y * sol[15]; sol[42] -= b1c.z * sol[15]; sol[43] -= b1c.w * sol[15]; sol[44] -= b1d.x * sol[15]; sol[45] -= b1d.y * sol[15]; sol[46] -= b1d.z * sol[15]; sol[47] -= b1d.w * sol[15];
  __builtin_amdgcn_sched_barrier(0);
  b1a = *(const float4*)(Lr + 1056); b1b = *(const float4*)(Lr + 1060); b1c = *(const float4*)(Lr + 1064); b1d = *(const float4*)(Lr + 1068);
  __builtin_amdgcn_sched_barrier(0);
  sol[48] -= b2a.x * sol[15]; sol[49] -= b2a.y * sol[15]; sol[50] -= b2a.z * sol[15]; sol[51] -= b2a.w * sol[15]; sol[52] -= b2b.x * sol[15]; sol[53] -= b2b.y * sol[15]; sol[54] -= b2b.z * sol[15]; sol[55] -= b2b.w * sol[15]; sol[56] -= b2c.x * sol[15]; sol[57] -= b2c.y * sol[15]; sol[58] -= b2c.z * sol[15]; sol[59] -= b2c.w * sol[15]; sol[60] -= b2d.x * sol[15]; sol[61] -= b2d.y * sol[15]; sol[62] -= b2d.z * sol[15]; sol[63] -= b2d.w * sol[15];
  __builtin_amdgcn_sched_barrier(0);
  b2a = *(const float4*)(Lr + 1072); b2b = *(const float4*)(Lr + 1076); b2c = *(const float4*)(Lr + 1080); b2d = *(const float4*)(Lr + 1084);
  __builtin_amdgcn_sched_barrier(0);
  sol[17] -= b0a.y * sol[16]; sol[18] -= b0a.z * sol[16]; sol[19] -= b0a.w * sol[16]; sol[20] -= b0b.x * sol[16]; sol[21] -= b0b.y * sol[16]; sol[22] -= b0b.z * sol[16]; sol[23] -= b0b.w * sol[16]; sol[24] -= b0c.x * sol[16]; sol[25] -= b0c.y * sol[16]; sol[26] -= b0c.z * sol[16]; sol[27] -= b0c.w * sol[16]; sol[28] -= b0d.x * sol[16]; sol[29] -= b0d.y * sol[16]; sol[30] -= b0d.z * sol[16]; sol[31] -= b0d.w * sol[16];
  __builtin_amdgcn_sched_barrier(0);
  b0a = *(const float4*)(Lr + 1104); b0b = *(const float4*)(Lr + 1108); b0c = *(const float4*)(Lr + 1112); b0d = *(const float4*)(Lr + 1116);
  __builtin_amdgcn_sched_barrier(0);
  sol[32] -= b1a.x * sol[16]; sol[33] -= b1a.y * sol[16]; sol[34] -= b1a.z * sol[16]; sol[35] -= b1a.w * sol[16]; sol[36] -= b1b.x * sol[16]; sol[37] -= b1b.y * sol[16]; sol[38] -= b1b.z * sol[16]; sol[39] -= b1b.w * sol[16]; sol[40] -= b1c.x * sol[16]; sol[41] -= b1c.y * sol[16]; sol[42] -= b1c.z * sol[16]; sol[43] -= b1c.w * sol[16]; sol[44] -= b1d.x * sol[16]; sol[45] -= b1d.y * sol[16]; sol[46] -= b1d.z * sol[16]; sol[47] -= b1d.w * sol[16];
  __builtin_amdgcn_sched_barrier(0);
  b1a = *(const float4*)(Lr + 1120); b1b = *(const float4*)(Lr + 1124); b1c = *(const float4*)(Lr + 1128); b1d = *(const float4*)(Lr + 1132);
  __builtin_amdgcn_sched_barrier(0);
  sol[48] -= b2a.x * sol[16]; sol[49] -= b2a.y * sol[16]; sol[50] -= b2a.z * sol[16]; sol[51] -= b2a.w * sol[16]; sol[52] -= b2b.x * sol[16]; sol[53] -= b2b.y * sol[16]; sol[54] -= b2b.z * sol[16]; sol[55] -= b2b.w * sol[16]; sol[56] -= b2c.x * sol[16]; sol[57] -= b2c.y * sol[16]; sol[58] -= b2c.z * sol[16]; sol[59] -= b2c.w * sol[16]; sol[60] -= b2d.x * sol[16]; sol[61] -= b2d.y * sol[16]; sol[62] -= b2d.z * sol[16]; sol[63] -= b2d.w * sol[16];
  __builtin_amdgcn_sched_barrier(0);
  b2a = *(const float4*)(Lr + 1136); b2b = *(const float4*)(Lr + 1140); b2c = *(const float4*)(Lr + 1144); b2d = *(const float4*)(Lr + 1148);
  __builtin_amdgcn_sched_barrier(0);
  sol[18] -= b0a.z * sol[17]; sol[19] -= b0a.w * sol[17]; sol[20] -= b0b.x * sol[17]; sol[21] -= b0b.y * sol[17]; sol[22] -= b0b.z * sol[17]; sol[23] -= b0b.w * sol[17]; sol[24] -= b0c.x * sol[17]; sol[25] -= b0c.y * sol[17]; sol[26] -= b0c.z * sol[17]; sol[27] -= b0c.w * sol[17]; sol[28] -= b0d.x * sol[17]; sol[29] -= b0d.y * sol[17]; sol[30] -= b0d.z * sol[17]; sol[31] -= b0d.w * sol[17];
  __builtin_amdgcn_sched_barrier(0);
  b0a = *(const float4*)(Lr + 1168); b0b = *(const float4*)(Lr + 1172); b0c = *(const float4*)(Lr + 1176); b0d = *(const float4*)(Lr + 1180);
  __builtin_amdgcn_sched_barrier(0);
  sol[32] -= b1a.x * sol[17]; sol[33] -= b1a.y * sol[17]; sol[34] -= b1a.z * sol[17]; sol[35] -= b1a.w * sol[17]; sol[36] -= b1b.x * sol[17]; sol[37] -= b1b.y * sol[17]; sol[38] -= b1b.z * sol[17]; sol[39] -= b1b.w * sol[17]; sol[40] -= b1c.x * sol[17]; sol[41] -= b1c.y * sol[17]; sol[42] -= b1c.z * sol[17]; sol[43] -= b1c.w * sol[17]; sol[44] -= b1d.x * sol[17]; sol[45] -= b1d.y * sol[17]; sol[46] -= b1d.z * sol[17]; sol[47] -= b1d.w * sol[17];
  __builtin_amdgcn_sched_barrier(0);
  b1a = *(const float4*)(Lr + 1184); b1b = *(const float4*)(Lr + 1188); b1c = *(const float4*)(Lr + 1192); b1d = *(const float4*)(Lr + 1196);
  __builtin_amdgcn_sched_barrier(0);
  sol[48] -= b2a.x * sol[17]; sol[49] -= b2a.y * sol[17]; sol[50] -= b2a.z * sol[17]; sol[51] -= b2a.w * sol[17]; sol[52] -= b2b.x * sol[17]; sol[53] -= b2b.y * sol[17]; sol[54] -= b2b.z * sol[17]; sol[55] -= b2b.w * sol[17]; sol[56] -= b2c.x * sol[17]; sol[57] -= b2c.y * sol[17]; sol[58] -= b2c.z * sol[17]; sol[59] -= b2c.w * sol[17]; sol[60] -= b2d.x * sol[17]; sol[61] -= b2d.y * sol[17]; sol[62] -= b2d.z * sol[17]; sol[63] -= b2d.w * sol[17];
  __builtin_amdgcn_sched_barrier(0);
  b2a = *(const float4*)(Lr + 1200); b2b = *(const float4*)(Lr + 1204); b2c = *(const float4*)(Lr + 1208); b2d = *(const float4*)(Lr + 1212);
  __builtin_amdgcn_sched_barrier(0);
  sol[19] -= b0a.w * sol[18]; sol[20] -= b0b.x * sol[18]; sol[21] -= b0b.y * sol[18]; sol[22] -= b0b.z * sol[18]; sol[23] -= b0b.w * sol[18]; sol[24] -= b0c.x * sol[18]; sol[25] -= b0c.y * sol[18]; sol[26] -= b0c.z * sol[18]; sol[27] -= b0c.w * sol[18]; sol[28] -= b0d.x * sol[18]; sol[29] -= b0d.y * sol[18]; sol[30] -= b0d.z * sol[18]; sol[31] -= b0d.w * sol[18];
  __builtin_amdgcn_sched_barrier(0);
  b0a = *(const float4*)(Lr + 1232); b0b = *(const float4*)(Lr + 1236); b0c = *(const float4*)(Lr + 1240); b0d = *(const float4*)(Lr + 1244);
  __builtin_amdgcn_sched_barrier(0);
  sol[32] -= b1a.x * sol[18]; sol[33] -= b1a.y * sol[18]; sol[34] -= b1a.z * sol[18]; sol[35] -= b1a.w * sol[18]; sol[36] -= b1b.x * sol[18]; sol[37] -= b1b.y * sol[18]; sol[38] -= b1b.z * sol[18]; sol[39] -= b1b.w * sol[18]; sol[40] -= b1c.x * sol[18]; sol[41] -= b1c.y * sol[18]; sol[42] -= b1c.z * sol[18]; sol[43] -= b1c.w * sol[18]; sol[44] -= b1d.x * sol[18]; sol[45] -= b1d.y * sol[18]; sol[46] -= b1d.z * sol[18]; sol[47] -= b1d.w * sol[18];
  __builtin_amdgcn_sched_barrier(0);
  b1a = *(const float4*)(Lr + 1248); b1b = *(const float4*)(Lr + 1252); b1c = *(const float4*)(Lr + 1256); b1d = *(const float4*)(Lr + 1260);
  __builtin_amdgcn_sched_barrier(0);
  sol[48] -= b2a.x * sol[18]; sol[49] -= b2a.y * sol[18]; sol[50] -= b2a.z * sol[18]; sol[51] -= b2a.w * sol[18]; sol[52] -= b2b.x * sol[18]; sol[53] -= b2b.y * sol[18]; sol[54] -= b2b.z * sol[18]; sol[55] -= b2b.w * sol[18]; sol[56] -= b2c.x * sol[18]; sol[57] -= b2c.y * sol[18]; sol[58] -= b2c.z * sol[18]; sol[59] -= b2c.w * sol[18]; sol[60] -= b2d.x * sol[18]; sol[61] -= b2d.y * sol[18]; sol[62] -= b2d.z * sol[18]; sol[63] -= b2d.w * sol[18];
  __builtin_amdgcn_sched_barrier(0);
  b2a = *(const float4*)(Lr + 1264); b2b = *(const float4*)(Lr + 1268); b2c = *(const float4*)(Lr + 1272); b2d = *(const float4*)(Lr + 1276);
  __builtin_amdgcn_sched_barrier(0);
  sol[20] -= b0b.x * sol[19]; sol[21] -= b0b.y * sol[19]; sol[22] -= b0b.z * sol[19]; sol[23] -= b0b.w * sol[19]; sol[24] -= b0c.x * sol[19]; sol[25] -= b0c.y * sol[19]; sol[26] -= b0c.z * sol[19]; sol[27] -= b0c.w * sol[19]; sol[28] -= b0d.x * sol[19]; sol[29] -= b0d.y * sol[19]; sol[30] -= b0d.z * sol[19]; sol[31] -= b0d.w * sol[19];
  __builtin_amdgcn_sched_barrier(0);
  b0a = *(const float4*)(Lr + 1296); b0b = *(const float4*)(Lr + 1300); b0c = *(const float4*)(Lr + 1304); b0d = *(const float4*)(Lr + 1308);
  __builtin_amdgcn_sched_barrier(0);
  sol[32] -= b1a.x * sol[19]; sol[33] -= b1a.y * sol[19]; sol[34] -= b1a.z * sol[19]; sol[35] -= b1a.w * sol[19]; sol[36] -= b1b.x * sol[19]; sol[37] -= b1b.y * sol[19]; sol[38] -= b1b.z * sol[19]; sol[39] -= b1b.w * sol[19]; sol[40] -= b1c.x * sol[19]; sol[41] -= b1c.y * sol[19]; sol[42] -= b1c.z * sol[19]; sol[43] -= b1c.w * sol[19]; sol[44] -= b1d.x * sol[19]; sol[45] -= b1d.y * sol[19]; sol[46] -= b1d.z * sol[19]; sol[47] -= b1d.w * sol[19];
  __builtin_amdgcn_sched_barrier(0);
  b1a = *(const float4*)(Lr + 1312); b1b = *(const float4*)(Lr + 1316); b1c = *(const float4*)(Lr + 1320); b1d = *(const float4*)(Lr + 1324);
  __builtin_amdgcn_sched_barrier(0);
  sol[48] -= b2a.x * sol[19]; sol[49] -= b2a.y * sol[19]; sol[50] -= b2a.z * sol[19]; sol[51] -= b2a.w * sol[19]; sol[52] -= b2b.x * sol[19]; sol[53] -= b2b.y * sol[19]; sol[54] -= b2b.z * sol[19]; sol[55] -= b2b.w * sol[19]; sol[56] -= b2c.x * sol[19]; sol[57] -= b2c.y * sol[19]; sol[58] -= b2c.z * sol[19]; sol[59] -= b2c.w * sol[19]; sol[60] -= b2d.x * sol[19]; sol[61] -= b2d.y * sol[19]; sol[62] -= b2d.z * sol[19]; sol[63] -= b2d.w * sol[19];
  __builtin_amdgcn_sched_barrier(0);
  b2a = *(const float4*)(Lr + 1328); b2b = *(const float4*)(Lr + 1332); b2c = *(const float4*)(Lr + 1336); b2d = *(const float4*)(Lr + 1340);
  __builtin_amdgcn_sched_barrier(0);
  sol[21] -= b0b.y * sol[20]; sol[22] -= b0b.z * sol[20]; sol[23] -= b0b.w * sol[20]; sol[24] -= b0c.x * sol[20]; sol[25] -= b0c.y * sol[20]; sol[26] -= b0c.z * sol[20]; sol[27] -= b0c.w * sol[20]; sol[28] -= b0d.x * sol[20]; sol[29] -= b0d.y * sol[20]; sol[30] -= b0d.z * sol[20]; sol[31] -= b0d.w * sol[20];
  __builtin_amdgcn_sched_barrier(0);
  b0a = *(const float4*)(Lr + 1360); b0b = *(const float4*)(Lr + 1364); b0c = *(const float4*)(Lr + 1368); b0d = *(const float4*)(Lr + 1372);
  __builtin_amdgcn_sched_barrier(0);
  sol[32] -= b1a.x * sol[20]; sol[33] -= b1a.y * sol[20]; sol[34] -= b1a.z * sol[20]; sol[35] -= b1a.w * sol[20]; sol[36] -= b1b.x * sol[20]; sol[37] -= b1b.y * sol[20]; sol[38] -= b1b.z * sol[20]; sol[39] -= b1b.w * sol[20]; sol[40] -= b1c.x * sol[20]; sol[41] -= b1c.y * sol[20]; sol[42] -= b1c.z * sol[20]; sol[43] -= b1c.w * sol[20]; sol[44] -= b1d.x * sol[20]; sol[45] -= b1d.y * sol[20]; sol[46] -= b1d.z * sol[20]; sol[47] -= b1d.w * sol[20];
  __builtin_amdgcn_sched_barrier(0);
  b1a = *(const float4*)(Lr + 1376); b1b = *(const float4*)(Lr + 1380); b1c = *(const float4*)(Lr + 1384); b1d = *(const float4*)(Lr + 1388);
  __builtin_amdgcn_sched_barrier(0);
  sol[48] -= b2a.x * sol[20]; sol[49] -= b2a.y * sol[20]; sol[50] -= b2a.z * sol[20]; sol[51] -= b2a.w * sol[20]; sol[52] -= b2b.x * sol[20]; sol[53] -= b2b.y * sol[20]; sol[54] -= b2b.z * sol[20]; sol[55] -= b2b.w * sol[20]; sol[56] -= b2c.x * sol[20]; sol[57] -= b2c.y * sol[20]; sol[58] -= b2c.z * sol[20]; sol[59] -= b2c.w * sol[20]; sol[60] -= b2d.x * sol[20]; sol[61] -= b2d.y * sol[20]; sol[62] -= b2d.z * sol[20]; sol[63] -= b2d.w * sol[20];
  __builtin_amdgcn_sched_barrier(0);
  b2a = *(const float4*)(Lr + 1392); b2b = *(const float4*)(Lr + 1396); b2c = *(const float4*)(Lr + 1400); b2d = *(const float4*)(Lr + 1404);
  __builtin_amdgcn_sched_barrier(0);
  sol[22] -= b0b.z * sol[21]; sol[23] -= b0b.w * sol[21]; sol[24] -= b0c.x * sol[21]; sol[25] -= b0c.y * sol[21]; sol[26] -= b0c.z * sol[21]; sol[27] -= b0c.w * sol[21]; sol[28] -= b0d.x * sol[21]; sol[29] -= b0d.y * sol[21]; sol[30] -= b0d.z * sol[21]; sol[31] -= b0d.w * sol[21];
  __builtin_amdgcn_sched_barrier(0);
  b0a = *(const float4*)(Lr + 1424); b0b = *(const float4*)(Lr + 1428); b0c = *(const float4*)(Lr + 1432); b0d = *(const float4*)(Lr + 1436);
  __builtin_amdgcn_sched_barrier(0);
  sol[32] -= b1a.x * sol[21]; sol[33] -= b1a.y * sol[21]; sol[34] -= b1a.z * sol[21]; sol[35] -= b1a.w * sol[21]; sol[36] -= b1b.x * sol[21]; sol[37] -= b1b.y * sol[21]; sol[38] -= b1b.z * sol[21]; sol[39] -= b1b.w * sol[21]; sol[40] -= b1c.x * sol[21]; sol[41] -= b1c.y * sol[21]; sol[42] -= b1c.z * sol[21]; sol[43] -= b1c.w * sol[21]; sol[44] -= b1d.x * sol[21]; sol[45] -= b1d.y * sol[21]; sol[46] -= b1d.z * sol[21]; sol[47] -= b1d.w * sol[21];
  __builtin_amdgcn_sched_barrier(0);
  b1a = *(const float4*)(Lr + 1440); b1b = *(const float4*)(Lr + 1444); b1c = *(const float4*)(Lr + 1448); b1d = *(const float4*)(Lr + 1452);
  __builtin_amdgcn_sched_barrier(0);
  sol[48] -= b2a.x * sol[21]; sol[49] -= b2a.y * sol[21]; sol[50] -= b2a.z * sol[21]; sol[51] -= b2a.w * sol[21]; sol[52] -= b2b.x * sol[21]; sol[53] -= b2b.y * sol[21]; sol[54] -= b2b.z * sol[21]; sol[55] -= b2b.w * sol[21]; sol[56] -= b2c.x * sol[21]; sol[57] -= b2c.y * sol[21]; sol[58] -= b2c.z * sol[21]; sol[59] -= b2c.w * sol[21]; sol[60] -= b2d.x * sol[21]; sol[61] -= b2d.y * sol[21]; sol[62] -= b2d.z * sol[21]; sol[63] -= b2d.w * sol[21];
  __builtin_amdgcn_sched_barrier(0);
  b2a = *(const float4*)(Lr + 1456); b2b = *(const float4*)(Lr + 1460); b2c = *(const float4*)(Lr + 1464); b2d = *(const float4*)(Lr + 1468);
  __builtin_amdgcn_sched_barrier(0);
  sol[23] -= b0b.w * sol[22]; sol[24] -= b0c.x * sol[22]; sol[25] -= b0c.y * sol[22]; sol[26] -= b0c.z * sol[22]; sol[27] -= b0c.w * sol[22]; sol[28] -= b0d.x * sol[22]; sol[29] -= b0d.y * sol[22]; sol[30] -= b0d.z * sol[22]; sol[31] -= b0d.w * sol[22];
  __builtin_amdgcn_sched_barrier(0);
  b0a = *(const float4*)(Lr + 1488); b0b = *(const float4*)(Lr + 1492); b0c = *(const float4*)(Lr + 1496); b0d = *(const float4*)(Lr + 1500);
  __builtin_amdgcn_sched_barrier(0);
  sol[32] -= b1a.x * sol[22]; sol[33] -= b1a.y * sol[22]; sol[34] -= b1a.z * sol[22]; sol[35] -= b1a.w * sol[22]; sol[36] -= b1b.x * sol[22]; sol[37] -= b1b.y * sol[22]; sol[38] -= b1b.z * sol[22]; sol[39] -= b1b.w * sol[22]; sol[40] -= b1c.x * sol[22]; sol[41] -= b1c.y * sol[22]; sol[42] -= b1c.z * sol[22]; sol[43] -= b1c.w * sol[22]; sol[44] -= b1d.x * sol[22]; sol[45] -= b1d.y * sol[22]; sol[46] -= b1d.z * sol[22]; sol[47] -= b1d.w * sol[22];
  __builtin_amdgcn_sched_barrier(0);
  b1a = *(const float4*)(Lr + 1504); b1b = *(const float4*)(Lr + 1508); b1c = *(const float4*)(Lr + 1512); b1d = *(const float4*)(Lr + 1516);
  __builtin_amdgcn_sched_barrier(0);
  sol[48] -= b2a.x * sol[22]; sol[49] -= b2a.y * sol[22]; sol[50] -= b2a.z * sol[22]; sol[51] -= b2a.w * sol[22]; sol[52] -= b2b.x * sol[22]; sol[53] -= b2b.y * sol[22]; sol[54] -= b2b.z * sol[22]; sol[55] -= b2b.w * sol[22]; sol[56] -= b2c.x * sol[22]; sol[57] -= b2c.y * sol[22]; sol[58] -= b2c.z * sol[22]; sol[59] -= b2c.w * sol[22]; sol[60] -= b2d.x * sol[22]; sol[61] -= b2d.y * sol[22]; sol[62] -= b2d.z * sol[22]; sol[63] -= b2d.w * sol[22];
  __builtin_amdgcn_sched_barrier(0);
  b2a = *(const float4*)(Lr + 1520); b2b = *(const float4*)(Lr + 1524); b2c = *(const float4*)(Lr + 1528); b2d = *(const float4*)(Lr + 1532);
  __builtin_amdgcn_sched_barrier(0);
  sol[24] -= b0c.x * sol[23]; sol[25] -= b0c.y * sol[23]; sol[26] -= b0c.z * sol[23]; sol[27] -= b0c.w * sol[23]; sol[28] -= b0d.x * sol[23]; sol[29] -= b0d.y * sol[23]; sol[30] -= b0d.z * sol[23]; sol[31] -= b0d.w * sol[23];
  __builtin_amdgcn_sched_barrier(0);
  b0a = *(const float4*)(Lr + 1552); b0b = *(const float4*)(Lr + 1556); b0c = *(const float4*)(Lr + 1560); b0d = *(const float4*)(Lr + 1564);
  __builtin_amdgcn_sched_barrier(0);
  sol[32] -= b1a.x * sol[23]; sol[33] -= b1a.y * sol[23]; sol[34] -= b1a.z * sol[23]; sol[35] -= b1a.w * sol[23]; sol[36] -= b1b.x * sol[23]; sol[37] -= b1b.y * sol[23]; sol[38] -= b1b.z * sol[23]; sol[39] -= b1b.w * sol[23]; sol[40] -= b1c.x * sol[23]; sol[41] -= b1c.y * sol[23]; sol[42] -= b1c.z * sol[23]; sol[43] -= b1c.w * sol[23]; sol[44] -= b1d.x * sol[23]; sol[45] -= b1d.y * sol[23]; sol[46] -= b1d.z * sol[23]; sol[47] -= b1d.w * sol[23];
  __builtin_amdgcn_sched_barrier(0);
  b1a = *(const float4*)(Lr + 1568); b1b = *(const float4*)(Lr + 1572); b1c = *(const float4*)(Lr + 1576); b1d = *(const float4*)(Lr + 1580);
  __builtin_amdgcn_sched_barrier(0);
  sol[48] -= b2a.x * sol[23]; sol[49] -= b2a.y * sol[23]; sol[50] -= b2a.z * sol[23]; sol[51] -= b2a.w * sol[23]; sol[52] -= b2b.x * sol[23]; sol[53] -= b2b.y * sol[23]; sol[54] -= b2b.z * sol[23]; sol[55] -= b2b.w * sol[23]; sol[56] -= b2c.x * sol[23]; sol[57] -= b2c.y * sol[23]; sol[58] -= b2c.z * sol[23]; sol[59] -= b2c.w * sol[23]; sol[60] -= b2d.x * sol[23]; sol[61] -= b2d.y * sol[23]; sol[62] -= b2d.z * sol[23]; sol[63] -= b2d.w * sol[23];
  __builtin_amdgcn_sched_barrier(0);
  b2a = *(const float4*)(Lr + 1584); b2b = *(const float4*)(Lr + 1588); b2c = *(const float4*)(Lr + 1592); b2d = *(const float4*)(Lr + 1596);
  __builtin_amdgcn_sched_barrier(0);
  sol[25] -= b0c.y * sol[24]; sol[26] -= b0c.z * sol[24]; sol[27] -= b0c.w * sol[24]; sol[28] -= b0d.x * sol[24]; sol[29] -= b0d.y * sol[24]; sol[30] -= b0d.z * sol[24]; sol[31] -= b0d.w * sol[24];
  __builtin_amdgcn_sched_barrier(0);
  b0a = *(const float4*)(Lr + 1616); b0b = *(const float4*)(Lr + 1620); b0c = *(const float4*)(Lr + 1624); b0d = *(const float4*)(Lr + 1628);
  __builtin_amdgcn_sched_barrier(0);
  sol[32] -= b1a.x * sol[24]; sol[33] -= b1a.y * sol[24]; sol[34] -= b1a.z * sol[24]; sol[35] -= b1a.w * sol[24]; sol[36] -= b1b.x * sol[24]; sol[37] -= b1b.y * sol[24]; sol[38] -= b1b.z * sol[24]; sol[39] -= b1b.w * sol[24]; sol[40] -= b1c.x * sol[24]; sol[41] -= b1c.y * sol[24]; sol[42] -= b1c.z * sol[24]; sol[43] -= b1c.w * sol[24]; sol[44] -= b1d.x * sol[24]; sol[45] -= b1d.y * sol[24]; sol[46] -= b1d.z * sol[24]; sol[47] -= b1d.w * sol[24];
  __builtin_amdgcn_sched_barrier(0);
  b1a = *(const float4*)(Lr + 1632); b1b = *(const float4*)(Lr + 1636); b1c = *(const float4*)(Lr + 1640); b1d = *(const float4*)(Lr + 1644);
  __builtin_amdgcn_sched_barrier(0);
  sol[48] -= b2a.x * sol[24]; sol[49] -= b2a.y * sol[24]; sol[50] -= b2a.z * sol[24]; sol[51] -= b2a.w * sol[24]; sol[52] -= b2b.x * sol[24]; sol[53] -= b2b.y * sol[24]; sol[54] -= b2b.z * sol[24]; sol[55] -= b2b.w * sol[24]; sol[56] -= b2c.x * sol[24]; sol[57] -= b2c.y * sol[24]; sol[58] -= b2c.z * sol[24]; sol[59] -= b2c.w * sol[24]; sol[60] -= b2d.x * sol[24]; sol[61] -= b2d.y * sol[24]; sol[62] -= b2d.z * sol[24]; sol[63] -= b2d.w * sol[24];
  __builtin_amdgcn_sched_barrier(0);
  b2a = *(const float4*)(Lr + 1648); b2b = *(const float4*)(Lr + 1652); b2c = *(const float4*)(Lr + 1656); b2d = *(const float4*)(Lr + 1660);
  __builtin_amdgcn_sched_barrier(0);
  sol[26] -= b0c.z * sol[25]; sol[27] -= b0c.w * sol[25]; sol[28] -= b0d.x * sol[25]; sol[29] -= b0d.y * sol[25]; sol[30] -= b0d.z * sol[25]; sol[31] -= b0d.w * sol[25];
  __builtin_amdgcn_sched_barrier(0);
  b0a = *(const float4*)(Lr + 1680); b0b = *(const float4*)(Lr + 1684); b0c = *(const float4*)(Lr + 1688); b0d = *(const float4*)(Lr + 1692);
  __builtin_amdgcn_sched_barrier(0);
  sol[32] -= b1a.x * sol[25]; sol[33] -= b1a.y * sol[25]; sol[34] -= b1a.z * sol[25]; sol[35] -= b1a.w * sol[25]; sol[36] -= b1b.x * sol[25]; sol[37] -= b1b.y * sol[25]; sol[38] -= b1b.z * sol[25]; sol[39] -= b1b.w * sol[25]; sol[40] -= b1c.x * sol[25]; sol[41] -= b1c.y * sol[25]; sol[42] -= b1c.z * sol[25]; sol[43] -= b1c.w * sol[25]; sol[44] -= b1d.x * sol[25]; sol[45] -= b1d.y * sol[25]; sol[46] -= b1d.z * sol[25]; sol[47] -= b1d.w * sol[25];
  __builtin_amdgcn_sched_barrier(0);
  b1a = *(const float4*)(Lr + 1696); b1b = *(const float4*)(Lr + 1700); b1c = *(const float4*)(Lr + 1704); b1d = *(const float4*)(Lr + 1708);
  __builtin_amdgcn_sched_barrier(0);
  sol[48] -= b2a.x * sol[25]; sol[49] -= b2a.y * sol[25]; sol[50] -= b2a.z * sol[25]; sol[51] -= b2a.w * sol[25]; sol[52] -= b2b.x * sol[25]; sol[53] -= b2b.y * sol[25]; sol[54] -= b2b.z * sol[25]; sol[55] -= b2b.w * sol[25]; sol[56] -= b2c.x * sol[25]; sol[57] -= b2c.y * sol[25]; sol[58] -= b2c.z * sol[25]; sol[59] -= b2c.w * sol[25]; sol[60] -= b2d.x * sol[25]; sol[61] -= b2d.y * sol[25]; sol[62] -= b2d.z * sol[25]; sol[63] -= b2d.w * sol[25];
  __builtin_amdgcn_sched_barrier(0);
  b2a = *(const float4*)(Lr + 1712); b2b = *(const float4*)(Lr + 1716); b2c = *(const float4*)(Lr + 1720); b2d = *(const float4*)(Lr + 1724);
  __builtin_amdgcn_sched_barrier(0);
  sol[27] -= b0c.w * sol[26]; sol[28] -= b0d.x * sol[26]; sol[29] -= b0d.y * sol[26]; sol[30] -= b0d.z * sol[26]; sol[31] -= b0d.w * sol[26];
  __builtin_amdgcn_sched_barrier(0);
  b0a = *(const float4*)(Lr + 1744); b0b = *(const float4*)(Lr + 1748); b0c = *(const float4*)(Lr + 1752); b0d = *(const float4*)(Lr + 1756);
  __builtin_amdgcn_sched_barrier(0);
  sol[32] -= b1a.x * sol[26]; sol[33] -= b1a.y * sol[26]; sol[34] -= b1a.z * sol[26]; sol[35] -= b1a.w * sol[26]; sol[36] -= b1b.x * sol[26]; sol[37] -= b1b.y * sol[26]; sol[38] -= b1b.z * sol[26]; sol[39] -= b1b.w * sol[26]; sol[40] -= b1c.x * sol[26]; sol[41] -= b1c.y * sol[26]; sol[42] -= b1c.z * sol[26]; sol[43] -= b1c.w * sol[26]; sol[44] -= b1d.x * sol[26]; sol[45] -= b1d.y * sol[26]; sol[46] -= b1d.z * sol[26]; sol[47] -= b1d.w * sol[26];
  __builtin_amdgcn_sched_barrier(0);
  b1a = *(const float4*)(Lr + 1760); b1b = *(const float4*)(Lr + 1764); b1c = *(const float4*)(Lr + 1768); b1d = *(const float4*)(Lr + 1772);
  __builtin_amdgcn_sched_barrier(0);
  sol[48] -= b2a.x * sol[26]; sol[49] -= b2a.y * sol[26]; sol[50] -= b2a.z * sol[26]; sol[51] -= b2a.w * sol[26]; sol[52] -= b2b.x * sol[26]; sol[53] -= b2b.y * sol[26]; sol[54] -= b2b.z * sol[26]; sol[55] -= b2b.w * sol[26]; sol[56] -= b2c.x * sol[26]; sol[57] -= b2c.y * sol[26]; sol[58] -= b2c.z * sol[26]; sol[59] -= b2c.w * sol[26]; sol[60] -= b2d.x * sol[26]; sol[61] -= b2d.y * sol[26]; sol[62] -= b2d.z * sol[26]; sol[63] -= b2d.w * sol[26];
  __builtin_amdgcn_sched_barrier(0);
  b2a = *(const float4*)(Lr + 1776); b2b = *(const float4*)(Lr + 1780); b2c = *(const float4*)(Lr + 1784); b2d = *(const float4*)(Lr + 1788);
  __builtin_amdgcn_sched_barrier(0);
  sol[28] -= b0d.x * sol[27]; sol[29] -= b0d.y * sol[27]; sol[30] -= b0d.z * sol[27]; sol[31] -= b0d.w * sol[27];
  __builtin_amdgcn_sched_barrier(0);
  b0a = *(const float4*)(Lr + 1808); b0b = *(const float4*)(Lr + 1812); b0c = *(const float4*)(Lr + 1816); b0d = *(const float4*)(Lr + 1820);
  __builtin_amdgcn_sched_barrier(0);
  sol[32] -= b1a.x * sol[27]; sol[33] -= b1a.y * sol[27]; sol[34] -= b1a.z * sol[27]; sol[35] -= b1a.w * sol[27]; sol[36] -= b1b.x * sol[27]; sol[37] -= b1b.y * sol[27]; sol[38] -= b1b.z * sol[27]; sol[39] -= b1b.w * sol[27]; sol[40] -= b1c.x * sol[27]; sol[41] -= b1c.y * sol[27]; sol[42] -= b1c.z * sol[27]; sol[43] -= b1c.w * sol[27]; sol[44] -= b1d.x * sol[27]; sol[45] -= b1d.y * sol[27]; sol[46] -= b1d.z * sol[27]; sol[47] -= b1d.w * sol[27];
  __builtin_amdgcn_sched_barrier(0);
  b1a = *(const float4*)(Lr + 1824); b1b = *(const float4*)(Lr + 1828); b1c = *(const float4*)(Lr + 1832); b1d = *(const float4*)(Lr + 1836);
  __builtin_amdgcn_sched_barrier(0);
  sol[48] -= b2a.x * sol[27]; sol[49] -= b2a.y * sol[27]; sol[50] -= b2a.z * sol[27]; sol[51] -= b2a.w * sol[27]; sol[52] -= b2b.x * sol[27]; sol[53] -= b2b.y * sol[27]; sol[54] -= b2b.z * sol[27]; sol[55] -= b2b.w * sol[27]; sol[56] -= b2c.x * sol[27]; sol[57] -= b2c.y * sol[27]; sol[58] -= b2c.z * sol[27]; sol[59] -= b2c.w * sol[27]; sol[60] -= b2d.x * sol[27]; sol[61] -= b2d.y * sol[27]; sol[62] -= b2d.z * sol[27]; sol[63] -= b2d.w * sol[27];
  __builtin_amdgcn_sched_barrier(0);
  b2a = *(const float4*)(Lr + 1840); b2b = *(const float4*)(Lr + 1844); b2c = *(const float4*)(Lr + 1848); b2d = *(const float4*)(Lr + 1852);
  __builtin_amdgcn_sched_barrier(0);
  sol[29] -= b0d.y * sol[28]; sol[30] -= b0d.z * sol[28]; sol[31] -= b0d.w * sol[28];
  __builtin_amdgcn_sched_barrier(0);
  b0a = *(const float4*)(Lr + 1872); b0b = *(const float4*)(Lr + 1876); b0c = *(const float4*)(Lr + 1880); b0d = *(const float4*)(Lr + 1884);
  __builtin_amdgcn_sched_barrier(0);
  sol[32] -= b1a.x * sol[28]; sol[33] -= b1a.y * sol[28]; sol[34] -= b1a.z * sol[28]; sol[35] -= b1a.w * sol[28]; sol[36] -= b1b.x * sol[28]; sol[37] -= b1b.y * sol[28]; sol[38] -= b1b.z * sol[28]; sol[39] -= b1b.w * sol[28]; sol[40] -= b1c.x * sol[28]; sol[41] -= b1c.y * sol[28]; sol[42] -= b1c.z * sol[28]; sol[43] -= b1c.w * sol[28]; sol[44] -= b1d.x * sol[28]; sol[45] -= b1d.y * sol[28]; sol[46] -= b1d.z * sol[28]; sol[47] -= b1d.w * sol[28];
  __builtin_amdgcn_sched_barrier(0);
  b1a = *(const float4*)(Lr + 1888); b1b = *(const float4*)(Lr + 1892); b1c = *(const float4*)(Lr + 1896); b1d = *(const float4*)(Lr + 1900);
  __builtin_amdgcn_sched_barrier(0);
  sol[48] -= b2a.x * sol[28]; sol[49] -= b2a.y * sol[28]; sol[50] -= b2a.z * sol[28]; sol[51] -= b2a.w * sol[28]; sol[52] -= b2b.x * sol[28]; sol[53] -= b2b.y * sol[28]; sol[54] -= b2b.z * sol[28]; sol[55] -= b2b.w * sol[28]; sol[56] -= b2c.x * sol[28]; sol[57] -= b2c.y * sol[28]; sol[58] -= b2c.z * sol[28]; sol[59] -= b2c.w * sol[28]; sol[60] -= b2d.x * sol[28]; sol[61] -= b2d.y * sol[28]; sol[62] -= b2d.z * sol[28]; sol[63] -= b2d.w * sol[28];
  __builtin_amdgcn_sched_barrier(0);
  b2a = *(const float4*)(Lr + 1904); b2b = *(const float4*)(Lr + 1908); b2c = *(const float4*)(Lr + 1912); b2d = *(const float4*)(Lr + 1916);
  __builtin_amdgcn_sched_barrier(0);
  sol[30] -= b0d.z * sol[29]; sol[31] -= b0d.w * sol[29];
  __builtin_amdgcn_sched_barrier(0);
  b0a = *(const float4*)(Lr + 1936); b0b = *(const float4*)(Lr + 1940); b0c = *(const float4*)(Lr + 1944); b0d = *(const float4*)(Lr + 1948);
  __builtin_amdgcn_sched_barrier(0);
  sol[32] -= b1a.x * sol[29]; sol[33] -= b1a.y * sol[29]; sol[34] -= b1a.z * sol[29]; sol[35] -= b1a.w * sol[29]; sol[36] -= b1b.x * sol[29]; sol[37] -= b1b.y * sol[29]; sol[38] -= b1b.z * sol[29]; sol[39] -= b1b.w * sol[29]; sol[40] -= b1c.x * sol[29]; sol[41] -= b1c.y * sol[29]; sol[42] -= b1c.z * sol[29]; sol[43] -= b1c.w * sol[29]; sol[44] -= b1d.x * sol[29]; sol[45] -= b1d.y * sol[29]; sol[46] -= b1d.z * sol[29]; sol[47] -= b1d.w * sol[29];
  __builtin_amdgcn_sched_barrier(0);
  b1a = *(const float4*)(Lr + 1952); b1b = *(const float4*)(Lr + 1956); b1c = *(const float4*)(Lr + 1960); b1d = *(const float4*)(Lr + 1964);
  __builtin_amdgcn_sched_barrier(0);
  sol[48] -= b2a.x * sol[29]; sol[49] -= b2a.y * sol[29]; sol[50] -= b2a.z * sol[29]; sol[51] -= b2a.w * sol[29]; sol[52] -= b2b.x * sol[29]; sol[53] -= b2b.y * sol[29]; sol[54] -= b2b.z * sol[29]; sol[55] -= b2b.w * sol[29]; sol[56] -= b2c.x * sol[29]; sol[57] -= b2c.y * sol[29]; sol[58] -= b2c.z * sol[29]; sol[59] -= b2c.w * sol[29]; sol[60] -= b2d.x * sol[29]; sol[61] -= b2d.y * sol[29]; sol[62] -= b2d.z * sol[29]; sol[63] -= b2d.w * sol[29];
  __builtin_amdgcn_sched_barrier(0);
  b2a = *(const float4*)(Lr + 1968); b2b = *(const float4*)(Lr + 1972); b2c = *(const float4*)(Lr + 1976); b2d = *(const float4*)(Lr + 1980);
  __builtin_amdgcn_sched_barrier(0);
  sol[31] -= b0d.w * sol[30];
  __builtin_amdgcn_sched_barrier(0);
  b0a = *(const float4*)(Lr + 2016); b0b = *(const float4*)(Lr + 2020); b0c = *(const float4*)(Lr + 2024); b0d = *(const float4*)(Lr + 2028);
  __builtin_amdgcn_sched_barrier(0);
  sol[32] -= b1a.x * sol[30]; sol[33] -= b1a.y * sol[30]; sol[34] -= b1a.z * sol[30]; sol[35] -= b1a.w * sol[30]; sol[36] -= b1b.x * sol[30]; sol[37] -= b1b.y * sol[30]; sol[38] -= b1b.z * sol[30]; sol[39] -= b1b.w * sol[30]; sol[40] -= b1c.x * sol[30]; sol[41] -= b1c.y * sol[30]; sol[42] -= b1c.z * sol[30]; sol[43] -= b1c.w * sol[30]; sol[44] -= b1d.x * sol[30]; sol[45] -= b1d.y * sol[30]; sol[46] -= b1d.z * sol[30]; sol[47] -= b1d.w * sol[30];
  __builtin_amdgcn_sched_barrier(0);
  b1a = *(const float4*)(Lr + 2032); b1b = *(const float4*)(Lr + 2036); b1c = *(const float4*)(Lr + 2040); b1d = *(const float4*)(Lr + 2044);
  __builtin_amdgcn_sched_barrier(0);
  sol[48] -= b2a.x * sol[30]; sol[49] -= b2a.y * sol[30]; sol[50] -= b2a.z * sol[30]; sol[51] -= b2a.w * sol[30]; sol[52] -= b2b.x * sol[30]; sol[53] -= b2b.y * sol[30]; sol[54] -= b2b.z * sol[30]; sol[55] -= b2b.w * sol[30]; sol[56] -= b2c.x * sol[30]; sol[57] -= b2c.y * sol[30]; sol[58] -= b2c.z * sol[30]; sol[59] -= b2c.w * sol[30]; sol[60] -= b2d.x * sol[30]; sol[61] -= b2d.y * sol[30]; sol[62] -= b2d.z * sol[30]; sol[63] -= b2d.w * sol[30];
  __builtin_amdgcn_sched_barrier(0);
  b2a = *(const float4*)(Lr + 2080); b2b = *(const float4*)(Lr + 2084); b2c = *(const float4*)(Lr + 2088); b2d = *(const float4*)(Lr + 2092);
  __builtin_amdgcn_sched_barrier(0);
  sol[32] -= b0a.x * sol[31]; sol[33] -= b0a.y * sol[31]; sol[34] -= b0a.z * sol[31]; sol[35] -= b0a.w * sol[31]; sol[36] -= b0b.x * sol[31]; sol[37] -= b0b.y * sol[31]; sol[38] -= b0b.z * sol[31]; sol[39] -= b0b.w * sol[31]; sol[40] -= b0c.x * sol[31]; sol[41] -= b0c.y * sol[31]; sol[42] -= b0c.z * sol[31]; sol[43] -= b0c.w * sol[31]; sol[44] -= b0d.x * sol[31]; sol[45] -= b0d.y * sol[31]; sol[46] -= b0d.z * sol[31]; sol[47] -= b0d.w * sol[31];
  __builtin_amdgcn_sched_barrier(0);
  b0a = *(const float4*)(Lr + 2096); b0b = *(const float4*)(Lr + 2100); b0c = *(const float4*)(Lr + 2104); b0d = *(const float4*)(Lr + 2108);
  __builtin_amdgcn_sched_barrier(0);
  sol[48] -= b1a.x * sol[31]; sol[49] -= b1a.y * sol[31]; sol[50] -= b1a.z * sol[31]; sol[51] -= b1a.w * sol[31]; sol[52] -= b1b.x * sol[31]; sol[53] -= b1b.y * sol[31]; sol[54] -= b1b.z * sol[31]; sol[55] -= b1b.w * sol[31]; sol[56] -= b1c.x * sol[31]; sol[57] -= b1c.y * sol[31]; sol[58] -= b1c.z * sol[31]; sol[59] -= b1c.w * sol[31]; sol[60] -= b1d.x * sol[31]; sol[61] -= b1d.y * sol[31]; sol[62] -= b1d.z * sol[31]; sol[63] -= b1d.w * sol[31];
  __builtin_amdgcn_sched_barrier(0);
  b1a = *(const float4*)(Lr + 2144); b1b = *(const float4*)(Lr + 2148); b1c = *(const float4*)(Lr + 2152); b1d = *(const float4*)(Lr + 2156);
  __builtin_amdgcn_sched_barrier(0);
  sol[33] -= b2a.y * sol[32]; sol[34] -= b2a.z * sol[32]; sol[35] -= b2a.w * sol[32]; sol[36] -= b2b.x * sol[32]; sol[37] -= b2b.y * sol[32]; sol[38] -= b2b.z * sol[32]; sol[39] -= b2b.w * sol[32]; sol[40] -= b2c.x * sol[32]; sol[41] -= b2c.y * sol[32]; sol[42] -= b2c.z * sol[32]; sol[43] -= b2c.w * sol[32]; sol[44] -= b2d.x * sol[32]; sol[45] -= b2d.y * sol[32]; sol[46] -= b2d.z * sol[32]; sol[47] -= b2d.w * sol[32];
  __builtin_amdgcn_sched_barrier(0);
  b2a = *(const float4*)(Lr + 2160); b2b = *(const float4*)(Lr + 2164); b2c = *(const float4*)(Lr + 2168); b2d = *(const float4*)(Lr + 2172);
  __builtin_amdgcn_sched_barrier(0);
  sol[48] -= b0a.x * sol[32]; sol[49] -= b0a.y * sol[32]; sol[50] -= b0a.z * sol[32]; sol[51] -= b0a.w * sol[32]; sol[52] -= b0b.x * sol[32]; sol[53] -= b0b.y * sol[32]; sol[54] -= b0b.z * sol[32]; sol[55] -= b0b.w * sol[32]; sol[56] -= b0c.x * sol[32]; sol[57] -= b0c.y * sol[32]; sol[58] -= b0c.z * sol[32]; sol[59] -= b0c.w * sol[32]; sol[60] -= b0d.x * sol[32]; sol[61] -= b0d.y * sol[32]; sol[62] -= b0d.z * sol[32]; sol[63] -= b0d.w * sol[32];
  __builtin_amdgcn_sched_barrier(0);
  b0a = *(const float4*)(Lr + 2208); b0b = *(const float4*)(Lr + 2212); b0c = *(const float4*)(Lr + 2216); b0d = *(const float4*)(Lr + 2220);
  __builtin_amdgcn_sched_barrier(0);
  sol[34] -= b1a.z * sol[33]; sol[35] -= b1a.w * sol[33]; sol[36] -= b1b.x * sol[33]; sol[37] -= b1b.y * sol[33]; sol[38] -= b1b.z * sol[33]; sol[39] -= b1b.w * sol[33]; sol[40] -= b1c.x * sol[33]; sol[41] -= b1c.y * sol[33]; sol[42] -= b1c.z * sol[33]; sol[43] -= b1c.w * sol[33]; sol[44] -= b1d.x * sol[33]; sol[45] -= b1d.y * sol[33]; sol[46] -= b1d.z * sol[33]; sol[47] -= b1d.w * sol[33];
  __builtin_amdgcn_sched_barrier(0);
  b1a = *(const float4*)(Lr + 2224); b1b = *(const float4*)(Lr + 2228); b1c = *(const float4*)(Lr + 2232); b1d = *(const float4*)(Lr + 2236);
  __builtin_amdgcn_sched_barrier(0);
  sol[48] -= b2a.x * sol[33]; sol[49] -= b2a.y * sol[33]; sol[50] -= b2a.z * sol[33]; sol[51] -= b2a.w * sol[33]; sol[52] -= b2b.x * sol[33]; sol[53] -= b2b.y * sol[33]; sol[54] -= b2b.z * sol[33]; sol[55] -= b2b.w * sol[33]; sol[56] -= b2c.x * sol[33]; sol[57] -= b2c.y * sol[33]; sol[58] -= b2c.z * sol[33]; sol[59] -= b2c.w * sol[33]; sol[60] -= b2d.x * sol[33]; sol[61] -= b2d.y * sol[33]; sol[62] -= b2d.z * sol[33]; sol[63] -= b2d.w * sol[33];
  __builtin_amdgcn_sched_barrier(0);
  b2a = *(const float4*)(Lr + 2272); b2b = *(const float4*)(Lr + 2276); b2c = *(const float4*)(Lr + 2280); b2d = *(const float4*)(Lr + 2284);
  __builtin_amdgcn_sched_barrier(0);
  sol[35] -= b0a.w * sol[34]; sol[36] -= b0b.x * sol[34]; sol[37] -= b0b.y * sol[34]; sol[38] -= b0b.z * sol[34]; sol[39] -= b0b.w * sol[34]; sol[40] -= b0c.x * sol[34]; sol[41] -= b0c.y * sol[34]; sol[42] -= b0c.z * sol[34]; sol[43] -= b0c.w * sol[34]; sol[44] -= b0d.x * sol[34]; sol[45] -= b0d.y * sol[34]; sol[46] -= b0d.z * sol[34]; sol[47] -= b0d.w * sol[34];
  __builtin_amdgcn_sched_barrier(0);
  b0a = *(const float4*)(Lr + 2288); b0b = *(const float4*)(Lr + 2292); b0c = *(const float4*)(Lr + 2296); b0d = *(const float4*)(Lr + 2300);
  __builtin_amdgcn_sched_barrier(0);
  sol[48] -= b1a.x * sol[34]; sol[49] -= b1a.y * sol[34]; sol[50] -= b1a.z * sol[34]; sol[51] -= b1a.w * sol[34]; sol[52] -= b1b.x * sol[34]; sol[53] -= b1b.y * sol[34]; sol[54] -= b1b.z * sol[34]; sol[55] -= b1b.w * sol[34]; sol[56] -= b1c.x * sol[34]; sol[57] -= b1c.y * sol[34]; sol[58] -= b1c.z * sol[34]; sol[59] -= b1c.w * sol[34]; sol[60] -= b1d.x * sol[34]; sol[61] -= b1d.y * sol[34]; sol[62] -= b1d.z * sol[34]; sol[63] -= b1d.w * sol[34];
  __builtin_amdgcn_sched_barrier(0);
  b1a = *(const float4*)(Lr + 2336); b1b = *(const float4*)(Lr + 2340); b1c = *(const float4*)(Lr + 2344); b1d = *(const float4*)(Lr + 2348);
  __builtin_amdgcn_sched_barrier(0);
  sol[36] -= b2b.x * sol[35]; sol[37] -= b2b.y * sol[35]; sol[38] -= b2b.z * sol[35]; sol[39] -= b2b.w * sol[35]; sol[40] -= b2c.x * sol[35]; sol[41] -= b2c.y * sol[35]; sol[42] -= b2c.z * sol[35]; sol[43] -= b2c.w * sol[35]; sol[44] -= b2d.x * sol[35]; sol[45] -= b2d.y * sol[35]; sol[46] -= b2d.z * sol[35]; sol[47] -= b2d.w * sol[35];
  __builtin_amdgcn_sched_barrier(0);
  b2a = *(const float4*)(Lr + 2352); b2b = *(const float4*)(Lr + 2356); b2c = *(const float4*)(Lr + 2360); b2d = *(const float4*)(Lr + 2364);
  __builtin_amdgcn_sched_barrier(0);
  sol[48] -= b0a.x * sol[35]; sol[49] -= b0a.y * sol[35]; sol[50] -= b0a.z * sol[35]; sol[51] -= b0a.w * sol[35]; sol[52] -= b0b.x * sol[35]; sol[53] -= b0b.y * sol[35]; sol[54] -= b0b.z * sol[35]; sol[55] -= b0b.w * sol[35]; sol[56] -= b0c.x * sol[35]; sol[57] -= b0c.y * sol[35]; sol[58] -= b0c.z * sol[35]; sol[59] -= b0c.w * sol[35]; sol[60] -= b0d.x * sol[35]; sol[61] -= b0d.y * sol[35]; sol[62] -= b0d.z * sol[35]; sol[63] -= b0d.w * sol[35];
  __builtin_amdgcn_sched_barrier(0);
  b0a = *(const float4*)(Lr + 2400); b0b = *(const float4*)(Lr + 2404); b0c = *(const float4*)(Lr + 2408); b0d = *(const float4*)(Lr + 2412);
  __builtin_amdgcn_sched_barrier(0);
  sol[37] -= b1b.y * sol[36]; sol[38] -= b1b.z * sol[36]; sol[39] -= b1b.w * sol[36]; sol[40] -= b1c.x * sol[36]; sol[41] -= b1c.y * sol[36]; sol[42] -= b1c.z * sol[36]; sol[43] -= b1c.w * sol[36]; sol[44] -= b1d.x * sol[36]; sol[45] -= b1d.y * sol[36]; sol[46] -= b1d.z * sol[36]; sol[47] -= b1d.w * sol[36];
  __builtin_amdgcn_sched_barrier(0);
  b1a = *(const float4*)(Lr + 2416); b1b = *(const float4*)(Lr + 2420); b1c = *(const float4*)(Lr + 2424); b1d = *(const float4*)(Lr + 2428);
  __builtin_amdgcn_sched_barrier(0);
  sol[48] -= b2a.x * sol[36]; sol[49] -= b2a.y * sol[36]; sol[50] -= b2a.z * sol[36]; sol[51] -= b2a.w * sol[36]; sol[52] -= b2b.x * sol[36]; sol[53] -= b2b.y * sol[36]; sol[54] -= b2b.z * sol[36]; sol[55] -= b2b.w * sol[36]; sol[56] -= b2c.x * sol[36]; sol[57] -= b2c.y * sol[36]; sol[58] -= b2c.z * sol[36]; sol[59] -= b2c.w * sol[36]; sol[60] -= b2d.x * sol[36]; sol[61] -= b2d.y * sol[36]; sol[62] -= b2d.z * sol[36]; sol[63] -= b2d.w * sol[36];
  __builtin_amdgcn_sched_barrier(0);
  b2a = *(const float4*)(Lr + 2464); b2b = *(const float4*)(Lr + 2468); b2c = *(const float4*)(Lr + 2472); b2d = *(const float4*)(Lr + 2476);
  __builtin_amdgcn_sched_barrier(0);
  sol[38] -= b0b.z * sol[37]; sol[39] -= b0b.w * sol[37]; sol[40] -= b0c.x * sol[37]; sol[41] -= b0c.y * sol[37]; sol[42] -= b0c.z * sol[37]; sol[43] -= b0c.w * sol[37]; sol[44] -= b0d.x * sol[37]; sol[45] -= b0d.y * sol[37]; sol[46] -= b0d.z * sol[37]; sol[47] -= b0d.w * sol[37];
  __builtin_amdgcn_sched_barrier(0);
  b0a = *(const float4*)(Lr + 2480); b0b = *(const float4*)(Lr + 2484); b0c = *(const float4*)(Lr + 2488); b0d = *(const float4*)(Lr + 2492);
  __builtin_amdgcn_sched_barrier(0);
  sol[48] -= b1a.x * sol[37]; sol[49] -= b1a.y * sol[37]; sol[50] -= b1a.z * sol[37]; sol[51] -= b1a.w * sol[37]; sol[52] -= b1b.x * sol[37]; sol[53] -= b1b.y * sol[37]; sol[54] -= b1b.z * sol[37]; sol[55] -= b1b.w * sol[37]; sol[56] -= b1c.x * sol[37]; sol[57] -= b1c.y * sol[37]; sol[58] -= b1c.z * sol[37]; sol[59] -= b1c.w * sol[37]; sol[60] -= b1d.x * sol[37]; sol[61] -= b1d.y * sol[37]; sol[62] -= b1d.z * sol[37]; sol[63] -= b1d.w * sol[37];
  __builtin_amdgcn_sched_barrier(0);
  b1a = *(const float4*)(Lr + 2528); b1b = *(const float4*)(Lr + 2532); b1c = *(const float4*)(Lr + 2536); b1d = *(const float4*)(Lr + 2540);
  __builtin_amdgcn_sched_barrier(0);
  sol[39] -= b2b.w * sol[38]; sol[40] -= b2c.x * sol[38]; sol[41] -= b2c.y * sol[38]; sol[42] -= b2c.z * sol[38]; sol[43] -= b2c.w * sol[38]; sol[44] -= b2d.x * sol[38]; sol[45] -= b2d.y * sol[38]; sol[46] -= b2d.z * sol[38]; sol[47] -= b2d.w * sol[38];
  __builtin_amdgcn_sched_barrier(0);
  b2a = *(const float4*)(Lr + 2544); b2b = *(const float4*)(Lr + 2548); b2c = *(const float4*)(Lr + 2552); b2d = *(const float4*)(Lr + 2556);
  __builtin_amdgcn_sched_barrier(0);
  sol[48] -= b0a.x * sol[38]; sol[49] -= b0a.y * sol[38]; sol[50] -= b0a.z * sol[38]; sol[51] -= b0a.w * sol[38]; sol[52] -= b0b.x * sol[38]; sol[53] -= b0b.y * sol[38]; sol[54] -= b0b.z * sol[38]; sol[55] -= b0b.w * sol[38]; sol[56] -= b0c.x * sol[38]; sol[57] -= b0c.y * sol[38]; sol[58] -= b0c.z * sol[38]; sol[59] -= b0c.w * sol[38]; sol[60] -= b0d.x * sol[38]; sol[61] -= b0d.y * sol[38]; sol[62] -= b0d.z * sol[38]; sol[63] -= b0d.w * sol[38];
  __builtin_amdgcn_sched_barrier(0);
  b0a = *(const float4*)(Lr + 2592); b0b = *(const float4*)(Lr + 2596); b0c = *(const float4*)(Lr + 2600); b0d = *(const float4*)(Lr + 2604);
  __builtin_amdgcn_sched_barrier(0);
  sol[40] -= b1c.x * sol[39]; sol[41] -= b1c.y * sol[39]; sol[42] -= b1c.z * sol[39]; sol[43] -= b1c.w * sol[39]; sol[44] -= b1d.x * sol[39]; sol[45] -= b1d.y * sol[39]; sol[46] -= b1d.z * sol[39]; sol[47] -= b1d.w * sol[39];
  __builtin_amdgcn_sched_barrier(0);
  b1a = *(const float4*)(Lr + 2608); b1b = *(const float4*)(Lr + 2612); b1c = *(const float4*)(Lr + 2616); b1d = *(const float4*)(Lr + 2620);
  __builtin_amdgcn_sched_barrier(0);
  sol[48] -= b2a.x * sol[39]; sol[49] -= b2a.y * sol[39]; sol[50] -= b2a.z * sol[39]; sol[51] -= b2a.w * sol[39]; sol[52] -= b2b.x * sol[39]; sol[53] -= b2b.y * sol[39]; sol[54] -= b2b.z * sol[39]; sol[55] -= b2b.w * sol[39]; sol[56] -= b2c.x * sol[39]; sol[57] -= b2c.y * sol[39]; sol[58] -= b2c.z * sol[39]; sol[59] -= b2c.w * sol[39]; sol[60] -= b2d.x * sol[39]; sol[61] -= b2d.y * sol[39]; sol[62] -= b2d.z * sol[39]; sol[63] -= b2d.w * sol[39];
  __builtin_amdgcn_sched_barrier(0);
  b2a = *(const float4*)(Lr + 2656); b2b = *(const float4*)(Lr + 2660); b2c = *(const float4*)(Lr + 2664); b2d = *(const float4*)(Lr + 2668);
  __builtin_amdgcn_sched_barrier(0);
  sol[41] -= b0c.y * sol[40]; sol[42] -= b0c.z * sol[40]; sol[43] -= b0c.w * sol[40]; sol[44] -= b0d.x * sol[40]; sol[45] -= b0d.y * sol[40]; sol[46] -= b0d.z * sol[40]; sol[47] -= b0d.w * sol[40];
  __builtin_amdgcn_sched_barrier(0);
  b0a = *(const float4*)(Lr + 2672); b0b = *(const float4*)(Lr + 2676); b0c = *(const float4*)(Lr + 2680); b0d = *(const float4*)(Lr + 2684);
  __builtin_amdgcn_sched_barrier(0);
  sol[48] -= b1a.x * sol[40]; sol[49] -= b1a.y * sol[40]; sol[50] -= b1a.z * sol[40]; sol[51] -= b1a.w * sol[40]; sol[52] -= b1b.x * sol[40]; sol[53] -= b1b.y * sol[40]; sol[54] -= b1b.z * sol[40]; sol[55] -= b1b.w * sol[40]; sol[56] -= b1c.x * sol[40]; sol[57] -= b1c.y * sol[40]; sol[58] -= b1c.z * sol[40]; sol[59] -= b1c.w * sol[40]; sol[60] -= b1d.x * sol[40]; sol[61] -= b1d.y * sol[40]; sol[62] -= b1d.z * sol[40]; sol[63] -= b1d.w * sol[40];
  __builtin_amdgcn_sched_barrier(0);
  b1a = *(const float4*)(Lr + 2720); b1b = *(const float4*)(Lr + 2724); b1c = *(const float4*)(Lr + 2728); b1d = *(const float4*)(Lr + 2732);
  __builtin_amdgcn_sched_barrier(0);
  sol[42] -= b2c.z * sol[41]; sol[43] -= b2c.w * sol[41]; sol[44] -= b2d.x * sol[41]; sol[45] -= b2d.y * sol[41]; sol[46] -= b2d.z * sol[41]; sol[47] -= b2d.w * sol[41];
  __builtin_amdgcn_sched_barrier(0);
  b2a = *(const float4*)(Lr + 2736); b2b = *(const float4*)(Lr + 2740); b2c = *(const float4*)(Lr + 2744); b2d = *(const float4*)(Lr + 2748);
  __builtin_amdgcn_sched_barrier(0);
  sol[48] -= b0a.x * sol[41]; sol[49] -= b0a.y * sol[41]; sol[50] -= b0a.z * sol[41]; sol[51] -= b0a.w * sol[41]; sol[52] -= b0b.x * sol[41]; sol[53] -= b0b.y * sol[41]; sol[54] -= b0b.z * sol[41]; sol[55] -= b0b.w * sol[41]; sol[56] -= b0c.x * sol[41]; sol[57] -= b0c.y * sol[41]; sol[58] -= b0c.z * sol[41]; sol[59] -= b0c.w * sol[41]; sol[60] -= b0d.x * sol[41]; sol[61] -= b0d.y * sol[41]; sol[62] -= b0d.z * sol[41]; sol[63] -= b0d.w * sol[41];
  __builtin_amdgcn_sched_barrier(0);
  b0a = *(const float4*)(Lr + 2784); b0b = *(const float4*)(Lr + 2788); b0c = *(const float4*)(Lr + 2792); b0d = *(const float4*)(Lr + 2796);
  __builtin_amdgcn_sched_barrier(0);
  sol[43] -= b1c.w * sol[42]; sol[44] -= b1d.x * sol[42]; sol[45] -= b1d.y * sol[42]; sol[46] -= b1d.z * sol[42]; sol[47] -= b1d.w * sol[42];
  __builtin_amdgcn_sched_barrier(0);
  b1a = *(const float4*)(Lr + 2800); b1b = *(const float4*)(Lr + 2804); b1c = *(const float4*)(Lr + 2808); b1d = *(const float4*)(Lr + 2812);
  __builtin_amdgcn_sched_barrier(0);
  sol[48] -= b2a.x * sol[42]; sol[49] -= b2a.y * sol[42]; sol[50] -= b2a.z * sol[42]; sol[51] -= b2a.w * sol[42]; sol[52] -= b2b.x * sol[42]; sol[53] -= b2b.y * sol[42]; sol[54] -= b2b.z * sol[42]; sol[55] -= b2b.w * sol[42]; sol[56] -= b2c.x * sol[42]; sol[57] -= b2c.y * sol[42]; sol[58] -= b2c.z * sol[42]; sol[59] -= b2c.w * sol[42]; sol[60] -= b2d.x * sol[42]; sol[61] -= b2d.y * sol[42]; sol[62] -= b2d.z * sol[42]; sol[63] -= b2d.w * sol[42];
  __builtin_amdgcn_sched_barrier(0);
  b2a = *(const float4*)(Lr + 2848); b2b = *(const float4*)(Lr + 2852); b2c = *(const float4*)(Lr + 2856); b2d = *(const float4*)(Lr + 2860);
  __builtin_amdgcn_sched_barrier(0);
  sol[44] -= b0d.x * sol[43]; sol[45] -= b0d.y * sol[43]; sol[46] -= b0d.z * sol[43]; sol[47] -= b0d.w * sol[43];
  __builtin_amdgcn_sched_barrier(0);
  b0a = *(const float4*)(Lr + 2864); b0b = *(const float4*)(Lr + 2868); b0c = *(const float4*)(Lr + 2872); b0d = *(const float4*)(Lr + 2876);
  __builtin_amdgcn_sched_barrier(0);
  sol[48] -= b1a.x * sol[43]; sol[49] -= b1a.y * sol[43]; sol[50] -= b1a.z * sol[43]; sol[51] -= b1a.w * sol[43]; sol[52] -= b1b.x * sol[43]; sol[53] -= b1b.y * sol[43]; sol[54] -= b1b.z * sol[43]; sol[55] -= b1b.w * sol[43]; sol[56] -= b1c.x * sol[43]; sol[57] -= b1c.y * sol[43]; sol[58] -= b1c.z * sol[43]; sol[59] -= b1c.w * sol[43]; sol[60] -= b1d.x * sol[43]; sol[61] -= b1d.y * sol[43]; sol[62] -= b1d.z * sol[43]; sol[63] -= b1d.w * sol[43];
  __builtin_amdgcn_sched_barrier(0);
  b1a = *(const float4*)(Lr + 2912); b1b = *(const float4*)(Lr + 2916); b1c = *(const float4*)(Lr + 2920); b1d = *(const float4*)(Lr + 2924);
  __builtin_amdgcn_sched_barrier(0);
  sol[45] -= b2d.y * sol[44]; sol[46] -= b2d.z * sol[44]; sol[47] -= b2d.w * sol[44];
  __builtin_amdgcn_sched_barrier(0);
  b2a = *(const float4*)(Lr + 2928); b2b = *(const float4*)(Lr + 2932); b2c = *(const float4*)(Lr + 2936); b2d = *(const float4*)(Lr + 2940);
  __builtin_amdgcn_sched_barrier(0);
  sol[48] -= b0a.x * sol[44]; sol[49] -= b0a.y * sol[44]; sol[50] -= b0a.z * sol[44]; sol[51] -= b0a.w * sol[44]; sol[52] -= b0b.x * sol[44]; sol[53] -= b0b.y * sol[44]; sol[54] -= b0b.z * sol[44]; sol[55] -= b0b.w * sol[44]; sol[56] -= b0c.x * sol[44]; sol[57] -= b0c.y * sol[44]; sol[58] -= b0c.z * sol[44]; sol[59] -= b0c.w * sol[44]; sol[60] -= b0d.x * sol[44]; sol[61] -= b0d.y * sol[44]; sol[62] -= b0d.z * sol[44]; sol[63] -= b0d.w * sol[44];
  __builtin_amdgcn_sched_barrier(0);
  b0a = *(const float4*)(Lr + 2976); b0b = *(const float4*)(Lr + 2980); b0c = *(const float4*)(Lr + 2984); b0d = *(const float4*)(Lr + 2988);
  __builtin_amdgcn_sched_barrier(0);
  sol[46] -= b1d.z * sol[45]; sol[47] -= b1d.w * sol[45];
  __builtin_amdgcn_sched_barrier(0);
  b1a = *(const float4*)(Lr + 2992); b1b = *(const float4*)(Lr + 2996); b1c = *(const float4*)(Lr + 3000); b1d = *(const float4*)(Lr + 3004);
  __builtin_amdgcn_sched_barrier(0);
  sol[48] -= b2a.x * sol[45]; sol[49] -= b2a.y * sol[45]; sol[50] -= b2a.z * sol[45]; sol[51] -= b2a.w * sol[45]; sol[52] -= b2b.x * sol[45]; sol[53] -= b2b.y * sol[45]; sol[54] -= b2b.z * sol[45]; sol[55] -= b2b.w * sol[45]; sol[56] -= b2c.x * sol[45]; sol[57] -= b2c.y * sol[45]; sol[58] -= b2c.z * sol[45]; sol[59] -= b2c.w * sol[45]; sol[60] -= b2d.x * sol[45]; sol[61] -= b2d.y * sol[45]; sol[62] -= b2d.z * sol[45]; sol[63] -= b2d.w * sol[45];
  __builtin_amdgcn_sched_barrier(0);
  b2a = *(const float4*)(Lr + 3056); b2b = *(const float4*)(Lr + 3060); b2c = *(const float4*)(Lr + 3064); b2d = *(const float4*)(Lr + 3068);
  __builtin_amdgcn_sched_barrier(0);
  sol[47] -= b0d.w * sol[46];
  __builtin_amdgcn_sched_barrier(0);
  b0a = *(const float4*)(Lr + 3120); b0b = *(const float4*)(Lr + 3124); b0c = *(const float4*)(Lr + 3128); b0d = *(const float4*)(Lr + 3132);
  __builtin_amdgcn_sched_barrier(0);
  sol[48] -= b1a.x * sol[46]; sol[49] -= b1a.y * sol[46]; sol[50] -= b1a.z * sol[46]; sol[51] -= b1a.w * sol[46]; sol[52] -= b1b.x * sol[46]; sol[53] -= b1b.y * sol[46]; sol[54] -= b1b.z * sol[46]; sol[55] -= b1b.w * sol[46]; sol[56] -= b1c.x * sol[46]; sol[57] -= b1c.y * sol[46]; sol[58] -= b1c.z * sol[46]; sol[59] -= b1c.w * sol[46]; sol[60] -= b1d.x * sol[46]; sol[61] -= b1d.y * sol[46]; sol[62] -= b1d.z * sol[46]; sol[63] -= b1d.w * sol[46];
  __builtin_amdgcn_sched_barrier(0);
  b1a = *(const float4*)(Lr + 3184); b1b = *(const float4*)(Lr + 3188); b1c = *(const float4*)(Lr + 3192); b1d = *(const float4*)(Lr + 3196);
  __builtin_amdgcn_sched_barrier(0);
  sol[48] -= b2a.x * sol[47]; sol[49] -= b2a.y * sol[47]; sol[50] -= b2a.z * sol[47]; sol[51] -= b2a.w * sol[47]; sol[52] -= b2b.x * sol[47]; sol[53] -= b2b.y * sol[47]; sol[54] -= b2b.z * sol[47]; sol[55] -= b2b.w * sol[47]; sol[56] -= b2c.x * sol[47]; sol[57] -= b2c.y * sol[47]; sol[58] -= b2c.z * sol[47]; sol[59] -= b2c.w * sol[47]; sol[60] -= b2d.x * sol[47]; sol[61] -= b2d.y * sol[47]; sol[62] -= b2d.z * sol[47]; sol[63] -= b2d.w * sol[47];
  __builtin_amdgcn_sched_barrier(0);
  b2a = *(const float4*)(Lr + 3248); b2b = *(const float4*)(Lr + 3252); b2c = *(const float4*)(Lr + 3256); b2d = *(const float4*)(Lr + 3260);
  __builtin_amdgcn_sched_barrier(0);
  sol[49] -= b0a.y * sol[48]; sol[50] -= b0a.z * sol[48]; sol[51] -= b0a.w * sol[48]; sol[52] -= b0b.x * sol[48]; sol[53] -= b0b.y * sol[48]; sol[54] -= b0b.z * sol[48]; sol[55] -= b0b.w * sol[48]; sol[56] -= b0c.x * sol[48]; sol[57] -= b0c.y * sol[48]; sol[58] -= b0c.z * sol[48]; sol[59] -= b0c.w * sol[48]; sol[60] -= b0d.x * sol[48]; sol[61] -= b0d.y * sol[48]; sol[62] -= b0d.z * sol[48]; sol[63] -= b0d.w * sol[48];
  __builtin_amdgcn_sched_barrier(0);
  b0a = *(const float4*)(Lr + 3312); b0b = *(const float4*)(Lr + 3316); b0c = *(const float4*)(Lr + 3320); b0d = *(const float4*)(Lr + 3324);
  __builtin_amdgcn_sched_barrier(0);
  sol[50] -= b1a.z * sol[49]; sol[51] -= b1a.w * sol[49]; sol[52] -= b1b.x * sol[49]; sol[53] -= b1b.y * sol[49]; sol[54] -= b1b.z * sol[49]; sol[55] -= b1b.w * sol[49]; sol[56] -= b1c.x * sol[49]; sol[57] -= b1c.y * sol[49]; sol[58] -= b1c.z * sol[49]; sol[59] -= b1c.w * sol[49]; sol[60] -= b1d.x * sol[49]; sol[61] -= b1d.y * sol[49]; sol[62] -= b1d.z * sol[49]; sol[63] -= b1d.w * sol[49];
  __builtin_amdgcn_sched_barrier(0);
  b1a = *(const float4*)(Lr + 3376); b1b = *(const float4*)(Lr + 3380); b1c = *(const float4*)(Lr + 3384); b1d = *(const float4*)(Lr + 3388);
  __builtin_amdgcn_sched_barrier(0);
  sol[51] -= b2a.w * sol[50]; sol[52] -= b2b.x * sol[50]; sol[53] -= b2b.y * sol[50]; sol[54] -= b2b.z * sol[50]; sol[55] -= b2b.w * sol[50]; sol[56] -= b2c.x * sol[50]; sol[57] -= b2c.y * sol[50]; sol[58] -= b2c.z * sol[50]; sol[59] -= b2c.w * sol[50]; sol[60] -= b2d.x * sol[50]; sol[61] -= b2d.y * sol[50]; sol[62] -= b2d.z * sol[50]; sol[63] -= b2d.w * sol[50];
  __builtin_amdgcn_sched_barrier(0);
  b2a = *(const float4*)(Lr + 3440); b2b = *(const float4*)(Lr + 3444); b2c = *(const float4*)(Lr + 3448); b2d = *(const float4*)(Lr + 3452);
  __builtin_amdgcn_sched_barrier(0);
  sol[52] -= b0b.x * sol[51]; sol[53] -= b0b.y * sol[51]; sol[54] -= b0b.z * sol[51]; sol[55] -= b0b.w * sol[51]; sol[56] -= b0c.x * sol[51]; sol[57] -= b0c.y * sol[51]; sol[58] -= b0c.z * sol[51]; sol[59] -= b0c.w * sol[51]; sol[60] -= b0d.x * sol[51]; sol[61] -= b0d.y * sol[51]; sol[62] -= b0d.z * sol[51]; sol[63] -= b0d.w * sol[51];
  __builtin_amdgcn_sched_barrier(0);
  b0a = *(const float4*)(Lr + 3504); b0b = *(const float4*)(Lr + 3508); b0c = *(const float4*)(Lr + 3512); b0d = *(const float4*)(Lr + 3516);
  __builtin_amdgcn_sched_barrier(0);
  sol[53] -= b1b.y * sol[52]; sol[54] -= b1b.z * sol[52]; sol[55] -= b1b.w * sol[52]; sol[56] -= b1c.x * sol[52]; sol[57] -= b1c.y * sol[52]; sol[58] -= b1c.z * sol[52]; sol[59] -= b1c.w * sol[52]; sol[60] -= b1d.x * sol[52]; sol[61] -= b1d.y * sol[52]; sol[62] -= b1d.z * sol[52]; sol[63] -= b1d.w * sol[52];
  __builtin_amdgcn_sched_barrier(0);
  b1a = *(const float4*)(Lr + 3568); b1b = *(const float4*)(Lr + 3572); b1c = *(const float4*)(Lr + 3576); b1d = *(const float4*)(Lr + 3580);
  __builtin_amdgcn_sched_barrier(0);
  sol[54] -= b2b.z * sol[53]; sol[55] -= b2b.w * sol[53]; sol[56] -= b2c.x * sol[53]; sol[57] -= b2c.y * sol[53]; sol[58] -= b2c.z * sol[53]; sol[59] -= b2c.w * sol[53]; sol[60] -= b2d.x * sol[53]; sol[61] -= b2d.y * sol[53]; sol[62] -= b2d.z * sol[53]; sol[63] -= b2d.w * sol[53];
  __builtin_amdgcn_sched_barrier(0);
  b2a = *(const float4*)(Lr + 3632); b2b = *(const float4*)(Lr + 3636); b2c = *(const float4*)(Lr + 3640); b2d = *(const float4*)(Lr + 3644);
  __builtin_amdgcn_sched_barrier(0);
  sol[55] -= b0b.w * sol[54]; sol[56] -= b0c.x * sol[54]; sol[57] -= b0c.y * sol[54]; sol[58] -= b0c.z * sol[54]; sol[59] -= b0c.w * sol[54]; sol[60] -= b0d.x * sol[54]; sol[61] -= b0d.y * sol[54]; sol[62] -= b0d.z * sol[54]; sol[63] -= b0d.w * sol[54];
  __builtin_amdgcn_sched_barrier(0);
  b0a = *(const float4*)(Lr + 3696); b0b = *(const float4*)(Lr + 3700); b0c = *(const float4*)(Lr + 3704); b0d = *(const float4*)(Lr + 3708);
  __builtin_amdgcn_sched_barrier(0);
  sol[56] -= b1c.x * sol[55]; sol[57] -= b1c.y * sol[55]; sol[58] -= b1c.z * sol[55]; sol[59] -= b1c.w * sol[55]; sol[60] -= b1d.x * sol[55]; sol[61] -= b1d.y * sol[55]; sol[62] -= b1d.z * sol[55]; sol[63] -= b1d.w * sol[55];
  __builtin_amdgcn_sched_barrier(0);
  b1a = *(const float4*)(Lr + 3760); b1b = *(const float4*)(Lr + 3764); b1c = *(const float4*)(Lr + 3768); b1d = *(const float4*)(Lr + 3772);
  __builtin_amdgcn_sched_barrier(0);
  sol[57] -= b2c.y * sol[56]; sol[58] -= b2c.z * sol[56]; sol[59] -= b2c.w * sol[56]; sol[60] -= b2d.x * sol[56]; sol[61] -= b2d.y * sol[56]; sol[62] -= b2d.z * sol[56]; sol[63] -= b2d.w * sol[56];
  __builtin_amdgcn_sched_barrier(0);
  b2a = *(const float4*)(Lr + 3824); b2b = *(const float4*)(Lr + 3828); b2c = *(const float4*)(Lr + 3832); b2d = *(const float4*)(Lr + 3836);
  __builtin_amdgcn_sched_barrier(0);
  sol[58] -= b0c.z * sol[57]; sol[59] -= b0c.w * sol[57]; sol[60] -= b0d.x * sol[57]; sol[61] -= b0d.y * sol[57]; sol[62] -= b0d.z * sol[57]; sol[63] -= b0d.w * sol[57];
  __builtin_amdgcn_sched_barrier(0);
  b0a = *(const float4*)(Lr + 3888); b0b = *(const float4*)(Lr + 3892); b0c = *(const float4*)(Lr + 3896); b0d = *(const float4*)(Lr + 3900);
  __builtin_amdgcn_sched_barrier(0);
  sol[59] -= b1c.w * sol[58]; sol[60] -= b1d.x * sol[58]; sol[61] -= b1d.y * sol[58]; sol[62] -= b1d.z * sol[58]; sol[63] -= b1d.w * sol[58];
  __builtin_amdgcn_sched_barrier(0);
  b1a = *(const float4*)(Lr + 3952); b1b = *(const float4*)(Lr + 3956); b1c = *(const float4*)(Lr + 3960); b1d = *(const float4*)(Lr + 3964);
  __builtin_amdgcn_sched_barrier(0);
  sol[60] -= b2d.x * sol[59]; sol[61] -= b2d.y * sol[59]; sol[62] -= b2d.z * sol[59]; sol[63] -= b2d.w * sol[59];
  __builtin_amdgcn_sched_barrier(0);
  b2a = *(const float4*)(Lr + 4016); b2b = *(const float4*)(Lr + 4020); b2c = *(const float4*)(Lr + 4024); b2d = *(const float4*)(Lr + 4028);
  __builtin_amdgcn_sched_barrier(0);
  sol[61] -= b0d.y * sol[60]; sol[62] -= b0d.z * sol[60]; sol[63] -= b0d.w * sol[60];
  __builtin_amdgcn_sched_barrier(0);
  __builtin_amdgcn_sched_barrier(0);
  sol[62] -= b1d.z * sol[61]; sol[63] -= b1d.w * sol[61];
  __builtin_amdgcn_sched_barrier(0);
  __builtin_amdgcn_sched_barrier(0);
  sol[63] -= b2d.w * sol[62];
  __builtin_amdgcn_sched_barrier(0);
}

template <int DIR>
__device__ __forceinline__ void solve_cols(const Params& P, int itb, int c, const float* Lt, const float* bpp, const float* gcp,
                                           const u16* Vs, const u16* Ks) {
  float sol[64];
  const float* bp_ = bpp + DIR * 64;
  const float* gc_ = gcp + DIR * 64;
  if (c < 128) {
    const u16* vp = Vs + c;
#pragma unroll
    for (int p = 0; p < 64; ++p) sol[p] = bp_[p] * bf2f(vp[(DIR ? (63 - p) : p) * 136]);
  } else {
    const u16* kp = Ks + (c - 128);
#pragma unroll
    for (int p = 0; p < 64; ++p) sol[p] = bp_[p] * __expf(gc_[p]) * bf2f(kp[(DIR ? (63 - p) : p) * 136]);
  }
  const float* Lr = Lt + opq(DIR * 4096);
  solve_elim(sol, Lr);
  const size_t it2 = (size_t)(itb + DIR);
  if (c < 128) {
    u16* UF = (u16*)(P.ws + OFF_UF) + (it2 * 128 + c) * 64;
#pragma unroll
    for (int q = 0; q < 8; ++q) *(uint4*)(UF + q * 8) = pack8(sol + q * 8);
  } else {
    u16* Wg = (u16*)(P.ws + OFF_R2) + it2 * 8192 + (c - 128);
#pragma unroll
    for (int p = 0; p < 64; ++p) Wg[p * 128] = f2bf(-sol[p]);
  }
}

__device__ __forceinline__ void delta_prep_item(const Params& P, int item, char* lds) {
  const int tid = opq(threadIdx.x), lane = tid & 63, wv = tid >> 6, fr = lane & 15, fq = lane >> 4;
  const int cid = item >> 2, h = item & 3;
  const int row0 = cid * 64;
  int seq_lo, seq_hi;
  if (cid < 256) { seq_lo = (cid >> 6) * 4096; seq_hi = seq_lo + 4096; }
  else { seq_lo = 16384 + ((cid - 256) >> 2) * 256; seq_hi = seq_lo + 256; }
  u16* Qs = (u16*)(lds + opq(0));
  u16* Ks = (u16*)(lds + opq(17408));
  u16* Vs = (u16*)(lds + opq(34816));
  float* KKs = (float*)(lds + opq(52224));
  float* QKs = (float*)(lds + opq(69632));
  float* Lt = (float*)(lds + opq(87040));
  float* gtok = (float*)(lds + opq(119808));
  float* btok = gtok + 128;
  float* gcp = btok + 128;
  float* bpp = gcp + 128;
  u16* QKN = (u16*)((char*)P.out + OFF_QKN);
  lds_barrier();
  {
    const int j = tid >> 3, sg = tid & 7;
    const int row = row0 + j;
    const bool hm = (row - 1 >= seq_lo), hp = (row + 1 < seq_hi);
    const u16* qkv = (const u16*)(P.ws + OFF_R3);
#pragma unroll
    for (int s = 0; s < 3; ++s) {
      const int col = s * 512 + h * 128 + sg * 16;
      const u16* p0 = qkv + (size_t)row * 1536 + col;
      float y[16];
      float ssq = 0.f;
#pragma unroll
      for (int hh = 0; hh < 2; ++hh) {
        const uint4 c0 = *(const uint4*)(p0 + hh * 8);
        uint4 m0 = *(const uint4*)(p0 - (hm ? 1536 : 0) + hh * 8);
        uint4 n0 = *(const uint4*)(p0 + (hp ? 1536 : 0) + hh * 8);
        m0.x = hm ? m0.x : 0u; m0.y = hm ? m0.y : 0u; m0.z = hm ? m0.z : 0u; m0.w = hm ? m0.w : 0u;
        n0.x = hp ? n0.x : 0u; n0.y = hp ? n0.y : 0u; n0.z = hp ? n0.z : 0u; n0.w = hp ? n0.w : 0u;
        float fc[8], fm[8], fn[8];
        unpack8(c0, fc); unpack8(m0, fm); unpack8(n0, fn);
        const float* cwp = P.dn_conv_w + col + hh * 8;
        float cw0[8], cw1[8], cw2[8];
        {
          const float4 t0 = *(const float4*)(cwp), t1 = *(const float4*)(cwp + 4);
          const float4 t2 = *(const float4*)(cwp + 1536), t3 = *(const float4*)(cwp + 1540);
          const float4 t4 = *(const float4*)(cwp + 3072), t5 = *(const float4*)(cwp + 3076);
          cw0[0] = t0.x; cw0[1] = t0.y; cw0[2] = t0.z; cw0[3] = t0.w; cw0[4] = t1.x; cw0[5] = t1.y; cw0[6] = t1.z; cw0[7] = t1.w;
          cw1[0] = t2.x; cw1[1] = t2.y; cw1[2] = t2.z; cw1[3] = t2.w; cw1[4] = t3.x; cw1[5] = t3.y; cw1[6] = t3.z; cw1[7] = t3.w;
          cw2[0] = t4.x; cw2[1] = t4.y; cw2[2] = t4.z; cw2[3] = t4.w; cw2[4] = t5.x; cw2[5] = t5.y; cw2[6] = t5.z; cw2[7] = t5.w;
        }
#pragma unroll
        for (int e = 0; e < 8; ++e) {
          const float v = cw0[e] * fm[e] + cw1[e] * fc[e] + cw2[e] * fn[e];
          const float yy = v * sigm(v);
          y[hh * 8 + e] = yy;
          ssq += yy * yy;
        }
      }
      if (s < 2) {
        ssq += __shfl_xor(ssq, 1, 64); ssq += __shfl_xor(ssq, 2, 64); ssq += __shfl_xor(ssq, 4, 64);
        const float sc = rsqrtf(ssq + 1e-6f) * ((s == 0) ? 0.08838834764831845f : 1.f);
#pragma unroll
        for (int e = 0; e < 16; ++e) y[e] *= sc;
      }
      u16* dl = ((s == 0) ? Qs : ((s == 1) ? Ks : Vs)) + j * 136 + sg * 16;
      const uint4 o0 = pack8(y), o1 = pack8(y + 8);
      *(uint4*)dl = o0; *(uint4*)(dl + 8) = o1;
      if (s < 2) {
        u16* dg = QKN + (size_t)row * 1024 + s * 512 + h * 128 + sg * 16;
        *(uint4*)dg = o0; *(uint4*)(dg + 8) = o1;
      }
    }
  }
  if (tid < 128) {
    const int j = tid & 63, dir = tid >> 6;
    const float* BA = (const float*)(P.ws + OFF_BA) + (size_t)(row0 + j) * 16;
    const float bl = BA[dir * 4 + h], al = BA[8 + dir * 4 + h];
    const float xx = al + P.dn_dt_bias[dir * 4 + h];
    const float sp = (xx > 20.f) ? xx : log1pf(expf(xx));
    gtok[dir * 64 + j] = -expf(P.dn_a_log[dir * 4 + h]) * sp;
    btok[dir * 64 + j] = 1.f / (1.f + expf(-bl));
  }
  lds_barrier();
  if (tid < 128) {
    const int dir = tid >> 6, p = tid & 63;
    const int tk = dir ? (63 - p) : p;
    float a = gtok[dir * 64 + tk];
    const float bv = btok[dir * 64 + tk];
#pragma unroll
    for (int o = 1; o < 64; o <<= 1) {
      const float t = __shfl_up(a, o, 64);
      if (p >= o) a += t;
    }
    gcp[dir * 64 + p] = a;
    bpp[dir * 64 + p] = bv;
  }
  {
#pragma unroll
    for (int q = 0; q < 4; ++q) {
      const int t = wv * 4 + q;
      const int which = t >> 4, mi = (t >> 2) & 3, ni = t & 3;
      const u16* Am = (which ? Qs : Ks) + (mi * 16 + fr) * 136 + fq * 8;
      const u16* Bm = Ks + (ni * 16 + fr) * 136 + fq * 8;
      f32x4 a4 = {0.f, 0.f, 0.f, 0.f};
#pragma unroll
      for (int kk = 0; kk < 4; ++kk)
        a4 = __builtin_amdgcn_mfma_f32_16x16x32_bf16(*(const bf16x8*)(Am + kk * 32), *(const bf16x8*)(Bm + kk * 32), a4, 0, 0, 0);
      float* dst = which ? QKs : KKs;
#pragma unroll
      for (int e = 0; e < 4; ++e) dst[(mi * 16 + fq * 4 + e) * 68 + ni * 16 + fr] = a4[e];
    }
  }
  lds_barrier();
  const int itb = item * 2;
  {
    u16* AQ = (u16*)((char*)P.out + OFF_AQ);
#pragma unroll 8
    for (int idx = tid; idx < 8192; idx += NT) {
      const int dir = idx >> 12, p = (idx >> 6) & 63, s = idx & 63;
      const int tp = dir ? (63 - p) : p, ts = dir ? (63 - s) : s;
      const float dg = gcp[dir * 64 + p] - gcp[dir * 64 + s];
      const float dec = (p >= s) ? __expf(dg) : 0.f;
      AQ[((size_t)(itb + dir) * 64 + p) * 64 + s] = f2bf(QKs[tp * 68 + ts] * dec);
    }
#pragma unroll 8
    for (int idx = tid; idx < 8192; idx += NT) {
      const int dir = idx >> 12, s = (idx >> 6) & 63, p = idx & 63;
      const int tp = dir ? (63 - p) : p, ts = dir ? (63 - s) : s;
      const float dg = gcp[dir * 64 + p] - gcp[dir * 64 + s];
      const float lv = (p > s) ? bpp[dir * 64 + p] * KKs[ts * 68 + tp] * __expf(dg) : 0.f;
      Lt[dir * 4096 + s * 64 + p] = lv;
    }
    if (tid < 128) {
      float* GC = (float*)(P.ws + OFF_GC);
      GC[(size_t)(itb + (tid >> 6)) * 64 + (tid & 63)] = gcp[tid];
    }
  }
  lds_barrier();
  if (tid < 256) solve_cols<0>(P, itb, tid, Lt, bpp, gcp, Vs, Ks);
  else solve_cols<1>(P, itb, tid - 256, Lt, bpp, gcp, Vs, Ks);
}

__device__ __forceinline__ void s5end_tile(const Params& P, int t, char* lds) {
  const int g = t / 6, mt = (t % 6) >> 1, nt = t & 1;
  const int m0 = mt * 256, n0 = nt * 128;
  f32x16 acc[2][2];
  acc_zero(acc);
  gemm_main((const u16*)(P.ws + OFF_U5) + ((size_t)g * 544 + m0) * 512, 512,
            (const u16*)(P.ws + OFF_MEND) + ((size_t)g * 256 + n0) * 512, 512, 512, acc, (u16*)lds);
  TILE_COORDS
  float* E = (float*)(P.ws + OFF_E);
#pragma unroll
  for (int i = 0; i < 2; ++i)
#pragma unroll
    for (int j = 0; j < 2; ++j)
#pragma unroll
      for (int e = 0; e < 16; ++e) {
        const int row = TROW(m0, i, e);
        if (row < 544) E[((size_t)g * 544 + row) * 256 + TCOL(n0, j)] = acc[i][j][e];
      }
}

__device__ __forceinline__ void scan_chunk(const u16* Wl, const u16* QTl, const u16* KTl, const u16* AQl, u16* ST, u16* VT,
                                           int wd, int wq, int fr, int fq, float gl, f32x4& av, f32x4& ao, f32x4& accS0, f32x4& accS1) {
  {
    bf16x8 bS[4], a1[4], a2[4];
#pragma unroll
    for (int kk = 0; kk < 4; ++kk) {
      bS[kk] = *(const bf16x8*)(ST + (wd * 16 + fr) * 136 + kk * 32 + fq * 8);
      a1[kk] = *(const bf16x8*)(Wl + (wq * 16 + fr) * 136 + kk * 32 + fq * 8);
      a2[kk] = *(const bf16x8*)(QTl + (wq * 16 + fr) * 136 + kk * 32 + fq * 8);
    }
    __builtin_amdgcn_sched_barrier(0);
#pragma unroll
    for (int kk = 0; kk < 4; ++kk) {
      av = __builtin_amdgcn_mfma_f32_16x16x32_bf16(a1[kk], bS[kk], av, 0, 0, 0);
      ao = __builtin_amdgcn_mfma_f32_16x16x32_bf16(a2[kk], bS[kk], ao, 0, 0, 0);
    }
  }
  {
    uint2 v; v.x = pack2(av[0], av[1]); v.y = pack2(av[2], av[3]);
    *(uint2*)(VT + (wd * 16 + fr) * 72 + wq * 16 + fq * 4) = v;
  }
  bf16x8 qa[2], k0[2], k1[2];
#pragma unroll
  for (int ks = 0; ks < 2; ++ks) {
    qa[ks] = *(const bf16x8*)(AQl + (wq * 16 + fr) * 72 + ks * 32 + fq * 8);
    const int r0_ = (2 * wq) * 16 + fr, r1_ = (2 * wq + 1) * 16 + fr;
    k0[ks] = *(const bf16x8*)(KTl + r0_ * 72 + ((ks * 32 + fq * 8) ^ (((r0_ >> 3) & 7) << 3)));
    k1[ks] = *(const bf16x8*)(KTl + r1_ * 72 + ((ks * 32 + fq * 8) ^ (((r1_ >> 3) & 7) << 3)));
  }
  accS0[0] *= gl; accS0[1] *= gl; accS0[2] *= gl; accS0[3] *= gl;
  accS1[0] *= gl; accS1[1] *= gl; accS1[2] *= gl; accS1[3] *= gl;
  lds_barrier();
  {
    bf16x8 bV[2];
#pragma unroll
    for (int ks = 0; ks < 2; ++ks) bV[ks] = *(const bf16x8*)(VT + (wd * 16 + fr) * 72 + ks * 32 + fq * 8);
#pragma unroll
    for (int ks = 0; ks < 2; ++ks) {
      ao = __builtin_amdgcn_mfma_f32_16x16x32_bf16(qa[ks], bV[ks], ao, 0, 0, 0);
      accS0 = __builtin_amdgcn_mfma_f32_16x16x32_bf16(k0[ks], bV[ks], accS0, 0, 0, 0);
      accS1 = __builtin_amdgcn_mfma_f32_16x16x32_bf16(k1[ks], bV[ks], accS1, 0, 0, 0);
    }
  }
  {
    uint2 v; v.x = pack2(accS0[0], accS0[1]); v.y = pack2(accS0[2], accS0[3]);
    *(uint2*)(ST + (wd * 16 + fr) * 136 + (2 * wq) * 16 + fq * 4) = v;
    v.x = pack2(accS1[0], accS1[1]); v.y = pack2(accS1[2], accS1[3]);
    *(uint2*)(ST + (wd * 16 + fr) * 136 + (2 * wq + 1) * 16 + fq * 4) = v;
  }
}

__device__ __forceinline__ void delta_scan_block(const Params& P, int sb, char* lds) {
  const int tid = opq(threadIdx.x), lane = tid & 63, w = tid >> 6, fr = lane & 15, fq = lane >> 4;
  const int bhd = sb & 31, dvq = sb >> 5;
  const int b = bhd >> 3, h = (bhd >> 1) & 3, dir = bhd & 1;
  const int wd = w & 1, wq = w >> 1;
  const int dv0 = dvq * 32 + wd * 16;
  u16* Wl = (u16*)(lds + opq(0));
  u16* QTl = (u16*)(lds + opq(17408));
  u16* KTl = (u16*)(lds + opq(34816));
  u16* AQl = (u16*)(lds + opq(53248));
  u16* ST = (u16*)(lds + opq(62464));
  u16* VT = (u16*)(lds + opq(71168));
  lds_barrier();
  for (int i = tid; i < 32 * 136 / 2; i += NT) ((uint32_t*)ST)[i] = 0u;
  f32x4 accS0 = {0.f, 0.f, 0.f, 0.f}, accS1 = {0.f, 0.f, 0.f, 0.f};
  const u16* QKN = (const u16*)((const char*)P.out + OFF_QKN);
  const u16* AQg = (const u16*)((const char*)P.out + OFF_AQ);
  const u16* Wg = (const u16*)(P.ws + OFF_R2);
  const u16* UFg = (const u16*)(P.ws + OFF_UF);
  const float* GC = (const float*)(P.ws + OFF_GC);
  u16* Og = (u16*)(P.ws + OFF_O);

#define GLD16(dst, ptr) asm volatile("global_load_dwordx4 %0, %1, off" : "=v"(dst) : "v"(ptr) : "memory")
#define GLD8(dst, ptr) asm volatile("global_load_dwordx2 %0, %1, off" : "=v"(dst) : "v"(ptr) : "memory")
#define GLD4(dst, ptr) asm volatile("global_load_dword %0, %1, off" : "=v"(dst) : "v"(ptr) : "memory")
#define SC_DECL(S)                                                   \
  u32x4 S##w0, S##w1, S##q0, S##q1, S##k0, S##k1, S##a;              \
  float S##gq0, S##gq1, S##g63;                                      \
  u32x2 S##u;                                                        \
  int S##row0 = 0, S##lat = 0;
#define SC_PF_ONE(S, i)                                                                            \
    {                                                                                              \
      const int id = tid + (i) * 512;                                                              \
      const int p = id >> 4, seg = id & 15;                                                        \
      const int tk = dir ? (63 - p) : p;                                                           \
      GLD16(S##w##i, Wg + it2__ * 8192 + p * 128 + seg * 8);                                       \
      GLD16(S##q##i, QKN + (size_t)(S##row0 + tk) * 1024 + h * 128 + seg * 8);                     \
      GLD4(S##gq##i, GC + it2__ * 64 + p);                                                         \
      GLD16(S##k##i, QKN + (size_t)(S##row0 + tk) * 1024 + 512 + h * 128 + seg * 8);               \
    }
#define SC_PREFETCH(S, n_)                                                                         \
  {                                                                                                \
    const int n__ = (n_);                                                                          \
    int cid__;                                                                                     \
    if (n__ < 4) { cid__ = 256 + b * 4 + (dir ? (3 - n__) : n__); S##lat = 0; }                    \
    else { const int m__ = n__ - 4; cid__ = b * 64 + (dir ? (63 - m__) : m__); S##lat = 1; }       \
    S##row0 = cid__ * 64;                                                                          \
    const size_t it2__ = (size_t)((cid__ * 4 + h) * 2 + dir);                                      \
    SC_PF_ONE(S, 0)                                                                                \
    SC_PF_ONE(S, 1)                                                                                \
    GLD4(S##g63, GC + it2__ * 64 + 63);                                                            \
    GLD16(S##a, AQg + it2__ * 4096 + (tid >> 3) * 64 + (tid & 7) * 8);                             \
    GLD8(S##u, UFg + (it2__ * 128 + dv0 + fr) * 64 + wq * 16 + fq * 4);                            \
  }
#define SC_WAIT(S, CNT)                                                                            \
  asm volatile("s_waitcnt vmcnt(" #CNT ")"                                                         \
               : "+v"(S##w0), "+v"(S##w1), "+v"(S##q0), "+v"(S##q1), "+v"(S##k0), "+v"(S##k1), "+v"(S##a), \
                 "+v"(S##gq0), "+v"(S##gq1), "+v"(S##g63), "+v"(S##u)                              \
               :: "memory");
#define SC_STAGE_ONE(S, i)                                                    \
    {                                                                         \
      const int id = tid + (i) * 512;                                         \
      const int p = id >> 4, seg = id & 15;                                   \
      *(u32x4*)(Wl + p * 136 + seg * 8) = S##w##i;                            \
      float f[8];                                                             \
      unpack8(make_uint4(S##q##i.x, S##q##i.y, S##q##i.z, S##q##i.w), f);     \
      const float sq = __expf(S##gq##i);                                      \
      f[0] *= sq; f[1] *= sq; f[2] *= sq; f[3] *= sq; f[4] *= sq; f[5] *= sq; f[6] *= sq; f[7] *= sq; \
      *(uint4*)(QTl + p * 136 + seg * 8) = pack8(f);                          \
      unpack8(make_uint4(S##k##i.x, S##k##i.y, S##k##i.z, S##k##i.w), f);     \
      const float sk = __expf(S##g63 - S##gq##i);                             \
      u16* kd = KTl + (seg * 8) * 72 + (p ^ ((seg & 7) << 3));                \
      kd[0 * 72] = f2bf(f[0] * sk); kd[1 * 72] = f2bf(f[1] * sk); kd[2 * 72] = f2bf(f[2] * sk); kd[3 * 72] = f2bf(f[3] * sk); \
      kd[4 * 72] = f2bf(f[4] * sk); kd[5 * 72] = f2bf(f[5] * sk); kd[6 * 72] = f2bf(f[6] * sk); kd[7 * 72] = f2bf(f[7] * sk); \
    }
#define SC_STEP(S, n_, WCNT, DO_PF)                                                                   \
  {                                                                                                   \
    SC_WAIT(S, WCNT)                                                                                  \
    const int cur_row0 = S##row0, cur_lat = S##lat;                                                   \
    const float gl = __expf(S##g63);                                                                  \
    SC_STAGE_ONE(S, 0)                                                                                \
    SC_STAGE_ONE(S, 1)                                                                                \
    *(u32x4*)(AQl + (tid >> 3) * 72 + (tid & 7) * 8) = S##a;                                          \
    f32x4 av = f32x4{lo16(S##u.x), hi16(S##u.x), lo16(S##u.y), hi16(S##u.y)};                         \
    f32x4 ao = f32x4{0.f, 0.f, 0.f, 0.f};                                                             \
    lds_barrier();                                                                                    \
    if (DO_PF) SC_PREFETCH(S, (n_) + 2)                                                               \
    scan_chunk(Wl, QTl, KTl, AQl, ST, VT, wd, wq, fr, fq, gl, av, ao, accS0, accS1);                  \
    if (cur_lat) {                                                                                    \
      const int p0 = wq * 16 + fq * 4;                                                                \
      u16* og = Og + ((size_t)dir * 16384 + cur_row0) * 512 + h * 128 + dv0 + fr;                     \
      og[(size_t)(dir ? (63 - (p0 + 0)) : (p0 + 0)) * 512] = f2bf(ao[0]);                             \
      og[(size_t)(dir ? (63 - (p0 + 1)) : (p0 + 1)) * 512] = f2bf(ao[1]);                             \
      og[(size_t)(dir ? (63 - (p0 + 2)) : (p0 + 2)) * 512] = f2bf(ao[2]);                             \
      og[(size_t)(dir ? (63 - (p0 + 3)) : (p0 + 3)) * 512] = f2bf(ao[3]);                             \
    }                                                                                                 \
    lds_barrier();                                                                                    \
  }
  SC_DECL(A)
  SC_DECL(B)
  SC_PREFETCH(A, 0)
  SC_PREFETCH(B, 1)
  for (int n = 0; n < 66; n += 2) {
    SC_STEP(A, n, 11, true)
    SC_STEP(B, n + 1, 11, true)
  }
  SC_STEP(A, 66, 0, false)
  SC_STEP(B, 67, 0, false)
#undef SC_DECL
#undef SC_PF_ONE
#undef SC_PREFETCH
#undef SC_WAIT
#undef SC_STAGE_ONE
#undef SC_STEP
#undef GLD16
#undef GLD8
#undef GLD4
}

__device__ __forceinline__ void s5_carry_block(const Params& P, int cb) {
  const int idx = cb * NT + opq(threadIdx.x);
  const int n = idx & 63, g = (idx >> 6) & 31, r = (idx >> 11) & 1, b = idx >> 12;
  const int rg = r * 32 + g;
  const float step = expf(P.s5_log_step[rg]);
  float lr, li;
  lam_pow(step, P.s5_a_re[rg * 64 + n], P.s5_a_im[rg * 64 + n], 32, lr, li);
  const float* __restrict__ E = (const float*)(P.ws + OFF_E) + (size_t)g * 544 * 256 + r * 128 + n;
  u16* __restrict__ XIN = (u16*)(P.ws + OFF_XIN) + (size_t)g * 512 * 256 + r * 128 + n;
  float xr = 0.f, xi = 0.f;
  {
    float er[8], ei[8];
#pragma unroll
    for (int k = 0; k < 8; ++k) {
      const int row = 512 + b * 8 + (r ? (7 - k) : k);
      er[k] = E[(size_t)row * 256]; ei[k] = E[(size_t)row * 256 + 64];
    }
#pragma unroll
    for (int k = 0; k < 8; ++k) {
      const float nr = lr * xr - li * xi + er[k], ni = lr * xi + li * xr + ei[k];
      xr = nr; xi = ni;
    }
  }
  for (int k0 = 0; k0 < 128; k0 += 8) {
    float er[8], ei[8];
#pragma unroll
    for (int k = 0; k < 8; ++k) {
      const int row = b * 128 + (r ? (127 - (k0 + k)) : (k0 + k));
      er[k] = E[(size_t)row * 256]; ei[k] = E[(size_t)row * 256 + 64];
    }
#pragma unroll
    for (int k = 0; k < 8; ++k) {
      const int row = b * 128 + (r ? (127 - (k0 + k)) : (k0 + k));
      XIN[(size_t)row * 256] = f2bf(xr);
      XIN[(size_t)row * 256 + 64] = f2bf(xi);
      const float nr = lr * xr - li * xi + er[k], ni = lr * xi + li * xr + ei[k];
      xr = nr; xi = ni;
    }
  }
}

__device__ __forceinline__ void s5out_tile(const Params& P, int t, char* lds) {
  const int g = t >> 3, mt = (t >> 2) & 1, nt = t & 3;
  const int m0 = mt * 256, n0 = nt * 128;
  f32x16 acc[2][2];
  acc_zero(acc);
  gemm_main((const u16*)(P.ws + OFF_XIN) + ((size_t)g * 512 + m0) * 256, 256,
            (const u16*)(P.ws + OFF_MST) + ((size_t)g * 512 + n0) * 256, 256, 256, acc, (u16*)lds);
  gemm_main((const u16*)(P.ws + OFF_U5) + ((size_t)g * 544 + m0) * 512, 512,
            (const u16*)(P.ws + OFF_MINTRA) + ((size_t)g * 512 + n0) * 512, 512, 512, acc, (u16*)lds);
  TILE_COORDS
  u16* YB = (u16*)(P.ws + OFF_YB);
#pragma unroll
  for (int i = 0; i < 2; ++i)
#pragma unroll
    for (int j = 0; j < 2; ++j)
#pragma unroll
      for (int e = 0; e < 16; ++e) {
        const int row = TROW(m0, i, e), nn = TCOL(n0, j);
        const int token = row * 32 + (nn >> 4);
        YB[(size_t)token * 512 + g * 16 + (nn & 15)] = f2bf(gelu_tanh(acc[i][j][e]));
      }
}

__device__ __forceinline__ void delta_post_item(const Params& P, int item) {
  const int lane = opq(threadIdx.x) & 63, w = opq(threadIdx.x) >> 6;
  const int row = item * 8 + w;
  const u16* O = (const u16*)(P.ws + OFF_O);
  const uint4 o0 = *(const uint4*)(O + (size_t)row * 512 + lane * 8);
  const uint4 o1 = *(const uint4*)(O + ((size_t)16384 + row) * 512 + lane * 8);
  const uint4 zz = *(const uint4*)((const u16*)(P.ws + OFF_Z) + (size_t)row * 512 + lane * 8);
  float a[8], bq[8], z[8];
  unpack8(o0, a); unpack8(o1, bq); unpack8(zz, z);
  float ss = 0.f;
#pragma unroll
  for (int e = 0; e < 8; ++e) { a[e] += bq[e]; ss += a[e] * a[e]; }
  ss += __shfl_xor(ss, 1, 64); ss += __shfl_xor(ss, 2, 64); ss += __shfl_xor(ss, 4, 64); ss += __shfl_xor(ss, 8, 64);
  const float rstd = rsqrtf(ss * (1.f / 128.f) + 1e-6f);
  const float* nw = P.dn_norm_w + (lane & 15) * 8;
  float y[8];
#pragma unroll
  for (int e = 0; e < 8; ++e) y[e] = a[e] * rstd * nw[e] * (z[e] * sigm(z[e]));
  *(uint4*)((u16*)(P.ws + OFF_YA) + (size_t)row * 512 + lane * 8) = pack8(y);
}

__device__ __forceinline__ void glu_tile(const Params& P, int t, char* lds) {
  int nt, mt;
  tile_map8(t, nt, mt);
  const int m0 = mt * 256, n0 = nt * 128;
  f32x16 acc[2][2];
  acc_zero(acc);
  gemm_main((const u16*)(P.ws + OFF_YB) + (size_t)m0 * 512, 512, (const u16*)(P.ws + OFF_WT_GLU) + (size_t)n0 * 512, 512, 512, acc, (u16*)lds);
  TILE_COORDS
  u16* YG = (u16*)(P.ws + OFF_YG);
  {
    const int oc = nt * 64 + wn_ * 32 + fr_;
    const float bv = P.b_glu[oc], bg = P.b_glu[512 + oc];
#pragma unroll
    for (int i = 0; i < 2; ++i)
#pragma unroll
      for (int e = 0; e < 16; ++e) {
        const float val = acc[i][0][e] + bv, gt = acc[i][1][e] + bg;
        YG[TIDX2(m0, nt * 64 + wn_ * 32, i, e, 512)] = f2bf(val * sigm(gt));
      }
  }
}

__device__ __forceinline__ void gates_tile(const Params& P, int t, char* lds) {
  int nt, mt;
  tile_map8(t, nt, mt);
  const int m0 = mt * 256, n0 = nt * 128;
  f32x16 acc[2][2];
  acc_zero(acc);
  gemm_main((const u16*)(P.ws + OFF_R2) + (size_t)m0 * 1024, 1024, (const u16*)(P.ws + OFF_WT_IN) + (size_t)(2688 + n0) * 1024, 1024, 1024, acc, (u16*)lds);
  TILE_COORDS
  u16* SG = (u16*)(P.ws + OFF_SG);
#pragma unroll
  for (int i = 0; i < 2; ++i)
#pragma unroll
    for (int j = 0; j < 2; ++j)
#pragma unroll
      for (int e = 0; e < 16; ++e) SG[TIDX(m0, n0, i, j, e, 2048)] = f2bf(sigm(acc[i][j][e]));
}

__device__ __forceinline__ void mix_tile(const Params& P, int t, char* lds) {
  int nt, mt;
  tile_map8(t, nt, mt);
  const int m0 = mt * 256, n0 = nt * 128;
  const u16* SG = (const u16*)(P.ws + OFF_SG);
  f32x16 acc[2][2];
  u16* MIX = (u16*)(P.ws + OFF_MIX);
  acc_zero(acc);
  gemm_main((const u16*)(P.ws + OFF_YA) + (size_t)m0 * 512, 512, (const u16*)(P.ws + OFF_WT_AOUT) + (size_t)n0 * 512, 512, 512, acc, (u16*)lds);
  {
    TILE_COORDS
    u16 sv[2][2][16];
#pragma unroll
    for (int i = 0; i < 2; ++i)
#pragma unroll
      for (int j = 0; j < 2; ++j)
#pragma unroll
        for (int e = 0; e < 16; ++e) sv[i][j][e] = SG[TIDX(m0, n0, i, j, e, 2048)];
#pragma unroll
    for (int i = 0; i < 2; ++i)
#pragma unroll
      for (int j = 0; j < 2; ++j)
#pragma unroll
        for (int e = 0; e < 16; ++e) MIX[TIDX(m0, n0, i, j, e, 1024)] = f2bf(bf2f(sv[i][j][e]) * acc[i][j][e]);
  }
  acc_zero(acc);
  gemm_main((const u16*)(P.ws + OFF_YG) + (size_t)m0 * 512, 512, (const u16*)(P.ws + OFF_WT_BOUT) + (size_t)n0 * 512, 512, 512, acc, (u16*)lds);
  {
    TILE_COORDS
#pragma unroll
    for (int i = 0; i < 2; ++i) {
      u16 sv[2][16], pv[2][16];
#pragma unroll
      for (int j = 0; j < 2; ++j)
#pragma unroll
        for (int e = 0; e < 16; ++e) {
          sv[j][e] = SG[TIDX(m0, n0, i, j, e, 2048) + 1024];
          pv[j][e] = MIX[TIDX(m0, n0, i, j, e, 1024)];
        }
#pragma unroll
      for (int j = 0; j < 2; ++j)
#pragma unroll
        for (int e = 0; e < 16; ++e)
          MIX[TIDX(m0, n0, i, j, e, 1024)] = f2bf(bf2f(pv[j][e]) + bf2f(sv[j][e]) * acc[i][j][e]);
    }
  }
}

__device__ __forceinline__ void wo_tile(const Params& P, int t, char* lds) {
  int nt, mt;
  tile_map8(t, nt, mt);
  const int m0 = mt * 256, n0 = nt * 128;
  f32x16 acc[2][2];
  acc_zero(acc);
  gemm_main((const u16*)(P.ws + OFF_MIX) + (size_t)m0 * 1024, 1024, (const u16*)(P.ws + OFF_WT_O) + (size_t)n0 * 1024, 1024, 1024, acc, (u16*)lds);
  TILE_COORDS
  const float* MOD = (const float*)(P.ws + OFF_MOD) + (m0 >> 12) * 6144 + 2 * 1024;
  float xv[2][2][16];
#pragma unroll
  for (int j = 0; j < 2; ++j)
#pragma unroll
    for (int i = 0; i < 2; ++i)
#pragma unroll
      for (int e = 0; e < 16; ++e) xv[i][j][e] = P.x[TIDX(m0, n0, i, j, e, 1024)];
#pragma unroll
  for (int j = 0; j < 2; ++j) {
    const int col = TCOL(n0, j);
    const float gate = MOD[col];
#pragma unroll
    for (int i = 0; i < 2; ++i)
#pragma unroll
      for (int e = 0; e < 16; ++e) P.out[TIDX(m0, n0, i, j, e, 1024)] = xv[i][j][e] + gate * acc[i][j][e];
  }
}

__device__ __forceinline__ void norm2_item(const Params& P, int item) {
  const int lane = opq(threadIdx.x) & 63, w = opq(threadIdx.x) >> 6;
  const int rowA = item * 16 + w, rowB = rowA + 8;
  const float* MA = (const float*)(P.ws + OFF_MOD) + (rowA >> 12) * 6144;
  const float* MB = (const float*)(P.ws + OFF_MOD) + (rowB >> 12) * 6144;
  u16* H = (u16*)(P.ws + OFF_R2);
  norm_row2(P.out + (size_t)rowA * 1024, P.out + (size_t)rowB * 1024, P.norm2_w, MA + 3 * 1024, MA + 4 * 1024, MB + 3 * 1024, MB + 4 * 1024,
            H + (size_t)rowA * 1024, H + (size_t)rowB * 1024, lane);
}

__device__ __forceinline__ void up_tile(const Params& P, int t, int hh, char* lds) {
  const int nt = t >> 6, mt = t & 63;
  const int m0 = mt * 256, n0 = nt * 128;
  f32x16 acc[2][2];
  acc_zero(acc);
  gemm_main((const u16*)(P.ws + OFF_R2) + (size_t)m0 * 1024, 1024,
            (const u16*)(P.ws + OFF_WT_UP) + ((size_t)hh * 2816 + n0) * 1024, 1024, 1024, acc, (u16*)lds);
  TILE_COORDS
  u16* UPH = (u16*)(P.ws + OFF_UPH);
#pragma unroll
  for (int i = 0; i < 2; ++i)
#pragma unroll
    for (int j = 0; j < 2; ++j)
#pragma unroll
      for (int e = 0; e < 16; ++e) UPH[TIDX(m0, n0, i, j, e, 2816)] = f2bf(acc[i][j][e]);
}

#define CG_LD(ci, dy)                                                                       \
    {                                                                                       \
      const int xc = x0 - 1 + (ci);                                                         \
      const bool cok = (xc >= 0) && (xc <= 63);                                             \
      const bool rok = ((dy) == 1) || ((dy) == 0 ? r0ok : r2ok);                            \
      const int yy = rok ? (y + (dy) - 1) : y;                                              \
      const u16* src = UPH + (base + (size_t)yy * 64 + (cok ? xc : x0)) * 2816 + c4 * 2;    \
      const uint4 q__ = *(const uint4*)src;               \
      uint2 g__ = make_uint2(q__.x, q__.y);                                                 \
      uint2 v__ = make_uint2(q__.z, q__.w);                                                 \
      const bool ok = cok && rok;                                                           \
      g__.x = ok ? g__.x : 0u; g__.y = ok ? g__.y : 0u;                                     \
      v__.x = ok ? v__.x : 0u; v__.y = ok ? v__.y : 0u;                                     \
      gg[ci][dy] = g__; vv[ci][dy] = v__;                                                   \
    }
__device__ __forceinline__ void convgate_phase(const Params& P, int hh) {
  const int tid = opq(threadIdx.x);
  if (tid >= 352) return;
  const int c4 = tid * 4;
  const u16* UPH = (const u16*)(P.ws + OFF_UPH);
  u16* G = (u16*)(P.ws + OFF_G);
  float wg[9][4], wv[9][4];
#pragma unroll
  for (int k = 0; k < 9; ++k) {
    const float4 a = *(const float4*)(P.ffn_conv_w + (size_t)k * 5632 + hh * 1408 + c4);
    const float4 bq = *(const float4*)(P.ffn_conv_w + (size_t)k * 5632 + 2816 + hh * 1408 + c4);
    wg[k][0] = a.x; wg[k][1] = a.y; wg[k][2] = a.z; wg[k][3] = a.w;
    wv[k][0] = bq.x; wv[k][1] = bq.y; wv[k][2] = bq.z; wv[k][3] = bq.w;
  }
  for (int item = blockIdx.x; item < 4096; item += gridDim.x) {
  const int xo = item & 15, y = (item >> 4) & 63, b = item >> 10;
  const size_t base = (size_t)b * 4096;
  const bool r0ok = (y > 0), r2ok = (y < 63);
  const int x0 = xo * 4;
  uint2 gg[6][3], vv[6][3];
#pragma unroll
  for (int ci = 0; ci < 6; ++ci) {
    CG_LD(ci, 0)
    CG_LD(ci, 1)
    CG_LD(ci, 2)
  }
#pragma unroll
  for (int xx = 0; xx < 4; ++xx) {
    float ag[4] = {0.f, 0.f, 0.f, 0.f}, av[4] = {0.f, 0.f, 0.f, 0.f};
#pragma unroll
    for (int dy = 0; dy < 3; ++dy)
#pragma unroll
      for (int dx = 0; dx < 3; ++dx) {
        const uint2 gq = gg[xx + dx][dy], vq = vv[xx + dx][dy];
        const int k = dy * 3 + dx;
        ag[0] += wg[k][0] * lo16(gq.x); ag[1] += wg[k][1] * hi16(gq.x); ag[2] += wg[k][2] * lo16(gq.y); ag[3] += wg[k][3] * hi16(gq.y);
        av[0] += wv[k][0] * lo16(vq.x); av[1] += wv[k][1] * hi16(vq.x); av[2] += wv[k][2] * lo16(vq.y); av[3] += wv[k][3] * hi16(vq.y);
      }
    uint2 o;
    o.x = pack2(ag[0] * sigm(ag[0]) * av[0], ag[1] * sigm(ag[1]) * av[1]);
    o.y = pack2(ag[2] * sigm(ag[2]) * av[2], ag[3] * sigm(ag[3]) * av[3]);
    *(uint2*)(G + (base + y * 64 + x0 + xx) * 2816 + hh * 1408 + c4) = o;
  }
  }
}
#undef CG_LD

__device__ __forceinline__ void down_tile(const Params& P, int t, char* lds) {
  int nt, mt;
  tile_map8(t, nt, mt);
  const int m0 = mt * 256, n0 = nt * 128;
  f32x16 acc[2][2];
  acc_zero(acc);
  gemm_main((const u16*)(P.ws + OFF_G) + (size_t)m0 * 2816, 2816, (const u16*)(P.ws + OFF_WT_DOWN) + (size_t)n0 * 2816, 2816, 2816, acc, (u16*)lds);
  TILE_COORDS
  const float* MOD = (const float*)(P.ws + OFF_MOD) + (m0 >> 12) * 6144 + 5 * 1024;
  float xv[2][2][16];
#pragma unroll
  for (int j = 0; j < 2; ++j)
#pragma unroll
    for (int i = 0; i < 2; ++i)
#pragma unroll
      for (int e = 0; e < 16; ++e) xv[i][j][e] = P.out[TIDX(m0, n0, i, j, e, 1024)];
#pragma unroll
  for (int j = 0; j < 2; ++j) {
    const int col = TCOL(n0, j);
    const float gate = MOD[col];
#pragma unroll
    for (int i = 0; i < 2; ++i)
#pragma unroll
      for (int e = 0; e < 16; ++e) P.out[TIDX(m0, n0, i, j, e, 1024)] = xv[i][j][e] + gate * acc[i][j][e];
  }
}

__device__ __forceinline__ void final_item(const Params& P, int item) {
  const int lane = opq(threadIdx.x) & 63, w = opq(threadIdx.x) >> 6;
  const int row = item * 8 + w;
  float* xr = P.out + (size_t)row * 1024;
  float4 v[4];
  float ss = 0.f;
#pragma unroll
  for (int it = 0; it < 4; ++it) {
    v[it] = *(const float4*)(xr + (it * 64 + lane) * 4);
    ss += v[it].x * v[it].x + v[it].y * v[it].y + v[it].z * v[it].z + v[it].w * v[it].w;
  }
  ss = wsum64(ss);
  const float rstd = rsqrtf(ss * (1.f / 1024.f) + 1e-6f);
#pragma unroll
  for (int it = 0; it < 4; ++it) {
    const int c = (it * 64 + lane) * 4;
    const float4 w4 = *(const float4*)(P.norm_f_w + c);
    float4 o;
    o.x = v[it].x * rstd * w4.x; o.y = v[it].y * rstd * w4.y; o.z = v[it].z * rstd * w4.z; o.w = v[it].w * rstd * w4.w;
    *(float4*)(xr + c) = o;
  }
}

__device__ __forceinline__ void run_phase(const Params& P, int ph, char* lds) {
  const int bid = blockIdx.x, nb = gridDim.x;
#ifdef ONLY_PHASE
  if (ph != ONLY_PHASE) return;
#endif
  switch (ph) {
    case 0: {
      for (int it = bid; it < 984 + 192 + 512; it += nb) {
        if (it < 296) convert_item(P.w_in, 1024, 4624, (u16*)(P.ws + OFF_WT_IN), 0, it, lds);
        else if (it < 328) convert_item(P.w_a_out, 512, 1024, (u16*)(P.ws + OFF_WT_AOUT), 1, it - 296, lds);
        else if (it < 360) convert_item(P.w_glu, 512, 1024, (u16*)(P.ws + OFF_WT_GLU), 2, it - 328, lds);
        else if (it < 392) convert_item(P.w_b_out, 512, 1024, (u16*)(P.ws + OFF_WT_BOUT), 3, it - 360, lds);
        else if (it < 456) convert_item(P.w_o, 1024, 1024, (u16*)(P.ws + OFF_WT_O), 4, it - 392, lds);
        else if (it < 808) convert_item(P.w_up, 1024, 5632, (u16*)(P.ws + OFF_WT_UP), 5, it - 456, lds);
        else if (it < 984) convert_item(P.w_down, 2816, 1024, (u16*)(P.ws + OFF_WT_DOWN), 6, it - 808, lds);
        else if (it < 1176) mod_item(P, it - 984, lds);
        else s5tab_item(P, it - 1176, lds);
      }
    } break;
    case 1:
      for (int it = bid; it < 1088 + 2048; it += nb) {
        if (it < 1088) norm1_item(P, it); else mintra_item(P, it - 1088);
      }
      break;
    case 2:
      for (int it = bid; it < 1396; it += nb) inproj_tile(P, it, lds);
      break;
    case 3:
      for (int it = bid; it < 1088 + 192; it += nb) {
        if (it < 1088) delta_prep_item(P, it, lds); else s5end_tile(P, it - 1088, lds);
      }
      break;
    case 4:
      if (bid < 128) delta_scan_block(P, bid, lds);
      else if (bid < 160) s5_carry_block(P, bid - 128);
      break;
    case 5:
      for (int it = bid; it < 256 + 2048 + 1024; it += nb) {
        if (it < 256) s5out_tile(P, it, lds);
        else if (it < 2304) delta_post_item(P, it - 256);
        else norm1_item(P, it - 2304);
      }
      break;
    case 6:
      for (int it = bid; it < 512 + 1024; it += nb) {
        if (it < 512) glu_tile(P, it, lds); else gates_tile(P, it - 512, lds);
      }
      break;
    case 7:
      for (int it = bid; it < 512; it += nb) mix_tile(P, it, lds);
      break;
    case 8:
      for (int it = bid; it < 512; it += nb) wo_tile(P, it, lds);
      break;
    case 9:
      for (int it = bid; it < 1024; it += nb) norm2_item(P, it);
      break;
    case 10:
      for (int it = bid; it < 1408; it += nb) up_tile(P, it, 0, lds);
      break;
    case 11:
      convgate_phase(P, 0);
      break;
    case 12:
      for (int it = bid; it < 1408; it += nb) up_tile(P, it, 1, lds);
      break;
    case 13:
      convgate_phase(P, 1);
      break;
    case 14:
      for (int it = bid; it < 512; it += nb) down_tile(P, it, lds);
      break;
    case 15:
      for (int it = bid; it < 2048; it += nb) final_item(P, it);
      break;
    default: break;
  }
}

typedef const __attribute__((address_space(4))) Params* KParamsPtr;
__global__ void __launch_bounds__(NT) fwd_megakernel(Params Pk) {
#if defined(__HIP_DEVICE_COMPILE__)
  extern __shared__ __attribute__((aligned(16))) char lds[];
  KParamsPtr pp = (KParamsPtr)__builtin_amdgcn_kernarg_segment_ptr();
  const int lo = (int)pp->ph_lo, hi = (int)pp->ph_hi;
#if MULTI_LAUNCH
  for (int ph = lo; ph < hi; ++ph) { KParamsPtr q = pp; asm volatile("" : "+s"(q)); Params P; for (int i_ = 0; i_ < (int)(sizeof(Params) / 8); ++i_) ((unsigned long long*)&P)[i_] = ((const __attribute__((address_space(4))) unsigned long long*)q)[i_]; run_phase(P, ph, lds); }
#else
  cg::grid_group grid = cg::this_grid();
  volatile LAS unsigned* xst = (volatile LAS unsigned*)(lds + (LDS_BYTES - 16));
  if (threadIdx.x == 0) { xst[0] = 0u; xst[1] = 0u; xst[2] = 0u; xst[3] = 0u; }
  __syncthreads();
  XcdBarrier xb = xcd_barrier_post((unsigned*)(pp->ws + OFF_BAR), xst);
  const unsigned rep_mask = (unsigned)pp->rep_mask;
  bool first_sync = true;
  for (int ph = lo; ph < hi; ++ph) {
    const int reps = 1 + (int)((rep_mask >> ph) & 1u);
    for (int rp = 0; rp < reps; ++rp) {
      {
        KParamsPtr q = pp;
        asm volatile("" : "+s"(q));
        Params P;
        {
          typedef __attribute__((address_space(1))) const float* GF;
          const float** dp = (const float**)&P;
          const __attribute__((address_space(4))) unsigned long long* sp = (const __attribute__((address_space(4))) unsigned long long*)q;
#pragma unroll
          for (int i_ = 0; i_ < 30; ++i_) dp[i_] = (const float*)(GF)(sp[i_]);
          P.out = (float*)(__attribute__((address_space(1))) float*)(sp[30]);
          P.ws = (char*)(__attribute__((address_space(1))) char*)(sp[31]);
          P.ph_lo = 0; P.ph_hi = 0; P.rep_mask = 0;
        }
        run_phase(P, ph, lds);
      }
      if (ph + 1 < hi || rp + 1 < reps) {
        if (first_sync) { grid.sync(); first_sync = false; }
        else xcd_barrier(xb);
      }
    }
  }
#endif
#endif
}

extern "C" void kernel_launch(void* const* d_in, const int* in_sizes, int n_in, void* d_out, int out_size, void* d_ws,
                              size_t ws_size, hipStream_t stream) {
  static int grid_blocks = 0;
  if (grid_blocks == 0) {
    if (n_in != 30 || out_size != 16384 * 1024 || ws_size < WS_NEED) {
      fprintf(stderr, "kernel_launch: unexpected shapes: n_in %d out %d ws %zu (need %zu)\n", n_in, out_size, ws_size, (size_t)WS_NEED);
      grid_blocks = -1;
      return;
    }
    int dev = 0, cus = 0, per_cu = 0;
    hipGetDevice(&dev);
    hipDeviceGetAttribute(&cus, hipDeviceAttributeMultiprocessorCount, dev);
    if (hipFuncSetAttribute((const void*)fwd_megakernel, hipFuncAttributeMaxDynamicSharedMemorySize, LDS_BYTES) != hipSuccess) {
      fprintf(stderr, "kernel_launch: hipFuncSetAttribute failed\n");
      grid_blocks = -1;
      return;
    }
    if (hipOccupancyMaxActiveBlocksPerMultiprocessor(&per_cu, (const void*)fwd_megakernel, NT, LDS_BYTES) != hipSuccess || per_cu < 1) {
      fprintf(stderr, "kernel_launch: occupancy query failed / zero (%d)\n", per_cu);
      grid_blocks = -1;
      return;
    }
    grid_blocks = cus;
    if (grid_blocks < 64) { fprintf(stderr, "kernel_launch: too few CUs (%d)\n", cus); grid_blocks = -1; return; }
  }
  if (grid_blocks < 0) return;
  (void)hipMemsetAsync((char*)d_ws + OFF_BAR, 0, XCD_BAR_WORDS * sizeof(unsigned), stream);
  Params p{};
  const float** pp = (const float**)&p;
  for (int i = 0; i < 30; ++i) pp[i] = (const float*)d_in[i];
  p.out = (float*)d_out;
  p.ws = (char*)d_ws;
#if MULTI_LAUNCH
  for (int ph = 0; ph < 16; ++ph) {
    p.ph_lo = ph; p.ph_hi = ph + 1;
    hipLaunchKernelGGL(fwd_megakernel, dim3(grid_blocks), dim3(NT), LDS_BYTES, stream, p);
  }
#else
  p.ph_lo = 0; p.ph_hi = 16;
#ifdef REPEAT_MASK
  p.rep_mask = REPEAT_MASK;
#endif
  void* args[] = {&p};
  hipError_t e = hipLaunchCooperativeKernel((const void*)fwd_megakernel, dim3(grid_blocks), dim3(NT), args, LDS_BYTES, stream);
  if (e != hipSuccess) fprintf(stderr, "cooperative launch failed: %s (grid %d)\n", hipGetErrorString(e), grid_blocks);
#endif
}
```

```cpp
#include <hip/hip_runtime.h>
#include <hip/hip_cooperative_groups.h>
#include <cstdio>
#include <cstdint>
namespace cg = cooperative_groups;

#ifndef MULTI_LAUNCH
#define MULTI_LAUNCH 0
#endif

typedef unsigned short u16;
typedef __attribute__((ext_vector_type(8))) short bf16x8;
typedef __attribute__((ext_vector_type(4))) float f32x4;
typedef __attribute__((ext_vector_type(16))) float f32x16;
typedef __attribute__((ext_vector_type(4))) unsigned int u32x4;
typedef __attribute__((ext_vector_type(2))) unsigned int u32x2;

#define NT 512
constexpr int LDS_BYTES = 131072 + 1024;
constexpr int NPHASE = 18;

constexpr size_t OFF_WT_IN   = 0;
constexpr size_t OFF_WT_AOUT = 9699328;
constexpr size_t OFF_WT_GLU  = 10747904;
constexpr size_t OFF_WT_BOUT = 11796480;
constexpr size_t OFF_WT_O    = 12845056;
constexpr size_t OFF_WT_UP   = 14942208;
constexpr size_t OFF_WT_DOWN = 26476544;
constexpr size_t OFF_MOD     = 32243712;
constexpr size_t OFF_BAR     = 32505856;
constexpr size_t OFF_R2      = 33554432;
constexpr size_t OFF_R1      = 69206016;
constexpr size_t OFF_KTAB    = OFF_R1;
constexpr size_t OFF_MEND    = OFF_R1 + 2097152;
constexpr size_t OFF_MST     = OFF_R1 + 10485760;
constexpr size_t OFF_MINTRA  = OFF_R1 + 18874368;
constexpr size_t OFF_R3      = 104857600;
constexpr size_t OFF_O       = OFF_R3;
constexpr size_t OFF_XIN     = OFF_R3 + 33554432;
constexpr size_t OFF_MIX     = 158334976;
constexpr size_t OFF_SG      = OFF_R1;
constexpr size_t OFF_Z       = 158334976;
constexpr size_t OFF_U5      = 175112192;
constexpr size_t OFF_BA      = 192937984;
constexpr size_t OFF_GC      = OFF_BA + 1179648;
constexpr size_t OFF_UF      = 195035136;
constexpr size_t OFF_YA      = OFF_UF;
constexpr size_t OFF_YB      = OFF_UF + 16777216;
constexpr size_t OFF_E       = 230686720;
constexpr size_t OFF_YG      = OFF_E;
constexpr size_t OFF_UPH     = OFF_R1;
constexpr size_t OFF_G       = 161480704;
constexpr size_t WS_NEED     = 253755392;
constexpr size_t OFF_QKN     = 0;
constexpr size_t OFF_AQ      = 35651584;

struct Params {
  const float *x, *c, *ctx, *c_ctx, *w_ada, *b_ada, *norm1_w, *w_in, *dn_conv_w, *dn_a_log, *dn_dt_bias, *dn_norm_w,
      *w_a_out, *s5_a_re, *s5_a_im, *s5_log_step, *s5_b_re, *s5_b_im, *s5_c_re, *s5_c_im, *s5_d, *w_glu, *b_glu,
      *w_b_out, *w_o, *norm2_w, *w_up, *ffn_conv_w, *w_down, *norm_f_w;
  float* out;
  char* ws;
  long long ph_lo, ph_hi;
  long long rep_mask;
};

#define XB_TMO      128
#define XB_XCNT(j)  (256  + 64 * (j))
#define XB_XSUB(j)  (1280 + 64 * (j))
#define XB_XGEN(j)  (2304 + 64 * (j))
#define XB_TOP      3328
#define XB_TOPGEN   3392
#define XCD_BAR_WORDS 3456
#define XB_SPIN_CAP (1u << 18)
#define LAS __attribute__((address_space(3)))

__device__ __forceinline__ unsigned xb_ld(unsigned* p)              { return __hip_atomic_load(p, __ATOMIC_RELAXED, __HIP_MEMORY_SCOPE_AGENT); }
__device__ __forceinline__ unsigned xb_add(unsigned* p, unsigned v) { return __hip_atomic_fetch_add(p, v, __ATOMIC_RELAXED, __HIP_MEMORY_SCOPE_AGENT); }
__device__ __forceinline__ unsigned xb_xcc_id() { return (unsigned)__builtin_amdgcn_s_getreg((3 << 11) | 20) & 0xFu; }
#define XB_SPIN(cond, bar) do { unsigned _sp = 0; while (cond) { __builtin_amdgcn_s_sleep(1); \
    if ((++_sp & 255u) == 0u) { if (xb_ld(&(bar)[XB_TMO])) break; if (_sp > XB_SPIN_CAP) { atomicAdd(&(bar)[XB_TMO], 1u); break; } } } } while (0)

struct XcdBarrier {
    unsigned* bar; unsigned x;
    volatile LAS unsigned* st;
};

__device__ __forceinline__ XcdBarrier xcd_barrier_post(unsigned* bar, volatile LAS unsigned* st) {
    XcdBarrier b; b.bar = bar; b.x = xb_xcc_id(); b.st = st;
    if (threadIdx.x == 0) (void)xb_add(&bar[XB_XCNT(b.x)], 1u);
    return b;
}
__device__ __forceinline__ void xcd_barrier_complete(unsigned* bar, unsigned x, unsigned& nloc, unsigned& nx) {
    const unsigned G = gridDim.x * gridDim.y * gridDim.z;
    unsigned sum, cnt, mine, sp = 0u;
    for (;;) {
        sum = 0u; cnt = 0u; mine = 0u;
#pragma unroll
        for (unsigned j = 0; j < 16; ++j) { const unsigned c = xb_ld(&bar[XB_XCNT(j)]); sum += c; cnt += (c > 0u) ? 1u : 0u; mine = (j == x) ? c : mine; }
        if (sum == G) break;
        __builtin_amdgcn_s_sleep(1);
        if ((++sp & 255u) == 0u) { if (xb_ld(&bar[XB_TMO])) break; if (sp > XB_SPIN_CAP) { atomicAdd(&bar[XB_TMO], 1u); break; } }
    }
    nloc = mine > 0u ? mine : 1u; nx = cnt > 0u ? cnt : 1u;
}

__device__ __forceinline__ void xcd_barrier(const XcdBarrier& b) {
    asm volatile("s_waitcnt vmcnt(0)" ::: "memory");
    __syncthreads();
    if (threadIdx.x == 0) {
        unsigned* bar = b.bar;
        __builtin_amdgcn_s_waitcnt(0);
        unsigned nloc = b.st[0], nx = b.st[1];
        if (nloc == 0u) { xcd_barrier_complete(bar, b.x, nloc, nx); b.st[0] = nloc; b.st[1] = nx; }
        const unsigned old = xb_add(&bar[XB_XSUB(b.x)], 1u);
        const unsigned gen = old / nloc;
        if (old + 1u == (gen + 1u) * nloc) {
            __builtin_amdgcn_fence(__ATOMIC_RELEASE, "agent");
            asm volatile("s_waitcnt vmcnt(0)" ::: "memory");
            const unsigned og = xb_add(&bar[XB_TOP], 1u);
            const unsigned tg = og / nx;
            if (og + 1u == (tg + 1u) * nx) xb_add(&bar[XB_TOPGEN], 1u);
            else XB_SPIN(xb_ld(&bar[XB_TOPGEN]) == tg, bar);
            __builtin_amdgcn_fence(__ATOMIC_ACQUIRE, "agent");
            xb_add(&bar[XB_XGEN(b.x)], 1u);
            asm volatile("s_waitcnt vmcnt(0)" ::: "memory");
        } else {
            XB_SPIN(xb_ld(&bar[XB_XGEN(b.x)]) == gen, bar);
            __builtin_amdgcn_fence(__ATOMIC_ACQUIRE, "agent");
            asm volatile("s_waitcnt vmcnt(0)" ::: "memory");
        }
    }
    __syncthreads();
}


typedef __attribute__((ext_vector_type(2))) float f32x2_t;
typedef __attribute__((ext_vector_type(2))) __bf16 bf16x2_t;
__device__ __forceinline__ u16 f2bf(float f) {
  const __bf16 h = (__bf16)f;
  return __builtin_bit_cast(u16, h);
}
__device__ __forceinline__ float bf2f(u16 h) { return __uint_as_float(((uint32_t)h) << 16); }
__device__ __forceinline__ uint32_t pack2(float a, float b) {
  const f32x2_t v = {a, b};
  const bf16x2_t r = __builtin_convertvector(v, bf16x2_t);
  return __builtin_bit_cast(uint32_t, r);
}
__device__ __forceinline__ float lo16(uint32_t w) { return __uint_as_float(w << 16); }
__device__ __forceinline__ float hi16(uint32_t w) { return __uint_as_float(w & 0xffff0000u); }
__device__ __forceinline__ int opq(int v) { asm volatile("" : "+v"(v)); return v; }
__device__ __forceinline__ void lds_barrier() {
  asm volatile("s_waitcnt lgkmcnt(0)" ::: "memory");
  __builtin_amdgcn_s_barrier();
  asm volatile("" ::: "memory");
}
__device__ __forceinline__ float sigm(float x) { return 1.f / (1.f + __expf(-x)); }
__device__ __forceinline__ void unpack8(uint4 v, float* f) {
  f[0] = lo16(v.x); f[1] = hi16(v.x); f[2] = lo16(v.y); f[3] = hi16(v.y);
  f[4] = lo16(v.z); f[5] = hi16(v.z); f[6] = lo16(v.w); f[7] = hi16(v.w);
}
__device__ __forceinline__ uint4 pack8(const float* f) {
  uint4 v; v.x = pack2(f[0], f[1]); v.y = pack2(f[2], f[3]); v.z = pack2(f[4], f[5]); v.w = pack2(f[6], f[7]);
  return v;
}
__device__ __forceinline__ float wsum64(float v) {
#pragma unroll
  for (int o = 32; o > 0; o >>= 1) v += __shfl_xor(v, o, 64);
  return v;
}
__device__ __forceinline__ float gelu_tanh(float x) {
  float u = 0.7978845608028654f * (x + 0.044715f * x * x * x);
  float t = 1.f - 2.f / (1.f + __expf(2.f * u));
  return 0.5f * x * (1.f + t);
}

__device__ __forceinline__ void g_frag(const u16* as, const u16* bs, int ks, bf16x8 (&a)[2], bf16x8 (&b)[2]) {
  a[0] = *(const bf16x8*)(as + ks * 16);
  a[1] = *(const bf16x8*)(as + 32 * 72 + ks * 16);
  b[0] = *(const bf16x8*)(bs + ks * 16);
  b[1] = *(const bf16x8*)(bs + 32 * 72 + ks * 16);
}
__device__ __forceinline__ void g_mma(const bf16x8 (&a)[2], const bf16x8 (&b)[2], f32x16 (&acc)[2][2]) {
  acc[0][0] = __builtin_amdgcn_mfma_f32_32x32x16_bf16(a[0], b[0], acc[0][0], 0, 0, 0);
  acc[0][1] = __builtin_amdgcn_mfma_f32_32x32x16_bf16(a[0], b[1], acc[0][1], 0, 0, 0);
  acc[1][0] = __builtin_amdgcn_mfma_f32_32x32x16_bf16(a[1], b[0], acc[1][0], 0, 0, 0);
  acc[1][1] = __builtin_amdgcn_mfma_f32_32x32x16_bf16(a[1], b[1], acc[1][1], 0, 0, 0);
}
__device__ __forceinline__ void gemm_main(const u16* __restrict__ A, int lda, const u16* __restrict__ Bt, int ldb, int K,
                                          f32x16 (&acc)[2][2], u16* lds) {
  const int tid = opq(threadIdx.x), lane = tid & 63, w = tid >> 6, wm = w >> 1, wn = w & 1, fr = lane & 31, fq = lane >> 5;
  u16* As = lds;
  u16* Bs = lds + 2 * 256 * 72;
  const int nk = K >> 6;
  uint4 p0, p1, p2, p3, p4, p5;
  uint4 q0, q1, q2, q3, q4, q5;
  uint4 r0, r1, r2, r3, r4, r5;
  const int lr = tid >> 3, lc = (tid & 7) * 8;
  const unsigned oa0 = (unsigned)(lr * lda + lc) * 2u, sa2 = (unsigned)lda * 128u;
  const unsigned oa1 = oa0 + sa2, oa2 = oa0 + 2u * sa2, oa3 = oa0 + 3u * sa2;
  const unsigned ob0 = (unsigned)(lr * ldb + lc) * 2u, ob1 = ob0 + (unsigned)ldb * 128u;
#define G_LOAD(S, kt_)                                          \
  {                                                             \
    const int kc_ = ((kt_) < nk) ? (kt_) : (nk - 1);            \
    const char* a_ = (const char*)A + kc_ * 128;                \
    const char* b_ = (const char*)Bt + kc_ * 128;               \
    S##0 = *(const uint4*)(a_ + oa0);                           \
    S##1 = *(const uint4*)(a_ + oa1);                           \
    S##2 = *(const uint4*)(a_ + oa2);                           \
    S##3 = *(const uint4*)(a_ + oa3);                           \
    S##4 = *(const uint4*)(b_ + ob0);                           \
    S##5 = *(const uint4*)(b_ + ob1);                           \
  }
#define G_STORE(S, buf_)                                                     \
  {                                                                          \
    u16* as_ = As + ((buf_) * 256 + lr) * 72 + lc;                           \
    u16* bs_ = Bs + ((buf_) * 128 + lr) * 72 + lc;                           \
    *(uint4*)(as_) = S##0;                                                   \
    *(uint4*)(as_ + 64 * 72) = S##1;                                         \
    *(uint4*)(as_ + 128 * 72) = S##2;                                        \
    *(uint4*)(as_ + 192 * 72) = S##3;                                        \
    *(uint4*)(bs_) = S##4;                                                   \
    *(uint4*)(bs_ + 64 * 72) = S##5;                                         \
  }
#define G_STEP(S, BUF, kt_)                                                               \
  {                                                                                       \
    const u16* as = As + ((BUF) * 256 + wm * 64 + fr) * 72 + fq * 8;                      \
    const u16* bs = Bs + ((BUF) * 128 + wn * 64 + fr) * 72 + fq * 8;                      \
    bf16x8 fa0[2], fb0[2], fa1[2], fb1[2], fa2[2], fb2[2];                                \
    g_frag(as, bs, 0, fa0, fb0);                                                          \
    g_frag(as, bs, 1, fa1, fb1);                                                          \
    __builtin_amdgcn_sched_barrier(0);                                                    \
    G_STORE(S, (BUF) ^ 1)                                                                 \
    G_LOAD(S, (kt_) + 4)                                                                  \
    __builtin_amdgcn_sched_barrier(0);                                                    \
    g_frag(as, bs, 2, fa2, fb2);                                                          \
    __builtin_amdgcn_sched_barrier(0);                                                    \
    g_mma(fa0, fb0, acc);                                                                 \
    __builtin_amdgcn_sched_barrier(0);                                                    \
    g_frag(as, bs, 3, fa0, fb0);                                                          \
    __builtin_amdgcn_sched_barrier(0);                                                    \
    g_mma(fa1, fb1, acc);                                                                 \
    g_mma(fa2, fb2, acc);                                                                 \
    g_mma(fa0, fb0, acc);                                                                 \
    lds_barrier();                                                                      \
  }
  G_LOAD(p, 0)
  lds_barrier();
  G_STORE(p, 0)
  G_LOAD(q, 1)
  G_LOAD(r, 2)
  G_LOAD(p, 3)
  lds_barrier();
  for (int kt = 0; kt < nk; kt += 6) {
    G_STEP(q, 0, kt)
    G_STEP(r, 1, kt + 1)
    if (kt + 2 < nk) {
      G_STEP(p, 0, kt + 2)
      G_STEP(q, 1, kt + 3)
    }
    if (kt + 4 < nk) {
      G_STEP(r, 0, kt + 4)
      G_STEP(p, 1, kt + 5)
    }
  }
#undef G_STEP
#undef G_LOAD
#undef G_STORE
}

__device__ __forceinline__ void acc_zero(f32x16 (&acc)[2][2]) {
#pragma unroll
  for (int i = 0; i < 2; ++i)
#pragma unroll
    for (int j = 0; j < 2; ++j)
#pragma unroll
      for (int e = 0; e < 16; ++e) acc[i][j][e] = 0.f;
}

#define TILE_COORDS                                                                                  \
  const int tid_ = opq(threadIdx.x), lane_ = tid_ & 63, w_ = __builtin_amdgcn_readfirstlane(tid_ >> 6), \
            wm_ = w_ >> 1, wn_ = w_ & 1, fr_ = lane_ & 31, fq_ = lane_ >> 5;
#define TROW(m0, i, e) ((m0) + wm_ * 64 + (i) * 32 + ((e) & 3) + 8 * ((e) >> 2) + 4 * fq_)
#define TCOL(n0, j) ((n0) + wn_ * 64 + (j) * 32 + fr_)
#define TIDX2(m0, cb, i, e, ld) ((size_t)((m0) + wm_ * 64 + (i) * 32 + ((e) & 3) + 8 * ((e) >> 2)) * (ld) + (cb) + (size_t)(unsigned)(4 * fq_ * (ld) + fr_))
#define TIDX(m0, n0, i, j, e, ld) TIDX2(m0, (n0) + wn_ * 64 + (j) * 32, i, e, ld)

__device__ __forceinline__ void tile_map8(int t, int& nt, int& mt) {
  const int sr = t >> 9, u = t & 511, rnd = u >> 8, idx = u & 255, xcd = idx & 7, slot = idx >> 3;
  mt = ((rnd * 8 + xcd) << 2) + (slot & 3);
  nt = sr * 8 + (slot >> 2);
}

__device__ __forceinline__ int srccol(int which, int r) {
  switch (which) {
    case 0:
      if (r < 2048) return r;
      if (r < 2560) return 2064 + (r - 2048);
      if (r < 2576) return 2048 + (r - 2560);
      if (r < 2688) return -1;
      if (r < 3712) return 2576 + (r - 2688);
      return 3600 + (r - 3712);
    case 2: {
      int tile = r >> 7, wn = (r >> 6) & 1, wi = r & 63;
      return (wi < 32) ? (tile * 64 + wn * 32 + wi) : (512 + tile * 64 + wn * 32 + (wi - 32));
    }
    case 5: {
      int hh = r / 2816, cc = r % 2816;
      int grp = cc >> 3, wi = cc & 7;
      return (wi < 4) ? (hh * 1408 + grp * 4 + wi) : (2816 + hh * 1408 + grp * 4 + (wi - 4));
    }
    default: return r;
  }
}

__device__ __forceinline__ void convert_item(const float* __restrict__ src, int K, int N, u16* __restrict__ dst, int which, int item, char* lds) {
  float* tile = (float*)lds;
  const int tid = opq(threadIdx.x);
  const int kb = K >> 8;
  const int r0 = (item / kb) * 64, k0 = (item % kb) * 256;
  lds_barrier();
  {
    const int n4 = (tid & 15) * 4, kk = tid >> 4;
    const int sc = srccol(which, r0 + n4);
    float4 v[8];
#pragma unroll
    for (int it = 0; it < 8; ++it) {
      const int k = kk + 32 * it;
      v[it] = (sc >= 0) ? *(const float4*)(src + (size_t)(k0 + k) * N + sc) : make_float4(0.f, 0.f, 0.f, 0.f);
    }
#pragma unroll
    for (int it = 0; it < 8; ++it) {
      const int k = kk + 32 * it;
      tile[(n4 + 0) * 257 + k] = v[it].x; tile[(n4 + 1) * 257 + k] = v[it].y;
      tile[(n4 + 2) * 257 + k] = v[it].z; tile[(n4 + 3) * 257 + k] = v[it].w;
    }
  }
  lds_barrier();
  {
    const int ks = (tid & 31) * 8, rr = tid >> 5;
#pragma unroll
    for (int it = 0; it < 4; ++it) {
      const int row = rr + 16 * it;
      float f[8];
#pragma unroll
      for (int e = 0; e < 8; ++e) f[e] = tile[row * 257 + ks + e];
      *(uint4*)(dst + (size_t)(r0 + row) * K + k0 + ks) = pack8(f);
    }
  }
}

__device__ __forceinline__ void mod_item(const Params& P, int item, char* lds) {
  float* sc = (float*)lds;
  float* red = sc + 5 * 1024;
  const int tid = opq(threadIdx.x);
  lds_barrier();
  for (int i = tid; i < 5 * 1024; i += NT) {
    const int r = i >> 10, k = i & 1023;
    float v = (r < 4) ? P.c[r * 1024 + k] : P.c_ctx[k];
    sc[i] = v * sigm(v);
  }
  lds_barrier();
  const int nn = tid & 31, kg = tid >> 5;
  const int n = item * 32 + nn;
  float a0 = 0, a1 = 0, a2 = 0, a3 = 0, a4 = 0;
  for (int kk = 0; kk < 64; ++kk) {
    const int k = kg * 64 + kk;
    const float wv = P.w_ada[(size_t)k * 6144 + n];
    a0 += sc[k] * wv; a1 += sc[1024 + k] * wv; a2 += sc[2048 + k] * wv; a3 += sc[3072 + k] * wv; a4 += sc[4096 + k] * wv;
  }
  red[(kg * 5 + 0) * 32 + nn] = a0; red[(kg * 5 + 1) * 32 + nn] = a1; red[(kg * 5 + 2) * 32 + nn] = a2;
  red[(kg * 5 + 3) * 32 + nn] = a3; red[(kg * 5 + 4) * 32 + nn] = a4;
  lds_barrier();
  if (tid < 160) {
    const int r = tid >> 5, n2 = tid & 31;
    float s = 0.f;
#pragma unroll
    for (int g = 0; g < 16; ++g) s += red[(g * 5 + r) * 32 + n2];
    float* MOD = (float*)(P.ws + OFF_MOD);
    MOD[r * 6144 + item * 32 + n2] = s + P.b_ada[item * 32 + n2];
  }
}

__device__ __forceinline__ void lam_pow(float step, float are, float aim, int e, float& pr, float& pi) {
  const float mag = expf((float)e * step * are);
  double ang = (double)e * (double)step * (double)aim;
  ang -= 6.283185307179586476925 * rint(ang * 0.15915494309189533577);
  float s, c;
  __sincosf((float)ang, &s, &c);
  pr = mag * c; pi = mag * s;
}

__device__ __forceinline__ void s5tab_item(const Params& P, int item, char* lds) {
  const int tid = opq(threadIdx.x);
  const int tq = item & 7, g = (item >> 3) & 31, r = item >> 8;
  float* cfr = (float*)lds;
  float* cfi = cfr + 64;
  float* p0r = cfi + 64;
  float* p0i = p0r + 64;
  float* p1r = p0i + 64;
  float* p1i = p1r + 64;
  float* Gr = p1i + 64;
  float* Gi = Gr + 1024;
  float* Cr = Gi + 1024;
  float* Ci = Cr + 1024;
  const int rg = r * 32 + g;
  u16* MEND = (u16*)(P.ws + OFF_MEND);
  u16* MST = (u16*)(P.ws + OFF_MST);
  float* KTAB = (float*)(P.ws + OFF_KTAB);
  lds_barrier();
  float step = 0.f, are = 0.f, aim = 0.f;
  if (tid < 64) {
    const int n = tid;
    step = expf(P.s5_log_step[rg]);
    are = P.s5_a_re[rg * 64 + n]; aim = P.s5_a_im[rg * 64 + n];
    const float za = step * are;
    double zb = (double)step * (double)aim;
    zb -= 6.283185307179586476925 * rint(zb * 0.15915494309189533577);
    float sb, cb, sh, ch;
    __sincosf((float)zb, &sb, &cb);
    __sincosf((float)(0.5 * zb), &sh, &ch);
    const float em1 = expm1f(za);
    const float re1 = em1 * cb - 2.f * sh * sh;
    const float im1 = (1.f + em1) * sb;
    const float den = are * are + aim * aim;
    cfr[n] = (re1 * are + im1 * aim) / den;
    cfi[n] = (im1 * are - re1 * aim) / den;
  }
  for (int i = tid; i < 1024; i += NT) {
    Cr[i] = P.s5_c_re[(size_t)rg * 1024 + i];
    Ci[i] = P.s5_c_im[(size_t)rg * 1024 + i];
  }
  const float br0 = P.s5_b_re[(size_t)rg * 1024 + tid], bi0 = P.s5_b_im[(size_t)rg * 1024 + tid];
  const float br1 = P.s5_b_re[(size_t)rg * 1024 + 512 + tid], bi1 = P.s5_b_im[(size_t)rg * 1024 + 512 + tid];
  for (int t4 = 0; t4 < 4; ++t4) {
    const int tau = tq * 4 + t4;
    if (tid < 64) {
      float pr, pi;
      lam_pow(step, are, aim, tau, pr, pi);
      p0r[tid] = pr; p0i[tid] = pi;
      lam_pow(step, are, aim, tau + 1, pr, pi);
      p1r[tid] = pr; p1i[tid] = pi;
    }
    lds_barrier();
    {
      const int i0 = tid, n0 = i0 >> 4;
      float tr = cfr[n0] * br0 - cfi[n0] * bi0, ti = cfr[n0] * bi0 + cfi[n0] * br0;
      Gr[i0] = p0r[n0] * tr - p0i[n0] * ti;
      Gi[i0] = p0r[n0] * ti + p0i[n0] * tr;
      const int i1 = tid + 512, n1 = i1 >> 4;
      tr = cfr[n1] * br1 - cfi[n1] * bi1; ti = cfr[n1] * bi1 + cfi[n1] * br1;
      Gr[i1] = p0r[n1] * tr - p0i[n1] * ti;
      Gi[i1] = p0r[n1] * ti + p0i[n1] * tr;
    }
    lds_barrier();
    {
      const int ii = (r == 0) ? (31 - tau) : tau;
      for (int i = tid; i < 2048; i += NT) {
        const int part = i >> 10, n = (i >> 4) & 63, pi_ = i & 15;
        const float v = part ? Gi[n * 16 + pi_] : Gr[n * 16 + pi_];
        MEND[((size_t)g * 256 + r * 128 + part * 64 + n) * 512 + ii * 16 + pi_] = f2bf(v);
      }
    }
    if (tid < 256) {
      const int po = tid >> 4, pi_ = tid & 15;
      float s = 0.f;
      for (int n = 0; n < 64; ++n) s += Cr[po * 64 + n] * Gr[n * 16 + pi_] - Ci[po * 64 + n] * Gi[n * 16 + pi_];
      KTAB[(((size_t)rg) * 32 + tau) * 256 + tid] = s;
    }
    {
      const int jj = (r == 0) ? tau : (31 - tau);
      for (int i = tid; i < 2048; i += NT) {
        const int po = i >> 7, part = (i >> 6) & 1, n = i & 63;
        const float cr = Cr[po * 64 + n], ci = Ci[po * 64 + n];
        const float v = part ? -(cr * p1i[n] + ci * p1r[n]) : (cr * p1r[n] - ci * p1i[n]);
        MST[((size_t)g * 512 + jj * 16 + po) * 256 + r * 128 + part * 64 + n] = f2bf(v);
      }
    }
    lds_barrier();
  }
}

__device__ __forceinline__ void norm_row(const float* __restrict__ xr, const float* __restrict__ nw, const float* __restrict__ shift,
                                         const float* __restrict__ scale, u16* __restrict__ dst, int lane) {
  float4 v[4];
  float ss = 0.f;
#pragma unroll
  for (int it = 0; it < 4; ++it) {
    v[it] = *(const float4*)(xr + (it * 64 + lane) * 4);
    ss += v[it].x * v[it].x + v[it].y * v[it].y + v[it].z * v[it].z + v[it].w * v[it].w;
  }
  ss = wsum64(ss);
  const float rstd = rsqrtf(ss * (1.f / 1024.f) + 1e-6f);
#pragma unroll
  for (int it = 0; it < 4; ++it) {
    const int c = (it * 64 + lane) * 4;
    const float4 w4 = *(const float4*)(nw + c), sh = *(const float4*)(shift + c), sc = *(const float4*)(scale + c);
    const float y0 = v[it].x * rstd * w4.x * (1.f + sc.x) + sh.x;
    const float y1 = v[it].y * rstd * w4.y * (1.f + sc.y) + sh.y;
    const float y2 = v[it].z * rstd * w4.z * (1.f + sc.z) + sh.z;
    const float y3 = v[it].w * rstd * w4.w * (1.f + sc.w) + sh.w;
    uint2 o; o.x = pack2(y0, y1); o.y = pack2(y2, y3);
    *(uint2*)(dst + c) = o;
  }
}

__device__ __forceinline__ void norm_row2(const float* __restrict__ xa, const float* __restrict__ xb, const float* __restrict__ nw,
                                          const float* __restrict__ shA, const float* __restrict__ scA,
                                          const float* __restrict__ shB, const float* __restrict__ scB,
                                          u16* __restrict__ da, u16* __restrict__ db, int lane) {
  float4 va[4], vb[4];
#pragma unroll
  for (int it = 0; it < 4; ++it) { va[it] = *(const float4*)(xa + (it * 64 + lane) * 4); vb[it] = *(const float4*)(xb + (it * 64 + lane) * 4); }
  float sa = 0.f, sb = 0.f;
#pragma unroll
  for (int it = 0; it < 4; ++it) {
    sa += va[it].x * va[it].x + va[it].y * va[it].y + va[it].z * va[it].z + va[it].w * va[it].w;
    sb += vb[it].x * vb[it].x + vb[it].y * vb[it].y + vb[it].z * vb[it].z + vb[it].w * vb[it].w;
  }
  sa = wsum64(sa); sb = wsum64(sb);
  const float ra = rsqrtf(sa * (1.f / 1024.f) + 1e-6f), rb = rsqrtf(sb * (1.f / 1024.f) + 1e-6f);
#pragma unroll
  for (int it = 0; it < 4; ++it) {
    const int c = (it * 64 + lane) * 4;
    const float4 w4 = *(const float4*)(nw + c);
    const float4 sh = *(const float4*)(shA + c), sc = *(const float4*)(scA + c);
    const float4 sh2 = *(const float4*)(shB + c), sc2 = *(const float4*)(scB + c);
    uint2 o;
    o.x = pack2(va[it].x * ra * w4.x * (1.f + sc.x) + sh.x, va[it].y * ra * w4.y * (1.f + sc.y) + sh.y);
    o.y = pack2(va[it].z * ra * w4.z * (1.f + sc.z) + sh.z, va[it].w * ra * w4.w * (1.f + sc.w) + sh.w);
    *(uint2*)(da + c) = o;
    o.x = pack2(vb[it].x * rb * w4.x * (1.f + sc2.x) + sh2.x, vb[it].y * rb * w4.y * (1.f + sc2.y) + sh2.y);
    o.y = pack2(vb[it].z * rb * w4.z * (1.f + sc2.z) + sh2.z, vb[it].w * rb * w4.w * (1.f + sc2.w) + sh2.w);
    *(uint2*)(db + c) = o;
  }
}

__device__ __forceinline__ void norm1_item(const Params& P, int item) {
  const int lane = opq(threadIdx.x) & 63, w = opq(threadIdx.x) >> 6;
  const int rowA = item * 16 + w, rowB = rowA + 8;
  const float* MOD = (const float*)(P.ws + OFF_MOD);
  const int ba = (rowA < 16384) ? (rowA >> 12) : 4, bb = (rowB < 16384) ? (rowB >> 12) : 4;
  const float* xa = (rowA < 16384) ? (P.x + (size_t)rowA * 1024) : (P.ctx + (size_t)(rowA - 16384) * 1024);
  const float* xb = (rowB < 16384) ? (P.x + (size_t)rowB * 1024) : (P.ctx + (size_t)(rowB - 16384) * 1024);
  u16* H = (u16*)(P.ws + OFF_R2);
  norm_row2(xa, xb, P.norm1_w, MOD + ba * 6144, MOD + ba * 6144 + 1024, MOD + bb * 6144, MOD + bb * 6144 + 1024,
            H + (size_t)rowA * 1024, H + (size_t)rowB * 1024, lane);
}

__device__ __forceinline__ void mintra_item(const Params& P, int item) {
  const int tid = opq(threadIdx.x);
  const int rowg = item * 8 + (tid >> 6);
  const int g = rowg >> 9, nout = rowg & 511, j = nout >> 4, po = nout & 15;
  const int k0 = (tid & 63) * 8, i = k0 >> 4, pi0 = k0 & 15;
  const float* KTAB = (const float*)(P.ws + OFF_KTAB);
  float f[8];
#pragma unroll
  for (int e = 0; e < 8; ++e) f[e] = 0.f;
  if (i <= j) {
    const float* kp = KTAB + (((size_t)(0 * 32 + g)) * 32 + (j - i)) * 256 + po * 16 + pi0;
#pragma unroll
    for (int e = 0; e < 8; ++e) f[e] += kp[e];
  }
  if (i >= j) {
    const float* kp = KTAB + (((size_t)(1 * 32 + g)) * 32 + (i - j)) * 256 + po * 16 + pi0;
#pragma unroll
    for (int e = 0; e < 8; ++e) f[e] += kp[e];
  }
  if (i == j) {
    const float dv = P.s5_d[g * 16 + po];
#pragma unroll
    for (int e = 0; e < 8; ++e) if (pi0 + e == po) f[e] += dv;
  }
  u16* MI = (u16*)(P.ws + OFF_MINTRA);
  *(uint4*)(MI + (size_t)rowg * 512 + k0) = pack8(f);
}

__device__ __forceinline__ void inproj_tile(const Params& P, int t, char* lds) {
  int mt, nt;
  if (t < 1024) tile_map8(t, nt, mt);
  else if (t < 1344) { nt = t / 64; mt = t % 64; }
  else {
    const int tt = t - 1344; mt = 64 + (tt & 3);
    const int ni = tt >> 2;
    nt = (ni < 8) ? (4 + ni) : ((ni < 12) ? (16 + ni - 8) : 20);
  }
  const int m0 = mt * 256, n0 = nt * 128;
  f32x16 acc[2][2];
  acc_zero(acc);
  gemm_main((const u16*)(P.ws + OFF_R2) + (size_t)m0 * 1024, 1024, (const u16*)(P.ws + OFF_WT_IN) + (size_t)n0 * 1024, 1024, 1024, acc, (u16*)lds);
  TILE_COORDS
  if (nt < 12) {
    u16* QKV = (u16*)(P.ws + OFF_R3);
#pragma unroll
    for (int i = 0; i < 2; ++i)
#pragma unroll
      for (int j = 0; j < 2; ++j)
#pragma unroll
        for (int e = 0; e < 16; ++e) QKV[TIDX(m0, n0, i, j, e, 1536)] = f2bf(acc[i][j][e]);
  } else if (nt < 16) {
    u16* Z = (u16*)(P.ws + OFF_Z);
#pragma unroll
    for (int i = 0; i < 2; ++i)
#pragma unroll
      for (int j = 0; j < 2; ++j)
#pragma unroll
        for (int e = 0; e < 16; ++e) Z[TIDX(m0, n0, i, j, e, 512) - 1536] = f2bf(acc[i][j][e]);
  } else if (nt < 20) {
    u16* U5 = (u16*)(P.ws + OFF_U5);
#pragma unroll
    for (int i = 0; i < 2; ++i)
#pragma unroll
      for (int j = 0; j < 2; ++j)
#pragma unroll
        for (int e = 0; e < 16; ++e) {
          const int cc = TCOL(n0, j) - 2048;
          U5[((size_t)(cc >> 4) * 17408 + TROW(m0, i, e)) * 16 + (cc & 15)] = f2bf(acc[i][j][e]);
        }
  } else {
    float* BA = (float*)(P.ws + OFF_BA);
#pragma unroll
    for (int i = 0; i < 2; ++i)
#pragma unroll
      for (int j = 0; j < 2; ++j)
#pragma unroll
        for (int e = 0; e < 16; ++e) {
          const int cc = TCOL(n0, j) - 2560;
          if (cc < 16) BA[(size_t)TROW(m0, i, e) * 16 + cc] = acc[i][j][e];
        }
  }
}

__device__ __forceinline__ void solve_elim(float (&sol)[64], const float* Lr) {
  float4 b0a, b0b, b0c, b0d, b1a, b1b, b1c, b1d, b2a, b2b, b2c, b2d;
  b0a = *(const float4*)(Lr + 0); b0b = *(const float4*)(Lr + 4); b0c = *(const float4*)(Lr + 8); b0d = *(const float4*)(Lr + 12);
  b1a = *(const float4*)(Lr + 16); b1b = *(const float4*)(Lr + 20); b1c = *(const float4*)(Lr + 24); b1d = *(const float4*)(Lr + 28);
  b2a = *(const float4*)(Lr + 32); b2b = *(const float4*)(Lr + 36); b2c = *(const float4*)(Lr + 40); b2d = *(const float4*)(Lr + 44);
  __builtin_amdgcn_sched_barrier(0);
  sol[1] -= b0a.y * sol[0]; sol[2] -= b0a.z * sol[0]; sol[3] -= b0a.w * sol[0]; sol[4] -= b0b.x * sol[0]; sol[5] -= b0b.y * sol[0]; sol[6] -= b0b.z * sol[0]; sol[7] -= b0b.w * sol[0]; sol[8] -= b0c.x * sol[0]; sol[9] -= b0c.y * sol[0]; sol[10] -= b0c.z * sol[0]; sol[11] -= b0c.w * sol[0]; sol[12] -= b0d.x * sol[0]; sol[13] -= b0d.y * sol[0]; sol[14] -= b0d.z * sol[0]; sol[15] -= b0d.w * sol[0];
  __builtin_amdgcn_sched_barrier(0);
  b0a = *(const float4*)(Lr + 48); b0b = *(const float4*)(Lr + 52); b0c = *(const float4*)(Lr + 56); b0d = *(const float4*)(Lr + 60);
  __builtin_amdgcn_sched_barrier(0);
  sol[16] -= b1a.x * sol[0]; sol[17] -= b1a.y * sol[0]; sol[18] -= b1a.z * sol[0]; sol[19] -= b1a.w * sol[0]; sol[20] -= b1b.x * sol[0]; sol[21] -= b1b.y * sol[0]; sol[22] -= b1b.z * sol[0]; sol[23] -= b1b.w * sol[0]; sol[24] -= b1c.x * sol[0]; sol[25] -= b1c.y * sol[0]; sol[26] -= b1c.z * sol[0]; sol[27] -= b1c.w * sol[0]; sol[28] -= b1d.x * sol[0]; sol[29] -= b1d.y * sol[0]; sol[30] -= b1d.z * sol[0]; sol[31] -= b1d.w * sol[0];
  __builtin_amdgcn_sched_barrier(0);
  b1a = *(const float4*)(Lr + 64); b1b = *(const float4*)(Lr + 68); b1c = *(const float4*)(Lr + 72); b1d = *(const float4*)(Lr + 76);
  __builtin_amdgcn_sched_barrier(0);
  sol[32] -= b2a.x * sol[0]; sol[33] -= b2a.y * sol[0]; sol[34] -= b2a.z * sol[0]; sol[35] -= b2a.w * sol[0]; sol[36] -= b2b.x * sol[0]; sol[37] -= b2b.y * sol[0]; sol[38] -= b2b.z * sol[0]; sol[39] -= b2b.w * sol[0]; sol[40] -= b2c.x * sol[0]; sol[41] -= b2c.y * sol[0]; sol[42] -= b2c.z * sol[0]; sol[43] -= b2c.w * sol[0]; sol[44] -= b2d.x * sol[0]; sol[45] -= b2d.y * sol[0]; sol[46] -= b2d.z * sol[0]; sol[47] -= b2d.w * sol[0];
  __builtin_amdgcn_sched_barrier(0);
  b2a = *(const float4*)(Lr + 80); b2b = *(const float4*)(Lr + 84); b2c = *(const float4*)(Lr + 88); b2d = *(const float4*)(Lr + 92);
  __builtin_amdgcn_sched_barrier(0);
  sol[48] -= b0a.x * sol[0]; sol[49] -= b0a.y * sol[0]; sol[50] -= b0a.z * sol[0]; sol[51] -= b0a.w * sol[0]; sol[52] -= b0b.x * sol[0]; sol[53] -= b0b.y * sol[0]; sol[54] -= b0b.z * sol[0]; sol[55] -= b0b.w * sol[0]; sol[56] -= b0c.x * sol[0]; sol[57] -= b0c.y * sol[0]; sol[58] -= b0c.z * sol[0]; sol[59] -= b0c.w * sol[0]; sol[60] -= b0d.x * sol[0]; sol[61] -= b0d.y * sol[0]; sol[62] -= b0d.z * sol[0]; sol[63] -= b0d.w * sol[0];
  __builtin_amdgcn_sched_barrier(0);
  b0a = *(const float4*)(Lr + 96); b0b = *(const float4*)(Lr + 100); b0c = *(const float4*)(Lr + 104); b0d = *(const float4*)(Lr + 108);
  __builtin_amdgcn_sched_barrier(0);
  sol[2] -= b1a.z * sol[1]; sol[3] -= b1a.w * sol[1]; sol[4] -= b1b.x * sol[1]; sol[5] -= b1b.y * sol[1]; sol[6] -= b1b.z * sol[1]; sol[7] -= b1b.w * sol[1]; sol[8] -= b1c.x * sol[1]; sol[9] -= b1c.y * sol[1]; sol[10] -= b1c.z * sol[1]; sol[11] -= b1c.w * sol[1]; sol[12] -= b1d.x * sol[1]; sol[13] -= b1d.y * sol[1]; sol[14] -= b1d.z * sol[1]; sol[15] -= b1d.w * sol[1];
  __builtin_amdgcn_sched_barrier(0);
  b1a = *(const float4*)(Lr + 112); b1b = *(const float4*)(Lr + 116); b1c = *(const float4*)(Lr + 120); b1d = *(const float4*)(Lr + 124);
  __builtin_amdgcn_sched_barrier(0);
  sol[16] -= b2a.x * sol[1]; sol[17] -= b2a.y * sol[1]; sol[18] -= b2a.z * sol[1]; sol[19] -= b2a.w * sol[1]; sol[20] -= b2b.x * sol[1]; sol[21] -= b2b.y * sol[1]; sol[22] -= b2b.z * sol[1]; sol[23] -= b2b.w * sol[1]; sol[24] -= b2c.x * sol[1]; sol[25] -= b2c.y * sol[1]; sol[26] -= b2c.z * sol[1]; sol[27] -= b2c.w * sol[1]; sol[28] -= b2d.x * sol[1]; sol[29] -= b2d.y * sol[1]; sol[30] -= b2d.z * sol[1]; sol[31] -= b2d.w * sol[1];
  __builtin_amdgcn_sched_barrier(0);
  b2a = *(const float4*)(Lr + 128); b2b = *(const float4*)(Lr + 132); b2c = *(const float4*)(Lr + 136); b2d = *(const float4*)(Lr + 140);
  __builtin_amdgcn_sched_barrier(0);
  sol[32] -= b0a.x * sol[1]; sol[33] -= b0a.y * sol[1]; sol[34] -= b0a.z * sol[1]; sol[35] -= b0a.w * sol[1]; sol[36] -= b0b.x * sol[1]; sol[37] -= b0b.y * sol[1]; sol[38] -= b0b.z * sol[1]; sol[39] -= b0b.w * sol[1]; sol[40] -= b0c.x * sol[1]; sol[41] -= b0c.y * sol[1]; sol[42] -= b0c.z * sol[1]; sol[43] -= b0c.w * sol[1]; sol[44] -= b0d.x * sol[1]; sol[45] -= b0d.y * sol[1]; sol[46] -= b0d.z * sol[1]; sol[47] -= b0d.w * sol[1];
  __builtin_amdgcn_sched_barrier(0);
  b0a = *(const float4*)(Lr + 144); b0b = *(const float4*)(Lr + 148); b0c = *(const float4*)(Lr + 152); b0d = *(const float4*)(Lr + 156);
  __builtin_amdgcn_sched_barrier(0);
  sol[48] -= b1a.x * sol[1]; sol[49] -= b1a.y * sol[1]; sol[50] -= b1a.z * sol[1]; sol[51] -= b1a.w * sol[1]; sol[52] -= b1b.x * sol[1]; sol[53] -= b1b.y * sol[1]; sol[54] -= b1b.z * sol[1]; sol[55] -= b1b.w * sol[1]; sol[56] -= b1c.x * sol[1]; sol[57] -= b1c.y * sol[1]; sol[58] -= b1c.z * sol[1]; sol[59] -= b1c.w * sol[1]; sol[60] -= b1d.x * sol[1]; sol[61] -= b1d.y * sol[1]; sol[62] -= b1d.z * sol[1]; sol[63] -= b1d.w * sol[1];
  __builtin_amdgcn_sched_barrier(0);
  b1a = *(const float4*)(Lr + 160); b1b = *(const float4*)(Lr + 164); b1c = *(const float4*)(Lr + 168); b1d = *(const float4*)(Lr + 172);
  __builtin_amdgcn_sched_barrier(0);
  sol[3] -= b2a.w * sol[2]; sol[4] -= b2b.x * sol[2]; sol[5] -= b2b.y * sol[2]; sol[6] -= b2b.z * sol[2]; sol[7] -= b2b.w * sol[2]; sol[8] -= b2c.x * sol[2]; sol[9] -= b2c.y * sol[2]; sol[10] -= b2c.z * sol[2]; sol[11] -= b2c.w * sol[2]; sol[12] -= b2d.x * sol[2]; sol[13] -= b2d.y * sol[2]; sol[14] -= b2d.z * sol[2]; sol[15] -= b2d.w * sol[2];
  __builtin_amdgcn_sched_barrier(0);
  b2a = *(const float4*)(Lr + 176); b2b = *(const float4*)(Lr + 180); b2c = *(const float4*)(Lr + 184); b2d = *(const float4*)(Lr + 188);
  __builtin_amdgcn_sched_barrier(0);
  sol[16] -= b0a.x * sol[2]; sol[17] -= b0a.y * sol[2]; sol[18] -= b0a.z * sol[2]; sol[19] -= b0a.w * sol[2]; sol[20] -= b0b.x * sol[2]; sol[21] -= b0b.y * sol[2]; sol[22] -= b0b.z * sol[2]; sol[23] -= b0b.w * sol[2]; sol[24] -= b0c.x * sol[2]; sol[25] -= b0c.y * sol[2]; sol[26] -= b0c.z * sol[2]; sol[27] -= b0c.w * sol[2]; sol[28] -= b0d.x * sol[2]; sol[29] -= b0d.y * sol[2]; sol[30] -= b0d.z * sol[2]; sol[31] -= b0d.w * sol[2];
  __builtin_amdgcn_sched_barrier(0);
  b0a = *(const float4*)(Lr + 192); b0b = *(const float4*)(Lr + 196); b0c = *(const float4*)(Lr + 200); b0d = *(const float4*)(Lr + 204);
  __builtin_amdgcn_sched_barrier(0);
  sol[32] -= b1a.x * sol[2]; sol[33] -= b1a.y * sol[2]; sol[34] -= b1a.z * sol[2]; sol[35] -= b1a.w * sol[2]; sol[36] -= b1b.x * sol[2]; sol[37] -= b1b.y * sol[2]; sol[38] -= b1b.z * sol[2]; sol[39] -= b1b.w * sol[2]; sol[40] -= b1c.x * sol[2]; sol[41] -= b1c.y * sol[2]; sol[42] -= b1c.z * sol[2]; sol[43] -= b1c.w * sol[2]; sol[44] -= b1d.x * sol[2]; sol[45] -= b1d.y * sol[2]; sol[46] -= b1d.z * sol[2]; sol[47] -= b1d.w * sol[2];
  __builtin_amdgcn_sched_barrier(0);
  b1a = *(const float4*)(Lr + 208); b1b = *(const float4*)(Lr + 212); b1c = *(const float4*)(Lr + 216); b1d = *(const float4*)(Lr + 220);
  __builtin_amdgcn_sched_barrier(0);
  sol[48] -= b2a.x * sol[2]; sol[49] -= b2a.y * sol[2]; sol[50] -= b2a.z * sol[2]; sol[51] -= b2a.w * sol[2]; sol[52] -= b2b.x * sol[2]; sol[53] -= b2b.y * sol[2]; sol[54] -= b2b.z * sol[2]; sol[55] -= b2b.w * sol[2]; sol[56] -= b2c.x * sol[2]; sol[57] -= b2c.y * sol[2]; sol[58] -= b2c.z * sol[2]; sol[59] -= b2c.w * sol[2]; sol[60] -= b2d.x * sol[2]; sol[61] -= b2d.y * sol[2]; sol[62] -= b2d.z * sol[2]; sol[63] -= b2d.w * sol[2];
  __builtin_amdgcn_sched_barrier(0);
  b2a = *(const float4*)(Lr + 224); b2b = *(const float4*)(Lr + 228); b2c = *(const float4*)(Lr + 232); b2d = *(const float4*)(Lr + 236);
  __builtin_amdgcn_sched_barrier(0);
  sol[4] -= b0b.x * sol[3]; sol[5] -= b0b.y * sol[3]; sol[6] -= b0b.z * sol[3]; sol[7] -= b0b.w * sol[3]; sol[8] -= b0c.x * sol[3]; sol[9] -= b0c.y * sol[3]; sol[10] -= b0c.z * sol[3]; sol[11] -= b0c.w * sol[3]; sol[12] -= b0d.x * sol[3]; sol[13] -= b0d.y * sol[3]; sol[14] -= b0d.z * sol[3]; sol[15] -= b0d.w * sol[3];
  __builtin_amdgcn_sched_barrier(0);
  b0a = *(const float4*)(Lr + 240); b0b = *(const float4*)(Lr + 244); b0c = *(const float4*)(Lr + 248); b0d = *(const float4*)(Lr + 252);
  __builtin_amdgcn_sched_barrier(0);
  sol[16] -= b1a.x * sol[3]; sol[17] -= b1a.y * sol[3]; sol[18] -= b1a.z * sol[3]; sol[19] -= b1a.w * sol[3]; sol[20] -= b1b.x * sol[3]; sol[21] -= b1b.y * sol[3]; sol[22] -= b1b.z * sol[3]; sol[23] -= b1b.w * sol[3]; sol[24] -= b1c.x * sol[3]; sol[25] -= b1c.y * sol[3]; sol[26] -= b1c.z * sol[3]; sol[27] -= b1c.w * sol[3]; sol[28] -= b1d.x * sol[3]; sol[29] -= b1d.y * sol[3]; sol[30] -= b1d.z * sol[3]; sol[31] -= b1d.w * sol[3];
  __builtin_amdgcn_sched_barrier(0);
  b1a = *(const float4*)(Lr + 256); b1b = *(const float4*)(Lr + 260); b1c = *(const float4*)(Lr + 264); b1d = *(const float4*)(Lr + 268);
  __builtin_amdgcn_sched_barrier(0);
  sol[32] -= b2a.x * sol[3]; sol[33] -= b2a.y * sol[3]; sol[34] -= b2a.z * sol[3]; sol[35] -= b2a.w * sol[3]; sol[36] -= b2b.x * sol[3]; sol[37] -= b2b.y * sol[3]; sol[38] -= b2b.z * sol[3]; sol[39] -= b2b.w * sol[3]; sol[40] -= b2c.x * sol[3]; sol[41] -= b2c.y * sol[3]; sol[42] -= b2c.z * sol[3]; sol[43] -= b2c.w * sol[3]; sol[44] -= b2d.x * sol[3]; sol[45] -= b2d.y * sol[3]; sol[46] -= b2d.z * sol[3]; sol[47] -= b2d.w * sol[3];
  __builtin_amdgcn_sched_barrier(0);
  b2a = *(const float4*)(Lr + 272); b2b = *(const float4*)(Lr + 276); b2c = *(const float4*)(Lr + 280); b2d = *(const float4*)(Lr + 284);
  __builtin_amdgcn_sched_barrier(0);
  sol[48] -= b0a.x * sol[3]; sol[49] -= b0a.y * sol[3]; sol[50] -= b0a.z * sol[3]; sol[51] -= b0a.w * sol[3]; sol[52] -= b0b.x * sol[3]; sol[53] -= b0b.y * sol[3]; sol[54] -= b0b.z * sol[3]; sol[55] -= b0b.w * sol[3]; sol[56] -= b0c.x * sol[3]; sol[57] -= b0c.y * sol[3]; sol[58] -= b0c.z * sol[3]; sol[59] -= b0c.w * sol[3]; sol[60] -= b0d.x * sol[3]; sol[61] -= b0d.y * sol[3]; sol[62] -= b0d.z * sol[3]; sol[63] -= b0d.w * sol[3];
  __builtin_amdgcn_sched_barrier(0);
  b0a = *(const float4*)(Lr + 288); b0b = *(const float4*)(Lr + 292); b0c = *(const float4*)(Lr + 296); b0d = *(const float4*)(Lr + 300);
  __builtin_amdgcn_sched_barrier(0);
  sol[5] -= b1b.y * sol[4]; sol[6] -= b1b.z * sol[4]; sol[7] -= b1b.w * sol[4]; sol[8] -= b1c.x * sol[4]; sol[9] -= b1c.y * sol[4]; sol[10] -= b1c.z * sol[4]; sol[11] -= b1c.w * sol[4]; sol[12] -= b1d.x * sol[4]; sol[13] -= b1d.y * sol[4]; sol[14] -= b1d.z * sol[4]; sol[15] -= b1d.w * sol[4];
  __builtin_amdgcn_sched_barrier(0);
  b1a = *(const float4*)(Lr + 304); b1b = *(const float4*)(Lr + 308); b1c = *(const float4*)(Lr + 312); b1d = *(const float4*)(Lr + 316);
  __builtin_amdgcn_sched_barrier(0);
  sol[16] -= b2a.x * sol[4]; sol[17] -= b2a.y * sol[4]; sol[18] -= b2a.z * sol[4]; sol[19] -= b2a.w * sol[4]; sol[20] -= b2b.x * sol[4]; sol[21] -= b2b.y * sol[4]; sol[22] -= b2b.z * sol[4]; sol[23] -= b2b.w * sol[4]; sol[24] -= b2c.x * sol[4]; sol[25] -= b2c.y * sol[4]; sol[26] -= b2c.z * sol[4]; sol[27] -= b2c.w * sol[4]; sol[28] -= b2d.x * sol[4]; sol[29] -= b2d.y * sol[4]; sol[30] -= b2d.z * sol[4]; sol[31] -= b2d.w * sol[4];
  __builtin_amdgcn_sched_barrier(0);
  b2a = *(const float4*)(Lr + 320); b2b = *(const float4*)(Lr + 324); b2c = *(const float4*)(Lr + 328); b2d = *(const float4*)(Lr + 332);
  __builtin_amdgcn_sched_barrier(0);
  sol[32] -= b0a.x * sol[4]; sol[33] -= b0a.y * sol[4]; sol[34] -= b0a.z * sol[4]; sol[35] -= b0a.w * sol[4]; sol[36] -= b0b.x * sol[4]; sol[37] -= b0b.y * sol[4]; sol[38] -= b0b.z * sol[4]; sol[39] -= b0b.w * sol[4]; sol[40] -= b0c.x * sol[4]; sol[41] -= b0c.y * sol[4]; sol[42] -= b0c.z * sol[4]; sol[43] -= b0c.w * sol[4]; sol[44] -= b0d.x * sol[4]; sol[45] -= b0d.y * sol[4]; sol[46] -= b0d.z * sol[4]; sol[47] -= b0d.w * sol[4];
  __builtin_amdgcn_sched_barrier(0);
  b0a = *(const float4*)(Lr + 336); b0b = *(const float4*)(Lr + 340); b0c = *(const float4*)(Lr + 344); b0d = *(const float4*)(Lr + 348);
  __builtin_amdgcn_sched_barrier(0);
  sol[48] -= b1a.x * sol[4]; sol[49] -= b1a.y * sol[4]; sol[50] -= b1a.z * sol[4]; sol[51] -= b1a.w * sol[4]; sol[52] -= b1b.x * sol[4]; sol[53] -= b1b.y * sol[4]; sol[54] -= b1b.z * sol[4]; sol[55] -= b1b.w * sol[4]; sol[56] -= b1c.x * sol[4]; sol[57] -= b1c.y * sol[4]; sol[58] -= b1c.z * sol[4]; sol[59] -= b1c.w * sol[4]; sol[60] -= b1d.x * sol[4]; sol[61] -= b1d.y * sol[4]; sol[62] -= b1d.z * sol[4]; sol[63] -= b1d.w * sol[4];
  __builtin_amdgcn_sched_barrier(0);
  b1a = *(const float4*)(Lr + 352); b1b = *(const float4*)(Lr + 356); b1c = *(const float4*)(Lr + 360); b1d = *(const float4*)(Lr + 364);
  __builtin_amdgcn_sched_barrier(0);
  sol[6] -= b2b.z * sol[5]; sol[7] -= b2b.w * sol[5]; sol[8] -= b2c.x * sol[5]; sol[9] -= b2c.y * sol[5]; sol[10] -= b2c.z * sol[5]; sol[11] -= b2c.w * sol[5]; sol[12] -= b2d.x * sol[5]; sol[13] -= b2d.y * sol[5]; sol[14] -= b2d.z * sol[5]; sol[15] -= b2d.w * sol[5];
  __builtin_amdgcn_sched_barrier(0);
  b2a = *(const float4*)(Lr + 368); b2b = *(const float4*)(Lr + 372); b2c = *(const float4*)(Lr + 376); b2d = *(const float4*)(Lr + 380);
  __builtin_amdgcn_sched_barrier(0);
  sol[16] -= b0a.x * sol[5]; sol[17] -= b0a.y * sol[5]; sol[18] -= b0a.z * sol[5]; sol[19] -= b0a.w * sol[5]; sol[20] -= b0b.x * sol[5]; sol[21] -= b0b.y * sol[5]; sol[22] -= b0b.z * sol[5]; sol[23] -= b0b.w * sol[5]; sol[24] -= b0c.x * sol[5]; sol[25] -= b0c.y * sol[5]; sol[26] -= b0c.z * sol[5]; sol[27] -= b0c.w * sol[5]; sol[28] -= b0d.x * sol[5]; sol[29] -= b0d.y * sol[5]; sol[30] -= b0d.z * sol[5]; sol[31] -= b0d.w * sol[5];
  __builtin_amdgcn_sched_barrier(0);
  b0a = *(const float4*)(Lr + 384); b0b = *(const float4*)(Lr + 388); b0c = *(const float4*)(Lr + 392); b0d = *(const float4*)(Lr + 396);
  __builtin_amdgcn_sched_barrier(0);
  sol[32] -= b1a.x * sol[5]; sol[33] -= b1a.y * sol[5]; sol[34] -= b1a.z * sol[5]; sol[35] -= b1a.w * sol[5]; sol[36] -= b1b.x * sol[5]; sol[37] -= b1b.y * sol[5]; sol[38] -= b1b.z * sol[5]; sol[39] -= b1b.w * sol[5]; sol[40] -= b1c.x * sol[5]; sol[41] -= b1c.y * sol[5]; sol[42] -= b1c.z * sol[5]; sol[43] -= b1c.w * sol[5]; sol[44] -= b1d.x * sol[5]; sol[45] -= b1d.y * sol[5]; sol[46] -= b1d.z * sol[5]; sol[47] -= b1d.w * sol[5];
  __builtin_amdgcn_sched_barrier(0);
  b1a = *(const float4*)(Lr + 400); b1b = *(const float4*)(Lr + 404); b1c = *(const float4*)(Lr + 408); b1d = *(const float4*)(Lr + 412);
  __builtin_amdgcn_sched_barrier(0);
  sol[48] -= b2a.x * sol[5]; sol[49] -= b2a.y * sol[5]; sol[50] -= b2a.z * sol[5]; sol[51] -= b2a.w * sol[5]; sol[52] -= b2b.x * sol[5]; sol[53] -= b2b.y * sol[5]; sol[54] -= b2b.z * sol[5]; sol[55] -= b2b.w * sol[5]; sol[56] -= b2c.x * sol[5]; sol[57] -= b2c.y * sol[5]; sol[58] -= b2c.z * sol[5]; sol[59] -= b2c.w * sol[5]; sol[60] -= b2d.x * sol[5]; sol[61] -= b2d.y * sol[5]; sol[62] -= b2d.z * sol[5]; sol[63] -= b2d.w * sol[5];
  __builtin_amdgcn_sched_barrier(0);
  b2a = *(const float4*)(Lr + 416); b2b = *(const float4*)(Lr + 420); b2c = *(const float4*)(Lr + 424); b2d = *(const float4*)(Lr + 428);
  __builtin_amdgcn_sched_barrier(0);
  sol[7] -= b0b.w * sol[6]; sol[8] -= b0c.x * sol[6]; sol[9] -= b0c.y * sol[6]; sol[10] -= b0c.z * sol[6]; sol[11] -= b0c.w * sol[6]; sol[12] -= b0d.x * sol[6]; sol[13] -= b0d.y * sol[6]; sol[14] -= b0d.z * sol[6]; sol[15] -= b0d.w * sol[6];
  __builtin_amdgcn_sched_barrier(0);
  b0a = *(const float4*)(Lr + 432); b0b = *(const float4*)(Lr + 436); b0c = *(const float4*)(Lr + 440); b0d = *(const float4*)(Lr + 444);
  __builtin_amdgcn_sched_barrier(0);
  sol[16] -= b1a.x * sol[6]; sol[17] -= b1a.y * sol[6]; sol[18] -= b1a.z * sol[6]; sol[19] -= b1a.w * sol[6]; sol[20] -= b1b.x * sol[6]; sol[21] -= b1b.y * sol[6]; sol[22] -= b1b.z * sol[6]; sol[23] -= b1b.w * sol[6]; sol[24] -= b1c.x * sol[6]; sol[25] -= b1c.y * sol[6]; sol[26] -= b1c.z * sol[6]; sol[27] -= b1c.w * sol[6]; sol[28] -= b1d.x * sol[6]; sol[29] -= b1d.y * sol[6]; sol[30] -= b1d.z * sol[6]; sol[31] -= b1d.w * sol[6];
  __builtin_amdgcn_sched_barrier(0);
  b1a = *(const float4*)(Lr + 448); b1b = *(const float4*)(Lr + 452); b1c = *(const float4*)(Lr + 456); b1d = *(const float4*)(Lr + 460);
  __builtin_amdgcn_sched_barrier(0);
  sol[32] -= b2a.x * sol[6]; sol[33] -= b2a.y * sol[6]; sol[34] -= b2a.z * sol[6]; sol[35] -= b2a.w * sol[6]; sol[36] -= b2b.x * sol[6]; sol[37] -= b2b.y * sol[6]; sol[38] -= b2b.z * sol[6]; sol[39] -= b2b.w * sol[6]; sol[40] -= b2c.x * sol[6]; sol[41] -= b2c.y * sol[6]; sol[42] -= b2c.z * sol[6]; sol[43] -= b2c.w * sol[6]; sol[44] -= b2d.x * sol[6]; sol[45] -= b2d.y * sol[6]; sol[46] -= b2d.z * sol[6]; sol[47] -= b2d.w * sol[6];
  __builtin_amdgcn_sched_barrier(0);
  b2a = *(const float4*)(Lr + 464); b2b = *(const float4*)(Lr + 468); b2c = *(const float4*)(Lr + 472); b2d = *(const float4*)(Lr + 476);
  __builtin_amdgcn_sched_barrier(0);
  sol[48] -= b0a.x * sol[6]; sol[49] -= b0a.y * sol[6]; sol[50] -= b0a.z * sol[6]; sol[51] -= b0a.w * sol[6]; sol[52] -= b0b.x * sol[6]; sol[53] -= b0b.y * sol[6]; sol[54] -= b0b.z * sol[6]; sol[55] -= b0b.w * sol[6]; sol[56] -= b0c.x * sol[6]; sol[57] -= b0c.y * sol[6]; sol[58] -= b0c.z * sol[6]; sol[59] -= b0c.w * sol[6]; sol[60] -= b0d.x * sol[6]; sol[61] -= b0d.y * sol[6]; sol[62] -= b0d.z * sol[6]; sol[63] -= b0d.w * sol[6];
  __builtin_amdgcn_sched_barrier(0);
  b0a = *(const float4*)(Lr + 480); b0b = *(const float4*)(Lr + 484); b0c = *(const float4*)(Lr + 488); b0d = *(const float4*)(Lr + 492);
  __builtin_amdgcn_sched_barrier(0);
  sol[8] -= b1c.x * sol[7]; sol[9] -= b1c.y * sol[7]; sol[10] -= b1c.z * sol[7]; sol[11] -= b1c.w * sol[7]; sol[12] -= b1d.x * sol[7]; sol[13] -= b1d.y * sol[7]; sol[14] -= b1d.z * sol[7]; sol[15] -= b1d.w * sol[7];
  __builtin_amdgcn_sched_barrier(0);
  b1a = *(const float4*)(Lr + 496); b1b = *(const float4*)(Lr + 500); b1c = *(const float4*)(Lr + 504); b1d = *(const float4*)(Lr + 508);
  __builtin_amdgcn_sched_barrier(0);
  sol[16] -= b2a.x * sol[7]; sol[17] -= b2a.y * sol[7]; sol[18] -= b2a.z * sol[7]; sol[19] -= b2a.w * sol[7]; sol[20] -= b2b.x * sol[7]; sol[21] -= b2b.y * sol[7]; sol[22] -= b2b.z * sol[7]; sol[23] -= b2b.w * sol[7]; sol[24] -= b2c.x * sol[7]; sol[25] -= b2c.y * sol[7]; sol[26] -= b2c.z * sol[7]; sol[27] -= b2c.w * sol[7]; sol[28] -= b2d.x * sol[7]; sol[29] -= b2d.y * sol[7]; sol[30] -= b2d.z * sol[7]; sol[31] -= b2d.w * sol[7];
  __builtin_amdgcn_sched_barrier(0);
  b2a = *(const float4*)(Lr + 512); b2b = *(const float4*)(Lr + 516); b2c = *(const float4*)(Lr + 520); b2d = *(const float4*)(Lr + 524);
  __builtin_amdgcn_sched_barrier(0);
  sol[32] -= b0a.x * sol[7]; sol[33] -= b0a.y * sol[7]; sol[34] -= b0a.z * sol[7]; sol[35] -= b0a.w * sol[7]; sol[36] -= b0b.x * sol[7]; sol[37] -= b0b.y * sol[7]; sol[38] -= b0b.z * sol[7]; sol[39] -= b0b.w * sol[7]; sol[40] -= b0c.x * sol[7]; sol[41] -= b0c.y * sol[7]; sol[42] -= b0c.z * sol[7]; sol[43] -= b0c.w * sol[7]; sol[44] -= b0d.x * sol[7]; sol[45] -= b0d.y * sol[7]; sol[46] -= b0d.z * sol[7]; sol[47] -= b0d.w * sol[7];
  __builtin_amdgcn_sched_barrier(0);
  b0a = *(const float4*)(Lr + 528); b0b = *(const float4*)(Lr + 532); b0c = *(const float4*)(Lr + 536); b0d = *(const float4*)(Lr + 540);
  __builtin_amdgcn_sched_barrier(0);
  sol[48] -= b1a.x * sol[7]; sol[49] -= b1a.y * sol[7]; sol[50] -= b1a.z * sol[7]; sol[51] -= b1a.w * sol[7]; sol[52] -= b1b.x * sol[7]; sol[53] -= b1b.y * sol[7]; sol[54] -= b1b.z * sol[7]; sol[55] -= b1b.w * sol[7]; sol[56] -= b1c.x * sol[7]; sol[57] -= b1c.y * sol[7]; sol[58] -= b1c.z * sol[7]; sol[59] -= b1c.w * sol[7]; sol[60] -= b1d.x * sol[7]; sol[61] -= b1d.y * sol[7]; sol[62] -= b1d.z * sol[7]; sol[63] -= b1d.w * sol[7];
  __builtin_amdgcn_sched_barrier(0);
  b1a = *(const float4*)(Lr + 544); b1b = *(const float4*)(Lr + 548); b1c = *(const float4*)(Lr + 552); b1d = *(const float4*)(Lr + 556);
  __builtin_amdgcn_sched_barrier(0);
  sol[9] -= b2c.y * sol[8]; sol[10] -= b2c.z * sol[8]; sol[11] -= b2c.w * sol[8]; sol[12] -= b2d.x * sol[8]; sol[13] -= b2d.y * sol[8]; sol[14] -= b2d.z * sol[8]; sol[15] -= b2d.w * sol[8];
  __builtin_amdgcn_sched_barrier(0);
  b2a = *(const float4*)(Lr + 560); b2b = *(const float4*)(Lr + 564); b2c = *(const float4*)(Lr + 568); b2d = *(const float4*)(Lr + 572);
  __builtin_amdgcn_sched_barrier(0);
  sol[16] -= b0a.x * sol[8]; sol[17] -= b0a.y * sol[8]; sol[18] -= b0a.z * sol[8]; sol[19] -= b0a.w * sol[8]; sol[20] -= b0b.x * sol[8]; sol[21] -= b0b.y * sol[8]; sol[22] -= b0b.z * sol[8]; sol[23] -= b0b.w * sol[8]; sol[24] -= b0c.x * sol[8]; sol[25] -= b0c.y * sol[8]; sol[26] -= b0c.z * sol[8]; sol[27] -= b0c.w * sol[8]; sol[28] -= b0d.x * sol[8]; sol[29] -= b0d.y * sol[8]; sol[30] -= b0d.z * sol[8]; sol[31] -= b0d.w * sol[8];
  __builtin_amdgcn_sched_barrier(0);
  b0a = *(const float4*)(Lr + 576); b0b = *(const float4*)(Lr + 580); b0c = *(const float4*)(Lr + 584); b0d = *(const float4*)(Lr + 588);
  __builtin_amdgcn_sched_barrier(0);
  sol[32] -= b1a.x * sol[8]; sol[33] -= b1a.y * sol[8]; sol[34] -= b1a.z * sol[8]; sol[35] -= b1a.w * sol[8]; sol[36] -= b1b.x * sol[8]; sol[37] -= b1b.y * sol[8]; sol[38] -= b1b.z * sol[8]; sol[39] -= b1b.w * sol[8]; sol[40] -= b1c.x * sol[8]; sol[41] -= b1c.y * sol[8]; sol[42] -= b1c.z * sol[8]; sol[43] -= b1c.w * sol[8]; sol[44] -= b1d.x * sol[8]; sol[45] -= b1d.y * sol[8]; sol[46] -= b1d.z * sol[8]; sol[47] -= b1d.w * sol[8];
  __builtin_amdgcn_sched_barrier(0);
  b1a = *(const float4*)(Lr + 592); b1b = *(const float4*)(Lr + 596); b1c = *(const float4*)(Lr + 600); b1d = *(const float4*)(Lr + 604);
  __builtin_amdgcn_sched_barrier(0);
  sol[48] -= b2a.x * sol[8]; sol[49] -= b2a.y * sol[8]; sol[50] -= b2a.z * sol[8]; sol[51] -= b2a.w * sol[8]; sol[52] -= b2b.x * sol[8]; sol[53] -= b2b.y * sol[8]; sol[54] -= b2b.z * sol[8]; sol[55] -= b2b.w * sol[8]; sol[56] -= b2c.x * sol[8]; sol[57] -= b2c.y * sol[8]; sol[58] -= b2c.z * sol[8]; sol[59] -= b2c.w * sol[8]; sol[60] -= b2d.x * sol[8]; sol[61] -= b2d.y * sol[8]; sol[62] -= b2d.z * sol[8]; sol[63] -= b2d.w * sol[8];
  __builtin_amdgcn_sched_barrier(0);
  b2a = *(const float4*)(Lr + 608); b2b = *(const float4*)(Lr + 612); b2c = *(const float4*)(Lr + 616); b2d = *(const float4*)(Lr + 620);
  __builtin_amdgcn_sched_barrier(0);
  sol[10] -= b0c.z * sol[9]; sol[11] -= b0c.w * sol[9]; sol[12] -= b0d.x * sol[9]; sol[13] -= b0d.y * sol[9]; sol[14] -= b0d.z * sol[9]; sol[15] -= b0d.w * sol[9];
  __builtin_amdgcn_sched_barrier(0);
  b0a = *(const float4*)(Lr + 624); b0b = *(const float4*)(Lr + 628); b0c = *(const float4*)(Lr + 632); b0d = *(const float4*)(Lr + 636);
  __builtin_amdgcn_sched_barrier(0);
  sol[16] -= b1a.x * sol[9]; sol[17] -= b1a.y * sol[9]; sol[18] -= b1a.z * sol[9]; sol[19] -= b1a.w * sol[9]; sol[20] -= b1b.x * sol[9]; sol[21] -= b1b.y * sol[9]; sol[22] -= b1b.z * sol[9]; sol[23] -= b1b.w * sol[9]; sol[24] -= b1c.x * sol[9]; sol[25] -= b1c.y * sol[9]; sol[26] -= b1c.z * sol[9]; sol[27] -= b1c.w * sol[9]; sol[28] -= b1d.x * sol[9]; sol[29] -= b1d.y * sol[9]; sol[30] -= b1d.z * sol[9]; sol[31] -= b1d.w * sol[9];
  __builtin_amdgcn_sched_barrier(0);
  b1a = *(const float4*)(Lr + 640); b1b = *(const float4*)(Lr + 644); b1c = *(const float4*)(Lr + 648); b1d = *(const float4*)(Lr + 652);
  __builtin_amdgcn_sched_barrier(0);
  sol[32] -= b2a.x * sol[9]; sol[33] -= b2a.y * sol[9]; sol[34] -= b2a.z * sol[9]; sol[35] -= b2a.w * sol[9]; sol[36] -= b2b.x * sol[9]; sol[37] -= b2b.y * sol[9]; sol[38] -= b2b.z * sol[9]; sol[39] -= b2b.w * sol[9]; sol[40] -= b2c.x * sol[9]; sol[41] -= b2c.y * sol[9]; sol[42] -= b2c.z * sol[9]; sol[43] -= b2c.w * sol[9]; sol[44] -= b2d.x * sol[9]; sol[45] -= b2d.y * sol[9]; sol[46] -= b2d.z * sol[9]; sol[47] -= b2d.w * sol[9];
  __builtin_amdgcn_sched_barrier(0);
  b2a = *(const float4*)(Lr + 656); b2b = *(const float4*)(Lr + 660); b2c = *(const float4*)(Lr + 664); b2d = *(const float4*)(Lr + 668);
  __builtin_amdgcn_sched_barrier(0);
  sol[48] -= b0a.x * sol[9]; sol[49] -= b0a.y * sol[9]; sol[50] -= b0a.z * sol[9]; sol[51] -= b0a.w * sol[9]; sol[52] -= b0b.x * sol[9]; sol[53] -= b0b.y * sol[9]; sol[54] -= b0b.z * sol[9]; sol[55] -= b0b.w * sol[9]; sol[56] -= b0c.x * sol[9]; sol[57] -= b0c.y * sol[9]; sol[58] -= b0c.z * sol[9]; sol[59] -= b0c.w * sol[9]; sol[60] -= b0d.x * sol[9]; sol[61] -= b0d.y * sol[9]; sol[62] -= b0d.z * sol[9]; sol[63] -= b0d.w * sol[9];
  __builtin_amdgcn_sched_barrier(0);
  b0a = *(const float4*)(Lr + 672); b0b = *(const float4*)(Lr + 676); b0c = *(const float4*)(Lr + 680); b0d = *(const float4*)(Lr + 684);
  __builtin_amdgcn_sched_barrier(0);
  sol[11] -= b1c.w * sol[10]; sol[12] -= b1d.x * sol[10]; sol[13] -= b1d.y * sol[10]; sol[14] -= b1d.z * sol[10]; sol[15] -= b1d.w * sol[10];
  __builtin_amdgcn_sched_barrier(0);
  b1a = *(const float4*)(Lr + 688); b1b = *(const float4*)(Lr + 692); b1c = *(const float4*)(Lr + 696); b1d = *(const float4*)(Lr + 700);
  __builtin_amdgcn_sched_barrier(0);
  sol[16] -= b2a.x * sol[10]; sol[17] -= b2a.y * sol[10]; sol[18] -= b2a.z * sol[10]; sol[19] -= b2a.w * sol[10]; sol[20] -= b2b.x * sol[10]; sol[21] -= b2b.y * sol[10]; sol[22] -= b2b.z * sol[10]; sol[23] -= b2b.w * sol[10]; sol[24] -= b2c.x * sol[10]; sol[25] -= b2c.y * sol[10]; sol[26] -= b2c.z * sol[10]; sol[27] -= b2c.w * sol[10]; sol[28] -= b2d.x * sol[10]; sol[29] -= b2d.y * sol[10]; sol[30] -= b2d.z * sol[10]; sol[31] -= b2d.w * sol[10];
  __builtin_amdgcn_sched_barrier(0);
  b2a = *(const float4*)(Lr + 704); b2b = *(const float4*)(Lr + 708); b2c = *(const float4*)(Lr + 712); b2d = *(const float4*)(Lr + 716);
  __builtin_amdgcn_sched_barrier(0);
  sol[32] -= b0a.x * sol[10]; sol[33] -= b0a.y * sol[10]; sol[34] -= b0a.z * sol[10]; sol[35] -= b0a.w * sol[10]; sol[36] -= b0b.x * sol[10]; sol[37] -= b0b.y * sol[10]; sol[38] -= b0b.z * sol[10]; sol[39] -= b0b.w * sol[10]; sol[40] -= b0c.x * sol[10]; sol[41] -= b0c.y * sol[10]; sol[42] -= b0c.z * sol[10]; sol[43] -= b0c.w * sol[10]; sol[44] -= b0d.x * sol[10]; sol[45] -= b0d.y * sol[10]; sol[46] -= b0d.z * sol[10]; sol[47] -= b0d.w * sol[10];
  __builtin_amdgcn_sched_barrier(0);
  b0a = *(const float4*)(Lr + 720); b0b = *(const float4*)(Lr + 724); b0c = *(const float4*)(Lr + 728); b0d = *(const float4*)(Lr + 732);
  __builtin_amdgcn_sched_barrier(0);
  sol[48] -= b1a.x * sol[10]; sol[49] -= b1a.y * sol[10]; sol[50] -= b1a.z * sol[10]; sol[51] -= b1a.w * sol[10]; sol[52] -= b1b.x * sol[10]; sol[53] -= b1b.y * sol[10]; sol[54] -= b1b.z * sol[10]; sol[55] -= b1b.w * sol[10]; sol[56] -= b1c.x * sol[10]; sol[57] -= b1c.y * sol[10]; sol[58] -= b1c.z * sol[10]; sol[59] -= b1c.w * sol[10]; sol[60] -= b1d.x * sol[10]; sol[61] -= b1d.y * sol[10]; sol[62] -= b1d.z * sol[10]; sol[63] -= b1d.w * sol[10];
  __builtin_amdgcn_sched_barrier(0);
  b1a = *(const float4*)(Lr + 736); b1b = *(const float4*)(Lr + 740); b1c = *(const float4*)(Lr + 744); b1d = *(const float4*)(Lr + 748);
  __builtin_amdgcn_sched_barrier(0);
  sol[12] -= b2d.x * sol[11]; sol[13] -= b2d.y * sol[11]; sol[14] -= b2d.z * sol[11]; sol[15] -= b2d.w * sol[11];
  __builtin_amdgcn_sched_barrier(0);
  b2a = *(const float4*)(Lr + 752); b2b = *(const float4*)(Lr + 756); b2c = *(const float4*)(Lr + 760); b2d = *(const float4*)(Lr + 764);
  __builtin_amdgcn_sched_barrier(0);
  sol[16] -= b0a.x * sol[11]; sol[17] -= b0a.y * sol[11]; sol[18] -= b0a.z * sol[11]; sol[19] -= b0a.w * sol[11]; sol[20] -= b0b.x * sol[11]; sol[21] -= b0b.y * sol[11]; sol[22] -= b0b.z * sol[11]; sol[23] -= b0b.w * sol[11]; sol[24] -= b0c.x * sol[11]; sol[25] -= b0c.y * sol[11]; sol[26] -= b0c.z * sol[11]; sol[27] -= b0c.w * sol[11]; sol[28] -= b0d.x * sol[11]; sol[29] -= b0d.y * sol[11]; sol[30] -= b0d.z * sol[11]; sol[31] -= b0d.w * sol[11];
  __builtin_amdgcn_sched_barrier(0);
  b0a = *(const float4*)(Lr + 768); b0b = *(const float4*)(Lr + 772); b0c = *(const float4*)(Lr + 776); b0d = *(const float4*)(Lr + 780);
  __builtin_amdgcn_sched_barrier(0);
  sol[32] -= b1a.x * sol[11]; sol[33] -= b1a.y * sol[11]; sol[34] -= b1a.z * sol[11]; sol[35] -= b1a.w * sol[11]; sol[36] -= b1b.x * sol[11]; sol[37] -= b1b.y * sol[11]; sol[38] -= b1b.z * sol[11]; sol[39] -= b1b.w * sol[11]; sol[40] -= b1c.x * sol[11]; sol[41] -= b1c.y * sol[11]; sol[42] -= b1c.z * sol[11]; sol[43] -= b1c.w * sol[11]; sol[44] -= b1d.x * sol[11]; sol[45] -= b1d.y * sol[11]; sol[46] -= b1d.z * sol[11]; sol[47] -= b1d.w * sol[11];
  __builtin_amdgcn_sched_barrier(0);
  b1a = *(const float4*)(Lr + 784); b1b = *(const float4*)(Lr + 788); b1c = *(const float4*)(Lr + 792); b1d = *(const float4*)(Lr + 796);
  __builtin_amdgcn_sched_barrier(0);
  sol[48] -= b2a.x * sol[11]; sol[49] -= b2a.y * sol[11]; sol[50] -= b2a.z * sol[11]; sol[51] -= b2a.w * sol[11]; sol[52] -= b2b.x * sol[11]; sol[53] -= b2b.y * sol[11]; sol[54] -= b2b.z * sol[11]; sol[55] -= b2b.w * sol[11]; sol[56] -= b2c.x * sol[11]; sol[57] -= b2c.y * sol[11]; sol[58] -= b2c.z * sol[11]; sol[59] -= b2c.w * sol[11]; sol[60] -= b2d.x * sol[11]; sol[61] -= b2d.y * sol[11]; sol[62] -= b2d.z * sol[11]; sol[63] -= b2d.w * sol[11];
  __builtin_amdgcn_sched_barrier(0);
  b2a = *(const float4*)(Lr + 800); b2b = *(const float4*)(Lr + 804); b2c = *(const float4*)(Lr + 808); b2d = *(const float4*)(Lr + 812);
  __builtin_amdgcn_sched_barrier(0);
  sol[13] -= b0d.y * sol[12]; sol[14] -= b0d.z * sol[12]; sol[15] -= b0d.w * sol[12];
  __builtin_amdgcn_sched_barrier(0);
  b0a = *(const float4*)(Lr + 816); b0b = *(const float4*)(Lr + 820); b0c = *(const float4*)(Lr + 824); b0d = *(const float4*)(Lr + 828);
  __builtin_amdgcn_sched_barrier(0);
  sol[16] -= b1a.x * sol[12]; sol[17] -= b1a.y * sol[12]; sol[18] -= b1a.z * sol[12]; sol[19] -= b1a.w * sol[12]; sol[20] -= b1b.x * sol[12]; sol[21] -= b1b.y * sol[12]; sol[22] -= b1b.z * sol[12]; sol[23] -= b1b.w * sol[12]; sol[24] -= b1c.x * sol[12]; sol[25] -= b1c.y * sol[12]; sol[26] -= b1c.z * sol[12]; sol[27] -= b1c.w * sol[12]; sol[28] -= b1d.x * sol[12]; sol[29] -= b1d.y * sol[12]; sol[30] -= b1d.z * sol[12]; sol[31] -= b1d.w * sol[12];
  __builtin_amdgcn_sched_barrier(0);
  b1a = *(const float4*)(Lr + 832); b1b = *(const float4*)(Lr + 836); b1c = *(const float4*)(Lr + 840); b1d = *(const float4*)(Lr + 844);
  __builtin_amdgcn_sched_barrier(0);
  sol[32] -= b2a.x * sol[12]; sol[33] -= b2a.y * sol[12]; sol[34] -= b2a.z * sol[12]; sol[35] -= b2a.w * sol[12]; sol[36] -= b2b.x * sol[12]; sol[37] -= b2b.y * sol[12]; sol[38] -= b2b.z * sol[12]; sol[39] -= b2b.w * sol[12]; sol[40] -= b2c.x * sol[12]; sol[41] -= b2c.y * sol[12]; sol[42] -= b2c.z * sol[12]; sol[43] -= b2c.w * sol[12]; sol[44] -= b2d.x * sol[12]; sol[45] -= b2d.y * sol[12]; sol[46] -= b2d.z * sol[12]; sol[47] -= b2d.w * sol[12];
  __builtin_amdgcn_sched_barrier(0);
  b2a = *(const float4*)(Lr + 848); b2b = *(const float4*)(Lr + 852); b2c = *(const float4*)(Lr + 856); b2d = *(const float4*)(Lr + 860);
  __builtin_amdgcn_sched_barrier(0);
  sol[48] -= b0a.x * sol[12]; sol[49] -= b0a.y * sol[12]; sol[50] -= b0a.z * sol[12]; sol[51] -= b0a.w * sol[12]; sol[52] -= b0b.x * sol[12]; sol[53] -= b0b.y * sol[12]; sol[54] -= b0b.z * sol[12]; sol[55] -= b0b.w * sol[12]; sol[56] -= b0c.x * sol[12]; sol[57] -= b0c.y * sol[12]; sol[58] -= b0c.z * sol[12]; sol[59] -= b0c.w * sol[12]; sol[60] -= b0d.x * sol[12]; sol[61] -= b0d.y * sol[12]; sol[62] -= b0d.z * sol[12]; sol[63] -= b0d.w * sol[12];
  __builtin_amdgcn_sched_barrier(0);
  b0a = *(const float4*)(Lr + 864); b0b = *(const float4*)(Lr + 868); b0c = *(const float4*)(Lr + 872); b0d = *(const float4*)(Lr + 876);
  __builtin_amdgcn_sched_barrier(0);
  sol[14] -= b1d.z * sol[13]; sol[15] -= b1d.w * sol[13];
  __builtin_amdgcn_sched_barrier(0);
  b1a = *(const float4*)(Lr + 880); b1b = *(const float4*)(Lr + 884); b1c = *(const float4*)(Lr + 888); b1d = *(const float4*)(Lr + 892);
  __builtin_amdgcn_sched_barrier(0);
  sol[16] -= b2a.x * sol[13]; sol[17] -= b2a.y * sol[13]; sol[18] -= b2a.z * sol[13]; sol[19] -= b2a.w * sol[13]; sol[20] -= b2b.x * sol[13]; sol[21] -= b2b.y * sol[13]; sol[22] -= b2b.z * sol[13]; sol[23] -= b2b.w * sol[13]; sol[24] -= b2c.x * sol[13]; sol[25] -= b2c.y * sol[13]; sol[26] -= b2c.z * sol[13]; sol[27] -= b2c.w * sol[13]; sol[28] -= b2d.x * sol[13]; sol[29] -= b2d.y * sol[13]; sol[30] -= b2d.z * sol[13]; sol[31] -= b2d.w * sol[13];
  __builtin_amdgcn_sched_barrier(0);
  b2a = *(const float4*)(Lr + 896); b2b = *(const float4*)(Lr + 900); b2c = *(const float4*)(Lr + 904); b2d = *(const float4*)(Lr + 908);
  __builtin_amdgcn_sched_barrier(0);
  sol[32] -= b0a.x * sol[13]; sol[33] -= b0a.y * sol[13]; sol[34] -= b0a.z * sol[13]; sol[35] -= b0a.w * sol[13]; sol[36] -= b0b.x * sol[13]; sol[37] -= b0b.y * sol[13]; sol[38] -= b0b.z * sol[13]; sol[39] -= b0b.w * sol[13]; sol[40] -= b0c.x * sol[13]; sol[41] -= b0c.y * sol[13]; sol[42] -= b0c.z * sol[13]; sol[43] -= b0c.w * sol[13]; sol[44] -= b0d.x * sol[13]; sol[45] -= b0d.y * sol[13]; sol[46] -= b0d.z * sol[13]; sol[47] -= b0d.w * sol[13];
  __builtin_amdgcn_sched_barrier(0);
  b0a = *(const float4*)(Lr + 912); b0b = *(const float4*)(Lr + 916); b0c = *(const float4*)(Lr + 920); b0d = *(const float4*)(Lr + 924);
  __builtin_amdgcn_sched_barrier(0);
  sol[48] -= b1a.x * sol[13]; sol[49] -= b1a.y * sol[13]; sol[50] -= b1a.z * sol[13]; sol[51] -= b1a.w * sol[13]; sol[52] -= b1b.x * sol[13]; sol[53] -= b1b.y * sol[13]; sol[54] -= b1b.z * sol[13]; sol[55] -= b1b.w * sol[13]; sol[56] -= b1c.x * sol[13]; sol[57] -= b1c.y * sol[13]; sol[58] -= b1c.z * sol[13]; sol[59] -= b1c.w * sol[13]; sol[60] -= b1d.x * sol[13]; sol[61] -= b1d.y * sol[13]; sol[62] -= b1d.z * sol[13]; sol[63] -= b1d.w * sol[13];
  __builtin_amdgcn_sched_barrier(0);
  b1a = *(const float4*)(Lr + 928); b1b = *(const float4*)(Lr + 932); b1c = *(const float4*)(Lr + 936); b1d = *(const float4*)(Lr + 940);
  __builtin_amdgcn_sched_barrier(0);
  sol[15] -= b2d.w * sol[14];
  __builtin_amdgcn_sched_barrier(0);
  b2a = *(const float4*)(Lr + 944); b2b = *(const float4*)(Lr + 948); b2c = *(const float4*)(Lr + 952); b2d = *(const float4*)(Lr + 956);
  __builtin_amdgcn_sched_barrier(0);
  sol[16] -= b0a.x * sol[14]; sol[17] -= b0a.y * sol[14]; sol[18] -= b0a.z * sol[14]; sol[19] -= b0a.w * sol[14]; sol[20] -= b0b.x * sol[14]; sol[21] -= b0b.y * sol[14]; sol[22] -= b0b.z * sol[14]; sol[23] -= b0b.w * sol[14]; sol[24] -= b0c.x * sol[14]; sol[25] -= b0c.y * sol[14]; sol[26] -= b0c.z * sol[14]; sol[27] -= b0c.w * sol[14]; sol[28] -= b0d.x * sol[14]; sol[29] -= b0d.y * sol[14]; sol[30] -= b0d.z * sol[14]; sol[31] -= b0d.w * sol[14];
  __builtin_amdgcn_sched_barrier(0);
  b0a = *(const float4*)(Lr + 976); b0b = *(const float4*)(Lr + 980); b0c = *(const float4*)(Lr + 984); b0d = *(const float4*)(Lr + 988);
  __builtin_amdgcn_sched_barrier(0);
  sol[32] -= b1a.x * sol[14]; sol[33] -= b1a.y * sol[14]; sol[34] -= b1a.z * sol[14]; sol[35] -= b1a.w * sol[14]; sol[36] -= b1b.x * sol[14]; sol[37] -= b1b.y * sol[14]; sol[38] -= b1b.z * sol[14]; sol[39] -= b1b.w * sol[14]; sol[40] -= b1c.x * sol[14]; sol[41] -= b1c.y * sol[14]; sol[42] -= b1c.z * sol[14]; sol[43] -= b1c.w * sol[14]; sol[44] -= b1d.x * sol[14]; sol[45] -= b1d.y * sol[14]; sol[46] -= b1d.z * sol[14]; sol[47] -= b1d.w * sol[14];
  __builtin_amdgcn_sched_barrier(0);
  b1a = *(const float4*)(Lr + 992); b1b = *(const float4*)(Lr + 996); b1c = *(const float4*)(Lr + 1000); b1d = *(const float4*)(Lr + 1004);
  __builtin_amdgcn_sched_barrier(0);
  sol[48] -= b2a.x * sol[14]; sol[49] -= b2a.y * sol[14]; sol[50] -= b2a.z * sol[14]; sol[51] -= b2a.w * sol[14]; sol[52] -= b2b.x * sol[14]; sol[53] -= b2b.y * sol[14]; sol[54] -= b2b.z * sol[14]; sol[55] -= b2b.w * sol[14]; sol[56] -= b2c.x * sol[14]; sol[57] -= b2c.y * sol[14]; sol[58] -= b2c.z * sol[14]; sol[59] -= b2c.w * sol[14]; sol[60] -= b2d.x * sol[14]; sol[61] -= b2d.y * sol[14]; sol[62] -= b2d.z * sol[14]; sol[63] -= b2d.w * sol[14];
  __builtin_amdgcn_sched_barrier(0);
  b2a = *(const float4*)(Lr + 1008); b2b = *(const float4*)(Lr + 1012); b2c = *(const float4*)(Lr + 1016); b2d = *(const float4*)(Lr + 1020);
  __builtin_amdgcn_sched_barrier(0);
  sol[16] -= b0a.x * sol[15]; sol[17] -= b0a.y * sol[15]; sol[18] -= b0a.z * sol[15]; sol[19] -= b0a.w * sol[15]; sol[20] -= b0b.x * sol[15]; sol[21] -= b0b.y * sol[15]; sol[22] -= b0b.z * sol[15]; sol[23] -= b0b.w * sol[15]; sol[24] -= b0c.x * sol[15]; sol[25] -= b0c.y * sol[15]; sol[26] -= b0c.z * sol[15]; sol[27] -= b0c.w * sol[15]; sol[28] -= b0d.x * sol[15]; sol[29] -= b0d.y * sol[15]; sol[30] -= b0d.z * sol[15]; sol[31] -= b0d.w * sol[15];
  __builtin_amdgcn_sched_barrier(0);
  b0a = *(const float4*)(Lr + 1040); b0b = *(const float4*)(Lr + 1044); b0c = *(const float4*)(Lr + 1048); b0d = *(const float4*)(Lr + 1052);
  __builtin_amdgcn_sched_barrier(0);
  sol[32] -= b1a.x * sol[15]; sol[33] -= b1a.y * sol[15]; sol[34] -= b1a.z * sol[15]; sol[35] -= b1a.w * sol[15]; sol[36] -= b1b.x * sol[15]; sol[37] -= b1b.y * sol[15]; sol[38] -= b1b.z * sol[15]; sol[39] -= b1b.w * sol[15]; sol[40] -= b1c.x * sol[15]; sol[41] -= b1c.y * sol[15]; sol[42] -= b1c.z * sol[15]; sol[43] -= b1c.w * sol[15]; sol[44] -= b1d.x * sol[15]; sol[45] -= b1d.y * sol[15]; sol[46] -= b1d.z * sol[15]; sol[47] -= b1d.w * sol[15];
  __builtin_amdgcn_sched_barrier(0);
  b1a = *(const float4*)(Lr + 1056); b1b = *(const float4*)(Lr + 1060); b1c = *(const float4*)(Lr + 1064); b1d = *(const float4*)(Lr + 1068);
  __builtin_amdgcn_sched_barrier(0);
  sol[48] -= b2a.x * sol[15]; sol[49] -= b2a.y * sol[15]; sol[50] -= b2a.z * sol[15]; sol[51] -= b2a.w * sol[15]; sol[52] -= b2b.x * sol[15]; sol[53] -= b2b.y * sol[15]; sol[54] -= b2b.z * sol[15]; sol[55] -= b2b.w * sol[15]; sol[56] -= b2c.x * sol[15]; sol[57] -= b2c.y * sol[15]; sol[58] -= b2c.z * sol[15]; sol[59] -= b2c.w * sol[15]; sol[60] -= b2d.x * sol[15]; sol[61] -= b2d.y * sol[15]; sol[62] -= b2d.z * sol[15]; sol[63] -= b2d.w * sol[15];
  __builtin_amdgcn_sched_barrier(0);
  b2a = *(const float4*)(Lr + 1072); b2b = *(const float4*)(Lr + 1076); b2c = *(const float4*)(Lr + 1080); b2d = *(const float4*)(Lr + 1084);
  __builtin_amdgcn_sched_barrier(0);
  sol[17] -= b0a.y * sol[16]; sol[18] -= b0a.z * sol[16]; sol[19] -= b0a.w * sol[16]; sol[20] -= b0b.x * sol[16]; sol[21] -= b0b.y * sol[16]; sol[22] -= b0b.z * sol[16]; sol[23] -= b0b.w * sol[16]; sol[24] -= b0c.x * sol[16]; sol[25] -= b0c.y * sol[16]; sol[26] -= b0c.z * sol[16]; sol[27] -= b0c.w * sol[16]; sol[28] -= b0d.x * sol[16]; sol[29] -= b0d.y * sol[16]; sol[30] -= b0d.z * sol[16]; sol[31] -= b0d.w * sol[16];
  __builtin_amdgcn_sched_barrier(0);
  b0a = *(const float4*)(Lr + 1104); b0b = *(const float4*)(Lr + 1108); b0c = *(const float4*)(Lr + 1112); b0d = *(const float4*)(Lr + 1116);
  __builtin_amdgcn_sched_barrier(0);
  sol[32] -= b1a.x * sol[16]; sol[33] -= b1a.y * sol[16]; sol[34] -= b1a.z * sol[16]; sol[35] -= b1a.w * sol[16]; sol[36] -= b1b.x * sol[16]; sol[37] -= b1b.y * sol[16]; sol[38] -= b1b.z * sol[16]; sol[39] -= b1b.w * sol[16]; sol[40] -= b1c.x * sol[16]; sol[41] -= b1c.y * sol[16]; sol[42] -= b1c.z * sol[16]; sol[43] -= b1c.w * sol[16]; sol[44] -= b1d.x * sol[16]; sol[45] -= b1d.y * sol[16]; sol[46] -= b1d.z * sol[16]; sol[47] -= b1d.w * sol[16];
  __builtin_amdgcn_sched_barrier(0);
  b1a = *(const float4*)(Lr + 1120); b1b = *(const float4*)(Lr + 1124); b1c = *(const float4*)(Lr + 1128); b1d = *(const float4*)(Lr + 1132);
  __builtin_amdgcn_sched_barrier(0);
  sol[48] -= b2a.x * sol[16]; sol[49] -= b2a.y * sol[16]; sol[50] -= b2a.z * sol[16]; sol[51] -= b2a.w * sol[16]; sol[52] -= b2b.x * sol[16]; sol[53] -= b2b.y * sol[16]; sol[54] -= b2b.z * sol[16]; sol[55] -= b2b.w * sol[16]; sol[56] -= b2c.x * sol[16]; sol[57] -= b2c.y * sol[16]; sol[58] -= b2c.z * sol[16]; sol[59] -= b2c.w * sol[16]; sol[60] -= b2d.x * sol[16]; sol[61] -= b2d.y * sol[16]; sol[62] -= b2d.z * sol[16]; sol[63] -= b2d.w * sol[16];
  __builtin_amdgcn_sched_barrier(0);
  b2a = *(const float4*)(Lr + 1136); b2b = *(const float4*)(Lr + 1140); b2c = *(const float4*)(Lr + 1144); b2d = *(const float4*)(Lr + 1148);
  __builtin_amdgcn_sched_barrier(0);
  sol[18] -= b0a.z * sol[17]; sol[19] -= b0a.w * sol[17]; sol[20] -= b0b.x * sol[17]; sol[21] -= b0b.y * sol[17]; sol[22] -= b0b.z * sol[17]; sol[23] -= b0b.w * sol[17]; sol[24] -= b0c.x * sol[17]; sol[25] -= b0c.y * sol[17]; sol[26] -= b0c.z * sol[17]; sol[27] -= b0c.w * sol[17]; sol[28] -= b0d.x * sol[17]; sol[29] -= b0d.y * sol[17]; sol[30] -= b0d.z * sol[17]; sol[31] -= b0d.w * sol[17];
  __builtin_amdgcn_sched_barrier(0);
  b0a = *(const float4*)(Lr + 1168); b0b = *(const float4*)(Lr + 1172); b0c = *(const float4*)(Lr + 1176); b0d = *(const float4*)(Lr + 1180);
  __builtin_amdgcn_sched_barrier(0);
  sol[32] -= b1a.x * sol[17]; sol[33] -= b1a.y * sol[17]; sol[34] -= b1a.z * sol[17]; sol[35] -= b1a.w * sol[17]; sol[36] -= b1b.x * sol[17]; sol[37] -= b1b.y * sol[17]; sol[38] -= b1b.z * sol[17]; sol[39] -= b1b.w * sol[17]; sol[40] -= b1c.x * sol[17]; sol[41] -= b1c.y * sol[17]; sol[42] -= b1c.z * sol[17]; sol[43] -= b1c.w * sol[17]; sol[44] -= b1d.x * sol[17]; sol[45] -= b1d.y * sol[17]; sol[46] -= b1d.z * sol[17]; sol[47] -= b1d.w * sol[17];
  __builtin_amdgcn_sched_barrier(0);
  b1a = *(const float4*)(Lr + 1184); b1b = *(const float4*)(Lr + 1188); b1c = *(const float4*)(Lr + 1192); b1d = *(const float4*)(Lr + 1196);
  __builtin_amdgcn_sched_barrier(0);
  sol[48] -= b2a.x * sol[17]; sol[49] -= b2a.y * sol[17]; sol[50] -= b2a.z * sol[17]; sol[51] -= b2a.w * sol[17]; sol[52] -= b2b.x * sol[17]; sol[53] -= b2b.y * sol[17]; sol[54] -= b2b.z * sol[17]; sol[55] -= b2b.w * sol[17]; sol[56] -= b2c.x * sol[17]; sol[57] -= b2c.y * sol[17]; sol[58] -= b2c.z * sol[17]; sol[59] -= b2c.w * sol[17]; sol[60] -= b2d.x * sol[17]; sol[61] -= b2d.y * sol[17]; sol[62] -= b2d.z * sol[17]; sol[63] -= b2d.w * sol[17];
  __builtin_amdgcn_sched_barrier(0);
  b2a = *(const float4*)(Lr + 1200); b2b = *(const float4*)(Lr + 1204); b2c = *(const float4*)(Lr + 1208); b2d = *(const float4*)(Lr + 1212);
  __builtin_amdgcn_sched_barrier(0);
  sol[19] -= b0a.w * sol[18]; sol[20] -= b0b.x * sol[18]; sol[21] -= b0b.y * sol[18]; sol[22] -= b0b.z * sol[18]; sol[23] -= b0b.w * sol[18]; sol[24] -= b0c.x * sol[18]; sol[25] -= b0c.y * sol[18]; sol[26] -= b0c.z * sol[18]; sol[27] -= b0c.w * sol[18]; sol[28] -= b0d.x * sol[18]; sol[29] -= b0d.y * sol[18]; sol[30] -= b0d.z * sol[18]; sol[31] -= b0d.w * sol[18];
  __builtin_amdgcn_sched_barrier(0);
  b0a = *(const float4*)(Lr + 1232); b0b = *(const float4*)(Lr + 1236); b0c = *(const float4*)(Lr + 1240); b0d = *(const float4*)(Lr + 1244);
  __builtin_amdgcn_sched_barrier(0);
  sol[32] -= b1a.x * sol[18]; sol[33] -= b1a.y * sol[18]; sol[34] -= b1a.z * sol[18]; sol[35] -= b1a.w * sol[18]; sol[36] -= b1b.x * sol[18]; sol[37] -= b1b.y * sol[18]; sol[38] -= b1b.z * sol[18]; sol[39] -= b1b.w * sol[18]; sol[40] -= b1c.x * sol[18]; sol[41] -= b1c.y * sol[18]; sol[42] -= b1c.z * sol[18]; sol[43] -= b1c.w * sol[18]; sol[44] -= b1d.x * sol[18]; sol[45] -= b1d.y * sol[18]; sol[46] -= b1d.z * sol[18]; sol[47] -= b1d.w * sol[18];
  __builtin_amdgcn_sched_barrier(0);
  b1a = *(const float4*)(Lr + 1248); b1b = *(const float4*)(Lr + 1252); b1c = *(const float4*)(Lr + 1256); b1d = *(const float4*)(Lr + 1260);
  __builtin_amdgcn_sched_barrier(0);
  sol[48] -= b2a.x * sol[18]; sol[49] -= b2a.y * sol[18]; sol[50] -= b2a.z * sol[18]; sol[51] -= b2a.w * sol[18]; sol[52] -= b2b.x * sol[18]; sol[53] -= b2b.y * sol[18]; sol[54] -= b2b.z * sol[18]; sol[55] -= b2b.w * sol[18]; sol[56] -= b2c.x * sol[18]; sol[57] -= b2c.y * sol[18]; sol[58] -= b2c.z * sol[18]; sol[59] -= b2c.w * sol[18]; sol[60] -= b2d.x * sol[18]; sol[61] -= b2d.y * sol[18]; sol[62] -= b2d.z * sol[18]; sol[63] -= b2d.w * sol[18];
  __builtin_amdgcn_sched_barrier(0);
  b2a = *(const float4*)(Lr + 1264); b2b = *(const float4*)(Lr + 1268); b2c = *(const float4*)(Lr + 1272); b2d = *(const float4*)(Lr + 1276);
  __builtin_amdgcn_sched_barrier(0);
  sol[20] -= b0b.x * sol[19]; sol[21] -= b0b.y * sol[19]; sol[22] -= b0b.z * sol[19]; sol[23] -= b0b.w * sol[19]; sol[24] -= b0c.x * sol[19]; sol[25] -= b0c.y * sol[19]; sol[26] -= b0c.z * sol[19]; sol[27] -= b0c.w * sol[19]; sol[28] -= b0d.x * sol[19]; sol[29] -= b0d.y * sol[19]; sol[30] -= b0d.z * sol[19]; sol[31] -= b0d.w * sol[19];
  __builtin_amdgcn_sched_barrier(0);
  b0a = *(const float4*)(Lr + 1296); b0b = *(const float4*)(Lr + 1300); b0c = *(const float4*)(Lr + 1304); b0d = *(const float4*)(Lr + 1308);
  __builtin_amdgcn_sched_barrier(0);
  sol[32] -= b1a.x * sol[19]; sol[33] -= b1a.y * sol[19]; sol[34] -= b1a.z * sol[19]; sol[35] -= b1a.w * sol[19]; sol[36] -= b1b.x * sol[19]; sol[37] -= b1b.y * sol[19]; sol[38] -= b1b.z * sol[19]; sol[39] -= b1b.w * sol[19]; sol[40] -= b1c.x * sol[19]; sol[41] -= b1c.y * sol[19]; sol[42] -= b1c.z * sol[19]; sol[43] -= b1c.w * sol[19]; sol[44] -= b1d.x * sol[19]; sol[45] -= b1d.y * sol[19]; sol[46] -= b1d.z * sol[19]; sol[47] -= b1d.w * sol[19];
  __builtin_amdgcn_sched_barrier(0);
  b1a = *(const float4*)(Lr + 1312); b1b = *(const float4*)(Lr + 1316); b1c = *(const float4*)(Lr + 1320); b1d = *(const float4*)(Lr + 1324);
  __builtin_amdgcn_sched_barrier(0);
  sol[48] -= b2a.x * sol[19]; sol[49] -= b2a.y * sol[19]; sol[50] -= b2a.z * sol[19]; sol[51] -= b2a.w * sol[19]; sol[52] -= b2b.x * sol[19]; sol[53] -= b2b.y * sol[19]; sol[54] -= b2b.z * sol[19]; sol[55] -= b2b.w * sol[19]; sol[56] -= b2c.x * sol[19]; sol[57] -= b2c.y * sol[19]; sol[58] -= b2c.z * sol[19]; sol[59] -= b2c.w * sol[19]; sol[60] -= b2d.x * sol[19]; sol[61] -= b2d.y * sol[19]; sol[62] -= b2d.z * sol[19]; sol[63] -= b2d.w * sol[19];
  __builtin_amdgcn_sched_barrier(0);
  b2a = *(const float4*)(Lr + 1328); b2b = *(const float4*)(Lr + 1332); b2c = *(const float4*)(Lr + 1336); b2d = *(const float4*)(Lr + 1340);
  __builtin_amdgcn_sched_barrier(0);
  sol[21] -= b0b.y * sol[20]; sol[22] -= b0b.z * sol[20]; sol[23] -= b0b.w * sol[20]; sol[24] -= b0c.x * sol[20]; sol[25] -= b0c.y * sol[20]; sol[26] -= b0c.z * sol[20]; sol[27] -= b0c.w * sol[20]; sol[28] -= b0d.x * sol[20]; sol[29] -= b0d.y * sol[20]; sol[30] -= b0d.z * sol[20]; sol[31] -= b0d.w * sol[20];
  __builtin_amdgcn_sched_barrier(0);
  b0a = *(const float4*)(Lr + 1360); b0b = *(const float4*)(Lr + 1364); b0c = *(const float4*)(Lr + 1368); b0d = *(const float4*)(Lr + 1372);
  __builtin_amdgcn_sched_barrier(0);
  sol[32] -= b1a.x * sol[20]; sol[33] -= b1a.y * sol[20]; sol[34] -= b1a.z * sol[20]; sol[35] -= b1a.w * sol[20]; sol[36] -= b1b.x * sol[20]; sol[37] -= b1b.y * sol[20]; sol[38] -= b1b.z * sol[20]; sol[39] -= b1b.w * sol[20]; sol[40] -= b1c.x * sol[20]; sol[41] -= b1c.y * sol[20]; sol[42] -= b1c.z * sol[20]; sol[43] -= b1c.w * sol[20]; sol[44] -= b1d.x * sol[20]; sol[45] -= b1d.y * sol[20]; sol[46] -= b1d.z * sol[20]; sol[47] -= b1d.w * sol[20];
  __builtin_amdgcn_sched_barrier(0);
  b1a = *(const float4*)(Lr + 1376); b1b = *(const float4*)(Lr + 1380); b1c = *(const float4*)(Lr + 1384); b1d = *(const float4*)(Lr + 1388);
  __builtin_amdgcn_sched_barrier(0);
  sol[48] -= b2a.x * sol[20]; sol[49] -= b2a.y * sol[20]; sol[50] -= b2a.z * sol[20]; sol[51] -= b2a.w * sol[20]; sol[52] -= b2b.x * sol[20]; sol[53] -= b2b.y * sol[20]; sol[54] -= b2b.z * sol[20]; sol[55] -= b2b.w * sol[20]; sol[56] -= b2c.x * sol[20]; sol[57] -= b2c.y * sol[20]; sol[58] -= b2c.z * sol[20]; sol[59] -= b2c.w * sol[20]; sol[60] -= b2d.x * sol[20]; sol[61] -= b2d.y * sol[20]; sol[62] -= b2d.z * sol[20]; sol[63] -= b2d.w * sol[20];
  __builtin_amdgcn_sched_barrier(0);
  b2a = *(const float4*)(Lr + 1392); b2b = *(const float4*)(Lr + 1396); b2c = *(const float4*)(Lr + 1400); b2d = *(const float4*)(Lr + 1404);
  __builtin_amdgcn_sched_barrier(0);
  sol[22] -= b0b.z * sol[21]; sol[23] -= b0b.w * sol[21]; sol[24] -= b0c.x * sol[21]; sol[25] -= b0c.y * sol[21]; sol[26] -= b0c.z * sol[21]; sol[27] -= b0c.w * sol[21]; sol[28] -= b0d.x * sol[21]; sol[29] -= b0d.y * sol[21]; sol[30] -= b0d.z * sol[21]; sol[31] -= b0d.w * sol[21];
  __builtin_amdgcn_sched_barrier(0);
  b0a = *(const float4*)(Lr + 1424); b0b = *(const float4*)(Lr + 1428); b0c = *(const float4*)(Lr + 1432); b0d = *(const float4*)(Lr + 1436);
  __builtin_amdgcn_sched_barrier(0);
  sol[32] -= b1a.x * sol[21]; sol[33] -= b1a.y * sol[21]; sol[34] -= b1a.z * sol[21]; sol[35] -= b1a.w * sol[21]; sol[36] -= b1b.x * sol[21]; sol[37] -= b1b.y * sol[21]; sol[38] -= b1b.z * sol[21]; sol[39] -= b1b.w * sol[21]; sol[40] -= b1c.x * sol[21]; sol[41] -= b1c.y * sol[21]; sol[42] -= b1c.z * sol[21]; sol[43] -= b1c.w * sol[21]; sol[44] -= b1d.x * sol[21]; sol[45] -= b1d.y * sol[21]; sol[46] -= b1d.z * sol[21]; sol[47] -= b1d.w * sol[21];
  __builtin_amdgcn_sched_barrier(0);
  b1a = *(const float4*)(Lr + 1440); b1b = *(const float4*)(Lr + 1444); b1c = *(const float4*)(Lr + 1448); b1d = *(const float4*)(Lr + 1452);
  __builtin_amdgcn_sched_barrier(0);
  sol[48] -= b2a.x * sol[21]; sol[49] -= b2a.y * sol[21]; sol[50] -= b2a.z * sol[21]; sol[51] -= b2a.w * sol[21]; sol[52] -= b2b.x * sol[21]; sol[53] -= b2b.y * sol[21]; sol[54] -= b2b.z * sol[21]; sol[55] -= b2b.w * sol[21]; sol[56] -= b2c.x * sol[21]; sol[57] -= b2c.y * sol[21]; sol[58] -= b2c.z * sol[21]; sol[59] -= b2c.w * sol[21]; sol[60] -= b2d.x * sol[21]; sol[61] -= b2d.y * sol[21]; sol[62] -= b2d.z * sol[21]; sol[63] -= b2d.w * sol[21];
  __builtin_amdgcn_sched_barrier(0);
  b2a = *(const float4*)(Lr + 1456); b2b = *(const float4*)(Lr + 1460); b2c = *(const float4*)(Lr + 1464); b2d = *(const float4*)(Lr + 1468);
  __builtin_amdgcn_sched_barrier(0);
  sol[23] -= b0b.w * sol[22]; sol[24] -= b0c.x * sol[22]; sol[25] -= b0c.y * sol[22]; sol[26] -= b0c.z * sol[22]; sol[27] -= b0c.w * sol[22]; sol[28] -= b0d.x * sol[22]; sol[29] -= b0d.y * sol[22]; sol[30] -= b0d.z * sol[22]; sol[31] -= b0d.w * sol[22];
  __builtin_amdgcn_sched_barrier(0);
  b0a = *(const float4*)(Lr + 1488); b0b = *(const float4*)(Lr + 1492); b0c = *(const float4*)(Lr + 1496); b0d = *(const float4*)(Lr + 1500);
  __builtin_amdgcn_sched_barrier(0);
  sol[32] -= b1a.x * sol[22]; sol[33] -= b1a.y * sol[22]; sol[34] -= b1a.z * sol[22]; sol[35] -= b1a.w * sol[22]; sol[36] -= b1b.x * sol[22]; sol[37] -= b1b.y * sol[22]; sol[38] -= b1b.z * sol[22]; sol[39] -= b1b.w * sol[22]; sol[40] -= b1c.x * sol[22]; sol[41] -= b1c.y * sol[22]; sol[42] -= b1c.z * sol[22]; sol[43] -= b1c.w * sol[22]; sol[44] -= b1d.x * sol[22]; sol[45] -= b1d.y * sol[22]; sol[46] -= b1d.z * sol[22]; sol[47] -= b1d.w * sol[22];
  __builtin_amdgcn_sched_barrier(0);
  b1a = *(const float4*)(Lr + 1504); b1b = *(const float4*)(Lr + 1508); b1c = *(const float4*)(Lr + 1512); b1d = *(const float4*)(Lr + 1516);
  __builtin_amdgcn_sched_barrier(0);
  sol[48] -= b2a.x * sol[22]; sol[49] -= b2a.y * sol[22]; sol[50] -= b2a.z * sol[22]; sol[51] -= b2a.w * sol[22]; sol[52] -= b2b.x * sol[22]; sol[53] -= b2b.y * sol[22]; sol[54] -= b2b.z * sol[22]; sol[55] -= b2b.w * sol[22]; sol[56] -= b2c.x * sol[22]; sol[57] -= b2c.y * sol[22]; sol[58] -= b2c.z * sol[22]; sol[59] -= b2c.w * sol[22]; sol[60] -= b2d.x * sol[22]; sol[61] -= b2d.y * sol[22]; sol[62] -= b2d.z * sol[22]; sol[63] -= b2d.w * sol[22];
  __builtin_amdgcn_sched_barrier(0);
  b2a = *(const float4*)(Lr + 1520); b2b = *(const float4*)(Lr + 1524); b2c = *(const float4*)(Lr + 1528); b2d = *(const float4*)(Lr + 1532);
  __builtin_amdgcn_sched_barrier(0);
  sol[24] -= b0c.x * sol[23]; sol[25] -= b0c.y * sol[23]; sol[26] -= b0c.z * sol[23]; sol[27] -= b0c.w * sol[23]; sol[28] -= b0d.x * sol[23]; sol[29] -= b0d.y * sol[23]; sol[30] -= b0d.z * sol[23]; sol[31] -= b0d.w * sol[23];
  __builtin_amdgcn_sched_barrier(0);
  b0a = *(const float4*)(Lr + 1552); b0b = *(const float4*)(Lr + 1556); b0c = *(const float4*)(Lr + 1560); b0d = *(const float4*)(Lr + 1564);
  __builtin_amdgcn_sched_barrier(0);
  sol[32] -= b1a.x * sol[23]; sol[33] -= b1a.y * sol[23]; sol[34] -= b1a.z * sol[23]; sol[35] -= b1a.w * sol[23]; sol[36] -= b1b.x * sol[23]; sol[37] -= b1b.y * sol[23]; sol[38] -= b1b.z * sol[23]; sol[39] -= b1b.w * sol[23]; sol[40] -= b1c.x * sol[23]; sol[41] -= b1c.y * sol[23]; sol[42] -= b1c.z * sol[23]; sol[43] -= b1c.w * sol[23]; sol[44] -= b1d.x * sol[23]; sol[45] -= b1d.y * sol[23]; sol[46] -= b1d.z * sol[23]; sol[47] -= b1d.w * sol[23];
  __builtin_amdgcn_sched_barrier(0);
  b1a = *(const float4*)(Lr + 1568); b1b = *(const float4*)(Lr + 1572); b1c = *(const float4*)(Lr + 1576); b1d = *(const float4*)(Lr + 1580);
  __builtin_amdgcn_sched_barrier(0);
  sol[48] -= b2a.x * sol[23]; sol[49] -= b2a.y * sol[23]; sol[50] -= b2a.z * sol[23]; sol[51] -= b2a.w * sol[23]; sol[52] -= b2b.x * sol[23]; sol[53] -= b2b.y * sol[23]; sol[54] -= b2b.z * sol[23]; sol[55] -= b2b.w * sol[23]; sol[56] -= b2c.x * sol[23]; sol[57] -= b2c.y * sol[23]; sol[58] -= b2c.z * sol[23]; sol[59] -= b2c.w * sol[23]; sol[60] -= b2d.x * sol[23]; sol[61] -= b2d.y * sol[23]; sol[62] -= b2d.z * sol[23]; sol[63] -= b2d.w * sol[23];
  __builtin_amdgcn_sched_barrier(0);
  b2a = *(const float4*)(Lr + 1584); b2b = *(const float4*)(Lr + 1588); b2c = *(const float4*)(Lr + 1592); b2d = *(const float4*)(Lr + 1596);
  __builtin_amdgcn_sched_barrier(0);
  sol[25] -= b0c.y * sol[24]; sol[26] -= b0c.z * sol[24]; sol[27] -= b0c.w * sol[24]; sol[28] -= b0d.x * sol[24]; sol[29] -= b0d.y * sol[24]; sol[30] -= b0d.z * sol[24]; sol[31] -= b0d.w * sol[24];
  __builtin_amdgcn_sched_barrier(0);
  b0a = *(const float4*)(Lr + 1616); b0b = *(const float4*)(Lr + 1620); b0c = *(const float4*)(Lr + 1624); b0d = *(const float4*)(Lr + 1628);
  __builtin_amdgcn_sched_barrier(0);
  sol[32] -= b1a.x * sol[24]; sol[33] -= b1a.y * sol[24]; sol[34] -= b1a.z * sol[24]; sol[35] -= b1a.w * sol[24]; sol[36] -= b1b.x * sol[24]; sol[37] -= b1b.y * sol[24]; sol[38] -= b1b.z * sol[24]; sol[39] -= b1b.w * sol[24]; sol[40] -= b1c.x * sol[24]; sol[41] -= b1c.y * sol[24]; sol[42] -= b1c.z * sol[24]; sol[43] -= b1c.w * sol[24]; sol[44] -= b1d.x * sol[24]; sol[45] -= b1d.y * sol[24]; sol[46] -= b1d.z * sol[24]; sol[47] -= b1d.w * sol[24];
  __builtin_amdgcn_sched_barrier(0);
  b1a = *(const float4*)(Lr + 1632); b1b = *(const float4*)(Lr + 1636); b1c = *(const float4*)(Lr + 1640); b1d = *(const float4*)(Lr + 1644);
  __builtin_amdgcn_sched_barrier(0);
  sol[48] -= b2a.x * sol[24]; sol[49] -= b2a.y * sol[24]; sol[50] -= b2a.z * sol[24]; sol[51] -= b2a.w * sol[24]; sol[52] -= b2b.x * sol[24]; sol[53] -= b2b.y * sol[24]; sol[54] -= b2b.z * sol[24]; sol[55] -= b2b.w * sol[24]; sol[56] -= b2c.x * sol[24]; sol[57] -= b2c.y * sol[24]; sol[58] -= b2c.z * sol[24]; sol[59] -= b2c.w * sol[24]; sol[60] -= b2d.x * sol[24]; sol[61] -= b2d.y * sol[24]; sol[62] -= b2d.z * sol[24]; sol[63] -= b2d.w * sol[24];
  __builtin_amdgcn_sched_barrier(0);
  b2a = *(const float4*)(Lr + 1648); b2b = *(const float4*)(Lr + 1652); b2c = *(const float4*)(Lr + 1656); b2d = *(const float4*)(Lr + 1660);
  __builtin_amdgcn_sched_barrier(0);
  sol[26] -= b0c.z * sol[25]; sol[27] -= b0c.w * sol[25]; sol[28] -= b0d.x * sol[25]; sol[29] -= b0d.y * sol[25]; sol[30] -= b0d.z * sol[25]; sol[31] -= b0d.w * sol[25];
  __builtin_amdgcn_sched_barrier(0);
  b0a = *(const float4*)(Lr + 1680); b0b = *(const float4*)(Lr + 1684); b0c = *(const float4*)(Lr + 1688); b0d = *(const float4*)(Lr + 1692);
  __builtin_amdgcn_sched_barrier(0);
  sol[32] -= b1a.x * sol[25]; sol[33] -= b1a.y * sol[25]; sol[34] -= b1a.z * sol[25]; sol[35] -= b1a.w * sol[25]; sol[36] -= b1b.x * sol[25]; sol[37] -= b1b.y * sol[25]; sol[38] -= b1b.z * sol[25]; sol[39] -= b1b.w * sol[25]; sol[40] -= b1c.x * sol[25]; sol[41] -= b1c.y * sol[25]; sol[42] -= b1c.z * sol[25]; sol[43] -= b1c.w * sol[25]; sol[44] -= b1d.x * sol[25]; sol[45] -= b1d.y * sol[25]; sol[46] -= b1d.z * sol[25]; sol[47] -= b1d.w * sol[25];
  __builtin_amdgcn_sched_barrier(0);
  b1a = *(const float4*)(Lr + 1696); b1b = *(const float4*)(Lr + 1700); b1c = *(const float4*)(Lr + 1704); b1d = *(const float4*)(Lr + 1708);
  __builtin_amdgcn_sched_barrier(0);
  sol[48] -= b2a.x * sol[25]; sol[49] -= b2a.y * sol[25]; sol[50] -= b2a.z * sol[25]; sol[51] -= b2a.w * sol[25]; sol[52] -= b2b.x * sol[25]; sol[53] -= b2b.y * sol[25]; sol[54] -= b2b.z * sol[25]; sol[55] -= b2b.w * sol[25]; sol[56] -= b2c.x * sol[25]; sol[57] -= b2c.y * sol[25]; sol[58] -= b2c.z * sol[25]; sol[59] -= b2c.w * sol[25]; sol[60] -= b2d.x * sol[25]; sol[61] -= b2d.y * sol[25]; sol[62] -= b2d.z * sol[25]; sol[63] -= b2d.w * sol[25];
  __builtin_amdgcn_sched_barrier(0);
  b2a = *(const float4*)(Lr + 1712); b2b = *(const float4*)(Lr + 1716); b2c = *(const float4*)(Lr + 1720); b2d = *(const float4*)(Lr + 1724);
  __builtin_amdgcn_sched_barrier(0);
  sol[27] -= b0c.w * sol[26]; sol[28] -= b0d.x * sol[26]; sol[29] -= b0d.y * sol[26]; sol[30] -= b0d.z * sol[26]; sol[31] -= b0d.w * sol[26];
  __builtin_amdgcn_sched_barrier(0);
  b0a = *(const float4*)(Lr + 1744); b0b = *(const float4*)(Lr + 1748); b0c = *(const float4*)(Lr + 1752); b0d = *(const float4*)(Lr + 1756);
  __builtin_amdgcn_sched_barrier(0);
  sol[32] -= b1a.x * sol[26]; sol[33] -= b1a.y * sol[26]; sol[34] -= b1a.z * sol[26]; sol[35] -= b1a.w * sol[26]; sol[36] -= b1b.x * sol[26]; sol[37] -= b1b.y * sol[26]; sol[38] -= b1b.z * sol[26]; sol[39] -= b1b.w * sol[26]; sol[40] -= b1c.x * sol[26]; sol[41] -= b1c.y * sol[26]; sol[42] -= b1c.z * sol[26]; sol[43] -= b1c.w * sol[26]; sol[44] -= b1d.x * sol[26]; sol[45] -= b1d.y * sol[26]; sol[46] -= b1d.z * sol[26]; sol[47] -= b1d.w * sol[26];
  __builtin_amdgcn_sched_barrier(0);
  b1a = *(const float4*)(Lr + 1760); b1b = *(const float4*)(Lr + 1764); b1c = *(const float4*)(Lr + 1768); b1d = *(const float4*)(Lr + 1772);
  __builtin_amdgcn_sched_barrier(0);
  sol[48] -= b2a.x * sol[26]; sol[49] -= b2a.y * sol[26]; sol[50] -= b2a.z * sol[26]; sol[51] -= b2a.w * sol[26]; sol[52] -= b2b.x * sol[26]; sol[53] -= b2b.y * sol[26]; sol[54] -= b2b.z * sol[26]; sol[55] -= b2b.w * sol[26]; sol[56] -= b2c.x * sol[26]; sol[57] -= b2c.y * sol[26]; sol[58] -= b2c.z * sol[26]; sol[59] -= b2c.w * sol[26]; sol[60] -= b2d.x * sol[26]; sol[61] -= b2d.y * sol[26]; sol[62] -= b2d.z * sol[26]; sol[63] -= b2d.w * sol[26];
  __builtin_amdgcn_sched_barrier(0);
  b2a = *(const float4*)(Lr + 1776); b2b = *(const float4*)(Lr + 1780); b2c = *(const float4*)(Lr + 1784); b2d = *(const float4*)(Lr + 1788);
  __builtin_amdgcn_sched_barrier(0);
  sol[28] -= b0d.x * sol[27]; sol[29] -= b0d.y * sol[27]; sol[30] -= b0d.z * sol[27]; sol[31] -= b0d.w * sol[27];
  __builtin_amdgcn_sched_barrier(0);
  b0a = *(const float4*)(Lr + 1808); b0b = *(const float4*)(Lr + 1812); b0c = *(const float4*)(Lr + 1816); b0d = *(const float4*)(Lr + 1820);
  __builtin_amdgcn_sched_barrier(0);
  sol[32] -= b1a.x * sol[27]; sol[33] -= b1a.y * sol[27]; sol[34] -= b1a.z * sol[27]; sol[35] -= b1a.w * sol[27]; sol[36] -= b1b.x * sol[27]; sol[37] -= b1b.y * sol[27]; sol[38] -= b1b.z * sol[27]; sol[39] -= b1b.w * sol[27]; sol[40] -= b1c.x * sol[27]; sol[41] -= b1c.y * sol[27]; sol[42] -= b1c.z * sol[27]; sol[43] -= b1c.w * sol[27]; sol[44] -= b1d.x * sol[27]; sol[45] -= b1d.y * sol[27]; sol[46] -= b1d.z * sol[27]; sol[47] -= b1d.w * sol[27];
  __builtin_amdgcn_sched_barrier(0);
  b1a = *(const float4*)(Lr + 1824); b1b = *(const float4*)(Lr + 1828); b1c = *(const float4*)(Lr + 1832); b1d = *(const float4*)(Lr + 1836);
  __builtin_amdgcn_sched_barrier(0);
  sol[48] -= b2a.x * sol[27]; sol[49] -= b2a.y * sol[27]; sol[50] -= b2a.z * sol[27]; sol[51] -= b2a.w * sol[27]; sol[52] -= b2b.x * sol[27]; sol[53] -= b2b.y * sol[27]; sol[54] -= b2b.z * sol[27]; sol[55] -= b2b.w * sol[27]; sol[56] -= b2c.x * sol[27]; sol[57] -= b2c.y * sol[27]; sol[58] -= b2c.z * sol[27]; sol[59] -= b2c.w * sol[27]; sol[60] -= b2d.x * sol[27]; sol[61] -= b2d.y * sol[27]; sol[62] -= b2d.z * sol[27]; sol[63] -= b2d.w * sol[27];
  __builtin_amdgcn_sched_barrier(0);
  b2a = *(const float4*)(Lr + 1840); b2b = *(const float4*)(Lr + 1844); b2c = *(const float4*)(Lr + 1848); b2d = *(const float4*)(Lr + 1852);
  __builtin_amdgcn_sched_barrier(0);
  sol[29] -= b0d.y * sol[28]; sol[30] -= b0d.z * sol[28]; sol[31] -= b0d.w * sol[28];
  __builtin_amdgcn_sched_barrier(0);
  b0a = *(const float4*)(Lr + 1872); b0b = *(const float4*)(Lr + 1876); b0c = *(const float4*)(Lr + 1880); b0d = *(const float4*)(Lr + 1884);
  __builtin_amdgcn_sched_barrier(0);
  sol[32] -= b1a.x * sol[28]; sol[33] -= b1a.y * sol[28]; sol[34] -= b1a.z * sol[28]; sol[35] -= b1a.w * sol[28]; sol[36] -= b1b.x * sol[28]; sol[37] -= b1b.y * sol[28]; sol[38] -= b1b.z * sol[28]; sol[39] -= b1b.w * sol[28]; sol[40] -= b1c.x * sol[28]; sol[41] -= b1c.y * sol[28]; sol[42] -= b1c.z * sol[28]; sol[43] -= b1c.w * sol[28]; sol[44] -= b1d.x * sol[28]; sol[45] -= b1d.y * sol[28]; sol[46] -= b1d.z * sol[28]; sol[47] -= b1d.w * sol[28];
  __builtin_amdgcn_sched_barrier(0);
  b1a = *(const float4*)(Lr + 1888); b1b = *(const float4*)(Lr + 1892); b1c = *(const float4*)(Lr + 1896); b1d = *(const float4*)(Lr + 1900);
  __builtin_amdgcn_sched_barrier(0);
  sol[48] -= b2a.x * sol[28]; sol[49] -= b2a.y * sol[28]; sol[50] -= b2a.z * sol[28]; sol[51] -= b2a.w * sol[28]; sol[52] -= b2b.x * sol[28]; sol[53] -= b2b.y * sol[28]; sol[54] -= b2b.z * sol[28]; sol[55] -= b2b.w * sol[28]; sol[56] -= b2c.x * sol[28]; sol[57] -= b2c.y * sol[28]; sol[58] -= b2c.z * sol[28]; sol[59] -= b2c.w * sol[28]; sol[60] -= b2d.x * sol[28]; sol[61] -= b2d.y * sol[28]; sol[62] -= b2d.z * sol[28]; sol[63] -= b2d.w * sol[28];
  __builtin_amdgcn_sched_barrier(0);
  b2a = *(const float4*)(Lr + 1904); b2b = *(const float4*)(Lr + 1908); b2c = *(const float4*)(Lr + 1912); b2d = *(const float4*)(Lr + 1916);
  __builtin_amdgcn_sched_barrier(0);
  sol[30] -= b0d.z * sol[29]; sol[31] -= b0d.w * sol[29];
  __builtin_amdgcn_sched_barrier(0);
  b0a = *(const float4*)(Lr + 1936); b0b = *(const float4*)(Lr + 1940); b0c = *(const float4*)(Lr + 1944); b0d = *(const float4*)(Lr + 1948);
  __builtin_amdgcn_sched_barrier(0);
  sol[32] -= b1a.x * sol[29]; sol[33] -= b1a.y * sol[29]; sol[34] -= b1a.z * sol[29]; sol[35] -= b1a.w * sol[29]; sol[36] -= b1b.x * sol[29]; sol[37] -= b1b.y * sol[29]; sol[38] -= b1b.z * sol[29]; sol[39] -= b1b.w * sol[29]; sol[40] -= b1c.x * sol[29]; sol[41] -= b1c.y * sol[29]; sol[42] -= b1c.z * sol[29]; sol[43] -= b1c.w * sol[29]; sol[44] -= b1d.x * sol[29]; sol[45] -= b1d.y * sol[29]; sol[46] -= b1d.z * sol[29]; sol[47] -= b1d.w * sol[29];
  __builtin_amdgcn_sched_barrier(0);
  b1a = *(const float4*)(Lr + 1952); b1b = *(const float4*)(Lr + 1956); b1c = *(const float4*)(Lr + 1960); b1d = *(const float4*)(Lr + 1964);
  __builtin_amdgcn_sched_barrier(0);
  sol[48] -= b2a.x * sol[29]; sol[49] -= b2a.y * sol[29]; sol[50] -= b2a.z * sol[29]; sol[51] -= b2a.w * sol[29]; sol[52] -= b2b.x * sol[29]; sol[53] -= b2b.y * sol[29]; sol[54] -= b2b.z * sol[29]; sol[55] -= b2b.w * sol[29]; sol[56] -= b2c.x * sol[29]; sol[57] -= b2c.y * sol[29]; sol[58] -= b2c.z * sol[29]; sol[59] -= b2c.w * sol[29]; sol[60] -= b2d.x * sol[29]; sol[61] -= b2d.y * sol[29]; sol[62] -= b2d.z * sol[29]; sol[63] -= b2d.w * sol[29];
  __builtin_amdgcn_sched_barrier(0);
  b2a = *(const float4*)(Lr + 1968); b2b = *(const float4*)(Lr + 1972); b2c = *(const float4*)(Lr + 1976); b2d = *(const float4*)(Lr + 1980);
  __builtin_amdgcn_sched_barrier(0);
  sol[31] -= b0d.w * sol[30];
  __builtin_amdgcn_sched_barrier(0);
  b0a = *(const float4*)(Lr + 2016); b0b = *(const float4*)(Lr + 2020); b0c = *(const float4*)(Lr + 2024); b0d = *(const float4*)(Lr + 2028);
  __builtin_amdgcn_sched_barrier(0);
  sol[32] -= b1a.x * sol[30]; sol[33] -= b1a.y * sol[30]; sol[34] -= b1a.z * sol[30]; sol[35] -= b1a.w * sol[30]; sol[36] -= b1b.x * sol[30]; sol[37] -= b1b.y * sol[30]; sol[38] -= b1b.z * sol[30]; sol[39] -= b1b.w * sol[30]; sol[40] -= b1c.x * sol[30]; sol[41] -= b1c.y * sol[30]; sol[42] -= b1c.z * sol[30]; sol[43] -= b1c.w * sol[30]; sol[44] -= b1d.x * sol[30]; sol[45] -= b1d.y * sol[30]; sol[46] -= b1d.z * sol[30]; sol[47] -= b1d.w * sol[30];
  __builtin_amdgcn_sched_barrier(0);
  b1a = *(const float4*)(Lr + 2032); b1b = *(const float4*)(Lr + 2036); b1c = *(const float4*)(Lr + 2040); b1d = *(const float4*)(Lr + 2044);
  __builtin_amdgcn_sched_barrier(0);
  sol[48] -= b2a.x * sol[30]; sol[49] -= b2a.y * sol[30]; sol[50] -= b2a.z * sol[30]; sol[51] -= b2a.w * sol[30]; sol[52] -= b2b.x * sol[30]; sol[53] -= b2b.y * sol[30]; sol[54] -= b2b.z * sol[30]; sol[55] -= b2b.w * sol[30]; sol[56] -= b2c.x * sol[30]; sol[57] -= b2c.y * sol[30]; sol[58] -= b2c.z * sol[30]; sol[59] -= b2c.w * sol[30]; sol[60] -= b2d.x * sol[30]; sol[61] -= b2d.y * sol[30]; sol[62] -= b2d.z * sol[30]; sol[63] -= b2d.w * sol[30];
  __builtin_amdgcn_sched_barrier(0);
  b2a = *(const float4*)(Lr + 2080); b2b = *(const float4*)(Lr + 2084); b2c = *(const float4*)(Lr + 2088); b2d = *(const float4*)(Lr + 2092);
  __builtin_amdgcn_sched_barrier(0);
  sol[32] -= b0a.x * sol[31]; sol[33] -= b0a.y * sol[31]; sol[34] -= b0a.z * sol[31]; sol[35] -= b0a.w * sol[31]; sol[36] -= b0b.x * sol[31]; sol[37] -= b0b.y * sol[31]; sol[38] -= b0b.z * sol[31]; sol[39] -= b0b.w * sol[31]; sol[40] -= b0c.x * sol[31]; sol[41] -= b0c.y * sol[31]; sol[42] -= b0c.z * sol[31]; sol[43] -= b0c.w * sol[31]; sol[44] -= b0d.x * sol[31]; sol[45] -= b0d.y * sol[31]; sol[46] -= b0d.z * sol[31]; sol[47] -= b0d.w * sol[31];
  __builtin_amdgcn_sched_barrier(0);
  b0a = *(const float4*)(Lr + 2096); b0b = *(const float4*)(Lr + 2100); b0c = *(const float4*)(Lr + 2104); b0d = *(const float4*)(Lr + 2108);
  __builtin_amdgcn_sched_barrier(0);
  sol[48] -= b1a.x * sol[31]; sol[49] -= b1a.y * sol[31]; sol[50] -= b1a.z * sol[31]; sol[51] -= b1a.w * sol[31]; sol[52] -= b1b.x * sol[31]; sol[53] -= b1b.y * sol[31]; sol[54] -= b1b.z * sol[31]; sol[55] -= b1b.w * sol[31]; sol[56] -= b1c.x * sol[31]; sol[57] -= b1c.y * sol[31]; sol[58] -= b1c.z * sol[31]; sol[59] -= b1c.w * sol[31]; sol[60] -= b1d.x * sol[31]; sol[61] -= b1d.y * sol[31]; sol[62] -= b1d.z * sol[31]; sol[63] -= b1d.w * sol[31];
  __builtin_amdgcn_sched_barrier(0);
  b1a = *(const float4*)(Lr + 2144); b1b = *(const float4*)(Lr + 2148); b1c = *(const float4*)(Lr + 2152); b1d = *(const float4*)(Lr + 2156);
  __builtin_amdgcn_sched_barrier(0);
  sol[33] -= b2a.y * sol[32]; sol[34] -= b2a.z * sol[32]; sol[35] -= b2a.w * sol[32]; sol[36] -= b2b.x * sol[32]; sol[37] -= b2b.y * sol[32]; sol[38] -= b2b.z * sol[32]; sol[39] -= b2b.w * sol[32]; sol[40] -= b2c.x * sol[32]; sol[41] -= b2c.y * sol[32]; sol[42] -= b2c.z * sol[32]; sol[43] -= b2c.w * sol[32]; sol[44] -= b2d.x * sol[32]; sol[45] -= b2d.y * sol[32]; sol[46] -= b2d.z * sol[32]; sol[47] -= b2d.w * sol[32];
  __builtin_amdgcn_sched_barrier(0);
  b2a = *(const float4*)(Lr + 2160); b2b = *(const float4*)(Lr + 2164); b2c = *(const float4*)(Lr + 2168); b2d = *(const float4*)(Lr + 2172);
  __builtin_amdgcn_sched_barrier(0);
  sol[48] -= b0a.x * sol[32]; sol[49] -= b0a.y * sol[32]; sol[50] -= b0a.z * sol[32]; sol[51] -= b0a.w * sol[32]; sol[52] -= b0b.x * sol[32]; sol[53] -= b0b.y * sol[32]; sol[54] -= b0b.z * sol[32]; sol[55] -= b0b.w * sol[32]; sol[56] -= b0c.x * sol[32]; sol[57] -= b0c.y * sol[32]; sol[58] -= b0c.z * sol[32]; sol[59] -= b0c.w * sol[32]; sol[60] -= b0d.x * sol[32]; sol[61] -= b0d.y * sol[32]; sol[62] -= b0d.z * sol[32]; sol[63] -= b0d.w * sol[32];
  __builtin_amdgcn_sched_barrier(0);
  b0a = *(const float4*)(Lr + 2208); b0b = *(const float4*)(Lr + 2212); b0c = *(const float4*)(Lr + 2216); b0d = *(const float4*)(Lr + 2220);
  __builtin_amdgcn_sched_barrier(0);
  sol[34] -= b1a.z * sol[33]; sol[35] -= b1a.w * sol[33]; sol[36] -= b1b.x * sol[33]; sol[37] -= b1b.y * sol[33]; sol[38] -= b1b.z * sol[33]; sol[39] -= b1b.w * sol[33]; sol[40] -= b1c.x * sol[33]; sol[41] -= b1c.y * sol[33]; sol[42] -= b1c.z * sol[33]; sol[43] -= b1c.w * sol[33]; sol[44] -= b1d.x * sol[33]; sol[45] -= b1d.y * sol[33]; sol[46] -= b1d.z * sol[33]; sol[47] -= b1d.w * sol[33];
  __builtin_amdgcn_sched_barrier(0);
  b1a = *(const float4*)(Lr + 2224); b1b = *(const float4*)(Lr + 2228); b1c = *(const float4*)(Lr + 2232); b1d = *(const float4*)(Lr + 2236);
  __builtin_amdgcn_sched_barrier(0);
  sol[48] -= b2a.x * sol[33]; sol[49] -= b2a.y * sol[33]; sol[50] -= b2a.z * sol[33]; sol[51] -= b2a.w * sol[33]; sol[52] -= b2b.x * sol[33]; sol[53] -= b2b.y * sol[33]; sol[54] -= b2b.z * sol[33]; sol[55] -= b2b.w * sol[33]; sol[56] -= b2c.x * sol[33]; sol[57] -= b2c.y * sol[33]; sol[58] -= b2c.z * sol[33]; sol[59] -= b2c.w * sol[33]; sol[60] -= b2d.x * sol[33]; sol[61] -= b2d.y * sol[33]; sol[62] -= b2d.z * sol[33]; sol[63] -= b2d.w * sol[33];
  __builtin_amdgcn_sched_barrier(0);
  b2a = *(const float4*)(Lr + 2272); b2b = *(const float4*)(Lr + 2276); b2c = *(const float4*)(Lr + 2280); b2d = *(const float4*)(Lr + 2284);
  __builtin_amdgcn_sched_barrier(0);
  sol[35] -= b0a.w * sol[34]; sol[36] -= b0b.x * sol[34]; sol[37] -= b0b.y * sol[34]; sol[38] -= b0b.z * sol[34]; sol[39] -= b0b.w * sol[34]; sol[40] -= b0c.x * sol[34]; sol[41] -= b0c.y * sol[34]; sol[42] -= b0c.z * sol[34]; sol[43] -= b0c.w * sol[34]; sol[44] -= b0d.x * sol[34]; sol[45] -= b0d.y * sol[34]; sol[46] -= b0d.z * sol[34]; sol[47] -= b0d.w * sol[34];
  __builtin_amdgcn_sched_barrier(0);
  b0a = *(const float4*)(Lr + 2288); b0b = *(const float4*)(Lr + 2292); b0c = *(const float4*)(Lr + 2296); b0d = *(const float4*)(Lr + 2300);
  __builtin_amdgcn_sched_barrier(0);
  sol[48] -= b1a.x * sol[34]; sol[49] -= b1a.y * sol[34]; sol[50] -= b1a.z * sol[34]; sol[51] -= b1a.w * sol[34]; sol[52] -= b1b.x * sol[34]; sol[53] -= b1b.y * sol[34]; sol[54] -= b1b.z * sol[34]; sol[55] -= b1b.w * sol[34]; sol[56] -= b1c.x * sol[34]; sol[57] -= b1c.y * sol[34]; sol[58] -= b1c.z * sol[34]; sol[59] -= b1c.w * sol[34]; sol[60] -= b1d.x * sol[34]; sol[61] -= b1d.y * sol[34]; sol[62] -= b1d.z * sol[34]; sol[63] -= b1d.w * sol[34];
  __builtin_amdgcn_sched_barrier(0);
  b1a = *(const float4*)(Lr + 2336); b1b = *(const float4*)(Lr + 2340); b1c = *(const float4*)(Lr + 2344); b1d = *(const float4*)(Lr + 2348);
  __builtin_amdgcn_sched_barrier(0);
  sol[36] -= b2b.x * sol[35]; sol[37] -= b2b.y * sol[35]; sol[38] -= b2b.z * sol[35]; sol[39] -= b2b.w * sol[35]; sol[40] -= b2c.x * sol[35]; sol[41] -= b2c.y * sol[35]; sol[42] -= b2c.z * sol[35]; sol[43] -= b2c.w * sol[35]; sol[44] -= b2d.x * sol[35]; sol[45] -= b2d.y * sol[35]; sol[46] -= b2d.z * sol[35]; sol[47] -= b2d.w * sol[35];
  __builtin_amdgcn_sched_barrier(0);
  b2a = *(const float4*)(Lr + 2352); b2b = *(const float4*)(Lr + 2356); b2c = *(const float4*)(Lr + 2360); b2d = *(const float4*)(Lr + 2364);
  __builtin_amdgcn_sched_barrier(0);
  sol[48] -= b0a.x * sol[35]; sol[49] -= b0a.y * sol[35]; sol[50] -= b0a.z * sol[35]; sol[51] -= b0a.w * sol[35]; sol[52] -= b0b.x * sol[35]; sol[53] -= b0b.y * sol[35]; sol[54] -= b0b.z * sol[35]; sol[55] -= b0b.w * sol[35]; sol[56] -= b0c.x * sol[35]; sol[57] -= b0c.y * sol[35]; sol[58] -= b0c.z * sol[35]; sol[59] -= b0c.w * sol[35]; sol[60] -= b0d.x * sol[35]; sol[61] -= b0d.y * sol[35]; sol[62] -= b0d.z * sol[35]; sol[63] -= b0d.w * sol[35];
  __builtin_amdgcn_sched_barrier(0);
  b0a = *(const float4*)(Lr + 2400); b0b = *(const float4*)(Lr + 2404); b0c = *(const float4*)(Lr + 2408); b0d = *(const float4*)(Lr + 2412);
  __builtin_amdgcn_sched_barrier(0);
  sol[37] -= b1b.y * sol[36]; sol[38] -= b1b.z * sol[36]; sol[39] -= b1b.w * sol[36]; sol[40] -= b1c.x * sol[36]; sol[41] -= b1c.y * sol[36]; sol[42] -= b1c.z * sol[36]; sol[43] -= b1c.w * sol[36]; sol[44] -= b1d.x * sol[36]; sol[45] -= b1d.y * sol[36]; sol[46] -= b1d.z * sol[36]; sol[47] -= b1d.w * sol[36];
  __builtin_amdgcn_sched_barrier(0);
  b1a = *(const float4*)(Lr + 2416); b1b = *(const float4*)(Lr + 2420); b1c = *(const float4*)(Lr + 2424); b1d = *(const float4*)(Lr + 2428);
  __builtin_amdgcn_sched_barrier(0);
  sol[48] -= b2a.x * sol[36]; sol[49] -= b2a.y * sol[36]; sol[50] -= b2a.z * sol[36]; sol[51] -= b2a.w * sol[36]; sol[52] -= b2b.x * sol[36]; sol[53] -= b2b.y * sol[36]; sol[54] -= b2b.z * sol[36]; sol[55] -= b2b.w * sol[36]; sol[56] -= b2c.x * sol[36]; sol[57] -= b2c.y * sol[36]; sol[58] -= b2c.z * sol[36]; sol[59] -= b2c.w * sol[36]; sol[60] -= b2d.x * sol[36]; sol[61] -= b2d.y * sol[36]; sol[62] -= b2d.z * sol[36]; sol[63] -= b2d.w * sol[36];
  __builtin_amdgcn_sched_barrier(0);
  b2a = *(const float4*)(Lr + 2464); b2b = *(const float4*)(Lr + 2468); b2c = *(const float4*)(Lr + 2472); b2d = *(const float4*)(Lr + 2476);
  __builtin_amdgcn_sched_barrier(0);
  sol[38] -= b0b.z * sol[37]; sol[39] -= b0b.w * sol[37]; sol[40] -= b0c.x * sol[37]; sol[41] -= b0c.y * sol[37]; sol[42] -= b0c.z * sol[37]; sol[43] -= b0c.w * sol[37]; sol[44] -= b0d.x * sol[37]; sol[45] -= b0d.y * sol[37]; sol[46] -= b0d.z * sol[37]; sol[47] -= b0d.w * sol[37];
  __builtin_amdgcn_sched_barrier(0);
  b0a = *(const float4*)(Lr + 2480); b0b = *(const float4*)(Lr + 2484); b0c = *(const float4*)(Lr + 2488); b0d = *(const float4*)(Lr + 2492);
  __builtin_amdgcn_sched_barrier(0);
  sol[48] -= b1a.x * sol[37]; sol[49] -= b1a.y * sol[37]; sol[50] -= b1a.z * sol[37]; sol[51] -= b1a.w * sol[37]; sol[52] -= b1b.x * sol[37]; sol[53] -= b1b.y * sol[37]; sol[54] -= b1b.z * sol[37]; sol[55] -= b1b.w * sol[37]; sol[56] -= b1c.x * sol[37]; sol[57] -= b1c.y * sol[37]; sol[58] -= b1c.z * sol[37]; sol[59] -= b1c.w * sol[37]; sol[60] -= b1d.x * sol[37]; sol[61] -= b1d.y * sol[37]; sol[62] -= b1d.z * sol[37]; sol[63] -= b1d.w * sol[37];
  __builtin_amdgcn_sched_barrier(0);
  b1a = *(const float4*)(Lr + 2528); b1b = *(const float4*)(Lr + 2532); b1c = *(const float4*)(Lr + 2536); b1d = *(const float4*)(Lr + 2540);
  __builtin_amdgcn_sched_barrier(0);
  sol[39] -= b2b.w * sol[38]; sol[40] -= b2c.x * sol[38]; sol[41] -= b2c.y * sol[38]; sol[42] -= b2c.z * sol[38]; sol[43] -= b2c.w * sol[38]; sol[44] -= b2d.x * sol[38]; sol[45] -= b2d.y * sol[38]; sol[46] -= b2d.z * sol[38]; sol[47] -= b2d.w * sol[38];
  __builtin_amdgcn_sched_barrier(0);
  b2a = *(const float4*)(Lr + 2544); b2b = *(const float4*)(Lr + 2548); b2c = *(const float4*)(Lr + 2552); b2d = *(const float4*)(Lr + 2556);
  __builtin_amdgcn_sched_barrier(0);
  sol[48] -= b0a.x * sol[38]; sol[49] -= b0a.y * sol[38]; sol[50] -= b0a.z * sol[38]; sol[51] -= b0a.w * sol[38]; sol[52] -= b0b.x * sol[38]; sol[53] -= b0b.y * sol[38]; sol[54] -= b0b.z * sol[38]; sol[55] -= b0b.w * sol[38]; sol[56] -= b0c.x * sol[38]; sol[57] -= b0c.y * sol[38]; sol[58] -= b0c.z * sol[38]; sol[59] -= b0c.w * sol[38]; sol[60] -= b0d.x * sol[38]; sol[61] -= b0d.y * sol[38]; sol[62] -= b0d.z * sol[38]; sol[63] -= b0d.w * sol[38];
  __builtin_amdgcn_sched_barrier(0);
  b0a = *(const float4*)(Lr + 2592); b0b = *(const float4*)(Lr + 2596); b0c = *(const float4*)(Lr + 2600); b0d = *(const float4*)(Lr + 2604);
  __builtin_amdgcn_sched_barrier(0);
  sol[40] -= b1c.x * sol[39]; sol[41] -= b1c.y * sol[39]; sol[42] -= b1c.z * sol[39]; sol[43] -= b1c.w * sol[39]; sol[44] -= b1d.x * sol[39]; sol[45] -= b1d.y * sol[39]; sol[46] -= b1d.z * sol[39]; sol[47] -= b1d.w * sol[39];
  __builtin_amdgcn_sched_barrier(0);
  b1a = *(const float4*)(Lr + 2608); b1b = *(const float4*)(Lr + 2612); b1c = *(const float4*)(Lr + 2616); b1d = *(const float4*)(Lr + 2620);
  __builtin_amdgcn_sched_barrier(0);
  sol[48] -= b2a.x * sol[39]; sol[49] -= b2a.y * sol[39]; sol[50] -= b2a.z * sol[39]; sol[51] -= b2a.w * sol[39]; sol[52] -= b2b.x * sol[39]; sol[53] -= b2b.y * sol[39]; sol[54] -= b2b.z * sol[39]; sol[55] -= b2b.w * sol[39]; sol[56] -= b2c.x * sol[39]; sol[57] -= b2c.y * sol[39]; sol[58] -= b2c.z * sol[39]; sol[59] -= b2c.w * sol[39]; sol[60] -= b2d.x * sol[39]; sol[61] -= b2d.y * sol[39]; sol[62] -= b2d.z * sol[39]; sol[63] -= b2d.w * sol[39];
  __builtin_amdgcn_sched_barrier(0);
  b2a = *(const float4*)(Lr + 2656); b2b = *(const float4*)(Lr + 2660); b2c = *(const float4*)(Lr + 2664); b2d = *(const float4*)(Lr + 2668);
  __builtin_amdgcn_sched_barrier(0);
  sol[41] -= b0c.y * sol[40]; sol[42] -= b0c.z * sol[40]; sol[43] -= b0c.w * sol[40]; sol[44] -= b0d.x * sol[40]; sol[45] -= b0d.y * sol[40]; sol[46] -= b0d.z * sol[40]; sol[47] -= b0d.w * sol[40];
  __builtin_amdgcn_sched_barrier(0);
  b0a = *(const float4*)(Lr + 2672); b0b = *(const float4*)(Lr + 2676); b0c = *(const float4*)(Lr + 2680); b0d = *(const float4*)(Lr + 2684);
  __builtin_amdgcn_sched_barrier(0);
  sol[48] -= b1a.x * sol[40]; sol[49] -= b1a.y * sol[40]; sol[50] -= b1a.z * sol[40]; sol[51] -= b1a.w * sol[40]; sol[52] -= b1b.x * sol[40]; sol[53] -= b1b.y * sol[40]; sol[54] -= b1b.z * sol[40]; sol[55] -= b1b.w * sol[40]; sol[56] -= b1c.x * sol[40]; sol[57] -= b1c.y * sol[40]; sol[58] -= b1c.z * sol[40]; sol[59] -= b1c.w * sol[40]; sol[60] -= b1d.x * sol[40]; sol[61] -= b1d.y * sol[40]; sol[62] -= b1d.z * sol[40]; sol[63] -= b1d.w * sol[40];
  __builtin_amdgcn_sched_barrier(0);
  b1a = *(const float4*)(Lr + 2720); b1b = *(const float4*)(Lr + 2724); b1c = *(const float4*)(Lr + 2728); b1d = *(const float4*)(Lr + 2732);
  __builtin_amdgcn_sched_barrier(0);
  sol[42] -= b2c.z * sol[41]; sol[43] -= b2c.w * sol[41]; sol[44] -= b2d.x * sol[41]; sol[45] -= b2d.y * sol[41]; sol[46] -= b2d.z * sol[41]; sol[47] -= b2d.w * sol[41];
  __builtin_amdgcn_sched_barrier(0);
  b2a = *(const float4*)(Lr + 2736); b2b = *(const float4*)(Lr + 2740); b2c = *(const float4*)(Lr + 2744); b2d = *(const float4*)(Lr + 2748);
  __builtin_amdgcn_sched_barrier(0);
  sol[48] -= b0a.x * sol[41]; sol[49] -= b0a.y * sol[41]; sol[50] -= b0a.z * sol[41]; sol[51] -= b0a.w * sol[41]; sol[52] -= b0b.x * sol[41]; sol[53] -= b0b.y * sol[41]; sol[54] -= b0b.z * sol[41]; sol[55] -= b0b.w * sol[41]; sol[56] -= b0c.x * sol[41]; sol[57] -= b0c.y * sol[41]; sol[58] -= b0c.z * sol[41]; sol[59] -= b0c.w * sol[41]; sol[60] -= b0d.x * sol[41]; sol[61] -= b0d.y * sol[41]; sol[62] -= b0d.z * sol[41]; sol[63] -= b0d.w * sol[41];
  __builtin_amdgcn_sched_barrier(0);
  b0a = *(const float4*)(Lr + 2784); b0b = *(const float4*)(Lr + 2788); b0c = *(const float4*)(Lr + 2792); b0d = *(const float4*)(Lr + 2796);
  __builtin_amdgcn_sched_barrier(0);
  sol[43] -= b1c.w * sol[42]; sol[44] -= b1d.x * sol[42]; sol[45] -= b1d.y * sol[42]; sol[46] -= b1d.z * sol[42]; sol[47] -= b1d.w * sol[42];
  __builtin_amdgcn_sched_barrier(0);
  b1a = *(const float4*)(Lr + 2800); b1b = *(const float4*)(Lr + 2804); b1c = *(const float4*)(Lr + 2808); b1d = *(const float4*)(Lr + 2812);
  __builtin_amdgcn_sched_barrier(0);
  sol[48] -= b2a.x * sol[42]; sol[49] -= b2a.y * sol[42]; sol[50] -= b2a.z * sol[42]; sol[51] -= b2a.w * sol[42]; sol[52] -= b2b.x * sol[42]; sol[53] -= b2b.y * sol[42]; sol[54] -= b2b.z * sol[42]; sol[55] -= b2b.w * sol[42]; sol[56] -= b2c.x * sol[42]; sol[57] -= b2c.y * sol[42]; sol[58] -= b2c.z * sol[42]; sol[59] -= b2c.w * sol[42]; sol[60] -= b2d.x * sol[42]; sol[61] -= b2d.y * sol[42]; sol[62] -= b2d.z * sol[42]; sol[63] -= b2d.w * sol[42];
  __builtin_amdgcn_sched_barrier(0);
  b2a = *(const float4*)(Lr + 2848); b2b = *(const float4*)(Lr + 2852); b2c = *(const float4*)(Lr + 2856); b2d = *(const float4*)(Lr + 2860);
  __builtin_amdgcn_sched_barrier(0);
  sol[44] -= b0d.x * sol[43]; sol[45] -= b0d.y * sol[43]; sol[46] -= b0d.z * sol[43]; sol[47] -= b0d.w * sol[43];
  __builtin_amdgcn_sched_barrier(0);
  b0a = *(const float4*)(Lr + 2864); b0b = *(const float4*)(Lr + 2868); b0c = *(const float4*)(Lr + 2872); b0d = *(const float4*)(Lr + 2876);
  __builtin_amdgcn_sched_barrier(0);
  sol[48] -= b1a.x * sol[43]; sol[49] -= b1a.y * sol[43]; sol[50] -= b1a.z * sol[43]; sol[51] -= b1a.w * sol[43]; sol[52] -= b1b.x * sol[43]; sol[53] -= b1b.y * sol[43]; sol[54] -= b1b.z * sol[43]; sol[55] -= b1b.w * sol[43]; sol[56] -= b1c.x * sol[43]; sol[57] -= b1c.y * sol[43]; sol[58] -= b1c.z * sol[43]; sol[59] -= b1c.w * sol[43]; sol[60] -= b1d.x * sol[43]; sol[61] -= b1d.y * sol[43]; sol[62] -= b1d.z * sol[43]; sol[63] -= b1d.w * sol[43];
  __builtin_amdgcn_sched_barrier(0);
  b1a = *(const float4*)(Lr + 2912); b1b = *(const float4*)(Lr + 2916); b1c = *(const float4*)(Lr + 2920); b1d = *(const float4*)(Lr + 2924);
  __builtin_amdgcn_sched_barrier(0);
  sol[45] -= b2d.y * sol[44]; sol[46] -= b2d.z * sol[44]; sol[47] -= b2d.w * sol[44];
  __builtin_amdgcn_sched_barrier(0);
  b2a = *(const float4*)(Lr + 2928); b2b = *(const float4*)(Lr + 2932); b2c = *(const float4*)(Lr + 2936); b2d = *(const float4*)(Lr + 2940);
  __builtin_amdgcn_sched_barrier(0);
  sol[48] -= b0a.x * sol[44]; sol[49] -= b0a.y * sol[44]; sol[50] -= b0a.z * sol[44]; sol[51] -= b0a.w * sol[44]; sol[52] -= b0b.x * sol[44]; sol[53] -= b0b.y * sol[44]; sol[54] -= b0b.z * sol[44]; sol[55] -= b0b.w * sol[44]; sol[56] -= b0c.x * sol[44]; sol[57] -= b0c.y * sol[44]; sol[58] -= b0c.z * sol[44]; sol[59] -= b0c.w * sol[44]; sol[60] -= b0d.x * sol[44]; sol[61] -= b0d.y * sol[44]; sol[62] -= b0d.z * sol[44]; sol[63] -= b0d.w * sol[44];
  __builtin_amdgcn_sched_barrier(0);
  b0a = *(const float4*)(Lr + 2976); b0b = *(const float4*)(Lr + 2980); b0c = *(const float4*)(Lr + 2984); b0d = *(const float4*)(Lr + 2988);
  __builtin_amdgcn_sched_barrier(0);
  sol[46] -= b1d.z * sol[45]; sol[47] -= b1d.w * sol[45];
  __builtin_amdgcn_sched_barrier(0);
  b1a = *(const float4*)(Lr + 2992); b1b = *(const float4*)(Lr + 2996); b1c = *(const float4*)(Lr + 3000); b1d = *(const float4*)(Lr + 3004);
  __builtin_amdgcn_sched_barrier(0);
  sol[48] -= b2a.x * sol[45]; sol[49] -= b2a.y * sol[45]; sol[50] -= b2a.z * sol[45]; sol[51] -= b2a.w * sol[45]; sol[52] -= b2b.x * sol[45]; sol[53] -= b2b.y * sol[45]; sol[54] -= b2b.z * sol[45]; sol[55] -= b2b.w * sol[45]; sol[56] -= b2c.x * sol[45]; sol[57] -= b2c.y * sol[45]; sol[58] -= b2c.z * sol[45]; sol[59] -= b2c.w * sol[45]; sol[60] -= b2d.x * sol[45]; sol[61] -= b2d.y * sol[45]; sol[62] -= b2d.z * sol[45]; sol[63] -= b2d.w * sol[45];
  __builtin_amdgcn_sched_barrier(0);
  b2a = *(const float4*)(Lr + 3056); b2b = *(const float4*)(Lr + 3060); b2c = *(const float4*)(Lr + 3064); b2d = *(const float4*)(Lr + 3068);
  __builtin_amdgcn_sched_barrier(0);
  sol[47] -= b0d.w * sol[46];
  __builtin_amdgcn_sched_barrier(0);
  b0a = *(const float4*)(Lr + 3120); b0b = *(const float4*)(Lr + 3124); b0c = *(const float4*)(Lr + 3128); b0d = *(const float4*)(Lr + 3132);
  __builtin_amdgcn_sched_barrier(0);
  sol[48] -= b1a.x * sol[46]; sol[49] -= b1a.y * sol[46]; sol[50] -= b1a.z * sol[46]; sol[51] -= b1a.w * sol[46]; sol[52] -= b1b.x * sol[46]; sol[53] -= b1b.y * sol[46]; sol[54] -= b1b.z * sol[46]; sol[55] -= b1b.w * sol[46]; sol[56] -= b1c.x * sol[46]; sol[57] -= b1c.y * sol[46]; sol[58] -= b1c.z * sol[46]; sol[59] -= b1c.w * sol[46]; sol[60] -= b1d.x * sol[46]; sol[61] -= b1d.y * sol[46]; sol[62] -= b1d.z * sol[46]; sol[63] -= b1d.w * sol[46];
  __builtin_amdgcn_sched_barrier(0);
  b1a = *(const float4*)(Lr + 3184); b1b = *(const float4*)(Lr + 3188); b1c = *(const float4*)(Lr + 3192); b1d = *(const float4*)(Lr + 3196);
  __builtin_amdgcn_sched_barrier(0);
  sol[48] -= b2a.x * sol[47]; sol[49] -= b2a.y * sol[47]; sol[50] -= b2a.z * sol[47]; sol[51] -= b2a.w * sol[47]; sol[52] -= b2b.x * sol[47]; sol[53] -= b2b.y * sol[47]; sol[54] -= b2b.z * sol[47]; sol[55] -= b2b.w * sol[47]; sol[56] -= b2c.x * sol[47]; sol[57] -= b2c.y * sol[47]; sol[58] -= b2c.z * sol[47]; sol[59] -= b2c.w * sol[47]; sol[60] -= b2d.x * sol[47]; sol[61] -= b2d.y * sol[47]; sol[62] -= b2d.z * sol[47]; sol[63] -= b2d.w * sol[47];
  __builtin_amdgcn_sched_barrier(0);
  b2a = *(const float4*)(Lr + 3248); b2b = *(const float4*)(Lr + 3252); b2c = *(const float4*)(Lr + 3256); b2d = *(const float4*)(Lr + 3260);
  __builtin_amdgcn_sched_barrier(0);
  sol[49] -= b0a.y * sol[48]; sol[50] -= b0a.z * sol[48]; sol[51] -= b0a.w * sol[48]; sol[52] -= b0b.x * sol[48]; sol[53] -= b0b.y * sol[48]; sol[54] -= b0b.z * sol[48]; sol[55] -= b0b.w * sol[48]; sol[56] -= b0c.x * sol[48]; sol[57] -= b0c.y * sol[48]; sol[58] -= b0c.z * sol[48]; sol[59] -= b0c.w * sol[48]; sol[60] -= b0d.x * sol[48]; sol[61] -= b0d.y * sol[48]; sol[62] -= b0d.z * sol[48]; sol[63] -= b0d.w * sol[48];
  __builtin_amdgcn_sched_barrier(0);
  b0a = *(const float4*)(Lr + 3312); b0b = *(const float4*)(Lr + 3316); b0c = *(const float4*)(Lr + 3320); b0d = *(const float4*)(Lr + 3324);
  __builtin_amdgcn_sched_barrier(0);
  sol[50] -= b1a.z * sol[49]; sol[51] -= b1a.w * sol[49]; sol[52] -= b1b.x * sol[49]; sol[53] -= b1b.y * sol[49]; sol[54] -= b1b.z * sol[49]; sol[55] -= b1b.w * sol[49]; sol[56] -= b1c.x * sol[49]; sol[57] -= b1c.y * sol[49]; sol[58] -= b1c.z * sol[49]; sol[59] -= b1c.w * sol[49]; sol[60] -= b1d.x * sol[49]; sol[61] -= b1d.y * sol[49]; sol[62] -= b1d.z * sol[49]; sol[63] -= b1d.w * sol[49];
  __builtin_amdgcn_sched_barrier(0);
  b1a = *(const float4*)(Lr + 3376); b1b = *(const float4*)(Lr + 3380); b1c = *(const float4*)(Lr + 3384); b1d = *(const float4*)(Lr + 3388);
  __builtin_amdgcn_sched_barrier(0);
  sol[51] -= b2a.w * sol[50]; sol[52] -= b2b.x * sol[50]; sol[53] -= b2b.y * sol[50]; sol[54] -= b2b.z * sol[50]; sol[55] -= b2b.w * sol[50]; sol[56] -= b2c.x * sol[50]; sol[57] -= b2c.y * sol[50]; sol[58] -= b2c.z * sol[50]; sol[59] -= b2c.w * sol[50]; sol[60] -= b2d.x * sol[50]; sol[61] -= b2d.y * sol[50]; sol[62] -= b2d.z * sol[50]; sol[63] -= b2d.w * sol[50];
  __builtin_amdgcn_sched_barrier(0);
  b2a = *(const float4*)(Lr + 3440); b2b = *(const float4*)(Lr + 3444); b2c = *(const float4*)(Lr + 3448); b2d = *(const float4*)(Lr + 3452);
  __builtin_amdgcn_sched_barrier(0);
  sol[52] -= b0b.x * sol[51]; sol[53] -= b0b.y * sol[51]; sol[54] -= b0b.z * sol[51]; sol[55] -= b0b.w * sol[51]; sol[56] -= b0c.x * sol[51]; sol[57] -= b0c.y * sol[51]; sol[58] -= b0c.z * sol[51]; sol[59] -= b0c.w * sol[51]; sol[60] -= b0d.x * sol[51]; sol[61] -= b0d.y * sol[51]; sol[62] -= b0d.z * sol[51]; sol[63] -= b0d.w * sol[51];
  __builtin_amdgcn_sched_barrier(0);
  b0a = *(const float4*)(Lr + 3504); b0b = *(const float4*)(Lr + 3508); b0c = *(const float4*)(Lr + 3512); b0d = *(const float4*)(Lr + 3516);
  __builtin_amdgcn_sched_barrier(0);
  sol[53] -= b1b.y * sol[52]; sol[54] -= b1b.z * sol[52]; sol[55] -= b1b.w * sol[52]; sol[56] -= b1c.x * sol[52]; sol[57] -= b1c.y * sol[52]; sol[58] -= b1c.z * sol[52]; sol[59] -= b1c.w * sol[52]; sol[60] -= b1d.x * sol[52]; sol[61] -= b1d.y * sol[52]; sol[62] -= b1d.z * sol[52]; sol[63] -= b1d.w * sol[52];
  __builtin_amdgcn_sched_barrier(0);
  b1a = *(const float4*)(Lr + 3568); b1b = *(const float4*)(Lr + 3572); b1c = *(const float4*)(Lr + 3576); b1d = *(const float4*)(Lr + 3580);
  __builtin_amdgcn_sched_barrier(0);
  sol[54] -= b2b.z * sol[53]; sol[55] -= b2b.w * sol[53]; sol[56] -= b2c.x * sol[53]; sol[57] -= b2c.y * sol[53]; sol[58] -= b2c.z * sol[53]; sol[59] -= b2c.w * sol[53]; sol[60] -= b2d.x * sol[53]; sol[61] -= b2d.y * sol[53]; sol[62] -= b2d.z * sol[53]; sol[63] -= b2d.w * sol[53];
  __builtin_amdgcn_sched_barrier(0);
  b2a = *(const float4*)(Lr + 3632); b2b = *(const float4*)(Lr + 3636); b2c = *(const float4*)(Lr + 3640); b2d = *(const float4*)(Lr + 3644);
  __builtin_amdgcn_sched_barrier(0);
  sol[55] -= b0b.w * sol[54]; sol[56] -= b0c.x * sol[54]; sol[57] -= b0c.y * sol[54]; sol[58] -= b0c.z * sol[54]; sol[59] -= b0c.w * sol[54]; sol[60] -= b0d.x * sol[54]; sol[61] -= b0d.y * sol[54]; sol[62] -= b0d.z * sol[54]; sol[63] -= b0d.w * sol[54];
  __builtin_amdgcn_sched_barrier(0);
  b0a = *(const float4*)(Lr + 3696); b0b = *(const float4*)(Lr + 3700); b0c = *(const float4*)(Lr + 3704); b0d = *(const float4*)(Lr + 3708);
  __builtin_amdgcn_sched_barrier(0);
  sol[56] -= b1c.x * sol[55]; sol[57] -= b1c.y * sol[55]; sol[58] -= b1c.z * sol[55]; sol[59] -= b1c.w * sol[55]; sol[60] -= b1d.x * sol[55]; sol[61] -= b1d.y * sol[55]; sol[62] -= b1d.z * sol[55]; sol[63] -= b1d.w * sol[55];
  __builtin_amdgcn_sched_barrier(0);
  b1a = *(const float4*)(Lr + 3760); b1b = *(const float4*)(Lr + 3764); b1c = *(const float4*)(Lr + 3768); b1d = *(const float4*)(Lr + 3772);
  __builtin_amdgcn_sched_barrier(0);
  sol[57] -= b2c.y * sol[56]; sol[58] -= b2c.z * sol[56]; sol[59] -= b2c.w * sol[56]; sol[60] -= b2d.x * sol[56]; sol[61] -= b2d.y * sol[56]; sol[62] -= b2d.z * sol[56]; sol[63] -= b2d.w * sol[56];
  __builtin_amdgcn_sched_barrier(0);
  b2a = *(const float4*)(Lr + 3824); b2b = *(const float4*)(Lr + 3828); b2c = *(const float4*)(Lr + 3832); b2d = *(const float4*)(Lr + 3836);
  __builtin_amdgcn_sched_barrier(0);
  sol[58] -= b0c.z * sol[57]; sol[59] -= b0c.w * sol[57]; sol[60] -= b0d.x * sol[57]; sol[61] -= b0d.y * sol[57]; sol[62] -= b0d.z * sol[57]; sol[63] -= b0d.w * sol[57];
  __builtin_amdgcn_sched_barrier(0);
  b0a = *(const float4*)(Lr + 3888); b0b = *(const float4*)(Lr + 3892); b0c = *(const float4*)(Lr + 3896); b0d = *(const float4*)(Lr + 3900);
  __builtin_amdgcn_sched_barrier(0);
  sol[59] -= b1c.w * sol[58]; sol[60] -= b1d.x * sol[58]; sol[61] -= b1d.y * sol[58]; sol[62] -= b1d.z * sol[58]; sol[63] -= b1d.w * sol[58];
  __builtin_amdgcn_sched_barrier(0);
  b1a = *(const float4*)(Lr + 3952); b1b = *(const float4*)(Lr + 3956); b1c = *(const float4*)(Lr + 3960); b1d = *(const float4*)(Lr + 3964);
  __builtin_amdgcn_sched_barrier(0);
  sol[60] -= b2d.x * sol[59]; sol[61] -= b2d.y * sol[59]; sol[62] -= b2d.z * sol[59]; sol[63] -= b2d.w * sol[59];
  __builtin_amdgcn_sched_barrier(0);
  b2a = *(const float4*)(Lr + 4016); b2b = *(const float4*)(Lr + 4020); b2c = *(const float4*)(Lr + 4024); b2d = *(const float4*)(Lr + 4028);
  __builtin_amdgcn_sched_barrier(0);
  sol[61] -= b0d.y * sol[60]; sol[62] -= b0d.z * sol[60]; sol[63] -= b0d.w * sol[60];
  __builtin_amdgcn_sched_barrier(0);
  __builtin_amdgcn_sched_barrier(0);
  sol[62] -= b1d.z * sol[61]; sol[63] -= b1d.w * sol[61];
  __builtin_amdgcn_sched_barrier(0);
  __builtin_amdgcn_sched_barrier(0);
  sol[63] -= b2d.w * sol[62];
  __builtin_amdgcn_sched_barrier(0);
}

template <int DIR>
__device__ __forceinline__ void solve_cols(const Params& P, int itb, int c, const float* Lt, const float* bpp, const float* gcp,
                                           const u16* Vs, const u16* Ks) {
  float sol[64];
  const float* bp_ = bpp + DIR * 64;
  const float* gc_ = gcp + DIR * 64;
  if (c < 128) {
    const u16* vp = Vs + c;
#pragma unroll
    for (int p = 0; p < 64; ++p) sol[p] = bp_[p] * bf2f(vp[(DIR ? (63 - p) : p) * 136]);
  } else {
    const u16* kp = Ks + (c - 128);
#pragma unroll
    for (int p = 0; p < 64; ++p) sol[p] = bp_[p] * __expf(gc_[p]) * bf2f(kp[(DIR ? (63 - p) : p) * 136]);
  }
  const float* Lr = Lt + opq(DIR * 4096);
  solve_elim(sol, Lr);
  const size_t it2 = (size_t)(itb + DIR);
  if (c < 128) {
    u16* UF = (u16*)(P.ws + OFF_UF) + (it2 * 128 + c) * 64;
#pragma unroll
    for (int q = 0; q < 8; ++q) *(uint4*)(UF + q * 8) = pack8(sol + q * 8);
  } else {
    u16* Wg = (u16*)(P.ws + OFF_R2) + it2 * 8192 + (c - 128);
#pragma unroll
    for (int p = 0; p < 64; ++p) Wg[p * 128] = f2bf(-sol[p]);
  }
}

__device__ __forceinline__ void delta_prep_item(const Params& P, int item, char* lds) {
  const int tid = opq(threadIdx.x), lane = tid & 63, wv = tid >> 6, fr = lane & 15, fq = lane >> 4;
  const int cid = item >> 2, h = item & 3;
  const int row0 = cid * 64;
  int seq_lo, seq_hi;
  if (cid < 256) { seq_lo = (cid >> 6) * 4096; seq_hi = seq_lo + 4096; }
  else { seq_lo = 16384 + ((cid - 256) >> 2) * 256; seq_hi = seq_lo + 256; }
  u16* Qs = (u16*)(lds + opq(0));
  u16* Ks = (u16*)(lds + opq(17408));
  u16* Vs = (u16*)(lds + opq(34816));
  float* KKs = (float*)(lds + opq(52224));
  float* QKs = (float*)(lds + opq(69632));
  float* Lt = (float*)(lds + opq(87040));
  float* gtok = (float*)(lds + opq(119808));
  float* btok = gtok + 128;
  float* gcp = btok + 128;
  float* bpp = gcp + 128;
  u16* QKN = (u16*)((char*)P.out + OFF_QKN);
  lds_barrier();
  {
    const int j = tid >> 3, sg = tid & 7;
    const int row = row0 + j;
    const bool hm = (row - 1 >= seq_lo), hp = (row + 1 < seq_hi);
    const u16* qkv = (const u16*)(P.ws + OFF_R3);
#pragma unroll
    for (int s = 0; s < 3; ++s) {
      const int col = s * 512 + h * 128 + sg * 16;
      const u16* p0 = qkv + (size_t)row * 1536 + col;
      float y[16];
      float ssq = 0.f;
#pragma unroll
      for (int hh = 0; hh < 2; ++hh) {
        const uint4 c0 = *(const uint4*)(p0 + hh * 8);
        uint4 m0 = *(const uint4*)(p0 - (hm ? 1536 : 0) + hh * 8);
        uint4 n0 = *(const uint4*)(p0 + (hp ? 1536 : 0) + hh * 8);
        m0.x = hm ? m0.x : 0u; m0.y = hm ? m0.y : 0u; m0.z = hm ? m0.z : 0u; m0.w = hm ? m0.w : 0u;
        n0.x = hp ? n0.x : 0u; n0.y = hp ? n0.y : 0u; n0.z = hp ? n0.z : 0u; n0.w = hp ? n0.w : 0u;
        float fc[8], fm[8], fn[8];
        unpack8(c0, fc); unpack8(m0, fm); unpack8(n0, fn);
        const float* cwp = P.dn_conv_w + col + hh * 8;
        float cw0[8], cw1[8], cw2[8];
        {
          const float4 t0 = *(const float4*)(cwp), t1 = *(const float4*)(cwp + 4);
          const float4 t2 = *(const float4*)(cwp + 1536), t3 = *(const float4*)(cwp + 1540);
          const float4 t4 = *(const float4*)(cwp + 3072), t5 = *(const float4*)(cwp + 3076);
          cw0[0] = t0.x; cw0[1] = t0.y; cw0[2] = t0.z; cw0[3] = t0.w; cw0[4] = t1.x; cw0[5] = t1.y; cw0[6] = t1.z; cw0[7] = t1.w;
          cw1[0] = t2.x; cw1[1] = t2.y; cw1[2] = t2.z; cw1[3] = t2.w; cw1[4] = t3.x; cw1[5] = t3.y; cw1[6] = t3.z; cw1[7] = t3.w;
          cw2[0] = t4.x; cw2[1] = t4.y; cw2[2] = t4.z; cw2[3] = t4.w; cw2[4] = t5.x; cw2[5] = t5.y; cw2[6] = t5.z; cw2[7] = t5.w;
        }
#pragma unroll
        for (int e = 0; e < 8; ++e) {
          const float v = cw0[e] * fm[e] + cw1[e] * fc[e] + cw2[e] * fn[e];
          const float yy = v * sigm(v);
          y[hh * 8 + e] = yy;
          ssq += yy * yy;
        }
      }
      if (s < 2) {
        ssq += __shfl_xor(ssq, 1, 64); ssq += __shfl_xor(ssq, 2, 64); ssq += __shfl_xor(ssq, 4, 64);
        const float sc = rsqrtf(ssq + 1e-6f) * ((s == 0) ? 0.08838834764831845f : 1.f);
#pragma unroll
        for (int e = 0; e < 16; ++e) y[e] *= sc;
      }
      u16* dl = ((s == 0) ? Qs : ((s == 1) ? Ks : Vs)) + j * 136 + sg * 16;
      const uint4 o0 = pack8(y), o1 = pack8(y + 8);
      *(uint4*)dl = o0; *(uint4*)(dl + 8) = o1;
      if (s < 2) {
        u16* dg = QKN + (size_t)row * 1024 + s * 512 + h * 128 + sg * 16;
        *(uint4*)dg = o0; *(uint4*)(dg + 8) = o1;
      }
    }
  }
  if (tid < 128) {
    const int j = tid & 63, dir = tid >> 6;
    const float* BA = (const float*)(P.ws + OFF_BA) + (size_t)(row0 + j) * 16;
    const float bl = BA[dir * 4 + h], al = BA[8 + dir * 4 + h];
    const float xx = al + P.dn_dt_bias[dir * 4 + h];
    const float sp = (xx > 20.f) ? xx : log1pf(expf(xx));
    gtok[dir * 64 + j] = -expf(P.dn_a_log[dir * 4 + h]) * sp;
    btok[dir * 64 + j] = 1.f / (1.f + expf(-bl));
  }
  lds_barrier();
  if (tid < 128) {
    const int dir = tid >> 6, p = tid & 63;
    const int tk = dir ? (63 - p) : p;
    float a = gtok[dir * 64 + tk];
    const float bv = btok[dir * 64 + tk];
#pragma unroll
    for (int o = 1; o < 64; o <<= 1) {
      const float t = __shfl_up(a, o, 64);
      if (p >= o) a += t;
    }
    gcp[dir * 64 + p] = a;
    bpp[dir * 64 + p] = bv;
  }
  {
#pragma unroll
    for (int q = 0; q < 4; ++q) {
      const int t = wv * 4 + q;
      const int which = t >> 4, mi = (t >> 2) & 3, ni = t & 3;
      const u16* Am = (which ? Qs : Ks) + (mi * 16 + fr) * 136 + fq * 8;
      const u16* Bm = Ks + (ni * 16 + fr) * 136 + fq * 8;
      f32x4 a4 = {0.f, 0.f, 0.f, 0.f};
#pragma unroll
      for (int kk = 0; kk < 4; ++kk)
        a4 = __builtin_amdgcn_mfma_f32_16x16x32_bf16(*(const bf16x8*)(Am + kk * 32), *(const bf16x8*)(Bm + kk * 32), a4, 0, 0, 0);
      float* dst = which ? QKs : KKs;
#pragma unroll
      for (int e = 0; e < 4; ++e) dst[(mi * 16 + fq * 4 + e) * 68 + ni * 16 + fr] = a4[e];
    }
  }
  lds_barrier();
  const int itb = item * 2;
  {
    u16* AQ = (u16*)((char*)P.out + OFF_AQ);
#pragma unroll 8
    for (int idx = tid; idx < 8192; idx += NT) {
      const int dir = idx >> 12, p = (idx >> 6) & 63, s = idx & 63;
      const int tp = dir ? (63 - p) : p, ts = dir ? (63 - s) : s;
      const float dg = gcp[dir * 64 + p] - gcp[dir * 64 + s];
      const float dec = (p >= s) ? __expf(dg) : 0.f;
      AQ[((size_t)(itb + dir) * 64 + p) * 64 + s] = f2bf(QKs[tp * 68 + ts] * dec);
    }
#pragma unroll 8
    for (int idx = tid; idx < 8192; idx += NT) {
      const int dir = idx >> 12, s = (idx >> 6) & 63, p = idx & 63;
      const int tp = dir ? (63 - p) : p, ts = dir ? (63 - s) : s;
      const float dg = gcp[dir * 64 + p] - gcp[dir * 64 + s];
      const float lv = (p > s) ? bpp[dir * 64 + p] * KKs[ts * 68 + tp] * __expf(dg) : 0.f;
      Lt[dir * 4096 + s * 64 + p] = lv;
    }
    if (tid < 128) {
      float* GC = (float*)(P.ws + OFF_GC);
      GC[(size_t)(itb + (tid >> 6)) * 64 + (tid & 63)] = gcp[tid];
    }
  }
  lds_barrier();
  if (tid < 256) solve_cols<0>(P, itb, tid, Lt, bpp, gcp, Vs, Ks);
  else solve_cols<1>(P, itb, tid - 256, Lt, bpp, gcp, Vs, Ks);
}

__device__ __forceinline__ void s5end_tile(const Params& P, int t, char* lds) {
  const int g = t / 6, mt = (t % 6) >> 1, nt = t & 1;
  const int m0 = mt * 256, n0 = nt * 128;
  f32x16 acc[2][2];
  acc_zero(acc);
  gemm_main((const u16*)(P.ws + OFF_U5) + ((size_t)g * 544 + m0) * 512, 512,
            (const u16*)(P.ws + OFF_MEND) + ((size_t)g * 256 + n0) * 512, 512, 512, acc, (u16*)lds);
  TILE_COORDS
  float* E = (float*)(P.ws + OFF_E);
#pragma unroll
  for (int i = 0; i < 2; ++i)
#pragma unroll
    for (int j = 0; j < 2; ++j)
#pragma unroll
      for (int e = 0; e < 16; ++e) {
        const int row = TROW(m0, i, e);
        if (row < 544) E[((size_t)g * 544 + row) * 256 + TCOL(n0, j)] = acc[i][j][e];
      }
}

__device__ __forceinline__ void scan_chunk(const u16* Wl, const u16* QTl, const u16* KTl, const u16* AQl, u16* ST, u16* VT,
                                           int wd, int wq, int fr, int fq, float gl, f32x4& av, f32x4& ao, f32x4& accS0, f32x4& accS1) {
  {
    bf16x8 bS[4], a1[4], a2[4];
#pragma unroll
    for (int kk = 0; kk < 4; ++kk) {
      bS[kk] = *(const bf16x8*)(ST + (wd * 16 + fr) * 136 + kk * 32 + fq * 8);
      a1[kk] = *(const bf16x8*)(Wl + (wq * 16 + fr) * 136 + kk * 32 + fq * 8);
      a2[kk] = *(const bf16x8*)(QTl + (wq * 16 + fr) * 136 + kk * 32 + fq * 8);
    }
    __builtin_amdgcn_sched_barrier(0);
#pragma unroll
    for (int kk = 0; kk < 4; ++kk) {
      av = __builtin_amdgcn_mfma_f32_16x16x32_bf16(a1[kk], bS[kk], av, 0, 0, 0);
      ao = __builtin_amdgcn_mfma_f32_16x16x32_bf16(a2[kk], bS[kk], ao, 0, 0, 0);
    }
  }
  {
    uint2 v; v.x = pack2(av[0], av[1]); v.y = pack2(av[2], av[3]);
    *(uint2*)(VT + (wd * 16 + fr) * 72 + wq * 16 + fq * 4) = v;
  }
  bf16x8 qa[2], k0[2], k1[2];
#pragma unroll
  for (int ks = 0; ks < 2; ++ks) {
    qa[ks] = *(const bf16x8*)(AQl + (wq * 16 + fr) * 72 + ks * 32 + fq * 8);
    const int r0_ = (2 * wq) * 16 + fr, r1_ = (2 * wq + 1) * 16 + fr;
    k0[ks] = *(const bf16x8*)(KTl + r0_ * 72 + ((ks * 32 + fq * 8) ^ (((r0_ >> 3) & 7) << 3)));
    k1[ks] = *(const bf16x8*)(KTl + r1_ * 72 + ((ks * 32 + fq * 8) ^ (((r1_ >> 3) & 7) << 3)));
  }
  accS0[0] *= gl; accS0[1] *= gl; accS0[2] *= gl; accS0[3] *= gl;
  accS1[0] *= gl; accS1[1] *= gl; accS1[2] *= gl; accS1[3] *= gl;
  lds_barrier();
  {
    bf16x8 bV[2];
#pragma unroll
    for (int ks = 0; ks < 2; ++ks) bV[ks] = *(const bf16x8*)(VT + (wd * 16 + fr) * 72 + ks * 32 + fq * 8);
#pragma unroll
    for (int ks = 0; ks < 2; ++ks) {
      ao = __builtin_amdgcn_mfma_f32_16x16x32_bf16(qa[ks], bV[ks], ao, 0, 0, 0);
      accS0 = __builtin_amdgcn_mfma_f32_16x16x32_bf16(k0[ks], bV[ks], accS0, 0, 0, 0);
      accS1 = __builtin_amdgcn_mfma_f32_16x16x32_bf16(k1[ks], bV[ks], accS1, 0, 0, 0);
    }
  }
  {
    uint2 v; v.x = pack2(accS0[0], accS0[1]); v.y = pack2(accS0[2], accS0[3]);
    *(uint2*)(ST + (wd * 16 + fr) * 136 + (2 * wq) * 16 + fq * 4) = v;
    v.x = pack2(accS1[0], accS1[1]); v.y = pack2(accS1[2], accS1[3]);
    *(uint2*)(ST + (wd * 16 + fr) * 136 + (2 * wq + 1) * 16 + fq * 4) = v;
  }
}

__device__ __forceinline__ void delta_scan_block(const Params& P, int sb, char* lds) {
  const int tid = opq(threadIdx.x), lane = tid & 63, w = tid >> 6, fr = lane & 15, fq = lane >> 4;
  const int bhd = sb & 31, dvq = sb >> 5;
  const int b = bhd >> 3, h = (bhd >> 1) & 3, dir = bhd & 1;
  const int wd = w & 1, wq = w >> 1;
  const int dv0 = dvq * 32 + wd * 16;
  u16* Wl = (u16*)(lds + opq(0));
  u16* QTl = (u16*)(lds + opq(17408));
  u16* KTl = (u16*)(lds + opq(34816));
  u16* AQl = (u16*)(lds + opq(53248));
  u16* ST = (u16*)(lds + opq(62464));
  u16* VT = (u16*)(lds + opq(71168));
  lds_barrier();
  for (int i = tid; i < 32 * 136 / 2; i += NT) ((uint32_t*)ST)[i] = 0u;
  f32x4 accS0 = {0.f, 0.f, 0.f, 0.f}, accS1 = {0.f, 0.f, 0.f, 0.f};
  const u16* QKN = (const u16*)((const char*)P.out + OFF_QKN);
  const u16* AQg = (const u16*)((const char*)P.out + OFF_AQ);
  const u16* Wg = (const u16*)(P.ws + OFF_R2);
  const u16* UFg = (const u16*)(P.ws + OFF_UF);
  const float* GC = (const float*)(P.ws + OFF_GC);
  u16* Og = (u16*)(P.ws + OFF_O);

#define GLD16(dst, ptr) asm volatile("global_load_dwordx4 %0, %1, off" : "=v"(dst) : "v"(ptr) : "memory")
#define GLD8(dst, ptr) asm volatile("global_load_dwordx2 %0, %1, off" : "=v"(dst) : "v"(ptr) : "memory")
#define GLD4(dst, ptr) asm volatile("global_load_dword %0, %1, off" : "=v"(dst) : "v"(ptr) : "memory")
#define SC_DECL(S)                                                   \
  u32x4 S##w0, S##w1, S##q0, S##q1, S##k0, S##k1, S##a;              \
  float S##gq0, S##gq1, S##g63;                                      \
  u32x2 S##u;                                                        \
  int S##row0 = 0, S##lat = 0;
#define SC_PF_ONE(S, i)                                                                            \
    {                                                                                              \
      const int id = tid + (i) * 512;                                                              \
      const int p = id >> 4, seg = id & 15;                                                        \
      const int tk = dir ? (63 - p) : p;                                                           \
      GLD16(S##w##i, Wg + it2__ * 8192 + p * 128 + seg * 8);                                       \
      GLD16(S##q##i, QKN + (size_t)(S##row0 + tk) * 1024 + h * 128 + seg * 8);                     \
      GLD4(S##gq##i, GC + it2__ * 64 + p);                                                         \
      GLD16(S##k##i, QKN + (size_t)(S##row0 + tk) * 1024 + 512 + h * 128 + seg * 8);               \
    }
#define SC_PREFETCH(S, n_)                                                                         \
  {                                                                                                \
    const int n__ = (n_);                                                                          \
    int cid__;                                                                                     \
    if (n__ < 4) { cid__ = 256 + b * 4 + (dir ? (3 - n__) : n__); S##lat = 0; }                    \
    else { const int m__ = n__ - 4; cid__ = b * 64 + (dir ? (63 - m__) : m__); S##lat = 1; }       \
    S##row0 = cid__ * 64;                                                                          \
    const size_t it2__ = (size_t)((cid__ * 4 + h) * 2 + dir);                                      \
    SC_PF_ONE(S, 0)                                                                                \
    SC_PF_ONE(S, 1)                                                                                \
    GLD4(S##g63, GC + it2__ * 64 + 63);                                                            \
    GLD16(S##a, AQg + it2__ * 4096 + (tid >> 3) * 64 + (tid & 7) * 8);                             \
    GLD8(S##u, UFg + (it2__ * 128 + dv0 + fr) * 64 + wq * 16 + fq * 4);                            \
  }
#define SC_WAIT(S, CNT)                                                                            \
  asm volatile("s_waitcnt vmcnt(" #CNT ")"                                                         \
               : "+v"(S##w0), "+v"(S##w1), "+v"(S##q0), "+v"(S##q1), "+v"(S##k0), "+v"(S##k1), "+v"(S##a), \
                 "+v"(S##gq0), "+v"(S##gq1), "+v"(S##g63), "+v"(S##u)                              \
               :: "memory");
#define SC_STAGE_ONE(S, i)                                                    \
    {                                                                         \
      const int id = tid + (i) * 512;                                         \
      const int p = id >> 4, seg = id & 15;                                   \
      *(u32x4*)(Wl + p * 136 + seg * 8) = S##w##i;                            \
      float f[8];                                                             \
      unpack8(make_uint4(S##q##i.x, S##q##i.y, S##q##i.z, S##q##i.w), f);     \
      const float sq = __expf(S##gq##i);                                      \
      f[0] *= sq; f[1] *= sq; f[2] *= sq; f[3] *= sq; f[4] *= sq; f[5] *= sq; f[6] *= sq; f[7] *= sq; \
      *(uint4*)(QTl + p * 136 + seg * 8) = pack8(f);                          \
      unpack8(make_uint4(S##k##i.x, S##k##i.y, S##k##i.z, S##k##i.w), f);     \
      const float sk = __expf(S##g63 - S##gq##i);                             \
      u16* kd = KTl + (seg * 8) * 72 + (p ^ ((seg & 7) << 3));                \
      kd[0 * 72] = f2bf(f[0] * sk); kd[1 * 72] = f2bf(f[1] * sk); kd[2 * 72] = f2bf(f[2] * sk); kd[3 * 72] = f2bf(f[3] * sk); \
      kd[4 * 72] = f2bf(f[4] * sk); kd[5 * 72] = f2bf(f[5] * sk); kd[6 * 72] = f2bf(f[6] * sk); kd[7 * 72] = f2bf(f[7] * sk); \
    }
#define SC_STEP(S, n_, WCNT, DO_PF)                                                                   \
  {                                                                                                   \
    SC_WAIT(S, WCNT)                                                                                  \
    const int cur_row0 = S##row0, cur_lat = S##lat;                                                   \
    const float gl = __expf(S##g63);                                                                  \
    SC_STAGE_ONE(S, 0)                                                                                \
    SC_STAGE_ONE(S, 1)                                                                                \
    *(u32x4*)(AQl + (tid >> 3) * 72 + (tid & 7) * 8) = S##a;                                          \
    f32x4 av = f32x4{lo16(S##u.x), hi16(S##u.x), lo16(S##u.y), hi16(S##u.y)};                         \
    f32x4 ao = f32x4{0.f, 0.f, 0.f, 0.f};                                                             \
    lds_barrier();                                                                                    \
    if (DO_PF) SC_PREFETCH(S, (n_) + 2)                                                               \
    scan_chunk(Wl, QTl, KTl, AQl, ST, VT, wd, wq, fr, fq, gl, av, ao, accS0, accS1);                  \
    if (cur_lat) {                                                                                    \
      const int p0 = wq * 16 + fq * 4;                                                                \
      u16* og = Og + ((size_t)dir * 16384 + cur_row0) * 512 + h * 128 + dv0 + fr;                     \
      og[(size_t)(dir ? (63 - (p0 + 0)) : (p0 + 0)) * 512] = f2bf(ao[0]);                             \
      og[(size_t)(dir ? (63 - (p0 + 1)) : (p0 + 1)) * 512] = f2bf(ao[1]);                             \
      og[(size_t)(dir ? (63 - (p0 + 2)) : (p0 + 2)) * 512] = f2bf(ao[2]);                             \
      og[(size_t)(dir ? (63 - (p0 + 3)) : (p0 + 3)) * 512] = f2bf(ao[3]);                             \
    }                                                                                                 \
    lds_barrier();                                                                                    \
  }
  SC_DECL(A)
  SC_DECL(B)
  SC_PREFETCH(A, 0)
  SC_PREFETCH(B, 1)
  for (int n = 0; n < 66; n += 2) {
    SC_STEP(A, n, 11, true)
    SC_STEP(B, n + 1, 11, true)
  }
  SC_STEP(A, 66, 0, false)
  SC_STEP(B, 67, 0, false)
#undef SC_DECL
#undef SC_PF_ONE
#undef SC_PREFETCH
#undef SC_WAIT
#undef SC_STAGE_ONE
#undef SC_STEP
#undef GLD16
#undef GLD8
#undef GLD4
}

__device__ __forceinline__ void s5_carry_block(const Params& P, int cb) {
  const int idx = cb * NT + opq(threadIdx.x);
  const int n = idx & 63, g = (idx >> 6) & 31, r = (idx >> 11) & 1, b = idx >> 12;
  const int rg = r * 32 + g;
  const float step = expf(P.s5_log_step[rg]);
  float lr, li;
  lam_pow(step, P.s5_a_re[rg * 64 + n], P.s5_a_im[rg * 64 + n], 32, lr, li);
  const float* __restrict__ E = (const float*)(P.ws + OFF_E) + (size_t)g * 544 * 256 + r * 128 + n;
  u16* __restrict__ XIN = (u16*)(P.ws + OFF_XIN) + (size_t)g * 512 * 256 + r * 128 + n;
  float xr = 0.f, xi = 0.f;
  {
    float er[8], ei[8];
#pragma unroll
    for (int k = 0; k < 8; ++k) {
      const int row = 512 + b * 8 + (r ? (7 - k) : k);
      er[k] = E[(size_t)row * 256]; ei[k] = E[(size_t)row * 256 + 64];
    }
#pragma unroll
    for (int k = 0; k < 8; ++k) {
      const float nr = lr * xr - li * xi + er[k], ni = lr * xi + li * xr + ei[k];
      xr = nr; xi = ni;
    }
  }
  for (int k0 = 0; k0 < 128; k0 += 8) {
    float er[8], ei[8];
#pragma unroll
    for (int k = 0; k < 8; ++k) {
      const int row = b * 128 + (r ? (127 - (k0 + k)) : (k0 + k));
      er[k] = E[(size_t)row * 256]; ei[k] = E[(size_t)row * 256 + 64];
    }
#pragma unroll
    for (int k = 0; k < 8; ++k) {
      const int row = b * 128 + (r ? (127 - (k0 + k)) : (k0 + k));
      XIN[(size_t)row * 256] = f2bf(xr);
      XIN[(size_t)row * 256 + 64] = f2bf(xi);
      const float nr = lr * xr - li * xi + er[k], ni = lr * xi + li * xr + ei[k];
      xr = nr; xi = ni;
    }
  }
}

__device__ __forceinline__ void s5out_tile(const Params& P, int t, char* lds) {
  const int g = t >> 3, mt = (t >> 2) & 1, nt = t & 3;
  const int m0 = mt * 256, n0 = nt * 128;
  f32x16 acc[2][2];
  acc_zero(acc);
  gemm_main((const u16*)(P.ws + OFF_XIN) + ((size_t)g * 512 + m0) * 256, 256,
            (const u16*)(P.ws + OFF_MST) + ((size_t)g * 512 + n0) * 256, 256, 256, acc, (u16*)lds);
  gemm_main((const u16*)(P.ws + OFF_U5) + ((size_t)g * 544 + m0) * 512, 512,
            (const u16*)(P.ws + OFF_MINTRA) + ((size_t)g * 512 + n0) * 512, 512, 512, acc, (u16*)lds);
  TILE_COORDS
  u16* YB = (u16*)(P.ws + OFF_YB);
#pragma unroll
  for (int i = 0; i < 2; ++i)
#pragma unroll
    for (int j = 0; j < 2; ++j)
#pragma unroll
      for (int e = 0; e < 16; ++e) {
        const int row = TROW(m0, i, e), nn = TCOL(n0, j);
        const int token = row * 32 + (nn >> 4);
        YB[(size_t)token * 512 + g * 16 + (nn & 15)] = f2bf(gelu_tanh(acc[i][j][e]));
      }
}

__device__ __forceinline__ void delta_post_item(const Params& P, int item) {
  const int lane = opq(threadIdx.x) & 63, w = opq(threadIdx.x) >> 6;
  const int row = item * 8 + w;
  const u16* O = (const u16*)(P.ws + OFF_O);
  const uint4 o0 = *(const uint4*)(O + (size_t)row * 512 + lane * 8);
  const uint4 o1 = *(const uint4*)(O + ((size_t)16384 + row) * 512 + lane * 8);
  const uint4 zz = *(const uint4*)((const u16*)(P.ws + OFF_Z) + (size_t)row * 512 + lane * 8);
  float a[8], bq[8], z[8];
  unpack8(o0, a); unpack8(o1, bq); unpack8(zz, z);
  float ss = 0.f;
#pragma unroll
  for (int e = 0; e < 8; ++e) { a[e] += bq[e]; ss += a[e] * a[e]; }
  ss += __shfl_xor(ss, 1, 64); ss += __shfl_xor(ss, 2, 64); ss += __shfl_xor(ss, 4, 64); ss += __shfl_xor(ss, 8, 64);
  const float rstd = rsqrtf(ss * (1.f / 128.f) + 1e-6f);
  const float* nw = P.dn_norm_w + (lane & 15) * 8;
  float y[8];
#pragma unroll
  for (int e = 0; e < 8; ++e) y[e] = a[e] * rstd * nw[e] * (z[e] * sigm(z[e]));
  *(uint4*)((u16*)(P.ws + OFF_YA) + (size_t)row * 512 + lane * 8) = pack8(y);
}

__device__ __forceinline__ void glu_tile(const Params& P, int t, char* lds) {
  int nt, mt;
  tile_map8(t, nt, mt);
  const int m0 = mt * 256, n0 = nt * 128;
  f32x16 acc[2][2];
  acc_zero(acc);
  gemm_main((const u16*)(P.ws + OFF_YB) + (size_t)m0 * 512, 512, (const u16*)(P.ws + OFF_WT_GLU) + (size_t)n0 * 512, 512, 512, acc, (u16*)lds);
  TILE_COORDS
  u16* YG = (u16*)(P.ws + OFF_YG);
  {
    const int oc = nt * 64 + wn_ * 32 + fr_;
    const float bv = P.b_glu[oc], bg = P.b_glu[512 + oc];
#pragma unroll
    for (int i = 0; i < 2; ++i)
#pragma unroll
      for (int e = 0; e < 16; ++e) {
        const float val = acc[i][0][e] + bv, gt = acc[i][1][e] + bg;
        YG[TIDX2(m0, nt * 64 + wn_ * 32, i, e, 512)] = f2bf(val * sigm(gt));
      }
  }
}

__device__ __forceinline__ void gates_tile(const Params& P, int t, char* lds) {
  int nt, mt;
  tile_map8(t, nt, mt);
  const int m0 = mt * 256, n0 = nt * 128;
  f32x16 acc[2][2];
  acc_zero(acc);
  gemm_main((const u16*)(P.ws + OFF_R2) + (size_t)m0 * 1024, 1024, (const u16*)(P.ws + OFF_WT_IN) + (size_t)(2688 + n0) * 1024, 1024, 1024, acc, (u16*)lds);
  TILE_COORDS
  u16* SG = (u16*)(P.ws + OFF_SG);
#pragma unroll
  for (int i = 0; i < 2; ++i)
#pragma unroll
    for (int j = 0; j < 2; ++j)
#pragma unroll
      for (int e = 0; e < 16; ++e) SG[TIDX(m0, n0, i, j, e, 2048)] = f2bf(sigm(acc[i][j][e]));
}

__device__ __forceinline__ void mix_tile(const Params& P, int t, char* lds) {
  int nt, mt;
  tile_map8(t, nt, mt);
  const int m0 = mt * 256, n0 = nt * 128;
  const u16* SG = (const u16*)(P.ws + OFF_SG);
  f32x16 acc[2][2];
  u16* MIX = (u16*)(P.ws + OFF_MIX);
  acc_zero(acc);
  gemm_main((const u16*)(P.ws + OFF_YA) + (size_t)m0 * 512, 512, (const u16*)(P.ws + OFF_WT_AOUT) + (size_t)n0 * 512, 512, 512, acc, (u16*)lds);
  {
    TILE_COORDS
    u16 sv[2][2][16];
#pragma unroll
    for (int i = 0; i < 2; ++i)
#pragma unroll
      for (int j = 0; j < 2; ++j)
#pragma unroll
        for (int e = 0; e < 16; ++e) sv[i][j][e] = SG[TIDX(m0, n0, i, j, e, 2048)];
#pragma unroll
    for (int i = 0; i < 2; ++i)
#pragma unroll
      for (int j = 0; j < 2; ++j)
#pragma unroll
        for (int e = 0; e < 16; ++e) MIX[TIDX(m0, n0, i, j, e, 1024)] = f2bf(bf2f(sv[i][j][e]) * acc[i][j][e]);
  }
  acc_zero(acc);
  gemm_main((const u16*)(P.ws + OFF_YG) + (size_t)m0 * 512, 512, (const u16*)(P.ws + OFF_WT_BOUT) + (size_t)n0 * 512, 512, 512, acc, (u16*)lds);
  {
    TILE_COORDS
#pragma unroll
    for (int i = 0; i < 2; ++i) {
      u16 sv[2][16], pv[2][16];
#pragma unroll
      for (int j = 0; j < 2; ++j)
#pragma unroll
        for (int e = 0; e < 16; ++e) {
          sv[j][e] = SG[TIDX(m0, n0, i, j, e, 2048) + 1024];
          pv[j][e] = MIX[TIDX(m0, n0, i, j, e, 1024)];
        }
#pragma unroll
      for (int j = 0; j < 2; ++j)
#pragma unroll
        for (int e = 0; e < 16; ++e)
          MIX[TIDX(m0, n0, i, j, e, 1024)] = f2bf(bf2f(pv[j][e]) + bf2f(sv[j][e]) * acc[i][j][e]);
    }
  }
}

__device__ __forceinline__ void wo_tile(const Params& P, int t, char* lds) {
  int nt, mt;
  tile_map8(t, nt, mt);
  const int m0 = mt * 256, n0 = nt * 128;
  f32x16 acc[2][2];
  acc_zero(acc);
  gemm_main((const u16*)(P.ws + OFF_MIX) + (size_t)m0 * 1024, 1024, (const u16*)(P.ws + OFF_WT_O) + (size_t)n0 * 1024, 1024, 1024, acc, (u16*)lds);
  TILE_COORDS
  const float* MOD = (const float*)(P.ws + OFF_MOD) + (m0 >> 12) * 6144 + 2 * 1024;
  float xv[2][2][16];
#pragma unroll
  for (int j = 0; j < 2; ++j)
#pragma unroll
    for (int i = 0; i < 2; ++i)
#pragma unroll
      for (int e = 0; e < 16; ++e) xv[i][j][e] = P.x[TIDX(m0, n0, i, j, e, 1024)];
#pragma unroll
  for (int j = 0; j < 2; ++j) {
    const int col = TCOL(n0, j);
    const float gate = MOD[col];
#pragma unroll
    for (int i = 0; i < 2; ++i)
#pragma unroll
      for (int e = 0; e < 16; ++e) P.out[TIDX(m0, n0, i, j, e, 1024)] = xv[i][j][e] + gate * acc[i][j][e];
  }
}

__device__ __forceinline__ void norm2_item(const Params& P, int item) {
  const int lane = opq(threadIdx.x) & 63, w = opq(threadIdx.x) >> 6;
  const int rowA = item * 16 + w, rowB = rowA + 8;
  const float* MA = (const float*)(P.ws + OFF_MOD) + (rowA >> 12) * 6144;
  const float* MB = (const float*)(P.ws + OFF_MOD) + (rowB >> 12) * 6144;
  u16* H = (u16*)(P.ws + OFF_R2);
  norm_row2(P.out + (size_t)rowA * 1024, P.out + (size_t)rowB * 1024, P.norm2_w, MA + 3 * 1024, MA + 4 * 1024, MB + 3 * 1024, MB + 4 * 1024,
            H + (size_t)rowA * 1024, H + (size_t)rowB * 1024, lane);
}

__device__ __forceinline__ void up_tile(const Params& P, int t, int hh, char* lds) {
  int nt = t >> 6, mt = t & 63;
  if (t < 1024) tile_map8(t, nt, mt);
  const int m0 = mt * 256, n0 = nt * 128;
  f32x16 acc[2][2];
  acc_zero(acc);
  gemm_main((const u16*)(P.ws + OFF_R2) + (size_t)m0 * 1024, 1024,
            (const u16*)(P.ws + OFF_WT_UP) + ((size_t)hh * 2816 + n0) * 1024, 1024, 1024, acc, (u16*)lds);
  TILE_COORDS
  u16* UPH = (u16*)(P.ws + OFF_UPH);
#pragma unroll
  for (int i = 0; i < 2; ++i)
#pragma unroll
    for (int j = 0; j < 2; ++j)
#pragma unroll
      for (int e = 0; e < 16; ++e) UPH[TIDX(m0, n0, i, j, e, 2816)] = f2bf(acc[i][j][e]);
}

#define CG_LD(ci, dy)                                                                       \
    {                                                                                       \
      const int xc = x0 - 1 + (ci);                                                         \
      const bool cok = (xc >= 0) && (xc <= 63);                                             \
      const bool rok = ((dy) == 1) || ((dy) == 0 ? r0ok : r2ok);                            \
      const int yy = rok ? (y + (dy) - 1) : y;                                              \
      const u16* src = UPH + (base + (size_t)yy * 64 + (cok ? xc : x0)) * 2816 + c4 * 2;    \
      const uint4 q__ = *(const uint4*)src;               \
      uint2 g__ = make_uint2(q__.x, q__.y);                                                 \
      uint2 v__ = make_uint2(q__.z, q__.w);                                                 \
      const bool ok = cok && rok;                                                           \
      g__.x = ok ? g__.x : 0u; g__.y = ok ? g__.y : 0u;                                     \
      v__.x = ok ? v__.x : 0u; v__.y = ok ? v__.y : 0u;                                     \
      gg[ci][dy] = g__; vv[ci][dy] = v__;                                                   \
    }
__device__ __forceinline__ void convgate_phase(const Params& P, int hh) {
  const int tid = opq(threadIdx.x);
  if (tid >= 352) return;
  const int c4 = tid * 4;
  const u16* UPH = (const u16*)(P.ws + OFF_UPH);
  u16* G = (u16*)(P.ws + OFF_G);
  float wg[9][4], wv[9][4];
#pragma unroll
  for (int k = 0; k < 9; ++k) {
    const float4 a = *(const float4*)(P.ffn_conv_w + (size_t)k * 5632 + hh * 1408 + c4);
    const float4 bq = *(const float4*)(P.ffn_conv_w + (size_t)k * 5632 + 2816 + hh * 1408 + c4);
    wg[k][0] = a.x; wg[k][1] = a.y; wg[k][2] = a.z; wg[k][3] = a.w;
    wv[k][0] = bq.x; wv[k][1] = bq.y; wv[k][2] = bq.z; wv[k][3] = bq.w;
  }
  for (int item = blockIdx.x; item < 4096; item += gridDim.x) {
  const int xo = item & 15, y = (item >> 4) & 63, b = item >> 10;
  const size_t base = (size_t)b * 4096;
  const bool r0ok = (y > 0), r2ok = (y < 63);
  const int x0 = xo * 4;
  uint2 gg[6][3], vv[6][3];
#pragma unroll
  for (int ci = 0; ci < 6; ++ci) {
    CG_LD(ci, 0)
    CG_LD(ci, 1)
    CG_LD(ci, 2)
  }
#pragma unroll
  for (int xx = 0; xx < 4; ++xx) {
    float ag[4] = {0.f, 0.f, 0.f, 0.f}, av[4] = {0.f, 0.f, 0.f, 0.f};
#pragma unroll
    for (int dy = 0; dy < 3; ++dy)
#pragma unroll
      for (int dx = 0; dx < 3; ++dx) {
        const uint2 gq = gg[xx + dx][dy], vq = vv[xx + dx][dy];
        const int k = dy * 3 + dx;
        ag[0] += wg[k][0] * lo16(gq.x); ag[1] += wg[k][1] * hi16(gq.x); ag[2] += wg[k][2] * lo16(gq.y); ag[3] += wg[k][3] * hi16(gq.y);
        av[0] += wv[k][0] * lo16(vq.x); av[1] += wv[k][1] * hi16(vq.x); av[2] += wv[k][2] * lo16(vq.y); av[3] += wv[k][3] * hi16(vq.y);
      }
    uint2 o;
    o.x = pack2(ag[0] * sigm(ag[0]) * av[0], ag[1] * sigm(ag[1]) * av[1]);
    o.y = pack2(ag[2] * sigm(ag[2]) * av[2], ag[3] * sigm(ag[3]) * av[3]);
    *(uint2*)(G + (base + y * 64 + x0 + xx) * 2816 + hh * 1408 + c4) = o;
  }
  }
}
#undef CG_LD

__device__ __forceinline__ void down_tile(const Params& P, int t, char* lds) {
  int nt, mt;
  tile_map8(t, nt, mt);
  const int m0 = mt * 256, n0 = nt * 128;
  f32x16 acc[2][2];
  acc_zero(acc);
  gemm_main((const u16*)(P.ws + OFF_G) + (size_t)m0 * 2816, 2816, (const u16*)(P.ws + OFF_WT_DOWN) + (size_t)n0 * 2816, 2816, 2816, acc, (u16*)lds);
  TILE_COORDS
  const float* MOD = (const float*)(P.ws + OFF_MOD) + (m0 >> 12) * 6144 + 5 * 1024;
  float xv[2][2][16];
#pragma unroll
  for (int j = 0; j < 2; ++j)
#pragma unroll
    for (int i = 0; i < 2; ++i)
#pragma unroll
      for (int e = 0; e < 16; ++e) xv[i][j][e] = P.out[TIDX(m0, n0, i, j, e, 1024)];
#pragma unroll
  for (int j = 0; j < 2; ++j) {
    const int col = TCOL(n0, j);
    const float gate = MOD[col];
#pragma unroll
    for (int i = 0; i < 2; ++i)
#pragma unroll
      for (int e = 0; e < 16; ++e) P.out[TIDX(m0, n0, i, j, e, 1024)] = xv[i][j][e] + gate * acc[i][j][e];
  }
}

__device__ __forceinline__ void final_item(const Params& P, int item) {
  const int lane = opq(threadIdx.x) & 63, w = opq(threadIdx.x) >> 6;
  const int row = item * 8 + w;
  float* xr = P.out + (size_t)row * 1024;
  float4 v[4];
  float ss = 0.f;
#pragma unroll
  for (int it = 0; it < 4; ++it) {
    v[it] = *(const float4*)(xr + (it * 64 + lane) * 4);
    ss += v[it].x * v[it].x + v[it].y * v[it].y + v[it].z * v[it].z + v[it].w * v[it].w;
  }
  ss = wsum64(ss);
  const float rstd = rsqrtf(ss * (1.f / 1024.f) + 1e-6f);
#pragma unroll
  for (int it = 0; it < 4; ++it) {
    const int c = (it * 64 + lane) * 4;
    const float4 w4 = *(const float4*)(P.norm_f_w + c);
    float4 o;
    o.x = v[it].x * rstd * w4.x; o.y = v[it].y * rstd * w4.y; o.z = v[it].z * rstd * w4.z; o.w = v[it].w * rstd * w4.w;
    *(float4*)(xr + c) = o;
  }
}

__device__ __forceinline__ void run_phase(const Params& P, int ph, char* lds) {
  const int bid = blockIdx.x, nb = gridDim.x;
#ifdef ONLY_PHASE
  if (ph != ONLY_PHASE) return;
#endif
  switch (ph) {
    case 0: {
      for (int it = bid; it < 984 + 192 + 512; it += nb) {
        if (it < 296) convert_item(P.w_in, 1024, 4624, (u16*)(P.ws + OFF_WT_IN), 0, it, lds);
        else if (it < 328) convert_item(P.w_a_out, 512, 1024, (u16*)(P.ws + OFF_WT_AOUT), 1, it - 296, lds);
        else if (it < 360) convert_item(P.w_glu, 512, 1024, (u16*)(P.ws + OFF_WT_GLU), 2, it - 328, lds);
        else if (it < 392) convert_item(P.w_b_out, 512, 1024, (u16*)(P.ws + OFF_WT_BOUT), 3, it - 360, lds);
        else if (it < 456) convert_item(P.w_o, 1024, 1024, (u16*)(P.ws + OFF_WT_O), 4, it - 392, lds);
        else if (it < 808) convert_item(P.w_up, 1024, 5632, (u16*)(P.ws + OFF_WT_UP), 5, it - 456, lds);
        else if (it < 984) convert_item(P.w_down, 2816, 1024, (u16*)(P.ws + OFF_WT_DOWN), 6, it - 808, lds);
        else if (it < 1176) mod_item(P, it - 984, lds);
        else s5tab_item(P, it - 1176, lds);
      }
    } break;
    case 1:
      for (int it = bid; it < 1088 + 2048; it += nb) {
        if (it < 1088) norm1_item(P, it); else mintra_item(P, it - 1088);
      }
      break;
    case 2:
      for (int it = bid; it < 1396; it += nb) inproj_tile(P, it, lds);
      break;
    case 3:
      for (int it = bid; it < 1088 + 192; it += nb) {
        if (it < 1088) delta_prep_item(P, it, lds); else s5end_tile(P, it - 1088, lds);
      }
      break;
    case 4:
      if (bid < 128) delta_scan_block(P, bid, lds);
      else if (bid < 160) s5_carry_block(P, bid - 128);
      break;
    case 5:
      for (int it = bid; it < 256 + 2048 + 1024; it += nb) {
        if (it < 256) s5out_tile(P, it, lds);
        else if (it < 2304) delta_post_item(P, it - 256);
        else norm1_item(P, it - 2304);
      }
      break;
    case 6:
      for (int it = bid; it < 512 + 1024; it += nb) {
        if (it < 512) glu_tile(P, it, lds); else gates_tile(P, it - 512, lds);
      }
      break;
    case 7:
      for (int it = bid; it < 512; it += nb) mix_tile(P, it, lds);
      break;
    case 8:
      for (int it = bid; it < 512; it += nb) wo_tile(P, it, lds);
      break;
    case 9:
      for (int it = bid; it < 1024; it += nb) norm2_item(P, it);
      break;
    case 10:
      for (int it = bid; it < 1408; it += nb) up_tile(P, it, 0, lds);
      break;
    case 11:
      convgate_phase(P, 0);
      break;
    case 12:
      for (int it = bid; it < 1408; it += nb) up_tile(P, it, 1, lds);
      break;
    case 13:
      convgate_phase(P, 1);
      break;
    case 14:
      for (int it = bid; it < 512; it += nb) down_tile(P, it, lds);
      break;
    case 15:
      for (int it = bid; it < 2048; it += nb) final_item(P, it);
      break;
    default: break;
  }
}

typedef const __attribute__((address_space(4))) Params* KParamsPtr;
__global__ void __launch_bounds__(NT) fwd_megakernel(Params Pk) {
#if defined(__HIP_DEVICE_COMPILE__)
  extern __shared__ __attribute__((aligned(16))) char lds[];
  KParamsPtr pp = (KParamsPtr)__builtin_amdgcn_kernarg_segment_ptr();
  const int lo = (int)pp->ph_lo, hi = (int)pp->ph_hi;
#if MULTI_LAUNCH
  for (int ph = lo; ph < hi; ++ph) { KParamsPtr q = pp; asm volatile("" : "+s"(q)); Params P; for (int i_ = 0; i_ < (int)(sizeof(Params) / 8); ++i_) ((unsigned long long*)&P)[i_] = ((const __attribute__((address_space(4))) unsigned long long*)q)[i_]; run_phase(P, ph, lds); }
#else
  cg::grid_group grid = cg::this_grid();
  volatile LAS unsigned* xst = (volatile LAS unsigned*)(lds + (LDS_BYTES - 16));
  if (threadIdx.x == 0) { xst[0] = 0u; xst[1] = 0u; xst[2] = 0u; xst[3] = 0u; }
  __syncthreads();
  XcdBarrier xb = xcd_barrier_post((unsigned*)(pp->ws + OFF_BAR), xst);
  const unsigned rep_mask = (unsigned)pp->rep_mask;
  bool first_sync = true;
  for (int ph = lo; ph < hi; ++ph) {
    const int reps = 1 + (int)((rep_mask >> ph) & 1u);
    for (int rp = 0; rp < reps; ++rp) {
      {
        KParamsPtr q = pp;
        asm volatile("" : "+s"(q));
        Params P;
        {
          typedef __attribute__((address_space(1))) const float* GF;
          const float** dp = (const float**)&P;
          const __attribute__((address_space(4))) unsigned long long* sp = (const __attribute__((address_space(4))) unsigned long long*)q;
#pragma unroll
          for (int i_ = 0; i_ < 30; ++i_) dp[i_] = (const float*)(GF)(sp[i_]);
          P.out = (float*)(__attribute__((address_space(1))) float*)(sp[30]);
          P.ws = (char*)(__attribute__((address_space(1))) char*)(sp[31]);
          P.ph_lo = 0; P.ph_hi = 0; P.rep_mask = 0;
        }
        run_phase(P, ph, lds);
      }
      if (ph + 1 < hi || rp + 1 < reps) {
        if (first_sync) { grid.sync(); first_sync = false; }
        else xcd_barrier(xb);
      }
    }
  }
#endif
#endif
}

extern "C" void kernel_launch(void* const* d_in, const int* in_sizes, int n_in, void* d_out, int out_size, void* d_ws,
                              size_t ws_size, hipStream_t stream) {
  static int grid_blocks = 0;
  if (grid_blocks == 0) {
    if (n_in != 30 || out_size != 16384 * 1024 || ws_size < WS_NEED) {
      fprintf(stderr, "kernel_launch: unexpected shapes: n_in %d out %d ws %zu (need %zu)\n", n_in, out_size, ws_size, (size_t)WS_NEED);
      grid_blocks = -1;
      return;
    }
    int dev = 0, cus = 0, per_cu = 0;
    hipGetDevice(&dev);
    hipDeviceGetAttribute(&cus, hipDeviceAttributeMultiprocessorCount, dev);
    if (hipFuncSetAttribute((const void*)fwd_megakernel, hipFuncAttributeMaxDynamicSharedMemorySize, LDS_BYTES) != hipSuccess) {
      fprintf(stderr, "kernel_launch: hipFuncSetAttribute failed\n");
      grid_blocks = -1;
      return;
    }
    if (hipOccupancyMaxActiveBlocksPerMultiprocessor(&per_cu, (const void*)fwd_megakernel, NT, LDS_BYTES) != hipSuccess || per_cu < 1) {
      fprintf(stderr, "kernel_launch: occupancy query failed / zero (%d)\n", per_cu);
      grid_blocks = -1;
      return;
    }
    grid_blocks = cus;
    if (grid_blocks < 64) { fprintf(stderr, "kernel_launch: too few CUs (%d)\n", cus); grid_blocks = -1; return; }
  }
  if (grid_blocks < 0) return;
  (void)hipMemsetAsync((char*)d_ws + OFF_BAR, 0, XCD_BAR_WORDS * sizeof(unsigned), stream);
  Params p{};
  const float** pp = (const float**)&p;
  for (int i = 0; i < 30; ++i) pp[i] = (const float*)d_in[i];
  p.out = (float*)d_out;
  p.ws = (char*)d_ws;
#if MULTI_LAUNCH
  for (int ph = 0; ph < 16; ++ph) {
    p.ph_lo = ph; p.ph_hi = ph + 1;
    hipLaunchKernelGGL(fwd_megakernel, dim3(grid_blocks), dim3(NT), LDS_BYTES, stream, p);
  }
#else
  p.ph_lo = 0; p.ph_hi = 16;
#ifdef REPEAT_MASK
  p.rep_mask = REPEAT_MASK;
#endif
  void* args[] = {&p};
  hipError_t e = hipLaunchCooperativeKernel((const void*)fwd_megakernel, dim3(grid_blocks), dim3(NT), args, LDS_BYTES, stream);
  if (e != hipSuccess) fprintf(stderr, "cooperative launch failed: %s (grid %d)\n", hipGetErrorString(e), grid_blocks);
#endif
}
```
